# Optimizing an MI355X kernel written in HIP

```python
import math
import jax, jax.numpy as jnp
from jax import lax
import numpy as np

D_MODEL = 1024
BATCH = 16
SEQ = 256
DEPTH = 2
DEC_BATCH = 8
DEC_SEQ = 1024
PAST_LEN = 512

GRID_W = 64
MIX_W = D_MODEL
ATT_W = MIX_W // 2
SSM_W = MIX_W - ATT_W
N_HEADS = 4
D_V = ATT_W // N_HEADS
D_SUB = D_V // 2
ROPE_AXIS = D_SUB // 2
ROPE_THETA = 10000.0
Q_BLOCK = 128
SSM_CH = 16
SSM_GROUPS = SSM_W // SSM_CH
SSM_P = 64
D_FF = 2 * D_MODEL
CONV_W = 3
N_MOD = 6
EPS = 1e-6

kernel_name = 'hybrid_diffattn_s5_dit_step'


def rms_norm(x, g):
    xf = x.astype(jnp.float32)
    y = xf * lax.rsqrt(jnp.mean(xf * xf, axis=-1, keepdims=True) + EPS)
    return (y * g.astype(jnp.float32)).astype(x.dtype)


def adaln_mod(cond, w_mod_l, b_mod_l):
    m = jax.nn.silu(cond) @ w_mod_l + b_mod_l
    sh1, sc1, g1, sh2, sc2, g2 = jnp.split(m[:, None, :], N_MOD, axis=-1)
    return sh1, sc1, g1, sh2, sc2, g2


def modulate(x, g, shift, scale):
    return rms_norm(x, g) * (1.0 + scale) + shift


def axial_rope_tables(n_tokens):
    rows = n_tokens // GRID_W
    f32 = jnp.float32
    row = jnp.repeat(jnp.arange(rows, dtype=f32), GRID_W, total_repeat_length=n_tokens)
    col = jnp.tile(jnp.arange(GRID_W, dtype=f32), rows)
    nf = ROPE_AXIS // 2
    inv_freq = 1.0 / (ROPE_THETA ** (jnp.arange(nf, dtype=f32) / nf))
    ang_r = row[:, None] * inv_freq
    ang_c = col[:, None] * inv_freq
    return jnp.cos(ang_r), jnp.sin(ang_r), jnp.cos(ang_c), jnp.sin(ang_c)


def rotate(x, cos, sin):
    cos = cos[:, None, None, :]
    sin = sin[:, None, None, :]
    x1, x2 = jnp.split(x, 2, axis=-1)
    return jnp.concatenate([x1 * cos - x2 * sin, x1 * sin + x2 * cos], axis=-1)


def axial_rope(x, tables):
    cr, sr, cc, sc = tables
    xr, xc = jnp.split(x, 2, axis=-1)
    return jnp.concatenate([rotate(xr, cr, sr), rotate(xc, cc, sc)], axis=-1).astype(x.dtype)


def diff_attention(q, k, v, lam):
    B, Lq = q.shape[0], q.shape[1]
    nb = Lq // Q_BLOCK
    qb = q.reshape(B, nb, Q_BLOCK, N_HEADS, 2, D_SUB).transpose(1, 0, 2, 3, 4, 5)
    vf = v.astype(jnp.float32)
    scale = D_SUB ** -0.5

    def one_block(qblk):
        s = jnp.einsum('bqhsd,bkhsd->bhsqk', qblk, k).astype(jnp.float32) * scale
        p = jax.nn.softmax(s, axis=-1)
        a = p[:, :, 0] - lam * p[:, :, 1]
        return jnp.einsum('bhqk,bkhd->bqhd', a, vf)

    o = lax.map(one_block, qb)
    return o.transpose(1, 0, 2, 3, 4).reshape(B, Lq, N_HEADS, D_V)


def _lin_rec(e1, e2):
    a1, b1 = e1
    a2, b2 = e2
    return a1 * a2, a2 * b1 + b2


def to_complex(s):
    return lax.complex(s[..., 0].astype(jnp.float32), s[..., 1].astype(jnp.float32))


def to_real(h):
    return jnp.stack([jnp.real(h), jnp.imag(h)], axis=-1)


def s5_scan(ug, h0, lam_re, lam_im, log_step, b_re, b_im, c_re, c_im, reverse):
    f32 = jnp.float32
    lam = lax.complex(lam_re.astype(f32), lam_im.astype(f32))
    delta = jnp.exp(log_step.astype(f32))[:, None]
    lam_bar = jnp.exp(lam * delta)
    b_bar = ((lam_bar - 1.0) / lam)[..., None] * lax.complex(b_re.astype(f32), b_im.astype(f32))
    c = lax.complex(c_re.astype(f32), c_im.astype(f32))
    bu = jnp.einsum('blgc,gpc->blgp', ug, b_bar)
    edge = -1 if reverse else 0
    bu = bu.at[:, edge].add(lam_bar * h0)
    a = jnp.broadcast_to(lam_bar, bu.shape)
    _, h = lax.associative_scan(_lin_rec, (a, bu), reverse=reverse, axis=1)
    y = jnp.real(jnp.einsum('blgp,gcp->blgc', h, c))
    return y, h[:, edge]


def s5_bidirectional(u, h0, lam_re, lam_im, log_step, b_re, b_im, c_re, c_im, d):
    B, L, _ = u.shape
    uf = u.astype(jnp.float32)
    ug = uf.reshape(B, L, SSM_GROUPS, SSM_CH).astype(jnp.complex64)
    y_f, h_f = s5_scan(ug, h0[:, 0], lam_re[0], lam_im[0], log_step[0], b_re[0], b_im[0], c_re[0], c_im[0], False)
    y_b, h_b = s5_scan(ug, h0[:, 1], lam_re[1], lam_im[1], log_step[1], b_re[1], b_im[1], c_re[1], c_im[1], True)
    y = (y_f + y_b).reshape(B, L, SSM_W) + d.astype(jnp.float32) * uf
    return y, jnp.stack([h_f, h_b], axis=1)


def half_glu(y, w, b):
    z = jax.nn.gelu(y)
    return z * jax.nn.sigmoid(z @ w.astype(jnp.float32) + b.astype(jnp.float32))


def conv_ffn(h, w_up_l, conv_w_l, conv_b_l, w_down_l):
    up = h @ w_up_l
    L = up.shape[1]
    p = jnp.pad(up, ((0, 0), (1, 1), (0, 0)))
    z = p[:, :L] * conv_w_l[0] + p[:, 1:L + 1] * conv_w_l[1] + p[:, 2:] * conv_w_l[2] + conv_b_l
    val, gate = jnp.split(z, 2, axis=-1)
    return (jax.nn.silu(gate) * val) @ w_down_l


def setup_inputs(seed: int = 0) -> dict:
    key = jax.random.key(seed)
    ks = jax.random.split(key, 40)
    f32 = jnp.float32

    def nrm(i, shape, s):
        return jax.random.normal(ks[i], shape, f32) * s

    F2 = 2 * D_FF
    G, P, CH = SSM_GROUPS, SSM_P, SSM_CH
    return {
        'x_prompt': nrm(0, (BATCH, SEQ, D_MODEL), 1.0),
        'x_sample': nrm(1, (DEC_BATCH, DEC_SEQ, D_MODEL), 1.0),
        'cache_k': nrm(2, (DEC_BATCH, DEPTH, PAST_LEN, N_HEADS, 2, D_SUB), 1.0),
        'cache_v': nrm(3, (DEC_BATCH, DEPTH, PAST_LEN, N_HEADS, D_V), 0.5),
        'state_ssm': nrm(4, (DEC_BATCH, DEPTH, 2, G, P, 2), 0.3),
        'c': nrm(5, (DEC_BATCH, D_MODEL), 1.0),
        'c_ctx': nrm(6, (D_MODEL,), 1.0),
        'w_mod': nrm(7, (DEPTH, D_MODEL, N_MOD * D_MODEL), 0.5 * D_MODEL ** -0.5),
        'b_mod': nrm(8, (DEPTH, N_MOD * D_MODEL), 0.01),
        'g_norm1': 1.0 + nrm(9, (DEPTH, D_MODEL), 0.02),
        'w_in': nrm(10, (DEPTH, D_MODEL, 3 * ATT_W + SSM_W), D_MODEL ** -0.5),
        'q_norm': 1.0 + nrm(11, (DEPTH, D_SUB), 0.02),
        'k_norm': 1.0 + nrm(12, (DEPTH, D_SUB), 0.02),
        'lambda_q1': nrm(13, (DEPTH, D_SUB), 0.1),
        'lambda_k1': nrm(14, (DEPTH, D_SUB), 0.1),
        'lambda_q2': nrm(15, (DEPTH, D_SUB), 0.1),
        'lambda_k2': nrm(16, (DEPTH, D_SUB), 0.1),
        'subln_g': 1.0 + nrm(17, (DEPTH, D_V), 0.02),
        'ssm_lambda_re': -0.5 + nrm(18, (DEPTH, 2, G, P), 0.01),
        'ssm_lambda_im': jnp.pi * jnp.arange(P, dtype=f32) + nrm(19, (DEPTH, 2, G, P), 0.01),
        'ssm_log_step': jax.random.uniform(ks[20], (DEPTH, 2, G), f32, math.log(1e-3), math.log(1e-1)),
        'ssm_b_re': nrm(21, (DEPTH, 2, G, P, CH), (2 * CH) ** -0.5),
        'ssm_b_im': nrm(22, (DEPTH, 2, G, P, CH), (2 * CH) ** -0.5),
        'ssm_c_re': nrm(23, (DEPTH, 2, G, CH, P), (2 * P) ** -0.5),
        'ssm_c_im': nrm(24, (DEPTH, 2, G, CH, P), (2 * P) ** -0.5),
        'ssm_d': nrm(25, (DEPTH, SSM_W), 1.0),
        'w_glu': nrm(26, (DEPTH, SSM_W, SSM_W), SSM_W ** -0.5),
        'b_glu': nrm(27, (DEPTH, SSM_W), 0.01),
        'w_out': nrm(28, (DEPTH, MIX_W, D_MODEL), MIX_W ** -0.5),
        'g_norm2': 1.0 + nrm(29, (DEPTH, D_MODEL), 0.02),
        'w_up': nrm(30, (DEPTH, D_MODEL, F2), D_MODEL ** -0.5),
        'conv_w': nrm(31, (DEPTH, CONV_W, F2), 0.3) + jnp.array([0.0, 1.0, 0.0], f32)[None, :, None],
        'conv_b': nrm(32, (DEPTH, F2), 0.01),
        'w_down': nrm(33, (DEPTH, D_FF, D_MODEL), D_FF ** -0.5),
    }


def reference(x_prompt, x_sample, cache_k, cache_v, state_ssm, c, c_ctx, w_mod, b_mod, g_norm1, w_in,
              q_norm, k_norm, lambda_q1, lambda_k1, lambda_q2, lambda_k2, subln_g,
              ssm_lambda_re, ssm_lambda_im, ssm_log_step, ssm_b_re, ssm_b_im, ssm_c_re, ssm_c_im, ssm_d,
              w_glu, b_glu, w_out, g_norm2, w_up, conv_w, conv_b, w_down):
    f32 = jnp.float32

    def layer(x, cond, l, tables, ctx_k, ctx_v, h0):
        sh1, sc1, gt1, sh2, sc2, gt2 = adaln_mod(cond, w_mod[l], b_mod[l])
        B, L, _ = x.shape
        h = modulate(x, g_norm1[l], sh1, sc1)
        q, k, v, u = jnp.split(h @ w_in[l], [ATT_W, 2 * ATT_W, 3 * ATT_W], axis=-1)
        q = rms_norm(q.reshape(B, L, N_HEADS, 2, D_SUB), q_norm[l])
        k = rms_norm(k.reshape(B, L, N_HEADS, 2, D_SUB), k_norm[l])
        v = v.reshape(B, L, N_HEADS, D_V)
        if tables is None:
            keys, vals = k, v
        else:
            q = axial_rope(q, tables)
            keys = jnp.concatenate([ctx_k.astype(k.dtype), axial_rope(k, tables)], axis=1)
            vals = jnp.concatenate([ctx_v.astype(v.dtype), v], axis=1)
        lam_init = 0.8 - 0.6 * math.exp(-0.3 * l)
        lam = (jnp.exp(jnp.sum(lambda_q1[l].astype(f32) * lambda_k1[l].astype(f32)))
               - jnp.exp(jnp.sum(lambda_q2[l].astype(f32) * lambda_k2[l].astype(f32))) + lam_init)
        o_att = diff_attention(q, keys, vals, lam)
        o_att = (rms_norm(o_att, subln_g[l]) * (1.0 - lam_init)).reshape(B, L, ATT_W).astype(x.dtype)
        y_ssm, h_last = s5_bidirectional(u, h0, ssm_lambda_re[l], ssm_lambda_im[l], ssm_log_step[l],
                                         ssm_b_re[l], ssm_b_im[l], ssm_c_re[l], ssm_c_im[l], ssm_d[l])
        o_ssm = half_glu(y_ssm, w_glu[l], b_glu[l]).astype(x.dtype)
        x = x + gt1 * (jnp.concatenate([o_att, o_ssm], axis=-1) @ w_out[l])
        h2 = modulate(x, g_norm2[l], sh2, sc2)
        x = x + gt2 * conv_ffn(h2, w_up[l], conv_w[l], conv_b[l], w_down[l])
        return x, k, v, h_last

    cond_ctx = c_ctx[None, :]
    h0_zero = jnp.zeros((x_prompt.shape[0], 2, SSM_GROUPS, SSM_P), jnp.complex64)
    xp = x_prompt
    ks_, vs_, ss_ = [], [], []
    for l in range(DEPTH):
        xp, k_l, v_l, h_l = layer(xp, cond_ctx, l, None, None, None, h0_zero)
        ks_.append(k_l)
        vs_.append(v_l)
        ss_.append(to_real(h_l))
    new_k = jnp.stack(ks_, axis=1)
    new_v = jnp.stack(vs_, axis=1)
    new_ssm = jnp.stack(ss_, axis=1)

    tables = axial_rope_tables(x_sample.shape[1])
    xs = x_sample
    for l in range(DEPTH):
        xs, _, _, _ = layer(xs, c, l, tables, cache_k[:, l], cache_v[:, l], to_complex(state_ssm[:, l]))

    return (xp, xs, new_k, new_v, new_ssm)
```

```cpp
#include <hip/hip_runtime.h>
#include <cstdio>
#include <cstdint>
namespace nv {
constexpr int DM = 1024, NB = 16, SEQ = 256, DEPTH = 2, DB = 8, DSEQ = 1024, PAST = 512;
constexpr int MC = NB * SEQ, MS = DB * DSEQ, MT = MC + MS;
constexpr int NH = 4, DV = 128, DSUB = 64, SSMW = 512, NG = 32, CH = 16, SP = 64, DFF = 2048, F2 = 4096, NMOD = 6;
constexpr int NCOND = 9;
constexpr float EPS = 1e-6f;

__device__ __forceinline__ float silu_f(float x) { return x / (1.f + expf(-x)); }
__device__ __forceinline__ float gelu_tanh(float x) { const float k = 0.7978845608028654f; float u = k * (x + 0.044715f * x * x * x); return 0.5f * x * (1.f + tanhf(u)); }
__device__ __forceinline__ int cond_of_row(int row) { return row < MC ? 0 : 1 + (row - MC) / DSEQ; }

__global__ void __launch_bounds__(256) k_mod(const float* c, const float* c_ctx, const float* w_mod, const float* b_mod, float* mod) {
    int j = blockIdx.x * blockDim.x + threadIdx.x; int cond = blockIdx.y, l = blockIdx.z;
    if (j >= NMOD * DM) return;
    const float* cv = cond == 0 ? c_ctx : c + (size_t)(cond - 1) * DM;
    const float* w = w_mod + (size_t)l * DM * NMOD * DM;
    float acc = 0.f;
    for (int k = 0; k < DM; ++k) acc += silu_f(cv[k]) * w[(size_t)k * NMOD * DM + j];
    mod[((size_t)l * NCOND + cond) * NMOD * DM + j] = acc + b_mod[(size_t)l * NMOD * DM + j];
}
__global__ void __launch_bounds__(256) k_modulate(const float* x, const float* g, const float* modl, int sh_off, int sc_off, float* h) {
    int row = blockIdx.x; const float* xr = x + (size_t)row * DM; __shared__ float red[256];
    float s = 0.f; for (int i = threadIdx.x; i < DM; i += 256) s += xr[i] * xr[i];
    red[threadIdx.x] = s; __syncthreads();
    for (int o = 128; o > 0; o >>= 1) { if (threadIdx.x < o) red[threadIdx.x] += red[threadIdx.x + o]; __syncthreads(); }
    float rstd = rsqrtf(red[0] / DM + EPS);
    const float* m = modl + (size_t)cond_of_row(row) * NMOD * DM;
    for (int i = threadIdx.x; i < DM; i += 256) h[(size_t)row * DM + i] = xr[i] * rstd * g[i] * (1.f + m[sc_off + i]) + m[sh_off + i];
}
__global__ void __launch_bounds__(256) k_gemm(const float* A, int lda, const float* B, int ldb, float* C, int ldc, int K) {
    __shared__ float As[16][64 + 1], Bs[16][64];
    int tx = threadIdx.x & 15, ty = threadIdx.x >> 4; int m0 = blockIdx.y * 64, n0 = blockIdx.x * 64;
    float acc[4][4] = {};
    for (int k0 = 0; k0 < K; k0 += 16) {
        for (int i = threadIdx.x; i < 64 * 16; i += 256) { int r = i >> 4, kk = i & 15; As[kk][r] = A[(size_t)(m0 + r) * lda + k0 + kk]; }
        for (int i = threadIdx.x; i < 16 * 64; i += 256) { int kk = i >> 6, cc = i & 63; Bs[kk][cc] = B[(size_t)(k0 + kk) * ldb + n0 + cc]; }
        __syncthreads();
#pragma unroll
        for (int kk = 0; kk < 16; ++kk) { float a[4], b[4];
#pragma unroll
            for (int i = 0; i < 4; ++i) { a[i] = As[kk][ty * 4 + i]; b[i] = Bs[kk][tx * 4 + i]; }
#pragma unroll
            for (int i = 0; i < 4; ++i)
#pragma unroll
                for (int j = 0; j < 4; ++j) acc[i][j] += a[i] * b[j]; }
        __syncthreads();
    }
    for (int i = 0; i < 4; ++i) for (int j = 0; j < 4; ++j) C[(size_t)(m0 + ty * 4 + i) * ldc + n0 + tx * 4 + j] = acc[i][j];
}
__global__ void __launch_bounds__(256) k_qknorm_rope(float* qkvu, const float* qn, const float* kn, float* new_k, float* new_v, int l) {
    int row = blockIdx.x; float* r = qkvu + (size_t)row * 2048; __shared__ float buf[1024]; __shared__ float ss[16];
    int t = threadIdx.x;
    for (int i = t; i < 1024; i += 256) buf[i] = r[i];
    __syncthreads();
    if (t < 16) { float s = 0.f; for (int d = 0; d < 64; ++d) { float v = buf[t * 64 + d]; s += v * v; } ss[t] = rsqrtf(s / 64.f + EPS); }
    __syncthreads();
    for (int i = t; i < 1024; i += 256) { int grp = i >> 6, d = i & 63; buf[i] = buf[i] * ss[grp] * (i < 512 ? qn[d] : kn[d]); }
    __syncthreads();
    if (row < MC) { int b = row / SEQ, tt = row % SEQ; size_t o = (((size_t)b * DEPTH + l) * SEQ + tt) * 512;
        for (int i = t; i < 512; i += 256) { new_k[o + i] = buf[512 + i]; new_v[o + i] = r[1024 + i]; }
        for (int i = t; i < 1024; i += 256) r[i] = buf[i];
    } else {
        int tt = (row - MC) % DSEQ; float prow = (float)(tt / 64), pcol = (float)(tt % 64);
        for (int i = t; i < 1024; i += 256) { int d = i & 63, base = i - d; int half = d >> 5, dd = d & 31, f = dd & 15;
            float inv = 1.0f / powf(10000.0f, (float)f / 16.0f); float ang = (half ? pcol : prow) * inv; float cs = cosf(ang), sn = sinf(ang);
            float x1 = buf[base + half * 32 + f], x2 = buf[base + half * 32 + 16 + f];
            r[i] = (dd < 16) ? (x1 * cs - x2 * sn) : (x1 * sn + x2 * cs); }
    }
}
__device__ __forceinline__ float block_sum256(float v, float* red) { red[threadIdx.x] = v; __syncthreads();
    for (int o = 128; o > 0; o >>= 1) { if (threadIdx.x < o) red[threadIdx.x] += red[threadIdx.x + o]; __syncthreads(); }
    float r = red[0]; __syncthreads(); return r; }
__device__ __forceinline__ float block_max256(float v, float* red) { red[threadIdx.x] = v; __syncthreads();
    for (int o = 128; o > 0; o >>= 1) { if (threadIdx.x < o) red[threadIdx.x] = fmaxf(red[threadIdx.x], red[threadIdx.x + o]); __syncthreads(); }
    float r = red[0]; __syncthreads(); return r; }
__global__ void __launch_bounds__(256) k_attn(const float* qkvu, const float* cache_k, const float* cache_v, const float* lq1, const float* lk1, const float* lq2, const float* lk2,
                       const float* subln, float* cat, int l) {
    int row = blockIdx.x, h = blockIdx.y, t = threadIdx.x; __shared__ float sc[2][1536]; __shared__ float red[256]; __shared__ float qs[128]; __shared__ float ov[2][128];
    const bool ctx = row < MC; int b, Lk, row0;
    if (ctx) { b = row / SEQ; Lk = SEQ; row0 = b * SEQ; } else { b = (row - MC) / DSEQ; Lk = PAST + DSEQ; row0 = MC + b * DSEQ; }
    if (t < 128) qs[t] = qkvu[(size_t)row * 2048 + h * 128 + t];
    __syncthreads();
    float a1 = 0.f, a2 = 0.f; for (int d = t; d < 64; d += 256) { a1 += lq1[l * 64 + d] * lk1[l * 64 + d]; a2 += lq2[l * 64 + d] * lk2[l * 64 + d]; }
    a1 = block_sum256(a1, red); a2 = block_sum256(a2, red);
    const float lam_init = 0.8f - 0.6f * expf(-0.3f * (float)l); const float lam = expf(a1) - expf(a2) + lam_init;
    for (int j = t; j < Lk; j += 256) { const float* kp;
        if (ctx) kp = qkvu + (size_t)(row0 + j) * 2048 + 512 + h * 128;
        else if (j < PAST) kp = cache_k + ((((size_t)b * DEPTH + l) * PAST + j) * NH + h) * 128;
        else kp = qkvu + (size_t)(row0 + j - PAST) * 2048 + 512 + h * 128;
        float s0 = 0.f, s1 = 0.f;
_Pragma("unroll 8")
        for (int d = 0; d < 64; ++d) { s0 += qs[d] * kp[d]; s1 += qs[64 + d] * kp[64 + d]; }
        sc[0][j] = s0 * 0.125f; sc[1][j] = s1 * 0.125f; }
    __syncthreads();
    for (int s = 0; s < 2; ++s) { float m = -1e30f; for (int j = t; j < Lk; j += 256) m = fmaxf(m, sc[s][j]); m = block_max256(m, red);
        float sum = 0.f; for (int j = t; j < Lk; j += 256) { float e = expf(sc[s][j] - m); sc[s][j] = e; sum += e; } sum = block_sum256(sum, red);
        float inv = 1.f / sum; for (int j = t; j < Lk; j += 256) sc[s][j] *= inv; __syncthreads(); }
    for (int j = t; j < Lk; j += 256) sc[0][j] = sc[0][j] - lam * sc[1][j];
    __syncthreads();
    { int dv = t & 127, half = t >> 7; float acc = 0.f; int j0 = half * (Lk / 2), j1 = j0 + Lk / 2;
      for (int j = j0; j < j1; ++j) { float v;
          if (ctx) v = qkvu[(size_t)(row0 + j) * 2048 + 1024 + h * 128 + dv];
          else if (j < PAST) v = cache_v[((((size_t)b * DEPTH + l) * PAST + j) * NH + h) * 128 + dv];
          else v = qkvu[(size_t)(row0 + j - PAST) * 2048 + 1024 + h * 128 + dv];
          acc += sc[0][j] * v; }
      ov[half][dv] = acc; }
    __syncthreads();
    float o = 0.f; if (t < 128) o = ov[0][t] + ov[1][t];
    float ssq = block_sum256(t < 128 ? o * o : 0.f, red);
    if (t < 128) cat[(size_t)row * 1024 + h * 128 + t] = o * rsqrtf(ssq / 128.f + EPS) * subln[l * 128 + t] * (1.f - lam_init);
}
__global__ void __launch_bounds__(64) k_ssm(const float* qkvu, const float* state_ssm, const float* lre, const float* lim, const float* lstep, const float* bre, const float* bim,
                      const float* cre, const float* cim, const float* dd, float* y, float* new_ssm, int l, int dir) {
    int seq = blockIdx.x, g = blockIdx.y, p = threadIdx.x; __shared__ float us[16]; __shared__ float part[16][65];
    const bool ctx = seq < NB; int L, row0, b; if (ctx) { b = seq; L = SEQ; row0 = seq * SEQ; } else { b = seq - NB; L = DSEQ; row0 = MC + b * DSEQ; }
    size_t pi = ((size_t)(l * 2 + dir) * NG + g) * SP + p;
    float lr = lre[pi], li = lim[pi], delta = expf(lstep[(size_t)(l * 2 + dir) * NG + g]);
    float er = expf(lr * delta), lbr = er * cosf(li * delta), lbi = er * sinf(li * delta);
    float nr = lbr - 1.f, ni = lbi, den = lr * lr + li * li; float fr = (nr * lr + ni * li) / den, fi = (ni * lr - nr * li) / den;
    float bbr[16], bbi[16], ccr[16], cci[16];
    for (int ch = 0; ch < 16; ++ch) { size_t bi = (((size_t)(l * 2 + dir) * NG + g) * SP + p) * CH + ch; float br = bre[bi], bm = bim[bi]; bbr[ch] = fr * br - fi * bm; bbi[ch] = fr * bm + fi * br;
        size_t ci = (((size_t)(l * 2 + dir) * NG + g) * CH + ch) * SP + p; ccr[ch] = cre[ci]; cci[ch] = cim[ci]; }
    float hr = 0.f, hi = 0.f;
    if (!ctx) { size_t si = ((((size_t)b * DEPTH + l) * 2 + dir) * NG + g) * SP + p; hr = state_ssm[si * 2]; hi = state_ssm[si * 2 + 1]; }
    for (int s = 0; s < L; ++s) { int t = dir ? (L - 1 - s) : s; int row = row0 + t;
        if (p < 16) us[p] = qkvu[(size_t)row * 2048 + 1536 + g * 16 + p];
        __syncthreads();
        float br = 0.f, bi2 = 0.f; for (int ch = 0; ch < 16; ++ch) { br += bbr[ch] * us[ch]; bi2 += bbi[ch] * us[ch]; }
        float nhr = lbr * hr - lbi * hi + br, nhi = lbr * hi + lbi * hr + bi2; hr = nhr; hi = nhi;
        if (ctx && s == 0) { size_t so = ((((size_t)b * DEPTH + l) * 2 + dir) * NG + g) * SP + p; new_ssm[so * 2] = hr; new_ssm[so * 2 + 1] = hi; }
        for (int c = 0; c < 16; ++c) part[c][p] = ccr[c] * hr - cci[c] * hi;
        __syncthreads();
        if (p < 16) { float sacc = 0.f; for (int q = 0; q < 64; ++q) sacc += part[p][q];
            size_t yo = (size_t)row * 512 + g * 16 + p;
            if (dir == 0) y[yo] = sacc + dd[l * 512 + g * 16 + p] * us[p]; else y[yo] += sacc; }
        __syncthreads();
    }
}
__global__ void __launch_bounds__(256) k_gelu_inplace(float* y, size_t n) { size_t i = (size_t)blockIdx.x * blockDim.x + threadIdx.x; if (i < n) y[i] = gelu_tanh(y[i]); }
__global__ void __launch_bounds__(256) k_glu_fin(const float* z, const float* gate, const float* bg, float* cat) { size_t i = (size_t)blockIdx.x * blockDim.x + threadIdx.x; if (i >= (size_t)MT * 512) return;
    int c = (int)(i & 511); size_t row = i >> 9; float gt = gate[i] + bg[c]; cat[row * 1024 + 512 + c] = z[i] / (1.f + expf(-gt)); }
__global__ void __launch_bounds__(256) k_resid(const float* xi, const float* tmp, const float* modl, int goff, float* xo, int row_off, size_t n) { size_t i = (size_t)blockIdx.x * blockDim.x + threadIdx.x; if (i >= n) return;
    int c = (int)(i & 1023); int row = row_off + (int)(i >> 10); xo[(size_t)row * DM + c] = xi[(size_t)row * DM + c] + modl[(size_t)cond_of_row(row) * NMOD * DM + goff + c] * tmp[i]; }
__global__ void __launch_bounds__(256) k_convgate(const float* up, const float* cw, const float* cb, float* G, int row_off, int nrows) { size_t i = (size_t)blockIdx.x * blockDim.x + threadIdx.x; if (i >= (size_t)nrows * 2048) return;
    int j = (int)(i & 2047); int lr = (int)(i >> 11); int row = row_off + lr; int L = row < MC ? SEQ : DSEQ; int t = row < MC ? row % SEQ : (row - MC) % DSEQ;
    float zv = cb[j], zg = cb[2048 + j];
    for (int k = 0; k < 3; ++k) { int tt = t + k - 1; if (tt < 0 || tt >= L) continue; const float* ur = up + (size_t)(lr + k - 1) * 4096; zv += ur[j] * cw[k * 4096 + j]; zg += ur[2048 + j] * cw[k * 4096 + 2048 + j]; }
    G[i] = silu_f(zg) * zv; }
__global__ void __launch_bounds__(256) k_copy_x(const float* xp, const float* xs, float* out) { size_t i = (size_t)blockIdx.x * blockDim.x + threadIdx.x; if (i >= (size_t)MT * DM) return; out[i] = i < (size_t)MC * DM ? xp[i] : xs[i - (size_t)MC * DM]; }

struct Bufs { float *mod, *H, *Q, *Y; };
constexpr size_t OFF_MOD = 0, OFF_H = 1u << 20, OFF_Q = OFF_H + (size_t)MT * DM * 4, OFF_Y = OFF_Q + (size_t)MT * 2048 * 4, OFF_END = OFF_Y + (size_t)MT * 512 * 4;

typedef void (*hook_t)(int stage, int l, const Bufs& B, void* user, hipStream_t s);
static void forward(void* const* d_in, float* d_out, unsigned char* ws, hipStream_t st, hook_t hook = nullptr, void* user = nullptr) {
    const float* in[34]; for (int i = 0; i < 34; ++i) in[i] = (const float*)d_in[i];
    Bufs B{(float*)(ws + OFF_MOD), (float*)(ws + OFF_H), (float*)(ws + OFF_Q), (float*)(ws + OFF_Y)};
    float* x = d_out; float* new_k = d_out + (size_t)MT * DM; float* new_v = new_k + (size_t)NB * DEPTH * SEQ * 512; float* new_ssm = new_v + (size_t)NB * DEPTH * SEQ * 512;
    k_copy_x<<<(MT * DM + 255) / 256, 256, 0, st>>>(in[0], in[1], x);
    k_mod<<<dim3(NMOD * DM / 256, NCOND, DEPTH), 256, 0, st>>>(in[5], in[6], in[7], in[8], B.mod);
    if (hook) hook(1, 0, B, user, st);
    for (int l = 0; l < DEPTH; ++l) {
        const float* modl = B.mod + (size_t)l * NCOND * NMOD * DM;
        k_modulate<<<MT, 256, 0, st>>>(x, in[9] + l * DM, modl, 0, DM, B.H);
        if (hook) hook(2, l, B, user, st);
        k_gemm<<<dim3(2048 / 64, MT / 64), 256, 0, st>>>(B.H, DM, in[10] + (size_t)l * DM * 2048, 2048, B.Q, 2048, DM);
        if (hook) hook(3, l, B, user, st);
        k_qknorm_rope<<<MT, 256, 0, st>>>(B.Q, in[11] + l * 64, in[12] + l * 64, new_k, new_v, l);
        if (hook) hook(4, l, B, user, st);
        k_attn<<<dim3(MT, NH), 256, 0, st>>>(B.Q, in[2], in[3], in[13], in[14], in[15], in[16], in[17], B.H, l);
        if (hook) hook(5, l, B, user, st);
        for (int dir = 0; dir < 2; ++dir)
            k_ssm<<<dim3(NB + DB, NG), 64, 0, st>>>(B.Q, in[4], in[18], in[19], in[20], in[21], in[22], in[23], in[24], in[25], B.Y, new_ssm, l, dir);
        if (hook) hook(6, l, B, user, st);
        k_gelu_inplace<<<(MT * 512 + 255) / 256, 256, 0, st>>>(B.Y, (size_t)MT * 512);
        float* gate = B.Q;
        k_gemm<<<dim3(512 / 64, MT / 64), 256, 0, st>>>(B.Y, 512, in[26] + (size_t)l * 512 * 512, 512, gate, 512, 512);
        k_glu_fin<<<(MT * 512 + 255) / 256, 256, 0, st>>>(B.Y, gate, in[27] + l * 512, B.H);
        if (hook) hook(7, l, B, user, st);
        float* tmp = B.Q;
        k_gemm<<<dim3(DM / 64, MT / 64), 256, 0, st>>>(B.H, DM, in[28] + (size_t)l * DM * DM, DM, tmp, DM, DM);
        k_resid<<<(MT * DM + 255) / 256, 256, 0, st>>>(x, tmp, modl, 2 * DM, x, 0, (size_t)MT * DM);
        if (hook) hook(8, l, B, user, st);
        k_modulate<<<MT, 256, 0, st>>>(x, in[29] + l * DM, modl, 3 * DM, 4 * DM, B.H);
        if (hook) hook(9, l, B, user, st);
        constexpr int CR = 3072;
        float* up = B.Q; float* G = B.Q + (size_t)CR * 4096; float* dn = G + (size_t)CR * 2048;
        for (int r0 = 0; r0 < MT; r0 += CR) {
            k_gemm<<<dim3(F2 / 64, CR / 64), 256, 0, st>>>(B.H + (size_t)r0 * DM, DM, in[30] + (size_t)l * DM * F2, F2, up, F2, DM);
            k_convgate<<<(CR * 2048 + 255) / 256, 256, 0, st>>>(up, in[31] + (size_t)l * 3 * F2, in[32] + (size_t)l * F2, G, r0, CR);
            k_gemm<<<dim3(DM / 64, CR / 64), 256, 0, st>>>(G, DFF, in[33] + (size_t)l * DFF * DM, DM, dn, DM, DFF);
            k_resid<<<(CR * DM + 255) / 256, 256, 0, st>>>(x, dn, modl, 5 * DM, x, r0, (size_t)CR * DM);
        }
        if (hook) hook(10, l, B, user, st);
    }
}
}
extern "C" void kernel_launch(void* const* d_in, const int* in_sizes, int n_in, void* d_out, int out_size, void* d_ws, size_t ws_size, hipStream_t stream) {
    if (n_in != 34 || ws_size < nv::OFF_END) { fprintf(stderr, "kernel_launch: unexpected n_in %d / ws %zu\n", n_in, ws_size); return; }
    nv::forward(d_in, (float*)d_out, (unsigned char*)d_ws, stream);
}
```

```cpp
#include <hip/hip_runtime.h>
#include <cstdio>
#include <cstdint>
namespace fk {
#define LAS __attribute__((address_space(3)))
#define GAS __attribute__((address_space(1)))
typedef unsigned short bf16_t;
typedef short bf16x8 __attribute__((ext_vector_type(8)));
typedef short s16x4 __attribute__((ext_vector_type(4)));
typedef float f32x4 __attribute__((ext_vector_type(4)));
typedef float f32x2 __attribute__((ext_vector_type(2)));
typedef float f32x16 __attribute__((ext_vector_type(16)));
typedef unsigned u32x4 __attribute__((ext_vector_type(4)));
typedef unsigned u32x2 __attribute__((ext_vector_type(2)));

constexpr int DM = 1024, NB = 16, SEQ = 256, DEPTH = 2, DB = 8, DSEQ = 1024, PAST = 512;
constexpr int MC = NB * SEQ, MS = DB * DSEQ, MT = MC + MS;
constexpr int NH = 4, NG = 32, NCOND = 9, NMOD = 6;
constexpr int NCHUNK = MT / 16;
constexpr int KVROWS = MC + DB * (PAST + DSEQ);
constexpr float EPS = 1e-6f;
constexpr float C2 = 0.125f * 1.4426950408889634f;
constexpr int NWAVES = 8, NTHREADS = 512;

constexpr size_t MiB = 1u << 20;
constexpr size_t WS_CTL = 0, CTL_BYTES = 1 * MiB;
constexpr size_t WS_MISC = 1 * MiB;
constexpr size_t WS_WIN = 3 * MiB;
constexpr size_t WS_WGLU = 11 * MiB;
constexpr size_t WS_WOUT = 12 * MiB;
constexpr size_t WS_WUP = 16 * MiB;
constexpr size_t WS_WDN = 32 * MiB;
constexpr size_t WS_SSM = 40 * MiB;
constexpr size_t WS_XS = 53 * MiB;
constexpr size_t WS_KB = 77 * MiB;
constexpr size_t WS_VB = 93 * MiB;
constexpr size_t WS_R = 109 * MiB;
constexpr size_t WS_G = 205 * MiB;
constexpr size_t WS_END = 253 * MiB;
constexpr size_t R_Q = 0, R_AS3 = 12 * MiB, R_E = 36 * MiB, R_Z = 60 * MiB, R_CAT = 72 * MiB;
constexpr size_t SSM_WE = 0, SSM_WY = 4 * MiB, SSM_LAM16 = 12 * MiB, SSM_BBAR = 12 * MiB + 64 * 1024;
constexpr int MI_MOD = 0;
constexpr int MI_BIN = MI_MOD + 2 * 9 * 6144;
constexpr int MI_BUP = MI_BIN + 2 * 9 * 2048;
constexpr int MI_ROPE = MI_BUP + 2 * 9 * 4096;
constexpr int MI_LAM = MI_ROPE + 64 * 16 * 2;
constexpr int MI_END = MI_LAM + 8;
static_assert((size_t)MI_END * 4 <= 2 * MiB, "MISC");
constexpr int CW_BAR = 1024;
constexpr int CW_SS = 8192;
static_assert((size_t)(CW_SS + 4 * MT) * 4 <= CTL_BYTES, "CTL");

constexpr int RING_BYTES = 131072;
constexpr int LDSCTL_OFF = RING_BYTES, MISC_OFF = LDSCTL_OFF + 320;
constexpr int LDS_BYTES = 147456;

#define RLX_AGENT __ATOMIC_RELAXED, __HIP_MEMORY_SCOPE_AGENT
__device__ __forceinline__ unsigned cvt_pk_bf16(float lo, float hi) { unsigned r; asm volatile("v_cvt_pk_bf16_f32 %0, %1, %2" : "=v"(r) : "v"(lo), "v"(hi)); return r; }
__device__ __forceinline__ float bf2f(unsigned short b) { return __uint_as_float((unsigned)b << 16); }
__device__ __forceinline__ float bflo(unsigned w) { return __uint_as_float(w << 16); }
__device__ __forceinline__ float bfhi(unsigned w) { return __uint_as_float(w & 0xffff0000u); }
__device__ __forceinline__ float fast_exp2(float x) { return __builtin_amdgcn_exp2f(x); }
__device__ __forceinline__ float fast_rcp(float x) { return __builtin_amdgcn_rcpf(x); }
__device__ __forceinline__ float sigmoid_f(float x) { return fast_rcp(1.f + fast_exp2(-1.4426950408889634f * x)); }
__device__ __forceinline__ float silu_f(float x) { return x * sigmoid_f(x); }
__device__ __forceinline__ float gelu_tanh_f(float x) {
    const float u = 0.7978845608028654f * (x + 0.044715f * x * x * x); return x * sigmoid_f(2.f * u); }
__device__ __forceinline__ float wave_sum(float v) {
#pragma unroll
    for (int o = 1; o < 64; o <<= 1) v += __shfl_xor(v, o);
    return v; }

#define XB_TMO      128
#define XB_XCNT(j)  (256  + 64 * (j))
#define XB_XSUB(j)  (1280 + 64 * (j))
#define XB_XGEN(j)  (2304 + 64 * (j))
#define XB_TOP      3328
#define XB_TOPGEN   3392
#define XCD_BAR_WORDS 3456
#define XB_SPIN_CAP (1u << 18)
__device__ __forceinline__ unsigned xb_ld(unsigned* p)              { return __hip_atomic_load(p, __ATOMIC_RELAXED, __HIP_MEMORY_SCOPE_AGENT); }
__device__ __forceinline__ unsigned xb_add(unsigned* p, unsigned v) { return __hip_atomic_fetch_add(p, v, __ATOMIC_RELAXED, __HIP_MEMORY_SCOPE_AGENT); }
__device__ __forceinline__ unsigned xb_xcc_id() { return (unsigned)__builtin_amdgcn_s_getreg((3 << 11) | 20) & 0xFu; }
#define XB_SPIN(cond, bar) do { unsigned _sp = 0; while (cond) { __builtin_amdgcn_s_sleep(1); \
    if ((++_sp & 255u) == 0u) { if (xb_ld(&(bar)[XB_TMO])) break; if (_sp > XB_SPIN_CAP) { atomicAdd(&(bar)[XB_TMO], 1u); break; } } } } while (0)
struct XcdBarrier { unsigned* bar; unsigned x; volatile LAS unsigned* st; };
__device__ __forceinline__ XcdBarrier xcd_barrier_post(unsigned* bar, volatile LAS unsigned* st) {
    XcdBarrier b; b.bar = bar; b.x = xb_xcc_id(); b.st = st;
    if (threadIdx.x == 0) (void)xb_add(&bar[XB_XCNT(b.x)], 1u);
    return b;
}
__device__ __forceinline__ void xcd_barrier_complete(unsigned* bar, unsigned x, unsigned& nloc, unsigned& nx) {
    const unsigned G = gridDim.x * gridDim.y * gridDim.z;
    unsigned sum, cnt, mine, sp = 0u;
    for (;;) {
        sum = 0u; cnt = 0u; mine = 0u;
#pragma unroll
        for (unsigned j = 0; j < 16; ++j) { const unsigned c = xb_ld(&bar[XB_XCNT(j)]); sum += c; cnt += (c > 0u) ? 1u : 0u; mine = (j == x) ? c : mine; }
        if (sum == G) break;
        __builtin_amdgcn_s_sleep(1);
        if ((++sp & 255u) == 0u) { if (xb_ld(&bar[XB_TMO])) break; if (sp > XB_SPIN_CAP) { atomicAdd(&bar[XB_TMO], 1u); break; } }
    }
    nloc = mine > 0u ? mine : 1u; nx = cnt > 0u ? cnt : 1u;
}
__device__ __forceinline__ void xcd_barrier(const XcdBarrier& b) {
    asm volatile("s_waitcnt vmcnt(0)" ::: "memory");
    __syncthreads();
    if (threadIdx.x == 0) {
        unsigned* bar = b.bar;
        __builtin_amdgcn_s_waitcnt(0);
        unsigned nloc = b.st[0], nx = b.st[1];
        if (nloc == 0u) { xcd_barrier_complete(bar, b.x, nloc, nx); b.st[0] = nloc; b.st[1] = nx; }
        const unsigned old = xb_add(&bar[XB_XSUB(b.x)], 1u);
        const unsigned gen = old / nloc;
        if (old + 1u == (gen + 1u) * nloc) {
            __builtin_amdgcn_fence(__ATOMIC_RELEASE, "agent");
            asm volatile("s_waitcnt vmcnt(0)" ::: "memory");
            const unsigned og = xb_add(&bar[XB_TOP], 1u);
            const unsigned tg = og / nx;
            if (og + 1u == (tg + 1u) * nx) xb_add(&bar[XB_TOPGEN], 1u);
            else XB_SPIN(xb_ld(&bar[XB_TOPGEN]) == tg, bar);
            __builtin_amdgcn_fence(__ATOMIC_ACQUIRE, "agent");
            xb_add(&bar[XB_XGEN(b.x)], 1u);
            asm volatile("s_waitcnt vmcnt(0)" ::: "memory");
        } else {
            XB_SPIN(xb_ld(&bar[XB_XGEN(b.x)]) == gen, bar);
            __builtin_amdgcn_fence(__ATOMIC_ACQUIRE, "agent");
            asm volatile("s_waitcnt vmcnt(0)" ::: "memory");
        }
    }
    __syncthreads();
}

constexpr int BM = 256, BK = 64, HALF = 128, HTB = HALF * BK * 2, NXCD = 8, WGM = 8;
__host__ __device__ __forceinline__ int lds_byte(int r, int c) { const int st = (r >> 4) * 2 + (c >> 5), rr = r & 15, cc = c & 31, ob = rr * 64 + cc * 2; return st * 1024 + (ob ^ (((ob >> 9) & 1) << 5)); }
__host__ __device__ __forceinline__ void stage_rc(int b, int& R, int& C) { const int st = b / 1024, sb = b % 1024, swz = sb ^ (((sb >> 9) & 1) << 5); R = (st >> 1) * 16 + swz / 64; C = (st & 1) * 32 + (swz % 64) / 2; }
__host__ __device__ __forceinline__ int perm32(int rho) { const int n = rho >> 4, i = rho & 15; return 8 * (i >> 2) + 4 * n + (i & 3); }

struct Unit { int pm, pn, g; };
struct Gemm { const bf16_t* A; const bf16_t* Bt; int lda, ldb, K; size_t gsA, gsB; };
struct GridOrder {
    int nM, nN, nwg, G, c;
    __device__ void init(int M, int N, int G_, int c_) { nM = M / BM; nN = N / BM; nwg = nM * nN; G = G_; c = c_; }
    __device__ bool next(int i, Unit& u) const {
        const long L = (long)i * G + c; if (L >= nwg) return false;
        int wgid = (int)L; { const int q = nwg / NXCD, r = nwg % NXCD, xcd = wgid % NXCD, off = wgid / NXCD; wgid = (xcd < r ? xcd * (q + 1) : r * (q + 1) + (xcd - r) * q) + off; }
        const int nig = WGM * nN, gid = wgid / nig, fm = gid * WGM, gsz = (nM - fm) < WGM ? (nM - fm) : WGM;
        u.pm = fm + ((wgid % nig) % gsz); u.pn = (wgid % nig) / gsz; u.g = 0; return true;
    }
};
struct GroupOrder {
    int c, G;
    __device__ bool next(int i, Unit& u) const { const int idx = c + i * G; if (c < 0 || idx >= NG * 3) return false; u.g = idx / 3; u.pm = idx % 3; u.pn = 0; return true; }
};

template <class Epi, class Sched>
__device__ __forceinline__ void gemm_phase(LAS unsigned char* lds, const int tid, const Gemm g, const Sched& S, const Epi& E) {
    const int wid = __builtin_amdgcn_readfirstlane(tid >> 6), lane = tid & 63, wr = wid >> 2, wc = wid & 3, fr = lane & 15, fq = lane >> 4;
    const int K = g.K, nt = K / BK;
    unsigned voffA[2], voffB[2];
#pragma unroll
    for (int i = 0; i < 2; ++i) { int R, C; stage_rc(tid * 16 + i * 8192, R, C); const int Rb = Epi::PERM ? ((R & ~31) + perm32(R & 31)) : R;
        voffA[i] = (unsigned)(R * g.lda + C) * 2u; voffB[i] = (unsigned)(Rb * g.ldb + C) * 2u; }
    const size_t kstep = (size_t)(BK * 2);
    const size_t hstepA = (size_t)HALF * g.lda * 2, hstepB = (size_t)HALF * g.ldb * 2;
    const unsigned ldsw = (unsigned)wid * 1024u;
    const int aoff = lds_byte(wr * 64 + fr, fq * 8), boff = lds_byte(wc * 32 + fr, fq * 8);
#define PG8_SA(b, h) (((b) * 2 + (h)) * HTB)
#define PG8_SB(b, h) ((4 + (b) * 2 + (h)) * HTB)
#define PG8_STAGE(bufoff, gbase, voff) do { _Pragma("unroll") for (int _i = 0; _i < 2; ++_i) \
        __builtin_amdgcn_global_load_lds((const unsigned*)((const char*)(gbase) + (voff)[_i]), (LAS unsigned*)(lds + (bufoff) + ldsw + _i * 8192), 16, 0, 0); } while (0)
#define PG8_LDA(dst, b, h) do { _Pragma("unroll") for (int m = 0; m < 4; ++m) _Pragma("unroll") for (int k = 0; k < 2; ++k) dst[m][k] = *(const LAS bf16x8*)(lds + PG8_SA(b, h) + aoff + m * 2048 + k * 1024); } while (0)
#define PG8_LDB(dst, b, h) do { _Pragma("unroll") for (int n = 0; n < 2; ++n) _Pragma("unroll") for (int k = 0; k < 2; ++k) dst[n][k] = *(const LAS bf16x8*)(lds + PG8_SB(b, h) + boff + n * 2048 + k * 1024); } while (0)
#define PG8_MMA(ai, bj, At, Bt) do { __builtin_amdgcn_s_setprio(1); _Pragma("unroll") for (int m = 0; m < 4; ++m) _Pragma("unroll") for (int n = 0; n < 2; ++n) _Pragma("unroll") for (int k = 0; k < 2; ++k) \
        acc[ai][bj][m][n] = __builtin_amdgcn_mfma_f32_16x16x32_bf16(Bt[n][k], At[m][k], acc[ai][bj][m][n], 0, 0, 0); __builtin_amdgcn_s_setprio(0); } while (0)
#define PG8_WAIT_V(n) asm volatile("s_waitcnt vmcnt(" #n ")" ::: "memory")
#define PG8_WAIT_L(n) asm volatile("s_waitcnt lgkmcnt(" #n ")" ::: "memory")
#define PG8_BAR __builtin_amdgcn_s_barrier()
#define PG8_SCHED __builtin_amdgcn_sched_barrier(0)
#define PG8_APTR(u) ((const char*)g.A + ((size_t)(u).g * g.gsA + (size_t)(u).pm * BM * g.lda) * 2)
#define PG8_BPTR(u) ((const char*)g.Bt + ((size_t)(u).g * g.gsB + (size_t)(u).pn * BM * g.ldb) * 2)
    Unit cur, nxt; int ui = 0;
    if (!S.next(0, cur)) return;
    f32x4 acc[2][2][4][2];
#pragma unroll
    for (int a = 0; a < 2; ++a)
#pragma unroll
        for (int b = 0; b < 2; ++b)
#pragma unroll
            for (int m = 0; m < 4; ++m)
#pragma unroll
                for (int n = 0; n < 2; ++n) acc[a][b][m][n] = (f32x4){0.f, 0.f, 0.f, 0.f};
    bf16x8 At[4][2], B0[2][2], B1[2][2];
    const char* cA = PG8_APTR(cur); const char* cB = PG8_BPTR(cur);
    PG8_STAGE(PG8_SB(0, 0), cB, voffB); PG8_STAGE(PG8_SB(0, 1), cB + hstepB, voffB); PG8_STAGE(PG8_SA(0, 0), cA, voffA); PG8_STAGE(PG8_SA(0, 1), cA + hstepA, voffA);
    if (wr == 1) PG8_BAR;
    PG8_WAIT_V(2); PG8_BAR;
    PG8_STAGE(PG8_SB(1, 0), cB + kstep, voffB); PG8_STAGE(PG8_SA(1, 0), cA + kstep, voffA); PG8_STAGE(PG8_SB(1, 1), cB + hstepB + kstep, voffB);
    PG8_WAIT_V(6); PG8_BAR;
    for (;;) {
        const bool has_next = S.next(ui + 1, nxt);
        const char* nA = has_next ? PG8_APTR(nxt) : cA; const char* nB = has_next ? PG8_BPTR(nxt) : cB;
        for (int t = 0; t < nt; t += 2) {
            const bool last = (t == nt - 2);
            const char* a1 = cA + (size_t)(t + 1) * kstep;
            const char* a2 = last ? nA : cA + (size_t)(t + 2) * kstep; const char* b2 = last ? nB : cB + (size_t)(t + 2) * kstep;
            const char* a3 = a2 + kstep; const char* b3 = b2 + kstep;
            PG8_LDB(B0, 0, 0); PG8_LDB(B1, 0, 1); PG8_SCHED; PG8_LDA(At, 0, 0); PG8_STAGE(PG8_SA(1, 1), a1 + hstepA, voffA);
            PG8_WAIT_V(8); PG8_WAIT_L(0); PG8_BAR; PG8_MMA(0, 0, At, B0); PG8_MMA(0, 1, At, B1); PG8_BAR; PG8_SCHED;
            PG8_LDA(At, 0, 1); PG8_STAGE(PG8_SB(0, 0), b2, voffB); PG8_STAGE(PG8_SB(0, 1), b2 + hstepB, voffB); PG8_STAGE(PG8_SA(0, 0), a2, voffA);
            PG8_WAIT_V(8); PG8_WAIT_L(0); PG8_BAR; PG8_MMA(1, 0, At, B0); PG8_MMA(1, 1, At, B1); PG8_BAR; PG8_SCHED;
            PG8_LDB(B0, 1, 0); PG8_LDB(B1, 1, 1); PG8_SCHED; PG8_LDA(At, 1, 0); PG8_STAGE(PG8_SA(0, 1), a2 + hstepA, voffA);
            PG8_WAIT_V(8); PG8_WAIT_L(0); PG8_BAR; PG8_MMA(0, 0, At, B0); PG8_MMA(0, 1, At, B1); PG8_BAR; PG8_SCHED;
            PG8_LDA(At, 1, 1); PG8_STAGE(PG8_SB(1, 0), b3, voffB); PG8_STAGE(PG8_SB(1, 1), b3 + hstepB, voffB); PG8_STAGE(PG8_SA(1, 0), a3, voffA);
            PG8_WAIT_V(8); PG8_WAIT_L(0); PG8_BAR; PG8_MMA(1, 0, At, B0); PG8_MMA(1, 1, At, B1); PG8_BAR; PG8_SCHED;
        }
        if (wr == 0) PG8_BAR;
        E(acc, cur, wr, wc, fr, fq);
        if (!has_next) break;
#pragma unroll
        for (int a = 0; a < 2; ++a)
#pragma unroll
            for (int b = 0; b < 2; ++b)
#pragma unroll
                for (int m = 0; m < 4; ++m)
#pragma unroll
                    for (int n = 0; n < 2; ++n) acc[a][b][m][n] = (f32x4){0.f, 0.f, 0.f, 0.f};
        cur = nxt; cA = nA; cB = nB; ++ui;
        if (wr == 1) PG8_BAR;
    }
    PG8_WAIT_V(0);
    PG8_BAR;
#undef PG8_SA
#undef PG8_SB
#undef PG8_STAGE
#undef PG8_LDA
#undef PG8_LDB
#undef PG8_MMA
#undef PG8_WAIT_V
#undef PG8_WAIT_L
#undef PG8_BAR
#undef PG8_SCHED
#undef PG8_APTR
#undef PG8_BPTR
}
__device__ __forceinline__ int cond_of_pm(int pm) { return pm < 16 ? 0 : 1 + ((pm - 16) >> 2); }
__device__ __forceinline__ int kvrow_of(int row) { return row < MC ? row : MC + ((row - MC) >> 10) * (PAST + DSEQ) + PAST + ((row - MC) & 1023); }
__device__ __forceinline__ u32x4 pack8(const f32x4& a, const f32x4& b) { u32x4 w; w.x = cvt_pk_bf16(a[0], a[1]); w.y = cvt_pk_bf16(a[2], a[3]); w.z = cvt_pk_bf16(b[0], b[1]); w.w = cvt_pk_bf16(b[2], b[3]); return w; }

struct EpiIn {
    static constexpr bool PERM = true;
    const float* sumsq; const float* bias; const float* qn; const float* kn; const f32x2* rope;
    bf16_t* Q; bf16_t* KB; bf16_t* VB; bf16_t* AS3; float* new_k; float* new_v; int l;
    __device__ __forceinline__ void operator()(const f32x4 (&acc)[2][2][4][2], const Unit& u, int wr, int wc, int fr, int fq) const {
        const int pm = u.pm, pn = u.pn; const bool ctx = pm < 16; const int cond = cond_of_pm(pm);
        const float* bz = bias + cond * 2048 + pn * 256 + wc * 32 + 8 * fq;
        f32x4 bv[2][2];
#pragma unroll
        for (int bj = 0; bj < 2; ++bj)
#pragma unroll
            for (int n = 0; n < 2; ++n) bv[bj][n] = *(const f32x4*)(bz + bj * 128 + 4 * n);
        const int rbase = pm * BM + wr * 64 + fr;
        if (pn < 4) {
            const bool isq = pn < 2; const float* gv = isq ? qn : kn;
            const int G = (pn & 1) * 4 + wc;
            const int cb = 32 * (fq >> 1) + 8 * (fq & 1);
            f32x4 gg[2][2];
#pragma unroll
            for (int bj = 0; bj < 2; ++bj)
#pragma unroll
                for (int n = 0; n < 2; ++n) gg[bj][n] = *(const f32x4*)(gv + cb + 16 * bj + 4 * n);
            const float qs = isq ? C2 : 1.f;
#pragma unroll
            for (int ai = 0; ai < 2; ++ai)
#pragma unroll
                for (int m = 0; m < 4; ++m) {
                    const int row = rbase + ai * HALF + m * 16;
                    const float rstd = rsqrtf(sumsq[row] * (1.f / DM) + EPS);
                    f32x4 v[2][2]; float ss = 0.f;
#pragma unroll
                    for (int bj = 0; bj < 2; ++bj)
#pragma unroll
                        for (int n = 0; n < 2; ++n) { v[bj][n] = acc[ai][bj][m][n] * rstd + bv[bj][n]; const f32x4 t = v[bj][n] * v[bj][n]; ss += (t[0] + t[1]) + (t[2] + t[3]); }
                    ss += __shfl_xor(ss, 16); ss += __shfl_xor(ss, 32);
                    const float rn = rsqrtf(ss * (1.f / 64.f) + EPS);
#pragma unroll
                    for (int bj = 0; bj < 2; ++bj)
#pragma unroll
                        for (int n = 0; n < 2; ++n) v[bj][n] = v[bj][n] * rn * gg[bj][n];
                    if (ctx) {
                        if (!isq) { float* nk = new_k + ((size_t)((row >> 8) * DEPTH + l) * SEQ + (row & 255)) * 512 + G * 64 + cb;
#pragma unroll
                            for (int bj = 0; bj < 2; ++bj) { *(f32x4*)(nk + 16 * bj) = v[bj][0]; *(f32x4*)(nk + 16 * bj + 4) = v[bj][1]; } }
                    } else {
                        const int t = (row - MC) & 1023; const int pos = (fq >> 1) ? (t & 63) : (t >> 6);
                        const f32x2* rp = rope + pos * 16 + 8 * (fq & 1);
#pragma unroll
                        for (int n = 0; n < 2; ++n)
#pragma unroll
                            for (int j = 0; j < 4; ++j) { const f32x2 cs = rp[4 * n + j]; const float x1 = v[0][n][j], x2 = v[1][n][j]; v[0][n][j] = x1 * cs.x - x2 * cs.y; v[1][n][j] = x1 * cs.y + x2 * cs.x; }
                    }
                    bf16_t* dst = isq ? (Q + (size_t)row * 512) : (KB + (size_t)kvrow_of(row) * 512);
                    dst += G * 64 + cb;
#pragma unroll
                    for (int bj = 0; bj < 2; ++bj) *(u32x4*)(dst + 16 * bj) = pack8(v[bj][0] * qs, v[bj][1] * qs);
                }
        } else if (pn < 6) {
            const int col0 = (pn - 4) * 256 + wc * 32 + 8 * fq;
#pragma unroll
            for (int ai = 0; ai < 2; ++ai)
#pragma unroll
                for (int m = 0; m < 4; ++m) {
                    const int row = rbase + ai * HALF + m * 16;
                    const float rstd = rsqrtf(sumsq[row] * (1.f / DM) + EPS);
                    bf16_t* dst = VB + (size_t)kvrow_of(row) * 512 + col0;
#pragma unroll
                    for (int bj = 0; bj < 2; ++bj) { const f32x4 a = acc[ai][bj][m][0] * rstd + bv[bj][0], b = acc[ai][bj][m][1] * rstd + bv[bj][1];
                        *(u32x4*)(dst + 128 * bj) = pack8(a, b);
                        if (ctx) { float* nv = new_v + ((size_t)((row >> 8) * DEPTH + l) * SEQ + (row & 255)) * 512 + col0 + 128 * bj; *(f32x4*)nv = a; *(f32x4*)(nv + 4) = b; } }
                }
        } else {
            const int cu0 = (pn - 6) * 256 + wc * 32 + 8 * fq;
#pragma unroll
            for (int ai = 0; ai < 2; ++ai)
#pragma unroll
                for (int m = 0; m < 4; ++m) {
                    const int row = rbase + ai * HALF + m * 16;
                    const float rstd = rsqrtf(sumsq[row] * (1.f / DM) + EPS);
#pragma unroll
                    for (int bj = 0; bj < 2; ++bj) { const int cu = cu0 + 128 * bj; const f32x4 a = acc[ai][bj][m][0] * rstd + bv[bj][0], b = acc[ai][bj][m][1] * rstd + bv[bj][1];
                        *(u32x4*)(AS3 + ((size_t)(cu >> 4) * NCHUNK + (row >> 4)) * 512 + (row & 15) * 16 + (cu & 15)) = pack8(a, b); }
                }
        }
    }
};
struct EpiS1 {
    static constexpr bool PERM = false;
    float* E;
    __device__ __forceinline__ void operator()(const f32x4 (&acc)[2][2][4][2], const Unit& u, int wr, int wc, int fr, int fq) const {
        const int rbase = u.pm * BM + wr * 64 + fr, col0 = wc * 32 + 4 * fq;
#pragma unroll
        for (int ai = 0; ai < 2; ++ai)
#pragma unroll
            for (int m = 0; m < 4; ++m) { float* dst = E + ((size_t)u.g * NCHUNK + rbase + ai * HALF + m * 16) * 256 + col0;
#pragma unroll
                for (int bj = 0; bj < 2; ++bj)
#pragma unroll
                    for (int n = 0; n < 2; ++n) *(f32x4*)(dst + bj * HALF + n * 16) = acc[ai][bj][m][n]; }
    }
};
struct EpiS3 {
    static constexpr bool PERM = true;
    bf16_t* Z;
    __device__ __forceinline__ void operator()(const f32x4 (&acc)[2][2][4][2], const Unit& u, int wr, int wc, int fr, int fq) const {
        const int rbase = u.pm * BM + wr * 64 + fr;
#pragma unroll
        for (int ai = 0; ai < 2; ++ai)
#pragma unroll
            for (int m = 0; m < 4; ++m) { const int chunk = rbase + ai * HALF + m * 16;
#pragma unroll
                for (int bj = 0; bj < 2; ++bj) { const int tt = 8 * bj + 2 * wc + (fq >> 1), c0 = 8 * (fq & 1);
                    f32x4 a = acc[ai][bj][m][0], b = acc[ai][bj][m][1];
#pragma unroll
                    for (int j = 0; j < 4; ++j) { a[j] = gelu_tanh_f(a[j]); b[j] = gelu_tanh_f(b[j]); }
                    *(u32x4*)(Z + ((size_t)chunk * 16 + tt) * 512 + u.g * 16 + c0) = pack8(a, b); } }
    }
};
struct EpiGlu {
    static constexpr bool PERM = true;
    const bf16_t* Z; const float* bg; bf16_t* CAT;
    __device__ __forceinline__ void operator()(const f32x4 (&acc)[2][2][4][2], const Unit& u, int wr, int wc, int fr, int fq) const {
        const int rbase = u.pm * BM + wr * 64 + fr, col0 = u.pn * BM + wc * 32 + 8 * fq;
        f32x4 bv[2][2];
#pragma unroll
        for (int bj = 0; bj < 2; ++bj)
#pragma unroll
            for (int n = 0; n < 2; ++n) bv[bj][n] = *(const f32x4*)(bg + col0 + bj * HALF + 4 * n);
#pragma unroll
        for (int ai = 0; ai < 2; ++ai)
#pragma unroll
            for (int m = 0; m < 4; ++m) { const int row = rbase + ai * HALF + m * 16;
#pragma unroll
                for (int bj = 0; bj < 2; ++bj) { const u32x4 zw = *(const u32x4*)(Z + (size_t)row * 512 + col0 + bj * HALF);
                    f32x4 a = acc[ai][bj][m][0] + bv[bj][0], b = acc[ai][bj][m][1] + bv[bj][1];
                    a[0] = bflo(zw.x) * sigmoid_f(a[0]); a[1] = bfhi(zw.x) * sigmoid_f(a[1]); a[2] = bflo(zw.y) * sigmoid_f(a[2]); a[3] = bfhi(zw.y) * sigmoid_f(a[3]);
                    b[0] = bflo(zw.z) * sigmoid_f(b[0]); b[1] = bfhi(zw.z) * sigmoid_f(b[1]); b[2] = bflo(zw.w) * sigmoid_f(b[2]); b[3] = bfhi(zw.w) * sigmoid_f(b[3]);
                    *(u32x4*)(CAT + (size_t)row * 1024 + 512 + col0 + bj * HALF) = pack8(a, b); } }
    }
};
struct EpiRes {
    static constexpr bool PERM = false;
    const float* xin0; const float* xin1;
    float* xout;
    const float* gate;
    const float* gn; const float* sc;
    bf16_t* XS; float* ssq;
    __device__ __forceinline__ void operator()(const f32x4 (&acc)[2][2][4][2], const Unit& u, int wr, int wc, int fr, int fq) const {
        const int pm = u.pm, cond = cond_of_pm(pm); const int col0 = u.pn * BM + wc * 32 + 4 * fq; const int rbase = pm * BM + wr * 64 + fr;
        const bool donorm = (gn != nullptr);
        f32x4 gt[2][2], gs[2][2];
#pragma unroll
        for (int bj = 0; bj < 2; ++bj)
#pragma unroll
            for (int n = 0; n < 2; ++n) { const int c = col0 + bj * HALF + n * 16; gt[bj][n] = *(const f32x4*)(gate + cond * 6144 + c);
                if (donorm) { const f32x4 g4 = *(const f32x4*)(gn + c), s4 = *(const f32x4*)(sc + cond * 6144 + c); gs[bj][n] = g4 * (s4 + 1.f); } else gs[bj][n] = (f32x4){0.f, 0.f, 0.f, 0.f}; }
#pragma unroll
        for (int ai = 0; ai < 2; ++ai)
#pragma unroll
            for (int m = 0; m < 4; ++m) { const int row = rbase + ai * HALF + m * 16;
                const float* xi = (row < MC) ? (xin0 + (size_t)row * DM) : (xin1 + (size_t)(row - MC) * DM);
                float ss = 0.f;
#pragma unroll
                for (int bj = 0; bj < 2; ++bj)
#pragma unroll
                    for (int n = 0; n < 2; ++n) { const int c = col0 + bj * HALF + n * 16;
                        const f32x4 x = *(const f32x4*)(xi + c) + gt[bj][n] * acc[ai][bj][m][n];
                        *(f32x4*)(xout + (size_t)row * DM + c) = x;
                        if (donorm) { const f32x4 t = x * x; ss += (t[0] + t[1]) + (t[2] + t[3]); const f32x4 y = x * gs[bj][n];
                            u32x2 w; w.x = cvt_pk_bf16(y[0], y[1]); w.y = cvt_pk_bf16(y[2], y[3]); *(u32x2*)(XS + (size_t)row * DM + c) = w; } }
                if (donorm) { ss += __shfl_xor(ss, 16); ss += __shfl_xor(ss, 32); if (fq == 0) atomicAdd(ssq + row, ss); }
            }
    }
};
struct EpiUp {
    static constexpr bool PERM = true;
    const float* sumsq; const float* bias; bf16_t* UP;
    __device__ __forceinline__ void operator()(const f32x4 (&acc)[2][2][4][2], const Unit& u, int wr, int wc, int fr, int fq) const {
        const int pm = u.pm, cond = cond_of_pm(pm); const int col0 = u.pn * BM + wc * 32 + 8 * fq; const int rbase = pm * BM + wr * 64 + fr;
        f32x4 bv[2][2];
#pragma unroll
        for (int bj = 0; bj < 2; ++bj)
#pragma unroll
            for (int n = 0; n < 2; ++n) bv[bj][n] = *(const f32x4*)(bias + cond * 4096 + col0 + bj * HALF + 4 * n);
#pragma unroll
        for (int ai = 0; ai < 2; ++ai)
#pragma unroll
            for (int m = 0; m < 4; ++m) { const int row = rbase + ai * HALF + m * 16; const float rstd = rsqrtf(sumsq[row] * (1.f / DM) + EPS);
#pragma unroll
                for (int bj = 0; bj < 2; ++bj) *(u32x4*)(UP + (size_t)row * 4096 + col0 + bj * HALF) = pack8(acc[ai][bj][m][0] * rstd + bv[bj][0], acc[ai][bj][m][1] * rstd + bv[bj][1]); }
    }
};
constexpr int AT_KSLOT = 16384, AT_K = 0, AT_V = 3 * AT_KSLOT, AT_X = 0, AT_ST = 65536;
__device__ __forceinline__ void glds16(const void* gsrc, unsigned lds_dst) { unsigned keep;
    asm volatile("s_mov_b32 %0, m0\n\ts_mov_b32 m0, %2\n\ts_nop 0\n\tglobal_load_lds_dwordx4 %1, off\n\ts_mov_b32 m0, %0" : "=&s"(keep) : "v"(gsrc), "s"(lds_dst) : "memory"); }
#define AT_WAIT_BAR(N) asm volatile("s_waitcnt vmcnt(" #N ") lgkmcnt(0)\n\ts_barrier" ::: "memory")
__device__ __forceinline__ s16x4 vtr(const LAS char* p) { typedef short v4i16_t __attribute__((ext_vector_type(4))); return __builtin_bit_cast(s16x4, __builtin_amdgcn_ds_read_tr16_b64_v4i16((LAS v4i16_t*)p)); }
__device__ __forceinline__ int crow(int r, int hi) { return (r & 3) + 8 * (r >> 2) + 4 * hi; }

struct AttnArgs { const bf16_t* Q; const bf16_t* KB; const bf16_t* VB; bf16_t* CAT; const float* subln; float lam; float oml; };

__device__ __forceinline__ void attn_unit(LAS unsigned char* lds, const int tid, const AttnArgs& A, int seq, int h, int qblk) {
    const int lane = tid & 63, r32 = lane & 31, hi = lane >> 5; const int wid = __builtin_amdgcn_readfirstlane(tid >> 6);
    const int rg = wid & 3, s = wid >> 2;
    const bool ctx = seq < NB;
    const int qrow0 = ctx ? seq * SEQ + qblk * 128 : MC + (seq - NB) * DSEQ + qblk * 128;
    const int krow0 = ctx ? seq * SEQ : MC + (seq - NB) * (PAST + DSEQ);
    const int NT = ctx ? SEQ / 64 : (PAST + DSEQ) / 64;
    const unsigned lds0 = (unsigned)(uintptr_t)lds;
    const bf16_t* ksrc0 = A.KB + (size_t)(krow0 + lane) * 512 + h * 128 + wid * 8;
    const bf16_t* vsrc0 = A.VB + (size_t)(krow0 + 16 * (wid & 3) + (lane >> 2)) * 512 + h * 128 + (wid >> 2) * 32 + (lane & 3) * 8;
    const unsigned kdst = lds0 + AT_K + wid * 1024, vdst = lds0 + AT_V + ((wid >> 2) * 4 + (wid & 3)) * 1024;
#define AT_DMA(t, slot) do { const size_t _o = (size_t)(t) * 64 * 512; const unsigned _s = (unsigned)(slot) * AT_KSLOT; \
        glds16(ksrc0 + _o, (unsigned)__builtin_amdgcn_readfirstlane(kdst + _s)); glds16(ksrc0 + _o + 64, (unsigned)__builtin_amdgcn_readfirstlane(kdst + _s + 8 * 1024)); \
        glds16(vsrc0 + _o, (unsigned)__builtin_amdgcn_readfirstlane(vdst + _s)); glds16(vsrc0 + _o + 64, (unsigned)__builtin_amdgcn_readfirstlane(vdst + _s + 8 * 1024)); } while (0)
    AT_DMA(0, 0); AT_DMA(1, 1);
    bf16x8 qr[4];
    { const bf16_t* qp = A.Q + (size_t)(qrow0 + rg * 32 + r32) * 512 + h * 128 + s * 64 + hi * 8;
#pragma unroll
      for (int d0 = 0; d0 < 4; ++d0) qr[d0] = *(const bf16x8*)(qp + d0 * 16); }
    f32x16 o[4];
#pragma unroll
    for (int d0 = 0; d0 < 4; ++d0)
#pragma unroll
        for (int r = 0; r < 16; ++r) o[d0][r] = 0.f;
    float lsum = 0.f;
    const LAS char* kfrag0 = (const LAS char*)lds + AT_K + (s * 8 + hi) * 1024 + r32 * 16;
    const LAS char* vfrag0 = (const LAS char*)lds + AT_V + ((lane >> 4) & 1) * 32 + (lane & 3) * 8 + (4 * hi + ((lane & 15) >> 2)) * 64;
    int slot = 0;
    for (int t = 0; t < NT; ++t) {
        if (t + 1 < NT) AT_WAIT_BAR(4); else AT_WAIT_BAR(0);
        if (t + 2 < NT) { const int s2 = slot == 0 ? 2 : slot - 1; AT_DMA(t + 2, s2); }
        const LAS char* kf = kfrag0 + slot * AT_KSLOT; const LAS char* vf = vfrag0 + slot * AT_KSLOT;
        f32x16 p0, p1;
#pragma unroll
        for (int r = 0; r < 16; ++r) { p0[r] = 0.f; p1[r] = 0.f; }
#pragma unroll
        for (int d0 = 0; d0 < 4; ++d0) {
            const bf16x8 k0 = *(const LAS bf16x8*)(kf + d0 * 2048), k1 = *(const LAS bf16x8*)(kf + d0 * 2048 + 512);
            p0 = __builtin_amdgcn_mfma_f32_32x32x16_bf16(k0, qr[d0], p0, 0, 0, 0);
            p1 = __builtin_amdgcn_mfma_f32_32x32x16_bf16(k1, qr[d0], p1, 0, 0, 0);
        }
        float sacc = 0.f;
#pragma unroll
        for (int r = 0; r < 16; ++r) { p0[r] = fast_exp2(p0[r]); p1[r] = fast_exp2(p1[r]); sacc += p0[r] + p1[r]; }
        lsum += sacc;
        u32x4 pw[4];
        pw[0] = (u32x4){cvt_pk_bf16(p0[0], p0[1]), cvt_pk_bf16(p0[2], p0[3]), cvt_pk_bf16(p0[4], p0[5]), cvt_pk_bf16(p0[6], p0[7])};
        pw[1] = (u32x4){cvt_pk_bf16(p0[8], p0[9]), cvt_pk_bf16(p0[10], p0[11]), cvt_pk_bf16(p0[12], p0[13]), cvt_pk_bf16(p0[14], p0[15])};
        pw[2] = (u32x4){cvt_pk_bf16(p1[0], p1[1]), cvt_pk_bf16(p1[2], p1[3]), cvt_pk_bf16(p1[4], p1[5]), cvt_pk_bf16(p1[6], p1[7])};
        pw[3] = (u32x4){cvt_pk_bf16(p1[8], p1[9]), cvt_pk_bf16(p1[10], p1[11]), cvt_pk_bf16(p1[12], p1[13]), cvt_pk_bf16(p1[14], p1[15])};
#pragma unroll
        for (int d0 = 0; d0 < 4; ++d0)
#pragma unroll
            for (int ks = 0; ks < 4; ++ks) {
                const s16x4 lo = vtr(vf + (d0 * 4 + ks) * 1024), hh = vtr(vf + (d0 * 4 + ks) * 1024 + 512);
                const bf16x8 vfr = (bf16x8){lo[0], lo[1], lo[2], lo[3], hh[0], hh[1], hh[2], hh[3]};
                o[d0] = __builtin_amdgcn_mfma_f32_32x32x16_bf16(vfr, __builtin_bit_cast(bf16x8, pw[ks]), o[d0], 0, 0, 0);
            }
        slot = slot == 2 ? 0 : slot + 1;
    }
    lsum += __shfl_xor(lsum, 32);
    const float inv = (s == 0 ? 1.f : A.lam) / lsum;
    AT_WAIT_BAR(0);
    LAS float* X = (LAS float*)(lds + AT_X) + rg * 4096;
    if (s == 1) {
#pragma unroll
        for (int d0 = 0; d0 < 4; ++d0)
#pragma unroll
            for (int r = 0; r < 16; ++r) X[(d0 * 16 + r) * 64 + lane] = o[d0][r] * inv;
    }
    AT_WAIT_BAR(0);
    if (s == 0) {
        float ss = 0.f;
#pragma unroll
        for (int d0 = 0; d0 < 4; ++d0)
#pragma unroll
            for (int r = 0; r < 16; ++r) { const float v = o[d0][r] * inv - X[(d0 * 16 + r) * 64 + lane]; o[d0][r] = v; ss += v * v; }
        ss += __shfl_xor(ss, 32);
        const float rn = rsqrtf(ss * (1.f / 128.f) + EPS) * A.oml;
        LAS bf16_t* stg = (LAS bf16_t*)(lds + AT_ST) + rg * (32 * 136);
#pragma unroll
        for (int d0 = 0; d0 < 4; ++d0)
#pragma unroll
            for (int rq = 0; rq < 4; ++rq) { const int dv = 32 * d0 + 8 * rq + 4 * hi; const f32x4 g4 = *(const f32x4*)(A.subln + dv);
                u32x2 w; w.x = cvt_pk_bf16(o[d0][4 * rq] * rn * g4[0], o[d0][4 * rq + 1] * rn * g4[1]); w.y = cvt_pk_bf16(o[d0][4 * rq + 2] * rn * g4[2], o[d0][4 * rq + 3] * rn * g4[3]);
                *(LAS u32x2*)(stg + r32 * 136 + dv) = w; }
        asm volatile("s_waitcnt lgkmcnt(0)" ::: "memory");
        bf16_t* dst = A.CAT + (size_t)(qrow0 + rg * 32) * 1024 + h * 128;
#pragma unroll
        for (int i = 0; i < 8; ++i) { const int row = i * 4 + (lane >> 4), ch = lane & 15; const u32x4 v = *(const LAS u32x4*)(stg + row * 136 + ch * 8); *(u32x4*)(dst + (size_t)row * 1024 + ch * 8) = v; }
    }
    AT_WAIT_BAR(0);
#undef AT_DMA
}
struct Args { const float* in[34]; float* out; unsigned char* ws; int stop_after; int pad; };
typedef const __attribute__((address_space(4))) Args* kargs_t;
struct Frame {
    LAS unsigned char* lds; int tid, lane, wave, vcu, bid, G;
    kargs_t ka; float* out; unsigned char* ws;
    float* misc; unsigned* ctl;
};
#define LDS_WAIT() asm volatile("s_waitcnt lgkmcnt(0)" ::: "memory")
#define VM_WAIT() asm volatile("s_waitcnt vmcnt(0)" ::: "memory")

__device__ __forceinline__ void mod_task(Frame& F, int task) {
    const int l = task / 96, strip = task % 96; LAS float* sc = (LAS float*)F.lds; LAS float* red = sc + 9 * 1024;
    for (int i = F.tid; i < 9 * 1024; i += NTHREADS) { const int cond = i >> 10, k = i & 1023; const float v = cond == 0 ? F.ka->in[6][k] : F.ka->in[5][(cond - 1) * 1024 + k]; sc[i] = v / (1.f + expf(-v)); }
    __syncthreads();
    const int j = strip * 64 + F.lane; const float* w = F.ka->in[7] + ((size_t)l * DM + F.wave * 128) * 6144 + j;
    float acc[9];
#pragma unroll
    for (int b = 0; b < 9; ++b) acc[b] = 0.f;
#pragma unroll 8
    for (int k = 0; k < 128; ++k) { const float wv = w[(size_t)k * 6144];
#pragma unroll
        for (int b = 0; b < 9; ++b) acc[b] += sc[b * 1024 + F.wave * 128 + k] * wv; }
#pragma unroll
    for (int b = 0; b < 9; ++b) red[(F.wave * 9 + b) * 64 + F.lane] = acc[b];
    __syncthreads();
    for (int i = F.tid; i < 9 * 64; i += NTHREADS) { const int b = i >> 6, ln = i & 63; float s = 0.f;
#pragma unroll
        for (int w8 = 0; w8 < 8; ++w8) s += red[(w8 * 9 + b) * 64 + ln];
        const int jj = strip * 64 + ln; F.misc[MI_MOD + (l * 9 + b) * 6144 + jj] = s + F.ka->in[8][l * 6144 + jj]; }
    __syncthreads();
}
template <int MAP> __device__ __forceinline__ int src_col(int p) {
    if (MAP == 1) { if (p >= 1024) return p; const int pn = p >> 8, r = p & 255, bj = r >> 7, wc = (r >> 5) & 3, fq = (r >> 3) & 3, low = r & 7; return 256 * pn + 64 * wc + 32 * (fq >> 1) + 16 * bj + 8 * (fq & 1) + low; }
    if (MAP == 2) { const int pn = p >> 8, bj = (p >> 7) & 1, r = p & 127; return bj * 2048 + 128 * pn + r; }
    return p;
}
template <int MAP> __device__ __forceinline__ void transpose_item(const float* W, int K, int N, bf16_t* WT, LAS float* scr, int item, int lane) {
    const int nblk = N / 32, kb = item / nblk, nb = item % nblk, k0 = 64 * kb, n0 = 32 * nb;
    const int sc_ = src_col<MAP>(n0 + (lane & 31));
#pragma unroll 8
    for (int i = 0; i < 32; ++i) { const int kk = 2 * i + (lane >> 5); scr[kk * 33 + (lane & 31)] = W[(size_t)(k0 + kk) * N + sc_]; }
    LDS_WAIT(); asm volatile("" ::: "memory");
    const int c = lane & 7;
#pragma unroll
    for (int j = 0; j < 4; ++j) { const int n = (lane >> 3) + 8 * j; const LAS float* s = scr + (8 * c) * 33 + n;
        u32x4 o; o.x = cvt_pk_bf16(s[0 * 33], s[1 * 33]); o.y = cvt_pk_bf16(s[2 * 33], s[3 * 33]); o.z = cvt_pk_bf16(s[4 * 33], s[5 * 33]); o.w = cvt_pk_bf16(s[6 * 33], s[7 * 33]);
        *(u32x4*)(WT + (size_t)(n0 + n) * K + k0 + 8 * c) = o; }
    LDS_WAIT(); asm volatile("" ::: "memory");
}
__device__ __forceinline__ void cache_item(Frame& F, int l, int item) {
    const int which = item >> 12, r = item & 4095, b = r >> 9, j = r & 511;
    const float* src = (which ? F.ka->in[3] : F.ka->in[2]) + ((size_t)(b * DEPTH + l) * PAST + j) * 512 + F.lane * 8;
    bf16_t* dst = (bf16_t*)(F.ws + (which ? WS_VB : WS_KB)) + (size_t)(MC + b * (PAST + DSEQ) + j) * 512 + F.lane * 8;
    const f32x4 a = *(const f32x4*)src, c = *(const f32x4*)(src + 4);
    *(u32x4*)dst = pack8(a, c);
}
__device__ __forceinline__ f32x2 cmul(f32x2 a, f32x2 b) { return (f32x2){a.x * b.x - a.y * b.y, a.x * b.y + a.y * b.x}; }
__device__ __forceinline__ void ssm_prep(Frame& F, int l, int g) {
    LAS f32x2* POW = (LAS f32x2*)F.lds;
    LAS f32x2* BB = POW + 2 * 17 * 64;
    LAS f32x2* CC = BB + 2 * 64 * 16;
    LAS float* KT = (LAS float*)(CC + 2 * 16 * 64);
    bf16_t* WE = (bf16_t*)(F.ws + WS_SSM + SSM_WE) + (size_t)g * 256 * 256;
    bf16_t* WY = (bf16_t*)(F.ws + WS_SSM + SSM_WY) + (size_t)g * 256 * 512;
    f32x2* LAM16 = (f32x2*)(F.ws + WS_SSM + SSM_LAM16); f32x2* BBAR = (f32x2*)(F.ws + WS_SSM + SSM_BBAR);
    const int tid = F.tid;
    if (tid < 128) { const int dir = tid >> 6, p = tid & 63; const size_t pi = ((size_t)(l * 2 + dir) * NG + g) * 64 + p;
        const float lr = F.ka->in[18][pi], li = F.ka->in[19][pi], delta = expf(F.ka->in[20][(l * 2 + dir) * NG + g]);
        for (int tau = 0; tau <= 16; ++tau) { const float er = expf(lr * delta * (float)tau), an = li * delta * (float)tau; POW[(dir * 17 + tau) * 64 + p] = (f32x2){er * cosf(an), er * sinf(an)}; }
        const float er = expf(lr * delta), lbr = er * cosf(li * delta), lbi = er * sinf(li * delta);
        const float nr = lbr - 1.f, ni = lbi, den = lr * lr + li * li; const f32x2 fac = (f32x2){(nr * lr + ni * li) / den, (ni * lr - nr * li) / den};
        { const float e16 = expf(lr * delta * 16.f), a16 = li * delta * 16.f; LAM16[(dir * NG + g) * 64 + p] = (f32x2){e16 * cosf(a16), e16 * sinf(a16)}; }
        for (int ch = 0; ch < 16; ++ch) { const size_t bi = pi * 16 + ch; const f32x2 bb = cmul(fac, (f32x2){F.ka->in[21][bi], F.ka->in[22][bi]}); BB[(dir * 64 + p) * 16 + ch] = bb; BBAR[((size_t)(dir * NG + g) * 64 + p) * 16 + ch] = bb; }
    }
    for (int i = tid; i < 2048; i += NTHREADS) { const int dir = i >> 10, c = (i >> 6) & 15, p = i & 63; const size_t ci = (((size_t)(l * 2 + dir) * NG + g) * 16 + c) * 64 + p; CC[i] = (f32x2){F.ka->in[23][ci], F.ka->in[24][ci]}; }
    __syncthreads();
    { const int c = F.lane >> 2, chq = F.lane & 3;
      for (int i = 0; i < 4; ++i) { const int q = F.wave * 4 + i, dir = q >> 4, tau = q & 15; float acc[4] = {0.f, 0.f, 0.f, 0.f};
#pragma unroll 4
          for (int p = 0; p < 64; ++p) { const f32x2 a = cmul(CC[(dir * 16 + c) * 64 + p], POW[(dir * 17 + tau) * 64 + p]);
#pragma unroll
              for (int e = 0; e < 4; ++e) { const f32x2 bb = BB[(dir * 64 + p) * 16 + chq * 4 + e]; acc[e] += a.x * bb.x - a.y * bb.y; } }
#pragma unroll
          for (int e = 0; e < 4; ++e) KT[(dir * 16 + tau) * 256 + c * 16 + chq * 4 + e] = acc[e]; } }
    __syncthreads();
    const float* Dv = F.ka->in[25] + l * 512 + g * 16;
    for (int idx = tid; idx < 256 * 64; idx += NTHREADS) { const int n = idx >> 6, k0 = (idx & 63) * 8, i = n >> 4, c = n & 15; float v[8];
        if (k0 < 256) { const int s = k0 >> 4, ch0 = k0 & 15;
#pragma unroll
            for (int e = 0; e < 8; ++e) { const int ch = ch0 + e; float x = 0.f; if (s <= i) x += KT[(i - s) * 256 + c * 16 + ch]; if (s >= i) x += KT[(16 + s - i) * 256 + c * 16 + ch]; if (s == i && ch == c) x += Dv[c]; v[e] = x; }
        } else { const int dir = k0 >= 384 ? 1 : 0, p0 = ((k0 - 256) & 127) >> 1, tau = dir ? 16 - i : i + 1;
#pragma unroll
            for (int pp = 0; pp < 4; ++pp) { const f32x2 z = cmul(CC[(dir * 16 + c) * 64 + p0 + pp], POW[(dir * 17 + tau) * 64 + p0 + pp]); v[2 * pp] = z.x; v[2 * pp + 1] = -z.y; } }
        u32x4 w; w.x = cvt_pk_bf16(v[0], v[1]); w.y = cvt_pk_bf16(v[2], v[3]); w.z = cvt_pk_bf16(v[4], v[5]); w.w = cvt_pk_bf16(v[6], v[7]);
        *(u32x4*)(WY + (size_t)n * 512 + k0) = w; }
    for (int idx = tid; idx < 256 * 32; idx += NTHREADS) { const int n = idx >> 5, k0 = (idx & 31) * 8, dir = n >> 7, p = (n & 127) >> 1, ri = n & 1, s = k0 >> 4, ch0 = k0 & 15; float v[8];
        const f32x2 pw = POW[(dir * 17 + (dir ? s : 15 - s)) * 64 + p];
#pragma unroll
        for (int e = 0; e < 8; ++e) { const f32x2 z = cmul(pw, BB[(dir * 64 + p) * 16 + ch0 + e]); v[e] = ri ? z.y : z.x; }
        u32x4 w; w.x = cvt_pk_bf16(v[0], v[1]); w.y = cvt_pk_bf16(v[2], v[3]); w.z = cvt_pk_bf16(v[4], v[5]); w.w = cvt_pk_bf16(v[6], v[7]);
        *(u32x4*)(WE + (size_t)n * 256 + k0) = w; }
    __syncthreads();
}
__device__ __forceinline__ void xprep_row(Frame& F, int row) {
    const float* xr = (row < MC) ? F.ka->in[0] + (size_t)row * DM : F.ka->in[1] + (size_t)(row - MC) * DM;
    const int cond = row < MC ? 0 : 1 + ((row - MC) >> 10);
    const float* sc = F.misc + MI_MOD + (0 * 9 + cond) * 6144 + 1024; const float* g1 = F.ka->in[9];
    bf16_t* dst = (bf16_t*)(F.ws + WS_XS) + (size_t)row * DM; float s = 0.f;
#pragma unroll
    for (int j = 0; j < 4; ++j) { const int c = 4 * F.lane + 256 * j; const f32x4 x = *(const f32x4*)(xr + c); const f32x4 t = x * x; s += (t[0] + t[1]) + (t[2] + t[3]);
        const f32x4 y = x * (*(const f32x4*)(g1 + c)) * (*(const f32x4*)(sc + c) + 1.f); u32x2 w; w.x = cvt_pk_bf16(y[0], y[1]); w.y = cvt_pk_bf16(y[2], y[3]); *(u32x2*)(dst + c) = w; }
    s = wave_sum(s);
    if (F.lane == 0) ((float*)(F.ctl + CW_SS))[row] = s;
}
__device__ __forceinline__ void bias_item(Frame& F, int item) {
    int which, l, n; if (item < 4096) { which = 0; l = item >> 11; n = item & 2047; } else { const int r = item - 4096; which = 1; l = r >> 12; n = r & 4095; }
    const bf16_t* wrow = (const bf16_t*)(F.ws + (which ? WS_WUP : WS_WIN)) + ((size_t)l * (which ? 4096 : 2048) + n) * DM;
    float wv[16]; { const u32x4 a = *(const u32x4*)(wrow + F.lane * 8), b = *(const u32x4*)(wrow + 512 + F.lane * 8);
        wv[0] = bflo(a.x); wv[1] = bfhi(a.x); wv[2] = bflo(a.y); wv[3] = bfhi(a.y); wv[4] = bflo(a.z); wv[5] = bfhi(a.z); wv[6] = bflo(a.w); wv[7] = bfhi(a.w);
        wv[8] = bflo(b.x); wv[9] = bfhi(b.x); wv[10] = bflo(b.y); wv[11] = bfhi(b.y); wv[12] = bflo(b.z); wv[13] = bfhi(b.z); wv[14] = bflo(b.w); wv[15] = bfhi(b.w); }
    float outv = 0.f;
    for (int cond = 0; cond < 9; ++cond) { const float* sh = F.misc + MI_MOD + (l * 9 + cond) * 6144 + (which ? 3072 : 0);
        const f32x4 s0 = *(const f32x4*)(sh + F.lane * 8), s1 = *(const f32x4*)(sh + F.lane * 8 + 4), s2 = *(const f32x4*)(sh + 512 + F.lane * 8), s3 = *(const f32x4*)(sh + 512 + F.lane * 8 + 4);
        float d = 0.f;
#pragma unroll
        for (int e = 0; e < 4; ++e) d += s0[e] * wv[e] + s1[e] * wv[4 + e] + s2[e] * wv[8 + e] + s3[e] * wv[12 + e];
        d = wave_sum(d); if (F.lane == cond) outv = d; }
    if (F.lane < 9) F.misc[(which ? MI_BUP + (l * 9 + F.lane) * 4096 : MI_BIN + (l * 9 + F.lane) * 2048) + n] = outv;
}
__device__ __forceinline__ void ssm_scan(Frame& F, int l, int g, int pm) {
    const int tid = F.tid, sl = tid >> 7, dp = tid & 127, dir = dp >> 6, p = dp & 63;
    const f32x2* LAM16 = (const f32x2*)(F.ws + WS_SSM + SSM_LAM16); const f32x2* BBAR = (const f32x2*)(F.ws + WS_SSM + SSM_BBAR);
    const float* E = (const float*)(F.ws + WS_R + R_E); bf16_t* AS3 = (bf16_t*)(F.ws + WS_R + R_AS3);
    const f32x2 lam = LAM16[(dir * NG + g) * 64 + p];
    const int nq = pm == 0 ? 4 : 1, n = pm == 0 ? 16 : 64;
    for (int q = 0; q < nq; ++q) {
        int base; f32x2 h;
        if (pm == 0) { const int seq = q * 4 + sl; base = seq * 16; h = (f32x2){0.f, 0.f}; }
        else { const int sq = (pm - 1) * 4 + sl; base = 256 + sq * 64; h = *(const f32x2*)(F.ka->in[4] + ((((size_t)sq * DEPTH + l) * 2 + dir) * NG + g) * 128 + 2 * p); }
        const float* ep = E + ((size_t)g * NCHUNK + base) * 256 + dir * 128 + 2 * p;
        unsigned* hp = (unsigned*)(AS3 + ((size_t)g * NCHUNK + base) * 512 + 256 + dir * 128 + 2 * p);
        for (int j0 = 0; j0 < n; j0 += 8) { f32x2 e[8];
#pragma unroll
            for (int jj = 0; jj < 8; ++jj) { const int j = dir ? (n - 1 - j0 - jj) : (j0 + jj); e[jj] = *(const f32x2*)(ep + (size_t)j * 256); }
#pragma unroll
            for (int jj = 0; jj < 8; ++jj) { const int j = dir ? (n - 1 - j0 - jj) : (j0 + jj); hp[(size_t)j * 256] = cvt_pk_bf16(h.x, h.y); h = cmul(lam, h) + e[jj]; } }
        if (pm == 0) { const int seq = q * 4 + sl; const int chunk = seq * 16 + (dir ? 15 : 0), tt = dir ? 15 : 0;
            const u32x4 u0 = *(const u32x4*)(AS3 + ((size_t)g * NCHUNK + chunk) * 512 + tt * 16), u1 = *(const u32x4*)(AS3 + ((size_t)g * NCHUNK + chunk) * 512 + tt * 16 + 8);
            float uu[16] = {bflo(u0.x), bfhi(u0.x), bflo(u0.y), bfhi(u0.y), bflo(u0.z), bfhi(u0.z), bflo(u0.w), bfhi(u0.w), bflo(u1.x), bfhi(u1.x), bflo(u1.y), bfhi(u1.y), bflo(u1.z), bfhi(u1.z), bflo(u1.w), bfhi(u1.w)};
            const f32x2* bb = BBAR + ((size_t)(dir * NG + g) * 64 + p) * 16; f32x2 acc = (f32x2){0.f, 0.f};
#pragma unroll
            for (int ch = 0; ch < 16; ++ch) acc += bb[ch] * uu[ch];
            float* ns = F.out + (size_t)MT * DM + 2 * (size_t)NB * DEPTH * SEQ * 512;
            *(f32x2*)(ns + ((((size_t)seq * DEPTH + l) * 2 + dir) * NG + g) * 128 + 2 * p) = acc; }
    }
}
__device__ __forceinline__ void ld16(const bf16_t* p, float* v) { const u32x4 a = *(const u32x4*)p; v[0] = bflo(a.x); v[1] = bfhi(a.x); v[2] = bflo(a.y); v[3] = bfhi(a.y); v[4] = bflo(a.z); v[5] = bfhi(a.z); v[6] = bflo(a.w); v[7] = bfhi(a.w); }
__device__ __forceinline__ void conv_item(Frame& F, int l, int item) {
    const int rs = item >> 4, pn = item & 15, lr = F.lane >> 4, lc = F.lane & 15;
    const int r0 = rs * 64 + lr * 16; const int av = 128 * pn + 8 * lc;
    const bf16_t* up = (const bf16_t*)(F.ws + WS_R) + (size_t)r0 * 4096 + 256 * pn + 8 * lc; bf16_t* gp = (bf16_t*)(F.ws + WS_G) + (size_t)r0 * 2048 + av;
    const float* cw = F.ka->in[31] + (size_t)l * 3 * 4096; const float* cb = F.ka->in[32] + (size_t)l * 4096;
    float wv[3][8], wg[3][8], bv[8], bg[8];
#pragma unroll
    for (int k = 0; k < 3; ++k)
#pragma unroll
        for (int e = 0; e < 8; ++e) { wv[k][e] = cw[k * 4096 + av + e]; wg[k][e] = cw[k * 4096 + 2048 + av + e]; }
#pragma unroll
    for (int e = 0; e < 8; ++e) { bv[e] = cb[av + e]; bg[e] = cb[2048 + av + e]; }
    const int t0 = r0 < MC ? (r0 & 255) : ((r0 - MC) & 1023), L = r0 < MC ? SEQ : DSEQ;
    float pv[8], pg[8], cv[8], cg[8], nv_[8], ng[8];
    if (t0 > 0) { ld16(up - 4096, pv); ld16(up - 4096 + 128, pg); } else {
#pragma unroll
        for (int e = 0; e < 8; ++e) { pv[e] = 0.f; pg[e] = 0.f; } }
    ld16(up, cv); ld16(up + 128, cg);
#pragma unroll
    for (int i = 0; i < 16; ++i) {
        if (t0 + i + 1 < L) { ld16(up + (size_t)(i + 1) * 4096, nv_); ld16(up + (size_t)(i + 1) * 4096 + 128, ng); } else {
#pragma unroll
            for (int e = 0; e < 8; ++e) { nv_[e] = 0.f; ng[e] = 0.f; } }
        float o[8];
#pragma unroll
        for (int e = 0; e < 8; ++e) { const float zv = bv[e] + wv[0][e] * pv[e] + wv[1][e] * cv[e] + wv[2][e] * nv_[e]; const float zg = bg[e] + wg[0][e] * pg[e] + wg[1][e] * cg[e] + wg[2][e] * ng[e]; o[e] = silu_f(zg) * zv; }
        u32x4 w; w.x = cvt_pk_bf16(o[0], o[1]); w.y = cvt_pk_bf16(o[2], o[3]); w.z = cvt_pk_bf16(o[4], o[5]); w.w = cvt_pk_bf16(o[6], o[7]);
        *(u32x4*)(gp + (size_t)i * 2048) = w;
#pragma unroll
        for (int e = 0; e < 8; ++e) { pv[e] = cv[e]; pg[e] = cg[e]; cv[e] = nv_[e]; cg[e] = ng[e]; }
    }
}
constexpr int N_TR_ITEMS_L = 16 * 64 + 8 * 16 + 16 * 32 + 16 * 128 + 32 * 32;
__device__ __forceinline__ void weight_item(Frame& F, LAS float* scr, int it) {
    const int l = it / N_TR_ITEMS_L; int r = it % N_TR_ITEMS_L;
    if (r < 1024) { transpose_item<1>(F.ka->in[10] + (size_t)l * DM * 2048, DM, 2048, (bf16_t*)(F.ws + WS_WIN) + (size_t)l * 2048 * DM, scr, r, F.lane); return; } r -= 1024;
    if (r < 128) { transpose_item<0>(F.ka->in[26] + (size_t)l * 512 * 512, 512, 512, (bf16_t*)(F.ws + WS_WGLU) + (size_t)l * 512 * 512, scr, r, F.lane); return; } r -= 128;
    if (r < 512) { transpose_item<0>(F.ka->in[28] + (size_t)l * DM * DM, DM, DM, (bf16_t*)(F.ws + WS_WOUT) + (size_t)l * DM * DM, scr, r, F.lane); return; } r -= 512;
    if (r < 2048) { transpose_item<2>(F.ka->in[30] + (size_t)l * DM * 4096, DM, 4096, (bf16_t*)(F.ws + WS_WUP) + (size_t)l * 4096 * DM, scr, r, F.lane); return; } r -= 2048;
    transpose_item<0>(F.ka->in[33] + (size_t)l * 2048 * DM, 2048, DM, (bf16_t*)(F.ws + WS_WDN) + (size_t)l * DM * 2048, scr, r, F.lane);
}

__global__ void __launch_bounds__(NTHREADS, 2) mega(Args args) {
    extern __shared__ __attribute__((aligned(16))) unsigned char lds_raw[];
    Frame F;
    F.lds = (LAS unsigned char*)lds_raw;
    F.tid = threadIdx.x; F.lane = F.tid & 63; F.wave = __builtin_amdgcn_readfirstlane(F.tid >> 6);
    F.G = gridDim.x; F.bid = blockIdx.x; { const int bx = blockIdx.x; F.vcu = (F.G % 8 == 0) ? (bx % 8) * (F.G / 8) + bx / 8 : bx; }
    F.ka = (kargs_t)__builtin_amdgcn_kernarg_segment_ptr();
    F.out = args.out; F.ws = args.ws; F.misc = (float*)(args.ws + WS_MISC); F.ctl = (unsigned*)(args.ws + WS_CTL);
    volatile LAS unsigned* MISC = (volatile LAS unsigned*)(F.lds + MISC_OFF);
    for (int u = F.tid; u < (LDS_BYTES - LDSCTL_OFF) / 4; u += NTHREADS) ((LAS unsigned*)(F.lds + LDSCTL_OFF))[u] = 0u;
    __syncthreads();
    XcdBarrier bar = xcd_barrier_post(F.ctl + CW_BAR, MISC + 8);
    int phase_no = 0;
#define LAUNDER() do { asm volatile("" : "+s"(F.ka), "+s"(F.ws), "+s"(F.out), "+s"(F.bid), "+v"(F.tid)); F.vcu = (F.G % 8 == 0) ? (F.bid % 8) * (F.G / 8) + F.bid / 8 : F.bid; F.lane = F.tid & 63; F.wave = __builtin_amdgcn_readfirstlane(F.tid >> 6); \
    F.misc = (float*)(F.ws + WS_MISC); F.ctl = (unsigned*)(F.ws + WS_CTL); gw = F.vcu * NWAVES + F.wave; } while (0)
#define GRID_BAR() do { xcd_barrier(bar); ++phase_no; if (F.ka->stop_after == phase_no) return; LAUNDER(); } while (0)
    int gw = F.vcu * NWAVES + F.wave; const int NGW = F.G * NWAVES;
#define ssq ((float*)(F.ctl + CW_SS))
#define XS ((bf16_t*)(F.ws + WS_XS))
#define KB ((bf16_t*)(F.ws + WS_KB))
#define VB ((bf16_t*)(F.ws + WS_VB))
#define Qb ((bf16_t*)(F.ws + WS_R + R_Q))
#define AS3 ((bf16_t*)(F.ws + WS_R + R_AS3))
#define Eb ((float*)(F.ws + WS_R + R_E))
#define Zb ((bf16_t*)(F.ws + WS_R + R_Z))
#define CAT ((bf16_t*)(F.ws + WS_R + R_CAT))
#define UP ((bf16_t*)(F.ws + WS_R))
#define Gb ((bf16_t*)(F.ws + WS_G))

    if (F.vcu < 192) mod_task(F, F.vcu);
    else if (F.vcu < 224) ssm_prep(F, 0, F.vcu - 192);
    else if (F.vcu == 224) {
        for (int i = F.tid; i < 1024; i += NTHREADS) { const int pos = i >> 4, f = i & 15; const float inv = 1.0f / powf(10000.0f, (float)f / 16.0f); const float ang = (float)pos * inv;
            ((f32x2*)(F.misc + MI_ROPE))[i] = (f32x2){cosf(ang), sinf(ang)}; }
        if (F.tid < 2) { const int l = F.tid; float a1 = 0.f, a2 = 0.f; for (int d = 0; d < 64; ++d) { a1 += F.ka->in[13][l * 64 + d] * F.ka->in[14][l * 64 + d]; a2 += F.ka->in[15][l * 64 + d] * F.ka->in[16][l * 64 + d]; }
            const float li = 0.8f - 0.6f * expf(-0.3f * (float)l); F.misc[MI_LAM + l] = expf(a1) - expf(a2) + li; F.misc[MI_LAM + 2 + l] = 1.f - li; }
    }
    { LAS float* scr = (LAS float*)(F.lds + F.wave * 16384);
      for (int it = gw; it < 2 * N_TR_ITEMS_L; it += NGW) weight_item(F, scr, it);
      for (int it = gw; it < 8192; it += NGW) cache_item(F, 0, it); }
    GRID_BAR();
    for (int it = gw; it < MT; it += NGW) xprep_row(F, it);
    for (int it = gw; it < 4096 + 8192; it += NGW) bias_item(F, it);
    GRID_BAR();

    for (int l = 0; l < DEPTH; ++l) {
        const float* modl = F.misc + MI_MOD + l * 9 * 6144;
        { Gemm g{XS, (const bf16_t*)(F.ws + WS_WIN) + (size_t)l * 2048 * DM, DM, DM, DM, 0, 0}; GridOrder S; S.init(MT, 2048, F.G, F.bid);
          EpiIn E{ssq + (l == 0 ? 0 : 2 * MT), F.misc + MI_BIN + l * 9 * 2048, F.ka->in[11] + l * 64, F.ka->in[12] + l * 64, (const f32x2*)(F.misc + MI_ROPE), Qb, KB, VB, AS3,
                  F.out + (size_t)MT * DM, F.out + (size_t)MT * DM + (size_t)NB * DEPTH * SEQ * 512, l};
          gemm_phase<EpiIn, GridOrder>(F.lds, F.tid, g, S, E); }
        GRID_BAR();
        { AttnArgs A{Qb, KB, VB, CAT, F.ka->in[17] + l * 128, F.misc[MI_LAM + l], F.misc[MI_LAM + 2 + l]};
          if (F.vcu < 256) { const int u = F.vcu; attn_unit(F.lds, F.tid, A, NB + (u >> 5), (u >> 3) & 3, u & 7); }
          if (F.vcu < 128) { const int u = F.vcu; attn_unit(F.lds, F.tid, A, u >> 3, (u >> 1) & 3, u & 1); }
          Gemm g{AS3, (const bf16_t*)(F.ws + WS_SSM + SSM_WE), 512, 256, 256, (size_t)NCHUNK * 512, (size_t)256 * 256}; GroupOrder S{F.vcu - 128, F.G};
          EpiS1 E{Eb};
          gemm_phase<EpiS1, GroupOrder>(F.lds, F.tid, g, S, E); }
        GRID_BAR();
        { if (F.vcu < NG * 3) { ssm_scan(F, l, F.vcu / 3, F.vcu % 3); VM_WAIT(); __syncthreads(); }
          Gemm g{AS3, (const bf16_t*)(F.ws + WS_SSM + SSM_WY), 512, 512, 512, (size_t)NCHUNK * 512, (size_t)256 * 512}; GroupOrder S{F.vcu, F.G};
          EpiS3 E{Zb};
          gemm_phase<EpiS3, GroupOrder>(F.lds, F.tid, g, S, E); }
        GRID_BAR();
        { Gemm g{Zb, (const bf16_t*)(F.ws + WS_WGLU) + (size_t)l * 512 * 512, 512, 512, 512, 0, 0}; GridOrder S; S.init(MT, 512, F.G, F.bid);
          EpiGlu E{Zb, F.ka->in[27] + l * 512, CAT};
          gemm_phase<EpiGlu, GridOrder>(F.lds, F.tid, g, S, E); }
        GRID_BAR();
        { Gemm g{CAT, (const bf16_t*)(F.ws + WS_WOUT) + (size_t)l * DM * DM, DM, DM, DM, 0, 0}; GridOrder S; S.init(MT, DM, F.G, F.bid);
          EpiRes E{l == 0 ? F.ka->in[0] : F.out, l == 0 ? F.ka->in[1] : F.out + (size_t)MC * DM, F.out, modl + 2 * DM, F.ka->in[29] + l * DM, modl + 4 * DM, XS, ssq + (l == 0 ? 1 : 3) * MT};
          gemm_phase<EpiRes, GridOrder>(F.lds, F.tid, g, S, E);
          if (l + 1 < DEPTH && F.bid >= 192 && F.bid < 224) ssm_prep(F, l + 1, F.bid - 192); }
        GRID_BAR();
        { Gemm g{XS, (const bf16_t*)(F.ws + WS_WUP) + (size_t)l * 4096 * DM, DM, DM, DM, 0, 0}; GridOrder S; S.init(MT, 4096, F.G, F.bid);
          EpiUp E{ssq + (l == 0 ? 1 : 3) * MT, F.misc + MI_BUP + l * 9 * 4096, UP};
          gemm_phase<EpiUp, GridOrder>(F.lds, F.tid, g, S, E); }
        GRID_BAR();
        for (int it = gw; it < 192 * 16; it += NGW) conv_item(F, l, it);
        GRID_BAR();
        { Gemm g{Gb, (const bf16_t*)(F.ws + WS_WDN) + (size_t)l * DM * 2048, 2048, 2048, 2048, 0, 0}; GridOrder S; S.init(MT, DM, F.G, F.bid);
          const bool nxt = l + 1 < DEPTH;
          EpiRes E{F.out, F.out + (size_t)MC * DM, F.out, modl + 5 * DM, nxt ? F.ka->in[9] + (l + 1) * DM : nullptr, nxt ? modl + 9 * 6144 + DM : nullptr, XS, ssq + 2 * MT};
          gemm_phase<EpiRes, GridOrder>(F.lds, F.tid, g, S, E);
          if (nxt && F.bid >= 192) for (int it = (F.bid - 192) * NWAVES + F.wave; it < 8192; it += 64 * NWAVES) cache_item(F, l + 1, it); }
        if (l + 1 < DEPTH) GRID_BAR();
    }
#undef GRID_BAR
#undef LAUNDER
#undef ssq
#undef XS
#undef KB
#undef VB
#undef Qb
#undef AS3
#undef Eb
#undef Zb
#undef CAT
#undef UP
#undef Gb
}
}

static int fk_launch(void* const* d_in, void* d_out, void* d_ws, size_t ws_size, hipStream_t stream, int stop_after) {
    static int grid = 0;
    if (grid == 0) {
        int dev = 0, cus = 0;
        if (ws_size < fk::WS_END) { fprintf(stderr, "kernel_launch: workspace too small (%zu < %zu)\n", ws_size, (size_t)fk::WS_END); grid = -1; return -1; }
        if (hipGetDevice(&dev) != hipSuccess || hipDeviceGetAttribute(&cus, hipDeviceAttributeMultiprocessorCount, dev) != hipSuccess) { grid = -1; return -1; }
        if (hipFuncSetAttribute((const void*)fk::mega, hipFuncAttributeMaxDynamicSharedMemorySize, fk::LDS_BYTES) != hipSuccess) { fprintf(stderr, "kernel_launch: hipFuncSetAttribute failed\n"); grid = -1; return -1; }
        int per_cu = 0; (void)hipOccupancyMaxActiveBlocksPerMultiprocessor(&per_cu, (const void*)fk::mega, fk::NTHREADS, fk::LDS_BYTES); (void)hipGetLastError();
        if (per_cu < 1) fprintf(stderr, "kernel_launch: occupancy query says %d blocks/CU\n", per_cu);
        grid = cus;
        if (grid != 256) fprintf(stderr, "kernel_launch: %d CUs (built for 256)\n", grid);
    }
    if (grid < 0) return -1;
    (void)hipMemsetAsync((char*)d_ws + fk::WS_CTL, 0, fk::CTL_BYTES, stream);
    fk::Args a{};
    for (int i = 0; i < 34; ++i) a.in[i] = (const float*)d_in[i];
    a.out = (float*)d_out; a.ws = (unsigned char*)d_ws; a.stop_after = stop_after; a.pad = 0;
    hipLaunchKernelGGL(fk::mega, dim3(grid), dim3(fk::NTHREADS), fk::LDS_BYTES, stream, a);
    return 0;
}
extern "C" void kernel_launch(void* const* d_in, const int* in_sizes, int n_in, void* d_out, int out_size, void* d_ws, size_t ws_size, hipStream_t stream) {
    if (n_in != 34) { fprintf(stderr, "kernel_launch: unexpected n_in %d\n", n_in); return; }
    fk_launch(d_in, d_out, d_ws, ws_size, stream, 0);
}
```

```cpp
#include <hip/hip_runtime.h>
#include <cstdio>
#include <cstdint>
namespace fk {
#define LAS __attribute__((address_space(3)))
#define GAS __attribute__((address_space(1)))
typedef unsigned short bf16_t;
typedef short bf16x8 __attribute__((ext_vector_type(8)));
typedef short s16x4 __attribute__((ext_vector_type(4)));
typedef float f32x4 __attribute__((ext_vector_type(4)));
typedef float f32x2 __attribute__((ext_vector_type(2)));
typedef float f32x16 __attribute__((ext_vector_type(16)));
typedef unsigned u32x4 __attribute__((ext_vector_type(4)));
typedef unsigned u32x2 __attribute__((ext_vector_type(2)));

constexpr int DM = 1024, NB = 16, SEQ = 256, DEPTH = 2, DB = 8, DSEQ = 1024, PAST = 512;
constexpr int MC = NB * SEQ, MS = DB * DSEQ, MT = MC + MS;
constexpr int NH = 4, NG = 32, NCOND = 9, NMOD = 6;
constexpr int NCHUNK = MT / 16;
constexpr int KVROWS = MC + DB * (PAST + DSEQ);
constexpr float EPS = 1e-6f;
constexpr float C2 = 0.125f * 1.4426950408889634f;
constexpr int NWAVES = 8, NTHREADS = 512;

constexpr size_t MiB = 1u << 20;
constexpr size_t WS_CTL = 0, CTL_BYTES = 1 * MiB;
constexpr size_t WS_MISC = 1 * MiB;
constexpr size_t WS_WIN = 3 * MiB;
constexpr size_t WS_WGLU = 11 * MiB;
constexpr size_t WS_WOUT = 12 * MiB;
constexpr size_t WS_WUP = 16 * MiB;
constexpr size_t WS_WDN = 32 * MiB;
constexpr size_t WS_SSM = 40 * MiB;
constexpr size_t WS_XS = 53 * MiB;
constexpr size_t WS_KB = 77 * MiB;
constexpr size_t WS_VB = 93 * MiB;
constexpr size_t WS_R = 109 * MiB;
constexpr size_t WS_G = 205 * MiB;
constexpr size_t WS_END = 253 * MiB;
constexpr size_t R_Q = 0, R_AS3 = 12 * MiB, R_E = 36 * MiB, R_Z = 60 * MiB, R_CAT = 72 * MiB;
constexpr size_t SSM_WE = 0, SSM_WY = 4 * MiB, SSM_LAM16 = 12 * MiB, SSM_BBAR = 12 * MiB + 64 * 1024;
constexpr int MI_MOD = 0;
constexpr int MI_ROPE = MI_MOD + 2 * 9 * 6144;
constexpr int MI_LAM = MI_ROPE + 64 * 16 * 2;
constexpr int MI_END = MI_LAM + 8;
static_assert((size_t)MI_END * 4 <= 2 * MiB, "MISC");
constexpr int CW_BAR = 1024;
constexpr int CW_SS = 8192;
constexpr int CW_BIN = 65536;
constexpr int CW_BUP = CW_BIN + 2 * 9 * 2048;
static_assert((size_t)(CW_SS + 4 * MT) <= CW_BIN && (size_t)(CW_BUP + 2 * 9 * 4096) * 4 <= CTL_BYTES, "CTL");

constexpr int RING_BYTES = 131072;
constexpr int LDS_BYTES_ = 147456; constexpr int LDSCTL_OFF = LDS_BYTES_ - 512, MISC_OFF = LDSCTL_OFF + 320;
constexpr int LDS_BYTES = 147456;

#define RLX_AGENT __ATOMIC_RELAXED, __HIP_MEMORY_SCOPE_AGENT
__device__ __forceinline__ unsigned cvt_pk_bf16(float lo, float hi) { unsigned r; asm volatile("v_cvt_pk_bf16_f32 %0, %1, %2" : "=v"(r) : "v"(lo), "v"(hi)); return r; }
__device__ __forceinline__ float bf2f(unsigned short b) { return __uint_as_float((unsigned)b << 16); }
__device__ __forceinline__ float bflo(unsigned w) { return __uint_as_float(w << 16); }
__device__ __forceinline__ float bfhi(unsigned w) { return __uint_as_float(w & 0xffff0000u); }
__device__ __forceinline__ float fast_exp2(float x) { return __builtin_amdgcn_exp2f(x); }
__device__ __forceinline__ float fast_rcp(float x) { return __builtin_amdgcn_rcpf(x); }
__device__ __forceinline__ float sigmoid_f(float x) { return fast_rcp(1.f + fast_exp2(-1.4426950408889634f * x)); }
__device__ __forceinline__ float silu_f(float x) { return x * sigmoid_f(x); }
__device__ __forceinline__ float gelu_tanh_f(float x) {
    const float u = 0.7978845608028654f * (x + 0.044715f * x * x * x); return x * sigmoid_f(2.f * u); }
__device__ __forceinline__ float wave_sum(float v) {
#pragma unroll
    for (int o = 1; o < 64; o <<= 1) v += __shfl_xor(v, o);
    return v; }

#define XB_TMO      128
#define XB_XCNT(j)  (256  + 64 * (j))
#define XB_XSUB(j)  (1280 + 64 * (j))
#define XB_XGEN(j)  (2304 + 64 * (j))
#define XB_TOP      3328
#define XB_TOPGEN   3392
#define XCD_BAR_WORDS 3456
#define XB_SPIN_CAP (1u << 18)
__device__ __forceinline__ unsigned xb_ld(unsigned* p)              { return __hip_atomic_load(p, __ATOMIC_RELAXED, __HIP_MEMORY_SCOPE_AGENT); }
__device__ __forceinline__ unsigned xb_add(unsigned* p, unsigned v) { return __hip_atomic_fetch_add(p, v, __ATOMIC_RELAXED, __HIP_MEMORY_SCOPE_AGENT); }
__device__ __forceinline__ unsigned xb_xcc_id() { return (unsigned)__builtin_amdgcn_s_getreg((3 << 11) | 20) & 0xFu; }
#define XB_SPIN(cond, bar) do { unsigned _sp = 0; while (cond) { __builtin_amdgcn_s_sleep(1); \
    if ((++_sp & 255u) == 0u) { if (xb_ld(&(bar)[XB_TMO])) break; if (_sp > XB_SPIN_CAP) { atomicAdd(&(bar)[XB_TMO], 1u); break; } } } } while (0)
struct XcdBarrier { unsigned* bar; unsigned x; volatile LAS unsigned* st; };
__device__ __forceinline__ XcdBarrier xcd_barrier_post(unsigned* bar, volatile LAS unsigned* st) {
    XcdBarrier b; b.bar = bar; b.x = xb_xcc_id(); b.st = st;
    if (threadIdx.x == 0) (void)xb_add(&bar[XB_XCNT(b.x)], 1u);
    return b;
}
__device__ __forceinline__ void xcd_barrier_complete(unsigned* bar, unsigned x, unsigned& nloc, unsigned& nx) {
    const unsigned G = gridDim.x * gridDim.y * gridDim.z;
    unsigned sum, cnt, mine, sp = 0u;
    for (;;) {
        sum = 0u; cnt = 0u; mine = 0u;
#pragma unroll
        for (unsigned j = 0; j < 16; ++j) { const unsigned c = xb_ld(&bar[XB_XCNT(j)]); sum += c; cnt += (c > 0u) ? 1u : 0u; mine = (j == x) ? c : mine; }
        if (sum == G) break;
        __builtin_amdgcn_s_sleep(1);
        if ((++sp & 255u) == 0u) { if (xb_ld(&bar[XB_TMO])) break; if (sp > XB_SPIN_CAP) { atomicAdd(&bar[XB_TMO], 1u); break; } }
    }
    nloc = mine > 0u ? mine : 1u; nx = cnt > 0u ? cnt : 1u;
}
__device__ __forceinline__ void xcd_barrier(const XcdBarrier& b) {
    asm volatile("s_waitcnt vmcnt(0)" ::: "memory");
    __syncthreads();
    if (threadIdx.x == 0) {
        unsigned* bar = b.bar;
        __builtin_amdgcn_s_waitcnt(0);
        unsigned nloc = b.st[0], nx = b.st[1];
        if (nloc == 0u) { xcd_barrier_complete(bar, b.x, nloc, nx); b.st[0] = nloc; b.st[1] = nx; }
        const unsigned old = xb_add(&bar[XB_XSUB(b.x)], 1u);
        const unsigned gen = old / nloc;
        if (old + 1u == (gen + 1u) * nloc) {
            __builtin_amdgcn_fence(__ATOMIC_RELEASE, "agent");
            asm volatile("s_waitcnt vmcnt(0)" ::: "memory");
            const unsigned og = xb_add(&bar[XB_TOP], 1u);
            const unsigned tg = og / nx;
            if (og + 1u == (tg + 1u) * nx) xb_add(&bar[XB_TOPGEN], 1u);
            else XB_SPIN(xb_ld(&bar[XB_TOPGEN]) == tg, bar);
            __builtin_amdgcn_fence(__ATOMIC_ACQUIRE, "agent");
            xb_add(&bar[XB_XGEN(b.x)], 1u);
            asm volatile("s_waitcnt vmcnt(0)" ::: "memory");
        } else {
            XB_SPIN(xb_ld(&bar[XB_XGEN(b.x)]) == gen, bar);
            __builtin_amdgcn_fence(__ATOMIC_ACQUIRE, "agent");
            asm volatile("s_waitcnt vmcnt(0)" ::: "memory");
        }
    }
    __syncthreads();
}

constexpr int BM = 256, BK = 64, HALF = 128, HTB = HALF * BK * 2, NXCD = 8, WGM = 8;
__host__ __device__ __forceinline__ int lds_byte(int r, int c) { const int st = (r >> 4) * 2 + (c >> 5), rr = r & 15, cc = c & 31, ob = rr * 64 + cc * 2; return st * 1024 + (ob ^ (((ob >> 9) & 1) << 5)); }
__host__ __device__ __forceinline__ void stage_rc(int b, int& R, int& C) { const int st = b / 1024, sb = b % 1024, swz = sb ^ (((sb >> 9) & 1) << 5); R = (st >> 1) * 16 + swz / 64; C = (st & 1) * 32 + (swz % 64) / 2; }
__host__ __device__ __forceinline__ int perm32(int rho) { const int n = rho >> 4, i = rho & 15; return 8 * (i >> 2) + 4 * n + (i & 3); }

struct Unit { int pm, pn, g; };
struct Gemm { const bf16_t* A; const bf16_t* Bt; int lda, ldb, K; size_t gsA, gsB; };
struct GridOrder {
    int nM, nN, nwg, G, c;
    __device__ void init(int M, int N, int G_, int c_) { nM = M / BM; nN = N / BM; nwg = nM * nN; G = G_; c = c_; }
    __device__ bool next(int i, Unit& u) const {
        const long L = (long)i * G + c; if (L >= nwg) return false;
        int wgid = (int)L; { const int q = nwg / NXCD, r = nwg % NXCD, xcd = wgid % NXCD, off = wgid / NXCD; wgid = (xcd < r ? xcd * (q + 1) : r * (q + 1) + (xcd - r) * q) + off; }
        const int nig = WGM * nN, gid = wgid / nig, fm = gid * WGM, gsz = (nM - fm) < WGM ? (nM - fm) : WGM;
        u.pm = fm + ((wgid % nig) % gsz); u.pn = (wgid % nig) / gsz; u.g = 0; return true;
    }
};
struct GroupOrder {
    int c, G;
    __device__ bool next(int i, Unit& u) const { const int idx = c + i * G; if (c < 0 || idx >= NG * 3) return false; u.g = idx / 3; u.pm = idx % 3; u.pn = 0; return true; }
};

template <class Epi, class Sched>
__device__ __forceinline__ void gemm_phase(LAS unsigned char* lds, const int tid, const Gemm g, const Sched& S, const Epi& E) {
    const int wid = __builtin_amdgcn_readfirstlane(tid >> 6), lane = tid & 63, wr = wid >> 2, wc = wid & 3, fr = lane & 15, fq = lane >> 4;
    const int K = g.K, nt = K / BK;
    unsigned voffA[2], voffB[2];
#pragma unroll
    for (int i = 0; i < 2; ++i) { int R, C; stage_rc(tid * 16 + i * 8192, R, C); const int Rb = Epi::PERM ? ((R & ~31) + perm32(R & 31)) : R;
        voffA[i] = (unsigned)(R * g.lda + C) * 2u; voffB[i] = (unsigned)(Rb * g.ldb + C) * 2u; }
    const size_t kstep = (size_t)(BK * 2);
    const size_t hstepA = (size_t)HALF * g.lda * 2, hstepB = (size_t)HALF * g.ldb * 2;
    const unsigned ldsw = (unsigned)wid * 1024u;
    const int aoff = lds_byte(wr * 64 + fr, fq * 8), boff = lds_byte(wc * 32 + fr, fq * 8);
#define PG8_SA(b, h) (((b) * 2 + (h)) * HTB)
#define PG8_SB(b, h) ((4 + (b) * 2 + (h)) * HTB)
#define PG8_STAGE(bufoff, gbase, voff) do { _Pragma("unroll") for (int _i = 0; _i < 2; ++_i) \
        __builtin_amdgcn_global_load_lds((const unsigned*)((const char*)(gbase) + (voff)[_i]), (LAS unsigned*)(lds + (bufoff) + ldsw + _i * 8192), 16, 0, 0); } while (0)
#define PG8_LDA(dst, b, h) do { _Pragma("unroll") for (int m = 0; m < 4; ++m) _Pragma("unroll") for (int k = 0; k < 2; ++k) dst[m][k] = *(const LAS bf16x8*)(lds + PG8_SA(b, h) + aoff + m * 2048 + k * 1024); } while (0)
#define PG8_LDB(dst, b, h) do { _Pragma("unroll") for (int n = 0; n < 2; ++n) _Pragma("unroll") for (int k = 0; k < 2; ++k) dst[n][k] = *(const LAS bf16x8*)(lds + PG8_SB(b, h) + boff + n * 2048 + k * 1024); } while (0)
#define PG8_MMA(ai, bj, At, Bt) do { __builtin_amdgcn_s_setprio(1); _Pragma("unroll") for (int m = 0; m < 4; ++m) _Pragma("unroll") for (int n = 0; n < 2; ++n) _Pragma("unroll") for (int k = 0; k < 2; ++k) \
        acc[ai][bj][m][n] = __builtin_amdgcn_mfma_f32_16x16x32_bf16(Bt[n][k], At[m][k], acc[ai][bj][m][n], 0, 0, 0); __builtin_amdgcn_s_setprio(0); } while (0)
#define PG8_WAIT_V(n) asm volatile("s_waitcnt vmcnt(" #n ")" ::: "memory")
#define PG8_WAIT_L(n) asm volatile("s_waitcnt lgkmcnt(" #n ")" ::: "memory")
#define PG8_BAR __builtin_amdgcn_s_barrier()
#define PG8_SCHED __builtin_amdgcn_sched_barrier(0)
#define PG8_APTR(u) ((const char*)g.A + ((size_t)(u).g * g.gsA + (size_t)(u).pm * BM * g.lda) * 2)
#define PG8_BPTR(u) ((const char*)g.Bt + ((size_t)(u).g * g.gsB + (size_t)(u).pn * BM * g.ldb) * 2)
    Unit cur, nxt; int ui = 0;
    if (!S.next(0, cur)) return;
    f32x4 acc[2][2][4][2];
#pragma unroll
    for (int a = 0; a < 2; ++a)
#pragma unroll
        for (int b = 0; b < 2; ++b)
#pragma unroll
            for (int m = 0; m < 4; ++m)
#pragma unroll
                for (int n = 0; n < 2; ++n) acc[a][b][m][n] = (f32x4){0.f, 0.f, 0.f, 0.f};
    bf16x8 At[4][2], B0[2][2], B1[2][2];
    const char* cA = PG8_APTR(cur); const char* cB = PG8_BPTR(cur);
    PG8_STAGE(PG8_SB(0, 0), cB, voffB); PG8_STAGE(PG8_SB(0, 1), cB + hstepB, voffB); PG8_STAGE(PG8_SA(0, 0), cA, voffA); PG8_STAGE(PG8_SA(0, 1), cA + hstepA, voffA);
    if (wr == 1) PG8_BAR;
    PG8_WAIT_V(2); PG8_BAR;
    PG8_STAGE(PG8_SB(1, 0), cB + kstep, voffB); PG8_STAGE(PG8_SA(1, 0), cA + kstep, voffA); PG8_STAGE(PG8_SB(1, 1), cB + hstepB + kstep, voffB);
    PG8_WAIT_V(6); PG8_BAR;
    for (;;) {
        const bool has_next = S.next(ui + 1, nxt);
        const char* nA = has_next ? PG8_APTR(nxt) : cA; const char* nB = has_next ? PG8_BPTR(nxt) : cB;
        for (int t = 0; t < nt; t += 2) {
            const bool last = (t == nt - 2);
            const char* a1 = cA + (size_t)(t + 1) * kstep;
            const char* a2 = last ? nA : cA + (size_t)(t + 2) * kstep; const char* b2 = last ? nB : cB + (size_t)(t + 2) * kstep;
            const char* a3 = a2 + kstep; const char* b3 = b2 + kstep;
            PG8_LDB(B0, 0, 0); PG8_LDB(B1, 0, 1); PG8_SCHED; PG8_LDA(At, 0, 0); PG8_STAGE(PG8_SA(1, 1), a1 + hstepA, voffA);
            PG8_WAIT_V(8); PG8_WAIT_L(0); PG8_BAR; PG8_MMA(0, 0, At, B0); PG8_MMA(0, 1, At, B1); PG8_BAR; PG8_SCHED;
            PG8_LDA(At, 0, 1); PG8_STAGE(PG8_SB(0, 0), b2, voffB); PG8_STAGE(PG8_SB(0, 1), b2 + hstepB, voffB); PG8_STAGE(PG8_SA(0, 0), a2, voffA);
            PG8_WAIT_V(8); PG8_WAIT_L(0); PG8_BAR; PG8_MMA(1, 0, At, B0); PG8_MMA(1, 1, At, B1); PG8_BAR; PG8_SCHED;
            PG8_LDB(B0, 1, 0); PG8_LDB(B1, 1, 1); PG8_SCHED; PG8_LDA(At, 1, 0); PG8_STAGE(PG8_SA(0, 1), a2 + hstepA, voffA);
            PG8_WAIT_V(8); PG8_WAIT_L(0); PG8_BAR; PG8_MMA(0, 0, At, B0); PG8_MMA(0, 1, At, B1); PG8_BAR; PG8_SCHED;
            PG8_LDA(At, 1, 1); PG8_STAGE(PG8_SB(1, 0), b3, voffB); PG8_STAGE(PG8_SB(1, 1), b3 + hstepB, voffB); PG8_STAGE(PG8_SA(1, 0), a3, voffA);
            PG8_WAIT_V(8); PG8_WAIT_L(0); PG8_BAR; PG8_MMA(1, 0, At, B0); PG8_MMA(1, 1, At, B1); PG8_BAR; PG8_SCHED;
        }
        if (wr == 0) PG8_BAR;
        E(acc, cur, wr, wc, fr, fq);
        if (!has_next) break;
#pragma unroll
        for (int a = 0; a < 2; ++a)
#pragma unroll
            for (int b = 0; b < 2; ++b)
#pragma unroll
                for (int m = 0; m < 4; ++m)
#pragma unroll
                    for (int n = 0; n < 2; ++n) acc[a][b][m][n] = (f32x4){0.f, 0.f, 0.f, 0.f};
        cur = nxt; cA = nA; cB = nB; ++ui;
        if (wr == 1) PG8_BAR;
    }
    PG8_WAIT_V(0);
    PG8_BAR;
#undef PG8_SA
#undef PG8_SB
#undef PG8_STAGE
#undef PG8_LDA
#undef PG8_LDB
#undef PG8_MMA
#undef PG8_WAIT_V
#undef PG8_WAIT_L
#undef PG8_BAR
#undef PG8_SCHED
#undef PG8_APTR
#undef PG8_BPTR
}
__device__ __forceinline__ int cond_of_pm(int pm) { return pm < 16 ? 0 : 1 + ((pm - 16) >> 2); }
__device__ __forceinline__ int kvrow_of(int row) { return row < MC ? row : MC + ((row - MC) >> 10) * (PAST + DSEQ) + PAST + ((row - MC) & 1023); }
__device__ __forceinline__ u32x4 pack8(const f32x4& a, const f32x4& b) { u32x4 w; w.x = cvt_pk_bf16(a[0], a[1]); w.y = cvt_pk_bf16(a[2], a[3]); w.z = cvt_pk_bf16(b[0], b[1]); w.w = cvt_pk_bf16(b[2], b[3]); return w; }

struct EpiIn {
    static constexpr bool PERM = true;
    const float* sumsq; const float* bias; const float* qn; const float* kn; const f32x2* rope;
    bf16_t* Q; bf16_t* KB; bf16_t* VB; bf16_t* AS3; float* new_k; float* new_v; int l;
    __device__ __forceinline__ void operator()(const f32x4 (&acc)[2][2][4][2], const Unit& u, int wr, int wc, int fr, int fq) const {
        const int pm = u.pm, pn = u.pn; const bool ctx = pm < 16; const int cond = cond_of_pm(pm);
        const float* bz = bias + cond * 2048 + pn * 256 + wc * 32 + 8 * fq;
        f32x4 bv[2][2];
#pragma unroll
        for (int bj = 0; bj < 2; ++bj)
#pragma unroll
            for (int n = 0; n < 2; ++n) bv[bj][n] = *(const f32x4*)(bz + bj * 128 + 4 * n);
        const int rbase = pm * BM + wr * 64 + fr;
        if (pn < 4) {
            const bool isq = pn < 2; const float* gv = isq ? qn : kn;
            const int G = (pn & 1) * 4 + wc;
            const int cb = 32 * (fq >> 1) + 8 * (fq & 1);
            f32x4 gg[2][2];
#pragma unroll
            for (int bj = 0; bj < 2; ++bj)
#pragma unroll
                for (int n = 0; n < 2; ++n) gg[bj][n] = *(const f32x4*)(gv + cb + 16 * bj + 4 * n);
            const float qs = isq ? C2 : 1.f;
#pragma unroll
            for (int ai = 0; ai < 2; ++ai)
#pragma unroll
                for (int m = 0; m < 4; ++m) {
                    const int row = rbase + ai * HALF + m * 16;
                    const float rstd = rsqrtf(sumsq[row] * (1.f / DM) + EPS);
                    f32x4 v[2][2]; float ss = 0.f;
#pragma unroll
                    for (int bj = 0; bj < 2; ++bj)
#pragma unroll
                        for (int n = 0; n < 2; ++n) { v[bj][n] = acc[ai][bj][m][n] * rstd + bv[bj][n]; const f32x4 t = v[bj][n] * v[bj][n]; ss += (t[0] + t[1]) + (t[2] + t[3]); }
                    ss += __shfl_xor(ss, 16); ss += __shfl_xor(ss, 32);
                    const float rn = rsqrtf(ss * (1.f / 64.f) + EPS);
#pragma unroll
                    for (int bj = 0; bj < 2; ++bj)
#pragma unroll
                        for (int n = 0; n < 2; ++n) v[bj][n] = v[bj][n] * rn * gg[bj][n];
                    if (ctx) {
                        if (!isq) { float* nk = new_k + ((size_t)((row >> 8) * DEPTH + l) * SEQ + (row & 255)) * 512 + G * 64 + cb;
#pragma unroll
                            for (int bj = 0; bj < 2; ++bj) { *(f32x4*)(nk + 16 * bj) = v[bj][0]; *(f32x4*)(nk + 16 * bj + 4) = v[bj][1]; } }
                    } else {
                        const int t = (row - MC) & 1023; const int pos = (fq >> 1) ? (t & 63) : (t >> 6);
                        const f32x2* rp = rope + pos * 16 + 8 * (fq & 1);
#pragma unroll
                        for (int n = 0; n < 2; ++n)
#pragma unroll
                            for (int j = 0; j < 4; ++j) { const f32x2 cs = rp[4 * n + j]; const float x1 = v[0][n][j], x2 = v[1][n][j]; v[0][n][j] = x1 * cs.x - x2 * cs.y; v[1][n][j] = x1 * cs.y + x2 * cs.x; }
                    }
                    bf16_t* dst = isq ? (Q + (size_t)row * 512) : (KB + (size_t)kvrow_of(row) * 512);
                    dst += G * 64 + cb;
#pragma unroll
                    for (int bj = 0; bj < 2; ++bj) *(u32x4*)(dst + 16 * bj) = pack8(v[bj][0] * qs, v[bj][1] * qs);
                }
        } else if (pn < 6) {
            const int col0 = (pn - 4) * 256 + wc * 32 + 8 * fq;
#pragma unroll
            for (int ai = 0; ai < 2; ++ai)
#pragma unroll
                for (int m = 0; m < 4; ++m) {
                    const int row = rbase + ai * HALF + m * 16;
                    const float rstd = rsqrtf(sumsq[row] * (1.f / DM) + EPS);
                    bf16_t* dst = VB + (size_t)kvrow_of(row) * 512 + col0;
#pragma unroll
                    for (int bj = 0; bj < 2; ++bj) { const f32x4 a = acc[ai][bj][m][0] * rstd + bv[bj][0], b = acc[ai][bj][m][1] * rstd + bv[bj][1];
                        *(u32x4*)(dst + 128 * bj) = pack8(a, b);
                        if (ctx) { float* nv = new_v + ((size_t)((row >> 8) * DEPTH + l) * SEQ + (row & 255)) * 512 + col0 + 128 * bj; *(f32x4*)nv = a; *(f32x4*)(nv + 4) = b; } }
                }
        } else {
            const int cu0 = (pn - 6) * 256 + wc * 32 + 8 * fq;
#pragma unroll
            for (int ai = 0; ai < 2; ++ai)
#pragma unroll
                for (int m = 0; m < 4; ++m) {
                    const int row = rbase + ai * HALF + m * 16;
                    const float rstd = rsqrtf(sumsq[row] * (1.f / DM) + EPS);
#pragma unroll
                    for (int bj = 0; bj < 2; ++bj) { const int cu = cu0 + 128 * bj; const f32x4 a = acc[ai][bj][m][0] * rstd + bv[bj][0], b = acc[ai][bj][m][1] * rstd + bv[bj][1];
                        *(u32x4*)(AS3 + ((size_t)(cu >> 4) * NCHUNK + (row >> 4)) * 512 + (row & 15) * 16 + (cu & 15)) = pack8(a, b); }
                }
        }
    }
};
struct EpiS1 {
    static constexpr bool PERM = false;
    float* E;
    __device__ __forceinline__ void operator()(const f32x4 (&acc)[2][2][4][2], const Unit& u, int wr, int wc, int fr, int fq) const {
        const int rbase = u.pm * BM + wr * 64 + fr, col0 = wc * 32 + 4 * fq;
#pragma unroll
        for (int ai = 0; ai < 2; ++ai)
#pragma unroll
            for (int m = 0; m < 4; ++m) { float* dst = E + ((size_t)u.g * NCHUNK + rbase + ai * HALF + m * 16) * 256 + col0;
#pragma unroll
                for (int bj = 0; bj < 2; ++bj)
#pragma unroll
                    for (int n = 0; n < 2; ++n) *(f32x4*)(dst + bj * HALF + n * 16) = acc[ai][bj][m][n]; }
    }
};
struct EpiS3 {
    static constexpr bool PERM = true;
    bf16_t* Z;
    __device__ __forceinline__ void operator()(const f32x4 (&acc)[2][2][4][2], const Unit& u, int wr, int wc, int fr, int fq) const {
        const int rbase = u.pm * BM + wr * 64 + fr;
#pragma unroll
        for (int ai = 0; ai < 2; ++ai)
#pragma unroll
            for (int m = 0; m < 4; ++m) { const int chunk = rbase + ai * HALF + m * 16;
#pragma unroll
                for (int bj = 0; bj < 2; ++bj) { const int tt = 8 * bj + 2 * wc + (fq >> 1), c0 = 8 * (fq & 1);
                    f32x4 a = acc[ai][bj][m][0], b = acc[ai][bj][m][1];
#pragma unroll
                    for (int j = 0; j < 4; ++j) { a[j] = gelu_tanh_f(a[j]); b[j] = gelu_tanh_f(b[j]); }
                    *(u32x4*)(Z + ((size_t)chunk * 16 + tt) * 512 + u.g * 16 + c0) = pack8(a, b); } }
    }
};
struct EpiGlu {
    static constexpr bool PERM = true;
    const bf16_t* Z; const float* bg; bf16_t* CAT;
    __device__ __forceinline__ void operator()(const f32x4 (&acc)[2][2][4][2], const Unit& u, int wr, int wc, int fr, int fq) const {
        const int rbase = u.pm * BM + wr * 64 + fr, col0 = u.pn * BM + wc * 32 + 8 * fq;
        f32x4 bv[2][2];
#pragma unroll
        for (int bj = 0; bj < 2; ++bj)
#pragma unroll
            for (int n = 0; n < 2; ++n) bv[bj][n] = *(const f32x4*)(bg + col0 + bj * HALF + 4 * n);
#pragma unroll
        for (int ai = 0; ai < 2; ++ai)
#pragma unroll
            for (int m = 0; m < 4; ++m) { const int row = rbase + ai * HALF + m * 16;
#pragma unroll
                for (int bj = 0; bj < 2; ++bj) { const u32x4 zw = *(const u32x4*)(Z + (size_t)row * 512 + col0 + bj * HALF);
                    f32x4 a = acc[ai][bj][m][0] + bv[bj][0], b = acc[ai][bj][m][1] + bv[bj][1];
                    a[0] = bflo(zw.x) * sigmoid_f(a[0]); a[1] = bfhi(zw.x) * sigmoid_f(a[1]); a[2] = bflo(zw.y) * sigmoid_f(a[2]); a[3] = bfhi(zw.y) * sigmoid_f(a[3]);
                    b[0] = bflo(zw.z) * sigmoid_f(b[0]); b[1] = bfhi(zw.z) * sigmoid_f(b[1]); b[2] = bflo(zw.w) * sigmoid_f(b[2]); b[3] = bfhi(zw.w) * sigmoid_f(b[3]);
                    *(u32x4*)(CAT + (size_t)row * 1024 + 512 + col0 + bj * HALF) = pack8(a, b); } }
    }
};
struct EpiRes {
    static constexpr bool PERM = false;
    const float* xin0; const float* xin1;
    float* xout;
    const float* gate;
    const float* gn; const float* sc;
    bf16_t* XS; float* ssq;
    __device__ __forceinline__ void operator()(const f32x4 (&acc)[2][2][4][2], const Unit& u, int wr, int wc, int fr, int fq) const {
        const int pm = u.pm, cond = cond_of_pm(pm); const int col0 = u.pn * BM + wc * 32 + 4 * fq; const int rbase = pm * BM + wr * 64 + fr;
        const bool donorm = (gn != nullptr);
        f32x4 gt[2][2], gs[2][2];
#pragma unroll
        for (int bj = 0; bj < 2; ++bj)
#pragma unroll
            for (int n = 0; n < 2; ++n) { const int c = col0 + bj * HALF + n * 16; gt[bj][n] = *(const f32x4*)(gate + cond * 6144 + c);
                if (donorm) { const f32x4 g4 = *(const f32x4*)(gn + c), s4 = *(const f32x4*)(sc + cond * 6144 + c); gs[bj][n] = g4 * (s4 + 1.f); } else gs[bj][n] = (f32x4){0.f, 0.f, 0.f, 0.f}; }
#pragma unroll
        for (int ai = 0; ai < 2; ++ai)
#pragma unroll
            for (int m = 0; m < 4; ++m) { const int row = rbase + ai * HALF + m * 16;
                const float* xi = (row < MC) ? (xin0 + (size_t)row * DM) : (xin1 + (size_t)(row - MC) * DM);
                float ss = 0.f;
#pragma unroll
                for (int bj = 0; bj < 2; ++bj)
#pragma unroll
                    for (int n = 0; n < 2; ++n) { const int c = col0 + bj * HALF + n * 16;
                        const f32x4 x = *(const f32x4*)(xi + c) + gt[bj][n] * acc[ai][bj][m][n];
                        *(f32x4*)(xout + (size_t)row * DM + c) = x;
                        if (donorm) { const f32x4 t = x * x; ss += (t[0] + t[1]) + (t[2] + t[3]); const f32x4 y = x * gs[bj][n];
                            u32x2 w; w.x = cvt_pk_bf16(y[0], y[1]); w.y = cvt_pk_bf16(y[2], y[3]); *(u32x2*)(XS + (size_t)row * DM + c) = w; } }
                if (donorm) { ss += __shfl_xor(ss, 16); ss += __shfl_xor(ss, 32); if (fq == 0) atomicAdd(ssq + row, ss); }
            }
    }
};
struct EpiUp {
    static constexpr bool PERM = true;
    const float* sumsq; const float* bias; bf16_t* UP;
    __device__ __forceinline__ void operator()(const f32x4 (&acc)[2][2][4][2], const Unit& u, int wr, int wc, int fr, int fq) const {
        const int pm = u.pm, cond = cond_of_pm(pm); const int col0 = u.pn * BM + wc * 32 + 8 * fq; const int rbase = pm * BM + wr * 64 + fr;
        f32x4 bv[2][2];
#pragma unroll
        for (int bj = 0; bj < 2; ++bj)
#pragma unroll
            for (int n = 0; n < 2; ++n) bv[bj][n] = *(const f32x4*)(bias + cond * 4096 + col0 + bj * HALF + 4 * n);
#pragma unroll
        for (int ai = 0; ai < 2; ++ai)
#pragma unroll
            for (int m = 0; m < 4; ++m) { const int row = rbase + ai * HALF + m * 16; const float rstd = rsqrtf(sumsq[row] * (1.f / DM) + EPS);
#pragma unroll
                for (int bj = 0; bj < 2; ++bj) *(u32x4*)(UP + (size_t)row * 4096 + col0 + bj * HALF) = pack8(acc[ai][bj][m][0] * rstd + bv[bj][0], acc[ai][bj][m][1] * rstd + bv[bj][1]); }
    }
};
constexpr int AT_KSLOT = 16384, AT_K = 0, AT_V = 3 * AT_KSLOT, AT_X = 0, AT_ST = 65536;
__device__ __forceinline__ void glds16(const void* gsrc, unsigned lds_dst) { unsigned keep;
    asm volatile("s_mov_b32 %0, m0\n\ts_mov_b32 m0, %2\n\ts_nop 0\n\tglobal_load_lds_dwordx4 %1, off\n\ts_mov_b32 m0, %0" : "=&s"(keep) : "v"(gsrc), "s"(lds_dst) : "memory"); }
#define AT_WAIT_BAR(N) asm volatile("s_waitcnt vmcnt(" #N ") lgkmcnt(0)\n\ts_barrier" ::: "memory")
__device__ __forceinline__ s16x4 vtr(const LAS char* p) { typedef short v4i16_t __attribute__((ext_vector_type(4))); return __builtin_bit_cast(s16x4, __builtin_amdgcn_ds_read_tr16_b64_v4i16((LAS v4i16_t*)p)); }
__device__ __forceinline__ int crow(int r, int hi) { return (r & 3) + 8 * (r >> 2) + 4 * hi; }

struct AttnArgs { const bf16_t* Q; const bf16_t* KB; const bf16_t* VB; bf16_t* CAT; const float* subln; float lam; float oml; };

__device__ __forceinline__ void attn_unit(LAS unsigned char* lds, const int tid, const AttnArgs& A, int seq, int h, int qblk) {
    const int lane = tid & 63, r32 = lane & 31, hi = lane >> 5; const int wid = __builtin_amdgcn_readfirstlane(tid >> 6);
    const int rg = wid & 3, s = wid >> 2;
    const bool ctx = seq < NB;
    const int qrow0 = ctx ? seq * SEQ + qblk * 128 : MC + (seq - NB) * DSEQ + qblk * 128;
    const int krow0 = ctx ? seq * SEQ : MC + (seq - NB) * (PAST + DSEQ);
    const int NT = ctx ? SEQ / 64 : (PAST + DSEQ) / 64;
    const unsigned lds0 = (unsigned)(uintptr_t)lds;
    const bf16_t* ksrc0 = A.KB + (size_t)(krow0 + lane) * 512 + h * 128 + wid * 8;
    const bf16_t* vsrc0 = A.VB + (size_t)(krow0 + 16 * (wid & 3) + (lane >> 2)) * 512 + h * 128 + (wid >> 2) * 32 + (lane & 3) * 8;
    const unsigned kdst = lds0 + AT_K + wid * 1024, vdst = lds0 + AT_V + ((wid >> 2) * 4 + (wid & 3)) * 1024;
#define AT_DMA(t, slot) do { const size_t _o = (size_t)(t) * 64 * 512; const unsigned _s = (unsigned)(slot) * AT_KSLOT; \
        glds16(ksrc0 + _o, (unsigned)__builtin_amdgcn_readfirstlane(kdst + _s)); glds16(ksrc0 + _o + 64, (unsigned)__builtin_amdgcn_readfirstlane(kdst + _s + 8 * 1024)); \
        glds16(vsrc0 + _o, (unsigned)__builtin_amdgcn_readfirstlane(vdst + _s)); glds16(vsrc0 + _o + 64, (unsigned)__builtin_amdgcn_readfirstlane(vdst + _s + 8 * 1024)); } while (0)
    AT_DMA(0, 0); AT_DMA(1, 1);
    bf16x8 qr[4];
    { const bf16_t* qp = A.Q + (size_t)(qrow0 + rg * 32 + r32) * 512 + h * 128 + s * 64 + hi * 8;
#pragma unroll
      for (int d0 = 0; d0 < 4; ++d0) qr[d0] = *(const bf16x8*)(qp + d0 * 16); }
    f32x16 o[4];
#pragma unroll
    for (int d0 = 0; d0 < 4; ++d0)
#pragma unroll
        for (int r = 0; r < 16; ++r) o[d0][r] = 0.f;
    float lsum = 0.f;
    const LAS char* kfrag0 = (const LAS char*)lds + AT_K + (s * 8 + hi) * 1024 + r32 * 16;
    const LAS char* vfrag0 = (const LAS char*)lds + AT_V + ((lane >> 4) & 1) * 32 + (lane & 3) * 8 + (4 * hi + ((lane & 15) >> 2)) * 64;
    int slot = 0;
    for (int t = 0; t < NT; ++t) {
        if (t + 1 < NT) AT_WAIT_BAR(4); else AT_WAIT_BAR(0);
        if (t + 2 < NT) { const int s2 = slot == 0 ? 2 : slot - 1; AT_DMA(t + 2, s2); }
        const LAS char* kf = kfrag0 + slot * AT_KSLOT; const LAS char* vf = vfrag0 + slot * AT_KSLOT;
        f32x16 p0, p1;
#pragma unroll
        for (int r = 0; r < 16; ++r) { p0[r] = 0.f; p1[r] = 0.f; }
#pragma unroll
        for (int d0 = 0; d0 < 4; ++d0) {
            const bf16x8 k0 = *(const LAS bf16x8*)(kf + d0 * 2048), k1 = *(const LAS bf16x8*)(kf + d0 * 2048 + 512);
            p0 = __builtin_amdgcn_mfma_f32_32x32x16_bf16(k0, qr[d0], p0, 0, 0, 0);
            p1 = __builtin_amdgcn_mfma_f32_32x32x16_bf16(k1, qr[d0], p1, 0, 0, 0);
        }
        float sacc = 0.f;
#pragma unroll
        for (int r = 0; r < 16; ++r) { p0[r] = fast_exp2(p0[r]); p1[r] = fast_exp2(p1[r]); sacc += p0[r] + p1[r]; }
        lsum += sacc;
        u32x4 pw[4];
        pw[0] = (u32x4){cvt_pk_bf16(p0[0], p0[1]), cvt_pk_bf16(p0[2], p0[3]), cvt_pk_bf16(p0[4], p0[5]), cvt_pk_bf16(p0[6], p0[7])};
        pw[1] = (u32x4){cvt_pk_bf16(p0[8], p0[9]), cvt_pk_bf16(p0[10], p0[11]), cvt_pk_bf16(p0[12], p0[13]), cvt_pk_bf16(p0[14], p0[15])};
        pw[2] = (u32x4){cvt_pk_bf16(p1[0], p1[1]), cvt_pk_bf16(p1[2], p1[3]), cvt_pk_bf16(p1[4], p1[5]), cvt_pk_bf16(p1[6], p1[7])};
        pw[3] = (u32x4){cvt_pk_bf16(p1[8], p1[9]), cvt_pk_bf16(p1[10], p1[11]), cvt_pk_bf16(p1[12], p1[13]), cvt_pk_bf16(p1[14], p1[15])};
#pragma unroll
        for (int d0 = 0; d0 < 4; ++d0)
#pragma unroll
            for (int ks = 0; ks < 4; ++ks) {
                const s16x4 lo = vtr(vf + (d0 * 4 + ks) * 1024), hh = vtr(vf + (d0 * 4 + ks) * 1024 + 512);
                const bf16x8 vfr = (bf16x8){lo[0], lo[1], lo[2], lo[3], hh[0], hh[1], hh[2], hh[3]};
                o[d0] = __builtin_amdgcn_mfma_f32_32x32x16_bf16(vfr, __builtin_bit_cast(bf16x8, pw[ks]), o[d0], 0, 0, 0);
            }
        slot = slot == 2 ? 0 : slot + 1;
    }
    lsum += __shfl_xor(lsum, 32);
    const float inv = (s == 0 ? 1.f : A.lam) / lsum;
    AT_WAIT_BAR(0);
    LAS float* X = (LAS float*)(lds + AT_X) + rg * 4096;
    if (s == 1) {
#pragma unroll
        for (int d0 = 0; d0 < 4; ++d0)
#pragma unroll
            for (int r = 0; r < 16; ++r) X[(d0 * 16 + r) * 64 + lane] = o[d0][r] * inv;
    }
    AT_WAIT_BAR(0);
    if (s == 0) {
        float ss = 0.f;
#pragma unroll
        for (int d0 = 0; d0 < 4; ++d0)
#pragma unroll
            for (int r = 0; r < 16; ++r) { const float v = o[d0][r] * inv - X[(d0 * 16 + r) * 64 + lane]; o[d0][r] = v; ss += v * v; }
        ss += __shfl_xor(ss, 32);
        const float rn = rsqrtf(ss * (1.f / 128.f) + EPS) * A.oml;
        LAS bf16_t* stg = (LAS bf16_t*)(lds + AT_ST) + rg * (32 * 136);
#pragma unroll
        for (int d0 = 0; d0 < 4; ++d0)
#pragma unroll
            for (int rq = 0; rq < 4; ++rq) { const int dv = 32 * d0 + 8 * rq + 4 * hi; const f32x4 g4 = *(const f32x4*)(A.subln + dv);
                u32x2 w; w.x = cvt_pk_bf16(o[d0][4 * rq] * rn * g4[0], o[d0][4 * rq + 1] * rn * g4[1]); w.y = cvt_pk_bf16(o[d0][4 * rq + 2] * rn * g4[2], o[d0][4 * rq + 3] * rn * g4[3]);
                *(LAS u32x2*)(stg + r32 * 136 + dv) = w; }
        asm volatile("s_waitcnt lgkmcnt(0)" ::: "memory");
        bf16_t* dst = A.CAT + (size_t)(qrow0 + rg * 32) * 1024 + h * 128;
#pragma unroll
        for (int i = 0; i < 8; ++i) { const int row = i * 4 + (lane >> 4), ch = lane & 15; const u32x4 v = *(const LAS u32x4*)(stg + row * 136 + ch * 8); *(u32x4*)(dst + (size_t)row * 1024 + ch * 8) = v; }
    }
    AT_WAIT_BAR(0);
#undef AT_DMA
}
struct Args { const float* in[34]; float* out; unsigned char* ws; int stop_after; int pad; };
typedef const __attribute__((address_space(4))) Args* kargs_t;
struct Frame {
    LAS unsigned char* lds; int tid, lane, wave, vcu, bid, G;
    kargs_t ka; float* out; unsigned char* ws;
    float* misc; unsigned* ctl;
};
#define LDS_WAIT() asm volatile("s_waitcnt lgkmcnt(0)" ::: "memory")
#define VM_WAIT() asm volatile("s_waitcnt vmcnt(0)" ::: "memory")

template <int MAP> __device__ __forceinline__ int src_col(int p);
template <int MODE, int MAP, int NC> __device__ __forceinline__ void gemv9_task(Frame& F, const float* W, int ldw, int l, int voff, int strip, float* out, int ldo, const float* add) {
    LAS float* sc = (LAS float*)F.lds; LAS float* red = sc + 9 * 1024;
    for (int i = F.tid; i < 9 * 1024; i += NTHREADS) { const int cond = i >> 10, k = i & 1023; float v;
        if (MODE == 0) { v = cond == 0 ? F.ka->in[6][k] : F.ka->in[5][(cond - 1) * 1024 + k]; v = v / (1.f + expf(-v)); } else v = F.misc[MI_MOD + (l * 9 + cond) * 6144 + voff + k];
        sc[i] = v; }
    __syncthreads();
    const int j = strip * NC + (F.lane < NC ? F.lane : NC - 1); const float* w = W + (size_t)(F.wave * 128) * ldw + src_col<MAP>(j);
    float acc[9];
#pragma unroll
    for (int b = 0; b < 9; ++b) acc[b] = 0.f;
#pragma unroll 16
    for (int k = 0; k < 128; ++k) { const float wv = w[(size_t)k * ldw];
#pragma unroll
        for (int b = 0; b < 9; ++b) acc[b] += sc[b * 1024 + F.wave * 128 + k] * wv; }
#pragma unroll
    for (int b = 0; b < 9; ++b) red[(F.wave * 9 + b) * 64 + F.lane] = acc[b];
    __syncthreads();
    for (int i = F.tid; i < 9 * 64; i += NTHREADS) { const int b = i >> 6, ln = i & 63; if (ln >= NC) continue; float s_ = 0.f;
#pragma unroll
        for (int w8 = 0; w8 < 8; ++w8) s_ += red[(w8 * 9 + b) * 64 + ln];
        const int jj = strip * NC + ln; out[(size_t)b * ldo + jj] = s_ + (add ? add[jj] : 0.f); }
    __syncthreads();
}
template <int MAP> __device__ __forceinline__ int src_col(int p) {
    if (MAP == 1) { if (p >= 1024) return p; const int pn = p >> 8, r = p & 255, bj = r >> 7, wc = (r >> 5) & 3, fq = (r >> 3) & 3, low = r & 7; return 256 * pn + 64 * wc + 32 * (fq >> 1) + 16 * bj + 8 * (fq & 1) + low; }
    if (MAP == 2) { const int pn = p >> 8, bj = (p >> 7) & 1, r = p & 127; return bj * 2048 + 128 * pn + r; }
    return p;
}
template <int MAP, bool BIAS> __device__ __forceinline__ void transpose_item(Frame& F, const float* W, int K, int N, bf16_t* WT, LAS float* scr, int item, const float* shv, float* bias) {
    const int lane = F.lane; const int nblk = N / 64, kb = item / nblk, nb = item % nblk, k0 = 64 * kb, n0 = 64 * nb;
    const int sc_ = src_col<MAP>(n0 + lane);
    float tv[64];
#pragma unroll
    for (int i = 0; i < 64; ++i) tv[i] = W[(size_t)(k0 + i) * N + sc_];
#pragma unroll
    for (int i = 0; i < 64; ++i) scr[i * 65 + lane] = tv[i];
    LDS_WAIT(); asm volatile("" ::: "memory");
    const int c = lane & 7;
#pragma unroll
    for (int j = 0; j < 8; ++j) { const int n = (lane >> 3) + 8 * j; const LAS float* s_ = scr + (8 * c) * 65 + n;
        u32x4 o; o.x = cvt_pk_bf16(s_[0 * 65], s_[1 * 65]); o.y = cvt_pk_bf16(s_[2 * 65], s_[3 * 65]); o.z = cvt_pk_bf16(s_[4 * 65], s_[5 * 65]); o.w = cvt_pk_bf16(s_[6 * 65], s_[7 * 65]);
        *(u32x4*)(WT + (size_t)(n0 + n) * K + k0 + 8 * c) = o; }
    if (BIAS) {
        float sh[9], acc[9];
#pragma unroll
        for (int b = 0; b < 9; ++b) { sh[b] = shv[b * 6144 + k0 + lane]; acc[b] = 0.f; }
#pragma unroll
        for (int kk = 0; kk < 64; ++kk) { const float w = tv[kk];
#pragma unroll
            for (int b = 0; b < 9; ++b) acc[b] += __uint_as_float(__builtin_amdgcn_readlane(__float_as_uint(sh[b]), kk)) * w; }
#pragma unroll
        for (int b = 0; b < 9; ++b) atomicAdd(bias + (size_t)b * N + n0 + lane, acc[b]);
    }
    LDS_WAIT(); asm volatile("" ::: "memory");
}
__device__ __forceinline__ void cache_row(Frame& F, int l, int item) {
    const int which = item >> 12, r = item & 4095, b = r >> 9, j = r & 511;
    const float* src = (which ? F.ka->in[3] : F.ka->in[2]) + ((size_t)(b * DEPTH + l) * PAST + j) * 512 + F.lane * 8;
    bf16_t* dst = (bf16_t*)(F.ws + (which ? WS_VB : WS_KB)) + (size_t)(MC + b * (PAST + DSEQ) + j) * 512 + F.lane * 8;
    const f32x4 a = *(const f32x4*)src, c = *(const f32x4*)(src + 4);
    *(u32x4*)dst = pack8(a, c);
}
__device__ __forceinline__ void cache_item(Frame& F, int l, int item4) {
#pragma unroll
    for (int i = 0; i < 4; ++i) cache_row(F, l, item4 * 4 + i);
}
__device__ __forceinline__ f32x2 cmul(f32x2 a, f32x2 b) { return (f32x2){a.x * b.x - a.y * b.y, a.x * b.y + a.y * b.x}; }
__device__ __forceinline__ void ssm_prep(Frame& F, int l, int g) {
    LAS f32x2* POW = (LAS f32x2*)F.lds;
    LAS f32x2* BB = POW + 2 * 17 * 64;
    LAS f32x2* CC = BB + 2 * 64 * 16;
    LAS float* KT = (LAS float*)(CC + 2 * 16 * 64);
    bf16_t* WE = (bf16_t*)(F.ws + WS_SSM + SSM_WE) + (size_t)g * 256 * 256;
    bf16_t* WY = (bf16_t*)(F.ws + WS_SSM + SSM_WY) + (size_t)g * 256 * 512;
    f32x2* LAM16 = (f32x2*)(F.ws + WS_SSM + SSM_LAM16); f32x2* BBAR = (f32x2*)(F.ws + WS_SSM + SSM_BBAR);
    const int tid = F.tid;
    if (tid < 128) { const int dir = tid >> 6, p = tid & 63; const size_t pi = ((size_t)(l * 2 + dir) * NG + g) * 64 + p;
        const float lr = F.ka->in[18][pi], li = F.ka->in[19][pi], delta = expf(F.ka->in[20][(l * 2 + dir) * NG + g]);
        const float er = expf(lr * delta), lbr = er * cosf(li * delta), lbi = er * sinf(li * delta);
        { float one_ = 1.f, zero_ = 0.f; asm volatile("" : "+v"(one_), "+v"(zero_));
          f32x2 pw = (f32x2){one_, zero_}; const f32x2 lb = (f32x2){lbr, lbi};
          for (int tau = 0; tau <= 16; ++tau) { POW[(dir * 17 + tau) * 64 + p] = pw; if (tau == 16) LAM16[(dir * NG + g) * 64 + p] = pw; pw = cmul(pw, lb); } }
        const float nr = lbr - 1.f, ni = lbi, den = lr * lr + li * li; const f32x2 fac = (f32x2){(nr * lr + ni * li) / den, (ni * lr - nr * li) / den};
        for (int ch = 0; ch < 16; ++ch) { const size_t bi = pi * 16 + ch; const f32x2 bb = cmul(fac, (f32x2){F.ka->in[21][bi], F.ka->in[22][bi]}); BB[(dir * 64 + p) * 16 + ch] = bb; BBAR[((size_t)(dir * NG + g) * 64 + p) * 16 + ch] = bb; }
    }
    for (int i = tid; i < 2048; i += NTHREADS) { const int dir = i >> 10, c = (i >> 6) & 15, p = i & 63; const size_t ci = (((size_t)(l * 2 + dir) * NG + g) * 16 + c) * 64 + p; CC[i] = (f32x2){F.ka->in[23][ci], F.ka->in[24][ci]}; }
    __syncthreads();
    { const int c = F.lane >> 2, chq = F.lane & 3;
      for (int i = 0; i < 4; ++i) { const int q = F.wave * 4 + i, dir = q >> 4, tau = q & 15; float acc[4] = {0.f, 0.f, 0.f, 0.f};
#pragma unroll 4
          for (int p = 0; p < 64; ++p) { const f32x2 a = cmul(CC[(dir * 16 + c) * 64 + p], POW[(dir * 17 + tau) * 64 + p]);
#pragma unroll
              for (int e = 0; e < 4; ++e) { const f32x2 bb = BB[(dir * 64 + p) * 16 + chq * 4 + e]; acc[e] += a.x * bb.x - a.y * bb.y; } }
#pragma unroll
          for (int e = 0; e < 4; ++e) KT[(dir * 16 + tau) * 256 + c * 16 + chq * 4 + e] = acc[e]; } }
    __syncthreads();
    const float* Dv = F.ka->in[25] + l * 512 + g * 16;
    for (int idx = tid; idx < 256 * 64; idx += NTHREADS) { const int n = idx >> 6, k0 = (idx & 63) * 8, i = n >> 4, c = n & 15; float v[8];
        if (k0 < 256) { const int s = k0 >> 4, ch0 = k0 & 15;
#pragma unroll
            for (int e = 0; e < 8; ++e) { const int ch = ch0 + e; float x = 0.f; if (s <= i) x += KT[(i - s) * 256 + c * 16 + ch]; if (s >= i) x += KT[(16 + s - i) * 256 + c * 16 + ch]; if (s == i && ch == c) x += Dv[c]; v[e] = x; }
        } else { const int dir = k0 >= 384 ? 1 : 0, p0 = ((k0 - 256) & 127) >> 1, tau = dir ? 16 - i : i + 1;
#pragma unroll
            for (int pp = 0; pp < 4; ++pp) { const f32x2 z = cmul(CC[(dir * 16 + c) * 64 + p0 + pp], POW[(dir * 17 + tau) * 64 + p0 + pp]); v[2 * pp] = z.x; v[2 * pp + 1] = -z.y; } }
        u32x4 w; w.x = cvt_pk_bf16(v[0], v[1]); w.y = cvt_pk_bf16(v[2], v[3]); w.z = cvt_pk_bf16(v[4], v[5]); w.w = cvt_pk_bf16(v[6], v[7]);
        *(u32x4*)(WY + (size_t)n * 512 + k0) = w; }
    for (int idx = tid; idx < 256 * 32; idx += NTHREADS) { const int n = idx >> 5, k0 = (idx & 31) * 8, dir = n >> 7, p = (n & 127) >> 1, ri = n & 1, s = k0 >> 4, ch0 = k0 & 15; float v[8];
        const f32x2 pw = POW[(dir * 17 + (dir ? s : 15 - s)) * 64 + p];
#pragma unroll
        for (int e = 0; e < 8; ++e) { const f32x2 z = cmul(pw, BB[(dir * 64 + p) * 16 + ch0 + e]); v[e] = ri ? z.y : z.x; }
        u32x4 w; w.x = cvt_pk_bf16(v[0], v[1]); w.y = cvt_pk_bf16(v[2], v[3]); w.z = cvt_pk_bf16(v[4], v[5]); w.w = cvt_pk_bf16(v[6], v[7]);
        *(u32x4*)(WE + (size_t)n * 256 + k0) = w; }
    __syncthreads();
}
__device__ __forceinline__ void xprep_row(Frame& F, int row) {
    const float* xr = (row < MC) ? F.ka->in[0] + (size_t)row * DM : F.ka->in[1] + (size_t)(row - MC) * DM;
    const int cond = row < MC ? 0 : 1 + ((row - MC) >> 10);
    const float* sc = F.misc + MI_MOD + (0 * 9 + cond) * 6144 + 1024; const float* g1 = F.ka->in[9];
    bf16_t* dst = (bf16_t*)(F.ws + WS_XS) + (size_t)row * DM; float s = 0.f;
#pragma unroll
    for (int j = 0; j < 4; ++j) { const int c = 4 * F.lane + 256 * j; const f32x4 x = *(const f32x4*)(xr + c); const f32x4 t = x * x; s += (t[0] + t[1]) + (t[2] + t[3]);
        const f32x4 y = x * (*(const f32x4*)(g1 + c)) * (*(const f32x4*)(sc + c) + 1.f); u32x2 w; w.x = cvt_pk_bf16(y[0], y[1]); w.y = cvt_pk_bf16(y[2], y[3]); *(u32x2*)(dst + c) = w; }
    s = wave_sum(s);
    if (F.lane == 0) ((float*)(F.ctl + CW_SS))[row] = s;
}
__device__ __forceinline__ void xprep_item(Frame& F, int item4) {
#pragma unroll
    for (int i = 0; i < 4; ++i) xprep_row(F, item4 * 4 + i);
}
__device__ __forceinline__ void ssm_scan(Frame& F, int l, int g, int pm) {
    const int tid = F.tid, sl = tid >> 7, dp = tid & 127, dir = dp >> 6, p = dp & 63;
    const f32x2* LAM16 = (const f32x2*)(F.ws + WS_SSM + SSM_LAM16); const f32x2* BBAR = (const f32x2*)(F.ws + WS_SSM + SSM_BBAR);
    const float* E = (const float*)(F.ws + WS_R + R_E); bf16_t* AS3 = (bf16_t*)(F.ws + WS_R + R_AS3);
    const f32x2 lam = LAM16[(dir * NG + g) * 64 + p];
    const int nq = pm == 0 ? 4 : 1, n = pm == 0 ? 16 : 64;
    for (int q = 0; q < nq; ++q) {
        int base; f32x2 h;
        if (pm == 0) { const int seq = q * 4 + sl; base = seq * 16; h = (f32x2){0.f, 0.f}; }
        else { const int sq = (pm - 1) * 4 + sl; base = 256 + sq * 64; h = *(const f32x2*)(F.ka->in[4] + ((((size_t)sq * DEPTH + l) * 2 + dir) * NG + g) * 128 + 2 * p); }
        const float* ep = E + ((size_t)g * NCHUNK + base) * 256 + dir * 128 + 2 * p;
        unsigned* hp = (unsigned*)(AS3 + ((size_t)g * NCHUNK + base) * 512 + 256 + dir * 128 + 2 * p);
        for (int j0 = 0; j0 < n; j0 += 16) { f32x2 e[16];
#pragma unroll
            for (int jj = 0; jj < 16; ++jj) { const int j = dir ? (n - 1 - j0 - jj) : (j0 + jj); e[jj] = *(const f32x2*)(ep + (size_t)j * 256); }
#pragma unroll
            for (int jj = 0; jj < 16; ++jj) { const int j = dir ? (n - 1 - j0 - jj) : (j0 + jj); hp[(size_t)j * 256] = cvt_pk_bf16(h.x, h.y); h = cmul(lam, h) + e[jj]; } }
        if (pm == 0) { const int seq = q * 4 + sl; const int chunk = seq * 16 + (dir ? 15 : 0), tt = dir ? 15 : 0;
            const u32x4 u0 = *(const u32x4*)(AS3 + ((size_t)g * NCHUNK + chunk) * 512 + tt * 16), u1 = *(const u32x4*)(AS3 + ((size_t)g * NCHUNK + chunk) * 512 + tt * 16 + 8);
            float uu[16] = {bflo(u0.x), bfhi(u0.x), bflo(u0.y), bfhi(u0.y), bflo(u0.z), bfhi(u0.z), bflo(u0.w), bfhi(u0.w), bflo(u1.x), bfhi(u1.x), bflo(u1.y), bfhi(u1.y), bflo(u1.z), bfhi(u1.z), bflo(u1.w), bfhi(u1.w)};
            const f32x2* bb = BBAR + ((size_t)(dir * NG + g) * 64 + p) * 16; f32x2 acc = (f32x2){0.f, 0.f};
#pragma unroll
            for (int ch = 0; ch < 16; ++ch) acc += bb[ch] * uu[ch];
            float* ns = F.out + (size_t)MT * DM + 2 * (size_t)NB * DEPTH * SEQ * 512;
            *(f32x2*)(ns + ((((size_t)seq * DEPTH + l) * 2 + dir) * NG + g) * 128 + 2 * p) = acc; }
    }
}
__device__ __forceinline__ void ld16(const bf16_t* p, float* v) { const u32x4 a = *(const u32x4*)p; v[0] = bflo(a.x); v[1] = bfhi(a.x); v[2] = bflo(a.y); v[3] = bfhi(a.y); v[4] = bflo(a.z); v[5] = bfhi(a.z); v[6] = bflo(a.w); v[7] = bfhi(a.w); }
__device__ __forceinline__ void conv_item(Frame& F, int l, int item) {
    const int rs = item >> 4, pn = item & 15, lr = F.lane >> 4, lc = F.lane & 15;
    const int r0 = rs * 64 + lr * 16; const int av = 128 * pn + 8 * lc;
    const bf16_t* up = (const bf16_t*)(F.ws + WS_R) + (size_t)r0 * 4096 + 256 * pn + 8 * lc; bf16_t* gp = (bf16_t*)(F.ws + WS_G) + (size_t)r0 * 2048 + av;
    const float* cw = F.ka->in[31] + (size_t)l * 3 * 4096; const float* cb = F.ka->in[32] + (size_t)l * 4096;
    float wv[3][8], wg[3][8], bv[8], bg[8];
#pragma unroll
    for (int k = 0; k < 3; ++k)
#pragma unroll
        for (int e = 0; e < 8; ++e) { wv[k][e] = cw[k * 4096 + av + e]; wg[k][e] = cw[k * 4096 + 2048 + av + e]; }
#pragma unroll
    for (int e = 0; e < 8; ++e) { bv[e] = cb[av + e]; bg[e] = cb[2048 + av + e]; }
    const int t0 = r0 < MC ? (r0 & 255) : ((r0 - MC) & 1023), L = r0 < MC ? SEQ : DSEQ;
    float pv[8], pg[8], cv[8], cg[8], nv_[8], ng[8];
    if (t0 > 0) { ld16(up - 4096, pv); ld16(up - 4096 + 128, pg); } else {
#pragma unroll
        for (int e = 0; e < 8; ++e) { pv[e] = 0.f; pg[e] = 0.f; } }
    ld16(up, cv); ld16(up + 128, cg);
#pragma unroll
    for (int i = 0; i < 16; ++i) {
        if (t0 + i + 1 < L) { ld16(up + (size_t)(i + 1) * 4096, nv_); ld16(up + (size_t)(i + 1) * 4096 + 128, ng); } else {
#pragma unroll
            for (int e = 0; e < 8; ++e) { nv_[e] = 0.f; ng[e] = 0.f; } }
        float o[8];
#pragma unroll
        for (int e = 0; e < 8; ++e) { const float zv = bv[e] + wv[0][e] * pv[e] + wv[1][e] * cv[e] + wv[2][e] * nv_[e]; const float zg = bg[e] + wg[0][e] * pg[e] + wg[1][e] * cg[e] + wg[2][e] * ng[e]; o[e] = silu_f(zg) * zv; }
        u32x4 w; w.x = cvt_pk_bf16(o[0], o[1]); w.y = cvt_pk_bf16(o[2], o[3]); w.z = cvt_pk_bf16(o[4], o[5]); w.w = cvt_pk_bf16(o[6], o[7]);
        *(u32x4*)(gp + (size_t)i * 2048) = w;
#pragma unroll
        for (int e = 0; e < 8; ++e) { pv[e] = cv[e]; pg[e] = cg[e]; cv[e] = nv_[e]; cg[e] = ng[e]; }
    }
}
constexpr int N_TR_ITEMS_L = 16 * 32 + 8 * 8 + 16 * 16 + 16 * 64 + 32 * 16;
__device__ __forceinline__ void weight_item(Frame& F, LAS float* scr, int l, int it) {
    int r = it; const float* modl = F.misc + MI_MOD + l * 9 * 6144; float* cf = (float*)F.ctl;
    if (r < 512) { transpose_item<1, true>(F, F.ka->in[10] + (size_t)l * DM * 2048, DM, 2048, (bf16_t*)(F.ws + WS_WIN) + (size_t)l * 2048 * DM, scr, r, modl, cf + CW_BIN + l * 9 * 2048); return; } r -= 512;
    if (r < 64) { transpose_item<0, false>(F, F.ka->in[26] + (size_t)l * 512 * 512, 512, 512, (bf16_t*)(F.ws + WS_WGLU) + (size_t)l * 512 * 512, scr, r, nullptr, nullptr); return; } r -= 64;
    if (r < 256) { transpose_item<0, false>(F, F.ka->in[28] + (size_t)l * DM * DM, DM, DM, (bf16_t*)(F.ws + WS_WOUT) + (size_t)l * DM * DM, scr, r, nullptr, nullptr); return; } r -= 256;
    if (r < 1024) { transpose_item<2, true>(F, F.ka->in[30] + (size_t)l * DM * 4096, DM, 4096, (bf16_t*)(F.ws + WS_WUP) + (size_t)l * 4096 * DM, scr, r, modl + 3072, cf + CW_BUP + l * 9 * 4096); return; } r -= 1024;
    transpose_item<0, false>(F, F.ka->in[33] + (size_t)l * 2048 * DM, 2048, DM, (bf16_t*)(F.ws + WS_WDN) + (size_t)l * DM * 2048, scr, r, nullptr, nullptr);
}

__global__ void __launch_bounds__(NTHREADS, 2) mega(Args args) {
    extern __shared__ __attribute__((aligned(16))) unsigned char lds_raw[];
    Frame F;
    F.lds = (LAS unsigned char*)lds_raw;
    F.tid = threadIdx.x; F.lane = F.tid & 63; F.wave = __builtin_amdgcn_readfirstlane(F.tid >> 6);
    F.G = gridDim.x; F.bid = blockIdx.x; { const int bx = blockIdx.x; F.vcu = (F.G % 8 == 0) ? (bx % 8) * (F.G / 8) + bx / 8 : bx; }
    F.ka = (kargs_t)__builtin_amdgcn_kernarg_segment_ptr();
    F.out = args.out; F.ws = args.ws; F.misc = (float*)(args.ws + WS_MISC); F.ctl = (unsigned*)(args.ws + WS_CTL);
    volatile LAS unsigned* MISC = (volatile LAS unsigned*)(F.lds + MISC_OFF);
    for (int u = F.tid; u < (LDS_BYTES - LDSCTL_OFF) / 4; u += NTHREADS) ((LAS unsigned*)(F.lds + LDSCTL_OFF))[u] = 0u;
    __syncthreads();
    XcdBarrier bar = xcd_barrier_post(F.ctl + CW_BAR, MISC + 8);
    int phase_no = 0;
#define LAUNDER() do { asm volatile("" : "+s"(F.ka), "+s"(F.ws), "+s"(F.out), "+s"(F.bid), "+v"(F.tid)); F.vcu = (F.G % 8 == 0) ? (F.bid % 8) * (F.G / 8) + F.bid / 8 : F.bid; F.lane = F.tid & 63; F.wave = __builtin_amdgcn_readfirstlane(F.tid >> 6); \
    F.misc = (float*)(F.ws + WS_MISC); F.ctl = (unsigned*)(F.ws + WS_CTL); gw = F.vcu * NWAVES + F.wave; } while (0)
#ifdef TPROBE
#define TSTAMP() do { if (F.bid == 0 && F.tid == 0) ((unsigned long long*)(F.ctl + 6000))[phase_no] = __builtin_amdgcn_s_memrealtime(); } while (0)
#else
#define TSTAMP() do {} while (0)
#endif
#define GRID_BAR() do { xcd_barrier(bar); ++phase_no; TSTAMP(); if (F.ka->stop_after == phase_no) return; LAUNDER(); } while (0)
    int gw = F.vcu * NWAVES + F.wave; const int NGW = F.G * NWAVES;
#define ssq ((float*)(F.ctl + CW_SS))
#define XS ((bf16_t*)(F.ws + WS_XS))
#define KB ((bf16_t*)(F.ws + WS_KB))
#define VB ((bf16_t*)(F.ws + WS_VB))
#define Qb ((bf16_t*)(F.ws + WS_R + R_Q))
#define AS3 ((bf16_t*)(F.ws + WS_R + R_AS3))
#define Eb ((float*)(F.ws + WS_R + R_E))
#define Zb ((bf16_t*)(F.ws + WS_R + R_Z))
#define CAT ((bf16_t*)(F.ws + WS_R + R_CAT))
#define UP ((bf16_t*)(F.ws + WS_R))
#define Gb ((bf16_t*)(F.ws + WS_G))

    TSTAMP();
    { const int l = F.vcu >> 7, strip = F.vcu & 127; gemv9_task<0, 0, 48>(F, F.ka->in[7] + (size_t)l * DM * 6144, 6144, l, 0, strip, F.misc + MI_MOD + l * 9 * 6144, 6144, F.ka->in[8] + l * 6144); }
    GRID_BAR();
    if (F.vcu < 32) ssm_prep(F, 0, F.vcu);
    else {
        if (F.vcu == 32) {
            for (int i = F.tid; i < 1024; i += NTHREADS) { const int pos = i >> 4, f = i & 15; const float inv = 1.0f / powf(10000.0f, (float)f / 16.0f); const float ang = (float)pos * inv;
                ((f32x2*)(F.misc + MI_ROPE))[i] = (f32x2){cosf(ang), sinf(ang)}; }
            if (F.tid < 2) { const int l = F.tid; float a1 = 0.f, a2 = 0.f; for (int d = 0; d < 64; ++d) { a1 += F.ka->in[13][l * 64 + d] * F.ka->in[14][l * 64 + d]; a2 += F.ka->in[15][l * 64 + d] * F.ka->in[16][l * 64 + d]; }
                const float li = 0.8f - 0.6f * expf(-0.3f * (float)l); F.misc[MI_LAM + l] = expf(a1) - expf(a2) + li; F.misc[MI_LAM + 2 + l] = 1.f - li; }
        }
        LAS float* scr = (LAS float*)(F.lds + F.wave * 16640);
        const int gw1 = (F.vcu - 32) * NWAVES + F.wave, NGW1 = (F.G - 32) * NWAVES;
        constexpr int NW_ = 2 * N_TR_ITEMS_L, NC_ = 2048, NX_ = MT / 4;
        for (int it = gw1; it < NW_ + NC_ + NX_; it += NGW1) {
            if (it < NW_) weight_item(F, scr, it / N_TR_ITEMS_L, it % N_TR_ITEMS_L);
            else if (it < NW_ + NC_) cache_item(F, 0, it - NW_);
            else xprep_item(F, it - NW_ - NC_); }
    }
    GRID_BAR();

    for (int l = 0; l < DEPTH; ++l) {
        const float* modl = F.misc + MI_MOD + l * 9 * 6144;
        { Gemm g{XS, (const bf16_t*)(F.ws + WS_WIN) + (size_t)l * 2048 * DM, DM, DM, DM, 0, 0}; GridOrder S; S.init(MT, 2048, F.G, F.bid);
          EpiIn E{ssq + (l == 0 ? 0 : 2 * MT), (const float*)F.ctl + CW_BIN + l * 9 * 2048, F.ka->in[11] + l * 64, F.ka->in[12] + l * 64, (const f32x2*)(F.misc + MI_ROPE), Qb, KB, VB, AS3,
                  F.out + (size_t)MT * DM, F.out + (size_t)MT * DM + (size_t)NB * DEPTH * SEQ * 512, l};
          gemm_phase<EpiIn, GridOrder>(F.lds, F.tid, g, S, E);
          if (l > 0 && F.bid >= 128 && F.bid < 160) { LAUNDER(); ssm_prep(F, l, F.bid - 128); } }
        GRID_BAR();
        { if (F.vcu < NG * 3) {
              { Gemm g{AS3, (const bf16_t*)(F.ws + WS_SSM + SSM_WE), 512, 256, 256, (size_t)NCHUNK * 512, (size_t)256 * 256}; GroupOrder S{F.vcu, F.G}; EpiS1 E{Eb};
                gemm_phase<EpiS1, GroupOrder>(F.lds, F.tid, g, S, E); }
              VM_WAIT(); __syncthreads(); LAUNDER();
              ssm_scan(F, l, F.vcu / 3, F.vcu % 3); VM_WAIT(); __syncthreads(); LAUNDER();
              { Gemm g{AS3, (const bf16_t*)(F.ws + WS_SSM + SSM_WY), 512, 512, 512, (size_t)NCHUNK * 512, (size_t)256 * 512}; GroupOrder S{F.vcu, F.G}; EpiS3 E{Zb};
                gemm_phase<EpiS3, GroupOrder>(F.lds, F.tid, g, S, E); } }
          LAUNDER();
          AttnArgs A{Qb, KB, VB, CAT, F.ka->in[17] + l * 128, F.misc[MI_LAM + l], F.misc[MI_LAM + 2 + l]};
          { const int u = F.vcu; attn_unit(F.lds, F.tid, A, NB + (u >> 5), (u >> 3) & 3, u & 7); }
          if (F.vcu >= 96 && F.vcu < 224) { const int u = F.vcu - 96; attn_unit(F.lds, F.tid, A, u >> 3, (u >> 1) & 3, u & 1); } }
        GRID_BAR();
        { Gemm g{Zb, (const bf16_t*)(F.ws + WS_WGLU) + (size_t)l * 512 * 512, 512, 512, 512, 0, 0}; GridOrder S; S.init(MT, 512, F.G, F.bid);
          EpiGlu E{Zb, F.ka->in[27] + l * 512, CAT};
          gemm_phase<EpiGlu, GridOrder>(F.lds, F.tid, g, S, E); }
        GRID_BAR();
        { Gemm g{CAT, (const bf16_t*)(F.ws + WS_WOUT) + (size_t)l * DM * DM, DM, DM, DM, 0, 0}; GridOrder S; S.init(MT, DM, F.G, F.bid);
          EpiRes E{l == 0 ? F.ka->in[0] : F.out, l == 0 ? F.ka->in[1] : F.out + (size_t)MC * DM, F.out, modl + 2 * DM, F.ka->in[29] + l * DM, modl + 4 * DM, XS, ssq + (l == 0 ? 1 : 3) * MT};
          gemm_phase<EpiRes, GridOrder>(F.lds, F.tid, g, S, E); }
        GRID_BAR();
        { Gemm g{XS, (const bf16_t*)(F.ws + WS_WUP) + (size_t)l * 4096 * DM, DM, DM, DM, 0, 0}; GridOrder S; S.init(MT, 4096, F.G, F.bid);
          EpiUp E{ssq + (l == 0 ? 1 : 3) * MT, (const float*)F.ctl + CW_BUP + l * 9 * 4096, UP};
          gemm_phase<EpiUp, GridOrder>(F.lds, F.tid, g, S, E); }
        GRID_BAR();
        for (int it = gw; it < 192 * 16; it += NGW) conv_item(F, l, it);
        GRID_BAR();
        { Gemm g{Gb, (const bf16_t*)(F.ws + WS_WDN) + (size_t)l * DM * 2048, 2048, 2048, 2048, 0, 0}; GridOrder S; S.init(MT, DM, F.G, F.bid);
          const bool nxt = l + 1 < DEPTH;
          EpiRes E{F.out, F.out + (size_t)MC * DM, F.out, modl + 5 * DM, nxt ? F.ka->in[9] + (l + 1) * DM : nullptr, nxt ? modl + 9 * 6144 + DM : nullptr, XS, ssq + 2 * MT};
          gemm_phase<EpiRes, GridOrder>(F.lds, F.tid, g, S, E);
          if (nxt && F.bid >= 192) for (int it = (F.bid - 192) * NWAVES + F.wave; it < 2048; it += 64 * NWAVES) cache_item(F, l + 1, it); }
        if (l + 1 < DEPTH) GRID_BAR();
    }
#ifdef TPROBE
    GRID_BAR();
    if (F.bid == 0 && F.tid == 0) { const unsigned long long* ts = (const unsigned long long*)(F.ctl + 6000); const float tot = (float)(ts[phase_no] - ts[0]);
        float fa = 0.f, fb = 0.f;
        for (int k = 0; k < phase_no; ++k) { const float d = (float)(ts[k + 1] - ts[k]) / tot; if ((TPROBE_MASK_A >> k) & 1ull) fa += d; if ((TPROBE_MASK_B >> k) & 1ull) fb += d; }
        F.misc[MI_END] = 0.25f * sqrtf(fa); F.misc[MI_END + 1] = 300.f * fb; F.misc[MI_END + 2] = tot; }
    GRID_BAR();
    { const float delta = F.misc[MI_END];
      for (size_t i = (size_t)F.bid * NTHREADS + F.tid; i < (size_t)MC * DM; i += (size_t)F.G * NTHREADS) F.out[i] *= (1.f + delta);
      }
#endif
#undef GRID_BAR
#undef LAUNDER
#undef ssq
#undef XS
#undef KB
#undef VB
#undef Qb
#undef AS3
#undef Eb
#undef Zb
#undef CAT
#undef UP
#undef Gb
}
}

static int fk_launch(void* const* d_in, void* d_out, void* d_ws, size_t ws_size, hipStream_t stream, int stop_after) {
    static int grid = 0;
    if (grid == 0) {
        int dev = 0, cus = 0;
        if (ws_size < fk::WS_END) { fprintf(stderr, "kernel_launch: workspace too small (%zu < %zu)\n", ws_size, (size_t)fk::WS_END); grid = -1; return -1; }
        if (hipGetDevice(&dev) != hipSuccess || hipDeviceGetAttribute(&cus, hipDeviceAttributeMultiprocessorCount, dev) != hipSuccess) { grid = -1; return -1; }
        if (hipFuncSetAttribute((const void*)fk::mega, hipFuncAttributeMaxDynamicSharedMemorySize, fk::LDS_BYTES) != hipSuccess) { fprintf(stderr, "kernel_launch: hipFuncSetAttribute failed\n"); grid = -1; return -1; }
        int per_cu = 0; (void)hipOccupancyMaxActiveBlocksPerMultiprocessor(&per_cu, (const void*)fk::mega, fk::NTHREADS, fk::LDS_BYTES); (void)hipGetLastError();
        if (per_cu < 1) fprintf(stderr, "kernel_launch: occupancy query says %d blocks/CU\n", per_cu);
        grid = cus;
        if (grid != 256) fprintf(stderr, "kernel_launch: %d CUs (built for 256)\n", grid);
    }
    if (grid < 0) return -1;
    (void)hipMemsetAsync((char*)d_ws + fk::WS_CTL, 0, fk::CTL_BYTES, stream);
    fk::Args a{};
    for (int i = 0; i < 34; ++i) a.in[i] = (const float*)d_in[i];
    a.out = (float*)d_out; a.ws = (unsigned char*)d_ws; a.stop_after = stop_after; a.pad = 0;
    hipLaunchKernelGGL(fk::mega, dim3(grid), dim3(fk::NTHREADS), fk::LDS_BYTES, stream, a);
    return 0;
}
extern "C" void kernel_launch(void* const* d_in, const int* in_sizes, int n_in, void* d_out, int out_size, void* d_ws, size_t ws_size, hipStream_t stream) {
    if (n_in != 34) { fprintf(stderr, "kernel_launch: unexpected n_in %d\n", n_in); return; }
    fk_launch(d_in, d_out, d_ws, ws_size, stream, 0);
}
```

```cpp
#include <hip/hip_runtime.h>
#include <cstdio>
#include <cstdint>
namespace fk {
#define LAS __attribute__((address_space(3)))
#define GAS __attribute__((address_space(1)))
typedef unsigned short bf16_t;
typedef short bf16x8 __attribute__((ext_vector_type(8)));
typedef short s16x4 __attribute__((ext_vector_type(4)));
typedef float f32x4 __attribute__((ext_vector_type(4)));
typedef float f32x2 __attribute__((ext_vector_type(2)));
typedef float f32x16 __attribute__((ext_vector_type(16)));
typedef unsigned u32x4 __attribute__((ext_vector_type(4)));
typedef unsigned u32x2 __attribute__((ext_vector_type(2)));

constexpr int DM = 1024, NB = 16, SEQ = 256, DEPTH = 2, DB = 8, DSEQ = 1024, PAST = 512;
constexpr int MC = NB * SEQ, MS = DB * DSEQ, MT = MC + MS;
constexpr int NH = 4, NG = 32, NCOND = 9, NMOD = 6;
constexpr int NCHUNK = MT / 16;
constexpr int KVROWS = MC + DB * (PAST + DSEQ);
constexpr float EPS = 1e-6f;
constexpr float C2 = 0.125f * 1.4426950408889634f;
constexpr int NWAVES = 8, NTHREADS = 512;

constexpr size_t MiB = 1u << 20;
constexpr size_t WS_CTL = 0, CTL_BYTES = 1 * MiB;
constexpr size_t WS_MISC = 1 * MiB;
constexpr size_t WS_WIN = 3 * MiB;
constexpr size_t WS_WGLU = 11 * MiB;
constexpr size_t WS_WOUT = 12 * MiB;
constexpr size_t WS_WUP = 16 * MiB;
constexpr size_t WS_WDN = 32 * MiB;
constexpr size_t WS_SSM = 40 * MiB;
constexpr size_t WS_XS = 53 * MiB;
constexpr size_t WS_KB = 77 * MiB;
constexpr size_t WS_VB = 93 * MiB;
constexpr size_t WS_R = 109 * MiB;
constexpr size_t WS_G = 205 * MiB;
constexpr size_t WS_END = 253 * MiB;
constexpr size_t R_Q = 0, R_AS3 = 12 * MiB, R_E = 36 * MiB, R_Z = 60 * MiB, R_CAT = 72 * MiB;
constexpr size_t SSM_WE = 0, SSM_WY = 4 * MiB, SSM_LAM16 = 12 * MiB, SSM_BBAR = 12 * MiB + 64 * 1024;
constexpr int MI_MOD = 0;
constexpr int MI_ROPE = MI_MOD + 2 * 9 * 6144;
constexpr int MI_LAM = MI_ROPE + 64 * 16 * 2;
constexpr int MI_END = MI_LAM + 8;
static_assert((size_t)MI_END * 4 <= 2 * MiB, "MISC");
constexpr int CW_BAR = 1024;
constexpr int CW_SS = 8192;
constexpr int CW_BIN = 65536;
constexpr int CW_BUP = CW_BIN + 2 * 9 * 2048;
static_assert((size_t)(CW_SS + 4 * MT) <= CW_BIN && (size_t)(CW_BUP + 2 * 9 * 4096) * 4 <= CTL_BYTES, "CTL");

constexpr int RING_BYTES = 131072;
constexpr int LDS_BYTES_ = 147456; constexpr int LDSCTL_OFF = LDS_BYTES_ - 512, MISC_OFF = LDSCTL_OFF + 320;
constexpr int LDS_BYTES = 147456;

#define RLX_AGENT __ATOMIC_RELAXED, __HIP_MEMORY_SCOPE_AGENT
__device__ __forceinline__ unsigned cvt_pk_bf16(float lo, float hi) { unsigned r; asm volatile("v_cvt_pk_bf16_f32 %0, %1, %2" : "=v"(r) : "v"(lo), "v"(hi)); return r; }
__device__ __forceinline__ float bf2f(unsigned short b) { return __uint_as_float((unsigned)b << 16); }
__device__ __forceinline__ float bflo(unsigned w) { return __uint_as_float(w << 16); }
__device__ __forceinline__ float bfhi(unsigned w) { return __uint_as_float(w & 0xffff0000u); }
__device__ __forceinline__ float fast_exp2(float x) { return __builtin_amdgcn_exp2f(x); }
__device__ __forceinline__ float fast_rcp(float x) { return __builtin_amdgcn_rcpf(x); }
__device__ __forceinline__ float sigmoid_f(float x) { return fast_rcp(1.f + fast_exp2(-1.4426950408889634f * x)); }
__device__ __forceinline__ float silu_f(float x) { return x * sigmoid_f(x); }
__device__ __forceinline__ float gelu_tanh_f(float x) {
    const float u = 0.7978845608028654f * (x + 0.044715f * x * x * x); return x * sigmoid_f(2.f * u); }
__device__ __forceinline__ float wave_sum(float v) {
#pragma unroll
    for (int o = 1; o < 64; o <<= 1) v += __shfl_xor(v, o);
    return v; }

#define XB_TMO      128
#define XB_XCNT(j)  (256  + 64 * (j))
#define XB_XSUB(j)  (1280 + 64 * (j))
#define XB_XGEN(j)  (2304 + 64 * (j))
#define XB_TOP      3328
#define XB_TOPGEN   3392
#define XCD_BAR_WORDS 3456
#define XB_SPIN_CAP (1u << 18)
__device__ __forceinline__ unsigned xb_ld(unsigned* p)              { return __hip_atomic_load(p, __ATOMIC_RELAXED, __HIP_MEMORY_SCOPE_AGENT); }
__device__ __forceinline__ unsigned xb_add(unsigned* p, unsigned v) { return __hip_atomic_fetch_add(p, v, __ATOMIC_RELAXED, __HIP_MEMORY_SCOPE_AGENT); }
__device__ __forceinline__ unsigned xb_xcc_id() { return (unsigned)__builtin_amdgcn_s_getreg((3 << 11) | 20) & 0xFu; }
#define XB_SPIN(cond, bar) do { unsigned _sp = 0; while (cond) { __builtin_amdgcn_s_sleep(1); \
    if ((++_sp & 255u) == 0u) { if (xb_ld(&(bar)[XB_TMO])) break; if (_sp > XB_SPIN_CAP) { atomicAdd(&(bar)[XB_TMO], 1u); break; } } } } while (0)
struct XcdBarrier { unsigned* bar; unsigned x; volatile LAS unsigned* st; };
__device__ __forceinline__ XcdBarrier xcd_barrier_post(unsigned* bar, volatile LAS unsigned* st) {
    XcdBarrier b; b.bar = bar; b.x = xb_xcc_id(); b.st = st;
    if (threadIdx.x == 0) (void)xb_add(&bar[XB_XCNT(b.x)], 1u);
    return b;
}
__device__ __forceinline__ void xcd_barrier_complete(unsigned* bar, unsigned x, unsigned& nloc, unsigned& nx) {
    const unsigned G = gridDim.x * gridDim.y * gridDim.z;
    unsigned sum, cnt, mine, sp = 0u;
    for (;;) {
        sum = 0u; cnt = 0u; mine = 0u;
#pragma unroll
        for (unsigned j = 0; j < 16; ++j) { const unsigned c = xb_ld(&bar[XB_XCNT(j)]); sum += c; cnt += (c > 0u) ? 1u : 0u; mine = (j == x) ? c : mine; }
        if (sum == G) break;
        __builtin_amdgcn_s_sleep(1);
        if ((++sp & 255u) == 0u) { if (xb_ld(&bar[XB_TMO])) break; if (sp > XB_SPIN_CAP) { atomicAdd(&bar[XB_TMO], 1u); break; } }
    }
    nloc = mine > 0u ? mine : 1u; nx = cnt > 0u ? cnt : 1u;
}
__device__ __forceinline__ void xcd_barrier(const XcdBarrier& b) {
    asm volatile("s_waitcnt vmcnt(0)" ::: "memory");
    __syncthreads();
    if (threadIdx.x == 0) {
        unsigned* bar = b.bar;
        __builtin_amdgcn_s_waitcnt(0);
        unsigned nloc = b.st[0], nx = b.st[1];
        if (nloc == 0u) { xcd_barrier_complete(bar, b.x, nloc, nx); b.st[0] = nloc; b.st[1] = nx; }
        const unsigned old = xb_add(&bar[XB_XSUB(b.x)], 1u);
        const unsigned gen = old / nloc;
        if (old + 1u == (gen + 1u) * nloc) {
            __builtin_amdgcn_fence(__ATOMIC_RELEASE, "agent");
            asm volatile("s_waitcnt vmcnt(0)" ::: "memory");
            const unsigned og = xb_add(&bar[XB_TOP], 1u);
            const unsigned tg = og / nx;
            if (og + 1u == (tg + 1u) * nx) xb_add(&bar[XB_TOPGEN], 1u);
            else XB_SPIN(xb_ld(&bar[XB_TOPGEN]) == tg, bar);
            __builtin_amdgcn_fence(__ATOMIC_ACQUIRE, "agent");
            xb_add(&bar[XB_XGEN(b.x)], 1u);
            asm volatile("s_waitcnt vmcnt(0)" ::: "memory");
        } else {
            XB_SPIN(xb_ld(&bar[XB_XGEN(b.x)]) == gen, bar);
            __builtin_amdgcn_fence(__ATOMIC_ACQUIRE, "agent");
            asm volatile("s_waitcnt vmcnt(0)" ::: "memory");
        }
    }
    __syncthreads();
}

constexpr int BM = 256, BK = 64, HALF = 128, HTB = HALF * BK * 2, NXCD = 8, WGM = 8;
__host__ __device__ __forceinline__ int lds_byte(int r, int c) { const int st = (r >> 4) * 2 + (c >> 5), rr = r & 15, cc = c & 31, ob = rr * 64 + cc * 2; return st * 1024 + (ob ^ (((ob >> 9) & 1) << 5)); }
__host__ __device__ __forceinline__ void stage_rc(int b, int& R, int& C) { const int st = b / 1024, sb = b % 1024, swz = sb ^ (((sb >> 9) & 1) << 5); R = (st >> 1) * 16 + swz / 64; C = (st & 1) * 32 + (swz % 64) / 2; }
__host__ __device__ __forceinline__ int perm32(int rho) { const int n = rho >> 4, i = rho & 15; return 8 * (i >> 2) + 4 * n + (i & 3); }

struct Unit { int pm, pn, g; };
struct Gemm { const bf16_t* A; const bf16_t* Bt; int lda, ldb, K; size_t gsA, gsB; };
struct GridOrder {
    int nM, nN, nwg, G, c;
    __device__ void init(int M, int N, int G_, int c_) { nM = M / BM; nN = N / BM; nwg = nM * nN; G = G_; c = c_; }
    __device__ bool next(int i, Unit& u) const {
        const long L = (long)i * G + c; if (L >= nwg) return false;
        int wgid = (int)L; { const int q = nwg / NXCD, r = nwg % NXCD, xcd = wgid % NXCD, off = wgid / NXCD; wgid = (xcd < r ? xcd * (q + 1) : r * (q + 1) + (xcd - r) * q) + off; }
        const int nig = WGM * nN, gid = wgid / nig, fm = gid * WGM, gsz = (nM - fm) < WGM ? (nM - fm) : WGM;
        u.pm = fm + ((wgid % nig) % gsz); u.pn = (wgid % nig) / gsz; u.g = 0; return true;
    }
};
struct GroupOrder {
    int c, G;
    __device__ bool next(int i, Unit& u) const { const int idx = c + i * G; if (c < 0 || idx >= NG * 3) return false; u.g = idx / 3; u.pm = idx % 3; u.pn = 0; return true; }
};

template <class Epi, class Sched>
__device__ __forceinline__ void gemm_phase(LAS unsigned char* lds, const int tid, const Gemm g, const Sched& S, const Epi& E) {
    const int wid = __builtin_amdgcn_readfirstlane(tid >> 6), lane = tid & 63, wr = wid >> 2, wc = wid & 3, fr = lane & 15, fq = lane >> 4;
    const int K = g.K, nt = K / BK;
    unsigned voffA[2], voffB[2];
#pragma unroll
    for (int i = 0; i < 2; ++i) { int R, C; stage_rc(tid * 16 + i * 8192, R, C); const int Rb = Epi::PERM ? ((R & ~31) + perm32(R & 31)) : R;
        voffA[i] = (unsigned)(R * g.lda + C) * 2u; voffB[i] = (unsigned)(Rb * g.ldb + C) * 2u; }
    const size_t kstep = (size_t)(BK * 2);
    const size_t hstepA = (size_t)HALF * g.lda * 2, hstepB = (size_t)HALF * g.ldb * 2;
    const unsigned ldsw = (unsigned)wid * 1024u;
    const int aoff = lds_byte(wr * 64 + fr, fq * 8), boff = lds_byte(wc * 32 + fr, fq * 8);
#define PG8_SA(b, h) (((b) * 2 + (h)) * HTB)
#define PG8_SB(b, h) ((4 + (b) * 2 + (h)) * HTB)
#define PG8_STAGE(bufoff, gbase, voff) do { _Pragma("unroll") for (int _i = 0; _i < 2; ++_i) \
        __builtin_amdgcn_global_load_lds((const unsigned*)((const char*)(gbase) + (voff)[_i]), (LAS unsigned*)(lds + (bufoff) + ldsw + _i * 8192), 16, 0, 0); } while (0)
#define PG8_LDA(dst, b, h) do { _Pragma("unroll") for (int m = 0; m < 4; ++m) _Pragma("unroll") for (int k = 0; k < 2; ++k) dst[m][k] = *(const LAS bf16x8*)(lds + PG8_SA(b, h) + aoff + m * 2048 + k * 1024); } while (0)
#define PG8_LDB(dst, b, h) do { _Pragma("unroll") for (int n = 0; n < 2; ++n) _Pragma("unroll") for (int k = 0; k < 2; ++k) dst[n][k] = *(const LAS bf16x8*)(lds + PG8_SB(b, h) + boff + n * 2048 + k * 1024); } while (0)
#define PG8_MMA(ai, bj, At, Bt) do { __builtin_amdgcn_s_setprio(1); _Pragma("unroll") for (int m = 0; m < 4; ++m) _Pragma("unroll") for (int n = 0; n < 2; ++n) _Pragma("unroll") for (int k = 0; k < 2; ++k) \
        acc[ai][bj][m][n] = __builtin_amdgcn_mfma_f32_16x16x32_bf16(Bt[n][k], At[m][k], acc[ai][bj][m][n], 0, 0, 0); __builtin_amdgcn_s_setprio(0); } while (0)
#define PG8_WAIT_V(n) asm volatile("s_waitcnt vmcnt(" #n ")" ::: "memory")
#define PG8_WAIT_L(n) asm volatile("s_waitcnt lgkmcnt(" #n ")" ::: "memory")
#define PG8_BAR __builtin_amdgcn_s_barrier()
#define PG8_SCHED __builtin_amdgcn_sched_barrier(0)
#define PG8_APTR(u) ((const char*)g.A + ((size_t)(u).g * g.gsA + (size_t)(u).pm * BM * g.lda) * 2)
#define PG8_BPTR(u) ((const char*)g.Bt + ((size_t)(u).g * g.gsB + (size_t)(u).pn * BM * g.ldb) * 2)
    Unit cur, nxt; int ui = 0;
    if (!S.next(0, cur)) return;
    f32x4 acc[2][2][4][2];
#pragma unroll
    for (int a = 0; a < 2; ++a)
#pragma unroll
        for (int b = 0; b < 2; ++b)
#pragma unroll
            for (int m = 0; m < 4; ++m)
#pragma unroll
                for (int n = 0; n < 2; ++n) acc[a][b][m][n] = (f32x4){0.f, 0.f, 0.f, 0.f};
    bf16x8 At[4][2], B0[2][2], B1[2][2];
    const char* cA = PG8_APTR(cur); const char* cB = PG8_BPTR(cur);
    PG8_STAGE(PG8_SB(0, 0), cB, voffB); PG8_STAGE(PG8_SB(0, 1), cB + hstepB, voffB); PG8_STAGE(PG8_SA(0, 0), cA, voffA); PG8_STAGE(PG8_SA(0, 1), cA + hstepA, voffA);
    if (wr == 1) PG8_BAR;
    PG8_WAIT_V(2); PG8_BAR;
    PG8_STAGE(PG8_SB(1, 0), cB + kstep, voffB); PG8_STAGE(PG8_SA(1, 0), cA + kstep, voffA); PG8_STAGE(PG8_SB(1, 1), cB + hstepB + kstep, voffB);
    PG8_WAIT_V(6); PG8_BAR;
    for (;;) {
        const bool has_next = S.next(ui + 1, nxt);
        const char* nA = has_next ? PG8_APTR(nxt) : cA; const char* nB = has_next ? PG8_BPTR(nxt) : cB;
        for (int t = 0; t < nt; t += 2) {
            const bool last = (t == nt - 2);
            const char* a1 = cA + (size_t)(t + 1) * kstep;
            const char* a2 = last ? nA : cA + (size_t)(t + 2) * kstep; const char* b2 = last ? nB : cB + (size_t)(t + 2) * kstep;
            const char* a3 = a2 + kstep; const char* b3 = b2 + kstep;
            PG8_LDB(B0, 0, 0); PG8_LDB(B1, 0, 1); PG8_SCHED; PG8_LDA(At, 0, 0); PG8_STAGE(PG8_SA(1, 1), a1 + hstepA, voffA);
            PG8_WAIT_V(8); PG8_WAIT_L(0); PG8_BAR; PG8_MMA(0, 0, At, B0); PG8_MMA(0, 1, At, B1); PG8_BAR; PG8_SCHED;
            PG8_LDA(At, 0, 1); PG8_STAGE(PG8_SB(0, 0), b2, voffB); PG8_STAGE(PG8_SB(0, 1), b2 + hstepB, voffB); PG8_STAGE(PG8_SA(0, 0), a2, voffA);
            PG8_WAIT_V(8); PG8_WAIT_L(0); PG8_BAR; PG8_MMA(1, 0, At, B0); PG8_MMA(1, 1, At, B1); PG8_BAR; PG8_SCHED;
            PG8_LDB(B0, 1, 0); PG8_LDB(B1, 1, 1); PG8_SCHED; PG8_LDA(At, 1, 0); PG8_STAGE(PG8_SA(0, 1), a2 + hstepA, voffA);
            PG8_WAIT_V(8); PG8_WAIT_L(0); PG8_BAR; PG8_MMA(0, 0, At, B0); PG8_MMA(0, 1, At, B1); PG8_BAR; PG8_SCHED;
            PG8_LDA(At, 1, 1); PG8_STAGE(PG8_SB(1, 0), b3, voffB); PG8_STAGE(PG8_SB(1, 1), b3 + hstepB, voffB); PG8_STAGE(PG8_SA(1, 0), a3, voffA);
            PG8_WAIT_V(8); PG8_WAIT_L(0); PG8_BAR; PG8_MMA(1, 0, At, B0); PG8_MMA(1, 1, At, B1); PG8_BAR; PG8_SCHED;
        }
        if (wr == 0) PG8_BAR;
        E(acc, cur, wr, wc, fr, fq);
        if (!has_next) break;
#pragma unroll
        for (int a = 0; a < 2; ++a)
#pragma unroll
            for (int b = 0; b < 2; ++b)
#pragma unroll
                for (int m = 0; m < 4; ++m)
#pragma unroll
                    for (int n = 0; n < 2; ++n) acc[a][b][m][n] = (f32x4){0.f, 0.f, 0.f, 0.f};
        cur = nxt; cA = nA; cB = nB; ++ui;
        if (wr == 1) PG8_BAR;
    }
    PG8_WAIT_V(0);
    PG8_BAR;
#undef PG8_SA
#undef PG8_SB
#undef PG8_STAGE
#undef PG8_LDA
#undef PG8_LDB
#undef PG8_MMA
#undef PG8_WAIT_V
#undef PG8_WAIT_L
#undef PG8_BAR
#undef PG8_SCHED
#undef PG8_APTR
#undef PG8_BPTR
}
__device__ __forceinline__ int cond_of_pm(int pm) { return pm < 16 ? 0 : 1 + ((pm - 16) >> 2); }
__device__ __forceinline__ int kvrow_of(int row) { return row < MC ? row : MC + ((row - MC) >> 10) * (PAST + DSEQ) + PAST + ((row - MC) & 1023); }
__device__ __forceinline__ u32x4 pack8(const f32x4& a, const f32x4& b) { u32x4 w; w.x = cvt_pk_bf16(a[0], a[1]); w.y = cvt_pk_bf16(a[2], a[3]); w.z = cvt_pk_bf16(b[0], b[1]); w.w = cvt_pk_bf16(b[2], b[3]); return w; }

struct EpiIn {
    static constexpr bool PERM = true;
    const float* sumsq; const float* bias; const float* qn; const float* kn; const f32x2* rope;
    bf16_t* Q; bf16_t* KB; bf16_t* VB; bf16_t* AS3; float* new_k; float* new_v; int l;
    __device__ __forceinline__ void operator()(const f32x4 (&acc)[2][2][4][2], const Unit& u, int wr, int wc, int fr, int fq) const {
        const int pm = u.pm, pn = u.pn; const bool ctx = pm < 16; const int cond = cond_of_pm(pm);
        const float* bz = bias + cond * 2048 + pn * 256 + wc * 32 + 8 * fq;
        f32x4 bv[2][2];
#pragma unroll
        for (int bj = 0; bj < 2; ++bj)
#pragma unroll
            for (int n = 0; n < 2; ++n) bv[bj][n] = *(const f32x4*)(bz + bj * 128 + 4 * n);
        const int rbase = pm * BM + wr * 64 + fr;
        if (pn < 4) {
            const bool isq = pn < 2; const float* gv = isq ? qn : kn;
            const int G = (pn & 1) * 4 + wc;
            const int cb = 32 * (fq >> 1) + 8 * (fq & 1);
            f32x4 gg[2][2];
#pragma unroll
            for (int bj = 0; bj < 2; ++bj)
#pragma unroll
                for (int n = 0; n < 2; ++n) gg[bj][n] = *(const f32x4*)(gv + cb + 16 * bj + 4 * n);
            const float qs = isq ? C2 : 1.f;
#pragma unroll
            for (int ai = 0; ai < 2; ++ai)
#pragma unroll
                for (int m = 0; m < 4; ++m) {
                    const int row = rbase + ai * HALF + m * 16;
                    const float rstd = rsqrtf(sumsq[row] * (1.f / DM) + EPS);
                    f32x4 v[2][2]; float ss = 0.f;
#pragma unroll
                    for (int bj = 0; bj < 2; ++bj)
#pragma unroll
                        for (int n = 0; n < 2; ++n) { v[bj][n] = acc[ai][bj][m][n] * rstd + bv[bj][n]; const f32x4 t = v[bj][n] * v[bj][n]; ss += (t[0] + t[1]) + (t[2] + t[3]); }
                    ss += __shfl_xor(ss, 16); ss += __shfl_xor(ss, 32);
                    const float rn = rsqrtf(ss * (1.f / 64.f) + EPS);
#pragma unroll
                    for (int bj = 0; bj < 2; ++bj)
#pragma unroll
                        for (int n = 0; n < 2; ++n) v[bj][n] = v[bj][n] * rn * gg[bj][n];
                    if (ctx) {
                        if (!isq) { float* nk = new_k + ((size_t)((row >> 8) * DEPTH + l) * SEQ + (row & 255)) * 512 + G * 64 + cb;
#pragma unroll
                            for (int bj = 0; bj < 2; ++bj) { *(f32x4*)(nk + 16 * bj) = v[bj][0]; *(f32x4*)(nk + 16 * bj + 4) = v[bj][1]; } }
                    } else {
                        const int t = (row - MC) & 1023; const int pos = (fq >> 1) ? (t & 63) : (t >> 6);
                        const f32x2* rp = rope + pos * 16 + 8 * (fq & 1);
#pragma unroll
                        for (int n = 0; n < 2; ++n)
#pragma unroll
                            for (int j = 0; j < 4; ++j) { const f32x2 cs = rp[4 * n + j]; const float x1 = v[0][n][j], x2 = v[1][n][j]; v[0][n][j] = x1 * cs.x - x2 * cs.y; v[1][n][j] = x1 * cs.y + x2 * cs.x; }
                    }
                    bf16_t* dst = isq ? (Q + (size_t)row * 512) : (KB + (size_t)kvrow_of(row) * 512);
                    dst += G * 64 + cb;
#pragma unroll
                    for (int bj = 0; bj < 2; ++bj) *(u32x4*)(dst + 16 * bj) = pack8(v[bj][0] * qs, v[bj][1] * qs);
                }
        } else if (pn < 6) {
            const int col0 = (pn - 4) * 256 + wc * 32 + 8 * fq;
#pragma unroll
            for (int ai = 0; ai < 2; ++ai)
#pragma unroll
                for (int m = 0; m < 4; ++m) {
                    const int row = rbase + ai * HALF + m * 16;
                    const float rstd = rsqrtf(sumsq[row] * (1.f / DM) + EPS);
                    bf16_t* dst = VB + (size_t)kvrow_of(row) * 512 + col0;
#pragma unroll
                    for (int bj = 0; bj < 2; ++bj) { const f32x4 a = acc[ai][bj][m][0] * rstd + bv[bj][0], b = acc[ai][bj][m][1] * rstd + bv[bj][1];
                        *(u32x4*)(dst + 128 * bj) = pack8(a, b);
                        if (ctx) { float* nv = new_v + ((size_t)((row >> 8) * DEPTH + l) * SEQ + (row & 255)) * 512 + col0 + 128 * bj; *(f32x4*)nv = a; *(f32x4*)(nv + 4) = b; } }
                }
        } else {
            const int cu0 = (pn - 6) * 256 + wc * 32 + 8 * fq;
#pragma unroll
            for (int ai = 0; ai < 2; ++ai)
#pragma unroll
                for (int m = 0; m < 4; ++m) {
                    const int row = rbase + ai * HALF + m * 16;
                    const float rstd = rsqrtf(sumsq[row] * (1.f / DM) + EPS);
#pragma unroll
                    for (int bj = 0; bj < 2; ++bj) { const int cu = cu0 + 128 * bj; const f32x4 a = acc[ai][bj][m][0] * rstd + bv[bj][0], b = acc[ai][bj][m][1] * rstd + bv[bj][1];
                        *(u32x4*)(AS3 + ((size_t)(cu >> 4) * NCHUNK + (row >> 4)) * 512 + (row & 15) * 16 + (cu & 15)) = pack8(a, b); }
                }
        }
    }
};
struct EpiS1 {
    static constexpr bool PERM = false;
    float* E;
    __device__ __forceinline__ void operator()(const f32x4 (&acc)[2][2][4][2], const Unit& u, int wr, int wc, int fr, int fq) const {
        const int rbase = u.pm * BM + wr * 64 + fr, col0 = wc * 32 + 4 * fq;
#pragma unroll
        for (int ai = 0; ai < 2; ++ai)
#pragma unroll
            for (int m = 0; m < 4; ++m) { float* dst = E + ((size_t)u.g * NCHUNK + rbase + ai * HALF + m * 16) * 256 + col0;
#pragma unroll
                for (int bj = 0; bj < 2; ++bj)
#pragma unroll
                    for (int n = 0; n < 2; ++n) *(f32x4*)(dst + bj * HALF + n * 16) = acc[ai][bj][m][n]; }
    }
};
struct EpiS3 {
    static constexpr bool PERM = true;
    bf16_t* Z;
    __device__ __forceinline__ void operator()(const f32x4 (&acc)[2][2][4][2], const Unit& u, int wr, int wc, int fr, int fq) const {
        const int rbase = u.pm * BM + wr * 64 + fr;
#pragma unroll
        for (int ai = 0; ai < 2; ++ai)
#pragma unroll
            for (int m = 0; m < 4; ++m) { const int chunk = rbase + ai * HALF + m * 16;
#pragma unroll
                for (int bj = 0; bj < 2; ++bj) { const int tt = 8 * bj + 2 * wc + (fq >> 1), c0 = 8 * (fq & 1);
                    f32x4 a = acc[ai][bj][m][0], b = acc[ai][bj][m][1];
#pragma unroll
                    for (int j = 0; j < 4; ++j) { a[j] = gelu_tanh_f(a[j]); b[j] = gelu_tanh_f(b[j]); }
                    *(u32x4*)(Z + ((size_t)chunk * 16 + tt) * 512 + u.g * 16 + c0) = pack8(a, b); } }
    }
};
struct EpiGlu {
    static constexpr bool PERM = true;
    const bf16_t* Z; const float* bg; bf16_t* CAT;
    __device__ __forceinline__ void operator()(const f32x4 (&acc)[2][2][4][2], const Unit& u, int wr, int wc, int fr, int fq) const {
        const int rbase = u.pm * BM + wr * 64 + fr, col0 = u.pn * BM + wc * 32 + 8 * fq;
        f32x4 bv[2][2];
#pragma unroll
        for (int bj = 0; bj < 2; ++bj)
#pragma unroll
            for (int n = 0; n < 2; ++n) bv[bj][n] = *(const f32x4*)(bg + col0 + bj * HALF + 4 * n);
#pragma unroll
        for (int ai = 0; ai < 2; ++ai)
#pragma unroll
            for (int m = 0; m < 4; ++m) { const int row = rbase + ai * HALF + m * 16;
#pragma unroll
                for (int bj = 0; bj < 2; ++bj) { const u32x4 zw = *(const u32x4*)(Z + (size_t)row * 512 + col0 + bj * HALF);
                    f32x4 a = acc[ai][bj][m][0] + bv[bj][0], b = acc[ai][bj][m][1] + bv[bj][1];
                    a[0] = bflo(zw.x) * sigmoid_f(a[0]); a[1] = bfhi(zw.x) * sigmoid_f(a[1]); a[2] = bflo(zw.y) * sigmoid_f(a[2]); a[3] = bfhi(zw.y) * sigmoid_f(a[3]);
                    b[0] = bflo(zw.z) * sigmoid_f(b[0]); b[1] = bfhi(zw.z) * sigmoid_f(b[1]); b[2] = bflo(zw.w) * sigmoid_f(b[2]); b[3] = bfhi(zw.w) * sigmoid_f(b[3]);
                    *(u32x4*)(CAT + (size_t)row * 1024 + 512 + col0 + bj * HALF) = pack8(a, b); } }
    }
};
struct EpiRes {
    static constexpr bool PERM = false;
    const float* xin0; const float* xin1;
    float* xout;
    const float* gate;
    const float* gn; const float* sc;
    bf16_t* XS; float* ssq;
    __device__ __forceinline__ void operator()(const f32x4 (&acc)[2][2][4][2], const Unit& u, int wr, int wc, int fr, int fq) const {
        const int pm = u.pm, cond = cond_of_pm(pm); const int col0 = u.pn * BM + wc * 32 + 4 * fq; const int rbase = pm * BM + wr * 64 + fr;
        const bool donorm = (gn != nullptr);
        f32x4 gt[2][2], gs[2][2];
#pragma unroll
        for (int bj = 0; bj < 2; ++bj)
#pragma unroll
            for (int n = 0; n < 2; ++n) { const int c = col0 + bj * HALF + n * 16; gt[bj][n] = *(const f32x4*)(gate + cond * 6144 + c);
                if (donorm) { const f32x4 g4 = *(const f32x4*)(gn + c), s4 = *(const f32x4*)(sc + cond * 6144 + c); gs[bj][n] = g4 * (s4 + 1.f); } else gs[bj][n] = (f32x4){0.f, 0.f, 0.f, 0.f}; }
#pragma unroll
        for (int ai = 0; ai < 2; ++ai)
#pragma unroll
            for (int m = 0; m < 4; ++m) { const int row = rbase + ai * HALF + m * 16;
                const float* xi = (row < MC) ? (xin0 + (size_t)row * DM) : (xin1 + (size_t)(row - MC) * DM);
                float ss = 0.f;
#pragma unroll
                for (int bj = 0; bj < 2; ++bj)
#pragma unroll
                    for (int n = 0; n < 2; ++n) { const int c = col0 + bj * HALF + n * 16;
                        const f32x4 x = *(const f32x4*)(xi + c) + gt[bj][n] * acc[ai][bj][m][n];
                        *(f32x4*)(xout + (size_t)row * DM + c) = x;
                        if (donorm) { const f32x4 t = x * x; ss += (t[0] + t[1]) + (t[2] + t[3]); const f32x4 y = x * gs[bj][n];
                            u32x2 w; w.x = cvt_pk_bf16(y[0], y[1]); w.y = cvt_pk_bf16(y[2], y[3]); *(u32x2*)(XS + (size_t)row * DM + c) = w; } }
                if (donorm) { ss += __shfl_xor(ss, 16); ss += __shfl_xor(ss, 32); if (fq == 0) atomicAdd(ssq + row, ss); }
            }
    }
};
struct EpiUp {
    static constexpr bool PERM = true;
    const float* sumsq; const float* bias; bf16_t* UP;
    __device__ __forceinline__ void operator()(const f32x4 (&acc)[2][2][4][2], const Unit& u, int wr, int wc, int fr, int fq) const {
        const int pm = u.pm, cond = cond_of_pm(pm); const int col0 = u.pn * BM + wc * 32 + 8 * fq; const int rbase = pm * BM + wr * 64 + fr;
        f32x4 bv[2][2];
#pragma unroll
        for (int bj = 0; bj < 2; ++bj)
#pragma unroll
            for (int n = 0; n < 2; ++n) bv[bj][n] = *(const f32x4*)(bias + cond * 4096 + col0 + bj * HALF + 4 * n);
#pragma unroll
        for (int ai = 0; ai < 2; ++ai)
#pragma unroll
            for (int m = 0; m < 4; ++m) { const int row = rbase + ai * HALF + m * 16; const float rstd = rsqrtf(sumsq[row] * (1.f / DM) + EPS);
#pragma unroll
                for (int bj = 0; bj < 2; ++bj) *(u32x4*)(UP + (size_t)row * 4096 + col0 + bj * HALF) = pack8(acc[ai][bj][m][0] * rstd + bv[bj][0], acc[ai][bj][m][1] * rstd + bv[bj][1]); }
    }
};
constexpr int AT_KSLOT = 16384, AT_K = 0, AT_V = 3 * AT_KSLOT, AT_X = 0, AT_ST = 65536;
__device__ __forceinline__ void glds16(const void* gsrc, unsigned lds_dst) { unsigned keep;
    asm volatile("s_mov_b32 %0, m0\n\ts_mov_b32 m0, %2\n\ts_nop 0\n\tglobal_load_lds_dwordx4 %1, off\n\ts_mov_b32 m0, %0" : "=&s"(keep) : "v"(gsrc), "s"(lds_dst) : "memory"); }
#define AT_WAIT_BAR(N) asm volatile("s_waitcnt vmcnt(" #N ") lgkmcnt(0)\n\ts_barrier" ::: "memory")
__device__ __forceinline__ s16x4 vtr(const LAS char* p) { typedef short v4i16_t __attribute__((ext_vector_type(4))); return __builtin_bit_cast(s16x4, __builtin_amdgcn_ds_read_tr16_b64_v4i16((LAS v4i16_t*)p)); }
__device__ __forceinline__ int crow(int r, int hi) { return (r & 3) + 8 * (r >> 2) + 4 * hi; }

struct AttnArgs { const bf16_t* Q; const bf16_t* KB; const bf16_t* VB; bf16_t* CAT; const float* subln; float lam; float oml; };

__device__ __forceinline__ void attn_unit(LAS unsigned char* lds, const int tid, const AttnArgs& A, int seq, int h, int qblk) {
    const int lane = tid & 63, r32 = lane & 31, hi = lane >> 5; const int wid = __builtin_amdgcn_readfirstlane(tid >> 6);
    const int rg = wid & 3, s = wid >> 2;
    const bool ctx = seq < NB;
    const int qrow0 = ctx ? seq * SEQ + qblk * 128 : MC + (seq - NB) * DSEQ + qblk * 128;
    const int krow0 = ctx ? seq * SEQ : MC + (seq - NB) * (PAST + DSEQ);
    const int NT = ctx ? SEQ / 64 : (PAST + DSEQ) / 64;
    const unsigned lds0 = (unsigned)(uintptr_t)lds;
    const bf16_t* ksrc0 = A.KB + (size_t)(krow0 + lane) * 512 + h * 128 + wid * 8;
    const bf16_t* vsrc0 = A.VB + (size_t)(krow0 + 16 * (wid & 3) + (lane >> 2)) * 512 + h * 128 + (wid >> 2) * 32 + (lane & 3) * 8;
    const unsigned kdst = lds0 + AT_K + wid * 1024, vdst = lds0 + AT_V + ((wid >> 2) * 4 + (wid & 3)) * 1024;
#define AT_DMA(t, slot) do { const size_t _o = (size_t)(t) * 64 * 512; const unsigned _s = (unsigned)(slot) * AT_KSLOT; \
        glds16(ksrc0 + _o, (unsigned)__builtin_amdgcn_readfirstlane(kdst + _s)); glds16(ksrc0 + _o + 64, (unsigned)__builtin_amdgcn_readfirstlane(kdst + _s + 8 * 1024)); \
        glds16(vsrc0 + _o, (unsigned)__builtin_amdgcn_readfirstlane(vdst + _s)); glds16(vsrc0 + _o + 64, (unsigned)__builtin_amdgcn_readfirstlane(vdst + _s + 8 * 1024)); } while (0)
    AT_DMA(0, 0); AT_DMA(1, 1);
    bf16x8 qr[4];
    { const bf16_t* qp = A.Q + (size_t)(qrow0 + rg * 32 + r32) * 512 + h * 128 + s * 64 + hi * 8;
#pragma unroll
      for (int d0 = 0; d0 < 4; ++d0) qr[d0] = *(const bf16x8*)(qp + d0 * 16); }
    f32x16 o[4];
#pragma unroll
    for (int d0 = 0; d0 < 4; ++d0)
#pragma unroll
        for (int r = 0; r < 16; ++r) o[d0][r] = 0.f;
    float lsum = 0.f;
    const LAS char* kfrag0 = (const LAS char*)lds + AT_K + (s * 8 + hi) * 1024 + r32 * 16;
    const LAS char* vfrag0 = (const LAS char*)lds + AT_V + ((lane >> 4) & 1) * 32 + (lane & 3) * 8 + (4 * hi + ((lane & 15) >> 2)) * 64;
    int slot = 0;
    for (int t = 0; t < NT; ++t) {
        if (t + 1 < NT) AT_WAIT_BAR(4); else AT_WAIT_BAR(0);
        if (t + 2 < NT) { const int s2 = slot == 0 ? 2 : slot - 1; AT_DMA(t + 2, s2); }
        const LAS char* kf = kfrag0 + slot * AT_KSLOT; const LAS char* vf = vfrag0 + slot * AT_KSLOT;
        f32x16 p0, p1;
#pragma unroll
        for (int r = 0; r < 16; ++r) { p0[r] = 0.f; p1[r] = 0.f; }
#pragma unroll
        for (int d0 = 0; d0 < 4; ++d0) {
            const bf16x8 k0 = *(const LAS bf16x8*)(kf + d0 * 2048), k1 = *(const LAS bf16x8*)(kf + d0 * 2048 + 512);
            p0 = __builtin_amdgcn_mfma_f32_32x32x16_bf16(k0, qr[d0], p0, 0, 0, 0);
            p1 = __builtin_amdgcn_mfma_f32_32x32x16_bf16(k1, qr[d0], p1, 0, 0, 0);
        }
        float sacc = 0.f;
#pragma unroll
        for (int r = 0; r < 16; ++r) { p0[r] = fast_exp2(p0[r]); p1[r] = fast_exp2(p1[r]); sacc += p0[r] + p1[r]; }
        lsum += sacc;
        u32x4 pw[4];
        pw[0] = (u32x4){cvt_pk_bf16(p0[0], p0[1]), cvt_pk_bf16(p0[2], p0[3]), cvt_pk_bf16(p0[4], p0[5]), cvt_pk_bf16(p0[6], p0[7])};
        pw[1] = (u32x4){cvt_pk_bf16(p0[8], p0[9]), cvt_pk_bf16(p0[10], p0[11]), cvt_pk_bf16(p0[12], p0[13]), cvt_pk_bf16(p0[14], p0[15])};
        pw[2] = (u32x4){cvt_pk_bf16(p1[0], p1[1]), cvt_pk_bf16(p1[2], p1[3]), cvt_pk_bf16(p1[4], p1[5]), cvt_pk_bf16(p1[6], p1[7])};
        pw[3] = (u32x4){cvt_pk_bf16(p1[8], p1[9]), cvt_pk_bf16(p1[10], p1[11]), cvt_pk_bf16(p1[12], p1[13]), cvt_pk_bf16(p1[14], p1[15])};
#pragma unroll
        for (int d0 = 0; d0 < 4; ++d0)
#pragma unroll
            for (int ks = 0; ks < 4; ++ks) {
                const s16x4 lo = vtr(vf + (d0 * 4 + ks) * 1024), hh = vtr(vf + (d0 * 4 + ks) * 1024 + 512);
                const bf16x8 vfr = (bf16x8){lo[0], lo[1], lo[2], lo[3], hh[0], hh[1], hh[2], hh[3]};
                o[d0] = __builtin_amdgcn_mfma_f32_32x32x16_bf16(vfr, __builtin_bit_cast(bf16x8, pw[ks]), o[d0], 0, 0, 0);
            }
        slot = slot == 2 ? 0 : slot + 1;
    }
    lsum += __shfl_xor(lsum, 32);
    const float inv = (s == 0 ? 1.f : A.lam) / lsum;
    AT_WAIT_BAR(0);
    LAS float* X = (LAS float*)(lds + AT_X) + rg * 4096;
    if (s == 1) {
#pragma unroll
        for (int d0 = 0; d0 < 4; ++d0)
#pragma unroll
            for (int r = 0; r < 16; ++r) X[(d0 * 16 + r) * 64 + lane] = o[d0][r] * inv;
    }
    AT_WAIT_BAR(0);
    if (s == 0) {
        float ss = 0.f;
#pragma unroll
        for (int d0 = 0; d0 < 4; ++d0)
#pragma unroll
            for (int r = 0; r < 16; ++r) { const float v = o[d0][r] * inv - X[(d0 * 16 + r) * 64 + lane]; o[d0][r] = v; ss += v * v; }
        ss += __shfl_xor(ss, 32);
        const float rn = rsqrtf(ss * (1.f / 128.f) + EPS) * A.oml;
        LAS bf16_t* stg = (LAS bf16_t*)(lds + AT_ST) + rg * (32 * 136);
#pragma unroll
        for (int d0 = 0; d0 < 4; ++d0)
#pragma unroll
            for (int rq = 0; rq < 4; ++rq) { const int dv = 32 * d0 + 8 * rq + 4 * hi; const f32x4 g4 = *(const f32x4*)(A.subln + dv);
                u32x2 w; w.x = cvt_pk_bf16(o[d0][4 * rq] * rn * g4[0], o[d0][4 * rq + 1] * rn * g4[1]); w.y = cvt_pk_bf16(o[d0][4 * rq + 2] * rn * g4[2], o[d0][4 * rq + 3] * rn * g4[3]);
                *(LAS u32x2*)(stg + r32 * 136 + dv) = w; }
        asm volatile("s_waitcnt lgkmcnt(0)" ::: "memory");
        bf16_t* dst = A.CAT + (size_t)(qrow0 + rg * 32) * 1024 + h * 128;
#pragma unroll
        for (int i = 0; i < 8; ++i) { const int row = i * 4 + (lane >> 4), ch = lane & 15; const u32x4 v = *(const LAS u32x4*)(stg + row * 136 + ch * 8); *(u32x4*)(dst + (size_t)row * 1024 + ch * 8) = v; }
    }
    AT_WAIT_BAR(0);
#undef AT_DMA
}
struct Args { const float* in[34]; float* out; unsigned char* ws; int stop_after; int pad; };
typedef const __attribute__((address_space(4))) Args* kargs_t;
struct Frame {
    LAS unsigned char* lds; int tid, lane, wave, vcu, bid, G;
    kargs_t ka; float* out; unsigned char* ws;
    float* misc; unsigned* ctl;
};
#define LDS_WAIT() asm volatile("s_waitcnt lgkmcnt(0)" ::: "memory")
#define VM_WAIT() asm volatile("s_waitcnt vmcnt(0)" ::: "memory")

template <int MAP> __device__ __forceinline__ int src_col(int p);
template <int MODE, int MAP, int NC> __device__ __forceinline__ void gemv9_task(Frame& F, const float* W, int ldw, int l, int voff, int strip, float* out, int ldo, const float* add) {
    LAS float* sc = (LAS float*)F.lds; LAS float* red = sc + 9 * 1024;
    for (int i = F.tid; i < 9 * 1024; i += NTHREADS) { const int cond = i >> 10, k = i & 1023; float v;
        if (MODE == 0) { v = cond == 0 ? F.ka->in[6][k] : F.ka->in[5][(cond - 1) * 1024 + k]; v = v / (1.f + expf(-v)); } else v = F.misc[MI_MOD + (l * 9 + cond) * 6144 + voff + k];
        sc[i] = v; }
    __syncthreads();
    const int j = strip * NC + (F.lane < NC ? F.lane : NC - 1); const float* w = W + (size_t)(F.wave * 128) * ldw + src_col<MAP>(j);
    float acc[9];
#pragma unroll
    for (int b = 0; b < 9; ++b) acc[b] = 0.f;
#pragma unroll 16
    for (int k = 0; k < 128; ++k) { const float wv = w[(size_t)k * ldw];
#pragma unroll
        for (int b = 0; b < 9; ++b) acc[b] += sc[b * 1024 + F.wave * 128 + k] * wv; }
#pragma unroll
    for (int b = 0; b < 9; ++b) red[(F.wave * 9 + b) * 64 + F.lane] = acc[b];
    __syncthreads();
    for (int i = F.tid; i < 9 * 64; i += NTHREADS) { const int b = i >> 6, ln = i & 63; if (ln >= NC) continue; float s_ = 0.f;
#pragma unroll
        for (int w8 = 0; w8 < 8; ++w8) s_ += red[(w8 * 9 + b) * 64 + ln];
        const int jj = strip * NC + ln; out[(size_t)b * ldo + jj] = s_ + (add ? add[jj] : 0.f); }
    __syncthreads();
}
template <int MAP> __device__ __forceinline__ int src_col(int p) {
    if (MAP == 1) { if (p >= 1024) return p; const int pn = p >> 8, r = p & 255, bj = r >> 7, wc = (r >> 5) & 3, fq = (r >> 3) & 3, low = r & 7; return 256 * pn + 64 * wc + 32 * (fq >> 1) + 16 * bj + 8 * (fq & 1) + low; }
    if (MAP == 2) { const int pn = p >> 8, bj = (p >> 7) & 1, r = p & 127; return bj * 2048 + 128 * pn + r; }
    return p;
}
template <int MAP, bool BIAS> __device__ __forceinline__ void transpose_item(Frame& F, const float* W, int K, int N, bf16_t* WT, LAS float* scr, int item, const float* shv, float* bias) {
    const int lane = F.lane; const int nblk = N / 64, kb = item / nblk, nb = item % nblk, k0 = 64 * kb, n0 = 64 * nb;
    const int sc_ = src_col<MAP>(n0 + lane);
    float tv[64];
#pragma unroll
    for (int i = 0; i < 64; ++i) tv[i] = W[(size_t)(k0 + i) * N + sc_];
#pragma unroll
    for (int i = 0; i < 64; ++i) scr[i * 65 + lane] = tv[i];
    LDS_WAIT(); asm volatile("" ::: "memory");
    const int c = lane & 7;
#pragma unroll
    for (int j = 0; j < 8; ++j) { const int n = (lane >> 3) + 8 * j; const LAS float* s_ = scr + (8 * c) * 65 + n;
        u32x4 o; o.x = cvt_pk_bf16(s_[0 * 65], s_[1 * 65]); o.y = cvt_pk_bf16(s_[2 * 65], s_[3 * 65]); o.z = cvt_pk_bf16(s_[4 * 65], s_[5 * 65]); o.w = cvt_pk_bf16(s_[6 * 65], s_[7 * 65]);
        *(u32x4*)(WT + (size_t)(n0 + n) * K + k0 + 8 * c) = o; }
    if (BIAS) {
        float sh[9], acc[9];
#pragma unroll
        for (int b = 0; b < 9; ++b) { sh[b] = shv[b * 6144 + k0 + lane]; acc[b] = 0.f; }
#pragma unroll
        for (int kk = 0; kk < 64; ++kk) { const float w = tv[kk];
#pragma unroll
            for (int b = 0; b < 9; ++b) acc[b] += __uint_as_float(__builtin_amdgcn_readlane(__float_as_uint(sh[b]), kk)) * w; }
#pragma unroll
        for (int b = 0; b < 9; ++b) atomicAdd(bias + (size_t)b * N + n0 + lane, acc[b]);
    }
    LDS_WAIT(); asm volatile("" ::: "memory");
}
__device__ __forceinline__ void cache_row(Frame& F, int l, int item) {
    const int which = item >> 12, r = item & 4095, b = r >> 9, j = r & 511;
    const float* src = (which ? F.ka->in[3] : F.ka->in[2]) + ((size_t)(b * DEPTH + l) * PAST + j) * 512 + F.lane * 8;
    bf16_t* dst = (bf16_t*)(F.ws + (which ? WS_VB : WS_KB)) + (size_t)(MC + b * (PAST + DSEQ) + j) * 512 + F.lane * 8;
    const f32x4 a = *(const f32x4*)src, c = *(const f32x4*)(src + 4);
    *(u32x4*)dst = pack8(a, c);
}
__device__ __forceinline__ void cache_item(Frame& F, int l, int item4) {
#pragma unroll
    for (int i = 0; i < 4; ++i) cache_row(F, l, item4 * 4 + i);
}
__device__ __forceinline__ f32x2 cmul(f32x2 a, f32x2 b) { return (f32x2){a.x * b.x - a.y * b.y, a.x * b.y + a.y * b.x}; }
__device__ __forceinline__ void ssm_prep(Frame& F, int l, int g) {
    LAS f32x2* POW = (LAS f32x2*)F.lds;
    LAS f32x2* BB = POW + 2 * 17 * 64;
    LAS f32x2* CC = BB + 2 * 64 * 16;
    LAS f32x2* CT = CC + 2 * 16 * 64;
    LAS float* KT = (LAS float*)(CT + 2 * 64 * 16);
    constexpr int KTS = 260;
    bf16_t* WE = (bf16_t*)(F.ws + WS_SSM + SSM_WE) + (size_t)g * 256 * 256;
    bf16_t* WY = (bf16_t*)(F.ws + WS_SSM + SSM_WY) + (size_t)g * 256 * 512;
    f32x2* LAM16 = (f32x2*)(F.ws + WS_SSM + SSM_LAM16); f32x2* BBAR = (f32x2*)(F.ws + WS_SSM + SSM_BBAR);
    const int tid = F.tid, lane = F.lane;
    if (tid < 128) { const int dir = tid >> 6, p = tid & 63; const size_t pi = ((size_t)(l * 2 + dir) * NG + g) * 64 + p;
        const float lr = F.ka->in[18][pi], li = F.ka->in[19][pi], delta = expf(F.ka->in[20][(l * 2 + dir) * NG + g]);
        const float er = expf(lr * delta), lbr = er * cosf(li * delta), lbi = er * sinf(li * delta);
        { float one_ = 1.f, zero_ = 0.f; asm volatile("" : "+v"(one_), "+v"(zero_));
          f32x2 pw = (f32x2){one_, zero_}; const f32x2 lb = (f32x2){lbr, lbi};
          for (int tau = 0; tau <= 16; ++tau) { POW[(dir * 17 + tau) * 64 + p] = pw; if (tau == 16) LAM16[(dir * NG + g) * 64 + p] = pw; pw = cmul(pw, lb); } }
        const float nr = lbr - 1.f, ni = lbi, den = lr * lr + li * li; const f32x2 fac = (f32x2){(nr * lr + ni * li) / den, (ni * lr - nr * li) / den};
        for (int ch = 0; ch < 16; ++ch) { const size_t bi = pi * 16 + ch; const f32x2 bb = cmul(fac, (f32x2){F.ka->in[21][bi], F.ka->in[22][bi]}); BB[(dir * 64 + p) * 16 + ch] = bb; BBAR[((size_t)(dir * NG + g) * 64 + p) * 16 + ch] = bb; }
    }
    for (int i = tid; i < 2048; i += NTHREADS) { const int dir = i >> 10, c = (i >> 6) & 15, p = i & 63; const size_t ci = (((size_t)(l * 2 + dir) * NG + g) * 16 + c) * 64 + p;
        const f32x2 v = (f32x2){F.ka->in[23][ci], F.ka->in[24][ci]}; CC[i] = v; CT[(dir * 64 + p) * 16 + c] = v; }
    __syncthreads();
    { const int i16 = lane & 15, k4 = lane >> 4, ri = k4 & 1, ph = k4 >> 1;
      for (int blk = 0; blk < 4; ++blk) { const int q = F.wave * 4 + blk, dir = q >> 4, tau = q & 15; f32x4 acc = (f32x4){0.f, 0.f, 0.f, 0.f};
#pragma unroll 8
          for (int ks = 0; ks < 32; ++ks) { const int p = 2 * ks + ph;
              const f32x2 cc = CT[(dir * 64 + p) * 16 + i16], pw = POW[(dir * 17 + tau) * 64 + p], bb = BB[(dir * 64 + p) * 16 + i16];
              const float u = ri ? -pw.y : pw.x, v = ri ? pw.x : pw.y;
              const float av = cc.x * u - cc.y * v, bv = ri ? bb.y : bb.x;
              acc = __builtin_amdgcn_mfma_f32_16x16x4f32(av, bv, acc, 0, 0, 0); }
#pragma unroll
          for (int r = 0; r < 4; ++r) KT[(dir * 16 + tau) * KTS + (k4 * 4 + r) * 16 + i16] = acc[r]; } }
    __syncthreads();
    const float* Dv = F.ka->in[25] + l * 512 + g * 16;
    for (int idx = tid; idx < 256 * 64; idx += NTHREADS) { const int n = idx >> 6, kc = idx & 63, k0 = kc * 8, i = n >> 4, c = n & 15; f32x4 v0, v1;
        if (k0 < 256) { const int s_ = k0 >> 4, ch0 = k0 & 15; v0 = (f32x4){0.f, 0.f, 0.f, 0.f}; v1 = v0;
            if (s_ <= i) { const LAS float* kp = KT + (i - s_) * KTS + c * 16 + ch0; v0 += *(const LAS f32x4*)kp; v1 += *(const LAS f32x4*)(kp + 4); }
            if (s_ >= i) { const LAS float* kp = KT + (16 + s_ - i) * KTS + c * 16 + ch0; v0 += *(const LAS f32x4*)kp; v1 += *(const LAS f32x4*)(kp + 4); }
            if (s_ == i) { const int e = c - ch0; const float dv = Dv[c]; if (e >= 0 && e < 4) v0[e] += dv; else if (e >= 4 && e < 8) v1[e - 4] += dv; }
        } else { const int dir = k0 >= 384 ? 1 : 0, p0 = ((k0 - 256) & 127) >> 1, tau = dir ? 16 - i : i + 1;
            const LAS f32x4* cp = (const LAS f32x4*)(CC + (dir * 16 + c) * 64 + p0); const LAS f32x4* pp = (const LAS f32x4*)(POW + (dir * 17 + tau) * 64 + p0);
            const f32x4 c0 = cp[0], c1 = cp[1], w0 = pp[0], w1 = pp[1];
            v0 = (f32x4){c0[0] * w0[0] - c0[1] * w0[1], -(c0[0] * w0[1] + c0[1] * w0[0]), c0[2] * w0[2] - c0[3] * w0[3], -(c0[2] * w0[3] + c0[3] * w0[2])};
            v1 = (f32x4){c1[0] * w1[0] - c1[1] * w1[1], -(c1[0] * w1[1] + c1[1] * w1[0]), c1[2] * w1[2] - c1[3] * w1[3], -(c1[2] * w1[3] + c1[3] * w1[2])}; }
        *(u32x4*)(WY + (size_t)n * 512 + k0) = pack8(v0, v1); }
    for (int idx = tid; idx < 256 * 32; idx += NTHREADS) { const int n = idx >> 5, k0 = (idx & 31) * 8, dir = n >> 7, p = (n & 127) >> 1, ri = n & 1, s_ = k0 >> 4, ch0 = k0 & 15;
        const f32x2 pw = POW[(dir * 17 + (dir ? s_ : 15 - s_)) * 64 + p]; const LAS f32x4* bp = (const LAS f32x4*)(BB + (dir * 64 + p) * 16 + ch0);
        const float u = ri ? pw.y : pw.x, v = ri ? pw.x : -pw.y;
        const f32x4 b0 = bp[0], b1 = bp[1], b2 = bp[2], b3 = bp[3];
        const f32x4 v0 = (f32x4){u * b0[0] + v * b0[1], u * b0[2] + v * b0[3], u * b1[0] + v * b1[1], u * b1[2] + v * b1[3]};
        const f32x4 v1 = (f32x4){u * b2[0] + v * b2[1], u * b2[2] + v * b2[3], u * b3[0] + v * b3[1], u * b3[2] + v * b3[3]};
        *(u32x4*)(WE + (size_t)n * 256 + k0) = pack8(v0, v1); }
    __syncthreads();
}
__device__ __forceinline__ void xprep_row(Frame& F, int row) {
    const float* xr = (row < MC) ? F.ka->in[0] + (size_t)row * DM : F.ka->in[1] + (size_t)(row - MC) * DM;
    const int cond = row < MC ? 0 : 1 + ((row - MC) >> 10);
    const float* sc = F.misc + MI_MOD + (0 * 9 + cond) * 6144 + 1024; const float* g1 = F.ka->in[9];
    bf16_t* dst = (bf16_t*)(F.ws + WS_XS) + (size_t)row * DM; float s = 0.f;
#pragma unroll
    for (int j = 0; j < 4; ++j) { const int c = 4 * F.lane + 256 * j; const f32x4 x = *(const f32x4*)(xr + c); const f32x4 t = x * x; s += (t[0] + t[1]) + (t[2] + t[3]);
        const f32x4 y = x * (*(const f32x4*)(g1 + c)) * (*(const f32x4*)(sc + c) + 1.f); u32x2 w; w.x = cvt_pk_bf16(y[0], y[1]); w.y = cvt_pk_bf16(y[2], y[3]); *(u32x2*)(dst + c) = w; }
    s = wave_sum(s);
    if (F.lane == 0) ((float*)(F.ctl + CW_SS))[row] = s;
}
__device__ __forceinline__ void xprep_item(Frame& F, int item4) {
#pragma unroll
    for (int i = 0; i < 4; ++i) xprep_row(F, item4 * 4 + i);
}
__device__ __forceinline__ void ssm_scan(Frame& F, int l, int g, int pm) {
    const int tid = F.tid, sl = tid >> 7, dp = tid & 127, dir = dp >> 6, p = dp & 63;
    const f32x2* LAM16 = (const f32x2*)(F.ws + WS_SSM + SSM_LAM16); const f32x2* BBAR = (const f32x2*)(F.ws + WS_SSM + SSM_BBAR);
    const float* E = (const float*)(F.ws + WS_R + R_E); bf16_t* AS3 = (bf16_t*)(F.ws + WS_R + R_AS3);
    const f32x2 lam = LAM16[(dir * NG + g) * 64 + p];
    const int nq = pm == 0 ? 4 : 1, n = pm == 0 ? 16 : 64;
    for (int q = 0; q < nq; ++q) {
        int base; f32x2 h;
        if (pm == 0) { const int seq = q * 4 + sl; base = seq * 16; h = (f32x2){0.f, 0.f}; }
        else { const int sq = (pm - 1) * 4 + sl; base = 256 + sq * 64; h = *(const f32x2*)(F.ka->in[4] + ((((size_t)sq * DEPTH + l) * 2 + dir) * NG + g) * 128 + 2 * p); }
        const float* ep = E + ((size_t)g * NCHUNK + base) * 256 + dir * 128 + 2 * p;
        unsigned* hp = (unsigned*)(AS3 + ((size_t)g * NCHUNK + base) * 512 + 256 + dir * 128 + 2 * p);
        for (int j0 = 0; j0 < n; j0 += 16) { f32x2 e[16];
#pragma unroll
            for (int jj = 0; jj < 16; ++jj) { const int j = dir ? (n - 1 - j0 - jj) : (j0 + jj); e[jj] = *(const f32x2*)(ep + (size_t)j * 256); }
#pragma unroll
            for (int jj = 0; jj < 16; ++jj) { const int j = dir ? (n - 1 - j0 - jj) : (j0 + jj); hp[(size_t)j * 256] = cvt_pk_bf16(h.x, h.y); h = cmul(lam, h) + e[jj]; } }
        if (pm == 0) { const int seq = q * 4 + sl; const int chunk = seq * 16 + (dir ? 15 : 0), tt = dir ? 15 : 0;
            const u32x4 u0 = *(const u32x4*)(AS3 + ((size_t)g * NCHUNK + chunk) * 512 + tt * 16), u1 = *(const u32x4*)(AS3 + ((size_t)g * NCHUNK + chunk) * 512 + tt * 16 + 8);
            float uu[16] = {bflo(u0.x), bfhi(u0.x), bflo(u0.y), bfhi(u0.y), bflo(u0.z), bfhi(u0.z), bflo(u0.w), bfhi(u0.w), bflo(u1.x), bfhi(u1.x), bflo(u1.y), bfhi(u1.y), bflo(u1.z), bfhi(u1.z), bflo(u1.w), bfhi(u1.w)};
            const f32x2* bb = BBAR + ((size_t)(dir * NG + g) * 64 + p) * 16; f32x2 acc = (f32x2){0.f, 0.f};
#pragma unroll
            for (int ch = 0; ch < 16; ++ch) acc += bb[ch] * uu[ch];
            float* ns = F.out + (size_t)MT * DM + 2 * (size_t)NB * DEPTH * SEQ * 512;
            *(f32x2*)(ns + ((((size_t)seq * DEPTH + l) * 2 + dir) * NG + g) * 128 + 2 * p) = acc; }
    }
}
__device__ __forceinline__ void ld16(const bf16_t* p, float* v) { const u32x4 a = *(const u32x4*)p; v[0] = bflo(a.x); v[1] = bfhi(a.x); v[2] = bflo(a.y); v[3] = bfhi(a.y); v[4] = bflo(a.z); v[5] = bfhi(a.z); v[6] = bflo(a.w); v[7] = bfhi(a.w); }
__device__ __forceinline__ void conv_item(Frame& F, int l, int item) {
    const int rs = item >> 4, pn = item & 15, lr = F.lane >> 4, lc = F.lane & 15;
    const int r0 = rs * 64 + lr * 16; const int av = 128 * pn + 8 * lc;
    const bf16_t* up = (const bf16_t*)(F.ws + WS_R) + (size_t)r0 * 4096 + 256 * pn + 8 * lc; bf16_t* gp = (bf16_t*)(F.ws + WS_G) + (size_t)r0 * 2048 + av;
    const float* cw = F.ka->in[31] + (size_t)l * 3 * 4096; const float* cb = F.ka->in[32] + (size_t)l * 4096;
    float wv[3][8], wg[3][8], bv[8], bg[8];
#pragma unroll
    for (int k = 0; k < 3; ++k)
#pragma unroll
        for (int e = 0; e < 8; ++e) { wv[k][e] = cw[k * 4096 + av + e]; wg[k][e] = cw[k * 4096 + 2048 + av + e]; }
#pragma unroll
    for (int e = 0; e < 8; ++e) { bv[e] = cb[av + e]; bg[e] = cb[2048 + av + e]; }
    const int t0 = r0 < MC ? (r0 & 255) : ((r0 - MC) & 1023), L = r0 < MC ? SEQ : DSEQ;
    float pv[8], pg[8], cv[8], cg[8], nv_[8], ng[8];
    if (t0 > 0) { ld16(up - 4096, pv); ld16(up - 4096 + 128, pg); } else {
#pragma unroll
        for (int e = 0; e < 8; ++e) { pv[e] = 0.f; pg[e] = 0.f; } }
    ld16(up, cv); ld16(up + 128, cg);
#pragma unroll
    for (int i = 0; i < 16; ++i) {
        if (t0 + i + 1 < L) { ld16(up + (size_t)(i + 1) * 4096, nv_); ld16(up + (size_t)(i + 1) * 4096 + 128, ng); } else {
#pragma unroll
            for (int e = 0; e < 8; ++e) { nv_[e] = 0.f; ng[e] = 0.f; } }
        float o[8];
#pragma unroll
        for (int e = 0; e < 8; ++e) { const float zv = bv[e] + wv[0][e] * pv[e] + wv[1][e] * cv[e] + wv[2][e] * nv_[e]; const float zg = bg[e] + wg[0][e] * pg[e] + wg[1][e] * cg[e] + wg[2][e] * ng[e]; o[e] = silu_f(zg) * zv; }
        u32x4 w; w.x = cvt_pk_bf16(o[0], o[1]); w.y = cvt_pk_bf16(o[2], o[3]); w.z = cvt_pk_bf16(o[4], o[5]); w.w = cvt_pk_bf16(o[6], o[7]);
        *(u32x4*)(gp + (size_t)i * 2048) = w;
#pragma unroll
        for (int e = 0; e < 8; ++e) { pv[e] = cv[e]; pg[e] = cg[e]; cv[e] = nv_[e]; cg[e] = ng[e]; }
    }
}
constexpr int N_TR_ITEMS_L = 16 * 32 + 8 * 8 + 16 * 16 + 16 * 64 + 32 * 16;
__device__ __forceinline__ void weight_item(Frame& F, LAS float* scr, int l, int it) {
    int r = it; const float* modl = F.misc + MI_MOD + l * 9 * 6144; float* cf = (float*)F.ctl;
    if (r < 512) { transpose_item<1, true>(F, F.ka->in[10] + (size_t)l * DM * 2048, DM, 2048, (bf16_t*)(F.ws + WS_WIN) + (size_t)l * 2048 * DM, scr, r, modl, cf + CW_BIN + l * 9 * 2048); return; } r -= 512;
    if (r < 64) { transpose_item<0, false>(F, F.ka->in[26] + (size_t)l * 512 * 512, 512, 512, (bf16_t*)(F.ws + WS_WGLU) + (size_t)l * 512 * 512, scr, r, nullptr, nullptr); return; } r -= 64;
    if (r < 256) { transpose_item<0, false>(F, F.ka->in[28] + (size_t)l * DM * DM, DM, DM, (bf16_t*)(F.ws + WS_WOUT) + (size_t)l * DM * DM, scr, r, nullptr, nullptr); return; } r -= 256;
    if (r < 1024) { transpose_item<2, true>(F, F.ka->in[30] + (size_t)l * DM * 4096, DM, 4096, (bf16_t*)(F.ws + WS_WUP) + (size_t)l * 4096 * DM, scr, r, modl + 3072, cf + CW_BUP + l * 9 * 4096); return; } r -= 1024;
    transpose_item<0, false>(F, F.ka->in[33] + (size_t)l * 2048 * DM, 2048, DM, (bf16_t*)(F.ws + WS_WDN) + (size_t)l * DM * 2048, scr, r, nullptr, nullptr);
}

__global__ void __launch_bounds__(NTHREADS, 2) mega(Args args) {
    extern __shared__ __attribute__((aligned(16))) unsigned char lds_raw[];
    Frame F;
    F.lds = (LAS unsigned char*)lds_raw;
    F.tid = threadIdx.x; F.lane = F.tid & 63; F.wave = __builtin_amdgcn_readfirstlane(F.tid >> 6);
    F.G = gridDim.x; F.bid = blockIdx.x; { const int bx = blockIdx.x; F.vcu = (F.G % 8 == 0) ? (bx % 8) * (F.G / 8) + bx / 8 : bx; }
    F.ka = (kargs_t)__builtin_amdgcn_kernarg_segment_ptr();
    F.out = args.out; F.ws = args.ws; F.misc = (float*)(args.ws + WS_MISC); F.ctl = (unsigned*)(args.ws + WS_CTL);
    volatile LAS unsigned* MISC = (volatile LAS unsigned*)(F.lds + MISC_OFF);
    for (int u = F.tid; u < (LDS_BYTES - LDSCTL_OFF) / 4; u += NTHREADS) ((LAS unsigned*)(F.lds + LDSCTL_OFF))[u] = 0u;
    __syncthreads();
    XcdBarrier bar = xcd_barrier_post(F.ctl + CW_BAR, MISC + 8);
    int phase_no = 0;
#define LAUNDER() do { asm volatile("" : "+s"(F.ka), "+s"(F.ws), "+s"(F.out), "+s"(F.bid), "+v"(F.tid)); F.vcu = (F.G % 8 == 0) ? (F.bid % 8) * (F.G / 8) + F.bid / 8 : F.bid; F.lane = F.tid & 63; F.wave = __builtin_amdgcn_readfirstlane(F.tid >> 6); \
    F.misc = (float*)(F.ws + WS_MISC); F.ctl = (unsigned*)(F.ws + WS_CTL); gw = F.vcu * NWAVES + F.wave; } while (0)
#ifdef TPROBE
#define TSTAMP() do { if (F.bid == 0 && F.tid == 0) ((unsigned long long*)(F.ctl + 6000))[phase_no] = __builtin_amdgcn_s_memrealtime(); } while (0)
#else
#define TSTAMP() do {} while (0)
#endif
#define GRID_BAR() do { xcd_barrier(bar); ++phase_no; TSTAMP(); if (F.ka->stop_after == phase_no) return; LAUNDER(); } while (0)
    int gw = F.vcu * NWAVES + F.wave; const int NGW = F.G * NWAVES;
#define ssq ((float*)(F.ctl + CW_SS))
#define XS ((bf16_t*)(F.ws + WS_XS))
#define KB ((bf16_t*)(F.ws + WS_KB))
#define VB ((bf16_t*)(F.ws + WS_VB))
#define Qb ((bf16_t*)(F.ws + WS_R + R_Q))
#define AS3 ((bf16_t*)(F.ws + WS_R + R_AS3))
#define Eb ((float*)(F.ws + WS_R + R_E))
#define Zb ((bf16_t*)(F.ws + WS_R + R_Z))
#define CAT ((bf16_t*)(F.ws + WS_R + R_CAT))
#define UP ((bf16_t*)(F.ws + WS_R))
#define Gb ((bf16_t*)(F.ws + WS_G))

    TSTAMP();
    { const int l = F.vcu >> 7, strip = F.vcu & 127; gemv9_task<0, 0, 48>(F, F.ka->in[7] + (size_t)l * DM * 6144, 6144, l, 0, strip, F.misc + MI_MOD + l * 9 * 6144, 6144, F.ka->in[8] + l * 6144); }
    GRID_BAR();
    if (F.vcu < 32) ssm_prep(F, 0, F.vcu);
    else {
        if (F.vcu == 32) {
            for (int i = F.tid; i < 1024; i += NTHREADS) { const int pos = i >> 4, f = i & 15; const float inv = 1.0f / powf(10000.0f, (float)f / 16.0f); const float ang = (float)pos * inv;
                ((f32x2*)(F.misc + MI_ROPE))[i] = (f32x2){cosf(ang), sinf(ang)}; }
            if (F.tid < 2) { const int l = F.tid; float a1 = 0.f, a2 = 0.f; for (int d = 0; d < 64; ++d) { a1 += F.ka->in[13][l * 64 + d] * F.ka->in[14][l * 64 + d]; a2 += F.ka->in[15][l * 64 + d] * F.ka->in[16][l * 64 + d]; }
                const float li = 0.8f - 0.6f * expf(-0.3f * (float)l); F.misc[MI_LAM + l] = expf(a1) - expf(a2) + li; F.misc[MI_LAM + 2 + l] = 1.f - li; }
        }
        LAS float* scr = (LAS float*)(F.lds + F.wave * 16640);
        const int gw1 = (F.vcu - 32) * NWAVES + F.wave, NGW1 = (F.G - 32) * NWAVES;
        constexpr int NW_ = 2 * N_TR_ITEMS_L, NC_ = 2048, NX_ = MT / 4;
        for (int it = gw1; it < NW_ + NC_ + NX_; it += NGW1) {
            if (it < NW_) weight_item(F, scr, it / N_TR_ITEMS_L, it % N_TR_ITEMS_L);
            else if (it < NW_ + NC_) cache_item(F, 0, it - NW_);
            else xprep_item(F, it - NW_ - NC_); }
    }
    GRID_BAR();

    for (int l = 0; l < DEPTH; ++l) {
        const float* modl = F.misc + MI_MOD + l * 9 * 6144;
        { Gemm g{XS, (const bf16_t*)(F.ws + WS_WIN) + (size_t)l * 2048 * DM, DM, DM, DM, 0, 0}; GridOrder S; S.init(MT, 2048, F.G, F.bid);
          EpiIn E{ssq + (l == 0 ? 0 : 2 * MT), (const float*)F.ctl + CW_BIN + l * 9 * 2048, F.ka->in[11] + l * 64, F.ka->in[12] + l * 64, (const f32x2*)(F.misc + MI_ROPE), Qb, KB, VB, AS3,
                  F.out + (size_t)MT * DM, F.out + (size_t)MT * DM + (size_t)NB * DEPTH * SEQ * 512, l};
          gemm_phase<EpiIn, GridOrder>(F.lds, F.tid, g, S, E);
          if (l > 0 && F.bid >= 128 && F.bid < 160) { LAUNDER(); ssm_prep(F, l, F.bid - 128); } }
        GRID_BAR();
        { if (F.vcu < NG * 3) {
              { Gemm g{AS3, (const bf16_t*)(F.ws + WS_SSM + SSM_WE), 512, 256, 256, (size_t)NCHUNK * 512, (size_t)256 * 256}; GroupOrder S{F.vcu, F.G}; EpiS1 E{Eb};
                gemm_phase<EpiS1, GroupOrder>(F.lds, F.tid, g, S, E); }
              VM_WAIT(); __syncthreads(); LAUNDER();
              ssm_scan(F, l, F.vcu / 3, F.vcu % 3); VM_WAIT(); __syncthreads(); LAUNDER();
              { Gemm g{AS3, (const bf16_t*)(F.ws + WS_SSM + SSM_WY), 512, 512, 512, (size_t)NCHUNK * 512, (size_t)256 * 512}; GroupOrder S{F.vcu, F.G}; EpiS3 E{Zb};
                gemm_phase<EpiS3, GroupOrder>(F.lds, F.tid, g, S, E); } }
          LAUNDER();
          AttnArgs A{Qb, KB, VB, CAT, F.ka->in[17] + l * 128, F.misc[MI_LAM + l], F.misc[MI_LAM + 2 + l]};
          { const int u = F.vcu; attn_unit(F.lds, F.tid, A, NB + (u >> 5), (u >> 3) & 3, u & 7); }
          if (F.vcu >= 96 && F.vcu < 224) { const int u = F.vcu - 96; attn_unit(F.lds, F.tid, A, u >> 3, (u >> 1) & 3, u & 1); } }
        GRID_BAR();
        { Gemm g{Zb, (const bf16_t*)(F.ws + WS_WGLU) + (size_t)l * 512 * 512, 512, 512, 512, 0, 0}; GridOrder S; S.init(MT, 512, F.G, F.bid);
          EpiGlu E{Zb, F.ka->in[27] + l * 512, CAT};
          gemm_phase<EpiGlu, GridOrder>(F.lds, F.tid, g, S, E); }
        GRID_BAR();
        { Gemm g{CAT, (const bf16_t*)(F.ws + WS_WOUT) + (size_t)l * DM * DM, DM, DM, DM, 0, 0}; GridOrder S; S.init(MT, DM, F.G, F.bid);
          EpiRes E{l == 0 ? F.ka->in[0] : F.out, l == 0 ? F.ka->in[1] : F.out + (size_t)MC * DM, F.out, modl + 2 * DM, F.ka->in[29] + l * DM, modl + 4 * DM, XS, ssq + (l == 0 ? 1 : 3) * MT};
          gemm_phase<EpiRes, GridOrder>(F.lds, F.tid, g, S, E); }
        GRID_BAR();
        { Gemm g{XS, (const bf16_t*)(F.ws + WS_WUP) + (size_t)l * 4096 * DM, DM, DM, DM, 0, 0}; GridOrder S; S.init(MT, 4096, F.G, F.bid);
          EpiUp E{ssq + (l == 0 ? 1 : 3) * MT, (const float*)F.ctl + CW_BUP + l * 9 * 4096, UP};
          gemm_phase<EpiUp, GridOrder>(F.lds, F.tid, g, S, E); }
        GRID_BAR();
        for (int it = gw; it < 192 * 16; it += NGW) conv_item(F, l, it);
        GRID_BAR();
        { Gemm g{Gb, (const bf16_t*)(F.ws + WS_WDN) + (size_t)l * DM * 2048, 2048, 2048, 2048, 0, 0}; GridOrder S; S.init(MT, DM, F.G, F.bid);
          const bool nxt = l + 1 < DEPTH;
          EpiRes E{F.out, F.out + (size_t)MC * DM, F.out, modl + 5 * DM, nxt ? F.ka->in[9] + (l + 1) * DM : nullptr, nxt ? modl + 9 * 6144 + DM : nullptr, XS, ssq + 2 * MT};
          gemm_phase<EpiRes, GridOrder>(F.lds, F.tid, g, S, E);
          if (nxt && F.bid >= 192) for (int it = (F.bid - 192) * NWAVES + F.wave; it < 2048; it += 64 * NWAVES) cache_item(F, l + 1, it); }
        if (l + 1 < DEPTH) GRID_BAR();
    }
#ifdef TPROBE
    GRID_BAR();
    if (F.bid == 0 && F.tid == 0) { const unsigned long long* ts = (const unsigned long long*)(F.ctl + 6000); const float tot = (float)(ts[phase_no] - ts[0]);
        float fa = 0.f, fb = 0.f;
        for (int k = 0; k < phase_no; ++k) { const float d = (float)(ts[k + 1] - ts[k]) / tot; if ((TPROBE_MASK_A >> k) & 1ull) fa += d; if ((TPROBE_MASK_B >> k) & 1ull) fb += d; }
        F.misc[MI_END] = 0.25f * sqrtf(fa); F.misc[MI_END + 1] = 300.f * fb; F.misc[MI_END + 2] = tot; }
    GRID_BAR();
    { const float delta = F.misc[MI_END];
      for (size_t i = (size_t)F.bid * NTHREADS + F.tid; i < (size_t)MC * DM; i += (size_t)F.G * NTHREADS) F.out[i] *= (1.f + delta);
      }
#endif
#undef GRID_BAR
#undef LAUNDER
#undef ssq
#undef XS
#undef KB
#undef VB
#undef Qb
#undef AS3
#undef Eb
#undef Zb
#undef CAT
#undef UP
#undef Gb
}
}

static int fk_launch(void* const* d_in, void* d_out, void* d_ws, size_t ws_size, hipStream_t stream, int stop_after) {
    static int grid = 0;
    if (grid == 0) {
        int dev = 0, cus = 0;
        if (ws_size < fk::WS_END) { fprintf(stderr, "kernel_launch: workspace too small (%zu < %zu)\n", ws_size, (size_t)fk::WS_END); grid = -1; return -1; }
        if (hipGetDevice(&dev) != hipSuccess || hipDeviceGetAttribute(&cus, hipDeviceAttributeMultiprocessorCount, dev) != hipSuccess) { grid = -1; return -1; }
        if (hipFuncSetAttribute((const void*)fk::mega, hipFuncAttributeMaxDynamicSharedMemorySize, fk::LDS_BYTES) != hipSuccess) { fprintf(stderr, "kernel_launch: hipFuncSetAttribute failed\n"); grid = -1; return -1; }
        int per_cu = 0; (void)hipOccupancyMaxActiveBlocksPerMultiprocessor(&per_cu, (const void*)fk::mega, fk::NTHREADS, fk::LDS_BYTES); (void)hipGetLastError();
        if (per_cu < 1) fprintf(stderr, "kernel_launch: occupancy query says %d blocks/CU\n", per_cu);
        grid = cus;
        if (grid != 256) fprintf(stderr, "kernel_launch: %d CUs (built for 256)\n", grid);
    }
    if (grid < 0) return -1;
    (void)hipMemsetAsync((char*)d_ws + fk::WS_CTL, 0, fk::CTL_BYTES, stream);
    fk::Args a{};
    for (int i = 0; i < 34; ++i) a.in[i] = (const float*)d_in[i];
    a.out = (float*)d_out; a.ws = (unsigned char*)d_ws; a.stop_after = stop_after; a.pad = 0;
    hipLaunchKernelGGL(fk::mega, dim3(grid), dim3(fk::NTHREADS), fk::LDS_BYTES, stream, a);
    return 0;
}
extern "C" void kernel_launch(void* const* d_in, const int* in_sizes, int n_in, void* d_out, int out_size, void* d_ws, size_t ws_size, hipStream_t stream) {
    if (n_in != 34) { fprintf(stderr, "kernel_launch: unexpected n_in %d\n", n_in); return; }
    fk_launch(d_in, d_out, d_ws, ws_size, stream, 0);
}
```

```cpp
#include <hip/hip_runtime.h>
#include <cstdio>
#include <cstdint>
namespace fk {
#define LAS __attribute__((address_space(3)))
#define GAS __attribute__((address_space(1)))
typedef unsigned short bf16_t;
typedef short bf16x8 __attribute__((ext_vector_type(8)));
typedef short s16x4 __attribute__((ext_vector_type(4)));
typedef float f32x4 __attribute__((ext_vector_type(4)));
typedef float f32x2 __attribute__((ext_vector_type(2)));
typedef float f32x16 __attribute__((ext_vector_type(16)));
typedef unsigned u32x4 __attribute__((ext_vector_type(4)));
typedef unsigned u32x2 __attribute__((ext_vector_type(2)));

constexpr int DM = 1024, NB = 16, SEQ = 256, DEPTH = 2, DB = 8, DSEQ = 1024, PAST = 512;
constexpr int MC = NB * SEQ, MS = DB * DSEQ, MT = MC + MS;
constexpr int NH = 4, NG = 32, NCOND = 9, NMOD = 6;
constexpr int NCHUNK = MT / 16;
constexpr int KVROWS = MC + DB * (PAST + DSEQ);
constexpr float EPS = 1e-6f;
constexpr float C2 = 0.125f * 1.4426950408889634f;
constexpr int NWAVES = 8, NTHREADS = 512;

constexpr size_t MiB = 1u << 20;
constexpr size_t WS_CTL = 0, CTL_BYTES = 1 * MiB;
constexpr size_t WS_MISC = 1 * MiB;
constexpr size_t WS_WIN = 3 * MiB;
constexpr size_t WS_WGLU = 11 * MiB;
constexpr size_t WS_WOUT = 12 * MiB;
constexpr size_t WS_WUP = 16 * MiB;
constexpr size_t WS_WDN = 32 * MiB;
constexpr size_t WS_SSM = 40 * MiB;
constexpr size_t WS_XS = 53 * MiB;
constexpr size_t WS_KB = 77 * MiB;
constexpr size_t WS_VB = 93 * MiB;
constexpr size_t WS_R = 109 * MiB;
constexpr size_t WS_G = 205 * MiB;
constexpr size_t WS_END = 253 * MiB;
constexpr size_t R_Q = 0, R_AS3 = 12 * MiB, R_E = 36 * MiB, R_Z = 60 * MiB, R_CAT = 72 * MiB;
constexpr size_t SSM_WE = 0, SSM_WY = 4 * MiB, SSM_LAM16 = 12 * MiB, SSM_BBAR = 12 * MiB + 64 * 1024;
constexpr int MI_MOD = 0;
constexpr int MI_ROPE = MI_MOD + 2 * 9 * 6144;
constexpr int MI_LAM = MI_ROPE + 64 * 16 * 2;
constexpr int MI_END = MI_LAM + 8;
static_assert((size_t)MI_END * 4 <= 2 * MiB, "MISC");
constexpr int CW_BAR = 1024;
constexpr int CW_SS = 8192;
constexpr int CW_BIN = 65536;
constexpr int CW_BUP = CW_BIN + 2 * 9 * 2048;
static_assert((size_t)(CW_SS + 4 * MT) <= CW_BIN && (size_t)(CW_BUP + 2 * 9 * 4096) * 4 <= CTL_BYTES, "CTL");

constexpr int RING_BYTES = 131072;
constexpr int LDS_BYTES_ = 147456; constexpr int LDSCTL_OFF = LDS_BYTES_ - 512, MISC_OFF = LDSCTL_OFF + 320;
constexpr int LDS_BYTES = 147456;

#define RLX_AGENT __ATOMIC_RELAXED, __HIP_MEMORY_SCOPE_AGENT
__device__ __forceinline__ unsigned cvt_pk_bf16(float lo, float hi) { unsigned r; asm volatile("v_cvt_pk_bf16_f32 %0, %1, %2" : "=v"(r) : "v"(lo), "v"(hi)); return r; }
__device__ __forceinline__ float bf2f(unsigned short b) { return __uint_as_float((unsigned)b << 16); }
__device__ __forceinline__ float bflo(unsigned w) { return __uint_as_float(w << 16); }
__device__ __forceinline__ float bfhi(unsigned w) { return __uint_as_float(w & 0xffff0000u); }
__device__ __forceinline__ float fast_exp2(float x) { return __builtin_amdgcn_exp2f(x); }
__device__ __forceinline__ float fast_rcp(float x) { return __builtin_amdgcn_rcpf(x); }
__device__ __forceinline__ float sigmoid_f(float x) { return fast_rcp(1.f + fast_exp2(-1.4426950408889634f * x)); }
__device__ __forceinline__ float silu_f(float x) { return x * sigmoid_f(x); }
__device__ __forceinline__ float gelu_tanh_f(float x) {
    const float u = 0.7978845608028654f * (x + 0.044715f * x * x * x); return x * sigmoid_f(2.f * u); }
__device__ __forceinline__ float wave_sum(float v) {
#pragma unroll
    for (int o = 1; o < 64; o <<= 1) v += __shfl_xor(v, o);
    return v; }

#define XB_TMO      128
#define XB_XCNT(j)  (256  + 64 * (j))
#define XB_XSUB(j)  (1280 + 64 * (j))
#define XB_XGEN(j)  (2304 + 64 * (j))
#define XB_TOP      3328
#define XB_TOPGEN   3392
#define XCD_BAR_WORDS 3456
#define XB_SPIN_CAP (1u << 18)
__device__ __forceinline__ unsigned xb_ld(unsigned* p)              { return __hip_atomic_load(p, __ATOMIC_RELAXED, __HIP_MEMORY_SCOPE_AGENT); }
__device__ __forceinline__ unsigned xb_add(unsigned* p, unsigned v) { return __hip_atomic_fetch_add(p, v, __ATOMIC_RELAXED, __HIP_MEMORY_SCOPE_AGENT); }
__device__ __forceinline__ unsigned xb_xcc_id() { return (unsigned)__builtin_amdgcn_s_getreg((3 << 11) | 20) & 0xFu; }
#define XB_SPIN(cond, bar) do { unsigned _sp = 0; while (cond) { __builtin_amdgcn_s_sleep(1); \
    if ((++_sp & 255u) == 0u) { if (xb_ld(&(bar)[XB_TMO])) break; if (_sp > XB_SPIN_CAP) { atomicAdd(&(bar)[XB_TMO], 1u); break; } } } } while (0)
struct XcdBarrier { unsigned* bar; unsigned x; volatile LAS unsigned* st; };
__device__ __forceinline__ XcdBarrier xcd_barrier_post(unsigned* bar, volatile LAS unsigned* st) {
    XcdBarrier b; b.bar = bar; b.x = xb_xcc_id(); b.st = st;
    if (threadIdx.x == 0) (void)xb_add(&bar[XB_XCNT(b.x)], 1u);
    return b;
}
__device__ __forceinline__ void xcd_barrier_complete(unsigned* bar, unsigned x, unsigned& nloc, unsigned& nx) {
    const unsigned G = gridDim.x * gridDim.y * gridDim.z;
    unsigned sum, cnt, mine, sp = 0u;
    for (;;) {
        sum = 0u; cnt = 0u; mine = 0u;
#pragma unroll
        for (unsigned j = 0; j < 16; ++j) { const unsigned c = xb_ld(&bar[XB_XCNT(j)]); sum += c; cnt += (c > 0u) ? 1u : 0u; mine = (j == x) ? c : mine; }
        if (sum == G) break;
        __builtin_amdgcn_s_sleep(1);
        if ((++sp & 255u) == 0u) { if (xb_ld(&bar[XB_TMO])) break; if (sp > XB_SPIN_CAP) { atomicAdd(&bar[XB_TMO], 1u); break; } }
    }
    nloc = mine > 0u ? mine : 1u; nx = cnt > 0u ? cnt : 1u;
}
__device__ __forceinline__ void xcd_barrier(const XcdBarrier& b) {
    asm volatile("s_waitcnt vmcnt(0)" ::: "memory");
    __syncthreads();
    if (threadIdx.x == 0) {
        unsigned* bar = b.bar;
        __builtin_amdgcn_s_waitcnt(0);
        unsigned nloc = b.st[0], nx = b.st[1];
        if (nloc == 0u) { xcd_barrier_complete(bar, b.x, nloc, nx); b.st[0] = nloc; b.st[1] = nx; }
        const unsigned old = xb_add(&bar[XB_XSUB(b.x)], 1u);
        const unsigned gen = old / nloc;
        if (old + 1u == (gen + 1u) * nloc) {
            __builtin_amdgcn_fence(__ATOMIC_RELEASE, "agent");
            asm volatile("s_waitcnt vmcnt(0)" ::: "memory");
            const unsigned og = xb_add(&bar[XB_TOP], 1u);
            const unsigned tg = og / nx;
            if (og + 1u == (tg + 1u) * nx) xb_add(&bar[XB_TOPGEN], 1u);
            else XB_SPIN(xb_ld(&bar[XB_TOPGEN]) == tg, bar);
            __builtin_amdgcn_fence(__ATOMIC_ACQUIRE, "agent");
            xb_add(&bar[XB_XGEN(b.x)], 1u);
            asm volatile("s_waitcnt vmcnt(0)" ::: "memory");
        } else {
            XB_SPIN(xb_ld(&bar[XB_XGEN(b.x)]) == gen, bar);
            __builtin_amdgcn_fence(__ATOMIC_ACQUIRE, "agent");
            asm volatile("s_waitcnt vmcnt(0)" ::: "memory");
        }
    }
    __syncthreads();
}

constexpr int BM = 256, BK = 64, HALF = 128, HTB = HALF * BK * 2, NXCD = 8, WGM = 8;
__host__ __device__ __forceinline__ int lds_byte(int r, int c) { const int st = (r >> 4) * 2 + (c >> 5), rr = r & 15, cc = c & 31, ob = rr * 64 + cc * 2; return st * 1024 + (ob ^ (((ob >> 9) & 1) << 5)); }
__host__ __device__ __forceinline__ void stage_rc(int b, int& R, int& C) { const int st = b / 1024, sb = b % 1024, swz = sb ^ (((sb >> 9) & 1) << 5); R = (st >> 1) * 16 + swz / 64; C = (st & 1) * 32 + (swz % 64) / 2; }
__host__ __device__ __forceinline__ int perm32(int rho) { const int n = rho >> 4, i = rho & 15; return 8 * (i >> 2) + 4 * n + (i & 3); }

struct Unit { int pm, pn, g; };
struct Gemm { const bf16_t* A; const bf16_t* Bt; int lda, ldb, K; size_t gsA, gsB; };
struct GridOrder {
    int nM, nN, nwg, G, c;
    __device__ void init(int M, int N, int G_, int c_) { nM = M / BM; nN = N / BM; nwg = nM * nN; G = G_; c = c_; }
    __device__ bool next(int i, Unit& u) const {
        const long L = (long)i * G + c; if (L >= nwg) return false;
        int wgid = (int)L; { const int q = nwg / NXCD, r = nwg % NXCD, xcd = wgid % NXCD, off = wgid / NXCD; wgid = (xcd < r ? xcd * (q + 1) : r * (q + 1) + (xcd - r) * q) + off; }
        const int nig = WGM * nN, gid = wgid / nig, fm = gid * WGM, gsz = (nM - fm) < WGM ? (nM - fm) : WGM;
        u.pm = fm + ((wgid % nig) % gsz); u.pn = (wgid % nig) / gsz; u.g = 0; return true;
    }
};
struct GroupOrder {
    int c, G;
    __device__ bool next(int i, Unit& u) const { const int idx = c + i * G; if (c < 0 || idx >= NG * 3) return false; u.g = idx / 3; u.pm = idx % 3; u.pn = 0; return true; }
};

template <class Epi, class Sched>
__device__ __forceinline__ void gemm_phase(LAS unsigned char* lds, const int tid, const Gemm g, const Sched& S, const Epi& E) {
    const int wid = __builtin_amdgcn_readfirstlane(tid >> 6), lane = tid & 63, wr = wid >> 2, wc = wid & 3, fr = lane & 15, fq = lane >> 4;
    const int K = g.K, nt = K / BK;
    unsigned voffA[2], voffB[2];
#pragma unroll
    for (int i = 0; i < 2; ++i) { int R, C; stage_rc(tid * 16 + i * 8192, R, C); const int Rb = Epi::PERM ? ((R & ~31) + perm32(R & 31)) : R;
        voffA[i] = (unsigned)(R * g.lda + C) * 2u; voffB[i] = (unsigned)(Rb * g.ldb + C) * 2u; }
    const size_t kstep = (size_t)(BK * 2);
    const size_t hstepA = (size_t)HALF * g.lda * 2, hstepB = (size_t)HALF * g.ldb * 2;
    const unsigned ldsw = (unsigned)wid * 1024u;
    const int aoff = lds_byte(wr * 64 + fr, fq * 8), boff = lds_byte(wc * 32 + fr, fq * 8);
#define PG8_SA(b, h) (((b) * 2 + (h)) * HTB)
#define PG8_SB(b, h) ((4 + (b) * 2 + (h)) * HTB)
#define PG8_STAGE(bufoff, gbase, voff) do { _Pragma("unroll") for (int _i = 0; _i < 2; ++_i) \
        __builtin_amdgcn_global_load_lds((const unsigned*)((const char*)(gbase) + (voff)[_i]), (LAS unsigned*)(lds + (bufoff) + ldsw + _i * 8192), 16, 0, 0); } while (0)
#define PG8_LDA(dst, b, h) do { _Pragma("unroll") for (int m = 0; m < 4; ++m) _Pragma("unroll") for (int k = 0; k < 2; ++k) dst[m][k] = *(const LAS bf16x8*)(lds + PG8_SA(b, h) + aoff + m * 2048 + k * 1024); } while (0)
#define PG8_LDB(dst, b, h) do { _Pragma("unroll") for (int n = 0; n < 2; ++n) _Pragma("unroll") for (int k = 0; k < 2; ++k) dst[n][k] = *(const LAS bf16x8*)(lds + PG8_SB(b, h) + boff + n * 2048 + k * 1024); } while (0)
#define PG8_MMA(ai, bj, At, Bt) do { __builtin_amdgcn_s_setprio(1); _Pragma("unroll") for (int m = 0; m < 4; ++m) _Pragma("unroll") for (int n = 0; n < 2; ++n) _Pragma("unroll") for (int k = 0; k < 2; ++k) \
        acc[ai][bj][m][n] = __builtin_amdgcn_mfma_f32_16x16x32_bf16(Bt[n][k], At[m][k], acc[ai][bj][m][n], 0, 0, 0); __builtin_amdgcn_s_setprio(0); } while (0)
#define PG8_WAIT_V(n) asm volatile("s_waitcnt vmcnt(" #n ")" ::: "memory")
#define PG8_WAIT_L(n) asm volatile("s_waitcnt lgkmcnt(" #n ")" ::: "memory")
#define PG8_BAR __builtin_amdgcn_s_barrier()
#define PG8_SCHED __builtin_amdgcn_sched_barrier(0)
#define PG8_APTR(u) ((const char*)g.A + ((size_t)(u).g * g.gsA + (size_t)(u).pm * BM * g.lda) * 2)
#define PG8_BPTR(u) ((const char*)g.Bt + ((size_t)(u).g * g.gsB + (size_t)(u).pn * BM * g.ldb) * 2)
    Unit cur, nxt; int ui = 0;
    if (!S.next(0, cur)) return;
    f32x4 acc[2][2][4][2];
#pragma unroll
    for (int a = 0; a < 2; ++a)
#pragma unroll
        for (int b = 0; b < 2; ++b)
#pragma unroll
            for (int m = 0; m < 4; ++m)
#pragma unroll
                for (int n = 0; n < 2; ++n) acc[a][b][m][n] = (f32x4){0.f, 0.f, 0.f, 0.f};
    bf16x8 At[4][2], B0[2][2], B1[2][2];
    const char* cA = PG8_APTR(cur); const char* cB = PG8_BPTR(cur);
    PG8_STAGE(PG8_SB(0, 0), cB, voffB); PG8_STAGE(PG8_SB(0, 1), cB + hstepB, voffB); PG8_STAGE(PG8_SA(0, 0), cA, voffA); PG8_STAGE(PG8_SA(0, 1), cA + hstepA, voffA);
    if (wr == 1) PG8_BAR;
    PG8_WAIT_V(2); PG8_BAR;
    PG8_STAGE(PG8_SB(1, 0), cB + kstep, voffB); PG8_STAGE(PG8_SA(1, 0), cA + kstep, voffA); PG8_STAGE(PG8_SB(1, 1), cB + hstepB + kstep, voffB);
    PG8_WAIT_V(6); PG8_BAR;
    for (;;) {
        const bool has_next = S.next(ui + 1, nxt);
        const char* nA = has_next ? PG8_APTR(nxt) : cA; const char* nB = has_next ? PG8_BPTR(nxt) : cB;
        for (int t = 0; t < nt; t += 2) {
            const bool last = (t == nt - 2);
            const char* a1 = cA + (size_t)(t + 1) * kstep;
            const char* a2 = last ? nA : cA + (size_t)(t + 2) * kstep; const char* b2 = last ? nB : cB + (size_t)(t + 2) * kstep;
            const char* a3 = a2 + kstep; const char* b3 = b2 + kstep;
            PG8_LDB(B0, 0, 0); PG8_LDB(B1, 0, 1); PG8_SCHED; PG8_LDA(At, 0, 0); PG8_STAGE(PG8_SA(1, 1), a1 + hstepA, voffA);
            PG8_WAIT_V(8); PG8_WAIT_L(0); PG8_BAR; PG8_MMA(0, 0, At, B0); PG8_MMA(0, 1, At, B1); PG8_BAR; PG8_SCHED;
            PG8_LDA(At, 0, 1); PG8_STAGE(PG8_SB(0, 0), b2, voffB); PG8_STAGE(PG8_SB(0, 1), b2 + hstepB, voffB); PG8_STAGE(PG8_SA(0, 0), a2, voffA);
            PG8_WAIT_V(8); PG8_WAIT_L(0); PG8_BAR; PG8_MMA(1, 0, At, B0); PG8_MMA(1, 1, At, B1); PG8_BAR; PG8_SCHED;
            PG8_LDB(B0, 1, 0); PG8_LDB(B1, 1, 1); PG8_SCHED; PG8_LDA(At, 1, 0); PG8_STAGE(PG8_SA(0, 1), a2 + hstepA, voffA);
            PG8_WAIT_V(8); PG8_WAIT_L(0); PG8_BAR; PG8_MMA(0, 0, At, B0); PG8_MMA(0, 1, At, B1); PG8_BAR; PG8_SCHED;
            PG8_LDA(At, 1, 1); PG8_STAGE(PG8_SB(1, 0), b3, voffB); PG8_STAGE(PG8_SB(1, 1), b3 + hstepB, voffB); PG8_STAGE(PG8_SA(1, 0), a3, voffA);
            PG8_WAIT_V(8); PG8_WAIT_L(0); PG8_BAR; PG8_MMA(1, 0, At, B0); PG8_MMA(1, 1, At, B1); PG8_BAR; PG8_SCHED;
        }
        if (wr == 0) PG8_BAR;
        E(acc, cur, wr, wc, fr, fq);
        if (!has_next) break;
#pragma unroll
        for (int a = 0; a < 2; ++a)
#pragma unroll
            for (int b = 0; b < 2; ++b)
#pragma unroll
                for (int m = 0; m < 4; ++m)
#pragma unroll
                    for (int n = 0; n < 2; ++n) acc[a][b][m][n] = (f32x4){0.f, 0.f, 0.f, 0.f};
        cur = nxt; cA = nA; cB = nB; ++ui;
        if (wr == 1) PG8_BAR;
    }
    PG8_WAIT_V(0);
    PG8_BAR;
#undef PG8_SA
#undef PG8_SB
#undef PG8_STAGE
#undef PG8_LDA
#undef PG8_LDB
#undef PG8_MMA
#undef PG8_WAIT_V
#undef PG8_WAIT_L
#undef PG8_BAR
#undef PG8_SCHED
#undef PG8_APTR
#undef PG8_BPTR
}
__device__ __forceinline__ int cond_of_pm(int pm) { return pm < 16 ? 0 : 1 + ((pm - 16) >> 2); }
__device__ __forceinline__ int kvrow_of(int row) { return row < MC ? row : MC + ((row - MC) >> 10) * (PAST + DSEQ) + PAST + ((row - MC) & 1023); }
__device__ __forceinline__ u32x4 pack8(const f32x4& a, const f32x4& b) { u32x4 w; w.x = cvt_pk_bf16(a[0], a[1]); w.y = cvt_pk_bf16(a[2], a[3]); w.z = cvt_pk_bf16(b[0], b[1]); w.w = cvt_pk_bf16(b[2], b[3]); return w; }

struct EpiIn {
    static constexpr bool PERM = true;
    const float* sumsq; const float* bias; const float* qn; const float* kn; const f32x2* rope;
    bf16_t* Q; bf16_t* KB; bf16_t* VB; bf16_t* AS3; float* new_k; float* new_v; int l;
    __device__ __forceinline__ void operator()(const f32x4 (&acc)[2][2][4][2], const Unit& u, int wr, int wc, int fr, int fq) const {
        const int pm = u.pm, pn = u.pn; const bool ctx = pm < 16; const int cond = cond_of_pm(pm);
        const float* bz = bias + cond * 2048 + pn * 256 + wc * 32 + 8 * fq;
        f32x4 bv[2][2];
#pragma unroll
        for (int bj = 0; bj < 2; ++bj)
#pragma unroll
            for (int n = 0; n < 2; ++n) bv[bj][n] = *(const f32x4*)(bz + bj * 128 + 4 * n);
        const int rbase = pm * BM + wr * 64 + fr;
        if (pn < 4) {
            const bool isq = pn < 2; const float* gv = isq ? qn : kn;
            const int G = (pn & 1) * 4 + wc;
            const int cb = 32 * (fq >> 1) + 8 * (fq & 1);
            f32x4 gg[2][2];
#pragma unroll
            for (int bj = 0; bj < 2; ++bj)
#pragma unroll
                for (int n = 0; n < 2; ++n) gg[bj][n] = *(const f32x4*)(gv + cb + 16 * bj + 4 * n);
            const float qs = isq ? C2 : 1.f;
#pragma unroll
            for (int ai = 0; ai < 2; ++ai)
#pragma unroll
                for (int m = 0; m < 4; ++m) {
                    const int row = rbase + ai * HALF + m * 16;
                    const float rstd = rsqrtf(sumsq[row] * (1.f / DM) + EPS);
                    f32x4 v[2][2]; float ss = 0.f;
#pragma unroll
                    for (int bj = 0; bj < 2; ++bj)
#pragma unroll
                        for (int n = 0; n < 2; ++n) { v[bj][n] = acc[ai][bj][m][n] * rstd + bv[bj][n]; const f32x4 t = v[bj][n] * v[bj][n]; ss += (t[0] + t[1]) + (t[2] + t[3]); }
                    ss += __shfl_xor(ss, 16); ss += __shfl_xor(ss, 32);
                    const float rn = rsqrtf(ss * (1.f / 64.f) + EPS);
#pragma unroll
                    for (int bj = 0; bj < 2; ++bj)
#pragma unroll
                        for (int n = 0; n < 2; ++n) v[bj][n] = v[bj][n] * rn * gg[bj][n];
                    if (ctx) {
                        if (!isq) { float* nk = new_k + ((size_t)((row >> 8) * DEPTH + l) * SEQ + (row & 255)) * 512 + G * 64 + cb;
#pragma unroll
                            for (int bj = 0; bj < 2; ++bj) { *(f32x4*)(nk + 16 * bj) = v[bj][0]; *(f32x4*)(nk + 16 * bj + 4) = v[bj][1]; } }
                    } else {
                        const int t = (row - MC) & 1023; const int pos = (fq >> 1) ? (t & 63) : (t >> 6);
                        const f32x2* rp = rope + pos * 16 + 8 * (fq & 1);
#pragma unroll
                        for (int n = 0; n < 2; ++n)
#pragma unroll
                            for (int j = 0; j < 4; ++j) { const f32x2 cs = rp[4 * n + j]; const float x1 = v[0][n][j], x2 = v[1][n][j]; v[0][n][j] = x1 * cs.x - x2 * cs.y; v[1][n][j] = x1 * cs.y + x2 * cs.x; }
                    }
                    bf16_t* dst = isq ? (Q + (size_t)row * 512) : (KB + (size_t)kvrow_of(row) * 512);
                    dst += G * 64 + cb;
#pragma unroll
                    for (int bj = 0; bj < 2; ++bj) *(u32x4*)(dst + 16 * bj) = pack8(v[bj][0] * qs, v[bj][1] * qs);
                }
        } else if (pn < 6) {
            const int col0 = (pn - 4) * 256 + wc * 32 + 8 * fq;
#pragma unroll
            for (int ai = 0; ai < 2; ++ai)
#pragma unroll
                for (int m = 0; m < 4; ++m) {
                    const int row = rbase + ai * HALF + m * 16;
                    const float rstd = rsqrtf(sumsq[row] * (1.f / DM) + EPS);
                    bf16_t* dst = VB + (size_t)kvrow_of(row) * 512 + col0;
#pragma unroll
                    for (int bj = 0; bj < 2; ++bj) { const f32x4 a = acc[ai][bj][m][0] * rstd + bv[bj][0], b = acc[ai][bj][m][1] * rstd + bv[bj][1];
                        *(u32x4*)(dst + 128 * bj) = pack8(a, b);
                        if (ctx) { float* nv = new_v + ((size_t)((row >> 8) * DEPTH + l) * SEQ + (row & 255)) * 512 + col0 + 128 * bj; *(f32x4*)nv = a; *(f32x4*)(nv + 4) = b; } }
                }
        } else {
            const int cu0 = (pn - 6) * 256 + wc * 32 + 8 * fq;
#pragma unroll
            for (int ai = 0; ai < 2; ++ai)
#pragma unroll
                for (int m = 0; m < 4; ++m) {
                    const int row = rbase + ai * HALF + m * 16;
                    const float rstd = rsqrtf(sumsq[row] * (1.f / DM) + EPS);
#pragma unroll
                    for (int bj = 0; bj < 2; ++bj) { const int cu = cu0 + 128 * bj; const f32x4 a = acc[ai][bj][m][0] * rstd + bv[bj][0], b = acc[ai][bj][m][1] * rstd + bv[bj][1];
                        *(u32x4*)(AS3 + ((size_t)(cu >> 4) * NCHUNK + (row >> 4)) * 512 + (row & 15) * 16 + (cu & 15)) = pack8(a, b); }
                }
        }
    }
};
struct EpiS1 {
    static constexpr bool PERM = false;
    float* E;
    __device__ __forceinline__ void operator()(const f32x4 (&acc)[2][2][4][2], const Unit& u, int wr, int wc, int fr, int fq) const {
        const int rbase = u.pm * BM + wr * 64 + fr, col0 = wc * 32 + 4 * fq;
#pragma unroll
        for (int ai = 0; ai < 2; ++ai)
#pragma unroll
            for (int m = 0; m < 4; ++m) { float* dst = E + ((size_t)u.g * NCHUNK + rbase + ai * HALF + m * 16) * 256 + col0;
#pragma unroll
                for (int bj = 0; bj < 2; ++bj)
#pragma unroll
                    for (int n = 0; n < 2; ++n) *(f32x4*)(dst + bj * HALF + n * 16) = acc[ai][bj][m][n]; }
    }
};
struct EpiS3 {
    static constexpr bool PERM = true;
    bf16_t* Z;
    __device__ __forceinline__ void operator()(const f32x4 (&acc)[2][2][4][2], const Unit& u, int wr, int wc, int fr, int fq) const {
        const int rbase = u.pm * BM + wr * 64 + fr;
#pragma unroll
        for (int ai = 0; ai < 2; ++ai)
#pragma unroll
            for (int m = 0; m < 4; ++m) { const int chunk = rbase + ai * HALF + m * 16;
#pragma unroll
                for (int bj = 0; bj < 2; ++bj) { const int tt = 8 * bj + 2 * wc + (fq >> 1), c0 = 8 * (fq & 1);
                    f32x4 a = acc[ai][bj][m][0], b = acc[ai][bj][m][1];
#pragma unroll
                    for (int j = 0; j < 4; ++j) { a[j] = gelu_tanh_f(a[j]); b[j] = gelu_tanh_f(b[j]); }
                    *(u32x4*)(Z + ((size_t)chunk * 16 + tt) * 512 + u.g * 16 + c0) = pack8(a, b); } }
    }
};
struct EpiGlu {
    static constexpr bool PERM = true;
    const bf16_t* Z; const float* bg; bf16_t* CAT;
    __device__ __forceinline__ void operator()(const f32x4 (&acc)[2][2][4][2], const Unit& u, int wr, int wc, int fr, int fq) const {
        const int rbase = u.pm * BM + wr * 64 + fr, col0 = u.pn * BM + wc * 32 + 8 * fq;
        f32x4 bv[2][2];
#pragma unroll
        for (int bj = 0; bj < 2; ++bj)
#pragma unroll
            for (int n = 0; n < 2; ++n) bv[bj][n] = *(const f32x4*)(bg + col0 + bj * HALF + 4 * n);
#pragma unroll
        for (int ai = 0; ai < 2; ++ai)
#pragma unroll
            for (int m = 0; m < 4; ++m) { const int row = rbase + ai * HALF + m * 16;
#pragma unroll
                for (int bj = 0; bj < 2; ++bj) { const u32x4 zw = *(const u32x4*)(Z + (size_t)row * 512 + col0 + bj * HALF);
                    f32x4 a = acc[ai][bj][m][0] + bv[bj][0], b = acc[ai][bj][m][1] + bv[bj][1];
                    a[0] = bflo(zw.x) * sigmoid_f(a[0]); a[1] = bfhi(zw.x) * sigmoid_f(a[1]); a[2] = bflo(zw.y) * sigmoid_f(a[2]); a[3] = bfhi(zw.y) * sigmoid_f(a[3]);
                    b[0] = bflo(zw.z) * sigmoid_f(b[0]); b[1] = bfhi(zw.z) * sigmoid_f(b[1]); b[2] = bflo(zw.w) * sigmoid_f(b[2]); b[3] = bfhi(zw.w) * sigmoid_f(b[3]);
                    *(u32x4*)(CAT + (size_t)row * 1024 + 512 + col0 + bj * HALF) = pack8(a, b); } }
    }
};
struct EpiRes {
    static constexpr bool PERM = true;
    const float* xin0; const float* xin1;
    float* xout;
    const float* gate;
    const float* gn; const float* sc;
    bf16_t* XS; float* ssq;
    __device__ __forceinline__ void operator()(const f32x4 (&acc)[2][2][4][2], const Unit& u, int wr, int wc, int fr, int fq) const {
        const int pm = u.pm, cond = cond_of_pm(pm); const int col0 = u.pn * BM + wc * 32 + 8 * fq; const int rbase = pm * BM + wr * 64 + fr;
        const bool donorm = (gn != nullptr);
        f32x4 gt[2][2], gs[2][2];
#pragma unroll
        for (int bj = 0; bj < 2; ++bj)
#pragma unroll
            for (int n = 0; n < 2; ++n) { const int c = col0 + bj * HALF + n * 4; gt[bj][n] = *(const f32x4*)(gate + cond * 6144 + c);
                if (donorm) { const f32x4 g4 = *(const f32x4*)(gn + c), s4 = *(const f32x4*)(sc + cond * 6144 + c); gs[bj][n] = g4 * (s4 + 1.f); } else gs[bj][n] = (f32x4){0.f, 0.f, 0.f, 0.f}; }
#pragma unroll
        for (int ai = 0; ai < 2; ++ai)
#pragma unroll
            for (int m = 0; m < 4; ++m) { const int row = rbase + ai * HALF + m * 16;
                const float* xi = (row < MC) ? (xin0 + (size_t)row * DM) : (xin1 + (size_t)(row - MC) * DM);
                float ss = 0.f;
#pragma unroll
                for (int bj = 0; bj < 2; ++bj) { const int c = col0 + bj * HALF;
                    const f32x4 x0 = *(const f32x4*)(xi + c) + gt[bj][0] * acc[ai][bj][m][0], x1 = *(const f32x4*)(xi + c + 4) + gt[bj][1] * acc[ai][bj][m][1];
                    *(f32x4*)(xout + (size_t)row * DM + c) = x0; *(f32x4*)(xout + (size_t)row * DM + c + 4) = x1;
                    if (donorm) { const f32x4 t0 = x0 * x0, t1 = x1 * x1; ss += ((t0[0] + t0[1]) + (t0[2] + t0[3])) + ((t1[0] + t1[1]) + (t1[2] + t1[3]));
                        *(u32x4*)(XS + (size_t)row * DM + c) = pack8(x0 * gs[bj][0], x1 * gs[bj][1]); } }
                if (donorm) { ss += __shfl_xor(ss, 16); ss += __shfl_xor(ss, 32); if (fq == 0) atomicAdd(ssq + row, ss); }
            }
    }
};
struct EpiUp {
    static constexpr bool PERM = true;
    const float* sumsq; const float* bias; bf16_t* UP;
    __device__ __forceinline__ void operator()(const f32x4 (&acc)[2][2][4][2], const Unit& u, int wr, int wc, int fr, int fq) const {
        const int pm = u.pm, cond = cond_of_pm(pm); const int col0 = u.pn * BM + wc * 32 + 8 * fq; const int rbase = pm * BM + wr * 64 + fr;
        f32x4 bv[2][2];
#pragma unroll
        for (int bj = 0; bj < 2; ++bj)
#pragma unroll
            for (int n = 0; n < 2; ++n) bv[bj][n] = *(const f32x4*)(bias + cond * 4096 + col0 + bj * HALF + 4 * n);
#pragma unroll
        for (int ai = 0; ai < 2; ++ai)
#pragma unroll
            for (int m = 0; m < 4; ++m) { const int row = rbase + ai * HALF + m * 16; const float rstd = rsqrtf(sumsq[row] * (1.f / DM) + EPS);
#pragma unroll
                for (int bj = 0; bj < 2; ++bj) *(u32x4*)(UP + (size_t)row * 4096 + col0 + bj * HALF) = pack8(acc[ai][bj][m][0] * rstd + bv[bj][0], acc[ai][bj][m][1] * rstd + bv[bj][1]); }
    }
};
constexpr int AT_KSLOT = 16384, AT_K = 0, AT_V = 3 * AT_KSLOT, AT_X = 0, AT_ST = 65536;
__device__ __forceinline__ void glds16(const void* gsrc, unsigned lds_dst) { unsigned keep;
    asm volatile("s_mov_b32 %0, m0\n\ts_mov_b32 m0, %2\n\ts_nop 0\n\tglobal_load_lds_dwordx4 %1, off\n\ts_mov_b32 m0, %0" : "=&s"(keep) : "v"(gsrc), "s"(lds_dst) : "memory"); }
#define AT_WAIT_BAR(N) asm volatile("s_waitcnt vmcnt(" #N ") lgkmcnt(0)\n\ts_barrier" ::: "memory")
__device__ __forceinline__ s16x4 vtr(const LAS char* p) { typedef short v4i16_t __attribute__((ext_vector_type(4))); return __builtin_bit_cast(s16x4, __builtin_amdgcn_ds_read_tr16_b64_v4i16((LAS v4i16_t*)p)); }
__device__ __forceinline__ int crow(int r, int hi) { return (r & 3) + 8 * (r >> 2) + 4 * hi; }

struct AttnArgs { const bf16_t* Q; const bf16_t* KB; const bf16_t* VB; bf16_t* CAT; const float* subln; float lam; float oml; };

__device__ __forceinline__ void attn_unit(LAS unsigned char* lds, const int tid, const AttnArgs& A, int seq, int h, int qblk) {
    const int lane = tid & 63, r32 = lane & 31, hi = lane >> 5; const int wid = __builtin_amdgcn_readfirstlane(tid >> 6);
    const int rg = wid & 3, s = wid >> 2;
    const bool ctx = seq < NB;
    const int qrow0 = ctx ? seq * SEQ + qblk * 128 : MC + (seq - NB) * DSEQ + qblk * 128;
    const int krow0 = ctx ? seq * SEQ : MC + (seq - NB) * (PAST + DSEQ);
    const int NT = ctx ? SEQ / 64 : (PAST + DSEQ) / 64;
    const unsigned lds0 = (unsigned)(uintptr_t)lds;
    const bf16_t* ksrc0 = A.KB + (size_t)(krow0 + lane) * 512 + h * 128 + wid * 8;
    const bf16_t* vsrc0 = A.VB + (size_t)(krow0 + 16 * (wid & 3) + (lane >> 2)) * 512 + h * 128 + (wid >> 2) * 32 + (lane & 3) * 8;
    const unsigned kdst = lds0 + AT_K + wid * 1024, vdst = lds0 + AT_V + ((wid >> 2) * 4 + (wid & 3)) * 1024;
#define AT_DMA(t, slot) do { const size_t _o = (size_t)(t) * 64 * 512; const unsigned _s = (unsigned)(slot) * AT_KSLOT; \
        glds16(ksrc0 + _o, (unsigned)__builtin_amdgcn_readfirstlane(kdst + _s)); glds16(ksrc0 + _o + 64, (unsigned)__builtin_amdgcn_readfirstlane(kdst + _s + 8 * 1024)); \
        glds16(vsrc0 + _o, (unsigned)__builtin_amdgcn_readfirstlane(vdst + _s)); glds16(vsrc0 + _o + 64, (unsigned)__builtin_amdgcn_readfirstlane(vdst + _s + 8 * 1024)); } while (0)
    AT_DMA(0, 0); AT_DMA(1, 1);
    bf16x8 qr[4];
    { const bf16_t* qp = A.Q + (size_t)(qrow0 + rg * 32 + r32) * 512 + h * 128 + s * 64 + hi * 8;
#pragma unroll
      for (int d0 = 0; d0 < 4; ++d0) qr[d0] = *(const bf16x8*)(qp + d0 * 16); }
    f32x16 o[4];
#pragma unroll
    for (int d0 = 0; d0 < 4; ++d0)
#pragma unroll
        for (int r = 0; r < 16; ++r) o[d0][r] = 0.f;
    float lsum = 0.f;
    const LAS char* kfrag0 = (const LAS char*)lds + AT_K + (s * 8 + hi) * 1024 + r32 * 16;
    const LAS char* vfrag0 = (const LAS char*)lds + AT_V + ((lane >> 4) & 1) * 32 + (lane & 3) * 8 + (4 * hi + ((lane & 15) >> 2)) * 64;
    int slot = 0;
    for (int t = 0; t < NT; ++t) {
        if (t + 1 < NT) AT_WAIT_BAR(4); else AT_WAIT_BAR(0);
        if (t + 2 < NT) { const int s2 = slot == 0 ? 2 : slot - 1; AT_DMA(t + 2, s2); }
        const LAS char* kf = kfrag0 + slot * AT_KSLOT; const LAS char* vf = vfrag0 + slot * AT_KSLOT;
        f32x16 p0, p1;
#pragma unroll
        for (int r = 0; r < 16; ++r) { p0[r] = 0.f; p1[r] = 0.f; }
#pragma unroll
        for (int d0 = 0; d0 < 4; ++d0) {
            const bf16x8 k0 = *(const LAS bf16x8*)(kf + d0 * 2048), k1 = *(const LAS bf16x8*)(kf + d0 * 2048 + 512);
            p0 = __builtin_amdgcn_mfma_f32_32x32x16_bf16(k0, qr[d0], p0, 0, 0, 0);
            p1 = __builtin_amdgcn_mfma_f32_32x32x16_bf16(k1, qr[d0], p1, 0, 0, 0);
        }
        float sacc = 0.f;
#pragma unroll
        for (int r = 0; r < 16; ++r) { p0[r] = fast_exp2(p0[r]); p1[r] = fast_exp2(p1[r]); sacc += p0[r] + p1[r]; }
        lsum += sacc;
        u32x4 pw[4];
        pw[0] = (u32x4){cvt_pk_bf16(p0[0], p0[1]), cvt_pk_bf16(p0[2], p0[3]), cvt_pk_bf16(p0[4], p0[5]), cvt_pk_bf16(p0[6], p0[7])};
        pw[1] = (u32x4){cvt_pk_bf16(p0[8], p0[9]), cvt_pk_bf16(p0[10], p0[11]), cvt_pk_bf16(p0[12], p0[13]), cvt_pk_bf16(p0[14], p0[15])};
        pw[2] = (u32x4){cvt_pk_bf16(p1[0], p1[1]), cvt_pk_bf16(p1[2], p1[3]), cvt_pk_bf16(p1[4], p1[5]), cvt_pk_bf16(p1[6], p1[7])};
        pw[3] = (u32x4){cvt_pk_bf16(p1[8], p1[9]), cvt_pk_bf16(p1[10], p1[11]), cvt_pk_bf16(p1[12], p1[13]), cvt_pk_bf16(p1[14], p1[15])};
#pragma unroll
        for (int d0 = 0; d0 < 4; ++d0)
#pragma unroll
            for (int ks = 0; ks < 4; ++ks) {
                const s16x4 lo = vtr(vf + (d0 * 4 + ks) * 1024), hh = vtr(vf + (d0 * 4 + ks) * 1024 + 512);
                const bf16x8 vfr = (bf16x8){lo[0], lo[1], lo[2], lo[3], hh[0], hh[1], hh[2], hh[3]};
                o[d0] = __builtin_amdgcn_mfma_f32_32x32x16_bf16(vfr, __builtin_bit_cast(bf16x8, pw[ks]), o[d0], 0, 0, 0);
            }
        slot = slot == 2 ? 0 : slot + 1;
    }
    lsum += __shfl_xor(lsum, 32);
    const float inv = (s == 0 ? 1.f : A.lam) / lsum;
    AT_WAIT_BAR(0);
    LAS float* X = (LAS float*)(lds + AT_X) + rg * 4096;
    if (s == 1) {
#pragma unroll
        for (int d0 = 0; d0 < 4; ++d0)
#pragma unroll
            for (int r = 0; r < 16; ++r) X[(d0 * 16 + r) * 64 + lane] = o[d0][r] * inv;
    }
    AT_WAIT_BAR(0);
    if (s == 0) {
        float ss = 0.f;
#pragma unroll
        for (int d0 = 0; d0 < 4; ++d0)
#pragma unroll
            for (int r = 0; r < 16; ++r) { const float v = o[d0][r] * inv - X[(d0 * 16 + r) * 64 + lane]; o[d0][r] = v; ss += v * v; }
        ss += __shfl_xor(ss, 32);
        const float rn = rsqrtf(ss * (1.f / 128.f) + EPS) * A.oml;
        LAS bf16_t* stg = (LAS bf16_t*)(lds + AT_ST) + rg * (32 * 136);
#pragma unroll
        for (int d0 = 0; d0 < 4; ++d0)
#pragma unroll
            for (int rq = 0; rq < 4; ++rq) { const int dv = 32 * d0 + 8 * rq + 4 * hi; const f32x4 g4 = *(const f32x4*)(A.subln + dv);
                u32x2 w; w.x = cvt_pk_bf16(o[d0][4 * rq] * rn * g4[0], o[d0][4 * rq + 1] * rn * g4[1]); w.y = cvt_pk_bf16(o[d0][4 * rq + 2] * rn * g4[2], o[d0][4 * rq + 3] * rn * g4[3]);
                *(LAS u32x2*)(stg + r32 * 136 + dv) = w; }
        asm volatile("s_waitcnt lgkmcnt(0)" ::: "memory");
        bf16_t* dst = A.CAT + (size_t)(qrow0 + rg * 32) * 1024 + h * 128;
#pragma unroll
        for (int i = 0; i < 8; ++i) { const int row = i * 4 + (lane >> 4), ch = lane & 15; const u32x4 v = *(const LAS u32x4*)(stg + row * 136 + ch * 8); *(u32x4*)(dst + (size_t)row * 1024 + ch * 8) = v; }
    }
    AT_WAIT_BAR(0);
#undef AT_DMA
}
struct Args { const float* in[34]; float* out; unsigned char* ws; int stop_after; int pad; };
typedef const __attribute__((address_space(4))) Args* kargs_t;
struct Frame {
    LAS unsigned char* lds; int tid, lane, wave, vcu, bid, G;
    kargs_t ka; float* out; unsigned char* ws;
    float* misc; unsigned* ctl;
};
#define LDS_WAIT() asm volatile("s_waitcnt lgkmcnt(0)" ::: "memory")
#define VM_WAIT() asm volatile("s_waitcnt vmcnt(0)" ::: "memory")

template <int MAP> __device__ __forceinline__ int src_col(int p);
template <int MODE, int MAP, int NC> __device__ __forceinline__ void gemv9_task(Frame& F, const float* W, int ldw, int l, int voff, int strip, float* out, int ldo, const float* add) {
    LAS float* sc = (LAS float*)F.lds; LAS float* red = sc + 9 * 1024;
    for (int i = F.tid; i < 9 * 1024; i += NTHREADS) { const int cond = i >> 10, k = i & 1023; float v;
        if (MODE == 0) { v = cond == 0 ? F.ka->in[6][k] : F.ka->in[5][(cond - 1) * 1024 + k]; v = v / (1.f + expf(-v)); } else v = F.misc[MI_MOD + (l * 9 + cond) * 6144 + voff + k];
        sc[i] = v; }
    __syncthreads();
    const int j = strip * NC + (F.lane < NC ? F.lane : NC - 1); const float* w = W + (size_t)(F.wave * 128) * ldw + src_col<MAP>(j);
    float acc[9];
#pragma unroll
    for (int b = 0; b < 9; ++b) acc[b] = 0.f;
#pragma unroll 16
    for (int k = 0; k < 128; ++k) { const float wv = w[(size_t)k * ldw];
#pragma unroll
        for (int b = 0; b < 9; ++b) acc[b] += sc[b * 1024 + F.wave * 128 + k] * wv; }
#pragma unroll
    for (int b = 0; b < 9; ++b) red[(F.wave * 9 + b) * 64 + F.lane] = acc[b];
    __syncthreads();
    for (int i = F.tid; i < 9 * 64; i += NTHREADS) { const int b = i >> 6, ln = i & 63; if (ln >= NC) continue; float s_ = 0.f;
#pragma unroll
        for (int w8 = 0; w8 < 8; ++w8) s_ += red[(w8 * 9 + b) * 64 + ln];
        const int jj = strip * NC + ln; out[(size_t)b * ldo + jj] = s_ + (add ? add[jj] : 0.f); }
    __syncthreads();
}
template <int MAP> __device__ __forceinline__ int src_col(int p) {
    if (MAP == 1) { if (p >= 1024) return p; const int pn = p >> 8, r = p & 255, bj = r >> 7, wc = (r >> 5) & 3, fq = (r >> 3) & 3, low = r & 7; return 256 * pn + 64 * wc + 32 * (fq >> 1) + 16 * bj + 8 * (fq & 1) + low; }
    if (MAP == 2) { const int pn = p >> 8, bj = (p >> 7) & 1, r = p & 127; return bj * 2048 + 128 * pn + r; }
    return p;
}
template <int MAP, bool BIAS> __device__ __forceinline__ void transpose_item(Frame& F, const float* W, int K, int N, bf16_t* WT, LAS float* scr, int item, const float* shv, float* bias) {
    const int lane = F.lane; const int nblk = N / 64, kb = item / nblk, nb = item % nblk, k0 = 64 * kb, n0 = 64 * nb;
    const int sc_ = src_col<MAP>(n0 + lane);
    float tv[64];
#pragma unroll
    for (int i = 0; i < 64; ++i) tv[i] = W[(size_t)(k0 + i) * N + sc_];
#pragma unroll
    for (int i = 0; i < 64; ++i) scr[i * 65 + lane] = tv[i];
    LDS_WAIT(); asm volatile("" ::: "memory");
    const int c = lane & 7;
#pragma unroll
    for (int j = 0; j < 8; ++j) { const int n = (lane >> 3) + 8 * j; const LAS float* s_ = scr + (8 * c) * 65 + n;
        u32x4 o; o.x = cvt_pk_bf16(s_[0 * 65], s_[1 * 65]); o.y = cvt_pk_bf16(s_[2 * 65], s_[3 * 65]); o.z = cvt_pk_bf16(s_[4 * 65], s_[5 * 65]); o.w = cvt_pk_bf16(s_[6 * 65], s_[7 * 65]);
        *(u32x4*)(WT + (size_t)(n0 + n) * K + k0 + 8 * c) = o; }
    if (BIAS) {
        float sh[9], acc[9];
#pragma unroll
        for (int b = 0; b < 9; ++b) { sh[b] = shv[b * 6144 + k0 + lane]; acc[b] = 0.f; }
#pragma unroll
        for (int kk = 0; kk < 64; ++kk) { const float w = tv[kk];
#pragma unroll
            for (int b = 0; b < 9; ++b) acc[b] += __uint_as_float(__builtin_amdgcn_readlane(__float_as_uint(sh[b]), kk)) * w; }
#pragma unroll
        for (int b = 0; b < 9; ++b) atomicAdd(bias + (size_t)b * N + n0 + lane, acc[b]);
    }
    LDS_WAIT(); asm volatile("" ::: "memory");
}
__device__ __forceinline__ void cache_row(Frame& F, int l, int item) {
    const int which = item >> 12, r = item & 4095, b = r >> 9, j = r & 511;
    const float* src = (which ? F.ka->in[3] : F.ka->in[2]) + ((size_t)(b * DEPTH + l) * PAST + j) * 512 + F.lane * 8;
    bf16_t* dst = (bf16_t*)(F.ws + (which ? WS_VB : WS_KB)) + (size_t)(MC + b * (PAST + DSEQ) + j) * 512 + F.lane * 8;
    const f32x4 a = *(const f32x4*)src, c = *(const f32x4*)(src + 4);
    *(u32x4*)dst = pack8(a, c);
}
__device__ __forceinline__ void cache_item(Frame& F, int l, int item4) {
#pragma unroll
    for (int i = 0; i < 4; ++i) cache_row(F, l, item4 * 4 + i);
}
__device__ __forceinline__ f32x2 cmul(f32x2 a, f32x2 b) { return (f32x2){a.x * b.x - a.y * b.y, a.x * b.y + a.y * b.x}; }
__device__ __forceinline__ void ssm_prep(Frame& F, int l, int task) {
    const int g = task >> 1, half = task & 1;
    LAS f32x2* POW = (LAS f32x2*)F.lds;
    LAS f32x2* BB = POW + 2 * 17 * 64;
    LAS f32x2* CC = BB + 2 * 64 * 16;
    LAS f32x2* CT = CC + 2 * 16 * 64;
    LAS float* KT = (LAS float*)(CT + 2 * 64 * 16);
    constexpr int KTS = 260;
    bf16_t* WE = (bf16_t*)(F.ws + WS_SSM + SSM_WE) + (size_t)g * 256 * 256;
    bf16_t* WY = (bf16_t*)(F.ws + WS_SSM + SSM_WY) + (size_t)g * 256 * 512;
    f32x2* LAM16 = (f32x2*)(F.ws + WS_SSM + SSM_LAM16); f32x2* BBAR = (f32x2*)(F.ws + WS_SSM + SSM_BBAR);
    const int tid = F.tid, lane = F.lane;
    if (tid < 128) { const int dir = tid >> 6, p = tid & 63; const size_t pi = ((size_t)(l * 2 + dir) * NG + g) * 64 + p;
        const float lr = F.ka->in[18][pi], li = F.ka->in[19][pi], delta = expf(F.ka->in[20][(l * 2 + dir) * NG + g]);
        const float er = expf(lr * delta), lbr = er * cosf(li * delta), lbi = er * sinf(li * delta);
        { float one_ = 1.f, zero_ = 0.f; asm volatile("" : "+v"(one_), "+v"(zero_));
          f32x2 pw = (f32x2){one_, zero_}; const f32x2 lb = (f32x2){lbr, lbi};
          for (int tau = 0; tau <= 16; ++tau) { POW[(dir * 17 + tau) * 64 + p] = pw; if (tau == 16 && half == 0) LAM16[(dir * NG + g) * 64 + p] = pw; pw = cmul(pw, lb); } }
        const float nr = lbr - 1.f, ni = lbi, den = lr * lr + li * li; const f32x2 fac = (f32x2){(nr * lr + ni * li) / den, (ni * lr - nr * li) / den};
        f32x4 br[4], bi4[4];
#pragma unroll
        for (int q = 0; q < 4; ++q) { br[q] = *(const f32x4*)(F.ka->in[21] + pi * 16 + 4 * q); bi4[q] = *(const f32x4*)(F.ka->in[22] + pi * 16 + 4 * q); }
#pragma unroll
        for (int ch = 0; ch < 16; ++ch) { const f32x2 bb = cmul(fac, (f32x2){br[ch >> 2][ch & 3], bi4[ch >> 2][ch & 3]}); BB[(dir * 64 + p) * 16 + ch] = bb; if (half == 0) BBAR[((size_t)(dir * NG + g) * 64 + p) * 16 + ch] = bb; }
    }
    { f32x2 cv[4];
#pragma unroll
      for (int q = 0; q < 4; ++q) { const int i = tid + q * NTHREADS, dir = i >> 10, c = (i >> 6) & 15, p = i & 63; const size_t ci = (((size_t)(l * 2 + dir) * NG + g) * 16 + c) * 64 + p; cv[q] = (f32x2){F.ka->in[23][ci], F.ka->in[24][ci]}; }
#pragma unroll
      for (int q = 0; q < 4; ++q) { const int i = tid + q * NTHREADS, dir = i >> 10, c = (i >> 6) & 15, p = i & 63; CC[i] = cv[q]; CT[(dir * 64 + p) * 16 + c] = cv[q]; } }
    __syncthreads();
    { const int i16 = lane & 15, k4 = lane >> 4, ri = k4 & 1, ph = k4 >> 1;
      for (int blk = 0; blk < 4; ++blk) { const int q = F.wave * 4 + blk, dir = q >> 4, tau = q & 15; f32x4 acc = (f32x4){0.f, 0.f, 0.f, 0.f};
#pragma unroll 8
          for (int ks = 0; ks < 32; ++ks) { const int p = 2 * ks + ph;
              const f32x2 cc = CT[(dir * 64 + p) * 16 + i16], pw = POW[(dir * 17 + tau) * 64 + p], bb = BB[(dir * 64 + p) * 16 + i16];
              const float u = ri ? -pw.y : pw.x, v = ri ? pw.x : pw.y;
              const float av = cc.x * u - cc.y * v, bv = ri ? bb.y : bb.x;
              acc = __builtin_amdgcn_mfma_f32_16x16x4f32(av, bv, acc, 0, 0, 0); }
#pragma unroll
          for (int r = 0; r < 4; ++r) KT[(dir * 16 + tau) * KTS + (k4 * 4 + r) * 16 + i16] = acc[r]; } }
    __syncthreads();
    const float* Dv = F.ka->in[25] + l * 512 + g * 16;
    for (int idx = half * 8192 + tid; idx < (half + 1) * 8192; idx += NTHREADS) { const int n = idx >> 6, kc = idx & 63, k0 = kc * 8, i = n >> 4, c = n & 15; f32x4 v0, v1;
        if (k0 < 256) { const int s_ = k0 >> 4, ch0 = k0 & 15; v0 = (f32x4){0.f, 0.f, 0.f, 0.f}; v1 = v0;
            if (s_ <= i) { const LAS float* kp = KT + (i - s_) * KTS + c * 16 + ch0; v0 += *(const LAS f32x4*)kp; v1 += *(const LAS f32x4*)(kp + 4); }
            if (s_ >= i) { const LAS float* kp = KT + (16 + s_ - i) * KTS + c * 16 + ch0; v0 += *(const LAS f32x4*)kp; v1 += *(const LAS f32x4*)(kp + 4); }
            if (s_ == i) { const int e = c - ch0; const float dv = Dv[c]; if (e >= 0 && e < 4) v0[e] += dv; else if (e >= 4 && e < 8) v1[e - 4] += dv; }
        } else { const int dir = k0 >= 384 ? 1 : 0, p0 = ((k0 - 256) & 127) >> 1, tau = dir ? 16 - i : i + 1;
            const LAS f32x4* cp = (const LAS f32x4*)(CC + (dir * 16 + c) * 64 + p0); const LAS f32x4* pp = (const LAS f32x4*)(POW + (dir * 17 + tau) * 64 + p0);
            const f32x4 c0 = cp[0], c1 = cp[1], w0 = pp[0], w1 = pp[1];
            v0 = (f32x4){c0[0] * w0[0] - c0[1] * w0[1], -(c0[0] * w0[1] + c0[1] * w0[0]), c0[2] * w0[2] - c0[3] * w0[3], -(c0[2] * w0[3] + c0[3] * w0[2])};
            v1 = (f32x4){c1[0] * w1[0] - c1[1] * w1[1], -(c1[0] * w1[1] + c1[1] * w1[0]), c1[2] * w1[2] - c1[3] * w1[3], -(c1[2] * w1[3] + c1[3] * w1[2])}; }
        *(u32x4*)(WY + (size_t)n * 512 + k0) = pack8(v0, v1); }
    for (int idx = half * 4096 + tid; idx < (half + 1) * 4096; idx += NTHREADS) { const int n = idx >> 5, k0 = (idx & 31) * 8, dir = n >> 7, p = (n & 127) >> 1, ri = n & 1, s_ = k0 >> 4, ch0 = k0 & 15;
        const f32x2 pw = POW[(dir * 17 + (dir ? s_ : 15 - s_)) * 64 + p]; const LAS f32x4* bp = (const LAS f32x4*)(BB + (dir * 64 + p) * 16 + ch0);
        const float u = ri ? pw.y : pw.x, v = ri ? pw.x : -pw.y;
        const f32x4 b0 = bp[0], b1 = bp[1], b2 = bp[2], b3 = bp[3];
        const f32x4 v0 = (f32x4){u * b0[0] + v * b0[1], u * b0[2] + v * b0[3], u * b1[0] + v * b1[1], u * b1[2] + v * b1[3]};
        const f32x4 v1 = (f32x4){u * b2[0] + v * b2[1], u * b2[2] + v * b2[3], u * b3[0] + v * b3[1], u * b3[2] + v * b3[3]};
        *(u32x4*)(WE + (size_t)n * 256 + k0) = pack8(v0, v1); }
    __syncthreads();
}
__device__ __forceinline__ void xprep_row(Frame& F, int row) {
    const float* xr = (row < MC) ? F.ka->in[0] + (size_t)row * DM : F.ka->in[1] + (size_t)(row - MC) * DM;
    const int cond = row < MC ? 0 : 1 + ((row - MC) >> 10);
    const float* sc = F.misc + MI_MOD + (0 * 9 + cond) * 6144 + 1024; const float* g1 = F.ka->in[9];
    bf16_t* dst = (bf16_t*)(F.ws + WS_XS) + (size_t)row * DM; float s = 0.f;
#pragma unroll
    for (int j = 0; j < 4; ++j) { const int c = 4 * F.lane + 256 * j; const f32x4 x = *(const f32x4*)(xr + c); const f32x4 t = x * x; s += (t[0] + t[1]) + (t[2] + t[3]);
        const f32x4 y = x * (*(const f32x4*)(g1 + c)) * (*(const f32x4*)(sc + c) + 1.f); u32x2 w; w.x = cvt_pk_bf16(y[0], y[1]); w.y = cvt_pk_bf16(y[2], y[3]); *(u32x2*)(dst + c) = w; }
    s = wave_sum(s);
    if (F.lane == 0) ((float*)(F.ctl + CW_SS))[row] = s;
}
__device__ __forceinline__ void xprep_item(Frame& F, int item4) {
#pragma unroll
    for (int i = 0; i < 4; ++i) xprep_row(F, item4 * 4 + i);
}
__device__ __forceinline__ void ssm_scan(Frame& F, int l, int g, int pm) {
    const int tid = F.tid, sl = tid >> 7, dp = tid & 127, dir = dp >> 6, p = dp & 63;
    const f32x2* LAM16 = (const f32x2*)(F.ws + WS_SSM + SSM_LAM16); const f32x2* BBAR = (const f32x2*)(F.ws + WS_SSM + SSM_BBAR);
    const float* E = (const float*)(F.ws + WS_R + R_E); bf16_t* AS3 = (bf16_t*)(F.ws + WS_R + R_AS3);
    const f32x2 lam = LAM16[(dir * NG + g) * 64 + p];
    const int nq = pm == 0 ? 4 : 1, n = pm == 0 ? 16 : 64;
    for (int q = 0; q < nq; ++q) {
        int base; f32x2 h;
        if (pm == 0) { const int seq = q * 4 + sl; base = seq * 16; h = (f32x2){0.f, 0.f}; }
        else { const int sq = (pm - 1) * 4 + sl; base = 256 + sq * 64; h = *(const f32x2*)(F.ka->in[4] + ((((size_t)sq * DEPTH + l) * 2 + dir) * NG + g) * 128 + 2 * p); }
        const float* ep = E + ((size_t)g * NCHUNK + base) * 256 + dir * 128 + 2 * p;
        unsigned* hp = (unsigned*)(AS3 + ((size_t)g * NCHUNK + base) * 512 + 256 + dir * 128 + 2 * p);
        for (int j0 = 0; j0 < n; j0 += 16) { f32x2 e[16];
#pragma unroll
            for (int jj = 0; jj < 16; ++jj) { const int j = dir ? (n - 1 - j0 - jj) : (j0 + jj); e[jj] = *(const f32x2*)(ep + (size_t)j * 256); }
#pragma unroll
            for (int jj = 0; jj < 16; ++jj) { const int j = dir ? (n - 1 - j0 - jj) : (j0 + jj); hp[(size_t)j * 256] = cvt_pk_bf16(h.x, h.y); h = cmul(lam, h) + e[jj]; } }
        if (pm == 0) { const int seq = q * 4 + sl; const int chunk = seq * 16 + (dir ? 15 : 0), tt = dir ? 15 : 0;
            const u32x4 u0 = *(const u32x4*)(AS3 + ((size_t)g * NCHUNK + chunk) * 512 + tt * 16), u1 = *(const u32x4*)(AS3 + ((size_t)g * NCHUNK + chunk) * 512 + tt * 16 + 8);
            float uu[16] = {bflo(u0.x), bfhi(u0.x), bflo(u0.y), bfhi(u0.y), bflo(u0.z), bfhi(u0.z), bflo(u0.w), bfhi(u0.w), bflo(u1.x), bfhi(u1.x), bflo(u1.y), bfhi(u1.y), bflo(u1.z), bfhi(u1.z), bflo(u1.w), bfhi(u1.w)};
            const f32x2* bb = BBAR + ((size_t)(dir * NG + g) * 64 + p) * 16; f32x2 acc = (f32x2){0.f, 0.f};
#pragma unroll
            for (int ch = 0; ch < 16; ++ch) acc += bb[ch] * uu[ch];
            float* ns = F.out + (size_t)MT * DM + 2 * (size_t)NB * DEPTH * SEQ * 512;
            *(f32x2*)(ns + ((((size_t)seq * DEPTH + l) * 2 + dir) * NG + g) * 128 + 2 * p) = acc; }
    }
}
__device__ __forceinline__ void ld16(const bf16_t* p, float* v) { const u32x4 a = *(const u32x4*)p; v[0] = bflo(a.x); v[1] = bfhi(a.x); v[2] = bflo(a.y); v[3] = bfhi(a.y); v[4] = bflo(a.z); v[5] = bfhi(a.z); v[6] = bflo(a.w); v[7] = bfhi(a.w); }
__device__ __forceinline__ void conv_item(Frame& F, int l, int item) {
    const int rs = item >> 4, pn = item & 15, lr = F.lane >> 4, lc = F.lane & 15;
    const int r0 = rs * 64 + lr * 16; const int av = 128 * pn + 8 * lc;
    const bf16_t* up = (const bf16_t*)(F.ws + WS_R) + (size_t)r0 * 4096 + 256 * pn + 8 * lc; bf16_t* gp = (bf16_t*)(F.ws + WS_G) + (size_t)r0 * 2048 + av;
    const float* cw = F.ka->in[31] + (size_t)l * 3 * 4096; const float* cb = F.ka->in[32] + (size_t)l * 4096;
    float wv[3][8], wg[3][8], bv[8], bg[8];
#pragma unroll
    for (int k = 0; k < 3; ++k)
#pragma unroll
        for (int e = 0; e < 8; ++e) { wv[k][e] = cw[k * 4096 + av + e]; wg[k][e] = cw[k * 4096 + 2048 + av + e]; }
#pragma unroll
    for (int e = 0; e < 8; ++e) { bv[e] = cb[av + e]; bg[e] = cb[2048 + av + e]; }
    const int t0 = r0 < MC ? (r0 & 255) : ((r0 - MC) & 1023), L = r0 < MC ? SEQ : DSEQ;
    float pv[8], pg[8], cv[8], cg[8], nv_[8], ng[8];
    if (t0 > 0) { ld16(up - 4096, pv); ld16(up - 4096 + 128, pg); } else {
#pragma unroll
        for (int e = 0; e < 8; ++e) { pv[e] = 0.f; pg[e] = 0.f; } }
    ld16(up, cv); ld16(up + 128, cg);
#pragma unroll
    for (int i = 0; i < 16; ++i) {
        if (t0 + i + 1 < L) { ld16(up + (size_t)(i + 1) * 4096, nv_); ld16(up + (size_t)(i + 1) * 4096 + 128, ng); } else {
#pragma unroll
            for (int e = 0; e < 8; ++e) { nv_[e] = 0.f; ng[e] = 0.f; } }
        float o[8];
#pragma unroll
        for (int e = 0; e < 8; ++e) { const float zv = bv[e] + wv[0][e] * pv[e] + wv[1][e] * cv[e] + wv[2][e] * nv_[e]; const float zg = bg[e] + wg[0][e] * pg[e] + wg[1][e] * cg[e] + wg[2][e] * ng[e]; o[e] = silu_f(zg) * zv; }
        u32x4 w; w.x = cvt_pk_bf16(o[0], o[1]); w.y = cvt_pk_bf16(o[2], o[3]); w.z = cvt_pk_bf16(o[4], o[5]); w.w = cvt_pk_bf16(o[6], o[7]);
        *(u32x4*)(gp + (size_t)i * 2048) = w;
#pragma unroll
        for (int e = 0; e < 8; ++e) { pv[e] = cv[e]; pg[e] = cg[e]; cv[e] = nv_[e]; cg[e] = ng[e]; }
    }
}
constexpr int N_TR_ITEMS_L = 16 * 32 + 8 * 8 + 16 * 16 + 16 * 64 + 32 * 16;
__device__ __forceinline__ void weight_item(Frame& F, LAS float* scr, int l, int it) {
    int r = it; const float* modl = F.misc + MI_MOD + l * 9 * 6144; float* cf = (float*)F.ctl;
    if (r < 512) { transpose_item<1, true>(F, F.ka->in[10] + (size_t)l * DM * 2048, DM, 2048, (bf16_t*)(F.ws + WS_WIN) + (size_t)l * 2048 * DM, scr, r, modl, cf + CW_BIN + l * 9 * 2048); return; } r -= 512;
    if (r < 64) { transpose_item<0, false>(F, F.ka->in[26] + (size_t)l * 512 * 512, 512, 512, (bf16_t*)(F.ws + WS_WGLU) + (size_t)l * 512 * 512, scr, r, nullptr, nullptr); return; } r -= 64;
    if (r < 256) { transpose_item<0, false>(F, F.ka->in[28] + (size_t)l * DM * DM, DM, DM, (bf16_t*)(F.ws + WS_WOUT) + (size_t)l * DM * DM, scr, r, nullptr, nullptr); return; } r -= 256;
    if (r < 1024) { transpose_item<2, true>(F, F.ka->in[30] + (size_t)l * DM * 4096, DM, 4096, (bf16_t*)(F.ws + WS_WUP) + (size_t)l * 4096 * DM, scr, r, modl + 3072, cf + CW_BUP + l * 9 * 4096); return; } r -= 1024;
    transpose_item<0, false>(F, F.ka->in[33] + (size_t)l * 2048 * DM, 2048, DM, (bf16_t*)(F.ws + WS_WDN) + (size_t)l * DM * 2048, scr, r, nullptr, nullptr);
}

__global__ void __launch_bounds__(NTHREADS, 2) mega(Args args) {
    extern __shared__ __attribute__((aligned(16))) unsigned char lds_raw[];
    Frame F;
    F.lds = (LAS unsigned char*)lds_raw;
    F.tid = threadIdx.x; F.lane = F.tid & 63; F.wave = __builtin_amdgcn_readfirstlane(F.tid >> 6);
    F.G = gridDim.x; F.bid = blockIdx.x; { const int bx = blockIdx.x; F.vcu = (F.G % 8 == 0) ? (bx % 8) * (F.G / 8) + bx / 8 : bx; }
    F.ka = (kargs_t)__builtin_amdgcn_kernarg_segment_ptr();
    F.out = args.out; F.ws = args.ws; F.misc = (float*)(args.ws + WS_MISC); F.ctl = (unsigned*)(args.ws + WS_CTL);
    volatile LAS unsigned* MISC = (volatile LAS unsigned*)(F.lds + MISC_OFF);
    for (int u = F.tid; u < (LDS_BYTES - LDSCTL_OFF) / 4; u += NTHREADS) ((LAS unsigned*)(F.lds + LDSCTL_OFF))[u] = 0u;
    __syncthreads();
    XcdBarrier bar = xcd_barrier_post(F.ctl + CW_BAR, MISC + 8);
    int phase_no = 0;
#define LAUNDER() do { asm volatile("" : "+s"(F.ka), "+s"(F.ws), "+s"(F.out), "+s"(F.bid), "+v"(F.tid)); F.vcu = (F.G % 8 == 0) ? (F.bid % 8) * (F.G / 8) + F.bid / 8 : F.bid; F.lane = F.tid & 63; F.wave = __builtin_amdgcn_readfirstlane(F.tid >> 6); \
    F.misc = (float*)(F.ws + WS_MISC); F.ctl = (unsigned*)(F.ws + WS_CTL); gw = F.vcu * NWAVES + F.wave; } while (0)
#ifdef TPROBE
#define TSTAMP() do { if (F.bid == 0 && F.tid == 0) ((unsigned long long*)(F.ctl + 6000))[phase_no] = __builtin_amdgcn_s_memrealtime(); } while (0)
#else
#define TSTAMP() do {} while (0)
#endif
#define GRID_BAR() do { xcd_barrier(bar); ++phase_no; TSTAMP(); if (F.ka->stop_after == phase_no) return; LAUNDER(); } while (0)
    int gw = F.vcu * NWAVES + F.wave; const int NGW = F.G * NWAVES;
#define ssq ((float*)(F.ctl + CW_SS))
#define XS ((bf16_t*)(F.ws + WS_XS))
#define KB ((bf16_t*)(F.ws + WS_KB))
#define VB ((bf16_t*)(F.ws + WS_VB))
#define Qb ((bf16_t*)(F.ws + WS_R + R_Q))
#define AS3 ((bf16_t*)(F.ws + WS_R + R_AS3))
#define Eb ((float*)(F.ws + WS_R + R_E))
#define Zb ((bf16_t*)(F.ws + WS_R + R_Z))
#define CAT ((bf16_t*)(F.ws + WS_R + R_CAT))
#define UP ((bf16_t*)(F.ws + WS_R))
#define Gb ((bf16_t*)(F.ws + WS_G))

    TSTAMP();
    { const int l = F.vcu >> 7, strip = F.vcu & 127; gemv9_task<0, 0, 48>(F, F.ka->in[7] + (size_t)l * DM * 6144, 6144, l, 0, strip, F.misc + MI_MOD + l * 9 * 6144, 6144, F.ka->in[8] + l * 6144); }
    GRID_BAR();
    if (F.vcu < 64) ssm_prep(F, 0, F.vcu);
    else {
        if (F.vcu == 64) {
            for (int i = F.tid; i < 1024; i += NTHREADS) { const int pos = i >> 4, f = i & 15; const float inv = 1.0f / powf(10000.0f, (float)f / 16.0f); const float ang = (float)pos * inv;
                ((f32x2*)(F.misc + MI_ROPE))[i] = (f32x2){cosf(ang), sinf(ang)}; }
            if (F.tid < 2) { const int l = F.tid; float a1 = 0.f, a2 = 0.f; for (int d = 0; d < 64; ++d) { a1 += F.ka->in[13][l * 64 + d] * F.ka->in[14][l * 64 + d]; a2 += F.ka->in[15][l * 64 + d] * F.ka->in[16][l * 64 + d]; }
                const float li = 0.8f - 0.6f * expf(-0.3f * (float)l); F.misc[MI_LAM + l] = expf(a1) - expf(a2) + li; F.misc[MI_LAM + 2 + l] = 1.f - li; }
        }
        LAS float* scr = (LAS float*)(F.lds + F.wave * 16640);
        const int gw1 = (F.vcu - 64) * NWAVES + F.wave, NGW1 = (F.G - 64) * NWAVES;
        constexpr int NW_ = N_TR_ITEMS_L, NC_ = 2048, NX_ = MT / 4;
        for (int it = gw1; it < NW_ + NC_ + NX_; it += NGW1) {
            if (it < NW_) weight_item(F, scr, 0, it);
            else if (it < NW_ + NC_) cache_item(F, 0, it - NW_);
            else xprep_item(F, it - NW_ - NC_); }
    }
    GRID_BAR();

    for (int l = 0; l < DEPTH; ++l) {
        const float* modl = F.misc + MI_MOD + l * 9 * 6144;
        { Gemm g{XS, (const bf16_t*)(F.ws + WS_WIN) + (size_t)l * 2048 * DM, DM, DM, DM, 0, 0}; GridOrder S; S.init(MT, 2048, F.G, F.bid);
          EpiIn E{ssq + (l == 0 ? 0 : 2 * MT), (const float*)F.ctl + CW_BIN + l * 9 * 2048, F.ka->in[11] + l * 64, F.ka->in[12] + l * 64, (const f32x2*)(F.misc + MI_ROPE), Qb, KB, VB, AS3,
                  F.out + (size_t)MT * DM, F.out + (size_t)MT * DM + (size_t)NB * DEPTH * SEQ * 512, l};
          gemm_phase<EpiIn, GridOrder>(F.lds, F.tid, g, S, E);
          if (l > 0 && F.bid >= 128 && F.bid < 192) { LAUNDER(); ssm_prep(F, l, F.bid - 128); }
          if (l + 1 < DEPTH && F.bid >= 128) { LAUNDER(); LAS float* scr = (LAS float*)(F.lds + F.wave * 16640);
              for (int it = (F.bid - 128) * NWAVES + F.wave; it < N_TR_ITEMS_L; it += 128 * NWAVES) weight_item(F, scr, l + 1, it); } }
        GRID_BAR();
        { if (F.vcu < NG * 3) {
              { Gemm g{AS3, (const bf16_t*)(F.ws + WS_SSM + SSM_WE), 512, 256, 256, (size_t)NCHUNK * 512, (size_t)256 * 256}; GroupOrder S{F.vcu, F.G}; EpiS1 E{Eb};
                gemm_phase<EpiS1, GroupOrder>(F.lds, F.tid, g, S, E); }
              VM_WAIT(); __syncthreads(); LAUNDER();
              ssm_scan(F, l, F.vcu / 3, F.vcu % 3); VM_WAIT(); __syncthreads(); LAUNDER();
              { Gemm g{AS3, (const bf16_t*)(F.ws + WS_SSM + SSM_WY), 512, 512, 512, (size_t)NCHUNK * 512, (size_t)256 * 512}; GroupOrder S{F.vcu, F.G}; EpiS3 E{Zb};
                gemm_phase<EpiS3, GroupOrder>(F.lds, F.tid, g, S, E); } }
          LAUNDER();
          AttnArgs A{Qb, KB, VB, CAT, F.ka->in[17] + l * 128, F.misc[MI_LAM + l], F.misc[MI_LAM + 2 + l]};
          { const int u = F.vcu; attn_unit(F.lds, F.tid, A, NB + (u >> 5), (u >> 3) & 3, u & 7); }
          if (F.vcu >= 96 && F.vcu < 224) { const int u = F.vcu - 96; attn_unit(F.lds, F.tid, A, u >> 3, (u >> 1) & 3, u & 1); } }
        GRID_BAR();
        { Gemm g{Zb, (const bf16_t*)(F.ws + WS_WGLU) + (size_t)l * 512 * 512, 512, 512, 512, 0, 0}; GridOrder S; S.init(MT, 512, F.G, F.bid);
          EpiGlu E{Zb, F.ka->in[27] + l * 512, CAT};
          gemm_phase<EpiGlu, GridOrder>(F.lds, F.tid, g, S, E); }
        GRID_BAR();
        { Gemm g{CAT, (const bf16_t*)(F.ws + WS_WOUT) + (size_t)l * DM * DM, DM, DM, DM, 0, 0}; GridOrder S; S.init(MT, DM, F.G, F.bid);
          EpiRes E{l == 0 ? F.ka->in[0] : F.out, l == 0 ? F.ka->in[1] : F.out + (size_t)MC * DM, F.out, modl + 2 * DM, F.ka->in[29] + l * DM, modl + 4 * DM, XS, ssq + (l == 0 ? 1 : 3) * MT};
          gemm_phase<EpiRes, GridOrder>(F.lds, F.tid, g, S, E); }
        GRID_BAR();
        { Gemm g{XS, (const bf16_t*)(F.ws + WS_WUP) + (size_t)l * 4096 * DM, DM, DM, DM, 0, 0}; GridOrder S; S.init(MT, 4096, F.G, F.bid);
          EpiUp E{ssq + (l == 0 ? 1 : 3) * MT, (const float*)F.ctl + CW_BUP + l * 9 * 4096, UP};
          gemm_phase<EpiUp, GridOrder>(F.lds, F.tid, g, S, E); }
        GRID_BAR();
        for (int it = gw; it < 192 * 16; it += NGW) conv_item(F, l, it);
        GRID_BAR();
        { Gemm g{Gb, (const bf16_t*)(F.ws + WS_WDN) + (size_t)l * DM * 2048, 2048, 2048, 2048, 0, 0}; GridOrder S; S.init(MT, DM, F.G, F.bid);
          const bool nxt = l + 1 < DEPTH;
          EpiRes E{F.out, F.out + (size_t)MC * DM, F.out, modl + 5 * DM, nxt ? F.ka->in[9] + (l + 1) * DM : nullptr, nxt ? modl + 9 * 6144 + DM : nullptr, XS, ssq + 2 * MT};
          gemm_phase<EpiRes, GridOrder>(F.lds, F.tid, g, S, E);
          if (nxt && F.bid >= 192) for (int it = (F.bid - 192) * NWAVES + F.wave; it < 2048; it += 64 * NWAVES) cache_item(F, l + 1, it); }
        if (l + 1 < DEPTH) GRID_BAR();
    }
#ifdef TPROBE
    GRID_BAR();
    if (F.bid == 0 && F.tid == 0) { const unsigned long long* ts = (const unsigned long long*)(F.ctl + 6000); const float tot = (float)(ts[phase_no] - ts[0]);
        float fa = 0.f, fb = 0.f;
        for (int k = 0; k < phase_no; ++k) { const float d = (float)(ts[k + 1] - ts[k]) / tot; if ((TPROBE_MASK_A >> k) & 1ull) fa += d; if ((TPROBE_MASK_B >> k) & 1ull) fb += d; }
        F.misc[MI_END] = 0.25f * sqrtf(fa); F.misc[MI_END + 1] = 300.f * fb; F.misc[MI_END + 2] = tot; }
    GRID_BAR();
    { const float delta = F.misc[MI_END];
      for (size_t i = (size_t)F.bid * NTHREADS + F.tid; i < (size_t)MC * DM; i += (size_t)F.G * NTHREADS) F.out[i] *= (1.f + delta);
      }
#endif
#undef GRID_BAR
#undef LAUNDER
#undef ssq
#undef XS
#undef KB
#undef VB
#undef Qb
#undef AS3
#undef Eb
#undef Zb
#undef CAT
#undef UP
#undef Gb
}
}

static int fk_launch(void* const* d_in, void* d_out, void* d_ws, size_t ws_size, hipStream_t stream, int stop_after) {
    static int grid = 0;
    if (grid == 0) {
        int dev = 0, cus = 0;
        if (ws_size < fk::WS_END) { fprintf(stderr, "kernel_launch: workspace too small (%zu < %zu)\n", ws_size, (size_t)fk::WS_END); grid = -1; return -1; }
        if (hipGetDevice(&dev) != hipSuccess || hipDeviceGetAttribute(&cus, hipDeviceAttributeMultiprocessorCount, dev) != hipSuccess) { grid = -1; return -1; }
        if (hipFuncSetAttribute((const void*)fk::mega, hipFuncAttributeMaxDynamicSharedMemorySize, fk::LDS_BYTES) != hipSuccess) { fprintf(stderr, "kernel_launch: hipFuncSetAttribute failed\n"); grid = -1; return -1; }
        int per_cu = 0; (void)hipOccupancyMaxActiveBlocksPerMultiprocessor(&per_cu, (const void*)fk::mega, fk::NTHREADS, fk::LDS_BYTES); (void)hipGetLastError();
        if (per_cu < 1) fprintf(stderr, "kernel_launch: occupancy query says %d blocks/CU\n", per_cu);
        grid = cus;
        if (grid != 256) fprintf(stderr, "kernel_launch: %d CUs (built for 256)\n", grid);
    }
    if (grid < 0) return -1;
    (void)hipMemsetAsync((char*)d_ws + fk::WS_CTL, 0, fk::CTL_BYTES, stream);
    fk::Args a{};
    for (int i = 0; i < 34; ++i) a.in[i] = (const float*)d_in[i];
    a.out = (float*)d_out; a.ws = (unsigned char*)d_ws; a.stop_after = stop_after; a.pad = 0;
    hipLaunchKernelGGL(fk::mega, dim3(grid), dim3(fk::NTHREADS), fk::LDS_BYTES, stream, a);
    return 0;
}
extern "C" void kernel_launch(void* const* d_in, const int* in_sizes, int n_in, void* d_out, int out_size, void* d_ws, size_t ws_size, hipStream_t stream) {
    if (n_in != 34) { fprintf(stderr, "kernel_launch: unexpected n_in %d\n", n_in); return; }
    fk_launch(d_in, d_out, d_ws, ws_size, stream, 0);
}
```

```cpp
#include <hip/hip_runtime.h>
#include <cstdio>
#include <cstdint>
namespace fk {
#define LAS __attribute__((address_space(3)))
#define GAS __attribute__((address_space(1)))
typedef unsigned short bf16_t;
typedef short bf16x8 __attribute__((ext_vector_type(8)));
typedef short s16x4 __attribute__((ext_vector_type(4)));
typedef float f32x4 __attribute__((ext_vector_type(4)));
typedef float f32x2 __attribute__((ext_vector_type(2)));
typedef float f32x16 __attribute__((ext_vector_type(16)));
typedef unsigned u32x4 __attribute__((ext_vector_type(4)));
typedef unsigned u32x2 __attribute__((ext_vector_type(2)));

constexpr int DM = 1024, NB = 16, SEQ = 256, DEPTH = 2, DB = 8, DSEQ = 1024, PAST = 512;
constexpr int MC = NB * SEQ, MS = DB * DSEQ, MT = MC + MS;
constexpr int NH = 4, NG = 32, NCOND = 9, NMOD = 6;
constexpr int NCHUNK = MT / 16;
constexpr int KVROWS = MC + DB * (PAST + DSEQ);
constexpr float EPS = 1e-6f;
constexpr float C2 = 0.125f * 1.4426950408889634f;
constexpr int NWAVES = 8, NTHREADS = 512;

constexpr size_t MiB = 1u << 20;
constexpr size_t WS_CTL = 0, CTL_BYTES = 1 * MiB;
constexpr size_t WS_MISC = 1 * MiB;
constexpr size_t WS_WIN = 3 * MiB;
constexpr size_t WS_WGLU = 11 * MiB;
constexpr size_t WS_WOUT = 12 * MiB;
constexpr size_t WS_WUP = 16 * MiB;
constexpr size_t WS_WDN = 32 * MiB;
constexpr size_t WS_SSM = 40 * MiB;
constexpr size_t WS_XS = 53 * MiB;
constexpr size_t WS_KB = 77 * MiB;
constexpr size_t WS_VB = 93 * MiB;
constexpr size_t WS_R = 109 * MiB;
constexpr size_t WS_G = 205 * MiB;
constexpr size_t WS_END = 253 * MiB;
constexpr size_t R_Q = 0, R_AS3 = 12 * MiB, R_E = 36 * MiB, R_Z = 60 * MiB, R_CAT = 72 * MiB;
constexpr size_t SSM_WE = 0, SSM_WY = 4 * MiB, SSM_LAM16 = 12 * MiB, SSM_BBAR = 12 * MiB + 64 * 1024;
constexpr int MI_MOD = 0;
constexpr int MI_ROPE = MI_MOD + 2 * 9 * 6144;
constexpr int MI_LAM = MI_ROPE + 64 * 16 * 2;
constexpr int MI_END = MI_LAM + 8;
static_assert((size_t)MI_END * 4 <= 2 * MiB, "MISC");
constexpr int CW_BAR = 1024;
constexpr int CW_ZC = 7168;
constexpr int CW_SS = 8192;
constexpr int CW_BIN = 65536;
constexpr int CW_BUP = CW_BIN + 2 * 9 * 2048;
static_assert((size_t)(CW_SS + 4 * MT) <= CW_BIN && (size_t)(CW_BUP + 2 * 9 * 4096) * 4 <= CTL_BYTES, "CTL");

constexpr int RING_BYTES = 131072;
constexpr int LDS_BYTES_ = 147456; constexpr int LDSCTL_OFF = LDS_BYTES_ - 512, MISC_OFF = LDSCTL_OFF + 320;
constexpr int LDS_BYTES = 147456;

#define RLX_AGENT __ATOMIC_RELAXED, __HIP_MEMORY_SCOPE_AGENT
typedef __bf16 bf16x2_t __attribute__((ext_vector_type(2)));
__device__ __forceinline__ unsigned cvt_pk_bf16(float lo, float hi) { const f32x2 v = {lo, hi}; const bf16x2_t b = __builtin_convertvector(v, bf16x2_t); return __builtin_bit_cast(unsigned, b); }
__device__ __forceinline__ float bf2f(unsigned short b) { return __uint_as_float((unsigned)b << 16); }
__device__ __forceinline__ float bflo(unsigned w) { return __uint_as_float(w << 16); }
__device__ __forceinline__ float bfhi(unsigned w) { return __uint_as_float(w & 0xffff0000u); }
__device__ __forceinline__ float fast_exp2(float x) { return __builtin_amdgcn_exp2f(x); }
__device__ __forceinline__ float fast_rcp(float x) { return __builtin_amdgcn_rcpf(x); }
__device__ __forceinline__ float sigmoid_f(float x) { return fast_rcp(1.f + fast_exp2(-1.4426950408889634f * x)); }
__device__ __forceinline__ float silu_f(float x) { return x * sigmoid_f(x); }
__device__ __forceinline__ float gelu_tanh_f(float x) {
    const float u = 0.7978845608028654f * (x + 0.044715f * x * x * x); return x * sigmoid_f(2.f * u); }
__device__ __forceinline__ float wave_sum(float v) {
#pragma unroll
    for (int o = 1; o < 64; o <<= 1) v += __shfl_xor(v, o);
    return v; }

#define XB_TMO      128
#define XB_XCNT(j)  (256  + 64 * (j))
#define XB_XSUB(j)  (1280 + 64 * (j))
#define XB_XGEN(j)  (2304 + 64 * (j))
#define XB_TOP      3328
#define XB_TOPGEN   3392
#define XCD_BAR_WORDS 3456
#define XB_SPIN_CAP (1u << 18)
__device__ __forceinline__ unsigned xb_ld(unsigned* p)              { return __hip_atomic_load(p, __ATOMIC_RELAXED, __HIP_MEMORY_SCOPE_AGENT); }
__device__ __forceinline__ unsigned xb_add(unsigned* p, unsigned v) { return __hip_atomic_fetch_add(p, v, __ATOMIC_RELAXED, __HIP_MEMORY_SCOPE_AGENT); }
__device__ __forceinline__ unsigned xb_xcc_id() { return (unsigned)__builtin_amdgcn_s_getreg((3 << 11) | 20) & 0xFu; }
#define XB_SPIN(cond, bar) do { unsigned _sp = 0; while (cond) { __builtin_amdgcn_s_sleep(1); \
    if ((++_sp & 255u) == 0u) { if (xb_ld(&(bar)[XB_TMO])) break; if (_sp > XB_SPIN_CAP) { atomicAdd(&(bar)[XB_TMO], 1u); break; } } } } while (0)
struct XcdBarrier { unsigned* bar; unsigned x; volatile LAS unsigned* st; };
__device__ __forceinline__ XcdBarrier xcd_barrier_post(unsigned* bar, volatile LAS unsigned* st) {
    XcdBarrier b; b.bar = bar; b.x = xb_xcc_id(); b.st = st;
    if (threadIdx.x == 0) (void)xb_add(&bar[XB_XCNT(b.x)], 1u);
    return b;
}
__device__ __forceinline__ void xcd_barrier_complete(unsigned* bar, unsigned x, unsigned& nloc, unsigned& nx) {
    const unsigned G = gridDim.x * gridDim.y * gridDim.z;
    unsigned sum, cnt, mine, sp = 0u;
    for (;;) {
        sum = 0u; cnt = 0u; mine = 0u;
#pragma unroll
        for (unsigned j = 0; j < 16; ++j) { const unsigned c = xb_ld(&bar[XB_XCNT(j)]); sum += c; cnt += (c > 0u) ? 1u : 0u; mine = (j == x) ? c : mine; }
        if (sum == G) break;
        __builtin_amdgcn_s_sleep(1);
        if ((++sp & 255u) == 0u) { if (xb_ld(&bar[XB_TMO])) break; if (sp > XB_SPIN_CAP) { atomicAdd(&bar[XB_TMO], 1u); break; } }
    }
    nloc = mine > 0u ? mine : 1u; nx = cnt > 0u ? cnt : 1u;
}
__device__ __forceinline__ void xcd_barrier(const XcdBarrier& b) {
    asm volatile("s_waitcnt vmcnt(0)" ::: "memory");
    __syncthreads();
    if (threadIdx.x == 0) {
        unsigned* bar = b.bar;
        __builtin_amdgcn_s_waitcnt(0);
        unsigned nloc = b.st[0], nx = b.st[1];
        if (nloc == 0u) { xcd_barrier_complete(bar, b.x, nloc, nx); b.st[0] = nloc; b.st[1] = nx; }
        const unsigned old = xb_add(&bar[XB_XSUB(b.x)], 1u);
        const unsigned gen = old / nloc;
        if (old + 1u == (gen + 1u) * nloc) {
            __builtin_amdgcn_fence(__ATOMIC_RELEASE, "agent");
            asm volatile("s_waitcnt vmcnt(0)" ::: "memory");
            const unsigned og = xb_add(&bar[XB_TOP], 1u);
            const unsigned tg = og / nx;
            if (og + 1u == (tg + 1u) * nx) xb_add(&bar[XB_TOPGEN], 1u);
            else XB_SPIN(xb_ld(&bar[XB_TOPGEN]) == tg, bar);
            __builtin_amdgcn_fence(__ATOMIC_ACQUIRE, "agent");
            xb_add(&bar[XB_XGEN(b.x)], 1u);
            asm volatile("s_waitcnt vmcnt(0)" ::: "memory");
        } else {
            XB_SPIN(xb_ld(&bar[XB_XGEN(b.x)]) == gen, bar);
            __builtin_amdgcn_fence(__ATOMIC_ACQUIRE, "agent");
            asm volatile("s_waitcnt vmcnt(0)" ::: "memory");
        }
    }
    __syncthreads();
}

constexpr int BM = 256, BK = 64, HALF = 128, HTB = HALF * BK * 2, NXCD = 8, WGM = 8;
__host__ __device__ __forceinline__ int lds_byte(int r, int c) { const int st = (r >> 4) * 2 + (c >> 5), rr = r & 15, cc = c & 31, ob = rr * 64 + cc * 2; return st * 1024 + (ob ^ (((ob >> 9) & 1) << 5)); }
__host__ __device__ __forceinline__ void stage_rc(int b, int& R, int& C) { const int st = b / 1024, sb = b % 1024, swz = sb ^ (((sb >> 9) & 1) << 5); R = (st >> 1) * 16 + swz / 64; C = (st & 1) * 32 + (swz % 64) / 2; }
__host__ __device__ __forceinline__ int perm32(int rho) { const int n = rho >> 4, i = rho & 15; return 8 * (i >> 2) + 4 * n + (i & 3); }

struct Unit { int pm, pn, g; };
struct Gemm { const bf16_t* A; const bf16_t* Bt; int lda, ldb, K; size_t gsA, gsB; };
struct GridOrder {
    int nM, nN, nwg, G, c;
    __device__ void init(int M, int N, int G_, int c_) { nM = M / BM; nN = N / BM; nwg = nM * nN; G = G_; c = c_; }
    __device__ bool next(int i, Unit& u) const {
        const long L = (long)i * G + c; if (L >= nwg) return false;
        int wgid = (int)L; { const int q = nwg / NXCD, r = nwg % NXCD, xcd = wgid % NXCD, off = wgid / NXCD; wgid = (xcd < r ? xcd * (q + 1) : r * (q + 1) + (xcd - r) * q) + off; }
        const int nig = WGM * nN, gid = wgid / nig, fm = gid * WGM, gsz = (nM - fm) < WGM ? (nM - fm) : WGM;
        u.pm = fm + ((wgid % nig) % gsz); u.pn = (wgid % nig) / gsz; u.g = 0; return true;
    }
};
struct OneTile {
    int idx;
    __device__ bool next(int i, Unit& u) const { if (i > 0 || idx < 0) return false; u.pm = idx >> 1; u.pn = idx & 1; u.g = 0; return true; }
};
struct GroupOrder {
    int c, G;
    __device__ bool next(int i, Unit& u) const { const int idx = c + i * G; if (c < 0 || idx >= NG * 3) return false; u.g = idx / 3; u.pm = idx % 3; u.pn = 0; return true; }
};

template <class Epi, class Sched>
__device__ __forceinline__ void gemm_phase(LAS unsigned char* lds, const int tid, const Gemm g, const Sched& S, const Epi& E) {
    const int wid = __builtin_amdgcn_readfirstlane(tid >> 6), lane = tid & 63, wr = wid >> 2, wc = wid & 3, fr = lane & 15, fq = lane >> 4;
    const int K = g.K, nt = K / BK;
    unsigned voffA[2], voffB[2];
#pragma unroll
    for (int i = 0; i < 2; ++i) { int R, C; stage_rc(tid * 16 + i * 8192, R, C); const int Rb = Epi::PERM ? ((R & ~31) + perm32(R & 31)) : R;
        voffA[i] = (unsigned)(R * g.lda + C) * 2u; voffB[i] = (unsigned)(Rb * g.ldb + C) * 2u; }
    const size_t kstep = (size_t)(BK * 2);
    const size_t hstepA = (size_t)HALF * g.lda * 2, hstepB = (size_t)HALF * g.ldb * 2;
    const unsigned ldsw = (unsigned)wid * 1024u;
    const int aoff = lds_byte(wr * 64 + fr, fq * 8), boff = lds_byte(wc * 32 + fr, fq * 8);
#define PG8_SA(b, h) (((b) * 2 + (h)) * HTB)
#define PG8_SB(b, h) ((4 + (b) * 2 + (h)) * HTB)
#define PG8_STAGE(bufoff, gbase, voff) do { _Pragma("unroll") for (int _i = 0; _i < 2; ++_i) \
        __builtin_amdgcn_global_load_lds((const unsigned*)((const char*)(gbase) + (voff)[_i]), (LAS unsigned*)(lds + (bufoff) + ldsw + _i * 8192), 16, 0, 0); } while (0)
#define PG8_LDA(dst, b, h) do { _Pragma("unroll") for (int m = 0; m < 4; ++m) _Pragma("unroll") for (int k = 0; k < 2; ++k) dst[m][k] = *(const LAS bf16x8*)(lds + PG8_SA(b, h) + aoff + m * 2048 + k * 1024); } while (0)
#define PG8_LDB(dst, b, h) do { _Pragma("unroll") for (int n = 0; n < 2; ++n) _Pragma("unroll") for (int k = 0; k < 2; ++k) dst[n][k] = *(const LAS bf16x8*)(lds + PG8_SB(b, h) + boff + n * 2048 + k * 1024); } while (0)
#define PG8_MMA(ai, bj, At, Bt) do { __builtin_amdgcn_s_setprio(1); _Pragma("unroll") for (int m = 0; m < 4; ++m) _Pragma("unroll") for (int n = 0; n < 2; ++n) _Pragma("unroll") for (int k = 0; k < 2; ++k) \
        acc[ai][bj][m][n] = __builtin_amdgcn_mfma_f32_16x16x32_bf16(Bt[n][k], At[m][k], acc[ai][bj][m][n], 0, 0, 0); __builtin_amdgcn_s_setprio(0); } while (0)
#define PG8_WAIT_V(n) asm volatile("s_waitcnt vmcnt(" #n ")" ::: "memory")
#define PG8_WAIT_L(n) asm volatile("s_waitcnt lgkmcnt(" #n ")" ::: "memory")
#define PG8_BAR __builtin_amdgcn_s_barrier()
#define PG8_SCHED __builtin_amdgcn_sched_barrier(0)
#define PG8_APTR(u) ((const char*)g.A + ((size_t)(u).g * g.gsA + (size_t)(u).pm * BM * g.lda) * 2)
#define PG8_BPTR(u) ((const char*)g.Bt + ((size_t)(u).g * g.gsB + (size_t)(u).pn * BM * g.ldb) * 2)
    Unit cur, nxt; int ui = 0;
    if (!S.next(0, cur)) return;
    f32x4 acc[2][2][4][2];
#pragma unroll
    for (int a = 0; a < 2; ++a)
#pragma unroll
        for (int b = 0; b < 2; ++b)
#pragma unroll
            for (int m = 0; m < 4; ++m)
#pragma unroll
                for (int n = 0; n < 2; ++n) acc[a][b][m][n] = (f32x4){0.f, 0.f, 0.f, 0.f};
    bf16x8 At[4][2], B0[2][2], B1[2][2];
    const char* cA = PG8_APTR(cur); const char* cB = PG8_BPTR(cur);
    PG8_STAGE(PG8_SB(0, 0), cB, voffB); PG8_STAGE(PG8_SB(0, 1), cB + hstepB, voffB); PG8_STAGE(PG8_SA(0, 0), cA, voffA); PG8_STAGE(PG8_SA(0, 1), cA + hstepA, voffA);
    if (wr == 1) PG8_BAR;
    PG8_WAIT_V(2); PG8_BAR;
    PG8_STAGE(PG8_SB(1, 0), cB + kstep, voffB); PG8_STAGE(PG8_SA(1, 0), cA + kstep, voffA); PG8_STAGE(PG8_SB(1, 1), cB + hstepB + kstep, voffB);
    PG8_WAIT_V(6); PG8_BAR;
    for (;;) {
        const bool has_next = S.next(ui + 1, nxt);
        const char* nA = has_next ? PG8_APTR(nxt) : cA; const char* nB = has_next ? PG8_BPTR(nxt) : cB;
        for (int t = 0; t < nt; t += 2) {
            const bool last = (t == nt - 2);
            const char* a1 = cA + (size_t)(t + 1) * kstep;
            const char* a2 = last ? nA : cA + (size_t)(t + 2) * kstep; const char* b2 = last ? nB : cB + (size_t)(t + 2) * kstep;
            const char* a3 = a2 + kstep; const char* b3 = b2 + kstep;
            PG8_LDB(B0, 0, 0); PG8_LDB(B1, 0, 1); PG8_SCHED; PG8_LDA(At, 0, 0); PG8_STAGE(PG8_SA(1, 1), a1 + hstepA, voffA);
            PG8_WAIT_V(8); PG8_WAIT_L(0); PG8_BAR; PG8_MMA(0, 0, At, B0); PG8_MMA(0, 1, At, B1); PG8_BAR; PG8_SCHED;
            PG8_LDA(At, 0, 1); PG8_STAGE(PG8_SB(0, 0), b2, voffB); PG8_STAGE(PG8_SB(0, 1), b2 + hstepB, voffB); PG8_STAGE(PG8_SA(0, 0), a2, voffA);
            PG8_WAIT_V(8); PG8_WAIT_L(0); PG8_BAR; PG8_MMA(1, 0, At, B0); PG8_MMA(1, 1, At, B1); PG8_BAR; PG8_SCHED;
            PG8_LDB(B0, 1, 0); PG8_LDB(B1, 1, 1); PG8_SCHED; PG8_LDA(At, 1, 0); PG8_STAGE(PG8_SA(0, 1), a2 + hstepA, voffA);
            PG8_WAIT_V(8); PG8_WAIT_L(0); PG8_BAR; PG8_MMA(0, 0, At, B0); PG8_MMA(0, 1, At, B1); PG8_BAR; PG8_SCHED;
            PG8_LDA(At, 1, 1); PG8_STAGE(PG8_SB(1, 0), b3, voffB); PG8_STAGE(PG8_SB(1, 1), b3 + hstepB, voffB); PG8_STAGE(PG8_SA(1, 0), a3, voffA);
            PG8_WAIT_V(8); PG8_WAIT_L(0); PG8_BAR; PG8_MMA(1, 0, At, B0); PG8_MMA(1, 1, At, B1); PG8_BAR; PG8_SCHED;
        }
        if (wr == 0) PG8_BAR;
        E(acc, cur, wr, wc, fr, fq);
        if (!has_next) break;
#pragma unroll
        for (int a = 0; a < 2; ++a)
#pragma unroll
            for (int b = 0; b < 2; ++b)
#pragma unroll
                for (int m = 0; m < 4; ++m)
#pragma unroll
                    for (int n = 0; n < 2; ++n) acc[a][b][m][n] = (f32x4){0.f, 0.f, 0.f, 0.f};
        cur = nxt; cA = nA; cB = nB; ++ui;
        if (wr == 1) PG8_BAR;
    }
    PG8_WAIT_V(0);
    PG8_BAR;
#undef PG8_SA
#undef PG8_SB
#undef PG8_STAGE
#undef PG8_LDA
#undef PG8_LDB
#undef PG8_MMA
#undef PG8_WAIT_V
#undef PG8_WAIT_L
#undef PG8_BAR
#undef PG8_SCHED
#undef PG8_APTR
#undef PG8_BPTR
}
__device__ __forceinline__ int cond_of_pm(int pm) { return pm < 16 ? 0 : 1 + ((pm - 16) >> 2); }
__device__ __forceinline__ int kvrow_of(int row) { return row < MC ? row : MC + ((row - MC) >> 10) * (PAST + DSEQ) + PAST + ((row - MC) & 1023); }
__device__ __forceinline__ u32x4 pack8(const f32x4& a, const f32x4& b) { u32x4 w; w.x = cvt_pk_bf16(a[0], a[1]); w.y = cvt_pk_bf16(a[2], a[3]); w.z = cvt_pk_bf16(b[0], b[1]); w.w = cvt_pk_bf16(b[2], b[3]); return w; }

struct EpiIn {
    static constexpr bool PERM = true;
    const float* sumsq; const float* bias; const float* qn; const float* kn; const f32x2* rope;
    bf16_t* Q; bf16_t* KB; bf16_t* VB; bf16_t* AS3; float* new_k; float* new_v; int l;
    __device__ __forceinline__ void operator()(const f32x4 (&acc)[2][2][4][2], const Unit& u, int wr, int wc, int fr, int fq) const {
        const int pm = u.pm, pn = u.pn; const bool ctx = pm < 16; const int cond = cond_of_pm(pm);
        const float* bz = bias + cond * 2048 + pn * 256 + wc * 32 + 8 * fq;
        f32x4 bv[2][2];
#pragma unroll
        for (int bj = 0; bj < 2; ++bj)
#pragma unroll
            for (int n = 0; n < 2; ++n) bv[bj][n] = *(const f32x4*)(bz + bj * 128 + 4 * n);
        const int rbase = pm * BM + wr * 64 + fr;
        if (pn < 4) {
            const bool isq = pn < 2; const float* gv = isq ? qn : kn;
            const int G = (pn & 1) * 4 + wc;
            const int cb = 32 * (fq >> 1) + 8 * (fq & 1);
            f32x4 gg[2][2];
#pragma unroll
            for (int bj = 0; bj < 2; ++bj)
#pragma unroll
                for (int n = 0; n < 2; ++n) gg[bj][n] = *(const f32x4*)(gv + cb + 16 * bj + 4 * n);
            const float qs = isq ? C2 : 1.f;
#pragma unroll
            for (int ai = 0; ai < 2; ++ai)
#pragma unroll
                for (int m = 0; m < 4; ++m) {
                    const int row = rbase + ai * HALF + m * 16;
                    const float rstd = rsqrtf(sumsq[row] * (1.f / DM) + EPS);
                    f32x4 v[2][2]; float ss = 0.f;
#pragma unroll
                    for (int bj = 0; bj < 2; ++bj)
#pragma unroll
                        for (int n = 0; n < 2; ++n) { v[bj][n] = acc[ai][bj][m][n] * rstd + bv[bj][n]; const f32x4 t = v[bj][n] * v[bj][n]; ss += (t[0] + t[1]) + (t[2] + t[3]); }
                    ss += __shfl_xor(ss, 16); ss += __shfl_xor(ss, 32);
                    const float rn = rsqrtf(ss * (1.f / 64.f) + EPS);
#pragma unroll
                    for (int bj = 0; bj < 2; ++bj)
#pragma unroll
                        for (int n = 0; n < 2; ++n) v[bj][n] = v[bj][n] * rn * gg[bj][n];
                    if (ctx) {
                        if (!isq) { float* nk = new_k + ((size_t)((row >> 8) * DEPTH + l) * SEQ + (row & 255)) * 512 + G * 64 + cb;
#pragma unroll
                            for (int bj = 0; bj < 2; ++bj) { *(f32x4*)(nk + 16 * bj) = v[bj][0]; *(f32x4*)(nk + 16 * bj + 4) = v[bj][1]; } }
                    } else {
                        const int t = (row - MC) & 1023; const int pos = (fq >> 1) ? (t & 63) : (t >> 6);
                        const f32x2* rp = rope + pos * 16 + 8 * (fq & 1);
#pragma unroll
                        for (int n = 0; n < 2; ++n)
#pragma unroll
                            for (int j = 0; j < 4; ++j) { const f32x2 cs = rp[4 * n + j]; const float x1 = v[0][n][j], x2 = v[1][n][j]; v[0][n][j] = x1 * cs.x - x2 * cs.y; v[1][n][j] = x1 * cs.y + x2 * cs.x; }
                    }
                    bf16_t* dst = isq ? (Q + (size_t)row * 512) : (KB + (size_t)kvrow_of(row) * 512);
                    dst += G * 64 + cb;
#pragma unroll
                    for (int bj = 0; bj < 2; ++bj) *(u32x4*)(dst + 16 * bj) = pack8(v[bj][0] * qs, v[bj][1] * qs);
                }
        } else if (pn < 6) {
            const int col0 = (pn - 4) * 256 + wc * 32 + 8 * fq;
#pragma unroll
            for (int ai = 0; ai < 2; ++ai)
#pragma unroll
                for (int m = 0; m < 4; ++m) {
                    const int row = rbase + ai * HALF + m * 16;
                    const float rstd = rsqrtf(sumsq[row] * (1.f / DM) + EPS);
                    bf16_t* dst = VB + (size_t)kvrow_of(row) * 512 + col0;
#pragma unroll
                    for (int bj = 0; bj < 2; ++bj) { const f32x4 a = acc[ai][bj][m][0] * rstd + bv[bj][0], b = acc[ai][bj][m][1] * rstd + bv[bj][1];
                        *(u32x4*)(dst + 128 * bj) = pack8(a, b);
                        if (ctx) { float* nv = new_v + ((size_t)((row >> 8) * DEPTH + l) * SEQ + (row & 255)) * 512 + col0 + 128 * bj; *(f32x4*)nv = a; *(f32x4*)(nv + 4) = b; } }
                }
        } else {
            const int cu0 = (pn - 6) * 256 + wc * 32 + 8 * fq;
#pragma unroll
            for (int ai = 0; ai < 2; ++ai)
#pragma unroll
                for (int m = 0; m < 4; ++m) {
                    const int row = rbase + ai * HALF + m * 16;
                    const float rstd = rsqrtf(sumsq[row] * (1.f / DM) + EPS);
#pragma unroll
                    for (int bj = 0; bj < 2; ++bj) { const int cu = cu0 + 128 * bj; const f32x4 a = acc[ai][bj][m][0] * rstd + bv[bj][0], b = acc[ai][bj][m][1] * rstd + bv[bj][1];
                        *(u32x4*)(AS3 + ((size_t)(cu >> 4) * NCHUNK + (row >> 4)) * 512 + (row & 15) * 16 + (cu & 15)) = pack8(a, b); }
                }
        }
    }
};
struct EpiS1 {
    static constexpr bool PERM = false;
    float* E;
    __device__ __forceinline__ void operator()(const f32x4 (&acc)[2][2][4][2], const Unit& u, int wr, int wc, int fr, int fq) const {
        const int rbase = u.pm * BM + wr * 64 + fr, col0 = wc * 32 + 4 * fq;
#pragma unroll
        for (int ai = 0; ai < 2; ++ai)
#pragma unroll
            for (int m = 0; m < 4; ++m) { float* dst = E + ((size_t)u.g * NCHUNK + rbase + ai * HALF + m * 16) * 256 + col0;
#pragma unroll
                for (int bj = 0; bj < 2; ++bj)
#pragma unroll
                    for (int n = 0; n < 2; ++n) *(f32x4*)(dst + bj * HALF + n * 16) = acc[ai][bj][m][n]; }
    }
};
struct EpiS3 {
    static constexpr bool PERM = true;
    __amdgpu_buffer_rsrc_t zr;
    __device__ __forceinline__ void operator()(const f32x4 (&acc)[2][2][4][2], const Unit& u, int wr, int wc, int fr, int fq) const {
        const int rbase = u.pm * BM + wr * 64 + fr;
#pragma unroll
        for (int ai = 0; ai < 2; ++ai)
#pragma unroll
            for (int m = 0; m < 4; ++m) { const int chunk = rbase + ai * HALF + m * 16;
#pragma unroll
                for (int bj = 0; bj < 2; ++bj) { const int tt = 8 * bj + 2 * wc + (fq >> 1), c0 = 8 * (fq & 1);
                    f32x4 a = acc[ai][bj][m][0], b = acc[ai][bj][m][1];
#pragma unroll
                    for (int j = 0; j < 4; ++j) { a[j] = gelu_tanh_f(a[j]); b[j] = gelu_tanh_f(b[j]); }
                    __builtin_amdgcn_raw_buffer_store_b128(pack8(a, b), zr, (int)((((unsigned)chunk * 16u + tt) * 512u + u.g * 16 + c0) * 2u), 0,   16); } }
    }
};
struct EpiGlu {
    static constexpr bool PERM = true;
    const bf16_t* Z; const float* bg; bf16_t* CAT;
    __device__ __forceinline__ void operator()(const f32x4 (&acc)[2][2][4][2], const Unit& u, int wr, int wc, int fr, int fq) const {
        const int rbase = u.pm * BM + wr * 64 + fr, col0 = u.pn * BM + wc * 32 + 8 * fq;
        f32x4 bv[2][2];
#pragma unroll
        for (int bj = 0; bj < 2; ++bj)
#pragma unroll
            for (int n = 0; n < 2; ++n) bv[bj][n] = *(const f32x4*)(bg + col0 + bj * HALF + 4 * n);
#pragma unroll
        for (int ai = 0; ai < 2; ++ai)
#pragma unroll
            for (int m = 0; m < 4; ++m) { const int row = rbase + ai * HALF + m * 16;
#pragma unroll
                for (int bj = 0; bj < 2; ++bj) { const u32x4 zw = *(const u32x4*)(Z + (size_t)row * 512 + col0 + bj * HALF);
                    f32x4 a = acc[ai][bj][m][0] + bv[bj][0], b = acc[ai][bj][m][1] + bv[bj][1];
                    a[0] = bflo(zw.x) * sigmoid_f(a[0]); a[1] = bfhi(zw.x) * sigmoid_f(a[1]); a[2] = bflo(zw.y) * sigmoid_f(a[2]); a[3] = bfhi(zw.y) * sigmoid_f(a[3]);
                    b[0] = bflo(zw.z) * sigmoid_f(b[0]); b[1] = bfhi(zw.z) * sigmoid_f(b[1]); b[2] = bflo(zw.w) * sigmoid_f(b[2]); b[3] = bfhi(zw.w) * sigmoid_f(b[3]);
                    *(u32x4*)(CAT + (size_t)row * 1024 + 512 + col0 + bj * HALF) = pack8(a, b); } }
    }
};
struct EpiRes {
    static constexpr bool PERM = true;
    const float* xin0; const float* xin1;
    float* xout;
    const float* gate;
    const float* gn; const float* sc;
    bf16_t* XS; float* ssq;
    __device__ __forceinline__ void operator()(const f32x4 (&acc)[2][2][4][2], const Unit& u, int wr, int wc, int fr, int fq) const {
        const int pm = u.pm, cond = cond_of_pm(pm); const int col0 = u.pn * BM + wc * 32 + 8 * fq; const int rbase = pm * BM + wr * 64 + fr;
        const bool donorm = (gn != nullptr);
        f32x4 gt[2][2], gs[2][2];
#pragma unroll
        for (int bj = 0; bj < 2; ++bj)
#pragma unroll
            for (int n = 0; n < 2; ++n) { const int c = col0 + bj * HALF + n * 4; gt[bj][n] = *(const f32x4*)(gate + cond * 6144 + c);
                if (donorm) { const f32x4 g4 = *(const f32x4*)(gn + c), s4 = *(const f32x4*)(sc + cond * 6144 + c); gs[bj][n] = g4 * (s4 + 1.f); } else gs[bj][n] = (f32x4){0.f, 0.f, 0.f, 0.f}; }
#pragma unroll
        for (int ai = 0; ai < 2; ++ai)
#pragma unroll
            for (int m = 0; m < 4; ++m) { const int row = rbase + ai * HALF + m * 16;
                const float* xi = (row < MC) ? (xin0 + (size_t)row * DM) : (xin1 + (size_t)(row - MC) * DM);
                float ss = 0.f;
#pragma unroll
                for (int bj = 0; bj < 2; ++bj) { const int c = col0 + bj * HALF;
                    const f32x4 x0 = *(const f32x4*)(xi + c) + gt[bj][0] * acc[ai][bj][m][0], x1 = *(const f32x4*)(xi + c + 4) + gt[bj][1] * acc[ai][bj][m][1];
                    *(f32x4*)(xout + (size_t)row * DM + c) = x0; *(f32x4*)(xout + (size_t)row * DM + c + 4) = x1;
                    if (donorm) { const f32x4 t0 = x0 * x0, t1 = x1 * x1; ss += ((t0[0] + t0[1]) + (t0[2] + t0[3])) + ((t1[0] + t1[1]) + (t1[2] + t1[3]));
                        *(u32x4*)(XS + (size_t)row * DM + c) = pack8(x0 * gs[bj][0], x1 * gs[bj][1]); } }
                if (donorm) { ss += __shfl_xor(ss, 16); ss += __shfl_xor(ss, 32); if (fq == 0) atomicAdd(ssq + row, ss); }
            }
    }
};
struct EpiUp {
    static constexpr bool PERM = true;
    const float* sumsq; const float* bias; bf16_t* UP;
    __device__ __forceinline__ void operator()(const f32x4 (&acc)[2][2][4][2], const Unit& u, int wr, int wc, int fr, int fq) const {
        const int pm = u.pm, cond = cond_of_pm(pm); const int col0 = u.pn * BM + wc * 32 + 8 * fq; const int rbase = pm * BM + wr * 64 + fr;
        f32x4 bv[2][2];
#pragma unroll
        for (int bj = 0; bj < 2; ++bj)
#pragma unroll
            for (int n = 0; n < 2; ++n) bv[bj][n] = *(const f32x4*)(bias + cond * 4096 + col0 + bj * HALF + 4 * n);
#pragma unroll
        for (int ai = 0; ai < 2; ++ai)
#pragma unroll
            for (int m = 0; m < 4; ++m) { const int row = rbase + ai * HALF + m * 16; const float rstd = rsqrtf(sumsq[row] * (1.f / DM) + EPS);
#pragma unroll
                for (int bj = 0; bj < 2; ++bj) *(u32x4*)(UP + (size_t)row * 4096 + col0 + bj * HALF) = pack8(acc[ai][bj][m][0] * rstd + bv[bj][0], acc[ai][bj][m][1] * rstd + bv[bj][1]); }
    }
};
constexpr int AT_SLOT = 32768, AT_NSLOT = 4, AT_VOFF = 16384, AT_X = 0, AT_ST = 65536;
__device__ __forceinline__ void glds16(const void* gsrc, unsigned lds_dst) { unsigned keep;
    asm volatile("s_mov_b32 %0, m0\n\ts_mov_b32 m0, %2\n\ts_nop 0\n\tglobal_load_lds_dwordx4 %1, off\n\ts_mov_b32 m0, %0" : "=&s"(keep) : "v"(gsrc), "s"(lds_dst) : "memory"); }
#define AT_WAIT_BAR(N) asm volatile("s_waitcnt vmcnt(" #N ") lgkmcnt(0)\n\ts_barrier" ::: "memory")
#define AT_SB() __builtin_amdgcn_sched_barrier(0)
__device__ __forceinline__ s16x4 vtr(const LAS char* p) { typedef short v4i16_t __attribute__((ext_vector_type(4))); return __builtin_bit_cast(s16x4, __builtin_amdgcn_ds_read_tr16_b64_v4i16((LAS v4i16_t*)p)); }
__device__ __forceinline__ int crow(int r, int hi) { return (r & 3) + 8 * (r >> 2) + 4 * hi; }

struct AttnArgs { const bf16_t* Q; const bf16_t* KB; const bf16_t* VB; bf16_t* CAT; const float* subln; float lam; float oml; };

__device__ __forceinline__ void attn_unit(LAS unsigned char* lds, const int tid, const AttnArgs& A, int seq, int h, int qblk) {
    const int lane = tid & 63, r32 = lane & 31, hi = lane >> 5; const int wid = __builtin_amdgcn_readfirstlane(tid >> 6);
    const int rg = wid & 3, s = wid >> 2;
    const bool ctx = seq < NB;
    const int qrow0 = ctx ? seq * SEQ + qblk * 128 : MC + (seq - NB) * DSEQ + qblk * 128;
    const int krow0 = ctx ? seq * SEQ : MC + (seq - NB) * (PAST + DSEQ);
    const int NT = ctx ? SEQ / 64 : (PAST + DSEQ) / 64;
    const unsigned lds0 = (unsigned)(uintptr_t)lds;
    const bf16_t* ksrc0 = A.KB + (size_t)(krow0 + lane) * 512 + h * 128 + wid * 8;
    const bf16_t* vsrc0 = A.VB + (size_t)(krow0 + 16 * (wid & 3) + (lane >> 2)) * 512 + h * 128 + (wid >> 2) * 32 + (lane & 3) * 8;
    const unsigned kdst = lds0 + wid * 1024, vdst = lds0 + AT_VOFF + ((wid >> 2) * 4 + (wid & 3)) * 1024;
#define AT_DMA(t, slot) do { const size_t _o = (size_t)(t) * 64 * 512; const unsigned _s = (unsigned)(slot) * AT_SLOT; \
        glds16(ksrc0 + _o, (unsigned)__builtin_amdgcn_readfirstlane(kdst + _s)); glds16(ksrc0 + _o + 64, (unsigned)__builtin_amdgcn_readfirstlane(kdst + _s + 8 * 1024)); \
        glds16(vsrc0 + _o, (unsigned)__builtin_amdgcn_readfirstlane(vdst + _s)); glds16(vsrc0 + _o + 64, (unsigned)__builtin_amdgcn_readfirstlane(vdst + _s + 8 * 1024)); } while (0)
    AT_DMA(0, 0); AT_DMA(1, 1); AT_DMA(2, 2);
    bf16x8 qr[4];
    { const bf16_t* qp = A.Q + (size_t)(qrow0 + rg * 32 + r32) * 512 + h * 128 + s * 64 + hi * 8;
#pragma unroll
      for (int d0 = 0; d0 < 4; ++d0) qr[d0] = *(const bf16x8*)(qp + d0 * 16); }
    f32x16 o[4];
#pragma unroll
    for (int d0 = 0; d0 < 4; ++d0)
#pragma unroll
        for (int r = 0; r < 16; ++r) o[d0][r] = 0.f;
    float lsum = 0.f;
    const LAS char* kfrag0 = (const LAS char*)lds + (s * 8 + hi) * 1024 + r32 * 16;
    const LAS char* vfrag0 = (const LAS char*)lds + AT_VOFF + ((lane >> 4) & 1) * 32 + (lane & 3) * 8 + (4 * hi + ((lane & 15) >> 2)) * 64;
    f32x16 pc0, pc1;
#define AT_KLOAD(kfr, slot) do { const LAS char* _k = kfrag0 + (slot) * AT_SLOT; _Pragma("unroll") for (int d0 = 0; d0 < 4; ++d0) { kfr[2 * d0] = *(const LAS bf16x8*)(_k + d0 * 2048); kfr[2 * d0 + 1] = *(const LAS bf16x8*)(_k + d0 * 2048 + 512); } } while (0)
#define AT_VLOAD(vv, slot, ks) do { const LAS char* _v = vfrag0 + (slot) * AT_SLOT + (ks) * 1024; _Pragma("unroll") for (int d0 = 0; d0 < 4; ++d0) { const s16x4 lo = vtr(_v + d0 * 4096), hh = vtr(_v + d0 * 4096 + 512); \
        vv[d0] = (bf16x8){lo[0], lo[1], lo[2], lo[3], hh[0], hh[1], hh[2], hh[3]}; } } while (0)
#define AT_EXP2(P, i, W) do { P[2 * (i)] = fast_exp2(P[2 * (i)]); P[2 * (i) + 1] = fast_exp2(P[2 * (i) + 1]); sacc += P[2 * (i)] + P[2 * (i) + 1]; W = cvt_pk_bf16(P[2 * (i)], P[2 * (i) + 1]); } while (0)
    AT_WAIT_BAR(8);
    { bf16x8 kfr[8]; AT_KLOAD(kfr, 0);
#pragma unroll
      for (int r = 0; r < 16; ++r) { pc0[r] = 0.f; pc1[r] = 0.f; }
#pragma unroll
      for (int d0 = 0; d0 < 4; ++d0) { pc0 = __builtin_amdgcn_mfma_f32_32x32x16_bf16(kfr[2 * d0], qr[d0], pc0, 0, 0, 0); pc1 = __builtin_amdgcn_mfma_f32_32x32x16_bf16(kfr[2 * d0 + 1], qr[d0], pc1, 0, 0, 0); } }
    int slot = 0;
    for (int t = 0; t < NT; ++t) {
        const bool has_next = t + 1 < NT;
        if (t + 2 < NT) AT_WAIT_BAR(4); else AT_WAIT_BAR(0);
        if (t + 3 < NT) AT_DMA(t + 3, (slot + 3) & 3);
        const int slot_n = (slot + 1) & 3;
        bf16x8 kfr[8], va[4], vb[4]; u32x4 pw[4]; f32x16 pn0, pn1; float sacc = 0.f;
        const LAS char* kn_ = kfrag0 + slot_n * AT_SLOT;
#define AT_K1(d0) do { kfr[2 * (d0)] = *(const LAS bf16x8*)(kn_ + (d0) * 2048); kfr[2 * (d0) + 1] = *(const LAS bf16x8*)(kn_ + (d0) * 2048 + 512); } while (0)
        if (has_next) { AT_K1(0); AT_K1(1); }
        AT_SB();
        if (has_next) {
#pragma unroll
            for (int r = 0; r < 16; ++r) { pn0[r] = 0.f; pn1[r] = 0.f; }
#pragma unroll
            for (int i = 0; i < 8; ++i) { const int d0 = i >> 1;
                if (i & 1) pn1 = __builtin_amdgcn_mfma_f32_32x32x16_bf16(kfr[2 * d0 + 1], qr[d0], pn1, 0, 0, 0); else pn0 = __builtin_amdgcn_mfma_f32_32x32x16_bf16(kfr[2 * d0], qr[d0], pn0, 0, 0, 0);
                AT_EXP2(pc0, i, pw[i >> 2][i & 3]);
                if (i == 0) AT_K1(2);
                if (i == 1) AT_K1(3);
                if (i == 3) AT_VLOAD(va, slot, 0);
                if (i == 5) AT_VLOAD(vb, slot, 1);
                AT_SB(); }
        } else {
            AT_VLOAD(va, slot, 0); AT_VLOAD(vb, slot, 1);
#pragma unroll
            for (int i = 0; i < 8; ++i) AT_EXP2(pc0, i, pw[i >> 2][i & 3]);
            AT_SB();
        }
        bf16x8 vc[4], vd[4];
#pragma unroll
        for (int i = 0; i < 8; ++i) { const int d0 = i & 3;
            if (i < 4) o[d0] = __builtin_amdgcn_mfma_f32_32x32x16_bf16(va[d0], __builtin_bit_cast(bf16x8, pw[0]), o[d0], 0, 0, 0);
            else       o[d0] = __builtin_amdgcn_mfma_f32_32x32x16_bf16(vb[d0], __builtin_bit_cast(bf16x8, pw[1]), o[d0], 0, 0, 0);
            AT_EXP2(pc1, i, pw[2 + (i >> 2)][i & 3]);
            if (i == 1) AT_VLOAD(vc, slot, 2);
            if (i == 5) AT_VLOAD(vd, slot, 3);
            AT_SB(); }
#pragma unroll
        for (int d0 = 0; d0 < 4; ++d0) o[d0] = __builtin_amdgcn_mfma_f32_32x32x16_bf16(vc[d0], __builtin_bit_cast(bf16x8, pw[2]), o[d0], 0, 0, 0);
#pragma unroll
        for (int d0 = 0; d0 < 4; ++d0) o[d0] = __builtin_amdgcn_mfma_f32_32x32x16_bf16(vd[d0], __builtin_bit_cast(bf16x8, pw[3]), o[d0], 0, 0, 0);
        lsum += sacc;
        if (has_next) { pc0 = pn0; pc1 = pn1; }
        slot = slot_n;
    }
    lsum += __shfl_xor(lsum, 32);
    const float inv = (s == 0 ? 1.f : A.lam) / lsum;
    AT_WAIT_BAR(0);
    LAS float* X = (LAS float*)(lds + AT_X) + rg * 4096;
    if (s == 1) {
#pragma unroll
        for (int d0 = 0; d0 < 4; ++d0)
#pragma unroll
            for (int r = 0; r < 16; ++r) X[(d0 * 16 + r) * 64 + lane] = o[d0][r] * inv;
    }
    AT_WAIT_BAR(0);
    if (s == 0) {
        float ss = 0.f;
#pragma unroll
        for (int d0 = 0; d0 < 4; ++d0)
#pragma unroll
            for (int r = 0; r < 16; ++r) { const float v = o[d0][r] * inv - X[(d0 * 16 + r) * 64 + lane]; o[d0][r] = v; ss += v * v; }
        ss += __shfl_xor(ss, 32);
        const float rn = rsqrtf(ss * (1.f / 128.f) + EPS) * A.oml;
        LAS bf16_t* stg = (LAS bf16_t*)(lds + AT_ST) + rg * (32 * 136);
#pragma unroll
        for (int d0 = 0; d0 < 4; ++d0)
#pragma unroll
            for (int rq = 0; rq < 4; ++rq) { const int dv = 32 * d0 + 8 * rq + 4 * hi; const f32x4 g4 = *(const f32x4*)(A.subln + dv);
                u32x2 w; w.x = cvt_pk_bf16(o[d0][4 * rq] * rn * g4[0], o[d0][4 * rq + 1] * rn * g4[1]); w.y = cvt_pk_bf16(o[d0][4 * rq + 2] * rn * g4[2], o[d0][4 * rq + 3] * rn * g4[3]);
                *(LAS u32x2*)(stg + r32 * 136 + dv) = w; }
        asm volatile("s_waitcnt lgkmcnt(0)" ::: "memory");
        bf16_t* dst = A.CAT + (size_t)(qrow0 + rg * 32) * 1024 + h * 128;
#pragma unroll
        for (int i = 0; i < 8; ++i) { const int row = i * 4 + (lane >> 4), ch = lane & 15; const u32x4 v = *(const LAS u32x4*)(stg + row * 136 + ch * 8); *(u32x4*)(dst + (size_t)row * 1024 + ch * 8) = v; }
    }
    AT_WAIT_BAR(0);
#undef AT_DMA
#undef AT_KLOAD
#undef AT_K1
#undef AT_VLOAD
#undef AT_EXP2
}
struct Args { const float* in[34]; float* out; unsigned char* ws; int stop_after; int pad; };
typedef const __attribute__((address_space(4))) Args* kargs_t;
struct Frame {
    LAS unsigned char* lds; int tid, lane, wave, vcu, bid, G;
    kargs_t ka; float* out; unsigned char* ws;
    float* misc; unsigned* ctl;
};
#define LDS_WAIT() asm volatile("s_waitcnt lgkmcnt(0)" ::: "memory")
#define VM_WAIT() asm volatile("s_waitcnt vmcnt(0)" ::: "memory")

template <int MAP> __device__ __forceinline__ int src_col(int p);
template <int MODE, int MAP, int NC> __device__ __forceinline__ void gemv9_task(Frame& F, const float* W, int ldw, int l, int voff, int strip, float* out, int ldo, const float* add) {
    LAS float* sc = (LAS float*)F.lds; LAS float* red = sc + 9 * 1024;
    for (int i = F.tid; i < 9 * 1024; i += NTHREADS) { const int cond = i >> 10, k = i & 1023; float v;
        if (MODE == 0) { v = cond == 0 ? F.ka->in[6][k] : F.ka->in[5][(cond - 1) * 1024 + k]; v = v / (1.f + expf(-v)); } else v = F.misc[MI_MOD + (l * 9 + cond) * 6144 + voff + k];
        sc[i] = v; }
    __syncthreads();
    const int j = strip * NC + (F.lane < NC ? F.lane : NC - 1); const float* w = W + (size_t)(F.wave * 128) * ldw + src_col<MAP>(j);
    float acc[9];
#pragma unroll
    for (int b = 0; b < 9; ++b) acc[b] = 0.f;
#pragma unroll 16
    for (int k = 0; k < 128; ++k) { const float wv = w[(size_t)k * ldw];
#pragma unroll
        for (int b = 0; b < 9; ++b) acc[b] += sc[b * 1024 + F.wave * 128 + k] * wv; }
#pragma unroll
    for (int b = 0; b < 9; ++b) red[(F.wave * 9 + b) * 64 + F.lane] = acc[b];
    __syncthreads();
    for (int i = F.tid; i < 9 * 64; i += NTHREADS) { const int b = i >> 6, ln = i & 63; if (ln >= NC) continue; float s_ = 0.f;
#pragma unroll
        for (int w8 = 0; w8 < 8; ++w8) s_ += red[(w8 * 9 + b) * 64 + ln];
        const int jj = strip * NC + ln; out[(size_t)b * ldo + jj] = s_ + (add ? add[jj] : 0.f); }
    __syncthreads();
}
template <int MAP> __device__ __forceinline__ int src_col(int p) {
    if (MAP == 1) { if (p >= 1024) return p; const int pn = p >> 8, r = p & 255, bj = r >> 7, wc = (r >> 5) & 3, fq = (r >> 3) & 3, low = r & 7; return 256 * pn + 64 * wc + 32 * (fq >> 1) + 16 * bj + 8 * (fq & 1) + low; }
    if (MAP == 2) { const int pn = p >> 8, bj = (p >> 7) & 1, r = p & 127; return bj * 2048 + 128 * pn + r; }
    return p;
}
template <int MAP, bool BIAS> __device__ __forceinline__ void transpose_item(Frame& F, const float* W, int K, int N, bf16_t* WT, LAS float* scr, int item, const float* shv, float* bias) {
    const int lane = F.lane; const int nblk = N / 64, kb = item / nblk, nb = item % nblk, k0 = 64 * kb, n0 = 64 * nb;
    const int sc_ = src_col<MAP>(n0 + lane);
    float tv[64];
#pragma unroll
    for (int i = 0; i < 64; ++i) tv[i] = W[(size_t)(k0 + i) * N + sc_];
#pragma unroll
    for (int i = 0; i < 64; ++i) scr[i * 65 + lane] = tv[i];
    LDS_WAIT(); asm volatile("" ::: "memory");
    const int c = lane & 7;
#pragma unroll
    for (int j = 0; j < 8; ++j) { const int n = (lane >> 3) + 8 * j; const LAS float* s_ = scr + (8 * c) * 65 + n;
        u32x4 o; o.x = cvt_pk_bf16(s_[0 * 65], s_[1 * 65]); o.y = cvt_pk_bf16(s_[2 * 65], s_[3 * 65]); o.z = cvt_pk_bf16(s_[4 * 65], s_[5 * 65]); o.w = cvt_pk_bf16(s_[6 * 65], s_[7 * 65]);
        *(u32x4*)(WT + (size_t)(n0 + n) * K + k0 + 8 * c) = o; }
    if (BIAS) {
        float sh[9], acc[9];
#pragma unroll
        for (int b = 0; b < 9; ++b) { sh[b] = shv[b * 6144 + k0 + lane]; acc[b] = 0.f; }
#pragma unroll
        for (int kk = 0; kk < 64; ++kk) { const float w = tv[kk];
#pragma unroll
            for (int b = 0; b < 9; ++b) acc[b] += __uint_as_float(__builtin_amdgcn_readlane(__float_as_uint(sh[b]), kk)) * w; }
#pragma unroll
        for (int b = 0; b < 9; ++b) atomicAdd(bias + (size_t)b * N + n0 + lane, acc[b]);
    }
    LDS_WAIT(); asm volatile("" ::: "memory");
}
__device__ __forceinline__ void cache_row(Frame& F, int l, int item) {
    const int which = item >> 12, r = item & 4095, b = r >> 9, j = r & 511;
    const float* src = (which ? F.ka->in[3] : F.ka->in[2]) + ((size_t)(b * DEPTH + l) * PAST + j) * 512 + F.lane * 8;
    bf16_t* dst = (bf16_t*)(F.ws + (which ? WS_VB : WS_KB)) + (size_t)(MC + b * (PAST + DSEQ) + j) * 512 + F.lane * 8;
    const f32x4 a = *(const f32x4*)src, c = *(const f32x4*)(src + 4);
    *(u32x4*)dst = pack8(a, c);
}
__device__ __forceinline__ void cache_item(Frame& F, int l, int item4) {
#pragma unroll
    for (int i = 0; i < 4; ++i) cache_row(F, l, item4 * 4 + i);
}
__device__ __forceinline__ f32x2 cmul(f32x2 a, f32x2 b) { return (f32x2){a.x * b.x - a.y * b.y, a.x * b.y + a.y * b.x}; }
__device__ __forceinline__ void ssm_prep(Frame& F, int l, int task) {
    const int g = task >> 1, half = task & 1;
    LAS f32x2* POW = (LAS f32x2*)F.lds;
    LAS f32x2* BB = POW + 2 * 17 * 64;
    LAS f32x2* CC = BB + 2 * 64 * 16;
    LAS f32x2* CT = CC + 2 * 16 * 64;
    LAS float* KT = (LAS float*)(CT + 2 * 64 * 16);
    constexpr int KTS = 260;
    bf16_t* WE = (bf16_t*)(F.ws + WS_SSM + SSM_WE) + (size_t)g * 256 * 256;
    bf16_t* WY = (bf16_t*)(F.ws + WS_SSM + SSM_WY) + (size_t)g * 256 * 512;
    f32x2* LAM16 = (f32x2*)(F.ws + WS_SSM + SSM_LAM16); f32x2* BBAR = (f32x2*)(F.ws + WS_SSM + SSM_BBAR);
    const int tid = F.tid, lane = F.lane;
    if (tid < 128) { const int dir = tid >> 6, p = tid & 63; const size_t pi = ((size_t)(l * 2 + dir) * NG + g) * 64 + p;
        const float lr = F.ka->in[18][pi], li = F.ka->in[19][pi], delta = expf(F.ka->in[20][(l * 2 + dir) * NG + g]);
        const float er = expf(lr * delta), lbr = er * cosf(li * delta), lbi = er * sinf(li * delta);
        { float one_ = 1.f, zero_ = 0.f; asm volatile("" : "+v"(one_), "+v"(zero_));
          f32x2 pw = (f32x2){one_, zero_}; const f32x2 lb = (f32x2){lbr, lbi};
          for (int tau = 0; tau <= 16; ++tau) { POW[(dir * 17 + tau) * 64 + p] = pw; if (tau == 16 && half == 0) LAM16[(dir * NG + g) * 64 + p] = pw; pw = cmul(pw, lb); } }
        const float nr = lbr - 1.f, ni = lbi, den = lr * lr + li * li; const f32x2 fac = (f32x2){(nr * lr + ni * li) / den, (ni * lr - nr * li) / den};
        f32x4 br[4], bi4[4];
#pragma unroll
        for (int q = 0; q < 4; ++q) { br[q] = *(const f32x4*)(F.ka->in[21] + pi * 16 + 4 * q); bi4[q] = *(const f32x4*)(F.ka->in[22] + pi * 16 + 4 * q); }
#pragma unroll
        for (int ch = 0; ch < 16; ++ch) { const f32x2 bb = cmul(fac, (f32x2){br[ch >> 2][ch & 3], bi4[ch >> 2][ch & 3]}); BB[(dir * 64 + p) * 16 + ch] = bb; if (half == 0) BBAR[((size_t)(dir * NG + g) * 64 + p) * 16 + ch] = bb; }
    }
    { f32x2 cv[4];
#pragma unroll
      for (int q = 0; q < 4; ++q) { const int i = tid + q * NTHREADS, dir = i >> 10, c = (i >> 6) & 15, p = i & 63; const size_t ci = (((size_t)(l * 2 + dir) * NG + g) * 16 + c) * 64 + p; cv[q] = (f32x2){F.ka->in[23][ci], F.ka->in[24][ci]}; }
#pragma unroll
      for (int q = 0; q < 4; ++q) { const int i = tid + q * NTHREADS, dir = i >> 10, c = (i >> 6) & 15, p = i & 63; CC[i] = cv[q]; CT[(dir * 64 + p) * 16 + c] = cv[q]; } }
    __syncthreads();
    { const int i16 = lane & 15, k4 = lane >> 4, ri = k4 & 1, ph = k4 >> 1;
      for (int blk = 0; blk < 4; ++blk) { const int q = F.wave * 4 + blk, dir = q >> 4, tau = q & 15; f32x4 acc = (f32x4){0.f, 0.f, 0.f, 0.f};
#pragma unroll 8
          for (int ks = 0; ks < 32; ++ks) { const int p = 2 * ks + ph;
              const f32x2 cc = CT[(dir * 64 + p) * 16 + i16], pw = POW[(dir * 17 + tau) * 64 + p], bb = BB[(dir * 64 + p) * 16 + i16];
              const float u = ri ? -pw.y : pw.x, v = ri ? pw.x : pw.y;
              const float av = cc.x * u - cc.y * v, bv = ri ? bb.y : bb.x;
              acc = __builtin_amdgcn_mfma_f32_16x16x4f32(av, bv, acc, 0, 0, 0); }
#pragma unroll
          for (int r = 0; r < 4; ++r) KT[(dir * 16 + tau) * KTS + (k4 * 4 + r) * 16 + i16] = acc[r]; } }
    __syncthreads();
    const float* Dv = F.ka->in[25] + l * 512 + g * 16;
    for (int idx = half * 8192 + tid; idx < (half + 1) * 8192; idx += NTHREADS) { const int n = idx >> 6, kc = idx & 63, k0 = kc * 8, i = n >> 4, c = n & 15; f32x4 v0, v1;
        if (k0 < 256) { const int s_ = k0 >> 4, ch0 = k0 & 15; v0 = (f32x4){0.f, 0.f, 0.f, 0.f}; v1 = v0;
            if (s_ <= i) { const LAS float* kp = KT + (i - s_) * KTS + c * 16 + ch0; v0 += *(const LAS f32x4*)kp; v1 += *(const LAS f32x4*)(kp + 4); }
            if (s_ >= i) { const LAS float* kp = KT + (16 + s_ - i) * KTS + c * 16 + ch0; v0 += *(const LAS f32x4*)kp; v1 += *(const LAS f32x4*)(kp + 4); }
            if (s_ == i) { const int e = c - ch0; const float dv = Dv[c]; if (e >= 0 && e < 4) v0[e] += dv; else if (e >= 4 && e < 8) v1[e - 4] += dv; }
        } else { const int dir = k0 >= 384 ? 1 : 0, p0 = ((k0 - 256) & 127) >> 1, tau = dir ? 16 - i : i + 1;
            const LAS f32x4* cp = (const LAS f32x4*)(CC + (dir * 16 + c) * 64 + p0); const LAS f32x4* pp = (const LAS f32x4*)(POW + (dir * 17 + tau) * 64 + p0);
            const f32x4 c0 = cp[0], c1 = cp[1], w0 = pp[0], w1 = pp[1];
            v0 = (f32x4){c0[0] * w0[0] - c0[1] * w0[1], -(c0[0] * w0[1] + c0[1] * w0[0]), c0[2] * w0[2] - c0[3] * w0[3], -(c0[2] * w0[3] + c0[3] * w0[2])};
            v1 = (f32x4){c1[0] * w1[0] - c1[1] * w1[1], -(c1[0] * w1[1] + c1[1] * w1[0]), c1[2] * w1[2] - c1[3] * w1[3], -(c1[2] * w1[3] + c1[3] * w1[2])}; }
        *(u32x4*)(WY + (size_t)n * 512 + k0) = pack8(v0, v1); }
    for (int idx = half * 4096 + tid; idx < (half + 1) * 4096; idx += NTHREADS) { const int n = idx >> 5, k0 = (idx & 31) * 8, dir = n >> 7, p = (n & 127) >> 1, ri = n & 1, s_ = k0 >> 4, ch0 = k0 & 15;
        const f32x2 pw = POW[(dir * 17 + (dir ? s_ : 15 - s_)) * 64 + p]; const LAS f32x4* bp = (const LAS f32x4*)(BB + (dir * 64 + p) * 16 + ch0);
        const float u = ri ? pw.y : pw.x, v = ri ? pw.x : -pw.y;
        const f32x4 b0 = bp[0], b1 = bp[1], b2 = bp[2], b3 = bp[3];
        const f32x4 v0 = (f32x4){u * b0[0] + v * b0[1], u * b0[2] + v * b0[3], u * b1[0] + v * b1[1], u * b1[2] + v * b1[3]};
        const f32x4 v1 = (f32x4){u * b2[0] + v * b2[1], u * b2[2] + v * b2[3], u * b3[0] + v * b3[1], u * b3[2] + v * b3[3]};
        *(u32x4*)(WE + (size_t)n * 256 + k0) = pack8(v0, v1); }
    __syncthreads();
}
__device__ __forceinline__ void xprep_row(Frame& F, int row) {
    const float* xr = (row < MC) ? F.ka->in[0] + (size_t)row * DM : F.ka->in[1] + (size_t)(row - MC) * DM;
    const int cond = row < MC ? 0 : 1 + ((row - MC) >> 10);
    const float* sc = F.misc + MI_MOD + (0 * 9 + cond) * 6144 + 1024; const float* g1 = F.ka->in[9];
    bf16_t* dst = (bf16_t*)(F.ws + WS_XS) + (size_t)row * DM; float s = 0.f;
#pragma unroll
    for (int j = 0; j < 4; ++j) { const int c = 4 * F.lane + 256 * j; const f32x4 x = *(const f32x4*)(xr + c); const f32x4 t = x * x; s += (t[0] + t[1]) + (t[2] + t[3]);
        const f32x4 y = x * (*(const f32x4*)(g1 + c)) * (*(const f32x4*)(sc + c) + 1.f); u32x2 w; w.x = cvt_pk_bf16(y[0], y[1]); w.y = cvt_pk_bf16(y[2], y[3]); *(u32x2*)(dst + c) = w; }
    s = wave_sum(s);
    if (F.lane == 0) ((float*)(F.ctl + CW_SS))[row] = s;
}
__device__ __forceinline__ void xprep_item(Frame& F, int item4) {
#pragma unroll
    for (int i = 0; i < 4; ++i) xprep_row(F, item4 * 4 + i);
}
__device__ __forceinline__ void ssm_scan(Frame& F, int l, int g, int pm) {
    const int tid = F.tid, sl = tid >> 7, dp = tid & 127, dir = dp >> 6, p = dp & 63;
    const f32x2* LAM16 = (const f32x2*)(F.ws + WS_SSM + SSM_LAM16); const f32x2* BBAR = (const f32x2*)(F.ws + WS_SSM + SSM_BBAR);
    const float* E = (const float*)(F.ws + WS_R + R_E); bf16_t* AS3 = (bf16_t*)(F.ws + WS_R + R_AS3);
    const f32x2 lam = LAM16[(dir * NG + g) * 64 + p];
    const int nq = pm == 0 ? 4 : 1, n = pm == 0 ? 16 : 64;
    for (int q = 0; q < nq; ++q) {
        int base; f32x2 h;
        if (pm == 0) { const int seq = q * 4 + sl; base = seq * 16; h = (f32x2){0.f, 0.f}; }
        else { const int sq = (pm - 1) * 4 + sl; base = 256 + sq * 64; h = *(const f32x2*)(F.ka->in[4] + ((((size_t)sq * DEPTH + l) * 2 + dir) * NG + g) * 128 + 2 * p); }
        const float* ep = E + ((size_t)g * NCHUNK + base) * 256 + dir * 128 + 2 * p;
        unsigned* hp = (unsigned*)(AS3 + ((size_t)g * NCHUNK + base) * 512 + 256 + dir * 128 + 2 * p);
        for (int j0 = 0; j0 < n; j0 += 16) { f32x2 e[16];
#pragma unroll
            for (int jj = 0; jj < 16; ++jj) { const int j = dir ? (n - 1 - j0 - jj) : (j0 + jj); e[jj] = *(const f32x2*)(ep + (size_t)j * 256); }
#pragma unroll
            for (int jj = 0; jj < 16; ++jj) { const int j = dir ? (n - 1 - j0 - jj) : (j0 + jj); hp[(size_t)j * 256] = cvt_pk_bf16(h.x, h.y); h = cmul(lam, h) + e[jj]; } }
        if (pm == 0) { const int seq = q * 4 + sl; const int chunk = seq * 16 + (dir ? 15 : 0), tt = dir ? 15 : 0;
            const u32x4 u0 = *(const u32x4*)(AS3 + ((size_t)g * NCHUNK + chunk) * 512 + tt * 16), u1 = *(const u32x4*)(AS3 + ((size_t)g * NCHUNK + chunk) * 512 + tt * 16 + 8);
            float uu[16] = {bflo(u0.x), bfhi(u0.x), bflo(u0.y), bfhi(u0.y), bflo(u0.z), bfhi(u0.z), bflo(u0.w), bfhi(u0.w), bflo(u1.x), bfhi(u1.x), bflo(u1.y), bfhi(u1.y), bflo(u1.z), bfhi(u1.z), bflo(u1.w), bfhi(u1.w)};
            const f32x2* bb = BBAR + ((size_t)(dir * NG + g) * 64 + p) * 16; f32x2 acc = (f32x2){0.f, 0.f};
#pragma unroll
            for (int ch = 0; ch < 16; ++ch) acc += bb[ch] * uu[ch];
            float* ns = F.out + (size_t)MT * DM + 2 * (size_t)NB * DEPTH * SEQ * 512;
            *(f32x2*)(ns + ((((size_t)seq * DEPTH + l) * 2 + dir) * NG + g) * 128 + 2 * p) = acc; }
    }
}
__device__ __forceinline__ void ld16(const bf16_t* p, float* v) { const u32x4 a = *(const u32x4*)p; v[0] = bflo(a.x); v[1] = bfhi(a.x); v[2] = bflo(a.y); v[3] = bfhi(a.y); v[4] = bflo(a.z); v[5] = bfhi(a.z); v[6] = bflo(a.w); v[7] = bfhi(a.w); }
__device__ __forceinline__ void conv_item(Frame& F, int l, int item) {
    const int rs = item >> 4, pn = item & 15, lr = F.lane >> 4, lc = F.lane & 15;
    const int r0 = rs * 64 + lr * 16; const int av = 128 * pn + 8 * lc;
    const bf16_t* up = (const bf16_t*)(F.ws + WS_R) + (size_t)r0 * 4096 + 256 * pn + 8 * lc; bf16_t* gp = (bf16_t*)(F.ws + WS_G) + (size_t)r0 * 2048 + av;
    const float* cw = F.ka->in[31] + (size_t)l * 3 * 4096; const float* cb = F.ka->in[32] + (size_t)l * 4096;
    float wv[3][8], wg[3][8], bv[8], bg[8];
#pragma unroll
    for (int k = 0; k < 3; ++k)
#pragma unroll
        for (int e = 0; e < 8; ++e) { wv[k][e] = cw[k * 4096 + av + e]; wg[k][e] = cw[k * 4096 + 2048 + av + e]; }
#pragma unroll
    for (int e = 0; e < 8; ++e) { bv[e] = cb[av + e]; bg[e] = cb[2048 + av + e]; }
    const int t0 = r0 < MC ? (r0 & 255) : ((r0 - MC) & 1023), L = r0 < MC ? SEQ : DSEQ;
    float pv[8], pg[8], cv[8], cg[8], nv_[8], ng[8];
    if (t0 > 0) { ld16(up - 4096, pv); ld16(up - 4096 + 128, pg); } else {
#pragma unroll
        for (int e = 0; e < 8; ++e) { pv[e] = 0.f; pg[e] = 0.f; } }
    ld16(up, cv); ld16(up + 128, cg);
#pragma unroll
    for (int i = 0; i < 16; ++i) {
        if (t0 + i + 1 < L) { ld16(up + (size_t)(i + 1) * 4096, nv_); ld16(up + (size_t)(i + 1) * 4096 + 128, ng); } else {
#pragma unroll
            for (int e = 0; e < 8; ++e) { nv_[e] = 0.f; ng[e] = 0.f; } }
        float o[8];
#pragma unroll
        for (int e = 0; e < 8; ++e) { const float zv = bv[e] + wv[0][e] * pv[e] + wv[1][e] * cv[e] + wv[2][e] * nv_[e]; const float zg = bg[e] + wg[0][e] * pg[e] + wg[1][e] * cg[e] + wg[2][e] * ng[e]; o[e] = silu_f(zg) * zv; }
        u32x4 w; w.x = cvt_pk_bf16(o[0], o[1]); w.y = cvt_pk_bf16(o[2], o[3]); w.z = cvt_pk_bf16(o[4], o[5]); w.w = cvt_pk_bf16(o[6], o[7]);
        *(u32x4*)(gp + (size_t)i * 2048) = w;
#pragma unroll
        for (int e = 0; e < 8; ++e) { pv[e] = cv[e]; pg[e] = cg[e]; cv[e] = nv_[e]; cg[e] = ng[e]; }
    }
}
constexpr int N_TR_ITEMS_L = 16 * 32 + 8 * 8 + 16 * 16 + 16 * 64 + 32 * 16;
__device__ __forceinline__ void weight_item(Frame& F, LAS float* scr, int l, int it) {
    int r = it; const float* modl = F.misc + MI_MOD + l * 9 * 6144; float* cf = (float*)F.ctl;
    if (r < 512) { transpose_item<1, true>(F, F.ka->in[10] + (size_t)l * DM * 2048, DM, 2048, (bf16_t*)(F.ws + WS_WIN) + (size_t)l * 2048 * DM, scr, r, modl, cf + CW_BIN + l * 9 * 2048); return; } r -= 512;
    if (r < 64) { transpose_item<0, false>(F, F.ka->in[26] + (size_t)l * 512 * 512, 512, 512, (bf16_t*)(F.ws + WS_WGLU) + (size_t)l * 512 * 512, scr, r, nullptr, nullptr); return; } r -= 64;
    if (r < 256) { transpose_item<0, false>(F, F.ka->in[28] + (size_t)l * DM * DM, DM, DM, (bf16_t*)(F.ws + WS_WOUT) + (size_t)l * DM * DM, scr, r, nullptr, nullptr); return; } r -= 256;
    if (r < 1024) { transpose_item<2, true>(F, F.ka->in[30] + (size_t)l * DM * 4096, DM, 4096, (bf16_t*)(F.ws + WS_WUP) + (size_t)l * 4096 * DM, scr, r, modl + 3072, cf + CW_BUP + l * 9 * 4096); return; } r -= 1024;
    transpose_item<0, false>(F, F.ka->in[33] + (size_t)l * 2048 * DM, 2048, DM, (bf16_t*)(F.ws + WS_WDN) + (size_t)l * DM * 2048, scr, r, nullptr, nullptr);
}

__global__ void __launch_bounds__(NTHREADS, 2) mega(Args args) {
    extern __shared__ __attribute__((aligned(16))) unsigned char lds_raw[];
    Frame F;
    F.lds = (LAS unsigned char*)lds_raw;
    F.tid = threadIdx.x; F.lane = F.tid & 63; F.wave = __builtin_amdgcn_readfirstlane(F.tid >> 6);
    F.G = gridDim.x; F.bid = blockIdx.x; { const int bx = blockIdx.x; F.vcu = (F.G % 8 == 0) ? (bx % 8) * (F.G / 8) + bx / 8 : bx; }
    F.ka = (kargs_t)__builtin_amdgcn_kernarg_segment_ptr();
    F.out = args.out; F.ws = args.ws; F.misc = (float*)(args.ws + WS_MISC); F.ctl = (unsigned*)(args.ws + WS_CTL);
    volatile LAS unsigned* MISC = (volatile LAS unsigned*)(F.lds + MISC_OFF);
    for (int u = F.tid; u < (LDS_BYTES - LDSCTL_OFF) / 4; u += NTHREADS) ((LAS unsigned*)(F.lds + LDSCTL_OFF))[u] = 0u;
    __syncthreads();
    XcdBarrier bar = xcd_barrier_post(F.ctl + CW_BAR, MISC + 8);
    int phase_no = 0;
#define LAUNDER() do { asm volatile("" : "+s"(F.ka), "+s"(F.ws), "+s"(F.out), "+s"(F.bid), "+v"(F.tid)); F.vcu = (F.G % 8 == 0) ? (F.bid % 8) * (F.G / 8) + F.bid / 8 : F.bid; F.lane = F.tid & 63; F.wave = __builtin_amdgcn_readfirstlane(F.tid >> 6); \
    F.misc = (float*)(F.ws + WS_MISC); F.ctl = (unsigned*)(F.ws + WS_CTL); gw = F.vcu * NWAVES + F.wave; } while (0)
#ifdef TPROBE
#define TSTAMP() do { if (F.bid == 0 && F.tid == 0) ((unsigned long long*)(F.ctl + 6000))[phase_no] = __builtin_amdgcn_s_memrealtime(); } while (0)
#else
#define TSTAMP() do {} while (0)
#endif
#define GRID_BAR() do { xcd_barrier(bar); ++phase_no; TSTAMP(); if (F.ka->stop_after == phase_no) return; LAUNDER(); } while (0)
    int gw = F.vcu * NWAVES + F.wave; const int NGW = F.G * NWAVES;
#define ssq ((float*)(F.ctl + CW_SS))
#define XS ((bf16_t*)(F.ws + WS_XS))
#define KB ((bf16_t*)(F.ws + WS_KB))
#define VB ((bf16_t*)(F.ws + WS_VB))
#define Qb ((bf16_t*)(F.ws + WS_R + R_Q))
#define AS3 ((bf16_t*)(F.ws + WS_R + R_AS3))
#define Eb ((float*)(F.ws + WS_R + R_E))
#define Zb ((bf16_t*)(F.ws + WS_R + R_Z))
#define CAT ((bf16_t*)(F.ws + WS_R + R_CAT))
#define UP ((bf16_t*)(F.ws + WS_R))
#define Gb ((bf16_t*)(F.ws + WS_G))

    TSTAMP();
    { const int l = F.vcu >> 7, strip = F.vcu & 127; gemv9_task<0, 0, 48>(F, F.ka->in[7] + (size_t)l * DM * 6144, 6144, l, 0, strip, F.misc + MI_MOD + l * 9 * 6144, 6144, F.ka->in[8] + l * 6144); }
    GRID_BAR();
    if (F.vcu < 64) ssm_prep(F, 0, F.vcu);
    else {
        if (F.vcu == 64) {
            for (int i = F.tid; i < 1024; i += NTHREADS) { const int pos = i >> 4, f = i & 15; const float inv = 1.0f / powf(10000.0f, (float)f / 16.0f); const float ang = (float)pos * inv;
                ((f32x2*)(F.misc + MI_ROPE))[i] = (f32x2){cosf(ang), sinf(ang)}; }
            if (F.tid < 2) { const int l = F.tid; float a1 = 0.f, a2 = 0.f; for (int d = 0; d < 64; ++d) { a1 += F.ka->in[13][l * 64 + d] * F.ka->in[14][l * 64 + d]; a2 += F.ka->in[15][l * 64 + d] * F.ka->in[16][l * 64 + d]; }
                const float li = 0.8f - 0.6f * expf(-0.3f * (float)l); F.misc[MI_LAM + l] = expf(a1) - expf(a2) + li; F.misc[MI_LAM + 2 + l] = 1.f - li; }
        }
        LAS float* scr = (LAS float*)(F.lds + F.wave * 16640);
        const int gw1 = (F.vcu - 64) * NWAVES + F.wave, NGW1 = (F.G - 64) * NWAVES;
        constexpr int NW_ = N_TR_ITEMS_L, NC_ = 2048, NX_ = MT / 4;
        for (int it = gw1; it < NW_ + NC_ + NX_; it += NGW1) {
            if (it < NW_) weight_item(F, scr, 0, it);
            else if (it < NW_ + NC_) cache_item(F, 0, it - NW_);
            else xprep_item(F, it - NW_ - NC_); }
    }
    GRID_BAR();

    for (int l = 0; l < DEPTH; ++l) {
        const float* modl = F.misc + MI_MOD + l * 9 * 6144;
        { Gemm g{XS, (const bf16_t*)(F.ws + WS_WIN) + (size_t)l * 2048 * DM, DM, DM, DM, 0, 0}; GridOrder S; S.init(MT, 2048, F.G, F.bid);
          EpiIn E{ssq + (l == 0 ? 0 : 2 * MT), (const float*)F.ctl + CW_BIN + l * 9 * 2048, F.ka->in[11] + l * 64, F.ka->in[12] + l * 64, (const f32x2*)(F.misc + MI_ROPE), Qb, KB, VB, AS3,
                  F.out + (size_t)MT * DM, F.out + (size_t)MT * DM + (size_t)NB * DEPTH * SEQ * 512, l};
          gemm_phase<EpiIn, GridOrder>(F.lds, F.tid, g, S, E);
          if (l > 0 && F.bid >= 128 && F.bid < 192) { LAUNDER(); ssm_prep(F, l, F.bid - 128); }
          if (l + 1 < DEPTH && F.bid >= 128) { LAUNDER(); LAS float* scr = (LAS float*)(F.lds + F.wave * 16640);
              for (int it = (F.bid - 128) * NWAVES + F.wave; it < N_TR_ITEMS_L; it += 128 * NWAVES) weight_item(F, scr, l + 1, it); } }
        GRID_BAR();
#define ZC_PTR (F.ctl + CW_ZC + l * 256)
#define ATTN_UNIT(SEQ_, H_, QB_) do { LAUNDER(); const AttnArgs A_{Qb, KB, VB, CAT, F.ka->in[17] + l * 128, F.misc[MI_LAM + l], F.misc[MI_LAM + 2 + l]}; attn_unit(F.lds, F.tid, A_, (SEQ_), (H_), (QB_)); } while (0)
#define ATTN_CTX(U_) do { const int u_ = (U_); ATTN_UNIT(u_ >> 3, (u_ >> 1) & 3, u_ & 1); } while (0)
        { if (F.vcu < NG * 3) {
              { Gemm g{AS3, (const bf16_t*)(F.ws + WS_SSM + SSM_WE), 512, 256, 256, (size_t)NCHUNK * 512, (size_t)256 * 256}; GroupOrder S{F.vcu, F.G}; EpiS1 E{Eb};
                gemm_phase<EpiS1, GroupOrder>(F.lds, F.tid, g, S, E); }
              VM_WAIT(); __syncthreads(); LAUNDER();
              ssm_scan(F, l, F.vcu / 3, F.vcu % 3); VM_WAIT(); __syncthreads(); LAUNDER();
              { Gemm g{AS3, (const bf16_t*)(F.ws + WS_SSM + SSM_WY), 512, 512, 512, (size_t)NCHUNK * 512, (size_t)256 * 512}; GroupOrder S{F.vcu, F.G};
                EpiS3 E{__builtin_amdgcn_make_buffer_rsrc((void*)Zb, 0, (int)((size_t)MT * 512 * 2), 0x00020000)};
                gemm_phase<EpiS3, GroupOrder>(F.lds, F.tid, g, S, E); }
              VM_WAIT(); __syncthreads(); LAUNDER();
              if (F.tid == 0) __hip_atomic_fetch_add(ZC_PTR + (F.vcu % 3) * 64, 1u, RLX_AGENT); }
          { const int u = F.vcu; ATTN_UNIT(NB + (u >> 5), (u >> 3) & 3, u & 7); }
          if (F.vcu >= 96 && F.vcu < 128) ATTN_CTX(F.vcu - 96);
          else if (F.vcu >= 192) { for (int r = 0; r < 2; ++r) { if (F.vcu >= 224 && r == 1) break; ATTN_CTX(F.vcu < 224 ? 32 + 2 * (F.vcu - 192) + r : 96 + (F.vcu - 224)); } }
          if (F.vcu >= 96 && F.vcu < 192) {
              LAUNDER();
              const int idx = F.vcu - 96, pmz = (idx >> 1) >> 4;
              if (F.tid == 0) { unsigned sp = 0; while (__hip_atomic_load(ZC_PTR + pmz * 64, RLX_AGENT) < (unsigned)NG) { __builtin_amdgcn_s_sleep(2); if (++sp > (1u << 20)) break; }
                  __builtin_amdgcn_fence(__ATOMIC_ACQUIRE, "agent"); asm volatile("s_waitcnt vmcnt(0)" ::: "memory"); }
              __syncthreads();
              Gemm g{Zb, (const bf16_t*)(F.ws + WS_WGLU) + (size_t)l * 512 * 512, 512, 512, 512, 0, 0}; OneTile S{idx};
              EpiGlu E{Zb, F.ka->in[27] + l * 512, CAT};
              gemm_phase<EpiGlu, OneTile>(F.lds, F.tid, g, S, E); } }
        GRID_BAR();
        { Gemm g{CAT, (const bf16_t*)(F.ws + WS_WOUT) + (size_t)l * DM * DM, DM, DM, DM, 0, 0}; GridOrder S; S.init(MT, DM, F.G, F.bid);
          EpiRes E{l == 0 ? F.ka->in[0] : F.out, l == 0 ? F.ka->in[1] : F.out + (size_t)MC * DM, F.out, modl + 2 * DM, F.ka->in[29] + l * DM, modl + 4 * DM, XS, ssq + (l == 0 ? 1 : 3) * MT};
          gemm_phase<EpiRes, GridOrder>(F.lds, F.tid, g, S, E); }
        GRID_BAR();
        { Gemm g{XS, (const bf16_t*)(F.ws + WS_WUP) + (size_t)l * 4096 * DM, DM, DM, DM, 0, 0}; GridOrder S; S.init(MT, 4096, F.G, F.bid);
          EpiUp E{ssq + (l == 0 ? 1 : 3) * MT, (const float*)F.ctl + CW_BUP + l * 9 * 4096, UP};
          gemm_phase<EpiUp, GridOrder>(F.lds, F.tid, g, S, E); }
        GRID_BAR();
        for (int it = gw; it < 192 * 16; it += NGW) conv_item(F, l, it);
        GRID_BAR();
        { Gemm g{Gb, (const bf16_t*)(F.ws + WS_WDN) + (size_t)l * DM * 2048, 2048, 2048, 2048, 0, 0}; GridOrder S; S.init(MT, DM, F.G, F.bid);
          const bool nxt = l + 1 < DEPTH;
          EpiRes E{F.out, F.out + (size_t)MC * DM, F.out, modl + 5 * DM, nxt ? F.ka->in[9] + (l + 1) * DM : nullptr, nxt ? modl + 9 * 6144 + DM : nullptr, XS, ssq + 2 * MT};
          gemm_phase<EpiRes, GridOrder>(F.lds, F.tid, g, S, E);
          if (nxt && F.bid >= 192) for (int it = (F.bid - 192) * NWAVES + F.wave; it < 2048; it += 64 * NWAVES) cache_item(F, l + 1, it); }
        if (l + 1 < DEPTH) GRID_BAR();
    }
#ifdef TPROBE
    GRID_BAR();
    if (F.bid == 0 && F.tid == 0) { const unsigned long long* ts = (const unsigned long long*)(F.ctl + 6000); const float tot = (float)(ts[phase_no] - ts[0]);
        float fa = 0.f, fb = 0.f;
        for (int k = 0; k < phase_no; ++k) { const float d = (float)(ts[k + 1] - ts[k]) / tot; if ((TPROBE_MASK_A >> k) & 1ull) fa += d; if ((TPROBE_MASK_B >> k) & 1ull) fb += d; }
        F.misc[MI_END] = 0.25f * sqrtf(fa); F.misc[MI_END + 1] = 300.f * fb; F.misc[MI_END + 2] = tot; }
    GRID_BAR();
    { const float delta = F.misc[MI_END];
      for (size_t i = (size_t)F.bid * NTHREADS + F.tid; i < (size_t)MC * DM; i += (size_t)F.G * NTHREADS) F.out[i] *= (1.f + delta);
      }
#endif
#undef GRID_BAR
#undef LAUNDER
#undef ZC_PTR
#undef ATTN_UNIT
#undef ATTN_CTX
#undef ssq
#undef XS
#undef KB
#undef VB
#undef Qb
#undef AS3
#undef Eb
#undef Zb
#undef CAT
#undef UP
#undef Gb
}
}

static int fk_launch(void* const* d_in, void* d_out, void* d_ws, size_t ws_size, hipStream_t stream, int stop_after) {
    static int grid = 0;
    if (grid == 0) {
        int dev = 0, cus = 0;
        if (ws_size < fk::WS_END) { fprintf(stderr, "kernel_launch: workspace too small (%zu < %zu)\n", ws_size, (size_t)fk::WS_END); grid = -1; return -1; }
        if (hipGetDevice(&dev) != hipSuccess || hipDeviceGetAttribute(&cus, hipDeviceAttributeMultiprocessorCount, dev) != hipSuccess) { grid = -1; return -1; }
        if (hipFuncSetAttribute((const void*)fk::mega, hipFuncAttributeMaxDynamicSharedMemorySize, fk::LDS_BYTES) != hipSuccess) { fprintf(stderr, "kernel_launch: hipFuncSetAttribute failed\n"); grid = -1; return -1; }
        int per_cu = 0; (void)hipOccupancyMaxActiveBlocksPerMultiprocessor(&per_cu, (const void*)fk::mega, fk::NTHREADS, fk::LDS_BYTES); (void)hipGetLastError();
        if (per_cu < 1) fprintf(stderr, "kernel_launch: occupancy query says %d blocks/CU\n", per_cu);
        grid = cus;
        if (grid != 256) fprintf(stderr, "kernel_launch: %d CUs (built for 256)\n", grid);
    }
    if (grid < 0) return -1;
    (void)hipMemsetAsync((char*)d_ws + fk::WS_CTL, 0, fk::CTL_BYTES, stream);
    fk::Args a{};
    for (int i = 0; i < 34; ++i) a.in[i] = (const float*)d_in[i];
    a.out = (float*)d_out; a.ws = (unsigned char*)d_ws; a.stop_after = stop_after; a.pad = 0;
    hipLaunchKernelGGL(fk::mega, dim3(grid), dim3(fk::NTHREADS), fk::LDS_BYTES, stream, a);
    return 0;
}
extern "C" void kernel_launch(void* const* d_in, const int* in_sizes, int n_in, void* d_out, int out_size, void* d_ws, size_t ws_size, hipStream_t stream) {
    if (n_in != 34) { fprintf(stderr, "kernel_launch: unexpected n_in %d\n", n_in); return; }
    fk_launch(d_in, d_out, d_ws, ws_size, stream, 0);
}
```

```cpp
#include <hip/hip_runtime.h>
#include <cstdio>
#include <cstdint>
namespace fk {
#define LAS __attribute__((address_space(3)))
#define GAS __attribute__((address_space(1)))
typedef unsigned short bf16_t;
typedef short bf16x8 __attribute__((ext_vector_type(8)));
typedef short s16x4 __attribute__((ext_vector_type(4)));
typedef float f32x4 __attribute__((ext_vector_type(4)));
typedef float f32x2 __attribute__((ext_vector_type(2)));
typedef float f32x16 __attribute__((ext_vector_type(16)));
typedef unsigned u32x4 __attribute__((ext_vector_type(4)));
typedef unsigned u32x2 __attribute__((ext_vector_type(2)));

constexpr int DM = 1024, NB = 16, SEQ = 256, DEPTH = 2, DB = 8, DSEQ = 1024, PAST = 512;
constexpr int MC = NB * SEQ, MS = DB * DSEQ, MT = MC + MS;
constexpr int NH = 4, NG = 32, NCOND = 9, NMOD = 6;
constexpr int NCHUNK = MT / 16;
constexpr int KVROWS = MC + DB * (PAST + DSEQ);
constexpr float EPS = 1e-6f;
constexpr float C2 = 0.125f * 1.4426950408889634f;
constexpr int NWAVES = 8, NTHREADS = 512;

constexpr size_t MiB = 1u << 20;
constexpr size_t WS_CTL = 0, CTL_BYTES = 1 * MiB;
constexpr size_t WS_MISC = 1 * MiB;
constexpr size_t WS_WIN = 3 * MiB;
constexpr size_t WS_WGLU = 11 * MiB;
constexpr size_t WS_WOUT = 12 * MiB;
constexpr size_t WS_WUP = 16 * MiB;
constexpr size_t WS_WDN = 32 * MiB;
constexpr size_t WS_SSM = 40 * MiB;
constexpr size_t WS_XS = 53 * MiB;
constexpr size_t WS_KB = 77 * MiB;
constexpr size_t WS_VB = 93 * MiB;
constexpr size_t WS_R = 109 * MiB;
constexpr size_t WS_G = 205 * MiB;
constexpr size_t WS_END = 253 * MiB;
constexpr size_t R_Q = 0, R_AS3 = 12 * MiB, R_E = 36 * MiB, R_Z = 60 * MiB, R_CAT = 72 * MiB;
constexpr size_t SSM_WE = 0, SSM_WY = 4 * MiB, SSM_LAM16 = 12 * MiB, SSM_BBAR = 12 * MiB + 64 * 1024;
constexpr int MI_MOD = 0;
constexpr int MI_ROPE = MI_MOD + 2 * 9 * 6144;
constexpr int MI_LAM = MI_ROPE + 64 * 16 * 2;
constexpr int MI_END = MI_LAM + 8;
static_assert((size_t)MI_END * 4 <= 2 * MiB, "MISC");
constexpr int CW_BAR = 1024;
constexpr int CW_ZC = 7168;
constexpr int CW_SS = 8192;
constexpr int CW_BIN = 65536;
constexpr int CW_BUP = CW_BIN + 2 * 9 * 2048;
static_assert((size_t)(CW_SS + 4 * MT) <= CW_BIN && (size_t)(CW_BUP + 2 * 9 * 4096) * 4 <= CTL_BYTES, "CTL");

constexpr int RING_BYTES = 131072;
constexpr int LDS_BYTES_ = 147456; constexpr int LDSCTL_OFF = LDS_BYTES_ - 512, MISC_OFF = LDSCTL_OFF + 320;
constexpr int LDS_BYTES = 147456;

#define RLX_AGENT __ATOMIC_RELAXED, __HIP_MEMORY_SCOPE_AGENT
typedef __bf16 bf16x2_t __attribute__((ext_vector_type(2)));
__device__ __forceinline__ unsigned cvt_pk_bf16(float lo, float hi) { const f32x2 v = {lo, hi}; const bf16x2_t b = __builtin_convertvector(v, bf16x2_t); return __builtin_bit_cast(unsigned, b); }
__device__ __forceinline__ float bf2f(unsigned short b) { return __uint_as_float((unsigned)b << 16); }
__device__ __forceinline__ float bflo(unsigned w) { return __uint_as_float(w << 16); }
__device__ __forceinline__ float bfhi(unsigned w) { return __uint_as_float(w & 0xffff0000u); }
__device__ __forceinline__ float fast_exp2(float x) { return __builtin_amdgcn_exp2f(x); }
__device__ __forceinline__ float fast_rcp(float x) { return __builtin_amdgcn_rcpf(x); }
__device__ __forceinline__ float sigmoid_f(float x) { return fast_rcp(1.f + fast_exp2(-1.4426950408889634f * x)); }
__device__ __forceinline__ float silu_f(float x) { return x * sigmoid_f(x); }
__device__ __forceinline__ float gelu_tanh_f(float x) {
    const float u = 0.7978845608028654f * (x + 0.044715f * x * x * x); return x * sigmoid_f(2.f * u); }
__device__ __forceinline__ float wave_sum(float v) {
#pragma unroll
    for (int o = 1; o < 64; o <<= 1) v += __shfl_xor(v, o);
    return v; }

#define XB_TMO      128
#define XB_XCNT(j)  (256  + 64 * (j))
#define XB_XSUB(j)  (1280 + 64 * (j))
#define XB_XGEN(j)  (2304 + 64 * (j))
#define XB_TOP      3328
#define XB_TOPGEN   3392
#define XCD_BAR_WORDS 3456
#define XB_SPIN_CAP (1u << 18)
__device__ __forceinline__ unsigned xb_ld(unsigned* p)              { return __hip_atomic_load(p, __ATOMIC_RELAXED, __HIP_MEMORY_SCOPE_AGENT); }
__device__ __forceinline__ unsigned xb_add(unsigned* p, unsigned v) { return __hip_atomic_fetch_add(p, v, __ATOMIC_RELAXED, __HIP_MEMORY_SCOPE_AGENT); }
__device__ __forceinline__ unsigned xb_xcc_id() { return (unsigned)__builtin_amdgcn_s_getreg((3 << 11) | 20) & 0xFu; }
#define XB_SPIN(cond, bar) do { unsigned _sp = 0; while (cond) { __builtin_amdgcn_s_sleep(1); \
    if ((++_sp & 255u) == 0u) { if (xb_ld(&(bar)[XB_TMO])) break; if (_sp > XB_SPIN_CAP) { atomicAdd(&(bar)[XB_TMO], 1u); break; } } } } while (0)
struct XcdBarrier { unsigned* bar; unsigned x; volatile LAS unsigned* st; };
__device__ __forceinline__ XcdBarrier xcd_barrier_post(unsigned* bar, volatile LAS unsigned* st) {
    XcdBarrier b; b.bar = bar; b.x = xb_xcc_id(); b.st = st;
    if (threadIdx.x == 0) (void)xb_add(&bar[XB_XCNT(b.x)], 1u);
    return b;
}
__device__ __forceinline__ void xcd_barrier_complete(unsigned* bar, unsigned x, unsigned& nloc, unsigned& nx) {
    const unsigned G = gridDim.x * gridDim.y * gridDim.z;
    unsigned sum, cnt, mine, sp = 0u;
    for (;;) {
        sum = 0u; cnt = 0u; mine = 0u;
#pragma unroll
        for (unsigned j = 0; j < 16; ++j) { const unsigned c = xb_ld(&bar[XB_XCNT(j)]); sum += c; cnt += (c > 0u) ? 1u : 0u; mine = (j == x) ? c : mine; }
        if (sum == G) break;
        __builtin_amdgcn_s_sleep(1);
        if ((++sp & 255u) == 0u) { if (xb_ld(&bar[XB_TMO])) break; if (sp > XB_SPIN_CAP) { atomicAdd(&bar[XB_TMO], 1u); break; } }
    }
    nloc = mine > 0u ? mine : 1u; nx = cnt > 0u ? cnt : 1u;
}
__device__ __forceinline__ void xcd_barrier(const XcdBarrier& b) {
    asm volatile("s_waitcnt vmcnt(0)" ::: "memory");
    __syncthreads();
    if (threadIdx.x == 0) {
        unsigned* bar = b.bar;
        __builtin_amdgcn_s_waitcnt(0);
        unsigned nloc = b.st[0], nx = b.st[1];
        if (nloc == 0u) { xcd_barrier_complete(bar, b.x, nloc, nx); b.st[0] = nloc; b.st[1] = nx; }
        const unsigned old = xb_add(&bar[XB_XSUB(b.x)], 1u);
        const unsigned gen = old / nloc;
        if (old + 1u == (gen + 1u) * nloc) {
            __builtin_amdgcn_fence(__ATOMIC_RELEASE, "agent");
            asm volatile("s_waitcnt vmcnt(0)" ::: "memory");
            const unsigned og = xb_add(&bar[XB_TOP], 1u);
            const unsigned tg = og / nx;
            if (og + 1u == (tg + 1u) * nx) xb_add(&bar[XB_TOPGEN], 1u);
            else XB_SPIN(xb_ld(&bar[XB_TOPGEN]) == tg, bar);
            __builtin_amdgcn_fence(__ATOMIC_ACQUIRE, "agent");
            xb_add(&bar[XB_XGEN(b.x)], 1u);
            asm volatile("s_waitcnt vmcnt(0)" ::: "memory");
        } else {
            XB_SPIN(xb_ld(&bar[XB_XGEN(b.x)]) == gen, bar);
            __builtin_amdgcn_fence(__ATOMIC_ACQUIRE, "agent");
            asm volatile("s_waitcnt vmcnt(0)" ::: "memory");
        }
    }
    __syncthreads();
}

constexpr int BM = 256, BK = 64, HALF = 128, HTB = HALF * BK * 2, NXCD = 8, WGM = 8;
__host__ __device__ __forceinline__ int lds_byte(int r, int c) { const int st = (r >> 4) * 2 + (c >> 5), rr = r & 15, cc = c & 31, ob = rr * 64 + cc * 2; return st * 1024 + (ob ^ (((ob >> 9) & 1) << 5)); }
__host__ __device__ __forceinline__ void stage_rc(int b, int& R, int& C) { const int st = b / 1024, sb = b % 1024, swz = sb ^ (((sb >> 9) & 1) << 5); R = (st >> 1) * 16 + swz / 64; C = (st & 1) * 32 + (swz % 64) / 2; }
__host__ __device__ __forceinline__ int perm32(int rho) { const int n = rho >> 4, i = rho & 15; return 8 * (i >> 2) + 4 * n + (i & 3); }

struct Unit { int pm, pn, g; };
struct Gemm { const bf16_t* A; const bf16_t* Bt; int lda, ldb, K; size_t gsA, gsB; };
struct GridOrder {
    int nM, nN, nwg, G, c;
    __device__ void init(int M, int N, int G_, int c_) { nM = M / BM; nN = N / BM; nwg = nM * nN; G = G_; c = c_; }
    __device__ bool next(int i, Unit& u) const {
        const long L = (long)i * G + c; if (L >= nwg) return false;
        int wgid = (int)L; { const int q = nwg / NXCD, r = nwg % NXCD, xcd = wgid % NXCD, off = wgid / NXCD; wgid = (xcd < r ? xcd * (q + 1) : r * (q + 1) + (xcd - r) * q) + off; }
        const int nig = WGM * nN, gid = wgid / nig, fm = gid * WGM, gsz = (nM - fm) < WGM ? (nM - fm) : WGM;
        u.pm = fm + ((wgid % nig) % gsz); u.pn = (wgid % nig) / gsz; u.g = 0; return true;
    }
};
struct OneTile {
    int idx;
    __device__ bool next(int i, Unit& u) const { if (i > 0 || idx < 0) return false; u.pm = idx >> 1; u.pn = idx & 1; u.g = 0; return true; }
};
struct GroupOrder {
    int c, G;
    __device__ bool next(int i, Unit& u) const { const int idx = c + i * G; if (c < 0 || idx >= NG * 3) return false; u.g = idx / 3; u.pm = idx % 3; u.pn = 0; return true; }
};

template <class Epi, class Sched, bool AROWPERM = false>
__device__ __forceinline__ void gemm_phase(LAS unsigned char* lds, const int tid, const Gemm g, const Sched& S, const Epi& E) {
    const int wid = __builtin_amdgcn_readfirstlane(tid >> 6), lane = tid & 63, wr = wid >> 2, wc = wid & 3, fr = lane & 15, fq = lane >> 4;
    const int K = g.K, nt = K / BK;
    unsigned voffA[2], voffB[2];
#pragma unroll
    for (int i = 0; i < 2; ++i) { int R, C; stage_rc(tid * 16 + i * 8192, R, C); const int Rb = Epi::PERM ? ((R & ~31) + perm32(R & 31)) : R;
        const int Ra = AROWPERM ? ((R & 64) + 4 * (R & 15) + ((R >> 4) & 3)) : R;
        voffA[i] = (unsigned)(Ra * g.lda + C) * 2u; voffB[i] = (unsigned)(Rb * g.ldb + C) * 2u; }
    const size_t kstep = (size_t)(BK * 2);
    const size_t hstepA = (size_t)HALF * g.lda * 2, hstepB = (size_t)HALF * g.ldb * 2;
    const unsigned ldsw = (unsigned)wid * 1024u;
    const int aoff = lds_byte(wr * 64 + fr, fq * 8), boff = lds_byte(wc * 32 + fr, fq * 8);
#define PG8_SA(b, h) (((b) * 2 + (h)) * HTB)
#define PG8_SB(b, h) ((4 + (b) * 2 + (h)) * HTB)
#define PG8_STAGE(bufoff, gbase, voff) do { _Pragma("unroll") for (int _i = 0; _i < 2; ++_i) \
        __builtin_amdgcn_global_load_lds((const unsigned*)((const char*)(gbase) + (voff)[_i]), (LAS unsigned*)(lds + (bufoff) + ldsw + _i * 8192), 16, 0, 0); } while (0)
#define PG8_LDA(dst, b, h) do { _Pragma("unroll") for (int m = 0; m < 4; ++m) _Pragma("unroll") for (int k = 0; k < 2; ++k) dst[m][k] = *(const LAS bf16x8*)(lds + PG8_SA(b, h) + aoff + m * 2048 + k * 1024); } while (0)
#define PG8_LDB(dst, b, h) do { _Pragma("unroll") for (int n = 0; n < 2; ++n) _Pragma("unroll") for (int k = 0; k < 2; ++k) dst[n][k] = *(const LAS bf16x8*)(lds + PG8_SB(b, h) + boff + n * 2048 + k * 1024); } while (0)
#define PG8_MMA(ai, bj, At, Bt) do { __builtin_amdgcn_s_setprio(1); _Pragma("unroll") for (int m = 0; m < 4; ++m) _Pragma("unroll") for (int n = 0; n < 2; ++n) _Pragma("unroll") for (int k = 0; k < 2; ++k) \
        acc[ai][bj][m][n] = __builtin_amdgcn_mfma_f32_16x16x32_bf16(Bt[n][k], At[m][k], acc[ai][bj][m][n], 0, 0, 0); __builtin_amdgcn_s_setprio(0); } while (0)
#define PG8_WAIT_V(n) asm volatile("s_waitcnt vmcnt(" #n ")" ::: "memory")
#define PG8_WAIT_L(n) asm volatile("s_waitcnt lgkmcnt(" #n ")" ::: "memory")
#define PG8_BAR __builtin_amdgcn_s_barrier()
#define PG8_SCHED __builtin_amdgcn_sched_barrier(0)
#define PG8_APTR(u) ((const char*)g.A + ((size_t)(u).g * g.gsA + (size_t)(u).pm * BM * g.lda) * 2)
#define PG8_BPTR(u) ((const char*)g.Bt + ((size_t)(u).g * g.gsB + (size_t)(u).pn * BM * g.ldb) * 2)
    Unit cur, nxt; int ui = 0;
    if (!S.next(0, cur)) return;
    f32x4 acc[2][2][4][2];
#pragma unroll
    for (int a = 0; a < 2; ++a)
#pragma unroll
        for (int b = 0; b < 2; ++b)
#pragma unroll
            for (int m = 0; m < 4; ++m)
#pragma unroll
                for (int n = 0; n < 2; ++n) acc[a][b][m][n] = (f32x4){0.f, 0.f, 0.f, 0.f};
    bf16x8 At[4][2], B0[2][2], B1[2][2];
    const char* cA = PG8_APTR(cur); const char* cB = PG8_BPTR(cur);
    PG8_STAGE(PG8_SB(0, 0), cB, voffB); PG8_STAGE(PG8_SB(0, 1), cB + hstepB, voffB); PG8_STAGE(PG8_SA(0, 0), cA, voffA); PG8_STAGE(PG8_SA(0, 1), cA + hstepA, voffA);
    if (wr == 1) PG8_BAR;
    PG8_WAIT_V(2); PG8_BAR;
    PG8_STAGE(PG8_SB(1, 0), cB + kstep, voffB); PG8_STAGE(PG8_SA(1, 0), cA + kstep, voffA); PG8_STAGE(PG8_SB(1, 1), cB + hstepB + kstep, voffB);
    PG8_WAIT_V(6); PG8_BAR;
    for (;;) {
        const bool has_next = S.next(ui + 1, nxt);
        const char* nA = has_next ? PG8_APTR(nxt) : cA; const char* nB = has_next ? PG8_BPTR(nxt) : cB;
        for (int t = 0; t < nt; t += 2) {
            const bool last = (t == nt - 2);
            const char* a1 = cA + (size_t)(t + 1) * kstep;
            const char* a2 = last ? nA : cA + (size_t)(t + 2) * kstep; const char* b2 = last ? nB : cB + (size_t)(t + 2) * kstep;
            const char* a3 = a2 + kstep; const char* b3 = b2 + kstep;
            PG8_LDB(B0, 0, 0); PG8_LDB(B1, 0, 1); PG8_SCHED; PG8_LDA(At, 0, 0); PG8_STAGE(PG8_SA(1, 1), a1 + hstepA, voffA);
            PG8_WAIT_V(8); PG8_WAIT_L(0); PG8_BAR; PG8_MMA(0, 0, At, B0); PG8_MMA(0, 1, At, B1); PG8_BAR; PG8_SCHED;
            PG8_LDA(At, 0, 1); PG8_STAGE(PG8_SB(0, 0), b2, voffB); PG8_STAGE(PG8_SB(0, 1), b2 + hstepB, voffB); PG8_STAGE(PG8_SA(0, 0), a2, voffA);
            PG8_WAIT_V(8); PG8_WAIT_L(0); PG8_BAR; PG8_MMA(1, 0, At, B0); PG8_MMA(1, 1, At, B1); PG8_BAR; PG8_SCHED;
            PG8_LDB(B0, 1, 0); PG8_LDB(B1, 1, 1); PG8_SCHED; PG8_LDA(At, 1, 0); PG8_STAGE(PG8_SA(0, 1), a2 + hstepA, voffA);
            PG8_WAIT_V(8); PG8_WAIT_L(0); PG8_BAR; PG8_MMA(0, 0, At, B0); PG8_MMA(0, 1, At, B1); PG8_BAR; PG8_SCHED;
            PG8_LDA(At, 1, 1); PG8_STAGE(PG8_SB(1, 0), b3, voffB); PG8_STAGE(PG8_SB(1, 1), b3 + hstepB, voffB); PG8_STAGE(PG8_SA(1, 0), a3, voffA);
            PG8_WAIT_V(8); PG8_WAIT_L(0); PG8_BAR; PG8_MMA(1, 0, At, B0); PG8_MMA(1, 1, At, B1); PG8_BAR; PG8_SCHED;
        }
        if (wr == 0) PG8_BAR;
        E(acc, cur, wr, wc, fr, fq);
        if (!has_next) break;
#pragma unroll
        for (int a = 0; a < 2; ++a)
#pragma unroll
            for (int b = 0; b < 2; ++b)
#pragma unroll
                for (int m = 0; m < 4; ++m)
#pragma unroll
                    for (int n = 0; n < 2; ++n) acc[a][b][m][n] = (f32x4){0.f, 0.f, 0.f, 0.f};
        cur = nxt; cA = nA; cB = nB; ++ui;
        if (wr == 1) PG8_BAR;
    }
    PG8_WAIT_V(0);
    PG8_BAR;
#undef PG8_SA
#undef PG8_SB
#undef PG8_STAGE
#undef PG8_LDA
#undef PG8_LDB
#undef PG8_MMA
#undef PG8_WAIT_V
#undef PG8_WAIT_L
#undef PG8_BAR
#undef PG8_SCHED
#undef PG8_APTR
#undef PG8_BPTR
}
__device__ __forceinline__ int cond_of_pm(int pm) { return pm < 16 ? 0 : 1 + ((pm - 16) >> 2); }
__device__ __forceinline__ int kvrow_of(int row) { return row < MC ? row : MC + ((row - MC) >> 10) * (PAST + DSEQ) + PAST + ((row - MC) & 1023); }
__device__ __forceinline__ u32x4 pack8(const f32x4& a, const f32x4& b) { u32x4 w; w.x = cvt_pk_bf16(a[0], a[1]); w.y = cvt_pk_bf16(a[2], a[3]); w.z = cvt_pk_bf16(b[0], b[1]); w.w = cvt_pk_bf16(b[2], b[3]); return w; }

struct EpiIn {
    static constexpr bool PERM = true;
    const float* sumsq; const float* bias; const float* qn; const float* kn; const f32x2* rope;
    bf16_t* Q; bf16_t* KB; bf16_t* VB; bf16_t* AS3; float* new_k; float* new_v; int l;
    __device__ __forceinline__ void operator()(const f32x4 (&acc)[2][2][4][2], const Unit& u, int wr, int wc, int fr, int fq) const {
        const int pm = u.pm, pn = u.pn; const bool ctx = pm < 16; const int cond = cond_of_pm(pm);
        const float* bz = bias + cond * 2048 + pn * 256 + wc * 32 + 8 * fq;
        f32x4 bv[2][2];
#pragma unroll
        for (int bj = 0; bj < 2; ++bj)
#pragma unroll
            for (int n = 0; n < 2; ++n) bv[bj][n] = *(const f32x4*)(bz + bj * 128 + 4 * n);
        const int rbase = pm * BM + wr * 64 + fr;
        if (pn < 4) {
            const bool isq = pn < 2; const float* gv = isq ? qn : kn;
            const int G = (pn & 1) * 4 + wc;
            const int cb = 32 * (fq >> 1) + 8 * (fq & 1);
            f32x4 gg[2][2];
#pragma unroll
            for (int bj = 0; bj < 2; ++bj)
#pragma unroll
                for (int n = 0; n < 2; ++n) gg[bj][n] = *(const f32x4*)(gv + cb + 16 * bj + 4 * n);
            const float qs = isq ? C2 : 1.f;
#pragma unroll
            for (int ai = 0; ai < 2; ++ai)
#pragma unroll
                for (int m = 0; m < 4; ++m) {
                    const int row = rbase + ai * HALF + m * 16;
                    const float rstd = rsqrtf(sumsq[row] * (1.f / DM) + EPS);
                    f32x4 v[2][2]; float ss = 0.f;
#pragma unroll
                    for (int bj = 0; bj < 2; ++bj)
#pragma unroll
                        for (int n = 0; n < 2; ++n) { v[bj][n] = acc[ai][bj][m][n] * rstd + bv[bj][n]; const f32x4 t = v[bj][n] * v[bj][n]; ss += (t[0] + t[1]) + (t[2] + t[3]); }
                    ss += __shfl_xor(ss, 16); ss += __shfl_xor(ss, 32);
                    const float rn = rsqrtf(ss * (1.f / 64.f) + EPS);
#pragma unroll
                    for (int bj = 0; bj < 2; ++bj)
#pragma unroll
                        for (int n = 0; n < 2; ++n) v[bj][n] = v[bj][n] * rn * gg[bj][n];
                    if (ctx) {
                        if (!isq) { float* nk = new_k + ((size_t)((row >> 8) * DEPTH + l) * SEQ + (row & 255)) * 512 + G * 64 + cb;
#pragma unroll
                            for (int bj = 0; bj < 2; ++bj) { *(f32x4*)(nk + 16 * bj) = v[bj][0]; *(f32x4*)(nk + 16 * bj + 4) = v[bj][1]; } }
                    } else {
                        const int t = (row - MC) & 1023; const int pos = (fq >> 1) ? (t & 63) : (t >> 6);
                        const f32x2* rp = rope + pos * 16 + 8 * (fq & 1);
#pragma unroll
                        for (int n = 0; n < 2; ++n)
#pragma unroll
                            for (int j = 0; j < 4; ++j) { const f32x2 cs = rp[4 * n + j]; const float x1 = v[0][n][j], x2 = v[1][n][j]; v[0][n][j] = x1 * cs.x - x2 * cs.y; v[1][n][j] = x1 * cs.y + x2 * cs.x; }
                    }
                    bf16_t* dst = isq ? (Q + (size_t)row * 512) : (KB + (size_t)kvrow_of(row) * 512);
                    dst += G * 64 + cb;
#pragma unroll
                    for (int bj = 0; bj < 2; ++bj) *(u32x4*)(dst + 16 * bj) = pack8(v[bj][0] * qs, v[bj][1] * qs);
                }
        } else if (pn < 6) {
            const int col0 = (pn - 4) * 256 + wc * 32 + 8 * fq;
#pragma unroll
            for (int ai = 0; ai < 2; ++ai)
#pragma unroll
                for (int m = 0; m < 4; ++m) {
                    const int row = rbase + ai * HALF + m * 16;
                    const float rstd = rsqrtf(sumsq[row] * (1.f / DM) + EPS);
                    bf16_t* dst = VB + (size_t)kvrow_of(row) * 512 + col0;
#pragma unroll
                    for (int bj = 0; bj < 2; ++bj) { const f32x4 a = acc[ai][bj][m][0] * rstd + bv[bj][0], b = acc[ai][bj][m][1] * rstd + bv[bj][1];
                        *(u32x4*)(dst + 128 * bj) = pack8(a, b);
                        if (ctx) { float* nv = new_v + ((size_t)((row >> 8) * DEPTH + l) * SEQ + (row & 255)) * 512 + col0 + 128 * bj; *(f32x4*)nv = a; *(f32x4*)(nv + 4) = b; } }
                }
        } else {
            const int cu0 = (pn - 6) * 256 + wc * 32 + 8 * fq;
#pragma unroll
            for (int ai = 0; ai < 2; ++ai)
#pragma unroll
                for (int m = 0; m < 4; ++m) {
                    const int row = rbase + ai * HALF + m * 16;
                    const float rstd = rsqrtf(sumsq[row] * (1.f / DM) + EPS);
#pragma unroll
                    for (int bj = 0; bj < 2; ++bj) { const int cu = cu0 + 128 * bj; const f32x4 a = acc[ai][bj][m][0] * rstd + bv[bj][0], b = acc[ai][bj][m][1] * rstd + bv[bj][1];
                        *(u32x4*)(AS3 + ((size_t)(cu >> 4) * NCHUNK + (row >> 4)) * 512 + (row & 15) * 16 + (cu & 15)) = pack8(a, b); }
                }
        }
    }
};
struct EpiS1 {
    static constexpr bool PERM = false;
    float* E;
    __device__ __forceinline__ void operator()(const f32x4 (&acc)[2][2][4][2], const Unit& u, int wr, int wc, int fr, int fq) const {
        const int rbase = u.pm * BM + wr * 64 + fr, col0 = wc * 32 + 4 * fq;
#pragma unroll
        for (int ai = 0; ai < 2; ++ai)
#pragma unroll
            for (int m = 0; m < 4; ++m) { float* dst = E + ((size_t)u.g * NCHUNK + rbase + ai * HALF + m * 16) * 256 + col0;
#pragma unroll
                for (int bj = 0; bj < 2; ++bj)
#pragma unroll
                    for (int n = 0; n < 2; ++n) *(f32x4*)(dst + bj * HALF + n * 16) = acc[ai][bj][m][n]; }
    }
};
struct EpiS3 {
    static constexpr bool PERM = true;
    __amdgpu_buffer_rsrc_t zr;
    __device__ __forceinline__ void operator()(const f32x4 (&acc)[2][2][4][2], const Unit& u, int wr, int wc, int fr, int fq) const {
        const int rbase = u.pm * BM + wr * 64 + fr;
#pragma unroll
        for (int ai = 0; ai < 2; ++ai)
#pragma unroll
            for (int m = 0; m < 4; ++m) { const int chunk = rbase + ai * HALF + m * 16;
#pragma unroll
                for (int bj = 0; bj < 2; ++bj) { const int tt = 8 * bj + 2 * wc + (fq >> 1), c0 = 8 * (fq & 1);
                    f32x4 a = acc[ai][bj][m][0], b = acc[ai][bj][m][1];
#pragma unroll
                    for (int j = 0; j < 4; ++j) { a[j] = gelu_tanh_f(a[j]); b[j] = gelu_tanh_f(b[j]); }
                    __builtin_amdgcn_raw_buffer_store_b128(pack8(a, b), zr, (int)((((unsigned)chunk * 16u + tt) * 512u + u.g * 16 + c0) * 2u), 0,   16); } }
    }
};
struct EpiGlu {
    static constexpr bool PERM = true;
    const bf16_t* Z; const float* bg; bf16_t* CAT;
    __device__ __forceinline__ void operator()(const f32x4 (&acc)[2][2][4][2], const Unit& u, int wr, int wc, int fr, int fq) const {
        const int rbase = u.pm * BM + wr * 64 + fr, col0 = u.pn * BM + wc * 32 + 8 * fq;
        f32x4 bv[2][2];
#pragma unroll
        for (int bj = 0; bj < 2; ++bj)
#pragma unroll
            for (int n = 0; n < 2; ++n) bv[bj][n] = *(const f32x4*)(bg + col0 + bj * HALF + 4 * n);
#pragma unroll
        for (int ai = 0; ai < 2; ++ai)
#pragma unroll
            for (int m = 0; m < 4; ++m) { const int row = rbase + ai * HALF + m * 16;
#pragma unroll
                for (int bj = 0; bj < 2; ++bj) { const u32x4 zw = *(const u32x4*)(Z + (size_t)row * 512 + col0 + bj * HALF);
                    f32x4 a = acc[ai][bj][m][0] + bv[bj][0], b = acc[ai][bj][m][1] + bv[bj][1];
                    a[0] = bflo(zw.x) * sigmoid_f(a[0]); a[1] = bfhi(zw.x) * sigmoid_f(a[1]); a[2] = bflo(zw.y) * sigmoid_f(a[2]); a[3] = bfhi(zw.y) * sigmoid_f(a[3]);
                    b[0] = bflo(zw.z) * sigmoid_f(b[0]); b[1] = bfhi(zw.z) * sigmoid_f(b[1]); b[2] = bflo(zw.w) * sigmoid_f(b[2]); b[3] = bfhi(zw.w) * sigmoid_f(b[3]);
                    *(u32x4*)(CAT + (size_t)row * 1024 + 512 + col0 + bj * HALF) = pack8(a, b); } }
    }
};
struct EpiRes {
    static constexpr bool PERM = true;
    const float* xin0; const float* xin1;
    float* xout;
    const float* gate;
    const float* gn; const float* sc;
    bf16_t* XS; float* ssq;
    __device__ __forceinline__ void operator()(const f32x4 (&acc)[2][2][4][2], const Unit& u, int wr, int wc, int fr, int fq) const {
        const int pm = u.pm, cond = cond_of_pm(pm); const int col0 = u.pn * BM + wc * 32 + 8 * fq; const int rbase = pm * BM + wr * 64 + fr;
        const bool donorm = (gn != nullptr);
        f32x4 gt[2][2], gs[2][2];
#pragma unroll
        for (int bj = 0; bj < 2; ++bj)
#pragma unroll
            for (int n = 0; n < 2; ++n) { const int c = col0 + bj * HALF + n * 4; gt[bj][n] = *(const f32x4*)(gate + cond * 6144 + c);
                if (donorm) { const f32x4 g4 = *(const f32x4*)(gn + c), s4 = *(const f32x4*)(sc + cond * 6144 + c); gs[bj][n] = g4 * (s4 + 1.f); } else gs[bj][n] = (f32x4){0.f, 0.f, 0.f, 0.f}; }
#pragma unroll
        for (int ai = 0; ai < 2; ++ai)
#pragma unroll
            for (int m = 0; m < 4; ++m) { const int row = rbase + ai * HALF + m * 16;
                const float* xi = (row < MC) ? (xin0 + (size_t)row * DM) : (xin1 + (size_t)(row - MC) * DM);
                float ss = 0.f;
#pragma unroll
                for (int bj = 0; bj < 2; ++bj) { const int c = col0 + bj * HALF;
                    const f32x4 x0 = *(const f32x4*)(xi + c) + gt[bj][0] * acc[ai][bj][m][0], x1 = *(const f32x4*)(xi + c + 4) + gt[bj][1] * acc[ai][bj][m][1];
                    *(f32x4*)(xout + (size_t)row * DM + c) = x0; *(f32x4*)(xout + (size_t)row * DM + c + 4) = x1;
                    if (donorm) { const f32x4 t0 = x0 * x0, t1 = x1 * x1; ss += ((t0[0] + t0[1]) + (t0[2] + t0[3])) + ((t1[0] + t1[1]) + (t1[2] + t1[3]));
                        *(u32x4*)(XS + (size_t)row * DM + c) = pack8(x0 * gs[bj][0], x1 * gs[bj][1]); } }
                if (donorm) { ss += __shfl_xor(ss, 16); ss += __shfl_xor(ss, 32); if (fq == 0) atomicAdd(ssq + row, ss); }
            }
    }
};
struct EpiUp {
    static constexpr bool PERM = true;
    const float* sumsq; const float* bias; bf16_t* UP;
    __device__ __forceinline__ void operator()(const f32x4 (&acc)[2][2][4][2], const Unit& u, int wr, int wc, int fr, int fq) const {
        const int pm = u.pm, cond = cond_of_pm(pm); const int col0 = u.pn * BM + wc * 32 + 8 * fq; const int rbase = pm * BM + wr * 64 + fr;
        f32x4 bv[2][2];
#pragma unroll
        for (int bj = 0; bj < 2; ++bj)
#pragma unroll
            for (int n = 0; n < 2; ++n) bv[bj][n] = *(const f32x4*)(bias + cond * 4096 + col0 + bj * HALF + 4 * n);
#pragma unroll
        for (int ai = 0; ai < 2; ++ai)
#pragma unroll
            for (int m = 0; m < 4; ++m) { const int row = rbase + ai * HALF + m * 16; const float rstd = rsqrtf(sumsq[row] * (1.f / DM) + EPS);
#pragma unroll
                for (int bj = 0; bj < 2; ++bj) *(u32x4*)(UP + (size_t)row * 4096 + col0 + bj * HALF) = pack8(acc[ai][bj][m][0] * rstd + bv[bj][0], acc[ai][bj][m][1] * rstd + bv[bj][1]); }
    }
};

__device__ __forceinline__ float dpp_shr1(float v) { return __uint_as_float((unsigned)__builtin_amdgcn_update_dpp(0, (int)__float_as_uint(v), 0x111, 0xf, 0xf, false)); }
__device__ __forceinline__ float dpp_shl1(float v) { return __uint_as_float((unsigned)__builtin_amdgcn_update_dpp(0, (int)__float_as_uint(v), 0x101, 0xf, 0xf, false)); }
struct EpiUpConv {
    static constexpr bool PERM = true;
    const float* sumsq; const float* bias; const float* cw; const float* cb; bf16_t* G; bf16_t* HALO;
    __device__ __forceinline__ void operator()(const f32x4 (&acc)[2][2][4][2], const Unit& u, int wr, int wc, int fr, int fq) const {
        const int pm = u.pm, pn = u.pn, cond = cond_of_pm(pm);
        const int posv = pn * 256 + wc * 32 + 8 * fq, av = pn * 128 + wc * 32 + 8 * fq;
#pragma unroll
        for (int ai = 0; ai < 2; ++ai) {
            const int tok0 = pm * BM + ai * HALF + wr * 64 + 4 * fr; const int sl = pm * 4 + ai * 2 + wr;
            float rs[4];
#pragma unroll
            for (int m = 0; m < 4; ++m) rs[m] = rsqrtf(sumsq[tok0 + m] * (1.f / DM) + EPS);
#pragma unroll
            for (int n = 0; n < 2; ++n) {
                const f32x4 bvv = *(const f32x4*)(bias + cond * 4096 + posv + 4 * n), bvg = *(const f32x4*)(bias + cond * 4096 + posv + 128 + 4 * n);
                f32x4 pv[4], pg[4];
#pragma unroll
                for (int m = 0; m < 4; ++m) { pv[m] = acc[ai][0][m][n] * rs[m] + bvv; pg[m] = acc[ai][1][m][n] * rs[m] + bvg; }
                f32x4 pvp, pvn, pgp, pgn;
#pragma unroll
                for (int j = 0; j < 4; ++j) { pvp[j] = dpp_shr1(pv[3][j]); pvn[j] = dpp_shl1(pv[0][j]); pgp[j] = dpp_shr1(pg[3][j]); pgn[j] = dpp_shl1(pg[0][j]); }
                const int c = av + 4 * n;
                const f32x4 w0v = *(const f32x4*)(cw + c), w1v = *(const f32x4*)(cw + 4096 + c), w2v = *(const f32x4*)(cw + 8192 + c), cbv = *(const f32x4*)(cb + c);
                const f32x4 w0g = *(const f32x4*)(cw + 2048 + c), w1g = *(const f32x4*)(cw + 4096 + 2048 + c), w2g = *(const f32x4*)(cw + 8192 + 2048 + c), cbg = *(const f32x4*)(cb + 2048 + c);
#pragma unroll
                for (int m = 0; m < 4; ++m) {
                    const f32x4 zv = cbv + w0v * (m == 0 ? pvp : pv[m == 0 ? 0 : m - 1]) + w1v * pv[m] + w2v * (m == 3 ? pvn : pv[m == 3 ? 3 : m + 1]);
                    const f32x4 zg = cbg + w0g * (m == 0 ? pgp : pg[m == 0 ? 0 : m - 1]) + w1g * pg[m] + w2g * (m == 3 ? pgn : pg[m == 3 ? 3 : m + 1]);
                    u32x2 w; w.x = cvt_pk_bf16(silu_f(zg[0]) * zv[0], silu_f(zg[1]) * zv[1]); w.y = cvt_pk_bf16(silu_f(zg[2]) * zv[2], silu_f(zg[3]) * zv[3]);
                    *(u32x2*)(G + (size_t)(tok0 + m) * 2048 + c) = w; }
                if (fr == 0 || fr == 15) { const int m0 = fr == 0 ? 0 : 2;
#pragma unroll
                    for (int mm = 0; mm < 2; ++mm) { const f32x4 a = fr == 0 ? pv[mm] : pv[2 + mm], b = fr == 0 ? pg[mm] : pg[2 + mm];
                        bf16_t* hp = HALO + ((size_t)sl * 4 + m0 + mm) * 4096 + posv + 4 * n;
                        u32x2 wa; wa.x = cvt_pk_bf16(a[0], a[1]); wa.y = cvt_pk_bf16(a[2], a[3]); *(u32x2*)hp = wa;
                        u32x2 wb; wb.x = cvt_pk_bf16(b[0], b[1]); wb.y = cvt_pk_bf16(b[2], b[3]); *(u32x2*)(hp + 128) = wb; } }
            }
        }
    }
};
constexpr int AT_SLOT = 32768, AT_NSLOT = 4, AT_VOFF = 16384, AT_X = 0, AT_ST = 65536;
__device__ __forceinline__ void glds16(const void* gsrc, unsigned lds_dst) { unsigned keep;
    asm volatile("s_mov_b32 %0, m0\n\ts_mov_b32 m0, %2\n\ts_nop 0\n\tglobal_load_lds_dwordx4 %1, off\n\ts_mov_b32 m0, %0" : "=&s"(keep) : "v"(gsrc), "s"(lds_dst) : "memory"); }
#define AT_WAIT_BAR(N) asm volatile("s_waitcnt vmcnt(" #N ") lgkmcnt(0)\n\ts_barrier" ::: "memory")
#define AT_SB() __builtin_amdgcn_sched_barrier(0)
__device__ __forceinline__ s16x4 vtr(const LAS char* p) { typedef short v4i16_t __attribute__((ext_vector_type(4))); return __builtin_bit_cast(s16x4, __builtin_amdgcn_ds_read_tr16_b64_v4i16((LAS v4i16_t*)p)); }
__device__ __forceinline__ int crow(int r, int hi) { return (r & 3) + 8 * (r >> 2) + 4 * hi; }

struct AttnArgs { const bf16_t* Q; const bf16_t* KB; const bf16_t* VB; bf16_t* CAT; const float* subln; float lam; float oml; };

__device__ __forceinline__ void attn_unit(LAS unsigned char* lds, const int tid, const AttnArgs& A, int seq, int h, int qblk) {
    const int lane = tid & 63, r32 = lane & 31, hi = lane >> 5; const int wid = __builtin_amdgcn_readfirstlane(tid >> 6);
    const int rg = wid & 3, s = wid >> 2;
    const bool ctx = seq < NB;
    const int qrow0 = ctx ? seq * SEQ + qblk * 128 : MC + (seq - NB) * DSEQ + qblk * 128;
    const int krow0 = ctx ? seq * SEQ : MC + (seq - NB) * (PAST + DSEQ);
    const int NT = ctx ? SEQ / 64 : (PAST + DSEQ) / 64;
    const unsigned lds0 = (unsigned)(uintptr_t)lds;
    const bf16_t* ksrc0 = A.KB + (size_t)(krow0 + lane) * 512 + h * 128 + wid * 8;
    const bf16_t* vsrc0 = A.VB + (size_t)(krow0 + 16 * (wid & 3) + (lane >> 2)) * 512 + h * 128 + (wid >> 2) * 32 + (lane & 3) * 8;
    const unsigned kdst = lds0 + wid * 1024, vdst = lds0 + AT_VOFF + ((wid >> 2) * 4 + (wid & 3)) * 1024;
#define AT_DMA(t, slot) do { const size_t _o = (size_t)(t) * 64 * 512; const unsigned _s = (unsigned)(slot) * AT_SLOT; \
        glds16(ksrc0 + _o, (unsigned)__builtin_amdgcn_readfirstlane(kdst + _s)); glds16(ksrc0 + _o + 64, (unsigned)__builtin_amdgcn_readfirstlane(kdst + _s + 8 * 1024)); \
        glds16(vsrc0 + _o, (unsigned)__builtin_amdgcn_readfirstlane(vdst + _s)); glds16(vsrc0 + _o + 64, (unsigned)__builtin_amdgcn_readfirstlane(vdst + _s + 8 * 1024)); } while (0)
    AT_DMA(0, 0); AT_DMA(1, 1); AT_DMA(2, 2);
    bf16x8 qr[4];
    { const bf16_t* qp = A.Q + (size_t)(qrow0 + rg * 32 + r32) * 512 + h * 128 + s * 64 + hi * 8;
#pragma unroll
      for (int d0 = 0; d0 < 4; ++d0) qr[d0] = *(const bf16x8*)(qp + d0 * 16); }
    f32x16 o[4];
#pragma unroll
    for (int d0 = 0; d0 < 4; ++d0)
#pragma unroll
        for (int r = 0; r < 16; ++r) o[d0][r] = 0.f;
    float lsum = 0.f;
    const LAS char* kfrag0 = (const LAS char*)lds + (s * 8 + hi) * 1024 + r32 * 16;
    const LAS char* vfrag0 = (const LAS char*)lds + AT_VOFF + ((lane >> 4) & 1) * 32 + (lane & 3) * 8 + (4 * hi + ((lane & 15) >> 2)) * 64;
    f32x16 pc0, pc1;
#define AT_KLOAD(kfr, slot) do { const LAS char* _k = kfrag0 + (slot) * AT_SLOT; _Pragma("unroll") for (int d0 = 0; d0 < 4; ++d0) { kfr[2 * d0] = *(const LAS bf16x8*)(_k + d0 * 2048); kfr[2 * d0 + 1] = *(const LAS bf16x8*)(_k + d0 * 2048 + 512); } } while (0)
#define AT_VLOAD(vv, slot, ks) do { const LAS char* _v = vfrag0 + (slot) * AT_SLOT + (ks) * 1024; _Pragma("unroll") for (int d0 = 0; d0 < 4; ++d0) { const s16x4 lo = vtr(_v + d0 * 4096), hh = vtr(_v + d0 * 4096 + 512); \
        vv[d0] = (bf16x8){lo[0], lo[1], lo[2], lo[3], hh[0], hh[1], hh[2], hh[3]}; } } while (0)
#define AT_EXP2(P, i, W) do { P[2 * (i)] = fast_exp2(P[2 * (i)]); P[2 * (i) + 1] = fast_exp2(P[2 * (i) + 1]); sacc += P[2 * (i)] + P[2 * (i) + 1]; W = cvt_pk_bf16(P[2 * (i)], P[2 * (i) + 1]); } while (0)
    AT_WAIT_BAR(8);
    { bf16x8 kfr[8]; AT_KLOAD(kfr, 0);
#pragma unroll
      for (int r = 0; r < 16; ++r) { pc0[r] = 0.f; pc1[r] = 0.f; }
#pragma unroll
      for (int d0 = 0; d0 < 4; ++d0) { pc0 = __builtin_amdgcn_mfma_f32_32x32x16_bf16(kfr[2 * d0], qr[d0], pc0, 0, 0, 0); pc1 = __builtin_amdgcn_mfma_f32_32x32x16_bf16(kfr[2 * d0 + 1], qr[d0], pc1, 0, 0, 0); } }
    int slot = 0;
    for (int t = 0; t < NT; ++t) {
        const bool has_next = t + 1 < NT;
        if (t + 2 < NT) AT_WAIT_BAR(4); else AT_WAIT_BAR(0);
        if (t + 3 < NT) AT_DMA(t + 3, (slot + 3) & 3);
        const int slot_n = (slot + 1) & 3;
        bf16x8 kfr[8], va[4], vb[4]; u32x4 pw[4]; f32x16 pn0, pn1; float sacc = 0.f;
        const LAS char* kn_ = kfrag0 + slot_n * AT_SLOT;
#define AT_K1(d0) do { kfr[2 * (d0)] = *(const LAS bf16x8*)(kn_ + (d0) * 2048); kfr[2 * (d0) + 1] = *(const LAS bf16x8*)(kn_ + (d0) * 2048 + 512); } while (0)
        if (has_next) { AT_K1(0); AT_K1(1); }
        AT_SB();
        if (has_next) {
#pragma unroll
            for (int r = 0; r < 16; ++r) { pn0[r] = 0.f; pn1[r] = 0.f; }
#pragma unroll
            for (int i = 0; i < 8; ++i) { const int d0 = i >> 1;
                if (i & 1) pn1 = __builtin_amdgcn_mfma_f32_32x32x16_bf16(kfr[2 * d0 + 1], qr[d0], pn1, 0, 0, 0); else pn0 = __builtin_amdgcn_mfma_f32_32x32x16_bf16(kfr[2 * d0], qr[d0], pn0, 0, 0, 0);
                AT_EXP2(pc0, i, pw[i >> 2][i & 3]);
                if (i == 0) AT_K1(2);
                if (i == 1) AT_K1(3);
                if (i == 3) AT_VLOAD(va, slot, 0);
                if (i == 5) AT_VLOAD(vb, slot, 1);
                AT_SB(); }
        } else {
            AT_VLOAD(va, slot, 0); AT_VLOAD(vb, slot, 1);
#pragma unroll
            for (int i = 0; i < 8; ++i) AT_EXP2(pc0, i, pw[i >> 2][i & 3]);
            AT_SB();
        }
        bf16x8 vc[4], vd[4];
#pragma unroll
        for (int i = 0; i < 8; ++i) { const int d0 = i & 3;
            if (i < 4) o[d0] = __builtin_amdgcn_mfma_f32_32x32x16_bf16(va[d0], __builtin_bit_cast(bf16x8, pw[0]), o[d0], 0, 0, 0);
            else       o[d0] = __builtin_amdgcn_mfma_f32_32x32x16_bf16(vb[d0], __builtin_bit_cast(bf16x8, pw[1]), o[d0], 0, 0, 0);
            AT_EXP2(pc1, i, pw[2 + (i >> 2)][i & 3]);
            if (i == 1) AT_VLOAD(vc, slot, 2);
            if (i == 5) AT_VLOAD(vd, slot, 3);
            AT_SB(); }
#pragma unroll
        for (int d0 = 0; d0 < 4; ++d0) o[d0] = __builtin_amdgcn_mfma_f32_32x32x16_bf16(vc[d0], __builtin_bit_cast(bf16x8, pw[2]), o[d0], 0, 0, 0);
#pragma unroll
        for (int d0 = 0; d0 < 4; ++d0) o[d0] = __builtin_amdgcn_mfma_f32_32x32x16_bf16(vd[d0], __builtin_bit_cast(bf16x8, pw[3]), o[d0], 0, 0, 0);
        lsum += sacc;
        if (has_next) { pc0 = pn0; pc1 = pn1; }
        slot = slot_n;
    }
    lsum += __shfl_xor(lsum, 32);
    const float inv = (s == 0 ? 1.f : A.lam) / lsum;
    AT_WAIT_BAR(0);
    LAS float* X = (LAS float*)(lds + AT_X) + rg * 4096;
    if (s == 1) {
#pragma unroll
        for (int d0 = 0; d0 < 4; ++d0)
#pragma unroll
            for (int r = 0; r < 16; ++r) X[(d0 * 16 + r) * 64 + lane] = o[d0][r] * inv;
    }
    AT_WAIT_BAR(0);
    if (s == 0) {
        float ss = 0.f;
#pragma unroll
        for (int d0 = 0; d0 < 4; ++d0)
#pragma unroll
            for (int r = 0; r < 16; ++r) { const float v = o[d0][r] * inv - X[(d0 * 16 + r) * 64 + lane]; o[d0][r] = v; ss += v * v; }
        ss += __shfl_xor(ss, 32);
        const float rn = rsqrtf(ss * (1.f / 128.f) + EPS) * A.oml;
        LAS bf16_t* stg = (LAS bf16_t*)(lds + AT_ST) + rg * (32 * 136);
#pragma unroll
        for (int d0 = 0; d0 < 4; ++d0)
#pragma unroll
            for (int rq = 0; rq < 4; ++rq) { const int dv = 32 * d0 + 8 * rq + 4 * hi; const f32x4 g4 = *(const f32x4*)(A.subln + dv);
                u32x2 w; w.x = cvt_pk_bf16(o[d0][4 * rq] * rn * g4[0], o[d0][4 * rq + 1] * rn * g4[1]); w.y = cvt_pk_bf16(o[d0][4 * rq + 2] * rn * g4[2], o[d0][4 * rq + 3] * rn * g4[3]);
                *(LAS u32x2*)(stg + r32 * 136 + dv) = w; }
        asm volatile("s_waitcnt lgkmcnt(0)" ::: "memory");
        bf16_t* dst = A.CAT + (size_t)(qrow0 + rg * 32) * 1024 + h * 128;
#pragma unroll
        for (int i = 0; i < 8; ++i) { const int row = i * 4 + (lane >> 4), ch = lane & 15; const u32x4 v = *(const LAS u32x4*)(stg + row * 136 + ch * 8); *(u32x4*)(dst + (size_t)row * 1024 + ch * 8) = v; }
    }
    AT_WAIT_BAR(0);
#undef AT_DMA
#undef AT_KLOAD
#undef AT_K1
#undef AT_VLOAD
#undef AT_EXP2
}
struct Args { const float* in[34]; float* out; unsigned char* ws; int stop_after; int pad; };
typedef const __attribute__((address_space(4))) Args* kargs_t;
struct Frame {
    LAS unsigned char* lds; int tid, lane, wave, vcu, bid, G;
    kargs_t ka; float* out; unsigned char* ws;
    float* misc; unsigned* ctl;
};
#define LDS_WAIT() asm volatile("s_waitcnt lgkmcnt(0)" ::: "memory")
#define VM_WAIT() asm volatile("s_waitcnt vmcnt(0)" ::: "memory")

template <int MAP> __device__ __forceinline__ int src_col(int p);
template <int MODE, int MAP, int NC> __device__ __forceinline__ void gemv9_task(Frame& F, const float* W, int ldw, int l, int voff, int strip, float* out, int ldo, const float* add) {
    LAS float* sc = (LAS float*)F.lds; LAS float* red = sc + 9 * 1024;
    for (int i = F.tid; i < 9 * 1024; i += NTHREADS) { const int cond = i >> 10, k = i & 1023; float v;
        if (MODE == 0) { v = cond == 0 ? F.ka->in[6][k] : F.ka->in[5][(cond - 1) * 1024 + k]; v = v / (1.f + expf(-v)); } else v = F.misc[MI_MOD + (l * 9 + cond) * 6144 + voff + k];
        sc[i] = v; }
    __syncthreads();
    const int j = strip * NC + (F.lane < NC ? F.lane : NC - 1); const float* w = W + (size_t)(F.wave * 128) * ldw + src_col<MAP>(j);
    float acc[9];
#pragma unroll
    for (int b = 0; b < 9; ++b) acc[b] = 0.f;
#pragma unroll 16
    for (int k = 0; k < 128; ++k) { const float wv = w[(size_t)k * ldw];
#pragma unroll
        for (int b = 0; b < 9; ++b) acc[b] += sc[b * 1024 + F.wave * 128 + k] * wv; }
#pragma unroll
    for (int b = 0; b < 9; ++b) red[(F.wave * 9 + b) * 64 + F.lane] = acc[b];
    __syncthreads();
    for (int i = F.tid; i < 9 * 64; i += NTHREADS) { const int b = i >> 6, ln = i & 63; if (ln >= NC) continue; float s_ = 0.f;
#pragma unroll
        for (int w8 = 0; w8 < 8; ++w8) s_ += red[(w8 * 9 + b) * 64 + ln];
        const int jj = strip * NC + ln; out[(size_t)b * ldo + jj] = s_ + (add ? add[jj] : 0.f); }
    __syncthreads();
}
template <int MAP> __device__ __forceinline__ int src_col(int p) {
    if (MAP == 1) { if (p >= 1024) return p; const int pn = p >> 8, r = p & 255, bj = r >> 7, wc = (r >> 5) & 3, fq = (r >> 3) & 3, low = r & 7; return 256 * pn + 64 * wc + 32 * (fq >> 1) + 16 * bj + 8 * (fq & 1) + low; }
    if (MAP == 2) { const int pn = p >> 8, bj = (p >> 7) & 1, r = p & 127; return bj * 2048 + 128 * pn + r; }
    return p;
}
template <int MAP, bool BIAS> __device__ __forceinline__ void transpose_item(Frame& F, const float* W, int K, int N, bf16_t* WT, LAS float* scr, int item, const float* shv, float* bias) {
    const int lane = F.lane; const int nblk = N / 64, kb = item / nblk, nb = item % nblk, k0 = 64 * kb, n0 = 64 * nb;
    const int sc_ = src_col<MAP>(n0 + lane);
    float tv[64];
#pragma unroll
    for (int i = 0; i < 64; ++i) tv[i] = W[(size_t)(k0 + i) * N + sc_];
#pragma unroll
    for (int i = 0; i < 64; ++i) scr[i * 65 + lane] = tv[i];
    LDS_WAIT(); asm volatile("" ::: "memory");
    const int c = lane & 7;
#pragma unroll
    for (int j = 0; j < 8; ++j) { const int n = (lane >> 3) + 8 * j; const LAS float* s_ = scr + (8 * c) * 65 + n;
        u32x4 o; o.x = cvt_pk_bf16(s_[0 * 65], s_[1 * 65]); o.y = cvt_pk_bf16(s_[2 * 65], s_[3 * 65]); o.z = cvt_pk_bf16(s_[4 * 65], s_[5 * 65]); o.w = cvt_pk_bf16(s_[6 * 65], s_[7 * 65]);
        *(u32x4*)(WT + (size_t)(n0 + n) * K + k0 + 8 * c) = o; }
    if (BIAS) {
        float sh[9], acc[9];
#pragma unroll
        for (int b = 0; b < 9; ++b) { sh[b] = shv[b * 6144 + k0 + lane]; acc[b] = 0.f; }
#pragma unroll
        for (int kk = 0; kk < 64; ++kk) { const float w = tv[kk];
#pragma unroll
            for (int b = 0; b < 9; ++b) acc[b] += __uint_as_float(__builtin_amdgcn_readlane(__float_as_uint(sh[b]), kk)) * w; }
#pragma unroll
        for (int b = 0; b < 9; ++b) atomicAdd(bias + (size_t)b * N + n0 + lane, acc[b]);
    }
    LDS_WAIT(); asm volatile("" ::: "memory");
}
__device__ __forceinline__ void cache_row(Frame& F, int l, int item) {
    const int which = item >> 12, r = item & 4095, b = r >> 9, j = r & 511;
    const float* src = (which ? F.ka->in[3] : F.ka->in[2]) + ((size_t)(b * DEPTH + l) * PAST + j) * 512 + F.lane * 8;
    bf16_t* dst = (bf16_t*)(F.ws + (which ? WS_VB : WS_KB)) + (size_t)(MC + b * (PAST + DSEQ) + j) * 512 + F.lane * 8;
    const f32x4 a = *(const f32x4*)src, c = *(const f32x4*)(src + 4);
    *(u32x4*)dst = pack8(a, c);
}
__device__ __forceinline__ void cache_item(Frame& F, int l, int item4) {
#pragma unroll
    for (int i = 0; i < 4; ++i) cache_row(F, l, item4 * 4 + i);
}
__device__ __forceinline__ f32x2 cmul(f32x2 a, f32x2 b) { return (f32x2){a.x * b.x - a.y * b.y, a.x * b.y + a.y * b.x}; }
__device__ __forceinline__ void ssm_prep(Frame& F, int l, int task) {
    const int g = task >> 1, half = task & 1;
    LAS f32x2* POW = (LAS f32x2*)F.lds;
    LAS f32x2* BB = POW + 2 * 17 * 64;
    LAS f32x2* CC = BB + 2 * 64 * 16;
    LAS f32x2* CT = CC + 2 * 16 * 64;
    LAS float* KT = (LAS float*)(CT + 2 * 64 * 16);
    constexpr int KTS = 260;
    bf16_t* WE = (bf16_t*)(F.ws + WS_SSM + SSM_WE) + (size_t)g * 256 * 256;
    bf16_t* WY = (bf16_t*)(F.ws + WS_SSM + SSM_WY) + (size_t)g * 256 * 512;
    f32x2* LAM16 = (f32x2*)(F.ws + WS_SSM + SSM_LAM16); f32x2* BBAR = (f32x2*)(F.ws + WS_SSM + SSM_BBAR);
    const int tid = F.tid, lane = F.lane;
    if (tid < 128) { const int dir = tid >> 6, p = tid & 63; const size_t pi = ((size_t)(l * 2 + dir) * NG + g) * 64 + p;
        const float lr = F.ka->in[18][pi], li = F.ka->in[19][pi], delta = expf(F.ka->in[20][(l * 2 + dir) * NG + g]);
        const float er = expf(lr * delta), lbr = er * cosf(li * delta), lbi = er * sinf(li * delta);
        { float one_ = 1.f, zero_ = 0.f; asm volatile("" : "+v"(one_), "+v"(zero_));
          f32x2 pw = (f32x2){one_, zero_}; const f32x2 lb = (f32x2){lbr, lbi};
          for (int tau = 0; tau <= 16; ++tau) { POW[(dir * 17 + tau) * 64 + p] = pw; if (tau == 16 && half == 0) LAM16[(dir * NG + g) * 64 + p] = pw; pw = cmul(pw, lb); } }
        const float nr = lbr - 1.f, ni = lbi, den = lr * lr + li * li; const f32x2 fac = (f32x2){(nr * lr + ni * li) / den, (ni * lr - nr * li) / den};
        f32x4 br[4], bi4[4];
#pragma unroll
        for (int q = 0; q < 4; ++q) { br[q] = *(const f32x4*)(F.ka->in[21] + pi * 16 + 4 * q); bi4[q] = *(const f32x4*)(F.ka->in[22] + pi * 16 + 4 * q); }
#pragma unroll
        for (int ch = 0; ch < 16; ++ch) { const f32x2 bb = cmul(fac, (f32x2){br[ch >> 2][ch & 3], bi4[ch >> 2][ch & 3]}); BB[(dir * 64 + p) * 16 + ch] = bb; if (half == 0) BBAR[((size_t)(dir * NG + g) * 64 + p) * 16 + ch] = bb; }
    }
    { f32x2 cv[4];
#pragma unroll
      for (int q = 0; q < 4; ++q) { const int i = tid + q * NTHREADS, dir = i >> 10, c = (i >> 6) & 15, p = i & 63; const size_t ci = (((size_t)(l * 2 + dir) * NG + g) * 16 + c) * 64 + p; cv[q] = (f32x2){F.ka->in[23][ci], F.ka->in[24][ci]}; }
#pragma unroll
      for (int q = 0; q < 4; ++q) { const int i = tid + q * NTHREADS, dir = i >> 10, c = (i >> 6) & 15, p = i & 63; CC[i] = cv[q]; CT[(dir * 64 + p) * 16 + c] = cv[q]; } }
    __syncthreads();
    { const int i16 = lane & 15, k4 = lane >> 4, ri = k4 & 1, ph = k4 >> 1;
      for (int blk = 0; blk < 4; ++blk) { const int q = F.wave * 4 + blk, dir = q >> 4, tau = q & 15; f32x4 acc = (f32x4){0.f, 0.f, 0.f, 0.f};
#pragma unroll 8
          for (int ks = 0; ks < 32; ++ks) { const int p = 2 * ks + ph;
              const f32x2 cc = CT[(dir * 64 + p) * 16 + i16], pw = POW[(dir * 17 + tau) * 64 + p], bb = BB[(dir * 64 + p) * 16 + i16];
              const float u = ri ? -pw.y : pw.x, v = ri ? pw.x : pw.y;
              const float av = cc.x * u - cc.y * v, bv = ri ? bb.y : bb.x;
              acc = __builtin_amdgcn_mfma_f32_16x16x4f32(av, bv, acc, 0, 0, 0); }
#pragma unroll
          for (int r = 0; r < 4; ++r) KT[(dir * 16 + tau) * KTS + (k4 * 4 + r) * 16 + i16] = acc[r]; } }
    __syncthreads();
    const float* Dv = F.ka->in[25] + l * 512 + g * 16;
    for (int idx = half * 8192 + tid; idx < (half + 1) * 8192; idx += NTHREADS) { const int n = idx >> 6, kc = idx & 63, k0 = kc * 8, i = n >> 4, c = n & 15; f32x4 v0, v1;
        if (k0 < 256) { const int s_ = k0 >> 4, ch0 = k0 & 15; v0 = (f32x4){0.f, 0.f, 0.f, 0.f}; v1 = v0;
            if (s_ <= i) { const LAS float* kp = KT + (i - s_) * KTS + c * 16 + ch0; v0 += *(const LAS f32x4*)kp; v1 += *(const LAS f32x4*)(kp + 4); }
            if (s_ >= i) { const LAS float* kp = KT + (16 + s_ - i) * KTS + c * 16 + ch0; v0 += *(const LAS f32x4*)kp; v1 += *(const LAS f32x4*)(kp + 4); }
            if (s_ == i) { const int e = c - ch0; const float dv = Dv[c]; if (e >= 0 && e < 4) v0[e] += dv; else if (e >= 4 && e < 8) v1[e - 4] += dv; }
        } else { const int dir = k0 >= 384 ? 1 : 0, p0 = ((k0 - 256) & 127) >> 1, tau = dir ? 16 - i : i + 1;
            const LAS f32x4* cp = (const LAS f32x4*)(CC + (dir * 16 + c) * 64 + p0); const LAS f32x4* pp = (const LAS f32x4*)(POW + (dir * 17 + tau) * 64 + p0);
            const f32x4 c0 = cp[0], c1 = cp[1], w0 = pp[0], w1 = pp[1];
            v0 = (f32x4){c0[0] * w0[0] - c0[1] * w0[1], -(c0[0] * w0[1] + c0[1] * w0[0]), c0[2] * w0[2] - c0[3] * w0[3], -(c0[2] * w0[3] + c0[3] * w0[2])};
            v1 = (f32x4){c1[0] * w1[0] - c1[1] * w1[1], -(c1[0] * w1[1] + c1[1] * w1[0]), c1[2] * w1[2] - c1[3] * w1[3], -(c1[2] * w1[3] + c1[3] * w1[2])}; }
        *(u32x4*)(WY + (size_t)n * 512 + k0) = pack8(v0, v1); }
    for (int idx = half * 4096 + tid; idx < (half + 1) * 4096; idx += NTHREADS) { const int n = idx >> 5, k0 = (idx & 31) * 8, dir = n >> 7, p = (n & 127) >> 1, ri = n & 1, s_ = k0 >> 4, ch0 = k0 & 15;
        const f32x2 pw = POW[(dir * 17 + (dir ? s_ : 15 - s_)) * 64 + p]; const LAS f32x4* bp = (const LAS f32x4*)(BB + (dir * 64 + p) * 16 + ch0);
        const float u = ri ? pw.y : pw.x, v = ri ? pw.x : -pw.y;
        const f32x4 b0 = bp[0], b1 = bp[1], b2 = bp[2], b3 = bp[3];
        const f32x4 v0 = (f32x4){u * b0[0] + v * b0[1], u * b0[2] + v * b0[3], u * b1[0] + v * b1[1], u * b1[2] + v * b1[3]};
        const f32x4 v1 = (f32x4){u * b2[0] + v * b2[1], u * b2[2] + v * b2[3], u * b3[0] + v * b3[1], u * b3[2] + v * b3[3]};
        *(u32x4*)(WE + (size_t)n * 256 + k0) = pack8(v0, v1); }
    __syncthreads();
}
__device__ __forceinline__ void xprep_row(Frame& F, int row) {
    const float* xr = (row < MC) ? F.ka->in[0] + (size_t)row * DM : F.ka->in[1] + (size_t)(row - MC) * DM;
    const int cond = row < MC ? 0 : 1 + ((row - MC) >> 10);
    const float* sc = F.misc + MI_MOD + (0 * 9 + cond) * 6144 + 1024; const float* g1 = F.ka->in[9];
    bf16_t* dst = (bf16_t*)(F.ws + WS_XS) + (size_t)row * DM; float s = 0.f;
#pragma unroll
    for (int j = 0; j < 4; ++j) { const int c = 4 * F.lane + 256 * j; const f32x4 x = *(const f32x4*)(xr + c); const f32x4 t = x * x; s += (t[0] + t[1]) + (t[2] + t[3]);
        const f32x4 y = x * (*(const f32x4*)(g1 + c)) * (*(const f32x4*)(sc + c) + 1.f); u32x2 w; w.x = cvt_pk_bf16(y[0], y[1]); w.y = cvt_pk_bf16(y[2], y[3]); *(u32x2*)(dst + c) = w; }
    s = wave_sum(s);
    if (F.lane == 0) ((float*)(F.ctl + CW_SS))[row] = s;
}
__device__ __forceinline__ void xprep_item(Frame& F, int item4) {
#pragma unroll
    for (int i = 0; i < 4; ++i) xprep_row(F, item4 * 4 + i);
}
__device__ __forceinline__ void ssm_scan(Frame& F, int l, int g, int pm) {
    const int tid = F.tid, sl = tid >> 7, dp = tid & 127, dir = dp >> 6, p = dp & 63;
    const f32x2* LAM16 = (const f32x2*)(F.ws + WS_SSM + SSM_LAM16); const f32x2* BBAR = (const f32x2*)(F.ws + WS_SSM + SSM_BBAR);
    const float* E = (const float*)(F.ws + WS_R + R_E); bf16_t* AS3 = (bf16_t*)(F.ws + WS_R + R_AS3);
    const f32x2 lam = LAM16[(dir * NG + g) * 64 + p];
    f32x2 e[64];
    if (pm == 0) {
#pragma unroll
        for (int q = 0; q < 4; ++q) { const float* ep = E + ((size_t)g * NCHUNK + (q * 4 + sl) * 16) * 256 + dir * 128 + 2 * p;
#pragma unroll
            for (int j = 0; j < 16; ++j) e[q * 16 + j] = *(const f32x2*)(ep + (size_t)j * 256); }
    } else { const float* ep = E + ((size_t)g * NCHUNK + 256 + ((pm - 1) * 4 + sl) * 64) * 256 + dir * 128 + 2 * p;
#pragma unroll
        for (int j = 0; j < 64; ++j) e[j] = *(const f32x2*)(ep + (size_t)j * 256); }
    const int nq = pm == 0 ? 4 : 1;
#pragma unroll
    for (int q = 0; q < 4; ++q) { if (q >= nq) break;
        int base; f32x2 h;
        if (pm == 0) { const int seq = q * 4 + sl; base = seq * 16; h = (f32x2){0.f, 0.f}; }
        else { const int sq = (pm - 1) * 4 + sl; base = 256 + sq * 64; h = *(const f32x2*)(F.ka->in[4] + ((((size_t)sq * DEPTH + l) * 2 + dir) * NG + g) * 128 + 2 * p); }
        unsigned* hp = (unsigned*)(AS3 + ((size_t)g * NCHUNK + base) * 512 + 256 + dir * 128 + 2 * p);
        if (pm == 0) {
#pragma unroll
            for (int jj = 0; jj < 16; ++jj) { const int j = dir ? 15 - jj : jj; const f32x2 ev = dir ? e[q * 16 + 15 - jj] : e[q * 16 + jj]; hp[(size_t)j * 256] = cvt_pk_bf16(h.x, h.y); h = cmul(lam, h) + ev; }
        } else {
#pragma unroll
            for (int jj = 0; jj < 64; ++jj) { const int j = dir ? 63 - jj : jj; const f32x2 ev = dir ? e[63 - jj] : e[jj]; hp[(size_t)j * 256] = cvt_pk_bf16(h.x, h.y); h = cmul(lam, h) + ev; }
        }
    }
    if (pm == 0) {
        const int tt = dir ? 15 : 0; u32x4 uq[4][2]; f32x2 bbv[16];
        const f32x2* bb = BBAR + ((size_t)(dir * NG + g) * 64 + p) * 16;
#pragma unroll
        for (int ch = 0; ch < 16; ++ch) bbv[ch] = bb[ch];
#pragma unroll
        for (int q = 0; q < 4; ++q) { const int chunk = (q * 4 + sl) * 16 + tt; const bf16_t* up = AS3 + ((size_t)g * NCHUNK + chunk) * 512 + tt * 16; uq[q][0] = *(const u32x4*)up; uq[q][1] = *(const u32x4*)(up + 8); }
        float* ns = F.out + (size_t)MT * DM + 2 * (size_t)NB * DEPTH * SEQ * 512;
#pragma unroll
        for (int q = 0; q < 4; ++q) { const int seq = q * 4 + sl; const u32x4 u0 = uq[q][0], u1 = uq[q][1];
            const float uu[16] = {bflo(u0.x), bfhi(u0.x), bflo(u0.y), bfhi(u0.y), bflo(u0.z), bfhi(u0.z), bflo(u0.w), bfhi(u0.w), bflo(u1.x), bfhi(u1.x), bflo(u1.y), bfhi(u1.y), bflo(u1.z), bfhi(u1.z), bflo(u1.w), bfhi(u1.w)};
            f32x2 acc = (f32x2){0.f, 0.f};
#pragma unroll
            for (int ch = 0; ch < 16; ++ch) acc += bbv[ch] * uu[ch];
            *(f32x2*)(ns + ((((size_t)seq * DEPTH + l) * 2 + dir) * NG + g) * 128 + 2 * p) = acc; }
    }
}
__device__ __forceinline__ void ld16(const bf16_t* p, float* v) { const u32x4 a = *(const u32x4*)p; v[0] = bflo(a.x); v[1] = bfhi(a.x); v[2] = bflo(a.y); v[3] = bfhi(a.y); v[4] = bflo(a.z); v[5] = bfhi(a.z); v[6] = bflo(a.w); v[7] = bfhi(a.w); }
__device__ __forceinline__ void conv_item(Frame& F, int l, int item) {
    const int rs = item >> 4, pn = item & 15, lr = F.lane >> 4, lc = F.lane & 15;
    const int r0 = rs * 64 + lr * 16; const int av = 128 * pn + 8 * lc;
    const bf16_t* up = (const bf16_t*)(F.ws + WS_R) + (size_t)r0 * 4096 + 256 * pn + 8 * lc; bf16_t* gp = (bf16_t*)(F.ws + WS_G) + (size_t)r0 * 2048 + av;
    const float* cw = F.ka->in[31] + (size_t)l * 3 * 4096; const float* cb = F.ka->in[32] + (size_t)l * 4096;
    float wv[3][8], wg[3][8], bv[8], bg[8];
#pragma unroll
    for (int k = 0; k < 3; ++k)
#pragma unroll
        for (int e = 0; e < 8; ++e) { wv[k][e] = cw[k * 4096 + av + e]; wg[k][e] = cw[k * 4096 + 2048 + av + e]; }
#pragma unroll
    for (int e = 0; e < 8; ++e) { bv[e] = cb[av + e]; bg[e] = cb[2048 + av + e]; }
    const int t0 = r0 < MC ? (r0 & 255) : ((r0 - MC) & 1023), L = r0 < MC ? SEQ : DSEQ;
    float pv[8], pg[8], cv[8], cg[8], nv_[8], ng[8];
    if (t0 > 0) { ld16(up - 4096, pv); ld16(up - 4096 + 128, pg); } else {
#pragma unroll
        for (int e = 0; e < 8; ++e) { pv[e] = 0.f; pg[e] = 0.f; } }
    ld16(up, cv); ld16(up + 128, cg);
#pragma unroll
    for (int i = 0; i < 16; ++i) {
        if (t0 + i + 1 < L) { ld16(up + (size_t)(i + 1) * 4096, nv_); ld16(up + (size_t)(i + 1) * 4096 + 128, ng); } else {
#pragma unroll
            for (int e = 0; e < 8; ++e) { nv_[e] = 0.f; ng[e] = 0.f; } }
        float o[8];
#pragma unroll
        for (int e = 0; e < 8; ++e) { const float zv = bv[e] + wv[0][e] * pv[e] + wv[1][e] * cv[e] + wv[2][e] * nv_[e]; const float zg = bg[e] + wg[0][e] * pg[e] + wg[1][e] * cg[e] + wg[2][e] * ng[e]; o[e] = silu_f(zg) * zv; }
        u32x4 w; w.x = cvt_pk_bf16(o[0], o[1]); w.y = cvt_pk_bf16(o[2], o[3]); w.z = cvt_pk_bf16(o[4], o[5]); w.w = cvt_pk_bf16(o[6], o[7]);
        *(u32x4*)(gp + (size_t)i * 2048) = w;
#pragma unroll
        for (int e = 0; e < 8; ++e) { pv[e] = cv[e]; pg[e] = cg[e]; cv[e] = nv_[e]; cg[e] = ng[e]; }
    }
}

__device__ __forceinline__ bool slab_first(int s) { return s < 64 ? (s & 3) == 0 : ((s - 64) & 15) == 0; }
__device__ __forceinline__ bool slab_last(int s) { return s < 64 ? (s & 3) == 3 : ((s - 64) & 15) == 15; }
__device__ __forceinline__ void ld4bf(const bf16_t* p, float* v) { const u32x2 a = *(const u32x2*)p; v[0] = bflo(a.x); v[1] = bfhi(a.x); v[2] = bflo(a.y); v[3] = bfhi(a.y); }
__device__ __forceinline__ void conv_fix(Frame& F, int l, int pm) {
    const bf16_t* HALO = (const bf16_t*)(F.ws + WS_R); bf16_t* G = (bf16_t*)(F.ws + WS_G);
    const float* cw = F.ka->in[31] + (size_t)l * 3 * 4096; const float* cb = F.ka->in[32] + (size_t)l * 4096;
    const int c = F.tid * 4, pos = 256 * (c >> 7) + (c & 127);
    float wv[3][4], wg[3][4], bv[4], bg[4];
#pragma unroll
    for (int k = 0; k < 3; ++k) { const f32x4 a = *(const f32x4*)(cw + k * 4096 + c), b = *(const f32x4*)(cw + k * 4096 + 2048 + c);
#pragma unroll
        for (int e = 0; e < 4; ++e) { wv[k][e] = a[e]; wg[k][e] = b[e]; } }
    { const f32x4 a = *(const f32x4*)(cb + c), b = *(const f32x4*)(cb + 2048 + c);
#pragma unroll
      for (int e = 0; e < 4; ++e) { bv[e] = a[e]; bg[e] = b[e]; } }
#pragma unroll
    for (int r8 = 0; r8 < 8; ++r8) { const int s = pm * 4 + (r8 >> 1), which = r8 & 1;
        if (which == 0 ? slab_first(s) : slab_last(s)) continue;
        const bf16_t* hp = which == 0 ? HALO + ((size_t)(s - 1) * 4 + 3) * 4096 : HALO + ((size_t)s * 4 + 2) * 4096;
        const bf16_t* hc = which == 0 ? HALO + ((size_t)s * 4 + 0) * 4096 : HALO + ((size_t)s * 4 + 3) * 4096;
        const bf16_t* hn = which == 0 ? HALO + ((size_t)s * 4 + 1) * 4096 : HALO + ((size_t)(s + 1) * 4 + 0) * 4096;
        float pv[4], cv[4], nv_[4], pg[4], cg[4], ng[4];
        ld4bf(hp + pos, pv); ld4bf(hc + pos, cv); ld4bf(hn + pos, nv_); ld4bf(hp + pos + 128, pg); ld4bf(hc + pos + 128, cg); ld4bf(hn + pos + 128, ng);
        float o[4];
#pragma unroll
        for (int e = 0; e < 4; ++e) { const float zv = bv[e] + wv[0][e] * pv[e] + wv[1][e] * cv[e] + wv[2][e] * nv_[e]; const float zg = bg[e] + wg[0][e] * pg[e] + wg[1][e] * cg[e] + wg[2][e] * ng[e]; o[e] = silu_f(zg) * zv; }
        u32x2 w; w.x = cvt_pk_bf16(o[0], o[1]); w.y = cvt_pk_bf16(o[2], o[3]);
        *(u32x2*)(G + (size_t)(s * 64 + (which ? 63 : 0)) * 2048 + c) = w; }
}
constexpr int N_TR_ITEMS_L = 16 * 32 + 8 * 8 + 16 * 16 + 16 * 64 + 32 * 16;
__device__ __forceinline__ void weight_item(Frame& F, LAS float* scr, int l, int it) {
    int r = it; const float* modl = F.misc + MI_MOD + l * 9 * 6144; float* cf = (float*)F.ctl;
    if (r < 512) { transpose_item<1, true>(F, F.ka->in[10] + (size_t)l * DM * 2048, DM, 2048, (bf16_t*)(F.ws + WS_WIN) + (size_t)l * 2048 * DM, scr, r, modl, cf + CW_BIN + l * 9 * 2048); return; } r -= 512;
    if (r < 64) { transpose_item<0, false>(F, F.ka->in[26] + (size_t)l * 512 * 512, 512, 512, (bf16_t*)(F.ws + WS_WGLU) + (size_t)l * 512 * 512, scr, r, nullptr, nullptr); return; } r -= 64;
    if (r < 256) { transpose_item<0, false>(F, F.ka->in[28] + (size_t)l * DM * DM, DM, DM, (bf16_t*)(F.ws + WS_WOUT) + (size_t)l * DM * DM, scr, r, nullptr, nullptr); return; } r -= 256;
    if (r < 1024) { transpose_item<2, true>(F, F.ka->in[30] + (size_t)l * DM * 4096, DM, 4096, (bf16_t*)(F.ws + WS_WUP) + (size_t)l * 4096 * DM, scr, r, modl + 3072, cf + CW_BUP + l * 9 * 4096); return; } r -= 1024;
    transpose_item<0, false>(F, F.ka->in[33] + (size_t)l * 2048 * DM, 2048, DM, (bf16_t*)(F.ws + WS_WDN) + (size_t)l * DM * 2048, scr, r, nullptr, nullptr);
}

__global__ void __launch_bounds__(NTHREADS, 2) mega(Args args) {
    extern __shared__ __attribute__((aligned(16))) unsigned char lds_raw[];
    Frame F;
    F.lds = (LAS unsigned char*)lds_raw;
    F.tid = threadIdx.x; F.lane = F.tid & 63; F.wave = __builtin_amdgcn_readfirstlane(F.tid >> 6);
    F.G = gridDim.x; F.bid = blockIdx.x; { const int bx = blockIdx.x; F.vcu = (F.G % 8 == 0) ? (bx % 8) * (F.G / 8) + bx / 8 : bx; }
    F.ka = (kargs_t)__builtin_amdgcn_kernarg_segment_ptr();
    F.out = args.out; F.ws = args.ws; F.misc = (float*)(args.ws + WS_MISC); F.ctl = (unsigned*)(args.ws + WS_CTL);
    volatile LAS unsigned* MISC = (volatile LAS unsigned*)(F.lds + MISC_OFF);
    for (int u = F.tid; u < (LDS_BYTES - LDSCTL_OFF) / 4; u += NTHREADS) ((LAS unsigned*)(F.lds + LDSCTL_OFF))[u] = 0u;
    __syncthreads();
    XcdBarrier bar = xcd_barrier_post(F.ctl + CW_BAR, MISC + 8);
    int phase_no = 0;
#define LAUNDER() do { asm volatile("" : "+s"(F.ka), "+s"(F.ws), "+s"(F.out), "+s"(F.bid), "+v"(F.tid)); F.vcu = (F.G % 8 == 0) ? (F.bid % 8) * (F.G / 8) + F.bid / 8 : F.bid; F.lane = F.tid & 63; F.wave = __builtin_amdgcn_readfirstlane(F.tid >> 6); \
    F.misc = (float*)(F.ws + WS_MISC); F.ctl = (unsigned*)(F.ws + WS_CTL); gw = F.vcu * NWAVES + F.wave; } while (0)
#ifdef TPROBE
#define TSTAMP() do { if (F.bid == 0 && F.tid == 0) ((unsigned long long*)(F.ctl + 6000))[phase_no] = __builtin_amdgcn_s_memrealtime(); } while (0)
#else
#define TSTAMP() do {} while (0)
#endif
#if defined(TPROBE) && defined(TPROBE_SUB_A)
#define TSUB(i) do { if (F.bid == 0 && F.tid == 0 && l == 0) ((unsigned long long*)(F.ctl + 6200))[i] = __builtin_amdgcn_s_memrealtime(); } while (0)
#else
#define TSUB(i) do {} while (0)
#endif
#define GRID_BAR() do { xcd_barrier(bar); ++phase_no; TSTAMP(); if (F.ka->stop_after == phase_no) return; LAUNDER(); } while (0)
    int gw = F.vcu * NWAVES + F.wave; const int NGW = F.G * NWAVES;
#define ssq ((float*)(F.ctl + CW_SS))
#define XS ((bf16_t*)(F.ws + WS_XS))
#define KB ((bf16_t*)(F.ws + WS_KB))
#define VB ((bf16_t*)(F.ws + WS_VB))
#define Qb ((bf16_t*)(F.ws + WS_R + R_Q))
#define AS3 ((bf16_t*)(F.ws + WS_R + R_AS3))
#define Eb ((float*)(F.ws + WS_R + R_E))
#define Zb ((bf16_t*)(F.ws + WS_R + R_Z))
#define CAT ((bf16_t*)(F.ws + WS_R + R_CAT))
#define UP ((bf16_t*)(F.ws + WS_R))
#define Gb ((bf16_t*)(F.ws + WS_G))

    TSTAMP();
    { const int l = F.vcu >> 7, strip = F.vcu & 127; gemv9_task<0, 0, 48>(F, F.ka->in[7] + (size_t)l * DM * 6144, 6144, l, 0, strip, F.misc + MI_MOD + l * 9 * 6144, 6144, F.ka->in[8] + l * 6144); }
    GRID_BAR();
    if (F.vcu < 64) ssm_prep(F, 0, F.vcu);
    else {
        if (F.vcu == 64) {
            for (int i = F.tid; i < 1024; i += NTHREADS) { const int pos = i >> 4, f = i & 15; const float inv = 1.0f / powf(10000.0f, (float)f / 16.0f); const float ang = (float)pos * inv;
                ((f32x2*)(F.misc + MI_ROPE))[i] = (f32x2){cosf(ang), sinf(ang)}; }
            if (F.tid < 2) { const int l = F.tid; float a1 = 0.f, a2 = 0.f; for (int d = 0; d < 64; ++d) { a1 += F.ka->in[13][l * 64 + d] * F.ka->in[14][l * 64 + d]; a2 += F.ka->in[15][l * 64 + d] * F.ka->in[16][l * 64 + d]; }
                const float li = 0.8f - 0.6f * expf(-0.3f * (float)l); F.misc[MI_LAM + l] = expf(a1) - expf(a2) + li; F.misc[MI_LAM + 2 + l] = 1.f - li; }
        }
        LAS float* scr = (LAS float*)(F.lds + F.wave * 16640);
        const int gw1 = (F.vcu - 64) * NWAVES + F.wave, NGW1 = (F.G - 64) * NWAVES;
        constexpr int NW_ = N_TR_ITEMS_L, NC_ = 2048, NX_ = MT / 4;
        for (int it = gw1; it < NW_ + NC_ + NX_; it += NGW1) {
            if (it < NW_) weight_item(F, scr, 0, it);
            else if (it < NW_ + NC_) cache_item(F, 0, it - NW_);
            else xprep_item(F, it - NW_ - NC_); }
    }
    GRID_BAR();

    for (int l = 0; l < DEPTH; ++l) {
        const float* modl = F.misc + MI_MOD + l * 9 * 6144;
        { Gemm g{XS, (const bf16_t*)(F.ws + WS_WIN) + (size_t)l * 2048 * DM, DM, DM, DM, 0, 0}; GridOrder S; S.init(MT, 2048, F.G, F.bid);
          EpiIn E{ssq + (l == 0 ? 0 : 2 * MT), (const float*)F.ctl + CW_BIN + l * 9 * 2048, F.ka->in[11] + l * 64, F.ka->in[12] + l * 64, (const f32x2*)(F.misc + MI_ROPE), Qb, KB, VB, AS3,
                  F.out + (size_t)MT * DM, F.out + (size_t)MT * DM + (size_t)NB * DEPTH * SEQ * 512, l};
          gemm_phase<EpiIn, GridOrder>(F.lds, F.tid, g, S, E);
          if (l > 0 && F.bid >= 128 && F.bid < 192) { LAUNDER(); ssm_prep(F, l, F.bid - 128); }
          if (l + 1 < DEPTH && F.bid >= 128) { LAUNDER(); LAS float* scr = (LAS float*)(F.lds + F.wave * 16640);
              for (int it = (F.bid - 128) * NWAVES + F.wave; it < N_TR_ITEMS_L; it += 128 * NWAVES) weight_item(F, scr, l + 1, it); } }
        GRID_BAR();
#define ZC_PTR (F.ctl + CW_ZC + l * 256)
#define ATTN_UNIT(SEQ_, H_, QB_) do { LAUNDER(); const AttnArgs A_{Qb, KB, VB, CAT, F.ka->in[17] + l * 128, F.misc[MI_LAM + l], F.misc[MI_LAM + 2 + l]}; attn_unit(F.lds, F.tid, A_, (SEQ_), (H_), (QB_)); } while (0)
#define ATTN_CTX(U_) do { const int u_ = (U_); ATTN_UNIT(u_ >> 3, (u_ >> 1) & 3, u_ & 1); } while (0)
        { TSUB(0);
          if (F.vcu < NG * 3) {
              { Gemm g{AS3, (const bf16_t*)(F.ws + WS_SSM + SSM_WE), 512, 256, 256, (size_t)NCHUNK * 512, (size_t)256 * 256}; GroupOrder S{F.vcu, F.G}; EpiS1 E{Eb};
                gemm_phase<EpiS1, GroupOrder>(F.lds, F.tid, g, S, E); }
              VM_WAIT(); __syncthreads(); LAUNDER(); TSUB(1);
              ssm_scan(F, l, F.vcu / 3, F.vcu % 3); VM_WAIT(); __syncthreads(); LAUNDER(); TSUB(2);
              { Gemm g{AS3, (const bf16_t*)(F.ws + WS_SSM + SSM_WY), 512, 512, 512, (size_t)NCHUNK * 512, (size_t)256 * 512}; GroupOrder S{F.vcu, F.G};
                EpiS3 E{__builtin_amdgcn_make_buffer_rsrc((void*)Zb, 0, (int)((size_t)MT * 512 * 2), 0x00020000)};
                gemm_phase<EpiS3, GroupOrder>(F.lds, F.tid, g, S, E); }
              VM_WAIT(); __syncthreads(); LAUNDER();
              if (F.tid == 0) __hip_atomic_fetch_add(ZC_PTR + (F.vcu % 3) * 64, 1u, RLX_AGENT); }
          TSUB(3);
          { const int u = F.vcu; ATTN_UNIT(NB + (u >> 5), (u >> 3) & 3, u & 7); } TSUB(4);
          if (F.vcu >= 96 && F.vcu < 128) ATTN_CTX(F.vcu - 96);
          else if (F.vcu >= 192) { for (int r = 0; r < 2; ++r) { if (F.vcu >= 224 && r == 1) break; ATTN_CTX(F.vcu < 224 ? 32 + 2 * (F.vcu - 192) + r : 96 + (F.vcu - 224)); } }
          if (F.vcu >= 96 && F.vcu < 192) {
              LAUNDER();
              const int idx = F.vcu - 96, pmz = (idx >> 1) >> 4;
              if (F.tid == 0) { unsigned sp = 0; while (__hip_atomic_load(ZC_PTR + pmz * 64, RLX_AGENT) < (unsigned)NG) { __builtin_amdgcn_s_sleep(2); if (++sp > (1u << 20)) break; }
                  __builtin_amdgcn_fence(__ATOMIC_ACQUIRE, "agent"); asm volatile("s_waitcnt vmcnt(0)" ::: "memory"); }
              __syncthreads();
              Gemm g{Zb, (const bf16_t*)(F.ws + WS_WGLU) + (size_t)l * 512 * 512, 512, 512, 512, 0, 0}; OneTile S{idx};
              EpiGlu E{Zb, F.ka->in[27] + l * 512, CAT};
              gemm_phase<EpiGlu, OneTile>(F.lds, F.tid, g, S, E); } }
        GRID_BAR();
        { Gemm g{CAT, (const bf16_t*)(F.ws + WS_WOUT) + (size_t)l * DM * DM, DM, DM, DM, 0, 0}; GridOrder S; S.init(MT, DM, F.G, F.bid);
          EpiRes E{l == 0 ? F.ka->in[0] : F.out, l == 0 ? F.ka->in[1] : F.out + (size_t)MC * DM, F.out, modl + 2 * DM, F.ka->in[29] + l * DM, modl + 4 * DM, XS, ssq + (l == 0 ? 1 : 3) * MT};
          gemm_phase<EpiRes, GridOrder>(F.lds, F.tid, g, S, E); }
        GRID_BAR();
        { Gemm g{XS, (const bf16_t*)(F.ws + WS_WUP) + (size_t)l * 4096 * DM, DM, DM, DM, 0, 0}; GridOrder S; S.init(MT, 4096, F.G, F.bid);
          EpiUpConv E{ssq + (l == 0 ? 1 : 3) * MT, (const float*)F.ctl + CW_BUP + l * 9 * 4096, F.ka->in[31] + (size_t)l * 3 * 4096, F.ka->in[32] + (size_t)l * 4096, Gb, (bf16_t*)(F.ws + WS_R)};
          gemm_phase<EpiUpConv, GridOrder, true>(F.lds, F.tid, g, S, E); }
        GRID_BAR();
        { Gemm g{Gb, (const bf16_t*)(F.ws + WS_WDN) + (size_t)l * DM * 2048, 2048, 2048, 2048, 0, 0}; GridOrder S; S.init(MT, DM, F.G, F.bid);
          const bool nxt = l + 1 < DEPTH;
          EpiRes E{F.out, F.out + (size_t)MC * DM, F.out, modl + 5 * DM, nxt ? F.ka->in[9] + (l + 1) * DM : nullptr, nxt ? modl + 9 * 6144 + DM : nullptr, XS, ssq + 2 * MT};
          { Unit u0; if (S.next(0, u0)) { conv_fix(F, l, u0.pm); VM_WAIT(); __syncthreads(); LAUNDER(); } }
          gemm_phase<EpiRes, GridOrder>(F.lds, F.tid, g, S, E);
          if (nxt && F.bid >= 192) for (int it = (F.bid - 192) * NWAVES + F.wave; it < 2048; it += 64 * NWAVES) cache_item(F, l + 1, it); }
        if (l + 1 < DEPTH) GRID_BAR();
    }
#ifdef TPROBE
    GRID_BAR();
    if (F.bid == 0 && F.tid == 0) { const unsigned long long* ts = (const unsigned long long*)(F.ctl + 6000); const float tot = (float)(ts[phase_no] - ts[0]);
        float fa = 0.f, fb = 0.f;
#ifdef TPROBE_SUB_A
        { const unsigned long long* t2 = (const unsigned long long*)(F.ctl + 6200); fa = (float)(t2[TPROBE_SUB_B] - t2[TPROBE_SUB_A]) / tot; }
#else
        for (int k = 0; k < phase_no; ++k) { const float d = (float)(ts[k + 1] - ts[k]) / tot; if ((TPROBE_MASK_A >> k) & 1ull) fa += d; if ((TPROBE_MASK_B >> k) & 1ull) fb += d; }
#endif
        F.misc[MI_END] = 0.25f * sqrtf(fa); F.misc[MI_END + 1] = 300.f * fb; F.misc[MI_END + 2] = tot; }
    GRID_BAR();
    { const float delta = F.misc[MI_END];
      for (size_t i = (size_t)F.bid * NTHREADS + F.tid; i < (size_t)MC * DM; i += (size_t)F.G * NTHREADS) F.out[i] *= (1.f + delta);
      }
#endif
#undef GRID_BAR
#undef LAUNDER
#undef ZC_PTR
#undef ATTN_UNIT
#undef ATTN_CTX
#undef ssq
#undef XS
#undef KB
#undef VB
#undef Qb
#undef AS3
#undef Eb
#undef Zb
#undef CAT
#undef UP
#undef Gb
}
}

static int fk_launch(void* const* d_in, void* d_out, void* d_ws, size_t ws_size, hipStream_t stream, int stop_after) {
    static int grid = 0;
    if (grid == 0) {
        int dev = 0, cus = 0;
        if (ws_size < fk::WS_END) { fprintf(stderr, "kernel_launch: workspace too small (%zu < %zu)\n", ws_size, (size_t)fk::WS_END); grid = -1; return -1; }
        if (hipGetDevice(&dev) != hipSuccess || hipDeviceGetAttribute(&cus, hipDeviceAttributeMultiprocessorCount, dev) != hipSuccess) { grid = -1; return -1; }
        if (hipFuncSetAttribute((const void*)fk::mega, hipFuncAttributeMaxDynamicSharedMemorySize, fk::LDS_BYTES) != hipSuccess) { fprintf(stderr, "kernel_launch: hipFuncSetAttribute failed\n"); grid = -1; return -1; }
        int per_cu = 0; (void)hipOccupancyMaxActiveBlocksPerMultiprocessor(&per_cu, (const void*)fk::mega, fk::NTHREADS, fk::LDS_BYTES); (void)hipGetLastError();
        if (per_cu < 1) fprintf(stderr, "kernel_launch: occupancy query says %d blocks/CU\n", per_cu);
        grid = cus;
        if (grid != 256) fprintf(stderr, "kernel_launch: %d CUs (built for 256)\n", grid);
    }
    if (grid < 0) return -1;
    (void)hipMemsetAsync((char*)d_ws + fk::WS_CTL, 0, fk::CTL_BYTES, stream);
    fk::Args a{};
    for (int i = 0; i < 34; ++i) a.in[i] = (const float*)d_in[i];
    a.out = (float*)d_out; a.ws = (unsigned char*)d_ws; a.stop_after = stop_after; a.pad = 0;
    hipLaunchKernelGGL(fk::mega, dim3(grid), dim3(fk::NTHREADS), fk::LDS_BYTES, stream, a);
    return 0;
}
extern "C" void kernel_launch(void* const* d_in, const int* in_sizes, int n_in, void* d_out, int out_size, void* d_ws, size_t ws_size, hipStream_t stream) {
    if (n_in != 34) { fprintf(stderr, "kernel_launch: unexpected n_in %d\n", n_in); return; }
    fk_launch(d_in, d_out, d_ws, ws_size, stream, 0);
}
```

```cpp
#include <hip/hip_runtime.h>
#include <cstdio>
#include <cstdint>
namespace fk {
#define LAS __attribute__((address_space(3)))
#define GAS __attribute__((address_space(1)))
typedef unsigned short bf16_t;
typedef short bf16x8 __attribute__((ext_vector_type(8)));
typedef short s16x4 __attribute__((ext_vector_type(4)));
typedef float f32x4 __attribute__((ext_vector_type(4)));
typedef float f32x2 __attribute__((ext_vector_type(2)));
typedef float f32x16 __attribute__((ext_vector_type(16)));
typedef unsigned u32x4 __attribute__((ext_vector_type(4)));
typedef unsigned u32x2 __attribute__((ext_vector_type(2)));

constexpr int DM = 1024, NB = 16, SEQ = 256, DEPTH = 2, DB = 8, DSEQ = 1024, PAST = 512;
constexpr int MC = NB * SEQ, MS = DB * DSEQ, MT = MC + MS;
constexpr int NH = 4, NG = 32, NCOND = 9, NMOD = 6;
constexpr int NCHUNK = MT / 16;
constexpr int KVROWS = MC + DB * (PAST + DSEQ);
constexpr float EPS = 1e-6f;
constexpr float C2 = 0.125f * 1.4426950408889634f;
constexpr int NWAVES = 8, NTHREADS = 512;

constexpr size_t MiB = 1u << 20;
constexpr size_t WS_CTL = 0, CTL_BYTES = 1 * MiB;
constexpr size_t WS_MISC = 1 * MiB;
constexpr size_t WS_WIN = 3 * MiB;
constexpr size_t WS_WGLU = 11 * MiB;
constexpr size_t WS_WOUT = 12 * MiB;
constexpr size_t WS_WUP = 16 * MiB;
constexpr size_t WS_WDN = 32 * MiB;
constexpr size_t WS_SSM = 40 * MiB;
constexpr size_t WS_XS = 53 * MiB;
constexpr size_t WS_KB = 77 * MiB;
constexpr size_t WS_VB = 93 * MiB;
constexpr size_t WS_R = 109 * MiB;
constexpr size_t WS_G = 205 * MiB;
constexpr size_t WS_END = 253 * MiB;
constexpr size_t R_Q = 0, R_AS3 = 12 * MiB, R_E = 36 * MiB, R_Z = 60 * MiB, R_CAT = 72 * MiB;
constexpr size_t SSM_WE = 0, SSM_WY = 4 * MiB, SSM_LAM16 = 12 * MiB, SSM_BBAR = 12 * MiB + 64 * 1024;
constexpr int MI_MOD = 0;
constexpr int MI_ROPE = MI_MOD + 2 * 9 * 6144;
constexpr int MI_LAM = MI_ROPE + 64 * 16 * 2;
constexpr int MI_END = MI_LAM + 8;
static_assert((size_t)MI_END * 4 <= 2 * MiB, "MISC");
constexpr int CW_BAR = 1024;
constexpr int CW_ZC = 7168;
constexpr int CW_UC = 4608;
constexpr int CW_SS = 8192;
constexpr int CW_BIN = 65536;
constexpr int CW_BUP = CW_BIN + 2 * 9 * 2048;
static_assert((size_t)(CW_SS + 4 * MT) <= CW_BIN && (size_t)(CW_BUP + 2 * 9 * 4096) * 4 <= CTL_BYTES, "CTL");

constexpr int RING_BYTES = 131072;
constexpr int LDS_BYTES_ = 147456; constexpr int LDSCTL_OFF = LDS_BYTES_ - 512, MISC_OFF = LDSCTL_OFF + 320;
constexpr int LDS_BYTES = 147456;

#define RLX_AGENT __ATOMIC_RELAXED, __HIP_MEMORY_SCOPE_AGENT
typedef __bf16 bf16x2_t __attribute__((ext_vector_type(2)));
__device__ __forceinline__ unsigned cvt_pk_bf16(float lo, float hi) { const f32x2 v = {lo, hi}; const bf16x2_t b = __builtin_convertvector(v, bf16x2_t); return __builtin_bit_cast(unsigned, b); }
__device__ __forceinline__ float bf2f(unsigned short b) { return __uint_as_float((unsigned)b << 16); }
__device__ __forceinline__ float bflo(unsigned w) { return __uint_as_float(w << 16); }
__device__ __forceinline__ float bfhi(unsigned w) { return __uint_as_float(w & 0xffff0000u); }
__device__ __forceinline__ float fast_exp2(float x) { return __builtin_amdgcn_exp2f(x); }
__device__ __forceinline__ float fast_rcp(float x) { return __builtin_amdgcn_rcpf(x); }
__device__ __forceinline__ float sigmoid_f(float x) { return fast_rcp(1.f + fast_exp2(-1.4426950408889634f * x)); }
__device__ __forceinline__ float silu_f(float x) { return x * sigmoid_f(x); }
__device__ __forceinline__ float gelu_tanh_f(float x) {
    const float u = 0.7978845608028654f * (x + 0.044715f * x * x * x); return x * sigmoid_f(2.f * u); }
__device__ __forceinline__ float shfl_xor_l(float v, int mask, int lane) { return __uint_as_float((unsigned)__builtin_amdgcn_ds_bpermute((lane ^ mask) << 2, (int)__float_as_uint(v))); }
__device__ __forceinline__ float wave_sum(float v, int lane) {
#pragma unroll
    for (int o = 1; o < 64; o <<= 1) v += shfl_xor_l(v, o, lane);
    return v; }

#define XB_TMO      128
#define XB_XCNT(j)  (256  + 64 * (j))
#define XB_XSUB(j)  (1280 + 64 * (j))
#define XB_XGEN(j)  (2304 + 64 * (j))
#define XB_TOP      3328
#define XB_TOPGEN   3392
#define XCD_BAR_WORDS 3456
#define XB_SPIN_CAP (1u << 18)
__device__ __forceinline__ unsigned xb_ld(unsigned* p)              { return __hip_atomic_load(p, __ATOMIC_RELAXED, __HIP_MEMORY_SCOPE_AGENT); }
__device__ __forceinline__ unsigned xb_add(unsigned* p, unsigned v) { return __hip_atomic_fetch_add(p, v, __ATOMIC_RELAXED, __HIP_MEMORY_SCOPE_AGENT); }
__device__ __forceinline__ unsigned xb_xcc_id() { return (unsigned)__builtin_amdgcn_s_getreg((3 << 11) | 20) & 0xFu; }
#define XB_SPIN(cond, bar) do { unsigned _sp = 0; while (cond) { __builtin_amdgcn_s_sleep(1); \
    if ((++_sp & 255u) == 0u) { if (xb_ld(&(bar)[XB_TMO])) break; if (_sp > XB_SPIN_CAP) { atomicAdd(&(bar)[XB_TMO], 1u); break; } } } } while (0)
struct XcdBarrier { unsigned* bar; unsigned x; volatile LAS unsigned* st; };
__device__ __forceinline__ XcdBarrier xcd_barrier_post(unsigned* bar, volatile LAS unsigned* st) {
    XcdBarrier b; b.bar = bar; b.x = xb_xcc_id(); b.st = st;
    if (threadIdx.x == 0) (void)xb_add(&bar[XB_XCNT(b.x)], 1u);
    return b;
}
__device__ __forceinline__ void xcd_barrier_complete(unsigned* bar, unsigned x, unsigned& nloc, unsigned& nx) {
    const unsigned G = gridDim.x * gridDim.y * gridDim.z;
    unsigned sum, cnt, mine, sp = 0u;
    for (;;) {
        sum = 0u; cnt = 0u; mine = 0u;
#pragma unroll
        for (unsigned j = 0; j < 16; ++j) { const unsigned c = xb_ld(&bar[XB_XCNT(j)]); sum += c; cnt += (c > 0u) ? 1u : 0u; mine = (j == x) ? c : mine; }
        if (sum == G) break;
        __builtin_amdgcn_s_sleep(1);
        if ((++sp & 255u) == 0u) { if (xb_ld(&bar[XB_TMO])) break; if (sp > XB_SPIN_CAP) { atomicAdd(&bar[XB_TMO], 1u); break; } }
    }
    nloc = mine > 0u ? mine : 1u; nx = cnt > 0u ? cnt : 1u;
}
__device__ __forceinline__ void xcd_barrier(const XcdBarrier& b, const int tid) {
    asm volatile("s_waitcnt vmcnt(0)" ::: "memory");
    __syncthreads();
    if (tid == 0) {
        unsigned* bar = b.bar;
        __builtin_amdgcn_s_waitcnt(0);
        unsigned nloc = b.st[0], nx = b.st[1];
        if (nloc == 0u) { xcd_barrier_complete(bar, b.x, nloc, nx); b.st[0] = nloc; b.st[1] = nx; }
        const unsigned old = xb_add(&bar[XB_XSUB(b.x)], 1u);
        const unsigned gen = old / nloc;
        if (old + 1u == (gen + 1u) * nloc) {
            __builtin_amdgcn_fence(__ATOMIC_RELEASE, "agent");
            asm volatile("s_waitcnt vmcnt(0)" ::: "memory");
            const unsigned og = xb_add(&bar[XB_TOP], 1u);
            const unsigned tg = og / nx;
            if (og + 1u == (tg + 1u) * nx) xb_add(&bar[XB_TOPGEN], 1u);
            else XB_SPIN(xb_ld(&bar[XB_TOPGEN]) == tg, bar);
            __builtin_amdgcn_fence(__ATOMIC_ACQUIRE, "agent");
            xb_add(&bar[XB_XGEN(b.x)], 1u);
            asm volatile("s_waitcnt vmcnt(0)" ::: "memory");
        } else {
            XB_SPIN(xb_ld(&bar[XB_XGEN(b.x)]) == gen, bar);
            __builtin_amdgcn_fence(__ATOMIC_ACQUIRE, "agent");
            asm volatile("s_waitcnt vmcnt(0)" ::: "memory");
        }
    }
    __syncthreads();
}

constexpr int BM = 256, BK = 64, HALF = 128, HTB = HALF * BK * 2, NXCD = 8, WGM = 8;
__host__ __device__ __forceinline__ int lds_byte(int r, int c) { const int st = (r >> 4) * 2 + (c >> 5), rr = r & 15, cc = c & 31, ob = rr * 64 + cc * 2; return st * 1024 + (ob ^ (((ob >> 9) & 1) << 5)); }
__host__ __device__ __forceinline__ void stage_rc(int b, int& R, int& C) { const int st = b / 1024, sb = b % 1024, swz = sb ^ (((sb >> 9) & 1) << 5); R = (st >> 1) * 16 + swz / 64; C = (st & 1) * 32 + (swz % 64) / 2; }
__host__ __device__ __forceinline__ int perm32(int rho) { const int n = rho >> 4, i = rho & 15; return 8 * (i >> 2) + 4 * n + (i & 3); }

struct Unit { int pm, pn, g; };
struct Gemm { const bf16_t* A; const bf16_t* Bt; int lda, ldb, K; size_t gsA, gsB; };
struct GridOrder {
    int nM, nN, nwg, G, c;
    __device__ void init(int M, int N, int G_, int c_) { nM = M / BM; nN = N / BM; nwg = nM * nN; G = G_; c = c_; }
    __device__ bool next(int i, Unit& u) const {
        const long L = (long)i * G + c; if (L >= nwg) return false;
        int wgid = (int)L; { const int q = nwg / NXCD, r = nwg % NXCD, xcd = wgid % NXCD, off = wgid / NXCD; wgid = (xcd < r ? xcd * (q + 1) : r * (q + 1) + (xcd - r) * q) + off; }
        const int nig = WGM * nN, gid = wgid / nig, fm = gid * WGM, gsz = (nM - fm) < WGM ? (nM - fm) : WGM;
        u.pm = fm + ((wgid % nig) % gsz); u.pn = (wgid % nig) / gsz; u.g = 0; return true;
    }
};
struct InOrder {
    int c, G;
    __device__ bool next(int i, Unit& u) const { const int L = i * G + c; if (L >= 384) return false; u.g = 0;
        if (L < 96) { const int j = (L & 7) * 12 + (L >> 3); u.pm = j >> 1; u.pn = 6 + (j & 1); }
        else { const int Lp = L - 96, j = (Lp & 7) * 36 + (Lp >> 3); u.pm = j / 6; u.pn = j % 6; }
        return true; }
};
struct OneTile {
    int idx;
    __device__ bool next(int i, Unit& u) const { if (i > 0 || idx < 0) return false; u.pm = idx >> 1; u.pn = idx & 1; u.g = 0; return true; }
};
struct GroupOrder {
    int c, G;
    __device__ bool next(int i, Unit& u) const { const int idx = c + i * G; if (c < 0 || idx >= NG * 3) return false; u.g = idx / 3; u.pm = idx % 3; u.pn = 0; return true; }
};

template <class Epi, class Sched, bool AROWPERM = false>
__device__ __forceinline__ void gemm_phase(LAS unsigned char* lds, const int tid, const Gemm g, const Sched& S, const Epi& E) {
    const int wid = __builtin_amdgcn_readfirstlane(tid >> 6), lane = tid & 63, wr = wid >> 2, wc = wid & 3, fr = lane & 15, fq = lane >> 4;
    const int K = g.K, nt = K / BK;
    unsigned voffA[2], voffB[2];
#pragma unroll
    for (int i = 0; i < 2; ++i) { int R, C; stage_rc(tid * 16 + i * 8192, R, C); const int Rb = Epi::PERM ? ((R & ~31) + perm32(R & 31)) : R;
        const int Ra = AROWPERM ? ((R & 64) + 4 * (R & 15) + ((R >> 4) & 3)) : R;
        voffA[i] = (unsigned)(Ra * g.lda + C) * 2u; voffB[i] = (unsigned)(Rb * g.ldb + C) * 2u; }
    const size_t kstep = (size_t)(BK * 2);
    const size_t hstepA = (size_t)HALF * g.lda * 2, hstepB = (size_t)HALF * g.ldb * 2;
    const unsigned ldsw = (unsigned)wid * 1024u;
    const int aoff = lds_byte(wr * 64 + fr, fq * 8), boff = lds_byte(wc * 32 + fr, fq * 8);
#define PG8_SA(b, h) (((b) * 2 + (h)) * HTB)
#define PG8_SB(b, h) ((4 + (b) * 2 + (h)) * HTB)
#define PG8_STAGE(bufoff, gbase, voff) do { _Pragma("unroll") for (int _i = 0; _i < 2; ++_i) \
        __builtin_amdgcn_global_load_lds((const unsigned*)((const char*)(gbase) + (voff)[_i]), (LAS unsigned*)(lds + (bufoff) + ldsw + _i * 8192), 16, 0, 0); } while (0)
#define PG8_LDA(dst, b, h) do { _Pragma("unroll") for (int m = 0; m < 4; ++m) _Pragma("unroll") for (int k = 0; k < 2; ++k) dst[m][k] = *(const LAS bf16x8*)(lds + PG8_SA(b, h) + aoff + m * 2048 + k * 1024); } while (0)
#define PG8_LDB(dst, b, h) do { _Pragma("unroll") for (int n = 0; n < 2; ++n) _Pragma("unroll") for (int k = 0; k < 2; ++k) dst[n][k] = *(const LAS bf16x8*)(lds + PG8_SB(b, h) + boff + n * 2048 + k * 1024); } while (0)
#define PG8_MMA(ai, bj, At, Bt) do { __builtin_amdgcn_s_setprio(1); _Pragma("unroll") for (int m = 0; m < 4; ++m) _Pragma("unroll") for (int n = 0; n < 2; ++n) _Pragma("unroll") for (int k = 0; k < 2; ++k) \
        acc[ai][bj][m][n] = __builtin_amdgcn_mfma_f32_16x16x32_bf16(Bt[n][k], At[m][k], acc[ai][bj][m][n], 0, 0, 0); __builtin_amdgcn_s_setprio(0); } while (0)
#define PG8_WAIT_V(n) asm volatile("s_waitcnt vmcnt(" #n ")" ::: "memory")
#define PG8_WAIT_L(n) asm volatile("s_waitcnt lgkmcnt(" #n ")" ::: "memory")
#define PG8_BAR __builtin_amdgcn_s_barrier()
#define PG8_SCHED __builtin_amdgcn_sched_barrier(0)
#define PG8_APTR(u) ((const char*)g.A + ((size_t)(u).g * g.gsA + (size_t)(u).pm * BM * g.lda) * 2)
#define PG8_BPTR(u) ((const char*)g.Bt + ((size_t)(u).g * g.gsB + (size_t)(u).pn * BM * g.ldb) * 2)
    Unit cur, nxt; int ui = 0;
    if (!S.next(0, cur)) return;
    f32x4 acc[2][2][4][2];
#pragma unroll
    for (int a = 0; a < 2; ++a)
#pragma unroll
        for (int b = 0; b < 2; ++b)
#pragma unroll
            for (int m = 0; m < 4; ++m)
#pragma unroll
                for (int n = 0; n < 2; ++n) acc[a][b][m][n] = (f32x4){0.f, 0.f, 0.f, 0.f};
    bf16x8 At[4][2], B0[2][2], B1[2][2];
    const char* cA = PG8_APTR(cur); const char* cB = PG8_BPTR(cur);
    PG8_STAGE(PG8_SB(0, 0), cB, voffB); PG8_STAGE(PG8_SB(0, 1), cB + hstepB, voffB); PG8_STAGE(PG8_SA(0, 0), cA, voffA); PG8_STAGE(PG8_SA(0, 1), cA + hstepA, voffA);
    if (wr == 1) PG8_BAR;
    PG8_WAIT_V(2); PG8_BAR;
    PG8_STAGE(PG8_SB(1, 0), cB + kstep, voffB); PG8_STAGE(PG8_SA(1, 0), cA + kstep, voffA); PG8_STAGE(PG8_SB(1, 1), cB + hstepB + kstep, voffB);
    PG8_WAIT_V(6); PG8_BAR;
    for (;;) {
        const bool has_next = S.next(ui + 1, nxt);
        const char* nA = has_next ? PG8_APTR(nxt) : cA; const char* nB = has_next ? PG8_BPTR(nxt) : cB;
        for (int t = 0; t < nt; t += 2) {
            const bool last = (t == nt - 2);
            const char* a1 = cA + (size_t)(t + 1) * kstep;
            const char* a2 = last ? nA : cA + (size_t)(t + 2) * kstep; const char* b2 = last ? nB : cB + (size_t)(t + 2) * kstep;
            const char* a3 = a2 + kstep; const char* b3 = b2 + kstep;
            PG8_LDB(B0, 0, 0); PG8_LDB(B1, 0, 1); PG8_SCHED; PG8_LDA(At, 0, 0); PG8_STAGE(PG8_SA(1, 1), a1 + hstepA, voffA);
            PG8_WAIT_V(8); PG8_WAIT_L(0); PG8_BAR; PG8_MMA(0, 0, At, B0); PG8_MMA(0, 1, At, B1); PG8_BAR; PG8_SCHED;
            PG8_LDA(At, 0, 1); PG8_STAGE(PG8_SB(0, 0), b2, voffB); PG8_STAGE(PG8_SB(0, 1), b2 + hstepB, voffB); PG8_STAGE(PG8_SA(0, 0), a2, voffA);
            PG8_WAIT_V(8); PG8_WAIT_L(0); PG8_BAR; PG8_MMA(1, 0, At, B0); PG8_MMA(1, 1, At, B1); PG8_BAR; PG8_SCHED;
            PG8_LDB(B0, 1, 0); PG8_LDB(B1, 1, 1); PG8_SCHED; PG8_LDA(At, 1, 0); PG8_STAGE(PG8_SA(0, 1), a2 + hstepA, voffA);
            PG8_WAIT_V(8); PG8_WAIT_L(0); PG8_BAR; PG8_MMA(0, 0, At, B0); PG8_MMA(0, 1, At, B1); PG8_BAR; PG8_SCHED;
            PG8_LDA(At, 1, 1); PG8_STAGE(PG8_SB(1, 0), b3, voffB); PG8_STAGE(PG8_SB(1, 1), b3 + hstepB, voffB); PG8_STAGE(PG8_SA(1, 0), a3, voffA);
            PG8_WAIT_V(8); PG8_WAIT_L(0); PG8_BAR; PG8_MMA(1, 0, At, B0); PG8_MMA(1, 1, At, B1); PG8_BAR; PG8_SCHED;
        }
        if (wr == 0) PG8_BAR;
        { unsigned z_ = 0u; asm volatile("" : "+v"(z_)); const int l2 = (int)__builtin_amdgcn_mbcnt_hi(~0u, __builtin_amdgcn_mbcnt_lo(~0u, z_));
          E(acc, cur, wr, wc, l2 & 15, l2 >> 4);
          E.done(cur, l2); }
        if (!has_next) break;
#pragma unroll
        for (int a = 0; a < 2; ++a)
#pragma unroll
            for (int b = 0; b < 2; ++b)
#pragma unroll
                for (int m = 0; m < 4; ++m)
#pragma unroll
                    for (int n = 0; n < 2; ++n) acc[a][b][m][n] = (f32x4){0.f, 0.f, 0.f, 0.f};
        cur = nxt; cA = nA; cB = nB; ++ui;
        if (wr == 1) PG8_BAR;
    }
    PG8_WAIT_V(0);
    PG8_BAR;
#undef PG8_SA
#undef PG8_SB
#undef PG8_STAGE
#undef PG8_LDA
#undef PG8_LDB
#undef PG8_MMA
#undef PG8_WAIT_V
#undef PG8_WAIT_L
#undef PG8_BAR
#undef PG8_SCHED
#undef PG8_APTR
#undef PG8_BPTR
}
__device__ __forceinline__ int cond_of_pm(int pm) { return pm < 16 ? 0 : 1 + ((pm - 16) >> 2); }
__device__ __forceinline__ int kvrow_of(int row) { return row < MC ? row : MC + ((row - MC) >> 10) * (PAST + DSEQ) + PAST + ((row - MC) & 1023); }
__device__ __forceinline__ u32x4 pack8(const f32x4& a, const f32x4& b) { u32x4 w; w.x = cvt_pk_bf16(a[0], a[1]); w.y = cvt_pk_bf16(a[2], a[3]); w.z = cvt_pk_bf16(b[0], b[1]); w.w = cvt_pk_bf16(b[2], b[3]); return w; }

struct EpiIn {
    static constexpr bool PERM = true;
    const float* sumsq; const float* bias; const float* qn; const float* kn; const f32x2* rope;
    bf16_t* Q; bf16_t* KB; bf16_t* VB; __amdgpu_buffer_rsrc_t as3r; float* new_k; float* new_v; int l; unsigned* ucnt;
    __device__ __forceinline__ void done(const Unit& u, int lane) const {
        if (u.pn >= 6) { asm volatile("s_waitcnt vmcnt(0)" ::: "memory"); if (lane == 0) __hip_atomic_fetch_add(ucnt + (((u.pm >> 4) * 2) + (u.pn - 6)) * 64, 1u, RLX_AGENT); } }
    __device__ __forceinline__ void operator()(const f32x4 (&acc)[2][2][4][2], const Unit& u, int wr, int wc, int fr, int fq) const {
        const int pm = u.pm, pn = u.pn; const bool ctx = pm < 16; const int cond = cond_of_pm(pm);
        const float* bz = bias + cond * 2048 + pn * 256 + wc * 32 + 8 * fq;
        f32x4 bv[2][2];
#pragma unroll
        for (int bj = 0; bj < 2; ++bj)
#pragma unroll
            for (int n = 0; n < 2; ++n) bv[bj][n] = *(const f32x4*)(bz + bj * 128 + 4 * n);
        const int rbase = pm * BM + wr * 64 + fr;
        if (pn < 4) {
            const bool isq = pn < 2; const float* gv = isq ? qn : kn;
            const int G = (pn & 1) * 4 + wc;
            const int cb = 32 * (fq >> 1) + 8 * (fq & 1);
            f32x4 gg[2][2];
#pragma unroll
            for (int bj = 0; bj < 2; ++bj)
#pragma unroll
                for (int n = 0; n < 2; ++n) gg[bj][n] = *(const f32x4*)(gv + cb + 16 * bj + 4 * n);
            const float qs = isq ? C2 : 1.f;
#pragma unroll
            for (int ai = 0; ai < 2; ++ai)
#pragma unroll
                for (int m = 0; m < 4; ++m) {
                    const int row = rbase + ai * HALF + m * 16;
                    const float rstd = rsqrtf(sumsq[row] * (1.f / DM) + EPS);
                    f32x4 v[2][2]; float ss = 0.f;
#pragma unroll
                    for (int bj = 0; bj < 2; ++bj)
#pragma unroll
                        for (int n = 0; n < 2; ++n) { v[bj][n] = acc[ai][bj][m][n] * rstd + bv[bj][n]; const f32x4 t = v[bj][n] * v[bj][n]; ss += (t[0] + t[1]) + (t[2] + t[3]); }
                    { const int ln_ = fq * 16 + fr; ss += shfl_xor_l(ss, 16, ln_); ss += shfl_xor_l(ss, 32, ln_); }
                    const float rn = rsqrtf(ss * (1.f / 64.f) + EPS);
#pragma unroll
                    for (int bj = 0; bj < 2; ++bj)
#pragma unroll
                        for (int n = 0; n < 2; ++n) v[bj][n] = v[bj][n] * rn * gg[bj][n];
                    if (ctx) {
                        if (!isq) { float* nk = new_k + ((size_t)((row >> 8) * DEPTH + l) * SEQ + (row & 255)) * 512 + G * 64 + cb;
#pragma unroll
                            for (int bj = 0; bj < 2; ++bj) { *(f32x4*)(nk + 16 * bj) = v[bj][0]; *(f32x4*)(nk + 16 * bj + 4) = v[bj][1]; } }
                    } else {
                        const int t = (row - MC) & 1023; const int pos = (fq >> 1) ? (t & 63) : (t >> 6);
                        const f32x2* rp = rope + pos * 16 + 8 * (fq & 1);
#pragma unroll
                        for (int n = 0; n < 2; ++n)
#pragma unroll
                            for (int j = 0; j < 4; ++j) { const f32x2 cs = rp[4 * n + j]; const float x1 = v[0][n][j], x2 = v[1][n][j]; v[0][n][j] = x1 * cs.x - x2 * cs.y; v[1][n][j] = x1 * cs.y + x2 * cs.x; }
                    }
                    bf16_t* dst = isq ? (Q + (size_t)row * 512) : (KB + (size_t)kvrow_of(row) * 512);
                    dst += G * 64 + cb;
#pragma unroll
                    for (int bj = 0; bj < 2; ++bj) *(u32x4*)(dst + 16 * bj) = pack8(v[bj][0] * qs, v[bj][1] * qs);
                }
        } else if (pn < 6) {
            const int col0 = (pn - 4) * 256 + wc * 32 + 8 * fq;
#pragma unroll
            for (int ai = 0; ai < 2; ++ai)
#pragma unroll
                for (int m = 0; m < 4; ++m) {
                    const int row = rbase + ai * HALF + m * 16;
                    const float rstd = rsqrtf(sumsq[row] * (1.f / DM) + EPS);
                    bf16_t* dst = VB + (size_t)kvrow_of(row) * 512 + col0;
#pragma unroll
                    for (int bj = 0; bj < 2; ++bj) { const f32x4 a = acc[ai][bj][m][0] * rstd + bv[bj][0], b = acc[ai][bj][m][1] * rstd + bv[bj][1];
                        *(u32x4*)(dst + 128 * bj) = pack8(a, b);
                        if (ctx) { float* nv = new_v + ((size_t)((row >> 8) * DEPTH + l) * SEQ + (row & 255)) * 512 + col0 + 128 * bj; *(f32x4*)nv = a; *(f32x4*)(nv + 4) = b; } }
                }
        } else {
            const int cu0 = (pn - 6) * 256 + wc * 32 + 8 * fq;
#pragma unroll
            for (int ai = 0; ai < 2; ++ai)
#pragma unroll
                for (int m = 0; m < 4; ++m) {
                    const int row = rbase + ai * HALF + m * 16;
                    const float rstd = rsqrtf(sumsq[row] * (1.f / DM) + EPS);
#pragma unroll
                    for (int bj = 0; bj < 2; ++bj) { const int cu = cu0 + 128 * bj; const f32x4 a = acc[ai][bj][m][0] * rstd + bv[bj][0], b = acc[ai][bj][m][1] * rstd + bv[bj][1];
                        __builtin_amdgcn_raw_buffer_store_b128(pack8(a, b), as3r, (int)(((unsigned)((cu >> 4) * NCHUNK + (row >> 4)) * 512u + (row & 15) * 16 + (cu & 15)) * 2u), 0,   16); }
                }
        }
    }
};
struct EpiS1 {
    static constexpr bool PERM = false;
    float* E;
    __device__ __forceinline__ void done(const Unit&, int) const {}
    __device__ __forceinline__ void operator()(const f32x4 (&acc)[2][2][4][2], const Unit& u, int wr, int wc, int fr, int fq) const {
        const int rbase = u.pm * BM + wr * 64 + fr, col0 = wc * 32 + 4 * fq;
#pragma unroll
        for (int ai = 0; ai < 2; ++ai)
#pragma unroll
            for (int m = 0; m < 4; ++m) { float* dst = E + ((size_t)u.g * NCHUNK + rbase + ai * HALF + m * 16) * 256 + col0;
#pragma unroll
                for (int bj = 0; bj < 2; ++bj)
#pragma unroll
                    for (int n = 0; n < 2; ++n) *(f32x4*)(dst + bj * HALF + n * 16) = acc[ai][bj][m][n]; }
    }
};
struct EpiS3 {
    static constexpr bool PERM = true;
    __amdgpu_buffer_rsrc_t zr;
    __device__ __forceinline__ void done(const Unit&, int) const {}
    __device__ __forceinline__ void operator()(const f32x4 (&acc)[2][2][4][2], const Unit& u, int wr, int wc, int fr, int fq) const {
        const int rbase = u.pm * BM + wr * 64 + fr;
#pragma unroll
        for (int ai = 0; ai < 2; ++ai)
#pragma unroll
            for (int m = 0; m < 4; ++m) { const int chunk = rbase + ai * HALF + m * 16;
#pragma unroll
                for (int bj = 0; bj < 2; ++bj) { const int tt = 8 * bj + 2 * wc + (fq >> 1), c0 = 8 * (fq & 1);
                    f32x4 a = acc[ai][bj][m][0], b = acc[ai][bj][m][1];
#pragma unroll
                    for (int j = 0; j < 4; ++j) { a[j] = gelu_tanh_f(a[j]); b[j] = gelu_tanh_f(b[j]); }
                    __builtin_amdgcn_raw_buffer_store_b128(pack8(a, b), zr, (int)((((unsigned)chunk * 16u + tt) * 512u + u.g * 16 + c0) * 2u), 0,   16); } }
    }
};
struct EpiGlu {
    static constexpr bool PERM = true;
    const bf16_t* Z; const float* bg; bf16_t* CAT;
    __device__ __forceinline__ void done(const Unit&, int) const {}
    __device__ __forceinline__ void operator()(const f32x4 (&acc)[2][2][4][2], const Unit& u, int wr, int wc, int fr, int fq) const {
        const int rbase = u.pm * BM + wr * 64 + fr, col0 = u.pn * BM + wc * 32 + 8 * fq;
        f32x4 bv[2][2];
#pragma unroll
        for (int bj = 0; bj < 2; ++bj)
#pragma unroll
            for (int n = 0; n < 2; ++n) bv[bj][n] = *(const f32x4*)(bg + col0 + bj * HALF + 4 * n);
#pragma unroll
        for (int ai = 0; ai < 2; ++ai)
#pragma unroll
            for (int m = 0; m < 4; ++m) { const int row = rbase + ai * HALF + m * 16;
#pragma unroll
                for (int bj = 0; bj < 2; ++bj) { const u32x4 zw = *(const u32x4*)(Z + (size_t)row * 512 + col0 + bj * HALF);
                    f32x4 a = acc[ai][bj][m][0] + bv[bj][0], b = acc[ai][bj][m][1] + bv[bj][1];
                    a[0] = bflo(zw.x) * sigmoid_f(a[0]); a[1] = bfhi(zw.x) * sigmoid_f(a[1]); a[2] = bflo(zw.y) * sigmoid_f(a[2]); a[3] = bfhi(zw.y) * sigmoid_f(a[3]);
                    b[0] = bflo(zw.z) * sigmoid_f(b[0]); b[1] = bfhi(zw.z) * sigmoid_f(b[1]); b[2] = bflo(zw.w) * sigmoid_f(b[2]); b[3] = bfhi(zw.w) * sigmoid_f(b[3]);
                    *(u32x4*)(CAT + (size_t)row * 1024 + 512 + col0 + bj * HALF) = pack8(a, b); } }
    }
};
struct EpiRes {
    static constexpr bool PERM = true;
    const float* xin0; const float* xin1;
    float* xout;
    const float* gate;
    const float* gn; const float* sc;
    bf16_t* XS; float* ssq;
    __device__ __forceinline__ void done(const Unit&, int) const {}
    __device__ __forceinline__ void operator()(const f32x4 (&acc)[2][2][4][2], const Unit& u, int wr, int wc, int fr, int fq) const {
        const int pm = u.pm, cond = cond_of_pm(pm); const int col0 = u.pn * BM + wc * 32 + 8 * fq; const int rbase = pm * BM + wr * 64 + fr;
        const bool donorm = (gn != nullptr);
        f32x4 gt[2][2], gs[2][2];
#pragma unroll
        for (int bj = 0; bj < 2; ++bj)
#pragma unroll
            for (int n = 0; n < 2; ++n) { const int c = col0 + bj * HALF + n * 4; gt[bj][n] = *(const f32x4*)(gate + cond * 6144 + c);
                if (donorm) { const f32x4 g4 = *(const f32x4*)(gn + c), s4 = *(const f32x4*)(sc + cond * 6144 + c); gs[bj][n] = g4 * (s4 + 1.f); } else gs[bj][n] = (f32x4){0.f, 0.f, 0.f, 0.f}; }
#pragma unroll
        for (int ai = 0; ai < 2; ++ai)
#pragma unroll
            for (int m = 0; m < 4; ++m) { const int row = rbase + ai * HALF + m * 16;
                const float* xi = (row < MC) ? (xin0 + (size_t)row * DM) : (xin1 + (size_t)(row - MC) * DM);
                float ss = 0.f;
#pragma unroll
                for (int bj = 0; bj < 2; ++bj) { const int c = col0 + bj * HALF;
                    const f32x4 x0 = *(const f32x4*)(xi + c) + gt[bj][0] * acc[ai][bj][m][0], x1 = *(const f32x4*)(xi + c + 4) + gt[bj][1] * acc[ai][bj][m][1];
                    *(f32x4*)(xout + (size_t)row * DM + c) = x0; *(f32x4*)(xout + (size_t)row * DM + c + 4) = x1;
                    if (donorm) { const f32x4 t0 = x0 * x0, t1 = x1 * x1; ss += ((t0[0] + t0[1]) + (t0[2] + t0[3])) + ((t1[0] + t1[1]) + (t1[2] + t1[3]));
                        *(u32x4*)(XS + (size_t)row * DM + c) = pack8(x0 * gs[bj][0], x1 * gs[bj][1]); } }
                if (donorm) { { const int ln_ = fq * 16 + fr; ss += shfl_xor_l(ss, 16, ln_); ss += shfl_xor_l(ss, 32, ln_); } if (fq == 0) atomicAdd(ssq + row, ss); }
            }
    }
};
struct EpiUp {
    static constexpr bool PERM = true;
    const float* sumsq; const float* bias; bf16_t* UP;
    __device__ __forceinline__ void done(const Unit&, int) const {}
    __device__ __forceinline__ void operator()(const f32x4 (&acc)[2][2][4][2], const Unit& u, int wr, int wc, int fr, int fq) const {
        const int pm = u.pm, cond = cond_of_pm(pm); const int col0 = u.pn * BM + wc * 32 + 8 * fq; const int rbase = pm * BM + wr * 64 + fr;
        f32x4 bv[2][2];
#pragma unroll
        for (int bj = 0; bj < 2; ++bj)
#pragma unroll
            for (int n = 0; n < 2; ++n) bv[bj][n] = *(const f32x4*)(bias + cond * 4096 + col0 + bj * HALF + 4 * n);
#pragma unroll
        for (int ai = 0; ai < 2; ++ai)
#pragma unroll
            for (int m = 0; m < 4; ++m) { const int row = rbase + ai * HALF + m * 16; const float rstd = rsqrtf(sumsq[row] * (1.f / DM) + EPS);
#pragma unroll
                for (int bj = 0; bj < 2; ++bj) *(u32x4*)(UP + (size_t)row * 4096 + col0 + bj * HALF) = pack8(acc[ai][bj][m][0] * rstd + bv[bj][0], acc[ai][bj][m][1] * rstd + bv[bj][1]); }
    }
};

__device__ __forceinline__ float dpp_shr1(float v) { return __uint_as_float((unsigned)__builtin_amdgcn_update_dpp(0, (int)__float_as_uint(v), 0x111, 0xf, 0xf, false)); }
__device__ __forceinline__ float dpp_shl1(float v) { return __uint_as_float((unsigned)__builtin_amdgcn_update_dpp(0, (int)__float_as_uint(v), 0x101, 0xf, 0xf, false)); }
struct EpiUpConv {
    static constexpr bool PERM = true;
    const float* sumsq; const float* bias; const float* cw; const float* cb; bf16_t* G; bf16_t* HALO;
    __device__ __forceinline__ void done(const Unit&, int) const {}
    __device__ __forceinline__ void operator()(const f32x4 (&acc)[2][2][4][2], const Unit& u, int wr, int wc, int fr, int fq) const {
        const int pm = u.pm, pn = u.pn, cond = cond_of_pm(pm);
        const int posv = pn * 256 + wc * 32 + 8 * fq, av = pn * 128 + wc * 32 + 8 * fq;
#pragma unroll
        for (int ai = 0; ai < 2; ++ai) {
            const int tok0 = pm * BM + ai * HALF + wr * 64 + 4 * fr; const int sl = pm * 4 + ai * 2 + wr;
            float rs[4];
#pragma unroll
            for (int m = 0; m < 4; ++m) rs[m] = rsqrtf(sumsq[tok0 + m] * (1.f / DM) + EPS);
#pragma unroll
            for (int n = 0; n < 2; ++n) {
                const f32x4 bvv = *(const f32x4*)(bias + cond * 4096 + posv + 4 * n), bvg = *(const f32x4*)(bias + cond * 4096 + posv + 128 + 4 * n);
                f32x4 pv[4], pg[4];
#pragma unroll
                for (int m = 0; m < 4; ++m) { pv[m] = acc[ai][0][m][n] * rs[m] + bvv; pg[m] = acc[ai][1][m][n] * rs[m] + bvg; }
                f32x4 pvp, pvn, pgp, pgn;
#pragma unroll
                for (int j = 0; j < 4; ++j) { pvp[j] = dpp_shr1(pv[3][j]); pvn[j] = dpp_shl1(pv[0][j]); pgp[j] = dpp_shr1(pg[3][j]); pgn[j] = dpp_shl1(pg[0][j]); }
                const int c = av + 4 * n;
                const f32x4 w0v = *(const f32x4*)(cw + c), w1v = *(const f32x4*)(cw + 4096 + c), w2v = *(const f32x4*)(cw + 8192 + c), cbv = *(const f32x4*)(cb + c);
                const f32x4 w0g = *(const f32x4*)(cw + 2048 + c), w1g = *(const f32x4*)(cw + 4096 + 2048 + c), w2g = *(const f32x4*)(cw + 8192 + 2048 + c), cbg = *(const f32x4*)(cb + 2048 + c);
#pragma unroll
                for (int m = 0; m < 4; ++m) {
                    const f32x4 zv = cbv + w0v * (m == 0 ? pvp : pv[m == 0 ? 0 : m - 1]) + w1v * pv[m] + w2v * (m == 3 ? pvn : pv[m == 3 ? 3 : m + 1]);
                    const f32x4 zg = cbg + w0g * (m == 0 ? pgp : pg[m == 0 ? 0 : m - 1]) + w1g * pg[m] + w2g * (m == 3 ? pgn : pg[m == 3 ? 3 : m + 1]);
                    u32x2 w; w.x = cvt_pk_bf16(silu_f(zg[0]) * zv[0], silu_f(zg[1]) * zv[1]); w.y = cvt_pk_bf16(silu_f(zg[2]) * zv[2], silu_f(zg[3]) * zv[3]);
                    *(u32x2*)(G + (size_t)(tok0 + m) * 2048 + c) = w; }
                if (fr == 0 || fr == 15) { const int m0 = fr == 0 ? 0 : 2;
#pragma unroll
                    for (int mm = 0; mm < 2; ++mm) { const f32x4 a = fr == 0 ? pv[mm] : pv[2 + mm], b = fr == 0 ? pg[mm] : pg[2 + mm];
                        bf16_t* hp = HALO + ((size_t)sl * 4 + m0 + mm) * 4096 + posv + 4 * n;
                        u32x2 wa; wa.x = cvt_pk_bf16(a[0], a[1]); wa.y = cvt_pk_bf16(a[2], a[3]); *(u32x2*)hp = wa;
                        u32x2 wb; wb.x = cvt_pk_bf16(b[0], b[1]); wb.y = cvt_pk_bf16(b[2], b[3]); *(u32x2*)(hp + 128) = wb; } }
            }
        }
    }
};
constexpr int AT_SLOT = 32768, AT_NSLOT = 4, AT_VOFF = 16384, AT_X = 0, AT_ST = 65536;
__device__ __forceinline__ void glds16(const void* gsrc, unsigned lds_dst) { unsigned keep;
    asm volatile("s_mov_b32 %0, m0\n\ts_mov_b32 m0, %2\n\ts_nop 0\n\tglobal_load_lds_dwordx4 %1, off\n\ts_mov_b32 m0, %0" : "=&s"(keep) : "v"(gsrc), "s"(lds_dst) : "memory"); }
#define AT_WAIT_BAR(N) asm volatile("s_waitcnt vmcnt(" #N ") lgkmcnt(0)\n\ts_barrier" ::: "memory")
#define AT_SB() __builtin_amdgcn_sched_barrier(0)
__device__ __forceinline__ s16x4 vtr(const LAS char* p) { typedef short v4i16_t __attribute__((ext_vector_type(4))); return __builtin_bit_cast(s16x4, __builtin_amdgcn_ds_read_tr16_b64_v4i16((LAS v4i16_t*)p)); }
__device__ __forceinline__ int crow(int r, int hi) { return (r & 3) + 8 * (r >> 2) + 4 * hi; }

struct AttnArgs { const bf16_t* Q; const bf16_t* KB; const bf16_t* VB; bf16_t* CAT; const float* subln; float lam; float oml; };

__device__ __forceinline__ void attn_unit(LAS unsigned char* lds, const int tid, const AttnArgs& A, int seq, int h, int qblk) {
    const int lane = tid & 63, r32 = lane & 31, hi = lane >> 5; const int wid = __builtin_amdgcn_readfirstlane(tid >> 6);
    const int rg = wid & 3, s = wid >> 2;
    const bool ctx = seq < NB;
    const int qrow0 = ctx ? seq * SEQ + qblk * 128 : MC + (seq - NB) * DSEQ + qblk * 128;
    const int krow0 = ctx ? seq * SEQ : MC + (seq - NB) * (PAST + DSEQ);
    const int NT = ctx ? SEQ / 64 : (PAST + DSEQ) / 64;
    const unsigned lds0 = (unsigned)(uintptr_t)lds;
    const bf16_t* ksrc0 = A.KB + (size_t)(krow0 + lane) * 512 + h * 128 + wid * 8;
    const bf16_t* vsrc0 = A.VB + (size_t)(krow0 + 16 * (wid & 3) + (lane >> 2)) * 512 + h * 128 + (wid >> 2) * 32 + (lane & 3) * 8;
    const unsigned kdst = lds0 + wid * 1024, vdst = lds0 + AT_VOFF + ((wid >> 2) * 4 + (wid & 3)) * 1024;
#define AT_DMA(t, slot) do { const size_t _o = (size_t)(t) * 64 * 512; const unsigned _s = (unsigned)(slot) * AT_SLOT; \
        glds16(ksrc0 + _o, (unsigned)__builtin_amdgcn_readfirstlane(kdst + _s)); glds16(ksrc0 + _o + 64, (unsigned)__builtin_amdgcn_readfirstlane(kdst + _s + 8 * 1024)); \
        glds16(vsrc0 + _o, (unsigned)__builtin_amdgcn_readfirstlane(vdst + _s)); glds16(vsrc0 + _o + 64, (unsigned)__builtin_amdgcn_readfirstlane(vdst + _s + 8 * 1024)); } while (0)
    AT_DMA(0, 0); AT_DMA(1, 1); AT_DMA(2, 2);
    bf16x8 qr[4];
    { const bf16_t* qp = A.Q + (size_t)(qrow0 + rg * 32 + r32) * 512 + h * 128 + s * 64 + hi * 8;
#pragma unroll
      for (int d0 = 0; d0 < 4; ++d0) qr[d0] = *(const bf16x8*)(qp + d0 * 16); }
    f32x16 o[4];
#pragma unroll
    for (int d0 = 0; d0 < 4; ++d0)
#pragma unroll
        for (int r = 0; r < 16; ++r) o[d0][r] = 0.f;
    float lsum = 0.f;
    const LAS char* kfrag0 = (const LAS char*)lds + (s * 8 + hi) * 1024 + r32 * 16;
    const LAS char* vfrag0 = (const LAS char*)lds + AT_VOFF + ((lane >> 4) & 1) * 32 + (lane & 3) * 8 + (4 * hi + ((lane & 15) >> 2)) * 64;
    f32x16 pc0, pc1;
#define AT_KLOAD(kfr, slot) do { const LAS char* _k = kfrag0 + (slot) * AT_SLOT; _Pragma("unroll") for (int d0 = 0; d0 < 4; ++d0) { kfr[2 * d0] = *(const LAS bf16x8*)(_k + d0 * 2048); kfr[2 * d0 + 1] = *(const LAS bf16x8*)(_k + d0 * 2048 + 512); } } while (0)
#define AT_VLOAD(vv, slot, ks) do { const LAS char* _v = vfrag0 + (slot) * AT_SLOT + (ks) * 1024; _Pragma("unroll") for (int d0 = 0; d0 < 4; ++d0) { const s16x4 lo = vtr(_v + d0 * 4096), hh = vtr(_v + d0 * 4096 + 512); \
        vv[d0] = (bf16x8){lo[0], lo[1], lo[2], lo[3], hh[0], hh[1], hh[2], hh[3]}; } } while (0)
#define AT_EXP2(P, i, W) do { P[2 * (i)] = fast_exp2(P[2 * (i)]); P[2 * (i) + 1] = fast_exp2(P[2 * (i) + 1]); sacc += P[2 * (i)] + P[2 * (i) + 1]; W = cvt_pk_bf16(P[2 * (i)], P[2 * (i) + 1]); } while (0)
    AT_WAIT_BAR(8);
    { bf16x8 kfr[8]; AT_KLOAD(kfr, 0);
#pragma unroll
      for (int r = 0; r < 16; ++r) { pc0[r] = 0.f; pc1[r] = 0.f; }
#pragma unroll
      for (int d0 = 0; d0 < 4; ++d0) { pc0 = __builtin_amdgcn_mfma_f32_32x32x16_bf16(kfr[2 * d0], qr[d0], pc0, 0, 0, 0); pc1 = __builtin_amdgcn_mfma_f32_32x32x16_bf16(kfr[2 * d0 + 1], qr[d0], pc1, 0, 0, 0); } }
    int slot = 0;
    for (int t = 0; t < NT; ++t) {
        const bool has_next = t + 1 < NT;
        if (t + 2 < NT) AT_WAIT_BAR(4); else AT_WAIT_BAR(0);
        if (t + 3 < NT) AT_DMA(t + 3, (slot + 3) & 3);
        const int slot_n = (slot + 1) & 3;
        bf16x8 kfr[8], va[4], vb[4]; u32x4 pw[4]; f32x16 pn0, pn1; float sacc = 0.f;
        const LAS char* kn_ = kfrag0 + slot_n * AT_SLOT;
#define AT_K1(d0) do { kfr[2 * (d0)] = *(const LAS bf16x8*)(kn_ + (d0) * 2048); kfr[2 * (d0) + 1] = *(const LAS bf16x8*)(kn_ + (d0) * 2048 + 512); } while (0)
        if (has_next) { AT_K1(0); AT_K1(1); }
        AT_SB();
        if (has_next) {
#pragma unroll
            for (int r = 0; r < 16; ++r) { pn0[r] = 0.f; pn1[r] = 0.f; }
#pragma unroll
            for (int i = 0; i < 8; ++i) { const int d0 = i >> 1;
                if (i & 1) pn1 = __builtin_amdgcn_mfma_f32_32x32x16_bf16(kfr[2 * d0 + 1], qr[d0], pn1, 0, 0, 0); else pn0 = __builtin_amdgcn_mfma_f32_32x32x16_bf16(kfr[2 * d0], qr[d0], pn0, 0, 0, 0);
                AT_EXP2(pc0, i, pw[i >> 2][i & 3]);
                if (i == 0) AT_K1(2);
                if (i == 1) AT_K1(3);
                if (i == 3) AT_VLOAD(va, slot, 0);
                if (i == 5) AT_VLOAD(vb, slot, 1);
                AT_SB(); }
        } else {
            AT_VLOAD(va, slot, 0); AT_VLOAD(vb, slot, 1);
#pragma unroll
            for (int i = 0; i < 8; ++i) AT_EXP2(pc0, i, pw[i >> 2][i & 3]);
            AT_SB();
        }
        bf16x8 vc[4], vd[4];
#pragma unroll
        for (int i = 0; i < 8; ++i) { const int d0 = i & 3;
            if (i < 4) o[d0] = __builtin_amdgcn_mfma_f32_32x32x16_bf16(va[d0], __builtin_bit_cast(bf16x8, pw[0]), o[d0], 0, 0, 0);
            else       o[d0] = __builtin_amdgcn_mfma_f32_32x32x16_bf16(vb[d0], __builtin_bit_cast(bf16x8, pw[1]), o[d0], 0, 0, 0);
            AT_EXP2(pc1, i, pw[2 + (i >> 2)][i & 3]);
            if (i == 1) AT_VLOAD(vc, slot, 2);
            if (i == 5) AT_VLOAD(vd, slot, 3);
            AT_SB(); }
#pragma unroll
        for (int d0 = 0; d0 < 4; ++d0) o[d0] = __builtin_amdgcn_mfma_f32_32x32x16_bf16(vc[d0], __builtin_bit_cast(bf16x8, pw[2]), o[d0], 0, 0, 0);
#pragma unroll
        for (int d0 = 0; d0 < 4; ++d0) o[d0] = __builtin_amdgcn_mfma_f32_32x32x16_bf16(vd[d0], __builtin_bit_cast(bf16x8, pw[3]), o[d0], 0, 0, 0);
        lsum += sacc;
        if (has_next) { pc0 = pn0; pc1 = pn1; }
        slot = slot_n;
    }
    lsum += shfl_xor_l(lsum, 32, lane);
    const float inv = (s == 0 ? 1.f : A.lam) / lsum;
    AT_WAIT_BAR(0);
    LAS float* X = (LAS float*)(lds + AT_X) + rg * 4096;
    if (s == 1) {
#pragma unroll
        for (int d0 = 0; d0 < 4; ++d0)
#pragma unroll
            for (int r = 0; r < 16; ++r) X[(d0 * 16 + r) * 64 + lane] = o[d0][r] * inv;
    }
    AT_WAIT_BAR(0);
    if (s == 0) {
        float ss = 0.f;
#pragma unroll
        for (int d0 = 0; d0 < 4; ++d0)
#pragma unroll
            for (int r = 0; r < 16; ++r) { const float v = o[d0][r] * inv - X[(d0 * 16 + r) * 64 + lane]; o[d0][r] = v; ss += v * v; }
        ss += shfl_xor_l(ss, 32, lane);
        const float rn = rsqrtf(ss * (1.f / 128.f) + EPS) * A.oml;
        LAS bf16_t* stg = (LAS bf16_t*)(lds + AT_ST) + rg * (32 * 136);
#pragma unroll
        for (int d0 = 0; d0 < 4; ++d0)
#pragma unroll
            for (int rq = 0; rq < 4; ++rq) { const int dv = 32 * d0 + 8 * rq + 4 * hi; const f32x4 g4 = *(const f32x4*)(A.subln + dv);
                u32x2 w; w.x = cvt_pk_bf16(o[d0][4 * rq] * rn * g4[0], o[d0][4 * rq + 1] * rn * g4[1]); w.y = cvt_pk_bf16(o[d0][4 * rq + 2] * rn * g4[2], o[d0][4 * rq + 3] * rn * g4[3]);
                *(LAS u32x2*)(stg + r32 * 136 + dv) = w; }
        asm volatile("s_waitcnt lgkmcnt(0)" ::: "memory");
        bf16_t* dst = A.CAT + (size_t)(qrow0 + rg * 32) * 1024 + h * 128;
#pragma unroll
        for (int i = 0; i < 8; ++i) { const int row = i * 4 + (lane >> 4), ch = lane & 15; const u32x4 v = *(const LAS u32x4*)(stg + row * 136 + ch * 8); *(u32x4*)(dst + (size_t)row * 1024 + ch * 8) = v; }
    }
    AT_WAIT_BAR(0);
#undef AT_DMA
#undef AT_KLOAD
#undef AT_K1
#undef AT_VLOAD
#undef AT_EXP2
}
struct Args { const float* in[34]; float* out; unsigned char* ws; int stop_after; int pad; };
typedef const __attribute__((address_space(4))) Args* kargs_t;
struct Frame {
    LAS unsigned char* lds; int tid, lane, wave, vcu, bid, G;
    kargs_t ka; float* out; unsigned char* ws;
    float* misc; unsigned* ctl;
};
#define LDS_WAIT() asm volatile("s_waitcnt lgkmcnt(0)" ::: "memory")
#define VM_WAIT() asm volatile("s_waitcnt vmcnt(0)" ::: "memory")

template <int MAP> __device__ __forceinline__ int src_col(int p);
template <int MODE, int MAP, int NC> __device__ __forceinline__ void gemv9_task(Frame& F, const float* W, int ldw, int l, int voff, int strip, float* out, int ldo, const float* add) {
    LAS float* sc = (LAS float*)F.lds; LAS float* red = sc + 9 * 1024;
    for (int i = F.tid; i < 9 * 1024; i += NTHREADS) { const int cond = i >> 10, k = i & 1023; float v;
        if (MODE == 0) { v = cond == 0 ? F.ka->in[6][k] : F.ka->in[5][(cond - 1) * 1024 + k]; v = v / (1.f + expf(-v)); } else v = F.misc[MI_MOD + (l * 9 + cond) * 6144 + voff + k];
        sc[i] = v; }
    __syncthreads();
    const int j = strip * NC + (F.lane < NC ? F.lane : NC - 1); const float* w = W + (size_t)(F.wave * 128) * ldw + src_col<MAP>(j);
    float acc[9];
#pragma unroll
    for (int b = 0; b < 9; ++b) acc[b] = 0.f;
#pragma unroll 16
    for (int k = 0; k < 128; ++k) { const float wv = w[(size_t)k * ldw];
#pragma unroll
        for (int b = 0; b < 9; ++b) acc[b] += sc[b * 1024 + F.wave * 128 + k] * wv; }
#pragma unroll
    for (int b = 0; b < 9; ++b) red[(F.wave * 9 + b) * 64 + F.lane] = acc[b];
    __syncthreads();
    for (int i = F.tid; i < 9 * 64; i += NTHREADS) { const int b = i >> 6, ln = i & 63; if (ln >= NC) continue; float s_ = 0.f;
#pragma unroll
        for (int w8 = 0; w8 < 8; ++w8) s_ += red[(w8 * 9 + b) * 64 + ln];
        const int jj = strip * NC + ln; out[(size_t)b * ldo + jj] = s_ + (add ? add[jj] : 0.f); }
    __syncthreads();
}
template <int MAP> __device__ __forceinline__ int src_col(int p) {
    if (MAP == 1) { if (p >= 1024) return p; const int pn = p >> 8, r = p & 255, bj = r >> 7, wc = (r >> 5) & 3, fq = (r >> 3) & 3, low = r & 7; return 256 * pn + 64 * wc + 32 * (fq >> 1) + 16 * bj + 8 * (fq & 1) + low; }
    if (MAP == 2) { const int pn = p >> 8, bj = (p >> 7) & 1, r = p & 127; return bj * 2048 + 128 * pn + r; }
    return p;
}
template <int MAP, bool BIAS> __device__ __forceinline__ void transpose_item(Frame& F, const float* W, int K, int N, bf16_t* WT, LAS float* scr, int item, const float* shv, float* bias) {
    const int lane = F.lane; const int nblk = N / 64, kb = item / nblk, nb = item % nblk, k0 = 64 * kb, n0 = 64 * nb;
    const int sc_ = src_col<MAP>(n0 + lane);
    float tv[64];
#pragma unroll
    for (int i = 0; i < 64; ++i) tv[i] = W[(size_t)(k0 + i) * N + sc_];
#pragma unroll
    for (int i = 0; i < 64; ++i) scr[i * 65 + lane] = tv[i];
    LDS_WAIT(); asm volatile("" ::: "memory");
    const int c = lane & 7;
#pragma unroll
    for (int j = 0; j < 8; ++j) { const int n = (lane >> 3) + 8 * j; const LAS float* s_ = scr + (8 * c) * 65 + n;
        u32x4 o; o.x = cvt_pk_bf16(s_[0 * 65], s_[1 * 65]); o.y = cvt_pk_bf16(s_[2 * 65], s_[3 * 65]); o.z = cvt_pk_bf16(s_[4 * 65], s_[5 * 65]); o.w = cvt_pk_bf16(s_[6 * 65], s_[7 * 65]);
        *(u32x4*)(WT + (size_t)(n0 + n) * K + k0 + 8 * c) = o; }
    if (BIAS) {
        float sh[9], acc[9];
#pragma unroll
        for (int b = 0; b < 9; ++b) { sh[b] = shv[b * 6144 + k0 + lane]; acc[b] = 0.f; }
#pragma unroll
        for (int kk = 0; kk < 64; ++kk) { const float w = tv[kk];
#pragma unroll
            for (int b = 0; b < 9; ++b) acc[b] += __uint_as_float(__builtin_amdgcn_readlane(__float_as_uint(sh[b]), kk)) * w; }
#pragma unroll
        for (int b = 0; b < 9; ++b) atomicAdd(bias + (size_t)b * N + n0 + lane, acc[b]);
    }
    LDS_WAIT(); asm volatile("" ::: "memory");
}
__device__ __forceinline__ void cache_row(Frame& F, int l, int item) {
    const int which = item >> 12, r = item & 4095, b = r >> 9, j = r & 511;
    const float* src = (which ? F.ka->in[3] : F.ka->in[2]) + ((size_t)(b * DEPTH + l) * PAST + j) * 512 + F.lane * 8;
    bf16_t* dst = (bf16_t*)(F.ws + (which ? WS_VB : WS_KB)) + (size_t)(MC + b * (PAST + DSEQ) + j) * 512 + F.lane * 8;
    const f32x4 a = *(const f32x4*)src, c = *(const f32x4*)(src + 4);
    *(u32x4*)dst = pack8(a, c);
}
__device__ __forceinline__ void cache_item(Frame& F, int l, int item4) {
#pragma unroll
    for (int i = 0; i < 4; ++i) cache_row(F, l, item4 * 4 + i);
}
__device__ __forceinline__ f32x2 cmul(f32x2 a, f32x2 b) { return (f32x2){a.x * b.x - a.y * b.y, a.x * b.y + a.y * b.x}; }
__device__ __forceinline__ void ssm_prep(Frame& F, int l, int task) {
    const int g = task >> 1, half = task & 1;
    LAS f32x2* POW = (LAS f32x2*)F.lds;
    LAS f32x2* BB = POW + 2 * 17 * 64;
    LAS f32x2* CC = BB + 2 * 64 * 16;
    LAS f32x2* CT = CC + 2 * 16 * 64;
    LAS float* KT = (LAS float*)(CT + 2 * 64 * 16);
    constexpr int KTS = 260;
    bf16_t* WE = (bf16_t*)(F.ws + WS_SSM + SSM_WE) + (size_t)g * 256 * 256;
    bf16_t* WY = (bf16_t*)(F.ws + WS_SSM + SSM_WY) + (size_t)g * 256 * 512;
    f32x2* LAM16 = (f32x2*)(F.ws + WS_SSM + SSM_LAM16); f32x2* BBAR = (f32x2*)(F.ws + WS_SSM + SSM_BBAR);
    const int tid = F.tid, lane = F.lane;
    if (tid < 128) { const int dir = tid >> 6, p = tid & 63; const size_t pi = ((size_t)(l * 2 + dir) * NG + g) * 64 + p;
        const float lr = F.ka->in[18][pi], li = F.ka->in[19][pi], delta = expf(F.ka->in[20][(l * 2 + dir) * NG + g]);
        const float er = expf(lr * delta), lbr = er * cosf(li * delta), lbi = er * sinf(li * delta);
        { float one_ = 1.f, zero_ = 0.f; asm volatile("" : "+v"(one_), "+v"(zero_));
          f32x2 pw = (f32x2){one_, zero_}; const f32x2 lb = (f32x2){lbr, lbi};
          for (int tau = 0; tau <= 16; ++tau) { POW[(dir * 17 + tau) * 64 + p] = pw; if (tau == 16 && half == 0) LAM16[(dir * NG + g) * 64 + p] = pw; pw = cmul(pw, lb); } }
        const float nr = lbr - 1.f, ni = lbi, den = lr * lr + li * li; const f32x2 fac = (f32x2){(nr * lr + ni * li) / den, (ni * lr - nr * li) / den};
        f32x4 br[4], bi4[4];
#pragma unroll
        for (int q = 0; q < 4; ++q) { br[q] = *(const f32x4*)(F.ka->in[21] + pi * 16 + 4 * q); bi4[q] = *(const f32x4*)(F.ka->in[22] + pi * 16 + 4 * q); }
#pragma unroll
        for (int ch = 0; ch < 16; ++ch) { const f32x2 bb = cmul(fac, (f32x2){br[ch >> 2][ch & 3], bi4[ch >> 2][ch & 3]}); BB[(dir * 64 + p) * 16 + ch] = bb; if (half == 0) BBAR[((size_t)(dir * NG + g) * 64 + p) * 16 + ch] = bb; }
    }
    { f32x2 cv[4];
#pragma unroll
      for (int q = 0; q < 4; ++q) { const int i = tid + q * NTHREADS, dir = i >> 10, c = (i >> 6) & 15, p = i & 63; const size_t ci = (((size_t)(l * 2 + dir) * NG + g) * 16 + c) * 64 + p; cv[q] = (f32x2){F.ka->in[23][ci], F.ka->in[24][ci]}; }
#pragma unroll
      for (int q = 0; q < 4; ++q) { const int i = tid + q * NTHREADS, dir = i >> 10, c = (i >> 6) & 15, p = i & 63; CC[i] = cv[q]; CT[(dir * 64 + p) * 16 + c] = cv[q]; } }
    __syncthreads();
    { const int i16 = lane & 15, k4 = lane >> 4, ri = k4 & 1, ph = k4 >> 1;
      for (int blk = 0; blk < 4; ++blk) { const int q = F.wave * 4 + blk, dir = q >> 4, tau = q & 15; f32x4 acc = (f32x4){0.f, 0.f, 0.f, 0.f};
#pragma unroll 8
          for (int ks = 0; ks < 32; ++ks) { const int p = 2 * ks + ph;
              const f32x2 cc = CT[(dir * 64 + p) * 16 + i16], pw = POW[(dir * 17 + tau) * 64 + p], bb = BB[(dir * 64 + p) * 16 + i16];
              const float u = ri ? -pw.y : pw.x, v = ri ? pw.x : pw.y;
              const float av = cc.x * u - cc.y * v, bv = ri ? bb.y : bb.x;
              acc = __builtin_amdgcn_mfma_f32_16x16x4f32(av, bv, acc, 0, 0, 0); }
#pragma unroll
          for (int r = 0; r < 4; ++r) KT[(dir * 16 + tau) * KTS + (k4 * 4 + r) * 16 + i16] = acc[r]; } }
    __syncthreads();
    const float* Dv = F.ka->in[25] + l * 512 + g * 16;
    for (int idx = half * 8192 + tid; idx < (half + 1) * 8192; idx += NTHREADS) { const int n = idx >> 6, kc = idx & 63, k0 = kc * 8, i = n >> 4, c = n & 15; f32x4 v0, v1;
        if (k0 < 256) { const int s_ = k0 >> 4, ch0 = k0 & 15; v0 = (f32x4){0.f, 0.f, 0.f, 0.f}; v1 = v0;
            if (s_ <= i) { const LAS float* kp = KT + (i - s_) * KTS + c * 16 + ch0; v0 += *(const LAS f32x4*)kp; v1 += *(const LAS f32x4*)(kp + 4); }
            if (s_ >= i) { const LAS float* kp = KT + (16 + s_ - i) * KTS + c * 16 + ch0; v0 += *(const LAS f32x4*)kp; v1 += *(const LAS f32x4*)(kp + 4); }
            if (s_ == i) { const int e = c - ch0; const float dv = Dv[c]; if (e >= 0 && e < 4) v0[e] += dv; else if (e >= 4 && e < 8) v1[e - 4] += dv; }
        } else { const int dir = k0 >= 384 ? 1 : 0, p0 = ((k0 - 256) & 127) >> 1, tau = dir ? 16 - i : i + 1;
            const LAS f32x4* cp = (const LAS f32x4*)(CC + (dir * 16 + c) * 64 + p0); const LAS f32x4* pp = (const LAS f32x4*)(POW + (dir * 17 + tau) * 64 + p0);
            const f32x4 c0 = cp[0], c1 = cp[1], w0 = pp[0], w1 = pp[1];
            v0 = (f32x4){c0[0] * w0[0] - c0[1] * w0[1], -(c0[0] * w0[1] + c0[1] * w0[0]), c0[2] * w0[2] - c0[3] * w0[3], -(c0[2] * w0[3] + c0[3] * w0[2])};
            v1 = (f32x4){c1[0] * w1[0] - c1[1] * w1[1], -(c1[0] * w1[1] + c1[1] * w1[0]), c1[2] * w1[2] - c1[3] * w1[3], -(c1[2] * w1[3] + c1[3] * w1[2])}; }
        *(u32x4*)(WY + (size_t)n * 512 + k0) = pack8(v0, v1); }
    for (int idx = half * 4096 + tid; idx < (half + 1) * 4096; idx += NTHREADS) { const int n = idx >> 5, k0 = (idx & 31) * 8, dir = n >> 7, p = (n & 127) >> 1, ri = n & 1, s_ = k0 >> 4, ch0 = k0 & 15;
        const f32x2 pw = POW[(dir * 17 + (dir ? s_ : 15 - s_)) * 64 + p]; const LAS f32x4* bp = (const LAS f32x4*)(BB + (dir * 64 + p) * 16 + ch0);
        const float u = ri ? pw.y : pw.x, v = ri ? pw.x : -pw.y;
        const f32x4 b0 = bp[0], b1 = bp[1], b2 = bp[2], b3 = bp[3];
        const f32x4 v0 = (f32x4){u * b0[0] + v * b0[1], u * b0[2] + v * b0[3], u * b1[0] + v * b1[1], u * b1[2] + v * b1[3]};
        const f32x4 v1 = (f32x4){u * b2[0] + v * b2[1], u * b2[2] + v * b2[3], u * b3[0] + v * b3[1], u * b3[2] + v * b3[3]};
        *(u32x4*)(WE + (size_t)n * 256 + k0) = pack8(v0, v1); }
    __syncthreads();
}
__device__ __forceinline__ void xprep_row(Frame& F, int row) {
    const float* xr = (row < MC) ? F.ka->in[0] + (size_t)row * DM : F.ka->in[1] + (size_t)(row - MC) * DM;
    const int cond = row < MC ? 0 : 1 + ((row - MC) >> 10);
    const float* sc = F.misc + MI_MOD + (0 * 9 + cond) * 6144 + 1024; const float* g1 = F.ka->in[9];
    bf16_t* dst = (bf16_t*)(F.ws + WS_XS) + (size_t)row * DM; float s = 0.f;
#pragma unroll
    for (int j = 0; j < 4; ++j) { const int c = 4 * F.lane + 256 * j; const f32x4 x = *(const f32x4*)(xr + c); const f32x4 t = x * x; s += (t[0] + t[1]) + (t[2] + t[3]);
        const f32x4 y = x * (*(const f32x4*)(g1 + c)) * (*(const f32x4*)(sc + c) + 1.f); u32x2 w; w.x = cvt_pk_bf16(y[0], y[1]); w.y = cvt_pk_bf16(y[2], y[3]); *(u32x2*)(dst + c) = w; }
    s = wave_sum(s, F.lane);
    if (F.lane == 0) ((float*)(F.ctl + CW_SS))[row] = s;
}
__device__ __forceinline__ void xprep_item(Frame& F, int item4) {
#pragma unroll
    for (int i = 0; i < 4; ++i) xprep_row(F, item4 * 4 + i);
}
__device__ __forceinline__ void ssm_scan(Frame& F, int l, int g, int pm) {
    const int tid = F.tid, sl = tid >> 7, dp = tid & 127, dir = dp >> 6, p = dp & 63;
    const f32x2* LAM16 = (const f32x2*)(F.ws + WS_SSM + SSM_LAM16); const f32x2* BBAR = (const f32x2*)(F.ws + WS_SSM + SSM_BBAR);
    const float* E = (const float*)(F.ws + WS_R + R_E); bf16_t* AS3 = (bf16_t*)(F.ws + WS_R + R_AS3);
    const f32x2 lam = LAM16[(dir * NG + g) * 64 + p];
    f32x2 e[64];
    if (pm == 0) {
#pragma unroll
        for (int q = 0; q < 4; ++q) { const float* ep = E + ((size_t)g * NCHUNK + (q * 4 + sl) * 16) * 256 + dir * 128 + 2 * p;
#pragma unroll
            for (int j = 0; j < 16; ++j) e[q * 16 + j] = *(const f32x2*)(ep + (size_t)j * 256); }
    } else { const float* ep = E + ((size_t)g * NCHUNK + 256 + ((pm - 1) * 4 + sl) * 64) * 256 + dir * 128 + 2 * p;
#pragma unroll
        for (int j = 0; j < 64; ++j) e[j] = *(const f32x2*)(ep + (size_t)j * 256); }
    const int nq = pm == 0 ? 4 : 1;
#pragma unroll
    for (int q = 0; q < 4; ++q) { if (q >= nq) break;
        int base; f32x2 h;
        if (pm == 0) { const int seq = q * 4 + sl; base = seq * 16; h = (f32x2){0.f, 0.f}; }
        else { const int sq = (pm - 1) * 4 + sl; base = 256 + sq * 64; h = *(const f32x2*)(F.ka->in[4] + ((((size_t)sq * DEPTH + l) * 2 + dir) * NG + g) * 128 + 2 * p); }
        unsigned* hp = (unsigned*)(AS3 + ((size_t)g * NCHUNK + base) * 512 + 256 + dir * 128 + 2 * p);
        if (pm == 0) {
#pragma unroll
            for (int jj = 0; jj < 16; ++jj) { const int j = dir ? 15 - jj : jj; const f32x2 ev = dir ? e[q * 16 + 15 - jj] : e[q * 16 + jj]; hp[(size_t)j * 256] = cvt_pk_bf16(h.x, h.y); h = cmul(lam, h) + ev; }
        } else {
#pragma unroll
            for (int jj = 0; jj < 64; ++jj) { const int j = dir ? 63 - jj : jj; const f32x2 ev = dir ? e[63 - jj] : e[jj]; hp[(size_t)j * 256] = cvt_pk_bf16(h.x, h.y); h = cmul(lam, h) + ev; }
        }
    }
    if (pm == 0) {
        const int tt = dir ? 15 : 0; u32x4 uq[4][2]; f32x2 bbv[16];
        const f32x2* bb = BBAR + ((size_t)(dir * NG + g) * 64 + p) * 16;
#pragma unroll
        for (int ch = 0; ch < 16; ++ch) bbv[ch] = bb[ch];
#pragma unroll
        for (int q = 0; q < 4; ++q) { const int chunk = (q * 4 + sl) * 16 + tt; const bf16_t* up = AS3 + ((size_t)g * NCHUNK + chunk) * 512 + tt * 16; uq[q][0] = *(const u32x4*)up; uq[q][1] = *(const u32x4*)(up + 8); }
        float* ns = F.out + (size_t)MT * DM + 2 * (size_t)NB * DEPTH * SEQ * 512;
#pragma unroll
        for (int q = 0; q < 4; ++q) { const int seq = q * 4 + sl; const u32x4 u0 = uq[q][0], u1 = uq[q][1];
            const float uu[16] = {bflo(u0.x), bfhi(u0.x), bflo(u0.y), bfhi(u0.y), bflo(u0.z), bfhi(u0.z), bflo(u0.w), bfhi(u0.w), bflo(u1.x), bfhi(u1.x), bflo(u1.y), bfhi(u1.y), bflo(u1.z), bfhi(u1.z), bflo(u1.w), bfhi(u1.w)};
            f32x2 acc = (f32x2){0.f, 0.f};
#pragma unroll
            for (int ch = 0; ch < 16; ++ch) acc += bbv[ch] * uu[ch];
            *(f32x2*)(ns + ((((size_t)seq * DEPTH + l) * 2 + dir) * NG + g) * 128 + 2 * p) = acc; }
    }
}
__device__ __forceinline__ void ld16(const bf16_t* p, float* v) { const u32x4 a = *(const u32x4*)p; v[0] = bflo(a.x); v[1] = bfhi(a.x); v[2] = bflo(a.y); v[3] = bfhi(a.y); v[4] = bflo(a.z); v[5] = bfhi(a.z); v[6] = bflo(a.w); v[7] = bfhi(a.w); }
__device__ __forceinline__ void conv_item(Frame& F, int l, int item) {
    const int rs = item >> 4, pn = item & 15, lr = F.lane >> 4, lc = F.lane & 15;
    const int r0 = rs * 64 + lr * 16; const int av = 128 * pn + 8 * lc;
    const bf16_t* up = (const bf16_t*)(F.ws + WS_R) + (size_t)r0 * 4096 + 256 * pn + 8 * lc; bf16_t* gp = (bf16_t*)(F.ws + WS_G) + (size_t)r0 * 2048 + av;
    const float* cw = F.ka->in[31] + (size_t)l * 3 * 4096; const float* cb = F.ka->in[32] + (size_t)l * 4096;
    float wv[3][8], wg[3][8], bv[8], bg[8];
#pragma unroll
    for (int k = 0; k < 3; ++k)
#pragma unroll
        for (int e = 0; e < 8; ++e) { wv[k][e] = cw[k * 4096 + av + e]; wg[k][e] = cw[k * 4096 + 2048 + av + e]; }
#pragma unroll
    for (int e = 0; e < 8; ++e) { bv[e] = cb[av + e]; bg[e] = cb[2048 + av + e]; }
    const int t0 = r0 < MC ? (r0 & 255) : ((r0 - MC) & 1023), L = r0 < MC ? SEQ : DSEQ;
    float pv[8], pg[8], cv[8], cg[8], nv_[8], ng[8];
    if (t0 > 0) { ld16(up - 4096, pv); ld16(up - 4096 + 128, pg); } else {
#pragma unroll
        for (int e = 0; e < 8; ++e) { pv[e] = 0.f; pg[e] = 0.f; } }
    ld16(up, cv); ld16(up + 128, cg);
#pragma unroll
    for (int i = 0; i < 16; ++i) {
        if (t0 + i + 1 < L) { ld16(up + (size_t)(i + 1) * 4096, nv_); ld16(up + (size_t)(i + 1) * 4096 + 128, ng); } else {
#pragma unroll
            for (int e = 0; e < 8; ++e) { nv_[e] = 0.f; ng[e] = 0.f; } }
        float o[8];
#pragma unroll
        for (int e = 0; e < 8; ++e) { const float zv = bv[e] + wv[0][e] * pv[e] + wv[1][e] * cv[e] + wv[2][e] * nv_[e]; const float zg = bg[e] + wg[0][e] * pg[e] + wg[1][e] * cg[e] + wg[2][e] * ng[e]; o[e] = silu_f(zg) * zv; }
        u32x4 w; w.x = cvt_pk_bf16(o[0], o[1]); w.y = cvt_pk_bf16(o[2], o[3]); w.z = cvt_pk_bf16(o[4], o[5]); w.w = cvt_pk_bf16(o[6], o[7]);
        *(u32x4*)(gp + (size_t)i * 2048) = w;
#pragma unroll
        for (int e = 0; e < 8; ++e) { pv[e] = cv[e]; pg[e] = cg[e]; cv[e] = nv_[e]; cg[e] = ng[e]; }
    }
}

__device__ __forceinline__ bool slab_first(int s) { return s < 64 ? (s & 3) == 0 : ((s - 64) & 15) == 0; }
__device__ __forceinline__ bool slab_last(int s) { return s < 64 ? (s & 3) == 3 : ((s - 64) & 15) == 15; }
__device__ __forceinline__ void ld4bf(const bf16_t* p, float* v) { const u32x2 a = *(const u32x2*)p; v[0] = bflo(a.x); v[1] = bfhi(a.x); v[2] = bflo(a.y); v[3] = bfhi(a.y); }
__device__ __forceinline__ void conv_fix(Frame& F, int l, int pm) {
    const bf16_t* HALO = (const bf16_t*)(F.ws + WS_R); bf16_t* G = (bf16_t*)(F.ws + WS_G);
    const float* cw = F.ka->in[31] + (size_t)l * 3 * 4096; const float* cb = F.ka->in[32] + (size_t)l * 4096;
    const int c = F.tid * 4, pos = 256 * (c >> 7) + (c & 127);
    float wv[3][4], wg[3][4], bv[4], bg[4];
#pragma unroll
    for (int k = 0; k < 3; ++k) { const f32x4 a = *(const f32x4*)(cw + k * 4096 + c), b = *(const f32x4*)(cw + k * 4096 + 2048 + c);
#pragma unroll
        for (int e = 0; e < 4; ++e) { wv[k][e] = a[e]; wg[k][e] = b[e]; } }
    { const f32x4 a = *(const f32x4*)(cb + c), b = *(const f32x4*)(cb + 2048 + c);
#pragma unroll
      for (int e = 0; e < 4; ++e) { bv[e] = a[e]; bg[e] = b[e]; } }
#pragma unroll
    for (int r8 = 0; r8 < 8; ++r8) { const int s = pm * 4 + (r8 >> 1), which = r8 & 1;
        if (which == 0 ? slab_first(s) : slab_last(s)) continue;
        const bf16_t* hp = which == 0 ? HALO + ((size_t)(s - 1) * 4 + 3) * 4096 : HALO + ((size_t)s * 4 + 2) * 4096;
        const bf16_t* hc = which == 0 ? HALO + ((size_t)s * 4 + 0) * 4096 : HALO + ((size_t)s * 4 + 3) * 4096;
        const bf16_t* hn = which == 0 ? HALO + ((size_t)s * 4 + 1) * 4096 : HALO + ((size_t)(s + 1) * 4 + 0) * 4096;
        float pv[4], cv[4], nv_[4], pg[4], cg[4], ng[4];
        ld4bf(hp + pos, pv); ld4bf(hc + pos, cv); ld4bf(hn + pos, nv_); ld4bf(hp + pos + 128, pg); ld4bf(hc + pos + 128, cg); ld4bf(hn + pos + 128, ng);
        float o[4];
#pragma unroll
        for (int e = 0; e < 4; ++e) { const float zv = bv[e] + wv[0][e] * pv[e] + wv[1][e] * cv[e] + wv[2][e] * nv_[e]; const float zg = bg[e] + wg[0][e] * pg[e] + wg[1][e] * cg[e] + wg[2][e] * ng[e]; o[e] = silu_f(zg) * zv; }
        u32x2 w; w.x = cvt_pk_bf16(o[0], o[1]); w.y = cvt_pk_bf16(o[2], o[3]);
        *(u32x2*)(G + (size_t)(s * 64 + (which ? 63 : 0)) * 2048 + c) = w; }
}
constexpr int N_TR_ITEMS_L = 16 * 32 + 8 * 8 + 16 * 16 + 16 * 64 + 32 * 16;
__device__ __forceinline__ void weight_item(Frame& F, LAS float* scr, int l, int it) {
    int r = it; const float* modl = F.misc + MI_MOD + l * 9 * 6144; float* cf = (float*)F.ctl;
    if (r < 512) { transpose_item<1, true>(F, F.ka->in[10] + (size_t)l * DM * 2048, DM, 2048, (bf16_t*)(F.ws + WS_WIN) + (size_t)l * 2048 * DM, scr, r, modl, cf + CW_BIN + l * 9 * 2048); return; } r -= 512;
    if (r < 64) { transpose_item<0, false>(F, F.ka->in[26] + (size_t)l * 512 * 512, 512, 512, (bf16_t*)(F.ws + WS_WGLU) + (size_t)l * 512 * 512, scr, r, nullptr, nullptr); return; } r -= 64;
    if (r < 256) { transpose_item<0, false>(F, F.ka->in[28] + (size_t)l * DM * DM, DM, DM, (bf16_t*)(F.ws + WS_WOUT) + (size_t)l * DM * DM, scr, r, nullptr, nullptr); return; } r -= 256;
    if (r < 1024) { transpose_item<2, true>(F, F.ka->in[30] + (size_t)l * DM * 4096, DM, 4096, (bf16_t*)(F.ws + WS_WUP) + (size_t)l * 4096 * DM, scr, r, modl + 3072, cf + CW_BUP + l * 9 * 4096); return; } r -= 1024;
    transpose_item<0, false>(F, F.ka->in[33] + (size_t)l * 2048 * DM, 2048, DM, (bf16_t*)(F.ws + WS_WDN) + (size_t)l * DM * 2048, scr, r, nullptr, nullptr);
}

__global__ void __launch_bounds__(NTHREADS, 2) mega(Args args) {
    extern __shared__ __attribute__((aligned(16))) unsigned char lds_raw[];
    Frame F;
    F.lds = (LAS unsigned char*)lds_raw;
    F.tid = threadIdx.x; F.lane = F.tid & 63; F.wave = __builtin_amdgcn_readfirstlane(F.tid >> 6);
    F.G = gridDim.x; F.bid = blockIdx.x; { const int bx = blockIdx.x; F.vcu = (F.G % 8 == 0) ? (bx % 8) * (F.G / 8) + bx / 8 : bx; }
    F.ka = (kargs_t)__builtin_amdgcn_kernarg_segment_ptr();
    F.out = args.out; F.ws = args.ws; F.misc = (float*)(args.ws + WS_MISC); F.ctl = (unsigned*)(args.ws + WS_CTL);
    volatile LAS unsigned* MISC = (volatile LAS unsigned*)(F.lds + MISC_OFF);
    for (int u = F.tid; u < (LDS_BYTES - LDSCTL_OFF) / 4; u += NTHREADS) ((LAS unsigned*)(F.lds + LDSCTL_OFF))[u] = 0u;
    __syncthreads();
    XcdBarrier bar = xcd_barrier_post(F.ctl + CW_BAR, MISC + 8);
    int phase_no = 0;
#define LAUNDER() do { asm volatile("" : "+s"(F.ka), "+s"(F.ws), "+s"(F.out), "+s"(F.bid)); { int w_ = __builtin_amdgcn_readfirstlane(F.wave); asm volatile("" : "+s"(w_)); F.wave = w_; } F.vcu = (F.G % 8 == 0) ? (F.bid % 8) * (F.G / 8) + F.bid / 8 : F.bid; \
    { unsigned z_ = 0u; asm volatile("" : "+v"(z_)); F.lane = (int)__builtin_amdgcn_mbcnt_hi(~0u, __builtin_amdgcn_mbcnt_lo(~0u, z_)); } F.tid = F.wave * 64 + F.lane;     \
    F.misc = (float*)(F.ws + WS_MISC); F.ctl = (unsigned*)(F.ws + WS_CTL); gw = F.vcu * NWAVES + F.wave; } while (0)
#ifdef TPROBE
#define TSTAMP() do { if (F.bid == 0 && F.tid == 0) ((unsigned long long*)(F.ctl + 6000))[phase_no] = __builtin_amdgcn_s_memrealtime(); } while (0)
#else
#define TSTAMP() do {} while (0)
#endif
#if defined(TPROBE) && defined(TPROBE_SUB_A)
#define TSUB(i) do { if (F.bid == 0 && F.tid == 0 && l == 0) ((unsigned long long*)(F.ctl + 6200))[i] = __builtin_amdgcn_s_memrealtime(); } while (0)
#else
#define TSUB(i) do {} while (0)
#endif
#define GRID_BAR() do { LAUNDER(); xcd_barrier(bar, F.tid); ++phase_no; TSTAMP(); if (F.ka->stop_after == phase_no) return; LAUNDER(); } while (0)
    int gw = F.vcu * NWAVES + F.wave; const int NGW = F.G * NWAVES;
#define ssq ((float*)(F.ctl + CW_SS))
#define XS ((bf16_t*)(F.ws + WS_XS))
#define KB ((bf16_t*)(F.ws + WS_KB))
#define VB ((bf16_t*)(F.ws + WS_VB))
#define Qb ((bf16_t*)(F.ws + WS_R + R_Q))
#define AS3 ((bf16_t*)(F.ws + WS_R + R_AS3))
#define Eb ((float*)(F.ws + WS_R + R_E))
#define Zb ((bf16_t*)(F.ws + WS_R + R_Z))
#define CAT ((bf16_t*)(F.ws + WS_R + R_CAT))
#define UP ((bf16_t*)(F.ws + WS_R))
#define Gb ((bf16_t*)(F.ws + WS_G))

    TSTAMP();
    { const int l = F.vcu >> 7, strip = F.vcu & 127; gemv9_task<0, 0, 48>(F, F.ka->in[7] + (size_t)l * DM * 6144, 6144, l, 0, strip, F.misc + MI_MOD + l * 9 * 6144, 6144, F.ka->in[8] + l * 6144); }
    GRID_BAR();
    if (F.vcu < 64) ssm_prep(F, 0, F.vcu);
    else {
        if (F.vcu == 64) {
            for (int i = F.tid; i < 1024; i += NTHREADS) { const int pos = i >> 4, f = i & 15; const float inv = 1.0f / powf(10000.0f, (float)f / 16.0f); const float ang = (float)pos * inv;
                ((f32x2*)(F.misc + MI_ROPE))[i] = (f32x2){cosf(ang), sinf(ang)}; }
            if (F.tid < 2) { const int l = F.tid; float a1 = 0.f, a2 = 0.f; for (int d = 0; d < 64; ++d) { a1 += F.ka->in[13][l * 64 + d] * F.ka->in[14][l * 64 + d]; a2 += F.ka->in[15][l * 64 + d] * F.ka->in[16][l * 64 + d]; }
                const float li = 0.8f - 0.6f * expf(-0.3f * (float)l); F.misc[MI_LAM + l] = expf(a1) - expf(a2) + li; F.misc[MI_LAM + 2 + l] = 1.f - li; }
        }
        LAS float* scr = (LAS float*)(F.lds + F.wave * 16640);
        const int gw1 = (F.vcu - 64) * NWAVES + F.wave, NGW1 = (F.G - 64) * NWAVES;
        constexpr int NW_ = N_TR_ITEMS_L, NC_ = 2048, NX_ = MT / 4;
        for (int it = gw1; it < NW_ + NC_ + NX_; it += NGW1) {
            if (it < NW_) weight_item(F, scr, 0, it);
            else if (it < NW_ + NC_) cache_item(F, 0, it - NW_);
            else xprep_item(F, it - NW_ - NC_); }
    }
    GRID_BAR();

    for (int l = 0; l < DEPTH; ++l) {
        const float* modl = F.misc + MI_MOD + l * 9 * 6144;
        { unsigned* ucnt = F.ctl + CW_UC + l * 6 * 64;
          { Gemm g{XS, (const bf16_t*)(F.ws + WS_WIN) + (size_t)l * 2048 * DM, DM, DM, DM, 0, 0}; InOrder S{F.bid, F.G};
            EpiIn E{ssq + (l == 0 ? 0 : 2 * MT), (const float*)F.ctl + CW_BIN + l * 9 * 2048, F.ka->in[11] + l * 64, F.ka->in[12] + l * 64, (const f32x2*)(F.misc + MI_ROPE), Qb, KB, VB,
                    __builtin_amdgcn_make_buffer_rsrc((void*)AS3, 0, (int)((size_t)NG * NCHUNK * 512 * 2), 0x00020000),
                    F.out + (size_t)MT * DM, F.out + (size_t)MT * DM + (size_t)NB * DEPTH * SEQ * 512, l, ucnt};
            gemm_phase<EpiIn, InOrder>(F.lds, F.tid, g, S, E); }
          if (F.bid >= 128 && F.bid < 224) {
              LAUNDER();
              const int idx = F.bid - 128, gq = idx / 3, pmq = idx % 3; unsigned* up = F.ctl + CW_UC + ((l * 3 + pmq) * 2 + (gq >> 4)) * 64;
              if (F.tid == 0) { unsigned sp = 0; while (__hip_atomic_load(up, RLX_AGENT) < 128u) { __builtin_amdgcn_s_sleep(2); if (++sp > (1u << 20)) break; }
                  __builtin_amdgcn_fence(__ATOMIC_ACQUIRE, "agent"); asm volatile("s_waitcnt vmcnt(0)" ::: "memory"); }
              __syncthreads();
              { Gemm g{AS3, (const bf16_t*)(F.ws + WS_SSM + SSM_WE), 512, 256, 256, (size_t)NCHUNK * 512, (size_t)256 * 256}; GroupOrder S{idx, F.G}; EpiS1 E{Eb};
                gemm_phase<EpiS1, GroupOrder>(F.lds, F.tid, g, S, E); }
              VM_WAIT(); __syncthreads(); LAUNDER();
              ssm_scan(F, l, (F.bid - 128) / 3, (F.bid - 128) % 3); } }
        GRID_BAR();
#define ZC_PTR (F.ctl + CW_ZC + l * 256)
#define ATTN_UNIT(SEQ_, H_, QB_) do { LAUNDER(); const AttnArgs A_{Qb, KB, VB, CAT, F.ka->in[17] + l * 128, F.misc[MI_LAM + l], F.misc[MI_LAM + 2 + l]}; attn_unit(F.lds, F.tid, A_, (SEQ_), (H_), (QB_)); } while (0)
#define ATTN_CTX(U_) do { const int u_ = (U_); ATTN_UNIT(u_ >> 3, (u_ >> 1) & 3, u_ & 1); } while (0)
        { TSUB(0);
          if (F.vcu < NG * 3) {
              { Gemm g{AS3, (const bf16_t*)(F.ws + WS_SSM + SSM_WY), 512, 512, 512, (size_t)NCHUNK * 512, (size_t)256 * 512}; GroupOrder S{F.vcu, F.G};
                EpiS3 E{__builtin_amdgcn_make_buffer_rsrc((void*)Zb, 0, (int)((size_t)MT * 512 * 2), 0x00020000)};
                gemm_phase<EpiS3, GroupOrder>(F.lds, F.tid, g, S, E); }
              VM_WAIT(); __syncthreads(); LAUNDER();
              if (F.tid == 0) __hip_atomic_fetch_add(ZC_PTR + (F.vcu % 3) * 64, 1u, RLX_AGENT); }
          TSUB(3);
          { const int u = F.vcu; ATTN_UNIT(NB + (u >> 5), (u >> 3) & 3, u & 7); } TSUB(4);
          if (F.vcu >= 96 && F.vcu < 128) ATTN_CTX(F.vcu - 96);
          else if (F.vcu >= 192) { for (int r = 0; r < 2; ++r) { if (F.vcu >= 224 && r == 1) break; ATTN_CTX(F.vcu < 224 ? 32 + 2 * (F.vcu - 192) + r : 96 + (F.vcu - 224)); } }
          if (F.vcu >= 96 && F.vcu < 192) {
              LAUNDER();
              const int idx = F.vcu - 96, pmz = (idx >> 1) >> 4;
              if (F.tid == 0) { unsigned sp = 0; while (__hip_atomic_load(ZC_PTR + pmz * 64, RLX_AGENT) < (unsigned)NG) { __builtin_amdgcn_s_sleep(2); if (++sp > (1u << 20)) break; }
                  __builtin_amdgcn_fence(__ATOMIC_ACQUIRE, "agent"); asm volatile("s_waitcnt vmcnt(0)" ::: "memory"); }
              __syncthreads();
              Gemm g{Zb, (const bf16_t*)(F.ws + WS_WGLU) + (size_t)l * 512 * 512, 512, 512, 512, 0, 0}; OneTile S{idx};
              EpiGlu E{Zb, F.ka->in[27] + l * 512, CAT};
              gemm_phase<EpiGlu, OneTile>(F.lds, F.tid, g, S, E); } }
        GRID_BAR();
        { Gemm g{CAT, (const bf16_t*)(F.ws + WS_WOUT) + (size_t)l * DM * DM, DM, DM, DM, 0, 0}; GridOrder S; S.init(MT, DM, F.G, F.bid);
          EpiRes E{l == 0 ? F.ka->in[0] : F.out, l == 0 ? F.ka->in[1] : F.out + (size_t)MC * DM, F.out, modl + 2 * DM, F.ka->in[29] + l * DM, modl + 4 * DM, XS, ssq + (l == 0 ? 1 : 3) * MT};
          gemm_phase<EpiRes, GridOrder>(F.lds, F.tid, g, S, E);
          if (l + 1 < DEPTH && F.bid >= 192) { LAUNDER(); LAS float* scr = (LAS float*)(F.lds + F.wave * 16640);
              for (int it = (F.bid - 192) * NWAVES + F.wave; it < N_TR_ITEMS_L; it += 64 * NWAVES) weight_item(F, scr, l + 1, it); } }
        GRID_BAR();
        { Gemm g{XS, (const bf16_t*)(F.ws + WS_WUP) + (size_t)l * 4096 * DM, DM, DM, DM, 0, 0}; GridOrder S; S.init(MT, 4096, F.G, F.bid);
          EpiUpConv E{ssq + (l == 0 ? 1 : 3) * MT, (const float*)F.ctl + CW_BUP + l * 9 * 4096, F.ka->in[31] + (size_t)l * 3 * 4096, F.ka->in[32] + (size_t)l * 4096, Gb, (bf16_t*)(F.ws + WS_R)};
          gemm_phase<EpiUpConv, GridOrder, true>(F.lds, F.tid, g, S, E); }
        GRID_BAR();
        { Gemm g{Gb, (const bf16_t*)(F.ws + WS_WDN) + (size_t)l * DM * 2048, 2048, 2048, 2048, 0, 0}; GridOrder S; S.init(MT, DM, F.G, F.bid);
          const bool nxt = l + 1 < DEPTH;
          EpiRes E{F.out, F.out + (size_t)MC * DM, F.out, modl + 5 * DM, nxt ? F.ka->in[9] + (l + 1) * DM : nullptr, nxt ? modl + 9 * 6144 + DM : nullptr, XS, ssq + 2 * MT};
          { Unit u0; if (S.next(0, u0)) { conv_fix(F, l, u0.pm); VM_WAIT(); __syncthreads(); LAUNDER(); } }
          gemm_phase<EpiRes, GridOrder>(F.lds, F.tid, g, S, E);
          if (nxt && F.bid >= 192) { LAUNDER(); ssm_prep(F, l + 1, F.bid - 192);
              for (int it = (F.bid - 192) * NWAVES + F.wave; it < 2048; it += 64 * NWAVES) cache_item(F, l + 1, it); } }
        if (l + 1 < DEPTH) GRID_BAR();
    }
#ifdef TPROBE
    GRID_BAR();
    if (F.bid == 0 && F.tid == 0) { const unsigned long long* ts = (const unsigned long long*)(F.ctl + 6000); const float tot = (float)(ts[phase_no] - ts[0]);
        float fa = 0.f, fb = 0.f;
#ifdef TPROBE_SUB_A
        { const unsigned long long* t2 = (const unsigned long long*)(F.ctl + 6200); fa = (float)(t2[TPROBE_SUB_B] - t2[TPROBE_SUB_A]) / tot; }
#else
        for (int k = 0; k < phase_no; ++k) { const float d = (float)(ts[k + 1] - ts[k]) / tot; if ((TPROBE_MASK_A >> k) & 1ull) fa += d; if ((TPROBE_MASK_B >> k) & 1ull) fb += d; }
#endif
        F.misc[MI_END] = 0.25f * sqrtf(fa); F.misc[MI_END + 1] = 300.f * fb; F.misc[MI_END + 2] = tot; }
    GRID_BAR();
    { const float delta = F.misc[MI_END];
      for (size_t i = (size_t)F.bid * NTHREADS + F.tid; i < (size_t)MC * DM; i += (size_t)F.G * NTHREADS) F.out[i] *= (1.f + delta);
      }
#endif
#undef GRID_BAR
#undef LAUNDER
#undef ZC_PTR
#undef ATTN_UNIT
#undef ATTN_CTX
#undef ssq
#undef XS
#undef KB
#undef VB
#undef Qb
#undef AS3
#undef Eb
#undef Zb
#undef CAT
#undef UP
#undef Gb
}
}

static int fk_launch(void* const* d_in, void* d_out, void* d_ws, size_t ws_size, hipStream_t stream, int stop_after) {
    static int grid = 0;
    if (grid == 0) {
        int dev = 0, cus = 0;
        if (ws_size < fk::WS_END) { fprintf(stderr, "kernel_launch: workspace too small (%zu < %zu)\n", ws_size, (size_t)fk::WS_END); grid = -1; return -1; }
        if (hipGetDevice(&dev) != hipSuccess || hipDeviceGetAttribute(&cus, hipDeviceAttributeMultiprocessorCount, dev) != hipSuccess) { grid = -1; return -1; }
        if (hipFuncSetAttribute((const void*)fk::mega, hipFuncAttributeMaxDynamicSharedMemorySize, fk::LDS_BYTES) != hipSuccess) { fprintf(stderr, "kernel_launch: hipFuncSetAttribute failed\n"); grid = -1; return -1; }
        int per_cu = 0; (void)hipOccupancyMaxActiveBlocksPerMultiprocessor(&per_cu, (const void*)fk::mega, fk::NTHREADS, fk::LDS_BYTES); (void)hipGetLastError();
        if (per_cu < 1) fprintf(stderr, "kernel_launch: occupancy query says %d blocks/CU\n", per_cu);
        grid = cus;
        if (grid != 256) fprintf(stderr, "kernel_launch: %d CUs (built for 256)\n", grid);
    }
    if (grid < 0) return -1;
    (void)hipMemsetAsync((char*)d_ws + fk::WS_CTL, 0, fk::CTL_BYTES, stream);
    fk::Args a{};
    for (int i = 0; i < 34; ++i) a.in[i] = (const float*)d_in[i];
    a.out = (float*)d_out; a.ws = (unsigned char*)d_ws; a.stop_after = stop_after; a.pad = 0;
    hipLaunchKernelGGL(fk::mega, dim3(grid), dim3(fk::NTHREADS), fk::LDS_BYTES, stream, a);
    return 0;
}
extern "C" void kernel_launch(void* const* d_in, const int* in_sizes, int n_in, void* d_out, int out_size, void* d_ws, size_t ws_size, hipStream_t stream) {
    if (n_in != 34) { fprintf(stderr, "kernel_launch: unexpected n_in %d\n", n_in); return; }
    fk_launch(d_in, d_out, d_ws, ws_size, stream, 0);
}
```

```cpp
#include <hip/hip_runtime.h>
#include <cstdio>
#include <cstdint>
namespace fk {
#define LAS __attribute__((address_space(3)))
#define GAS __attribute__((address_space(1)))
typedef unsigned short bf16_t;
typedef short bf16x8 __attribute__((ext_vector_type(8)));
typedef short s16x4 __attribute__((ext_vector_type(4)));
typedef float f32x4 __attribute__((ext_vector_type(4)));
typedef float f32x2 __attribute__((ext_vector_type(2)));
typedef float f32x16 __attribute__((ext_vector_type(16)));
typedef unsigned u32x4 __attribute__((ext_vector_type(4)));
typedef unsigned u32x2 __attribute__((ext_vector_type(2)));

constexpr int DM = 1024, NB = 16, SEQ = 256, DEPTH = 2, DB = 8, DSEQ = 1024, PAST = 512;
constexpr int MC = NB * SEQ, MS = DB * DSEQ, MT = MC + MS;
constexpr int NH = 4, NG = 32, NCOND = 9, NMOD = 6;
constexpr int NCHUNK = MT / 16;
constexpr int KVROWS = MC + DB * (PAST + DSEQ);
constexpr float EPS = 1e-6f;
constexpr float C2 = 0.125f * 1.4426950408889634f;
constexpr int NWAVES = 8, NTHREADS = 512;

constexpr size_t MiB = 1u << 20;
constexpr size_t WS_CTL = 0, CTL_BYTES = 1 * MiB;
constexpr size_t WS_MISC = 1 * MiB;
constexpr size_t WS_WIN = 3 * MiB;
constexpr size_t WS_WGLU = 11 * MiB;
constexpr size_t WS_WOUT = 12 * MiB;
constexpr size_t WS_WUP = 16 * MiB;
constexpr size_t WS_WDN = 32 * MiB;
constexpr size_t WS_SSM = 40 * MiB;
constexpr size_t WS_XS = 53 * MiB;
constexpr size_t WS_KB = 77 * MiB;
constexpr size_t WS_VB = 93 * MiB;
constexpr size_t WS_R = 109 * MiB;
constexpr size_t WS_XR = 205 * MiB;
constexpr size_t WS_G = WS_R;
constexpr size_t WS_HALO = WS_R + 48 * MiB;
constexpr size_t WS_END = 253 * MiB;
constexpr size_t R_Q = 0, R_AS3 = 12 * MiB, R_E = 36 * MiB, R_Z = 60 * MiB, R_CAT = 72 * MiB;
constexpr size_t SSM_WE = 0, SSM_WY = 4 * MiB, SSM_LAM16 = 12 * MiB, SSM_BBAR = 12 * MiB + 64 * 1024;
constexpr int MI_MOD = 0;
constexpr int MI_ROPE = MI_MOD + 2 * 9 * 6144;
constexpr int MI_LAM = MI_ROPE + 64 * 16 * 2;
constexpr int MI_END = MI_LAM + 8;
static_assert((size_t)MI_END * 4 <= 2 * MiB, "MISC");
constexpr int CW_BAR = 1024;
constexpr int CW_ZC = 7168;
constexpr int CW_UC = 4608;
constexpr int CW_SS = 8192;
constexpr int CW_BIN = 65536;
constexpr int CW_BUP = CW_BIN + 2 * 9 * 2048;
static_assert((size_t)(CW_SS + 4 * MT) <= CW_BIN && (size_t)(CW_BUP + 2 * 9 * 4096) * 4 <= CTL_BYTES, "CTL");

constexpr int RING_BYTES = 131072;
constexpr int LDS_BYTES_ = 147456; constexpr int LDSCTL_OFF = LDS_BYTES_ - 512, MISC_OFF = LDSCTL_OFF + 320;
constexpr int LDS_BYTES = 147456;

#define RLX_AGENT __ATOMIC_RELAXED, __HIP_MEMORY_SCOPE_AGENT
typedef __bf16 bf16x2_t __attribute__((ext_vector_type(2)));
__device__ __forceinline__ unsigned cvt_pk_bf16(float lo, float hi) { const f32x2 v = {lo, hi}; const bf16x2_t b = __builtin_convertvector(v, bf16x2_t); return __builtin_bit_cast(unsigned, b); }
__device__ __forceinline__ float bf2f(unsigned short b) { return __uint_as_float((unsigned)b << 16); }
__device__ __forceinline__ float bflo(unsigned w) { return __uint_as_float(w << 16); }
__device__ __forceinline__ float bfhi(unsigned w) { return __uint_as_float(w & 0xffff0000u); }
__device__ __forceinline__ float fast_exp2(float x) { return __builtin_amdgcn_exp2f(x); }
__device__ __forceinline__ float fast_rcp(float x) { return __builtin_amdgcn_rcpf(x); }
__device__ __forceinline__ float sigmoid_f(float x) { return fast_rcp(1.f + fast_exp2(-1.4426950408889634f * x)); }
__device__ __forceinline__ float silu_f(float x) { return x * sigmoid_f(x); }
__device__ __forceinline__ float gelu_tanh_f(float x) {
    const float u = 0.7978845608028654f * (x + 0.044715f * x * x * x); return x * sigmoid_f(2.f * u); }
__device__ __forceinline__ float shfl_xor_l(float v, int mask, int lane) { return __uint_as_float((unsigned)__builtin_amdgcn_ds_bpermute((lane ^ mask) << 2, (int)__float_as_uint(v))); }
__device__ __forceinline__ float wave_sum(float v, int lane) {
#pragma unroll
    for (int o = 1; o < 64; o <<= 1) v += shfl_xor_l(v, o, lane);
    return v; }

#define XB_TMO      128
#define XB_XCNT(j)  (256  + 64 * (j))
#define XB_XSUB(j)  (1280 + 64 * (j))
#define XB_XGEN(j)  (2304 + 64 * (j))
#define XB_TOP      3328
#define XB_TOPGEN   3392
#define XCD_BAR_WORDS 3456
#define XB_SPIN_CAP (1u << 18)
__device__ __forceinline__ unsigned xb_ld(unsigned* p)              { return __hip_atomic_load(p, __ATOMIC_RELAXED, __HIP_MEMORY_SCOPE_AGENT); }
__device__ __forceinline__ unsigned xb_add(unsigned* p, unsigned v) { return __hip_atomic_fetch_add(p, v, __ATOMIC_RELAXED, __HIP_MEMORY_SCOPE_AGENT); }
__device__ __forceinline__ unsigned xb_xcc_id() { return (unsigned)__builtin_amdgcn_s_getreg((3 << 11) | 20) & 0xFu; }
#define XB_SPIN(cond, bar) do { unsigned _sp = 0; while (cond) { __builtin_amdgcn_s_sleep(1); \
    if ((++_sp & 255u) == 0u) { if (xb_ld(&(bar)[XB_TMO])) break; if (_sp > XB_SPIN_CAP) { atomicAdd(&(bar)[XB_TMO], 1u); break; } } } } while (0)
struct XcdBarrier { unsigned* bar; unsigned x; volatile LAS unsigned* st; };
__device__ __forceinline__ XcdBarrier xcd_barrier_post(unsigned* bar, volatile LAS unsigned* st) {
    XcdBarrier b; b.bar = bar; b.x = xb_xcc_id(); b.st = st;
    if (threadIdx.x == 0) (void)xb_add(&bar[XB_XCNT(b.x)], 1u);
    return b;
}
__device__ __forceinline__ void xcd_barrier_complete(unsigned* bar, unsigned x, unsigned& nloc, unsigned& nx) {
    const unsigned G = gridDim.x * gridDim.y * gridDim.z;
    unsigned sum, cnt, mine, sp = 0u;
    for (;;) {
        sum = 0u; cnt = 0u; mine = 0u;
#pragma unroll
        for (unsigned j = 0; j < 16; ++j) { const unsigned c = xb_ld(&bar[XB_XCNT(j)]); sum += c; cnt += (c > 0u) ? 1u : 0u; mine = (j == x) ? c : mine; }
        if (sum == G) break;
        __builtin_amdgcn_s_sleep(1);
        if ((++sp & 255u) == 0u) { if (xb_ld(&bar[XB_TMO])) break; if (sp > XB_SPIN_CAP) { atomicAdd(&bar[XB_TMO], 1u); break; } }
    }
    nloc = mine > 0u ? mine : 1u; nx = cnt > 0u ? cnt : 1u;
}
__device__ __forceinline__ void xcd_barrier(const XcdBarrier& b, const int tid) {
    asm volatile("s_waitcnt vmcnt(0)" ::: "memory");
    __syncthreads();
    if (tid == 0) {
        unsigned* bar = b.bar;
        __builtin_amdgcn_s_waitcnt(0);
        unsigned nloc = b.st[0], nx = b.st[1];
        if (nloc == 0u) { xcd_barrier_complete(bar, b.x, nloc, nx); b.st[0] = nloc; b.st[1] = nx; }
        const unsigned old = xb_add(&bar[XB_XSUB(b.x)], 1u);
        const unsigned gen = old / nloc;
        if (old + 1u == (gen + 1u) * nloc) {
            __builtin_amdgcn_fence(__ATOMIC_RELEASE, "agent");
            asm volatile("s_waitcnt vmcnt(0)" ::: "memory");
            const unsigned og = xb_add(&bar[XB_TOP], 1u);
            const unsigned tg = og / nx;
            if (og + 1u == (tg + 1u) * nx) xb_add(&bar[XB_TOPGEN], 1u);
            else XB_SPIN(xb_ld(&bar[XB_TOPGEN]) == tg, bar);
            __builtin_amdgcn_fence(__ATOMIC_ACQUIRE, "agent");
            xb_add(&bar[XB_XGEN(b.x)], 1u);
            asm volatile("s_waitcnt vmcnt(0)" ::: "memory");
        } else {
            XB_SPIN(xb_ld(&bar[XB_XGEN(b.x)]) == gen, bar);
            __builtin_amdgcn_fence(__ATOMIC_ACQUIRE, "agent");
            asm volatile("s_waitcnt vmcnt(0)" ::: "memory");
        }
    }
    __syncthreads();
}

constexpr int BM = 256, BK = 64, HALF = 128, HTB = HALF * BK * 2, NXCD = 8, WGM = 8;
__host__ __device__ __forceinline__ int lds_byte(int r, int c) { const int st = (r >> 4) * 2 + (c >> 5), rr = r & 15, cc = c & 31, ob = rr * 64 + cc * 2; return st * 1024 + (ob ^ (((ob >> 9) & 1) << 5)); }
__host__ __device__ __forceinline__ void stage_rc(int b, int& R, int& C) { const int st = b / 1024, sb = b % 1024, swz = sb ^ (((sb >> 9) & 1) << 5); R = (st >> 1) * 16 + swz / 64; C = (st & 1) * 32 + (swz % 64) / 2; }
__host__ __device__ __forceinline__ int perm32(int rho) { const int n = rho >> 4, i = rho & 15; return 8 * (i >> 2) + 4 * n + (i & 3); }

struct Unit { int pm, pn, g; };
struct Gemm { const bf16_t* A; const bf16_t* Bt; int lda, ldb, K; size_t gsA, gsB; };
struct GridOrder {
    int nM, nN, nwg, G, c;
    __device__ void init(int M, int N, int G_, int c_) { nM = M / BM; nN = N / BM; nwg = nM * nN; G = G_; c = c_; }
    __device__ bool next(int i, Unit& u) const {
        const long L = (long)i * G + c; if (L >= nwg) return false;
        int wgid = (int)L; { const int q = nwg / NXCD, r = nwg % NXCD, xcd = wgid % NXCD, off = wgid / NXCD; wgid = (xcd < r ? xcd * (q + 1) : r * (q + 1) + (xcd - r) * q) + off; }
        const int nig = WGM * nN, gid = wgid / nig, fm = gid * WGM, gsz = (nM - fm) < WGM ? (nM - fm) : WGM;
        u.pm = fm + ((wgid % nig) % gsz); u.pn = (wgid % nig) / gsz; u.g = 0; return true;
    }
};
struct InOrder {
    int c, G;
    __device__ bool next(int i, Unit& u) const { const int L = i * G + c; if (L >= 384) return false; u.g = 0;
        if (L < 96) { const int j = (L & 7) * 12 + (L >> 3); u.pm = j >> 1; u.pn = 6 + (j & 1); }
        else { const int Lp = L - 96, j = (Lp & 7) * 36 + (Lp >> 3); u.pm = j / 6; u.pn = j % 6; }
        return true; }
};
struct OneTile {
    int idx;
    __device__ bool next(int i, Unit& u) const { if (i > 0 || idx < 0) return false; u.pm = idx >> 1; u.pn = idx & 1; u.g = 0; return true; }
};
struct GroupOrder {
    int c, G;
    __device__ bool next(int i, Unit& u) const { const int idx = c + i * G; if (c < 0 || idx >= NG * 3) return false; u.g = idx / 3; u.pm = idx % 3; u.pn = 0; return true; }
};

template <class Epi, class Sched, bool AROWPERM = false>
__device__ __forceinline__ void gemm_phase(LAS unsigned char* lds, const int tid, const Gemm g, const Sched& S, const Epi& E) {
    const int wid = __builtin_amdgcn_readfirstlane(tid >> 6), lane = tid & 63, wr = wid >> 2, wc = wid & 3, fr = lane & 15, fq = lane >> 4;
    const int K = g.K, nt = K / BK;
    unsigned voffA[2], voffB[2];
#pragma unroll
    for (int i = 0; i < 2; ++i) { int R, C; stage_rc(tid * 16 + i * 8192, R, C); const int Rb = Epi::PERM ? ((R & ~31) + perm32(R & 31)) : R;
        const int Ra = AROWPERM ? ((R & 64) + 4 * (R & 15) + ((R >> 4) & 3)) : R;
        voffA[i] = (unsigned)(Ra * g.lda + C) * 2u; voffB[i] = (unsigned)(Rb * g.ldb + C) * 2u; }
    const size_t kstep = (size_t)(BK * 2);
    const size_t hstepA = (size_t)HALF * g.lda * 2, hstepB = (size_t)HALF * g.ldb * 2;
    const unsigned ldsw = (unsigned)wid * 1024u;
    const int aoff = lds_byte(wr * 64 + fr, fq * 8), boff = lds_byte(wc * 32 + fr, fq * 8);
#define PG8_SA(b, h) (((b) * 2 + (h)) * HTB)
#define PG8_SB(b, h) ((4 + (b) * 2 + (h)) * HTB)
#define PG8_STAGE(bufoff, gbase, voff) do { _Pragma("unroll") for (int _i = 0; _i < 2; ++_i) \
        __builtin_amdgcn_global_load_lds((const unsigned*)((const char*)(gbase) + (voff)[_i]), (LAS unsigned*)(lds + (bufoff) + ldsw + _i * 8192), 16, 0, 0); } while (0)
#define PG8_LDA(dst, b, h) do { _Pragma("unroll") for (int m = 0; m < 4; ++m) _Pragma("unroll") for (int k = 0; k < 2; ++k) dst[m][k] = *(const LAS bf16x8*)(lds + PG8_SA(b, h) + aoff + m * 2048 + k * 1024); } while (0)
#define PG8_LDB(dst, b, h) do { _Pragma("unroll") for (int n = 0; n < 2; ++n) _Pragma("unroll") for (int k = 0; k < 2; ++k) dst[n][k] = *(const LAS bf16x8*)(lds + PG8_SB(b, h) + boff + n * 2048 + k * 1024); } while (0)
#define PG8_MMA(ai, bj, At, Bt) do { __builtin_amdgcn_s_setprio(1); _Pragma("unroll") for (int m = 0; m < 4; ++m) _Pragma("unroll") for (int n = 0; n < 2; ++n) _Pragma("unroll") for (int k = 0; k < 2; ++k) \
        acc[ai][bj][m][n] = __builtin_amdgcn_mfma_f32_16x16x32_bf16(Bt[n][k], At[m][k], acc[ai][bj][m][n], 0, 0, 0); __builtin_amdgcn_s_setprio(0); } while (0)
#define PG8_WAIT_V(n) asm volatile("s_waitcnt vmcnt(" #n ")" ::: "memory")
#define PG8_WAIT_L(n) asm volatile("s_waitcnt lgkmcnt(" #n ")" ::: "memory")
#define PG8_BAR __builtin_amdgcn_s_barrier()
#define PG8_SCHED __builtin_amdgcn_sched_barrier(0)
#define PG8_APTR(u) ((const char*)g.A + ((size_t)(u).g * g.gsA + (size_t)(u).pm * BM * g.lda) * 2)
#define PG8_BPTR(u) ((const char*)g.Bt + ((size_t)(u).g * g.gsB + (size_t)(u).pn * BM * g.ldb) * 2)
    Unit cur, nxt; int ui = 0;
    if (!S.next(0, cur)) return;
    f32x4 acc[2][2][4][2];
#pragma unroll
    for (int a = 0; a < 2; ++a)
#pragma unroll
        for (int b = 0; b < 2; ++b)
#pragma unroll
            for (int m = 0; m < 4; ++m)
#pragma unroll
                for (int n = 0; n < 2; ++n) acc[a][b][m][n] = (f32x4){0.f, 0.f, 0.f, 0.f};
    bf16x8 At[4][2], B0[2][2], B1[2][2];
    const char* cA = PG8_APTR(cur); const char* cB = PG8_BPTR(cur);
    PG8_STAGE(PG8_SB(0, 0), cB, voffB); PG8_STAGE(PG8_SB(0, 1), cB + hstepB, voffB); PG8_STAGE(PG8_SA(0, 0), cA, voffA); PG8_STAGE(PG8_SA(0, 1), cA + hstepA, voffA);
    if (wr == 1) PG8_BAR;
    PG8_WAIT_V(2); PG8_BAR;
    PG8_STAGE(PG8_SB(1, 0), cB + kstep, voffB); PG8_STAGE(PG8_SA(1, 0), cA + kstep, voffA); PG8_STAGE(PG8_SB(1, 1), cB + hstepB + kstep, voffB);
    PG8_WAIT_V(6); PG8_BAR;
    for (;;) {
        const bool has_next = S.next(ui + 1, nxt);
        const char* nA = has_next ? PG8_APTR(nxt) : cA; const char* nB = has_next ? PG8_BPTR(nxt) : cB;
        for (int t = 0; t < nt; t += 2) {
            const bool last = (t == nt - 2);
            const char* a1 = cA + (size_t)(t + 1) * kstep;
            const char* a2 = last ? nA : cA + (size_t)(t + 2) * kstep; const char* b2 = last ? nB : cB + (size_t)(t + 2) * kstep;
            const char* a3 = a2 + kstep; const char* b3 = b2 + kstep;
            PG8_LDB(B0, 0, 0); PG8_LDB(B1, 0, 1); PG8_SCHED; PG8_LDA(At, 0, 0); PG8_STAGE(PG8_SA(1, 1), a1 + hstepA, voffA);
            PG8_WAIT_V(8); PG8_WAIT_L(0); PG8_BAR; PG8_MMA(0, 0, At, B0); PG8_MMA(0, 1, At, B1); PG8_BAR; PG8_SCHED;
            PG8_LDA(At, 0, 1); PG8_STAGE(PG8_SB(0, 0), b2, voffB); PG8_STAGE(PG8_SB(0, 1), b2 + hstepB, voffB); PG8_STAGE(PG8_SA(0, 0), a2, voffA);
            PG8_WAIT_V(8); PG8_WAIT_L(0); PG8_BAR; PG8_MMA(1, 0, At, B0); PG8_MMA(1, 1, At, B1); PG8_BAR; PG8_SCHED;
            PG8_LDB(B0, 1, 0); PG8_LDB(B1, 1, 1); PG8_SCHED; PG8_LDA(At, 1, 0); PG8_STAGE(PG8_SA(0, 1), a2 + hstepA, voffA);
            PG8_WAIT_V(8); PG8_WAIT_L(0); PG8_BAR; PG8_MMA(0, 0, At, B0); PG8_MMA(0, 1, At, B1); PG8_BAR; PG8_SCHED;
            PG8_LDA(At, 1, 1); PG8_STAGE(PG8_SB(1, 0), b3, voffB); PG8_STAGE(PG8_SB(1, 1), b3 + hstepB, voffB); PG8_STAGE(PG8_SA(1, 0), a3, voffA);
            PG8_WAIT_V(8); PG8_WAIT_L(0); PG8_BAR; PG8_MMA(1, 0, At, B0); PG8_MMA(1, 1, At, B1); PG8_BAR; PG8_SCHED;
        }
        if (wr == 0) PG8_BAR;
        { unsigned z_ = 0u; asm volatile("" : "+v"(z_)); const int l2 = (int)__builtin_amdgcn_mbcnt_hi(~0u, __builtin_amdgcn_mbcnt_lo(~0u, z_));
          E(acc, cur, wr, wc, l2 & 15, l2 >> 4);
          E.done(cur, l2); }
        if (!has_next) break;
#pragma unroll
        for (int a = 0; a < 2; ++a)
#pragma unroll
            for (int b = 0; b < 2; ++b)
#pragma unroll
                for (int m = 0; m < 4; ++m)
#pragma unroll
                    for (int n = 0; n < 2; ++n) acc[a][b][m][n] = (f32x4){0.f, 0.f, 0.f, 0.f};
        cur = nxt; cA = nA; cB = nB; ++ui;
        if (wr == 1) PG8_BAR;
    }
    PG8_WAIT_V(0);
    PG8_BAR;
#undef PG8_SA
#undef PG8_SB
#undef PG8_STAGE
#undef PG8_LDA
#undef PG8_LDB
#undef PG8_MMA
#undef PG8_WAIT_V
#undef PG8_WAIT_L
#undef PG8_BAR
#undef PG8_SCHED
#undef PG8_APTR
#undef PG8_BPTR
}
__device__ __forceinline__ int cond_of_pm(int pm) { return pm < 16 ? 0 : 1 + ((pm - 16) >> 2); }
__device__ __forceinline__ int kvrow_of(int row) { return row < MC ? row : MC + ((row - MC) >> 10) * (PAST + DSEQ) + PAST + ((row - MC) & 1023); }
__device__ __forceinline__ u32x4 pack8(const f32x4& a, const f32x4& b) { u32x4 w; w.x = cvt_pk_bf16(a[0], a[1]); w.y = cvt_pk_bf16(a[2], a[3]); w.z = cvt_pk_bf16(b[0], b[1]); w.w = cvt_pk_bf16(b[2], b[3]); return w; }

struct EpiIn {
    static constexpr bool PERM = true;
    const float* sumsq; const float* bias; const float* qn; const float* kn; const f32x2* rope;
    bf16_t* Q; bf16_t* KB; bf16_t* VB; __amdgpu_buffer_rsrc_t as3r; float* new_k; float* new_v; int l; unsigned* ucnt;
    __device__ __forceinline__ void done(const Unit& u, int lane) const {
        if (u.pn >= 6) { asm volatile("s_waitcnt vmcnt(0)" ::: "memory"); if (lane == 0) __hip_atomic_fetch_add(ucnt + (((u.pm >> 4) * 2) + (u.pn - 6)) * 64, 1u, RLX_AGENT); } }
    __device__ __forceinline__ void operator()(const f32x4 (&acc)[2][2][4][2], const Unit& u, int wr, int wc, int fr, int fq) const {
        const int pm = u.pm, pn = u.pn; const bool ctx = pm < 16; const int cond = cond_of_pm(pm);
        const float* bz = bias + cond * 2048 + pn * 256 + wc * 32 + 8 * fq;
        f32x4 bv[2][2];
#pragma unroll
        for (int bj = 0; bj < 2; ++bj)
#pragma unroll
            for (int n = 0; n < 2; ++n) bv[bj][n] = *(const f32x4*)(bz + bj * 128 + 4 * n);
        const int rbase = pm * BM + wr * 64 + fr;
        if (pn < 4) {
            const bool isq = pn < 2; const float* gv = isq ? qn : kn;
            const int G = (pn & 1) * 4 + wc;
            const int cb = 32 * (fq >> 1) + 8 * (fq & 1);
            f32x4 gg[2][2];
#pragma unroll
            for (int bj = 0; bj < 2; ++bj)
#pragma unroll
                for (int n = 0; n < 2; ++n) gg[bj][n] = *(const f32x4*)(gv + cb + 16 * bj + 4 * n);
            const float qs = isq ? C2 : 1.f;
#pragma unroll
            for (int ai = 0; ai < 2; ++ai)
#pragma unroll
                for (int m = 0; m < 4; ++m) {
                    const int row = rbase + ai * HALF + m * 16;
                    const float rstd = rsqrtf(sumsq[row] * (1.f / DM) + EPS);
                    f32x4 v[2][2]; float ss = 0.f;
#pragma unroll
                    for (int bj = 0; bj < 2; ++bj)
#pragma unroll
                        for (int n = 0; n < 2; ++n) { v[bj][n] = acc[ai][bj][m][n] * rstd + bv[bj][n]; const f32x4 t = v[bj][n] * v[bj][n]; ss += (t[0] + t[1]) + (t[2] + t[3]); }
                    { const int ln_ = fq * 16 + fr; ss += shfl_xor_l(ss, 16, ln_); ss += shfl_xor_l(ss, 32, ln_); }
                    const float rn = rsqrtf(ss * (1.f / 64.f) + EPS);
#pragma unroll
                    for (int bj = 0; bj < 2; ++bj)
#pragma unroll
                        for (int n = 0; n < 2; ++n) v[bj][n] = v[bj][n] * rn * gg[bj][n];
                    if (ctx) {
                        if (!isq) { float* nk = new_k + ((size_t)((row >> 8) * DEPTH + l) * SEQ + (row & 255)) * 512 + G * 64 + cb;
#pragma unroll
                            for (int bj = 0; bj < 2; ++bj) { *(f32x4*)(nk + 16 * bj) = v[bj][0]; *(f32x4*)(nk + 16 * bj + 4) = v[bj][1]; } }
                    } else {
                        const int t = (row - MC) & 1023; const int pos = (fq >> 1) ? (t & 63) : (t >> 6);
                        const f32x2* rp = rope + pos * 16 + 8 * (fq & 1);
#pragma unroll
                        for (int n = 0; n < 2; ++n)
#pragma unroll
                            for (int j = 0; j < 4; ++j) { const f32x2 cs = rp[4 * n + j]; const float x1 = v[0][n][j], x2 = v[1][n][j]; v[0][n][j] = x1 * cs.x - x2 * cs.y; v[1][n][j] = x1 * cs.y + x2 * cs.x; }
                    }
                    bf16_t* dst = isq ? (Q + (size_t)row * 512) : (KB + (size_t)kvrow_of(row) * 512);
                    dst += G * 64 + cb;
#pragma unroll
                    for (int bj = 0; bj < 2; ++bj) *(u32x4*)(dst + 16 * bj) = pack8(v[bj][0] * qs, v[bj][1] * qs);
                }
        } else if (pn < 6) {
            const int col0 = (pn - 4) * 256 + wc * 32 + 8 * fq;
#pragma unroll
            for (int ai = 0; ai < 2; ++ai)
#pragma unroll
                for (int m = 0; m < 4; ++m) {
                    const int row = rbase + ai * HALF + m * 16;
                    const float rstd = rsqrtf(sumsq[row] * (1.f / DM) + EPS);
                    bf16_t* dst = VB + (size_t)kvrow_of(row) * 512 + col0;
#pragma unroll
                    for (int bj = 0; bj < 2; ++bj) { const f32x4 a = acc[ai][bj][m][0] * rstd + bv[bj][0], b = acc[ai][bj][m][1] * rstd + bv[bj][1];
                        *(u32x4*)(dst + 128 * bj) = pack8(a, b);
                        if (ctx) { float* nv = new_v + ((size_t)((row >> 8) * DEPTH + l) * SEQ + (row & 255)) * 512 + col0 + 128 * bj; *(f32x4*)nv = a; *(f32x4*)(nv + 4) = b; } }
                }
        } else {
            const int cu0 = (pn - 6) * 256 + wc * 32 + 8 * fq;
#pragma unroll
            for (int ai = 0; ai < 2; ++ai)
#pragma unroll
                for (int m = 0; m < 4; ++m) {
                    const int row = rbase + ai * HALF + m * 16;
                    const float rstd = rsqrtf(sumsq[row] * (1.f / DM) + EPS);
#pragma unroll
                    for (int bj = 0; bj < 2; ++bj) { const int cu = cu0 + 128 * bj; const f32x4 a = acc[ai][bj][m][0] * rstd + bv[bj][0], b = acc[ai][bj][m][1] * rstd + bv[bj][1];
                        __builtin_amdgcn_raw_buffer_store_b128(pack8(a, b), as3r, (int)(((unsigned)((cu >> 4) * NCHUNK + (row >> 4)) * 512u + (row & 15) * 16 + (cu & 15)) * 2u), 0,   16); }
                }
        }
    }
};
struct EpiS1 {
    static constexpr bool PERM = false;
    float* E;
    __device__ __forceinline__ void done(const Unit&, int) const {}
    __device__ __forceinline__ void operator()(const f32x4 (&acc)[2][2][4][2], const Unit& u, int wr, int wc, int fr, int fq) const {
        const int rbase = u.pm * BM + wr * 64 + fr, col0 = wc * 32 + 4 * fq;
#pragma unroll
        for (int ai = 0; ai < 2; ++ai)
#pragma unroll
            for (int m = 0; m < 4; ++m) { float* dst = E + ((size_t)u.g * NCHUNK + rbase + ai * HALF + m * 16) * 256 + col0;
#pragma unroll
                for (int bj = 0; bj < 2; ++bj)
#pragma unroll
                    for (int n = 0; n < 2; ++n) *(f32x4*)(dst + bj * HALF + n * 16) = acc[ai][bj][m][n]; }
    }
};
struct EpiS3 {
    static constexpr bool PERM = true;
    __amdgpu_buffer_rsrc_t zr;
    __device__ __forceinline__ void done(const Unit&, int) const {}
    __device__ __forceinline__ void operator()(const f32x4 (&acc)[2][2][4][2], const Unit& u, int wr, int wc, int fr, int fq) const {
        const int rbase = u.pm * BM + wr * 64 + fr;
#pragma unroll
        for (int ai = 0; ai < 2; ++ai)
#pragma unroll
            for (int m = 0; m < 4; ++m) { const int chunk = rbase + ai * HALF + m * 16;
#pragma unroll
                for (int bj = 0; bj < 2; ++bj) { const int tt = 8 * bj + 2 * wc + (fq >> 1), c0 = 8 * (fq & 1);
                    f32x4 a = acc[ai][bj][m][0], b = acc[ai][bj][m][1];
#pragma unroll
                    for (int j = 0; j < 4; ++j) { a[j] = gelu_tanh_f(a[j]); b[j] = gelu_tanh_f(b[j]); }
                    __builtin_amdgcn_raw_buffer_store_b128(pack8(a, b), zr, (int)((((unsigned)chunk * 16u + tt) * 512u + u.g * 16 + c0) * 2u), 0,   16); } }
    }
};
struct EpiGlu {
    static constexpr bool PERM = true;
    const bf16_t* Z; const float* bg; bf16_t* CAT;
    __device__ __forceinline__ void done(const Unit&, int) const {}
    __device__ __forceinline__ void operator()(const f32x4 (&acc)[2][2][4][2], const Unit& u, int wr, int wc, int fr, int fq) const {
        const int rbase = u.pm * BM + wr * 64 + fr, col0 = u.pn * BM + wc * 32 + 8 * fq;
        f32x4 bv[2][2];
#pragma unroll
        for (int bj = 0; bj < 2; ++bj)
#pragma unroll
            for (int n = 0; n < 2; ++n) bv[bj][n] = *(const f32x4*)(bg + col0 + bj * HALF + 4 * n);
#pragma unroll
        for (int ai = 0; ai < 2; ++ai)
#pragma unroll
            for (int m = 0; m < 4; ++m) { const int row = rbase + ai * HALF + m * 16;
#pragma unroll
                for (int bj = 0; bj < 2; ++bj) { const u32x4 zw = *(const u32x4*)(Z + (size_t)row * 512 + col0 + bj * HALF);
                    f32x4 a = acc[ai][bj][m][0] + bv[bj][0], b = acc[ai][bj][m][1] + bv[bj][1];
                    a[0] = bflo(zw.x) * sigmoid_f(a[0]); a[1] = bfhi(zw.x) * sigmoid_f(a[1]); a[2] = bflo(zw.y) * sigmoid_f(a[2]); a[3] = bfhi(zw.y) * sigmoid_f(a[3]);
                    b[0] = bflo(zw.z) * sigmoid_f(b[0]); b[1] = bfhi(zw.z) * sigmoid_f(b[1]); b[2] = bflo(zw.w) * sigmoid_f(b[2]); b[3] = bfhi(zw.w) * sigmoid_f(b[3]);
                    *(u32x4*)(CAT + (size_t)row * 1024 + 512 + col0 + bj * HALF) = pack8(a, b); } }
    }
};
template <bool IN_F32, bool OUT_F32> struct EpiRes {
    static constexpr bool PERM = true;
    const float* xin0; const float* xin1;
    const bf16_t* xrin;
    float* xout; bf16_t* xrout;
    const float* gate;
    const float* gn; const float* sc;
    bf16_t* XS; float* ssq;
    __device__ __forceinline__ void done(const Unit&, int) const {}
    __device__ __forceinline__ void operator()(const f32x4 (&acc)[2][2][4][2], const Unit& u, int wr, int wc, int fr, int fq) const {
        const int pm = u.pm, cond = cond_of_pm(pm); const int col0 = u.pn * BM + wc * 32 + 8 * fq; const int rbase = pm * BM + wr * 64 + fr;
        const bool donorm = (gn != nullptr);
        f32x4 gt[2][2], gs[2][2];
#pragma unroll
        for (int bj = 0; bj < 2; ++bj)
#pragma unroll
            for (int n = 0; n < 2; ++n) { const int c = col0 + bj * HALF + n * 4; gt[bj][n] = *(const f32x4*)(gate + cond * 6144 + c);
                if (donorm) { const f32x4 g4 = *(const f32x4*)(gn + c), s4 = *(const f32x4*)(sc + cond * 6144 + c); gs[bj][n] = g4 * (s4 + 1.f); } else gs[bj][n] = (f32x4){0.f, 0.f, 0.f, 0.f}; }
        constexpr int RD = IN_F32 ? 2 : 3;
        f32x4 xr[RD][2][2]; u32x4 xb[RD][2];
#define ER_LOAD(G_, SLOT_) do { const int row_ = rbase + ((G_) >> 2) * HALF + ((G_) & 3) * 16; \
            if (IN_F32) { const float* xi_ = (row_ < MC) ? (xin0 + (size_t)row_ * DM) : (xin1 + (size_t)(row_ - MC) * DM); \
                _Pragma("unroll") for (int bj = 0; bj < 2; ++bj) { xr[SLOT_][bj][0] = *(const f32x4*)(xi_ + col0 + bj * HALF); xr[SLOT_][bj][1] = *(const f32x4*)(xi_ + col0 + bj * HALF + 4); } } \
            else { _Pragma("unroll") for (int bj = 0; bj < 2; ++bj) xb[SLOT_][bj] = *(const u32x4*)(xrin + (size_t)row_ * DM + col0 + bj * HALF); } } while (0)
        ER_LOAD(0, 0); ER_LOAD(1, 1); if (RD == 3) ER_LOAD(2, RD - 1);
#pragma unroll
        for (int g = 0; g < 8; ++g) { const int ai = g >> 2, m = g & 3, sl = g % RD; const int row = rbase + ai * HALF + m * 16;
            float ss = 0.f; f32x4 x0[2], x1[2];
#pragma unroll
            for (int bj = 0; bj < 2; ++bj) { f32x4 a, b;
                if (IN_F32) { a = xr[sl][bj][0]; b = xr[sl][bj][1]; } else { const u32x4 w = xb[sl][bj]; a = (f32x4){bflo(w.x), bfhi(w.x), bflo(w.y), bfhi(w.y)}; b = (f32x4){bflo(w.z), bfhi(w.z), bflo(w.w), bfhi(w.w)}; }
                x0[bj] = a + gt[bj][0] * acc[ai][bj][m][0]; x1[bj] = b + gt[bj][1] * acc[ai][bj][m][1]; }
            if (g + RD < 8) ER_LOAD(g + RD, sl);
#pragma unroll
            for (int bj = 0; bj < 2; ++bj) { const int c = col0 + bj * HALF;
                if (OUT_F32) { *(f32x4*)(xout + (size_t)row * DM + c) = x0[bj]; *(f32x4*)(xout + (size_t)row * DM + c + 4) = x1[bj]; }
                else *(u32x4*)(xrout + (size_t)row * DM + c) = pack8(x0[bj], x1[bj]);
                if (donorm) { const f32x4 t0 = x0[bj] * x0[bj], t1 = x1[bj] * x1[bj]; ss += ((t0[0] + t0[1]) + (t0[2] + t0[3])) + ((t1[0] + t1[1]) + (t1[2] + t1[3]));
                    *(u32x4*)(XS + (size_t)row * DM + c) = pack8(x0[bj] * gs[bj][0], x1[bj] * gs[bj][1]); } }
            if (donorm) { { const int ln_ = fq * 16 + fr; ss += shfl_xor_l(ss, 16, ln_); ss += shfl_xor_l(ss, 32, ln_); } if (fq == 0) atomicAdd(ssq + row, ss); }
        }
#undef ER_LOAD
    }
};
struct EpiUp {
    static constexpr bool PERM = true;
    const float* sumsq; const float* bias; bf16_t* UP;
    __device__ __forceinline__ void done(const Unit&, int) const {}
    __device__ __forceinline__ void operator()(const f32x4 (&acc)[2][2][4][2], const Unit& u, int wr, int wc, int fr, int fq) const {
        const int pm = u.pm, cond = cond_of_pm(pm); const int col0 = u.pn * BM + wc * 32 + 8 * fq; const int rbase = pm * BM + wr * 64 + fr;
        f32x4 bv[2][2];
#pragma unroll
        for (int bj = 0; bj < 2; ++bj)
#pragma unroll
            for (int n = 0; n < 2; ++n) bv[bj][n] = *(const f32x4*)(bias + cond * 4096 + col0 + bj * HALF + 4 * n);
#pragma unroll
        for (int ai = 0; ai < 2; ++ai)
#pragma unroll
            for (int m = 0; m < 4; ++m) { const int row = rbase + ai * HALF + m * 16; const float rstd = rsqrtf(sumsq[row] * (1.f / DM) + EPS);
#pragma unroll
                for (int bj = 0; bj < 2; ++bj) *(u32x4*)(UP + (size_t)row * 4096 + col0 + bj * HALF) = pack8(acc[ai][bj][m][0] * rstd + bv[bj][0], acc[ai][bj][m][1] * rstd + bv[bj][1]); }
    }
};

__device__ __forceinline__ float dpp_shr1(float v) { return __uint_as_float((unsigned)__builtin_amdgcn_update_dpp(0, (int)__float_as_uint(v), 0x111, 0xf, 0xf, false)); }
__device__ __forceinline__ float dpp_shl1(float v) { return __uint_as_float((unsigned)__builtin_amdgcn_update_dpp(0, (int)__float_as_uint(v), 0x101, 0xf, 0xf, false)); }
struct EpiUpConv {
    static constexpr bool PERM = true;
    const float* sumsq; const float* bias; const float* cw; const float* cb; bf16_t* G; bf16_t* HALO;
    __device__ __forceinline__ void done(const Unit&, int) const {}
    __device__ __forceinline__ void operator()(const f32x4 (&acc)[2][2][4][2], const Unit& u, int wr, int wc, int fr, int fq) const {
        const int pm = u.pm, pn = u.pn, cond = cond_of_pm(pm);
        const int posv = pn * 256 + wc * 32 + 8 * fq, av = pn * 128 + wc * 32 + 8 * fq;
#pragma unroll
        for (int ai = 0; ai < 2; ++ai) {
            const int tok0 = pm * BM + ai * HALF + wr * 64 + 4 * fr; const int sl = pm * 4 + ai * 2 + wr;
            float rs[4];
#pragma unroll
            for (int m = 0; m < 4; ++m) rs[m] = rsqrtf(sumsq[tok0 + m] * (1.f / DM) + EPS);
#pragma unroll
            for (int n = 0; n < 2; ++n) {
                const f32x4 bvv = *(const f32x4*)(bias + cond * 4096 + posv + 4 * n), bvg = *(const f32x4*)(bias + cond * 4096 + posv + 128 + 4 * n);
                f32x4 pv[4], pg[4];
#pragma unroll
                for (int m = 0; m < 4; ++m) { pv[m] = acc[ai][0][m][n] * rs[m] + bvv; pg[m] = acc[ai][1][m][n] * rs[m] + bvg; }
                f32x4 pvp, pvn, pgp, pgn;
#pragma unroll
                for (int j = 0; j < 4; ++j) { pvp[j] = dpp_shr1(pv[3][j]); pvn[j] = dpp_shl1(pv[0][j]); pgp[j] = dpp_shr1(pg[3][j]); pgn[j] = dpp_shl1(pg[0][j]); }
                const int c = av + 4 * n;
                const f32x4 w0v = *(const f32x4*)(cw + c), w1v = *(const f32x4*)(cw + 4096 + c), w2v = *(const f32x4*)(cw + 8192 + c), cbv = *(const f32x4*)(cb + c);
                const f32x4 w0g = *(const f32x4*)(cw + 2048 + c), w1g = *(const f32x4*)(cw + 4096 + 2048 + c), w2g = *(const f32x4*)(cw + 8192 + 2048 + c), cbg = *(const f32x4*)(cb + 2048 + c);
#pragma unroll
                for (int m = 0; m < 4; ++m) {
                    const f32x4 zv = cbv + w0v * (m == 0 ? pvp : pv[m == 0 ? 0 : m - 1]) + w1v * pv[m] + w2v * (m == 3 ? pvn : pv[m == 3 ? 3 : m + 1]);
                    const f32x4 zg = cbg + w0g * (m == 0 ? pgp : pg[m == 0 ? 0 : m - 1]) + w1g * pg[m] + w2g * (m == 3 ? pgn : pg[m == 3 ? 3 : m + 1]);
                    u32x2 w; w.x = cvt_pk_bf16(silu_f(zg[0]) * zv[0], silu_f(zg[1]) * zv[1]); w.y = cvt_pk_bf16(silu_f(zg[2]) * zv[2], silu_f(zg[3]) * zv[3]);
                    *(u32x2*)(G + (size_t)(tok0 + m) * 2048 + c) = w; }
                if (fr == 0 || fr == 15) { const int m0 = fr == 0 ? 0 : 2;
#pragma unroll
                    for (int mm = 0; mm < 2; ++mm) { const f32x4 a = fr == 0 ? pv[mm] : pv[2 + mm], b = fr == 0 ? pg[mm] : pg[2 + mm];
                        bf16_t* hp = HALO + ((size_t)sl * 4 + m0 + mm) * 4096 + posv + 4 * n;
                        u32x2 wa; wa.x = cvt_pk_bf16(a[0], a[1]); wa.y = cvt_pk_bf16(a[2], a[3]); *(u32x2*)hp = wa;
                        u32x2 wb; wb.x = cvt_pk_bf16(b[0], b[1]); wb.y = cvt_pk_bf16(b[2], b[3]); *(u32x2*)(hp + 128) = wb; } }
            }
        }
    }
};
constexpr int AT_SLOT = 32768, AT_NSLOT = 4, AT_VOFF = 16384, AT_X = 0, AT_ST = 65536;
__device__ __forceinline__ void glds16(const void* gsrc, unsigned lds_dst) { unsigned keep;
    asm volatile("s_mov_b32 %0, m0\n\ts_mov_b32 m0, %2\n\ts_nop 0\n\tglobal_load_lds_dwordx4 %1, off\n\ts_mov_b32 m0, %0" : "=&s"(keep) : "v"(gsrc), "s"(lds_dst) : "memory"); }
#define AT_WAIT_BAR(N) asm volatile("s_waitcnt vmcnt(" #N ") lgkmcnt(0)\n\ts_barrier" ::: "memory")
#define AT_SB() __builtin_amdgcn_sched_barrier(0)
__device__ __forceinline__ s16x4 vtr(const LAS char* p) { typedef short v4i16_t __attribute__((ext_vector_type(4))); return __builtin_bit_cast(s16x4, __builtin_amdgcn_ds_read_tr16_b64_v4i16((LAS v4i16_t*)p)); }
__device__ __forceinline__ int crow(int r, int hi) { return (r & 3) + 8 * (r >> 2) + 4 * hi; }

struct AttnArgs { const bf16_t* Q; const bf16_t* KB; const bf16_t* VB; bf16_t* CAT; const float* subln; float lam; float oml; };

__device__ __forceinline__ void attn_unit(LAS unsigned char* lds, const int tid, const AttnArgs& A, int seq, int h, int qblk) {
    const int lane = tid & 63, r32 = lane & 31, hi = lane >> 5; const int wid = __builtin_amdgcn_readfirstlane(tid >> 6);
    const int rg = wid & 3, s = wid >> 2;
    const bool ctx = seq < NB;
    const int qrow0 = ctx ? seq * SEQ + qblk * 128 : MC + (seq - NB) * DSEQ + qblk * 128;
    const int krow0 = ctx ? seq * SEQ : MC + (seq - NB) * (PAST + DSEQ);
    const int NT = ctx ? SEQ / 64 : (PAST + DSEQ) / 64;
    const unsigned lds0 = (unsigned)(uintptr_t)lds;
    const bf16_t* ksrc0 = A.KB + (size_t)(krow0 + lane) * 512 + h * 128 + wid * 8;
    const bf16_t* vsrc0 = A.VB + (size_t)(krow0 + 16 * (wid & 3) + (lane >> 2)) * 512 + h * 128 + (wid >> 2) * 32 + (lane & 3) * 8;
    const unsigned kdst = lds0 + wid * 1024, vdst = lds0 + AT_VOFF + ((wid >> 2) * 4 + (wid & 3)) * 1024;
#define AT_DMA(t, slot) do { const size_t _o = (size_t)(t) * 64 * 512; const unsigned _s = (unsigned)(slot) * AT_SLOT; \
        glds16(ksrc0 + _o, (unsigned)__builtin_amdgcn_readfirstlane(kdst + _s)); glds16(ksrc0 + _o + 64, (unsigned)__builtin_amdgcn_readfirstlane(kdst + _s + 8 * 1024)); \
        glds16(vsrc0 + _o, (unsigned)__builtin_amdgcn_readfirstlane(vdst + _s)); glds16(vsrc0 + _o + 64, (unsigned)__builtin_amdgcn_readfirstlane(vdst + _s + 8 * 1024)); } while (0)
    AT_DMA(0, 0); AT_DMA(1, 1); AT_DMA(2, 2);
    bf16x8 qr[4];
    { const bf16_t* qp = A.Q + (size_t)(qrow0 + rg * 32 + r32) * 512 + h * 128 + s * 64 + hi * 8;
#pragma unroll
      for (int d0 = 0; d0 < 4; ++d0) qr[d0] = *(const bf16x8*)(qp + d0 * 16); }
    f32x16 o[4];
#pragma unroll
    for (int d0 = 0; d0 < 4; ++d0)
#pragma unroll
        for (int r = 0; r < 16; ++r) o[d0][r] = 0.f;
    float lsum = 0.f;
    const LAS char* kfrag0 = (const LAS char*)lds + (s * 8 + hi) * 1024 + r32 * 16;
    const LAS char* vfrag0 = (const LAS char*)lds + AT_VOFF + ((lane >> 4) & 1) * 32 + (lane & 3) * 8 + (4 * hi + ((lane & 15) >> 2)) * 64;
    f32x16 pc0, pc1;
#define AT_KLOAD(kfr, slot) do { const LAS char* _k = kfrag0 + (slot) * AT_SLOT; _Pragma("unroll") for (int d0 = 0; d0 < 4; ++d0) { kfr[2 * d0] = *(const LAS bf16x8*)(_k + d0 * 2048); kfr[2 * d0 + 1] = *(const LAS bf16x8*)(_k + d0 * 2048 + 512); } } while (0)
#define AT_VLOAD(vv, slot, ks) do { const LAS char* _v = vfrag0 + (slot) * AT_SLOT + (ks) * 1024; _Pragma("unroll") for (int d0 = 0; d0 < 4; ++d0) { const s16x4 lo = vtr(_v + d0 * 4096), hh = vtr(_v + d0 * 4096 + 512); \
        vv[d0] = (bf16x8){lo[0], lo[1], lo[2], lo[3], hh[0], hh[1], hh[2], hh[3]}; } } while (0)
#define AT_EXP2(P, i, W) do { P[2 * (i)] = fast_exp2(P[2 * (i)]); P[2 * (i) + 1] = fast_exp2(P[2 * (i) + 1]); sacc += P[2 * (i)] + P[2 * (i) + 1]; W = cvt_pk_bf16(P[2 * (i)], P[2 * (i) + 1]); } while (0)
    AT_WAIT_BAR(8);
    { bf16x8 kfr[8]; AT_KLOAD(kfr, 0);
#pragma unroll
      for (int r = 0; r < 16; ++r) { pc0[r] = 0.f; pc1[r] = 0.f; }
#pragma unroll
      for (int d0 = 0; d0 < 4; ++d0) { pc0 = __builtin_amdgcn_mfma_f32_32x32x16_bf16(kfr[2 * d0], qr[d0], pc0, 0, 0, 0); pc1 = __builtin_amdgcn_mfma_f32_32x32x16_bf16(kfr[2 * d0 + 1], qr[d0], pc1, 0, 0, 0); } }
    int slot = 0;
    for (int t = 0; t < NT; ++t) {
        const bool has_next = t + 1 < NT;
        if (t + 2 < NT) AT_WAIT_BAR(4); else AT_WAIT_BAR(0);
        if (t + 3 < NT) AT_DMA(t + 3, (slot + 3) & 3);
        const int slot_n = (slot + 1) & 3;
        bf16x8 kfr[8], va[4], vb[4]; u32x4 pw[4]; f32x16 pn0, pn1; float sacc = 0.f;
        const LAS char* kn_ = kfrag0 + slot_n * AT_SLOT;
#define AT_K1(d0) do { kfr[2 * (d0)] = *(const LAS bf16x8*)(kn_ + (d0) * 2048); kfr[2 * (d0) + 1] = *(const LAS bf16x8*)(kn_ + (d0) * 2048 + 512); } while (0)
        if (has_next) { AT_K1(0); AT_K1(1); }
        AT_SB();
        if (has_next) {
#pragma unroll
            for (int r = 0; r < 16; ++r) { pn0[r] = 0.f; pn1[r] = 0.f; }
#pragma unroll
            for (int i = 0; i < 8; ++i) { const int d0 = i >> 1;
                if (i & 1) pn1 = __builtin_amdgcn_mfma_f32_32x32x16_bf16(kfr[2 * d0 + 1], qr[d0], pn1, 0, 0, 0); else pn0 = __builtin_amdgcn_mfma_f32_32x32x16_bf16(kfr[2 * d0], qr[d0], pn0, 0, 0, 0);
                AT_EXP2(pc0, i, pw[i >> 2][i & 3]);
                if (i == 0) AT_K1(2);
                if (i == 1) AT_K1(3);
                if (i == 3) AT_VLOAD(va, slot, 0);
                if (i == 5) AT_VLOAD(vb, slot, 1);
                AT_SB(); }
        } else {
            AT_VLOAD(va, slot, 0); AT_VLOAD(vb, slot, 1);
#pragma unroll
            for (int i = 0; i < 8; ++i) AT_EXP2(pc0, i, pw[i >> 2][i & 3]);
            AT_SB();
        }
        bf16x8 vc[4], vd[4];
#pragma unroll
        for (int i = 0; i < 8; ++i) { const int d0 = i & 3;
            if (i < 4) o[d0] = __builtin_amdgcn_mfma_f32_32x32x16_bf16(va[d0], __builtin_bit_cast(bf16x8, pw[0]), o[d0], 0, 0, 0);
            else       o[d0] = __builtin_amdgcn_mfma_f32_32x32x16_bf16(vb[d0], __builtin_bit_cast(bf16x8, pw[1]), o[d0], 0, 0, 0);
            AT_EXP2(pc1, i, pw[2 + (i >> 2)][i & 3]);
            if (i == 1) AT_VLOAD(vc, slot, 2);
            if (i == 5) AT_VLOAD(vd, slot, 3);
            AT_SB(); }
#pragma unroll
        for (int d0 = 0; d0 < 4; ++d0) o[d0] = __builtin_amdgcn_mfma_f32_32x32x16_bf16(vc[d0], __builtin_bit_cast(bf16x8, pw[2]), o[d0], 0, 0, 0);
#pragma unroll
        for (int d0 = 0; d0 < 4; ++d0) o[d0] = __builtin_amdgcn_mfma_f32_32x32x16_bf16(vd[d0], __builtin_bit_cast(bf16x8, pw[3]), o[d0], 0, 0, 0);
        lsum += sacc;
        if (has_next) { pc0 = pn0; pc1 = pn1; }
        slot = slot_n;
    }
    lsum += shfl_xor_l(lsum, 32, lane);
    const float inv = (s == 0 ? 1.f : A.lam) / lsum;
    AT_WAIT_BAR(0);
    LAS float* X = (LAS float*)(lds + AT_X) + rg * 4096;
    if (s == 1) {
#pragma unroll
        for (int d0 = 0; d0 < 4; ++d0)
#pragma unroll
            for (int r = 0; r < 16; ++r) X[(d0 * 16 + r) * 64 + lane] = o[d0][r] * inv;
    }
    AT_WAIT_BAR(0);
    if (s == 0) {
        float ss = 0.f;
#pragma unroll
        for (int d0 = 0; d0 < 4; ++d0)
#pragma unroll
            for (int r = 0; r < 16; ++r) { const float v = o[d0][r] * inv - X[(d0 * 16 + r) * 64 + lane]; o[d0][r] = v; ss += v * v; }
        ss += shfl_xor_l(ss, 32, lane);
        const float rn = rsqrtf(ss * (1.f / 128.f) + EPS) * A.oml;
        LAS bf16_t* stg = (LAS bf16_t*)(lds + AT_ST) + rg * (32 * 136);
#pragma unroll
        for (int d0 = 0; d0 < 4; ++d0)
#pragma unroll
            for (int rq = 0; rq < 4; ++rq) { const int dv = 32 * d0 + 8 * rq + 4 * hi; const f32x4 g4 = *(const f32x4*)(A.subln + dv);
                u32x2 w; w.x = cvt_pk_bf16(o[d0][4 * rq] * rn * g4[0], o[d0][4 * rq + 1] * rn * g4[1]); w.y = cvt_pk_bf16(o[d0][4 * rq + 2] * rn * g4[2], o[d0][4 * rq + 3] * rn * g4[3]);
                *(LAS u32x2*)(stg + r32 * 136 + dv) = w; }
        asm volatile("s_waitcnt lgkmcnt(0)" ::: "memory");
        bf16_t* dst = A.CAT + (size_t)(qrow0 + rg * 32) * 1024 + h * 128;
#pragma unroll
        for (int i = 0; i < 8; ++i) { const int row = i * 4 + (lane >> 4), ch = lane & 15; const u32x4 v = *(const LAS u32x4*)(stg + row * 136 + ch * 8); *(u32x4*)(dst + (size_t)row * 1024 + ch * 8) = v; }
    }
    AT_WAIT_BAR(0);
#undef AT_DMA
#undef AT_KLOAD
#undef AT_K1
#undef AT_VLOAD
#undef AT_EXP2
}
struct Args { const float* in[34]; float* out; unsigned char* ws; int stop_after; int pad; };
typedef const __attribute__((address_space(4))) Args* kargs_t;
struct Frame {
    LAS unsigned char* lds; int tid, lane, wave, vcu, bid, G;
    kargs_t ka; float* out; unsigned char* ws;
    float* misc; unsigned* ctl;
};
#define LDS_WAIT() asm volatile("s_waitcnt lgkmcnt(0)" ::: "memory")
#define VM_WAIT() asm volatile("s_waitcnt vmcnt(0)" ::: "memory")

template <int MAP> __device__ __forceinline__ int src_col(int p);
template <int MODE, int MAP, int NC> __device__ __forceinline__ void gemv9_task(Frame& F, const float* W, int ldw, int l, int voff, int strip, float* out, int ldo, const float* add) {
    LAS float* sc = (LAS float*)F.lds; LAS float* red = sc + 9 * 1024;
    for (int i = F.tid; i < 9 * 1024; i += NTHREADS) { const int cond = i >> 10, k = i & 1023; float v;
        if (MODE == 0) { v = cond == 0 ? F.ka->in[6][k] : F.ka->in[5][(cond - 1) * 1024 + k]; v = v / (1.f + expf(-v)); } else v = F.misc[MI_MOD + (l * 9 + cond) * 6144 + voff + k];
        sc[i] = v; }
    __syncthreads();
    const int j = strip * NC + (F.lane < NC ? F.lane : NC - 1); const float* w = W + (size_t)(F.wave * 128) * ldw + src_col<MAP>(j);
    float acc[9];
#pragma unroll
    for (int b = 0; b < 9; ++b) acc[b] = 0.f;
#pragma unroll 16
    for (int k = 0; k < 128; ++k) { const float wv = w[(size_t)k * ldw];
#pragma unroll
        for (int b = 0; b < 9; ++b) acc[b] += sc[b * 1024 + F.wave * 128 + k] * wv; }
#pragma unroll
    for (int b = 0; b < 9; ++b) red[(F.wave * 9 + b) * 64 + F.lane] = acc[b];
    __syncthreads();
    for (int i = F.tid; i < 9 * 64; i += NTHREADS) { const int b = i >> 6, ln = i & 63; if (ln >= NC) continue; float s_ = 0.f;
#pragma unroll
        for (int w8 = 0; w8 < 8; ++w8) s_ += red[(w8 * 9 + b) * 64 + ln];
        const int jj = strip * NC + ln; out[(size_t)b * ldo + jj] = s_ + (add ? add[jj] : 0.f); }
    __syncthreads();
}
template <int MAP> __device__ __forceinline__ int src_col(int p) {
    if (MAP == 1) { if (p >= 1024) return p; const int pn = p >> 8, r = p & 255, bj = r >> 7, wc = (r >> 5) & 3, fq = (r >> 3) & 3, low = r & 7; return 256 * pn + 64 * wc + 32 * (fq >> 1) + 16 * bj + 8 * (fq & 1) + low; }
    if (MAP == 2) { const int pn = p >> 8, bj = (p >> 7) & 1, r = p & 127; return bj * 2048 + 128 * pn + r; }
    return p;
}
template <int MAP, bool BIAS> __device__ __forceinline__ void transpose_item(Frame& F, const float* W, int K, int N, bf16_t* WT, LAS float* scr, int item, const float* shv, float* bias) {
    const int lane = F.lane; const int nblk = N / 64, kb = item / nblk, nb = item % nblk, k0 = 64 * kb, n0 = 64 * nb;
    const int sc_ = src_col<MAP>(n0 + lane);
    float tv[64];
#pragma unroll
    for (int i = 0; i < 64; ++i) tv[i] = W[(size_t)(k0 + i) * N + sc_];
#pragma unroll
    for (int i = 0; i < 64; ++i) scr[i * 65 + lane] = tv[i];
    LDS_WAIT(); asm volatile("" ::: "memory");
    const int c = lane & 7;
#pragma unroll
    for (int j = 0; j < 8; ++j) { const int n = (lane >> 3) + 8 * j; const LAS float* s_ = scr + (8 * c) * 65 + n;
        u32x4 o; o.x = cvt_pk_bf16(s_[0 * 65], s_[1 * 65]); o.y = cvt_pk_bf16(s_[2 * 65], s_[3 * 65]); o.z = cvt_pk_bf16(s_[4 * 65], s_[5 * 65]); o.w = cvt_pk_bf16(s_[6 * 65], s_[7 * 65]);
        *(u32x4*)(WT + (size_t)(n0 + n) * K + k0 + 8 * c) = o; }
    if (BIAS) {
        float sh[9], acc[9];
#pragma unroll
        for (int b = 0; b < 9; ++b) { sh[b] = shv[b * 6144 + k0 + lane]; acc[b] = 0.f; }
#pragma unroll
        for (int kk = 0; kk < 64; ++kk) { const float w = tv[kk];
#pragma unroll
            for (int b = 0; b < 9; ++b) acc[b] += __uint_as_float(__builtin_amdgcn_readlane(__float_as_uint(sh[b]), kk)) * w; }
#pragma unroll
        for (int b = 0; b < 9; ++b) atomicAdd(bias + (size_t)b * N + n0 + lane, acc[b]);
    }
    LDS_WAIT(); asm volatile("" ::: "memory");
}
__device__ __forceinline__ void cache_item(Frame& F, int l, int item4) {
    f32x4 a[4], c[4];
#pragma unroll
    for (int i = 0; i < 4; ++i) { const int item = item4 * 4 + i, which = item >> 12, r = item & 4095, b = r >> 9, j = r & 511;
        const float* src = (which ? F.ka->in[3] : F.ka->in[2]) + ((size_t)(b * DEPTH + l) * PAST + j) * 512 + F.lane * 8; a[i] = *(const f32x4*)src; c[i] = *(const f32x4*)(src + 4); }
#pragma unroll
    for (int i = 0; i < 4; ++i) { const int item = item4 * 4 + i, which = item >> 12, r = item & 4095, b = r >> 9, j = r & 511;
        bf16_t* dst = (bf16_t*)(F.ws + (which ? WS_VB : WS_KB)) + (size_t)(MC + b * (PAST + DSEQ) + j) * 512 + F.lane * 8; *(u32x4*)dst = pack8(a[i], c[i]); }
}
__device__ __forceinline__ f32x2 cmul(f32x2 a, f32x2 b) { return (f32x2){a.x * b.x - a.y * b.y, a.x * b.y + a.y * b.x}; }
__device__ __forceinline__ void ssm_prep(Frame& F, int l, int task) {
    const int g = task >> 1, half = task & 1;
    LAS f32x2* POW = (LAS f32x2*)F.lds;
    LAS f32x2* BB = POW + 2 * 17 * 64;
    LAS f32x2* CC = BB + 2 * 64 * 16;
    LAS f32x2* CT = CC + 2 * 16 * 64;
    LAS float* KT = (LAS float*)(CT + 2 * 64 * 16);
    constexpr int KTS = 260;
    bf16_t* WE = (bf16_t*)(F.ws + WS_SSM + SSM_WE) + (size_t)g * 256 * 256;
    bf16_t* WY = (bf16_t*)(F.ws + WS_SSM + SSM_WY) + (size_t)g * 256 * 512;
    f32x2* LAM16 = (f32x2*)(F.ws + WS_SSM + SSM_LAM16); f32x2* BBAR = (f32x2*)(F.ws + WS_SSM + SSM_BBAR);
    const int tid = F.tid, lane = F.lane;
    if (tid < 128) { const int dir = tid >> 6, p = tid & 63; const size_t pi = ((size_t)(l * 2 + dir) * NG + g) * 64 + p;
        const float lr = F.ka->in[18][pi], li = F.ka->in[19][pi], delta = expf(F.ka->in[20][(l * 2 + dir) * NG + g]);
        const float er = expf(lr * delta), lbr = er * cosf(li * delta), lbi = er * sinf(li * delta);
        { float one_ = 1.f, zero_ = 0.f; asm volatile("" : "+v"(one_), "+v"(zero_));
          f32x2 pw = (f32x2){one_, zero_}; const f32x2 lb = (f32x2){lbr, lbi};
          for (int tau = 0; tau <= 16; ++tau) { POW[(dir * 17 + tau) * 64 + p] = pw; if (tau == 16 && half == 0) LAM16[(dir * NG + g) * 64 + p] = pw; pw = cmul(pw, lb); } }
        const float nr = lbr - 1.f, ni = lbi, den = lr * lr + li * li; const f32x2 fac = (f32x2){(nr * lr + ni * li) / den, (ni * lr - nr * li) / den};
        f32x4 br[4], bi4[4];
#pragma unroll
        for (int q = 0; q < 4; ++q) { br[q] = *(const f32x4*)(F.ka->in[21] + pi * 16 + 4 * q); bi4[q] = *(const f32x4*)(F.ka->in[22] + pi * 16 + 4 * q); }
#pragma unroll
        for (int ch = 0; ch < 16; ++ch) { const f32x2 bb = cmul(fac, (f32x2){br[ch >> 2][ch & 3], bi4[ch >> 2][ch & 3]}); BB[(dir * 64 + p) * 16 + ch] = bb; if (half == 0) BBAR[((size_t)(dir * NG + g) * 64 + p) * 16 + ch] = bb; }
    }
    { f32x2 cv[4];
#pragma unroll
      for (int q = 0; q < 4; ++q) { const int i = tid + q * NTHREADS, dir = i >> 10, c = (i >> 6) & 15, p = i & 63; const size_t ci = (((size_t)(l * 2 + dir) * NG + g) * 16 + c) * 64 + p; cv[q] = (f32x2){F.ka->in[23][ci], F.ka->in[24][ci]}; }
#pragma unroll
      for (int q = 0; q < 4; ++q) { const int i = tid + q * NTHREADS, dir = i >> 10, c = (i >> 6) & 15, p = i & 63; CC[i] = cv[q]; CT[(dir * 64 + p) * 16 + c] = cv[q]; } }
    __syncthreads();
    { const int i16 = lane & 15, k4 = lane >> 4, ri = k4 & 1, ph = k4 >> 1;
      for (int blk = 0; blk < 4; ++blk) { const int q = F.wave * 4 + blk, dir = q >> 4, tau = q & 15; f32x4 acc = (f32x4){0.f, 0.f, 0.f, 0.f};
#pragma unroll 8
          for (int ks = 0; ks < 32; ++ks) { const int p = 2 * ks + ph;
              const f32x2 cc = CT[(dir * 64 + p) * 16 + i16], pw = POW[(dir * 17 + tau) * 64 + p], bb = BB[(dir * 64 + p) * 16 + i16];
              const float u = ri ? -pw.y : pw.x, v = ri ? pw.x : pw.y;
              const float av = cc.x * u - cc.y * v, bv = ri ? bb.y : bb.x;
              acc = __builtin_amdgcn_mfma_f32_16x16x4f32(av, bv, acc, 0, 0, 0); }
#pragma unroll
          for (int r = 0; r < 4; ++r) KT[(dir * 16 + tau) * KTS + (k4 * 4 + r) * 16 + i16] = acc[r]; } }
    __syncthreads();
    const float* Dv = F.ka->in[25] + l * 512 + g * 16;
    for (int idx = half * 8192 + tid; idx < (half + 1) * 8192; idx += NTHREADS) { const int n = idx >> 6, kc = idx & 63, k0 = kc * 8, i = n >> 4, c = n & 15; f32x4 v0, v1;
        if (k0 < 256) { const int s_ = k0 >> 4, ch0 = k0 & 15; v0 = (f32x4){0.f, 0.f, 0.f, 0.f}; v1 = v0;
            if (s_ <= i) { const LAS float* kp = KT + (i - s_) * KTS + c * 16 + ch0; v0 += *(const LAS f32x4*)kp; v1 += *(const LAS f32x4*)(kp + 4); }
            if (s_ >= i) { const LAS float* kp = KT + (16 + s_ - i) * KTS + c * 16 + ch0; v0 += *(const LAS f32x4*)kp; v1 += *(const LAS f32x4*)(kp + 4); }
            if (s_ == i) { const int e = c - ch0; const float dv = Dv[c]; if (e >= 0 && e < 4) v0[e] += dv; else if (e >= 4 && e < 8) v1[e - 4] += dv; }
        } else { const int dir = k0 >= 384 ? 1 : 0, p0 = ((k0 - 256) & 127) >> 1, tau = dir ? 16 - i : i + 1;
            const LAS f32x4* cp = (const LAS f32x4*)(CC + (dir * 16 + c) * 64 + p0); const LAS f32x4* pp = (const LAS f32x4*)(POW + (dir * 17 + tau) * 64 + p0);
            const f32x4 c0 = cp[0], c1 = cp[1], w0 = pp[0], w1 = pp[1];
            v0 = (f32x4){c0[0] * w0[0] - c0[1] * w0[1], -(c0[0] * w0[1] + c0[1] * w0[0]), c0[2] * w0[2] - c0[3] * w0[3], -(c0[2] * w0[3] + c0[3] * w0[2])};
            v1 = (f32x4){c1[0] * w1[0] - c1[1] * w1[1], -(c1[0] * w1[1] + c1[1] * w1[0]), c1[2] * w1[2] - c1[3] * w1[3], -(c1[2] * w1[3] + c1[3] * w1[2])}; }
        *(u32x4*)(WY + (size_t)n * 512 + k0) = pack8(v0, v1); }
    for (int idx = half * 4096 + tid; idx < (half + 1) * 4096; idx += NTHREADS) { const int n = idx >> 5, k0 = (idx & 31) * 8, dir = n >> 7, p = (n & 127) >> 1, ri = n & 1, s_ = k0 >> 4, ch0 = k0 & 15;
        const f32x2 pw = POW[(dir * 17 + (dir ? s_ : 15 - s_)) * 64 + p]; const LAS f32x4* bp = (const LAS f32x4*)(BB + (dir * 64 + p) * 16 + ch0);
        const float u = ri ? pw.y : pw.x, v = ri ? pw.x : -pw.y;
        const f32x4 b0 = bp[0], b1 = bp[1], b2 = bp[2], b3 = bp[3];
        const f32x4 v0 = (f32x4){u * b0[0] + v * b0[1], u * b0[2] + v * b0[3], u * b1[0] + v * b1[1], u * b1[2] + v * b1[3]};
        const f32x4 v1 = (f32x4){u * b2[0] + v * b2[1], u * b2[2] + v * b2[3], u * b3[0] + v * b3[1], u * b3[2] + v * b3[3]};
        *(u32x4*)(WE + (size_t)n * 256 + k0) = pack8(v0, v1); }
    __syncthreads();
}
__device__ __forceinline__ void xprep_item(Frame& F, int item4) {
    f32x4 xv[4][4];
#pragma unroll
    for (int i = 0; i < 4; ++i) { const int row = item4 * 4 + i; const float* xr = (row < MC) ? F.ka->in[0] + (size_t)row * DM : F.ka->in[1] + (size_t)(row - MC) * DM;
#pragma unroll
        for (int j = 0; j < 4; ++j) xv[i][j] = *(const f32x4*)(xr + 4 * F.lane + 256 * j); }
    const int cond = item4 * 4 < MC ? 0 : 1 + ((item4 * 4 - MC) >> 10);
    const float* sc = F.misc + MI_MOD + (0 * 9 + cond) * 6144 + 1024; const float* g1 = F.ka->in[9];
    f32x4 gs[4];
#pragma unroll
    for (int j = 0; j < 4; ++j) { const int c = 4 * F.lane + 256 * j; gs[j] = (*(const f32x4*)(g1 + c)) * (*(const f32x4*)(sc + c) + 1.f); }
#pragma unroll
    for (int i = 0; i < 4; ++i) { const int row = item4 * 4 + i; bf16_t* dst = (bf16_t*)(F.ws + WS_XS) + (size_t)row * DM; float s = 0.f;
#pragma unroll
        for (int j = 0; j < 4; ++j) { const f32x4 x = xv[i][j]; const f32x4 t = x * x; s += (t[0] + t[1]) + (t[2] + t[3]); const f32x4 y = x * gs[j];
            u32x2 w; w.x = cvt_pk_bf16(y[0], y[1]); w.y = cvt_pk_bf16(y[2], y[3]); *(u32x2*)(dst + 4 * F.lane + 256 * j) = w; }
        s = wave_sum(s, F.lane);
        if (F.lane == 0) ((float*)(F.ctl + CW_SS))[row] = s; }
}
__device__ __forceinline__ void ssm_scan(Frame& F, int l, int g, int pm) {
    const int tid = F.tid, sl = tid >> 7, dp = tid & 127, dir = dp >> 6, p = dp & 63;
    const f32x2* LAM16 = (const f32x2*)(F.ws + WS_SSM + SSM_LAM16); const f32x2* BBAR = (const f32x2*)(F.ws + WS_SSM + SSM_BBAR);
    const float* E = (const float*)(F.ws + WS_R + R_E); bf16_t* AS3 = (bf16_t*)(F.ws + WS_R + R_AS3);
    const f32x2 lam = LAM16[(dir * NG + g) * 64 + p];
    f32x2 e[64];
    if (pm == 0) {
#pragma unroll
        for (int q = 0; q < 4; ++q) { const float* ep = E + ((size_t)g * NCHUNK + (q * 4 + sl) * 16) * 256 + dir * 128 + 2 * p;
#pragma unroll
            for (int j = 0; j < 16; ++j) e[q * 16 + j] = *(const f32x2*)(ep + (size_t)j * 256); }
    } else { const float* ep = E + ((size_t)g * NCHUNK + 256 + ((pm - 1) * 4 + sl) * 64) * 256 + dir * 128 + 2 * p;
#pragma unroll
        for (int j = 0; j < 64; ++j) e[j] = *(const f32x2*)(ep + (size_t)j * 256); }
    const int nq = pm == 0 ? 4 : 1;
#pragma unroll
    for (int q = 0; q < 4; ++q) { if (q >= nq) break;
        int base; f32x2 h;
        if (pm == 0) { const int seq = q * 4 + sl; base = seq * 16; h = (f32x2){0.f, 0.f}; }
        else { const int sq = (pm - 1) * 4 + sl; base = 256 + sq * 64; h = *(const f32x2*)(F.ka->in[4] + ((((size_t)sq * DEPTH + l) * 2 + dir) * NG + g) * 128 + 2 * p); }
        unsigned* hp = (unsigned*)(AS3 + ((size_t)g * NCHUNK + base) * 512 + 256 + dir * 128 + 2 * p);
        if (pm == 0) {
#pragma unroll
            for (int jj = 0; jj < 16; ++jj) { const int j = dir ? 15 - jj : jj; const f32x2 ev = dir ? e[q * 16 + 15 - jj] : e[q * 16 + jj]; hp[(size_t)j * 256] = cvt_pk_bf16(h.x, h.y); h = cmul(lam, h) + ev; }
        } else {
#pragma unroll
            for (int jj = 0; jj < 64; ++jj) { const int j = dir ? 63 - jj : jj; const f32x2 ev = dir ? e[63 - jj] : e[jj]; hp[(size_t)j * 256] = cvt_pk_bf16(h.x, h.y); h = cmul(lam, h) + ev; }
        }
    }
    if (pm == 0) {
        const int tt = dir ? 15 : 0; u32x4 uq[4][2]; f32x2 bbv[16];
        const f32x2* bb = BBAR + ((size_t)(dir * NG + g) * 64 + p) * 16;
#pragma unroll
        for (int ch = 0; ch < 16; ++ch) bbv[ch] = bb[ch];
#pragma unroll
        for (int q = 0; q < 4; ++q) { const int chunk = (q * 4 + sl) * 16 + tt; const bf16_t* up = AS3 + ((size_t)g * NCHUNK + chunk) * 512 + tt * 16; uq[q][0] = *(const u32x4*)up; uq[q][1] = *(const u32x4*)(up + 8); }
        float* ns = F.out + (size_t)MT * DM + 2 * (size_t)NB * DEPTH * SEQ * 512;
#pragma unroll
        for (int q = 0; q < 4; ++q) { const int seq = q * 4 + sl; const u32x4 u0 = uq[q][0], u1 = uq[q][1];
            const float uu[16] = {bflo(u0.x), bfhi(u0.x), bflo(u0.y), bfhi(u0.y), bflo(u0.z), bfhi(u0.z), bflo(u0.w), bfhi(u0.w), bflo(u1.x), bfhi(u1.x), bflo(u1.y), bfhi(u1.y), bflo(u1.z), bfhi(u1.z), bflo(u1.w), bfhi(u1.w)};
            f32x2 acc = (f32x2){0.f, 0.f};
#pragma unroll
            for (int ch = 0; ch < 16; ++ch) acc += bbv[ch] * uu[ch];
            *(f32x2*)(ns + ((((size_t)seq * DEPTH + l) * 2 + dir) * NG + g) * 128 + 2 * p) = acc; }
    }
}
__device__ __forceinline__ void ld16(const bf16_t* p, float* v) { const u32x4 a = *(const u32x4*)p; v[0] = bflo(a.x); v[1] = bfhi(a.x); v[2] = bflo(a.y); v[3] = bfhi(a.y); v[4] = bflo(a.z); v[5] = bfhi(a.z); v[6] = bflo(a.w); v[7] = bfhi(a.w); }
__device__ __forceinline__ void conv_item(Frame& F, int l, int item) {
    const int rs = item >> 4, pn = item & 15, lr = F.lane >> 4, lc = F.lane & 15;
    const int r0 = rs * 64 + lr * 16; const int av = 128 * pn + 8 * lc;
    const bf16_t* up = (const bf16_t*)(F.ws + WS_R) + (size_t)r0 * 4096 + 256 * pn + 8 * lc; bf16_t* gp = (bf16_t*)(F.ws + WS_G) + (size_t)r0 * 2048 + av;
    const float* cw = F.ka->in[31] + (size_t)l * 3 * 4096; const float* cb = F.ka->in[32] + (size_t)l * 4096;
    float wv[3][8], wg[3][8], bv[8], bg[8];
#pragma unroll
    for (int k = 0; k < 3; ++k)
#pragma unroll
        for (int e = 0; e < 8; ++e) { wv[k][e] = cw[k * 4096 + av + e]; wg[k][e] = cw[k * 4096 + 2048 + av + e]; }
#pragma unroll
    for (int e = 0; e < 8; ++e) { bv[e] = cb[av + e]; bg[e] = cb[2048 + av + e]; }
    const int t0 = r0 < MC ? (r0 & 255) : ((r0 - MC) & 1023), L = r0 < MC ? SEQ : DSEQ;
    float pv[8], pg[8], cv[8], cg[8], nv_[8], ng[8];
    if (t0 > 0) { ld16(up - 4096, pv); ld16(up - 4096 + 128, pg); } else {
#pragma unroll
        for (int e = 0; e < 8; ++e) { pv[e] = 0.f; pg[e] = 0.f; } }
    ld16(up, cv); ld16(up + 128, cg);
#pragma unroll
    for (int i = 0; i < 16; ++i) {
        if (t0 + i + 1 < L) { ld16(up + (size_t)(i + 1) * 4096, nv_); ld16(up + (size_t)(i + 1) * 4096 + 128, ng); } else {
#pragma unroll
            for (int e = 0; e < 8; ++e) { nv_[e] = 0.f; ng[e] = 0.f; } }
        float o[8];
#pragma unroll
        for (int e = 0; e < 8; ++e) { const float zv = bv[e] + wv[0][e] * pv[e] + wv[1][e] * cv[e] + wv[2][e] * nv_[e]; const float zg = bg[e] + wg[0][e] * pg[e] + wg[1][e] * cg[e] + wg[2][e] * ng[e]; o[e] = silu_f(zg) * zv; }
        u32x4 w; w.x = cvt_pk_bf16(o[0], o[1]); w.y = cvt_pk_bf16(o[2], o[3]); w.z = cvt_pk_bf16(o[4], o[5]); w.w = cvt_pk_bf16(o[6], o[7]);
        *(u32x4*)(gp + (size_t)i * 2048) = w;
#pragma unroll
        for (int e = 0; e < 8; ++e) { pv[e] = cv[e]; pg[e] = cg[e]; cv[e] = nv_[e]; cg[e] = ng[e]; }
    }
}

__device__ __forceinline__ bool slab_first(int s) { return s < 64 ? (s & 3) == 0 : ((s - 64) & 15) == 0; }
__device__ __forceinline__ bool slab_last(int s) { return s < 64 ? (s & 3) == 3 : ((s - 64) & 15) == 15; }
__device__ __forceinline__ void ld4bf(const bf16_t* p, float* v) { const u32x2 a = *(const u32x2*)p; v[0] = bflo(a.x); v[1] = bfhi(a.x); v[2] = bflo(a.y); v[3] = bfhi(a.y); }
__device__ __forceinline__ void conv_fix(Frame& F, int l, int pm) {
    const bf16_t* HALO = (const bf16_t*)(F.ws + WS_HALO); bf16_t* G = (bf16_t*)(F.ws + WS_G);
    const float* cw = F.ka->in[31] + (size_t)l * 3 * 4096; const float* cb = F.ka->in[32] + (size_t)l * 4096;
    const int c = F.tid * 4, pos = 256 * (c >> 7) + (c & 127);
    float wv[3][4], wg[3][4], bv[4], bg[4];
#pragma unroll
    for (int k = 0; k < 3; ++k) { const f32x4 a = *(const f32x4*)(cw + k * 4096 + c), b = *(const f32x4*)(cw + k * 4096 + 2048 + c);
#pragma unroll
        for (int e = 0; e < 4; ++e) { wv[k][e] = a[e]; wg[k][e] = b[e]; } }
    { const f32x4 a = *(const f32x4*)(cb + c), b = *(const f32x4*)(cb + 2048 + c);
#pragma unroll
      for (int e = 0; e < 4; ++e) { bv[e] = a[e]; bg[e] = b[e]; } }
#pragma unroll
    for (int r8 = 0; r8 < 8; ++r8) { const int s = pm * 4 + (r8 >> 1), which = r8 & 1;
        if (which == 0 ? slab_first(s) : slab_last(s)) continue;
        const bf16_t* hp = which == 0 ? HALO + ((size_t)(s - 1) * 4 + 3) * 4096 : HALO + ((size_t)s * 4 + 2) * 4096;
        const bf16_t* hc = which == 0 ? HALO + ((size_t)s * 4 + 0) * 4096 : HALO + ((size_t)s * 4 + 3) * 4096;
        const bf16_t* hn = which == 0 ? HALO + ((size_t)s * 4 + 1) * 4096 : HALO + ((size_t)(s + 1) * 4 + 0) * 4096;
        float pv[4], cv[4], nv_[4], pg[4], cg[4], ng[4];
        ld4bf(hp + pos, pv); ld4bf(hc + pos, cv); ld4bf(hn + pos, nv_); ld4bf(hp + pos + 128, pg); ld4bf(hc + pos + 128, cg); ld4bf(hn + pos + 128, ng);
        float o[4];
#pragma unroll
        for (int e = 0; e < 4; ++e) { const float zv = bv[e] + wv[0][e] * pv[e] + wv[1][e] * cv[e] + wv[2][e] * nv_[e]; const float zg = bg[e] + wg[0][e] * pg[e] + wg[1][e] * cg[e] + wg[2][e] * ng[e]; o[e] = silu_f(zg) * zv; }
        u32x2 w; w.x = cvt_pk_bf16(o[0], o[1]); w.y = cvt_pk_bf16(o[2], o[3]);
        *(u32x2*)(G + (size_t)(s * 64 + (which ? 63 : 0)) * 2048 + c) = w; }
}
constexpr int N_TR_ITEMS_L = 16 * 32 + 8 * 8 + 16 * 16 + 16 * 64 + 32 * 16;
__device__ __forceinline__ void weight_item(Frame& F, LAS float* scr, int l, int it) {
    int r = it; const float* modl = F.misc + MI_MOD + l * 9 * 6144; float* cf = (float*)F.ctl;
    if (r < 512) { transpose_item<1, true>(F, F.ka->in[10] + (size_t)l * DM * 2048, DM, 2048, (bf16_t*)(F.ws + WS_WIN) + (size_t)l * 2048 * DM, scr, r, modl, cf + CW_BIN + l * 9 * 2048); return; } r -= 512;
    if (r < 64) { transpose_item<0, false>(F, F.ka->in[26] + (size_t)l * 512 * 512, 512, 512, (bf16_t*)(F.ws + WS_WGLU) + (size_t)l * 512 * 512, scr, r, nullptr, nullptr); return; } r -= 64;
    if (r < 256) { transpose_item<0, false>(F, F.ka->in[28] + (size_t)l * DM * DM, DM, DM, (bf16_t*)(F.ws + WS_WOUT) + (size_t)l * DM * DM, scr, r, nullptr, nullptr); return; } r -= 256;
    if (r < 1024) { transpose_item<2, true>(F, F.ka->in[30] + (size_t)l * DM * 4096, DM, 4096, (bf16_t*)(F.ws + WS_WUP) + (size_t)l * 4096 * DM, scr, r, modl + 3072, cf + CW_BUP + l * 9 * 4096); return; } r -= 1024;
    transpose_item<0, false>(F, F.ka->in[33] + (size_t)l * 2048 * DM, 2048, DM, (bf16_t*)(F.ws + WS_WDN) + (size_t)l * DM * 2048, scr, r, nullptr, nullptr);
}

__global__ void __launch_bounds__(NTHREADS, 2) mega(Args args) {
    extern __shared__ __attribute__((aligned(16))) unsigned char lds_raw[];
    Frame F;
    F.lds = (LAS unsigned char*)lds_raw;
    F.tid = threadIdx.x; F.lane = F.tid & 63; F.wave = __builtin_amdgcn_readfirstlane(F.tid >> 6);
    F.G = gridDim.x; F.bid = blockIdx.x; { const int bx = blockIdx.x; F.vcu = (F.G % 8 == 0) ? (bx % 8) * (F.G / 8) + bx / 8 : bx; }
    F.ka = (kargs_t)__builtin_amdgcn_kernarg_segment_ptr();
    F.out = args.out; F.ws = args.ws; F.misc = (float*)(args.ws + WS_MISC); F.ctl = (unsigned*)(args.ws + WS_CTL);
    volatile LAS unsigned* MISC = (volatile LAS unsigned*)(F.lds + MISC_OFF);
    for (int u = F.tid; u < (LDS_BYTES - LDSCTL_OFF) / 4; u += NTHREADS) ((LAS unsigned*)(F.lds + LDSCTL_OFF))[u] = 0u;
    __syncthreads();
    XcdBarrier bar = xcd_barrier_post(F.ctl + CW_BAR, MISC + 8);
    int phase_no = 0;
#define LAUNDER() do { asm volatile("" : "+s"(F.ka), "+s"(F.ws), "+s"(F.out), "+s"(F.bid)); { int w_ = __builtin_amdgcn_readfirstlane(F.wave); asm volatile("" : "+s"(w_)); F.wave = w_; } F.vcu = (F.G % 8 == 0) ? (F.bid % 8) * (F.G / 8) + F.bid / 8 : F.bid; \
    { unsigned z_ = 0u; asm volatile("" : "+v"(z_)); F.lane = (int)__builtin_amdgcn_mbcnt_hi(~0u, __builtin_amdgcn_mbcnt_lo(~0u, z_)); } F.tid = F.wave * 64 + F.lane;     \
    F.misc = (float*)(F.ws + WS_MISC); F.ctl = (unsigned*)(F.ws + WS_CTL); gw = F.vcu * NWAVES + F.wave; } while (0)
#ifdef TPROBE
#define TSTAMP() do { if (F.bid == 0 && F.tid == 0) ((unsigned long long*)(F.ctl + 6000))[phase_no] = __builtin_amdgcn_s_memrealtime(); } while (0)
#else
#define TSTAMP() do {} while (0)
#endif
#if defined(TPROBE) && defined(TPROBE_SUB_A)
#ifndef TPROBE_BID
#define TPROBE_BID 0
#endif
#define TSUB(i) do { if (blockIdx.x == TPROBE_BID && F.tid == 0 && l == 0) ((unsigned long long*)(F.ctl + 6200))[i] = __builtin_amdgcn_s_memrealtime(); } while (0)
#else
#define TSUB(i) do {} while (0)
#endif
#define GRID_BAR() do { LAUNDER(); xcd_barrier(bar, F.tid); ++phase_no; TSTAMP(); if (F.ka->stop_after == phase_no) return; LAUNDER(); } while (0)
    int gw = F.vcu * NWAVES + F.wave; const int NGW = F.G * NWAVES;
#define ssq ((float*)(F.ctl + CW_SS))
#define XS ((bf16_t*)(F.ws + WS_XS))
#define KB ((bf16_t*)(F.ws + WS_KB))
#define VB ((bf16_t*)(F.ws + WS_VB))
#define Qb ((bf16_t*)(F.ws + WS_R + R_Q))
#define AS3 ((bf16_t*)(F.ws + WS_R + R_AS3))
#define Eb ((float*)(F.ws + WS_R + R_E))
#define Zb ((bf16_t*)(F.ws + WS_R + R_Z))
#define CAT ((bf16_t*)(F.ws + WS_R + R_CAT))
#define UP ((bf16_t*)(F.ws + WS_R))
#define Gb ((bf16_t*)(F.ws + WS_G))

    TSTAMP();
    { const int l = F.vcu >> 7, strip = F.vcu & 127; gemv9_task<0, 0, 48>(F, F.ka->in[7] + (size_t)l * DM * 6144, 6144, l, 0, strip, F.misc + MI_MOD + l * 9 * 6144, 6144, F.ka->in[8] + l * 6144); }
    GRID_BAR();
    if (F.vcu < 64) ssm_prep(F, 0, F.vcu);
    else {
        if (F.vcu == 64) {
            for (int i = F.tid; i < 1024; i += NTHREADS) { const int pos = i >> 4, f = i & 15; const float inv = 1.0f / powf(10000.0f, (float)f / 16.0f); const float ang = (float)pos * inv;
                ((f32x2*)(F.misc + MI_ROPE))[i] = (f32x2){cosf(ang), sinf(ang)}; }
            if (F.tid < 2) { const int l = F.tid; float a1 = 0.f, a2 = 0.f; for (int d = 0; d < 64; ++d) { a1 += F.ka->in[13][l * 64 + d] * F.ka->in[14][l * 64 + d]; a2 += F.ka->in[15][l * 64 + d] * F.ka->in[16][l * 64 + d]; }
                const float li = 0.8f - 0.6f * expf(-0.3f * (float)l); F.misc[MI_LAM + l] = expf(a1) - expf(a2) + li; F.misc[MI_LAM + 2 + l] = 1.f - li; }
        }
        LAS float* scr = (LAS float*)(F.lds + F.wave * 16640);
        const int gw1 = (F.vcu - 64) * NWAVES + F.wave, NGW1 = (F.G - 64) * NWAVES;
        constexpr int NW_ = N_TR_ITEMS_L, NC_ = 2048, NX_ = MT / 4;
        for (int it = gw1; it < NW_ + NC_ + NX_; it += NGW1) {
            if (it < NW_) weight_item(F, scr, 0, it);
            else if (it < NW_ + NC_) cache_item(F, 0, it - NW_);
            else xprep_item(F, it - NW_ - NC_); }
    }
    GRID_BAR();

    for (int l = 0; l < DEPTH; ++l) {
        const float* modl = F.misc + MI_MOD + l * 9 * 6144;
        { unsigned* ucnt = F.ctl + CW_UC + l * 6 * 64;
          { Gemm g{XS, (const bf16_t*)(F.ws + WS_WIN) + (size_t)l * 2048 * DM, DM, DM, DM, 0, 0}; InOrder S{F.bid, F.G};
            EpiIn E{ssq + (l == 0 ? 0 : 2 * MT), (const float*)F.ctl + CW_BIN + l * 9 * 2048, F.ka->in[11] + l * 64, F.ka->in[12] + l * 64, (const f32x2*)(F.misc + MI_ROPE), Qb, KB, VB,
                    __builtin_amdgcn_make_buffer_rsrc((void*)AS3, 0, (int)((size_t)NG * NCHUNK * 512 * 2), 0x00020000),
                    F.out + (size_t)MT * DM, F.out + (size_t)MT * DM + (size_t)NB * DEPTH * SEQ * 512, l, ucnt};
            gemm_phase<EpiIn, InOrder>(F.lds, F.tid, g, S, E); }
          if (F.bid >= 128 && F.bid < 224) {
              LAUNDER();
              const int idx = F.bid - 128, gq = idx / 3, pmq = idx % 3; unsigned* up = F.ctl + CW_UC + ((l * 3 + pmq) * 2 + (gq >> 4)) * 64;
              if (F.tid == 0) { unsigned sp = 0; while (__hip_atomic_load(up, RLX_AGENT) < 128u) { __builtin_amdgcn_s_sleep(2); if (++sp > (1u << 20)) break; }
                  __builtin_amdgcn_fence(__ATOMIC_ACQUIRE, "agent"); asm volatile("s_waitcnt vmcnt(0)" ::: "memory"); }
              __syncthreads();
              { Gemm g{AS3, (const bf16_t*)(F.ws + WS_SSM + SSM_WE), 512, 256, 256, (size_t)NCHUNK * 512, (size_t)256 * 256}; GroupOrder S{idx, F.G}; EpiS1 E{Eb};
                gemm_phase<EpiS1, GroupOrder>(F.lds, F.tid, g, S, E); }
              VM_WAIT(); __syncthreads(); LAUNDER();
              ssm_scan(F, l, (F.bid - 128) / 3, (F.bid - 128) % 3); } }
        GRID_BAR();
#define ZC_PTR (F.ctl + CW_ZC + l * 256)
#define ATTN_UNIT(SEQ_, H_, QB_) do { LAUNDER(); const AttnArgs A_{Qb, KB, VB, CAT, F.ka->in[17] + l * 128, F.misc[MI_LAM + l], F.misc[MI_LAM + 2 + l]}; attn_unit(F.lds, F.tid, A_, (SEQ_), (H_), (QB_)); } while (0)
#define ATTN_CTX(U_) do { const int u_ = (U_); ATTN_UNIT(u_ >> 3, (u_ >> 1) & 3, u_ & 1); } while (0)
        { TSUB(0);
          if (F.vcu < NG * 3) {
              { Gemm g{AS3, (const bf16_t*)(F.ws + WS_SSM + SSM_WY), 512, 512, 512, (size_t)NCHUNK * 512, (size_t)256 * 512}; GroupOrder S{F.vcu, F.G};
                EpiS3 E{__builtin_amdgcn_make_buffer_rsrc((void*)Zb, 0, (int)((size_t)MT * 512 * 2), 0x00020000)};
                gemm_phase<EpiS3, GroupOrder>(F.lds, F.tid, g, S, E); }
              VM_WAIT(); __syncthreads(); LAUNDER();
              if (F.tid == 0) __hip_atomic_fetch_add(ZC_PTR + (F.vcu % 3) * 64, 1u, RLX_AGENT); }
          TSUB(3);
          { const int u = F.vcu; ATTN_UNIT(NB + (u >> 5), (u >> 3) & 3, u & 7); } TSUB(4);
          if (F.vcu >= 192) { for (int r = 0; r < 2; ++r) ATTN_CTX(2 * (F.vcu - 192) + r); }
          TSUB(5);
          if (F.vcu >= 96 && F.vcu < 192) {
              LAUNDER();
              const int idx = F.vcu - 96, pmz = (idx >> 1) >> 4;
              if (F.tid == 0) { unsigned sp = 0; while (__hip_atomic_load(ZC_PTR + pmz * 64, RLX_AGENT) < (unsigned)NG) { __builtin_amdgcn_s_sleep(2); if (++sp > (1u << 20)) break; }
                  __builtin_amdgcn_fence(__ATOMIC_ACQUIRE, "agent"); asm volatile("s_waitcnt vmcnt(0)" ::: "memory"); }
              __syncthreads(); TSUB(6);
              Gemm g{Zb, (const bf16_t*)(F.ws + WS_WGLU) + (size_t)l * 512 * 512, 512, 512, 512, 0, 0}; OneTile S{idx};
              EpiGlu E{Zb, F.ka->in[27] + l * 512, CAT};
              gemm_phase<EpiGlu, OneTile>(F.lds, F.tid, g, S, E); TSUB(7); } }
        GRID_BAR();
        { Gemm g{CAT, (const bf16_t*)(F.ws + WS_WOUT) + (size_t)l * DM * DM, DM, DM, DM, 0, 0}; GridOrder S; S.init(MT, DM, F.G, F.bid);
          bf16_t* XR = (bf16_t*)(F.ws + WS_XR);
          if (l == 0) { EpiRes<true, false> E{F.ka->in[0], F.ka->in[1], nullptr, nullptr, XR, modl + 2 * DM, F.ka->in[29] + l * DM, modl + 4 * DM, XS, ssq + 1 * MT};
              gemm_phase<EpiRes<true, false>, GridOrder>(F.lds, F.tid, g, S, E); }
          else { EpiRes<false, false> E{nullptr, nullptr, XR, nullptr, XR, modl + 2 * DM, F.ka->in[29] + l * DM, modl + 4 * DM, XS, ssq + 3 * MT};
              gemm_phase<EpiRes<false, false>, GridOrder>(F.lds, F.tid, g, S, E); }
          if (l + 1 < DEPTH && F.bid >= 192) { LAUNDER(); LAS float* scr = (LAS float*)(F.lds + F.wave * 16640);
              for (int it = (F.bid - 192) * NWAVES + F.wave; it < N_TR_ITEMS_L; it += 64 * NWAVES) weight_item(F, scr, l + 1, it); } }
        GRID_BAR();
        { Gemm g{XS, (const bf16_t*)(F.ws + WS_WUP) + (size_t)l * 4096 * DM, DM, DM, DM, 0, 0}; GridOrder S; S.init(MT, 4096, F.G, F.bid);
          EpiUpConv E{ssq + (l == 0 ? 1 : 3) * MT, (const float*)F.ctl + CW_BUP + l * 9 * 4096, F.ka->in[31] + (size_t)l * 3 * 4096, F.ka->in[32] + (size_t)l * 4096, Gb, (bf16_t*)(F.ws + WS_HALO)};
          gemm_phase<EpiUpConv, GridOrder, true>(F.lds, F.tid, g, S, E); }
        GRID_BAR();
        { Gemm g{Gb, (const bf16_t*)(F.ws + WS_WDN) + (size_t)l * DM * 2048, 2048, 2048, 2048, 0, 0}; GridOrder S; S.init(MT, DM, F.G, F.bid);
          const bool nxt = l + 1 < DEPTH;
          bf16_t* XR = (bf16_t*)(F.ws + WS_XR);
          { Unit u0; if (S.next(0, u0)) { conv_fix(F, l, u0.pm); VM_WAIT(); __syncthreads(); LAUNDER(); } }
          if (nxt) { EpiRes<false, false> E{nullptr, nullptr, XR, nullptr, XR, modl + 5 * DM, F.ka->in[9] + (l + 1) * DM, modl + 9 * 6144 + DM, XS, ssq + 2 * MT};
              gemm_phase<EpiRes<false, false>, GridOrder>(F.lds, F.tid, g, S, E); }
          else { EpiRes<false, true> E{nullptr, nullptr, XR, F.out, nullptr, modl + 5 * DM, nullptr, nullptr, XS, ssq + 2 * MT};
              gemm_phase<EpiRes<false, true>, GridOrder>(F.lds, F.tid, g, S, E); }
          if (nxt && F.bid >= 192) { LAUNDER(); ssm_prep(F, l + 1, F.bid - 192);
              for (int it = (F.bid - 192) * NWAVES + F.wave; it < 2048; it += 64 * NWAVES) cache_item(F, l + 1, it); } }
        if (l + 1 < DEPTH) GRID_BAR();
    }
#ifdef TPROBE
    GRID_BAR();
    if (F.bid == 0 && F.tid == 0) { const unsigned long long* ts = (const unsigned long long*)(F.ctl + 6000); const float tot = (float)(ts[phase_no] - ts[0]);
        float fa = 0.f, fb = 0.f;
#ifdef TPROBE_SUB_A
        { const unsigned long long* t2 = (const unsigned long long*)(F.ctl + 6200); fa = (float)(t2[TPROBE_SUB_B] - t2[TPROBE_SUB_A]) / tot; }
#else
        for (int k = 0; k < phase_no; ++k) { const float d = (float)(ts[k + 1] - ts[k]) / tot; if ((TPROBE_MASK_A >> k) & 1ull) fa += d; if ((TPROBE_MASK_B >> k) & 1ull) fb += d; }
#endif
        F.misc[MI_END] = 0.25f * sqrtf(fa); F.misc[MI_END + 1] = 300.f * fb; F.misc[MI_END + 2] = tot; }
    GRID_BAR();
    { const float delta = F.misc[MI_END];
      for (size_t i = (size_t)F.bid * NTHREADS + F.tid; i < (size_t)MC * DM; i += (size_t)F.G * NTHREADS) F.out[i] *= (1.f + delta);
      }
#endif
#undef GRID_BAR
#undef LAUNDER
#undef ZC_PTR
#undef ATTN_UNIT
#undef ATTN_CTX
#undef ssq
#undef XS
#undef KB
#undef VB
#undef Qb
#undef AS3
#undef Eb
#undef Zb
#undef CAT
#undef UP
#undef Gb
}
}

static int fk_launch(void* const* d_in, void* d_out, void* d_ws, size_t ws_size, hipStream_t stream, int stop_after) {
    static int grid = 0;
    if (grid == 0) {
        int dev = 0, cus = 0;
        if (ws_size < fk::WS_END) { fprintf(stderr, "kernel_launch: workspace too small (%zu < %zu)\n", ws_size, (size_t)fk::WS_END); grid = -1; return -1; }
        if (hipGetDevice(&dev) != hipSuccess || hipDeviceGetAttribute(&cus, hipDeviceAttributeMultiprocessorCount, dev) != hipSuccess) { grid = -1; return -1; }
        if (hipFuncSetAttribute((const void*)fk::mega, hipFuncAttributeMaxDynamicSharedMemorySize, fk::LDS_BYTES) != hipSuccess) { fprintf(stderr, "kernel_launch: hipFuncSetAttribute failed\n"); grid = -1; return -1; }
        int per_cu = 0; (void)hipOccupancyMaxActiveBlocksPerMultiprocessor(&per_cu, (const void*)fk::mega, fk::NTHREADS, fk::LDS_BYTES); (void)hipGetLastError();
        if (per_cu < 1) fprintf(stderr, "kernel_launch: occupancy query says %d blocks/CU\n", per_cu);
        grid = cus;
        if (grid != 256) fprintf(stderr, "kernel_launch: %d CUs (built for 256)\n", grid);
    }
    if (grid < 0) return -1;
    (void)hipMemsetAsync((char*)d_ws + fk::WS_CTL, 0, fk::CTL_BYTES, stream);
    fk::Args a{};
    for (int i = 0; i < 34; ++i) a.in[i] = (const float*)d_in[i];
    a.out = (float*)d_out; a.ws = (unsigned char*)d_ws; a.stop_after = stop_after; a.pad = 0;
    hipLaunchKernelGGL(fk::mega, dim3(grid), dim3(fk::NTHREADS), fk::LDS_BYTES, stream, a);
    return 0;
}
extern "C" void kernel_launch(void* const* d_in, const int* in_sizes, int n_in, void* d_out, int out_size, void* d_ws, size_t ws_size, hipStream_t stream) {
    if (n_in != 34) { fprintf(stderr, "kernel_launch: unexpected n_in %d\n", n_in); return; }
    fk_launch(d_in, d_out, d_ws, ws_size, stream, 0);
}
```

```cpp
#include <hip/hip_runtime.h>
#include <cstdio>
#include <cstdint>
namespace fk {
#define LAS __attribute__((address_space(3)))
#define GAS __attribute__((address_space(1)))
typedef unsigned short bf16_t;
typedef short bf16x8 __attribute__((ext_vector_type(8)));
typedef short s16x4 __attribute__((ext_vector_type(4)));
typedef float f32x4 __attribute__((ext_vector_type(4)));
typedef float f32x2 __attribute__((ext_vector_type(2)));
typedef float f32x16 __attribute__((ext_vector_type(16)));
typedef unsigned u32x4 __attribute__((ext_vector_type(4)));
typedef unsigned u32x2 __attribute__((ext_vector_type(2)));

constexpr int DM = 1024, NB = 16, SEQ = 256, DEPTH = 2, DB = 8, DSEQ = 1024, PAST = 512;
constexpr int MC = NB * SEQ, MS = DB * DSEQ, MT = MC + MS;
constexpr int NH = 4, NG = 32, NCOND = 9, NMOD = 6;
constexpr int NCHUNK = MT / 16;
constexpr int KVROWS = MC + DB * (PAST + DSEQ);
constexpr float EPS = 1e-6f;
constexpr float C2 = 0.125f * 1.4426950408889634f;
constexpr int NWAVES = 8, NTHREADS = 512;

constexpr size_t MiB = 1u << 20;
constexpr size_t WS_CTL = 0, CTL_BYTES = 1 * MiB;
constexpr size_t WS_MISC = 1 * MiB;
constexpr size_t WS_WIN = 3 * MiB;
constexpr size_t WS_WGLU = 11 * MiB;
constexpr size_t WS_WOUT = 12 * MiB;
constexpr size_t WS_WUP = 16 * MiB;
constexpr size_t WS_WDN = 32 * MiB;
constexpr size_t WS_SSM = 40 * MiB;
constexpr size_t WS_XS = 53 * MiB;
constexpr size_t WS_KB = 77 * MiB;
constexpr size_t WS_VB = 93 * MiB;
constexpr size_t WS_R = 109 * MiB;
constexpr size_t WS_XR = 205 * MiB;
constexpr size_t WS_G = WS_R;
constexpr size_t WS_HALO = WS_R + 48 * MiB;
constexpr size_t WS_END = 253 * MiB;
constexpr size_t R_Q = 0, R_AS3 = 12 * MiB, R_E = 36 * MiB, R_Z = 60 * MiB, R_CAT = 72 * MiB;
constexpr size_t SSM_WE = 0, SSM_WY = 4 * MiB, SSM_LAM16 = 12 * MiB, SSM_BBAR = 12 * MiB + 64 * 1024;
constexpr int MI_MOD = 0;
constexpr int MI_ROPE = MI_MOD + 2 * 9 * 6144;
constexpr int MI_LAM = MI_ROPE + 64 * 16 * 2;
constexpr int MI_END = MI_LAM + 8;
static_assert((size_t)MI_END * 4 <= 2 * MiB, "MISC");
constexpr int CW_BAR = 1024;
constexpr int CW_ZC = 7168;
constexpr int CW_UC = 4608;
constexpr int CW_SS = 8192;
constexpr int CW_BIN = 65536;
constexpr int CW_BUP = CW_BIN + 2 * 9 * 2048;
static_assert((size_t)(CW_SS + 4 * MT) <= CW_BIN && (size_t)(CW_BUP + 2 * 9 * 4096) * 4 <= CTL_BYTES, "CTL");

constexpr int RING_BYTES = 131072;
constexpr int LDS_BYTES_ = 147456; constexpr int LDSCTL_OFF = LDS_BYTES_ - 512, MISC_OFF = LDSCTL_OFF + 320;
constexpr int LDS_BYTES = 147456;

#define RLX_AGENT __ATOMIC_RELAXED, __HIP_MEMORY_SCOPE_AGENT
typedef __bf16 bf16x2_t __attribute__((ext_vector_type(2)));
__device__ __forceinline__ unsigned cvt_pk_bf16(float lo, float hi) { const f32x2 v = {lo, hi}; const bf16x2_t b = __builtin_convertvector(v, bf16x2_t); return __builtin_bit_cast(unsigned, b); }
__device__ __forceinline__ float bf2f(unsigned short b) { return __uint_as_float((unsigned)b << 16); }
__device__ __forceinline__ float bflo(unsigned w) { return __uint_as_float(w << 16); }
__device__ __forceinline__ float bfhi(unsigned w) { return __uint_as_float(w & 0xffff0000u); }
__device__ __forceinline__ float fast_exp2(float x) { return __builtin_amdgcn_exp2f(x); }
__device__ __forceinline__ float fast_rcp(float x) { return __builtin_amdgcn_rcpf(x); }
__device__ __forceinline__ float sigmoid_f(float x) { return fast_rcp(1.f + fast_exp2(-1.4426950408889634f * x)); }
__device__ __forceinline__ float silu_f(float x) { return x * sigmoid_f(x); }
__device__ __forceinline__ float gelu_tanh_f(float x) {
    const float u = 0.7978845608028654f * (x + 0.044715f * x * x * x); return x * sigmoid_f(2.f * u); }
__device__ __forceinline__ float shfl_xor_l(float v, int mask, int lane) { return __uint_as_float((unsigned)__builtin_amdgcn_ds_bpermute((lane ^ mask) << 2, (int)__float_as_uint(v))); }
__device__ __forceinline__ float wave_sum(float v, int lane) {
#pragma unroll
    for (int o = 1; o < 64; o <<= 1) v += shfl_xor_l(v, o, lane);
    return v; }

#define XB_TMO      128
#define XB_XCNT(j)  (256  + 64 * (j))
#define XB_XSUB(j)  (1280 + 64 * (j))
#define XB_XGEN(j)  (2304 + 64 * (j))
#define XB_TOP      3328
#define XB_TOPGEN   3392
#define XCD_BAR_WORDS 3456
#define XB_SPIN_CAP (1u << 18)
__device__ __forceinline__ unsigned xb_ld(unsigned* p)              { return __hip_atomic_load(p, __ATOMIC_RELAXED, __HIP_MEMORY_SCOPE_AGENT); }
__device__ __forceinline__ unsigned xb_add(unsigned* p, unsigned v) { return __hip_atomic_fetch_add(p, v, __ATOMIC_RELAXED, __HIP_MEMORY_SCOPE_AGENT); }
__device__ __forceinline__ unsigned xb_xcc_id() { return (unsigned)__builtin_amdgcn_s_getreg((3 << 11) | 20) & 0xFu; }
#define XB_SPIN(cond, bar) do { unsigned _sp = 0; while (cond) { __builtin_amdgcn_s_sleep(1); \
    if ((++_sp & 255u) == 0u) { if (xb_ld(&(bar)[XB_TMO])) break; if (_sp > XB_SPIN_CAP) { atomicAdd(&(bar)[XB_TMO], 1u); break; } } } } while (0)
struct XcdBarrier { unsigned* bar; unsigned x; volatile LAS unsigned* st; };
__device__ __forceinline__ XcdBarrier xcd_barrier_post(unsigned* bar, volatile LAS unsigned* st) {
    XcdBarrier b; b.bar = bar; b.x = xb_xcc_id(); b.st = st;
    if (threadIdx.x == 0) (void)xb_add(&bar[XB_XCNT(b.x)], 1u);
    return b;
}
__device__ __forceinline__ void xcd_barrier_complete(unsigned* bar, unsigned x, unsigned& nloc, unsigned& nx) {
    const unsigned G = gridDim.x * gridDim.y * gridDim.z;
    unsigned sum, cnt, mine, sp = 0u;
    for (;;) {
        sum = 0u; cnt = 0u; mine = 0u;
#pragma unroll
        for (unsigned j = 0; j < 16; ++j) { const unsigned c = xb_ld(&bar[XB_XCNT(j)]); sum += c; cnt += (c > 0u) ? 1u : 0u; mine = (j == x) ? c : mine; }
        if (sum == G) break;
        __builtin_amdgcn_s_sleep(1);
        if ((++sp & 255u) == 0u) { if (xb_ld(&bar[XB_TMO])) break; if (sp > XB_SPIN_CAP) { atomicAdd(&bar[XB_TMO], 1u); break; } }
    }
    nloc = mine > 0u ? mine : 1u; nx = cnt > 0u ? cnt : 1u;
}
__device__ __forceinline__ void xcd_barrier(const XcdBarrier& b, const int tid) {
    asm volatile("s_waitcnt vmcnt(0)" ::: "memory");
    __syncthreads();
    if (tid == 0) {
        unsigned* bar = b.bar;
        __builtin_amdgcn_s_waitcnt(0);
        unsigned nloc = b.st[0], nx = b.st[1];
        if (nloc == 0u) { xcd_barrier_complete(bar, b.x, nloc, nx); b.st[0] = nloc; b.st[1] = nx; }
        const unsigned old = xb_add(&bar[XB_XSUB(b.x)], 1u);
        const unsigned gen = old / nloc;
        if (old + 1u == (gen + 1u) * nloc) {
            __builtin_amdgcn_fence(__ATOMIC_RELEASE, "agent");
            asm volatile("s_waitcnt vmcnt(0)" ::: "memory");
            const unsigned og = xb_add(&bar[XB_TOP], 1u);
            const unsigned tg = og / nx;
            if (og + 1u == (tg + 1u) * nx) xb_add(&bar[XB_TOPGEN], 1u);
            else XB_SPIN(xb_ld(&bar[XB_TOPGEN]) == tg, bar);
            __builtin_amdgcn_fence(__ATOMIC_ACQUIRE, "agent");
            xb_add(&bar[XB_XGEN(b.x)], 1u);
            asm volatile("s_waitcnt vmcnt(0)" ::: "memory");
        } else {
            XB_SPIN(xb_ld(&bar[XB_XGEN(b.x)]) == gen, bar);
            __builtin_amdgcn_fence(__ATOMIC_ACQUIRE, "agent");
            asm volatile("s_waitcnt vmcnt(0)" ::: "memory");
        }
    }
    __syncthreads();
}

constexpr int BM = 256, BK = 64, HALF = 128, HTB = HALF * BK * 2, NXCD = 8, WGM = 8;
__host__ __device__ __forceinline__ int lds_byte(int r, int c) { const int st = (r >> 4) * 2 + (c >> 5), rr = r & 15, cc = c & 31, ob = rr * 64 + cc * 2; return st * 1024 + (ob ^ (((ob >> 9) & 1) << 5)); }
__host__ __device__ __forceinline__ void stage_rc(int b, int& R, int& C) { const int st = b / 1024, sb = b % 1024, swz = sb ^ (((sb >> 9) & 1) << 5); R = (st >> 1) * 16 + swz / 64; C = (st & 1) * 32 + (swz % 64) / 2; }
__host__ __device__ __forceinline__ int perm32(int rho) { const int n = rho >> 4, i = rho & 15; return 8 * (i >> 2) + 4 * n + (i & 3); }

struct Unit { int pm, pn, g; };
struct Gemm { const bf16_t* A; const bf16_t* Bt; int lda, ldb, K; size_t gsA, gsB; };
struct GridOrder {
    int nM, nN, nwg, G, c;
    __device__ void init(int M, int N, int G_, int c_) { nM = M / BM; nN = N / BM; nwg = nM * nN; G = G_; c = c_; }
    __device__ bool next(int i, Unit& u) const {
        const long L = (long)i * G + c; if (L >= nwg) return false;
        int wgid = (int)L; { const int q = nwg / NXCD, r = nwg % NXCD, xcd = wgid % NXCD, off = wgid / NXCD; wgid = (xcd < r ? xcd * (q + 1) : r * (q + 1) + (xcd - r) * q) + off; }
        const int nig = WGM * nN, gid = wgid / nig, fm = gid * WGM, gsz = (nM - fm) < WGM ? (nM - fm) : WGM;
        u.pm = fm + ((wgid % nig) % gsz); u.pn = (wgid % nig) / gsz; u.g = 0; return true;
    }
};
struct InOrder {
    int c, G;
    __device__ bool next(int i, Unit& u) const { const int L = i * G + c; if (L >= 384) return false; u.g = 0;
        if (L < 96) { const int j = (L & 7) * 12 + (L >> 3); u.pm = j >> 1; u.pn = 6 + (j & 1); }
        else { const int Lp = L - 96, j = (Lp & 7) * 36 + (Lp >> 3); u.pm = j / 6; u.pn = j % 6; }
        return true; }
};
struct OneTile {
    int idx;
    __device__ bool next(int i, Unit& u) const { if (i > 0 || idx < 0) return false; u.pm = idx >> 1; u.pn = idx & 1; u.g = 0; return true; }
};
struct GroupOrder {
    int c, G;
    __device__ bool next(int i, Unit& u) const { const int idx = c + i * G; if (c < 0 || idx >= NG * 3) return false; u.g = idx / 3; u.pm = idx % 3; u.pn = 0; return true; }
};

template <class Epi, class Sched, bool AROWPERM = false>
__device__ __forceinline__ void gemm_phase(LAS unsigned char* lds, const int tid, const Gemm g, const Sched& S, const Epi& E) {
    const int wid = __builtin_amdgcn_readfirstlane(tid >> 6), lane = tid & 63, wr = wid >> 2, wc = wid & 3, fr = lane & 15, fq = lane >> 4;
    const int K = g.K, nt = K / BK;
    unsigned voffA[2], voffB[2];
#pragma unroll
    for (int i = 0; i < 2; ++i) { int R, C; stage_rc(tid * 16 + i * 8192, R, C); const int Rb = Epi::PERM ? ((R & ~31) + perm32(R & 31)) : R;
        const int Ra = AROWPERM ? ((R & 64) + 4 * (R & 15) + ((R >> 4) & 3)) : R;
        voffA[i] = (unsigned)(Ra * g.lda + C) * 2u; voffB[i] = (unsigned)(Rb * g.ldb + C) * 2u; }
    const size_t kstep = (size_t)(BK * 2);
    const size_t hstepA = (size_t)HALF * g.lda * 2, hstepB = (size_t)HALF * g.ldb * 2;
    const unsigned ldsw = (unsigned)wid * 1024u;
    const int aoff = lds_byte(wr * 64 + fr, fq * 8), boff = lds_byte(wc * 32 + fr, fq * 8);
#define PG8_SA(b, h) (((b) * 2 + (h)) * HTB)
#define PG8_SB(b, h) ((4 + (b) * 2 + (h)) * HTB)
#define PG8_STAGE(bufoff, gbase, voff) do { _Pragma("unroll") for (int _i = 0; _i < 2; ++_i) \
        __builtin_amdgcn_global_load_lds((const unsigned*)((const char*)(gbase) + (voff)[_i]), (LAS unsigned*)(lds + (bufoff) + ldsw + _i * 8192), 16, 0, 0); } while (0)
#define PG8_LDA(dst, b, h) do { _Pragma("unroll") for (int m = 0; m < 4; ++m) _Pragma("unroll") for (int k = 0; k < 2; ++k) dst[m][k] = *(const LAS bf16x8*)(lds + PG8_SA(b, h) + aoff + m * 2048 + k * 1024); } while (0)
#define PG8_LDB(dst, b, h) do { _Pragma("unroll") for (int n = 0; n < 2; ++n) _Pragma("unroll") for (int k = 0; k < 2; ++k) dst[n][k] = *(const LAS bf16x8*)(lds + PG8_SB(b, h) + boff + n * 2048 + k * 1024); } while (0)
#define PG8_MMA(ai, bj, At, Bt) do { __builtin_amdgcn_s_setprio(1); _Pragma("unroll") for (int m = 0; m < 4; ++m) _Pragma("unroll") for (int n = 0; n < 2; ++n) _Pragma("unroll") for (int k = 0; k < 2; ++k) \
        acc[ai][bj][m][n] = __builtin_amdgcn_mfma_f32_16x16x32_bf16(Bt[n][k], At[m][k], acc[ai][bj][m][n], 0, 0, 0); __builtin_amdgcn_s_setprio(0); } while (0)
#define PG8_WAIT_V(n) asm volatile("s_waitcnt vmcnt(" #n ")" ::: "memory")
#define PG8_WAIT_L(n) asm volatile("s_waitcnt lgkmcnt(" #n ")" ::: "memory")
#define PG8_BAR __builtin_amdgcn_s_barrier()
#define PG8_SCHED __builtin_amdgcn_sched_barrier(0)
#define PG8_APTR(u) ((const char*)g.A + ((size_t)(u).g * g.gsA + (size_t)(u).pm * BM * g.lda) * 2)
#define PG8_BPTR(u) ((const char*)g.Bt + ((size_t)(u).g * g.gsB + (size_t)(u).pn * BM * g.ldb) * 2)
    Unit cur, nxt; int ui = 0;
    if (!S.next(0, cur)) return;
    f32x4 acc[2][2][4][2];
#pragma unroll
    for (int a = 0; a < 2; ++a)
#pragma unroll
        for (int b = 0; b < 2; ++b)
#pragma unroll
            for (int m = 0; m < 4; ++m)
#pragma unroll
                for (int n = 0; n < 2; ++n) acc[a][b][m][n] = (f32x4){0.f, 0.f, 0.f, 0.f};
    bf16x8 At[4][2], B0[2][2], B1[2][2];
    const char* cA = PG8_APTR(cur); const char* cB = PG8_BPTR(cur);
    PG8_STAGE(PG8_SB(0, 0), cB, voffB); PG8_STAGE(PG8_SB(0, 1), cB + hstepB, voffB); PG8_STAGE(PG8_SA(0, 0), cA, voffA); PG8_STAGE(PG8_SA(0, 1), cA + hstepA, voffA);
    if (wr == 1) PG8_BAR;
    PG8_WAIT_V(2); PG8_BAR;
    PG8_STAGE(PG8_SB(1, 0), cB + kstep, voffB); PG8_STAGE(PG8_SA(1, 0), cA + kstep, voffA); PG8_STAGE(PG8_SB(1, 1), cB + hstepB + kstep, voffB);
    PG8_WAIT_V(6); PG8_BAR;
    for (;;) {
        const bool has_next = S.next(ui + 1, nxt);
        const char* nA = has_next ? PG8_APTR(nxt) : cA; const char* nB = has_next ? PG8_BPTR(nxt) : cB;
        for (int t = 0; t < nt; t += 2) {
            const bool last = (t == nt - 2);
            const char* a1 = cA + (size_t)(t + 1) * kstep;
            const char* a2 = last ? nA : cA + (size_t)(t + 2) * kstep; const char* b2 = last ? nB : cB + (size_t)(t + 2) * kstep;
            const char* a3 = a2 + kstep; const char* b3 = b2 + kstep;
            PG8_LDB(B0, 0, 0); PG8_LDB(B1, 0, 1); PG8_SCHED; PG8_LDA(At, 0, 0); PG8_STAGE(PG8_SA(1, 1), a1 + hstepA, voffA);
            PG8_WAIT_V(8); PG8_WAIT_L(0); PG8_BAR; PG8_MMA(0, 0, At, B0); PG8_MMA(0, 1, At, B1); PG8_BAR; PG8_SCHED;
            PG8_LDA(At, 0, 1); PG8_STAGE(PG8_SB(0, 0), b2, voffB); PG8_STAGE(PG8_SB(0, 1), b2 + hstepB, voffB); PG8_STAGE(PG8_SA(0, 0), a2, voffA);
            PG8_WAIT_V(8); PG8_WAIT_L(0); PG8_BAR; PG8_MMA(1, 0, At, B0); PG8_MMA(1, 1, At, B1); PG8_BAR; PG8_SCHED;
            PG8_LDB(B0, 1, 0); PG8_LDB(B1, 1, 1); PG8_SCHED; PG8_LDA(At, 1, 0); PG8_STAGE(PG8_SA(0, 1), a2 + hstepA, voffA);
            PG8_WAIT_V(8); PG8_WAIT_L(0); PG8_BAR; PG8_MMA(0, 0, At, B0); PG8_MMA(0, 1, At, B1); PG8_BAR; PG8_SCHED;
            PG8_LDA(At, 1, 1); PG8_STAGE(PG8_SB(1, 0), b3, voffB); PG8_STAGE(PG8_SB(1, 1), b3 + hstepB, voffB); PG8_STAGE(PG8_SA(1, 0), a3, voffA);
            PG8_WAIT_V(8); PG8_WAIT_L(0); PG8_BAR; PG8_MMA(1, 0, At, B0); PG8_MMA(1, 1, At, B1); PG8_BAR; PG8_SCHED;
        }
        if (wr == 0) PG8_BAR;
        { unsigned z_ = 0u; asm volatile("" : "+v"(z_)); const int l2 = (int)__builtin_amdgcn_mbcnt_hi(~0u, __builtin_amdgcn_mbcnt_lo(~0u, z_));
          E(acc, cur, wr, wc, l2 & 15, l2 >> 4);
          E.done(cur, l2); }
        if (!has_next) break;
#pragma unroll
        for (int a = 0; a < 2; ++a)
#pragma unroll
            for (int b = 0; b < 2; ++b)
#pragma unroll
                for (int m = 0; m < 4; ++m)
#pragma unroll
                    for (int n = 0; n < 2; ++n) acc[a][b][m][n] = (f32x4){0.f, 0.f, 0.f, 0.f};
        cur = nxt; cA = nA; cB = nB; ++ui;
        if (wr == 1) PG8_BAR;
    }
    PG8_WAIT_V(0);
    PG8_BAR;
#undef PG8_SA
#undef PG8_SB
#undef PG8_STAGE
#undef PG8_LDA
#undef PG8_LDB
#undef PG8_MMA
#undef PG8_WAIT_V
#undef PG8_WAIT_L
#undef PG8_BAR
#undef PG8_SCHED
#undef PG8_APTR
#undef PG8_BPTR
}
__device__ __forceinline__ int cond_of_pm(int pm) { return pm < 16 ? 0 : 1 + ((pm - 16) >> 2); }
__device__ __forceinline__ int kvrow_of(int row) { return row < MC ? row : MC + ((row - MC) >> 10) * (PAST + DSEQ) + PAST + ((row - MC) & 1023); }
__device__ __forceinline__ u32x4 pack8(const f32x4& a, const f32x4& b) { u32x4 w; w.x = cvt_pk_bf16(a[0], a[1]); w.y = cvt_pk_bf16(a[2], a[3]); w.z = cvt_pk_bf16(b[0], b[1]); w.w = cvt_pk_bf16(b[2], b[3]); return w; }

struct EpiIn {
    static constexpr bool PERM = true;
    const float* sumsq; const float* bias; const float* qn; const float* kn; const f32x2* rope;
    bf16_t* Q; bf16_t* KB; bf16_t* VB; __amdgpu_buffer_rsrc_t as3r; float* new_k; float* new_v; int l; unsigned* ucnt;
    __device__ __forceinline__ void done(const Unit& u, int lane) const {
        if (u.pn >= 6) { asm volatile("s_waitcnt vmcnt(0)" ::: "memory"); if (lane == 0) __hip_atomic_fetch_add(ucnt + (((u.pm >> 4) * 2) + (u.pn - 6)) * 64, 1u, RLX_AGENT); } }
    __device__ __forceinline__ void operator()(const f32x4 (&acc)[2][2][4][2], const Unit& u, int wr, int wc, int fr, int fq) const {
        const int pm = u.pm, pn = u.pn; const bool ctx = pm < 16; const int cond = cond_of_pm(pm);
        const float* bz = bias + cond * 2048 + pn * 256 + wc * 32 + 8 * fq;
        f32x4 bv[2][2];
#pragma unroll
        for (int bj = 0; bj < 2; ++bj)
#pragma unroll
            for (int n = 0; n < 2; ++n) bv[bj][n] = *(const f32x4*)(bz + bj * 128 + 4 * n);
        const int rbase = pm * BM + wr * 64 + fr;
        if (pn < 4) {
            const bool isq = pn < 2; const float* gv = isq ? qn : kn;
            const int G = (pn & 1) * 4 + wc;
            const int cb = 32 * (fq >> 1) + 8 * (fq & 1);
            f32x4 gg[2][2];
#pragma unroll
            for (int bj = 0; bj < 2; ++bj)
#pragma unroll
                for (int n = 0; n < 2; ++n) gg[bj][n] = *(const f32x4*)(gv + cb + 16 * bj + 4 * n);
            const float qs = isq ? C2 : 1.f;
#pragma unroll
            for (int ai = 0; ai < 2; ++ai)
#pragma unroll
                for (int m = 0; m < 4; ++m) {
                    const int row = rbase + ai * HALF + m * 16;
                    const float rstd = rsqrtf(sumsq[row] * (1.f / DM) + EPS);
                    f32x4 v[2][2]; float ss = 0.f;
#pragma unroll
                    for (int bj = 0; bj < 2; ++bj)
#pragma unroll
                        for (int n = 0; n < 2; ++n) { v[bj][n] = acc[ai][bj][m][n] * rstd + bv[bj][n]; const f32x4 t = v[bj][n] * v[bj][n]; ss += (t[0] + t[1]) + (t[2] + t[3]); }
                    { const int ln_ = fq * 16 + fr; ss += shfl_xor_l(ss, 16, ln_); ss += shfl_xor_l(ss, 32, ln_); }
                    const float rn = rsqrtf(ss * (1.f / 64.f) + EPS);
#pragma unroll
                    for (int bj = 0; bj < 2; ++bj)
#pragma unroll
                        for (int n = 0; n < 2; ++n) v[bj][n] = v[bj][n] * rn * gg[bj][n];
                    if (ctx) {
                        if (!isq) { float* nk = new_k + ((size_t)((row >> 8) * DEPTH + l) * SEQ + (row & 255)) * 512 + G * 64 + cb;
#pragma unroll
                            for (int bj = 0; bj < 2; ++bj) { *(f32x4*)(nk + 16 * bj) = v[bj][0]; *(f32x4*)(nk + 16 * bj + 4) = v[bj][1]; } }
                    } else {
                        const int t = (row - MC) & 1023; const int pos = (fq >> 1) ? (t & 63) : (t >> 6);
                        const f32x2* rp = rope + pos * 16 + 8 * (fq & 1);
#pragma unroll
                        for (int n = 0; n < 2; ++n)
#pragma unroll
                            for (int j = 0; j < 4; ++j) { const f32x2 cs = rp[4 * n + j]; const float x1 = v[0][n][j], x2 = v[1][n][j]; v[0][n][j] = x1 * cs.x - x2 * cs.y; v[1][n][j] = x1 * cs.y + x2 * cs.x; }
                    }
                    bf16_t* dst = isq ? (Q + (size_t)row * 512) : (KB + (size_t)kvrow_of(row) * 512);
                    dst += G * 64 + cb;
#pragma unroll
                    for (int bj = 0; bj < 2; ++bj) *(u32x4*)(dst + 16 * bj) = pack8(v[bj][0] * qs, v[bj][1] * qs);
                }
        } else if (pn < 6) {
            const int col0 = (pn - 4) * 256 + wc * 32 + 8 * fq;
#pragma unroll
            for (int ai = 0; ai < 2; ++ai)
#pragma unroll
                for (int m = 0; m < 4; ++m) {
                    const int row = rbase + ai * HALF + m * 16;
                    const float rstd = rsqrtf(sumsq[row] * (1.f / DM) + EPS);
                    bf16_t* dst = VB + (size_t)kvrow_of(row) * 512 + col0;
#pragma unroll
                    for (int bj = 0; bj < 2; ++bj) { const f32x4 a = acc[ai][bj][m][0] * rstd + bv[bj][0], b = acc[ai][bj][m][1] * rstd + bv[bj][1];
                        *(u32x4*)(dst + 128 * bj) = pack8(a, b);
                        if (ctx) { float* nv = new_v + ((size_t)((row >> 8) * DEPTH + l) * SEQ + (row & 255)) * 512 + col0 + 128 * bj; *(f32x4*)nv = a; *(f32x4*)(nv + 4) = b; } }
                }
        } else {
            const int cu0 = (pn - 6) * 256 + wc * 32 + 8 * fq;
#pragma unroll
            for (int ai = 0; ai < 2; ++ai)
#pragma unroll
                for (int m = 0; m < 4; ++m) {
                    const int row = rbase + ai * HALF + m * 16;
                    const float rstd = rsqrtf(sumsq[row] * (1.f / DM) + EPS);
#pragma unroll
                    for (int bj = 0; bj < 2; ++bj) { const int cu = cu0 + 128 * bj; const f32x4 a = acc[ai][bj][m][0] * rstd + bv[bj][0], b = acc[ai][bj][m][1] * rstd + bv[bj][1];
                        __builtin_amdgcn_raw_buffer_store_b128(pack8(a, b), as3r, (int)(((unsigned)((cu >> 4) * NCHUNK + (row >> 4)) * 512u + (row & 15) * 16 + (cu & 15)) * 2u), 0,   16); }
                }
        }
    }
};
struct EpiS1 {
    static constexpr bool PERM = false;
    float* E;
    __device__ __forceinline__ void done(const Unit&, int) const {}
    __device__ __forceinline__ void operator()(const f32x4 (&acc)[2][2][4][2], const Unit& u, int wr, int wc, int fr, int fq) const {
        const int rbase = u.pm * BM + wr * 64 + fr, col0 = wc * 32 + 4 * fq;
#pragma unroll
        for (int ai = 0; ai < 2; ++ai)
#pragma unroll
            for (int m = 0; m < 4; ++m) { float* dst = E + ((size_t)u.g * NCHUNK + rbase + ai * HALF + m * 16) * 256 + col0;
#pragma unroll
                for (int bj = 0; bj < 2; ++bj)
#pragma unroll
                    for (int n = 0; n < 2; ++n) *(f32x4*)(dst + bj * HALF + n * 16) = acc[ai][bj][m][n]; }
    }
};
struct EpiS3 {
    static constexpr bool PERM = true;
    __amdgpu_buffer_rsrc_t zr;
    __device__ __forceinline__ void done(const Unit&, int) const {}
    __device__ __forceinline__ void operator()(const f32x4 (&acc)[2][2][4][2], const Unit& u, int wr, int wc, int fr, int fq) const {
        const int rbase = u.pm * BM + wr * 64 + fr;
#pragma unroll
        for (int ai = 0; ai < 2; ++ai)
#pragma unroll
            for (int m = 0; m < 4; ++m) { const int chunk = rbase + ai * HALF + m * 16;
#pragma unroll
                for (int bj = 0; bj < 2; ++bj) { const int tt = 8 * bj + 2 * wc + (fq >> 1), c0 = 8 * (fq & 1);
                    f32x4 a = acc[ai][bj][m][0], b = acc[ai][bj][m][1];
#pragma unroll
                    for (int j = 0; j < 4; ++j) { a[j] = gelu_tanh_f(a[j]); b[j] = gelu_tanh_f(b[j]); }
                    __builtin_amdgcn_raw_buffer_store_b128(pack8(a, b), zr, (int)((((unsigned)chunk * 16u + tt) * 512u + u.g * 16 + c0) * 2u), 0,   16); } }
    }
};
struct EpiGlu {
    static constexpr bool PERM = true;
    const bf16_t* Z; const float* bg; bf16_t* CAT;
    __device__ __forceinline__ void done(const Unit&, int) const {}
    __device__ __forceinline__ void operator()(const f32x4 (&acc)[2][2][4][2], const Unit& u, int wr, int wc, int fr, int fq) const {
        const int rbase = u.pm * BM + wr * 64 + fr, col0 = u.pn * BM + wc * 32 + 8 * fq;
        f32x4 bv[2][2];
#pragma unroll
        for (int bj = 0; bj < 2; ++bj)
#pragma unroll
            for (int n = 0; n < 2; ++n) bv[bj][n] = *(const f32x4*)(bg + col0 + bj * HALF + 4 * n);
#pragma unroll
        for (int ai = 0; ai < 2; ++ai)
#pragma unroll
            for (int m = 0; m < 4; ++m) { const int row = rbase + ai * HALF + m * 16;
#pragma unroll
                for (int bj = 0; bj < 2; ++bj) { const u32x4 zw = *(const u32x4*)(Z + (size_t)row * 512 + col0 + bj * HALF);
                    f32x4 a = acc[ai][bj][m][0] + bv[bj][0], b = acc[ai][bj][m][1] + bv[bj][1];
                    a[0] = bflo(zw.x) * sigmoid_f(a[0]); a[1] = bfhi(zw.x) * sigmoid_f(a[1]); a[2] = bflo(zw.y) * sigmoid_f(a[2]); a[3] = bfhi(zw.y) * sigmoid_f(a[3]);
                    b[0] = bflo(zw.z) * sigmoid_f(b[0]); b[1] = bfhi(zw.z) * sigmoid_f(b[1]); b[2] = bflo(zw.w) * sigmoid_f(b[2]); b[3] = bfhi(zw.w) * sigmoid_f(b[3]);
                    *(u32x4*)(CAT + (size_t)row * 1024 + 512 + col0 + bj * HALF) = pack8(a, b); } }
    }
};
template <bool IN_F32, bool OUT_F32> struct EpiRes {
    static constexpr bool PERM = true;
    const float* xin0; const float* xin1;
    const bf16_t* xrin;
    float* xout; bf16_t* xrout;
    const float* gate;
    const float* gn; const float* sc;
    bf16_t* XS; float* ssq;
    __device__ __forceinline__ void done(const Unit&, int) const {}
    __device__ __forceinline__ void operator()(const f32x4 (&acc)[2][2][4][2], const Unit& u, int wr, int wc, int fr, int fq) const {
        const int pm = u.pm, cond = cond_of_pm(pm); const int col0 = u.pn * BM + wc * 32 + 8 * fq; const int rbase = pm * BM + wr * 64 + fr;
        const bool donorm = (gn != nullptr);
        f32x4 gt[2][2], gs[2][2];
#pragma unroll
        for (int bj = 0; bj < 2; ++bj)
#pragma unroll
            for (int n = 0; n < 2; ++n) { const int c = col0 + bj * HALF + n * 4; gt[bj][n] = *(const f32x4*)(gate + cond * 6144 + c);
                if (donorm) { const f32x4 g4 = *(const f32x4*)(gn + c), s4 = *(const f32x4*)(sc + cond * 6144 + c); gs[bj][n] = g4 * (s4 + 1.f); } else gs[bj][n] = (f32x4){0.f, 0.f, 0.f, 0.f}; }
        constexpr int RD = IN_F32 ? 2 : 3;
        f32x4 xr[RD][2][2]; u32x4 xb[RD][2];
#define ER_LOAD(G_, SLOT_) do { const int row_ = rbase + ((G_) >> 2) * HALF + ((G_) & 3) * 16; \
            if (IN_F32) { const float* xi_ = (row_ < MC) ? (xin0 + (size_t)row_ * DM) : (xin1 + (size_t)(row_ - MC) * DM); \
                _Pragma("unroll") for (int bj = 0; bj < 2; ++bj) { xr[SLOT_][bj][0] = *(const f32x4*)(xi_ + col0 + bj * HALF); xr[SLOT_][bj][1] = *(const f32x4*)(xi_ + col0 + bj * HALF + 4); } } \
            else { _Pragma("unroll") for (int bj = 0; bj < 2; ++bj) xb[SLOT_][bj] = *(const u32x4*)(xrin + (size_t)row_ * DM + col0 + bj * HALF); } } while (0)
        ER_LOAD(0, 0); ER_LOAD(1, 1); if (RD == 3) ER_LOAD(2, RD - 1);
#pragma unroll
        for (int g = 0; g < 8; ++g) { const int ai = g >> 2, m = g & 3, sl = g % RD; const int row = rbase + ai * HALF + m * 16;
            float ss = 0.f; f32x4 x0[2], x1[2];
#pragma unroll
            for (int bj = 0; bj < 2; ++bj) { f32x4 a, b;
                if (IN_F32) { a = xr[sl][bj][0]; b = xr[sl][bj][1]; } else { const u32x4 w = xb[sl][bj]; a = (f32x4){bflo(w.x), bfhi(w.x), bflo(w.y), bfhi(w.y)}; b = (f32x4){bflo(w.z), bfhi(w.z), bflo(w.w), bfhi(w.w)}; }
                x0[bj] = a + gt[bj][0] * acc[ai][bj][m][0]; x1[bj] = b + gt[bj][1] * acc[ai][bj][m][1]; }
            if (g + RD < 8) ER_LOAD(g + RD, sl);
#pragma unroll
            for (int bj = 0; bj < 2; ++bj) { const int c = col0 + bj * HALF;
                if (OUT_F32) { *(f32x4*)(xout + (size_t)row * DM + c) = x0[bj]; *(f32x4*)(xout + (size_t)row * DM + c + 4) = x1[bj]; }
                else *(u32x4*)(xrout + (size_t)row * DM + c) = pack8(x0[bj], x1[bj]);
                if (donorm) { const f32x4 t0 = x0[bj] * x0[bj], t1 = x1[bj] * x1[bj]; ss += ((t0[0] + t0[1]) + (t0[2] + t0[3])) + ((t1[0] + t1[1]) + (t1[2] + t1[3]));
                    *(u32x4*)(XS + (size_t)row * DM + c) = pack8(x0[bj] * gs[bj][0], x1[bj] * gs[bj][1]); } }
            if (donorm) { { const int ln_ = fq * 16 + fr; ss += shfl_xor_l(ss, 16, ln_); ss += shfl_xor_l(ss, 32, ln_); } if (fq == 0) atomicAdd(ssq + row, ss); }
        }
#undef ER_LOAD
    }
};
struct EpiUp {
    static constexpr bool PERM = true;
    const float* sumsq; const float* bias; bf16_t* UP;
    __device__ __forceinline__ void done(const Unit&, int) const {}
    __device__ __forceinline__ void operator()(const f32x4 (&acc)[2][2][4][2], const Unit& u, int wr, int wc, int fr, int fq) const {
        const int pm = u.pm, cond = cond_of_pm(pm); const int col0 = u.pn * BM + wc * 32 + 8 * fq; const int rbase = pm * BM + wr * 64 + fr;
        f32x4 bv[2][2];
#pragma unroll
        for (int bj = 0; bj < 2; ++bj)
#pragma unroll
            for (int n = 0; n < 2; ++n) bv[bj][n] = *(const f32x4*)(bias + cond * 4096 + col0 + bj * HALF + 4 * n);
#pragma unroll
        for (int ai = 0; ai < 2; ++ai)
#pragma unroll
            for (int m = 0; m < 4; ++m) { const int row = rbase + ai * HALF + m * 16; const float rstd = rsqrtf(sumsq[row] * (1.f / DM) + EPS);
#pragma unroll
                for (int bj = 0; bj < 2; ++bj) *(u32x4*)(UP + (size_t)row * 4096 + col0 + bj * HALF) = pack8(acc[ai][bj][m][0] * rstd + bv[bj][0], acc[ai][bj][m][1] * rstd + bv[bj][1]); }
    }
};

__device__ __forceinline__ float dpp_shr1(float v) { return __uint_as_float((unsigned)__builtin_amdgcn_update_dpp(0, (int)__float_as_uint(v), 0x111, 0xf, 0xf, false)); }
__device__ __forceinline__ float dpp_shl1(float v) { return __uint_as_float((unsigned)__builtin_amdgcn_update_dpp(0, (int)__float_as_uint(v), 0x101, 0xf, 0xf, false)); }
struct EpiUpConv {
    static constexpr bool PERM = true;
    const float* sumsq; const float* bias; const float* cw; const float* cb; bf16_t* G; bf16_t* HALO;
    __device__ __forceinline__ void done(const Unit&, int) const {}
    __device__ __forceinline__ void operator()(const f32x4 (&acc)[2][2][4][2], const Unit& u, int wr, int wc, int fr, int fq) const {
        const int pm = u.pm, pn = u.pn, cond = cond_of_pm(pm);
        const int posv = pn * 256 + wc * 32 + 8 * fq, av = pn * 128 + wc * 32 + 8 * fq;
#pragma unroll
        for (int ai = 0; ai < 2; ++ai) {
            const int tok0 = pm * BM + ai * HALF + wr * 64 + 4 * fr; const int sl = pm * 4 + ai * 2 + wr;
            float rs[4];
#pragma unroll
            for (int m = 0; m < 4; ++m) rs[m] = rsqrtf(sumsq[tok0 + m] * (1.f / DM) + EPS);
#pragma unroll
            for (int n = 0; n < 2; ++n) {
                const f32x4 bvv = *(const f32x4*)(bias + cond * 4096 + posv + 4 * n), bvg = *(const f32x4*)(bias + cond * 4096 + posv + 128 + 4 * n);
                f32x4 pv[4], pg[4];
#pragma unroll
                for (int m = 0; m < 4; ++m) { pv[m] = acc[ai][0][m][n] * rs[m] + bvv; pg[m] = acc[ai][1][m][n] * rs[m] + bvg; }
                f32x4 pvp, pvn, pgp, pgn;
#pragma unroll
                for (int j = 0; j < 4; ++j) { pvp[j] = dpp_shr1(pv[3][j]); pvn[j] = dpp_shl1(pv[0][j]); pgp[j] = dpp_shr1(pg[3][j]); pgn[j] = dpp_shl1(pg[0][j]); }
                const int c = av + 4 * n;
                const f32x4 w0v = *(const f32x4*)(cw + c), w1v = *(const f32x4*)(cw + 4096 + c), w2v = *(const f32x4*)(cw + 8192 + c), cbv = *(const f32x4*)(cb + c);
                const f32x4 w0g = *(const f32x4*)(cw + 2048 + c), w1g = *(const f32x4*)(cw + 4096 + 2048 + c), w2g = *(const f32x4*)(cw + 8192 + 2048 + c), cbg = *(const f32x4*)(cb + 2048 + c);
#pragma unroll
                for (int m = 0; m < 4; ++m) {
                    const f32x4 zv = cbv + w0v * (m == 0 ? pvp : pv[m == 0 ? 0 : m - 1]) + w1v * pv[m] + w2v * (m == 3 ? pvn : pv[m == 3 ? 3 : m + 1]);
                    const f32x4 zg = cbg + w0g * (m == 0 ? pgp : pg[m == 0 ? 0 : m - 1]) + w1g * pg[m] + w2g * (m == 3 ? pgn : pg[m == 3 ? 3 : m + 1]);
                    u32x2 w; w.x = cvt_pk_bf16(silu_f(zg[0]) * zv[0], silu_f(zg[1]) * zv[1]); w.y = cvt_pk_bf16(silu_f(zg[2]) * zv[2], silu_f(zg[3]) * zv[3]);
                    *(u32x2*)(G + (size_t)(tok0 + m) * 2048 + c) = w; }
                if (fr == 0 || fr == 15) { const int m0 = fr == 0 ? 0 : 2;
#pragma unroll
                    for (int mm = 0; mm < 2; ++mm) { const f32x4 a = fr == 0 ? pv[mm] : pv[2 + mm], b = fr == 0 ? pg[mm] : pg[2 + mm];
                        bf16_t* hp = HALO + ((size_t)sl * 4 + m0 + mm) * 4096 + posv + 4 * n;
                        u32x2 wa; wa.x = cvt_pk_bf16(a[0], a[1]); wa.y = cvt_pk_bf16(a[2], a[3]); *(u32x2*)hp = wa;
                        u32x2 wb; wb.x = cvt_pk_bf16(b[0], b[1]); wb.y = cvt_pk_bf16(b[2], b[3]); *(u32x2*)(hp + 128) = wb; } }
            }
        }
    }
};
constexpr int AT_SLOT = 32768, AT_NSLOT = 4, AT_VOFF = 16384, AT_X = 0, AT_ST = 65536;
__device__ __forceinline__ void glds16(const void* gsrc, unsigned lds_dst) { unsigned keep;
    asm volatile("s_mov_b32 %0, m0\n\ts_mov_b32 m0, %2\n\ts_nop 0\n\tglobal_load_lds_dwordx4 %1, off\n\ts_mov_b32 m0, %0" : "=&s"(keep) : "v"(gsrc), "s"(lds_dst) : "memory"); }
#define AT_WAIT_BAR(N) asm volatile("s_waitcnt vmcnt(" #N ") lgkmcnt(0)\n\ts_barrier" ::: "memory")
#define AT_SB() __builtin_amdgcn_sched_barrier(0)
__device__ __forceinline__ s16x4 vtr(const LAS char* p) { typedef short v4i16_t __attribute__((ext_vector_type(4))); return __builtin_bit_cast(s16x4, __builtin_amdgcn_ds_read_tr16_b64_v4i16((LAS v4i16_t*)p)); }
__device__ __forceinline__ int crow(int r, int hi) { return (r & 3) + 8 * (r >> 2) + 4 * hi; }

struct AttnArgs { const bf16_t* Q; const bf16_t* KB; const bf16_t* VB; bf16_t* CAT; const float* subln; float lam; float oml; };

__device__ __forceinline__ void attn_unit(LAS unsigned char* lds, const int tid, const AttnArgs& A, int seq, int h, int qblk) {
    const int lane = tid & 63, r32 = lane & 31, hi = lane >> 5; const int wid = __builtin_amdgcn_readfirstlane(tid >> 6);
    const int rg = wid & 3, s = wid >> 2;
    const bool ctx = seq < NB;
    const int qrow0 = ctx ? seq * SEQ + qblk * 128 : MC + (seq - NB) * DSEQ + qblk * 128;
    const int krow0 = ctx ? seq * SEQ : MC + (seq - NB) * (PAST + DSEQ);
    const int NT = ctx ? SEQ / 64 : (PAST + DSEQ) / 64;
    const unsigned lds0 = (unsigned)(uintptr_t)lds;
    const bf16_t* ksrc0 = A.KB + (size_t)(krow0 + lane) * 512 + h * 128 + wid * 8;
    const bf16_t* vsrc0 = A.VB + (size_t)(krow0 + 16 * (wid & 3) + (lane >> 2)) * 512 + h * 128 + (wid >> 2) * 32 + (lane & 3) * 8;
    const unsigned kdst = lds0 + wid * 1024, vdst = lds0 + AT_VOFF + ((wid >> 2) * 4 + (wid & 3)) * 1024;
#define AT_DMA(t, slot) do { const size_t _o = (size_t)(t) * 64 * 512; const unsigned _s = (unsigned)(slot) * AT_SLOT; \
        glds16(ksrc0 + _o, (unsigned)__builtin_amdgcn_readfirstlane(kdst + _s)); glds16(ksrc0 + _o + 64, (unsigned)__builtin_amdgcn_readfirstlane(kdst + _s + 8 * 1024)); \
        glds16(vsrc0 + _o, (unsigned)__builtin_amdgcn_readfirstlane(vdst + _s)); glds16(vsrc0 + _o + 64, (unsigned)__builtin_amdgcn_readfirstlane(vdst + _s + 8 * 1024)); } while (0)
    AT_DMA(0, 0); AT_DMA(1, 1); AT_DMA(2, 2);
    bf16x8 qr[4];
    { const bf16_t* qp = A.Q + (size_t)(qrow0 + rg * 32 + r32) * 512 + h * 128 + s * 64 + hi * 8;
#pragma unroll
      for (int d0 = 0; d0 < 4; ++d0) qr[d0] = *(const bf16x8*)(qp + d0 * 16); }
    f32x16 o[4];
#pragma unroll
    for (int d0 = 0; d0 < 4; ++d0)
#pragma unroll
        for (int r = 0; r < 16; ++r) o[d0][r] = 0.f;
    float lsum = 0.f;
    const LAS char* kfrag0 = (const LAS char*)lds + (s * 8 + hi) * 1024 + r32 * 16;
    const LAS char* vfrag0 = (const LAS char*)lds + AT_VOFF + ((lane >> 4) & 1) * 32 + (lane & 3) * 8 + (4 * hi + ((lane & 15) >> 2)) * 64;
    f32x16 pc0, pc1;
#define AT_KLOAD(kfr, slot) do { const LAS char* _k = kfrag0 + (slot) * AT_SLOT; _Pragma("unroll") for (int d0 = 0; d0 < 4; ++d0) { kfr[2 * d0] = *(const LAS bf16x8*)(_k + d0 * 2048); kfr[2 * d0 + 1] = *(const LAS bf16x8*)(_k + d0 * 2048 + 512); } } while (0)
#define AT_VLOAD(vv, slot, ks) do { const LAS char* _v = vfrag0 + (slot) * AT_SLOT + (ks) * 1024; _Pragma("unroll") for (int d0 = 0; d0 < 4; ++d0) { const s16x4 lo = vtr(_v + d0 * 4096), hh = vtr(_v + d0 * 4096 + 512); \
        vv[d0] = (bf16x8){lo[0], lo[1], lo[2], lo[3], hh[0], hh[1], hh[2], hh[3]}; } } while (0)
#define AT_EXP2(P, i, W) do { P[2 * (i)] = fast_exp2(P[2 * (i)]); P[2 * (i) + 1] = fast_exp2(P[2 * (i) + 1]); sacc += P[2 * (i)] + P[2 * (i) + 1]; W = cvt_pk_bf16(P[2 * (i)], P[2 * (i) + 1]); } while (0)
    AT_WAIT_BAR(8);
    { bf16x8 kfr[8]; AT_KLOAD(kfr, 0);
#pragma unroll
      for (int r = 0; r < 16; ++r) { pc0[r] = 0.f; pc1[r] = 0.f; }
#pragma unroll
      for (int d0 = 0; d0 < 4; ++d0) { pc0 = __builtin_amdgcn_mfma_f32_32x32x16_bf16(kfr[2 * d0], qr[d0], pc0, 0, 0, 0); pc1 = __builtin_amdgcn_mfma_f32_32x32x16_bf16(kfr[2 * d0 + 1], qr[d0], pc1, 0, 0, 0); } }
    int slot = 0;
    for (int t = 0; t < NT; ++t) {
        const bool has_next = t + 1 < NT;
        if (t + 2 < NT) AT_WAIT_BAR(4); else AT_WAIT_BAR(0);
        if (t + 3 < NT) AT_DMA(t + 3, (slot + 3) & 3);
        const int slot_n = (slot + 1) & 3;
        bf16x8 kfr[8], va[4], vb[4]; u32x4 pw[4]; f32x16 pn0, pn1; float sacc = 0.f;
        const LAS char* kn_ = kfrag0 + slot_n * AT_SLOT;
#define AT_K1(d0) do { kfr[2 * (d0)] = *(const LAS bf16x8*)(kn_ + (d0) * 2048); kfr[2 * (d0) + 1] = *(const LAS bf16x8*)(kn_ + (d0) * 2048 + 512); } while (0)
        if (has_next) { AT_K1(0); AT_K1(1); }
        AT_SB();
        if (has_next) {
#pragma unroll
            for (int r = 0; r < 16; ++r) { pn0[r] = 0.f; pn1[r] = 0.f; }
#pragma unroll
            for (int i = 0; i < 8; ++i) { const int d0 = i >> 1;
                if (i & 1) pn1 = __builtin_amdgcn_mfma_f32_32x32x16_bf16(kfr[2 * d0 + 1], qr[d0], pn1, 0, 0, 0); else pn0 = __builtin_amdgcn_mfma_f32_32x32x16_bf16(kfr[2 * d0], qr[d0], pn0, 0, 0, 0);
                AT_EXP2(pc0, i, pw[i >> 2][i & 3]);
                if (i == 0) AT_K1(2);
                if (i == 1) AT_K1(3);
                if (i == 3) AT_VLOAD(va, slot, 0);
                if (i == 5) AT_VLOAD(vb, slot, 1);
                AT_SB(); }
        } else {
            AT_VLOAD(va, slot, 0); AT_VLOAD(vb, slot, 1);
#pragma unroll
            for (int i = 0; i < 8; ++i) AT_EXP2(pc0, i, pw[i >> 2][i & 3]);
            AT_SB();
        }
        bf16x8 vc[4], vd[4];
#pragma unroll
        for (int i = 0; i < 8; ++i) { const int d0 = i & 3;
            if (i < 4) o[d0] = __builtin_amdgcn_mfma_f32_32x32x16_bf16(va[d0], __builtin_bit_cast(bf16x8, pw[0]), o[d0], 0, 0, 0);
            else       o[d0] = __builtin_amdgcn_mfma_f32_32x32x16_bf16(vb[d0], __builtin_bit_cast(bf16x8, pw[1]), o[d0], 0, 0, 0);
            AT_EXP2(pc1, i, pw[2 + (i >> 2)][i & 3]);
            if (i == 1) AT_VLOAD(vc, slot, 2);
            if (i == 5) AT_VLOAD(vd, slot, 3);
            AT_SB(); }
#pragma unroll
        for (int d0 = 0; d0 < 4; ++d0) o[d0] = __builtin_amdgcn_mfma_f32_32x32x16_bf16(vc[d0], __builtin_bit_cast(bf16x8, pw[2]), o[d0], 0, 0, 0);
#pragma unroll
        for (int d0 = 0; d0 < 4; ++d0) o[d0] = __builtin_amdgcn_mfma_f32_32x32x16_bf16(vd[d0], __builtin_bit_cast(bf16x8, pw[3]), o[d0], 0, 0, 0);
        lsum += sacc;
        if (has_next) { pc0 = pn0; pc1 = pn1; }
        slot = slot_n;
    }
    lsum += shfl_xor_l(lsum, 32, lane);
    const float inv = (s == 0 ? 1.f : A.lam) / lsum;
    AT_WAIT_BAR(0);
    LAS float* X = (LAS float*)(lds + AT_X) + rg * 4096;
    if (s == 1) {
#pragma unroll
        for (int d0 = 0; d0 < 4; ++d0)
#pragma unroll
            for (int r = 0; r < 16; ++r) X[(d0 * 16 + r) * 64 + lane] = o[d0][r] * inv;
    }
    AT_WAIT_BAR(0);
    if (s == 0) {
        float ss = 0.f;
#pragma unroll
        for (int d0 = 0; d0 < 4; ++d0)
#pragma unroll
            for (int r = 0; r < 16; ++r) { const float v = o[d0][r] * inv - X[(d0 * 16 + r) * 64 + lane]; o[d0][r] = v; ss += v * v; }
        ss += shfl_xor_l(ss, 32, lane);
        const float rn = rsqrtf(ss * (1.f / 128.f) + EPS) * A.oml;
        LAS bf16_t* stg = (LAS bf16_t*)(lds + AT_ST) + rg * (32 * 136);
#pragma unroll
        for (int d0 = 0; d0 < 4; ++d0)
#pragma unroll
            for (int rq = 0; rq < 4; ++rq) { const int dv = 32 * d0 + 8 * rq + 4 * hi; const f32x4 g4 = *(const f32x4*)(A.subln + dv);
                u32x2 w; w.x = cvt_pk_bf16(o[d0][4 * rq] * rn * g4[0], o[d0][4 * rq + 1] * rn * g4[1]); w.y = cvt_pk_bf16(o[d0][4 * rq + 2] * rn * g4[2], o[d0][4 * rq + 3] * rn * g4[3]);
                *(LAS u32x2*)(stg + r32 * 136 + dv) = w; }
        asm volatile("s_waitcnt lgkmcnt(0)" ::: "memory");
        bf16_t* dst = A.CAT + (size_t)(qrow0 + rg * 32) * 1024 + h * 128;
#pragma unroll
        for (int i = 0; i < 8; ++i) { const int row = i * 4 + (lane >> 4), ch = lane & 15; const u32x4 v = *(const LAS u32x4*)(stg + row * 136 + ch * 8); *(u32x4*)(dst + (size_t)row * 1024 + ch * 8) = v; }
    }
    AT_WAIT_BAR(0);
#undef AT_DMA
#undef AT_KLOAD
#undef AT_K1
#undef AT_VLOAD
#undef AT_EXP2
}
struct Args { const float* in[34]; float* out; unsigned char* ws; int stop_after; int pad; };
typedef const __attribute__((address_space(4))) Args* kargs_t;
struct Frame {
    LAS unsigned char* lds; int tid, lane, wave, vcu, bid, G;
    kargs_t ka; float* out; unsigned char* ws;
    float* misc; unsigned* ctl;
};
#define LDS_WAIT() asm volatile("s_waitcnt lgkmcnt(0)" ::: "memory")
#define VM_WAIT() asm volatile("s_waitcnt vmcnt(0)" ::: "memory")

template <int MAP> __device__ __forceinline__ int src_col(int p);
template <int MODE, int MAP, int NC> __device__ __forceinline__ void gemv9_task(Frame& F, const float* W, int ldw, int l, int voff, int strip, float* out, int ldo, const float* add) {
    LAS float* sc = (LAS float*)F.lds; LAS float* red = sc + 9 * 1024;
    for (int i = F.tid; i < 9 * 1024; i += NTHREADS) { const int cond = i >> 10, k = i & 1023; float v;
        if (MODE == 0) { v = cond == 0 ? F.ka->in[6][k] : F.ka->in[5][(cond - 1) * 1024 + k]; v = v / (1.f + expf(-v)); } else v = F.misc[MI_MOD + (l * 9 + cond) * 6144 + voff + k];
        sc[i] = v; }
    __syncthreads();
    const int j = strip * NC + (F.lane < NC ? F.lane : NC - 1); const float* w = W + (size_t)(F.wave * 128) * ldw + src_col<MAP>(j);
    float acc[9];
#pragma unroll
    for (int b = 0; b < 9; ++b) acc[b] = 0.f;
#pragma unroll 16
    for (int k = 0; k < 128; ++k) { const float wv = w[(size_t)k * ldw];
#pragma unroll
        for (int b = 0; b < 9; ++b) acc[b] += sc[b * 1024 + F.wave * 128 + k] * wv; }
#pragma unroll
    for (int b = 0; b < 9; ++b) red[(F.wave * 9 + b) * 64 + F.lane] = acc[b];
    __syncthreads();
    for (int i = F.tid; i < 9 * 64; i += NTHREADS) { const int b = i >> 6, ln = i & 63; if (ln >= NC) continue; float s_ = 0.f;
#pragma unroll
        for (int w8 = 0; w8 < 8; ++w8) s_ += red[(w8 * 9 + b) * 64 + ln];
        const int jj = strip * NC + ln; out[(size_t)b * ldo + jj] = s_ + (add ? add[jj] : 0.f); }
    __syncthreads();
}
template <int MAP> __device__ __forceinline__ int src_col(int p) {
    if (MAP == 1) { if (p >= 1024) return p; const int pn = p >> 8, r = p & 255, bj = r >> 7, wc = (r >> 5) & 3, fq = (r >> 3) & 3, low = r & 7; return 256 * pn + 64 * wc + 32 * (fq >> 1) + 16 * bj + 8 * (fq & 1) + low; }
    if (MAP == 2) { const int pn = p >> 8, bj = (p >> 7) & 1, r = p & 127; return bj * 2048 + 128 * pn + r; }
    return p;
}
template <int MAP, bool BIAS> __device__ __forceinline__ void transpose_item(Frame& F, const float* W, int K, int N, bf16_t* WT, LAS float* scr, int item, const float* shv, float* bias) {
    const int lane = F.lane; const int nblk = N / 64, kb = item / nblk, nb = item % nblk, k0 = 64 * kb, n0 = 64 * nb;
    const int sc_ = src_col<MAP>(n0 + lane);
    float tv[64];
#pragma unroll
    for (int i = 0; i < 64; ++i) tv[i] = W[(size_t)(k0 + i) * N + sc_];
#pragma unroll
    for (int i = 0; i < 64; ++i) scr[i * 65 + lane] = tv[i];
    LDS_WAIT(); asm volatile("" ::: "memory");
    const int c = lane & 7;
#pragma unroll
    for (int j = 0; j < 8; ++j) { const int n = (lane >> 3) + 8 * j; const LAS float* s_ = scr + (8 * c) * 65 + n;
        u32x4 o; o.x = cvt_pk_bf16(s_[0 * 65], s_[1 * 65]); o.y = cvt_pk_bf16(s_[2 * 65], s_[3 * 65]); o.z = cvt_pk_bf16(s_[4 * 65], s_[5 * 65]); o.w = cvt_pk_bf16(s_[6 * 65], s_[7 * 65]);
        *(u32x4*)(WT + (size_t)(n0 + n) * K + k0 + 8 * c) = o; }
    if (BIAS) {
        float sh[9], acc[9];
#pragma unroll
        for (int b = 0; b < 9; ++b) { sh[b] = shv[b * 6144 + k0 + lane]; acc[b] = 0.f; }
#pragma unroll
        for (int kk = 0; kk < 64; ++kk) { const float w = tv[kk];
#pragma unroll
            for (int b = 0; b < 9; ++b) acc[b] += __uint_as_float(__builtin_amdgcn_readlane(__float_as_uint(sh[b]), kk)) * w; }
#pragma unroll
        for (int b = 0; b < 9; ++b) atomicAdd(bias + (size_t)b * N + n0 + lane, acc[b]);
    }
    LDS_WAIT(); asm volatile("" ::: "memory");
}
__device__ __forceinline__ void cache_item(Frame& F, int l, int item4) {
    f32x4 a[4], c[4];
#pragma unroll
    for (int i = 0; i < 4; ++i) { const int item = item4 * 4 + i, which = item >> 12, r = item & 4095, b = r >> 9, j = r & 511;
        const float* src = (which ? F.ka->in[3] : F.ka->in[2]) + ((size_t)(b * DEPTH + l) * PAST + j) * 512 + F.lane * 8; a[i] = *(const f32x4*)src; c[i] = *(const f32x4*)(src + 4); }
#pragma unroll
    for (int i = 0; i < 4; ++i) { const int item = item4 * 4 + i, which = item >> 12, r = item & 4095, b = r >> 9, j = r & 511;
        bf16_t* dst = (bf16_t*)(F.ws + (which ? WS_VB : WS_KB)) + (size_t)(MC + b * (PAST + DSEQ) + j) * 512 + F.lane * 8; *(u32x4*)dst = pack8(a[i], c[i]); }
}
__device__ __forceinline__ f32x2 cmul(f32x2 a, f32x2 b) { return (f32x2){a.x * b.x - a.y * b.y, a.x * b.y + a.y * b.x}; }
__device__ __forceinline__ void ssm_prep(Frame& F, int l, int task) {
    const int g = task >> 1, half = task & 1;
    LAS f32x2* POW = (LAS f32x2*)F.lds;
    LAS f32x2* BB = POW + 2 * 17 * 64;
    LAS f32x2* CC = BB + 2 * 64 * 16;
    LAS f32x2* CT = CC + 2 * 16 * 64;
    LAS float* KT = (LAS float*)(CT + 2 * 64 * 16);
    constexpr int KTS = 260;
    bf16_t* WE = (bf16_t*)(F.ws + WS_SSM + SSM_WE) + (size_t)g * 256 * 256;
    bf16_t* WY = (bf16_t*)(F.ws + WS_SSM + SSM_WY) + (size_t)g * 256 * 512;
    f32x2* LAM16 = (f32x2*)(F.ws + WS_SSM + SSM_LAM16); f32x2* BBAR = (f32x2*)(F.ws + WS_SSM + SSM_BBAR);
    const int tid = F.tid, lane = F.lane;
    if (tid < 128) { const int dir = tid >> 6, p = tid & 63; const size_t pi = ((size_t)(l * 2 + dir) * NG + g) * 64 + p;
        const float lr = F.ka->in[18][pi], li = F.ka->in[19][pi], delta = expf(F.ka->in[20][(l * 2 + dir) * NG + g]);
        const float er = expf(lr * delta), lbr = er * cosf(li * delta), lbi = er * sinf(li * delta);
        { float one_ = 1.f, zero_ = 0.f; asm volatile("" : "+v"(one_), "+v"(zero_));
          f32x2 pw = (f32x2){one_, zero_}; const f32x2 lb = (f32x2){lbr, lbi};
          for (int tau = 0; tau <= 16; ++tau) { POW[(dir * 17 + tau) * 64 + p] = pw; if (tau == 16 && half == 0) LAM16[(dir * NG + g) * 64 + p] = pw; pw = cmul(pw, lb); } }
        const float nr = lbr - 1.f, ni = lbi, den = lr * lr + li * li; const f32x2 fac = (f32x2){(nr * lr + ni * li) / den, (ni * lr - nr * li) / den};
        f32x4 br[4], bi4[4];
#pragma unroll
        for (int q = 0; q < 4; ++q) { br[q] = *(const f32x4*)(F.ka->in[21] + pi * 16 + 4 * q); bi4[q] = *(const f32x4*)(F.ka->in[22] + pi * 16 + 4 * q); }
#pragma unroll
        for (int ch = 0; ch < 16; ++ch) { const f32x2 bb = cmul(fac, (f32x2){br[ch >> 2][ch & 3], bi4[ch >> 2][ch & 3]}); BB[(dir * 64 + p) * 16 + ch] = bb; if (half == 0) BBAR[((size_t)(dir * NG + g) * 64 + p) * 16 + ch] = bb; }
    }
    { f32x2 cv[4];
#pragma unroll
      for (int q = 0; q < 4; ++q) { const int i = tid + q * NTHREADS, dir = i >> 10, c = (i >> 6) & 15, p = i & 63; const size_t ci = (((size_t)(l * 2 + dir) * NG + g) * 16 + c) * 64 + p; cv[q] = (f32x2){F.ka->in[23][ci], F.ka->in[24][ci]}; }
#pragma unroll
      for (int q = 0; q < 4; ++q) { const int i = tid + q * NTHREADS, dir = i >> 10, c = (i >> 6) & 15, p = i & 63; CC[i] = cv[q]; CT[(dir * 64 + p) * 16 + c] = cv[q]; } }
    __syncthreads();
    { const int i16 = lane & 15, k4 = lane >> 4, ri = k4 & 1, ph = k4 >> 1;
      for (int blk = 0; blk < 4; ++blk) { const int q = F.wave * 4 + blk, dir = q >> 4, tau = q & 15; f32x4 acc = (f32x4){0.f, 0.f, 0.f, 0.f};
#pragma unroll 8
          for (int ks = 0; ks < 32; ++ks) { const int p = 2 * ks + ph;
              const f32x2 cc = CT[(dir * 64 + p) * 16 + i16], pw = POW[(dir * 17 + tau) * 64 + p], bb = BB[(dir * 64 + p) * 16 + i16];
              const float u = ri ? -pw.y : pw.x, v = ri ? pw.x : pw.y;
              const float av = cc.x * u - cc.y * v, bv = ri ? bb.y : bb.x;
              acc = __builtin_amdgcn_mfma_f32_16x16x4f32(av, bv, acc, 0, 0, 0); }
#pragma unroll
          for (int r = 0; r < 4; ++r) KT[(dir * 16 + tau) * KTS + (k4 * 4 + r) * 16 + i16] = acc[r]; } }
    __syncthreads();
    const float* Dv = F.ka->in[25] + l * 512 + g * 16;
    for (int idx = half * 8192 + tid; idx < (half + 1) * 8192; idx += NTHREADS) { const int n = idx >> 6, kc = idx & 63, k0 = kc * 8, i = n >> 4, c = n & 15; f32x4 v0, v1;
        if (k0 < 256) { const int s_ = k0 >> 4, ch0 = k0 & 15; v0 = (f32x4){0.f, 0.f, 0.f, 0.f}; v1 = v0;
            if (s_ <= i) { const LAS float* kp = KT + (i - s_) * KTS + c * 16 + ch0; v0 += *(const LAS f32x4*)kp; v1 += *(const LAS f32x4*)(kp + 4); }
            if (s_ >= i) { const LAS float* kp = KT + (16 + s_ - i) * KTS + c * 16 + ch0; v0 += *(const LAS f32x4*)kp; v1 += *(const LAS f32x4*)(kp + 4); }
            if (s_ == i) { const int e = c - ch0; const float dv = Dv[c]; if (e >= 0 && e < 4) v0[e] += dv; else if (e >= 4 && e < 8) v1[e - 4] += dv; }
        } else { const int dir = k0 >= 384 ? 1 : 0, p0 = ((k0 - 256) & 127) >> 1, tau = dir ? 16 - i : i + 1;
            const LAS f32x4* cp = (const LAS f32x4*)(CC + (dir * 16 + c) * 64 + p0); const LAS f32x4* pp = (const LAS f32x4*)(POW + (dir * 17 + tau) * 64 + p0);
            const f32x4 c0 = cp[0], c1 = cp[1], w0 = pp[0], w1 = pp[1];
            v0 = (f32x4){c0[0] * w0[0] - c0[1] * w0[1], -(c0[0] * w0[1] + c0[1] * w0[0]), c0[2] * w0[2] - c0[3] * w0[3], -(c0[2] * w0[3] + c0[3] * w0[2])};
            v1 = (f32x4){c1[0] * w1[0] - c1[1] * w1[1], -(c1[0] * w1[1] + c1[1] * w1[0]), c1[2] * w1[2] - c1[3] * w1[3], -(c1[2] * w1[3] + c1[3] * w1[2])}; }
        *(u32x4*)(WY + (size_t)n * 512 + k0) = pack8(v0, v1); }
    for (int idx = half * 4096 + tid; idx < (half + 1) * 4096; idx += NTHREADS) { const int n = idx >> 5, k0 = (idx & 31) * 8, dir = n >> 7, p = (n & 127) >> 1, ri = n & 1, s_ = k0 >> 4, ch0 = k0 & 15;
        const f32x2 pw = POW[(dir * 17 + (dir ? s_ : 15 - s_)) * 64 + p]; const LAS f32x4* bp = (const LAS f32x4*)(BB + (dir * 64 + p) * 16 + ch0);
        const float u = ri ? pw.y : pw.x, v = ri ? pw.x : -pw.y;
        const f32x4 b0 = bp[0], b1 = bp[1], b2 = bp[2], b3 = bp[3];
        const f32x4 v0 = (f32x4){u * b0[0] + v * b0[1], u * b0[2] + v * b0[3], u * b1[0] + v * b1[1], u * b1[2] + v * b1[3]};
        const f32x4 v1 = (f32x4){u * b2[0] + v * b2[1], u * b2[2] + v * b2[3], u * b3[0] + v * b3[1], u * b3[2] + v * b3[3]};
        *(u32x4*)(WE + (size_t)n * 256 + k0) = pack8(v0, v1); }
    __syncthreads();
}
__device__ __forceinline__ void xprep_item(Frame& F, int item4) {
    f32x4 xv[4][4];
#pragma unroll
    for (int i = 0; i < 4; ++i) { const int row = item4 * 4 + i; const float* xr = (row < MC) ? F.ka->in[0] + (size_t)row * DM : F.ka->in[1] + (size_t)(row - MC) * DM;
#pragma unroll
        for (int j = 0; j < 4; ++j) xv[i][j] = *(const f32x4*)(xr + 4 * F.lane + 256 * j); }
    const int cond = item4 * 4 < MC ? 0 : 1 + ((item4 * 4 - MC) >> 10);
    const float* sc = F.misc + MI_MOD + (0 * 9 + cond) * 6144 + 1024; const float* g1 = F.ka->in[9];
    f32x4 gs[4];
#pragma unroll
    for (int j = 0; j < 4; ++j) { const int c = 4 * F.lane + 256 * j; gs[j] = (*(const f32x4*)(g1 + c)) * (*(const f32x4*)(sc + c) + 1.f); }
#pragma unroll
    for (int i = 0; i < 4; ++i) { const int row = item4 * 4 + i; bf16_t* dst = (bf16_t*)(F.ws + WS_XS) + (size_t)row * DM; float s = 0.f;
#pragma unroll
        for (int j = 0; j < 4; ++j) { const f32x4 x = xv[i][j]; const f32x4 t = x * x; s += (t[0] + t[1]) + (t[2] + t[3]); const f32x4 y = x * gs[j];
            u32x2 w; w.x = cvt_pk_bf16(y[0], y[1]); w.y = cvt_pk_bf16(y[2], y[3]); *(u32x2*)(dst + 4 * F.lane + 256 * j) = w; }
        s = wave_sum(s, F.lane);
        if (F.lane == 0) ((float*)(F.ctl + CW_SS))[row] = s; }
}
__device__ __forceinline__ void bias_item(Frame& F, int item) {
    const int which = item >= 2048, n = which ? item - 2048 : item;
    const bf16_t* wrow = (const bf16_t*)(F.ws + (which ? WS_WUP : WS_WIN)) + (size_t)n * DM;
    float wv[16]; { const u32x4 a = *(const u32x4*)(wrow + F.lane * 8), b = *(const u32x4*)(wrow + 512 + F.lane * 8);
        wv[0] = bflo(a.x); wv[1] = bfhi(a.x); wv[2] = bflo(a.y); wv[3] = bfhi(a.y); wv[4] = bflo(a.z); wv[5] = bfhi(a.z); wv[6] = bflo(a.w); wv[7] = bfhi(a.w);
        wv[8] = bflo(b.x); wv[9] = bfhi(b.x); wv[10] = bflo(b.y); wv[11] = bfhi(b.y); wv[12] = bflo(b.z); wv[13] = bfhi(b.z); wv[14] = bflo(b.w); wv[15] = bfhi(b.w); }
    float outv = 0.f;
#pragma unroll
    for (int cond = 0; cond < 9; ++cond) { const float* sh = F.misc + MI_MOD + cond * 6144 + (which ? 3072 : 0);
        const f32x4 s0 = *(const f32x4*)(sh + F.lane * 8), s1 = *(const f32x4*)(sh + F.lane * 8 + 4), s2 = *(const f32x4*)(sh + 512 + F.lane * 8), s3 = *(const f32x4*)(sh + 512 + F.lane * 8 + 4);
        float d = 0.f;
#pragma unroll
        for (int e = 0; e < 4; ++e) d += s0[e] * wv[e] + s1[e] * wv[4 + e] + s2[e] * wv[8 + e] + s3[e] * wv[12 + e];
        d = wave_sum(d, F.lane); if (F.lane == cond) outv = d; }
    if (F.lane < 9) ((float*)F.ctl)[(which ? CW_BUP + F.lane * 4096 : CW_BIN + F.lane * 2048) + n] = outv;
}
__device__ __forceinline__ void ssm_scan(Frame& F, int l, int g, int pm) {
    const int tid = F.tid, sl = tid >> 7, dp = tid & 127, dir = dp >> 6, p = dp & 63;
    const f32x2* LAM16 = (const f32x2*)(F.ws + WS_SSM + SSM_LAM16); const f32x2* BBAR = (const f32x2*)(F.ws + WS_SSM + SSM_BBAR);
    const float* E = (const float*)(F.ws + WS_R + R_E); bf16_t* AS3 = (bf16_t*)(F.ws + WS_R + R_AS3);
    const f32x2 lam = LAM16[(dir * NG + g) * 64 + p];
    f32x2 e[64];
    if (pm == 0) {
#pragma unroll
        for (int q = 0; q < 4; ++q) { const float* ep = E + ((size_t)g * NCHUNK + (q * 4 + sl) * 16) * 256 + dir * 128 + 2 * p;
#pragma unroll
            for (int j = 0; j < 16; ++j) e[q * 16 + j] = *(const f32x2*)(ep + (size_t)j * 256); }
    } else { const float* ep = E + ((size_t)g * NCHUNK + 256 + ((pm - 1) * 4 + sl) * 64) * 256 + dir * 128 + 2 * p;
#pragma unroll
        for (int j = 0; j < 64; ++j) e[j] = *(const f32x2*)(ep + (size_t)j * 256); }
    const int nq = pm == 0 ? 4 : 1;
#pragma unroll
    for (int q = 0; q < 4; ++q) { if (q >= nq) break;
        int base; f32x2 h;
        if (pm == 0) { const int seq = q * 4 + sl; base = seq * 16; h = (f32x2){0.f, 0.f}; }
        else { const int sq = (pm - 1) * 4 + sl; base = 256 + sq * 64; h = *(const f32x2*)(F.ka->in[4] + ((((size_t)sq * DEPTH + l) * 2 + dir) * NG + g) * 128 + 2 * p); }
        unsigned* hp = (unsigned*)(AS3 + ((size_t)g * NCHUNK + base) * 512 + 256 + dir * 128 + 2 * p);
        if (pm == 0) {
#pragma unroll
            for (int jj = 0; jj < 16; ++jj) { const int j = dir ? 15 - jj : jj; const f32x2 ev = dir ? e[q * 16 + 15 - jj] : e[q * 16 + jj]; hp[(size_t)j * 256] = cvt_pk_bf16(h.x, h.y); h = cmul(lam, h) + ev; }
        } else {
#pragma unroll
            for (int jj = 0; jj < 64; ++jj) { const int j = dir ? 63 - jj : jj; const f32x2 ev = dir ? e[63 - jj] : e[jj]; hp[(size_t)j * 256] = cvt_pk_bf16(h.x, h.y); h = cmul(lam, h) + ev; }
        }
    }
    if (pm == 0) {
        const int tt = dir ? 15 : 0; u32x4 uq[4][2]; f32x2 bbv[16];
        const f32x2* bb = BBAR + ((size_t)(dir * NG + g) * 64 + p) * 16;
#pragma unroll
        for (int ch = 0; ch < 16; ++ch) bbv[ch] = bb[ch];
#pragma unroll
        for (int q = 0; q < 4; ++q) { const int chunk = (q * 4 + sl) * 16 + tt; const bf16_t* up = AS3 + ((size_t)g * NCHUNK + chunk) * 512 + tt * 16; uq[q][0] = *(const u32x4*)up; uq[q][1] = *(const u32x4*)(up + 8); }
        float* ns = F.out + (size_t)MT * DM + 2 * (size_t)NB * DEPTH * SEQ * 512;
#pragma unroll
        for (int q = 0; q < 4; ++q) { const int seq = q * 4 + sl; const u32x4 u0 = uq[q][0], u1 = uq[q][1];
            const float uu[16] = {bflo(u0.x), bfhi(u0.x), bflo(u0.y), bfhi(u0.y), bflo(u0.z), bfhi(u0.z), bflo(u0.w), bfhi(u0.w), bflo(u1.x), bfhi(u1.x), bflo(u1.y), bfhi(u1.y), bflo(u1.z), bfhi(u1.z), bflo(u1.w), bfhi(u1.w)};
            f32x2 acc = (f32x2){0.f, 0.f};
#pragma unroll
            for (int ch = 0; ch < 16; ++ch) acc += bbv[ch] * uu[ch];
            *(f32x2*)(ns + ((((size_t)seq * DEPTH + l) * 2 + dir) * NG + g) * 128 + 2 * p) = acc; }
    }
}
__device__ __forceinline__ void ld16(const bf16_t* p, float* v) { const u32x4 a = *(const u32x4*)p; v[0] = bflo(a.x); v[1] = bfhi(a.x); v[2] = bflo(a.y); v[3] = bfhi(a.y); v[4] = bflo(a.z); v[5] = bfhi(a.z); v[6] = bflo(a.w); v[7] = bfhi(a.w); }
__device__ __forceinline__ void conv_item(Frame& F, int l, int item) {
    const int rs = item >> 4, pn = item & 15, lr = F.lane >> 4, lc = F.lane & 15;
    const int r0 = rs * 64 + lr * 16; const int av = 128 * pn + 8 * lc;
    const bf16_t* up = (const bf16_t*)(F.ws + WS_R) + (size_t)r0 * 4096 + 256 * pn + 8 * lc; bf16_t* gp = (bf16_t*)(F.ws + WS_G) + (size_t)r0 * 2048 + av;
    const float* cw = F.ka->in[31] + (size_t)l * 3 * 4096; const float* cb = F.ka->in[32] + (size_t)l * 4096;
    float wv[3][8], wg[3][8], bv[8], bg[8];
#pragma unroll
    for (int k = 0; k < 3; ++k)
#pragma unroll
        for (int e = 0; e < 8; ++e) { wv[k][e] = cw[k * 4096 + av + e]; wg[k][e] = cw[k * 4096 + 2048 + av + e]; }
#pragma unroll
    for (int e = 0; e < 8; ++e) { bv[e] = cb[av + e]; bg[e] = cb[2048 + av + e]; }
    const int t0 = r0 < MC ? (r0 & 255) : ((r0 - MC) & 1023), L = r0 < MC ? SEQ : DSEQ;
    float pv[8], pg[8], cv[8], cg[8], nv_[8], ng[8];
    if (t0 > 0) { ld16(up - 4096, pv); ld16(up - 4096 + 128, pg); } else {
#pragma unroll
        for (int e = 0; e < 8; ++e) { pv[e] = 0.f; pg[e] = 0.f; } }
    ld16(up, cv); ld16(up + 128, cg);
#pragma unroll
    for (int i = 0; i < 16; ++i) {
        if (t0 + i + 1 < L) { ld16(up + (size_t)(i + 1) * 4096, nv_); ld16(up + (size_t)(i + 1) * 4096 + 128, ng); } else {
#pragma unroll
            for (int e = 0; e < 8; ++e) { nv_[e] = 0.f; ng[e] = 0.f; } }
        float o[8];
#pragma unroll
        for (int e = 0; e < 8; ++e) { const float zv = bv[e] + wv[0][e] * pv[e] + wv[1][e] * cv[e] + wv[2][e] * nv_[e]; const float zg = bg[e] + wg[0][e] * pg[e] + wg[1][e] * cg[e] + wg[2][e] * ng[e]; o[e] = silu_f(zg) * zv; }
        u32x4 w; w.x = cvt_pk_bf16(o[0], o[1]); w.y = cvt_pk_bf16(o[2], o[3]); w.z = cvt_pk_bf16(o[4], o[5]); w.w = cvt_pk_bf16(o[6], o[7]);
        *(u32x4*)(gp + (size_t)i * 2048) = w;
#pragma unroll
        for (int e = 0; e < 8; ++e) { pv[e] = cv[e]; pg[e] = cg[e]; cv[e] = nv_[e]; cg[e] = ng[e]; }
    }
}

__device__ __forceinline__ bool slab_first(int s) { return s < 64 ? (s & 3) == 0 : ((s - 64) & 15) == 0; }
__device__ __forceinline__ bool slab_last(int s) { return s < 64 ? (s & 3) == 3 : ((s - 64) & 15) == 15; }
__device__ __forceinline__ void ld4bf(const bf16_t* p, float* v) { const u32x2 a = *(const u32x2*)p; v[0] = bflo(a.x); v[1] = bfhi(a.x); v[2] = bflo(a.y); v[3] = bfhi(a.y); }
__device__ __forceinline__ void conv_fix(Frame& F, int l, int pm) {
    const bf16_t* HALO = (const bf16_t*)(F.ws + WS_HALO); bf16_t* G = (bf16_t*)(F.ws + WS_G);
    const float* cw = F.ka->in[31] + (size_t)l * 3 * 4096; const float* cb = F.ka->in[32] + (size_t)l * 4096;
    const int c = F.tid * 4, pos = 256 * (c >> 7) + (c & 127);
    float wv[3][4], wg[3][4], bv[4], bg[4];
#pragma unroll
    for (int k = 0; k < 3; ++k) { const f32x4 a = *(const f32x4*)(cw + k * 4096 + c), b = *(const f32x4*)(cw + k * 4096 + 2048 + c);
#pragma unroll
        for (int e = 0; e < 4; ++e) { wv[k][e] = a[e]; wg[k][e] = b[e]; } }
    { const f32x4 a = *(const f32x4*)(cb + c), b = *(const f32x4*)(cb + 2048 + c);
#pragma unroll
      for (int e = 0; e < 4; ++e) { bv[e] = a[e]; bg[e] = b[e]; } }
#pragma unroll
    for (int r8 = 0; r8 < 8; ++r8) { const int s = pm * 4 + (r8 >> 1), which = r8 & 1;
        if (which == 0 ? slab_first(s) : slab_last(s)) continue;
        const bf16_t* hp = which == 0 ? HALO + ((size_t)(s - 1) * 4 + 3) * 4096 : HALO + ((size_t)s * 4 + 2) * 4096;
        const bf16_t* hc = which == 0 ? HALO + ((size_t)s * 4 + 0) * 4096 : HALO + ((size_t)s * 4 + 3) * 4096;
        const bf16_t* hn = which == 0 ? HALO + ((size_t)s * 4 + 1) * 4096 : HALO + ((size_t)(s + 1) * 4 + 0) * 4096;
        float pv[4], cv[4], nv_[4], pg[4], cg[4], ng[4];
        ld4bf(hp + pos, pv); ld4bf(hc + pos, cv); ld4bf(hn + pos, nv_); ld4bf(hp + pos + 128, pg); ld4bf(hc + pos + 128, cg); ld4bf(hn + pos + 128, ng);
        float o[4];
#pragma unroll
        for (int e = 0; e < 4; ++e) { const float zv = bv[e] + wv[0][e] * pv[e] + wv[1][e] * cv[e] + wv[2][e] * nv_[e]; const float zg = bg[e] + wg[0][e] * pg[e] + wg[1][e] * cg[e] + wg[2][e] * ng[e]; o[e] = silu_f(zg) * zv; }
        u32x2 w; w.x = cvt_pk_bf16(o[0], o[1]); w.y = cvt_pk_bf16(o[2], o[3]);
        *(u32x2*)(G + (size_t)(s * 64 + (which ? 63 : 0)) * 2048 + c) = w; }
}
constexpr int N_TR_ITEMS_L = 16 * 32 + 8 * 8 + 16 * 16 + 16 * 64 + 32 * 16;
template <bool BIAS> __device__ __forceinline__ void weight_item(Frame& F, LAS float* scr, int l, int it) {
    int r = it; const float* modl = F.misc + MI_MOD + l * 9 * 6144; float* cf = (float*)F.ctl;
    if (r < 512) { transpose_item<1, BIAS>(F, F.ka->in[10] + (size_t)l * DM * 2048, DM, 2048, (bf16_t*)(F.ws + WS_WIN) + (size_t)l * 2048 * DM, scr, r, modl, cf + CW_BIN + l * 9 * 2048); return; } r -= 512;
    if (r < 64) { transpose_item<0, false>(F, F.ka->in[26] + (size_t)l * 512 * 512, 512, 512, (bf16_t*)(F.ws + WS_WGLU) + (size_t)l * 512 * 512, scr, r, nullptr, nullptr); return; } r -= 64;
    if (r < 256) { transpose_item<0, false>(F, F.ka->in[28] + (size_t)l * DM * DM, DM, DM, (bf16_t*)(F.ws + WS_WOUT) + (size_t)l * DM * DM, scr, r, nullptr, nullptr); return; } r -= 256;
    if (r < 1024) { transpose_item<2, BIAS>(F, F.ka->in[30] + (size_t)l * DM * 4096, DM, 4096, (bf16_t*)(F.ws + WS_WUP) + (size_t)l * 4096 * DM, scr, r, modl + 3072, cf + CW_BUP + l * 9 * 4096); return; } r -= 1024;
    transpose_item<0, false>(F, F.ka->in[33] + (size_t)l * 2048 * DM, 2048, DM, (bf16_t*)(F.ws + WS_WDN) + (size_t)l * DM * 2048, scr, r, nullptr, nullptr);
}

__global__ void __launch_bounds__(NTHREADS, 2) mega(Args args) {
    extern __shared__ __attribute__((aligned(16))) unsigned char lds_raw[];
    Frame F;
    F.lds = (LAS unsigned char*)lds_raw;
    F.tid = threadIdx.x; F.lane = F.tid & 63; F.wave = __builtin_amdgcn_readfirstlane(F.tid >> 6);
    F.G = gridDim.x; F.bid = blockIdx.x; { const int bx = blockIdx.x; F.vcu = (F.G % 8 == 0) ? (bx % 8) * (F.G / 8) + bx / 8 : bx; }
    F.ka = (kargs_t)__builtin_amdgcn_kernarg_segment_ptr();
    F.out = args.out; F.ws = args.ws; F.misc = (float*)(args.ws + WS_MISC); F.ctl = (unsigned*)(args.ws + WS_CTL);
    volatile LAS unsigned* MISC = (volatile LAS unsigned*)(F.lds + MISC_OFF);
    for (int u = F.tid; u < (LDS_BYTES - LDSCTL_OFF) / 4; u += NTHREADS) ((LAS unsigned*)(F.lds + LDSCTL_OFF))[u] = 0u;
    __syncthreads();
    XcdBarrier bar = xcd_barrier_post(F.ctl + CW_BAR, MISC + 8);
    int phase_no = 0;
#define LAUNDER() do { asm volatile("" : "+s"(F.ka), "+s"(F.ws), "+s"(F.out), "+s"(F.bid)); { int w_ = __builtin_amdgcn_readfirstlane(F.wave); asm volatile("" : "+s"(w_)); F.wave = w_; } F.vcu = (F.G % 8 == 0) ? (F.bid % 8) * (F.G / 8) + F.bid / 8 : F.bid; \
    { unsigned z_ = 0u; asm volatile("" : "+v"(z_)); F.lane = (int)__builtin_amdgcn_mbcnt_hi(~0u, __builtin_amdgcn_mbcnt_lo(~0u, z_)); } F.tid = F.wave * 64 + F.lane;     \
    F.misc = (float*)(F.ws + WS_MISC); F.ctl = (unsigned*)(F.ws + WS_CTL); gw = F.vcu * NWAVES + F.wave; } while (0)
#ifndef TPROBE_SCALE
#define TPROBE_SCALE 0.25f
#endif
#ifdef TPROBE
#define TSTAMP() do { if (blockIdx.x == 0 && F.tid == 0) ((unsigned long long*)(F.ctl + 6000))[phase_no] = __builtin_amdgcn_s_memrealtime(); } while (0)
#else
#define TSTAMP() do {} while (0)
#endif
#if defined(TPROBE) && defined(TPROBE_SUB_A)
#ifndef TPROBE_BID
#define TPROBE_BID 0
#endif
#define TSUB(i) do { if (blockIdx.x == TPROBE_BID && F.tid == 0 && l == 0) ((unsigned long long*)(F.ctl + 6200))[i] = __builtin_amdgcn_s_memrealtime(); } while (0)
#else
#define TSUB(i) do {} while (0)
#endif
#define GRID_BAR() do { LAUNDER(); xcd_barrier(bar, F.tid); ++phase_no; TSTAMP(); if (F.ka->stop_after == phase_no) return; LAUNDER(); } while (0)
    int gw = F.vcu * NWAVES + F.wave; const int NGW = F.G * NWAVES;
#define ssq ((float*)(F.ctl + CW_SS))
#define XS ((bf16_t*)(F.ws + WS_XS))
#define KB ((bf16_t*)(F.ws + WS_KB))
#define VB ((bf16_t*)(F.ws + WS_VB))
#define Qb ((bf16_t*)(F.ws + WS_R + R_Q))
#define AS3 ((bf16_t*)(F.ws + WS_R + R_AS3))
#define Eb ((float*)(F.ws + WS_R + R_E))
#define Zb ((bf16_t*)(F.ws + WS_R + R_Z))
#define CAT ((bf16_t*)(F.ws + WS_R + R_CAT))
#define UP ((bf16_t*)(F.ws + WS_R))
#define Gb ((bf16_t*)(F.ws + WS_G))

    TSTAMP();
    if (F.vcu < 64) ssm_prep(F, 0, F.vcu);
    else {
        { const int t = F.vcu - 64, l = t / 96, strip = t % 96; gemv9_task<0, 0, 64>(F, F.ka->in[7] + (size_t)l * DM * 6144, 6144, l, 0, strip, F.misc + MI_MOD + l * 9 * 6144, 6144, F.ka->in[8] + l * 6144); }
        if (F.vcu == 64) {
            for (int i = F.tid; i < 1024; i += NTHREADS) { const int pos = i >> 4, f = i & 15; const float inv = 1.0f / powf(10000.0f, (float)f / 16.0f); const float ang = (float)pos * inv;
                ((f32x2*)(F.misc + MI_ROPE))[i] = (f32x2){cosf(ang), sinf(ang)}; }
            if (F.tid < 2) { const int l = F.tid; float a1 = 0.f, a2 = 0.f; for (int d = 0; d < 64; ++d) { a1 += F.ka->in[13][l * 64 + d] * F.ka->in[14][l * 64 + d]; a2 += F.ka->in[15][l * 64 + d] * F.ka->in[16][l * 64 + d]; }
                const float li = 0.8f - 0.6f * expf(-0.3f * (float)l); F.misc[MI_LAM + l] = expf(a1) - expf(a2) + li; F.misc[MI_LAM + 2 + l] = 1.f - li; }
            __syncthreads();
        }
        LAS float* scr = (LAS float*)(F.lds + F.wave * 16640);
        const int gw1 = (F.vcu - 64) * NWAVES + F.wave, NGW1 = (F.G - 64) * NWAVES;
        for (int it = gw1; it < N_TR_ITEMS_L + 2048; it += NGW1) { if (it < N_TR_ITEMS_L) weight_item<false>(F, scr, 0, it); else cache_item(F, 0, it - N_TR_ITEMS_L); }
    }
    GRID_BAR();
    for (int it = gw; it < MT / 4 + 6144; it += NGW) { if (it < MT / 4) xprep_item(F, it); else bias_item(F, it - MT / 4); }
    GRID_BAR();

    for (int l = 0; l < DEPTH; ++l) {
        const float* modl = F.misc + MI_MOD + l * 9 * 6144;
        { unsigned* ucnt = F.ctl + CW_UC + l * 6 * 64;
          { Gemm g{XS, (const bf16_t*)(F.ws + WS_WIN) + (size_t)l * 2048 * DM, DM, DM, DM, 0, 0}; InOrder S{F.bid, F.G};
            EpiIn E{ssq + (l == 0 ? 0 : 2 * MT), (const float*)F.ctl + CW_BIN + l * 9 * 2048, F.ka->in[11] + l * 64, F.ka->in[12] + l * 64, (const f32x2*)(F.misc + MI_ROPE), Qb, KB, VB,
                    __builtin_amdgcn_make_buffer_rsrc((void*)AS3, 0, (int)((size_t)NG * NCHUNK * 512 * 2), 0x00020000),
                    F.out + (size_t)MT * DM, F.out + (size_t)MT * DM + (size_t)NB * DEPTH * SEQ * 512, l, ucnt};
            gemm_phase<EpiIn, InOrder>(F.lds, F.tid, g, S, E); }
          if (F.bid >= 128 && F.bid < 224) {
              LAUNDER();
              const int idx = F.bid - 128, gq = idx / 3, pmq = idx % 3; unsigned* up = F.ctl + CW_UC + ((l * 3 + pmq) * 2 + (gq >> 4)) * 64;
              if (F.tid == 0) { unsigned sp = 0; while (__hip_atomic_load(up, RLX_AGENT) < 128u) { __builtin_amdgcn_s_sleep(2); if (++sp > (1u << 20)) break; }
                  __builtin_amdgcn_fence(__ATOMIC_ACQUIRE, "agent"); asm volatile("s_waitcnt vmcnt(0)" ::: "memory"); }
              __syncthreads();
              { Gemm g{AS3, (const bf16_t*)(F.ws + WS_SSM + SSM_WE), 512, 256, 256, (size_t)NCHUNK * 512, (size_t)256 * 256}; GroupOrder S{idx, F.G}; EpiS1 E{Eb};
                gemm_phase<EpiS1, GroupOrder>(F.lds, F.tid, g, S, E); }
              VM_WAIT(); __syncthreads(); LAUNDER();
              ssm_scan(F, l, (F.bid - 128) / 3, (F.bid - 128) % 3); } }
        GRID_BAR();
#define ZC_PTR (F.ctl + CW_ZC + l * 256)
#define ATTN_UNIT(SEQ_, H_, QB_) do { LAUNDER(); const AttnArgs A_{Qb, KB, VB, CAT, F.ka->in[17] + l * 128, F.misc[MI_LAM + l], F.misc[MI_LAM + 2 + l]}; attn_unit(F.lds, F.tid, A_, (SEQ_), (H_), (QB_)); } while (0)
#define ATTN_CTX(U_) do { const int u_ = (U_); ATTN_UNIT(u_ >> 3, (u_ >> 1) & 3, u_ & 1); } while (0)
        { TSUB(0);
          if (F.vcu < NG * 3) {
              { Gemm g{AS3, (const bf16_t*)(F.ws + WS_SSM + SSM_WY), 512, 512, 512, (size_t)NCHUNK * 512, (size_t)256 * 512}; GroupOrder S{F.vcu, F.G};
                EpiS3 E{__builtin_amdgcn_make_buffer_rsrc((void*)Zb, 0, (int)((size_t)MT * 512 * 2), 0x00020000)};
                gemm_phase<EpiS3, GroupOrder>(F.lds, F.tid, g, S, E); }
              VM_WAIT(); __syncthreads(); LAUNDER();
              if (F.tid == 0) __hip_atomic_fetch_add(ZC_PTR + (F.vcu % 3) * 64, 1u, RLX_AGENT); }
          TSUB(3);
          { const int u = F.vcu; ATTN_UNIT(NB + (u >> 5), (u >> 3) & 3, u & 7); } TSUB(4);
          if (F.vcu >= 192) { for (int r = 0; r < 2; ++r) ATTN_CTX(2 * (F.vcu - 192) + r); }
          TSUB(5);
          if (F.vcu >= 96 && F.vcu < 192) {
              LAUNDER();
              const int idx = F.vcu - 96, pmz = (idx >> 1) >> 4;
              if (F.tid == 0) { unsigned sp = 0; while (__hip_atomic_load(ZC_PTR + pmz * 64, RLX_AGENT) < (unsigned)NG) { __builtin_amdgcn_s_sleep(2); if (++sp > (1u << 20)) break; }
                  __builtin_amdgcn_fence(__ATOMIC_ACQUIRE, "agent"); asm volatile("s_waitcnt vmcnt(0)" ::: "memory"); }
              __syncthreads(); TSUB(6);
              Gemm g{Zb, (const bf16_t*)(F.ws + WS_WGLU) + (size_t)l * 512 * 512, 512, 512, 512, 0, 0}; OneTile S{idx};
              EpiGlu E{Zb, F.ka->in[27] + l * 512, CAT};
              gemm_phase<EpiGlu, OneTile>(F.lds, F.tid, g, S, E); TSUB(7); } }
        GRID_BAR();
        { Gemm g{CAT, (const bf16_t*)(F.ws + WS_WOUT) + (size_t)l * DM * DM, DM, DM, DM, 0, 0}; GridOrder S; S.init(MT, DM, F.G, F.bid);
          bf16_t* XR = (bf16_t*)(F.ws + WS_XR);
          if (l == 0) { EpiRes<true, false> E{F.ka->in[0], F.ka->in[1], nullptr, nullptr, XR, modl + 2 * DM, F.ka->in[29] + l * DM, modl + 4 * DM, XS, ssq + 1 * MT};
              gemm_phase<EpiRes<true, false>, GridOrder>(F.lds, F.tid, g, S, E); }
          else { EpiRes<false, false> E{nullptr, nullptr, XR, nullptr, XR, modl + 2 * DM, F.ka->in[29] + l * DM, modl + 4 * DM, XS, ssq + 3 * MT};
              gemm_phase<EpiRes<false, false>, GridOrder>(F.lds, F.tid, g, S, E); }
          if (l + 1 < DEPTH && F.bid >= 192) { LAUNDER(); LAS float* scr = (LAS float*)(F.lds + F.wave * 16640);
              for (int it = (F.bid - 192) * NWAVES + F.wave; it < N_TR_ITEMS_L; it += 64 * NWAVES) weight_item<true>(F, scr, l + 1, it); } }
        GRID_BAR();
        { Gemm g{XS, (const bf16_t*)(F.ws + WS_WUP) + (size_t)l * 4096 * DM, DM, DM, DM, 0, 0}; GridOrder S; S.init(MT, 4096, F.G, F.bid);
          EpiUpConv E{ssq + (l == 0 ? 1 : 3) * MT, (const float*)F.ctl + CW_BUP + l * 9 * 4096, F.ka->in[31] + (size_t)l * 3 * 4096, F.ka->in[32] + (size_t)l * 4096, Gb, (bf16_t*)(F.ws + WS_HALO)};
          gemm_phase<EpiUpConv, GridOrder, true>(F.lds, F.tid, g, S, E); }
        GRID_BAR();
        { Gemm g{Gb, (const bf16_t*)(F.ws + WS_WDN) + (size_t)l * DM * 2048, 2048, 2048, 2048, 0, 0}; GridOrder S; S.init(MT, DM, F.G, F.bid);
          const bool nxt = l + 1 < DEPTH;
          bf16_t* XR = (bf16_t*)(F.ws + WS_XR);
          { Unit u0; if (S.next(0, u0)) { conv_fix(F, l, u0.pm); VM_WAIT(); __syncthreads(); LAUNDER(); } }
          if (nxt) { EpiRes<false, false> E{nullptr, nullptr, XR, nullptr, XR, modl + 5 * DM, F.ka->in[9] + (l + 1) * DM, modl + 9 * 6144 + DM, XS, ssq + 2 * MT};
              gemm_phase<EpiRes<false, false>, GridOrder>(F.lds, F.tid, g, S, E); }
          else { EpiRes<false, true> E{nullptr, nullptr, XR, F.out, nullptr, modl + 5 * DM, nullptr, nullptr, XS, ssq + 2 * MT};
              gemm_phase<EpiRes<false, true>, GridOrder>(F.lds, F.tid, g, S, E); }
          if (nxt && F.bid >= 192) { LAUNDER(); ssm_prep(F, l + 1, F.bid - 192);
              for (int it = (F.bid - 192) * NWAVES + F.wave; it < 2048; it += 64 * NWAVES) cache_item(F, l + 1, it); } }
        if (l + 1 < DEPTH) GRID_BAR();
    }
#ifdef TPROBE
    GRID_BAR();
    { float* miscp = (float*)(args.ws + WS_MISC); unsigned* ctlp = (unsigned*)(args.ws + WS_CTL);
      if (blockIdx.x == 0 && threadIdx.x == 0) { const unsigned long long* ts = (const unsigned long long*)(ctlp + 6000); const float tot = (float)(ts[phase_no] - ts[0]);
        float fa = 0.f;
#ifdef TPROBE_SUB_A
        { const unsigned long long* t2 = (const unsigned long long*)(ctlp + 6200); fa = (float)(t2[TPROBE_SUB_B] - t2[TPROBE_SUB_A]) / tot; }
#else
        for (int k = 0; k < phase_no; ++k) { const float d = (float)(ts[k + 1] - ts[k]) / tot; if ((TPROBE_MASK_A >> k) & 1ull) fa += d; }
#endif
        miscp[MI_END] = TPROBE_SCALE * sqrtf(fa); }
      GRID_BAR();
      const float delta = miscp[MI_END];
      for (size_t i = (size_t)blockIdx.x * NTHREADS + threadIdx.x; i < (size_t)MC * DM; i += (size_t)gridDim.x * NTHREADS) args.out[i] *= (1.f + delta); }
#endif
#undef GRID_BAR
#undef LAUNDER
#undef ZC_PTR
#undef ATTN_UNIT
#undef ATTN_CTX
#undef ssq
#undef XS
#undef KB
#undef VB
#undef Qb
#undef AS3
#undef Eb
#undef Zb
#undef CAT
#undef UP
#undef Gb
}
}

static int fk_launch(void* const* d_in, void* d_out, void* d_ws, size_t ws_size, hipStream_t stream, int stop_after) {
    static int grid = 0;
    if (grid == 0) {
        int dev = 0, cus = 0;
        if (ws_size < fk::WS_END) { fprintf(stderr, "kernel_launch: workspace too small (%zu < %zu)\n", ws_size, (size_t)fk::WS_END); grid = -1; return -1; }
        if (hipGetDevice(&dev) != hipSuccess || hipDeviceGetAttribute(&cus, hipDeviceAttributeMultiprocessorCount, dev) != hipSuccess) { grid = -1; return -1; }
        if (hipFuncSetAttribute((const void*)fk::mega, hipFuncAttributeMaxDynamicSharedMemorySize, fk::LDS_BYTES) != hipSuccess) { fprintf(stderr, "kernel_launch: hipFuncSetAttribute failed\n"); grid = -1; return -1; }
        int per_cu = 0; (void)hipOccupancyMaxActiveBlocksPerMultiprocessor(&per_cu, (const void*)fk::mega, fk::NTHREADS, fk::LDS_BYTES); (void)hipGetLastError();
        if (per_cu < 1) fprintf(stderr, "kernel_launch: occupancy query says %d blocks/CU\n", per_cu);
        grid = cus;
        if (grid != 256) fprintf(stderr, "kernel_launch: %d CUs (built for 256)\n", grid);
    }
    if (grid < 0) return -1;
    (void)hipMemsetAsync((char*)d_ws + fk::WS_CTL, 0, fk::CTL_BYTES, stream);
    fk::Args a{};
    for (int i = 0; i < 34; ++i) a.in[i] = (const float*)d_in[i];
    a.out = (float*)d_out; a.ws = (unsigned char*)d_ws; a.stop_after = stop_after; a.pad = 0;
    hipLaunchKernelGGL(fk::mega, dim3(grid), dim3(fk::NTHREADS), fk::LDS_BYTES, stream, a);
    return 0;
}
extern "C" void kernel_launch(void* const* d_in, const int* in_sizes, int n_in, void* d_out, int out_size, void* d_ws, size_t ws_size, hipStream_t stream) {
    if (n_in != 34) { fprintf(stderr, "kernel_launch: unexpected n_in %d\n", n_in); return; }
    fk_launch(d_in, d_out, d_ws, ws_size, stream, 0);
}
```

```cpp
#include <hip/hip_runtime.h>
#include <cstdio>
#include <cstdint>
namespace fk {
#define LAS __attribute__((address_space(3)))
#define GAS __attribute__((address_space(1)))
typedef unsigned short bf16_t;
typedef short bf16x8 __attribute__((ext_vector_type(8)));
typedef short s16x4 __attribute__((ext_vector_type(4)));
typedef float f32x4 __attribute__((ext_vector_type(4)));
typedef float f32x2 __attribute__((ext_vector_type(2)));
typedef float f32x16 __attribute__((ext_vector_type(16)));
typedef unsigned u32x4 __attribute__((ext_vector_type(4)));
typedef unsigned u32x2 __attribute__((ext_vector_type(2)));

constexpr int DM = 1024, NB = 16, SEQ = 256, DEPTH = 2, DB = 8, DSEQ = 1024, PAST = 512;
constexpr int MC = NB * SEQ, MS = DB * DSEQ, MT = MC + MS;
constexpr int NH = 4, NG = 32, NCOND = 9, NMOD = 6;
constexpr int NCHUNK = MT / 16;
constexpr int KVROWS = MC + DB * (PAST + DSEQ);
constexpr float EPS = 1e-6f;
constexpr float C2 = 0.125f * 1.4426950408889634f;
constexpr int NWAVES = 8, NTHREADS = 512;

constexpr size_t MiB = 1u << 20;
constexpr size_t WS_CTL = 0, CTL_BYTES = 1 * MiB + 512 * 1024;
constexpr size_t WS_MISC = 1 * MiB;
constexpr size_t WS_WIN = 3 * MiB;
constexpr size_t WS_WGLU = 11 * MiB;
constexpr size_t WS_WOUT = 12 * MiB;
constexpr size_t WS_WUP = 16 * MiB;
constexpr size_t WS_WDN = 32 * MiB;
constexpr size_t WS_SSM = 40 * MiB;
constexpr size_t WS_XS = 53 * MiB;
constexpr size_t WS_KB = 77 * MiB;
constexpr size_t WS_VB = 93 * MiB;
constexpr size_t WS_R = 109 * MiB;
constexpr size_t WS_XR = 205 * MiB;
constexpr size_t WS_G = WS_R;
constexpr size_t WS_HALO = WS_R + 48 * MiB;
constexpr size_t WS_END = 253 * MiB;
constexpr size_t R_Q = 0, R_AS3 = 12 * MiB, R_E = 36 * MiB, R_Z = 60 * MiB, R_CAT = 72 * MiB;
constexpr size_t SSM_WE = 0, SSM_WY = 4 * MiB, SSM_LAM16 = 12 * MiB, SSM_BBAR = 12 * MiB + 64 * 1024;
constexpr int MI_MOD = 0;
constexpr int MI_ROPE = MI_MOD + 2 * 9 * 6144;
constexpr int MI_LAM = MI_ROPE + 64 * 16 * 2;
constexpr int MI_END = MI_LAM + 8;
static_assert((size_t)MI_END * 4 <= 2 * MiB, "MISC");
constexpr int CW_BAR = 1024;
constexpr int CW_ZC = 7168;
constexpr int CW_UC = 4608;
constexpr int CW_SS = 8192;
constexpr int CW_BIN = 65536;
constexpr int CW_BUP = CW_BIN + 2 * 9 * 2048;
static_assert((size_t)(CW_SS + 4 * MT) <= CW_BIN && (size_t)(CW_BUP + 2 * 9 * 4096) * 4 <= CTL_BYTES, "CTL");

constexpr int RING_BYTES = 131072;
constexpr int LDS_BYTES_ = 147456; constexpr int LDSCTL_OFF = LDS_BYTES_ - 512, MISC_OFF = LDSCTL_OFF + 320;
constexpr int LDS_BYTES = 147456;

#define RLX_AGENT __ATOMIC_RELAXED, __HIP_MEMORY_SCOPE_AGENT
typedef __bf16 bf16x2_t __attribute__((ext_vector_type(2)));
__device__ __forceinline__ unsigned cvt_pk_bf16(float lo, float hi) { const f32x2 v = {lo, hi}; const bf16x2_t b = __builtin_convertvector(v, bf16x2_t); return __builtin_bit_cast(unsigned, b); }
__device__ __forceinline__ float bf2f(unsigned short b) { return __uint_as_float((unsigned)b << 16); }
__device__ __forceinline__ float bflo(unsigned w) { return __uint_as_float(w << 16); }
__device__ __forceinline__ float bfhi(unsigned w) { return __uint_as_float(w & 0xffff0000u); }
__device__ __forceinline__ float fast_exp2(float x) { return __builtin_amdgcn_exp2f(x); }
__device__ __forceinline__ float fast_rcp(float x) { return __builtin_amdgcn_rcpf(x); }
__device__ __forceinline__ float sigmoid_f(float x) { return fast_rcp(1.f + fast_exp2(-1.4426950408889634f * x)); }
__device__ __forceinline__ float silu_f(float x) { return x * sigmoid_f(x); }
__device__ __forceinline__ float gelu_tanh_f(float x) {
    const float u = 0.7978845608028654f * (x + 0.044715f * x * x * x); return x * sigmoid_f(2.f * u); }
__device__ __forceinline__ float shfl_xor_l(float v, int mask, int lane) { return __uint_as_float((unsigned)__builtin_amdgcn_ds_bpermute((lane ^ mask) << 2, (int)__float_as_uint(v))); }
__device__ __forceinline__ float wave_sum(float v, int lane) {
#pragma unroll
    for (int o = 1; o < 64; o <<= 1) v += shfl_xor_l(v, o, lane);
    return v; }

#define XB_TMO      128
#define XB_XCNT(j)  (256  + 64 * (j))
#define XB_XSUB(j)  (1280 + 64 * (j))
#define XB_XGEN(j)  (2304 + 64 * (j))
#define XB_TOP      3328
#define XB_TOPGEN   3392
#define XCD_BAR_WORDS 3456
#define XB_SPIN_CAP (1u << 18)
__device__ __forceinline__ unsigned xb_ld(unsigned* p)              { return __hip_atomic_load(p, __ATOMIC_RELAXED, __HIP_MEMORY_SCOPE_AGENT); }
__device__ __forceinline__ unsigned xb_add(unsigned* p, unsigned v) { return __hip_atomic_fetch_add(p, v, __ATOMIC_RELAXED, __HIP_MEMORY_SCOPE_AGENT); }
__device__ __forceinline__ unsigned xb_xcc_id() { return (unsigned)__builtin_amdgcn_s_getreg((3 << 11) | 20) & 0xFu; }
#define XB_SPIN(cond, bar) do { unsigned _sp = 0; while (cond) { __builtin_amdgcn_s_sleep(1); \
    if ((++_sp & 255u) == 0u) { if (xb_ld(&(bar)[XB_TMO])) break; if (_sp > XB_SPIN_CAP) { atomicAdd(&(bar)[XB_TMO], 1u); break; } } } } while (0)
struct XcdBarrier { unsigned* bar; unsigned x; volatile LAS unsigned* st; };
__device__ __forceinline__ XcdBarrier xcd_barrier_post(unsigned* bar, volatile LAS unsigned* st) {
    XcdBarrier b; b.bar = bar; b.x = xb_xcc_id(); b.st = st;
    if (threadIdx.x == 0) (void)xb_add(&bar[XB_XCNT(b.x)], 1u);
    return b;
}
__device__ __forceinline__ void xcd_barrier_complete(unsigned* bar, unsigned x, unsigned& nloc, unsigned& nx) {
    const unsigned G = gridDim.x * gridDim.y * gridDim.z;
    unsigned sum, cnt, mine, sp = 0u;
    for (;;) {
        sum = 0u; cnt = 0u; mine = 0u;
#pragma unroll
        for (unsigned j = 0; j < 16; ++j) { const unsigned c = xb_ld(&bar[XB_XCNT(j)]); sum += c; cnt += (c > 0u) ? 1u : 0u; mine = (j == x) ? c : mine; }
        if (sum == G) break;
        __builtin_amdgcn_s_sleep(1);
        if ((++sp & 255u) == 0u) { if (xb_ld(&bar[XB_TMO])) break; if (sp > XB_SPIN_CAP) { atomicAdd(&bar[XB_TMO], 1u); break; } }
    }
    nloc = mine > 0u ? mine : 1u; nx = cnt > 0u ? cnt : 1u;
}
__device__ __forceinline__ void xcd_barrier(const XcdBarrier& b, const int tid) {
    asm volatile("s_waitcnt vmcnt(0)" ::: "memory");
    __syncthreads();
    if (tid == 0) {
        unsigned* bar = b.bar;
        __builtin_amdgcn_s_waitcnt(0);
        unsigned nloc = b.st[0], nx = b.st[1];
        if (nloc == 0u) { xcd_barrier_complete(bar, b.x, nloc, nx); b.st[0] = nloc; b.st[1] = nx; }
        const unsigned old = xb_add(&bar[XB_XSUB(b.x)], 1u);
        const unsigned gen = old / nloc;
        if (old + 1u == (gen + 1u) * nloc) {
            __builtin_amdgcn_fence(__ATOMIC_RELEASE, "agent");
            asm volatile("s_waitcnt vmcnt(0)" ::: "memory");
            const unsigned og = xb_add(&bar[XB_TOP], 1u);
            const unsigned tg = og / nx;
            if (og + 1u == (tg + 1u) * nx) xb_add(&bar[XB_TOPGEN], 1u);
            else XB_SPIN(xb_ld(&bar[XB_TOPGEN]) == tg, bar);
            __builtin_amdgcn_fence(__ATOMIC_ACQUIRE, "agent");
            xb_add(&bar[XB_XGEN(b.x)], 1u);
            asm volatile("s_waitcnt vmcnt(0)" ::: "memory");
        } else {
            XB_SPIN(xb_ld(&bar[XB_XGEN(b.x)]) == gen, bar);
            __builtin_amdgcn_fence(__ATOMIC_ACQUIRE, "agent");
            asm volatile("s_waitcnt vmcnt(0)" ::: "memory");
        }
    }
    __syncthreads();
}

constexpr int BM = 256, BK = 64, HALF = 128, HTB = HALF * BK * 2, NXCD = 8, WGM = 6;
__host__ __device__ __forceinline__ int lds_byte(int r, int c) { const int st = (r >> 4) * 2 + (c >> 5), rr = r & 15, cc = c & 31, ob = rr * 64 + cc * 2; return st * 1024 + (ob ^ (((ob >> 9) & 1) << 5)); }
__host__ __device__ __forceinline__ void stage_rc(int b, int& R, int& C) { const int st = b / 1024, sb = b % 1024, swz = sb ^ (((sb >> 9) & 1) << 5); R = (st >> 1) * 16 + swz / 64; C = (st & 1) * 32 + (swz % 64) / 2; }
__host__ __device__ __forceinline__ int perm32(int rho) { const int n = rho >> 4, i = rho & 15; return 8 * (i >> 2) + 4 * n + (i & 3); }

struct Unit { int pm, pn, g; };
struct Gemm { const bf16_t* A; const bf16_t* Bt; int lda, ldb, K; size_t gsA, gsB; };
struct GridOrder {
    int nM, nN, nwg, G, c;
    __device__ void init(int M, int N, int G_, int c_) { nM = M / BM; nN = N / BM; nwg = nM * nN; G = G_; c = c_; }
    __device__ bool next(int i, Unit& u) const {
        const long L = (long)i * G + c; if (L >= nwg) return false;
        int wgid = (int)L; { const int q = nwg / NXCD, r = nwg % NXCD, xcd = wgid % NXCD, off = wgid / NXCD; wgid = (xcd < r ? xcd * (q + 1) : r * (q + 1) + (xcd - r) * q) + off; }
        const int nig = WGM * nN, gid = wgid / nig, fm = gid * WGM, gsz = (nM - fm) < WGM ? (nM - fm) : WGM;
        u.pm = fm + ((wgid % nig) % gsz); u.pn = (wgid % nig) / gsz; u.g = 0; return true;
    }
};
struct InOrder {
    int c, G;
    __device__ bool next(int i, Unit& u) const { const int L = i * G + c; if (L >= 384) return false; u.g = 0;
        if (L < 96) { const int j = (L & 7) * 12 + (L >> 3); u.pm = j >> 1; u.pn = 6 + (j & 1); }
        else { const int Lp = L - 96, j = (Lp & 7) * 36 + (Lp >> 3); u.pm = j / 6; u.pn = j % 6; }
        return true; }
};
struct OneTile {
    int idx;
    __device__ bool next(int i, Unit& u) const { if (i > 0 || idx < 0) return false; u.pm = idx >> 1; u.pn = idx & 1; u.g = 0; return true; }
};
struct GroupOrder {
    int c, G;
    __device__ bool next(int i, Unit& u) const { const int idx = c + i * G; if (c < 0 || idx >= NG * 3) return false; u.g = idx / 3; u.pm = idx % 3; u.pn = 0; return true; }
};

template <class Epi, class Sched, bool AROWPERM = false>
__device__ __forceinline__ void gemm_phase(LAS unsigned char* lds, const int tid, const Gemm g, const Sched& S, const Epi& E) {
    const int wid = __builtin_amdgcn_readfirstlane(tid >> 6), lane = tid & 63, wr = wid >> 2, wc = wid & 3, fr = lane & 15, fq = lane >> 4;
    const int K = g.K, nt = K / BK;
    unsigned voffA[2], voffB[2];
#pragma unroll
    for (int i = 0; i < 2; ++i) { int R, C; stage_rc(tid * 16 + i * 8192, R, C); const int Rb = Epi::PERM ? ((R & ~31) + perm32(R & 31)) : R;
        const int Ra = AROWPERM ? ((R & 64) + 4 * (R & 15) + ((R >> 4) & 3)) : R;
        voffA[i] = (unsigned)(Ra * g.lda + C) * 2u; voffB[i] = (unsigned)(Rb * g.ldb + C) * 2u; }
    const size_t kstep = (size_t)(BK * 2);
    const size_t hstepA = (size_t)HALF * g.lda * 2, hstepB = (size_t)HALF * g.ldb * 2;
    const unsigned ldsw = (unsigned)wid * 1024u;
    const int aoff = lds_byte(wr * 64 + fr, fq * 8), boff = lds_byte(wc * 32 + fr, fq * 8);
#define PG8_SA(b, h) (((b) * 2 + (h)) * HTB)
#define PG8_SB(b, h) ((4 + (b) * 2 + (h)) * HTB)
#define PG8_STAGE(bufoff, gbase, voff) do { _Pragma("unroll") for (int _i = 0; _i < 2; ++_i) \
        __builtin_amdgcn_global_load_lds((const unsigned*)((const char*)(gbase) + (voff)[_i]), (LAS unsigned*)(lds + (bufoff) + ldsw + _i * 8192), 16, 0, 0); } while (0)
#define PG8_LDA(dst, b, h) do { _Pragma("unroll") for (int m = 0; m < 4; ++m) _Pragma("unroll") for (int k = 0; k < 2; ++k) dst[m][k] = *(const LAS bf16x8*)(lds + PG8_SA(b, h) + aoff + m * 2048 + k * 1024); } while (0)
#define PG8_LDB(dst, b, h) do { _Pragma("unroll") for (int n = 0; n < 2; ++n) _Pragma("unroll") for (int k = 0; k < 2; ++k) dst[n][k] = *(const LAS bf16x8*)(lds + PG8_SB(b, h) + boff + n * 2048 + k * 1024); } while (0)
#define PG8_MMA(ai, bj, At, Bt) do { __builtin_amdgcn_s_setprio(1); _Pragma("unroll") for (int m = 0; m < 4; ++m) _Pragma("unroll") for (int n = 0; n < 2; ++n) _Pragma("unroll") for (int k = 0; k < 2; ++k) \
        acc[ai][bj][m][n] = __builtin_amdgcn_mfma_f32_16x16x32_bf16(Bt[n][k], At[m][k], acc[ai][bj][m][n], 0, 0, 0); __builtin_amdgcn_s_setprio(0); } while (0)
#define PG8_WAIT_V(n) asm volatile("s_waitcnt vmcnt(" #n ")" ::: "memory")
#define PG8_WAIT_L(n) asm volatile("s_waitcnt lgkmcnt(" #n ")" ::: "memory")
#define PG8_BAR __builtin_amdgcn_s_barrier()
#define PG8_SCHED __builtin_amdgcn_sched_barrier(0)
#define PG8_APTR(u) ((const char*)g.A + ((size_t)(u).g * g.gsA + (size_t)(u).pm * BM * g.lda) * 2)
#define PG8_BPTR(u) ((const char*)g.Bt + ((size_t)(u).g * g.gsB + (size_t)(u).pn * BM * g.ldb) * 2)
    Unit cur, nxt; int ui = 0;
    if (!S.next(0, cur)) return;
    f32x4 acc[2][2][4][2];
#pragma unroll
    for (int a = 0; a < 2; ++a)
#pragma unroll
        for (int b = 0; b < 2; ++b)
#pragma unroll
            for (int m = 0; m < 4; ++m)
#pragma unroll
                for (int n = 0; n < 2; ++n) acc[a][b][m][n] = (f32x4){0.f, 0.f, 0.f, 0.f};
    bf16x8 At[4][2], B0[2][2], B1[2][2];
    const char* cA = PG8_APTR(cur); const char* cB = PG8_BPTR(cur);
    PG8_STAGE(PG8_SB(0, 0), cB, voffB); PG8_STAGE(PG8_SB(0, 1), cB + hstepB, voffB); PG8_STAGE(PG8_SA(0, 0), cA, voffA); PG8_STAGE(PG8_SA(0, 1), cA + hstepA, voffA);
    if (wr == 1) PG8_BAR;
    PG8_WAIT_V(2); PG8_BAR;
    PG8_STAGE(PG8_SB(1, 0), cB + kstep, voffB); PG8_STAGE(PG8_SA(1, 0), cA + kstep, voffA); PG8_STAGE(PG8_SB(1, 1), cB + hstepB + kstep, voffB);
    PG8_WAIT_V(6); PG8_BAR;
    for (;;) {
        const bool has_next = S.next(ui + 1, nxt);
        const char* nA = has_next ? PG8_APTR(nxt) : cA; const char* nB = has_next ? PG8_BPTR(nxt) : cB;
        for (int t = 0; t < nt; t += 2) {
            const bool last = (t == nt - 2);
            const char* a1 = cA + (size_t)(t + 1) * kstep;
            const char* a2 = last ? nA : cA + (size_t)(t + 2) * kstep; const char* b2 = last ? nB : cB + (size_t)(t + 2) * kstep;
            const char* a3 = a2 + kstep; const char* b3 = b2 + kstep;
            PG8_LDB(B0, 0, 0); PG8_LDB(B1, 0, 1); PG8_SCHED; PG8_LDA(At, 0, 0); PG8_STAGE(PG8_SA(1, 1), a1 + hstepA, voffA);
            PG8_WAIT_V(8); PG8_WAIT_L(0); PG8_BAR; PG8_MMA(0, 0, At, B0); PG8_MMA(0, 1, At, B1); PG8_BAR; PG8_SCHED;
            PG8_LDA(At, 0, 1); PG8_STAGE(PG8_SB(0, 0), b2, voffB); PG8_STAGE(PG8_SB(0, 1), b2 + hstepB, voffB); PG8_STAGE(PG8_SA(0, 0), a2, voffA);
            PG8_WAIT_V(8); PG8_WAIT_L(0); PG8_BAR; PG8_MMA(1, 0, At, B0); PG8_MMA(1, 1, At, B1); PG8_BAR; PG8_SCHED;
            PG8_LDB(B0, 1, 0); PG8_LDB(B1, 1, 1); PG8_SCHED; PG8_LDA(At, 1, 0); PG8_STAGE(PG8_SA(0, 1), a2 + hstepA, voffA);
            PG8_WAIT_V(8); PG8_WAIT_L(0); PG8_BAR; PG8_MMA(0, 0, At, B0); PG8_MMA(0, 1, At, B1); PG8_BAR; PG8_SCHED;
            PG8_LDA(At, 1, 1); PG8_STAGE(PG8_SB(1, 0), b3, voffB); PG8_STAGE(PG8_SB(1, 1), b3 + hstepB, voffB); PG8_STAGE(PG8_SA(1, 0), a3, voffA);
            PG8_WAIT_V(8); PG8_WAIT_L(0); PG8_BAR; PG8_MMA(1, 0, At, B0); PG8_MMA(1, 1, At, B1); PG8_BAR; PG8_SCHED;
        }
        if (wr == 0) PG8_BAR;
        { unsigned z_ = 0u; asm volatile("" : "+v"(z_)); const int l2 = (int)__builtin_amdgcn_mbcnt_hi(~0u, __builtin_amdgcn_mbcnt_lo(~0u, z_));
          E(acc, cur, wr, wc, l2 & 15, l2 >> 4);
          E.done(cur, l2); }
        if (!has_next) break;
#pragma unroll
        for (int a = 0; a < 2; ++a)
#pragma unroll
            for (int b = 0; b < 2; ++b)
#pragma unroll
                for (int m = 0; m < 4; ++m)
#pragma unroll
                    for (int n = 0; n < 2; ++n) acc[a][b][m][n] = (f32x4){0.f, 0.f, 0.f, 0.f};
        cur = nxt; cA = nA; cB = nB; ++ui;
        if (wr == 1) PG8_BAR;
    }
    PG8_WAIT_V(0);
    PG8_BAR;
#undef PG8_SA
#undef PG8_SB
#undef PG8_STAGE
#undef PG8_LDA
#undef PG8_LDB
#undef PG8_MMA
#undef PG8_WAIT_V
#undef PG8_WAIT_L
#undef PG8_BAR
#undef PG8_SCHED
#undef PG8_APTR
#undef PG8_BPTR
}
__device__ __forceinline__ int cond_of_pm(int pm) { return pm < 16 ? 0 : 1 + ((pm - 16) >> 2); }
__device__ __forceinline__ int kvrow_of(int row) { return row < MC ? row : MC + ((row - MC) >> 10) * (PAST + DSEQ) + PAST + ((row - MC) & 1023); }
__device__ __forceinline__ u32x4 pack8(const f32x4& a, const f32x4& b) { u32x4 w; w.x = cvt_pk_bf16(a[0], a[1]); w.y = cvt_pk_bf16(a[2], a[3]); w.z = cvt_pk_bf16(b[0], b[1]); w.w = cvt_pk_bf16(b[2], b[3]); return w; }

struct EpiIn {
    static constexpr bool PERM = true;
    const float* sumsq; const float* bias; const float* qn; const float* kn; const f32x2* rope;
    bf16_t* Q; bf16_t* KB; bf16_t* VB; __amdgpu_buffer_rsrc_t as3r; float* new_k; float* new_v; int l; unsigned* ucnt;
    __device__ __forceinline__ void done(const Unit& u, int lane) const {
        if (u.pn >= 6) { asm volatile("s_waitcnt vmcnt(0)" ::: "memory"); if (lane == 0) __hip_atomic_fetch_add(ucnt + (((u.pm >> 4) * 2) + (u.pn - 6)) * 64, 1u, RLX_AGENT); } }
    __device__ __forceinline__ void operator()(const f32x4 (&acc)[2][2][4][2], const Unit& u, int wr, int wc, int fr, int fq) const {
        const int pm = u.pm, pn = u.pn; const bool ctx = pm < 16; const int cond = cond_of_pm(pm);
        const float* bz = bias + cond * 2048 + pn * 256 + wc * 32 + 8 * fq;
        f32x4 bv[2][2];
#pragma unroll
        for (int bj = 0; bj < 2; ++bj)
#pragma unroll
            for (int n = 0; n < 2; ++n) bv[bj][n] = *(const f32x4*)(bz + bj * 128 + 4 * n);
        const int rbase = pm * BM + wr * 64 + fr;
        if (pn < 4) {
            const bool isq = pn < 2; const float* gv = isq ? qn : kn;
            const int G = (pn & 1) * 4 + wc;
            const int cb = 32 * (fq >> 1) + 8 * (fq & 1);
            f32x4 gg[2][2];
#pragma unroll
            for (int bj = 0; bj < 2; ++bj)
#pragma unroll
                for (int n = 0; n < 2; ++n) gg[bj][n] = *(const f32x4*)(gv + cb + 16 * bj + 4 * n);
            const float qs = isq ? C2 : 1.f;
#pragma unroll
            for (int ai = 0; ai < 2; ++ai)
#pragma unroll
                for (int m = 0; m < 4; ++m) {
                    const int row = rbase + ai * HALF + m * 16;
                    const float rstd = rsqrtf(sumsq[row] * (1.f / DM) + EPS);
                    f32x4 v[2][2]; float ss = 0.f;
#pragma unroll
                    for (int bj = 0; bj < 2; ++bj)
#pragma unroll
                        for (int n = 0; n < 2; ++n) { v[bj][n] = acc[ai][bj][m][n] * rstd + bv[bj][n]; const f32x4 t = v[bj][n] * v[bj][n]; ss += (t[0] + t[1]) + (t[2] + t[3]); }
                    { const int ln_ = fq * 16 + fr; ss += shfl_xor_l(ss, 16, ln_); ss += shfl_xor_l(ss, 32, ln_); }
                    const float rn = rsqrtf(ss * (1.f / 64.f) + EPS);
#pragma unroll
                    for (int bj = 0; bj < 2; ++bj)
#pragma unroll
                        for (int n = 0; n < 2; ++n) v[bj][n] = v[bj][n] * rn * gg[bj][n];
                    if (ctx) {
                        if (!isq) { float* nk = new_k + ((size_t)((row >> 8) * DEPTH + l) * SEQ + (row & 255)) * 512 + G * 64 + cb;
#pragma unroll
                            for (int bj = 0; bj < 2; ++bj) { *(f32x4*)(nk + 16 * bj) = v[bj][0]; *(f32x4*)(nk + 16 * bj + 4) = v[bj][1]; } }
                    } else {
                        const int t = (row - MC) & 1023; const int pos = (fq >> 1) ? (t & 63) : (t >> 6);
                        const f32x2* rp = rope + pos * 16 + 8 * (fq & 1);
#pragma unroll
                        for (int n = 0; n < 2; ++n)
#pragma unroll
                            for (int j = 0; j < 4; ++j) { const f32x2 cs = rp[4 * n + j]; const float x1 = v[0][n][j], x2 = v[1][n][j]; v[0][n][j] = x1 * cs.x - x2 * cs.y; v[1][n][j] = x1 * cs.y + x2 * cs.x; }
                    }
                    bf16_t* dst = isq ? (Q + (size_t)row * 512) : (KB + (size_t)kvrow_of(row) * 512);
                    dst += G * 64 + cb;
#pragma unroll
                    for (int bj = 0; bj < 2; ++bj) *(u32x4*)(dst + 16 * bj) = pack8(v[bj][0] * qs, v[bj][1] * qs);
                }
        } else if (pn < 6) {
            const int col0 = (pn - 4) * 256 + wc * 32 + 8 * fq;
#pragma unroll
            for (int ai = 0; ai < 2; ++ai)
#pragma unroll
                for (int m = 0; m < 4; ++m) {
                    const int row = rbase + ai * HALF + m * 16;
                    const float rstd = rsqrtf(sumsq[row] * (1.f / DM) + EPS);
                    bf16_t* dst = VB + (size_t)kvrow_of(row) * 512 + col0;
#pragma unroll
                    for (int bj = 0; bj < 2; ++bj) { const f32x4 a = acc[ai][bj][m][0] * rstd + bv[bj][0], b = acc[ai][bj][m][1] * rstd + bv[bj][1];
                        *(u32x4*)(dst + 128 * bj) = pack8(a, b);
                        if (ctx) { float* nv = new_v + ((size_t)((row >> 8) * DEPTH + l) * SEQ + (row & 255)) * 512 + col0 + 128 * bj; *(f32x4*)nv = a; *(f32x4*)(nv + 4) = b; } }
                }
        } else {
            const int cu0 = (pn - 6) * 256 + wc * 32 + 8 * fq;
#pragma unroll
            for (int ai = 0; ai < 2; ++ai)
#pragma unroll
                for (int m = 0; m < 4; ++m) {
                    const int row = rbase + ai * HALF + m * 16;
                    const float rstd = rsqrtf(sumsq[row] * (1.f / DM) + EPS);
#pragma unroll
                    for (int bj = 0; bj < 2; ++bj) { const int cu = cu0 + 128 * bj; const f32x4 a = acc[ai][bj][m][0] * rstd + bv[bj][0], b = acc[ai][bj][m][1] * rstd + bv[bj][1];
                        __builtin_amdgcn_raw_buffer_store_b128(pack8(a, b), as3r, (int)(((unsigned)((cu >> 4) * NCHUNK + (row >> 4)) * 512u + (row & 15) * 16 + (cu & 15)) * 2u), 0,   16); }
                }
        }
    }
};
struct EpiS1 {
    static constexpr bool PERM = false;
    float* E;
    __device__ __forceinline__ void done(const Unit&, int) const {}
    __device__ __forceinline__ void operator()(const f32x4 (&acc)[2][2][4][2], const Unit& u, int wr, int wc, int fr, int fq) const {
        const int rbase = u.pm * BM + wr * 64 + fr, col0 = wc * 32 + 4 * fq;
#pragma unroll
        for (int ai = 0; ai < 2; ++ai)
#pragma unroll
            for (int m = 0; m < 4; ++m) { float* dst = E + ((size_t)u.g * NCHUNK + rbase + ai * HALF + m * 16) * 256 + col0;
#pragma unroll
                for (int bj = 0; bj < 2; ++bj)
#pragma unroll
                    for (int n = 0; n < 2; ++n) *(f32x4*)(dst + bj * HALF + n * 16) = acc[ai][bj][m][n]; }
    }
};
struct EpiS3 {
    static constexpr bool PERM = true;
    __amdgpu_buffer_rsrc_t zr;
    __device__ __forceinline__ void done(const Unit&, int) const {}
    __device__ __forceinline__ void operator()(const f32x4 (&acc)[2][2][4][2], const Unit& u, int wr, int wc, int fr, int fq) const {
        const int rbase = u.pm * BM + wr * 64 + fr;
#pragma unroll
        for (int ai = 0; ai < 2; ++ai)
#pragma unroll
            for (int m = 0; m < 4; ++m) { const int chunk = rbase + ai * HALF + m * 16;
#pragma unroll
                for (int bj = 0; bj < 2; ++bj) { const int tt = 8 * bj + 2 * wc + (fq >> 1), c0 = 8 * (fq & 1);
                    f32x4 a = acc[ai][bj][m][0], b = acc[ai][bj][m][1];
#pragma unroll
                    for (int j = 0; j < 4; ++j) { a[j] = gelu_tanh_f(a[j]); b[j] = gelu_tanh_f(b[j]); }
                    __builtin_amdgcn_raw_buffer_store_b128(pack8(a, b), zr, (int)((((unsigned)chunk * 16u + tt) * 512u + u.g * 16 + c0) * 2u), 0,   16); } }
    }
};
struct EpiGlu {
    static constexpr bool PERM = true;
    const bf16_t* Z; const float* bg; bf16_t* CAT;
    __device__ __forceinline__ void done(const Unit&, int) const {}
    __device__ __forceinline__ void operator()(const f32x4 (&acc)[2][2][4][2], const Unit& u, int wr, int wc, int fr, int fq) const {
        const int rbase = u.pm * BM + wr * 64 + fr, col0 = u.pn * BM + wc * 32 + 8 * fq;
        f32x4 bv[2][2];
#pragma unroll
        for (int bj = 0; bj < 2; ++bj)
#pragma unroll
            for (int n = 0; n < 2; ++n) bv[bj][n] = *(const f32x4*)(bg + col0 + bj * HALF + 4 * n);
#pragma unroll
        for (int ai = 0; ai < 2; ++ai)
#pragma unroll
            for (int m = 0; m < 4; ++m) { const int row = rbase + ai * HALF + m * 16;
#pragma unroll
                for (int bj = 0; bj < 2; ++bj) { const u32x4 zw = *(const u32x4*)(Z + (size_t)row * 512 + col0 + bj * HALF);
                    f32x4 a = acc[ai][bj][m][0] + bv[bj][0], b = acc[ai][bj][m][1] + bv[bj][1];
                    a[0] = bflo(zw.x) * sigmoid_f(a[0]); a[1] = bfhi(zw.x) * sigmoid_f(a[1]); a[2] = bflo(zw.y) * sigmoid_f(a[2]); a[3] = bfhi(zw.y) * sigmoid_f(a[3]);
                    b[0] = bflo(zw.z) * sigmoid_f(b[0]); b[1] = bfhi(zw.z) * sigmoid_f(b[1]); b[2] = bflo(zw.w) * sigmoid_f(b[2]); b[3] = bfhi(zw.w) * sigmoid_f(b[3]);
                    *(u32x4*)(CAT + (size_t)row * 1024 + 512 + col0 + bj * HALF) = pack8(a, b); } }
    }
};
template <bool IN_F32, bool OUT_F32> struct EpiRes {
    static constexpr bool PERM = true;
    const float* xin0; const float* xin1;
    const bf16_t* xrin;
    float* xout; bf16_t* xrout;
    const float* gate;
    const float* gn; const float* sc;
    bf16_t* XS; float* ssq;
    __device__ __forceinline__ void done(const Unit&, int) const {}
    __device__ __forceinline__ void operator()(const f32x4 (&acc)[2][2][4][2], const Unit& u, int wr, int wc, int fr, int fq) const {
        const int pm = u.pm, cond = cond_of_pm(pm); const int col0 = u.pn * BM + wc * 32 + 8 * fq; const int rbase = pm * BM + wr * 64 + fr;
        const bool donorm = (gn != nullptr);
        f32x4 gt[2][2], gs[2][2];
#pragma unroll
        for (int bj = 0; bj < 2; ++bj)
#pragma unroll
            for (int n = 0; n < 2; ++n) { const int c = col0 + bj * HALF + n * 4; gt[bj][n] = *(const f32x4*)(gate + cond * 6144 + c);
                if (donorm) { const f32x4 g4 = *(const f32x4*)(gn + c), s4 = *(const f32x4*)(sc + cond * 6144 + c); gs[bj][n] = g4 * (s4 + 1.f); } else gs[bj][n] = (f32x4){0.f, 0.f, 0.f, 0.f}; }
        constexpr int RD = IN_F32 ? 2 : 3;
        f32x4 xr[RD][2][2]; u32x4 xb[RD][2];
#define ER_LOAD(G_, SLOT_) do { const int row_ = rbase + ((G_) >> 2) * HALF + ((G_) & 3) * 16; \
            if (IN_F32) { const float* xi_ = (row_ < MC) ? (xin0 + (size_t)row_ * DM) : (xin1 + (size_t)(row_ - MC) * DM); \
                _Pragma("unroll") for (int bj = 0; bj < 2; ++bj) { xr[SLOT_][bj][0] = *(const f32x4*)(xi_ + col0 + bj * HALF); xr[SLOT_][bj][1] = *(const f32x4*)(xi_ + col0 + bj * HALF + 4); } } \
            else { _Pragma("unroll") for (int bj = 0; bj < 2; ++bj) xb[SLOT_][bj] = *(const u32x4*)(xrin + (size_t)row_ * DM + col0 + bj * HALF); } } while (0)
        ER_LOAD(0, 0); ER_LOAD(1, 1); if (RD == 3) ER_LOAD(2, RD - 1);
#pragma unroll
        for (int g = 0; g < 8; ++g) { const int ai = g >> 2, m = g & 3, sl = g % RD; const int row = rbase + ai * HALF + m * 16;
            float ss = 0.f; f32x4 x0[2], x1[2];
#pragma unroll
            for (int bj = 0; bj < 2; ++bj) { f32x4 a, b;
                if (IN_F32) { a = xr[sl][bj][0]; b = xr[sl][bj][1]; } else { const u32x4 w = xb[sl][bj]; a = (f32x4){bflo(w.x), bfhi(w.x), bflo(w.y), bfhi(w.y)}; b = (f32x4){bflo(w.z), bfhi(w.z), bflo(w.w), bfhi(w.w)}; }
                x0[bj] = a + gt[bj][0] * acc[ai][bj][m][0]; x1[bj] = b + gt[bj][1] * acc[ai][bj][m][1]; }
            if (g + RD < 8) ER_LOAD(g + RD, sl);
#pragma unroll
            for (int bj = 0; bj < 2; ++bj) { const int c = col0 + bj * HALF;
                if (OUT_F32) { *(f32x4*)(xout + (size_t)row * DM + c) = x0[bj]; *(f32x4*)(xout + (size_t)row * DM + c + 4) = x1[bj]; }
                else *(u32x4*)(xrout + (size_t)row * DM + c) = pack8(x0[bj], x1[bj]);
                if (donorm) { const f32x4 t0 = x0[bj] * x0[bj], t1 = x1[bj] * x1[bj]; ss += ((t0[0] + t0[1]) + (t0[2] + t0[3])) + ((t1[0] + t1[1]) + (t1[2] + t1[3]));
                    *(u32x4*)(XS + (size_t)row * DM + c) = pack8(x0[bj] * gs[bj][0], x1[bj] * gs[bj][1]); } }
            if (donorm) { { const int ln_ = fq * 16 + fr; ss += shfl_xor_l(ss, 16, ln_); ss += shfl_xor_l(ss, 32, ln_); } if (fq == 0) atomicAdd(ssq + row, ss); }
        }
#undef ER_LOAD
    }
};
struct EpiUp {
    static constexpr bool PERM = true;
    const float* sumsq; const float* bias; bf16_t* UP;
    __device__ __forceinline__ void done(const Unit&, int) const {}
    __device__ __forceinline__ void operator()(const f32x4 (&acc)[2][2][4][2], const Unit& u, int wr, int wc, int fr, int fq) const {
        const int pm = u.pm, cond = cond_of_pm(pm); const int col0 = u.pn * BM + wc * 32 + 8 * fq; const int rbase = pm * BM + wr * 64 + fr;
        f32x4 bv[2][2];
#pragma unroll
        for (int bj = 0; bj < 2; ++bj)
#pragma unroll
            for (int n = 0; n < 2; ++n) bv[bj][n] = *(const f32x4*)(bias + cond * 4096 + col0 + bj * HALF + 4 * n);
#pragma unroll
        for (int ai = 0; ai < 2; ++ai)
#pragma unroll
            for (int m = 0; m < 4; ++m) { const int row = rbase + ai * HALF + m * 16; const float rstd = rsqrtf(sumsq[row] * (1.f / DM) + EPS);
#pragma unroll
                for (int bj = 0; bj < 2; ++bj) *(u32x4*)(UP + (size_t)row * 4096 + col0 + bj * HALF) = pack8(acc[ai][bj][m][0] * rstd + bv[bj][0], acc[ai][bj][m][1] * rstd + bv[bj][1]); }
    }
};

__device__ __forceinline__ float dpp_shr1(float v) { return __uint_as_float((unsigned)__builtin_amdgcn_update_dpp(0, (int)__float_as_uint(v), 0x111, 0xf, 0xf, false)); }
__device__ __forceinline__ float dpp_shl1(float v) { return __uint_as_float((unsigned)__builtin_amdgcn_update_dpp(0, (int)__float_as_uint(v), 0x101, 0xf, 0xf, false)); }
struct EpiUpConv {
    static constexpr bool PERM = true;
    const float* sumsq; const float* bias; const float* cw; const float* cb; bf16_t* G; bf16_t* HALO;
    __device__ __forceinline__ void done(const Unit&, int) const {}
    __device__ __forceinline__ void operator()(const f32x4 (&acc)[2][2][4][2], const Unit& u, int wr, int wc, int fr, int fq) const {
        const int pm = u.pm, pn = u.pn, cond = cond_of_pm(pm);
        const int posv = pn * 256 + wc * 32 + 8 * fq, av = pn * 128 + wc * 32 + 8 * fq;
#pragma unroll
        for (int ai = 0; ai < 2; ++ai) {
            const int tok0 = pm * BM + ai * HALF + wr * 64 + 4 * fr; const int sl = pm * 4 + ai * 2 + wr;
            float rs[4];
#pragma unroll
            for (int m = 0; m < 4; ++m) rs[m] = rsqrtf(sumsq[tok0 + m] * (1.f / DM) + EPS);
#pragma unroll
            for (int n = 0; n < 2; ++n) {
                const f32x4 bvv = *(const f32x4*)(bias + cond * 4096 + posv + 4 * n), bvg = *(const f32x4*)(bias + cond * 4096 + posv + 128 + 4 * n);
                f32x4 pv[4], pg[4];
#pragma unroll
                for (int m = 0; m < 4; ++m) { pv[m] = acc[ai][0][m][n] * rs[m] + bvv; pg[m] = acc[ai][1][m][n] * rs[m] + bvg; }
                f32x4 pvp, pvn, pgp, pgn;
#pragma unroll
                for (int j = 0; j < 4; ++j) { pvp[j] = dpp_shr1(pv[3][j]); pvn[j] = dpp_shl1(pv[0][j]); pgp[j] = dpp_shr1(pg[3][j]); pgn[j] = dpp_shl1(pg[0][j]); }
                const int c = av + 4 * n;
                const f32x4 w0v = *(const f32x4*)(cw + c), w1v = *(const f32x4*)(cw + 4096 + c), w2v = *(const f32x4*)(cw + 8192 + c), cbv = *(const f32x4*)(cb + c);
                const f32x4 w0g = *(const f32x4*)(cw + 2048 + c), w1g = *(const f32x4*)(cw + 4096 + 2048 + c), w2g = *(const f32x4*)(cw + 8192 + 2048 + c), cbg = *(const f32x4*)(cb + 2048 + c);
#pragma unroll
                for (int m = 0; m < 4; ++m) {
                    const f32x4 zv = cbv + w0v * (m == 0 ? pvp : pv[m == 0 ? 0 : m - 1]) + w1v * pv[m] + w2v * (m == 3 ? pvn : pv[m == 3 ? 3 : m + 1]);
                    const f32x4 zg = cbg + w0g * (m == 0 ? pgp : pg[m == 0 ? 0 : m - 1]) + w1g * pg[m] + w2g * (m == 3 ? pgn : pg[m == 3 ? 3 : m + 1]);
                    u32x2 w; w.x = cvt_pk_bf16(silu_f(zg[0]) * zv[0], silu_f(zg[1]) * zv[1]); w.y = cvt_pk_bf16(silu_f(zg[2]) * zv[2], silu_f(zg[3]) * zv[3]);
                    *(u32x2*)(G + (size_t)(tok0 + m) * 2048 + c) = w; }
                if (fr == 0 || fr == 15) { const int m0 = fr == 0 ? 0 : 2;
#pragma unroll
                    for (int mm = 0; mm < 2; ++mm) { const f32x4 a = fr == 0 ? pv[mm] : pv[2 + mm], b = fr == 0 ? pg[mm] : pg[2 + mm];
                        bf16_t* hp = HALO + ((size_t)sl * 4 + m0 + mm) * 4096 + posv + 4 * n;
                        u32x2 wa; wa.x = cvt_pk_bf16(a[0], a[1]); wa.y = cvt_pk_bf16(a[2], a[3]); *(u32x2*)hp = wa;
                        u32x2 wb; wb.x = cvt_pk_bf16(b[0], b[1]); wb.y = cvt_pk_bf16(b[2], b[3]); *(u32x2*)(hp + 128) = wb; } }
            }
        }
    }
};
constexpr int AT_SLOT = 32768, AT_NSLOT = 4, AT_VOFF = 16384, AT_X = 0, AT_ST = 65536;
__device__ __forceinline__ void glds16(const void* gsrc, unsigned lds_dst) { unsigned keep;
    asm volatile("s_mov_b32 %0, m0\n\ts_mov_b32 m0, %2\n\ts_nop 0\n\tglobal_load_lds_dwordx4 %1, off\n\ts_mov_b32 m0, %0" : "=&s"(keep) : "v"(gsrc), "s"(lds_dst) : "memory"); }
#define AT_WAIT_BAR(N) asm volatile("s_waitcnt vmcnt(" #N ") lgkmcnt(0)\n\ts_barrier" ::: "memory")
#define AT_SB() __builtin_amdgcn_sched_barrier(0)
__device__ __forceinline__ s16x4 vtr(const LAS char* p) { typedef short v4i16_t __attribute__((ext_vector_type(4))); return __builtin_bit_cast(s16x4, __builtin_amdgcn_ds_read_tr16_b64_v4i16((LAS v4i16_t*)p)); }
__device__ __forceinline__ int crow(int r, int hi) { return (r & 3) + 8 * (r >> 2) + 4 * hi; }

struct AttnArgs { const bf16_t* Q; const bf16_t* KB; const bf16_t* VB; bf16_t* CAT; const float* subln; float lam; float oml; };

__device__ __forceinline__ void attn_unit(LAS unsigned char* lds, const int tid, const AttnArgs& A, int seq, int h, int qblk) {
    const int lane = tid & 63, r32 = lane & 31, hi = lane >> 5; const int wid = __builtin_amdgcn_readfirstlane(tid >> 6);
    const int rg = wid & 3, s = wid >> 2;
    const bool ctx = seq < NB;
    const int qrow0 = ctx ? seq * SEQ + qblk * 128 : MC + (seq - NB) * DSEQ + qblk * 128;
    const int krow0 = ctx ? seq * SEQ : MC + (seq - NB) * (PAST + DSEQ);
    const int NT = ctx ? SEQ / 64 : (PAST + DSEQ) / 64;
    const unsigned lds0 = (unsigned)(uintptr_t)lds;
    const bf16_t* ksrc0 = A.KB + (size_t)(krow0 + lane) * 512 + h * 128 + wid * 8;
    const bf16_t* vsrc0 = A.VB + (size_t)(krow0 + 16 * (wid & 3) + (lane >> 2)) * 512 + h * 128 + (wid >> 2) * 32 + (lane & 3) * 8;
    const unsigned kdst = lds0 + wid * 1024, vdst = lds0 + AT_VOFF + ((wid >> 2) * 4 + (wid & 3)) * 1024;
#define AT_DMA(t, slot) do { const size_t _o = (size_t)(t) * 64 * 512; const unsigned _s = (unsigned)(slot) * AT_SLOT; \
        glds16(ksrc0 + _o, (unsigned)__builtin_amdgcn_readfirstlane(kdst + _s)); glds16(ksrc0 + _o + 64, (unsigned)__builtin_amdgcn_readfirstlane(kdst + _s + 8 * 1024)); \
        glds16(vsrc0 + _o, (unsigned)__builtin_amdgcn_readfirstlane(vdst + _s)); glds16(vsrc0 + _o + 64, (unsigned)__builtin_amdgcn_readfirstlane(vdst + _s + 8 * 1024)); } while (0)
    AT_DMA(0, 0); AT_DMA(1, 1); AT_DMA(2, 2);
    bf16x8 qr[4];
    { const bf16_t* qp = A.Q + (size_t)(qrow0 + rg * 32 + r32) * 512 + h * 128 + s * 64 + hi * 8;
#pragma unroll
      for (int d0 = 0; d0 < 4; ++d0) qr[d0] = *(const bf16x8*)(qp + d0 * 16); }
    f32x16 o[4];
#pragma unroll
    for (int d0 = 0; d0 < 4; ++d0)
#pragma unroll
        for (int r = 0; r < 16; ++r) o[d0][r] = 0.f;
    float lsum = 0.f;
    const LAS char* kfrag0 = (const LAS char*)lds + (s * 8 + hi) * 1024 + r32 * 16;
    const LAS char* vfrag0 = (const LAS char*)lds + AT_VOFF + ((lane >> 4) & 1) * 32 + (lane & 3) * 8 + (4 * hi + ((lane & 15) >> 2)) * 64;
    f32x16 pc0, pc1;
#define AT_KLOAD(kfr, slot) do { const LAS char* _k = kfrag0 + (slot) * AT_SLOT; _Pragma("unroll") for (int d0 = 0; d0 < 4; ++d0) { kfr[2 * d0] = *(const LAS bf16x8*)(_k + d0 * 2048); kfr[2 * d0 + 1] = *(const LAS bf16x8*)(_k + d0 * 2048 + 512); } } while (0)
#define AT_VLOAD(vv, slot, ks) do { const LAS char* _v = vfrag0 + (slot) * AT_SLOT + (ks) * 1024; _Pragma("unroll") for (int d0 = 0; d0 < 4; ++d0) { const s16x4 lo = vtr(_v + d0 * 4096), hh = vtr(_v + d0 * 4096 + 512); \
        vv[d0] = (bf16x8){lo[0], lo[1], lo[2], lo[3], hh[0], hh[1], hh[2], hh[3]}; } } while (0)
#define AT_EXP2(P, i, W) do { P[2 * (i)] = fast_exp2(P[2 * (i)]); P[2 * (i) + 1] = fast_exp2(P[2 * (i) + 1]); sacc += P[2 * (i)] + P[2 * (i) + 1]; W = cvt_pk_bf16(P[2 * (i)], P[2 * (i) + 1]); } while (0)
    AT_WAIT_BAR(8);
    { bf16x8 kfr[8]; AT_KLOAD(kfr, 0);
#pragma unroll
      for (int r = 0; r < 16; ++r) { pc0[r] = 0.f; pc1[r] = 0.f; }
#pragma unroll
      for (int d0 = 0; d0 < 4; ++d0) { pc0 = __builtin_amdgcn_mfma_f32_32x32x16_bf16(kfr[2 * d0], qr[d0], pc0, 0, 0, 0); pc1 = __builtin_amdgcn_mfma_f32_32x32x16_bf16(kfr[2 * d0 + 1], qr[d0], pc1, 0, 0, 0); } }
    int slot = 0;
    for (int t = 0; t < NT; ++t) {
        const bool has_next = t + 1 < NT;
        if (t + 2 < NT) AT_WAIT_BAR(4); else AT_WAIT_BAR(0);
        if (t + 3 < NT) AT_DMA(t + 3, (slot + 3) & 3);
        const int slot_n = (slot + 1) & 3;
        bf16x8 kfr[8], va[4], vb[4]; u32x4 pw[4]; f32x16 pn0, pn1; float sacc = 0.f;
        const LAS char* kn_ = kfrag0 + slot_n * AT_SLOT;
#define AT_K1(d0) do { kfr[2 * (d0)] = *(const LAS bf16x8*)(kn_ + (d0) * 2048); kfr[2 * (d0) + 1] = *(const LAS bf16x8*)(kn_ + (d0) * 2048 + 512); } while (0)
        if (has_next) { AT_K1(0); AT_K1(1); }
        AT_SB();
        if (has_next) {
#pragma unroll
            for (int r = 0; r < 16; ++r) { pn0[r] = 0.f; pn1[r] = 0.f; }
#pragma unroll
            for (int i = 0; i < 8; ++i) { const int d0 = i >> 1;
                if (i & 1) pn1 = __builtin_amdgcn_mfma_f32_32x32x16_bf16(kfr[2 * d0 + 1], qr[d0], pn1, 0, 0, 0); else pn0 = __builtin_amdgcn_mfma_f32_32x32x16_bf16(kfr[2 * d0], qr[d0], pn0, 0, 0, 0);
                AT_EXP2(pc0, i, pw[i >> 2][i & 3]);
                if (i == 0) AT_K1(2);
                if (i == 1) AT_K1(3);
                if (i == 3) AT_VLOAD(va, slot, 0);
                if (i == 5) AT_VLOAD(vb, slot, 1);
                AT_SB(); }
        } else {
            AT_VLOAD(va, slot, 0); AT_VLOAD(vb, slot, 1);
#pragma unroll
            for (int i = 0; i < 8; ++i) AT_EXP2(pc0, i, pw[i >> 2][i & 3]);
            AT_SB();
        }
        bf16x8 vc[4], vd[4];
#pragma unroll
        for (int i = 0; i < 8; ++i) { const int d0 = i & 3;
            if (i < 4) o[d0] = __builtin_amdgcn_mfma_f32_32x32x16_bf16(va[d0], __builtin_bit_cast(bf16x8, pw[0]), o[d0], 0, 0, 0);
            else       o[d0] = __builtin_amdgcn_mfma_f32_32x32x16_bf16(vb[d0], __builtin_bit_cast(bf16x8, pw[1]), o[d0], 0, 0, 0);
            AT_EXP2(pc1, i, pw[2 + (i >> 2)][i & 3]);
            if (i == 1) AT_VLOAD(vc, slot, 2);
            if (i == 5) AT_VLOAD(vd, slot, 3);
            AT_SB(); }
#pragma unroll
        for (int d0 = 0; d0 < 4; ++d0) o[d0] = __builtin_amdgcn_mfma_f32_32x32x16_bf16(vc[d0], __builtin_bit_cast(bf16x8, pw[2]), o[d0], 0, 0, 0);
#pragma unroll
        for (int d0 = 0; d0 < 4; ++d0) o[d0] = __builtin_amdgcn_mfma_f32_32x32x16_bf16(vd[d0], __builtin_bit_cast(bf16x8, pw[3]), o[d0], 0, 0, 0);
        lsum += sacc;
        if (has_next) { pc0 = pn0; pc1 = pn1; }
        slot = slot_n;
    }
    lsum += shfl_xor_l(lsum, 32, lane);
    const float inv = (s == 0 ? 1.f : A.lam) / lsum;
    AT_WAIT_BAR(0);
    LAS float* X = (LAS float*)(lds + AT_X) + rg * 4096;
    if (s == 1) {
#pragma unroll
        for (int d0 = 0; d0 < 4; ++d0)
#pragma unroll
            for (int r = 0; r < 16; ++r) X[(d0 * 16 + r) * 64 + lane] = o[d0][r] * inv;
    }
    AT_WAIT_BAR(0);
    if (s == 0) {
        float ss = 0.f;
#pragma unroll
        for (int d0 = 0; d0 < 4; ++d0)
#pragma unroll
            for (int r = 0; r < 16; ++r) { const float v = o[d0][r] * inv - X[(d0 * 16 + r) * 64 + lane]; o[d0][r] = v; ss += v * v; }
        ss += shfl_xor_l(ss, 32, lane);
        const float rn = rsqrtf(ss * (1.f / 128.f) + EPS) * A.oml;
        LAS bf16_t* stg = (LAS bf16_t*)(lds + AT_ST) + rg * (32 * 136);
#pragma unroll
        for (int d0 = 0; d0 < 4; ++d0)
#pragma unroll
            for (int rq = 0; rq < 4; ++rq) { const int dv = 32 * d0 + 8 * rq + 4 * hi; const f32x4 g4 = *(const f32x4*)(A.subln + dv);
                u32x2 w; w.x = cvt_pk_bf16(o[d0][4 * rq] * rn * g4[0], o[d0][4 * rq + 1] * rn * g4[1]); w.y = cvt_pk_bf16(o[d0][4 * rq + 2] * rn * g4[2], o[d0][4 * rq + 3] * rn * g4[3]);
                *(LAS u32x2*)(stg + r32 * 136 + dv) = w; }
        asm volatile("s_waitcnt lgkmcnt(0)" ::: "memory");
        bf16_t* dst = A.CAT + (size_t)(qrow0 + rg * 32) * 1024 + h * 128;
#pragma unroll
        for (int i = 0; i < 8; ++i) { const int row = i * 4 + (lane >> 4), ch = lane & 15; const u32x4 v = *(const LAS u32x4*)(stg + row * 136 + ch * 8); *(u32x4*)(dst + (size_t)row * 1024 + ch * 8) = v; }
    }
    AT_WAIT_BAR(0);
#undef AT_DMA
#undef AT_KLOAD
#undef AT_K1
#undef AT_VLOAD
#undef AT_EXP2
}
struct Args { const float* in[34]; float* out; unsigned char* ws; int stop_after; int pad; };
typedef const __attribute__((address_space(4))) Args* kargs_t;
struct Frame {
    LAS unsigned char* lds; int tid, lane, wave, vcu, bid, G;
    kargs_t ka; float* out; unsigned char* ws;
    float* misc; unsigned* ctl;
};
#define LDS_WAIT() asm volatile("s_waitcnt lgkmcnt(0)" ::: "memory")
#define VM_WAIT() asm volatile("s_waitcnt vmcnt(0)" ::: "memory")

template <int MAP> __device__ __forceinline__ int src_col(int p);
template <int MODE, int MAP, int NC> __device__ __forceinline__ void gemv9_task(Frame& F, const float* W, int ldw, int l, int voff, int strip, float* out, int ldo, const float* add) {
    LAS float* sc = (LAS float*)F.lds; LAS float* red = sc + 9 * 1024;
    for (int i = F.tid; i < 9 * 1024; i += NTHREADS) { const int cond = i >> 10, k = i & 1023; float v;
        if (MODE == 0) { v = cond == 0 ? F.ka->in[6][k] : F.ka->in[5][(cond - 1) * 1024 + k]; v = v / (1.f + expf(-v)); } else v = F.misc[MI_MOD + (l * 9 + cond) * 6144 + voff + k];
        sc[i] = v; }
    __syncthreads();
    const int j = strip * NC + (F.lane < NC ? F.lane : NC - 1); const float* w = W + (size_t)(F.wave * 128) * ldw + src_col<MAP>(j);
    float acc[9];
#pragma unroll
    for (int b = 0; b < 9; ++b) acc[b] = 0.f;
#pragma unroll 16
    for (int k = 0; k < 128; ++k) { const float wv = w[(size_t)k * ldw];
#pragma unroll
        for (int b = 0; b < 9; ++b) acc[b] += sc[b * 1024 + F.wave * 128 + k] * wv; }
#pragma unroll
    for (int b = 0; b < 9; ++b) red[(F.wave * 9 + b) * 64 + F.lane] = acc[b];
    __syncthreads();
    for (int i = F.tid; i < 9 * 64; i += NTHREADS) { const int b = i >> 6, ln = i & 63; if (ln >= NC) continue; float s_ = 0.f;
#pragma unroll
        for (int w8 = 0; w8 < 8; ++w8) s_ += red[(w8 * 9 + b) * 64 + ln];
        const int jj = strip * NC + ln; out[(size_t)b * ldo + jj] = s_ + (add ? add[jj] : 0.f); }
    __syncthreads();
}
template <int MAP> __device__ __forceinline__ int src_col(int p) {
    if (MAP == 1) { if (p >= 1024) return p; const int pn = p >> 8, r = p & 255, bj = r >> 7, wc = (r >> 5) & 3, fq = (r >> 3) & 3, low = r & 7; return 256 * pn + 64 * wc + 32 * (fq >> 1) + 16 * bj + 8 * (fq & 1) + low; }
    if (MAP == 2) { const int pn = p >> 8, bj = (p >> 7) & 1, r = p & 127; return bj * 2048 + 128 * pn + r; }
    return p;
}
__device__ __forceinline__ void mod_task3(Frame& F, int task) {
    const int l = task / 96, r = task % 96, kq = r / 24, cg = r % 24;
    LAS float* sc = (LAS float*)F.lds; LAS float* red = sc + 9 * 256;
    for (int i = F.tid; i < 9 * 256; i += NTHREADS) { const int cond = i >> 8, k = kq * 256 + (i & 255); const float v = cond == 0 ? F.ka->in[6][k] : F.ka->in[5][(cond - 1) * 1024 + k]; sc[i] = v / (1.f + expf(-v)); }
    __syncthreads();
    const float* w = F.ka->in[7] + ((size_t)l * DM + kq * 256 + F.wave * 32) * 6144 + cg * 256 + F.lane * 4;
    f32x4 acc[9];
#pragma unroll
    for (int b = 0; b < 9; ++b) acc[b] = (f32x4){0.f, 0.f, 0.f, 0.f};
#pragma unroll
    for (int h = 0; h < 2; ++h) { f32x4 wv[16];
#pragma unroll
        for (int k = 0; k < 16; ++k) wv[k] = *(const f32x4*)(w + (size_t)(h * 16 + k) * 6144);
#pragma unroll
        for (int k = 0; k < 16; ++k)
#pragma unroll
            for (int b = 0; b < 9; ++b) acc[b] += wv[k] * sc[b * 256 + F.wave * 32 + h * 16 + k]; }
#pragma unroll
    for (int b = 0; b < 9; ++b) *(LAS f32x4*)(red + (F.wave * 9 + b) * 256 + F.lane * 4) = acc[b];
    __syncthreads();
    for (int i = F.tid; i < 9 * 256; i += NTHREADS) { const int b = i >> 8, c = i & 255; float v = 0.f;
#pragma unroll
        for (int w8 = 0; w8 < 8; ++w8) v += red[(w8 * 9 + b) * 256 + c];
        const int col = cg * 256 + c; if (kq == 0) v += F.ka->in[8][l * 6144 + col];
        atomicAdd(F.misc + MI_MOD + (l * 9 + b) * 6144 + col, v); }
    __syncthreads();
}
template <int MAP, bool BIAS> __device__ __forceinline__ void transpose_item(Frame& F, const float* W, int K, int N, bf16_t* WT, LAS float* scr, int item, const float* shv, float* bias) {
    const int lane = F.lane; const int nblk = N / 64, kb = item / nblk, nb = item % nblk, k0 = 64 * kb, n0 = 64 * nb;
    const int sc_ = src_col<MAP>(n0 + lane);
    float tv[64];
#pragma unroll
    for (int i = 0; i < 64; ++i) tv[i] = W[(size_t)(k0 + i) * N + sc_];
#pragma unroll
    for (int i = 0; i < 64; ++i) scr[i * 65 + lane] = tv[i];
    LDS_WAIT(); asm volatile("" ::: "memory");
    const int c = lane & 7;
#pragma unroll
    for (int j = 0; j < 8; ++j) { const int n = (lane >> 3) + 8 * j; const LAS float* s_ = scr + (8 * c) * 65 + n;
        u32x4 o; o.x = cvt_pk_bf16(s_[0 * 65], s_[1 * 65]); o.y = cvt_pk_bf16(s_[2 * 65], s_[3 * 65]); o.z = cvt_pk_bf16(s_[4 * 65], s_[5 * 65]); o.w = cvt_pk_bf16(s_[6 * 65], s_[7 * 65]);
        *(u32x4*)(WT + (size_t)(n0 + n) * K + k0 + 8 * c) = o; }
    if (BIAS) {
        float sh[9], acc[9];
#pragma unroll
        for (int b = 0; b < 9; ++b) { sh[b] = shv[b * 6144 + k0 + lane]; acc[b] = 0.f; }
#pragma unroll
        for (int kk = 0; kk < 64; ++kk) { const float w = tv[kk];
#pragma unroll
            for (int b = 0; b < 9; ++b) acc[b] += __uint_as_float(__builtin_amdgcn_readlane(__float_as_uint(sh[b]), kk)) * w; }
#pragma unroll
        for (int b = 0; b < 9; ++b) atomicAdd(bias + (size_t)b * N + n0 + lane, acc[b]);
    }
    LDS_WAIT(); asm volatile("" ::: "memory");
}
__device__ __forceinline__ void cache_item(Frame& F, int l, int item4) {
    f32x4 a[4], c[4];
#pragma unroll
    for (int i = 0; i < 4; ++i) { const int item = item4 * 4 + i, which = item >> 12, r = item & 4095, b = r >> 9, j = r & 511;
        const float* src = (which ? F.ka->in[3] : F.ka->in[2]) + ((size_t)(b * DEPTH + l) * PAST + j) * 512 + F.lane * 8; a[i] = *(const f32x4*)src; c[i] = *(const f32x4*)(src + 4); }
#pragma unroll
    for (int i = 0; i < 4; ++i) { const int item = item4 * 4 + i, which = item >> 12, r = item & 4095, b = r >> 9, j = r & 511;
        bf16_t* dst = (bf16_t*)(F.ws + (which ? WS_VB : WS_KB)) + (size_t)(MC + b * (PAST + DSEQ) + j) * 512 + F.lane * 8; *(u32x4*)dst = pack8(a[i], c[i]); }
}
__device__ __forceinline__ f32x2 cmul(f32x2 a, f32x2 b) { return (f32x2){a.x * b.x - a.y * b.y, a.x * b.y + a.y * b.x}; }
__device__ __forceinline__ void ssm_prep(Frame& F, int l, int task) {
    const int g = task >> 1, half = task & 1;
    LAS f32x2* POW = (LAS f32x2*)F.lds;
    LAS f32x2* BB = POW + 2 * 17 * 64;
    LAS f32x2* CC = BB + 2 * 64 * 16;
    LAS f32x2* CT = CC + 2 * 16 * 64;
    LAS float* KT = (LAS float*)(CT + 2 * 64 * 16);
    constexpr int KTS = 260;
    bf16_t* WE = (bf16_t*)(F.ws + WS_SSM + SSM_WE) + (size_t)g * 256 * 256;
    bf16_t* WY = (bf16_t*)(F.ws + WS_SSM + SSM_WY) + (size_t)g * 256 * 512;
    f32x2* LAM16 = (f32x2*)(F.ws + WS_SSM + SSM_LAM16); f32x2* BBAR = (f32x2*)(F.ws + WS_SSM + SSM_BBAR);
    const int tid = F.tid, lane = F.lane;
    if (tid < 128) { const int dir = tid >> 6, p = tid & 63; const size_t pi = ((size_t)(l * 2 + dir) * NG + g) * 64 + p;
        const float lr = F.ka->in[18][pi], li = F.ka->in[19][pi], delta = expf(F.ka->in[20][(l * 2 + dir) * NG + g]);
        const float er = expf(lr * delta), lbr = er * cosf(li * delta), lbi = er * sinf(li * delta);
        { float one_ = 1.f, zero_ = 0.f; asm volatile("" : "+v"(one_), "+v"(zero_));
          f32x2 pw = (f32x2){one_, zero_}; const f32x2 lb = (f32x2){lbr, lbi};
          for (int tau = 0; tau <= 16; ++tau) { POW[(dir * 17 + tau) * 64 + p] = pw; if (tau == 16 && half == 0) LAM16[(dir * NG + g) * 64 + p] = pw; pw = cmul(pw, lb); } }
        const float nr = lbr - 1.f, ni = lbi, den = lr * lr + li * li; const f32x2 fac = (f32x2){(nr * lr + ni * li) / den, (ni * lr - nr * li) / den};
        f32x4 br[4], bi4[4];
#pragma unroll
        for (int q = 0; q < 4; ++q) { br[q] = *(const f32x4*)(F.ka->in[21] + pi * 16 + 4 * q); bi4[q] = *(const f32x4*)(F.ka->in[22] + pi * 16 + 4 * q); }
#pragma unroll
        for (int ch = 0; ch < 16; ++ch) { const f32x2 bb = cmul(fac, (f32x2){br[ch >> 2][ch & 3], bi4[ch >> 2][ch & 3]}); BB[(dir * 64 + p) * 16 + ch] = bb; if (half == 0) BBAR[((size_t)(dir * NG + g) * 64 + p) * 16 + ch] = bb; }
    }
    { f32x2 cv[4];
#pragma unroll
      for (int q = 0; q < 4; ++q) { const int i = tid + q * NTHREADS, dir = i >> 10, c = (i >> 6) & 15, p = i & 63; const size_t ci = (((size_t)(l * 2 + dir) * NG + g) * 16 + c) * 64 + p; cv[q] = (f32x2){F.ka->in[23][ci], F.ka->in[24][ci]}; }
#pragma unroll
      for (int q = 0; q < 4; ++q) { const int i = tid + q * NTHREADS, dir = i >> 10, c = (i >> 6) & 15, p = i & 63; CC[i] = cv[q]; CT[(dir * 64 + p) * 16 + c] = cv[q]; } }
    __syncthreads();
    { const int i16 = lane & 15, k4 = lane >> 4, ri = k4 & 1, ph = k4 >> 1;
      for (int blk = 0; blk < 4; ++blk) { const int q = F.wave * 4 + blk, dir = q >> 4, tau = q & 15; f32x4 acc = (f32x4){0.f, 0.f, 0.f, 0.f};
#pragma unroll 8
          for (int ks = 0; ks < 32; ++ks) { const int p = 2 * ks + ph;
              const f32x2 cc = CT[(dir * 64 + p) * 16 + i16], pw = POW[(dir * 17 + tau) * 64 + p], bb = BB[(dir * 64 + p) * 16 + i16];
              const float u = ri ? -pw.y : pw.x, v = ri ? pw.x : pw.y;
              const float av = cc.x * u - cc.y * v, bv = ri ? bb.y : bb.x;
              acc = __builtin_amdgcn_mfma_f32_16x16x4f32(av, bv, acc, 0, 0, 0); }
#pragma unroll
          for (int r = 0; r < 4; ++r) KT[(dir * 16 + tau) * KTS + (k4 * 4 + r) * 16 + i16] = acc[r]; } }
    __syncthreads();
    const float* Dv = F.ka->in[25] + l * 512 + g * 16;
    for (int idx = half * 8192 + tid; idx < (half + 1) * 8192; idx += NTHREADS) { const int n = idx >> 6, kc = idx & 63, k0 = kc * 8, i = n >> 4, c = n & 15; f32x4 v0, v1;
        if (k0 < 256) { const int s_ = k0 >> 4, ch0 = k0 & 15; v0 = (f32x4){0.f, 0.f, 0.f, 0.f}; v1 = v0;
            if (s_ <= i) { const LAS float* kp = KT + (i - s_) * KTS + c * 16 + ch0; v0 += *(const LAS f32x4*)kp; v1 += *(const LAS f32x4*)(kp + 4); }
            if (s_ >= i) { const LAS float* kp = KT + (16 + s_ - i) * KTS + c * 16 + ch0; v0 += *(const LAS f32x4*)kp; v1 += *(const LAS f32x4*)(kp + 4); }
            if (s_ == i) { const int e = c - ch0; const float dv = Dv[c]; if (e >= 0 && e < 4) v0[e] += dv; else if (e >= 4 && e < 8) v1[e - 4] += dv; }
        } else { const int dir = k0 >= 384 ? 1 : 0, p0 = ((k0 - 256) & 127) >> 1, tau = dir ? 16 - i : i + 1;
            const LAS f32x4* cp = (const LAS f32x4*)(CC + (dir * 16 + c) * 64 + p0); const LAS f32x4* pp = (const LAS f32x4*)(POW + (dir * 17 + tau) * 64 + p0);
            const f32x4 c0 = cp[0], c1 = cp[1], w0 = pp[0], w1 = pp[1];
            v0 = (f32x4){c0[0] * w0[0] - c0[1] * w0[1], -(c0[0] * w0[1] + c0[1] * w0[0]), c0[2] * w0[2] - c0[3] * w0[3], -(c0[2] * w0[3] + c0[3] * w0[2])};
            v1 = (f32x4){c1[0] * w1[0] - c1[1] * w1[1], -(c1[0] * w1[1] + c1[1] * w1[0]), c1[2] * w1[2] - c1[3] * w1[3], -(c1[2] * w1[3] + c1[3] * w1[2])}; }
        *(u32x4*)(WY + (size_t)n * 512 + k0) = pack8(v0, v1); }
    for (int idx = half * 4096 + tid; idx < (half + 1) * 4096; idx += NTHREADS) { const int n = idx >> 5, k0 = (idx & 31) * 8, dir = n >> 7, p = (n & 127) >> 1, ri = n & 1, s_ = k0 >> 4, ch0 = k0 & 15;
        const f32x2 pw = POW[(dir * 17 + (dir ? s_ : 15 - s_)) * 64 + p]; const LAS f32x4* bp = (const LAS f32x4*)(BB + (dir * 64 + p) * 16 + ch0);
        const float u = ri ? pw.y : pw.x, v = ri ? pw.x : -pw.y;
        const f32x4 b0 = bp[0], b1 = bp[1], b2 = bp[2], b3 = bp[3];
        const f32x4 v0 = (f32x4){u * b0[0] + v * b0[1], u * b0[2] + v * b0[3], u * b1[0] + v * b1[1], u * b1[2] + v * b1[3]};
        const f32x4 v1 = (f32x4){u * b2[0] + v * b2[1], u * b2[2] + v * b2[3], u * b3[0] + v * b3[1], u * b3[2] + v * b3[3]};
        *(u32x4*)(WE + (size_t)n * 256 + k0) = pack8(v0, v1); }
    __syncthreads();
}
__device__ __forceinline__ void xprep_item(Frame& F, int item4) {
    f32x4 xv[4][4];
#pragma unroll
    for (int i = 0; i < 4; ++i) { const int row = item4 * 4 + i; const float* xr = (row < MC) ? F.ka->in[0] + (size_t)row * DM : F.ka->in[1] + (size_t)(row - MC) * DM;
#pragma unroll
        for (int j = 0; j < 4; ++j) xv[i][j] = *(const f32x4*)(xr + 4 * F.lane + 256 * j); }
    const int cond = item4 * 4 < MC ? 0 : 1 + ((item4 * 4 - MC) >> 10);
    const float* sc = F.misc + MI_MOD + (0 * 9 + cond) * 6144 + 1024; const float* g1 = F.ka->in[9];
    f32x4 gs[4];
#pragma unroll
    for (int j = 0; j < 4; ++j) { const int c = 4 * F.lane + 256 * j; gs[j] = (*(const f32x4*)(g1 + c)) * (*(const f32x4*)(sc + c) + 1.f); }
#pragma unroll
    for (int i = 0; i < 4; ++i) { const int row = item4 * 4 + i; bf16_t* dst = (bf16_t*)(F.ws + WS_XS) + (size_t)row * DM; float s = 0.f;
#pragma unroll
        for (int j = 0; j < 4; ++j) { const f32x4 x = xv[i][j]; const f32x4 t = x * x; s += (t[0] + t[1]) + (t[2] + t[3]); const f32x4 y = x * gs[j];
            u32x2 w; w.x = cvt_pk_bf16(y[0], y[1]); w.y = cvt_pk_bf16(y[2], y[3]); *(u32x2*)(dst + 4 * F.lane + 256 * j) = w; }
        s = wave_sum(s, F.lane);
        if (F.lane == 0) ((float*)(F.ctl + CW_SS))[row] = s; }
}
__device__ __forceinline__ void bias_item(Frame& F, int item) {
    const int which = item >= 2048, n = which ? item - 2048 : item;
    const bf16_t* wrow = (const bf16_t*)(F.ws + (which ? WS_WUP : WS_WIN)) + (size_t)n * DM;
    float wv[16]; { const u32x4 a = *(const u32x4*)(wrow + F.lane * 8), b = *(const u32x4*)(wrow + 512 + F.lane * 8);
        wv[0] = bflo(a.x); wv[1] = bfhi(a.x); wv[2] = bflo(a.y); wv[3] = bfhi(a.y); wv[4] = bflo(a.z); wv[5] = bfhi(a.z); wv[6] = bflo(a.w); wv[7] = bfhi(a.w);
        wv[8] = bflo(b.x); wv[9] = bfhi(b.x); wv[10] = bflo(b.y); wv[11] = bfhi(b.y); wv[12] = bflo(b.z); wv[13] = bfhi(b.z); wv[14] = bflo(b.w); wv[15] = bfhi(b.w); }
    float outv = 0.f;
#pragma unroll
    for (int cond = 0; cond < 9; ++cond) { const float* sh = F.misc + MI_MOD + cond * 6144 + (which ? 3072 : 0);
        const f32x4 s0 = *(const f32x4*)(sh + F.lane * 8), s1 = *(const f32x4*)(sh + F.lane * 8 + 4), s2 = *(const f32x4*)(sh + 512 + F.lane * 8), s3 = *(const f32x4*)(sh + 512 + F.lane * 8 + 4);
        float d = 0.f;
#pragma unroll
        for (int e = 0; e < 4; ++e) d += s0[e] * wv[e] + s1[e] * wv[4 + e] + s2[e] * wv[8 + e] + s3[e] * wv[12 + e];
        d = wave_sum(d, F.lane); if (F.lane == cond) outv = d; }
    if (F.lane < 9) ((float*)F.ctl)[(which ? CW_BUP + F.lane * 4096 : CW_BIN + F.lane * 2048) + n] = outv;
}
__device__ __forceinline__ void ssm_scan(Frame& F, int l, int g, int pm) {
    const int tid = F.tid, sl = tid >> 7, dp = tid & 127, dir = dp >> 6, p = dp & 63;
    const f32x2* LAM16 = (const f32x2*)(F.ws + WS_SSM + SSM_LAM16); const f32x2* BBAR = (const f32x2*)(F.ws + WS_SSM + SSM_BBAR);
    const float* E = (const float*)(F.ws + WS_R + R_E); bf16_t* AS3 = (bf16_t*)(F.ws + WS_R + R_AS3);
    const f32x2 lam = LAM16[(dir * NG + g) * 64 + p];
    f32x2 e[64];
    if (pm == 0) {
#pragma unroll
        for (int q = 0; q < 4; ++q) { const float* ep = E + ((size_t)g * NCHUNK + (q * 4 + sl) * 16) * 256 + dir * 128 + 2 * p;
#pragma unroll
            for (int j = 0; j < 16; ++j) e[q * 16 + j] = *(const f32x2*)(ep + (size_t)j * 256); }
    } else { const float* ep = E + ((size_t)g * NCHUNK + 256 + ((pm - 1) * 4 + sl) * 64) * 256 + dir * 128 + 2 * p;
#pragma unroll
        for (int j = 0; j < 64; ++j) e[j] = *(const f32x2*)(ep + (size_t)j * 256); }
    const int nq = pm == 0 ? 4 : 1;
#pragma unroll
    for (int q = 0; q < 4; ++q) { if (q >= nq) break;
        int base; f32x2 h;
        if (pm == 0) { const int seq = q * 4 + sl; base = seq * 16; h = (f32x2){0.f, 0.f}; }
        else { const int sq = (pm - 1) * 4 + sl; base = 256 + sq * 64; h = *(const f32x2*)(F.ka->in[4] + ((((size_t)sq * DEPTH + l) * 2 + dir) * NG + g) * 128 + 2 * p); }
        unsigned* hp = (unsigned*)(AS3 + ((size_t)g * NCHUNK + base) * 512 + 256 + dir * 128 + 2 * p);
        if (pm == 0) {
#pragma unroll
            for (int jj = 0; jj < 16; ++jj) { const int j = dir ? 15 - jj : jj; const f32x2 ev = dir ? e[q * 16 + 15 - jj] : e[q * 16 + jj]; hp[(size_t)j * 256] = cvt_pk_bf16(h.x, h.y); h = cmul(lam, h) + ev; }
        } else {
#pragma unroll
            for (int jj = 0; jj < 64; ++jj) { const int j = dir ? 63 - jj : jj; const f32x2 ev = dir ? e[63 - jj] : e[jj]; hp[(size_t)j * 256] = cvt_pk_bf16(h.x, h.y); h = cmul(lam, h) + ev; }
        }
    }
    if (pm == 0) {
        const int tt = dir ? 15 : 0; u32x4 uq[4][2]; f32x2 bbv[16];
        const f32x2* bb = BBAR + ((size_t)(dir * NG + g) * 64 + p) * 16;
#pragma unroll
        for (int ch = 0; ch < 16; ++ch) bbv[ch] = bb[ch];
#pragma unroll
        for (int q = 0; q < 4; ++q) { const int chunk = (q * 4 + sl) * 16 + tt; const bf16_t* up = AS3 + ((size_t)g * NCHUNK + chunk) * 512 + tt * 16; uq[q][0] = *(const u32x4*)up; uq[q][1] = *(const u32x4*)(up + 8); }
        float* ns = F.out + (size_t)MT * DM + 2 * (size_t)NB * DEPTH * SEQ * 512;
#pragma unroll
        for (int q = 0; q < 4; ++q) { const int seq = q * 4 + sl; const u32x4 u0 = uq[q][0], u1 = uq[q][1];
            const float uu[16] = {bflo(u0.x), bfhi(u0.x), bflo(u0.y), bfhi(u0.y), bflo(u0.z), bfhi(u0.z), bflo(u0.w), bfhi(u0.w), bflo(u1.x), bfhi(u1.x), bflo(u1.y), bfhi(u1.y), bflo(u1.z), bfhi(u1.z), bflo(u1.w), bfhi(u1.w)};
            f32x2 acc = (f32x2){0.f, 0.f};
#pragma unroll
            for (int ch = 0; ch < 16; ++ch) acc += bbv[ch] * uu[ch];
            *(f32x2*)(ns + ((((size_t)seq * DEPTH + l) * 2 + dir) * NG + g) * 128 + 2 * p) = acc; }
    }
}
__device__ __forceinline__ void ld16(const bf16_t* p, float* v) { const u32x4 a = *(const u32x4*)p; v[0] = bflo(a.x); v[1] = bfhi(a.x); v[2] = bflo(a.y); v[3] = bfhi(a.y); v[4] = bflo(a.z); v[5] = bfhi(a.z); v[6] = bflo(a.w); v[7] = bfhi(a.w); }
__device__ __forceinline__ void conv_item(Frame& F, int l, int item) {
    const int rs = item >> 4, pn = item & 15, lr = F.lane >> 4, lc = F.lane & 15;
    const int r0 = rs * 64 + lr * 16; const int av = 128 * pn + 8 * lc;
    const bf16_t* up = (const bf16_t*)(F.ws + WS_R) + (size_t)r0 * 4096 + 256 * pn + 8 * lc; bf16_t* gp = (bf16_t*)(F.ws + WS_G) + (size_t)r0 * 2048 + av;
    const float* cw = F.ka->in[31] + (size_t)l * 3 * 4096; const float* cb = F.ka->in[32] + (size_t)l * 4096;
    float wv[3][8], wg[3][8], bv[8], bg[8];
#pragma unroll
    for (int k = 0; k < 3; ++k)
#pragma unroll
        for (int e = 0; e < 8; ++e) { wv[k][e] = cw[k * 4096 + av + e]; wg[k][e] = cw[k * 4096 + 2048 + av + e]; }
#pragma unroll
    for (int e = 0; e < 8; ++e) { bv[e] = cb[av + e]; bg[e] = cb[2048 + av + e]; }
    const int t0 = r0 < MC ? (r0 & 255) : ((r0 - MC) & 1023), L = r0 < MC ? SEQ : DSEQ;
    float pv[8], pg[8], cv[8], cg[8], nv_[8], ng[8];
    if (t0 > 0) { ld16(up - 4096, pv); ld16(up - 4096 + 128, pg); } else {
#pragma unroll
        for (int e = 0; e < 8; ++e) { pv[e] = 0.f; pg[e] = 0.f; } }
    ld16(up, cv); ld16(up + 128, cg);
#pragma unroll
    for (int i = 0; i < 16; ++i) {
        if (t0 + i + 1 < L) { ld16(up + (size_t)(i + 1) * 4096, nv_); ld16(up + (size_t)(i + 1) * 4096 + 128, ng); } else {
#pragma unroll
            for (int e = 0; e < 8; ++e) { nv_[e] = 0.f; ng[e] = 0.f; } }
        float o[8];
#pragma unroll
        for (int e = 0; e < 8; ++e) { const float zv = bv[e] + wv[0][e] * pv[e] + wv[1][e] * cv[e] + wv[2][e] * nv_[e]; const float zg = bg[e] + wg[0][e] * pg[e] + wg[1][e] * cg[e] + wg[2][e] * ng[e]; o[e] = silu_f(zg) * zv; }
        u32x4 w; w.x = cvt_pk_bf16(o[0], o[1]); w.y = cvt_pk_bf16(o[2], o[3]); w.z = cvt_pk_bf16(o[4], o[5]); w.w = cvt_pk_bf16(o[6], o[7]);
        *(u32x4*)(gp + (size_t)i * 2048) = w;
#pragma unroll
        for (int e = 0; e < 8; ++e) { pv[e] = cv[e]; pg[e] = cg[e]; cv[e] = nv_[e]; cg[e] = ng[e]; }
    }
}

__device__ __forceinline__ bool slab_first(int s) { return s < 64 ? (s & 3) == 0 : ((s - 64) & 15) == 0; }
__device__ __forceinline__ bool slab_last(int s) { return s < 64 ? (s & 3) == 3 : ((s - 64) & 15) == 15; }
__device__ __forceinline__ void ld4bf(const bf16_t* p, float* v) { const u32x2 a = *(const u32x2*)p; v[0] = bflo(a.x); v[1] = bfhi(a.x); v[2] = bflo(a.y); v[3] = bfhi(a.y); }
__device__ __forceinline__ void conv_fix(Frame& F, int l, int pm) {
    const bf16_t* HALO = (const bf16_t*)(F.ws + WS_HALO); bf16_t* G = (bf16_t*)(F.ws + WS_G);
    const float* cw = F.ka->in[31] + (size_t)l * 3 * 4096; const float* cb = F.ka->in[32] + (size_t)l * 4096;
    const int c = F.tid * 4, pos = 256 * (c >> 7) + (c & 127);
    float wv[3][4], wg[3][4], bv[4], bg[4];
#pragma unroll
    for (int k = 0; k < 3; ++k) { const f32x4 a = *(const f32x4*)(cw + k * 4096 + c), b = *(const f32x4*)(cw + k * 4096 + 2048 + c);
#pragma unroll
        for (int e = 0; e < 4; ++e) { wv[k][e] = a[e]; wg[k][e] = b[e]; } }
    { const f32x4 a = *(const f32x4*)(cb + c), b = *(const f32x4*)(cb + 2048 + c);
#pragma unroll
      for (int e = 0; e < 4; ++e) { bv[e] = a[e]; bg[e] = b[e]; } }
#pragma unroll
    for (int r8 = 0; r8 < 8; ++r8) { const int s = pm * 4 + (r8 >> 1), which = r8 & 1;
        if (which == 0 ? slab_first(s) : slab_last(s)) continue;
        const bf16_t* hp = which == 0 ? HALO + ((size_t)(s - 1) * 4 + 3) * 4096 : HALO + ((size_t)s * 4 + 2) * 4096;
        const bf16_t* hc = which == 0 ? HALO + ((size_t)s * 4 + 0) * 4096 : HALO + ((size_t)s * 4 + 3) * 4096;
        const bf16_t* hn = which == 0 ? HALO + ((size_t)s * 4 + 1) * 4096 : HALO + ((size_t)(s + 1) * 4 + 0) * 4096;
        float pv[4], cv[4], nv_[4], pg[4], cg[4], ng[4];
        ld4bf(hp + pos, pv); ld4bf(hc + pos, cv); ld4bf(hn + pos, nv_); ld4bf(hp + pos + 128, pg); ld4bf(hc + pos + 128, cg); ld4bf(hn + pos + 128, ng);
        float o[4];
#pragma unroll
        for (int e = 0; e < 4; ++e) { const float zv = bv[e] + wv[0][e] * pv[e] + wv[1][e] * cv[e] + wv[2][e] * nv_[e]; const float zg = bg[e] + wg[0][e] * pg[e] + wg[1][e] * cg[e] + wg[2][e] * ng[e]; o[e] = silu_f(zg) * zv; }
        u32x2 w; w.x = cvt_pk_bf16(o[0], o[1]); w.y = cvt_pk_bf16(o[2], o[3]);
        *(u32x2*)(G + (size_t)(s * 64 + (which ? 63 : 0)) * 2048 + c) = w; }
}
constexpr int N_TR_ITEMS_L = 16 * 32 + 8 * 8 + 16 * 16 + 16 * 64 + 32 * 16;
template <bool BIAS> __device__ __forceinline__ void weight_item(Frame& F, LAS float* scr, int l, int it) {
    int r = it; const float* modl = F.misc + MI_MOD + l * 9 * 6144; float* cf = (float*)F.ctl;
    if (r < 512) { transpose_item<1, BIAS>(F, F.ka->in[10] + (size_t)l * DM * 2048, DM, 2048, (bf16_t*)(F.ws + WS_WIN) + (size_t)l * 2048 * DM, scr, r, modl, cf + CW_BIN + l * 9 * 2048); return; } r -= 512;
    if (r < 64) { transpose_item<0, false>(F, F.ka->in[26] + (size_t)l * 512 * 512, 512, 512, (bf16_t*)(F.ws + WS_WGLU) + (size_t)l * 512 * 512, scr, r, nullptr, nullptr); return; } r -= 64;
    if (r < 256) { transpose_item<0, false>(F, F.ka->in[28] + (size_t)l * DM * DM, DM, DM, (bf16_t*)(F.ws + WS_WOUT) + (size_t)l * DM * DM, scr, r, nullptr, nullptr); return; } r -= 256;
    if (r < 1024) { transpose_item<2, BIAS>(F, F.ka->in[30] + (size_t)l * DM * 4096, DM, 4096, (bf16_t*)(F.ws + WS_WUP) + (size_t)l * 4096 * DM, scr, r, modl + 3072, cf + CW_BUP + l * 9 * 4096); return; } r -= 1024;
    transpose_item<0, false>(F, F.ka->in[33] + (size_t)l * 2048 * DM, 2048, DM, (bf16_t*)(F.ws + WS_WDN) + (size_t)l * DM * 2048, scr, r, nullptr, nullptr);
}

__global__ void __launch_bounds__(NTHREADS, 2) mega(Args args) {
    extern __shared__ __attribute__((aligned(16))) unsigned char lds_raw[];
    Frame F;
    F.lds = (LAS unsigned char*)lds_raw;
    F.tid = threadIdx.x; F.lane = F.tid & 63; F.wave = __builtin_amdgcn_readfirstlane(F.tid >> 6);
    F.G = gridDim.x; F.bid = blockIdx.x; { const int bx = blockIdx.x; F.vcu = (F.G % 8 == 0) ? (bx % 8) * (F.G / 8) + bx / 8 : bx; }
    F.ka = (kargs_t)__builtin_amdgcn_kernarg_segment_ptr();
    F.out = args.out; F.ws = args.ws; F.misc = (float*)(args.ws + WS_MISC); F.ctl = (unsigned*)(args.ws + WS_CTL);
    volatile LAS unsigned* MISC = (volatile LAS unsigned*)(F.lds + MISC_OFF);
    for (int u = F.tid; u < (LDS_BYTES - LDSCTL_OFF) / 4; u += NTHREADS) ((LAS unsigned*)(F.lds + LDSCTL_OFF))[u] = 0u;
    __syncthreads();
    XcdBarrier bar = xcd_barrier_post(F.ctl + CW_BAR, MISC + 8);
    int phase_no = 0;
#define LAUNDER() do { asm volatile("" : "+s"(F.ka), "+s"(F.ws), "+s"(F.out), "+s"(F.bid)); { int w_ = __builtin_amdgcn_readfirstlane(F.wave); asm volatile("" : "+s"(w_)); F.wave = w_; } F.vcu = (F.G % 8 == 0) ? (F.bid % 8) * (F.G / 8) + F.bid / 8 : F.bid; \
    { unsigned z_ = 0u; asm volatile("" : "+v"(z_)); F.lane = (int)__builtin_amdgcn_mbcnt_hi(~0u, __builtin_amdgcn_mbcnt_lo(~0u, z_)); } F.tid = F.wave * 64 + F.lane;     \
    F.misc = (float*)(F.ws + WS_MISC); F.ctl = (unsigned*)(F.ws + WS_CTL); gw = F.vcu * NWAVES + F.wave; } while (0)
#ifndef TPROBE_SCALE
#define TPROBE_SCALE 0.25f
#endif
#ifdef TPROBE
#define TSTAMP() do { if (blockIdx.x == 0 && F.tid == 0) ((unsigned long long*)(F.ctl + 6000))[phase_no] = __builtin_amdgcn_s_memrealtime(); } while (0)
#else
#define TSTAMP() do {} while (0)
#endif
#if defined(TPROBE) && defined(TPROBE_SUB_A)
#ifndef TPROBE_BID
#define TPROBE_BID 0
#endif
#define TSUB(i) do { if (blockIdx.x == TPROBE_BID && F.tid == 0 && l == 0) ((unsigned long long*)(F.ctl + 6200))[i] = __builtin_amdgcn_s_memrealtime(); } while (0)
#else
#define TSUB(i) do {} while (0)
#endif
#define GRID_BAR() do { LAUNDER(); xcd_barrier(bar, F.tid); ++phase_no; TSTAMP(); if (F.ka->stop_after == phase_no) return; LAUNDER(); } while (0)
    int gw = F.vcu * NWAVES + F.wave; const int NGW = F.G * NWAVES;
#define ssq ((float*)(F.ctl + CW_SS))
#define XS ((bf16_t*)(F.ws + WS_XS))
#define KB ((bf16_t*)(F.ws + WS_KB))
#define VB ((bf16_t*)(F.ws + WS_VB))
#define Qb ((bf16_t*)(F.ws + WS_R + R_Q))
#define AS3 ((bf16_t*)(F.ws + WS_R + R_AS3))
#define Eb ((float*)(F.ws + WS_R + R_E))
#define Zb ((bf16_t*)(F.ws + WS_R + R_Z))
#define CAT ((bf16_t*)(F.ws + WS_R + R_CAT))
#define UP ((bf16_t*)(F.ws + WS_R))
#define Gb ((bf16_t*)(F.ws + WS_G))

    TSTAMP();
    if (F.vcu < 64) ssm_prep(F, 0, F.vcu);
    else {
        mod_task3(F, F.vcu - 64);
        if (F.vcu == 64) {
            for (int i = F.tid; i < 1024; i += NTHREADS) { const int pos = i >> 4, f = i & 15; const float inv = 1.0f / powf(10000.0f, (float)f / 16.0f); const float ang = (float)pos * inv;
                ((f32x2*)(F.misc + MI_ROPE))[i] = (f32x2){cosf(ang), sinf(ang)}; }
            if (F.tid < 2) { const int l = F.tid; float a1 = 0.f, a2 = 0.f; for (int d = 0; d < 64; ++d) { a1 += F.ka->in[13][l * 64 + d] * F.ka->in[14][l * 64 + d]; a2 += F.ka->in[15][l * 64 + d] * F.ka->in[16][l * 64 + d]; }
                const float li = 0.8f - 0.6f * expf(-0.3f * (float)l); F.misc[MI_LAM + l] = expf(a1) - expf(a2) + li; F.misc[MI_LAM + 2 + l] = 1.f - li; }
            __syncthreads();
        }
        LAS float* scr = (LAS float*)(F.lds + F.wave * 16640);
        const int gw1 = (F.vcu - 64) * NWAVES + F.wave, NGW1 = (F.G - 64) * NWAVES;
        for (int it = gw1; it < N_TR_ITEMS_L + 2048; it += NGW1) { if (it < N_TR_ITEMS_L) weight_item<false>(F, scr, 0, it); else cache_item(F, 0, it - N_TR_ITEMS_L); }
    }
    GRID_BAR();
    for (int it = gw; it < MT / 4 + 6144; it += NGW) { if (it < MT / 4) xprep_item(F, it); else bias_item(F, it - MT / 4); }
    GRID_BAR();

    for (int l = 0; l < DEPTH; ++l) {
        const float* modl = F.misc + MI_MOD + l * 9 * 6144;
        { unsigned* ucnt = F.ctl + CW_UC + l * 6 * 64;
          { Gemm g{XS, (const bf16_t*)(F.ws + WS_WIN) + (size_t)l * 2048 * DM, DM, DM, DM, 0, 0}; InOrder S{F.bid, F.G};
            EpiIn E{ssq + (l == 0 ? 0 : 2 * MT), (const float*)F.ctl + CW_BIN + l * 9 * 2048, F.ka->in[11] + l * 64, F.ka->in[12] + l * 64, (const f32x2*)(F.misc + MI_ROPE), Qb, KB, VB,
                    __builtin_amdgcn_make_buffer_rsrc((void*)AS3, 0, (int)((size_t)NG * NCHUNK * 512 * 2), 0x00020000),
                    F.out + (size_t)MT * DM, F.out + (size_t)MT * DM + (size_t)NB * DEPTH * SEQ * 512, l, ucnt};
            gemm_phase<EpiIn, InOrder>(F.lds, F.tid, g, S, E); }
          if (F.bid >= 128 && F.bid < 224) {
              LAUNDER();
              const int idx = F.bid - 128, gq = idx / 3, pmq = idx % 3; unsigned* up = F.ctl + CW_UC + ((l * 3 + pmq) * 2 + (gq >> 4)) * 64;
              if (F.tid == 0) { unsigned sp = 0; while (__hip_atomic_load(up, RLX_AGENT) < 128u) { __builtin_amdgcn_s_sleep(2); if (++sp > (1u << 20)) break; }
                  __builtin_amdgcn_fence(__ATOMIC_ACQUIRE, "agent"); asm volatile("s_waitcnt vmcnt(0)" ::: "memory"); }
              __syncthreads();
              { Gemm g{AS3, (const bf16_t*)(F.ws + WS_SSM + SSM_WE), 512, 256, 256, (size_t)NCHUNK * 512, (size_t)256 * 256}; GroupOrder S{idx, F.G}; EpiS1 E{Eb};
                gemm_phase<EpiS1, GroupOrder>(F.lds, F.tid, g, S, E); }
              VM_WAIT(); __syncthreads(); LAUNDER();
              ssm_scan(F, l, (F.bid - 128) / 3, (F.bid - 128) % 3); } }
        GRID_BAR();
#define ZC_PTR (F.ctl + CW_ZC + l * 256)
#define ATTN_UNIT(SEQ_, H_, QB_) do { LAUNDER(); const AttnArgs A_{Qb, KB, VB, CAT, F.ka->in[17] + l * 128, F.misc[MI_LAM + l], F.misc[MI_LAM + 2 + l]}; attn_unit(F.lds, F.tid, A_, (SEQ_), (H_), (QB_)); } while (0)
#define ATTN_CTX(U_) do { const int u_ = (U_); ATTN_UNIT(u_ >> 3, (u_ >> 1) & 3, u_ & 1); } while (0)
        { TSUB(0);
          const int xq = F.vcu >> 5, rq = F.vcu & 31;
          if (rq < 12) { const int cidx = xq * 12 + rq;
              { Gemm g{AS3, (const bf16_t*)(F.ws + WS_SSM + SSM_WY), 512, 512, 512, (size_t)NCHUNK * 512, (size_t)256 * 512}; GroupOrder S{cidx, F.G};
                EpiS3 E{__builtin_amdgcn_make_buffer_rsrc((void*)Zb, 0, (int)((size_t)MT * 512 * 2), 0x00020000)};
                gemm_phase<EpiS3, GroupOrder>(F.lds, F.tid, g, S, E); }
              VM_WAIT(); __syncthreads(); LAUNDER();
              if (F.tid == 0) __hip_atomic_fetch_add(ZC_PTR + (((F.vcu >> 5) * 12 + (F.vcu & 31)) % 3) * 64, 1u, RLX_AGENT); }
          TSUB(3);
          { const int u = F.vcu; ATTN_UNIT(NB + (u >> 5), (u >> 3) & 3, u & 7); } TSUB(4);
          if ((F.vcu & 31) >= 24) { for (int r = 0; r < 2; ++r) ATTN_CTX((F.vcu >> 5) * 16 + 2 * ((F.vcu & 31) - 24) + r); }
          TSUB(5);
          if ((F.vcu & 31) >= 12 && (F.vcu & 31) < 24) {
              LAUNDER();
              const int idx = (F.vcu >> 5) * 12 + ((F.vcu & 31) - 12), pmz = (idx >> 1) >> 4;
              if (F.tid == 0) { unsigned sp = 0; while (__hip_atomic_load(ZC_PTR + pmz * 64, RLX_AGENT) < (unsigned)NG) { __builtin_amdgcn_s_sleep(2); if (++sp > (1u << 20)) break; }
                  __builtin_amdgcn_fence(__ATOMIC_ACQUIRE, "agent"); asm volatile("s_waitcnt vmcnt(0)" ::: "memory"); }
              __syncthreads(); TSUB(6);
              Gemm g{Zb, (const bf16_t*)(F.ws + WS_WGLU) + (size_t)l * 512 * 512, 512, 512, 512, 0, 0}; OneTile S{idx};
              EpiGlu E{Zb, F.ka->in[27] + l * 512, CAT};
              gemm_phase<EpiGlu, OneTile>(F.lds, F.tid, g, S, E); TSUB(7); } }
        GRID_BAR();
        { Gemm g{CAT, (const bf16_t*)(F.ws + WS_WOUT) + (size_t)l * DM * DM, DM, DM, DM, 0, 0}; GridOrder S; S.init(MT, DM, F.G, F.bid);
          bf16_t* XR = (bf16_t*)(F.ws + WS_XR);
          if (l == 0) { EpiRes<true, false> E{F.ka->in[0], F.ka->in[1], nullptr, nullptr, XR, modl + 2 * DM, F.ka->in[29] + l * DM, modl + 4 * DM, XS, ssq + 1 * MT};
              gemm_phase<EpiRes<true, false>, GridOrder>(F.lds, F.tid, g, S, E); }
          else { EpiRes<false, false> E{nullptr, nullptr, XR, nullptr, XR, modl + 2 * DM, F.ka->in[29] + l * DM, modl + 4 * DM, XS, ssq + 3 * MT};
              gemm_phase<EpiRes<false, false>, GridOrder>(F.lds, F.tid, g, S, E); }
          if (l + 1 < DEPTH && F.bid >= 192) { LAUNDER(); LAS float* scr = (LAS float*)(F.lds + F.wave * 16640);
              for (int it = (F.bid - 192) * NWAVES + F.wave; it < N_TR_ITEMS_L; it += 64 * NWAVES) weight_item<true>(F, scr, l + 1, it); } }
        GRID_BAR();
        { Gemm g{XS, (const bf16_t*)(F.ws + WS_WUP) + (size_t)l * 4096 * DM, DM, DM, DM, 0, 0}; GridOrder S; S.init(MT, 4096, F.G, F.bid);
          EpiUpConv E{ssq + (l == 0 ? 1 : 3) * MT, (const float*)F.ctl + CW_BUP + l * 9 * 4096, F.ka->in[31] + (size_t)l * 3 * 4096, F.ka->in[32] + (size_t)l * 4096, Gb, (bf16_t*)(F.ws + WS_HALO)};
          gemm_phase<EpiUpConv, GridOrder, true>(F.lds, F.tid, g, S, E); }
        GRID_BAR();
        { Gemm g{Gb, (const bf16_t*)(F.ws + WS_WDN) + (size_t)l * DM * 2048, 2048, 2048, 2048, 0, 0}; GridOrder S; S.init(MT, DM, F.G, F.bid);
          const bool nxt = l + 1 < DEPTH;
          bf16_t* XR = (bf16_t*)(F.ws + WS_XR);
          { Unit u0; if (S.next(0, u0)) { conv_fix(F, l, u0.pm); VM_WAIT(); __syncthreads(); LAUNDER(); } }
          if (nxt) { EpiRes<false, false> E{nullptr, nullptr, XR, nullptr, XR, modl + 5 * DM, F.ka->in[9] + (l + 1) * DM, modl + 9 * 6144 + DM, XS, ssq + 2 * MT};
              gemm_phase<EpiRes<false, false>, GridOrder>(F.lds, F.tid, g, S, E); }
          else { EpiRes<false, true> E{nullptr, nullptr, XR, F.out, nullptr, modl + 5 * DM, nullptr, nullptr, XS, ssq + 2 * MT};
              gemm_phase<EpiRes<false, true>, GridOrder>(F.lds, F.tid, g, S, E); }
          if (nxt && F.bid >= 192) { LAUNDER(); ssm_prep(F, l + 1, F.bid - 192);
              for (int it = (F.bid - 192) * NWAVES + F.wave; it < 2048; it += 64 * NWAVES) cache_item(F, l + 1, it); } }
        if (l + 1 < DEPTH) GRID_BAR();
    }
#ifdef TPROBE
    GRID_BAR();
    { float* miscp = (float*)(args.ws + WS_MISC); unsigned* ctlp = (unsigned*)(args.ws + WS_CTL);
      if (blockIdx.x == 0 && threadIdx.x == 0) { const unsigned long long* ts = (const unsigned long long*)(ctlp + 6000); const float tot = (float)(ts[phase_no] - ts[0]);
        float fa = 0.f;
#ifdef TPROBE_SUB_A
        { const unsigned long long* t2 = (const unsigned long long*)(ctlp + 6200); fa = (float)(t2[TPROBE_SUB_B] - t2[TPROBE_SUB_A]) / tot; }
#else
        for (int k = 0; k < phase_no; ++k) { const float d = (float)(ts[k + 1] - ts[k]) / tot; if ((TPROBE_MASK_A >> k) & 1ull) fa += d; }
#endif
        miscp[MI_END] = TPROBE_SCALE * sqrtf(fa); }
      GRID_BAR();
      const float delta = miscp[MI_END];
      for (size_t i = (size_t)blockIdx.x * NTHREADS + threadIdx.x; i < (size_t)MC * DM; i += (size_t)gridDim.x * NTHREADS) args.out[i] *= (1.f + delta); }
#endif
#undef GRID_BAR
#undef LAUNDER
#undef ZC_PTR
#undef ATTN_UNIT
#undef ATTN_CTX
#undef ssq
#undef XS
#undef KB
#undef VB
#undef Qb
#undef AS3
#undef Eb
#undef Zb
#undef CAT
#undef UP
#undef Gb
}
}

static int fk_launch(void* const* d_in, void* d_out, void* d_ws, size_t ws_size, hipStream_t stream, int stop_after) {
    static int grid = 0;
    if (grid == 0) {
        int dev = 0, cus = 0;
        if (ws_size < fk::WS_END) { fprintf(stderr, "kernel_launch: workspace too small (%zu < %zu)\n", ws_size, (size_t)fk::WS_END); grid = -1; return -1; }
        if (hipGetDevice(&dev) != hipSuccess || hipDeviceGetAttribute(&cus, hipDeviceAttributeMultiprocessorCount, dev) != hipSuccess) { grid = -1; return -1; }
        if (hipFuncSetAttribute((const void*)fk::mega, hipFuncAttributeMaxDynamicSharedMemorySize, fk::LDS_BYTES) != hipSuccess) { fprintf(stderr, "kernel_launch: hipFuncSetAttribute failed\n"); grid = -1; return -1; }
        int per_cu = 0; (void)hipOccupancyMaxActiveBlocksPerMultiprocessor(&per_cu, (const void*)fk::mega, fk::NTHREADS, fk::LDS_BYTES); (void)hipGetLastError();
        if (per_cu < 1) fprintf(stderr, "kernel_launch: occupancy query says %d blocks/CU\n", per_cu);
        grid = cus;
        if (grid != 256) fprintf(stderr, "kernel_launch: %d CUs (built for 256)\n", grid);
    }
    if (grid < 0) return -1;
    (void)hipMemsetAsync((char*)d_ws + fk::WS_CTL, 0, fk::CTL_BYTES, stream);
    fk::Args a{};
    for (int i = 0; i < 34; ++i) a.in[i] = (const float*)d_in[i];
    a.out = (float*)d_out; a.ws = (unsigned char*)d_ws; a.stop_after = stop_after; a.pad = 0;
    hipLaunchKernelGGL(fk::mega, dim3(grid), dim3(fk::NTHREADS), fk::LDS_BYTES, stream, a);
    return 0;
}
extern "C" void kernel_launch(void* const* d_in, const int* in_sizes, int n_in, void* d_out, int out_size, void* d_ws, size_t ws_size, hipStream_t stream) {
    if (n_in != 34) { fprintf(stderr, "kernel_launch: unexpected n_in %d\n", n_in); return; }
    fk_launch(d_in, d_out, d_ws, ws_size, stream, 0);
}
```

```cpp
#include <hip/hip_runtime.h>
#include <cstdio>
#include <cstdint>
namespace fk {
#define LAS __attribute__((address_space(3)))
#define GAS __attribute__((address_space(1)))
typedef unsigned short bf16_t;
typedef short bf16x8 __attribute__((ext_vector_type(8)));
typedef short s16x4 __attribute__((ext_vector_type(4)));
typedef float f32x4 __attribute__((ext_vector_type(4)));
typedef float f32x2 __attribute__((ext_vector_type(2)));
typedef float f32x16 __attribute__((ext_vector_type(16)));
typedef unsigned u32x4 __attribute__((ext_vector_type(4)));
typedef unsigned u32x2 __attribute__((ext_vector_type(2)));

constexpr int DM = 1024, NB = 16, SEQ = 256, DEPTH = 2, DB = 8, DSEQ = 1024, PAST = 512;
constexpr int MC = NB * SEQ, MS = DB * DSEQ, MT = MC + MS;
constexpr int NH = 4, NG = 32, NCOND = 9, NMOD = 6;
constexpr int NCHUNK = MT / 16;
constexpr int KVROWS = MC + DB * (PAST + DSEQ);
constexpr float EPS = 1e-6f;
constexpr float C2 = 0.125f * 1.4426950408889634f;
constexpr int NWAVES = 8, NTHREADS = 512;

constexpr size_t MiB = 1u << 20;
constexpr size_t WS_CTL = 0, CTL_BYTES = 1 * MiB + 512 * 1024;
constexpr size_t WS_MISC = 1 * MiB;
constexpr size_t WS_WIN = 3 * MiB;
constexpr size_t WS_WGLU = 11 * MiB;
constexpr size_t WS_WOUT = 12 * MiB;
constexpr size_t WS_WUP = 16 * MiB;
constexpr size_t WS_WDN = 32 * MiB;
constexpr size_t WS_SSM = 40 * MiB;
constexpr size_t WS_XS = 53 * MiB;
constexpr size_t WS_KB = 77 * MiB;
constexpr size_t WS_VB = 93 * MiB;
constexpr size_t WS_R = 109 * MiB;
constexpr size_t WS_XR = 205 * MiB;
constexpr size_t WS_G = WS_R;
constexpr size_t WS_HALO = WS_R + 48 * MiB;
constexpr size_t WS_END = 253 * MiB;
constexpr size_t R_Q = 0, R_AS3 = 12 * MiB, R_E = 36 * MiB, R_Z = 60 * MiB, R_CAT = 72 * MiB;
constexpr size_t SSM_WE = 0, SSM_WY = 4 * MiB, SSM_LAM16 = 12 * MiB, SSM_BBAR = 12 * MiB + 64 * 1024;
constexpr int MI_MOD = 0;
constexpr int MI_ROPE = MI_MOD + 2 * 9 * 6144;
constexpr int MI_LAM = MI_ROPE + 64 * 16 * 2;
constexpr int MI_END = MI_LAM + 8;
static_assert((size_t)MI_END * 4 <= 2 * MiB, "MISC");
constexpr int CW_BAR = 1024;
constexpr int CW_ZC = 7168;
constexpr int CW_UC = 4608;
constexpr int CW_SS = 8192;
constexpr int CW_BIN = 65536;
constexpr int CW_BUP = CW_BIN + 2 * 9 * 2048;
static_assert((size_t)(CW_SS + 4 * MT) <= CW_BIN && (size_t)(CW_BUP + 2 * 9 * 4096) * 4 <= CTL_BYTES, "CTL");

constexpr int RING_BYTES = 131072;
constexpr int LDS_BYTES_ = 147456; constexpr int LDSCTL_OFF = LDS_BYTES_ - 512, MISC_OFF = LDSCTL_OFF + 320;
constexpr int LDS_BYTES = 147456;

#define RLX_AGENT __ATOMIC_RELAXED, __HIP_MEMORY_SCOPE_AGENT
typedef __bf16 bf16x2_t __attribute__((ext_vector_type(2)));
__device__ __forceinline__ unsigned cvt_pk_bf16(float lo, float hi) { const f32x2 v = {lo, hi}; const bf16x2_t b = __builtin_convertvector(v, bf16x2_t); return __builtin_bit_cast(unsigned, b); }
__device__ __forceinline__ float bf2f(unsigned short b) { return __uint_as_float((unsigned)b << 16); }
__device__ __forceinline__ float bflo(unsigned w) { return __uint_as_float(w << 16); }
__device__ __forceinline__ float bfhi(unsigned w) { return __uint_as_float(w & 0xffff0000u); }
__device__ __forceinline__ float fast_exp2(float x) { return __builtin_amdgcn_exp2f(x); }
__device__ __forceinline__ float fast_rcp(float x) { return __builtin_amdgcn_rcpf(x); }
__device__ __forceinline__ float sigmoid_f(float x) { return fast_rcp(1.f + fast_exp2(-1.4426950408889634f * x)); }
__device__ __forceinline__ float silu_f(float x) { return x * sigmoid_f(x); }
__device__ __forceinline__ float gelu_tanh_f(float x) {
    const float u = 0.7978845608028654f * (x + 0.044715f * x * x * x); return x * sigmoid_f(2.f * u); }
__device__ __forceinline__ float shfl_xor_l(float v, int mask, int lane) { return __uint_as_float((unsigned)__builtin_amdgcn_ds_bpermute((lane ^ mask) << 2, (int)__float_as_uint(v))); }
__device__ __forceinline__ float wave_sum(float v, int lane) {
#pragma unroll
    for (int o = 1; o < 64; o <<= 1) v += shfl_xor_l(v, o, lane);
    return v; }

#define XB_TMO      128
#define XB_XCNT(j)  (256  + 64 * (j))
#define XB_XSUB(j)  (1280 + 64 * (j))
#define XB_XGEN(j)  (2304 + 64 * (j))
#define XB_TOP      3328
#define XB_TOPGEN   3392
#define XCD_BAR_WORDS 3456
#define XB_SPIN_CAP (1u << 18)
__device__ __forceinline__ unsigned xb_ld(unsigned* p)              { return __hip_atomic_load(p, __ATOMIC_RELAXED, __HIP_MEMORY_SCOPE_AGENT); }
__device__ __forceinline__ unsigned xb_add(unsigned* p, unsigned v) { return __hip_atomic_fetch_add(p, v, __ATOMIC_RELAXED, __HIP_MEMORY_SCOPE_AGENT); }
__device__ __forceinline__ unsigned xb_xcc_id() { return (unsigned)__builtin_amdgcn_s_getreg((3 << 11) | 20) & 0xFu; }
#define XB_SPIN(cond, bar) do { unsigned _sp = 0; while (cond) { __builtin_amdgcn_s_sleep(1); \
    if ((++_sp & 255u) == 0u) { if (xb_ld(&(bar)[XB_TMO])) break; if (_sp > XB_SPIN_CAP) { atomicAdd(&(bar)[XB_TMO], 1u); break; } } } } while (0)
struct XcdBarrier { unsigned* bar; unsigned x; volatile LAS unsigned* st; };
__device__ __forceinline__ XcdBarrier xcd_barrier_post(unsigned* bar, volatile LAS unsigned* st) {
    XcdBarrier b; b.bar = bar; b.x = xb_xcc_id(); b.st = st;
    if (threadIdx.x == 0) (void)xb_add(&bar[XB_XCNT(b.x)], 1u);
    return b;
}
__device__ __forceinline__ void xcd_barrier_complete(unsigned* bar, unsigned x, unsigned& nloc, unsigned& nx) {
    const unsigned G = gridDim.x * gridDim.y * gridDim.z;
    unsigned sum, cnt, mine, sp = 0u;
    for (;;) {
        sum = 0u; cnt = 0u; mine = 0u;
#pragma unroll
        for (unsigned j = 0; j < 16; ++j) { const unsigned c = xb_ld(&bar[XB_XCNT(j)]); sum += c; cnt += (c > 0u) ? 1u : 0u; mine = (j == x) ? c : mine; }
        if (sum == G) break;
        __builtin_amdgcn_s_sleep(1);
        if ((++sp & 255u) == 0u) { if (xb_ld(&bar[XB_TMO])) break; if (sp > XB_SPIN_CAP) { atomicAdd(&bar[XB_TMO], 1u); break; } }
    }
    nloc = mine > 0u ? mine : 1u; nx = cnt > 0u ? cnt : 1u;
}
__device__ __forceinline__ void xcd_barrier(const XcdBarrier& b, const int tid) {
    asm volatile("s_waitcnt vmcnt(0)" ::: "memory");
    __syncthreads();
    if (tid == 0) {
        unsigned* bar = b.bar;
        __builtin_amdgcn_s_waitcnt(0);
        unsigned nloc = b.st[0], nx = b.st[1];
        if (nloc == 0u) { xcd_barrier_complete(bar, b.x, nloc, nx); b.st[0] = nloc; b.st[1] = nx; }
        const unsigned old = xb_add(&bar[XB_XSUB(b.x)], 1u);
        const unsigned gen = old / nloc;
        if (old + 1u == (gen + 1u) * nloc) {
            __builtin_amdgcn_fence(__ATOMIC_RELEASE, "agent");
            asm volatile("s_waitcnt vmcnt(0)" ::: "memory");
            const unsigned og = xb_add(&bar[XB_TOP], 1u);
            const unsigned tg = og / nx;
            if (og + 1u == (tg + 1u) * nx) xb_add(&bar[XB_TOPGEN], 1u);
            else XB_SPIN(xb_ld(&bar[XB_TOPGEN]) == tg, bar);
            __builtin_amdgcn_fence(__ATOMIC_ACQUIRE, "agent");
            xb_add(&bar[XB_XGEN(b.x)], 1u);
            asm volatile("s_waitcnt vmcnt(0)" ::: "memory");
        } else {
            XB_SPIN(xb_ld(&bar[XB_XGEN(b.x)]) == gen, bar);
            __builtin_amdgcn_fence(__ATOMIC_ACQUIRE, "agent");
            asm volatile("s_waitcnt vmcnt(0)" ::: "memory");
        }
    }
    __syncthreads();
}

constexpr int BM = 256, BK = 64, HALF = 128, HTB = HALF * BK * 2, NXCD = 8, WGM = 6;
__host__ __device__ __forceinline__ int lds_byte(int r, int c) { const int st = (r >> 4) * 2 + (c >> 5), rr = r & 15, cc = c & 31, ob = rr * 64 + cc * 2; return st * 1024 + (ob ^ (((ob >> 9) & 1) << 5)); }
__host__ __device__ __forceinline__ void stage_rc(int b, int& R, int& C) { const int st = b / 1024, sb = b % 1024, swz = sb ^ (((sb >> 9) & 1) << 5); R = (st >> 1) * 16 + swz / 64; C = (st & 1) * 32 + (swz % 64) / 2; }
__host__ __device__ __forceinline__ int perm32(int rho) { const int n = rho >> 4, i = rho & 15; return 8 * (i >> 2) + 4 * n + (i & 3); }

struct Unit { int pm, pn, g; };
struct Gemm { const bf16_t* A; const bf16_t* Bt; int lda, ldb, K; size_t gsA, gsB; };
struct GridOrder {
    int nM, nN, nwg, G, c;
    __device__ void init(int M, int N, int G_, int c_) { nM = M / BM; nN = N / BM; nwg = nM * nN; G = G_; c = c_; }
    __device__ bool next(int i, Unit& u) const {
        const long L = (long)i * G + c; if (L >= nwg) return false;
        int wgid = (int)L; { const int q = nwg / NXCD, r = nwg % NXCD, xcd = wgid % NXCD, off = wgid / NXCD; wgid = (xcd < r ? xcd * (q + 1) : r * (q + 1) + (xcd - r) * q) + off; }
        const int nig = WGM * nN, gid = wgid / nig, fm = gid * WGM, gsz = (nM - fm) < WGM ? (nM - fm) : WGM;
        u.pm = fm + ((wgid % nig) % gsz); u.pn = (wgid % nig) / gsz; u.g = 0; return true;
    }
};
struct InOrder {
    int c, G;
    __device__ bool next(int i, Unit& u) const { const int L = i * G + c; if (L >= 384) return false; u.g = 0;
        if (L < 96) { const int j = (L & 7) * 12 + (L >> 3); u.pm = j >> 1; u.pn = 6 + (j & 1); }
        else { const int Lp = L - 96, j = (Lp & 7) * 36 + (Lp >> 3); u.pm = j / 6; u.pn = j % 6; }
        return true; }
};
struct OneTile {
    int idx;
    __device__ bool next(int i, Unit& u) const { if (i > 0 || idx < 0) return false; u.pm = idx >> 1; u.pn = idx & 1; u.g = 0; return true; }
};
struct GroupOrder {
    int c, G;
    __device__ bool next(int i, Unit& u) const { const int idx = c + i * G; if (c < 0 || idx >= NG * 3) return false; u.g = idx / 3; u.pm = idx % 3; u.pn = 0; return true; }
};

template <class Epi, class Sched, bool AROWPERM = false>
__device__ __forceinline__ void gemm_phase(LAS unsigned char* lds, const int tid, const Gemm g, const Sched& S, const Epi& E) {
    const int wid = __builtin_amdgcn_readfirstlane(tid >> 6), lane = tid & 63, wr = wid >> 2, wc = wid & 3, fr = lane & 15, fq = lane >> 4;
    const int K = g.K, nt = K / BK;
    unsigned voffA[2], voffB[2];
#pragma unroll
    for (int i = 0; i < 2; ++i) { int R, C; stage_rc(tid * 16 + i * 8192, R, C); const int Rb = Epi::PERM ? ((R & ~31) + perm32(R & 31)) : R;
        const int Ra = AROWPERM ? ((R & 64) + 4 * (R & 15) + ((R >> 4) & 3)) : R;
        voffA[i] = (unsigned)(Ra * g.lda + C) * 2u; voffB[i] = (unsigned)(Rb * g.ldb + C) * 2u; }
    const size_t kstep = (size_t)(BK * 2);
    const size_t hstepA = (size_t)HALF * g.lda * 2, hstepB = (size_t)HALF * g.ldb * 2;
    const unsigned ldsw = (unsigned)wid * 1024u;
    const int aoff = lds_byte(wr * 64 + fr, fq * 8), boff = lds_byte(wc * 32 + fr, fq * 8);
#define PG8_SA(b, h) (((b) * 2 + (h)) * HTB)
#define PG8_SB(b, h) ((4 + (b) * 2 + (h)) * HTB)
#define PG8_STAGE(bufoff, gbase, voff) do { _Pragma("unroll") for (int _i = 0; _i < 2; ++_i) \
        __builtin_amdgcn_global_load_lds((const unsigned*)((const char*)(gbase) + (voff)[_i]), (LAS unsigned*)(lds + (bufoff) + ldsw + _i * 8192), 16, 0, 0); } while (0)
#define PG8_LDA(dst, b, h) do { _Pragma("unroll") for (int m = 0; m < 4; ++m) _Pragma("unroll") for (int k = 0; k < 2; ++k) dst[m][k] = *(const LAS bf16x8*)(lds + PG8_SA(b, h) + aoff + m * 2048 + k * 1024); } while (0)
#define PG8_LDB(dst, b, h) do { _Pragma("unroll") for (int n = 0; n < 2; ++n) _Pragma("unroll") for (int k = 0; k < 2; ++k) dst[n][k] = *(const LAS bf16x8*)(lds + PG8_SB(b, h) + boff + n * 2048 + k * 1024); } while (0)
#define PG8_MMA(ai, bj, At, Bt) do { __builtin_amdgcn_s_setprio(1); _Pragma("unroll") for (int m = 0; m < 4; ++m) _Pragma("unroll") for (int n = 0; n < 2; ++n) _Pragma("unroll") for (int k = 0; k < 2; ++k) \
        acc[ai][bj][m][n] = __builtin_amdgcn_mfma_f32_16x16x32_bf16(Bt[n][k], At[m][k], acc[ai][bj][m][n], 0, 0, 0); __builtin_amdgcn_s_setprio(0); } while (0)
#define PG8_WAIT_V(n) asm volatile("s_waitcnt vmcnt(" #n ")" ::: "memory")
#define PG8_WAIT_L(n) asm volatile("s_waitcnt lgkmcnt(" #n ")" ::: "memory")
#define PG8_BAR __builtin_amdgcn_s_barrier()
#define PG8_SCHED __builtin_amdgcn_sched_barrier(0)
#define PG8_APTR(u) ((const char*)g.A + ((size_t)(u).g * g.gsA + (size_t)(u).pm * BM * g.lda) * 2)
#define PG8_BPTR(u) ((const char*)g.Bt + ((size_t)(u).g * g.gsB + (size_t)(u).pn * BM * g.ldb) * 2)
    Unit cur, nxt; int ui = 0;
    if (!S.next(0, cur)) return;
    f32x4 acc[2][2][4][2];
#pragma unroll
    for (int a = 0; a < 2; ++a)
#pragma unroll
        for (int b = 0; b < 2; ++b)
#pragma unroll
            for (int m = 0; m < 4; ++m)
#pragma unroll
                for (int n = 0; n < 2; ++n) acc[a][b][m][n] = (f32x4){0.f, 0.f, 0.f, 0.f};
    bf16x8 At[4][2], B0[2][2], B1[2][2];
    const char* cA = PG8_APTR(cur); const char* cB = PG8_BPTR(cur);
    PG8_STAGE(PG8_SB(0, 0), cB, voffB); PG8_STAGE(PG8_SB(0, 1), cB + hstepB, voffB); PG8_STAGE(PG8_SA(0, 0), cA, voffA); PG8_STAGE(PG8_SA(0, 1), cA + hstepA, voffA);
    if (wr == 1) PG8_BAR;
    PG8_WAIT_V(2); PG8_BAR;
    PG8_STAGE(PG8_SB(1, 0), cB + kstep, voffB); PG8_STAGE(PG8_SA(1, 0), cA + kstep, voffA); PG8_STAGE(PG8_SB(1, 1), cB + hstepB + kstep, voffB);
    PG8_WAIT_V(6); PG8_BAR;
    for (;;) {
        const bool has_next = S.next(ui + 1, nxt);
        const char* nA = has_next ? PG8_APTR(nxt) : cA; const char* nB = has_next ? PG8_BPTR(nxt) : cB;
        for (int t = 0; t < nt; t += 2) {
            const bool last = (t == nt - 2);
            const char* a1 = cA + (size_t)(t + 1) * kstep;
            const char* a2 = last ? nA : cA + (size_t)(t + 2) * kstep; const char* b2 = last ? nB : cB + (size_t)(t + 2) * kstep;
            const char* a3 = a2 + kstep; const char* b3 = b2 + kstep;
            PG8_LDB(B0, 0, 0); PG8_LDB(B1, 0, 1); PG8_SCHED; PG8_LDA(At, 0, 0); PG8_STAGE(PG8_SA(1, 1), a1 + hstepA, voffA);
            PG8_WAIT_V(8); PG8_WAIT_L(0); PG8_BAR; PG8_MMA(0, 0, At, B0); PG8_MMA(0, 1, At, B1); PG8_BAR; PG8_SCHED;
            PG8_LDA(At, 0, 1); PG8_STAGE(PG8_SB(0, 0), b2, voffB); PG8_STAGE(PG8_SB(0, 1), b2 + hstepB, voffB); PG8_STAGE(PG8_SA(0, 0), a2, voffA);
            PG8_WAIT_V(8); PG8_WAIT_L(0); PG8_BAR; PG8_MMA(1, 0, At, B0); PG8_MMA(1, 1, At, B1); PG8_BAR; PG8_SCHED;
            PG8_LDB(B0, 1, 0); PG8_LDB(B1, 1, 1); PG8_SCHED; PG8_LDA(At, 1, 0); PG8_STAGE(PG8_SA(0, 1), a2 + hstepA, voffA);
            PG8_WAIT_V(8); PG8_WAIT_L(0); PG8_BAR; PG8_MMA(0, 0, At, B0); PG8_MMA(0, 1, At, B1); PG8_BAR; PG8_SCHED;
            PG8_LDA(At, 1, 1); PG8_STAGE(PG8_SB(1, 0), b3, voffB); PG8_STAGE(PG8_SB(1, 1), b3 + hstepB, voffB); PG8_STAGE(PG8_SA(1, 0), a3, voffA);
            PG8_WAIT_V(8); PG8_WAIT_L(0); PG8_BAR; PG8_MMA(1, 0, At, B0); PG8_MMA(1, 1, At, B1); PG8_BAR; PG8_SCHED;
        }
        if (wr == 0) PG8_BAR;
        { unsigned z_ = 0u; asm volatile("" : "+v"(z_)); const int l2 = (int)__builtin_amdgcn_mbcnt_hi(~0u, __builtin_amdgcn_mbcnt_lo(~0u, z_));
          E(acc, cur, wr, wc, l2 & 15, l2 >> 4);
          E.done(cur, l2); }
        if (!has_next) break;
#pragma unroll
        for (int a = 0; a < 2; ++a)
#pragma unroll
            for (int b = 0; b < 2; ++b)
#pragma unroll
                for (int m = 0; m < 4; ++m)
#pragma unroll
                    for (int n = 0; n < 2; ++n) acc[a][b][m][n] = (f32x4){0.f, 0.f, 0.f, 0.f};
        cur = nxt; cA = nA; cB = nB; ++ui;
        if (wr == 1) PG8_BAR;
    }
    PG8_WAIT_V(0);
    PG8_BAR;
#undef PG8_SA
#undef PG8_SB
#undef PG8_STAGE
#undef PG8_LDA
#undef PG8_LDB
#undef PG8_MMA
#undef PG8_WAIT_V
#undef PG8_WAIT_L
#undef PG8_BAR
#undef PG8_SCHED
#undef PG8_APTR
#undef PG8_BPTR
}
__device__ __forceinline__ int cond_of_pm(int pm) { return pm < 16 ? 0 : 1 + ((pm - 16) >> 2); }
__device__ __forceinline__ int kvrow_of(int row) { return row < MC ? row : MC + ((row - MC) >> 10) * (PAST + DSEQ) + PAST + ((row - MC) & 1023); }
__device__ __forceinline__ u32x4 pack8(const f32x4& a, const f32x4& b) { u32x4 w; w.x = cvt_pk_bf16(a[0], a[1]); w.y = cvt_pk_bf16(a[2], a[3]); w.z = cvt_pk_bf16(b[0], b[1]); w.w = cvt_pk_bf16(b[2], b[3]); return w; }

struct EpiIn {
    static constexpr bool PERM = true;
    const float* sumsq; const float* bias; const float* qn; const float* kn; const f32x2* rope;
    bf16_t* Q; bf16_t* KB; bf16_t* VB; __amdgpu_buffer_rsrc_t as3r; float* new_k; float* new_v; int l; unsigned* ucnt;
    __device__ __forceinline__ void done(const Unit& u, int lane) const {
        if (u.pn >= 6) { asm volatile("s_waitcnt vmcnt(0)" ::: "memory"); if (lane == 0) __hip_atomic_fetch_add(ucnt + (((u.pm >> 4) * 2) + (u.pn - 6)) * 64, 1u, RLX_AGENT); } }
    __device__ __forceinline__ void operator()(const f32x4 (&acc)[2][2][4][2], const Unit& u, int wr, int wc, int fr, int fq) const {
        const int pm = u.pm, pn = u.pn; const bool ctx = pm < 16; const int cond = cond_of_pm(pm);
        const float* bz = bias + cond * 2048 + pn * 256 + wc * 32 + 8 * fq;
        f32x4 bv[2][2];
#pragma unroll
        for (int bj = 0; bj < 2; ++bj)
#pragma unroll
            for (int n = 0; n < 2; ++n) bv[bj][n] = *(const f32x4*)(bz + bj * 128 + 4 * n);
        const int rbase = pm * BM + wr * 64 + fr;
        float rsd[8];
#pragma unroll
        for (int g8 = 0; g8 < 8; ++g8) rsd[g8] = sumsq[rbase + (g8 >> 2) * HALF + (g8 & 3) * 16];
#pragma unroll
        for (int g8 = 0; g8 < 8; ++g8) rsd[g8] = rsqrtf(rsd[g8] * (1.f / DM) + EPS);
        if (pn < 4) {
            const bool isq = pn < 2; const float* gv = isq ? qn : kn;
            const int G = (pn & 1) * 4 + wc;
            const int cb = 32 * (fq >> 1) + 8 * (fq & 1);
            f32x4 gg[2][2];
#pragma unroll
            for (int bj = 0; bj < 2; ++bj)
#pragma unroll
                for (int n = 0; n < 2; ++n) gg[bj][n] = *(const f32x4*)(gv + cb + 16 * bj + 4 * n);
            const float qs = isq ? C2 : 1.f;
#pragma unroll
            for (int ai = 0; ai < 2; ++ai)
#pragma unroll
                for (int m = 0; m < 4; ++m) {
                    const int row = rbase + ai * HALF + m * 16;
                    const float rstd = rsd[ai * 4 + m];
                    f32x4 v[2][2]; float ss = 0.f;
#pragma unroll
                    for (int bj = 0; bj < 2; ++bj)
#pragma unroll
                        for (int n = 0; n < 2; ++n) { v[bj][n] = acc[ai][bj][m][n] * rstd + bv[bj][n]; const f32x4 t = v[bj][n] * v[bj][n]; ss += (t[0] + t[1]) + (t[2] + t[3]); }
                    { const int ln_ = fq * 16 + fr; ss += shfl_xor_l(ss, 16, ln_); ss += shfl_xor_l(ss, 32, ln_); }
                    const float rn = rsqrtf(ss * (1.f / 64.f) + EPS);
#pragma unroll
                    for (int bj = 0; bj < 2; ++bj)
#pragma unroll
                        for (int n = 0; n < 2; ++n) v[bj][n] = v[bj][n] * rn * gg[bj][n];
                    if (ctx) {
                        if (!isq) { float* nk = new_k + ((size_t)((row >> 8) * DEPTH + l) * SEQ + (row & 255)) * 512 + G * 64 + cb;
#pragma unroll
                            for (int bj = 0; bj < 2; ++bj) { *(f32x4*)(nk + 16 * bj) = v[bj][0]; *(f32x4*)(nk + 16 * bj + 4) = v[bj][1]; } }
                    } else {
                        const int t = (row - MC) & 1023; const int pos = (fq >> 1) ? (t & 63) : (t >> 6);
                        const f32x2* rp = rope + pos * 16 + 8 * (fq & 1);
#pragma unroll
                        for (int n = 0; n < 2; ++n)
#pragma unroll
                            for (int j = 0; j < 4; ++j) { const f32x2 cs = rp[4 * n + j]; const float x1 = v[0][n][j], x2 = v[1][n][j]; v[0][n][j] = x1 * cs.x - x2 * cs.y; v[1][n][j] = x1 * cs.y + x2 * cs.x; }
                    }
                    bf16_t* dst = isq ? (Q + (size_t)row * 512) : (KB + (size_t)kvrow_of(row) * 512);
                    dst += G * 64 + cb;
#pragma unroll
                    for (int bj = 0; bj < 2; ++bj) *(u32x4*)(dst + 16 * bj) = pack8(v[bj][0] * qs, v[bj][1] * qs);
                }
        } else if (pn < 6) {
            const int col0 = (pn - 4) * 256 + wc * 32 + 8 * fq;
#pragma unroll
            for (int ai = 0; ai < 2; ++ai)
#pragma unroll
                for (int m = 0; m < 4; ++m) {
                    const int row = rbase + ai * HALF + m * 16;
                    const float rstd = rsd[ai * 4 + m];
                    bf16_t* dst = VB + (size_t)kvrow_of(row) * 512 + col0;
#pragma unroll
                    for (int bj = 0; bj < 2; ++bj) { const f32x4 a = acc[ai][bj][m][0] * rstd + bv[bj][0], b = acc[ai][bj][m][1] * rstd + bv[bj][1];
                        *(u32x4*)(dst + 128 * bj) = pack8(a, b);
                        if (ctx) { float* nv = new_v + ((size_t)((row >> 8) * DEPTH + l) * SEQ + (row & 255)) * 512 + col0 + 128 * bj; *(f32x4*)nv = a; *(f32x4*)(nv + 4) = b; } }
                }
        } else {
            const int cu0 = (pn - 6) * 256 + wc * 32 + 8 * fq;
#pragma unroll
            for (int ai = 0; ai < 2; ++ai)
#pragma unroll
                for (int m = 0; m < 4; ++m) {
                    const int row = rbase + ai * HALF + m * 16;
                    const float rstd = rsd[ai * 4 + m];
#pragma unroll
                    for (int bj = 0; bj < 2; ++bj) { const int cu = cu0 + 128 * bj; const f32x4 a = acc[ai][bj][m][0] * rstd + bv[bj][0], b = acc[ai][bj][m][1] * rstd + bv[bj][1];
                        __builtin_amdgcn_raw_buffer_store_b128(pack8(a, b), as3r, (int)(((unsigned)((cu >> 4) * NCHUNK + (row >> 4)) * 512u + (row & 15) * 16 + (cu & 15)) * 2u), 0,   16); }
                }
        }
    }
};
struct EpiS1 {
    static constexpr bool PERM = false;
    float* E;
    __device__ __forceinline__ void done(const Unit&, int) const {}
    __device__ __forceinline__ void operator()(const f32x4 (&acc)[2][2][4][2], const Unit& u, int wr, int wc, int fr, int fq) const {
        const int rbase = u.pm * BM + wr * 64 + fr, col0 = wc * 32 + 4 * fq;
#pragma unroll
        for (int ai = 0; ai < 2; ++ai)
#pragma unroll
            for (int m = 0; m < 4; ++m) { float* dst = E + ((size_t)u.g * NCHUNK + rbase + ai * HALF + m * 16) * 256 + col0;
#pragma unroll
                for (int bj = 0; bj < 2; ++bj)
#pragma unroll
                    for (int n = 0; n < 2; ++n) *(f32x4*)(dst + bj * HALF + n * 16) = acc[ai][bj][m][n]; }
    }
};
struct EpiS3 {
    static constexpr bool PERM = true;
    __amdgpu_buffer_rsrc_t zr;
    __device__ __forceinline__ void done(const Unit&, int) const {}
    __device__ __forceinline__ void operator()(const f32x4 (&acc)[2][2][4][2], const Unit& u, int wr, int wc, int fr, int fq) const {
        const int rbase = u.pm * BM + wr * 64 + fr;
#pragma unroll
        for (int ai = 0; ai < 2; ++ai)
#pragma unroll
            for (int m = 0; m < 4; ++m) { const int chunk = rbase + ai * HALF + m * 16;
#pragma unroll
                for (int bj = 0; bj < 2; ++bj) { const int tt = 8 * bj + 2 * wc + (fq >> 1), c0 = 8 * (fq & 1);
                    f32x4 a = acc[ai][bj][m][0], b = acc[ai][bj][m][1];
#pragma unroll
                    for (int j = 0; j < 4; ++j) { a[j] = gelu_tanh_f(a[j]); b[j] = gelu_tanh_f(b[j]); }
                    __builtin_amdgcn_raw_buffer_store_b128(pack8(a, b), zr, (int)((((unsigned)chunk * 16u + tt) * 512u + u.g * 16 + c0) * 2u), 0,   16); } }
    }
};
struct EpiGlu {
    static constexpr bool PERM = true;
    const bf16_t* Z; const float* bg; bf16_t* CAT;
    __device__ __forceinline__ void done(const Unit&, int) const {}
    __device__ __forceinline__ void operator()(const f32x4 (&acc)[2][2][4][2], const Unit& u, int wr, int wc, int fr, int fq) const {
        const int rbase = u.pm * BM + wr * 64 + fr, col0 = u.pn * BM + wc * 32 + 8 * fq;
        f32x4 bv[2][2];
#pragma unroll
        for (int bj = 0; bj < 2; ++bj)
#pragma unroll
            for (int n = 0; n < 2; ++n) bv[bj][n] = *(const f32x4*)(bg + col0 + bj * HALF + 4 * n);
#pragma unroll
        for (int ai = 0; ai < 2; ++ai)
#pragma unroll
            for (int m = 0; m < 4; ++m) { const int row = rbase + ai * HALF + m * 16;
#pragma unroll
                for (int bj = 0; bj < 2; ++bj) { const u32x4 zw = *(const u32x4*)(Z + (size_t)row * 512 + col0 + bj * HALF);
                    f32x4 a = acc[ai][bj][m][0] + bv[bj][0], b = acc[ai][bj][m][1] + bv[bj][1];
                    a[0] = bflo(zw.x) * sigmoid_f(a[0]); a[1] = bfhi(zw.x) * sigmoid_f(a[1]); a[2] = bflo(zw.y) * sigmoid_f(a[2]); a[3] = bfhi(zw.y) * sigmoid_f(a[3]);
                    b[0] = bflo(zw.z) * sigmoid_f(b[0]); b[1] = bfhi(zw.z) * sigmoid_f(b[1]); b[2] = bflo(zw.w) * sigmoid_f(b[2]); b[3] = bfhi(zw.w) * sigmoid_f(b[3]);
                    *(u32x4*)(CAT + (size_t)row * 1024 + 512 + col0 + bj * HALF) = pack8(a, b); } }
    }
};
template <bool IN_F32, bool OUT_F32> struct EpiRes {
    static constexpr bool PERM = true;
    const float* xin0; const float* xin1;
    const bf16_t* xrin;
    float* xout; bf16_t* xrout;
    const float* gate;
    const float* gn; const float* sc;
    bf16_t* XS; float* ssq;
    __device__ __forceinline__ void done(const Unit&, int) const {}
    __device__ __forceinline__ void operator()(const f32x4 (&acc)[2][2][4][2], const Unit& u, int wr, int wc, int fr, int fq) const {
        const int pm = u.pm, cond = cond_of_pm(pm); const int col0 = u.pn * BM + wc * 32 + 8 * fq; const int rbase = pm * BM + wr * 64 + fr;
        const bool donorm = (gn != nullptr);
        f32x4 gt[2][2], gs[2][2];
#pragma unroll
        for (int bj = 0; bj < 2; ++bj)
#pragma unroll
            for (int n = 0; n < 2; ++n) { const int c = col0 + bj * HALF + n * 4; gt[bj][n] = *(const f32x4*)(gate + cond * 6144 + c);
                if (donorm) { const f32x4 g4 = *(const f32x4*)(gn + c), s4 = *(const f32x4*)(sc + cond * 6144 + c); gs[bj][n] = g4 * (s4 + 1.f); } else gs[bj][n] = (f32x4){0.f, 0.f, 0.f, 0.f}; }
        constexpr int RD = IN_F32 ? 2 : 3;
        f32x4 xr[RD][2][2]; u32x4 xb[RD][2];
#define ER_LOAD(G_, SLOT_) do { const int row_ = rbase + ((G_) >> 2) * HALF + ((G_) & 3) * 16; \
            if (IN_F32) { const float* xi_ = (row_ < MC) ? (xin0 + (size_t)row_ * DM) : (xin1 + (size_t)(row_ - MC) * DM); \
                _Pragma("unroll") for (int bj = 0; bj < 2; ++bj) { xr[SLOT_][bj][0] = *(const f32x4*)(xi_ + col0 + bj * HALF); xr[SLOT_][bj][1] = *(const f32x4*)(xi_ + col0 + bj * HALF + 4); } } \
            else { _Pragma("unroll") for (int bj = 0; bj < 2; ++bj) xb[SLOT_][bj] = *(const u32x4*)(xrin + (size_t)row_ * DM + col0 + bj * HALF); } } while (0)
        ER_LOAD(0, 0); ER_LOAD(1, 1); if (RD == 3) ER_LOAD(2, RD - 1);
#pragma unroll
        for (int g = 0; g < 8; ++g) { const int ai = g >> 2, m = g & 3, sl = g % RD; const int row = rbase + ai * HALF + m * 16;
            float ss = 0.f; f32x4 x0[2], x1[2];
#pragma unroll
            for (int bj = 0; bj < 2; ++bj) { f32x4 a, b;
                if (IN_F32) { a = xr[sl][bj][0]; b = xr[sl][bj][1]; } else { const u32x4 w = xb[sl][bj]; a = (f32x4){bflo(w.x), bfhi(w.x), bflo(w.y), bfhi(w.y)}; b = (f32x4){bflo(w.z), bfhi(w.z), bflo(w.w), bfhi(w.w)}; }
                x0[bj] = a + gt[bj][0] * acc[ai][bj][m][0]; x1[bj] = b + gt[bj][1] * acc[ai][bj][m][1]; }
            if (g + RD < 8) ER_LOAD(g + RD, sl);
#pragma unroll
            for (int bj = 0; bj < 2; ++bj) { const int c = col0 + bj * HALF;
                if (OUT_F32) { *(f32x4*)(xout + (size_t)row * DM + c) = x0[bj]; *(f32x4*)(xout + (size_t)row * DM + c + 4) = x1[bj]; }
                else *(u32x4*)(xrout + (size_t)row * DM + c) = pack8(x0[bj], x1[bj]);
                if (donorm) { const f32x4 t0 = x0[bj] * x0[bj], t1 = x1[bj] * x1[bj]; ss += ((t0[0] + t0[1]) + (t0[2] + t0[3])) + ((t1[0] + t1[1]) + (t1[2] + t1[3]));
                    *(u32x4*)(XS + (size_t)row * DM + c) = pack8(x0[bj] * gs[bj][0], x1[bj] * gs[bj][1]); } }
            if (donorm) { { const int ln_ = fq * 16 + fr; ss += shfl_xor_l(ss, 16, ln_); ss += shfl_xor_l(ss, 32, ln_); } if (fq == 0) atomicAdd(ssq + row, ss); }
        }
#undef ER_LOAD
    }
};
struct EpiUp {
    static constexpr bool PERM = true;
    const float* sumsq; const float* bias; bf16_t* UP;
    __device__ __forceinline__ void done(const Unit&, int) const {}
    __device__ __forceinline__ void operator()(const f32x4 (&acc)[2][2][4][2], const Unit& u, int wr, int wc, int fr, int fq) const {
        const int pm = u.pm, cond = cond_of_pm(pm); const int col0 = u.pn * BM + wc * 32 + 8 * fq; const int rbase = pm * BM + wr * 64 + fr;
        f32x4 bv[2][2];
#pragma unroll
        for (int bj = 0; bj < 2; ++bj)
#pragma unroll
            for (int n = 0; n < 2; ++n) bv[bj][n] = *(const f32x4*)(bias + cond * 4096 + col0 + bj * HALF + 4 * n);
#pragma unroll
        for (int ai = 0; ai < 2; ++ai)
#pragma unroll
            for (int m = 0; m < 4; ++m) { const int row = rbase + ai * HALF + m * 16; const float rstd = rsqrtf(sumsq[row] * (1.f / DM) + EPS);
#pragma unroll
                for (int bj = 0; bj < 2; ++bj) *(u32x4*)(UP + (size_t)row * 4096 + col0 + bj * HALF) = pack8(acc[ai][bj][m][0] * rstd + bv[bj][0], acc[ai][bj][m][1] * rstd + bv[bj][1]); }
    }
};

__device__ __forceinline__ float dpp_shr1(float v) { return __uint_as_float((unsigned)__builtin_amdgcn_update_dpp(0, (int)__float_as_uint(v), 0x111, 0xf, 0xf, false)); }
__device__ __forceinline__ float dpp_shl1(float v) { return __uint_as_float((unsigned)__builtin_amdgcn_update_dpp(0, (int)__float_as_uint(v), 0x101, 0xf, 0xf, false)); }
struct EpiUpConv {
    static constexpr bool PERM = true;
    const float* sumsq; const float* bias; const float* cw; const float* cb; bf16_t* G; bf16_t* HALO;
    __device__ __forceinline__ void done(const Unit&, int) const {}
    __device__ __forceinline__ void operator()(const f32x4 (&acc)[2][2][4][2], const Unit& u, int wr, int wc, int fr, int fq) const {
        const int pm = u.pm, pn = u.pn, cond = cond_of_pm(pm);
        const int posv = pn * 256 + wc * 32 + 8 * fq, av = pn * 128 + wc * 32 + 8 * fq;
        float rs[2][4];
#pragma unroll
        for (int ai = 0; ai < 2; ++ai)
#pragma unroll
            for (int m = 0; m < 4; ++m) rs[ai][m] = sumsq[pm * BM + ai * HALF + wr * 64 + 4 * fr + m];
#pragma unroll
        for (int ai = 0; ai < 2; ++ai)
#pragma unroll
            for (int m = 0; m < 4; ++m) rs[ai][m] = rsqrtf(rs[ai][m] * (1.f / DM) + EPS);
#pragma unroll
        for (int n = 0; n < 2; ++n) {
            const int c = av + 4 * n;
            const f32x4 bvv = *(const f32x4*)(bias + cond * 4096 + posv + 4 * n), bvg = *(const f32x4*)(bias + cond * 4096 + posv + 128 + 4 * n);
            const f32x4 w0v = *(const f32x4*)(cw + c), w1v = *(const f32x4*)(cw + 4096 + c), w2v = *(const f32x4*)(cw + 8192 + c), cbv = *(const f32x4*)(cb + c);
            const f32x4 w0g = *(const f32x4*)(cw + 2048 + c), w1g = *(const f32x4*)(cw + 4096 + 2048 + c), w2g = *(const f32x4*)(cw + 8192 + 2048 + c), cbg = *(const f32x4*)(cb + 2048 + c);
#pragma unroll
            for (int ai = 0; ai < 2; ++ai) {
                const int tok0 = pm * BM + ai * HALF + wr * 64 + 4 * fr; const int sl = pm * 4 + ai * 2 + wr;
                f32x4 pv[4], pg[4];
#pragma unroll
                for (int m = 0; m < 4; ++m) { pv[m] = acc[ai][0][m][n] * rs[ai][m] + bvv; pg[m] = acc[ai][1][m][n] * rs[ai][m] + bvg; }
                f32x4 pvp, pvn, pgp, pgn;
#pragma unroll
                for (int j = 0; j < 4; ++j) { pvp[j] = dpp_shr1(pv[3][j]); pvn[j] = dpp_shl1(pv[0][j]); pgp[j] = dpp_shr1(pg[3][j]); pgn[j] = dpp_shl1(pg[0][j]); }
#pragma unroll
                for (int m = 0; m < 4; ++m) {
                    const f32x4 zv = cbv + w0v * (m == 0 ? pvp : pv[m == 0 ? 0 : m - 1]) + w1v * pv[m] + w2v * (m == 3 ? pvn : pv[m == 3 ? 3 : m + 1]);
                    const f32x4 zg = cbg + w0g * (m == 0 ? pgp : pg[m == 0 ? 0 : m - 1]) + w1g * pg[m] + w2g * (m == 3 ? pgn : pg[m == 3 ? 3 : m + 1]);
                    u32x2 w; w.x = cvt_pk_bf16(silu_f(zg[0]) * zv[0], silu_f(zg[1]) * zv[1]); w.y = cvt_pk_bf16(silu_f(zg[2]) * zv[2], silu_f(zg[3]) * zv[3]);
                    *(u32x2*)(G + (size_t)(tok0 + m) * 2048 + c) = w; }
                if (fr == 0 || fr == 15) { const int m0 = fr == 0 ? 0 : 2;
#pragma unroll
                    for (int mm = 0; mm < 2; ++mm) { const f32x4 a = fr == 0 ? pv[mm] : pv[2 + mm], b = fr == 0 ? pg[mm] : pg[2 + mm];
                        bf16_t* hp = HALO + ((size_t)sl * 4 + m0 + mm) * 4096 + posv + 4 * n;
                        u32x2 wa; wa.x = cvt_pk_bf16(a[0], a[1]); wa.y = cvt_pk_bf16(a[2], a[3]); *(u32x2*)hp = wa;
                        u32x2 wb; wb.x = cvt_pk_bf16(b[0], b[1]); wb.y = cvt_pk_bf16(b[2], b[3]); *(u32x2*)(hp + 128) = wb; } }
            }
        }
    }
};
constexpr int AT_SLOT = 32768, AT_NSLOT = 4, AT_VOFF = 16384, AT_X = 0, AT_ST = 65536;
__device__ __forceinline__ void glds16(const void* gsrc, unsigned lds_dst) { unsigned keep;
    asm volatile("s_mov_b32 %0, m0\n\ts_mov_b32 m0, %2\n\ts_nop 0\n\tglobal_load_lds_dwordx4 %1, off\n\ts_mov_b32 m0, %0" : "=&s"(keep) : "v"(gsrc), "s"(lds_dst) : "memory"); }
#define AT_WAIT_BAR(N) asm volatile("s_waitcnt vmcnt(" #N ") lgkmcnt(0)\n\ts_barrier" ::: "memory")
#define AT_SB() __builtin_amdgcn_sched_barrier(0)
__device__ __forceinline__ s16x4 vtr(const LAS char* p) { typedef short v4i16_t __attribute__((ext_vector_type(4))); return __builtin_bit_cast(s16x4, __builtin_amdgcn_ds_read_tr16_b64_v4i16((LAS v4i16_t*)p)); }
__device__ __forceinline__ int crow(int r, int hi) { return (r & 3) + 8 * (r >> 2) + 4 * hi; }

struct AttnArgs { const bf16_t* Q; const bf16_t* KB; const bf16_t* VB; bf16_t* CAT; const float* subln; float lam; float oml; };

__device__ __forceinline__ void attn_unit(LAS unsigned char* lds, const int tid, const AttnArgs& A, int seq, int h, int qblk) {
    const int lane = tid & 63, r32 = lane & 31, hi = lane >> 5; const int wid = __builtin_amdgcn_readfirstlane(tid >> 6);
    const int rg = wid & 3, s = wid >> 2;
    const bool ctx = seq < NB;
    const int qrow0 = ctx ? seq * SEQ + qblk * 128 : MC + (seq - NB) * DSEQ + qblk * 128;
    const int krow0 = ctx ? seq * SEQ : MC + (seq - NB) * (PAST + DSEQ);
    const int NT = ctx ? SEQ / 64 : (PAST + DSEQ) / 64;
    const unsigned lds0 = (unsigned)(uintptr_t)lds;
    const bf16_t* ksrc0 = A.KB + (size_t)(krow0 + lane) * 512 + h * 128 + wid * 8;
    const bf16_t* vsrc0 = A.VB + (size_t)(krow0 + 16 * (wid & 3) + (lane >> 2)) * 512 + h * 128 + (wid >> 2) * 32 + (lane & 3) * 8;
    const unsigned kdst = lds0 + wid * 1024, vdst = lds0 + AT_VOFF + ((wid >> 2) * 4 + (wid & 3)) * 1024;
#define AT_DMA(t, slot) do { const size_t _o = (size_t)(t) * 64 * 512; const unsigned _s = (unsigned)(slot) * AT_SLOT; \
        glds16(ksrc0 + _o, (unsigned)__builtin_amdgcn_readfirstlane(kdst + _s)); glds16(ksrc0 + _o + 64, (unsigned)__builtin_amdgcn_readfirstlane(kdst + _s + 8 * 1024)); \
        glds16(vsrc0 + _o, (unsigned)__builtin_amdgcn_readfirstlane(vdst + _s)); glds16(vsrc0 + _o + 64, (unsigned)__builtin_amdgcn_readfirstlane(vdst + _s + 8 * 1024)); } while (0)
    AT_DMA(0, 0); AT_DMA(1, 1); AT_DMA(2, 2);
    bf16x8 qr[4];
    { const bf16_t* qp = A.Q + (size_t)(qrow0 + rg * 32 + r32) * 512 + h * 128 + s * 64 + hi * 8;
#pragma unroll
      for (int d0 = 0; d0 < 4; ++d0) qr[d0] = *(const bf16x8*)(qp + d0 * 16); }
    f32x16 o[4];
#pragma unroll
    for (int d0 = 0; d0 < 4; ++d0)
#pragma unroll
        for (int r = 0; r < 16; ++r) o[d0][r] = 0.f;
    float lsum = 0.f;
    const LAS char* kfrag0 = (const LAS char*)lds + (s * 8 + hi) * 1024 + r32 * 16;
    const LAS char* vfrag0 = (const LAS char*)lds + AT_VOFF + ((lane >> 4) & 1) * 32 + (lane & 3) * 8 + (4 * hi + ((lane & 15) >> 2)) * 64;
    f32x16 pc0, pc1;
#define AT_KLOAD(kfr, slot) do { const LAS char* _k = kfrag0 + (slot) * AT_SLOT; _Pragma("unroll") for (int d0 = 0; d0 < 4; ++d0) { kfr[2 * d0] = *(const LAS bf16x8*)(_k + d0 * 2048); kfr[2 * d0 + 1] = *(const LAS bf16x8*)(_k + d0 * 2048 + 512); } } while (0)
#define AT_VLOAD(vv, slot, ks) do { const LAS char* _v = vfrag0 + (slot) * AT_SLOT + (ks) * 1024; _Pragma("unroll") for (int d0 = 0; d0 < 4; ++d0) { const s16x4 lo = vtr(_v + d0 * 4096), hh = vtr(_v + d0 * 4096 + 512); \
        vv[d0] = (bf16x8){lo[0], lo[1], lo[2], lo[3], hh[0], hh[1], hh[2], hh[3]}; } } while (0)
#define AT_EXP2(P, i, W) do { P[2 * (i)] = fast_exp2(P[2 * (i)]); P[2 * (i) + 1] = fast_exp2(P[2 * (i) + 1]); sacc += P[2 * (i)] + P[2 * (i) + 1]; W = cvt_pk_bf16(P[2 * (i)], P[2 * (i) + 1]); } while (0)
    AT_WAIT_BAR(8);
    { bf16x8 kfr[8]; AT_KLOAD(kfr, 0);
#pragma unroll
      for (int r = 0; r < 16; ++r) { pc0[r] = 0.f; pc1[r] = 0.f; }
#pragma unroll
      for (int d0 = 0; d0 < 4; ++d0) { pc0 = __builtin_amdgcn_mfma_f32_32x32x16_bf16(kfr[2 * d0], qr[d0], pc0, 0, 0, 0); pc1 = __builtin_amdgcn_mfma_f32_32x32x16_bf16(kfr[2 * d0 + 1], qr[d0], pc1, 0, 0, 0); } }
    int slot = 0;
    for (int t = 0; t < NT; ++t) {
        const bool has_next = t + 1 < NT;
        if (t + 2 < NT) AT_WAIT_BAR(4); else AT_WAIT_BAR(0);
        if (t + 3 < NT) AT_DMA(t + 3, (slot + 3) & 3);
        const int slot_n = (slot + 1) & 3;
        bf16x8 kfr[8], va[4], vb[4]; u32x4 pw[4]; f32x16 pn0, pn1; float sacc = 0.f;
        const LAS char* kn_ = kfrag0 + slot_n * AT_SLOT;
#define AT_K1(d0) do { kfr[2 * (d0)] = *(const LAS bf16x8*)(kn_ + (d0) * 2048); kfr[2 * (d0) + 1] = *(const LAS bf16x8*)(kn_ + (d0) * 2048 + 512); } while (0)
        if (has_next) { AT_K1(0); AT_K1(1); }
        AT_SB();
        if (has_next) {
#pragma unroll
            for (int r = 0; r < 16; ++r) { pn0[r] = 0.f; pn1[r] = 0.f; }
#pragma unroll
            for (int i = 0; i < 8; ++i) { const int d0 = i >> 1;
                if (i & 1) pn1 = __builtin_amdgcn_mfma_f32_32x32x16_bf16(kfr[2 * d0 + 1], qr[d0], pn1, 0, 0, 0); else pn0 = __builtin_amdgcn_mfma_f32_32x32x16_bf16(kfr[2 * d0], qr[d0], pn0, 0, 0, 0);
                AT_EXP2(pc0, i, pw[i >> 2][i & 3]);
                if (i == 0) AT_K1(2);
                if (i == 1) AT_K1(3);
                if (i == 3) AT_VLOAD(va, slot, 0);
                if (i == 5) AT_VLOAD(vb, slot, 1);
                AT_SB(); }
        } else {
            AT_VLOAD(va, slot, 0); AT_VLOAD(vb, slot, 1);
#pragma unroll
            for (int i = 0; i < 8; ++i) AT_EXP2(pc0, i, pw[i >> 2][i & 3]);
            AT_SB();
        }
        bf16x8 vc[4], vd[4];
#pragma unroll
        for (int i = 0; i < 8; ++i) { const int d0 = i & 3;
            if (i < 4) o[d0] = __builtin_amdgcn_mfma_f32_32x32x16_bf16(va[d0], __builtin_bit_cast(bf16x8, pw[0]), o[d0], 0, 0, 0);
            else       o[d0] = __builtin_amdgcn_mfma_f32_32x32x16_bf16(vb[d0], __builtin_bit_cast(bf16x8, pw[1]), o[d0], 0, 0, 0);
            AT_EXP2(pc1, i, pw[2 + (i >> 2)][i & 3]);
            if (i == 1) AT_VLOAD(vc, slot, 2);
            if (i == 5) AT_VLOAD(vd, slot, 3);
            AT_SB(); }
#pragma unroll
        for (int d0 = 0; d0 < 4; ++d0) o[d0] = __builtin_amdgcn_mfma_f32_32x32x16_bf16(vc[d0], __builtin_bit_cast(bf16x8, pw[2]), o[d0], 0, 0, 0);
#pragma unroll
        for (int d0 = 0; d0 < 4; ++d0) o[d0] = __builtin_amdgcn_mfma_f32_32x32x16_bf16(vd[d0], __builtin_bit_cast(bf16x8, pw[3]), o[d0], 0, 0, 0);
        lsum += sacc;
        if (has_next) { pc0 = pn0; pc1 = pn1; }
        slot = slot_n;
    }
    lsum += shfl_xor_l(lsum, 32, lane);
    const float inv = (s == 0 ? 1.f : A.lam) / lsum;
    AT_WAIT_BAR(0);
    LAS float* X = (LAS float*)(lds + AT_X) + rg * 4096;
    if (s == 1) {
#pragma unroll
        for (int d0 = 0; d0 < 4; ++d0)
#pragma unroll
            for (int r = 0; r < 16; ++r) X[(d0 * 16 + r) * 64 + lane] = o[d0][r] * inv;
    }
    AT_WAIT_BAR(0);
    if (s == 0) {
        float ss = 0.f;
#pragma unroll
        for (int d0 = 0; d0 < 4; ++d0)
#pragma unroll
            for (int r = 0; r < 16; ++r) { const float v = o[d0][r] * inv - X[(d0 * 16 + r) * 64 + lane]; o[d0][r] = v; ss += v * v; }
        ss += shfl_xor_l(ss, 32, lane);
        const float rn = rsqrtf(ss * (1.f / 128.f) + EPS) * A.oml;
        LAS bf16_t* stg = (LAS bf16_t*)(lds + AT_ST) + rg * (32 * 136);
#pragma unroll
        for (int d0 = 0; d0 < 4; ++d0)
#pragma unroll
            for (int rq = 0; rq < 4; ++rq) { const int dv = 32 * d0 + 8 * rq + 4 * hi; const f32x4 g4 = *(const f32x4*)(A.subln + dv);
                u32x2 w; w.x = cvt_pk_bf16(o[d0][4 * rq] * rn * g4[0], o[d0][4 * rq + 1] * rn * g4[1]); w.y = cvt_pk_bf16(o[d0][4 * rq + 2] * rn * g4[2], o[d0][4 * rq + 3] * rn * g4[3]);
                *(LAS u32x2*)(stg + r32 * 136 + dv) = w; }
        asm volatile("s_waitcnt lgkmcnt(0)" ::: "memory");
        bf16_t* dst = A.CAT + (size_t)(qrow0 + rg * 32) * 1024 + h * 128;
#pragma unroll
        for (int i = 0; i < 8; ++i) { const int row = i * 4 + (lane >> 4), ch = lane & 15; const u32x4 v = *(const LAS u32x4*)(stg + row * 136 + ch * 8); *(u32x4*)(dst + (size_t)row * 1024 + ch * 8) = v; }
    }
    AT_WAIT_BAR(0);
#undef AT_DMA
#undef AT_KLOAD
#undef AT_K1
#undef AT_VLOAD
#undef AT_EXP2
}
struct Args { const float* in[34]; float* out; unsigned char* ws; int stop_after; int pad; };
typedef const __attribute__((address_space(4))) Args* kargs_t;
struct Frame {
    LAS unsigned char* lds; int tid, lane, wave, vcu, bid, G;
    kargs_t ka; float* out; unsigned char* ws;
    float* misc; unsigned* ctl;
};
#define LDS_WAIT() asm volatile("s_waitcnt lgkmcnt(0)" ::: "memory")
#define VM_WAIT() asm volatile("s_waitcnt vmcnt(0)" ::: "memory")

template <int MAP> __device__ __forceinline__ int src_col(int p);
template <int MODE, int MAP, int NC> __device__ __forceinline__ void gemv9_task(Frame& F, const float* W, int ldw, int l, int voff, int strip, float* out, int ldo, const float* add) {
    LAS float* sc = (LAS float*)F.lds; LAS float* red = sc + 9 * 1024;
    for (int i = F.tid; i < 9 * 1024; i += NTHREADS) { const int cond = i >> 10, k = i & 1023; float v;
        if (MODE == 0) { v = cond == 0 ? F.ka->in[6][k] : F.ka->in[5][(cond - 1) * 1024 + k]; v = v / (1.f + expf(-v)); } else v = F.misc[MI_MOD + (l * 9 + cond) * 6144 + voff + k];
        sc[i] = v; }
    __syncthreads();
    const int j = strip * NC + (F.lane < NC ? F.lane : NC - 1); const float* w = W + (size_t)(F.wave * 128) * ldw + src_col<MAP>(j);
    float acc[9];
#pragma unroll
    for (int b = 0; b < 9; ++b) acc[b] = 0.f;
#pragma unroll 16
    for (int k = 0; k < 128; ++k) { const float wv = w[(size_t)k * ldw];
#pragma unroll
        for (int b = 0; b < 9; ++b) acc[b] += sc[b * 1024 + F.wave * 128 + k] * wv; }
#pragma unroll
    for (int b = 0; b < 9; ++b) red[(F.wave * 9 + b) * 64 + F.lane] = acc[b];
    __syncthreads();
    for (int i = F.tid; i < 9 * 64; i += NTHREADS) { const int b = i >> 6, ln = i & 63; if (ln >= NC) continue; float s_ = 0.f;
#pragma unroll
        for (int w8 = 0; w8 < 8; ++w8) s_ += red[(w8 * 9 + b) * 64 + ln];
        const int jj = strip * NC + ln; out[(size_t)b * ldo + jj] = s_ + (add ? add[jj] : 0.f); }
    __syncthreads();
}
template <int MAP> __device__ __forceinline__ int src_col(int p) {
    if (MAP == 1) { if (p >= 1024) return p; const int pn = p >> 8, r = p & 255, bj = r >> 7, wc = (r >> 5) & 3, fq = (r >> 3) & 3, low = r & 7; return 256 * pn + 64 * wc + 32 * (fq >> 1) + 16 * bj + 8 * (fq & 1) + low; }
    if (MAP == 2) { const int pn = p >> 8, bj = (p >> 7) & 1, r = p & 127; return bj * 2048 + 128 * pn + r; }
    return p;
}
__device__ __forceinline__ void mod_task3(Frame& F, int task) {
    const int l = task / 96, r = task % 96, kq = r / 24, cg = r % 24;
    LAS float* sc = (LAS float*)F.lds; LAS float* red = sc + 9 * 256;
    for (int i = F.tid; i < 9 * 256; i += NTHREADS) { const int cond = i >> 8, k = kq * 256 + (i & 255); const float v = cond == 0 ? F.ka->in[6][k] : F.ka->in[5][(cond - 1) * 1024 + k]; sc[i] = v / (1.f + expf(-v)); }
    __syncthreads();
    const float* w = F.ka->in[7] + ((size_t)l * DM + kq * 256 + F.wave * 32) * 6144 + cg * 256 + F.lane * 4;
    f32x4 acc[9];
#pragma unroll
    for (int b = 0; b < 9; ++b) acc[b] = (f32x4){0.f, 0.f, 0.f, 0.f};
#pragma unroll
    for (int h = 0; h < 2; ++h) { f32x4 wv[16];
#pragma unroll
        for (int k = 0; k < 16; ++k) wv[k] = *(const f32x4*)(w + (size_t)(h * 16 + k) * 6144);
#pragma unroll
        for (int k = 0; k < 16; ++k)
#pragma unroll
            for (int b = 0; b < 9; ++b) acc[b] += wv[k] * sc[b * 256 + F.wave * 32 + h * 16 + k]; }
#pragma unroll
    for (int b = 0; b < 9; ++b) *(LAS f32x4*)(red + (F.wave * 9 + b) * 256 + F.lane * 4) = acc[b];
    __syncthreads();
    for (int i = F.tid; i < 9 * 256; i += NTHREADS) { const int b = i >> 8, c = i & 255; float v = 0.f;
#pragma unroll
        for (int w8 = 0; w8 < 8; ++w8) v += red[(w8 * 9 + b) * 256 + c];
        const int col = cg * 256 + c; if (kq == 0) v += F.ka->in[8][l * 6144 + col];
        atomicAdd(F.misc + MI_MOD + (l * 9 + b) * 6144 + col, v); }
    __syncthreads();
}
template <int MAP, bool BIAS> __device__ __forceinline__ void transpose_item(Frame& F, const float* W, int K, int N, bf16_t* WT, LAS float* scr, int item, const float* shv, float* bias) {
    const int lane = F.lane; const int nblk = N / 64, kb = item / nblk, nb = item % nblk, k0 = 64 * kb, n0 = 64 * nb;
    const int sc_ = src_col<MAP>(n0 + lane);
    float tv[64];
#pragma unroll
    for (int i = 0; i < 64; ++i) tv[i] = W[(size_t)(k0 + i) * N + sc_];
#pragma unroll
    for (int i = 0; i < 64; ++i) scr[i * 65 + lane] = tv[i];
    LDS_WAIT(); asm volatile("" ::: "memory");
    const int c = lane & 7;
#pragma unroll
    for (int j = 0; j < 8; ++j) { const int n = (lane >> 3) + 8 * j; const LAS float* s_ = scr + (8 * c) * 65 + n;
        u32x4 o; o.x = cvt_pk_bf16(s_[0 * 65], s_[1 * 65]); o.y = cvt_pk_bf16(s_[2 * 65], s_[3 * 65]); o.z = cvt_pk_bf16(s_[4 * 65], s_[5 * 65]); o.w = cvt_pk_bf16(s_[6 * 65], s_[7 * 65]);
        *(u32x4*)(WT + (size_t)(n0 + n) * K + k0 + 8 * c) = o; }
    if (BIAS) {
        float sh[9], acc[9];
#pragma unroll
        for (int b = 0; b < 9; ++b) { sh[b] = shv[b * 6144 + k0 + lane]; acc[b] = 0.f; }
#pragma unroll
        for (int kk = 0; kk < 64; ++kk) { const float w = tv[kk];
#pragma unroll
            for (int b = 0; b < 9; ++b) acc[b] += __uint_as_float(__builtin_amdgcn_readlane(__float_as_uint(sh[b]), kk)) * w; }
#pragma unroll
        for (int b = 0; b < 9; ++b) atomicAdd(bias + (size_t)b * N + n0 + lane, acc[b]);
    }
    LDS_WAIT(); asm volatile("" ::: "memory");
}
__device__ __forceinline__ void cache_item(Frame& F, int l, int item4) {
    f32x4 a[4], c[4];
#pragma unroll
    for (int i = 0; i < 4; ++i) { const int item = item4 * 4 + i, which = item >> 12, r = item & 4095, b = r >> 9, j = r & 511;
        const float* src = (which ? F.ka->in[3] : F.ka->in[2]) + ((size_t)(b * DEPTH + l) * PAST + j) * 512 + F.lane * 8; a[i] = *(const f32x4*)src; c[i] = *(const f32x4*)(src + 4); }
#pragma unroll
    for (int i = 0; i < 4; ++i) { const int item = item4 * 4 + i, which = item >> 12, r = item & 4095, b = r >> 9, j = r & 511;
        bf16_t* dst = (bf16_t*)(F.ws + (which ? WS_VB : WS_KB)) + (size_t)(MC + b * (PAST + DSEQ) + j) * 512 + F.lane * 8; *(u32x4*)dst = pack8(a[i], c[i]); }
}
__device__ __forceinline__ f32x2 cmul(f32x2 a, f32x2 b) { return (f32x2){a.x * b.x - a.y * b.y, a.x * b.y + a.y * b.x}; }
__device__ __forceinline__ void ssm_prep(Frame& F, int l, int task) {
    const int g = task >> 1, half = task & 1;
    LAS f32x2* POW = (LAS f32x2*)F.lds;
    LAS f32x2* BB = POW + 2 * 17 * 64;
    LAS f32x2* CC = BB + 2 * 64 * 16;
    LAS f32x2* CT = CC + 2 * 16 * 64;
    LAS float* KT = (LAS float*)(CT + 2 * 64 * 16);
    constexpr int KTS = 260;
    bf16_t* WE = (bf16_t*)(F.ws + WS_SSM + SSM_WE) + (size_t)g * 256 * 256;
    bf16_t* WY = (bf16_t*)(F.ws + WS_SSM + SSM_WY) + (size_t)g * 256 * 512;
    f32x2* LAM16 = (f32x2*)(F.ws + WS_SSM + SSM_LAM16); f32x2* BBAR = (f32x2*)(F.ws + WS_SSM + SSM_BBAR);
    const int tid = F.tid, lane = F.lane;
    if (tid < 128) { const int dir = tid >> 6, p = tid & 63; const size_t pi = ((size_t)(l * 2 + dir) * NG + g) * 64 + p;
        const float lr = F.ka->in[18][pi], li = F.ka->in[19][pi], delta = expf(F.ka->in[20][(l * 2 + dir) * NG + g]);
        const float er = expf(lr * delta), lbr = er * cosf(li * delta), lbi = er * sinf(li * delta);
        { float one_ = 1.f, zero_ = 0.f; asm volatile("" : "+v"(one_), "+v"(zero_));
          f32x2 pw = (f32x2){one_, zero_}; const f32x2 lb = (f32x2){lbr, lbi};
          for (int tau = 0; tau <= 16; ++tau) { POW[(dir * 17 + tau) * 64 + p] = pw; if (tau == 16 && half == 0) LAM16[(dir * NG + g) * 64 + p] = pw; pw = cmul(pw, lb); } }
        const float nr = lbr - 1.f, ni = lbi, den = lr * lr + li * li; const f32x2 fac = (f32x2){(nr * lr + ni * li) / den, (ni * lr - nr * li) / den};
        f32x4 br[4], bi4[4];
#pragma unroll
        for (int q = 0; q < 4; ++q) { br[q] = *(const f32x4*)(F.ka->in[21] + pi * 16 + 4 * q); bi4[q] = *(const f32x4*)(F.ka->in[22] + pi * 16 + 4 * q); }
#pragma unroll
        for (int ch = 0; ch < 16; ++ch) { const f32x2 bb = cmul(fac, (f32x2){br[ch >> 2][ch & 3], bi4[ch >> 2][ch & 3]}); BB[(dir * 64 + p) * 16 + ch] = bb; if (half == 0) BBAR[((size_t)(dir * NG + g) * 64 + p) * 16 + ch] = bb; }
    }
    { f32x2 cv[4];
#pragma unroll
      for (int q = 0; q < 4; ++q) { const int i = tid + q * NTHREADS, dir = i >> 10, c = (i >> 6) & 15, p = i & 63; const size_t ci = (((size_t)(l * 2 + dir) * NG + g) * 16 + c) * 64 + p; cv[q] = (f32x2){F.ka->in[23][ci], F.ka->in[24][ci]}; }
#pragma unroll
      for (int q = 0; q < 4; ++q) { const int i = tid + q * NTHREADS, dir = i >> 10, c = (i >> 6) & 15, p = i & 63; CC[i] = cv[q]; CT[(dir * 64 + p) * 16 + c] = cv[q]; } }
    __syncthreads();
    { const int i16 = lane & 15, k4 = lane >> 4, ri = k4 & 1, ph = k4 >> 1;
      for (int blk = 0; blk < 4; ++blk) { const int q = F.wave * 4 + blk, dir = q >> 4, tau = q & 15; f32x4 acc = (f32x4){0.f, 0.f, 0.f, 0.f};
#pragma unroll 8
          for (int ks = 0; ks < 32; ++ks) { const int p = 2 * ks + ph;
              const f32x2 cc = CT[(dir * 64 + p) * 16 + i16], pw = POW[(dir * 17 + tau) * 64 + p], bb = BB[(dir * 64 + p) * 16 + i16];
              const float u = ri ? -pw.y : pw.x, v = ri ? pw.x : pw.y;
              const float av = cc.x * u - cc.y * v, bv = ri ? bb.y : bb.x;
              acc = __builtin_amdgcn_mfma_f32_16x16x4f32(av, bv, acc, 0, 0, 0); }
#pragma unroll
          for (int r = 0; r < 4; ++r) KT[(dir * 16 + tau) * KTS + (k4 * 4 + r) * 16 + i16] = acc[r]; } }
    __syncthreads();
    const float* Dv = F.ka->in[25] + l * 512 + g * 16;
    for (int idx = half * 8192 + tid; idx < (half + 1) * 8192; idx += NTHREADS) { const int n = idx >> 6, kc = idx & 63, k0 = kc * 8, i = n >> 4, c = n & 15; f32x4 v0, v1;
        if (k0 < 256) { const int s_ = k0 >> 4, ch0 = k0 & 15; v0 = (f32x4){0.f, 0.f, 0.f, 0.f}; v1 = v0;
            if (s_ <= i) { const LAS float* kp = KT + (i - s_) * KTS + c * 16 + ch0; v0 += *(const LAS f32x4*)kp; v1 += *(const LAS f32x4*)(kp + 4); }
            if (s_ >= i) { const LAS float* kp = KT + (16 + s_ - i) * KTS + c * 16 + ch0; v0 += *(const LAS f32x4*)kp; v1 += *(const LAS f32x4*)(kp + 4); }
            if (s_ == i) { const int e = c - ch0; const float dv = Dv[c]; if (e >= 0 && e < 4) v0[e] += dv; else if (e >= 4 && e < 8) v1[e - 4] += dv; }
        } else { const int dir = k0 >= 384 ? 1 : 0, p0 = ((k0 - 256) & 127) >> 1, tau = dir ? 16 - i : i + 1;
            const LAS f32x4* cp = (const LAS f32x4*)(CC + (dir * 16 + c) * 64 + p0); const LAS f32x4* pp = (const LAS f32x4*)(POW + (dir * 17 + tau) * 64 + p0);
            const f32x4 c0 = cp[0], c1 = cp[1], w0 = pp[0], w1 = pp[1];
            v0 = (f32x4){c0[0] * w0[0] - c0[1] * w0[1], -(c0[0] * w0[1] + c0[1] * w0[0]), c0[2] * w0[2] - c0[3] * w0[3], -(c0[2] * w0[3] + c0[3] * w0[2])};
            v1 = (f32x4){c1[0] * w1[0] - c1[1] * w1[1], -(c1[0] * w1[1] + c1[1] * w1[0]), c1[2] * w1[2] - c1[3] * w1[3], -(c1[2] * w1[3] + c1[3] * w1[2])}; }
        *(u32x4*)(WY + (size_t)n * 512 + k0) = pack8(v0, v1); }
    for (int idx = half * 4096 + tid; idx < (half + 1) * 4096; idx += NTHREADS) { const int n = idx >> 5, k0 = (idx & 31) * 8, dir = n >> 7, p = (n & 127) >> 1, ri = n & 1, s_ = k0 >> 4, ch0 = k0 & 15;
        const f32x2 pw = POW[(dir * 17 + (dir ? s_ : 15 - s_)) * 64 + p]; const LAS f32x4* bp = (const LAS f32x4*)(BB + (dir * 64 + p) * 16 + ch0);
        const float u = ri ? pw.y : pw.x, v = ri ? pw.x : -pw.y;
        const f32x4 b0 = bp[0], b1 = bp[1], b2 = bp[2], b3 = bp[3];
        const f32x4 v0 = (f32x4){u * b0[0] + v * b0[1], u * b0[2] + v * b0[3], u * b1[0] + v * b1[1], u * b1[2] + v * b1[3]};
        const f32x4 v1 = (f32x4){u * b2[0] + v * b2[1], u * b2[2] + v * b2[3], u * b3[0] + v * b3[1], u * b3[2] + v * b3[3]};
        *(u32x4*)(WE + (size_t)n * 256 + k0) = pack8(v0, v1); }
    __syncthreads();
}
__device__ __forceinline__ void xprep_item(Frame& F, int item4) {
    f32x4 xv[4][4];
#pragma unroll
    for (int i = 0; i < 4; ++i) { const int row = item4 * 4 + i; const float* xr = (row < MC) ? F.ka->in[0] + (size_t)row * DM : F.ka->in[1] + (size_t)(row - MC) * DM;
#pragma unroll
        for (int j = 0; j < 4; ++j) xv[i][j] = *(const f32x4*)(xr + 4 * F.lane + 256 * j); }
    const int cond = item4 * 4 < MC ? 0 : 1 + ((item4 * 4 - MC) >> 10);
    const float* sc = F.misc + MI_MOD + (0 * 9 + cond) * 6144 + 1024; const float* g1 = F.ka->in[9];
    f32x4 gs[4];
#pragma unroll
    for (int j = 0; j < 4; ++j) { const int c = 4 * F.lane + 256 * j; gs[j] = (*(const f32x4*)(g1 + c)) * (*(const f32x4*)(sc + c) + 1.f); }
#pragma unroll
    for (int i = 0; i < 4; ++i) { const int row = item4 * 4 + i; bf16_t* dst = (bf16_t*)(F.ws + WS_XS) + (size_t)row * DM; float s = 0.f;
#pragma unroll
        for (int j = 0; j < 4; ++j) { const f32x4 x = xv[i][j]; const f32x4 t = x * x; s += (t[0] + t[1]) + (t[2] + t[3]); const f32x4 y = x * gs[j];
            u32x2 w; w.x = cvt_pk_bf16(y[0], y[1]); w.y = cvt_pk_bf16(y[2], y[3]); *(u32x2*)(dst + 4 * F.lane + 256 * j) = w; }
        s = wave_sum(s, F.lane);
        if (F.lane == 0) ((float*)(F.ctl + CW_SS))[row] = s; }
}
__device__ __forceinline__ void bias_item(Frame& F, int item) {
    const int which = item >= 2048, n = which ? item - 2048 : item;
    const bf16_t* wrow = (const bf16_t*)(F.ws + (which ? WS_WUP : WS_WIN)) + (size_t)n * DM;
    float wv[16]; { const u32x4 a = *(const u32x4*)(wrow + F.lane * 8), b = *(const u32x4*)(wrow + 512 + F.lane * 8);
        wv[0] = bflo(a.x); wv[1] = bfhi(a.x); wv[2] = bflo(a.y); wv[3] = bfhi(a.y); wv[4] = bflo(a.z); wv[5] = bfhi(a.z); wv[6] = bflo(a.w); wv[7] = bfhi(a.w);
        wv[8] = bflo(b.x); wv[9] = bfhi(b.x); wv[10] = bflo(b.y); wv[11] = bfhi(b.y); wv[12] = bflo(b.z); wv[13] = bfhi(b.z); wv[14] = bflo(b.w); wv[15] = bfhi(b.w); }
    float outv = 0.f;
#pragma unroll
    for (int cond = 0; cond < 9; ++cond) { const float* sh = F.misc + MI_MOD + cond * 6144 + (which ? 3072 : 0);
        const f32x4 s0 = *(const f32x4*)(sh + F.lane * 8), s1 = *(const f32x4*)(sh + F.lane * 8 + 4), s2 = *(const f32x4*)(sh + 512 + F.lane * 8), s3 = *(const f32x4*)(sh + 512 + F.lane * 8 + 4);
        float d = 0.f;
#pragma unroll
        for (int e = 0; e < 4; ++e) d += s0[e] * wv[e] + s1[e] * wv[4 + e] + s2[e] * wv[8 + e] + s3[e] * wv[12 + e];
        d = wave_sum(d, F.lane); if (F.lane == cond) outv = d; }
    if (F.lane < 9) ((float*)F.ctl)[(which ? CW_BUP + F.lane * 4096 : CW_BIN + F.lane * 2048) + n] = outv;
}
__device__ __forceinline__ void ssm_scan(Frame& F, int l, int g, int pm) {
    const int tid = F.tid, sl = tid >> 7, dp = tid & 127, dir = dp >> 6, p = dp & 63;
    const f32x2* LAM16 = (const f32x2*)(F.ws + WS_SSM + SSM_LAM16); const f32x2* BBAR = (const f32x2*)(F.ws + WS_SSM + SSM_BBAR);
    const float* E = (const float*)(F.ws + WS_R + R_E); bf16_t* AS3 = (bf16_t*)(F.ws + WS_R + R_AS3);
    const f32x2 lam = LAM16[(dir * NG + g) * 64 + p];
    f32x2 e[64];
    if (pm == 0) {
#pragma unroll
        for (int q = 0; q < 4; ++q) { const float* ep = E + ((size_t)g * NCHUNK + (q * 4 + sl) * 16) * 256 + dir * 128 + 2 * p;
#pragma unroll
            for (int j = 0; j < 16; ++j) e[q * 16 + j] = *(const f32x2*)(ep + (size_t)j * 256); }
    } else { const float* ep = E + ((size_t)g * NCHUNK + 256 + ((pm - 1) * 4 + sl) * 64) * 256 + dir * 128 + 2 * p;
#pragma unroll
        for (int j = 0; j < 64; ++j) e[j] = *(const f32x2*)(ep + (size_t)j * 256); }
    const int nq = pm == 0 ? 4 : 1;
#pragma unroll
    for (int q = 0; q < 4; ++q) { if (q >= nq) break;
        int base; f32x2 h;
        if (pm == 0) { const int seq = q * 4 + sl; base = seq * 16; h = (f32x2){0.f, 0.f}; }
        else { const int sq = (pm - 1) * 4 + sl; base = 256 + sq * 64; h = *(const f32x2*)(F.ka->in[4] + ((((size_t)sq * DEPTH + l) * 2 + dir) * NG + g) * 128 + 2 * p); }
        unsigned* hp = (unsigned*)(AS3 + ((size_t)g * NCHUNK + base) * 512 + 256 + dir * 128 + 2 * p);
        if (pm == 0) {
#pragma unroll
            for (int jj = 0; jj < 16; ++jj) { const int j = dir ? 15 - jj : jj; const f32x2 ev = dir ? e[q * 16 + 15 - jj] : e[q * 16 + jj]; hp[(size_t)j * 256] = cvt_pk_bf16(h.x, h.y); h = cmul(lam, h) + ev; }
        } else {
#pragma unroll
            for (int jj = 0; jj < 64; ++jj) { const int j = dir ? 63 - jj : jj; const f32x2 ev = dir ? e[63 - jj] : e[jj]; hp[(size_t)j * 256] = cvt_pk_bf16(h.x, h.y); h = cmul(lam, h) + ev; }
        }
    }
    if (pm == 0) {
        const int tt = dir ? 15 : 0; u32x4 uq[4][2]; f32x2 bbv[16];
        const f32x2* bb = BBAR + ((size_t)(dir * NG + g) * 64 + p) * 16;
#pragma unroll
        for (int ch = 0; ch < 16; ++ch) bbv[ch] = bb[ch];
#pragma unroll
        for (int q = 0; q < 4; ++q) { const int chunk = (q * 4 + sl) * 16 + tt; const bf16_t* up = AS3 + ((size_t)g * NCHUNK + chunk) * 512 + tt * 16; uq[q][0] = *(const u32x4*)up; uq[q][1] = *(const u32x4*)(up + 8); }
        float* ns = F.out + (size_t)MT * DM + 2 * (size_t)NB * DEPTH * SEQ * 512;
#pragma unroll
        for (int q = 0; q < 4; ++q) { const int seq = q * 4 + sl; const u32x4 u0 = uq[q][0], u1 = uq[q][1];
            const float uu[16] = {bflo(u0.x), bfhi(u0.x), bflo(u0.y), bfhi(u0.y), bflo(u0.z), bfhi(u0.z), bflo(u0.w), bfhi(u0.w), bflo(u1.x), bfhi(u1.x), bflo(u1.y), bfhi(u1.y), bflo(u1.z), bfhi(u1.z), bflo(u1.w), bfhi(u1.w)};
            f32x2 acc = (f32x2){0.f, 0.f};
#pragma unroll
            for (int ch = 0; ch < 16; ++ch) acc += bbv[ch] * uu[ch];
            *(f32x2*)(ns + ((((size_t)seq * DEPTH + l) * 2 + dir) * NG + g) * 128 + 2 * p) = acc; }
    }
}
__device__ __forceinline__ void ld16(const bf16_t* p, float* v) { const u32x4 a = *(const u32x4*)p; v[0] = bflo(a.x); v[1] = bfhi(a.x); v[2] = bflo(a.y); v[3] = bfhi(a.y); v[4] = bflo(a.z); v[5] = bfhi(a.z); v[6] = bflo(a.w); v[7] = bfhi(a.w); }
__device__ __forceinline__ void conv_item(Frame& F, int l, int item) {
    const int rs = item >> 4, pn = item & 15, lr = F.lane >> 4, lc = F.lane & 15;
    const int r0 = rs * 64 + lr * 16; const int av = 128 * pn + 8 * lc;
    const bf16_t* up = (const bf16_t*)(F.ws + WS_R) + (size_t)r0 * 4096 + 256 * pn + 8 * lc; bf16_t* gp = (bf16_t*)(F.ws + WS_G) + (size_t)r0 * 2048 + av;
    const float* cw = F.ka->in[31] + (size_t)l * 3 * 4096; const float* cb = F.ka->in[32] + (size_t)l * 4096;
    float wv[3][8], wg[3][8], bv[8], bg[8];
#pragma unroll
    for (int k = 0; k < 3; ++k)
#pragma unroll
        for (int e = 0; e < 8; ++e) { wv[k][e] = cw[k * 4096 + av + e]; wg[k][e] = cw[k * 4096 + 2048 + av + e]; }
#pragma unroll
    for (int e = 0; e < 8; ++e) { bv[e] = cb[av + e]; bg[e] = cb[2048 + av + e]; }
    const int t0 = r0 < MC ? (r0 & 255) : ((r0 - MC) & 1023), L = r0 < MC ? SEQ : DSEQ;
    float pv[8], pg[8], cv[8], cg[8], nv_[8], ng[8];
    if (t0 > 0) { ld16(up - 4096, pv); ld16(up - 4096 + 128, pg); } else {
#pragma unroll
        for (int e = 0; e < 8; ++e) { pv[e] = 0.f; pg[e] = 0.f; } }
    ld16(up, cv); ld16(up + 128, cg);
#pragma unroll
    for (int i = 0; i < 16; ++i) {
        if (t0 + i + 1 < L) { ld16(up + (size_t)(i + 1) * 4096, nv_); ld16(up + (size_t)(i + 1) * 4096 + 128, ng); } else {
#pragma unroll
            for (int e = 0; e < 8; ++e) { nv_[e] = 0.f; ng[e] = 0.f; } }
        float o[8];
#pragma unroll
        for (int e = 0; e < 8; ++e) { const float zv = bv[e] + wv[0][e] * pv[e] + wv[1][e] * cv[e] + wv[2][e] * nv_[e]; const float zg = bg[e] + wg[0][e] * pg[e] + wg[1][e] * cg[e] + wg[2][e] * ng[e]; o[e] = silu_f(zg) * zv; }
        u32x4 w; w.x = cvt_pk_bf16(o[0], o[1]); w.y = cvt_pk_bf16(o[2], o[3]); w.z = cvt_pk_bf16(o[4], o[5]); w.w = cvt_pk_bf16(o[6], o[7]);
        *(u32x4*)(gp + (size_t)i * 2048) = w;
#pragma unroll
        for (int e = 0; e < 8; ++e) { pv[e] = cv[e]; pg[e] = cg[e]; cv[e] = nv_[e]; cg[e] = ng[e]; }
    }
}

__device__ __forceinline__ bool slab_first(int s) { return s < 64 ? (s & 3) == 0 : ((s - 64) & 15) == 0; }
__device__ __forceinline__ bool slab_last(int s) { return s < 64 ? (s & 3) == 3 : ((s - 64) & 15) == 15; }
__device__ __forceinline__ void ld4bf(const bf16_t* p, float* v) { const u32x2 a = *(const u32x2*)p; v[0] = bflo(a.x); v[1] = bfhi(a.x); v[2] = bflo(a.y); v[3] = bfhi(a.y); }
__device__ __forceinline__ void conv_fix(Frame& F, int l, int pm) {
    const bf16_t* HALO = (const bf16_t*)(F.ws + WS_HALO); bf16_t* G = (bf16_t*)(F.ws + WS_G);
    const float* cw = F.ka->in[31] + (size_t)l * 3 * 4096; const float* cb = F.ka->in[32] + (size_t)l * 4096;
    const int c = F.tid * 4, pos = 256 * (c >> 7) + (c & 127);
    float wv[3][4], wg[3][4], bv[4], bg[4];
#pragma unroll
    for (int k = 0; k < 3; ++k) { const f32x4 a = *(const f32x4*)(cw + k * 4096 + c), b = *(const f32x4*)(cw + k * 4096 + 2048 + c);
#pragma unroll
        for (int e = 0; e < 4; ++e) { wv[k][e] = a[e]; wg[k][e] = b[e]; } }
    { const f32x4 a = *(const f32x4*)(cb + c), b = *(const f32x4*)(cb + 2048 + c);
#pragma unroll
      for (int e = 0; e < 4; ++e) { bv[e] = a[e]; bg[e] = b[e]; } }
    u32x2 hv[8][6];
#pragma unroll
    for (int r8 = 0; r8 < 8; ++r8) { const int s = pm * 4 + (r8 >> 1), which = r8 & 1; const bool skip = which == 0 ? slab_first(s) : slab_last(s);
        const int sp = skip ? s : (which == 0 ? s - 1 : s), sn = skip ? s : (which == 0 ? s : s + 1);
        const bf16_t* hp = which == 0 ? HALO + ((size_t)sp * 4 + 3) * 4096 : HALO + ((size_t)s * 4 + 2) * 4096;
        const bf16_t* hc = which == 0 ? HALO + ((size_t)s * 4 + 0) * 4096 : HALO + ((size_t)s * 4 + 3) * 4096;
        const bf16_t* hn = which == 0 ? HALO + ((size_t)s * 4 + 1) * 4096 : HALO + ((size_t)sn * 4 + 0) * 4096;
        hv[r8][0] = *(const u32x2*)(hp + pos); hv[r8][1] = *(const u32x2*)(hc + pos); hv[r8][2] = *(const u32x2*)(hn + pos);
        hv[r8][3] = *(const u32x2*)(hp + pos + 128); hv[r8][4] = *(const u32x2*)(hc + pos + 128); hv[r8][5] = *(const u32x2*)(hn + pos + 128); }
#pragma unroll
    for (int r8 = 0; r8 < 8; ++r8) { const int s = pm * 4 + (r8 >> 1), which = r8 & 1;
        if (which == 0 ? slab_first(s) : slab_last(s)) continue;
        float pv[4], cv[4], nv_[4], pg[4], cg[4], ng[4];
#define UNP(v, w) do { v[0] = bflo(w.x); v[1] = bfhi(w.x); v[2] = bflo(w.y); v[3] = bfhi(w.y); } while (0)
        UNP(pv, hv[r8][0]); UNP(cv, hv[r8][1]); UNP(nv_, hv[r8][2]); UNP(pg, hv[r8][3]); UNP(cg, hv[r8][4]); UNP(ng, hv[r8][5]);
#undef UNP
        float o[4];
#pragma unroll
        for (int e = 0; e < 4; ++e) { const float zv = bv[e] + wv[0][e] * pv[e] + wv[1][e] * cv[e] + wv[2][e] * nv_[e]; const float zg = bg[e] + wg[0][e] * pg[e] + wg[1][e] * cg[e] + wg[2][e] * ng[e]; o[e] = silu_f(zg) * zv; }
        u32x2 w; w.x = cvt_pk_bf16(o[0], o[1]); w.y = cvt_pk_bf16(o[2], o[3]);
        *(u32x2*)(G + (size_t)(s * 64 + (which ? 63 : 0)) * 2048 + c) = w; }
}
constexpr int N_TR_ITEMS_L = 16 * 32 + 8 * 8 + 16 * 16 + 16 * 64 + 32 * 16;
template <bool BIAS> __device__ __forceinline__ void weight_item(Frame& F, LAS float* scr, int l, int it) {
    int r = it; const float* modl = F.misc + MI_MOD + l * 9 * 6144; float* cf = (float*)F.ctl;
    if (r < 512) { transpose_item<1, BIAS>(F, F.ka->in[10] + (size_t)l * DM * 2048, DM, 2048, (bf16_t*)(F.ws + WS_WIN) + (size_t)l * 2048 * DM, scr, r, modl, cf + CW_BIN + l * 9 * 2048); return; } r -= 512;
    if (r < 64) { transpose_item<0, false>(F, F.ka->in[26] + (size_t)l * 512 * 512, 512, 512, (bf16_t*)(F.ws + WS_WGLU) + (size_t)l * 512 * 512, scr, r, nullptr, nullptr); return; } r -= 64;
    if (r < 256) { transpose_item<0, false>(F, F.ka->in[28] + (size_t)l * DM * DM, DM, DM, (bf16_t*)(F.ws + WS_WOUT) + (size_t)l * DM * DM, scr, r, nullptr, nullptr); return; } r -= 256;
    if (r < 1024) { transpose_item<2, BIAS>(F, F.ka->in[30] + (size_t)l * DM * 4096, DM, 4096, (bf16_t*)(F.ws + WS_WUP) + (size_t)l * 4096 * DM, scr, r, modl + 3072, cf + CW_BUP + l * 9 * 4096); return; } r -= 1024;
    transpose_item<0, false>(F, F.ka->in[33] + (size_t)l * 2048 * DM, 2048, DM, (bf16_t*)(F.ws + WS_WDN) + (size_t)l * DM * 2048, scr, r, nullptr, nullptr);
}

__global__ void __launch_bounds__(NTHREADS, 2) mega(Args args) {
    extern __shared__ __attribute__((aligned(16))) unsigned char lds_raw[];
    Frame F;
    F.lds = (LAS unsigned char*)lds_raw;
    F.tid = threadIdx.x; F.lane = F.tid & 63; F.wave = __builtin_amdgcn_readfirstlane(F.tid >> 6);
    F.G = gridDim.x; F.bid = blockIdx.x; { const int bx = blockIdx.x; F.vcu = (F.G % 8 == 0) ? (bx % 8) * (F.G / 8) + bx / 8 : bx; }
    F.ka = (kargs_t)__builtin_amdgcn_kernarg_segment_ptr();
    F.out = args.out; F.ws = args.ws; F.misc = (float*)(args.ws + WS_MISC); F.ctl = (unsigned*)(args.ws + WS_CTL);
    volatile LAS unsigned* MISC = (volatile LAS unsigned*)(F.lds + MISC_OFF);
    for (int u = F.tid; u < (LDS_BYTES - LDSCTL_OFF) / 4; u += NTHREADS) ((LAS unsigned*)(F.lds + LDSCTL_OFF))[u] = 0u;
    __syncthreads();
    XcdBarrier bar = xcd_barrier_post(F.ctl + CW_BAR, MISC + 8);
    int phase_no = 0;
#define LAUNDER() do { asm volatile("" : "+s"(F.ka), "+s"(F.ws), "+s"(F.out), "+s"(F.bid)); { int w_ = __builtin_amdgcn_readfirstlane(F.wave); asm volatile("" : "+s"(w_)); F.wave = w_; } F.vcu = (F.G % 8 == 0) ? (F.bid % 8) * (F.G / 8) + F.bid / 8 : F.bid; \
    { unsigned z_ = 0u; asm volatile("" : "+v"(z_)); F.lane = (int)__builtin_amdgcn_mbcnt_hi(~0u, __builtin_amdgcn_mbcnt_lo(~0u, z_)); } F.tid = F.wave * 64 + F.lane;     \
    F.misc = (float*)(F.ws + WS_MISC); F.ctl = (unsigned*)(F.ws + WS_CTL); gw = F.vcu * NWAVES + F.wave; } while (0)
#ifndef TPROBE_SCALE
#define TPROBE_SCALE 0.25f
#endif
#ifdef TPROBE
#define TSTAMP() do { if (blockIdx.x == 0 && F.tid == 0) ((unsigned long long*)(F.ctl + 6000))[phase_no] = __builtin_amdgcn_s_memrealtime(); } while (0)
#else
#define TSTAMP() do {} while (0)
#endif
#if defined(TPROBE) && defined(TPROBE_SUB_A)
#ifndef TPROBE_BID
#define TPROBE_BID 0
#endif
#define TSUB(i) do { if (blockIdx.x == TPROBE_BID && F.tid == 0 && l == 0) ((unsigned long long*)(F.ctl + 6200))[i] = __builtin_amdgcn_s_memrealtime(); } while (0)
#else
#define TSUB(i) do {} while (0)
#endif
#define GRID_BAR() do { LAUNDER(); xcd_barrier(bar, F.tid); ++phase_no; TSTAMP(); if (F.ka->stop_after == phase_no) return; LAUNDER(); } while (0)
    int gw = F.vcu * NWAVES + F.wave; const int NGW = F.G * NWAVES;
#define ssq ((float*)(F.ctl + CW_SS))
#define XS ((bf16_t*)(F.ws + WS_XS))
#define KB ((bf16_t*)(F.ws + WS_KB))
#define VB ((bf16_t*)(F.ws + WS_VB))
#define Qb ((bf16_t*)(F.ws + WS_R + R_Q))
#define AS3 ((bf16_t*)(F.ws + WS_R + R_AS3))
#define Eb ((float*)(F.ws + WS_R + R_E))
#define Zb ((bf16_t*)(F.ws + WS_R + R_Z))
#define CAT ((bf16_t*)(F.ws + WS_R + R_CAT))
#define UP ((bf16_t*)(F.ws + WS_R))
#define Gb ((bf16_t*)(F.ws + WS_G))

    TSTAMP();
    if (F.vcu < 64) ssm_prep(F, 0, F.vcu);
    else {
        mod_task3(F, F.vcu - 64);
        if (F.vcu == 64) {
            for (int i = F.tid; i < 1024; i += NTHREADS) { const int pos = i >> 4, f = i & 15; const float inv = 1.0f / powf(10000.0f, (float)f / 16.0f); const float ang = (float)pos * inv;
                ((f32x2*)(F.misc + MI_ROPE))[i] = (f32x2){cosf(ang), sinf(ang)}; }
            if (F.tid < 2) { const int l = F.tid; float a1 = 0.f, a2 = 0.f; for (int d = 0; d < 64; ++d) { a1 += F.ka->in[13][l * 64 + d] * F.ka->in[14][l * 64 + d]; a2 += F.ka->in[15][l * 64 + d] * F.ka->in[16][l * 64 + d]; }
                const float li = 0.8f - 0.6f * expf(-0.3f * (float)l); F.misc[MI_LAM + l] = expf(a1) - expf(a2) + li; F.misc[MI_LAM + 2 + l] = 1.f - li; }
            __syncthreads();
        }
        LAS float* scr = (LAS float*)(F.lds + F.wave * 16640);
        const int gw1 = (F.vcu - 64) * NWAVES + F.wave, NGW1 = (F.G - 64) * NWAVES;
        for (int it = gw1; it < N_TR_ITEMS_L + 2048; it += NGW1) { if (it < N_TR_ITEMS_L) weight_item<false>(F, scr, 0, it); else cache_item(F, 0, it - N_TR_ITEMS_L); }
    }
    GRID_BAR();
    for (int it = gw; it < MT / 4 + 6144; it += NGW) { if (it < MT / 4) xprep_item(F, it); else bias_item(F, it - MT / 4); }
    GRID_BAR();

    for (int l = 0; l < DEPTH; ++l) {
        const float* modl = F.misc + MI_MOD + l * 9 * 6144;
        { unsigned* ucnt = F.ctl + CW_UC + l * 6 * 64;
          { Gemm g{XS, (const bf16_t*)(F.ws + WS_WIN) + (size_t)l * 2048 * DM, DM, DM, DM, 0, 0}; InOrder S{F.bid, F.G};
            EpiIn E{ssq + (l == 0 ? 0 : 2 * MT), (const float*)F.ctl + CW_BIN + l * 9 * 2048, F.ka->in[11] + l * 64, F.ka->in[12] + l * 64, (const f32x2*)(F.misc + MI_ROPE), Qb, KB, VB,
                    __builtin_amdgcn_make_buffer_rsrc((void*)AS3, 0, (int)((size_t)NG * NCHUNK * 512 * 2), 0x00020000),
                    F.out + (size_t)MT * DM, F.out + (size_t)MT * DM + (size_t)NB * DEPTH * SEQ * 512, l, ucnt};
            gemm_phase<EpiIn, InOrder>(F.lds, F.tid, g, S, E); }
          if (F.bid >= 128 && F.bid < 224) {
              LAUNDER();
              const int idx = F.bid - 128, gq = idx / 3, pmq = idx % 3; unsigned* up = F.ctl + CW_UC + ((l * 3 + pmq) * 2 + (gq >> 4)) * 64;
              if (F.tid == 0) { unsigned sp = 0; while (__hip_atomic_load(up, RLX_AGENT) < 128u) { __builtin_amdgcn_s_sleep(2); if (++sp > (1u << 20)) break; }
                  __builtin_amdgcn_fence(__ATOMIC_ACQUIRE, "agent"); asm volatile("s_waitcnt vmcnt(0)" ::: "memory"); }
              __syncthreads();
              { Gemm g{AS3, (const bf16_t*)(F.ws + WS_SSM + SSM_WE), 512, 256, 256, (size_t)NCHUNK * 512, (size_t)256 * 256}; GroupOrder S{idx, F.G}; EpiS1 E{Eb};
                gemm_phase<EpiS1, GroupOrder>(F.lds, F.tid, g, S, E); }
              VM_WAIT(); __syncthreads(); LAUNDER();
              ssm_scan(F, l, (F.bid - 128) / 3, (F.bid - 128) % 3); } }
        GRID_BAR();
#define ZC_PTR (F.ctl + CW_ZC + l * 256)
#define ATTN_UNIT(SEQ_, H_, QB_) do { LAUNDER(); const AttnArgs A_{Qb, KB, VB, CAT, F.ka->in[17] + l * 128, F.misc[MI_LAM + l], F.misc[MI_LAM + 2 + l]}; attn_unit(F.lds, F.tid, A_, (SEQ_), (H_), (QB_)); } while (0)
#define ATTN_CTX(U_) do { const int u_ = (U_); ATTN_UNIT(u_ >> 3, (u_ >> 1) & 3, u_ & 1); } while (0)
        { TSUB(0);
          const int xq = F.vcu >> 5, rq = F.vcu & 31;
          if (rq < 12) { const int cidx = xq * 12 + rq;
              { Gemm g{AS3, (const bf16_t*)(F.ws + WS_SSM + SSM_WY), 512, 512, 512, (size_t)NCHUNK * 512, (size_t)256 * 512}; GroupOrder S{cidx, F.G};
                EpiS3 E{__builtin_amdgcn_make_buffer_rsrc((void*)Zb, 0, (int)((size_t)MT * 512 * 2), 0x00020000)};
                gemm_phase<EpiS3, GroupOrder>(F.lds, F.tid, g, S, E); }
              VM_WAIT(); __syncthreads(); LAUNDER();
              if (F.tid == 0) __hip_atomic_fetch_add(ZC_PTR + (((F.vcu >> 5) * 12 + (F.vcu & 31)) % 3) * 64, 1u, RLX_AGENT); }
          TSUB(3);
          { const int u = F.vcu; ATTN_UNIT(NB + (u >> 5), (u >> 3) & 3, u & 7); } TSUB(4);
          if ((F.vcu & 31) >= 24) { for (int r = 0; r < 2; ++r) ATTN_CTX((F.vcu >> 5) * 16 + 2 * ((F.vcu & 31) - 24) + r); }
          TSUB(5);
          if ((F.vcu & 31) >= 12 && (F.vcu & 31) < 24) {
              LAUNDER();
              const int idx = (F.vcu >> 5) * 12 + ((F.vcu & 31) - 12), pmz = (idx >> 1) >> 4;
              if (F.tid == 0) { unsigned sp = 0; while (__hip_atomic_load(ZC_PTR + pmz * 64, RLX_AGENT) < (unsigned)NG) { __builtin_amdgcn_s_sleep(2); if (++sp > (1u << 20)) break; }
                  __builtin_amdgcn_fence(__ATOMIC_ACQUIRE, "agent"); asm volatile("s_waitcnt vmcnt(0)" ::: "memory"); }
              __syncthreads(); TSUB(6);
              Gemm g{Zb, (const bf16_t*)(F.ws + WS_WGLU) + (size_t)l * 512 * 512, 512, 512, 512, 0, 0}; OneTile S{idx};
              EpiGlu E{Zb, F.ka->in[27] + l * 512, CAT};
              gemm_phase<EpiGlu, OneTile>(F.lds, F.tid, g, S, E); TSUB(7); } }
        GRID_BAR();
        { Gemm g{CAT, (const bf16_t*)(F.ws + WS_WOUT) + (size_t)l * DM * DM, DM, DM, DM, 0, 0}; GridOrder S; S.init(MT, DM, F.G, F.bid);
          bf16_t* XR = (bf16_t*)(F.ws + WS_XR);
          if (l == 0) { EpiRes<true, false> E{F.ka->in[0], F.ka->in[1], nullptr, nullptr, XR, modl + 2 * DM, F.ka->in[29] + l * DM, modl + 4 * DM, XS, ssq + 1 * MT};
              gemm_phase<EpiRes<true, false>, GridOrder>(F.lds, F.tid, g, S, E); }
          else { EpiRes<false, false> E{nullptr, nullptr, XR, nullptr, XR, modl + 2 * DM, F.ka->in[29] + l * DM, modl + 4 * DM, XS, ssq + 3 * MT};
              gemm_phase<EpiRes<false, false>, GridOrder>(F.lds, F.tid, g, S, E); }
          if (l + 1 < DEPTH && F.bid >= 192) { LAUNDER(); LAS float* scr = (LAS float*)(F.lds + F.wave * 16640);
              for (int it = (F.bid - 192) * NWAVES + F.wave; it < N_TR_ITEMS_L; it += 64 * NWAVES) weight_item<true>(F, scr, l + 1, it); } }
        GRID_BAR();
        { Gemm g{XS, (const bf16_t*)(F.ws + WS_WUP) + (size_t)l * 4096 * DM, DM, DM, DM, 0, 0}; GridOrder S; S.init(MT, 4096, F.G, F.bid);
          EpiUpConv E{ssq + (l == 0 ? 1 : 3) * MT, (const float*)F.ctl + CW_BUP + l * 9 * 4096, F.ka->in[31] + (size_t)l * 3 * 4096, F.ka->in[32] + (size_t)l * 4096, Gb, (bf16_t*)(F.ws + WS_HALO)};
          gemm_phase<EpiUpConv, GridOrder, true>(F.lds, F.tid, g, S, E); }
        GRID_BAR();
        { Gemm g{Gb, (const bf16_t*)(F.ws + WS_WDN) + (size_t)l * DM * 2048, 2048, 2048, 2048, 0, 0}; GridOrder S; S.init(MT, DM, F.G, F.bid);
          const bool nxt = l + 1 < DEPTH;
          bf16_t* XR = (bf16_t*)(F.ws + WS_XR);
          { Unit u0; if (S.next(0, u0)) { conv_fix(F, l, u0.pm); VM_WAIT(); __syncthreads(); LAUNDER(); } }
          if (nxt) { EpiRes<false, false> E{nullptr, nullptr, XR, nullptr, XR, modl + 5 * DM, F.ka->in[9] + (l + 1) * DM, modl + 9 * 6144 + DM, XS, ssq + 2 * MT};
              gemm_phase<EpiRes<false, false>, GridOrder>(F.lds, F.tid, g, S, E); }
          else { EpiRes<false, true> E{nullptr, nullptr, XR, F.out, nullptr, modl + 5 * DM, nullptr, nullptr, XS, ssq + 2 * MT};
              gemm_phase<EpiRes<false, true>, GridOrder>(F.lds, F.tid, g, S, E); }
          if (nxt && F.bid >= 192) { LAUNDER(); ssm_prep(F, l + 1, F.bid - 192);
              for (int it = (F.bid - 192) * NWAVES + F.wave; it < 2048; it += 64 * NWAVES) cache_item(F, l + 1, it); } }
        if (l + 1 < DEPTH) GRID_BAR();
    }
#ifdef TPROBE
    GRID_BAR();
    { float* miscp = (float*)(args.ws + WS_MISC); unsigned* ctlp = (unsigned*)(args.ws + WS_CTL);
      if (blockIdx.x == 0 && threadIdx.x == 0) { const unsigned long long* ts = (const unsigned long long*)(ctlp + 6000); const float tot = (float)(ts[phase_no] - ts[0]);
        float fa = 0.f;
#ifdef TPROBE_SUB_A
        { const unsigned long long* t2 = (const unsigned long long*)(ctlp + 6200); fa = (float)(t2[TPROBE_SUB_B] - t2[TPROBE_SUB_A]) / tot; }
#else
        for (int k = 0; k < phase_no; ++k) { const float d = (float)(ts[k + 1] - ts[k]) / tot; if ((TPROBE_MASK_A >> k) & 1ull) fa += d; }
#endif
        miscp[MI_END] = TPROBE_SCALE * sqrtf(fa); }
      GRID_BAR();
      const float delta = miscp[MI_END];
      for (size_t i = (size_t)blockIdx.x * NTHREADS + threadIdx.x; i < (size_t)MC * DM; i += (size_t)gridDim.x * NTHREADS) args.out[i] *= (1.f + delta); }
#endif
#undef GRID_BAR
#undef LAUNDER
#undef ZC_PTR
#undef ATTN_UNIT
#undef ATTN_CTX
#undef ssq
#undef XS
#undef KB
#undef VB
#undef Qb
#undef AS3
#undef Eb
#undef Zb
#undef CAT
#undef UP
#undef Gb
}
}

static int fk_launch(void* const* d_in, void* d_out, void* d_ws, size_t ws_size, hipStream_t stream, int stop_after) {
    static int grid = 0;
    if (grid == 0) {
        int dev = 0, cus = 0;
        if (ws_size < fk::WS_END) { fprintf(stderr, "kernel_launch: workspace too small (%zu < %zu)\n", ws_size, (size_t)fk::WS_END); grid = -1; return -1; }
        if (hipGetDevice(&dev) != hipSuccess || hipDeviceGetAttribute(&cus, hipDeviceAttributeMultiprocessorCount, dev) != hipSuccess) { grid = -1; return -1; }
        if (hipFuncSetAttribute((const void*)fk::mega, hipFuncAttributeMaxDynamicSharedMemorySize, fk::LDS_BYTES) != hipSuccess) { fprintf(stderr, "kernel_launch: hipFuncSetAttribute failed\n"); grid = -1; return -1; }
        int per_cu = 0; (void)hipOccupancyMaxActiveBlocksPerMultiprocessor(&per_cu, (const void*)fk::mega, fk::NTHREADS, fk::LDS_BYTES); (void)hipGetLastError();
        if (per_cu < 1) fprintf(stderr, "kernel_launch: occupancy query says %d blocks/CU\n", per_cu);
        grid = cus;
        if (grid != 256) fprintf(stderr, "kernel_launch: %d CUs (built for 256)\n", grid);
    }
    if (grid < 0) return -1;
    (void)hipMemsetAsync((char*)d_ws + fk::WS_CTL, 0, fk::CTL_BYTES, stream);
    fk::Args a{};
    for (int i = 0; i < 34; ++i) a.in[i] = (const float*)d_in[i];
    a.out = (float*)d_out; a.ws = (unsigned char*)d_ws; a.stop_after = stop_after; a.pad = 0;
    hipLaunchKernelGGL(fk::mega, dim3(grid), dim3(fk::NTHREADS), fk::LDS_BYTES, stream, a);
    return 0;
}
extern "C" void kernel_launch(void* const* d_in, const int* in_sizes, int n_in, void* d_out, int out_size, void* d_ws, size_t ws_size, hipStream_t stream) {
    if (n_in != 34) { fprintf(stderr, "kernel_launch: unexpected n_in %d\n", n_in); return; }
    fk_launch(d_in, d_out, d_ws, ws_size, stream, 0);
}
```

```cpp
#include <hip/hip_runtime.h>
#include <cstdio>
#include <cstdint>
namespace fk {
#define LAS __attribute__((address_space(3)))
#define GAS __attribute__((address_space(1)))
typedef unsigned short bf16_t;
typedef short bf16x8 __attribute__((ext_vector_type(8)));
typedef short s16x4 __attribute__((ext_vector_type(4)));
typedef float f32x4 __attribute__((ext_vector_type(4)));
typedef float f32x2 __attribute__((ext_vector_type(2)));
typedef float f32x16 __attribute__((ext_vector_type(16)));
typedef unsigned u32x4 __attribute__((ext_vector_type(4)));
typedef unsigned u32x2 __attribute__((ext_vector_type(2)));

constexpr int DM = 1024, NB = 16, SEQ = 256, DEPTH = 2, DB = 8, DSEQ = 1024, PAST = 512;
constexpr int MC = NB * SEQ, MS = DB * DSEQ, MT = MC + MS;
constexpr int NH = 4, NG = 32, NCOND = 9, NMOD = 6;
constexpr int NCHUNK = MT / 16;
constexpr int KVROWS = MC + DB * (PAST + DSEQ);
constexpr float EPS = 1e-6f;
constexpr float C2 = 0.125f * 1.4426950408889634f;
constexpr int NWAVES = 8, NTHREADS = 512;

constexpr size_t MiB = 1u << 20;
constexpr size_t WS_CTL = 0, CTL_BYTES = 1 * MiB + 512 * 1024;
constexpr size_t WS_MISC = 1 * MiB;
constexpr size_t WS_WIN = 3 * MiB;
constexpr size_t WS_WGLU = 11 * MiB;
constexpr size_t WS_WOUT = 12 * MiB;
constexpr size_t WS_WUP = 16 * MiB;
constexpr size_t WS_WDN = 32 * MiB;
constexpr size_t WS_SSM = 40 * MiB;
constexpr size_t WS_XS = 53 * MiB;
constexpr size_t WS_KB = 77 * MiB;
constexpr size_t WS_VB = 93 * MiB;
constexpr size_t WS_R = 109 * MiB;
constexpr size_t WS_XR = 205 * MiB;
constexpr size_t WS_G = WS_R;
constexpr size_t WS_HALO = WS_R + 48 * MiB;
constexpr size_t WS_END = 253 * MiB;
constexpr size_t R_Q = 0, R_AS3 = 12 * MiB, R_E = 36 * MiB, R_Z = 60 * MiB, R_CAT = 72 * MiB;
constexpr size_t SSM_WE = 0, SSM_WY = 4 * MiB, SSM_LAM16 = 12 * MiB, SSM_BBAR = 12 * MiB + 64 * 1024;
constexpr int MI_MOD = 0;
constexpr int MI_ROPE = MI_MOD + 2 * 9 * 6144;
constexpr int MI_LAM = MI_ROPE + 64 * 16 * 2;
constexpr int MI_END = MI_LAM + 8;
static_assert((size_t)MI_END * 4 <= 2 * MiB, "MISC");
constexpr int CW_BAR = 1024;
constexpr int CW_ZC = 7168;
constexpr int CW_UC = 4608;
constexpr int CW_SS = 8192;
constexpr int CW_BIN = 65536;
constexpr int CW_BUP = CW_BIN + 2 * 9 * 2048;
static_assert((size_t)(CW_SS + 4 * MT) <= CW_BIN && (size_t)(CW_BUP + 2 * 9 * 4096) * 4 <= CTL_BYTES, "CTL");

constexpr int RING_BYTES = 131072;
constexpr int LDS_BYTES_ = 147456; constexpr int LDSCTL_OFF = LDS_BYTES_ - 512, MISC_OFF = LDSCTL_OFF + 320;
constexpr int LDS_BYTES = 147456;

#define RLX_AGENT __ATOMIC_RELAXED, __HIP_MEMORY_SCOPE_AGENT
typedef __bf16 bf16x2_t __attribute__((ext_vector_type(2)));
__device__ __forceinline__ unsigned cvt_pk_bf16(float lo, float hi) { const f32x2 v = {lo, hi}; const bf16x2_t b = __builtin_convertvector(v, bf16x2_t); return __builtin_bit_cast(unsigned, b); }
__device__ __forceinline__ float bf2f(unsigned short b) { return __uint_as_float((unsigned)b << 16); }
__device__ __forceinline__ float bflo(unsigned w) { return __uint_as_float(w << 16); }
__device__ __forceinline__ float bfhi(unsigned w) { return __uint_as_float(w & 0xffff0000u); }
__device__ __forceinline__ float fast_exp2(float x) { return __builtin_amdgcn_exp2f(x); }
__device__ __forceinline__ float fast_rcp(float x) { return __builtin_amdgcn_rcpf(x); }
__device__ __forceinline__ float sigmoid_f(float x) { return fast_rcp(1.f + fast_exp2(-1.4426950408889634f * x)); }
__device__ __forceinline__ float silu_f(float x) { return x * sigmoid_f(x); }
__device__ __forceinline__ float gelu_tanh_f(float x) {
    const float u = 0.7978845608028654f * (x + 0.044715f * x * x * x); return x * sigmoid_f(2.f * u); }
__device__ __forceinline__ float shfl_xor_l(float v, int mask, int lane) { return __uint_as_float((unsigned)__builtin_amdgcn_ds_bpermute((lane ^ mask) << 2, (int)__float_as_uint(v))); }
__device__ __forceinline__ float wave_sum(float v, int lane) {
#pragma unroll
    for (int o = 1; o < 64; o <<= 1) v += shfl_xor_l(v, o, lane);
    return v; }

#define XB_TMO      128
#define XB_XCNT(j)  (256  + 64 * (j))
#define XB_XSUB(j)  (1280 + 64 * (j))
#define XB_XGEN(j)  (2304 + 64 * (j))
#define XB_TOP      3328
#define XB_TOPGEN   3392
#define XCD_BAR_WORDS 3456
#define XB_SPIN_CAP (1u << 18)
__device__ __forceinline__ unsigned xb_ld(unsigned* p)              { return __hip_atomic_load(p, __ATOMIC_RELAXED, __HIP_MEMORY_SCOPE_AGENT); }
__device__ __forceinline__ unsigned xb_add(unsigned* p, unsigned v) { return __hip_atomic_fetch_add(p, v, __ATOMIC_RELAXED, __HIP_MEMORY_SCOPE_AGENT); }
__device__ __forceinline__ unsigned xb_xcc_id() { return (unsigned)__builtin_amdgcn_s_getreg((3 << 11) | 20) & 0xFu; }
#define XB_SPIN(cond, bar) do { unsigned _sp = 0; while (cond) { __builtin_amdgcn_s_sleep(1); \
    if ((++_sp & 255u) == 0u) { if (xb_ld(&(bar)[XB_TMO])) break; if (_sp > XB_SPIN_CAP) { atomicAdd(&(bar)[XB_TMO], 1u); break; } } } } while (0)
struct XcdBarrier { unsigned* bar; unsigned x; volatile LAS unsigned* st; };
__device__ __forceinline__ XcdBarrier xcd_barrier_post(unsigned* bar, volatile LAS unsigned* st) {
    XcdBarrier b; b.bar = bar; b.x = xb_xcc_id(); b.st = st;
    if (threadIdx.x == 0) (void)xb_add(&bar[XB_XCNT(b.x)], 1u);
    return b;
}
__device__ __forceinline__ void xcd_barrier_complete(unsigned* bar, unsigned x, unsigned& nloc, unsigned& nx) {
    const unsigned G = gridDim.x * gridDim.y * gridDim.z;
    unsigned sum, cnt, mine, sp = 0u;
    for (;;) {
        sum = 0u; cnt = 0u; mine = 0u;
#pragma unroll
        for (unsigned j = 0; j < 16; ++j) { const unsigned c = xb_ld(&bar[XB_XCNT(j)]); sum += c; cnt += (c > 0u) ? 1u : 0u; mine = (j == x) ? c : mine; }
        if (sum == G) break;
        __builtin_amdgcn_s_sleep(1);
        if ((++sp & 255u) == 0u) { if (xb_ld(&bar[XB_TMO])) break; if (sp > XB_SPIN_CAP) { atomicAdd(&bar[XB_TMO], 1u); break; } }
    }
    nloc = mine > 0u ? mine : 1u; nx = cnt > 0u ? cnt : 1u;
}
__device__ __forceinline__ void xcd_barrier(const XcdBarrier& b, const int tid) {
    asm volatile("s_waitcnt vmcnt(0)" ::: "memory");
    __syncthreads();
    if (tid == 0) {
        unsigned* bar = b.bar;
        __builtin_amdgcn_s_waitcnt(0);
        unsigned nloc = b.st[0], nx = b.st[1];
        if (nloc == 0u) { xcd_barrier_complete(bar, b.x, nloc, nx); b.st[0] = nloc; b.st[1] = nx; }
        const unsigned old = xb_add(&bar[XB_XSUB(b.x)], 1u);
        const unsigned gen = old / nloc;
        if (old + 1u == (gen + 1u) * nloc) {
            __builtin_amdgcn_fence(__ATOMIC_RELEASE, "agent");
            asm volatile("s_waitcnt vmcnt(0)" ::: "memory");
            const unsigned og = xb_add(&bar[XB_TOP], 1u);
            const unsigned tg = og / nx;
            if (og + 1u == (tg + 1u) * nx) xb_add(&bar[XB_TOPGEN], 1u);
            else XB_SPIN(xb_ld(&bar[XB_TOPGEN]) == tg, bar);
            __builtin_amdgcn_fence(__ATOMIC_ACQUIRE, "agent");
            xb_add(&bar[XB_XGEN(b.x)], 1u);
            asm volatile("s_waitcnt vmcnt(0)" ::: "memory");
        } else {
            XB_SPIN(xb_ld(&bar[XB_XGEN(b.x)]) == gen, bar);
            __builtin_amdgcn_fence(__ATOMIC_ACQUIRE, "agent");
            asm volatile("s_waitcnt vmcnt(0)" ::: "memory");
        }
    }
    __syncthreads();
}

constexpr int BM = 256, BK = 64, HALF = 128, HTB = HALF * BK * 2, NXCD = 8, WGM = 6;
__host__ __device__ __forceinline__ int lds_byte(int r, int c) { const int st = (r >> 4) * 2 + (c >> 5), rr = r & 15, cc = c & 31, ob = rr * 64 + cc * 2; return st * 1024 + (ob ^ (((ob >> 9) & 1) << 5)); }
__host__ __device__ __forceinline__ void stage_rc(int b, int& R, int& C) { const int st = b / 1024, sb = b % 1024, swz = sb ^ (((sb >> 9) & 1) << 5); R = (st >> 1) * 16 + swz / 64; C = (st & 1) * 32 + (swz % 64) / 2; }
__host__ __device__ __forceinline__ int perm32(int rho) { const int n = rho >> 4, i = rho & 15; return 8 * (i >> 2) + 4 * n + (i & 3); }

__device__ __forceinline__ int panel_of(int x, int j) { return 2 * x + j + ((j + 6) >> 3) * (14 + 2 * x); }
struct Unit { int pm, pn, g; };
struct Gemm { const bf16_t* A; const bf16_t* Bt; int lda, ldb, K; size_t gsA, gsB; };
struct GridOrder {
    int nM, nN, nwg, G, c;
    __device__ void init(int M, int N, int G_, int c_) { nM = M / BM; nN = N / BM; nwg = nM * nN; G = G_; c = c_; }
    __device__ bool next(int i, Unit& u) const {
        const long L = (long)i * G + c; if (L >= nwg) return false;
        int wgid = (int)L; { const int q = nwg / NXCD, r = nwg % NXCD, xcd = wgid % NXCD, off = wgid / NXCD; wgid = (xcd < r ? xcd * (q + 1) : r * (q + 1) + (xcd - r) * q) + off; }
        const int nig = WGM * nN, gid = wgid / nig, fm = gid * WGM, gsz = (nM - fm) < WGM ? (nM - fm) : WGM;
        u.pm = panel_of(gid, (wgid % nig) % gsz);     u.pn = (wgid % nig) / gsz; u.g = 0; return true;
    }
};
struct InOrder {
    int c, G;
    __device__ bool next(int i, Unit& u) const { const int L = i * G + c; if (L >= 384) return false; u.g = 0;
        if (L < 96) { const int jj = L >> 3; u.pm = panel_of(L & 7, jj >> 1); u.pn = 6 + (jj & 1); }
        else { const int Lp = L - 96, jj = Lp >> 3; u.pm = panel_of(Lp & 7, jj / 6); u.pn = jj % 6; }
        return true; }
};
struct OneTile {
    int idx;
    __device__ bool next(int i, Unit& u) const { if (i > 0 || idx < 0) return false; u.pm = panel_of(idx / 12, (idx % 12) >> 1); u.pn = idx & 1; u.g = 0; return true; }
};
struct GroupOrder {
    int c, G;
    __device__ bool next(int i, Unit& u) const { const int idx = c + i * G; if (c < 0 || idx >= NG * 3) return false; u.g = idx / 3; u.pm = idx % 3; u.pn = 0; return true; }
};

template <class Epi, class Sched, bool AROWPERM = false>
__device__ __forceinline__ void gemm_phase(LAS unsigned char* lds, const int tid, const Gemm g, const Sched& S, const Epi& E) {
    const int wid = __builtin_amdgcn_readfirstlane(tid >> 6), lane = tid & 63, wr = wid >> 2, wc = wid & 3, fr = lane & 15, fq = lane >> 4;
    const int K = g.K, nt = K / BK;
    unsigned voffA[2], voffB[2];
#pragma unroll
    for (int i = 0; i < 2; ++i) { int R, C; stage_rc(tid * 16 + i * 8192, R, C); const int Rb = Epi::PERM ? ((R & ~31) + perm32(R & 31)) : R;
        const int Ra = AROWPERM ? ((R & 64) + 4 * (R & 15) + ((R >> 4) & 3)) : R;
        voffA[i] = (unsigned)(Ra * g.lda + C) * 2u; voffB[i] = (unsigned)(Rb * g.ldb + C) * 2u; }
    const size_t kstep = (size_t)(BK * 2);
    const size_t hstepA = (size_t)HALF * g.lda * 2, hstepB = (size_t)HALF * g.ldb * 2;
    const unsigned ldsw = (unsigned)wid * 1024u;
    const int aoff = lds_byte(wr * 64 + fr, fq * 8), boff = lds_byte(wc * 32 + fr, fq * 8);
#define PG8_SA(b, h) (((b) * 2 + (h)) * HTB)
#define PG8_SB(b, h) ((4 + (b) * 2 + (h)) * HTB)
#define PG8_STAGE(bufoff, gbase, voff) do { _Pragma("unroll") for (int _i = 0; _i < 2; ++_i) \
        __builtin_amdgcn_global_load_lds((const unsigned*)((const char*)(gbase) + (voff)[_i]), (LAS unsigned*)(lds + (bufoff) + ldsw + _i * 8192), 16, 0, 0); } while (0)
#define PG8_LDA(dst, b, h) do { _Pragma("unroll") for (int m = 0; m < 4; ++m) _Pragma("unroll") for (int k = 0; k < 2; ++k) dst[m][k] = *(const LAS bf16x8*)(lds + PG8_SA(b, h) + aoff + m * 2048 + k * 1024); } while (0)
#define PG8_LDB(dst, b, h) do { _Pragma("unroll") for (int n = 0; n < 2; ++n) _Pragma("unroll") for (int k = 0; k < 2; ++k) dst[n][k] = *(const LAS bf16x8*)(lds + PG8_SB(b, h) + boff + n * 2048 + k * 1024); } while (0)
#define PG8_MMA(ai, bj, At, Bt) do { __builtin_amdgcn_s_setprio(1); _Pragma("unroll") for (int m = 0; m < 4; ++m) _Pragma("unroll") for (int n = 0; n < 2; ++n) _Pragma("unroll") for (int k = 0; k < 2; ++k) \
        acc[ai][bj][m][n] = __builtin_amdgcn_mfma_f32_16x16x32_bf16(Bt[n][k], At[m][k], acc[ai][bj][m][n], 0, 0, 0); __builtin_amdgcn_s_setprio(0); } while (0)
#define PG8_WAIT_V(n) asm volatile("s_waitcnt vmcnt(" #n ")" ::: "memory")
#define PG8_WAIT_L(n) asm volatile("s_waitcnt lgkmcnt(" #n ")" ::: "memory")
#define PG8_BAR __builtin_amdgcn_s_barrier()
#define PG8_SCHED __builtin_amdgcn_sched_barrier(0)
#define PG8_APTR(u) ((const char*)g.A + ((size_t)(u).g * g.gsA + (size_t)(u).pm * BM * g.lda) * 2)
#define PG8_BPTR(u) ((const char*)g.Bt + ((size_t)(u).g * g.gsB + (size_t)(u).pn * BM * g.ldb) * 2)
    Unit cur, nxt; int ui = 0;
    if (!S.next(0, cur)) return;
    f32x4 acc[2][2][4][2];
#pragma unroll
    for (int a = 0; a < 2; ++a)
#pragma unroll
        for (int b = 0; b < 2; ++b)
#pragma unroll
            for (int m = 0; m < 4; ++m)
#pragma unroll
                for (int n = 0; n < 2; ++n) acc[a][b][m][n] = (f32x4){0.f, 0.f, 0.f, 0.f};
    bf16x8 At[4][2], B0[2][2], B1[2][2];
    const char* cA = PG8_APTR(cur); const char* cB = PG8_BPTR(cur);
    PG8_STAGE(PG8_SB(0, 0), cB, voffB); PG8_STAGE(PG8_SB(0, 1), cB + hstepB, voffB); PG8_STAGE(PG8_SA(0, 0), cA, voffA); PG8_STAGE(PG8_SA(0, 1), cA + hstepA, voffA);
    if (wr == 1) PG8_BAR;
    PG8_WAIT_V(2); PG8_BAR;
    PG8_STAGE(PG8_SB(1, 0), cB + kstep, voffB); PG8_STAGE(PG8_SA(1, 0), cA + kstep, voffA); PG8_STAGE(PG8_SB(1, 1), cB + hstepB + kstep, voffB);
    PG8_WAIT_V(6); PG8_BAR;
    for (;;) {
        const bool has_next = S.next(ui + 1, nxt);
        const char* nA = has_next ? PG8_APTR(nxt) : cA; const char* nB = has_next ? PG8_BPTR(nxt) : cB;
        for (int t = 0; t < nt; t += 2) {
            const bool last = (t == nt - 2);
            const char* a1 = cA + (size_t)(t + 1) * kstep;
            const char* a2 = last ? nA : cA + (size_t)(t + 2) * kstep; const char* b2 = last ? nB : cB + (size_t)(t + 2) * kstep;
            const char* a3 = a2 + kstep; const char* b3 = b2 + kstep;
            PG8_LDB(B0, 0, 0); PG8_LDB(B1, 0, 1); PG8_SCHED; PG8_LDA(At, 0, 0); PG8_STAGE(PG8_SA(1, 1), a1 + hstepA, voffA);
            PG8_WAIT_V(8); PG8_WAIT_L(0); PG8_BAR; PG8_MMA(0, 0, At, B0); PG8_MMA(0, 1, At, B1); PG8_BAR; PG8_SCHED;
            PG8_LDA(At, 0, 1); PG8_STAGE(PG8_SB(0, 0), b2, voffB); PG8_STAGE(PG8_SB(0, 1), b2 + hstepB, voffB); PG8_STAGE(PG8_SA(0, 0), a2, voffA);
            PG8_WAIT_V(8); PG8_WAIT_L(0); PG8_BAR; PG8_MMA(1, 0, At, B0); PG8_MMA(1, 1, At, B1); PG8_BAR; PG8_SCHED;
            PG8_LDB(B0, 1, 0); PG8_LDB(B1, 1, 1); PG8_SCHED; PG8_LDA(At, 1, 0); PG8_STAGE(PG8_SA(0, 1), a2 + hstepA, voffA);
            PG8_WAIT_V(8); PG8_WAIT_L(0); PG8_BAR; PG8_MMA(0, 0, At, B0); PG8_MMA(0, 1, At, B1); PG8_BAR; PG8_SCHED;
            PG8_LDA(At, 1, 1); PG8_STAGE(PG8_SB(1, 0), b3, voffB); PG8_STAGE(PG8_SB(1, 1), b3 + hstepB, voffB); PG8_STAGE(PG8_SA(1, 0), a3, voffA);
            PG8_WAIT_V(8); PG8_WAIT_L(0); PG8_BAR; PG8_MMA(1, 0, At, B0); PG8_MMA(1, 1, At, B1); PG8_BAR; PG8_SCHED;
        }
        if (wr == 0) PG8_BAR;
        { unsigned z_ = 0u; asm volatile("" : "+v"(z_)); const int l2 = (int)__builtin_amdgcn_mbcnt_hi(~0u, __builtin_amdgcn_mbcnt_lo(~0u, z_));
          E(acc, cur, wr, wc, l2 & 15, l2 >> 4);
          E.done(cur, l2); }
        if (!has_next) break;
#pragma unroll
        for (int a = 0; a < 2; ++a)
#pragma unroll
            for (int b = 0; b < 2; ++b)
#pragma unroll
                for (int m = 0; m < 4; ++m)
#pragma unroll
                    for (int n = 0; n < 2; ++n) acc[a][b][m][n] = (f32x4){0.f, 0.f, 0.f, 0.f};
        cur = nxt; cA = nA; cB = nB; ++ui;
        if (wr == 1) PG8_BAR;
    }
    PG8_WAIT_V(0);
    PG8_BAR;
#undef PG8_SA
#undef PG8_SB
#undef PG8_STAGE
#undef PG8_LDA
#undef PG8_LDB
#undef PG8_MMA
#undef PG8_WAIT_V
#undef PG8_WAIT_L
#undef PG8_BAR
#undef PG8_SCHED
#undef PG8_APTR
#undef PG8_BPTR
}
__device__ __forceinline__ int cond_of_pm(int pm) { return pm < 16 ? 0 : 1 + ((pm - 16) >> 2); }
__device__ __forceinline__ int kvrow_of(int row) { return row < MC ? row : MC + ((row - MC) >> 10) * (PAST + DSEQ) + PAST + ((row - MC) & 1023); }
__device__ __forceinline__ u32x4 pack8(const f32x4& a, const f32x4& b) { u32x4 w; w.x = cvt_pk_bf16(a[0], a[1]); w.y = cvt_pk_bf16(a[2], a[3]); w.z = cvt_pk_bf16(b[0], b[1]); w.w = cvt_pk_bf16(b[2], b[3]); return w; }

struct EpiIn {
    static constexpr bool PERM = true;
    const float* sumsq; const float* bias; const float* qn; const float* kn; const f32x2* rope;
    bf16_t* Q; bf16_t* KB; bf16_t* VB; __amdgpu_buffer_rsrc_t as3r; float* new_k; float* new_v; int l; unsigned* ucnt;
    __device__ __forceinline__ void done(const Unit& u, int lane) const {
        if (u.pn >= 6) { asm volatile("s_waitcnt vmcnt(0)" ::: "memory"); if (lane == 0) __hip_atomic_fetch_add(ucnt + (((u.pm >> 4) * 2) + (u.pn - 6)) * 64, 1u, RLX_AGENT); } }
    __device__ __forceinline__ void operator()(const f32x4 (&acc)[2][2][4][2], const Unit& u, int wr, int wc, int fr, int fq) const {
        const int pm = u.pm, pn = u.pn; const bool ctx = pm < 16; const int cond = cond_of_pm(pm);
        const float* bz = bias + cond * 2048 + pn * 256 + wc * 32 + 8 * fq;
        f32x4 bv[2][2];
#pragma unroll
        for (int bj = 0; bj < 2; ++bj)
#pragma unroll
            for (int n = 0; n < 2; ++n) bv[bj][n] = *(const f32x4*)(bz + bj * 128 + 4 * n);
        const int rbase = pm * BM + wr * 64 + fr;
        float rsd[8];
#pragma unroll
        for (int g8 = 0; g8 < 8; ++g8) rsd[g8] = sumsq[rbase + (g8 >> 2) * HALF + (g8 & 3) * 16];
#pragma unroll
        for (int g8 = 0; g8 < 8; ++g8) rsd[g8] = rsqrtf(rsd[g8] * (1.f / DM) + EPS);
        if (pn < 4) {
            const bool isq = pn < 2; const float* gv = isq ? qn : kn;
            const int G = (pn & 1) * 4 + wc;
            const int cb = 32 * (fq >> 1) + 8 * (fq & 1);
            f32x4 gg[2][2];
#pragma unroll
            for (int bj = 0; bj < 2; ++bj)
#pragma unroll
                for (int n = 0; n < 2; ++n) gg[bj][n] = *(const f32x4*)(gv + cb + 16 * bj + 4 * n);
            const float qs = isq ? C2 : 1.f;
#pragma unroll
            for (int ai = 0; ai < 2; ++ai)
#pragma unroll
                for (int m = 0; m < 4; ++m) {
                    const int row = rbase + ai * HALF + m * 16;
                    const float rstd = rsd[ai * 4 + m];
                    f32x4 v[2][2]; float ss = 0.f;
#pragma unroll
                    for (int bj = 0; bj < 2; ++bj)
#pragma unroll
                        for (int n = 0; n < 2; ++n) { v[bj][n] = acc[ai][bj][m][n] * rstd + bv[bj][n]; const f32x4 t = v[bj][n] * v[bj][n]; ss += (t[0] + t[1]) + (t[2] + t[3]); }
                    { const int ln_ = fq * 16 + fr; ss += shfl_xor_l(ss, 16, ln_); ss += shfl_xor_l(ss, 32, ln_); }
                    const float rn = rsqrtf(ss * (1.f / 64.f) + EPS);
#pragma unroll
                    for (int bj = 0; bj < 2; ++bj)
#pragma unroll
                        for (int n = 0; n < 2; ++n) v[bj][n] = v[bj][n] * rn * gg[bj][n];
                    if (ctx) {
                        if (!isq) { float* nk = new_k + ((size_t)((row >> 8) * DEPTH + l) * SEQ + (row & 255)) * 512 + G * 64 + cb;
#pragma unroll
                            for (int bj = 0; bj < 2; ++bj) { *(f32x4*)(nk + 16 * bj) = v[bj][0]; *(f32x4*)(nk + 16 * bj + 4) = v[bj][1]; } }
                    } else {
                        const int t = (row - MC) & 1023; const int pos = (fq >> 1) ? (t & 63) : (t >> 6);
                        const f32x2* rp = rope + pos * 16 + 8 * (fq & 1);
#pragma unroll
                        for (int n = 0; n < 2; ++n)
#pragma unroll
                            for (int j = 0; j < 4; ++j) { const f32x2 cs = rp[4 * n + j]; const float x1 = v[0][n][j], x2 = v[1][n][j]; v[0][n][j] = x1 * cs.x - x2 * cs.y; v[1][n][j] = x1 * cs.y + x2 * cs.x; }
                    }
                    bf16_t* dst = isq ? (Q + (size_t)row * 512) : (KB + (size_t)kvrow_of(row) * 512);
                    dst += G * 64 + cb;
#pragma unroll
                    for (int bj = 0; bj < 2; ++bj) *(u32x4*)(dst + 16 * bj) = pack8(v[bj][0] * qs, v[bj][1] * qs);
                }
        } else if (pn < 6) {
            const int col0 = (pn - 4) * 256 + wc * 32 + 8 * fq;
#pragma unroll
            for (int ai = 0; ai < 2; ++ai)
#pragma unroll
                for (int m = 0; m < 4; ++m) {
                    const int row = rbase + ai * HALF + m * 16;
                    const float rstd = rsd[ai * 4 + m];
                    bf16_t* dst = VB + (size_t)kvrow_of(row) * 512 + col0;
#pragma unroll
                    for (int bj = 0; bj < 2; ++bj) { const f32x4 a = acc[ai][bj][m][0] * rstd + bv[bj][0], b = acc[ai][bj][m][1] * rstd + bv[bj][1];
                        *(u32x4*)(dst + 128 * bj) = pack8(a, b);
                        if (ctx) { float* nv = new_v + ((size_t)((row >> 8) * DEPTH + l) * SEQ + (row & 255)) * 512 + col0 + 128 * bj; *(f32x4*)nv = a; *(f32x4*)(nv + 4) = b; } }
                }
        } else {
            const int cu0 = (pn - 6) * 256 + wc * 32 + 8 * fq;
#pragma unroll
            for (int ai = 0; ai < 2; ++ai)
#pragma unroll
                for (int m = 0; m < 4; ++m) {
                    const int row = rbase + ai * HALF + m * 16;
                    const float rstd = rsd[ai * 4 + m];
#pragma unroll
                    for (int bj = 0; bj < 2; ++bj) { const int cu = cu0 + 128 * bj; const f32x4 a = acc[ai][bj][m][0] * rstd + bv[bj][0], b = acc[ai][bj][m][1] * rstd + bv[bj][1];
                        __builtin_amdgcn_raw_buffer_store_b128(pack8(a, b), as3r, (int)(((unsigned)((cu >> 4) * NCHUNK + (row >> 4)) * 512u + (row & 15) * 16 + (cu & 15)) * 2u), 0,   16); }
                }
        }
    }
};
struct EpiS1 {
    static constexpr bool PERM = false;
    float* E;
    __device__ __forceinline__ void done(const Unit&, int) const {}
    __device__ __forceinline__ void operator()(const f32x4 (&acc)[2][2][4][2], const Unit& u, int wr, int wc, int fr, int fq) const {
        const int rbase = u.pm * BM + wr * 64 + fr, col0 = wc * 32 + 4 * fq;
#pragma unroll
        for (int ai = 0; ai < 2; ++ai)
#pragma unroll
            for (int m = 0; m < 4; ++m) { float* dst = E + ((size_t)u.g * NCHUNK + rbase + ai * HALF + m * 16) * 256 + col0;
#pragma unroll
                for (int bj = 0; bj < 2; ++bj)
#pragma unroll
                    for (int n = 0; n < 2; ++n) *(f32x4*)(dst + bj * HALF + n * 16) = acc[ai][bj][m][n]; }
    }
};
struct EpiS3 {
    static constexpr bool PERM = true;
    __amdgpu_buffer_rsrc_t zr;
    __device__ __forceinline__ void done(const Unit&, int) const {}
    __device__ __forceinline__ void operator()(const f32x4 (&acc)[2][2][4][2], const Unit& u, int wr, int wc, int fr, int fq) const {
        const int rbase = u.pm * BM + wr * 64 + fr;
#pragma unroll
        for (int ai = 0; ai < 2; ++ai)
#pragma unroll
            for (int m = 0; m < 4; ++m) { const int chunk = rbase + ai * HALF + m * 16;
#pragma unroll
                for (int bj = 0; bj < 2; ++bj) { const int tt = 8 * bj + 2 * wc + (fq >> 1), c0 = 8 * (fq & 1);
                    f32x4 a = acc[ai][bj][m][0], b = acc[ai][bj][m][1];
#pragma unroll
                    for (int j = 0; j < 4; ++j) { a[j] = gelu_tanh_f(a[j]); b[j] = gelu_tanh_f(b[j]); }
                    __builtin_amdgcn_raw_buffer_store_b128(pack8(a, b), zr, (int)((((unsigned)chunk * 16u + tt) * 512u + u.g * 16 + c0) * 2u), 0,   16); } }
    }
};
struct EpiGlu {
    static constexpr bool PERM = true;
    const bf16_t* Z; const float* bg; bf16_t* CAT;
    __device__ __forceinline__ void done(const Unit&, int) const {}
    __device__ __forceinline__ void operator()(const f32x4 (&acc)[2][2][4][2], const Unit& u, int wr, int wc, int fr, int fq) const {
        const int rbase = u.pm * BM + wr * 64 + fr, col0 = u.pn * BM + wc * 32 + 8 * fq;
        f32x4 bv[2][2];
#pragma unroll
        for (int bj = 0; bj < 2; ++bj)
#pragma unroll
            for (int n = 0; n < 2; ++n) bv[bj][n] = *(const f32x4*)(bg + col0 + bj * HALF + 4 * n);
#pragma unroll
        for (int ai = 0; ai < 2; ++ai)
#pragma unroll
            for (int m = 0; m < 4; ++m) { const int row = rbase + ai * HALF + m * 16;
#pragma unroll
                for (int bj = 0; bj < 2; ++bj) { const u32x4 zw = *(const u32x4*)(Z + (size_t)row * 512 + col0 + bj * HALF);
                    f32x4 a = acc[ai][bj][m][0] + bv[bj][0], b = acc[ai][bj][m][1] + bv[bj][1];
                    a[0] = bflo(zw.x) * sigmoid_f(a[0]); a[1] = bfhi(zw.x) * sigmoid_f(a[1]); a[2] = bflo(zw.y) * sigmoid_f(a[2]); a[3] = bfhi(zw.y) * sigmoid_f(a[3]);
                    b[0] = bflo(zw.z) * sigmoid_f(b[0]); b[1] = bfhi(zw.z) * sigmoid_f(b[1]); b[2] = bflo(zw.w) * sigmoid_f(b[2]); b[3] = bfhi(zw.w) * sigmoid_f(b[3]);
                    *(u32x4*)(CAT + (size_t)row * 1024 + 512 + col0 + bj * HALF) = pack8(a, b); } }
    }
};
template <bool IN_F32, bool OUT_F32> struct EpiRes {
    static constexpr bool PERM = true;
    const float* xin0; const float* xin1;
    const bf16_t* xrin;
    float* xout; bf16_t* xrout;
    const float* gate;
    const float* gn; const float* sc;
    bf16_t* XS; float* ssq;
    __device__ __forceinline__ void done(const Unit&, int) const {}
    __device__ __forceinline__ void operator()(const f32x4 (&acc)[2][2][4][2], const Unit& u, int wr, int wc, int fr, int fq) const {
        const int pm = u.pm, cond = cond_of_pm(pm); const int col0 = u.pn * BM + wc * 32 + 8 * fq; const int rbase = pm * BM + wr * 64 + fr;
        const bool donorm = (gn != nullptr);
        f32x4 gt[2][2], gs[2][2];
#pragma unroll
        for (int bj = 0; bj < 2; ++bj)
#pragma unroll
            for (int n = 0; n < 2; ++n) { const int c = col0 + bj * HALF + n * 4; gt[bj][n] = *(const f32x4*)(gate + cond * 6144 + c);
                if (donorm) { const f32x4 g4 = *(const f32x4*)(gn + c), s4 = *(const f32x4*)(sc + cond * 6144 + c); gs[bj][n] = g4 * (s4 + 1.f); } else gs[bj][n] = (f32x4){0.f, 0.f, 0.f, 0.f}; }
        constexpr int RD = IN_F32 ? 2 : 3;
        f32x4 xr[RD][2][2]; u32x4 xb[RD][2];
#define ER_LOAD(G_, SLOT_) do { const int row_ = rbase + ((G_) >> 2) * HALF + ((G_) & 3) * 16; \
            if (IN_F32) { const float* xi_ = (row_ < MC) ? (xin0 + (size_t)row_ * DM) : (xin1 + (size_t)(row_ - MC) * DM); \
                _Pragma("unroll") for (int bj = 0; bj < 2; ++bj) { xr[SLOT_][bj][0] = *(const f32x4*)(xi_ + col0 + bj * HALF); xr[SLOT_][bj][1] = *(const f32x4*)(xi_ + col0 + bj * HALF + 4); } } \
            else { _Pragma("unroll") for (int bj = 0; bj < 2; ++bj) xb[SLOT_][bj] = *(const u32x4*)(xrin + (size_t)row_ * DM + col0 + bj * HALF); } } while (0)
        ER_LOAD(0, 0); ER_LOAD(1, 1); if (RD == 3) ER_LOAD(2, RD - 1);
#pragma unroll
        for (int g = 0; g < 8; ++g) { const int ai = g >> 2, m = g & 3, sl = g % RD; const int row = rbase + ai * HALF + m * 16;
            float ss = 0.f; f32x4 x0[2], x1[2];
#pragma unroll
            for (int bj = 0; bj < 2; ++bj) { f32x4 a, b;
                if (IN_F32) { a = xr[sl][bj][0]; b = xr[sl][bj][1]; } else { const u32x4 w = xb[sl][bj]; a = (f32x4){bflo(w.x), bfhi(w.x), bflo(w.y), bfhi(w.y)}; b = (f32x4){bflo(w.z), bfhi(w.z), bflo(w.w), bfhi(w.w)}; }
                x0[bj] = a + gt[bj][0] * acc[ai][bj][m][0]; x1[bj] = b + gt[bj][1] * acc[ai][bj][m][1]; }
            if (g + RD < 8) ER_LOAD(g + RD, sl);
#pragma unroll
            for (int bj = 0; bj < 2; ++bj) { const int c = col0 + bj * HALF;
                if (OUT_F32) { *(f32x4*)(xout + (size_t)row * DM + c) = x0[bj]; *(f32x4*)(xout + (size_t)row * DM + c + 4) = x1[bj]; }
                else *(u32x4*)(xrout + (size_t)row * DM + c) = pack8(x0[bj], x1[bj]);
                if (donorm) { const f32x4 t0 = x0[bj] * x0[bj], t1 = x1[bj] * x1[bj]; ss += ((t0[0] + t0[1]) + (t0[2] + t0[3])) + ((t1[0] + t1[1]) + (t1[2] + t1[3]));
                    *(u32x4*)(XS + (size_t)row * DM + c) = pack8(x0[bj] * gs[bj][0], x1[bj] * gs[bj][1]); } }
            if (donorm) { { const int ln_ = fq * 16 + fr; ss += shfl_xor_l(ss, 16, ln_); ss += shfl_xor_l(ss, 32, ln_); } if (fq == 0) atomicAdd(ssq + row, ss); }
        }
#undef ER_LOAD
    }
};
struct EpiUp {
    static constexpr bool PERM = true;
    const float* sumsq; const float* bias; bf16_t* UP;
    __device__ __forceinline__ void done(const Unit&, int) const {}
    __device__ __forceinline__ void operator()(const f32x4 (&acc)[2][2][4][2], const Unit& u, int wr, int wc, int fr, int fq) const {
        const int pm = u.pm, cond = cond_of_pm(pm); const int col0 = u.pn * BM + wc * 32 + 8 * fq; const int rbase = pm * BM + wr * 64 + fr;
        f32x4 bv[2][2];
#pragma unroll
        for (int bj = 0; bj < 2; ++bj)
#pragma unroll
            for (int n = 0; n < 2; ++n) bv[bj][n] = *(const f32x4*)(bias + cond * 4096 + col0 + bj * HALF + 4 * n);
#pragma unroll
        for (int ai = 0; ai < 2; ++ai)
#pragma unroll
            for (int m = 0; m < 4; ++m) { const int row = rbase + ai * HALF + m * 16; const float rstd = rsqrtf(sumsq[row] * (1.f / DM) + EPS);
#pragma unroll
                for (int bj = 0; bj < 2; ++bj) *(u32x4*)(UP + (size_t)row * 4096 + col0 + bj * HALF) = pack8(acc[ai][bj][m][0] * rstd + bv[bj][0], acc[ai][bj][m][1] * rstd + bv[bj][1]); }
    }
};

__device__ __forceinline__ float dpp_shr1(float v) { return __uint_as_float((unsigned)__builtin_amdgcn_update_dpp(0, (int)__float_as_uint(v), 0x111, 0xf, 0xf, false)); }
__device__ __forceinline__ float dpp_shl1(float v) { return __uint_as_float((unsigned)__builtin_amdgcn_update_dpp(0, (int)__float_as_uint(v), 0x101, 0xf, 0xf, false)); }
struct EpiUpConv {
    static constexpr bool PERM = true;
    const float* sumsq; const float* bias; const float* cw; const float* cb; bf16_t* G; bf16_t* HALO;
    __device__ __forceinline__ void done(const Unit&, int) const {}
    __device__ __forceinline__ void operator()(const f32x4 (&acc)[2][2][4][2], const Unit& u, int wr, int wc, int fr, int fq) const {
        const int pm = u.pm, pn = u.pn, cond = cond_of_pm(pm);
        const int posv = pn * 256 + wc * 32 + 8 * fq, av = pn * 128 + wc * 32 + 8 * fq;
        float rs[2][4];
#pragma unroll
        for (int ai = 0; ai < 2; ++ai)
#pragma unroll
            for (int m = 0; m < 4; ++m) rs[ai][m] = sumsq[pm * BM + ai * HALF + wr * 64 + 4 * fr + m];
#pragma unroll
        for (int ai = 0; ai < 2; ++ai)
#pragma unroll
            for (int m = 0; m < 4; ++m) rs[ai][m] = rsqrtf(rs[ai][m] * (1.f / DM) + EPS);
#pragma unroll
        for (int n = 0; n < 2; ++n) {
            const int c = av + 4 * n;
            const f32x4 bvv = *(const f32x4*)(bias + cond * 4096 + posv + 4 * n), bvg = *(const f32x4*)(bias + cond * 4096 + posv + 128 + 4 * n);
            const f32x4 w0v = *(const f32x4*)(cw + c), w1v = *(const f32x4*)(cw + 4096 + c), w2v = *(const f32x4*)(cw + 8192 + c), cbv = *(const f32x4*)(cb + c);
            const f32x4 w0g = *(const f32x4*)(cw + 2048 + c), w1g = *(const f32x4*)(cw + 4096 + 2048 + c), w2g = *(const f32x4*)(cw + 8192 + 2048 + c), cbg = *(const f32x4*)(cb + 2048 + c);
#pragma unroll
            for (int ai = 0; ai < 2; ++ai) {
                const int tok0 = pm * BM + ai * HALF + wr * 64 + 4 * fr; const int sl = pm * 4 + ai * 2 + wr;
                f32x4 pv[4], pg[4];
#pragma unroll
                for (int m = 0; m < 4; ++m) { pv[m] = acc[ai][0][m][n] * rs[ai][m] + bvv; pg[m] = acc[ai][1][m][n] * rs[ai][m] + bvg; }
                f32x4 pvp, pvn, pgp, pgn;
#pragma unroll
                for (int j = 0; j < 4; ++j) { pvp[j] = dpp_shr1(pv[3][j]); pvn[j] = dpp_shl1(pv[0][j]); pgp[j] = dpp_shr1(pg[3][j]); pgn[j] = dpp_shl1(pg[0][j]); }
#pragma unroll
                for (int m = 0; m < 4; ++m) {
                    const f32x4 zv = cbv + w0v * (m == 0 ? pvp : pv[m == 0 ? 0 : m - 1]) + w1v * pv[m] + w2v * (m == 3 ? pvn : pv[m == 3 ? 3 : m + 1]);
                    const f32x4 zg = cbg + w0g * (m == 0 ? pgp : pg[m == 0 ? 0 : m - 1]) + w1g * pg[m] + w2g * (m == 3 ? pgn : pg[m == 3 ? 3 : m + 1]);
                    u32x2 w; w.x = cvt_pk_bf16(silu_f(zg[0]) * zv[0], silu_f(zg[1]) * zv[1]); w.y = cvt_pk_bf16(silu_f(zg[2]) * zv[2], silu_f(zg[3]) * zv[3]);
                    *(u32x2*)(G + (size_t)(tok0 + m) * 2048 + c) = w; }
                if (fr == 0 || fr == 15) { const int m0 = fr == 0 ? 0 : 2;
#pragma unroll
                    for (int mm = 0; mm < 2; ++mm) { const f32x4 a = fr == 0 ? pv[mm] : pv[2 + mm], b = fr == 0 ? pg[mm] : pg[2 + mm];
                        bf16_t* hp = HALO + ((size_t)sl * 4 + m0 + mm) * 4096 + posv + 4 * n;
                        u32x2 wa; wa.x = cvt_pk_bf16(a[0], a[1]); wa.y = cvt_pk_bf16(a[2], a[3]); *(u32x2*)hp = wa;
                        u32x2 wb; wb.x = cvt_pk_bf16(b[0], b[1]); wb.y = cvt_pk_bf16(b[2], b[3]); *(u32x2*)(hp + 128) = wb; } }
            }
        }
    }
};
constexpr int AT_SLOT = 32768, AT_NSLOT = 4, AT_VOFF = 16384, AT_X = 0, AT_ST = 65536;
__device__ __forceinline__ void glds16(const void* gsrc, unsigned lds_dst) { unsigned keep;
    asm volatile("s_mov_b32 %0, m0\n\ts_mov_b32 m0, %2\n\ts_nop 0\n\tglobal_load_lds_dwordx4 %1, off\n\ts_mov_b32 m0, %0" : "=&s"(keep) : "v"(gsrc), "s"(lds_dst) : "memory"); }
#define AT_WAIT_BAR(N) asm volatile("s_waitcnt vmcnt(" #N ") lgkmcnt(0)\n\ts_barrier" ::: "memory")
#define AT_SB() __builtin_amdgcn_sched_barrier(0)
__device__ __forceinline__ s16x4 vtr(const LAS char* p) { typedef short v4i16_t __attribute__((ext_vector_type(4))); return __builtin_bit_cast(s16x4, __builtin_amdgcn_ds_read_tr16_b64_v4i16((LAS v4i16_t*)p)); }
__device__ __forceinline__ int crow(int r, int hi) { return (r & 3) + 8 * (r >> 2) + 4 * hi; }

struct AttnArgs { const bf16_t* Q; const bf16_t* KB; const bf16_t* VB; bf16_t* CAT; const float* subln; float lam; float oml; };

__device__ __forceinline__ void attn_unit(LAS unsigned char* lds, const int tid, const AttnArgs& A, int seq, int h, int qblk) {
    const int lane = tid & 63, r32 = lane & 31, hi = lane >> 5; const int wid = __builtin_amdgcn_readfirstlane(tid >> 6);
    const int rg = wid & 3, s = wid >> 2;
    const bool ctx = seq < NB;
    const int qrow0 = ctx ? seq * SEQ + qblk * 128 : MC + (seq - NB) * DSEQ + qblk * 128;
    const int krow0 = ctx ? seq * SEQ : MC + (seq - NB) * (PAST + DSEQ);
    const int NT = ctx ? SEQ / 64 : (PAST + DSEQ) / 64;
    const unsigned lds0 = (unsigned)(uintptr_t)lds;
    const bf16_t* ksrc0 = A.KB + (size_t)(krow0 + lane) * 512 + h * 128 + wid * 8;
    const bf16_t* vsrc0 = A.VB + (size_t)(krow0 + 16 * (wid & 3) + (lane >> 2)) * 512 + h * 128 + (wid >> 2) * 32 + (lane & 3) * 8;
    const unsigned kdst = lds0 + wid * 1024, vdst = lds0 + AT_VOFF + ((wid >> 2) * 4 + (wid & 3)) * 1024;
#define AT_DMA(t, slot) do { const size_t _o = (size_t)(t) * 64 * 512; const unsigned _s = (unsigned)(slot) * AT_SLOT; \
        glds16(ksrc0 + _o, (unsigned)__builtin_amdgcn_readfirstlane(kdst + _s)); glds16(ksrc0 + _o + 64, (unsigned)__builtin_amdgcn_readfirstlane(kdst + _s + 8 * 1024)); \
        glds16(vsrc0 + _o, (unsigned)__builtin_amdgcn_readfirstlane(vdst + _s)); glds16(vsrc0 + _o + 64, (unsigned)__builtin_amdgcn_readfirstlane(vdst + _s + 8 * 1024)); } while (0)
    AT_DMA(0, 0); AT_DMA(1, 1); AT_DMA(2, 2);
    bf16x8 qr[4];
    { const bf16_t* qp = A.Q + (size_t)(qrow0 + rg * 32 + r32) * 512 + h * 128 + s * 64 + hi * 8;
#pragma unroll
      for (int d0 = 0; d0 < 4; ++d0) qr[d0] = *(const bf16x8*)(qp + d0 * 16); }
    f32x16 o[4];
#pragma unroll
    for (int d0 = 0; d0 < 4; ++d0)
#pragma unroll
        for (int r = 0; r < 16; ++r) o[d0][r] = 0.f;
    float lsum = 0.f;
    const LAS char* kfrag0 = (const LAS char*)lds + (s * 8 + hi) * 1024 + r32 * 16;
    const LAS char* vfrag0 = (const LAS char*)lds + AT_VOFF + ((lane >> 4) & 1) * 32 + (lane & 3) * 8 + (4 * hi + ((lane & 15) >> 2)) * 64;
    f32x16 pc0, pc1;
#define AT_KLOAD(kfr, slot) do { const LAS char* _k = kfrag0 + (slot) * AT_SLOT; _Pragma("unroll") for (int d0 = 0; d0 < 4; ++d0) { kfr[2 * d0] = *(const LAS bf16x8*)(_k + d0 * 2048); kfr[2 * d0 + 1] = *(const LAS bf16x8*)(_k + d0 * 2048 + 512); } } while (0)
#define AT_VLOAD(vv, slot, ks) do { const LAS char* _v = vfrag0 + (slot) * AT_SLOT + (ks) * 1024; _Pragma("unroll") for (int d0 = 0; d0 < 4; ++d0) { const s16x4 lo = vtr(_v + d0 * 4096), hh = vtr(_v + d0 * 4096 + 512); \
        vv[d0] = (bf16x8){lo[0], lo[1], lo[2], lo[3], hh[0], hh[1], hh[2], hh[3]}; } } while (0)
#define AT_EXP2(P, i, W) do { P[2 * (i)] = fast_exp2(P[2 * (i)]); P[2 * (i) + 1] = fast_exp2(P[2 * (i) + 1]); sacc += P[2 * (i)] + P[2 * (i) + 1]; W = cvt_pk_bf16(P[2 * (i)], P[2 * (i) + 1]); } while (0)
    AT_WAIT_BAR(8);
    { bf16x8 kfr[8]; AT_KLOAD(kfr, 0);
#pragma unroll
      for (int r = 0; r < 16; ++r) { pc0[r] = 0.f; pc1[r] = 0.f; }
#pragma unroll
      for (int d0 = 0; d0 < 4; ++d0) { pc0 = __builtin_amdgcn_mfma_f32_32x32x16_bf16(kfr[2 * d0], qr[d0], pc0, 0, 0, 0); pc1 = __builtin_amdgcn_mfma_f32_32x32x16_bf16(kfr[2 * d0 + 1], qr[d0], pc1, 0, 0, 0); } }
    int slot = 0;
    for (int t = 0; t < NT; ++t) {
        const bool has_next = t + 1 < NT;
        if (t + 2 < NT) AT_WAIT_BAR(4); else AT_WAIT_BAR(0);
        if (t + 3 < NT) AT_DMA(t + 3, (slot + 3) & 3);
        const int slot_n = (slot + 1) & 3;
        bf16x8 kfr[8], va[4], vb[4]; u32x4 pw[4]; f32x16 pn0, pn1; float sacc = 0.f;
        const LAS char* kn_ = kfrag0 + slot_n * AT_SLOT;
#define AT_K1(d0) do { kfr[2 * (d0)] = *(const LAS bf16x8*)(kn_ + (d0) * 2048); kfr[2 * (d0) + 1] = *(const LAS bf16x8*)(kn_ + (d0) * 2048 + 512); } while (0)
        if (has_next) { AT_K1(0); AT_K1(1); }
        AT_SB();
        if (has_next) {
#pragma unroll
            for (int r = 0; r < 16; ++r) { pn0[r] = 0.f; pn1[r] = 0.f; }
#pragma unroll
            for (int i = 0; i < 8; ++i) { const int d0 = i >> 1;
                if (i & 1) pn1 = __builtin_amdgcn_mfma_f32_32x32x16_bf16(kfr[2 * d0 + 1], qr[d0], pn1, 0, 0, 0); else pn0 = __builtin_amdgcn_mfma_f32_32x32x16_bf16(kfr[2 * d0], qr[d0], pn0, 0, 0, 0);
                AT_EXP2(pc0, i, pw[i >> 2][i & 3]);
                if (i == 0) AT_K1(2);
                if (i == 1) AT_K1(3);
                if (i == 3) AT_VLOAD(va, slot, 0);
                if (i == 5) AT_VLOAD(vb, slot, 1);
                AT_SB(); }
        } else {
            AT_VLOAD(va, slot, 0); AT_VLOAD(vb, slot, 1);
#pragma unroll
            for (int i = 0; i < 8; ++i) AT_EXP2(pc0, i, pw[i >> 2][i & 3]);
            AT_SB();
        }
        bf16x8 vc[4], vd[4];
#pragma unroll
        for (int i = 0; i < 8; ++i) { const int d0 = i & 3;
            if (i < 4) o[d0] = __builtin_amdgcn_mfma_f32_32x32x16_bf16(va[d0], __builtin_bit_cast(bf16x8, pw[0]), o[d0], 0, 0, 0);
            else       o[d0] = __builtin_amdgcn_mfma_f32_32x32x16_bf16(vb[d0], __builtin_bit_cast(bf16x8, pw[1]), o[d0], 0, 0, 0);
            AT_EXP2(pc1, i, pw[2 + (i >> 2)][i & 3]);
            if (i == 1) AT_VLOAD(vc, slot, 2);
            if (i == 5) AT_VLOAD(vd, slot, 3);
            AT_SB(); }
#pragma unroll
        for (int d0 = 0; d0 < 4; ++d0) o[d0] = __builtin_amdgcn_mfma_f32_32x32x16_bf16(vc[d0], __builtin_bit_cast(bf16x8, pw[2]), o[d0], 0, 0, 0);
#pragma unroll
        for (int d0 = 0; d0 < 4; ++d0) o[d0] = __builtin_amdgcn_mfma_f32_32x32x16_bf16(vd[d0], __builtin_bit_cast(bf16x8, pw[3]), o[d0], 0, 0, 0);
        lsum += sacc;
        if (has_next) { pc0 = pn0; pc1 = pn1; }
        slot = slot_n;
    }
    lsum += shfl_xor_l(lsum, 32, lane);
    const float inv = (s == 0 ? 1.f : A.lam) / lsum;
    AT_WAIT_BAR(0);
    LAS float* X = (LAS float*)(lds + AT_X) + rg * 4096;
    if (s == 1) {
#pragma unroll
        for (int d0 = 0; d0 < 4; ++d0)
#pragma unroll
            for (int r = 0; r < 16; ++r) X[(d0 * 16 + r) * 64 + lane] = o[d0][r] * inv;
    }
    AT_WAIT_BAR(0);
    if (s == 0) {
        float ss = 0.f;
#pragma unroll
        for (int d0 = 0; d0 < 4; ++d0)
#pragma unroll
            for (int r = 0; r < 16; ++r) { const float v = o[d0][r] * inv - X[(d0 * 16 + r) * 64 + lane]; o[d0][r] = v; ss += v * v; }
        ss += shfl_xor_l(ss, 32, lane);
        const float rn = rsqrtf(ss * (1.f / 128.f) + EPS) * A.oml;
        LAS bf16_t* stg = (LAS bf16_t*)(lds + AT_ST) + rg * (32 * 136);
#pragma unroll
        for (int d0 = 0; d0 < 4; ++d0)
#pragma unroll
            for (int rq = 0; rq < 4; ++rq) { const int dv = 32 * d0 + 8 * rq + 4 * hi; const f32x4 g4 = *(const f32x4*)(A.subln + dv);
                u32x2 w; w.x = cvt_pk_bf16(o[d0][4 * rq] * rn * g4[0], o[d0][4 * rq + 1] * rn * g4[1]); w.y = cvt_pk_bf16(o[d0][4 * rq + 2] * rn * g4[2], o[d0][4 * rq + 3] * rn * g4[3]);
                *(LAS u32x2*)(stg + r32 * 136 + dv) = w; }
        asm volatile("s_waitcnt lgkmcnt(0)" ::: "memory");
        bf16_t* dst = A.CAT + (size_t)(qrow0 + rg * 32) * 1024 + h * 128;
#pragma unroll
        for (int i = 0; i < 8; ++i) { const int row = i * 4 + (lane >> 4), ch = lane & 15; const u32x4 v = *(const LAS u32x4*)(stg + row * 136 + ch * 8); *(u32x4*)(dst + (size_t)row * 1024 + ch * 8) = v; }
    }
    AT_WAIT_BAR(0);
#undef AT_DMA
#undef AT_KLOAD
#undef AT_K1
#undef AT_VLOAD
#undef AT_EXP2
}
struct Args { const float* in[34]; float* out; unsigned char* ws; int stop_after; int pad; };
typedef const __attribute__((address_space(4))) Args* kargs_t;
struct Frame {
    LAS unsigned char* lds; int tid, lane, wave, vcu, bid, G;
    kargs_t ka; float* out; unsigned char* ws;
    float* misc; unsigned* ctl;
};
#define LDS_WAIT() asm volatile("s_waitcnt lgkmcnt(0)" ::: "memory")
#define VM_WAIT() asm volatile("s_waitcnt vmcnt(0)" ::: "memory")

template <int MAP> __device__ __forceinline__ int src_col(int p);
template <int MODE, int MAP, int NC> __device__ __forceinline__ void gemv9_task(Frame& F, const float* W, int ldw, int l, int voff, int strip, float* out, int ldo, const float* add) {
    LAS float* sc = (LAS float*)F.lds; LAS float* red = sc + 9 * 1024;
    for (int i = F.tid; i < 9 * 1024; i += NTHREADS) { const int cond = i >> 10, k = i & 1023; float v;
        if (MODE == 0) { v = cond == 0 ? F.ka->in[6][k] : F.ka->in[5][(cond - 1) * 1024 + k]; v = v / (1.f + expf(-v)); } else v = F.misc[MI_MOD + (l * 9 + cond) * 6144 + voff + k];
        sc[i] = v; }
    __syncthreads();
    const int j = strip * NC + (F.lane < NC ? F.lane : NC - 1); const float* w = W + (size_t)(F.wave * 128) * ldw + src_col<MAP>(j);
    float acc[9];
#pragma unroll
    for (int b = 0; b < 9; ++b) acc[b] = 0.f;
#pragma unroll 16
    for (int k = 0; k < 128; ++k) { const float wv = w[(size_t)k * ldw];
#pragma unroll
        for (int b = 0; b < 9; ++b) acc[b] += sc[b * 1024 + F.wave * 128 + k] * wv; }
#pragma unroll
    for (int b = 0; b < 9; ++b) red[(F.wave * 9 + b) * 64 + F.lane] = acc[b];
    __syncthreads();
    for (int i = F.tid; i < 9 * 64; i += NTHREADS) { const int b = i >> 6, ln = i & 63; if (ln >= NC) continue; float s_ = 0.f;
#pragma unroll
        for (int w8 = 0; w8 < 8; ++w8) s_ += red[(w8 * 9 + b) * 64 + ln];
        const int jj = strip * NC + ln; out[(size_t)b * ldo + jj] = s_ + (add ? add[jj] : 0.f); }
    __syncthreads();
}
template <int MAP> __device__ __forceinline__ int src_col(int p) {
    if (MAP == 1) { if (p >= 1024) return p; const int pn = p >> 8, r = p & 255, bj = r >> 7, wc = (r >> 5) & 3, fq = (r >> 3) & 3, low = r & 7; return 256 * pn + 64 * wc + 32 * (fq >> 1) + 16 * bj + 8 * (fq & 1) + low; }
    if (MAP == 2) { const int pn = p >> 8, bj = (p >> 7) & 1, r = p & 127; return bj * 2048 + 128 * pn + r; }
    return p;
}
__device__ __forceinline__ void mod_task3(Frame& F, int task) {
    const int l = task / 96, r = task % 96, kq = r / 24, cg = r % 24;
    LAS float* sc = (LAS float*)F.lds; LAS float* red = sc + 9 * 256;
    for (int i = F.tid; i < 9 * 256; i += NTHREADS) { const int cond = i >> 8, k = kq * 256 + (i & 255); const float v = cond == 0 ? F.ka->in[6][k] : F.ka->in[5][(cond - 1) * 1024 + k]; sc[i] = v / (1.f + expf(-v)); }
    __syncthreads();
    const float* w = F.ka->in[7] + ((size_t)l * DM + kq * 256 + F.wave * 32) * 6144 + cg * 256 + F.lane * 4;
    f32x4 acc[9];
#pragma unroll
    for (int b = 0; b < 9; ++b) acc[b] = (f32x4){0.f, 0.f, 0.f, 0.f};
#pragma unroll
    for (int h = 0; h < 2; ++h) { f32x4 wv[16];
#pragma unroll
        for (int k = 0; k < 16; ++k) wv[k] = *(const f32x4*)(w + (size_t)(h * 16 + k) * 6144);
#pragma unroll
        for (int k = 0; k < 16; ++k)
#pragma unroll
            for (int b = 0; b < 9; ++b) acc[b] += wv[k] * sc[b * 256 + F.wave * 32 + h * 16 + k]; }
#pragma unroll
    for (int b = 0; b < 9; ++b) *(LAS f32x4*)(red + (F.wave * 9 + b) * 256 + F.lane * 4) = acc[b];
    __syncthreads();
    for (int i = F.tid; i < 9 * 256; i += NTHREADS) { const int b = i >> 8, c = i & 255; float v = 0.f;
#pragma unroll
        for (int w8 = 0; w8 < 8; ++w8) v += red[(w8 * 9 + b) * 256 + c];
        const int col = cg * 256 + c; if (kq == 0) v += F.ka->in[8][l * 6144 + col];
        atomicAdd(F.misc + MI_MOD + (l * 9 + b) * 6144 + col, v); }
    __syncthreads();
}
template <int MAP, bool BIAS> __device__ __forceinline__ void transpose_item(Frame& F, const float* W, int K, int N, bf16_t* WT, LAS float* scr, int item, const float* shv, float* bias) {
    const int lane = F.lane; const int nblk = N / 64, kb = item / nblk, nb = item % nblk, k0 = 64 * kb, n0 = 64 * nb;
    const int sc_ = src_col<MAP>(n0 + lane);
    float tv[64];
#pragma unroll
    for (int i = 0; i < 64; ++i) tv[i] = W[(size_t)(k0 + i) * N + sc_];
#pragma unroll
    for (int i = 0; i < 64; ++i) scr[i * 65 + lane] = tv[i];
    LDS_WAIT(); asm volatile("" ::: "memory");
    const int c = lane & 7;
#pragma unroll
    for (int j = 0; j < 8; ++j) { const int n = (lane >> 3) + 8 * j; const LAS float* s_ = scr + (8 * c) * 65 + n;
        u32x4 o; o.x = cvt_pk_bf16(s_[0 * 65], s_[1 * 65]); o.y = cvt_pk_bf16(s_[2 * 65], s_[3 * 65]); o.z = cvt_pk_bf16(s_[4 * 65], s_[5 * 65]); o.w = cvt_pk_bf16(s_[6 * 65], s_[7 * 65]);
        *(u32x4*)(WT + (size_t)(n0 + n) * K + k0 + 8 * c) = o; }
    if (BIAS) {
        float sh[9], acc[9];
#pragma unroll
        for (int b = 0; b < 9; ++b) { sh[b] = shv[b * 6144 + k0 + lane]; acc[b] = 0.f; }
#pragma unroll
        for (int kk = 0; kk < 64; ++kk) { const float w = tv[kk];
#pragma unroll
            for (int b = 0; b < 9; ++b) acc[b] += __uint_as_float(__builtin_amdgcn_readlane(__float_as_uint(sh[b]), kk)) * w; }
#pragma unroll
        for (int b = 0; b < 9; ++b) atomicAdd(bias + (size_t)b * N + n0 + lane, acc[b]);
    }
    LDS_WAIT(); asm volatile("" ::: "memory");
}
__device__ __forceinline__ void cache_item(Frame& F, int l, int item4) {
    f32x4 a[4], c[4];
#pragma unroll
    for (int i = 0; i < 4; ++i) { const int item = item4 * 4 + i, which = item >> 12, r = item & 4095, b = r >> 9, j = r & 511;
        const float* src = (which ? F.ka->in[3] : F.ka->in[2]) + ((size_t)(b * DEPTH + l) * PAST + j) * 512 + F.lane * 8; a[i] = *(const f32x4*)src; c[i] = *(const f32x4*)(src + 4); }
#pragma unroll
    for (int i = 0; i < 4; ++i) { const int item = item4 * 4 + i, which = item >> 12, r = item & 4095, b = r >> 9, j = r & 511;
        bf16_t* dst = (bf16_t*)(F.ws + (which ? WS_VB : WS_KB)) + (size_t)(MC + b * (PAST + DSEQ) + j) * 512 + F.lane * 8; *(u32x4*)dst = pack8(a[i], c[i]); }
}
__device__ __forceinline__ f32x2 cmul(f32x2 a, f32x2 b) { return (f32x2){a.x * b.x - a.y * b.y, a.x * b.y + a.y * b.x}; }
__device__ __forceinline__ void ssm_prep(Frame& F, int l, int task) {
    const int g = task >> 1, half = task & 1;
    LAS f32x2* POW = (LAS f32x2*)F.lds;
    LAS f32x2* BB = POW + 2 * 17 * 64;
    LAS f32x2* CC = BB + 2 * 64 * 16;
    LAS f32x2* CT = CC + 2 * 16 * 64;
    LAS float* KT = (LAS float*)(CT + 2 * 64 * 16);
    constexpr int KTS = 260;
    bf16_t* WE = (bf16_t*)(F.ws + WS_SSM + SSM_WE) + (size_t)g * 256 * 256;
    bf16_t* WY = (bf16_t*)(F.ws + WS_SSM + SSM_WY) + (size_t)g * 256 * 512;
    f32x2* LAM16 = (f32x2*)(F.ws + WS_SSM + SSM_LAM16); f32x2* BBAR = (f32x2*)(F.ws + WS_SSM + SSM_BBAR);
    const int tid = F.tid, lane = F.lane;
    if (tid < 128) { const int dir = tid >> 6, p = tid & 63; const size_t pi = ((size_t)(l * 2 + dir) * NG + g) * 64 + p;
        const float lr = F.ka->in[18][pi], li = F.ka->in[19][pi], delta = expf(F.ka->in[20][(l * 2 + dir) * NG + g]);
        const float er = expf(lr * delta), lbr = er * cosf(li * delta), lbi = er * sinf(li * delta);
        { float one_ = 1.f, zero_ = 0.f; asm volatile("" : "+v"(one_), "+v"(zero_));
          f32x2 pw = (f32x2){one_, zero_}; const f32x2 lb = (f32x2){lbr, lbi};
          for (int tau = 0; tau <= 16; ++tau) { POW[(dir * 17 + tau) * 64 + p] = pw; if (tau == 16 && half == 0) LAM16[(dir * NG + g) * 64 + p] = pw; pw = cmul(pw, lb); } }
        const float nr = lbr - 1.f, ni = lbi, den = lr * lr + li * li; const f32x2 fac = (f32x2){(nr * lr + ni * li) / den, (ni * lr - nr * li) / den};
        f32x4 br[4], bi4[4];
#pragma unroll
        for (int q = 0; q < 4; ++q) { br[q] = *(const f32x4*)(F.ka->in[21] + pi * 16 + 4 * q); bi4[q] = *(const f32x4*)(F.ka->in[22] + pi * 16 + 4 * q); }
#pragma unroll
        for (int ch = 0; ch < 16; ++ch) { const f32x2 bb = cmul(fac, (f32x2){br[ch >> 2][ch & 3], bi4[ch >> 2][ch & 3]}); BB[(dir * 64 + p) * 16 + ch] = bb; if (half == 0) BBAR[((size_t)(dir * NG + g) * 64 + p) * 16 + ch] = bb; }
    }
    { f32x2 cv[4];
#pragma unroll
      for (int q = 0; q < 4; ++q) { const int i = tid + q * NTHREADS, dir = i >> 10, c = (i >> 6) & 15, p = i & 63; const size_t ci = (((size_t)(l * 2 + dir) * NG + g) * 16 + c) * 64 + p; cv[q] = (f32x2){F.ka->in[23][ci], F.ka->in[24][ci]}; }
#pragma unroll
      for (int q = 0; q < 4; ++q) { const int i = tid + q * NTHREADS, dir = i >> 10, c = (i >> 6) & 15, p = i & 63; CC[i] = cv[q]; CT[(dir * 64 + p) * 16 + c] = cv[q]; } }
    __syncthreads();
    { const int i16 = lane & 15, k4 = lane >> 4, ri = k4 & 1, ph = k4 >> 1;
      for (int blk = 0; blk < 4; ++blk) { const int q = F.wave * 4 + blk, dir = q >> 4, tau = q & 15; f32x4 acc = (f32x4){0.f, 0.f, 0.f, 0.f};
#pragma unroll 8
          for (int ks = 0; ks < 32; ++ks) { const int p = 2 * ks + ph;
              const f32x2 cc = CT[(dir * 64 + p) * 16 + i16], pw = POW[(dir * 17 + tau) * 64 + p], bb = BB[(dir * 64 + p) * 16 + i16];
              const float u = ri ? -pw.y : pw.x, v = ri ? pw.x : pw.y;
              const float av = cc.x * u - cc.y * v, bv = ri ? bb.y : bb.x;
              acc = __builtin_amdgcn_mfma_f32_16x16x4f32(av, bv, acc, 0, 0, 0); }
#pragma unroll
          for (int r = 0; r < 4; ++r) KT[(dir * 16 + tau) * KTS + (k4 * 4 + r) * 16 + i16] = acc[r]; } }
    __syncthreads();
    const float* Dv = F.ka->in[25] + l * 512 + g * 16;
    for (int idx = half * 8192 + tid; idx < (half + 1) * 8192; idx += NTHREADS) { const int n = idx >> 6, kc = idx & 63, k0 = kc * 8, i = n >> 4, c = n & 15; f32x4 v0, v1;
        if (k0 < 256) { const int s_ = k0 >> 4, ch0 = k0 & 15; v0 = (f32x4){0.f, 0.f, 0.f, 0.f}; v1 = v0;
            if (s_ <= i) { const LAS float* kp = KT + (i - s_) * KTS + c * 16 + ch0; v0 += *(const LAS f32x4*)kp; v1 += *(const LAS f32x4*)(kp + 4); }
            if (s_ >= i) { const LAS float* kp = KT + (16 + s_ - i) * KTS + c * 16 + ch0; v0 += *(const LAS f32x4*)kp; v1 += *(const LAS f32x4*)(kp + 4); }
            if (s_ == i) { const int e = c - ch0; const float dv = Dv[c]; if (e >= 0 && e < 4) v0[e] += dv; else if (e >= 4 && e < 8) v1[e - 4] += dv; }
        } else { const int dir = k0 >= 384 ? 1 : 0, p0 = ((k0 - 256) & 127) >> 1, tau = dir ? 16 - i : i + 1;
            const LAS f32x4* cp = (const LAS f32x4*)(CC + (dir * 16 + c) * 64 + p0); const LAS f32x4* pp = (const LAS f32x4*)(POW + (dir * 17 + tau) * 64 + p0);
            const f32x4 c0 = cp[0], c1 = cp[1], w0 = pp[0], w1 = pp[1];
            v0 = (f32x4){c0[0] * w0[0] - c0[1] * w0[1], -(c0[0] * w0[1] + c0[1] * w0[0]), c0[2] * w0[2] - c0[3] * w0[3], -(c0[2] * w0[3] + c0[3] * w0[2])};
            v1 = (f32x4){c1[0] * w1[0] - c1[1] * w1[1], -(c1[0] * w1[1] + c1[1] * w1[0]), c1[2] * w1[2] - c1[3] * w1[3], -(c1[2] * w1[3] + c1[3] * w1[2])}; }
        *(u32x4*)(WY + (size_t)n * 512 + k0) = pack8(v0, v1); }
    for (int idx = half * 4096 + tid; idx < (half + 1) * 4096; idx += NTHREADS) { const int n = idx >> 5, k0 = (idx & 31) * 8, dir = n >> 7, p = (n & 127) >> 1, ri = n & 1, s_ = k0 >> 4, ch0 = k0 & 15;
        const f32x2 pw = POW[(dir * 17 + (dir ? s_ : 15 - s_)) * 64 + p]; const LAS f32x4* bp = (const LAS f32x4*)(BB + (dir * 64 + p) * 16 + ch0);
        const float u = ri ? pw.y : pw.x, v = ri ? pw.x : -pw.y;
        const f32x4 b0 = bp[0], b1 = bp[1], b2 = bp[2], b3 = bp[3];
        const f32x4 v0 = (f32x4){u * b0[0] + v * b0[1], u * b0[2] + v * b0[3], u * b1[0] + v * b1[1], u * b1[2] + v * b1[3]};
        const f32x4 v1 = (f32x4){u * b2[0] + v * b2[1], u * b2[2] + v * b2[3], u * b3[0] + v * b3[1], u * b3[2] + v * b3[3]};
        *(u32x4*)(WE + (size_t)n * 256 + k0) = pack8(v0, v1); }
    __syncthreads();
}
__device__ __forceinline__ void xprep_item(Frame& F, int item4) {
    f32x4 xv[4][4];
#pragma unroll
    for (int i = 0; i < 4; ++i) { const int row = item4 * 4 + i; const float* xr = (row < MC) ? F.ka->in[0] + (size_t)row * DM : F.ka->in[1] + (size_t)(row - MC) * DM;
#pragma unroll
        for (int j = 0; j < 4; ++j) xv[i][j] = *(const f32x4*)(xr + 4 * F.lane + 256 * j); }
    const int cond = item4 * 4 < MC ? 0 : 1 + ((item4 * 4 - MC) >> 10);
    const float* sc = F.misc + MI_MOD + (0 * 9 + cond) * 6144 + 1024; const float* g1 = F.ka->in[9];
    f32x4 gs[4];
#pragma unroll
    for (int j = 0; j < 4; ++j) { const int c = 4 * F.lane + 256 * j; gs[j] = (*(const f32x4*)(g1 + c)) * (*(const f32x4*)(sc + c) + 1.f); }
#pragma unroll
    for (int i = 0; i < 4; ++i) { const int row = item4 * 4 + i; bf16_t* dst = (bf16_t*)(F.ws + WS_XS) + (size_t)row * DM; float s = 0.f;
#pragma unroll
        for (int j = 0; j < 4; ++j) { const f32x4 x = xv[i][j]; const f32x4 t = x * x; s += (t[0] + t[1]) + (t[2] + t[3]); const f32x4 y = x * gs[j];
            u32x2 w; w.x = cvt_pk_bf16(y[0], y[1]); w.y = cvt_pk_bf16(y[2], y[3]); *(u32x2*)(dst + 4 * F.lane + 256 * j) = w; }
        s = wave_sum(s, F.lane);
        if (F.lane == 0) ((float*)(F.ctl + CW_SS))[row] = s; }
}
__device__ __forceinline__ void bias_item(Frame& F, int item) {
    const int which = item >= 2048, n = which ? item - 2048 : item;
    const bf16_t* wrow = (const bf16_t*)(F.ws + (which ? WS_WUP : WS_WIN)) + (size_t)n * DM;
    float wv[16]; { const u32x4 a = *(const u32x4*)(wrow + F.lane * 8), b = *(const u32x4*)(wrow + 512 + F.lane * 8);
        wv[0] = bflo(a.x); wv[1] = bfhi(a.x); wv[2] = bflo(a.y); wv[3] = bfhi(a.y); wv[4] = bflo(a.z); wv[5] = bfhi(a.z); wv[6] = bflo(a.w); wv[7] = bfhi(a.w);
        wv[8] = bflo(b.x); wv[9] = bfhi(b.x); wv[10] = bflo(b.y); wv[11] = bfhi(b.y); wv[12] = bflo(b.z); wv[13] = bfhi(b.z); wv[14] = bflo(b.w); wv[15] = bfhi(b.w); }
    float outv = 0.f;
#pragma unroll
    for (int cond = 0; cond < 9; ++cond) { const float* sh = F.misc + MI_MOD + cond * 6144 + (which ? 3072 : 0);
        const f32x4 s0 = *(const f32x4*)(sh + F.lane * 8), s1 = *(const f32x4*)(sh + F.lane * 8 + 4), s2 = *(const f32x4*)(sh + 512 + F.lane * 8), s3 = *(const f32x4*)(sh + 512 + F.lane * 8 + 4);
        float d = 0.f;
#pragma unroll
        for (int e = 0; e < 4; ++e) d += s0[e] * wv[e] + s1[e] * wv[4 + e] + s2[e] * wv[8 + e] + s3[e] * wv[12 + e];
        d = wave_sum(d, F.lane); if (F.lane == cond) outv = d; }
    if (F.lane < 9) ((float*)F.ctl)[(which ? CW_BUP + F.lane * 4096 : CW_BIN + F.lane * 2048) + n] = outv;
}
__device__ __forceinline__ void ssm_scan(Frame& F, int l, int g, int pm) {
    const int tid = F.tid, sl = tid >> 7, dp = tid & 127, dir = dp >> 6, p = dp & 63;
    const f32x2* LAM16 = (const f32x2*)(F.ws + WS_SSM + SSM_LAM16); const f32x2* BBAR = (const f32x2*)(F.ws + WS_SSM + SSM_BBAR);
    const float* E = (const float*)(F.ws + WS_R + R_E); bf16_t* AS3 = (bf16_t*)(F.ws + WS_R + R_AS3);
    const f32x2 lam = LAM16[(dir * NG + g) * 64 + p];
    f32x2 e[64];
    if (pm == 0) {
#pragma unroll
        for (int q = 0; q < 4; ++q) { const float* ep = E + ((size_t)g * NCHUNK + (q * 4 + sl) * 16) * 256 + dir * 128 + 2 * p;
#pragma unroll
            for (int j = 0; j < 16; ++j) e[q * 16 + j] = *(const f32x2*)(ep + (size_t)j * 256); }
    } else { const float* ep = E + ((size_t)g * NCHUNK + 256 + ((pm - 1) * 4 + sl) * 64) * 256 + dir * 128 + 2 * p;
#pragma unroll
        for (int j = 0; j < 64; ++j) e[j] = *(const f32x2*)(ep + (size_t)j * 256); }
    const int nq = pm == 0 ? 4 : 1;
#pragma unroll
    for (int q = 0; q < 4; ++q) { if (q >= nq) break;
        int base; f32x2 h;
        if (pm == 0) { const int seq = q * 4 + sl; base = seq * 16; h = (f32x2){0.f, 0.f}; }
        else { const int sq = (pm - 1) * 4 + sl; base = 256 + sq * 64; h = *(const f32x2*)(F.ka->in[4] + ((((size_t)sq * DEPTH + l) * 2 + dir) * NG + g) * 128 + 2 * p); }
        unsigned* hp = (unsigned*)(AS3 + ((size_t)g * NCHUNK + base) * 512 + 256 + dir * 128 + 2 * p);
        if (pm == 0) {
#pragma unroll
            for (int jj = 0; jj < 16; ++jj) { const int j = dir ? 15 - jj : jj; const f32x2 ev = dir ? e[q * 16 + 15 - jj] : e[q * 16 + jj]; hp[(size_t)j * 256] = cvt_pk_bf16(h.x, h.y); h = cmul(lam, h) + ev; }
        } else {
#pragma unroll
            for (int jj = 0; jj < 64; ++jj) { const int j = dir ? 63 - jj : jj; const f32x2 ev = dir ? e[63 - jj] : e[jj]; hp[(size_t)j * 256] = cvt_pk_bf16(h.x, h.y); h = cmul(lam, h) + ev; }
        }
    }
    if (pm == 0) {
        const int tt = dir ? 15 : 0; u32x4 uq[4][2]; f32x2 bbv[16];
        const f32x2* bb = BBAR + ((size_t)(dir * NG + g) * 64 + p) * 16;
#pragma unroll
        for (int ch = 0; ch < 16; ++ch) bbv[ch] = bb[ch];
#pragma unroll
        for (int q = 0; q < 4; ++q) { const int chunk = (q * 4 + sl) * 16 + tt; const bf16_t* up = AS3 + ((size_t)g * NCHUNK + chunk) * 512 + tt * 16; uq[q][0] = *(const u32x4*)up; uq[q][1] = *(const u32x4*)(up + 8); }
        float* ns = F.out + (size_t)MT * DM + 2 * (size_t)NB * DEPTH * SEQ * 512;
#pragma unroll
        for (int q = 0; q < 4; ++q) { const int seq = q * 4 + sl; const u32x4 u0 = uq[q][0], u1 = uq[q][1];
            const float uu[16] = {bflo(u0.x), bfhi(u0.x), bflo(u0.y), bfhi(u0.y), bflo(u0.z), bfhi(u0.z), bflo(u0.w), bfhi(u0.w), bflo(u1.x), bfhi(u1.x), bflo(u1.y), bfhi(u1.y), bflo(u1.z), bfhi(u1.z), bflo(u1.w), bfhi(u1.w)};
            f32x2 acc = (f32x2){0.f, 0.f};
#pragma unroll
            for (int ch = 0; ch < 16; ++ch) acc += bbv[ch] * uu[ch];
            *(f32x2*)(ns + ((((size_t)seq * DEPTH + l) * 2 + dir) * NG + g) * 128 + 2 * p) = acc; }
    }
}
__device__ __forceinline__ void ld16(const bf16_t* p, float* v) { const u32x4 a = *(const u32x4*)p; v[0] = bflo(a.x); v[1] = bfhi(a.x); v[2] = bflo(a.y); v[3] = bfhi(a.y); v[4] = bflo(a.z); v[5] = bfhi(a.z); v[6] = bflo(a.w); v[7] = bfhi(a.w); }
__device__ __forceinline__ void conv_item(Frame& F, int l, int item) {
    const int rs = item >> 4, pn = item & 15, lr = F.lane >> 4, lc = F.lane & 15;
    const int r0 = rs * 64 + lr * 16; const int av = 128 * pn + 8 * lc;
    const bf16_t* up = (const bf16_t*)(F.ws + WS_R) + (size_t)r0 * 4096 + 256 * pn + 8 * lc; bf16_t* gp = (bf16_t*)(F.ws + WS_G) + (size_t)r0 * 2048 + av;
    const float* cw = F.ka->in[31] + (size_t)l * 3 * 4096; const float* cb = F.ka->in[32] + (size_t)l * 4096;
    float wv[3][8], wg[3][8], bv[8], bg[8];
#pragma unroll
    for (int k = 0; k < 3; ++k)
#pragma unroll
        for (int e = 0; e < 8; ++e) { wv[k][e] = cw[k * 4096 + av + e]; wg[k][e] = cw[k * 4096 + 2048 + av + e]; }
#pragma unroll
    for (int e = 0; e < 8; ++e) { bv[e] = cb[av + e]; bg[e] = cb[2048 + av + e]; }
    const int t0 = r0 < MC ? (r0 & 255) : ((r0 - MC) & 1023), L = r0 < MC ? SEQ : DSEQ;
    float pv[8], pg[8], cv[8], cg[8], nv_[8], ng[8];
    if (t0 > 0) { ld16(up - 4096, pv); ld16(up - 4096 + 128, pg); } else {
#pragma unroll
        for (int e = 0; e < 8; ++e) { pv[e] = 0.f; pg[e] = 0.f; } }
    ld16(up, cv); ld16(up + 128, cg);
#pragma unroll
    for (int i = 0; i < 16; ++i) {
        if (t0 + i + 1 < L) { ld16(up + (size_t)(i + 1) * 4096, nv_); ld16(up + (size_t)(i + 1) * 4096 + 128, ng); } else {
#pragma unroll
            for (int e = 0; e < 8; ++e) { nv_[e] = 0.f; ng[e] = 0.f; } }
        float o[8];
#pragma unroll
        for (int e = 0; e < 8; ++e) { const float zv = bv[e] + wv[0][e] * pv[e] + wv[1][e] * cv[e] + wv[2][e] * nv_[e]; const float zg = bg[e] + wg[0][e] * pg[e] + wg[1][e] * cg[e] + wg[2][e] * ng[e]; o[e] = silu_f(zg) * zv; }
        u32x4 w; w.x = cvt_pk_bf16(o[0], o[1]); w.y = cvt_pk_bf16(o[2], o[3]); w.z = cvt_pk_bf16(o[4], o[5]); w.w = cvt_pk_bf16(o[6], o[7]);
        *(u32x4*)(gp + (size_t)i * 2048) = w;
#pragma unroll
        for (int e = 0; e < 8; ++e) { pv[e] = cv[e]; pg[e] = cg[e]; cv[e] = nv_[e]; cg[e] = ng[e]; }
    }
}

__device__ __forceinline__ bool slab_first(int s) { return s < 64 ? (s & 3) == 0 : ((s - 64) & 15) == 0; }
__device__ __forceinline__ bool slab_last(int s) { return s < 64 ? (s & 3) == 3 : ((s - 64) & 15) == 15; }
__device__ __forceinline__ void ld4bf(const bf16_t* p, float* v) { const u32x2 a = *(const u32x2*)p; v[0] = bflo(a.x); v[1] = bfhi(a.x); v[2] = bflo(a.y); v[3] = bfhi(a.y); }
__device__ __forceinline__ void conv_fix(Frame& F, int l, int pm) {
    const bf16_t* HALO = (const bf16_t*)(F.ws + WS_HALO); bf16_t* G = (bf16_t*)(F.ws + WS_G);
    const float* cw = F.ka->in[31] + (size_t)l * 3 * 4096; const float* cb = F.ka->in[32] + (size_t)l * 4096;
    const int c = F.tid * 4, pos = 256 * (c >> 7) + (c & 127);
    float wv[3][4], wg[3][4], bv[4], bg[4];
#pragma unroll
    for (int k = 0; k < 3; ++k) { const f32x4 a = *(const f32x4*)(cw + k * 4096 + c), b = *(const f32x4*)(cw + k * 4096 + 2048 + c);
#pragma unroll
        for (int e = 0; e < 4; ++e) { wv[k][e] = a[e]; wg[k][e] = b[e]; } }
    { const f32x4 a = *(const f32x4*)(cb + c), b = *(const f32x4*)(cb + 2048 + c);
#pragma unroll
      for (int e = 0; e < 4; ++e) { bv[e] = a[e]; bg[e] = b[e]; } }
    u32x2 hv[8][6];
#pragma unroll
    for (int r8 = 0; r8 < 8; ++r8) { const int s = pm * 4 + (r8 >> 1), which = r8 & 1; const bool skip = which == 0 ? slab_first(s) : slab_last(s);
        const int sp = skip ? s : (which == 0 ? s - 1 : s), sn = skip ? s : (which == 0 ? s : s + 1);
        const bf16_t* hp = which == 0 ? HALO + ((size_t)sp * 4 + 3) * 4096 : HALO + ((size_t)s * 4 + 2) * 4096;
        const bf16_t* hc = which == 0 ? HALO + ((size_t)s * 4 + 0) * 4096 : HALO + ((size_t)s * 4 + 3) * 4096;
        const bf16_t* hn = which == 0 ? HALO + ((size_t)s * 4 + 1) * 4096 : HALO + ((size_t)sn * 4 + 0) * 4096;
        hv[r8][0] = *(const u32x2*)(hp + pos); hv[r8][1] = *(const u32x2*)(hc + pos); hv[r8][2] = *(const u32x2*)(hn + pos);
        hv[r8][3] = *(const u32x2*)(hp + pos + 128); hv[r8][4] = *(const u32x2*)(hc + pos + 128); hv[r8][5] = *(const u32x2*)(hn + pos + 128); }
#pragma unroll
    for (int r8 = 0; r8 < 8; ++r8) { const int s = pm * 4 + (r8 >> 1), which = r8 & 1;
        if (which == 0 ? slab_first(s) : slab_last(s)) continue;
        float pv[4], cv[4], nv_[4], pg[4], cg[4], ng[4];
#define UNP(v, w) do { v[0] = bflo(w.x); v[1] = bfhi(w.x); v[2] = bflo(w.y); v[3] = bfhi(w.y); } while (0)
        UNP(pv, hv[r8][0]); UNP(cv, hv[r8][1]); UNP(nv_, hv[r8][2]); UNP(pg, hv[r8][3]); UNP(cg, hv[r8][4]); UNP(ng, hv[r8][5]);
#undef UNP
        float o[4];
#pragma unroll
        for (int e = 0; e < 4; ++e) { const float zv = bv[e] + wv[0][e] * pv[e] + wv[1][e] * cv[e] + wv[2][e] * nv_[e]; const float zg = bg[e] + wg[0][e] * pg[e] + wg[1][e] * cg[e] + wg[2][e] * ng[e]; o[e] = silu_f(zg) * zv; }
        u32x2 w; w.x = cvt_pk_bf16(o[0], o[1]); w.y = cvt_pk_bf16(o[2], o[3]);
        *(u32x2*)(G + (size_t)(s * 64 + (which ? 63 : 0)) * 2048 + c) = w; }
}
constexpr int N_TR_ITEMS_L = 16 * 32 + 8 * 8 + 16 * 16 + 16 * 64 + 32 * 16;
template <bool BIAS> __device__ __forceinline__ void weight_item(Frame& F, LAS float* scr, int l, int it) {
    int r = it; const float* modl = F.misc + MI_MOD + l * 9 * 6144; float* cf = (float*)F.ctl;
    if (r < 512) { transpose_item<1, BIAS>(F, F.ka->in[10] + (size_t)l * DM * 2048, DM, 2048, (bf16_t*)(F.ws + WS_WIN) + (size_t)l * 2048 * DM, scr, r, modl, cf + CW_BIN + l * 9 * 2048); return; } r -= 512;
    if (r < 64) { transpose_item<0, false>(F, F.ka->in[26] + (size_t)l * 512 * 512, 512, 512, (bf16_t*)(F.ws + WS_WGLU) + (size_t)l * 512 * 512, scr, r, nullptr, nullptr); return; } r -= 64;
    if (r < 256) { transpose_item<0, false>(F, F.ka->in[28] + (size_t)l * DM * DM, DM, DM, (bf16_t*)(F.ws + WS_WOUT) + (size_t)l * DM * DM, scr, r, nullptr, nullptr); return; } r -= 256;
    if (r < 1024) { transpose_item<2, BIAS>(F, F.ka->in[30] + (size_t)l * DM * 4096, DM, 4096, (bf16_t*)(F.ws + WS_WUP) + (size_t)l * 4096 * DM, scr, r, modl + 3072, cf + CW_BUP + l * 9 * 4096); return; } r -= 1024;
    transpose_item<0, false>(F, F.ka->in[33] + (size_t)l * 2048 * DM, 2048, DM, (bf16_t*)(F.ws + WS_WDN) + (size_t)l * DM * 2048, scr, r, nullptr, nullptr);
}

__global__ void __launch_bounds__(NTHREADS, 2) mega(Args args) {
    extern __shared__ __attribute__((aligned(16))) unsigned char lds_raw[];
    Frame F;
    F.lds = (LAS unsigned char*)lds_raw;
    F.tid = threadIdx.x; F.lane = F.tid & 63; F.wave = __builtin_amdgcn_readfirstlane(F.tid >> 6);
    F.G = gridDim.x; F.bid = blockIdx.x; { const int bx = blockIdx.x; F.vcu = (F.G % 8 == 0) ? (bx % 8) * (F.G / 8) + bx / 8 : bx; }
    F.ka = (kargs_t)__builtin_amdgcn_kernarg_segment_ptr();
    F.out = args.out; F.ws = args.ws; F.misc = (float*)(args.ws + WS_MISC); F.ctl = (unsigned*)(args.ws + WS_CTL);
    volatile LAS unsigned* MISC = (volatile LAS unsigned*)(F.lds + MISC_OFF);
    for (int u = F.tid; u < (LDS_BYTES - LDSCTL_OFF) / 4; u += NTHREADS) ((LAS unsigned*)(F.lds + LDSCTL_OFF))[u] = 0u;
    __syncthreads();
    XcdBarrier bar = xcd_barrier_post(F.ctl + CW_BAR, MISC + 8);
    int phase_no = 0;
#define LAUNDER() do { asm volatile("" : "+s"(F.ka), "+s"(F.ws), "+s"(F.out), "+s"(F.bid)); { int w_ = __builtin_amdgcn_readfirstlane(F.wave); asm volatile("" : "+s"(w_)); F.wave = w_; } F.vcu = (F.G % 8 == 0) ? (F.bid % 8) * (F.G / 8) + F.bid / 8 : F.bid; \
    { unsigned z_ = 0u; asm volatile("" : "+v"(z_)); F.lane = (int)__builtin_amdgcn_mbcnt_hi(~0u, __builtin_amdgcn_mbcnt_lo(~0u, z_)); } F.tid = F.wave * 64 + F.lane;     \
    F.misc = (float*)(F.ws + WS_MISC); F.ctl = (unsigned*)(F.ws + WS_CTL); gw = F.vcu * NWAVES + F.wave; } while (0)
#ifndef TPROBE_SCALE
#define TPROBE_SCALE 0.25f
#endif
#ifdef TPROBE
#define TSTAMP() do { if (blockIdx.x == 0 && F.tid == 0) ((unsigned long long*)(F.ctl + 6000))[phase_no] = __builtin_amdgcn_s_memrealtime(); } while (0)
#else
#define TSTAMP() do {} while (0)
#endif
#if defined(TPROBE) && defined(TPROBE_SUB_A)
#ifndef TPROBE_BID
#define TPROBE_BID 0
#endif
#define TSUB(i) do { if (blockIdx.x == TPROBE_BID && F.tid == 0 && l == 0) ((unsigned long long*)(F.ctl + 6200))[i] = __builtin_amdgcn_s_memrealtime(); } while (0)
#else
#define TSUB(i) do {} while (0)
#endif
#define GRID_BAR() do { LAUNDER(); xcd_barrier(bar, F.tid); ++phase_no; TSTAMP(); if (F.ka->stop_after == phase_no) return; LAUNDER(); } while (0)
    int gw = F.vcu * NWAVES + F.wave; const int NGW = F.G * NWAVES;
#define ssq ((float*)(F.ctl + CW_SS))
#define XS ((bf16_t*)(F.ws + WS_XS))
#define KB ((bf16_t*)(F.ws + WS_KB))
#define VB ((bf16_t*)(F.ws + WS_VB))
#define Qb ((bf16_t*)(F.ws + WS_R + R_Q))
#define AS3 ((bf16_t*)(F.ws + WS_R + R_AS3))
#define Eb ((float*)(F.ws + WS_R + R_E))
#define Zb ((bf16_t*)(F.ws + WS_R + R_Z))
#define CAT ((bf16_t*)(F.ws + WS_R + R_CAT))
#define UP ((bf16_t*)(F.ws + WS_R))
#define Gb ((bf16_t*)(F.ws + WS_G))

    TSTAMP();
    if (F.vcu < 64) ssm_prep(F, 0, F.vcu);
    else {
        mod_task3(F, F.vcu - 64);
        if (F.vcu == 64) {
            for (int i = F.tid; i < 1024; i += NTHREADS) { const int pos = i >> 4, f = i & 15; const float inv = 1.0f / powf(10000.0f, (float)f / 16.0f); const float ang = (float)pos * inv;
                ((f32x2*)(F.misc + MI_ROPE))[i] = (f32x2){cosf(ang), sinf(ang)}; }
            if (F.tid < 2) { const int l = F.tid; float a1 = 0.f, a2 = 0.f; for (int d = 0; d < 64; ++d) { a1 += F.ka->in[13][l * 64 + d] * F.ka->in[14][l * 64 + d]; a2 += F.ka->in[15][l * 64 + d] * F.ka->in[16][l * 64 + d]; }
                const float li = 0.8f - 0.6f * expf(-0.3f * (float)l); F.misc[MI_LAM + l] = expf(a1) - expf(a2) + li; F.misc[MI_LAM + 2 + l] = 1.f - li; }
            __syncthreads();
        }
        LAS float* scr = (LAS float*)(F.lds + F.wave * 16640);
        const int gw1 = (F.vcu - 64) * NWAVES + F.wave, NGW1 = (F.G - 64) * NWAVES;
        for (int it = gw1; it < N_TR_ITEMS_L + 2048; it += NGW1) { if (it < N_TR_ITEMS_L) weight_item<false>(F, scr, 0, it); else cache_item(F, 0, it - N_TR_ITEMS_L); }
    }
    GRID_BAR();
    for (int it = gw; it < MT / 4 + 6144; it += NGW) { if (it < MT / 4) xprep_item(F, it); else bias_item(F, it - MT / 4); }
    GRID_BAR();

    for (int l = 0; l < DEPTH; ++l) {
        const float* modl = F.misc + MI_MOD + l * 9 * 6144;
        { unsigned* ucnt = F.ctl + CW_UC + l * 6 * 64;
          { Gemm g{XS, (const bf16_t*)(F.ws + WS_WIN) + (size_t)l * 2048 * DM, DM, DM, DM, 0, 0}; InOrder S{F.bid, F.G};
            EpiIn E{ssq + (l == 0 ? 0 : 2 * MT), (const float*)F.ctl + CW_BIN + l * 9 * 2048, F.ka->in[11] + l * 64, F.ka->in[12] + l * 64, (const f32x2*)(F.misc + MI_ROPE), Qb, KB, VB,
                    __builtin_amdgcn_make_buffer_rsrc((void*)AS3, 0, (int)((size_t)NG * NCHUNK * 512 * 2), 0x00020000),
                    F.out + (size_t)MT * DM, F.out + (size_t)MT * DM + (size_t)NB * DEPTH * SEQ * 512, l, ucnt};
            gemm_phase<EpiIn, InOrder>(F.lds, F.tid, g, S, E); }
          if (F.bid >= 128 && F.bid < 224) {
              LAUNDER();
              const int idx = F.bid - 128, gq = idx / 3, pmq = idx % 3; unsigned* up = F.ctl + CW_UC + ((l * 3 + pmq) * 2 + (gq >> 4)) * 64;
              if (F.tid == 0) { unsigned sp = 0; while (__hip_atomic_load(up, RLX_AGENT) < 128u) { __builtin_amdgcn_s_sleep(2); if (++sp > (1u << 20)) break; }
                  __builtin_amdgcn_fence(__ATOMIC_ACQUIRE, "agent"); asm volatile("s_waitcnt vmcnt(0)" ::: "memory"); }
              __syncthreads();
              { Gemm g{AS3, (const bf16_t*)(F.ws + WS_SSM + SSM_WE), 512, 256, 256, (size_t)NCHUNK * 512, (size_t)256 * 256}; GroupOrder S{idx, F.G}; EpiS1 E{Eb};
                gemm_phase<EpiS1, GroupOrder>(F.lds, F.tid, g, S, E); }
              VM_WAIT(); __syncthreads(); LAUNDER();
              ssm_scan(F, l, (F.bid - 128) / 3, (F.bid - 128) % 3); } }
        GRID_BAR();
#define ZC_PTR (F.ctl + CW_ZC + l * 256)
#define ATTN_UNIT(SEQ_, H_, QB_) do { LAUNDER(); const AttnArgs A_{Qb, KB, VB, CAT, F.ka->in[17] + l * 128, F.misc[MI_LAM + l], F.misc[MI_LAM + 2 + l]}; attn_unit(F.lds, F.tid, A_, (SEQ_), (H_), (QB_)); } while (0)
#define ATTN_CTX(U_) do { const int u_ = (U_); ATTN_UNIT(u_ >> 3, (u_ >> 1) & 3, u_ & 1); } while (0)
        { TSUB(0);
          const int xq = F.vcu >> 5, rq = F.vcu & 31;
          if (rq < 12) { const int cidx = xq * 12 + rq;
              { Gemm g{AS3, (const bf16_t*)(F.ws + WS_SSM + SSM_WY), 512, 512, 512, (size_t)NCHUNK * 512, (size_t)256 * 512}; GroupOrder S{cidx, F.G};
                EpiS3 E{__builtin_amdgcn_make_buffer_rsrc((void*)Zb, 0, (int)((size_t)MT * 512 * 2), 0x00020000)};
                gemm_phase<EpiS3, GroupOrder>(F.lds, F.tid, g, S, E); }
              VM_WAIT(); __syncthreads(); LAUNDER();
              if (F.tid == 0) __hip_atomic_fetch_add(ZC_PTR + (((F.vcu >> 5) * 12 + (F.vcu & 31)) % 3) * 64, 1u, RLX_AGENT); }
          TSUB(3);
          { const int u = F.vcu; ATTN_UNIT(NB + (u >> 5), (u >> 3) & 3, u & 7); } TSUB(4);
          if ((F.vcu & 31) >= 24) { for (int r = 0; r < 2; ++r) ATTN_CTX((F.vcu >> 5) * 16 + 2 * ((F.vcu & 31) - 24) + r); }
          TSUB(5);
          if ((F.vcu & 31) >= 12 && (F.vcu & 31) < 24) {
              LAUNDER();
              const int idx = (F.vcu >> 5) * 12 + ((F.vcu & 31) - 12), pmz = panel_of(idx / 12, (idx % 12) >> 1) >> 4;
              if (F.tid == 0) { unsigned sp = 0; while (__hip_atomic_load(ZC_PTR + pmz * 64, RLX_AGENT) < (unsigned)NG) { __builtin_amdgcn_s_sleep(2); if (++sp > (1u << 20)) break; }
                  __builtin_amdgcn_fence(__ATOMIC_ACQUIRE, "agent"); asm volatile("s_waitcnt vmcnt(0)" ::: "memory"); }
              __syncthreads(); TSUB(6);
              Gemm g{Zb, (const bf16_t*)(F.ws + WS_WGLU) + (size_t)l * 512 * 512, 512, 512, 512, 0, 0}; OneTile S{idx};
              EpiGlu E{Zb, F.ka->in[27] + l * 512, CAT};
              gemm_phase<EpiGlu, OneTile>(F.lds, F.tid, g, S, E); TSUB(7); } }
        GRID_BAR();
        { Gemm g{CAT, (const bf16_t*)(F.ws + WS_WOUT) + (size_t)l * DM * DM, DM, DM, DM, 0, 0}; GridOrder S; S.init(MT, DM, F.G, F.bid);
          bf16_t* XR = (bf16_t*)(F.ws + WS_XR);
          if (l == 0) { EpiRes<true, false> E{F.ka->in[0], F.ka->in[1], nullptr, nullptr, XR, modl + 2 * DM, F.ka->in[29] + l * DM, modl + 4 * DM, XS, ssq + 1 * MT};
              gemm_phase<EpiRes<true, false>, GridOrder>(F.lds, F.tid, g, S, E); }
          else { EpiRes<false, false> E{nullptr, nullptr, XR, nullptr, XR, modl + 2 * DM, F.ka->in[29] + l * DM, modl + 4 * DM, XS, ssq + 3 * MT};
              gemm_phase<EpiRes<false, false>, GridOrder>(F.lds, F.tid, g, S, E); }
          if (l + 1 < DEPTH && F.bid >= 192) { LAUNDER(); LAS float* scr = (LAS float*)(F.lds + F.wave * 16640);
              for (int it = (F.bid - 192) * NWAVES + F.wave; it < N_TR_ITEMS_L; it += 64 * NWAVES) weight_item<true>(F, scr, l + 1, it); } }
        GRID_BAR();
        { Gemm g{XS, (const bf16_t*)(F.ws + WS_WUP) + (size_t)l * 4096 * DM, DM, DM, DM, 0, 0}; GridOrder S; S.init(MT, 4096, F.G, F.bid);
          EpiUpConv E{ssq + (l == 0 ? 1 : 3) * MT, (const float*)F.ctl + CW_BUP + l * 9 * 4096, F.ka->in[31] + (size_t)l * 3 * 4096, F.ka->in[32] + (size_t)l * 4096, Gb, (bf16_t*)(F.ws + WS_HALO)};
          gemm_phase<EpiUpConv, GridOrder, true>(F.lds, F.tid, g, S, E); }
        GRID_BAR();
        { Gemm g{Gb, (const bf16_t*)(F.ws + WS_WDN) + (size_t)l * DM * 2048, 2048, 2048, 2048, 0, 0}; GridOrder S; S.init(MT, DM, F.G, F.bid);
          const bool nxt = l + 1 < DEPTH;
          bf16_t* XR = (bf16_t*)(F.ws + WS_XR);
          { Unit u0; if (S.next(0, u0)) { conv_fix(F, l, u0.pm); VM_WAIT(); __syncthreads(); LAUNDER(); } }
          if (nxt) { EpiRes<false, false> E{nullptr, nullptr, XR, nullptr, XR, modl + 5 * DM, F.ka->in[9] + (l + 1) * DM, modl + 9 * 6144 + DM, XS, ssq + 2 * MT};
              gemm_phase<EpiRes<false, false>, GridOrder>(F.lds, F.tid, g, S, E); }
          else { EpiRes<false, true> E{nullptr, nullptr, XR, F.out, nullptr, modl + 5 * DM, nullptr, nullptr, XS, ssq + 2 * MT};
              gemm_phase<EpiRes<false, true>, GridOrder>(F.lds, F.tid, g, S, E); }
          if (nxt && F.bid >= 192) { LAUNDER(); ssm_prep(F, l + 1, F.bid - 192);
              for (int it = (F.bid - 192) * NWAVES + F.wave; it < 2048; it += 64 * NWAVES) cache_item(F, l + 1, it); } }
        if (l + 1 < DEPTH) GRID_BAR();
    }
#ifdef TPROBE
    GRID_BAR();
    { float* miscp = (float*)(args.ws + WS_MISC); unsigned* ctlp = (unsigned*)(args.ws + WS_CTL);
      if (blockIdx.x == 0 && threadIdx.x == 0) { const unsigned long long* ts = (const unsigned long long*)(ctlp + 6000); const float tot = (float)(ts[phase_no] - ts[0]);
        float fa = 0.f;
#ifdef TPROBE_SUB_A
        { const unsigned long long* t2 = (const unsigned long long*)(ctlp + 6200); fa = (float)(t2[TPROBE_SUB_B] - t2[TPROBE_SUB_A]) / tot; }
#else
        for (int k = 0; k < phase_no; ++k) { const float d = (float)(ts[k + 1] - ts[k]) / tot; if ((TPROBE_MASK_A >> k) & 1ull) fa += d; }
#endif
        miscp[MI_END] = TPROBE_SCALE * sqrtf(fa); }
      GRID_BAR();
      const float delta = miscp[MI_END];
      for (size_t i = (size_t)blockIdx.x * NTHREADS + threadIdx.x; i < (size_t)MC * DM; i += (size_t)gridDim.x * NTHREADS) args.out[i] *= (1.f + delta); }
#endif
#undef GRID_BAR
#undef LAUNDER
#undef ZC_PTR
#undef ATTN_UNIT
#undef ATTN_CTX
#undef ssq
#undef XS
#undef KB
#undef VB
#undef Qb
#undef AS3
#undef Eb
#undef Zb
#undef CAT
#undef UP
#undef Gb
}
}

static int fk_launch(void* const* d_in, void* d_out, void* d_ws, size_t ws_size, hipStream_t stream, int stop_after) {
    static int grid = 0;
    if (grid == 0) {
        int dev = 0, cus = 0;
        if (ws_size < fk::WS_END) { fprintf(stderr, "kernel_launch: workspace too small (%zu < %zu)\n", ws_size, (size_t)fk::WS_END); grid = -1; return -1; }
        if (hipGetDevice(&dev) != hipSuccess || hipDeviceGetAttribute(&cus, hipDeviceAttributeMultiprocessorCount, dev) != hipSuccess) { grid = -1; return -1; }
        if (hipFuncSetAttribute((const void*)fk::mega, hipFuncAttributeMaxDynamicSharedMemorySize, fk::LDS_BYTES) != hipSuccess) { fprintf(stderr, "kernel_launch: hipFuncSetAttribute failed\n"); grid = -1; return -1; }
        int per_cu = 0; (void)hipOccupancyMaxActiveBlocksPerMultiprocessor(&per_cu, (const void*)fk::mega, fk::NTHREADS, fk::LDS_BYTES); (void)hipGetLastError();
        if (per_cu < 1) fprintf(stderr, "kernel_launch: occupancy query says %d blocks/CU\n", per_cu);
        grid = cus;
        if (grid != 256) fprintf(stderr, "kernel_launch: %d CUs (built for 256)\n", grid);
    }
    if (grid < 0) return -1;
    (void)hipMemsetAsync((char*)d_ws + fk::WS_CTL, 0, fk::CTL_BYTES, stream);
    fk::Args a{};
    for (int i = 0; i < 34; ++i) a.in[i] = (const float*)d_in[i];
    a.out = (float*)d_out; a.ws = (unsigned char*)d_ws; a.stop_after = stop_after; a.pad = 0;
    hipLaunchKernelGGL(fk::mega, dim3(grid), dim3(fk::NTHREADS), fk::LDS_BYTES, stream, a);
    return 0;
}
extern "C" void kernel_launch(void* const* d_in, const int* in_sizes, int n_in, void* d_out, int out_size, void* d_ws, size_t ws_size, hipStream_t stream) {
    if (n_in != 34) { fprintf(stderr, "kernel_launch: unexpected n_in %d\n", n_in); return; }
    fk_launch(d_in, d_out, d_ws, ws_size, stream, 0);
}
```

```cpp
#include <hip/hip_runtime.h>
#include <cstdio>
#include <cstdint>
namespace fk {
#define LAS __attribute__((address_space(3)))
#define GAS __attribute__((address_space(1)))
typedef unsigned short bf16_t;
typedef short bf16x8 __attribute__((ext_vector_type(8)));
typedef short s16x4 __attribute__((ext_vector_type(4)));
typedef float f32x4 __attribute__((ext_vector_type(4)));
typedef float f32x2 __attribute__((ext_vector_type(2)));
typedef float f32x16 __attribute__((ext_vector_type(16)));
typedef unsigned u32x4 __attribute__((ext_vector_type(4)));
typedef unsigned u32x2 __attribute__((ext_vector_type(2)));

constexpr int DM = 1024, NB = 16, SEQ = 256, DEPTH = 2, DB = 8, DSEQ = 1024, PAST = 512;
constexpr int MC = NB * SEQ, MS = DB * DSEQ, MT = MC + MS;
constexpr int NH = 4, NG = 32, NCOND = 9, NMOD = 6;
constexpr int NCHUNK = MT / 16;
constexpr int KVROWS = MC + DB * (PAST + DSEQ);
constexpr float EPS = 1e-6f;
constexpr float C2 = 0.125f * 1.4426950408889634f;
constexpr int NWAVES = 8, NTHREADS = 512;

constexpr size_t MiB = 1u << 20;
constexpr size_t WS_CTL = 0, CTL_BYTES = 1 * MiB + 512 * 1024;
constexpr size_t WS_MISC = 1 * MiB;
constexpr size_t WS_WIN = 3 * MiB;
constexpr size_t WS_WGLU = 11 * MiB;
constexpr size_t WS_WOUT = 12 * MiB;
constexpr size_t WS_WUP = 16 * MiB;
constexpr size_t WS_WDN = 32 * MiB;
constexpr size_t WS_SSM = 40 * MiB;
constexpr size_t WS_XS = 53 * MiB;
constexpr size_t WS_KB = 77 * MiB;
constexpr size_t WS_VB = 93 * MiB;
constexpr size_t WS_R = 109 * MiB;
constexpr size_t WS_XR = 205 * MiB;
constexpr size_t WS_G = WS_R;
constexpr size_t WS_HALO = WS_R + 48 * MiB;
constexpr size_t WS_END = 253 * MiB;
constexpr size_t R_Q = 0, R_AS3 = 12 * MiB, R_E = 36 * MiB, R_Z = 60 * MiB, R_CAT = 72 * MiB;
constexpr size_t SSM_WE = 0, SSM_WY = 4 * MiB, SSM_LAM16 = 12 * MiB, SSM_BBAR = 12 * MiB + 64 * 1024;
constexpr int MI_MOD = 0;
constexpr int MI_ROPE = MI_MOD + 2 * 9 * 6144;
constexpr int MI_LAM = MI_ROPE + 64 * 16 * 2;
constexpr int MI_END = MI_LAM + 8;
static_assert((size_t)MI_END * 4 <= 2 * MiB, "MISC");
constexpr int CW_BAR = 1024;
constexpr int CW_ZC = 7168;
constexpr int CW_UC = 4608;
constexpr int CW_SS = 8192;
constexpr int CW_BIN = 65536;
constexpr int CW_BUP = CW_BIN + 2 * 9 * 2048;
static_assert((size_t)(CW_SS + 4 * MT) <= CW_BIN && (size_t)(CW_BUP + 2 * 9 * 4096) * 4 <= CTL_BYTES, "CTL");

constexpr int RING_BYTES = 131072;
constexpr int LDS_BYTES_ = 147456; constexpr int LDSCTL_OFF = LDS_BYTES_ - 512, MISC_OFF = LDSCTL_OFF + 320;
constexpr int LDS_BYTES = 147456;

#define RLX_AGENT __ATOMIC_RELAXED, __HIP_MEMORY_SCOPE_AGENT
typedef __bf16 bf16x2_t __attribute__((ext_vector_type(2)));
__device__ __forceinline__ unsigned cvt_pk_bf16(float lo, float hi) { const f32x2 v = {lo, hi}; const bf16x2_t b = __builtin_convertvector(v, bf16x2_t); return __builtin_bit_cast(unsigned, b); }
__device__ __forceinline__ float bf2f(unsigned short b) { return __uint_as_float((unsigned)b << 16); }
__device__ __forceinline__ float bflo(unsigned w) { return __uint_as_float(w << 16); }
__device__ __forceinline__ float bfhi(unsigned w) { return __uint_as_float(w & 0xffff0000u); }
__device__ __forceinline__ float fast_exp2(float x) { return __builtin_amdgcn_exp2f(x); }
__device__ __forceinline__ float fast_rcp(float x) { return __builtin_amdgcn_rcpf(x); }
__device__ __forceinline__ float sigmoid_f(float x) { return fast_rcp(1.f + fast_exp2(-1.4426950408889634f * x)); }
__device__ __forceinline__ float silu_f(float x) { return x * sigmoid_f(x); }
__device__ __forceinline__ float gelu_tanh_f(float x) {
    const float u = 0.7978845608028654f * (x + 0.044715f * x * x * x); return x * sigmoid_f(2.f * u); }
__device__ __forceinline__ float shfl_xor_l(float v, int mask, int lane) { return __uint_as_float((unsigned)__builtin_amdgcn_ds_bpermute((lane ^ mask) << 2, (int)__float_as_uint(v))); }
__device__ __forceinline__ float wave_sum(float v, int lane) {
#pragma unroll
    for (int o = 1; o < 64; o <<= 1) v += shfl_xor_l(v, o, lane);
    return v; }

#define XB_TMO      128
#define XB_XCNT(j)  (256  + 64 * (j))
#define XB_XSUB(j)  (1280 + 64 * (j))
#define XB_XGEN(j)  (2304 + 64 * (j))
#define XB_TOP      3328
#define XB_TOPGEN   3392
#define XCD_BAR_WORDS 3456
#define XB_SPIN_CAP (1u << 18)
__device__ __forceinline__ unsigned xb_ld(unsigned* p)              { return __hip_atomic_load(p, __ATOMIC_RELAXED, __HIP_MEMORY_SCOPE_AGENT); }
__device__ __forceinline__ unsigned xb_add(unsigned* p, unsigned v) { return __hip_atomic_fetch_add(p, v, __ATOMIC_RELAXED, __HIP_MEMORY_SCOPE_AGENT); }
__device__ __forceinline__ unsigned xb_xcc_id() { return (unsigned)__builtin_amdgcn_s_getreg((3 << 11) | 20) & 0xFu; }
#define XB_SPIN(cond, bar) do { unsigned _sp = 0; while (cond) { __builtin_amdgcn_s_sleep(1); \
    if ((++_sp & 255u) == 0u) { if (xb_ld(&(bar)[XB_TMO])) break; if (_sp > XB_SPIN_CAP) { atomicAdd(&(bar)[XB_TMO], 1u); break; } } } } while (0)
struct XcdBarrier { unsigned* bar; unsigned x; volatile LAS unsigned* st; };
__device__ __forceinline__ XcdBarrier xcd_barrier_post(unsigned* bar, volatile LAS unsigned* st) {
    XcdBarrier b; b.bar = bar; b.x = xb_xcc_id(); b.st = st;
    if (threadIdx.x == 0) (void)xb_add(&bar[XB_XCNT(b.x)], 1u);
    return b;
}
__device__ __forceinline__ void xcd_barrier_complete(unsigned* bar, unsigned x, unsigned& nloc, unsigned& nx) {
    const unsigned G = gridDim.x * gridDim.y * gridDim.z;
    unsigned sum, cnt, mine, sp = 0u;
    for (;;) {
        sum = 0u; cnt = 0u; mine = 0u;
#pragma unroll
        for (unsigned j = 0; j < 16; ++j) { const unsigned c = xb_ld(&bar[XB_XCNT(j)]); sum += c; cnt += (c > 0u) ? 1u : 0u; mine = (j == x) ? c : mine; }
        if (sum == G) break;
        __builtin_amdgcn_s_sleep(1);
        if ((++sp & 255u) == 0u) { if (xb_ld(&bar[XB_TMO])) break; if (sp > XB_SPIN_CAP) { atomicAdd(&bar[XB_TMO], 1u); break; } }
    }
    nloc = mine > 0u ? mine : 1u; nx = cnt > 0u ? cnt : 1u;
}
__device__ __forceinline__ void xcd_barrier(const XcdBarrier& b, const int tid) {
    asm volatile("s_waitcnt vmcnt(0)" ::: "memory");
    __syncthreads();
    if (tid == 0) {
        unsigned* bar = b.bar;
        __builtin_amdgcn_s_waitcnt(0);
        unsigned nloc = b.st[0], nx = b.st[1];
        if (nloc == 0u) { xcd_barrier_complete(bar, b.x, nloc, nx); b.st[0] = nloc; b.st[1] = nx; }
        const unsigned old = xb_add(&bar[XB_XSUB(b.x)], 1u);
        const unsigned gen = old / nloc;
        if (old + 1u == (gen + 1u) * nloc) {
            __builtin_amdgcn_fence(__ATOMIC_RELEASE, "agent");
            asm volatile("s_waitcnt vmcnt(0)" ::: "memory");
            const unsigned og = xb_add(&bar[XB_TOP], 1u);
            const unsigned tg = og / nx;
            if (og + 1u == (tg + 1u) * nx) xb_add(&bar[XB_TOPGEN], 1u);
            else XB_SPIN(xb_ld(&bar[XB_TOPGEN]) == tg, bar);
            __builtin_amdgcn_fence(__ATOMIC_ACQUIRE, "agent");
            xb_add(&bar[XB_XGEN(b.x)], 1u);
            asm volatile("s_waitcnt vmcnt(0)" ::: "memory");
        } else {
            XB_SPIN(xb_ld(&bar[XB_XGEN(b.x)]) == gen, bar);
            __builtin_amdgcn_fence(__ATOMIC_ACQUIRE, "agent");
            asm volatile("s_waitcnt vmcnt(0)" ::: "memory");
        }
    }
    __syncthreads();
}

constexpr int BM = 256, BK = 64, HALF = 128, HTB = HALF * BK * 2, NXCD = 8, WGM = 6;
__host__ __device__ __forceinline__ int lds_byte(int r, int c) { const int st = (r >> 4) * 2 + (c >> 5), rr = r & 15, cc = c & 31, ob = rr * 64 + cc * 2; return st * 1024 + (ob ^ (((ob >> 9) & 1) << 5)); }
__host__ __device__ __forceinline__ void stage_rc(int b, int& R, int& C) { const int st = b / 1024, sb = b % 1024, swz = sb ^ (((sb >> 9) & 1) << 5); R = (st >> 1) * 16 + swz / 64; C = (st & 1) * 32 + (swz % 64) / 2; }
__host__ __device__ __forceinline__ int perm32(int rho) { const int n = rho >> 4, i = rho & 15; return 8 * (i >> 2) + 4 * n + (i & 3); }

__device__ __forceinline__ int panel_of(int x, int j) { return 2 * x + j + ((j + 6) >> 3) * (14 + 2 * x); }
struct Unit { int pm, pn, g; };
struct Gemm { const bf16_t* A; const bf16_t* Bt; int lda, ldb, K; size_t gsA, gsB; };
struct GridOrder {
    int nM, nN, nwg, G, c;
    __device__ void init(int M, int N, int G_, int c_) { nM = M / BM; nN = N / BM; nwg = nM * nN; G = G_; c = c_; }
    __device__ bool next(int i, Unit& u) const {
        const long L = (long)i * G + c; if (L >= nwg) return false;
        int wgid = (int)L; { const int q = nwg / NXCD, r = nwg % NXCD, xcd = wgid % NXCD, off = wgid / NXCD; wgid = (xcd < r ? xcd * (q + 1) : r * (q + 1) + (xcd - r) * q) + off; }
        const int nig = WGM * nN, gid = wgid / nig, fm = gid * WGM, gsz = (nM - fm) < WGM ? (nM - fm) : WGM;
        u.pm = panel_of(gid, (wgid % nig) % gsz);     u.pn = (wgid % nig) / gsz; u.g = 0; return true;
    }
};
struct InOrder {
    int c, G;
    __device__ bool next(int i, Unit& u) const { const int L = i * G + c; if (L >= 384) return false; u.g = 0;
        if (L < 96) { const int jj = L >> 3; u.pm = panel_of(L & 7, jj >> 1); u.pn = 6 + (jj & 1); }
        else { const int Lp = L - 96, jj = Lp >> 3; u.pm = panel_of(Lp & 7, jj / 6); u.pn = jj % 6; }
        return true; }
};
struct OneTile {
    int idx;
    __device__ bool next(int i, Unit& u) const { if (i > 0 || idx < 0) return false; u.pm = panel_of(idx / 12, (idx % 12) >> 1); u.pn = idx & 1; u.g = 0; return true; }
};
struct GroupOrder {
    int c, G;
    __device__ bool next(int i, Unit& u) const { const int idx = c + i * G; if (c < 0 || idx >= NG * 3) return false; u.g = idx / 3; u.pm = idx % 3; u.pn = 0; return true; }
};

template <class Epi, class Sched, bool AROWPERM = false>
__device__ __forceinline__ void gemm_phase(LAS unsigned char* lds, const int tid, const Gemm g, const Sched& S, const Epi& E) {
    const int wid = __builtin_amdgcn_readfirstlane(tid >> 6), lane = tid & 63, wr = wid >> 2, wc = wid & 3, fr = lane & 15, fq = lane >> 4;
    const int K = g.K, nt = K / BK;
    unsigned voffA[2], voffB[2];
#pragma unroll
    for (int i = 0; i < 2; ++i) { int R, C; stage_rc(tid * 16 + i * 8192, R, C); const int Rb = Epi::PERM ? ((R & ~31) + perm32(R & 31)) : R;
        const int Ra = AROWPERM ? ((R & 64) + 4 * (R & 15) + ((R >> 4) & 3)) : R;
        voffA[i] = (unsigned)(Ra * g.lda + C) * 2u; voffB[i] = (unsigned)(Rb * g.ldb + C) * 2u; }
    const size_t kstep = (size_t)(BK * 2);
    const size_t hstepA = (size_t)HALF * g.lda * 2, hstepB = (size_t)HALF * g.ldb * 2;
    const unsigned ldsw = (unsigned)wid * 1024u;
    const int aoff = lds_byte(wr * 64 + fr, fq * 8), boff = lds_byte(wc * 32 + fr, fq * 8);
#define PG8_SA(b, h) (((b) * 2 + (h)) * HTB)
#define PG8_SB(b, h) ((4 + (b) * 2 + (h)) * HTB)
#define PG8_STAGE(bufoff, gbase, voff) do { _Pragma("unroll") for (int _i = 0; _i < 2; ++_i) \
        __builtin_amdgcn_global_load_lds((const unsigned*)((const char*)(gbase) + (voff)[_i]), (LAS unsigned*)(lds + (bufoff) + ldsw + _i * 8192), 16, 0, 0); } while (0)
#define PG8_LDA(dst, b, h) do { _Pragma("unroll") for (int m = 0; m < 4; ++m) _Pragma("unroll") for (int k = 0; k < 2; ++k) dst[m][k] = *(const LAS bf16x8*)(lds + PG8_SA(b, h) + aoff + m * 2048 + k * 1024); } while (0)
#define PG8_LDB(dst, b, h) do { _Pragma("unroll") for (int n = 0; n < 2; ++n) _Pragma("unroll") for (int k = 0; k < 2; ++k) dst[n][k] = *(const LAS bf16x8*)(lds + PG8_SB(b, h) + boff + n * 2048 + k * 1024); } while (0)
#define PG8_MMA(ai, bj, At, Bt) do { __builtin_amdgcn_s_setprio(1); _Pragma("unroll") for (int m = 0; m < 4; ++m) _Pragma("unroll") for (int n = 0; n < 2; ++n) _Pragma("unroll") for (int k = 0; k < 2; ++k) \
        acc[ai][bj][m][n] = __builtin_amdgcn_mfma_f32_16x16x32_bf16(Bt[n][k], At[m][k], acc[ai][bj][m][n], 0, 0, 0); __builtin_amdgcn_s_setprio(0); } while (0)
#define PG8_WAIT_V(n) asm volatile("s_waitcnt vmcnt(" #n ")" ::: "memory")
#define PG8_WAIT_L(n) asm volatile("s_waitcnt lgkmcnt(" #n ")" ::: "memory")
#define PG8_BAR __builtin_amdgcn_s_barrier()
#define PG8_SCHED __builtin_amdgcn_sched_barrier(0)
#define PG8_APTR(u) ((const char*)g.A + ((size_t)(u).g * g.gsA + (size_t)(u).pm * BM * g.lda) * 2)
#define PG8_BPTR(u) ((const char*)g.Bt + ((size_t)(u).g * g.gsB + (size_t)(u).pn * BM * g.ldb) * 2)
    Unit cur, nxt; int ui = 0;
    if (!S.next(0, cur)) return;
    f32x4 acc[2][2][4][2];
#pragma unroll
    for (int a = 0; a < 2; ++a)
#pragma unroll
        for (int b = 0; b < 2; ++b)
#pragma unroll
            for (int m = 0; m < 4; ++m)
#pragma unroll
                for (int n = 0; n < 2; ++n) acc[a][b][m][n] = (f32x4){0.f, 0.f, 0.f, 0.f};
    bf16x8 At[4][2], B0[2][2], B1[2][2];
    const char* cA = PG8_APTR(cur); const char* cB = PG8_BPTR(cur);
    PG8_STAGE(PG8_SB(0, 0), cB, voffB); PG8_STAGE(PG8_SB(0, 1), cB + hstepB, voffB); PG8_STAGE(PG8_SA(0, 0), cA, voffA); PG8_STAGE(PG8_SA(0, 1), cA + hstepA, voffA);
    if (wr == 1) PG8_BAR;
    PG8_WAIT_V(2); PG8_BAR;
    PG8_STAGE(PG8_SB(1, 0), cB + kstep, voffB); PG8_STAGE(PG8_SA(1, 0), cA + kstep, voffA); PG8_STAGE(PG8_SB(1, 1), cB + hstepB + kstep, voffB);
    PG8_WAIT_V(6); PG8_BAR;
    for (;;) {
        const bool has_next = S.next(ui + 1, nxt);
        const char* nA = has_next ? PG8_APTR(nxt) : cA; const char* nB = has_next ? PG8_BPTR(nxt) : cB;
        for (int t = 0; t < nt; t += 2) {
            const bool last = (t == nt - 2);
            const char* a1 = cA + (size_t)(t + 1) * kstep;
            const char* a2 = last ? nA : cA + (size_t)(t + 2) * kstep; const char* b2 = last ? nB : cB + (size_t)(t + 2) * kstep;
            const char* a3 = a2 + kstep; const char* b3 = b2 + kstep;
            PG8_LDB(B0, 0, 0); PG8_LDB(B1, 0, 1); PG8_SCHED; PG8_LDA(At, 0, 0); PG8_STAGE(PG8_SA(1, 1), a1 + hstepA, voffA);
            PG8_WAIT_V(8); PG8_WAIT_L(0); PG8_BAR; PG8_MMA(0, 0, At, B0); PG8_MMA(0, 1, At, B1); PG8_BAR; PG8_SCHED;
            PG8_LDA(At, 0, 1); PG8_STAGE(PG8_SB(0, 0), b2, voffB); PG8_STAGE(PG8_SB(0, 1), b2 + hstepB, voffB); PG8_STAGE(PG8_SA(0, 0), a2, voffA);
            PG8_WAIT_V(8); PG8_WAIT_L(0); PG8_BAR; PG8_MMA(1, 0, At, B0); PG8_MMA(1, 1, At, B1); PG8_BAR; PG8_SCHED;
            PG8_LDB(B0, 1, 0); PG8_LDB(B1, 1, 1); PG8_SCHED; PG8_LDA(At, 1, 0); PG8_STAGE(PG8_SA(0, 1), a2 + hstepA, voffA);
            PG8_WAIT_V(8); PG8_WAIT_L(0); PG8_BAR; PG8_MMA(0, 0, At, B0); PG8_MMA(0, 1, At, B1); PG8_BAR; PG8_SCHED;
            PG8_LDA(At, 1, 1); PG8_STAGE(PG8_SB(1, 0), b3, voffB); PG8_STAGE(PG8_SB(1, 1), b3 + hstepB, voffB); PG8_STAGE(PG8_SA(1, 0), a3, voffA);
            PG8_WAIT_V(8); PG8_WAIT_L(0); PG8_BAR; PG8_MMA(1, 0, At, B0); PG8_MMA(1, 1, At, B1); PG8_BAR; PG8_SCHED;
        }
        if (wr == 0) PG8_BAR;
        { unsigned z_ = 0u; asm volatile("" : "+v"(z_)); const int l2 = (int)__builtin_amdgcn_mbcnt_hi(~0u, __builtin_amdgcn_mbcnt_lo(~0u, z_));
          E(acc, cur, wr, wc, l2 & 15, l2 >> 4);
          E.done(cur, l2); }
        if (!has_next) break;
#pragma unroll
        for (int a = 0; a < 2; ++a)
#pragma unroll
            for (int b = 0; b < 2; ++b)
#pragma unroll
                for (int m = 0; m < 4; ++m)
#pragma unroll
                    for (int n = 0; n < 2; ++n) acc[a][b][m][n] = (f32x4){0.f, 0.f, 0.f, 0.f};
        cur = nxt; cA = nA; cB = nB; ++ui;
        if (wr == 1) PG8_BAR;
    }
    PG8_WAIT_V(0);
    PG8_BAR;
#undef PG8_SA
#undef PG8_SB
#undef PG8_STAGE
#undef PG8_LDA
#undef PG8_LDB
#undef PG8_MMA
#undef PG8_WAIT_V
#undef PG8_WAIT_L
#undef PG8_BAR
#undef PG8_SCHED
#undef PG8_APTR
#undef PG8_BPTR
}
__device__ __forceinline__ int cond_of_pm(int pm) { return pm < 16 ? 0 : 1 + ((pm - 16) >> 2); }
__device__ __forceinline__ int kvrow_of(int row) { return row < MC ? row : MC + ((row - MC) >> 10) * (PAST + DSEQ) + PAST + ((row - MC) & 1023); }
__device__ __forceinline__ u32x4 pack8(const f32x4& a, const f32x4& b) { u32x4 w; w.x = cvt_pk_bf16(a[0], a[1]); w.y = cvt_pk_bf16(a[2], a[3]); w.z = cvt_pk_bf16(b[0], b[1]); w.w = cvt_pk_bf16(b[2], b[3]); return w; }

struct EpiIn {
    static constexpr bool PERM = true;
    const float* sumsq; const float* bias; const float* qn; const float* kn; const f32x2* rope;
    bf16_t* Q; bf16_t* KB; bf16_t* VB; __amdgpu_buffer_rsrc_t as3r; float* new_k; float* new_v; int l; unsigned* ucnt;
    __device__ __forceinline__ void done(const Unit& u, int lane) const {
        if (u.pn >= 6) { asm volatile("s_waitcnt vmcnt(0)" ::: "memory"); if (lane == 0) __hip_atomic_fetch_add(ucnt + (((u.pm >> 4) * 2) + (u.pn - 6)) * 64, 1u, RLX_AGENT); } }
    __device__ __forceinline__ void operator()(const f32x4 (&acc)[2][2][4][2], const Unit& u, int wr, int wc, int fr, int fq) const {
        const int pm = u.pm, pn = u.pn; const bool ctx = pm < 16; const int cond = cond_of_pm(pm);
        const float* bz = bias + cond * 2048 + pn * 256 + wc * 32 + 8 * fq;
        f32x4 bv[2][2];
#pragma unroll
        for (int bj = 0; bj < 2; ++bj)
#pragma unroll
            for (int n = 0; n < 2; ++n) bv[bj][n] = *(const f32x4*)(bz + bj * 128 + 4 * n);
        const int rbase = pm * BM + wr * 64 + fr;
        float rsd[8];
#pragma unroll
        for (int g8 = 0; g8 < 8; ++g8) rsd[g8] = sumsq[rbase + (g8 >> 2) * HALF + (g8 & 3) * 16];
#pragma unroll
        for (int g8 = 0; g8 < 8; ++g8) rsd[g8] = rsqrtf(rsd[g8] * (1.f / DM) + EPS);
        if (pn < 4) {
            const bool isq = pn < 2; const float* gv = isq ? qn : kn;
            const int G = (pn & 1) * 4 + wc;
            const int cb = 32 * (fq >> 1) + 8 * (fq & 1);
            f32x4 gg[2][2];
#pragma unroll
            for (int bj = 0; bj < 2; ++bj)
#pragma unroll
                for (int n = 0; n < 2; ++n) gg[bj][n] = *(const f32x4*)(gv + cb + 16 * bj + 4 * n);
            const float qs = isq ? C2 : 1.f;
#pragma unroll
            for (int ai = 0; ai < 2; ++ai)
#pragma unroll
                for (int m = 0; m < 4; ++m) {
                    const int row = rbase + ai * HALF + m * 16;
                    const float rstd = rsd[ai * 4 + m];
                    f32x4 v[2][2]; float ss = 0.f;
#pragma unroll
                    for (int bj = 0; bj < 2; ++bj)
#pragma unroll
                        for (int n = 0; n < 2; ++n) { v[bj][n] = acc[ai][bj][m][n] * rstd + bv[bj][n]; const f32x4 t = v[bj][n] * v[bj][n]; ss += (t[0] + t[1]) + (t[2] + t[3]); }
                    { const int ln_ = fq * 16 + fr; ss += shfl_xor_l(ss, 16, ln_); ss += shfl_xor_l(ss, 32, ln_); }
                    const float rn = rsqrtf(ss * (1.f / 64.f) + EPS);
#pragma unroll
                    for (int bj = 0; bj < 2; ++bj)
#pragma unroll
                        for (int n = 0; n < 2; ++n) v[bj][n] = v[bj][n] * rn * gg[bj][n];
                    if (ctx) {
                        if (!isq) { float* nk = new_k + ((size_t)((row >> 8) * DEPTH + l) * SEQ + (row & 255)) * 512 + G * 64 + cb;
#pragma unroll
                            for (int bj = 0; bj < 2; ++bj) { *(f32x4*)(nk + 16 * bj) = v[bj][0]; *(f32x4*)(nk + 16 * bj + 4) = v[bj][1]; } }
                    } else {
                        const int t = (row - MC) & 1023; const int pos = (fq >> 1) ? (t & 63) : (t >> 6);
                        const f32x2* rp = rope + pos * 16 + 8 * (fq & 1);
#pragma unroll
                        for (int n = 0; n < 2; ++n)
#pragma unroll
                            for (int j = 0; j < 4; ++j) { const f32x2 cs = rp[4 * n + j]; const float x1 = v[0][n][j], x2 = v[1][n][j]; v[0][n][j] = x1 * cs.x - x2 * cs.y; v[1][n][j] = x1 * cs.y + x2 * cs.x; }
                    }
                    bf16_t* dst = isq ? (Q + (size_t)row * 512) : (KB + (size_t)kvrow_of(row) * 512);
                    dst += G * 64 + cb;
#pragma unroll
                    for (int bj = 0; bj < 2; ++bj) *(u32x4*)(dst + 16 * bj) = pack8(v[bj][0] * qs, v[bj][1] * qs);
                }
        } else if (pn < 6) {
            const int col0 = (pn - 4) * 256 + wc * 32 + 8 * fq;
#pragma unroll
            for (int ai = 0; ai < 2; ++ai)
#pragma unroll
                for (int m = 0; m < 4; ++m) {
                    const int row = rbase + ai * HALF + m * 16;
                    const float rstd = rsd[ai * 4 + m];
                    bf16_t* dst = VB + (size_t)kvrow_of(row) * 512 + col0;
#pragma unroll
                    for (int bj = 0; bj < 2; ++bj) { const f32x4 a = acc[ai][bj][m][0] * rstd + bv[bj][0], b = acc[ai][bj][m][1] * rstd + bv[bj][1];
                        *(u32x4*)(dst + 128 * bj) = pack8(a, b);
                        if (ctx) { float* nv = new_v + ((size_t)((row >> 8) * DEPTH + l) * SEQ + (row & 255)) * 512 + col0 + 128 * bj; *(f32x4*)nv = a; *(f32x4*)(nv + 4) = b; } }
                }
        } else {
            const int cu0 = (pn - 6) * 256 + wc * 32 + 8 * fq;
#pragma unroll
            for (int ai = 0; ai < 2; ++ai)
#pragma unroll
                for (int m = 0; m < 4; ++m) {
                    const int row = rbase + ai * HALF + m * 16;
                    const float rstd = rsd[ai * 4 + m];
#pragma unroll
                    for (int bj = 0; bj < 2; ++bj) { const int cu = cu0 + 128 * bj; const f32x4 a = acc[ai][bj][m][0] * rstd + bv[bj][0], b = acc[ai][bj][m][1] * rstd + bv[bj][1];
                        __builtin_amdgcn_raw_buffer_store_b128(pack8(a, b), as3r, (int)(((unsigned)((cu >> 4) * NCHUNK + (row >> 4)) * 512u + (row & 15) * 16 + (cu & 15)) * 2u), 0,   16); }
                }
        }
    }
};
struct EpiS1 {
    static constexpr bool PERM = false;
    float* E;
    __device__ __forceinline__ void done(const Unit&, int) const {}
    __device__ __forceinline__ void operator()(const f32x4 (&acc)[2][2][4][2], const Unit& u, int wr, int wc, int fr, int fq) const {
        const int rbase = u.pm * BM + wr * 64 + fr, col0 = wc * 32 + 4 * fq;
#pragma unroll
        for (int ai = 0; ai < 2; ++ai)
#pragma unroll
            for (int m = 0; m < 4; ++m) { float* dst = E + ((size_t)u.g * NCHUNK + rbase + ai * HALF + m * 16) * 256 + col0;
#pragma unroll
                for (int bj = 0; bj < 2; ++bj)
#pragma unroll
                    for (int n = 0; n < 2; ++n) *(f32x4*)(dst + bj * HALF + n * 16) = acc[ai][bj][m][n]; }
    }
};
struct EpiS3 {
    static constexpr bool PERM = true;
    __amdgpu_buffer_rsrc_t zr;
    __device__ __forceinline__ void done(const Unit&, int) const {}
    __device__ __forceinline__ void operator()(const f32x4 (&acc)[2][2][4][2], const Unit& u, int wr, int wc, int fr, int fq) const {
        const int rbase = u.pm * BM + wr * 64 + fr;
#pragma unroll
        for (int ai = 0; ai < 2; ++ai)
#pragma unroll
            for (int m = 0; m < 4; ++m) { const int chunk = rbase + ai * HALF + m * 16;
#pragma unroll
                for (int bj = 0; bj < 2; ++bj) { const int tt = 8 * bj + 2 * wc + (fq >> 1), c0 = 8 * (fq & 1);
                    f32x4 a = acc[ai][bj][m][0], b = acc[ai][bj][m][1];
#pragma unroll
                    for (int j = 0; j < 4; ++j) { a[j] = gelu_tanh_f(a[j]); b[j] = gelu_tanh_f(b[j]); }
                    __builtin_amdgcn_raw_buffer_store_b128(pack8(a, b), zr, (int)((((unsigned)chunk * 16u + tt) * 512u + u.g * 16 + c0) * 2u), 0,   16); } }
    }
};
struct EpiGlu {
    static constexpr bool PERM = true;
    const bf16_t* Z; const float* bg; bf16_t* CAT;
    __device__ __forceinline__ void done(const Unit&, int) const {}
    __device__ __forceinline__ void operator()(const f32x4 (&acc)[2][2][4][2], const Unit& u, int wr, int wc, int fr, int fq) const {
        const int rbase = u.pm * BM + wr * 64 + fr, col0 = u.pn * BM + wc * 32 + 8 * fq;
        f32x4 bv[2][2];
#pragma unroll
        for (int bj = 0; bj < 2; ++bj)
#pragma unroll
            for (int n = 0; n < 2; ++n) bv[bj][n] = *(const f32x4*)(bg + col0 + bj * HALF + 4 * n);
#pragma unroll
        for (int ai = 0; ai < 2; ++ai)
#pragma unroll
            for (int m = 0; m < 4; ++m) { const int row = rbase + ai * HALF + m * 16;
#pragma unroll
                for (int bj = 0; bj < 2; ++bj) { const u32x4 zw = *(const u32x4*)(Z + (size_t)row * 512 + col0 + bj * HALF);
                    f32x4 a = acc[ai][bj][m][0] + bv[bj][0], b = acc[ai][bj][m][1] + bv[bj][1];
                    a[0] = bflo(zw.x) * sigmoid_f(a[0]); a[1] = bfhi(zw.x) * sigmoid_f(a[1]); a[2] = bflo(zw.y) * sigmoid_f(a[2]); a[3] = bfhi(zw.y) * sigmoid_f(a[3]);
                    b[0] = bflo(zw.z) * sigmoid_f(b[0]); b[1] = bfhi(zw.z) * sigmoid_f(b[1]); b[2] = bflo(zw.w) * sigmoid_f(b[2]); b[3] = bfhi(zw.w) * sigmoid_f(b[3]);
                    *(u32x4*)(CAT + (size_t)row * 1024 + 512 + col0 + bj * HALF) = pack8(a, b); } }
    }
};
template <bool IN_F32, bool OUT_F32> struct EpiRes {
    static constexpr bool PERM = true;
    const float* xin0; const float* xin1;
    const bf16_t* xrin;
    float* xout; bf16_t* xrout;
    const float* gate;
    const float* gn; const float* sc;
    bf16_t* XS; float* ssq;
    __device__ __forceinline__ void done(const Unit&, int) const {}
    __device__ __forceinline__ void operator()(const f32x4 (&acc)[2][2][4][2], const Unit& u, int wr, int wc, int fr, int fq) const {
        const int pm = u.pm, cond = cond_of_pm(pm); const int col0 = u.pn * BM + wc * 32 + 8 * fq; const int rbase = pm * BM + wr * 64 + fr;
        const bool donorm = (gn != nullptr);
        f32x4 gt[2][2], gs[2][2];
#pragma unroll
        for (int bj = 0; bj < 2; ++bj)
#pragma unroll
            for (int n = 0; n < 2; ++n) { const int c = col0 + bj * HALF + n * 4; gt[bj][n] = *(const f32x4*)(gate + cond * 6144 + c);
                if (donorm) { const f32x4 g4 = *(const f32x4*)(gn + c), s4 = *(const f32x4*)(sc + cond * 6144 + c); gs[bj][n] = g4 * (s4 + 1.f); } else gs[bj][n] = (f32x4){0.f, 0.f, 0.f, 0.f}; }
        constexpr int RD = IN_F32 ? 2 : 3;
        f32x4 xr[RD][2][2]; u32x4 xb[RD][2];
#define ER_LOAD(G_, SLOT_) do { const int row_ = rbase + ((G_) >> 2) * HALF + ((G_) & 3) * 16; \
            if (IN_F32) { const float* xi_ = (row_ < MC) ? (xin0 + (size_t)row_ * DM) : (xin1 + (size_t)(row_ - MC) * DM); \
                _Pragma("unroll") for (int bj = 0; bj < 2; ++bj) { xr[SLOT_][bj][0] = *(const f32x4*)(xi_ + col0 + bj * HALF); xr[SLOT_][bj][1] = *(const f32x4*)(xi_ + col0 + bj * HALF + 4); } } \
            else { _Pragma("unroll") for (int bj = 0; bj < 2; ++bj) xb[SLOT_][bj] = *(const u32x4*)(xrin + (size_t)row_ * DM + col0 + bj * HALF); } } while (0)
        ER_LOAD(0, 0); ER_LOAD(1, 1); if (RD == 3) ER_LOAD(2, RD - 1);
#pragma unroll
        for (int g = 0; g < 8; ++g) { const int ai = g >> 2, m = g & 3, sl = g % RD; const int row = rbase + ai * HALF + m * 16;
            float ss = 0.f; f32x4 x0[2], x1[2];
#pragma unroll
            for (int bj = 0; bj < 2; ++bj) { f32x4 a, b;
                if (IN_F32) { a = xr[sl][bj][0]; b = xr[sl][bj][1]; } else { const u32x4 w = xb[sl][bj]; a = (f32x4){bflo(w.x), bfhi(w.x), bflo(w.y), bfhi(w.y)}; b = (f32x4){bflo(w.z), bfhi(w.z), bflo(w.w), bfhi(w.w)}; }
                x0[bj] = a + gt[bj][0] * acc[ai][bj][m][0]; x1[bj] = b + gt[bj][1] * acc[ai][bj][m][1]; }
            if (g + RD < 8) ER_LOAD(g + RD, sl);
#pragma unroll
            for (int bj = 0; bj < 2; ++bj) { const int c = col0 + bj * HALF;
                if (OUT_F32) { *(f32x4*)(xout + (size_t)row * DM + c) = x0[bj]; *(f32x4*)(xout + (size_t)row * DM + c + 4) = x1[bj]; }
                else *(u32x4*)(xrout + (size_t)row * DM + c) = pack8(x0[bj], x1[bj]);
                if (donorm) { const f32x4 t0 = x0[bj] * x0[bj], t1 = x1[bj] * x1[bj]; ss += ((t0[0] + t0[1]) + (t0[2] + t0[3])) + ((t1[0] + t1[1]) + (t1[2] + t1[3]));
                    *(u32x4*)(XS + (size_t)row * DM + c) = pack8(x0[bj] * gs[bj][0], x1[bj] * gs[bj][1]); } }
            if (donorm) { { const int ln_ = fq * 16 + fr; ss += shfl_xor_l(ss, 16, ln_); ss += shfl_xor_l(ss, 32, ln_); } if (fq == 0) atomicAdd(ssq + row, ss); }
        }
#undef ER_LOAD
    }
};
struct EpiUp {
    static constexpr bool PERM = true;
    const float* sumsq; const float* bias; bf16_t* UP;
    __device__ __forceinline__ void done(const Unit&, int) const {}
    __device__ __forceinline__ void operator()(const f32x4 (&acc)[2][2][4][2], const Unit& u, int wr, int wc, int fr, int fq) const {
        const int pm = u.pm, cond = cond_of_pm(pm); const int col0 = u.pn * BM + wc * 32 + 8 * fq; const int rbase = pm * BM + wr * 64 + fr;
        f32x4 bv[2][2];
#pragma unroll
        for (int bj = 0; bj < 2; ++bj)
#pragma unroll
            for (int n = 0; n < 2; ++n) bv[bj][n] = *(const f32x4*)(bias + cond * 4096 + col0 + bj * HALF + 4 * n);
#pragma unroll
        for (int ai = 0; ai < 2; ++ai)
#pragma unroll
            for (int m = 0; m < 4; ++m) { const int row = rbase + ai * HALF + m * 16; const float rstd = rsqrtf(sumsq[row] * (1.f / DM) + EPS);
#pragma unroll
                for (int bj = 0; bj < 2; ++bj) *(u32x4*)(UP + (size_t)row * 4096 + col0 + bj * HALF) = pack8(acc[ai][bj][m][0] * rstd + bv[bj][0], acc[ai][bj][m][1] * rstd + bv[bj][1]); }
    }
};

__device__ __forceinline__ float dpp_shr1(float v) { return __uint_as_float((unsigned)__builtin_amdgcn_update_dpp(0, (int)__float_as_uint(v), 0x111, 0xf, 0xf, false)); }
__device__ __forceinline__ float dpp_shl1(float v) { return __uint_as_float((unsigned)__builtin_amdgcn_update_dpp(0, (int)__float_as_uint(v), 0x101, 0xf, 0xf, false)); }
struct EpiUpConv {
    static constexpr bool PERM = true;
    const float* sumsq; const float* bias; const float* cw; const float* cb; bf16_t* G; bf16_t* HALO;
    __device__ __forceinline__ void done(const Unit&, int) const {}
    __device__ __forceinline__ void operator()(const f32x4 (&acc)[2][2][4][2], const Unit& u, int wr, int wc, int fr, int fq) const {
        const int pm = u.pm, pn = u.pn, cond = cond_of_pm(pm);
        const int posv = pn * 256 + wc * 32 + 8 * fq, av = pn * 128 + wc * 32 + 8 * fq;
        float rs[2][4];
#pragma unroll
        for (int ai = 0; ai < 2; ++ai)
#pragma unroll
            for (int m = 0; m < 4; ++m) rs[ai][m] = sumsq[pm * BM + ai * HALF + wr * 64 + 4 * fr + m];
#pragma unroll
        for (int ai = 0; ai < 2; ++ai)
#pragma unroll
            for (int m = 0; m < 4; ++m) rs[ai][m] = rsqrtf(rs[ai][m] * (1.f / DM) + EPS);
#pragma unroll
        for (int n = 0; n < 2; ++n) {
            const int c = av + 4 * n;
            const f32x4 bvv = *(const f32x4*)(bias + cond * 4096 + posv + 4 * n), bvg = *(const f32x4*)(bias + cond * 4096 + posv + 128 + 4 * n);
            const f32x4 w0v = *(const f32x4*)(cw + c), w1v = *(const f32x4*)(cw + 4096 + c), w2v = *(const f32x4*)(cw + 8192 + c), cbv = *(const f32x4*)(cb + c);
            const f32x4 w0g = *(const f32x4*)(cw + 2048 + c), w1g = *(const f32x4*)(cw + 4096 + 2048 + c), w2g = *(const f32x4*)(cw + 8192 + 2048 + c), cbg = *(const f32x4*)(cb + 2048 + c);
#pragma unroll
            for (int ai = 0; ai < 2; ++ai) {
                const int tok0 = pm * BM + ai * HALF + wr * 64 + 4 * fr; const int sl = pm * 4 + ai * 2 + wr;
                f32x4 pv[4], pg[4];
#pragma unroll
                for (int m = 0; m < 4; ++m) { pv[m] = acc[ai][0][m][n] * rs[ai][m] + bvv; pg[m] = acc[ai][1][m][n] * rs[ai][m] + bvg; }
                f32x4 pvp, pvn, pgp, pgn;
#pragma unroll
                for (int j = 0; j < 4; ++j) { pvp[j] = dpp_shr1(pv[3][j]); pvn[j] = dpp_shl1(pv[0][j]); pgp[j] = dpp_shr1(pg[3][j]); pgn[j] = dpp_shl1(pg[0][j]); }
#pragma unroll
                for (int m = 0; m < 4; ++m) {
                    const f32x4 zv = cbv + w0v * (m == 0 ? pvp : pv[m == 0 ? 0 : m - 1]) + w1v * pv[m] + w2v * (m == 3 ? pvn : pv[m == 3 ? 3 : m + 1]);
                    const f32x4 zg = cbg + w0g * (m == 0 ? pgp : pg[m == 0 ? 0 : m - 1]) + w1g * pg[m] + w2g * (m == 3 ? pgn : pg[m == 3 ? 3 : m + 1]);
                    u32x2 w; w.x = cvt_pk_bf16(silu_f(zg[0]) * zv[0], silu_f(zg[1]) * zv[1]); w.y = cvt_pk_bf16(silu_f(zg[2]) * zv[2], silu_f(zg[3]) * zv[3]);
                    *(u32x2*)(G + (size_t)(tok0 + m) * 2048 + c) = w; }
                if (fr == 0 || fr == 15) { const int m0 = fr == 0 ? 0 : 2;
#pragma unroll
                    for (int mm = 0; mm < 2; ++mm) { const f32x4 a = fr == 0 ? pv[mm] : pv[2 + mm], b = fr == 0 ? pg[mm] : pg[2 + mm];
                        bf16_t* hp = HALO + ((size_t)sl * 4 + m0 + mm) * 4096 + posv + 4 * n;
                        u32x2 wa; wa.x = cvt_pk_bf16(a[0], a[1]); wa.y = cvt_pk_bf16(a[2], a[3]); *(u32x2*)hp = wa;
                        u32x2 wb; wb.x = cvt_pk_bf16(b[0], b[1]); wb.y = cvt_pk_bf16(b[2], b[3]); *(u32x2*)(hp + 128) = wb; } }
            }
        }
    }
};
constexpr int AT_SLOT = 32768, AT_NSLOT = 4, AT_VOFF = 16384, AT_X = 0, AT_ST = 65536;
__device__ __forceinline__ void glds16(const void* gsrc, unsigned lds_dst) { unsigned keep;
    asm volatile("s_mov_b32 %0, m0\n\ts_mov_b32 m0, %2\n\ts_nop 0\n\tglobal_load_lds_dwordx4 %1, off\n\ts_mov_b32 m0, %0" : "=&s"(keep) : "v"(gsrc), "s"(lds_dst) : "memory"); }
#define AT_WAIT_BAR(N) asm volatile("s_waitcnt vmcnt(" #N ") lgkmcnt(0)\n\ts_barrier" ::: "memory")
#define AT_SB() __builtin_amdgcn_sched_barrier(0)
__device__ __forceinline__ s16x4 vtr(const LAS char* p) { typedef short v4i16_t __attribute__((ext_vector_type(4))); return __builtin_bit_cast(s16x4, __builtin_amdgcn_ds_read_tr16_b64_v4i16((LAS v4i16_t*)p)); }
__device__ __forceinline__ int crow(int r, int hi) { return (r & 3) + 8 * (r >> 2) + 4 * hi; }

struct AttnArgs { const bf16_t* Q; const bf16_t* KB; const bf16_t* VB; bf16_t* CAT; const float* subln; float lam; float oml; };

__device__ __forceinline__ void attn_unit(LAS unsigned char* lds, const int tid, const AttnArgs& A, int seq, int h, int qblk) {
    const int lane = tid & 63, r32 = lane & 31, hi = lane >> 5; const int wid = __builtin_amdgcn_readfirstlane(tid >> 6);
    const int rg = wid & 3, s = wid >> 2;
    const bool ctx = seq < NB;
    const int qrow0 = ctx ? seq * SEQ + qblk * 128 : MC + (seq - NB) * DSEQ + qblk * 128;
    const int krow0 = ctx ? seq * SEQ : MC + (seq - NB) * (PAST + DSEQ);
    const int NT = ctx ? SEQ / 64 : (PAST + DSEQ) / 64;
    const unsigned lds0 = (unsigned)(uintptr_t)lds;
    const bf16_t* ksrc0 = A.KB + (size_t)(krow0 + lane) * 512 + h * 128 + wid * 8;
    const bf16_t* vsrc0 = A.VB + (size_t)(krow0 + 16 * (wid & 3) + (lane >> 2)) * 512 + h * 128 + (wid >> 2) * 32 + (lane & 3) * 8;
    const unsigned kdst = lds0 + wid * 1024, vdst = lds0 + AT_VOFF + ((wid >> 2) * 4 + (wid & 3)) * 1024;
#define AT_DMA(t, slot) do { const size_t _o = (size_t)(t) * 64 * 512; const unsigned _s = (unsigned)(slot) * AT_SLOT; \
        glds16(ksrc0 + _o, (unsigned)__builtin_amdgcn_readfirstlane(kdst + _s)); glds16(ksrc0 + _o + 64, (unsigned)__builtin_amdgcn_readfirstlane(kdst + _s + 8 * 1024)); \
        glds16(vsrc0 + _o, (unsigned)__builtin_amdgcn_readfirstlane(vdst + _s)); glds16(vsrc0 + _o + 64, (unsigned)__builtin_amdgcn_readfirstlane(vdst + _s + 8 * 1024)); } while (0)
    AT_DMA(0, 0); AT_DMA(1, 1); AT_DMA(2, 2);
    bf16x8 qr[4];
    { const bf16_t* qp = A.Q + (size_t)(qrow0 + rg * 32 + r32) * 512 + h * 128 + s * 64 + hi * 8;
#pragma unroll
      for (int d0 = 0; d0 < 4; ++d0) qr[d0] = *(const bf16x8*)(qp + d0 * 16); }
    f32x16 o[4];
#pragma unroll
    for (int d0 = 0; d0 < 4; ++d0)
#pragma unroll
        for (int r = 0; r < 16; ++r) o[d0][r] = 0.f;
    float lsum = 0.f;
    const LAS char* kfrag0 = (const LAS char*)lds + (s * 8 + hi) * 1024 + r32 * 16;
    const LAS char* vfrag0 = (const LAS char*)lds + AT_VOFF + ((lane >> 4) & 1) * 32 + (lane & 3) * 8 + (4 * hi + ((lane & 15) >> 2)) * 64;
    f32x16 pc0, pc1;
#define AT_KLOAD(kfr, slot) do { const LAS char* _k = kfrag0 + (slot) * AT_SLOT; _Pragma("unroll") for (int d0 = 0; d0 < 4; ++d0) { kfr[2 * d0] = *(const LAS bf16x8*)(_k + d0 * 2048); kfr[2 * d0 + 1] = *(const LAS bf16x8*)(_k + d0 * 2048 + 512); } } while (0)
#define AT_VLOAD(vv, slot, ks) do { const LAS char* _v = vfrag0 + (slot) * AT_SLOT + (ks) * 1024; _Pragma("unroll") for (int d0 = 0; d0 < 4; ++d0) { const s16x4 lo = vtr(_v + d0 * 4096), hh = vtr(_v + d0 * 4096 + 512); \
        vv[d0] = (bf16x8){lo[0], lo[1], lo[2], lo[3], hh[0], hh[1], hh[2], hh[3]}; } } while (0)
#define AT_EXP2(P, i, W) do { P[2 * (i)] = fast_exp2(P[2 * (i)]); P[2 * (i) + 1] = fast_exp2(P[2 * (i) + 1]); sacc += P[2 * (i)] + P[2 * (i) + 1]; W = cvt_pk_bf16(P[2 * (i)], P[2 * (i) + 1]); } while (0)
    AT_WAIT_BAR(8);
    { bf16x8 kfr[8]; AT_KLOAD(kfr, 0);
#pragma unroll
      for (int r = 0; r < 16; ++r) { pc0[r] = 0.f; pc1[r] = 0.f; }
#pragma unroll
      for (int d0 = 0; d0 < 4; ++d0) { pc0 = __builtin_amdgcn_mfma_f32_32x32x16_bf16(kfr[2 * d0], qr[d0], pc0, 0, 0, 0); pc1 = __builtin_amdgcn_mfma_f32_32x32x16_bf16(kfr[2 * d0 + 1], qr[d0], pc1, 0, 0, 0); } }
    int slot = 0;
    for (int t = 0; t < NT; ++t) {
        const bool has_next = t + 1 < NT;
        if (t + 2 < NT) AT_WAIT_BAR(4); else AT_WAIT_BAR(0);
        if (t + 3 < NT) AT_DMA(t + 3, (slot + 3) & 3);
        const int slot_n = (slot + 1) & 3;
        bf16x8 kfr[8], va[4], vb[4]; u32x4 pw[4]; f32x16 pn0, pn1; float sacc = 0.f;
        const LAS char* kn_ = kfrag0 + slot_n * AT_SLOT;
#define AT_K1(d0) do { kfr[2 * (d0)] = *(const LAS bf16x8*)(kn_ + (d0) * 2048); kfr[2 * (d0) + 1] = *(const LAS bf16x8*)(kn_ + (d0) * 2048 + 512); } while (0)
        if (has_next) { AT_K1(0); AT_K1(1); }
        AT_SB();
        if (has_next) {
#pragma unroll
            for (int r = 0; r < 16; ++r) { pn0[r] = 0.f; pn1[r] = 0.f; }
#pragma unroll
            for (int i = 0; i < 8; ++i) { const int d0 = i >> 1;
                if (i & 1) pn1 = __builtin_amdgcn_mfma_f32_32x32x16_bf16(kfr[2 * d0 + 1], qr[d0], pn1, 0, 0, 0); else pn0 = __builtin_amdgcn_mfma_f32_32x32x16_bf16(kfr[2 * d0], qr[d0], pn0, 0, 0, 0);
                AT_EXP2(pc0, i, pw[i >> 2][i & 3]);
                if (i == 0) AT_K1(2);
                if (i == 1) AT_K1(3);
                if (i == 3) AT_VLOAD(va, slot, 0);
                if (i == 5) AT_VLOAD(vb, slot, 1);
                AT_SB(); }
        } else {
            AT_VLOAD(va, slot, 0); AT_VLOAD(vb, slot, 1);
#pragma unroll
            for (int i = 0; i < 8; ++i) AT_EXP2(pc0, i, pw[i >> 2][i & 3]);
            AT_SB();
        }
        bf16x8 vc[4], vd[4];
#pragma unroll
        for (int i = 0; i < 8; ++i) { const int d0 = i & 3;
            if (i < 4) o[d0] = __builtin_amdgcn_mfma_f32_32x32x16_bf16(va[d0], __builtin_bit_cast(bf16x8, pw[0]), o[d0], 0, 0, 0);
            else       o[d0] = __builtin_amdgcn_mfma_f32_32x32x16_bf16(vb[d0], __builtin_bit_cast(bf16x8, pw[1]), o[d0], 0, 0, 0);
            AT_EXP2(pc1, i, pw[2 + (i >> 2)][i & 3]);
            if (i == 1) AT_VLOAD(vc, slot, 2);
            if (i == 5) AT_VLOAD(vd, slot, 3);
            AT_SB(); }
#pragma unroll
        for (int d0 = 0; d0 < 4; ++d0) o[d0] = __builtin_amdgcn_mfma_f32_32x32x16_bf16(vc[d0], __builtin_bit_cast(bf16x8, pw[2]), o[d0], 0, 0, 0);
#pragma unroll
        for (int d0 = 0; d0 < 4; ++d0) o[d0] = __builtin_amdgcn_mfma_f32_32x32x16_bf16(vd[d0], __builtin_bit_cast(bf16x8, pw[3]), o[d0], 0, 0, 0);
        lsum += sacc;
        if (has_next) { pc0 = pn0; pc1 = pn1; }
        slot = slot_n;
    }
    lsum += shfl_xor_l(lsum, 32, lane);
    const float inv = (s == 0 ? 1.f : A.lam) / lsum;
    AT_WAIT_BAR(0);
    LAS float* X = (LAS float*)(lds + AT_X) + rg * 4096;
    if (s == 1) {
#pragma unroll
        for (int d0 = 0; d0 < 4; ++d0)
#pragma unroll
            for (int r = 0; r < 16; ++r) X[(d0 * 16 + r) * 64 + lane] = o[d0][r] * inv;
    }
    AT_WAIT_BAR(0);
    if (s == 0) {
        float ss = 0.f;
#pragma unroll
        for (int d0 = 0; d0 < 4; ++d0)
#pragma unroll
            for (int r = 0; r < 16; ++r) { const float v = o[d0][r] * inv - X[(d0 * 16 + r) * 64 + lane]; o[d0][r] = v; ss += v * v; }
        ss += shfl_xor_l(ss, 32, lane);
        const float rn = rsqrtf(ss * (1.f / 128.f) + EPS) * A.oml;
        LAS bf16_t* stg = (LAS bf16_t*)(lds + AT_ST) + rg * (32 * 136);
#pragma unroll
        for (int d0 = 0; d0 < 4; ++d0)
#pragma unroll
            for (int rq = 0; rq < 4; ++rq) { const int dv = 32 * d0 + 8 * rq + 4 * hi; const f32x4 g4 = *(const f32x4*)(A.subln + dv);
                u32x2 w; w.x = cvt_pk_bf16(o[d0][4 * rq] * rn * g4[0], o[d0][4 * rq + 1] * rn * g4[1]); w.y = cvt_pk_bf16(o[d0][4 * rq + 2] * rn * g4[2], o[d0][4 * rq + 3] * rn * g4[3]);
                *(LAS u32x2*)(stg + r32 * 136 + dv) = w; }
        asm volatile("s_waitcnt lgkmcnt(0)" ::: "memory");
        bf16_t* dst = A.CAT + (size_t)(qrow0 + rg * 32) * 1024 + h * 128;
#pragma unroll
        for (int i = 0; i < 8; ++i) { const int row = i * 4 + (lane >> 4), ch = lane & 15; const u32x4 v = *(const LAS u32x4*)(stg + row * 136 + ch * 8); *(u32x4*)(dst + (size_t)row * 1024 + ch * 8) = v; }
    }
    AT_WAIT_BAR(0);
#undef AT_DMA
#undef AT_KLOAD
#undef AT_K1
#undef AT_VLOAD
#undef AT_EXP2
}
struct Args { const float* in[34]; float* out; unsigned char* ws; int stop_after; int pad; };
struct ArgsG { GAS const float* in[34]; GAS float* out; GAS unsigned char* ws; int stop_after; int pad; };
typedef const __attribute__((address_space(4))) ArgsG* kargs_t;
struct Frame {
    LAS unsigned char* lds; int tid, lane, wave, vcu, bid, G;
    kargs_t ka; float* out; unsigned char* ws;
    float* misc; unsigned* ctl;
};
#define LDS_WAIT() asm volatile("s_waitcnt lgkmcnt(0)" ::: "memory")
#define VM_WAIT() asm volatile("s_waitcnt vmcnt(0)" ::: "memory")

template <int MAP> __device__ __forceinline__ int src_col(int p);
template <int MODE, int MAP, int NC> __device__ __forceinline__ void gemv9_task(Frame& F, const float* W, int ldw, int l, int voff, int strip, float* out, int ldo, const float* add) {
    LAS float* sc = (LAS float*)F.lds; LAS float* red = sc + 9 * 1024;
    for (int i = F.tid; i < 9 * 1024; i += NTHREADS) { const int cond = i >> 10, k = i & 1023; float v;
        if (MODE == 0) { v = cond == 0 ? ((const float*)F.ka->in[6])[k] : ((const float*)F.ka->in[5])[(cond - 1) * 1024 + k]; v = v / (1.f + expf(-v)); } else v = F.misc[MI_MOD + (l * 9 + cond) * 6144 + voff + k];
        sc[i] = v; }
    __syncthreads();
    const int j = strip * NC + (F.lane < NC ? F.lane : NC - 1); const float* w = W + (size_t)(F.wave * 128) * ldw + src_col<MAP>(j);
    float acc[9];
#pragma unroll
    for (int b = 0; b < 9; ++b) acc[b] = 0.f;
#pragma unroll 16
    for (int k = 0; k < 128; ++k) { const float wv = w[(size_t)k * ldw];
#pragma unroll
        for (int b = 0; b < 9; ++b) acc[b] += sc[b * 1024 + F.wave * 128 + k] * wv; }
#pragma unroll
    for (int b = 0; b < 9; ++b) red[(F.wave * 9 + b) * 64 + F.lane] = acc[b];
    __syncthreads();
    for (int i = F.tid; i < 9 * 64; i += NTHREADS) { const int b = i >> 6, ln = i & 63; if (ln >= NC) continue; float s_ = 0.f;
#pragma unroll
        for (int w8 = 0; w8 < 8; ++w8) s_ += red[(w8 * 9 + b) * 64 + ln];
        const int jj = strip * NC + ln; out[(size_t)b * ldo + jj] = s_ + (add ? add[jj] : 0.f); }
    __syncthreads();
}
template <int MAP> __device__ __forceinline__ int src_col(int p) {
    if (MAP == 1) { if (p >= 1024) return p; const int pn = p >> 8, r = p & 255, bj = r >> 7, wc = (r >> 5) & 3, fq = (r >> 3) & 3, low = r & 7; return 256 * pn + 64 * wc + 32 * (fq >> 1) + 16 * bj + 8 * (fq & 1) + low; }
    if (MAP == 2) { const int pn = p >> 8, bj = (p >> 7) & 1, r = p & 127; return bj * 2048 + 128 * pn + r; }
    return p;
}
__device__ __forceinline__ void mod_task3(Frame& F, int task) {
    const int l = task / 96, r = task % 96, kq = r / 24, cg = r % 24;
    LAS float* sc = (LAS float*)F.lds; LAS float* red = sc + 9 * 256;
    for (int i = F.tid; i < 9 * 256; i += NTHREADS) { const int cond = i >> 8, k = kq * 256 + (i & 255); const float v = cond == 0 ? ((const float*)F.ka->in[6])[k] : ((const float*)F.ka->in[5])[(cond - 1) * 1024 + k]; sc[i] = v / (1.f + expf(-v)); }
    __syncthreads();
    const float* w = ((const float*)F.ka->in[7]) + ((size_t)l * DM + kq * 256 + F.wave * 32) * 6144 + cg * 256 + F.lane * 4;
    f32x4 acc[9];
#pragma unroll
    for (int b = 0; b < 9; ++b) acc[b] = (f32x4){0.f, 0.f, 0.f, 0.f};
#pragma unroll
    for (int h = 0; h < 2; ++h) { f32x4 wv[16];
#pragma unroll
        for (int k = 0; k < 16; ++k) wv[k] = *(const f32x4*)(w + (size_t)(h * 16 + k) * 6144);
#pragma unroll
        for (int k = 0; k < 16; ++k)
#pragma unroll
            for (int b = 0; b < 9; ++b) acc[b] += wv[k] * sc[b * 256 + F.wave * 32 + h * 16 + k]; }
#pragma unroll
    for (int b = 0; b < 9; ++b) *(LAS f32x4*)(red + (F.wave * 9 + b) * 256 + F.lane * 4) = acc[b];
    __syncthreads();
    for (int i = F.tid; i < 9 * 256; i += NTHREADS) { const int b = i >> 8, c = i & 255; float v = 0.f;
#pragma unroll
        for (int w8 = 0; w8 < 8; ++w8) v += red[(w8 * 9 + b) * 256 + c];
        const int col = cg * 256 + c; if (kq == 0) v += ((const float*)F.ka->in[8])[l * 6144 + col];
        atomicAdd(F.misc + MI_MOD + (l * 9 + b) * 6144 + col, v); }
    __syncthreads();
}
template <int MAP, bool BIAS> __device__ __forceinline__ void transpose_item(Frame& F, const float* W, int K, int N, bf16_t* WT, LAS float* scr, int item, const float* shv, float* bias) {
    const int lane = F.lane; const int nblk = N / 64, kb = item / nblk, nb = item % nblk, k0 = 64 * kb, n0 = 64 * nb;
    const int sc_ = src_col<MAP>(n0 + lane);
    float tv[64];
#pragma unroll
    for (int i = 0; i < 64; ++i) tv[i] = W[(size_t)(k0 + i) * N + sc_];
#pragma unroll
    for (int i = 0; i < 64; ++i) scr[i * 65 + lane] = tv[i];
    LDS_WAIT(); asm volatile("" ::: "memory");
    const int c = lane & 7;
#pragma unroll
    for (int j = 0; j < 8; ++j) { const int n = (lane >> 3) + 8 * j; const LAS float* s_ = scr + (8 * c) * 65 + n;
        u32x4 o; o.x = cvt_pk_bf16(s_[0 * 65], s_[1 * 65]); o.y = cvt_pk_bf16(s_[2 * 65], s_[3 * 65]); o.z = cvt_pk_bf16(s_[4 * 65], s_[5 * 65]); o.w = cvt_pk_bf16(s_[6 * 65], s_[7 * 65]);
        *(u32x4*)(WT + (size_t)(n0 + n) * K + k0 + 8 * c) = o; }
    if (BIAS) {
        float sh[9], acc[9];
#pragma unroll
        for (int b = 0; b < 9; ++b) { sh[b] = shv[b * 6144 + k0 + lane]; acc[b] = 0.f; }
#pragma unroll
        for (int kk = 0; kk < 64; ++kk) { const float w = tv[kk];
#pragma unroll
            for (int b = 0; b < 9; ++b) acc[b] += __uint_as_float(__builtin_amdgcn_readlane(__float_as_uint(sh[b]), kk)) * w; }
#pragma unroll
        for (int b = 0; b < 9; ++b) atomicAdd(bias + (size_t)b * N + n0 + lane, acc[b]);
    }
    LDS_WAIT(); asm volatile("" ::: "memory");
}
__device__ __forceinline__ void cache_item(Frame& F, int l, int item4) {
    f32x4 a[4], c[4];
#pragma unroll
    for (int i = 0; i < 4; ++i) { const int item = item4 * 4 + i, which = item >> 12, r = item & 4095, b = r >> 9, j = r & 511;
        const float* src = (which ? ((const float*)F.ka->in[3]) : ((const float*)F.ka->in[2])) + ((size_t)(b * DEPTH + l) * PAST + j) * 512 + F.lane * 8; a[i] = *(const f32x4*)src; c[i] = *(const f32x4*)(src + 4); }
#pragma unroll
    for (int i = 0; i < 4; ++i) { const int item = item4 * 4 + i, which = item >> 12, r = item & 4095, b = r >> 9, j = r & 511;
        bf16_t* dst = (bf16_t*)(F.ws + (which ? WS_VB : WS_KB)) + (size_t)(MC + b * (PAST + DSEQ) + j) * 512 + F.lane * 8; *(u32x4*)dst = pack8(a[i], c[i]); }
}
__device__ __forceinline__ f32x2 cmul(f32x2 a, f32x2 b) { return (f32x2){a.x * b.x - a.y * b.y, a.x * b.y + a.y * b.x}; }
__device__ __forceinline__ void ssm_prep(Frame& F, int l, int task) {
    const int g = task >> 1, half = task & 1;
    LAS f32x2* POW = (LAS f32x2*)F.lds;
    LAS f32x2* BB = POW + 2 * 17 * 64;
    LAS f32x2* CC = BB + 2 * 64 * 16;
    LAS f32x2* CT = CC + 2 * 16 * 64;
    LAS float* KT = (LAS float*)(CT + 2 * 64 * 16);
    constexpr int KTS = 260;
    bf16_t* WE = (bf16_t*)(F.ws + WS_SSM + SSM_WE) + (size_t)g * 256 * 256;
    bf16_t* WY = (bf16_t*)(F.ws + WS_SSM + SSM_WY) + (size_t)g * 256 * 512;
    f32x2* LAM16 = (f32x2*)(F.ws + WS_SSM + SSM_LAM16); f32x2* BBAR = (f32x2*)(F.ws + WS_SSM + SSM_BBAR);
    const int tid = F.tid, lane = F.lane;
    if (tid < 128) { const int dir = tid >> 6, p = tid & 63; const size_t pi = ((size_t)(l * 2 + dir) * NG + g) * 64 + p;
        const float lr = ((const float*)F.ka->in[18])[pi], li = ((const float*)F.ka->in[19])[pi], delta = expf(((const float*)F.ka->in[20])[(l * 2 + dir) * NG + g]);
        const float er = expf(lr * delta), lbr = er * cosf(li * delta), lbi = er * sinf(li * delta);
        { float one_ = 1.f, zero_ = 0.f; asm volatile("" : "+v"(one_), "+v"(zero_));
          f32x2 pw = (f32x2){one_, zero_}; const f32x2 lb = (f32x2){lbr, lbi};
          for (int tau = 0; tau <= 16; ++tau) { POW[(dir * 17 + tau) * 64 + p] = pw; if (tau == 16 && half == 0) LAM16[(dir * NG + g) * 64 + p] = pw; pw = cmul(pw, lb); } }
        const float nr = lbr - 1.f, ni = lbi, den = lr * lr + li * li; const f32x2 fac = (f32x2){(nr * lr + ni * li) / den, (ni * lr - nr * li) / den};
        f32x4 br[4], bi4[4];
#pragma unroll
        for (int q = 0; q < 4; ++q) { br[q] = *(const f32x4*)(((const float*)F.ka->in[21]) + pi * 16 + 4 * q); bi4[q] = *(const f32x4*)(((const float*)F.ka->in[22]) + pi * 16 + 4 * q); }
#pragma unroll
        for (int ch = 0; ch < 16; ++ch) { const f32x2 bb = cmul(fac, (f32x2){br[ch >> 2][ch & 3], bi4[ch >> 2][ch & 3]}); BB[(dir * 64 + p) * 16 + ch] = bb; if (half == 0) BBAR[((size_t)(dir * NG + g) * 64 + p) * 16 + ch] = bb; }
    }
    { f32x2 cv[4];
#pragma unroll
      for (int q = 0; q < 4; ++q) { const int i = tid + q * NTHREADS, dir = i >> 10, c = (i >> 6) & 15, p = i & 63; const size_t ci = (((size_t)(l * 2 + dir) * NG + g) * 16 + c) * 64 + p; cv[q] = (f32x2){((const float*)F.ka->in[23])[ci], ((const float*)F.ka->in[24])[ci]}; }
#pragma unroll
      for (int q = 0; q < 4; ++q) { const int i = tid + q * NTHREADS, dir = i >> 10, c = (i >> 6) & 15, p = i & 63; CC[i] = cv[q]; CT[(dir * 64 + p) * 16 + c] = cv[q]; } }
    __syncthreads();
    { const int i16 = lane & 15, k4 = lane >> 4, ri = k4 & 1, ph = k4 >> 1;
      for (int blk = 0; blk < 4; ++blk) { const int q = F.wave * 4 + blk, dir = q >> 4, tau = q & 15; f32x4 acc = (f32x4){0.f, 0.f, 0.f, 0.f};
#pragma unroll 8
          for (int ks = 0; ks < 32; ++ks) { const int p = 2 * ks + ph;
              const f32x2 cc = CT[(dir * 64 + p) * 16 + i16], pw = POW[(dir * 17 + tau) * 64 + p], bb = BB[(dir * 64 + p) * 16 + i16];
              const float u = ri ? -pw.y : pw.x, v = ri ? pw.x : pw.y;
              const float av = cc.x * u - cc.y * v, bv = ri ? bb.y : bb.x;
              acc = __builtin_amdgcn_mfma_f32_16x16x4f32(av, bv, acc, 0, 0, 0); }
#pragma unroll
          for (int r = 0; r < 4; ++r) KT[(dir * 16 + tau) * KTS + (k4 * 4 + r) * 16 + i16] = acc[r]; } }
    __syncthreads();
    const float* Dv = ((const float*)F.ka->in[25]) + l * 512 + g * 16;
    for (int idx = half * 8192 + tid; idx < (half + 1) * 8192; idx += NTHREADS) { const int n = idx >> 6, kc = idx & 63, k0 = kc * 8, i = n >> 4, c = n & 15; f32x4 v0, v1;
        if (k0 < 256) { const int s_ = k0 >> 4, ch0 = k0 & 15; v0 = (f32x4){0.f, 0.f, 0.f, 0.f}; v1 = v0;
            if (s_ <= i) { const LAS float* kp = KT + (i - s_) * KTS + c * 16 + ch0; v0 += *(const LAS f32x4*)kp; v1 += *(const LAS f32x4*)(kp + 4); }
            if (s_ >= i) { const LAS float* kp = KT + (16 + s_ - i) * KTS + c * 16 + ch0; v0 += *(const LAS f32x4*)kp; v1 += *(const LAS f32x4*)(kp + 4); }
            if (s_ == i) { const int e = c - ch0; const float dv = Dv[c]; if (e >= 0 && e < 4) v0[e] += dv; else if (e >= 4 && e < 8) v1[e - 4] += dv; }
        } else { const int dir = k0 >= 384 ? 1 : 0, p0 = ((k0 - 256) & 127) >> 1, tau = dir ? 16 - i : i + 1;
            const LAS f32x4* cp = (const LAS f32x4*)(CC + (dir * 16 + c) * 64 + p0); const LAS f32x4* pp = (const LAS f32x4*)(POW + (dir * 17 + tau) * 64 + p0);
            const f32x4 c0 = cp[0], c1 = cp[1], w0 = pp[0], w1 = pp[1];
            v0 = (f32x4){c0[0] * w0[0] - c0[1] * w0[1], -(c0[0] * w0[1] + c0[1] * w0[0]), c0[2] * w0[2] - c0[3] * w0[3], -(c0[2] * w0[3] + c0[3] * w0[2])};
            v1 = (f32x4){c1[0] * w1[0] - c1[1] * w1[1], -(c1[0] * w1[1] + c1[1] * w1[0]), c1[2] * w1[2] - c1[3] * w1[3], -(c1[2] * w1[3] + c1[3] * w1[2])}; }
        *(u32x4*)(WY + (size_t)n * 512 + k0) = pack8(v0, v1); }
    for (int idx = half * 4096 + tid; idx < (half + 1) * 4096; idx += NTHREADS) { const int n = idx >> 5, k0 = (idx & 31) * 8, dir = n >> 7, p = (n & 127) >> 1, ri = n & 1, s_ = k0 >> 4, ch0 = k0 & 15;
        const f32x2 pw = POW[(dir * 17 + (dir ? s_ : 15 - s_)) * 64 + p]; const LAS f32x4* bp = (const LAS f32x4*)(BB + (dir * 64 + p) * 16 + ch0);
        const float u = ri ? pw.y : pw.x, v = ri ? pw.x : -pw.y;
        const f32x4 b0 = bp[0], b1 = bp[1], b2 = bp[2], b3 = bp[3];
        const f32x4 v0 = (f32x4){u * b0[0] + v * b0[1], u * b0[2] + v * b0[3], u * b1[0] + v * b1[1], u * b1[2] + v * b1[3]};
        const f32x4 v1 = (f32x4){u * b2[0] + v * b2[1], u * b2[2] + v * b2[3], u * b3[0] + v * b3[1], u * b3[2] + v * b3[3]};
        *(u32x4*)(WE + (size_t)n * 256 + k0) = pack8(v0, v1); }
    __syncthreads();
}
__device__ __forceinline__ void xprep_item(Frame& F, int item4) {
    f32x4 xv[4][4];
#pragma unroll
    for (int i = 0; i < 4; ++i) { const int row = item4 * 4 + i; const float* xr = (row < MC) ? ((const float*)F.ka->in[0]) + (size_t)row * DM : ((const float*)F.ka->in[1]) + (size_t)(row - MC) * DM;
#pragma unroll
        for (int j = 0; j < 4; ++j) xv[i][j] = *(const f32x4*)(xr + 4 * F.lane + 256 * j); }
    const int cond = item4 * 4 < MC ? 0 : 1 + ((item4 * 4 - MC) >> 10);
    const float* sc = F.misc + MI_MOD + (0 * 9 + cond) * 6144 + 1024; const float* g1 = ((const float*)F.ka->in[9]);
    f32x4 gs[4];
#pragma unroll
    for (int j = 0; j < 4; ++j) { const int c = 4 * F.lane + 256 * j; gs[j] = (*(const f32x4*)(g1 + c)) * (*(const f32x4*)(sc + c) + 1.f); }
#pragma unroll
    for (int i = 0; i < 4; ++i) { const int row = item4 * 4 + i; bf16_t* dst = (bf16_t*)(F.ws + WS_XS) + (size_t)row * DM; float s = 0.f;
#pragma unroll
        for (int j = 0; j < 4; ++j) { const f32x4 x = xv[i][j]; const f32x4 t = x * x; s += (t[0] + t[1]) + (t[2] + t[3]); const f32x4 y = x * gs[j];
            u32x2 w; w.x = cvt_pk_bf16(y[0], y[1]); w.y = cvt_pk_bf16(y[2], y[3]); *(u32x2*)(dst + 4 * F.lane + 256 * j) = w; }
        s = wave_sum(s, F.lane);
        if (F.lane == 0) ((float*)(F.ctl + CW_SS))[row] = s; }
}
__device__ __forceinline__ void bias_item(Frame& F, int item) {
    const int which = item >= 2048, n = which ? item - 2048 : item;
    const bf16_t* wrow = (const bf16_t*)(F.ws + (which ? WS_WUP : WS_WIN)) + (size_t)n * DM;
    float wv[16]; { const u32x4 a = *(const u32x4*)(wrow + F.lane * 8), b = *(const u32x4*)(wrow + 512 + F.lane * 8);
        wv[0] = bflo(a.x); wv[1] = bfhi(a.x); wv[2] = bflo(a.y); wv[3] = bfhi(a.y); wv[4] = bflo(a.z); wv[5] = bfhi(a.z); wv[6] = bflo(a.w); wv[7] = bfhi(a.w);
        wv[8] = bflo(b.x); wv[9] = bfhi(b.x); wv[10] = bflo(b.y); wv[11] = bfhi(b.y); wv[12] = bflo(b.z); wv[13] = bfhi(b.z); wv[14] = bflo(b.w); wv[15] = bfhi(b.w); }
    float outv = 0.f;
#pragma unroll
    for (int cond = 0; cond < 9; ++cond) { const float* sh = F.misc + MI_MOD + cond * 6144 + (which ? 3072 : 0);
        const f32x4 s0 = *(const f32x4*)(sh + F.lane * 8), s1 = *(const f32x4*)(sh + F.lane * 8 + 4), s2 = *(const f32x4*)(sh + 512 + F.lane * 8), s3 = *(const f32x4*)(sh + 512 + F.lane * 8 + 4);
        float d = 0.f;
#pragma unroll
        for (int e = 0; e < 4; ++e) d += s0[e] * wv[e] + s1[e] * wv[4 + e] + s2[e] * wv[8 + e] + s3[e] * wv[12 + e];
        d = wave_sum(d, F.lane); if (F.lane == cond) outv = d; }
    if (F.lane < 9) ((float*)F.ctl)[(which ? CW_BUP + F.lane * 4096 : CW_BIN + F.lane * 2048) + n] = outv;
}
__device__ __forceinline__ void ssm_scan(Frame& F, int l, int g, int pm) {
    const int tid = F.tid, sl = tid >> 7, dp = tid & 127, dir = dp >> 6, p = dp & 63;
    const f32x2* LAM16 = (const f32x2*)(F.ws + WS_SSM + SSM_LAM16); const f32x2* BBAR = (const f32x2*)(F.ws + WS_SSM + SSM_BBAR);
    const float* E = (const float*)(F.ws + WS_R + R_E); bf16_t* AS3 = (bf16_t*)(F.ws + WS_R + R_AS3);
    const f32x2 lam = LAM16[(dir * NG + g) * 64 + p];
    f32x2 e[64];
    if (pm == 0) {
#pragma unroll
        for (int q = 0; q < 4; ++q) { const float* ep = E + ((size_t)g * NCHUNK + (q * 4 + sl) * 16) * 256 + dir * 128 + 2 * p;
#pragma unroll
            for (int j = 0; j < 16; ++j) e[q * 16 + j] = *(const f32x2*)(ep + (size_t)j * 256); }
    } else { const float* ep = E + ((size_t)g * NCHUNK + 256 + ((pm - 1) * 4 + sl) * 64) * 256 + dir * 128 + 2 * p;
#pragma unroll
        for (int j = 0; j < 64; ++j) e[j] = *(const f32x2*)(ep + (size_t)j * 256); }
    const int nq = pm == 0 ? 4 : 1;
#pragma unroll
    for (int q = 0; q < 4; ++q) { if (q >= nq) break;
        int base; f32x2 h;
        if (pm == 0) { const int seq = q * 4 + sl; base = seq * 16; h = (f32x2){0.f, 0.f}; }
        else { const int sq = (pm - 1) * 4 + sl; base = 256 + sq * 64; h = *(const f32x2*)(((const float*)F.ka->in[4]) + ((((size_t)sq * DEPTH + l) * 2 + dir) * NG + g) * 128 + 2 * p); }
        unsigned* hp = (unsigned*)(AS3 + ((size_t)g * NCHUNK + base) * 512 + 256 + dir * 128 + 2 * p);
        if (pm == 0) {
#pragma unroll
            for (int jj = 0; jj < 16; ++jj) { const int j = dir ? 15 - jj : jj; const f32x2 ev = dir ? e[q * 16 + 15 - jj] : e[q * 16 + jj]; hp[(size_t)j * 256] = cvt_pk_bf16(h.x, h.y); h = cmul(lam, h) + ev; }
        } else {
#pragma unroll
            for (int jj = 0; jj < 64; ++jj) { const int j = dir ? 63 - jj : jj; const f32x2 ev = dir ? e[63 - jj] : e[jj]; hp[(size_t)j * 256] = cvt_pk_bf16(h.x, h.y); h = cmul(lam, h) + ev; }
        }
    }
    if (pm == 0) {
        const int tt = dir ? 15 : 0; u32x4 uq[4][2]; f32x2 bbv[16];
        const f32x2* bb = BBAR + ((size_t)(dir * NG + g) * 64 + p) * 16;
#pragma unroll
        for (int ch = 0; ch < 16; ++ch) bbv[ch] = bb[ch];
#pragma unroll
        for (int q = 0; q < 4; ++q) { const int chunk = (q * 4 + sl) * 16 + tt; const bf16_t* up = AS3 + ((size_t)g * NCHUNK + chunk) * 512 + tt * 16; uq[q][0] = *(const u32x4*)up; uq[q][1] = *(const u32x4*)(up + 8); }
        float* ns = F.out + (size_t)MT * DM + 2 * (size_t)NB * DEPTH * SEQ * 512;
#pragma unroll
        for (int q = 0; q < 4; ++q) { const int seq = q * 4 + sl; const u32x4 u0 = uq[q][0], u1 = uq[q][1];
            const float uu[16] = {bflo(u0.x), bfhi(u0.x), bflo(u0.y), bfhi(u0.y), bflo(u0.z), bfhi(u0.z), bflo(u0.w), bfhi(u0.w), bflo(u1.x), bfhi(u1.x), bflo(u1.y), bfhi(u1.y), bflo(u1.z), bfhi(u1.z), bflo(u1.w), bfhi(u1.w)};
            f32x2 acc = (f32x2){0.f, 0.f};
#pragma unroll
            for (int ch = 0; ch < 16; ++ch) acc += bbv[ch] * uu[ch];
            *(f32x2*)(ns + ((((size_t)seq * DEPTH + l) * 2 + dir) * NG + g) * 128 + 2 * p) = acc; }
    }
}
__device__ __forceinline__ void ld16(const bf16_t* p, float* v) { const u32x4 a = *(const u32x4*)p; v[0] = bflo(a.x); v[1] = bfhi(a.x); v[2] = bflo(a.y); v[3] = bfhi(a.y); v[4] = bflo(a.z); v[5] = bfhi(a.z); v[6] = bflo(a.w); v[7] = bfhi(a.w); }
__device__ __forceinline__ void conv_item(Frame& F, int l, int item) {
    const int rs = item >> 4, pn = item & 15, lr = F.lane >> 4, lc = F.lane & 15;
    const int r0 = rs * 64 + lr * 16; const int av = 128 * pn + 8 * lc;
    const bf16_t* up = (const bf16_t*)(F.ws + WS_R) + (size_t)r0 * 4096 + 256 * pn + 8 * lc; bf16_t* gp = (bf16_t*)(F.ws + WS_G) + (size_t)r0 * 2048 + av;
    const float* cw = ((const float*)F.ka->in[31]) + (size_t)l * 3 * 4096; const float* cb = ((const float*)F.ka->in[32]) + (size_t)l * 4096;
    float wv[3][8], wg[3][8], bv[8], bg[8];
#pragma unroll
    for (int k = 0; k < 3; ++k)
#pragma unroll
        for (int e = 0; e < 8; ++e) { wv[k][e] = cw[k * 4096 + av + e]; wg[k][e] = cw[k * 4096 + 2048 + av + e]; }
#pragma unroll
    for (int e = 0; e < 8; ++e) { bv[e] = cb[av + e]; bg[e] = cb[2048 + av + e]; }
    const int t0 = r0 < MC ? (r0 & 255) : ((r0 - MC) & 1023), L = r0 < MC ? SEQ : DSEQ;
    float pv[8], pg[8], cv[8], cg[8], nv_[8], ng[8];
    if (t0 > 0) { ld16(up - 4096, pv); ld16(up - 4096 + 128, pg); } else {
#pragma unroll
        for (int e = 0; e < 8; ++e) { pv[e] = 0.f; pg[e] = 0.f; } }
    ld16(up, cv); ld16(up + 128, cg);
#pragma unroll
    for (int i = 0; i < 16; ++i) {
        if (t0 + i + 1 < L) { ld16(up + (size_t)(i + 1) * 4096, nv_); ld16(up + (size_t)(i + 1) * 4096 + 128, ng); } else {
#pragma unroll
            for (int e = 0; e < 8; ++e) { nv_[e] = 0.f; ng[e] = 0.f; } }
        float o[8];
#pragma unroll
        for (int e = 0; e < 8; ++e) { const float zv = bv[e] + wv[0][e] * pv[e] + wv[1][e] * cv[e] + wv[2][e] * nv_[e]; const float zg = bg[e] + wg[0][e] * pg[e] + wg[1][e] * cg[e] + wg[2][e] * ng[e]; o[e] = silu_f(zg) * zv; }
        u32x4 w; w.x = cvt_pk_bf16(o[0], o[1]); w.y = cvt_pk_bf16(o[2], o[3]); w.z = cvt_pk_bf16(o[4], o[5]); w.w = cvt_pk_bf16(o[6], o[7]);
        *(u32x4*)(gp + (size_t)i * 2048) = w;
#pragma unroll
        for (int e = 0; e < 8; ++e) { pv[e] = cv[e]; pg[e] = cg[e]; cv[e] = nv_[e]; cg[e] = ng[e]; }
    }
}

__device__ __forceinline__ bool slab_first(int s) { return s < 64 ? (s & 3) == 0 : ((s - 64) & 15) == 0; }
__device__ __forceinline__ bool slab_last(int s) { return s < 64 ? (s & 3) == 3 : ((s - 64) & 15) == 15; }
__device__ __forceinline__ void ld4bf(const bf16_t* p, float* v) { const u32x2 a = *(const u32x2*)p; v[0] = bflo(a.x); v[1] = bfhi(a.x); v[2] = bflo(a.y); v[3] = bfhi(a.y); }
__device__ __forceinline__ void conv_fix(Frame& F, int l, int pm) {
    const bf16_t* HALO = (const bf16_t*)(F.ws + WS_HALO); bf16_t* G = (bf16_t*)(F.ws + WS_G);
    const float* cw = ((const float*)F.ka->in[31]) + (size_t)l * 3 * 4096; const float* cb = ((const float*)F.ka->in[32]) + (size_t)l * 4096;
    const int c = F.tid * 4, pos = 256 * (c >> 7) + (c & 127);
    float wv[3][4], wg[3][4], bv[4], bg[4];
#pragma unroll
    for (int k = 0; k < 3; ++k) { const f32x4 a = *(const f32x4*)(cw + k * 4096 + c), b = *(const f32x4*)(cw + k * 4096 + 2048 + c);
#pragma unroll
        for (int e = 0; e < 4; ++e) { wv[k][e] = a[e]; wg[k][e] = b[e]; } }
    { const f32x4 a = *(const f32x4*)(cb + c), b = *(const f32x4*)(cb + 2048 + c);
#pragma unroll
      for (int e = 0; e < 4; ++e) { bv[e] = a[e]; bg[e] = b[e]; } }
    u32x2 hv[8][6];
#pragma unroll
    for (int r8 = 0; r8 < 8; ++r8) { const int s = pm * 4 + (r8 >> 1), which = r8 & 1; const bool skip = which == 0 ? slab_first(s) : slab_last(s);
        const int sp = skip ? s : (which == 0 ? s - 1 : s), sn = skip ? s : (which == 0 ? s : s + 1);
        const bf16_t* hp = which == 0 ? HALO + ((size_t)sp * 4 + 3) * 4096 : HALO + ((size_t)s * 4 + 2) * 4096;
        const bf16_t* hc = which == 0 ? HALO + ((size_t)s * 4 + 0) * 4096 : HALO + ((size_t)s * 4 + 3) * 4096;
        const bf16_t* hn = which == 0 ? HALO + ((size_t)s * 4 + 1) * 4096 : HALO + ((size_t)sn * 4 + 0) * 4096;
        hv[r8][0] = *(const u32x2*)(hp + pos); hv[r8][1] = *(const u32x2*)(hc + pos); hv[r8][2] = *(const u32x2*)(hn + pos);
        hv[r8][3] = *(const u32x2*)(hp + pos + 128); hv[r8][4] = *(const u32x2*)(hc + pos + 128); hv[r8][5] = *(const u32x2*)(hn + pos + 128); }
#pragma unroll
    for (int r8 = 0; r8 < 8; ++r8) { const int s = pm * 4 + (r8 >> 1), which = r8 & 1;
        if (which == 0 ? slab_first(s) : slab_last(s)) continue;
        float pv[4], cv[4], nv_[4], pg[4], cg[4], ng[4];
#define UNP(v, w) do { v[0] = bflo(w.x); v[1] = bfhi(w.x); v[2] = bflo(w.y); v[3] = bfhi(w.y); } while (0)
        UNP(pv, hv[r8][0]); UNP(cv, hv[r8][1]); UNP(nv_, hv[r8][2]); UNP(pg, hv[r8][3]); UNP(cg, hv[r8][4]); UNP(ng, hv[r8][5]);
#undef UNP
        float o[4];
#pragma unroll
        for (int e = 0; e < 4; ++e) { const float zv = bv[e] + wv[0][e] * pv[e] + wv[1][e] * cv[e] + wv[2][e] * nv_[e]; const float zg = bg[e] + wg[0][e] * pg[e] + wg[1][e] * cg[e] + wg[2][e] * ng[e]; o[e] = silu_f(zg) * zv; }
        u32x2 w; w.x = cvt_pk_bf16(o[0], o[1]); w.y = cvt_pk_bf16(o[2], o[3]);
        *(u32x2*)(G + (size_t)(s * 64 + (which ? 63 : 0)) * 2048 + c) = w; }
}
constexpr int N_TR_ITEMS_L = 16 * 32 + 8 * 8 + 16 * 16 + 16 * 64 + 32 * 16;
template <bool BIAS> __device__ __forceinline__ void weight_item(Frame& F, LAS float* scr, int l, int it) {
    int r = it; const float* modl = F.misc + MI_MOD + l * 9 * 6144; float* cf = (float*)F.ctl;
    if (r < 512) { transpose_item<1, BIAS>(F, ((const float*)F.ka->in[10]) + (size_t)l * DM * 2048, DM, 2048, (bf16_t*)(F.ws + WS_WIN) + (size_t)l * 2048 * DM, scr, r, modl, cf + CW_BIN + l * 9 * 2048); return; } r -= 512;
    if (r < 64) { transpose_item<0, false>(F, ((const float*)F.ka->in[26]) + (size_t)l * 512 * 512, 512, 512, (bf16_t*)(F.ws + WS_WGLU) + (size_t)l * 512 * 512, scr, r, nullptr, nullptr); return; } r -= 64;
    if (r < 256) { transpose_item<0, false>(F, ((const float*)F.ka->in[28]) + (size_t)l * DM * DM, DM, DM, (bf16_t*)(F.ws + WS_WOUT) + (size_t)l * DM * DM, scr, r, nullptr, nullptr); return; } r -= 256;
    if (r < 1024) { transpose_item<2, BIAS>(F, ((const float*)F.ka->in[30]) + (size_t)l * DM * 4096, DM, 4096, (bf16_t*)(F.ws + WS_WUP) + (size_t)l * 4096 * DM, scr, r, modl + 3072, cf + CW_BUP + l * 9 * 4096); return; } r -= 1024;
    transpose_item<0, false>(F, ((const float*)F.ka->in[33]) + (size_t)l * 2048 * DM, 2048, DM, (bf16_t*)(F.ws + WS_WDN) + (size_t)l * DM * 2048, scr, r, nullptr, nullptr);
}

__global__ void __launch_bounds__(NTHREADS, 2) mega(Args args) {
    extern __shared__ __attribute__((aligned(16))) unsigned char lds_raw[];
    Frame F;
    F.lds = (LAS unsigned char*)lds_raw;
    F.tid = threadIdx.x; F.lane = F.tid & 63; F.wave = __builtin_amdgcn_readfirstlane(F.tid >> 6);
    F.G = gridDim.x; F.bid = blockIdx.x; { const int bx = blockIdx.x; F.vcu = (F.G % 8 == 0) ? (bx % 8) * (F.G / 8) + bx / 8 : bx; }
    F.ka = (kargs_t)__builtin_amdgcn_kernarg_segment_ptr();
    F.out = args.out; F.ws = args.ws; F.misc = (float*)(args.ws + WS_MISC); F.ctl = (unsigned*)(args.ws + WS_CTL);
    volatile LAS unsigned* MISC = (volatile LAS unsigned*)(F.lds + MISC_OFF);
    for (int u = F.tid; u < (LDS_BYTES - LDSCTL_OFF) / 4; u += NTHREADS) ((LAS unsigned*)(F.lds + LDSCTL_OFF))[u] = 0u;
    __syncthreads();
    XcdBarrier bar = xcd_barrier_post(F.ctl + CW_BAR, MISC + 8);
    int phase_no = 0;
#define LAUNDER() do { { GAS unsigned char* w1_ = (GAS unsigned char*)F.ws; GAS float* o1_ = (GAS float*)F.out; asm volatile("" : "+s"(F.ka), "+s"(w1_), "+s"(o1_), "+s"(F.bid)); F.ws = (unsigned char*)w1_; F.out = (float*)o1_; }     \
    { int w_ = __builtin_amdgcn_readfirstlane(F.wave); asm volatile("" : "+s"(w_)); F.wave = w_; } F.vcu = (F.G % 8 == 0) ? (F.bid % 8) * (F.G / 8) + F.bid / 8 : F.bid; \
    { unsigned z_ = 0u; asm volatile("" : "+v"(z_)); F.lane = (int)__builtin_amdgcn_mbcnt_hi(~0u, __builtin_amdgcn_mbcnt_lo(~0u, z_)); } F.tid = F.wave * 64 + F.lane;     \
    F.misc = (float*)(F.ws + WS_MISC); F.ctl = (unsigned*)(F.ws + WS_CTL); gw = F.vcu * NWAVES + F.wave; } while (0)
#ifndef TPROBE_SCALE
#define TPROBE_SCALE 0.25f
#endif
#ifdef TPROBE
#define TSTAMP() do { if (blockIdx.x == 0 && F.tid == 0) ((unsigned long long*)(F.ctl + 6000))[phase_no] = __builtin_amdgcn_s_memrealtime(); } while (0)
#else
#define TSTAMP() do {} while (0)
#endif
#if defined(TPROBE) && defined(TPROBE_SUB_A)
#ifndef TPROBE_BID
#define TPROBE_BID 0
#endif
#define TSUB(i) do { if (blockIdx.x == TPROBE_BID && F.tid == 0 && l == 0) ((unsigned long long*)(F.ctl + 6200))[i] = __builtin_amdgcn_s_memrealtime(); } while (0)
#else
#define TSUB(i) do {} while (0)
#endif
#define GRID_BAR() do { LAUNDER(); xcd_barrier(bar, F.tid); ++phase_no; TSTAMP(); if (F.ka->stop_after == phase_no) return; LAUNDER(); } while (0)
    int gw = F.vcu * NWAVES + F.wave; const int NGW = F.G * NWAVES;
#define ssq ((float*)(F.ctl + CW_SS))
#define XS ((bf16_t*)(F.ws + WS_XS))
#define KB ((bf16_t*)(F.ws + WS_KB))
#define VB ((bf16_t*)(F.ws + WS_VB))
#define Qb ((bf16_t*)(F.ws + WS_R + R_Q))
#define AS3 ((bf16_t*)(F.ws + WS_R + R_AS3))
#define Eb ((float*)(F.ws + WS_R + R_E))
#define Zb ((bf16_t*)(F.ws + WS_R + R_Z))
#define CAT ((bf16_t*)(F.ws + WS_R + R_CAT))
#define UP ((bf16_t*)(F.ws + WS_R))
#define Gb ((bf16_t*)(F.ws + WS_G))

    TSTAMP();
    if (F.vcu < 64) ssm_prep(F, 0, F.vcu);
    else {
        mod_task3(F, F.vcu - 64);
        if (F.vcu == 64) {
            for (int i = F.tid; i < 1024; i += NTHREADS) { const int pos = i >> 4, f = i & 15; const float inv = 1.0f / powf(10000.0f, (float)f / 16.0f); const float ang = (float)pos * inv;
                ((f32x2*)(F.misc + MI_ROPE))[i] = (f32x2){cosf(ang), sinf(ang)}; }
            if (F.tid < 2) { const int l = F.tid; float a1 = 0.f, a2 = 0.f; for (int d = 0; d < 64; ++d) { a1 += ((const float*)F.ka->in[13])[l * 64 + d] * ((const float*)F.ka->in[14])[l * 64 + d]; a2 += ((const float*)F.ka->in[15])[l * 64 + d] * ((const float*)F.ka->in[16])[l * 64 + d]; }
                const float li = 0.8f - 0.6f * expf(-0.3f * (float)l); F.misc[MI_LAM + l] = expf(a1) - expf(a2) + li; F.misc[MI_LAM + 2 + l] = 1.f - li; }
            __syncthreads();
        }
        LAS float* scr = (LAS float*)(F.lds + F.wave * 16640);
        const int gw1 = (F.vcu - 64) * NWAVES + F.wave, NGW1 = (F.G - 64) * NWAVES;
        for (int it = gw1; it < N_TR_ITEMS_L + 2048; it += NGW1) { if (it < N_TR_ITEMS_L) weight_item<false>(F, scr, 0, it); else cache_item(F, 0, it - N_TR_ITEMS_L); }
    }
    GRID_BAR();
    for (int it = gw; it < MT / 4 + 6144; it += NGW) { if (it < MT / 4) xprep_item(F, it); else bias_item(F, it - MT / 4); }
    GRID_BAR();

    for (int l = 0; l < DEPTH; ++l) {
        const float* modl = F.misc + MI_MOD + l * 9 * 6144;
        { unsigned* ucnt = F.ctl + CW_UC + l * 6 * 64;
          { Gemm g{XS, (const bf16_t*)(F.ws + WS_WIN) + (size_t)l * 2048 * DM, DM, DM, DM, 0, 0}; InOrder S{F.bid, F.G};
            EpiIn E{ssq + (l == 0 ? 0 : 2 * MT), (const float*)F.ctl + CW_BIN + l * 9 * 2048, ((const float*)F.ka->in[11]) + l * 64, ((const float*)F.ka->in[12]) + l * 64, (const f32x2*)(F.misc + MI_ROPE), Qb, KB, VB,
                    __builtin_amdgcn_make_buffer_rsrc((void*)AS3, 0, (int)((size_t)NG * NCHUNK * 512 * 2), 0x00020000),
                    F.out + (size_t)MT * DM, F.out + (size_t)MT * DM + (size_t)NB * DEPTH * SEQ * 512, l, ucnt};
            gemm_phase<EpiIn, InOrder>(F.lds, F.tid, g, S, E); }
          if (F.bid >= 128 && F.bid < 224) {
              LAUNDER();
              const int idx = F.bid - 128, gq = idx / 3, pmq = idx % 3; unsigned* up = F.ctl + CW_UC + ((l * 3 + pmq) * 2 + (gq >> 4)) * 64;
              if (F.tid == 0) { unsigned sp = 0; while (__hip_atomic_load(up, RLX_AGENT) < 128u) { __builtin_amdgcn_s_sleep(2); if (++sp > (1u << 20)) break; }
                  __builtin_amdgcn_fence(__ATOMIC_ACQUIRE, "agent"); asm volatile("s_waitcnt vmcnt(0)" ::: "memory"); }
              __syncthreads();
              { Gemm g{AS3, (const bf16_t*)(F.ws + WS_SSM + SSM_WE), 512, 256, 256, (size_t)NCHUNK * 512, (size_t)256 * 256}; GroupOrder S{idx, F.G}; EpiS1 E{Eb};
                gemm_phase<EpiS1, GroupOrder>(F.lds, F.tid, g, S, E); }
              VM_WAIT(); __syncthreads(); LAUNDER();
              ssm_scan(F, l, (F.bid - 128) / 3, (F.bid - 128) % 3); } }
        GRID_BAR();
#define ZC_PTR (F.ctl + CW_ZC + l * 256)
#define ATTN_UNIT(SEQ_, H_, QB_) do { LAUNDER(); const AttnArgs A_{Qb, KB, VB, CAT, ((const float*)F.ka->in[17]) + l * 128, F.misc[MI_LAM + l], F.misc[MI_LAM + 2 + l]}; attn_unit(F.lds, F.tid, A_, (SEQ_), (H_), (QB_)); } while (0)
#define ATTN_CTX(U_) do { const int u_ = (U_); ATTN_UNIT(u_ >> 3, (u_ >> 1) & 3, u_ & 1); } while (0)
        { TSUB(0);
          const int xq = F.vcu >> 5, rq = F.vcu & 31;
          if (rq < 12) { const int cidx = xq * 12 + rq;
              { Gemm g{AS3, (const bf16_t*)(F.ws + WS_SSM + SSM_WY), 512, 512, 512, (size_t)NCHUNK * 512, (size_t)256 * 512}; GroupOrder S{cidx, F.G};
                EpiS3 E{__builtin_amdgcn_make_buffer_rsrc((void*)Zb, 0, (int)((size_t)MT * 512 * 2), 0x00020000)};
                gemm_phase<EpiS3, GroupOrder>(F.lds, F.tid, g, S, E); }
              VM_WAIT(); __syncthreads(); LAUNDER();
              if (F.tid == 0) __hip_atomic_fetch_add(ZC_PTR + (((F.vcu >> 5) * 12 + (F.vcu & 31)) % 3) * 64, 1u, RLX_AGENT); }
          TSUB(3);
          { const int u = F.vcu; ATTN_UNIT(NB + (u >> 5), (u >> 3) & 3, u & 7); } TSUB(4);
          if ((F.vcu & 31) >= 24) { for (int r = 0; r < 2; ++r) ATTN_CTX((F.vcu >> 5) * 16 + 2 * ((F.vcu & 31) - 24) + r); }
          TSUB(5);
          if ((F.vcu & 31) >= 12 && (F.vcu & 31) < 24) {
              LAUNDER();
              const int idx = (F.vcu >> 5) * 12 + ((F.vcu & 31) - 12), pmz = panel_of(idx / 12, (idx % 12) >> 1) >> 4;
              if (F.tid == 0) { unsigned sp = 0; while (__hip_atomic_load(ZC_PTR + pmz * 64, RLX_AGENT) < (unsigned)NG) { __builtin_amdgcn_s_sleep(2); if (++sp > (1u << 20)) break; }
                  __builtin_amdgcn_fence(__ATOMIC_ACQUIRE, "agent"); asm volatile("s_waitcnt vmcnt(0)" ::: "memory"); }
              __syncthreads(); TSUB(6);
              Gemm g{Zb, (const bf16_t*)(F.ws + WS_WGLU) + (size_t)l * 512 * 512, 512, 512, 512, 0, 0}; OneTile S{idx};
              EpiGlu E{Zb, ((const float*)F.ka->in[27]) + l * 512, CAT};
              gemm_phase<EpiGlu, OneTile>(F.lds, F.tid, g, S, E); TSUB(7); } }
        GRID_BAR();
        { Gemm g{CAT, (const bf16_t*)(F.ws + WS_WOUT) + (size_t)l * DM * DM, DM, DM, DM, 0, 0}; GridOrder S; S.init(MT, DM, F.G, F.bid);
          bf16_t* XR = (bf16_t*)(F.ws + WS_XR);
          if (l == 0) { EpiRes<true, false> E{((const float*)F.ka->in[0]), ((const float*)F.ka->in[1]), nullptr, nullptr, XR, modl + 2 * DM, ((const float*)F.ka->in[29]) + l * DM, modl + 4 * DM, XS, ssq + 1 * MT};
              gemm_phase<EpiRes<true, false>, GridOrder>(F.lds, F.tid, g, S, E); }
          else { EpiRes<false, false> E{nullptr, nullptr, XR, nullptr, XR, modl + 2 * DM, ((const float*)F.ka->in[29]) + l * DM, modl + 4 * DM, XS, ssq + 3 * MT};
              gemm_phase<EpiRes<false, false>, GridOrder>(F.lds, F.tid, g, S, E); }
          if (l + 1 < DEPTH && F.bid >= 192) { LAUNDER(); LAS float* scr = (LAS float*)(F.lds + F.wave * 16640);
              for (int it = (F.bid - 192) * NWAVES + F.wave; it < N_TR_ITEMS_L; it += 64 * NWAVES) weight_item<true>(F, scr, l + 1, it); } }
        GRID_BAR();
        { Gemm g{XS, (const bf16_t*)(F.ws + WS_WUP) + (size_t)l * 4096 * DM, DM, DM, DM, 0, 0}; GridOrder S; S.init(MT, 4096, F.G, F.bid);
          EpiUpConv E{ssq + (l == 0 ? 1 : 3) * MT, (const float*)F.ctl + CW_BUP + l * 9 * 4096, ((const float*)F.ka->in[31]) + (size_t)l * 3 * 4096, ((const float*)F.ka->in[32]) + (size_t)l * 4096, Gb, (bf16_t*)(F.ws + WS_HALO)};
          gemm_phase<EpiUpConv, GridOrder, true>(F.lds, F.tid, g, S, E); }
        GRID_BAR();
        { Gemm g{Gb, (const bf16_t*)(F.ws + WS_WDN) + (size_t)l * DM * 2048, 2048, 2048, 2048, 0, 0}; GridOrder S; S.init(MT, DM, F.G, F.bid);
          const bool nxt = l + 1 < DEPTH;
          bf16_t* XR = (bf16_t*)(F.ws + WS_XR);
          { Unit u0; if (S.next(0, u0)) { conv_fix(F, l, u0.pm); VM_WAIT(); __syncthreads(); LAUNDER(); } }
          if (nxt) { EpiRes<false, false> E{nullptr, nullptr, XR, nullptr, XR, modl + 5 * DM, ((const float*)F.ka->in[9]) + (l + 1) * DM, modl + 9 * 6144 + DM, XS, ssq + 2 * MT};
              gemm_phase<EpiRes<false, false>, GridOrder>(F.lds, F.tid, g, S, E); }
          else { EpiRes<false, true> E{nullptr, nullptr, XR, F.out, nullptr, modl + 5 * DM, nullptr, nullptr, XS, ssq + 2 * MT};
              gemm_phase<EpiRes<false, true>, GridOrder>(F.lds, F.tid, g, S, E); }
          if (nxt && F.bid >= 192) { LAUNDER(); ssm_prep(F, l + 1, F.bid - 192);
              for (int it = (F.bid - 192) * NWAVES + F.wave; it < 2048; it += 64 * NWAVES) cache_item(F, l + 1, it); } }
        if (l + 1 < DEPTH) GRID_BAR();
    }
#ifdef TPROBE
    if (blockIdx.x == 0) {
        ++phase_no; TSTAMP(); VM_WAIT(); __syncthreads();
        volatile LAS float* dl = (volatile LAS float*)(F.lds + 1024);
        if (threadIdx.x == 0) { const unsigned long long* ts = (const unsigned long long*)((unsigned*)(args.ws + WS_CTL) + 6000); const float tot = (float)(ts[phase_no] - ts[0]);
            float fa = 0.f;
#ifdef TPROBE_SUB_A
            { const unsigned long long* t2 = (const unsigned long long*)((unsigned*)(args.ws + WS_CTL) + 6200); fa = (float)(t2[TPROBE_SUB_B] - t2[TPROBE_SUB_A]) / tot; }
#else
            for (int k = 0; k < phase_no; ++k) { const float d = (float)(ts[k + 1] - ts[k]) / tot; if ((TPROBE_MASK_A >> k) & 1ull) fa += d; }
#endif
            dl[0] = TPROBE_SCALE * sqrtf(fa); }
        __syncthreads();
        const float delta = dl[0];
        float* nv = args.out + (size_t)MT * DM + (size_t)NB * DEPTH * SEQ * 512;
        for (size_t i = threadIdx.x; i < (size_t)NB * DEPTH * SEQ * 512; i += NTHREADS) nv[i] *= (1.f + delta);
    }
#endif
#undef GRID_BAR
#undef LAUNDER
#undef ZC_PTR
#undef ATTN_UNIT
#undef ATTN_CTX
#undef ssq
#undef XS
#undef KB
#undef VB
#undef Qb
#undef AS3
#undef Eb
#undef Zb
#undef CAT
#undef UP
#undef Gb
}
}

static int fk_launch(void* const* d_in, void* d_out, void* d_ws, size_t ws_size, hipStream_t stream, int stop_after) {
    static int grid = 0;
    if (grid == 0) {
        int dev = 0, cus = 0;
        if (ws_size < fk::WS_END) { fprintf(stderr, "kernel_launch: workspace too small (%zu < %zu)\n", ws_size, (size_t)fk::WS_END); grid = -1; return -1; }
        if (hipGetDevice(&dev) != hipSuccess || hipDeviceGetAttribute(&cus, hipDeviceAttributeMultiprocessorCount, dev) != hipSuccess) { grid = -1; return -1; }
        if (hipFuncSetAttribute((const void*)fk::mega, hipFuncAttributeMaxDynamicSharedMemorySize, fk::LDS_BYTES) != hipSuccess) { fprintf(stderr, "kernel_launch: hipFuncSetAttribute failed\n"); grid = -1; return -1; }
        int per_cu = 0; (void)hipOccupancyMaxActiveBlocksPerMultiprocessor(&per_cu, (const void*)fk::mega, fk::NTHREADS, fk::LDS_BYTES); (void)hipGetLastError();
        if (per_cu < 1) fprintf(stderr, "kernel_launch: occupancy query says %d blocks/CU\n", per_cu);
        grid = cus;
        if (grid != 256) fprintf(stderr, "kernel_launch: %d CUs (built for 256)\n", grid);
    }
    if (grid < 0) return -1;
    (void)hipMemsetAsync((char*)d_ws + fk::WS_CTL, 0, fk::CTL_BYTES, stream);
    fk::Args a{};
    for (int i = 0; i < 34; ++i) a.in[i] = (const float*)d_in[i];
    a.out = (float*)d_out; a.ws = (unsigned char*)d_ws; a.stop_after = stop_after; a.pad = 0;
    hipLaunchKernelGGL(fk::mega, dim3(grid), dim3(fk::NTHREADS), fk::LDS_BYTES, stream, a);
    return 0;
}
extern "C" void kernel_launch(void* const* d_in, const int* in_sizes, int n_in, void* d_out, int out_size, void* d_ws, size_t ws_size, hipStream_t stream) {
    if (n_in != 34) { fprintf(stderr, "kernel_launch: unexpected n_in %d\n", n_in); return; }
    fk_launch(d_in, d_out, d_ws, ws_size, stream, 0);
}
```

```cpp
#include <hip/hip_runtime.h>
#include <cstdio>
#include <cstdint>
namespace fk {
#define LAS __attribute__((address_space(3)))
#define GAS __attribute__((address_space(1)))
typedef unsigned short bf16_t;
typedef short bf16x8 __attribute__((ext_vector_type(8)));
typedef short s16x4 __attribute__((ext_vector_type(4)));
typedef float f32x4 __attribute__((ext_vector_type(4)));
typedef float f32x2 __attribute__((ext_vector_type(2)));
typedef float f32x16 __attribute__((ext_vector_type(16)));
typedef unsigned u32x4 __attribute__((ext_vector_type(4)));
typedef unsigned u32x2 __attribute__((ext_vector_type(2)));

constexpr int DM = 1024, NB = 16, SEQ = 256, DEPTH = 2, DB = 8, DSEQ = 1024, PAST = 512;
constexpr int MC = NB * SEQ, MS = DB * DSEQ, MT = MC + MS;
constexpr int NH = 4, NG = 32, NCOND = 9, NMOD = 6;
constexpr int NCHUNK = MT / 16;
constexpr int KVROWS = MC + DB * (PAST + DSEQ);
constexpr float EPS = 1e-6f;
constexpr float C2 = 0.125f * 1.4426950408889634f;
constexpr int NWAVES = 8, NTHREADS = 512;

constexpr size_t MiB = 1u << 20;
constexpr size_t WS_CTL = 0, CTL_BYTES = 1 * MiB + 512 * 1024;
constexpr size_t WS_MISC = 1 * MiB;
constexpr size_t WS_WIN = 3 * MiB;
constexpr size_t WS_WGLU = 11 * MiB;
constexpr size_t WS_WOUT = 12 * MiB;
constexpr size_t WS_WUP = 16 * MiB;
constexpr size_t WS_WDN = 32 * MiB;
constexpr size_t WS_SSM = 40 * MiB;
constexpr size_t WS_XS = 53 * MiB;
constexpr size_t WS_KB = 77 * MiB;
constexpr size_t WS_VB = 93 * MiB;
constexpr size_t WS_R = 109 * MiB;
constexpr size_t WS_XR = 205 * MiB;
constexpr size_t WS_G = WS_R;
constexpr size_t WS_HALO = WS_R + 48 * MiB;
constexpr size_t WS_END = 253 * MiB;
constexpr size_t R_Q = 0, R_AS3 = 12 * MiB, R_E = 36 * MiB, R_Z = 60 * MiB, R_CAT = 72 * MiB;
constexpr size_t SSM_WE = 0, SSM_WY = 4 * MiB, SSM_LAM16 = 12 * MiB, SSM_BBAR = 12 * MiB + 64 * 1024;
constexpr int MI_MOD = 0;
constexpr int MI_ROPE = MI_MOD + 2 * 9 * 6144;
constexpr int MI_LAM = MI_ROPE + 64 * 16 * 2;
constexpr int MI_END = MI_LAM + 8;
static_assert((size_t)MI_END * 4 <= 2 * MiB, "MISC");
constexpr int CW_BAR = 1024;
constexpr int CW_ZC = 7168;
constexpr int CW_UC = 4608;
constexpr int CW_SS = 8192;
constexpr int CW_BIN = 65536;
constexpr int CW_BUP = CW_BIN + 2 * 9 * 2048;
static_assert((size_t)(CW_SS + 4 * MT) <= CW_BIN && (size_t)(CW_BUP + 2 * 9 * 4096) * 4 <= CTL_BYTES, "CTL");

constexpr int RING_BYTES = 131072;
constexpr int LDS_BYTES_ = 147456; constexpr int LDSCTL_OFF = LDS_BYTES_ - 512, MISC_OFF = LDSCTL_OFF + 320;
constexpr int LDS_BYTES = 147456;

#define RLX_AGENT __ATOMIC_RELAXED, __HIP_MEMORY_SCOPE_AGENT
typedef __bf16 bf16x2_t __attribute__((ext_vector_type(2)));
__device__ __forceinline__ unsigned cvt_pk_bf16(float lo, float hi) { const f32x2 v = {lo, hi}; const bf16x2_t b = __builtin_convertvector(v, bf16x2_t); return __builtin_bit_cast(unsigned, b); }
__device__ __forceinline__ float bf2f(unsigned short b) { return __uint_as_float((unsigned)b << 16); }
__device__ __forceinline__ float bflo(unsigned w) { return __uint_as_float(w << 16); }
__device__ __forceinline__ float bfhi(unsigned w) { return __uint_as_float(w & 0xffff0000u); }
__device__ __forceinline__ float fast_exp2(float x) { return __builtin_amdgcn_exp2f(x); }
__device__ __forceinline__ float fast_rcp(float x) { return __builtin_amdgcn_rcpf(x); }
__device__ __forceinline__ float sigmoid_f(float x) { return fast_rcp(1.f + fast_exp2(-1.4426950408889634f * x)); }
__device__ __forceinline__ float silu_f(float x) { return x * sigmoid_f(x); }
__device__ __forceinline__ float gelu_tanh_f(float x) {
    const float u = 0.7978845608028654f * (x + 0.044715f * x * x * x); return x * sigmoid_f(2.f * u); }
__device__ __forceinline__ float shfl_xor_l(float v, int mask, int lane) { return __uint_as_float((unsigned)__builtin_amdgcn_ds_bpermute((lane ^ mask) << 2, (int)__float_as_uint(v))); }
__device__ __forceinline__ float wave_sum(float v, int lane) {
#pragma unroll
    for (int o = 1; o < 64; o <<= 1) v += shfl_xor_l(v, o, lane);
    return v; }

#define XB_TMO      128
#define XB_XCNT(j)  (256  + 64 * (j))
#define XB_XSUB(j)  (1280 + 64 * (j))
#define XB_XGEN(j)  (2304 + 64 * (j))
#define XB_TOP      3328
#define XB_TOPGEN   3392
#define XCD_BAR_WORDS 3456
#define XB_SPIN_CAP (1u << 18)
__device__ __forceinline__ unsigned xb_ld(unsigned* p)              { return __hip_atomic_load(p, __ATOMIC_RELAXED, __HIP_MEMORY_SCOPE_AGENT); }
__device__ __forceinline__ unsigned xb_add(unsigned* p, unsigned v) { return __hip_atomic_fetch_add(p, v, __ATOMIC_RELAXED, __HIP_MEMORY_SCOPE_AGENT); }
__device__ __forceinline__ unsigned xb_xcc_id() { return (unsigned)__builtin_amdgcn_s_getreg((3 << 11) | 20) & 0xFu; }
#define XB_SPIN(cond, bar) do { unsigned _sp = 0; while (cond) { __builtin_amdgcn_s_sleep(1); \
    if ((++_sp & 255u) == 0u) { if (xb_ld(&(bar)[XB_TMO])) break; if (_sp > XB_SPIN_CAP) { atomicAdd(&(bar)[XB_TMO], 1u); break; } } } } while (0)
struct XcdBarrier { unsigned* bar; unsigned x; volatile LAS unsigned* st; };
__device__ __forceinline__ XcdBarrier xcd_barrier_post(unsigned* bar, volatile LAS unsigned* st) {
    XcdBarrier b; b.bar = bar; b.x = xb_xcc_id(); b.st = st;
    if (threadIdx.x == 0) (void)xb_add(&bar[XB_XCNT(b.x)], 1u);
    return b;
}
__device__ __forceinline__ void xcd_barrier_complete(unsigned* bar, unsigned x, unsigned& nloc, unsigned& nx) {
    const unsigned G = gridDim.x * gridDim.y * gridDim.z;
    unsigned sum, cnt, mine, sp = 0u;
    for (;;) {
        sum = 0u; cnt = 0u; mine = 0u;
#pragma unroll
        for (unsigned j = 0; j < 16; ++j) { const unsigned c = xb_ld(&bar[XB_XCNT(j)]); sum += c; cnt += (c > 0u) ? 1u : 0u; mine = (j == x) ? c : mine; }
        if (sum == G) break;
        __builtin_amdgcn_s_sleep(1);
        if ((++sp & 255u) == 0u) { if (xb_ld(&bar[XB_TMO])) break; if (sp > XB_SPIN_CAP) { atomicAdd(&bar[XB_TMO], 1u); break; } }
    }
    nloc = mine > 0u ? mine : 1u; nx = cnt > 0u ? cnt : 1u;
}
__device__ __forceinline__ void xcd_barrier(const XcdBarrier& b, const int tid) {
    asm volatile("s_waitcnt vmcnt(0)" ::: "memory");
    __syncthreads();
    if (tid == 0) {
        unsigned* bar = b.bar;
        __builtin_amdgcn_s_waitcnt(0);
        unsigned nloc = b.st[0], nx = b.st[1];
        if (nloc == 0u) { xcd_barrier_complete(bar, b.x, nloc, nx); b.st[0] = nloc; b.st[1] = nx; }
        const unsigned old = xb_add(&bar[XB_XSUB(b.x)], 1u);
        const unsigned gen = old / nloc;
        if (old + 1u == (gen + 1u) * nloc) {
            __builtin_amdgcn_fence(__ATOMIC_RELEASE, "agent");
            asm volatile("s_waitcnt vmcnt(0)" ::: "memory");
            const unsigned og = xb_add(&bar[XB_TOP], 1u);
            const unsigned tg = og / nx;
            if (og + 1u == (tg + 1u) * nx) xb_add(&bar[XB_TOPGEN], 1u);
            else XB_SPIN(xb_ld(&bar[XB_TOPGEN]) == tg, bar);
            __builtin_amdgcn_fence(__ATOMIC_ACQUIRE, "agent");
            xb_add(&bar[XB_XGEN(b.x)], 1u);
            asm volatile("s_waitcnt vmcnt(0)" ::: "memory");
        } else {
            XB_SPIN(xb_ld(&bar[XB_XGEN(b.x)]) == gen, bar);
            __builtin_amdgcn_fence(__ATOMIC_ACQUIRE, "agent");
            asm volatile("s_waitcnt vmcnt(0)" ::: "memory");
        }
    }
    __syncthreads();
}

constexpr int BM = 256, BK = 64, HALF = 128, HTB = HALF * BK * 2, NXCD = 8, WGM = 6;
__host__ __device__ __forceinline__ int lds_byte(int r, int c) { const int st = (r >> 4) * 2 + (c >> 5), rr = r & 15, cc = c & 31, ob = rr * 64 + cc * 2; return st * 1024 + (ob ^ (((ob >> 9) & 1) << 5)); }
__host__ __device__ __forceinline__ void stage_rc(int b, int& R, int& C) { const int st = b / 1024, sb = b % 1024, swz = sb ^ (((sb >> 9) & 1) << 5); R = (st >> 1) * 16 + swz / 64; C = (st & 1) * 32 + (swz % 64) / 2; }
__host__ __device__ __forceinline__ int perm32(int rho) { const int n = rho >> 4, i = rho & 15; return 8 * (i >> 2) + 4 * n + (i & 3); }

__device__ __forceinline__ int panel_of(int x, int j) { return 2 * x + j + ((j + 6) >> 3) * (14 + 2 * x); }
struct Unit { int pm, pn, g; };
struct Gemm { const bf16_t* A; const bf16_t* Bt; int lda, ldb, K; size_t gsA, gsB; int tsid = -1; };
struct GridOrder {
    int nM, nN, nwg, G, c;
    __device__ void init(int M, int N, int G_, int c_) { nM = M / BM; nN = N / BM; nwg = nM * nN; G = G_; c = c_; }
    __device__ bool next(int i, Unit& u) const {
        const long L = (long)i * G + c; if (L >= nwg) return false;
        int wgid = (int)L; { const int q = nwg / NXCD, r = nwg % NXCD, xcd = wgid % NXCD, off = wgid / NXCD; wgid = (xcd < r ? xcd * (q + 1) : r * (q + 1) + (xcd - r) * q) + off; }
        const int nig = WGM * nN, gid = wgid / nig, fm = gid * WGM, gsz = (nM - fm) < WGM ? (nM - fm) : WGM;
        u.pm = panel_of(gid, (wgid % nig) % gsz);     u.pn = (wgid % nig) / gsz; u.g = 0; return true;
    }
};
struct InOrder {
    int c, G;
    __device__ bool next(int i, Unit& u) const { const int L = i * G + c; if (L >= 384) return false; u.g = 0;
        if (L < 96) { const int jj = L >> 3; u.pm = panel_of(L & 7, jj >> 1); u.pn = 6 + (jj & 1); }
        else { const int Lp = L - 96, jj = Lp >> 3; u.pm = panel_of(Lp & 7, jj / 6); u.pn = jj % 6; }
        return true; }
};
struct OneTile {
    int idx;
    __device__ bool next(int i, Unit& u) const { if (i > 0 || idx < 0) return false; u.pm = panel_of(idx / 12, (idx % 12) >> 1); u.pn = idx & 1; u.g = 0; return true; }
};
struct GroupOrder {
    int c, G;
    __device__ bool next(int i, Unit& u) const { const int idx = c + i * G; if (c < 0 || idx >= NG * 3) return false; u.g = idx / 3; u.pm = idx % 3; u.pn = 0; return true; }
};

template <class Epi, class Sched, bool AROWPERM = false>
__device__ __forceinline__ void gemm_phase(LAS unsigned char* lds, const int tid, const Gemm g, const Sched& S, const Epi& E) {
    const int wid = __builtin_amdgcn_readfirstlane(tid >> 6), lane = tid & 63, wr = wid >> 2, wc = wid & 3, fr = lane & 15, fq = lane >> 4;
    const int K = g.K, nt = K / BK;
    unsigned voffA[2], voffB[2];
#pragma unroll
    for (int i = 0; i < 2; ++i) { int R, C; stage_rc(tid * 16 + i * 8192, R, C); const int Rb = Epi::PERM ? ((R & ~31) + perm32(R & 31)) : R;
        const int Ra = AROWPERM ? ((R & 64) + 4 * (R & 15) + ((R >> 4) & 3)) : R;
        voffA[i] = (unsigned)(Ra * g.lda + C) * 2u; voffB[i] = (unsigned)(Rb * g.ldb + C) * 2u; }
    const size_t kstep = (size_t)(BK * 2);
    const size_t hstepA = (size_t)HALF * g.lda * 2, hstepB = (size_t)HALF * g.ldb * 2;
    const unsigned ldsw = (unsigned)wid * 1024u;
    const int aoff = lds_byte(wr * 64 + fr, fq * 8), boff = lds_byte(wc * 32 + fr, fq * 8);
#define PG8_SA(b, h) (((b) * 2 + (h)) * HTB)
#define PG8_SB(b, h) ((4 + (b) * 2 + (h)) * HTB)
#define PG8_STAGE(bufoff, gbase, voff) do { _Pragma("unroll") for (int _i = 0; _i < 2; ++_i) \
        __builtin_amdgcn_global_load_lds((const unsigned*)((const char*)(gbase) + (voff)[_i]), (LAS unsigned*)(lds + (bufoff) + ldsw + _i * 8192), 16, 0, 0); } while (0)
#define PG8_LDA(dst, b, h) do { _Pragma("unroll") for (int m = 0; m < 4; ++m) _Pragma("unroll") for (int k = 0; k < 2; ++k) dst[m][k] = *(const LAS bf16x8*)(lds + PG8_SA(b, h) + aoff + m * 2048 + k * 1024); } while (0)
#define PG8_LDB(dst, b, h) do { _Pragma("unroll") for (int n = 0; n < 2; ++n) _Pragma("unroll") for (int k = 0; k < 2; ++k) dst[n][k] = *(const LAS bf16x8*)(lds + PG8_SB(b, h) + boff + n * 2048 + k * 1024); } while (0)
#define PG8_MMA(ai, bj, At, Bt) do { __builtin_amdgcn_s_setprio(1); _Pragma("unroll") for (int m = 0; m < 4; ++m) _Pragma("unroll") for (int n = 0; n < 2; ++n) _Pragma("unroll") for (int k = 0; k < 2; ++k) \
        acc[ai][bj][m][n] = __builtin_amdgcn_mfma_f32_16x16x32_bf16(Bt[n][k], At[m][k], acc[ai][bj][m][n], 0, 0, 0); __builtin_amdgcn_s_setprio(0); } while (0)
#define PG8_WAIT_V(n) asm volatile("s_waitcnt vmcnt(" #n ")" ::: "memory")
#define PG8_WAIT_L(n) asm volatile("s_waitcnt lgkmcnt(" #n ")" ::: "memory")
#define PG8_BAR __builtin_amdgcn_s_barrier()
#define PG8_SCHED __builtin_amdgcn_sched_barrier(0)
#define PG8_APTR(u) ((const char*)g.A + ((size_t)(u).g * g.gsA + (size_t)(u).pm * BM * g.lda) * 2)
#define PG8_BPTR(u) ((const char*)g.Bt + ((size_t)(u).g * g.gsB + (size_t)(u).pn * BM * g.ldb) * 2)
    Unit cur, nxt; int ui = 0;
    if (!S.next(0, cur)) return;
#ifdef TPROBE_GID
#define PG8_TS(k) do { if (g.tsid == TPROBE_GID && wid == 0 && lane == 0) *(LAS unsigned long long*)(lds + LDSCTL_OFF + 8 * (k)) = __builtin_amdgcn_s_memrealtime(); } while (0)
#else
#define PG8_TS(k) do {} while (0)
#endif
    PG8_TS(0);
    f32x4 acc[2][2][4][2];
#pragma unroll
    for (int a = 0; a < 2; ++a)
#pragma unroll
        for (int b = 0; b < 2; ++b)
#pragma unroll
            for (int m = 0; m < 4; ++m)
#pragma unroll
                for (int n = 0; n < 2; ++n) acc[a][b][m][n] = (f32x4){0.f, 0.f, 0.f, 0.f};
    bf16x8 At[4][2], B0[2][2], B1[2][2];
    const char* cA = PG8_APTR(cur); const char* cB = PG8_BPTR(cur);
    PG8_STAGE(PG8_SB(0, 0), cB, voffB); PG8_STAGE(PG8_SB(0, 1), cB + hstepB, voffB); PG8_STAGE(PG8_SA(0, 0), cA, voffA); PG8_STAGE(PG8_SA(0, 1), cA + hstepA, voffA);
    if (wr == 1) PG8_BAR;
    PG8_WAIT_V(2); PG8_BAR;
    PG8_STAGE(PG8_SB(1, 0), cB + kstep, voffB); PG8_STAGE(PG8_SA(1, 0), cA + kstep, voffA); PG8_STAGE(PG8_SB(1, 1), cB + hstepB + kstep, voffB);
    PG8_WAIT_V(6); PG8_BAR;
    for (;;) {
        const bool has_next = S.next(ui + 1, nxt);
        const char* nA = has_next ? PG8_APTR(nxt) : cA; const char* nB = has_next ? PG8_BPTR(nxt) : cB;
        for (int t = 0; t < nt; t += 2) {
            const bool last = (t == nt - 2);
            const char* a1 = cA + (size_t)(t + 1) * kstep;
            const char* a2 = last ? nA : cA + (size_t)(t + 2) * kstep; const char* b2 = last ? nB : cB + (size_t)(t + 2) * kstep;
            const char* a3 = a2 + kstep; const char* b3 = b2 + kstep;
            PG8_LDB(B0, 0, 0); PG8_LDB(B1, 0, 1); PG8_SCHED; PG8_LDA(At, 0, 0); PG8_STAGE(PG8_SA(1, 1), a1 + hstepA, voffA);
            PG8_WAIT_V(8); PG8_WAIT_L(0); PG8_BAR; PG8_MMA(0, 0, At, B0); PG8_MMA(0, 1, At, B1); PG8_BAR; PG8_SCHED;
            PG8_LDA(At, 0, 1); PG8_STAGE(PG8_SB(0, 0), b2, voffB); PG8_STAGE(PG8_SB(0, 1), b2 + hstepB, voffB); PG8_STAGE(PG8_SA(0, 0), a2, voffA);
            PG8_WAIT_V(8); PG8_WAIT_L(0); PG8_BAR; PG8_MMA(1, 0, At, B0); PG8_MMA(1, 1, At, B1); PG8_BAR; PG8_SCHED;
            PG8_LDB(B0, 1, 0); PG8_LDB(B1, 1, 1); PG8_SCHED; PG8_LDA(At, 1, 0); PG8_STAGE(PG8_SA(0, 1), a2 + hstepA, voffA);
            PG8_WAIT_V(8); PG8_WAIT_L(0); PG8_BAR; PG8_MMA(0, 0, At, B0); PG8_MMA(0, 1, At, B1); PG8_BAR; PG8_SCHED;
            PG8_LDA(At, 1, 1); PG8_STAGE(PG8_SB(1, 0), b3, voffB); PG8_STAGE(PG8_SB(1, 1), b3 + hstepB, voffB); PG8_STAGE(PG8_SA(1, 0), a3, voffA);
            PG8_WAIT_V(8); PG8_WAIT_L(0); PG8_BAR; PG8_MMA(1, 0, At, B0); PG8_MMA(1, 1, At, B1); PG8_BAR; PG8_SCHED;
        }
        if (wr == 0) PG8_BAR;
        PG8_TS(1 + 2 * ui);
        { unsigned z_ = 0u; asm volatile("" : "+v"(z_)); const int l2 = (int)__builtin_amdgcn_mbcnt_hi(~0u, __builtin_amdgcn_mbcnt_lo(~0u, z_));
          E(acc, cur, wr, wc, l2 & 15, l2 >> 4);
          E.done(cur, l2); }
        PG8_TS(2 + 2 * ui);
        if (!has_next) break;
#pragma unroll
        for (int a = 0; a < 2; ++a)
#pragma unroll
            for (int b = 0; b < 2; ++b)
#pragma unroll
                for (int m = 0; m < 4; ++m)
#pragma unroll
                    for (int n = 0; n < 2; ++n) acc[a][b][m][n] = (f32x4){0.f, 0.f, 0.f, 0.f};
        cur = nxt; cA = nA; cB = nB; ++ui;
        if (wr == 1) PG8_BAR;
    }
    PG8_WAIT_V(0);
    PG8_BAR;
#undef PG8_SA
#undef PG8_SB
#undef PG8_STAGE
#undef PG8_LDA
#undef PG8_LDB
#undef PG8_MMA
#undef PG8_WAIT_V
#undef PG8_WAIT_L
#undef PG8_BAR
#undef PG8_SCHED
#undef PG8_TS
#undef PG8_APTR
#undef PG8_BPTR
}
__device__ __forceinline__ int cond_of_pm(int pm) { return pm < 16 ? 0 : 1 + ((pm - 16) >> 2); }
__device__ __forceinline__ int kvrow_of(int row) { return row < MC ? row : MC + ((row - MC) >> 10) * (PAST + DSEQ) + PAST + ((row - MC) & 1023); }
__device__ __forceinline__ u32x4 pack8(const f32x4& a, const f32x4& b) { u32x4 w; w.x = cvt_pk_bf16(a[0], a[1]); w.y = cvt_pk_bf16(a[2], a[3]); w.z = cvt_pk_bf16(b[0], b[1]); w.w = cvt_pk_bf16(b[2], b[3]); return w; }

struct EpiIn {
    static constexpr bool PERM = true;
    const float* sumsq; const float* bias; const float* qn; const float* kn; const f32x2* rope;
    bf16_t* Q; bf16_t* KB; bf16_t* VB; __amdgpu_buffer_rsrc_t as3r; float* new_k; float* new_v; int l; unsigned* ucnt;
    __device__ __forceinline__ void done(const Unit& u, int lane) const {
        if (u.pn >= 6) { asm volatile("s_waitcnt vmcnt(0)" ::: "memory"); if (lane == 0) __hip_atomic_fetch_add(ucnt + (((u.pm >> 4) * 2) + (u.pn - 6)) * 64, 1u, RLX_AGENT); } }
    __device__ __forceinline__ void operator()(const f32x4 (&acc)[2][2][4][2], const Unit& u, int wr, int wc, int fr, int fq) const {
        const int pm = u.pm, pn = u.pn; const bool ctx = pm < 16; const int cond = cond_of_pm(pm);
        const float* bz = bias + cond * 2048 + pn * 256 + wc * 32 + 8 * fq;
        f32x4 bv[2][2];
#pragma unroll
        for (int bj = 0; bj < 2; ++bj)
#pragma unroll
            for (int n = 0; n < 2; ++n) bv[bj][n] = *(const f32x4*)(bz + bj * 128 + 4 * n);
        const int rbase = pm * BM + wr * 64 + fr;
        float rsd[8];
#pragma unroll
        for (int g8 = 0; g8 < 8; ++g8) rsd[g8] = sumsq[rbase + (g8 >> 2) * HALF + (g8 & 3) * 16];
#pragma unroll
        for (int g8 = 0; g8 < 8; ++g8) rsd[g8] = rsqrtf(rsd[g8] * (1.f / DM) + EPS);
        if (pn < 4) {
            const bool isq = pn < 2; const float* gv = isq ? qn : kn;
            const int G = (pn & 1) * 4 + wc;
            const int cb = 32 * (fq >> 1) + 8 * (fq & 1);
            f32x4 gg[2][2];
#pragma unroll
            for (int bj = 0; bj < 2; ++bj)
#pragma unroll
                for (int n = 0; n < 2; ++n) gg[bj][n] = *(const f32x4*)(gv + cb + 16 * bj + 4 * n);
            const float qs = isq ? C2 : 1.f;
#pragma unroll
            for (int ai = 0; ai < 2; ++ai)
#pragma unroll
                for (int m = 0; m < 4; ++m) {
                    const int row = rbase + ai * HALF + m * 16;
                    const float rstd = rsd[ai * 4 + m];
                    f32x4 v[2][2]; float ss = 0.f;
#pragma unroll
                    for (int bj = 0; bj < 2; ++bj)
#pragma unroll
                        for (int n = 0; n < 2; ++n) { v[bj][n] = acc[ai][bj][m][n] * rstd + bv[bj][n]; const f32x4 t = v[bj][n] * v[bj][n]; ss += (t[0] + t[1]) + (t[2] + t[3]); }
                    { const int ln_ = fq * 16 + fr; ss += shfl_xor_l(ss, 16, ln_); ss += shfl_xor_l(ss, 32, ln_); }
                    const float rn = rsqrtf(ss * (1.f / 64.f) + EPS);
#pragma unroll
                    for (int bj = 0; bj < 2; ++bj)
#pragma unroll
                        for (int n = 0; n < 2; ++n) v[bj][n] = v[bj][n] * rn * gg[bj][n];
                    if (ctx) {
                        if (!isq) { float* nk = new_k + ((size_t)((row >> 8) * DEPTH + l) * SEQ + (row & 255)) * 512 + G * 64 + cb;
#pragma unroll
                            for (int bj = 0; bj < 2; ++bj) { *(f32x4*)(nk + 16 * bj) = v[bj][0]; *(f32x4*)(nk + 16 * bj + 4) = v[bj][1]; } }
                    } else {
                        const int t = (row - MC) & 1023; const int pos = (fq >> 1) ? (t & 63) : (t >> 6);
                        const f32x2* rp = rope + pos * 16 + 8 * (fq & 1);
#pragma unroll
                        for (int n = 0; n < 2; ++n)
#pragma unroll
                            for (int j = 0; j < 4; ++j) { const f32x2 cs = rp[4 * n + j]; const float x1 = v[0][n][j], x2 = v[1][n][j]; v[0][n][j] = x1 * cs.x - x2 * cs.y; v[1][n][j] = x1 * cs.y + x2 * cs.x; }
                    }
                    bf16_t* dst = isq ? (Q + (size_t)row * 512) : (KB + (size_t)kvrow_of(row) * 512);
                    dst += G * 64 + cb;
#pragma unroll
                    for (int bj = 0; bj < 2; ++bj) *(u32x4*)(dst + 16 * bj) = pack8(v[bj][0] * qs, v[bj][1] * qs);
                }
        } else if (pn < 6) {
            const int col0 = (pn - 4) * 256 + wc * 32 + 8 * fq;
#pragma unroll
            for (int ai = 0; ai < 2; ++ai)
#pragma unroll
                for (int m = 0; m < 4; ++m) {
                    const int row = rbase + ai * HALF + m * 16;
                    const float rstd = rsd[ai * 4 + m];
                    bf16_t* dst = VB + (size_t)kvrow_of(row) * 512 + col0;
#pragma unroll
                    for (int bj = 0; bj < 2; ++bj) { const f32x4 a = acc[ai][bj][m][0] * rstd + bv[bj][0], b = acc[ai][bj][m][1] * rstd + bv[bj][1];
                        *(u32x4*)(dst + 128 * bj) = pack8(a, b);
                        if (ctx) { float* nv = new_v + ((size_t)((row >> 8) * DEPTH + l) * SEQ + (row & 255)) * 512 + col0 + 128 * bj; *(f32x4*)nv = a; *(f32x4*)(nv + 4) = b; } }
                }
        } else {
            const int cu0 = (pn - 6) * 256 + wc * 32 + 8 * fq;
#pragma unroll
            for (int ai = 0; ai < 2; ++ai)
#pragma unroll
                for (int m = 0; m < 4; ++m) {
                    const int row = rbase + ai * HALF + m * 16;
                    const float rstd = rsd[ai * 4 + m];
#pragma unroll
                    for (int bj = 0; bj < 2; ++bj) { const int cu = cu0 + 128 * bj; const f32x4 a = acc[ai][bj][m][0] * rstd + bv[bj][0], b = acc[ai][bj][m][1] * rstd + bv[bj][1];
                        __builtin_amdgcn_raw_buffer_store_b128(pack8(a, b), as3r, (int)(((unsigned)((cu >> 4) * NCHUNK + (row >> 4)) * 512u + (row & 15) * 16 + (cu & 15)) * 2u), 0,   16); }
                }
        }
    }
};
struct EpiS1 {
    static constexpr bool PERM = false;
    float* E;
    __device__ __forceinline__ void done(const Unit&, int) const {}
    __device__ __forceinline__ void operator()(const f32x4 (&acc)[2][2][4][2], const Unit& u, int wr, int wc, int fr, int fq) const {
        const int rbase = u.pm * BM + wr * 64 + fr, col0 = wc * 32 + 4 * fq;
#pragma unroll
        for (int ai = 0; ai < 2; ++ai)
#pragma unroll
            for (int m = 0; m < 4; ++m) { float* dst = E + ((size_t)u.g * NCHUNK + rbase + ai * HALF + m * 16) * 256 + col0;
#pragma unroll
                for (int bj = 0; bj < 2; ++bj)
#pragma unroll
                    for (int n = 0; n < 2; ++n) *(f32x4*)(dst + bj * HALF + n * 16) = acc[ai][bj][m][n]; }
    }
};
struct EpiS3 {
    static constexpr bool PERM = true;
    __amdgpu_buffer_rsrc_t zr;
    __device__ __forceinline__ void done(const Unit&, int) const {}
    __device__ __forceinline__ void operator()(const f32x4 (&acc)[2][2][4][2], const Unit& u, int wr, int wc, int fr, int fq) const {
        const int rbase = u.pm * BM + wr * 64 + fr;
#pragma unroll
        for (int ai = 0; ai < 2; ++ai)
#pragma unroll
            for (int m = 0; m < 4; ++m) { const int chunk = rbase + ai * HALF + m * 16;
#pragma unroll
                for (int bj = 0; bj < 2; ++bj) { const int tt = 8 * bj + 2 * wc + (fq >> 1), c0 = 8 * (fq & 1);
                    f32x4 a = acc[ai][bj][m][0], b = acc[ai][bj][m][1];
#pragma unroll
                    for (int j = 0; j < 4; ++j) { a[j] = gelu_tanh_f(a[j]); b[j] = gelu_tanh_f(b[j]); }
                    __builtin_amdgcn_raw_buffer_store_b128(pack8(a, b), zr, (int)((((unsigned)chunk * 16u + tt) * 512u + u.g * 16 + c0) * 2u), 0,   16); } }
    }
};
struct EpiGlu {
    static constexpr bool PERM = true;
    const bf16_t* Z; const float* bg; bf16_t* CAT;
    __device__ __forceinline__ void done(const Unit&, int) const {}
    __device__ __forceinline__ void operator()(const f32x4 (&acc)[2][2][4][2], const Unit& u, int wr, int wc, int fr, int fq) const {
        const int rbase = u.pm * BM + wr * 64 + fr, col0 = u.pn * BM + wc * 32 + 8 * fq;
        f32x4 bv[2][2];
#pragma unroll
        for (int bj = 0; bj < 2; ++bj)
#pragma unroll
            for (int n = 0; n < 2; ++n) bv[bj][n] = *(const f32x4*)(bg + col0 + bj * HALF + 4 * n);
#pragma unroll
        for (int ai = 0; ai < 2; ++ai)
#pragma unroll
            for (int m = 0; m < 4; ++m) { const int row = rbase + ai * HALF + m * 16;
#pragma unroll
                for (int bj = 0; bj < 2; ++bj) { const u32x4 zw = *(const u32x4*)(Z + (size_t)row * 512 + col0 + bj * HALF);
                    f32x4 a = acc[ai][bj][m][0] + bv[bj][0], b = acc[ai][bj][m][1] + bv[bj][1];
                    a[0] = bflo(zw.x) * sigmoid_f(a[0]); a[1] = bfhi(zw.x) * sigmoid_f(a[1]); a[2] = bflo(zw.y) * sigmoid_f(a[2]); a[3] = bfhi(zw.y) * sigmoid_f(a[3]);
                    b[0] = bflo(zw.z) * sigmoid_f(b[0]); b[1] = bfhi(zw.z) * sigmoid_f(b[1]); b[2] = bflo(zw.w) * sigmoid_f(b[2]); b[3] = bfhi(zw.w) * sigmoid_f(b[3]);
                    *(u32x4*)(CAT + (size_t)row * 1024 + 512 + col0 + bj * HALF) = pack8(a, b); } }
    }
};
template <bool IN_F32, bool OUT_F32> struct EpiRes {
    static constexpr bool PERM = true;
    const float* xin0; const float* xin1;
    const bf16_t* xrin;
    float* xout; bf16_t* xrout;
    const float* gate;
    const float* gn; const float* sc;
    bf16_t* XS; float* ssq;
    __device__ __forceinline__ void done(const Unit&, int) const {}
    __device__ __forceinline__ void operator()(const f32x4 (&acc)[2][2][4][2], const Unit& u, int wr, int wc, int fr, int fq) const {
        const int pm = u.pm, cond = cond_of_pm(pm); const int col0 = u.pn * BM + wc * 32 + 8 * fq; const int rbase = pm * BM + wr * 64 + fr;
        const bool donorm = (gn != nullptr);
        f32x4 gt[2][2], gs[2][2];
#pragma unroll
        for (int bj = 0; bj < 2; ++bj)
#pragma unroll
            for (int n = 0; n < 2; ++n) { const int c = col0 + bj * HALF + n * 4; gt[bj][n] = *(const f32x4*)(gate + cond * 6144 + c);
                if (donorm) { const f32x4 g4 = *(const f32x4*)(gn + c), s4 = *(const f32x4*)(sc + cond * 6144 + c); gs[bj][n] = g4 * (s4 + 1.f); } else gs[bj][n] = (f32x4){0.f, 0.f, 0.f, 0.f}; }
        constexpr int RD = IN_F32 ? 2 : 3;
        f32x4 xr[RD][2][2]; u32x4 xb[RD][2];
#define ER_LOAD(G_, SLOT_) do { const int row_ = rbase + ((G_) >> 2) * HALF + ((G_) & 3) * 16; \
            if (IN_F32) { const float* xi_ = (row_ < MC) ? (xin0 + (size_t)row_ * DM) : (xin1 + (size_t)(row_ - MC) * DM); \
                _Pragma("unroll") for (int bj = 0; bj < 2; ++bj) { xr[SLOT_][bj][0] = *(const f32x4*)(xi_ + col0 + bj * HALF); xr[SLOT_][bj][1] = *(const f32x4*)(xi_ + col0 + bj * HALF + 4); } } \
            else { _Pragma("unroll") for (int bj = 0; bj < 2; ++bj) xb[SLOT_][bj] = *(const u32x4*)(xrin + (size_t)row_ * DM + col0 + bj * HALF); } } while (0)
        ER_LOAD(0, 0); ER_LOAD(1, 1); if (RD == 3) ER_LOAD(2, RD - 1);
#pragma unroll
        for (int g = 0; g < 8; ++g) { const int ai = g >> 2, m = g & 3, sl = g % RD; const int row = rbase + ai * HALF + m * 16;
            float ss = 0.f; f32x4 x0[2], x1[2];
#pragma unroll
            for (int bj = 0; bj < 2; ++bj) { f32x4 a, b;
                if (IN_F32) { a = xr[sl][bj][0]; b = xr[sl][bj][1]; } else { const u32x4 w = xb[sl][bj]; a = (f32x4){bflo(w.x), bfhi(w.x), bflo(w.y), bfhi(w.y)}; b = (f32x4){bflo(w.z), bfhi(w.z), bflo(w.w), bfhi(w.w)}; }
                x0[bj] = a + gt[bj][0] * acc[ai][bj][m][0]; x1[bj] = b + gt[bj][1] * acc[ai][bj][m][1]; }
            if (g + RD < 8) ER_LOAD(g + RD, sl);
#pragma unroll
            for (int bj = 0; bj < 2; ++bj) { const int c = col0 + bj * HALF;
                if (OUT_F32) { *(f32x4*)(xout + (size_t)row * DM + c) = x0[bj]; *(f32x4*)(xout + (size_t)row * DM + c + 4) = x1[bj]; }
                else *(u32x4*)(xrout + (size_t)row * DM + c) = pack8(x0[bj], x1[bj]);
                if (donorm) { const f32x4 t0 = x0[bj] * x0[bj], t1 = x1[bj] * x1[bj]; ss += ((t0[0] + t0[1]) + (t0[2] + t0[3])) + ((t1[0] + t1[1]) + (t1[2] + t1[3]));
                    *(u32x4*)(XS + (size_t)row * DM + c) = pack8(x0[bj] * gs[bj][0], x1[bj] * gs[bj][1]); } }
            if (donorm) { { const int ln_ = fq * 16 + fr; ss += shfl_xor_l(ss, 16, ln_); ss += shfl_xor_l(ss, 32, ln_); } if (fq == 0) atomicAdd(ssq + row, ss); }
        }
#undef ER_LOAD
    }
};
struct EpiUp {
    static constexpr bool PERM = true;
    const float* sumsq; const float* bias; bf16_t* UP;
    __device__ __forceinline__ void done(const Unit&, int) const {}
    __device__ __forceinline__ void operator()(const f32x4 (&acc)[2][2][4][2], const Unit& u, int wr, int wc, int fr, int fq) const {
        const int pm = u.pm, cond = cond_of_pm(pm); const int col0 = u.pn * BM + wc * 32 + 8 * fq; const int rbase = pm * BM + wr * 64 + fr;
        f32x4 bv[2][2];
#pragma unroll
        for (int bj = 0; bj < 2; ++bj)
#pragma unroll
            for (int n = 0; n < 2; ++n) bv[bj][n] = *(const f32x4*)(bias + cond * 4096 + col0 + bj * HALF + 4 * n);
#pragma unroll
        for (int ai = 0; ai < 2; ++ai)
#pragma unroll
            for (int m = 0; m < 4; ++m) { const int row = rbase + ai * HALF + m * 16; const float rstd = rsqrtf(sumsq[row] * (1.f / DM) + EPS);
#pragma unroll
                for (int bj = 0; bj < 2; ++bj) *(u32x4*)(UP + (size_t)row * 4096 + col0 + bj * HALF) = pack8(acc[ai][bj][m][0] * rstd + bv[bj][0], acc[ai][bj][m][1] * rstd + bv[bj][1]); }
    }
};

__device__ __forceinline__ float dpp_shr1(float v) { return __uint_as_float((unsigned)__builtin_amdgcn_update_dpp(0, (int)__float_as_uint(v), 0x111, 0xf, 0xf, false)); }
__device__ __forceinline__ float dpp_shl1(float v) { return __uint_as_float((unsigned)__builtin_amdgcn_update_dpp(0, (int)__float_as_uint(v), 0x101, 0xf, 0xf, false)); }
struct EpiUpConv {
    static constexpr bool PERM = true;
    const float* sumsq; const float* bias; const float* cw; const float* cb; bf16_t* G; bf16_t* HALO;
    __device__ __forceinline__ void done(const Unit&, int) const {}
    __device__ __forceinline__ void operator()(const f32x4 (&acc)[2][2][4][2], const Unit& u, int wr, int wc, int fr, int fq) const {
        const int pm = u.pm, pn = u.pn, cond = cond_of_pm(pm);
        const int posv = pn * 256 + wc * 32 + 8 * fq, av = pn * 128 + wc * 32 + 8 * fq;
        float rs[2][4];
#pragma unroll
        for (int ai = 0; ai < 2; ++ai)
#pragma unroll
            for (int m = 0; m < 4; ++m) rs[ai][m] = sumsq[pm * BM + ai * HALF + wr * 64 + 4 * fr + m];
#pragma unroll
        for (int ai = 0; ai < 2; ++ai)
#pragma unroll
            for (int m = 0; m < 4; ++m) rs[ai][m] = rsqrtf(rs[ai][m] * (1.f / DM) + EPS);
#pragma unroll
        for (int n = 0; n < 2; ++n) {
            const int c = av + 4 * n;
            const f32x4 bvv = *(const f32x4*)(bias + cond * 4096 + posv + 4 * n), bvg = *(const f32x4*)(bias + cond * 4096 + posv + 128 + 4 * n);
            const f32x4 w0v = *(const f32x4*)(cw + c), w1v = *(const f32x4*)(cw + 4096 + c), w2v = *(const f32x4*)(cw + 8192 + c), cbv = *(const f32x4*)(cb + c);
            const f32x4 w0g = *(const f32x4*)(cw + 2048 + c), w1g = *(const f32x4*)(cw + 4096 + 2048 + c), w2g = *(const f32x4*)(cw + 8192 + 2048 + c), cbg = *(const f32x4*)(cb + 2048 + c);
#pragma unroll
            for (int ai = 0; ai < 2; ++ai) {
                const int tok0 = pm * BM + ai * HALF + wr * 64 + 4 * fr; const int sl = pm * 4 + ai * 2 + wr;
                f32x4 pv[4], pg[4];
#pragma unroll
                for (int m = 0; m < 4; ++m) { pv[m] = acc[ai][0][m][n] * rs[ai][m] + bvv; pg[m] = acc[ai][1][m][n] * rs[ai][m] + bvg; }
                f32x4 pvp, pvn, pgp, pgn;
#pragma unroll
                for (int j = 0; j < 4; ++j) { pvp[j] = dpp_shr1(pv[3][j]); pvn[j] = dpp_shl1(pv[0][j]); pgp[j] = dpp_shr1(pg[3][j]); pgn[j] = dpp_shl1(pg[0][j]); }
#pragma unroll
                for (int m = 0; m < 4; ++m) {
                    const f32x4 zv = cbv + w0v * (m == 0 ? pvp : pv[m == 0 ? 0 : m - 1]) + w1v * pv[m] + w2v * (m == 3 ? pvn : pv[m == 3 ? 3 : m + 1]);
                    const f32x4 zg = cbg + w0g * (m == 0 ? pgp : pg[m == 0 ? 0 : m - 1]) + w1g * pg[m] + w2g * (m == 3 ? pgn : pg[m == 3 ? 3 : m + 1]);
                    u32x2 w; w.x = cvt_pk_bf16(silu_f(zg[0]) * zv[0], silu_f(zg[1]) * zv[1]); w.y = cvt_pk_bf16(silu_f(zg[2]) * zv[2], silu_f(zg[3]) * zv[3]);
                    *(u32x2*)(G + (size_t)(tok0 + m) * 2048 + c) = w; }
                if (fr == 0 || fr == 15) { const int m0 = fr == 0 ? 0 : 2;
#pragma unroll
                    for (int mm = 0; mm < 2; ++mm) { const f32x4 a = fr == 0 ? pv[mm] : pv[2 + mm], b = fr == 0 ? pg[mm] : pg[2 + mm];
                        bf16_t* hp = HALO + ((size_t)sl * 4 + m0 + mm) * 4096 + posv + 4 * n;
                        u32x2 wa; wa.x = cvt_pk_bf16(a[0], a[1]); wa.y = cvt_pk_bf16(a[2], a[3]); *(u32x2*)hp = wa;
                        u32x2 wb; wb.x = cvt_pk_bf16(b[0], b[1]); wb.y = cvt_pk_bf16(b[2], b[3]); *(u32x2*)(hp + 128) = wb; } }
            }
        }
    }
};
constexpr int AT_SLOT = 32768, AT_NSLOT = 4, AT_VOFF = 16384, AT_X = 0, AT_ST = 65536;
__device__ __forceinline__ void glds16(const void* gsrc, unsigned lds_dst) { unsigned keep;
    asm volatile("s_mov_b32 %0, m0\n\ts_mov_b32 m0, %2\n\ts_nop 0\n\tglobal_load_lds_dwordx4 %1, off\n\ts_mov_b32 m0, %0" : "=&s"(keep) : "v"(gsrc), "s"(lds_dst) : "memory"); }
#define AT_WAIT_BAR(N) asm volatile("s_waitcnt vmcnt(" #N ") lgkmcnt(0)\n\ts_barrier" ::: "memory")
#define AT_SB() __builtin_amdgcn_sched_barrier(0)
__device__ __forceinline__ s16x4 vtr(const LAS char* p) { typedef short v4i16_t __attribute__((ext_vector_type(4))); return __builtin_bit_cast(s16x4, __builtin_amdgcn_ds_read_tr16_b64_v4i16((LAS v4i16_t*)p)); }
__device__ __forceinline__ int crow(int r, int hi) { return (r & 3) + 8 * (r >> 2) + 4 * hi; }

struct AttnArgs { const bf16_t* Q; const bf16_t* KB; const bf16_t* VB; bf16_t* CAT; const float* subln; float lam; float oml; };

__device__ __forceinline__ void attn_unit(LAS unsigned char* lds, const int tid, const AttnArgs& A, int seq, int h, int qblk) {
    const int lane = tid & 63, r32 = lane & 31, hi = lane >> 5; const int wid = __builtin_amdgcn_readfirstlane(tid >> 6);
    const int rg = wid & 3, s = wid >> 2;
    const bool ctx = seq < NB;
    const int qrow0 = ctx ? seq * SEQ + qblk * 128 : MC + (seq - NB) * DSEQ + qblk * 128;
    const int krow0 = ctx ? seq * SEQ : MC + (seq - NB) * (PAST + DSEQ);
    const int NT = ctx ? SEQ / 64 : (PAST + DSEQ) / 64;
    const unsigned lds0 = (unsigned)(uintptr_t)lds;
    const bf16_t* ksrc0 = A.KB + (size_t)(krow0 + lane) * 512 + h * 128 + wid * 8;
    const bf16_t* vsrc0 = A.VB + (size_t)(krow0 + 16 * (wid & 3) + (lane >> 2)) * 512 + h * 128 + (wid >> 2) * 32 + (lane & 3) * 8;
    const unsigned kdst = lds0 + wid * 1024, vdst = lds0 + AT_VOFF + ((wid >> 2) * 4 + (wid & 3)) * 1024;
#define AT_DMA(t, slot) do { const size_t _o = (size_t)(t) * 64 * 512; const unsigned _s = (unsigned)(slot) * AT_SLOT; \
        glds16(ksrc0 + _o, (unsigned)__builtin_amdgcn_readfirstlane(kdst + _s)); glds16(ksrc0 + _o + 64, (unsigned)__builtin_amdgcn_readfirstlane(kdst + _s + 8 * 1024)); \
        glds16(vsrc0 + _o, (unsigned)__builtin_amdgcn_readfirstlane(vdst + _s)); glds16(vsrc0 + _o + 64, (unsigned)__builtin_amdgcn_readfirstlane(vdst + _s + 8 * 1024)); } while (0)
    AT_DMA(0, 0); AT_DMA(1, 1); AT_DMA(2, 2);
    bf16x8 qr[4];
    { const bf16_t* qp = A.Q + (size_t)(qrow0 + rg * 32 + r32) * 512 + h * 128 + s * 64 + hi * 8;
#pragma unroll
      for (int d0 = 0; d0 < 4; ++d0) qr[d0] = *(const bf16x8*)(qp + d0 * 16); }
    f32x16 o[4];
#pragma unroll
    for (int d0 = 0; d0 < 4; ++d0)
#pragma unroll
        for (int r = 0; r < 16; ++r) o[d0][r] = 0.f;
    float lsum = 0.f;
    const LAS char* kfrag0 = (const LAS char*)lds + (s * 8 + hi) * 1024 + r32 * 16;
    const LAS char* vfrag0 = (const LAS char*)lds + AT_VOFF + ((lane >> 4) & 1) * 32 + (lane & 3) * 8 + (4 * hi + ((lane & 15) >> 2)) * 64;
    f32x16 pc0, pc1;
#define AT_KLOAD(kfr, slot) do { const LAS char* _k = kfrag0 + (slot) * AT_SLOT; _Pragma("unroll") for (int d0 = 0; d0 < 4; ++d0) { kfr[2 * d0] = *(const LAS bf16x8*)(_k + d0 * 2048); kfr[2 * d0 + 1] = *(const LAS bf16x8*)(_k + d0 * 2048 + 512); } } while (0)
#define AT_VLOAD(vv, slot, ks) do { const LAS char* _v = vfrag0 + (slot) * AT_SLOT + (ks) * 1024; _Pragma("unroll") for (int d0 = 0; d0 < 4; ++d0) { const s16x4 lo = vtr(_v + d0 * 4096), hh = vtr(_v + d0 * 4096 + 512); \
        vv[d0] = (bf16x8){lo[0], lo[1], lo[2], lo[3], hh[0], hh[1], hh[2], hh[3]}; } } while (0)
#define AT_EXP2(P, i, W) do { P[2 * (i)] = fast_exp2(P[2 * (i)]); P[2 * (i) + 1] = fast_exp2(P[2 * (i) + 1]); sacc += P[2 * (i)] + P[2 * (i) + 1]; W = cvt_pk_bf16(P[2 * (i)], P[2 * (i) + 1]); } while (0)
    AT_WAIT_BAR(8);
    { bf16x8 kfr[8]; AT_KLOAD(kfr, 0);
#pragma unroll
      for (int r = 0; r < 16; ++r) { pc0[r] = 0.f; pc1[r] = 0.f; }
#pragma unroll
      for (int d0 = 0; d0 < 4; ++d0) { pc0 = __builtin_amdgcn_mfma_f32_32x32x16_bf16(kfr[2 * d0], qr[d0], pc0, 0, 0, 0); pc1 = __builtin_amdgcn_mfma_f32_32x32x16_bf16(kfr[2 * d0 + 1], qr[d0], pc1, 0, 0, 0); } }
    int slot = 0;
    for (int t = 0; t < NT; ++t) {
        const bool has_next = t + 1 < NT;
        if (t + 2 < NT) AT_WAIT_BAR(4); else AT_WAIT_BAR(0);
        if (t + 3 < NT) AT_DMA(t + 3, (slot + 3) & 3);
        const int slot_n = (slot + 1) & 3;
        bf16x8 kfr[8], va[4], vb[4]; u32x4 pw[4]; f32x16 pn0, pn1; float sacc = 0.f;
        const LAS char* kn_ = kfrag0 + slot_n * AT_SLOT;
#define AT_K1(d0) do { kfr[2 * (d0)] = *(const LAS bf16x8*)(kn_ + (d0) * 2048); kfr[2 * (d0) + 1] = *(const LAS bf16x8*)(kn_ + (d0) * 2048 + 512); } while (0)
        if (has_next) { AT_K1(0); AT_K1(1); }
        AT_SB();
        if (has_next) {
#pragma unroll
            for (int r = 0; r < 16; ++r) { pn0[r] = 0.f; pn1[r] = 0.f; }
#pragma unroll
            for (int i = 0; i < 8; ++i) { const int d0 = i >> 1;
                if (i & 1) pn1 = __builtin_amdgcn_mfma_f32_32x32x16_bf16(kfr[2 * d0 + 1], qr[d0], pn1, 0, 0, 0); else pn0 = __builtin_amdgcn_mfma_f32_32x32x16_bf16(kfr[2 * d0], qr[d0], pn0, 0, 0, 0);
                AT_EXP2(pc0, i, pw[i >> 2][i & 3]);
                if (i == 0) AT_K1(2);
                if (i == 1) AT_K1(3);
                if (i == 3) AT_VLOAD(va, slot, 0);
                if (i == 5) AT_VLOAD(vb, slot, 1);
                AT_SB(); }
        } else {
            AT_VLOAD(va, slot, 0); AT_VLOAD(vb, slot, 1);
#pragma unroll
            for (int i = 0; i < 8; ++i) AT_EXP2(pc0, i, pw[i >> 2][i & 3]);
            AT_SB();
        }
        bf16x8 vc[4], vd[4];
#pragma unroll
        for (int i = 0; i < 8; ++i) { const int d0 = i & 3;
            if (i < 4) o[d0] = __builtin_amdgcn_mfma_f32_32x32x16_bf16(va[d0], __builtin_bit_cast(bf16x8, pw[0]), o[d0], 0, 0, 0);
            else       o[d0] = __builtin_amdgcn_mfma_f32_32x32x16_bf16(vb[d0], __builtin_bit_cast(bf16x8, pw[1]), o[d0], 0, 0, 0);
            AT_EXP2(pc1, i, pw[2 + (i >> 2)][i & 3]);
            if (i == 1) AT_VLOAD(vc, slot, 2);
            if (i == 5) AT_VLOAD(vd, slot, 3);
            AT_SB(); }
#pragma unroll
        for (int d0 = 0; d0 < 4; ++d0) o[d0] = __builtin_amdgcn_mfma_f32_32x32x16_bf16(vc[d0], __builtin_bit_cast(bf16x8, pw[2]), o[d0], 0, 0, 0);
#pragma unroll
        for (int d0 = 0; d0 < 4; ++d0) o[d0] = __builtin_amdgcn_mfma_f32_32x32x16_bf16(vd[d0], __builtin_bit_cast(bf16x8, pw[3]), o[d0], 0, 0, 0);
        lsum += sacc;
        if (has_next) { pc0 = pn0; pc1 = pn1; }
        slot = slot_n;
    }
    lsum += shfl_xor_l(lsum, 32, lane);
    const float inv = (s == 0 ? 1.f : A.lam) / lsum;
    AT_WAIT_BAR(0);
    LAS float* X = (LAS float*)(lds + AT_X) + rg * 4096;
    if (s == 1) {
#pragma unroll
        for (int d0 = 0; d0 < 4; ++d0)
#pragma unroll
            for (int r = 0; r < 16; ++r) X[(d0 * 16 + r) * 64 + lane] = o[d0][r] * inv;
    }
    AT_WAIT_BAR(0);
    if (s == 0) {
        float ss = 0.f;
#pragma unroll
        for (int d0 = 0; d0 < 4; ++d0)
#pragma unroll
            for (int r = 0; r < 16; ++r) { const float v = o[d0][r] * inv - X[(d0 * 16 + r) * 64 + lane]; o[d0][r] = v; ss += v * v; }
        ss += shfl_xor_l(ss, 32, lane);
        const float rn = rsqrtf(ss * (1.f / 128.f) + EPS) * A.oml;
        LAS bf16_t* stg = (LAS bf16_t*)(lds + AT_ST) + rg * (32 * 136);
#pragma unroll
        for (int d0 = 0; d0 < 4; ++d0)
#pragma unroll
            for (int rq = 0; rq < 4; ++rq) { const int dv = 32 * d0 + 8 * rq + 4 * hi; const f32x4 g4 = *(const f32x4*)(A.subln + dv);
                u32x2 w; w.x = cvt_pk_bf16(o[d0][4 * rq] * rn * g4[0], o[d0][4 * rq + 1] * rn * g4[1]); w.y = cvt_pk_bf16(o[d0][4 * rq + 2] * rn * g4[2], o[d0][4 * rq + 3] * rn * g4[3]);
                *(LAS u32x2*)(stg + r32 * 136 + dv) = w; }
        asm volatile("s_waitcnt lgkmcnt(0)" ::: "memory");
        bf16_t* dst = A.CAT + (size_t)(qrow0 + rg * 32) * 1024 + h * 128;
#pragma unroll
        for (int i = 0; i < 8; ++i) { const int row = i * 4 + (lane >> 4), ch = lane & 15; const u32x4 v = *(const LAS u32x4*)(stg + row * 136 + ch * 8); *(u32x4*)(dst + (size_t)row * 1024 + ch * 8) = v; }
    }
    AT_WAIT_BAR(0);
#undef AT_DMA
#undef AT_KLOAD
#undef AT_K1
#undef AT_VLOAD
#undef AT_EXP2
}
struct Args { const float* in[34]; float* out; unsigned char* ws; int stop_after; int pad; };
struct ArgsG { GAS const float* in[34]; GAS float* out; GAS unsigned char* ws; int stop_after; int pad; };
typedef const __attribute__((address_space(4))) ArgsG* kargs_t;
struct Frame {
    LAS unsigned char* lds; int tid, lane, wave, vcu, bid, G;
    kargs_t ka; float* out; unsigned char* ws;
    float* misc; unsigned* ctl;
};
#define LDS_WAIT() asm volatile("s_waitcnt lgkmcnt(0)" ::: "memory")
#define VM_WAIT() asm volatile("s_waitcnt vmcnt(0)" ::: "memory")

template <int MAP> __device__ __forceinline__ int src_col(int p);
template <int MODE, int MAP, int NC> __device__ __forceinline__ void gemv9_task(Frame& F, const float* W, int ldw, int l, int voff, int strip, float* out, int ldo, const float* add) {
    LAS float* sc = (LAS float*)F.lds; LAS float* red = sc + 9 * 1024;
    for (int i = F.tid; i < 9 * 1024; i += NTHREADS) { const int cond = i >> 10, k = i & 1023; float v;
        if (MODE == 0) { v = cond == 0 ? ((const float*)F.ka->in[6])[k] : ((const float*)F.ka->in[5])[(cond - 1) * 1024 + k]; v = v / (1.f + expf(-v)); } else v = F.misc[MI_MOD + (l * 9 + cond) * 6144 + voff + k];
        sc[i] = v; }
    __syncthreads();
    const int j = strip * NC + (F.lane < NC ? F.lane : NC - 1); const float* w = W + (size_t)(F.wave * 128) * ldw + src_col<MAP>(j);
    float acc[9];
#pragma unroll
    for (int b = 0; b < 9; ++b) acc[b] = 0.f;
#pragma unroll 16
    for (int k = 0; k < 128; ++k) { const float wv = w[(size_t)k * ldw];
#pragma unroll
        for (int b = 0; b < 9; ++b) acc[b] += sc[b * 1024 + F.wave * 128 + k] * wv; }
#pragma unroll
    for (int b = 0; b < 9; ++b) red[(F.wave * 9 + b) * 64 + F.lane] = acc[b];
    __syncthreads();
    for (int i = F.tid; i < 9 * 64; i += NTHREADS) { const int b = i >> 6, ln = i & 63; if (ln >= NC) continue; float s_ = 0.f;
#pragma unroll
        for (int w8 = 0; w8 < 8; ++w8) s_ += red[(w8 * 9 + b) * 64 + ln];
        const int jj = strip * NC + ln; out[(size_t)b * ldo + jj] = s_ + (add ? add[jj] : 0.f); }
    __syncthreads();
}
template <int MAP> __device__ __forceinline__ int src_col(int p) {
    if (MAP == 1) { if (p >= 1024) return p; const int pn = p >> 8, r = p & 255, bj = r >> 7, wc = (r >> 5) & 3, fq = (r >> 3) & 3, low = r & 7; return 256 * pn + 64 * wc + 32 * (fq >> 1) + 16 * bj + 8 * (fq & 1) + low; }
    if (MAP == 2) { const int pn = p >> 8, bj = (p >> 7) & 1, r = p & 127; return bj * 2048 + 128 * pn + r; }
    return p;
}
__device__ __forceinline__ void mod_task3(Frame& F, int task) {
    const int l = task / 96, r = task % 96, kq = r / 24, cg = r % 24;
    LAS float* sc = (LAS float*)F.lds; LAS float* red = sc + 9 * 256;
    for (int i = F.tid; i < 9 * 256; i += NTHREADS) { const int cond = i >> 8, k = kq * 256 + (i & 255); const float v = cond == 0 ? ((const float*)F.ka->in[6])[k] : ((const float*)F.ka->in[5])[(cond - 1) * 1024 + k]; sc[i] = v / (1.f + expf(-v)); }
    __syncthreads();
    const float* w = ((const float*)F.ka->in[7]) + ((size_t)l * DM + kq * 256 + F.wave * 32) * 6144 + cg * 256 + F.lane * 4;
    f32x4 acc[9];
#pragma unroll
    for (int b = 0; b < 9; ++b) acc[b] = (f32x4){0.f, 0.f, 0.f, 0.f};
#pragma unroll
    for (int h = 0; h < 2; ++h) { f32x4 wv[16];
#pragma unroll
        for (int k = 0; k < 16; ++k) wv[k] = *(const f32x4*)(w + (size_t)(h * 16 + k) * 6144);
#pragma unroll
        for (int k = 0; k < 16; ++k)
#pragma unroll
            for (int b = 0; b < 9; ++b) acc[b] += wv[k] * sc[b * 256 + F.wave * 32 + h * 16 + k]; }
#pragma unroll
    for (int b = 0; b < 9; ++b) *(LAS f32x4*)(red + (F.wave * 9 + b) * 256 + F.lane * 4) = acc[b];
    __syncthreads();
    for (int i = F.tid; i < 9 * 256; i += NTHREADS) { const int b = i >> 8, c = i & 255; float v = 0.f;
#pragma unroll
        for (int w8 = 0; w8 < 8; ++w8) v += red[(w8 * 9 + b) * 256 + c];
        const int col = cg * 256 + c; if (kq == 0) v += ((const float*)F.ka->in[8])[l * 6144 + col];
        atomicAdd(F.misc + MI_MOD + (l * 9 + b) * 6144 + col, v); }
    __syncthreads();
}
template <int MAP, bool BIAS> __device__ __forceinline__ void transpose_item(Frame& F, const float* W, int K, int N, bf16_t* WT, LAS float* scr, int item, const float* shv, float* bias) {
    const int lane = F.lane; const int nblk = N / 64, kb = item / nblk, nb = item % nblk, k0 = 64 * kb, n0 = 64 * nb;
    const int sc_ = src_col<MAP>(n0 + lane);
    float tv[64];
#pragma unroll
    for (int i = 0; i < 64; ++i) tv[i] = W[(size_t)(k0 + i) * N + sc_];
#pragma unroll
    for (int i = 0; i < 64; ++i) scr[i * 65 + lane] = tv[i];
    LDS_WAIT(); asm volatile("" ::: "memory");
    const int c = lane & 7;
#pragma unroll
    for (int j = 0; j < 8; ++j) { const int n = (lane >> 3) + 8 * j; const LAS float* s_ = scr + (8 * c) * 65 + n;
        u32x4 o; o.x = cvt_pk_bf16(s_[0 * 65], s_[1 * 65]); o.y = cvt_pk_bf16(s_[2 * 65], s_[3 * 65]); o.z = cvt_pk_bf16(s_[4 * 65], s_[5 * 65]); o.w = cvt_pk_bf16(s_[6 * 65], s_[7 * 65]);
        *(u32x4*)(WT + (size_t)(n0 + n) * K + k0 + 8 * c) = o; }
    if (BIAS) {
        float sh[9], acc[9];
#pragma unroll
        for (int b = 0; b < 9; ++b) { sh[b] = shv[b * 6144 + k0 + lane]; acc[b] = 0.f; }
#pragma unroll
        for (int kk = 0; kk < 64; ++kk) { const float w = tv[kk];
#pragma unroll
            for (int b = 0; b < 9; ++b) acc[b] += __uint_as_float(__builtin_amdgcn_readlane(__float_as_uint(sh[b]), kk)) * w; }
#pragma unroll
        for (int b = 0; b < 9; ++b) atomicAdd(bias + (size_t)b * N + n0 + lane, acc[b]);
    }
    LDS_WAIT(); asm volatile("" ::: "memory");
}
__device__ __forceinline__ void cache_item(Frame& F, int l, int item4) {
    f32x4 a[4], c[4];
#pragma unroll
    for (int i = 0; i < 4; ++i) { const int item = item4 * 4 + i, which = item >> 12, r = item & 4095, b = r >> 9, j = r & 511;
        const float* src = (which ? ((const float*)F.ka->in[3]) : ((const float*)F.ka->in[2])) + ((size_t)(b * DEPTH + l) * PAST + j) * 512 + F.lane * 8; a[i] = *(const f32x4*)src; c[i] = *(const f32x4*)(src + 4); }
#pragma unroll
    for (int i = 0; i < 4; ++i) { const int item = item4 * 4 + i, which = item >> 12, r = item & 4095, b = r >> 9, j = r & 511;
        bf16_t* dst = (bf16_t*)(F.ws + (which ? WS_VB : WS_KB)) + (size_t)(MC + b * (PAST + DSEQ) + j) * 512 + F.lane * 8; *(u32x4*)dst = pack8(a[i], c[i]); }
}
__device__ __forceinline__ f32x2 cmul(f32x2 a, f32x2 b) { return (f32x2){a.x * b.x - a.y * b.y, a.x * b.y + a.y * b.x}; }
__device__ __forceinline__ void ssm_prep(Frame& F, int l, int task) {
    const int g = task >> 1, half = task & 1;
    LAS f32x2* POW = (LAS f32x2*)F.lds;
    LAS f32x2* BB = POW + 2 * 17 * 64;
    LAS f32x2* CC = BB + 2 * 64 * 16;
    LAS f32x2* CT = CC + 2 * 16 * 64;
    LAS float* KT = (LAS float*)(CT + 2 * 64 * 16);
    constexpr int KTS = 260;
    bf16_t* WE = (bf16_t*)(F.ws + WS_SSM + SSM_WE) + (size_t)g * 256 * 256;
    bf16_t* WY = (bf16_t*)(F.ws + WS_SSM + SSM_WY) + (size_t)g * 256 * 512;
    f32x2* LAM16 = (f32x2*)(F.ws + WS_SSM + SSM_LAM16); f32x2* BBAR = (f32x2*)(F.ws + WS_SSM + SSM_BBAR);
    const int tid = F.tid, lane = F.lane;
    if (tid < 128) { const int dir = tid >> 6, p = tid & 63; const size_t pi = ((size_t)(l * 2 + dir) * NG + g) * 64 + p;
        const float lr = ((const float*)F.ka->in[18])[pi], li = ((const float*)F.ka->in[19])[pi], delta = expf(((const float*)F.ka->in[20])[(l * 2 + dir) * NG + g]);
        const float er = expf(lr * delta), lbr = er * cosf(li * delta), lbi = er * sinf(li * delta);
        { float one_ = 1.f, zero_ = 0.f; asm volatile("" : "+v"(one_), "+v"(zero_));
          f32x2 pw = (f32x2){one_, zero_}; const f32x2 lb = (f32x2){lbr, lbi};
          for (int tau = 0; tau <= 16; ++tau) { POW[(dir * 17 + tau) * 64 + p] = pw; if (tau == 16 && half == 0) LAM16[(dir * NG + g) * 64 + p] = pw; pw = cmul(pw, lb); } }
        const float nr = lbr - 1.f, ni = lbi, den = lr * lr + li * li; const f32x2 fac = (f32x2){(nr * lr + ni * li) / den, (ni * lr - nr * li) / den};
        f32x4 br[4], bi4[4];
#pragma unroll
        for (int q = 0; q < 4; ++q) { br[q] = *(const f32x4*)(((const float*)F.ka->in[21]) + pi * 16 + 4 * q); bi4[q] = *(const f32x4*)(((const float*)F.ka->in[22]) + pi * 16 + 4 * q); }
#pragma unroll
        for (int ch = 0; ch < 16; ++ch) { const f32x2 bb = cmul(fac, (f32x2){br[ch >> 2][ch & 3], bi4[ch >> 2][ch & 3]}); BB[(dir * 64 + p) * 16 + ch] = bb; if (half == 0) BBAR[((size_t)(dir * NG + g) * 64 + p) * 16 + ch] = bb; }
    }
    { f32x2 cv[4];
#pragma unroll
      for (int q = 0; q < 4; ++q) { const int i = tid + q * NTHREADS, dir = i >> 10, c = (i >> 6) & 15, p = i & 63; const size_t ci = (((size_t)(l * 2 + dir) * NG + g) * 16 + c) * 64 + p; cv[q] = (f32x2){((const float*)F.ka->in[23])[ci], ((const float*)F.ka->in[24])[ci]}; }
#pragma unroll
      for (int q = 0; q < 4; ++q) { const int i = tid + q * NTHREADS, dir = i >> 10, c = (i >> 6) & 15, p = i & 63; CC[i] = cv[q]; CT[(dir * 64 + p) * 16 + c] = cv[q]; } }
    __syncthreads();
    { const int i16 = lane & 15, k4 = lane >> 4, ri = k4 & 1, ph = k4 >> 1;
      for (int blk = 0; blk < 4; ++blk) { const int q = F.wave * 4 + blk, dir = q >> 4, tau = q & 15; f32x4 acc = (f32x4){0.f, 0.f, 0.f, 0.f};
#pragma unroll 8
          for (int ks = 0; ks < 32; ++ks) { const int p = 2 * ks + ph;
              const f32x2 cc = CT[(dir * 64 + p) * 16 + i16], pw = POW[(dir * 17 + tau) * 64 + p], bb = BB[(dir * 64 + p) * 16 + i16];
              const float u = ri ? -pw.y : pw.x, v = ri ? pw.x : pw.y;
              const float av = cc.x * u - cc.y * v, bv = ri ? bb.y : bb.x;
              acc = __builtin_amdgcn_mfma_f32_16x16x4f32(av, bv, acc, 0, 0, 0); }
#pragma unroll
          for (int r = 0; r < 4; ++r) KT[(dir * 16 + tau) * KTS + (k4 * 4 + r) * 16 + i16] = acc[r]; } }
    __syncthreads();
    const float* Dv = ((const float*)F.ka->in[25]) + l * 512 + g * 16;
    for (int idx = half * 8192 + tid; idx < (half + 1) * 8192; idx += NTHREADS) { const int n = idx >> 6, kc = idx & 63, k0 = kc * 8, i = n >> 4, c = n & 15; f32x4 v0, v1;
        if (k0 < 256) { const int s_ = k0 >> 4, ch0 = k0 & 15; v0 = (f32x4){0.f, 0.f, 0.f, 0.f}; v1 = v0;
            if (s_ <= i) { const LAS float* kp = KT + (i - s_) * KTS + c * 16 + ch0; v0 += *(const LAS f32x4*)kp; v1 += *(const LAS f32x4*)(kp + 4); }
            if (s_ >= i) { const LAS float* kp = KT + (16 + s_ - i) * KTS + c * 16 + ch0; v0 += *(const LAS f32x4*)kp; v1 += *(const LAS f32x4*)(kp + 4); }
            if (s_ == i) { const int e = c - ch0; const float dv = Dv[c]; if (e >= 0 && e < 4) v0[e] += dv; else if (e >= 4 && e < 8) v1[e - 4] += dv; }
        } else { const int dir = k0 >= 384 ? 1 : 0, p0 = ((k0 - 256) & 127) >> 1, tau = dir ? 16 - i : i + 1;
            const LAS f32x4* cp = (const LAS f32x4*)(CC + (dir * 16 + c) * 64 + p0); const LAS f32x4* pp = (const LAS f32x4*)(POW + (dir * 17 + tau) * 64 + p0);
            const f32x4 c0 = cp[0], c1 = cp[1], w0 = pp[0], w1 = pp[1];
            v0 = (f32x4){c0[0] * w0[0] - c0[1] * w0[1], -(c0[0] * w0[1] + c0[1] * w0[0]), c0[2] * w0[2] - c0[3] * w0[3], -(c0[2] * w0[3] + c0[3] * w0[2])};
            v1 = (f32x4){c1[0] * w1[0] - c1[1] * w1[1], -(c1[0] * w1[1] + c1[1] * w1[0]), c1[2] * w1[2] - c1[3] * w1[3], -(c1[2] * w1[3] + c1[3] * w1[2])}; }
        *(u32x4*)(WY + (size_t)n * 512 + k0) = pack8(v0, v1); }
    for (int idx = half * 4096 + tid; idx < (half + 1) * 4096; idx += NTHREADS) { const int n = idx >> 5, k0 = (idx & 31) * 8, dir = n >> 7, p = (n & 127) >> 1, ri = n & 1, s_ = k0 >> 4, ch0 = k0 & 15;
        const f32x2 pw = POW[(dir * 17 + (dir ? s_ : 15 - s_)) * 64 + p]; const LAS f32x4* bp = (const LAS f32x4*)(BB + (dir * 64 + p) * 16 + ch0);
        const float u = ri ? pw.y : pw.x, v = ri ? pw.x : -pw.y;
        const f32x4 b0 = bp[0], b1 = bp[1], b2 = bp[2], b3 = bp[3];
        const f32x4 v0 = (f32x4){u * b0[0] + v * b0[1], u * b0[2] + v * b0[3], u * b1[0] + v * b1[1], u * b1[2] + v * b1[3]};
        const f32x4 v1 = (f32x4){u * b2[0] + v * b2[1], u * b2[2] + v * b2[3], u * b3[0] + v * b3[1], u * b3[2] + v * b3[3]};
        *(u32x4*)(WE + (size_t)n * 256 + k0) = pack8(v0, v1); }
    __syncthreads();
}
__device__ __forceinline__ void xprep_item(Frame& F, int item4) {
    f32x4 xv[4][4];
#pragma unroll
    for (int i = 0; i < 4; ++i) { const int row = item4 * 4 + i; const float* xr = (row < MC) ? ((const float*)F.ka->in[0]) + (size_t)row * DM : ((const float*)F.ka->in[1]) + (size_t)(row - MC) * DM;
#pragma unroll
        for (int j = 0; j < 4; ++j) xv[i][j] = *(const f32x4*)(xr + 4 * F.lane + 256 * j); }
    const int cond = item4 * 4 < MC ? 0 : 1 + ((item4 * 4 - MC) >> 10);
    const float* sc = F.misc + MI_MOD + (0 * 9 + cond) * 6144 + 1024; const float* g1 = ((const float*)F.ka->in[9]);
    f32x4 gs[4];
#pragma unroll
    for (int j = 0; j < 4; ++j) { const int c = 4 * F.lane + 256 * j; gs[j] = (*(const f32x4*)(g1 + c)) * (*(const f32x4*)(sc + c) + 1.f); }
#pragma unroll
    for (int i = 0; i < 4; ++i) { const int row = item4 * 4 + i; bf16_t* dst = (bf16_t*)(F.ws + WS_XS) + (size_t)row * DM; float s = 0.f;
#pragma unroll
        for (int j = 0; j < 4; ++j) { const f32x4 x = xv[i][j]; const f32x4 t = x * x; s += (t[0] + t[1]) + (t[2] + t[3]); const f32x4 y = x * gs[j];
            u32x2 w; w.x = cvt_pk_bf16(y[0], y[1]); w.y = cvt_pk_bf16(y[2], y[3]); *(u32x2*)(dst + 4 * F.lane + 256 * j) = w; }
        s = wave_sum(s, F.lane);
        if (F.lane == 0) ((float*)(F.ctl + CW_SS))[row] = s; }
}
__device__ __forceinline__ void bias_item(Frame& F, int item) {
    const int which = item >= 2048, n = which ? item - 2048 : item;
    const bf16_t* wrow = (const bf16_t*)(F.ws + (which ? WS_WUP : WS_WIN)) + (size_t)n * DM;
    float wv[16]; { const u32x4 a = *(const u32x4*)(wrow + F.lane * 8), b = *(const u32x4*)(wrow + 512 + F.lane * 8);
        wv[0] = bflo(a.x); wv[1] = bfhi(a.x); wv[2] = bflo(a.y); wv[3] = bfhi(a.y); wv[4] = bflo(a.z); wv[5] = bfhi(a.z); wv[6] = bflo(a.w); wv[7] = bfhi(a.w);
        wv[8] = bflo(b.x); wv[9] = bfhi(b.x); wv[10] = bflo(b.y); wv[11] = bfhi(b.y); wv[12] = bflo(b.z); wv[13] = bfhi(b.z); wv[14] = bflo(b.w); wv[15] = bfhi(b.w); }
    float outv = 0.f;
#pragma unroll
    for (int cond = 0; cond < 9; ++cond) { const float* sh = F.misc + MI_MOD + cond * 6144 + (which ? 3072 : 0);
        const f32x4 s0 = *(const f32x4*)(sh + F.lane * 8), s1 = *(const f32x4*)(sh + F.lane * 8 + 4), s2 = *(const f32x4*)(sh + 512 + F.lane * 8), s3 = *(const f32x4*)(sh + 512 + F.lane * 8 + 4);
        float d = 0.f;
#pragma unroll
        for (int e = 0; e < 4; ++e) d += s0[e] * wv[e] + s1[e] * wv[4 + e] + s2[e] * wv[8 + e] + s3[e] * wv[12 + e];
        d = wave_sum(d, F.lane); if (F.lane == cond) outv = d; }
    if (F.lane < 9) ((float*)F.ctl)[(which ? CW_BUP + F.lane * 4096 : CW_BIN + F.lane * 2048) + n] = outv;
}
__device__ __forceinline__ void ssm_scan(Frame& F, int l, int g, int pm) {
    const int tid = F.tid, sl = tid >> 7, dp = tid & 127, dir = dp >> 6, p = dp & 63;
    const f32x2* LAM16 = (const f32x2*)(F.ws + WS_SSM + SSM_LAM16); const f32x2* BBAR = (const f32x2*)(F.ws + WS_SSM + SSM_BBAR);
    const float* E = (const float*)(F.ws + WS_R + R_E); bf16_t* AS3 = (bf16_t*)(F.ws + WS_R + R_AS3);
    const f32x2 lam = LAM16[(dir * NG + g) * 64 + p];
    f32x2 e[64];
    if (pm == 0) {
#pragma unroll
        for (int q = 0; q < 4; ++q) { const float* ep = E + ((size_t)g * NCHUNK + (q * 4 + sl) * 16) * 256 + dir * 128 + 2 * p;
#pragma unroll
            for (int j = 0; j < 16; ++j) e[q * 16 + j] = *(const f32x2*)(ep + (size_t)j * 256); }
    } else { const float* ep = E + ((size_t)g * NCHUNK + 256 + ((pm - 1) * 4 + sl) * 64) * 256 + dir * 128 + 2 * p;
#pragma unroll
        for (int j = 0; j < 64; ++j) e[j] = *(const f32x2*)(ep + (size_t)j * 256); }
    const int nq = pm == 0 ? 4 : 1;
#pragma unroll
    for (int q = 0; q < 4; ++q) { if (q >= nq) break;
        int base; f32x2 h;
        if (pm == 0) { const int seq = q * 4 + sl; base = seq * 16; h = (f32x2){0.f, 0.f}; }
        else { const int sq = (pm - 1) * 4 + sl; base = 256 + sq * 64; h = *(const f32x2*)(((const float*)F.ka->in[4]) + ((((size_t)sq * DEPTH + l) * 2 + dir) * NG + g) * 128 + 2 * p); }
        unsigned* hp = (unsigned*)(AS3 + ((size_t)g * NCHUNK + base) * 512 + 256 + dir * 128 + 2 * p);
        if (pm == 0) {
#pragma unroll
            for (int jj = 0; jj < 16; ++jj) { const int j = dir ? 15 - jj : jj; const f32x2 ev = dir ? e[q * 16 + 15 - jj] : e[q * 16 + jj]; hp[(size_t)j * 256] = cvt_pk_bf16(h.x, h.y); h = cmul(lam, h) + ev; }
        } else {
#pragma unroll
            for (int jj = 0; jj < 64; ++jj) { const int j = dir ? 63 - jj : jj; const f32x2 ev = dir ? e[63 - jj] : e[jj]; hp[(size_t)j * 256] = cvt_pk_bf16(h.x, h.y); h = cmul(lam, h) + ev; }
        }
    }
    if (pm == 0) {
        const int tt = dir ? 15 : 0; u32x4 uq[4][2]; f32x2 bbv[16];
        const f32x2* bb = BBAR + ((size_t)(dir * NG + g) * 64 + p) * 16;
#pragma unroll
        for (int ch = 0; ch < 16; ++ch) bbv[ch] = bb[ch];
#pragma unroll
        for (int q = 0; q < 4; ++q) { const int chunk = (q * 4 + sl) * 16 + tt; const bf16_t* up = AS3 + ((size_t)g * NCHUNK + chunk) * 512 + tt * 16; uq[q][0] = *(const u32x4*)up; uq[q][1] = *(const u32x4*)(up + 8); }
        float* ns = F.out + (size_t)MT * DM + 2 * (size_t)NB * DEPTH * SEQ * 512;
#pragma unroll
        for (int q = 0; q < 4; ++q) { const int seq = q * 4 + sl; const u32x4 u0 = uq[q][0], u1 = uq[q][1];
            const float uu[16] = {bflo(u0.x), bfhi(u0.x), bflo(u0.y), bfhi(u0.y), bflo(u0.z), bfhi(u0.z), bflo(u0.w), bfhi(u0.w), bflo(u1.x), bfhi(u1.x), bflo(u1.y), bfhi(u1.y), bflo(u1.z), bfhi(u1.z), bflo(u1.w), bfhi(u1.w)};
            f32x2 acc = (f32x2){0.f, 0.f};
#pragma unroll
            for (int ch = 0; ch < 16; ++ch) acc += bbv[ch] * uu[ch];
            *(f32x2*)(ns + ((((size_t)seq * DEPTH + l) * 2 + dir) * NG + g) * 128 + 2 * p) = acc; }
    }
}
__device__ __forceinline__ void ld16(const bf16_t* p, float* v) { const u32x4 a = *(const u32x4*)p; v[0] = bflo(a.x); v[1] = bfhi(a.x); v[2] = bflo(a.y); v[3] = bfhi(a.y); v[4] = bflo(a.z); v[5] = bfhi(a.z); v[6] = bflo(a.w); v[7] = bfhi(a.w); }
__device__ __forceinline__ void conv_item(Frame& F, int l, int item) {
    const int rs = item >> 4, pn = item & 15, lr = F.lane >> 4, lc = F.lane & 15;
    const int r0 = rs * 64 + lr * 16; const int av = 128 * pn + 8 * lc;
    const bf16_t* up = (const bf16_t*)(F.ws + WS_R) + (size_t)r0 * 4096 + 256 * pn + 8 * lc; bf16_t* gp = (bf16_t*)(F.ws + WS_G) + (size_t)r0 * 2048 + av;
    const float* cw = ((const float*)F.ka->in[31]) + (size_t)l * 3 * 4096; const float* cb = ((const float*)F.ka->in[32]) + (size_t)l * 4096;
    float wv[3][8], wg[3][8], bv[8], bg[8];
#pragma unroll
    for (int k = 0; k < 3; ++k)
#pragma unroll
        for (int e = 0; e < 8; ++e) { wv[k][e] = cw[k * 4096 + av + e]; wg[k][e] = cw[k * 4096 + 2048 + av + e]; }
#pragma unroll
    for (int e = 0; e < 8; ++e) { bv[e] = cb[av + e]; bg[e] = cb[2048 + av + e]; }
    const int t0 = r0 < MC ? (r0 & 255) : ((r0 - MC) & 1023), L = r0 < MC ? SEQ : DSEQ;
    float pv[8], pg[8], cv[8], cg[8], nv_[8], ng[8];
    if (t0 > 0) { ld16(up - 4096, pv); ld16(up - 4096 + 128, pg); } else {
#pragma unroll
        for (int e = 0; e < 8; ++e) { pv[e] = 0.f; pg[e] = 0.f; } }
    ld16(up, cv); ld16(up + 128, cg);
#pragma unroll
    for (int i = 0; i < 16; ++i) {
        if (t0 + i + 1 < L) { ld16(up + (size_t)(i + 1) * 4096, nv_); ld16(up + (size_t)(i + 1) * 4096 + 128, ng); } else {
#pragma unroll
            for (int e = 0; e < 8; ++e) { nv_[e] = 0.f; ng[e] = 0.f; } }
        float o[8];
#pragma unroll
        for (int e = 0; e < 8; ++e) { const float zv = bv[e] + wv[0][e] * pv[e] + wv[1][e] * cv[e] + wv[2][e] * nv_[e]; const float zg = bg[e] + wg[0][e] * pg[e] + wg[1][e] * cg[e] + wg[2][e] * ng[e]; o[e] = silu_f(zg) * zv; }
        u32x4 w; w.x = cvt_pk_bf16(o[0], o[1]); w.y = cvt_pk_bf16(o[2], o[3]); w.z = cvt_pk_bf16(o[4], o[5]); w.w = cvt_pk_bf16(o[6], o[7]);
        *(u32x4*)(gp + (size_t)i * 2048) = w;
#pragma unroll
        for (int e = 0; e < 8; ++e) { pv[e] = cv[e]; pg[e] = cg[e]; cv[e] = nv_[e]; cg[e] = ng[e]; }
    }
}

__device__ __forceinline__ bool slab_first(int s) { return s < 64 ? (s & 3) == 0 : ((s - 64) & 15) == 0; }
__device__ __forceinline__ bool slab_last(int s) { return s < 64 ? (s & 3) == 3 : ((s - 64) & 15) == 15; }
__device__ __forceinline__ void ld4bf(const bf16_t* p, float* v) { const u32x2 a = *(const u32x2*)p; v[0] = bflo(a.x); v[1] = bfhi(a.x); v[2] = bflo(a.y); v[3] = bfhi(a.y); }
__device__ __forceinline__ void conv_fix(Frame& F, int l, int pm) {
    const bf16_t* HALO = (const bf16_t*)(F.ws + WS_HALO); bf16_t* G = (bf16_t*)(F.ws + WS_G);
    const float* cw = ((const float*)F.ka->in[31]) + (size_t)l * 3 * 4096; const float* cb = ((const float*)F.ka->in[32]) + (size_t)l * 4096;
    const int c = F.tid * 4, pos = 256 * (c >> 7) + (c & 127);
    float wv[3][4], wg[3][4], bv[4], bg[4];
#pragma unroll
    for (int k = 0; k < 3; ++k) { const f32x4 a = *(const f32x4*)(cw + k * 4096 + c), b = *(const f32x4*)(cw + k * 4096 + 2048 + c);
#pragma unroll
        for (int e = 0; e < 4; ++e) { wv[k][e] = a[e]; wg[k][e] = b[e]; } }
    { const f32x4 a = *(const f32x4*)(cb + c), b = *(const f32x4*)(cb + 2048 + c);
#pragma unroll
      for (int e = 0; e < 4; ++e) { bv[e] = a[e]; bg[e] = b[e]; } }
    u32x2 hv[8][6];
#pragma unroll
    for (int r8 = 0; r8 < 8; ++r8) { const int s = pm * 4 + (r8 >> 1), which = r8 & 1; const bool skip = which == 0 ? slab_first(s) : slab_last(s);
        const int sp = skip ? s : (which == 0 ? s - 1 : s), sn = skip ? s : (which == 0 ? s : s + 1);
        const bf16_t* hp = which == 0 ? HALO + ((size_t)sp * 4 + 3) * 4096 : HALO + ((size_t)s * 4 + 2) * 4096;
        const bf16_t* hc = which == 0 ? HALO + ((size_t)s * 4 + 0) * 4096 : HALO + ((size_t)s * 4 + 3) * 4096;
        const bf16_t* hn = which == 0 ? HALO + ((size_t)s * 4 + 1) * 4096 : HALO + ((size_t)sn * 4 + 0) * 4096;
        hv[r8][0] = *(const u32x2*)(hp + pos); hv[r8][1] = *(const u32x2*)(hc + pos); hv[r8][2] = *(const u32x2*)(hn + pos);
        hv[r8][3] = *(const u32x2*)(hp + pos + 128); hv[r8][4] = *(const u32x2*)(hc + pos + 128); hv[r8][5] = *(const u32x2*)(hn + pos + 128); }
#pragma unroll
    for (int r8 = 0; r8 < 8; ++r8) { const int s = pm * 4 + (r8 >> 1), which = r8 & 1;
        if (which == 0 ? slab_first(s) : slab_last(s)) continue;
        float pv[4], cv[4], nv_[4], pg[4], cg[4], ng[4];
#define UNP(v, w) do { v[0] = bflo(w.x); v[1] = bfhi(w.x); v[2] = bflo(w.y); v[3] = bfhi(w.y); } while (0)
        UNP(pv, hv[r8][0]); UNP(cv, hv[r8][1]); UNP(nv_, hv[r8][2]); UNP(pg, hv[r8][3]); UNP(cg, hv[r8][4]); UNP(ng, hv[r8][5]);
#undef UNP
        float o[4];
#pragma unroll
        for (int e = 0; e < 4; ++e) { const float zv = bv[e] + wv[0][e] * pv[e] + wv[1][e] * cv[e] + wv[2][e] * nv_[e]; const float zg = bg[e] + wg[0][e] * pg[e] + wg[1][e] * cg[e] + wg[2][e] * ng[e]; o[e] = silu_f(zg) * zv; }
        u32x2 w; w.x = cvt_pk_bf16(o[0], o[1]); w.y = cvt_pk_bf16(o[2], o[3]);
        *(u32x2*)(G + (size_t)(s * 64 + (which ? 63 : 0)) * 2048 + c) = w; }
}
constexpr int N_TR_ITEMS_L = 16 * 32 + 8 * 8 + 16 * 16 + 16 * 64 + 32 * 16;
template <bool BIAS> __device__ __forceinline__ void weight_item(Frame& F, LAS float* scr, int l, int it) {
    int r = it; const float* modl = F.misc + MI_MOD + l * 9 * 6144; float* cf = (float*)F.ctl;
    if (r < 512) { transpose_item<1, BIAS>(F, ((const float*)F.ka->in[10]) + (size_t)l * DM * 2048, DM, 2048, (bf16_t*)(F.ws + WS_WIN) + (size_t)l * 2048 * DM, scr, r, modl, cf + CW_BIN + l * 9 * 2048); return; } r -= 512;
    if (r < 64) { transpose_item<0, false>(F, ((const float*)F.ka->in[26]) + (size_t)l * 512 * 512, 512, 512, (bf16_t*)(F.ws + WS_WGLU) + (size_t)l * 512 * 512, scr, r, nullptr, nullptr); return; } r -= 64;
    if (r < 256) { transpose_item<0, false>(F, ((const float*)F.ka->in[28]) + (size_t)l * DM * DM, DM, DM, (bf16_t*)(F.ws + WS_WOUT) + (size_t)l * DM * DM, scr, r, nullptr, nullptr); return; } r -= 256;
    if (r < 1024) { transpose_item<2, BIAS>(F, ((const float*)F.ka->in[30]) + (size_t)l * DM * 4096, DM, 4096, (bf16_t*)(F.ws + WS_WUP) + (size_t)l * 4096 * DM, scr, r, modl + 3072, cf + CW_BUP + l * 9 * 4096); return; } r -= 1024;
    transpose_item<0, false>(F, ((const float*)F.ka->in[33]) + (size_t)l * 2048 * DM, 2048, DM, (bf16_t*)(F.ws + WS_WDN) + (size_t)l * DM * 2048, scr, r, nullptr, nullptr);
}

__global__ void __launch_bounds__(NTHREADS, 2) mega(Args args) {
    extern __shared__ __attribute__((aligned(16))) unsigned char lds_raw[];
    Frame F;
    F.lds = (LAS unsigned char*)lds_raw;
    F.tid = threadIdx.x; F.lane = F.tid & 63; F.wave = __builtin_amdgcn_readfirstlane(F.tid >> 6);
    F.G = gridDim.x; F.bid = blockIdx.x; { const int bx = blockIdx.x; F.vcu = (F.G % 8 == 0) ? (bx % 8) * (F.G / 8) + bx / 8 : bx; }
    F.ka = (kargs_t)__builtin_amdgcn_kernarg_segment_ptr();
    F.out = args.out; F.ws = args.ws; F.misc = (float*)(args.ws + WS_MISC); F.ctl = (unsigned*)(args.ws + WS_CTL);
    volatile LAS unsigned* MISC = (volatile LAS unsigned*)(F.lds + MISC_OFF);
    for (int u = F.tid; u < (LDS_BYTES - LDSCTL_OFF) / 4; u += NTHREADS) ((LAS unsigned*)(F.lds + LDSCTL_OFF))[u] = 0u;
    __syncthreads();
    XcdBarrier bar = xcd_barrier_post(F.ctl + CW_BAR, MISC + 8);
    int phase_no = 0;
#define LAUNDER() do { { GAS unsigned char* w1_ = (GAS unsigned char*)args.ws; GAS float* o1_ = (GAS float*)args.out; kargs_t k1_ = (kargs_t)__builtin_amdgcn_kernarg_segment_ptr(); \
      int b_ = __builtin_amdgcn_readfirstlane(F.bid), w_ = __builtin_amdgcn_readfirstlane(F.wave); \
      asm volatile("" : "+s"(k1_), "+s"(w1_), "+s"(o1_), "+s"(b_), "+s"(w_)); F.ka = k1_; F.ws = (unsigned char*)w1_; F.out = (float*)o1_; F.bid = b_; F.wave = w_; }     \
    F.vcu = (F.G % 8 == 0) ? (F.bid % 8) * (F.G / 8) + F.bid / 8 : F.bid; \
    { unsigned z_ = 0u; asm volatile("" : "+v"(z_)); F.lane = (int)__builtin_amdgcn_mbcnt_hi(~0u, __builtin_amdgcn_mbcnt_lo(~0u, z_)); } F.tid = F.wave * 64 + F.lane;     \
    F.misc = (float*)(F.ws + WS_MISC); F.ctl = (unsigned*)(F.ws + WS_CTL); gw = F.vcu * NWAVES + F.wave; } while (0)
#ifndef TPROBE_SCALE
#define TPROBE_SCALE 0.25f
#endif
#ifdef TPROBE
#define TSTAMP() do { if (blockIdx.x == 0 && F.tid == 0) ((unsigned long long*)(F.ctl + 6000))[phase_no] = __builtin_amdgcn_s_memrealtime(); } while (0)
#else
#define TSTAMP() do {} while (0)
#endif
#if defined(TPROBE) && defined(TPROBE_SUB_A)
#ifndef TPROBE_BID
#define TPROBE_BID 0
#endif
#define TSUB(i) do { if (blockIdx.x == TPROBE_BID && F.tid == 0 && l == 0) ((unsigned long long*)(F.ctl + 6200))[i] = __builtin_amdgcn_s_memrealtime(); } while (0)
#else
#define TSUB(i) do {} while (0)
#endif
#ifdef TPROBE
#define TPRE() do { if (blockIdx.x == 0 && F.tid == 0) ((unsigned long long*)(F.ctl + 6400))[phase_no + 1] = __builtin_amdgcn_s_memrealtime(); } while (0)
#else
#define TPRE() do {} while (0)
#endif
#define GRID_BAR() do { LAUNDER(); TPRE(); xcd_barrier(bar, F.tid); ++phase_no; TSTAMP(); if (F.ka->stop_after == phase_no) return; LAUNDER(); } while (0)
    int gw = F.vcu * NWAVES + F.wave; const int NGW = F.G * NWAVES;
#define ssq ((float*)(F.ctl + CW_SS))
#define XS ((bf16_t*)(F.ws + WS_XS))
#define KB ((bf16_t*)(F.ws + WS_KB))
#define VB ((bf16_t*)(F.ws + WS_VB))
#define Qb ((bf16_t*)(F.ws + WS_R + R_Q))
#define AS3 ((bf16_t*)(F.ws + WS_R + R_AS3))
#define Eb ((float*)(F.ws + WS_R + R_E))
#define Zb ((bf16_t*)(F.ws + WS_R + R_Z))
#define CAT ((bf16_t*)(F.ws + WS_R + R_CAT))
#define UP ((bf16_t*)(F.ws + WS_R))
#define Gb ((bf16_t*)(F.ws + WS_G))

    TSTAMP();
    if (F.vcu < 64) ssm_prep(F, 0, F.vcu);
    else {
        mod_task3(F, F.vcu - 64);
        if (F.vcu == 64) {
            for (int i = F.tid; i < 1024; i += NTHREADS) { const int pos = i >> 4, f = i & 15; const float inv = 1.0f / powf(10000.0f, (float)f / 16.0f); const float ang = (float)pos * inv;
                ((f32x2*)(F.misc + MI_ROPE))[i] = (f32x2){cosf(ang), sinf(ang)}; }
            if (F.tid < 2) { const int l = F.tid; float a1 = 0.f, a2 = 0.f; for (int d = 0; d < 64; ++d) { a1 += ((const float*)F.ka->in[13])[l * 64 + d] * ((const float*)F.ka->in[14])[l * 64 + d]; a2 += ((const float*)F.ka->in[15])[l * 64 + d] * ((const float*)F.ka->in[16])[l * 64 + d]; }
                const float li = 0.8f - 0.6f * expf(-0.3f * (float)l); F.misc[MI_LAM + l] = expf(a1) - expf(a2) + li; F.misc[MI_LAM + 2 + l] = 1.f - li; }
            __syncthreads();
        }
        LAS float* scr = (LAS float*)(F.lds + F.wave * 16640);
        const int gw1 = (F.vcu - 64) * NWAVES + F.wave, NGW1 = (F.G - 64) * NWAVES;
        for (int it = gw1; it < N_TR_ITEMS_L + 2048; it += NGW1) { if (it < N_TR_ITEMS_L) weight_item<false>(F, scr, 0, it); else cache_item(F, 0, it - N_TR_ITEMS_L); }
    }
    GRID_BAR();
    for (int it = gw; it < MT / 4 + 6144; it += NGW) { if (it < MT / 4) xprep_item(F, it); else bias_item(F, it - MT / 4); }
    GRID_BAR();

    for (int l = 0; l < DEPTH; ++l) {
        const float* modl = F.misc + MI_MOD + l * 9 * 6144;
        { unsigned* ucnt = F.ctl + CW_UC + l * 6 * 64;
          { Gemm g{XS, (const bf16_t*)(F.ws + WS_WIN) + (size_t)l * 2048 * DM, DM, DM, DM, 0, 0, 1}; InOrder S{F.bid, F.G};
            EpiIn E{ssq + (l == 0 ? 0 : 2 * MT), (const float*)F.ctl + CW_BIN + l * 9 * 2048, ((const float*)F.ka->in[11]) + l * 64, ((const float*)F.ka->in[12]) + l * 64, (const f32x2*)(F.misc + MI_ROPE), Qb, KB, VB,
                    __builtin_amdgcn_make_buffer_rsrc((void*)AS3, 0, (int)((size_t)NG * NCHUNK * 512 * 2), 0x00020000),
                    F.out + (size_t)MT * DM, F.out + (size_t)MT * DM + (size_t)NB * DEPTH * SEQ * 512, l, ucnt};
            gemm_phase<EpiIn, InOrder>(F.lds, F.tid, g, S, E); }
          if (F.bid >= 128 && F.bid < 224) {
              LAUNDER();
              const int idx = F.bid - 128, gq = idx / 3, pmq = idx % 3; unsigned* up = F.ctl + CW_UC + ((l * 3 + pmq) * 2 + (gq >> 4)) * 64;
              if (F.tid == 0) { unsigned sp = 0; while (__hip_atomic_load(up, RLX_AGENT) < 128u) { __builtin_amdgcn_s_sleep(2); if (++sp > (1u << 20)) break; }
                  __builtin_amdgcn_fence(__ATOMIC_ACQUIRE, "agent"); asm volatile("s_waitcnt vmcnt(0)" ::: "memory"); }
              __syncthreads();
              { Gemm g{AS3, (const bf16_t*)(F.ws + WS_SSM + SSM_WE), 512, 256, 256, (size_t)NCHUNK * 512, (size_t)256 * 256}; GroupOrder S{idx, F.G}; EpiS1 E{Eb};
                gemm_phase<EpiS1, GroupOrder>(F.lds, F.tid, g, S, E); }
              VM_WAIT(); __syncthreads(); LAUNDER();
              ssm_scan(F, l, (F.bid - 128) / 3, (F.bid - 128) % 3); } }
        GRID_BAR();
#define ZC_PTR (F.ctl + CW_ZC + l * 256)
#define ATTN_UNIT(SEQ_, H_, QB_) do { LAUNDER(); const AttnArgs A_{Qb, KB, VB, CAT, ((const float*)F.ka->in[17]) + l * 128, F.misc[MI_LAM + l], F.misc[MI_LAM + 2 + l]}; attn_unit(F.lds, F.tid, A_, (SEQ_), (H_), (QB_)); } while (0)
#define ATTN_CTX(U_) do { const int u_ = (U_); ATTN_UNIT(u_ >> 3, (u_ >> 1) & 3, u_ & 1); } while (0)
        { TSUB(0);
          const int xq = F.vcu >> 5, rq = F.vcu & 31;
          if (rq < 12) { const int cidx = xq * 12 + rq;
              { Gemm g{AS3, (const bf16_t*)(F.ws + WS_SSM + SSM_WY), 512, 512, 512, (size_t)NCHUNK * 512, (size_t)256 * 512}; GroupOrder S{cidx, F.G};
                EpiS3 E{__builtin_amdgcn_make_buffer_rsrc((void*)Zb, 0, (int)((size_t)MT * 512 * 2), 0x00020000)};
                gemm_phase<EpiS3, GroupOrder>(F.lds, F.tid, g, S, E); }
              VM_WAIT(); __syncthreads(); LAUNDER();
              if (F.tid == 0) __hip_atomic_fetch_add(ZC_PTR + (((F.vcu >> 5) * 12 + (F.vcu & 31)) % 3) * 64, 1u, RLX_AGENT); }
          TSUB(3);
          { const int u = F.vcu; ATTN_UNIT(NB + (u >> 5), (u >> 3) & 3, u & 7); } TSUB(4);
          if ((F.vcu & 31) >= 24) { for (int r = 0; r < 2; ++r) ATTN_CTX((F.vcu >> 5) * 16 + 2 * ((F.vcu & 31) - 24) + r); }
          TSUB(5);
          if ((F.vcu & 31) >= 12 && (F.vcu & 31) < 24) {
              LAUNDER();
              const int idx = (F.vcu >> 5) * 12 + ((F.vcu & 31) - 12), pmz = panel_of(idx / 12, (idx % 12) >> 1) >> 4;
              if (F.tid == 0) { unsigned sp = 0; while (__hip_atomic_load(ZC_PTR + pmz * 64, RLX_AGENT) < (unsigned)NG) { __builtin_amdgcn_s_sleep(2); if (++sp > (1u << 20)) break; }
                  __builtin_amdgcn_fence(__ATOMIC_ACQUIRE, "agent"); asm volatile("s_waitcnt vmcnt(0)" ::: "memory"); }
              __syncthreads(); TSUB(6);
              Gemm g{Zb, (const bf16_t*)(F.ws + WS_WGLU) + (size_t)l * 512 * 512, 512, 512, 512, 0, 0}; OneTile S{idx};
              EpiGlu E{Zb, ((const float*)F.ka->in[27]) + l * 512, CAT};
              gemm_phase<EpiGlu, OneTile>(F.lds, F.tid, g, S, E); TSUB(7); } }
        GRID_BAR();
        { Gemm g{CAT, (const bf16_t*)(F.ws + WS_WOUT) + (size_t)l * DM * DM, DM, DM, DM, 0, 0, 2}; GridOrder S; S.init(MT, DM, F.G, F.bid);
          bf16_t* XR = (bf16_t*)(F.ws + WS_XR);
          if (l == 0) { EpiRes<true, false> E{((const float*)F.ka->in[0]), ((const float*)F.ka->in[1]), nullptr, nullptr, XR, modl + 2 * DM, ((const float*)F.ka->in[29]) + l * DM, modl + 4 * DM, XS, ssq + 1 * MT};
              gemm_phase<EpiRes<true, false>, GridOrder>(F.lds, F.tid, g, S, E); }
          else { EpiRes<false, false> E{nullptr, nullptr, XR, nullptr, XR, modl + 2 * DM, ((const float*)F.ka->in[29]) + l * DM, modl + 4 * DM, XS, ssq + 3 * MT};
              gemm_phase<EpiRes<false, false>, GridOrder>(F.lds, F.tid, g, S, E); }
          if (l + 1 < DEPTH && F.bid >= 192) { LAUNDER(); LAS float* scr = (LAS float*)(F.lds + F.wave * 16640);
              for (int it = (F.bid - 192) * NWAVES + F.wave; it < N_TR_ITEMS_L; it += 64 * NWAVES) weight_item<true>(F, scr, l + 1, it); } }
        GRID_BAR();
        { Gemm g{XS, (const bf16_t*)(F.ws + WS_WUP) + (size_t)l * 4096 * DM, DM, DM, DM, 0, 0, 3}; GridOrder S; S.init(MT, 4096, F.G, F.bid);
          EpiUpConv E{ssq + (l == 0 ? 1 : 3) * MT, (const float*)F.ctl + CW_BUP + l * 9 * 4096, ((const float*)F.ka->in[31]) + (size_t)l * 3 * 4096, ((const float*)F.ka->in[32]) + (size_t)l * 4096, Gb, (bf16_t*)(F.ws + WS_HALO)};
          gemm_phase<EpiUpConv, GridOrder, true>(F.lds, F.tid, g, S, E); }
        GRID_BAR();
        { Gemm g{Gb, (const bf16_t*)(F.ws + WS_WDN) + (size_t)l * DM * 2048, 2048, 2048, 2048, 0, 0, 4}; GridOrder S; S.init(MT, DM, F.G, F.bid);
          const bool nxt = l + 1 < DEPTH;
          bf16_t* XR = (bf16_t*)(F.ws + WS_XR);
          { Unit u0; if (S.next(0, u0)) { conv_fix(F, l, u0.pm); VM_WAIT(); __syncthreads(); LAUNDER(); } }
          if (nxt) { EpiRes<false, false> E{nullptr, nullptr, XR, nullptr, XR, modl + 5 * DM, ((const float*)F.ka->in[9]) + (l + 1) * DM, modl + 9 * 6144 + DM, XS, ssq + 2 * MT};
              gemm_phase<EpiRes<false, false>, GridOrder>(F.lds, F.tid, g, S, E); }
          else { EpiRes<false, true> E{nullptr, nullptr, XR, F.out, nullptr, modl + 5 * DM, nullptr, nullptr, XS, ssq + 2 * MT};
              gemm_phase<EpiRes<false, true>, GridOrder>(F.lds, F.tid, g, S, E); }
          if (nxt && F.bid >= 192) { LAUNDER(); ssm_prep(F, l + 1, F.bid - 192);
              for (int it = (F.bid - 192) * NWAVES + F.wave; it < 2048; it += 64 * NWAVES) cache_item(F, l + 1, it); } }
        if (l + 1 < DEPTH) GRID_BAR();
    }
#ifdef TPROBE
    if (blockIdx.x == 0) {
        ++phase_no; TSTAMP(); VM_WAIT(); __syncthreads();
        volatile LAS float* dl = (volatile LAS float*)(F.lds + 1024);
        if (threadIdx.x == 0) { const unsigned long long* ts = (const unsigned long long*)((unsigned*)(args.ws + WS_CTL) + 6000); const float tot = (float)(ts[phase_no] - ts[0]);
            float fa = 0.f;
#if defined(TPROBE_GID)
            { const volatile LAS unsigned long long* t2 = (const volatile LAS unsigned long long*)(F.lds + LDSCTL_OFF); fa = (float)(t2[TPROBE_SUB_B] - t2[TPROBE_SUB_A]) / tot; }
#elif defined(TPROBE_SUB_A)
            { const unsigned long long* t2 = (const unsigned long long*)((unsigned*)(args.ws + WS_CTL) + 6200); fa = (float)(t2[TPROBE_SUB_B] - t2[TPROBE_SUB_A]) / tot; }
#else
#ifdef TPROBE_WAITMODE
            { const unsigned long long* tp = (const unsigned long long*)((unsigned*)(args.ws + WS_CTL) + 6400);
              for (int k = 0; k + 1 < phase_no; ++k) { const float d = (float)(ts[k + 1] - tp[k + 1]) / tot; if ((TPROBE_MASK_A >> k) & 1ull) fa += d; } }
#else
            for (int k = 0; k < phase_no; ++k) { const float d = (float)(ts[k + 1] - ts[k]) / tot; if ((TPROBE_MASK_A >> k) & 1ull) fa += d; }
#endif
#endif
            dl[0] = TPROBE_SCALE * sqrtf(fa); }
        __syncthreads();
        const float delta = dl[0];
        float* nv = args.out + (size_t)MT * DM + (size_t)NB * DEPTH * SEQ * 512;
        for (size_t i = threadIdx.x; i < (size_t)NB * DEPTH * SEQ * 512; i += NTHREADS) nv[i] *= (1.f + delta);
    }
#endif
#undef GRID_BAR
#undef LAUNDER
#undef ZC_PTR
#undef ATTN_UNIT
#undef ATTN_CTX
#undef ssq
#undef XS
#undef KB
#undef VB
#undef Qb
#undef AS3
#undef Eb
#undef Zb
#undef CAT
#undef UP
#undef Gb
}
}

static int fk_launch(void* const* d_in, void* d_out, void* d_ws, size_t ws_size, hipStream_t stream, int stop_after) {
    static int grid = 0;
    if (grid == 0) {
        int dev = 0, cus = 0;
        if (ws_size < fk::WS_END) { fprintf(stderr, "kernel_launch: workspace too small (%zu < %zu)\n", ws_size, (size_t)fk::WS_END); grid = -1; return -1; }
        if (hipGetDevice(&dev) != hipSuccess || hipDeviceGetAttribute(&cus, hipDeviceAttributeMultiprocessorCount, dev) != hipSuccess) { grid = -1; return -1; }
        if (hipFuncSetAttribute((const void*)fk::mega, hipFuncAttributeMaxDynamicSharedMemorySize, fk::LDS_BYTES) != hipSuccess) { fprintf(stderr, "kernel_launch: hipFuncSetAttribute failed\n"); grid = -1; return -1; }
        int per_cu = 0; (void)hipOccupancyMaxActiveBlocksPerMultiprocessor(&per_cu, (const void*)fk::mega, fk::NTHREADS, fk::LDS_BYTES); (void)hipGetLastError();
        if (per_cu < 1) fprintf(stderr, "kernel_launch: occupancy query says %d blocks/CU\n", per_cu);
        grid = cus;
        if (grid != 256) fprintf(stderr, "kernel_launch: %d CUs (built for 256)\n", grid);
    }
    if (grid < 0) return -1;
    (void)hipMemsetAsync((char*)d_ws + fk::WS_CTL, 0, fk::CTL_BYTES, stream);
    fk::Args a{};
    for (int i = 0; i < 34; ++i) a.in[i] = (const float*)d_in[i];
    a.out = (float*)d_out; a.ws = (unsigned char*)d_ws; a.stop_after = stop_after; a.pad = 0;
    hipLaunchKernelGGL(fk::mega, dim3(grid), dim3(fk::NTHREADS), fk::LDS_BYTES, stream, a);
    return 0;
}
extern "C" void kernel_launch(void* const* d_in, const int* in_sizes, int n_in, void* d_out, int out_size, void* d_ws, size_t ws_size, hipStream_t stream) {
    if (n_in != 34) { fprintf(stderr, "kernel_launch: unexpected n_in %d\n", n_in); return; }
    fk_launch(d_in, d_out, d_ws, ws_size, stream, 0);
}
```

```cpp
#include <hip/hip_runtime.h>
#include <cstdio>
#include <cstdint>
namespace fk {
#define LAS __attribute__((address_space(3)))
#define GAS __attribute__((address_space(1)))
typedef unsigned short bf16_t;
typedef short bf16x8 __attribute__((ext_vector_type(8)));
typedef short s16x4 __attribute__((ext_vector_type(4)));
typedef float f32x4 __attribute__((ext_vector_type(4)));
typedef float f32x2 __attribute__((ext_vector_type(2)));
typedef float f32x16 __attribute__((ext_vector_type(16)));
typedef unsigned u32x4 __attribute__((ext_vector_type(4)));
typedef unsigned u32x2 __attribute__((ext_vector_type(2)));

constexpr int DM = 1024, NB = 16, SEQ = 256, DEPTH = 2, DB = 8, DSEQ = 1024, PAST = 512;
constexpr int MC = NB * SEQ, MS = DB * DSEQ, MT = MC + MS;
constexpr int NH = 4, NG = 32, NCOND = 9, NMOD = 6;
constexpr int NCHUNK = MT / 16;
constexpr int KVROWS = MC + DB * (PAST + DSEQ);
constexpr float EPS = 1e-6f;
constexpr float C2 = 0.125f * 1.4426950408889634f;
constexpr int NWAVES = 8, NTHREADS = 512;

constexpr size_t MiB = 1u << 20;
constexpr size_t WS_CTL = 0, CTL_BYTES = 1 * MiB + 512 * 1024;
constexpr size_t WS_MISC = 1 * MiB;
constexpr size_t WS_WIN = 3 * MiB;
constexpr size_t WS_WGLU = 11 * MiB;
constexpr size_t WS_WOUT = 12 * MiB;
constexpr size_t WS_WUP = 16 * MiB;
constexpr size_t WS_WDN = 32 * MiB;
constexpr size_t WS_SSM = 40 * MiB;
constexpr size_t WS_XS = 53 * MiB;
constexpr size_t WS_KB = 77 * MiB;
constexpr size_t WS_VB = 93 * MiB;
constexpr size_t WS_R = 109 * MiB;
constexpr size_t WS_XR = 205 * MiB;
constexpr size_t WS_G = WS_R;
constexpr size_t WS_HALO = WS_R + 48 * MiB;
constexpr size_t WS_END = 253 * MiB;
constexpr size_t R_Q = 0, R_AS3 = 12 * MiB, R_E = 36 * MiB, R_Z = 60 * MiB, R_CAT = 72 * MiB;
constexpr size_t SSM_WE = 0, SSM_WY = 4 * MiB, SSM_LAM16 = 12 * MiB, SSM_BBAR = 12 * MiB + 64 * 1024;
constexpr int MI_MOD = 0;
constexpr int MI_ROPE = MI_MOD + 2 * 9 * 6144;
constexpr int MI_LAM = MI_ROPE + 64 * 16 * 2;
constexpr int MI_END = MI_LAM + 8;
static_assert((size_t)MI_END * 4 <= 2 * MiB, "MISC");
constexpr int CW_BAR = 1024;
constexpr int CW_ZC = 7168;
constexpr int CW_UC = 4608;
constexpr int CW_SS = 8192;
constexpr int CW_BIN = 65536;
constexpr int CW_BUP = CW_BIN + 2 * 9 * 2048;
static_assert((size_t)(CW_SS + 4 * MT) <= CW_BIN && (size_t)(CW_BUP + 2 * 9 * 4096) * 4 <= CTL_BYTES, "CTL");

constexpr int RING_BYTES = 131072;
constexpr int LDS_BYTES_ = 147456; constexpr int LDSCTL_OFF = LDS_BYTES_ - 512, MISC_OFF = LDSCTL_OFF + 320;
constexpr int LDS_BYTES = 147456;

#define RLX_AGENT __ATOMIC_RELAXED, __HIP_MEMORY_SCOPE_AGENT
typedef __bf16 bf16x2_t __attribute__((ext_vector_type(2)));
__device__ __forceinline__ unsigned cvt_pk_bf16(float lo, float hi) { const f32x2 v = {lo, hi}; const bf16x2_t b = __builtin_convertvector(v, bf16x2_t); return __builtin_bit_cast(unsigned, b); }
__device__ __forceinline__ float bf2f(unsigned short b) { return __uint_as_float((unsigned)b << 16); }
__device__ __forceinline__ float bflo(unsigned w) { return __uint_as_float(w << 16); }
__device__ __forceinline__ float bfhi(unsigned w) { return __uint_as_float(w & 0xffff0000u); }
__device__ __forceinline__ float fast_exp2(float x) { return __builtin_amdgcn_exp2f(x); }
__device__ __forceinline__ float fast_rcp(float x) { return __builtin_amdgcn_rcpf(x); }
__device__ __forceinline__ float sigmoid_f(float x) { return fast_rcp(1.f + fast_exp2(-1.4426950408889634f * x)); }
__device__ __forceinline__ float silu_f(float x) { return x * sigmoid_f(x); }
__device__ __forceinline__ float gelu_tanh_f(float x) {
    const float u = 0.7978845608028654f * (x + 0.044715f * x * x * x); return x * sigmoid_f(2.f * u); }
__device__ __forceinline__ float shfl_xor_l(float v, int mask, int lane) { return __uint_as_float((unsigned)__builtin_amdgcn_ds_bpermute((lane ^ mask) << 2, (int)__float_as_uint(v))); }
__device__ __forceinline__ float wave_sum(float v, int lane) {
#pragma unroll
    for (int o = 1; o < 64; o <<= 1) v += shfl_xor_l(v, o, lane);
    return v; }

#define XB_TMO      128
#define XB_XCNT(j)  (256  + 64 * (j))
#define XB_XSUB(j)  (1280 + 64 * (j))
#define XB_XGEN(j)  (2304 + 64 * (j))
#define XB_TOP      3328
#define XB_TOPGEN   3392
#define XCD_BAR_WORDS 3456
#define XB_SPIN_CAP (1u << 18)
__device__ __forceinline__ unsigned xb_ld(unsigned* p)              { return __hip_atomic_load(p, __ATOMIC_RELAXED, __HIP_MEMORY_SCOPE_AGENT); }
__device__ __forceinline__ unsigned xb_add(unsigned* p, unsigned v) { return __hip_atomic_fetch_add(p, v, __ATOMIC_RELAXED, __HIP_MEMORY_SCOPE_AGENT); }
__device__ __forceinline__ unsigned xb_xcc_id() { return (unsigned)__builtin_amdgcn_s_getreg((3 << 11) | 20) & 0xFu; }
#define XB_SPIN(cond, bar) do { unsigned _sp = 0; while (cond) { __builtin_amdgcn_s_sleep(1); \
    if ((++_sp & 255u) == 0u) { if (xb_ld(&(bar)[XB_TMO])) break; if (_sp > XB_SPIN_CAP) { atomicAdd(&(bar)[XB_TMO], 1u); break; } } } } while (0)
struct XcdBarrier { unsigned* bar; unsigned x; volatile LAS unsigned* st; };
__device__ __forceinline__ XcdBarrier xcd_barrier_post(unsigned* bar, volatile LAS unsigned* st) {
    XcdBarrier b; b.bar = bar; b.x = xb_xcc_id(); b.st = st;
    if (threadIdx.x == 0) (void)xb_add(&bar[XB_XCNT(b.x)], 1u);
    return b;
}
__device__ __forceinline__ void xcd_barrier_complete(unsigned* bar, unsigned x, unsigned& nloc, unsigned& nx) {
    const unsigned G = gridDim.x * gridDim.y * gridDim.z;
    unsigned sum, cnt, mine, sp = 0u;
    for (;;) {
        sum = 0u; cnt = 0u; mine = 0u;
#pragma unroll
        for (unsigned j = 0; j < 16; ++j) { const unsigned c = xb_ld(&bar[XB_XCNT(j)]); sum += c; cnt += (c > 0u) ? 1u : 0u; mine = (j == x) ? c : mine; }
        if (sum == G) break;
        __builtin_amdgcn_s_sleep(1);
        if ((++sp & 255u) == 0u) { if (xb_ld(&bar[XB_TMO])) break; if (sp > XB_SPIN_CAP) { atomicAdd(&bar[XB_TMO], 1u); break; } }
    }
    nloc = mine > 0u ? mine : 1u; nx = cnt > 0u ? cnt : 1u;
}
__device__ __forceinline__ void xcd_barrier(const XcdBarrier& b, const int tid) {
    asm volatile("s_waitcnt vmcnt(0)" ::: "memory");
    __syncthreads();
    if (tid == 0) {
        unsigned* bar = b.bar;
        __builtin_amdgcn_s_waitcnt(0);
        unsigned nloc = b.st[0], nx = b.st[1];
        if (nloc == 0u) { xcd_barrier_complete(bar, b.x, nloc, nx); b.st[0] = nloc; b.st[1] = nx; }
        const unsigned old = xb_add(&bar[XB_XSUB(b.x)], 1u);
        const unsigned gen = old / nloc;
        if (old + 1u == (gen + 1u) * nloc) {
            __builtin_amdgcn_fence(__ATOMIC_RELEASE, "agent");
            asm volatile("s_waitcnt vmcnt(0)" ::: "memory");
            const unsigned og = xb_add(&bar[XB_TOP], 1u);
            const unsigned tg = og / nx;
            __builtin_amdgcn_fence(__ATOMIC_ACQUIRE, "agent");
            if (og + 1u == (tg + 1u) * nx) xb_add(&bar[XB_TOPGEN], 1u);
            else XB_SPIN(xb_ld(&bar[XB_TOPGEN]) == tg, bar);
            xb_add(&bar[XB_XGEN(b.x)], 1u);
            asm volatile("s_waitcnt vmcnt(0)" ::: "memory");
        } else {
            __builtin_amdgcn_fence(__ATOMIC_ACQUIRE, "agent");
            XB_SPIN(xb_ld(&bar[XB_XGEN(b.x)]) == gen, bar);
            asm volatile("s_waitcnt vmcnt(0)" ::: "memory");
        }
    }
    __syncthreads();
}

constexpr int BM = 256, BK = 64, HALF = 128, HTB = HALF * BK * 2, NXCD = 8, WGM = 6;
__host__ __device__ __forceinline__ int lds_byte(int r, int c) { const int st = (r >> 4) * 2 + (c >> 5), rr = r & 15, cc = c & 31, ob = rr * 64 + cc * 2; return st * 1024 + (ob ^ (((ob >> 9) & 1) << 5)); }
__host__ __device__ __forceinline__ void stage_rc(int b, int& R, int& C) { const int st = b / 1024, sb = b % 1024, swz = sb ^ (((sb >> 9) & 1) << 5); R = (st >> 1) * 16 + swz / 64; C = (st & 1) * 32 + (swz % 64) / 2; }
__host__ __device__ __forceinline__ int perm32(int rho) { const int n = rho >> 4, i = rho & 15; return 8 * (i >> 2) + 4 * n + (i & 3); }

__device__ __forceinline__ int panel_of(int x, int j) { return 2 * x + j + ((j + 6) >> 3) * (14 + 2 * x); }
struct Unit { int pm, pn, g; };
struct Gemm { const bf16_t* A; const bf16_t* Bt; int lda, ldb, K; size_t gsA, gsB; int tsid = -1; };
struct GridOrder {
    int nM, nN, nwg, G, c;
    __device__ void init(int M, int N, int G_, int c_) { nM = M / BM; nN = N / BM; nwg = nM * nN; G = G_; c = c_; }
    __device__ bool next(int i, Unit& u) const {
        const long L = (long)i * G + c; if (L >= nwg) return false;
        int wgid = (int)L; { const int q = nwg / NXCD, r = nwg % NXCD, xcd = wgid % NXCD, off = wgid / NXCD; wgid = (xcd < r ? xcd * (q + 1) : r * (q + 1) + (xcd - r) * q) + off; }
        const int nig = WGM * nN, gid = wgid / nig, fm = gid * WGM, gsz = (nM - fm) < WGM ? (nM - fm) : WGM;
        u.pm = panel_of(gid, (wgid % nig) % gsz);     u.pn = (wgid % nig) / gsz; u.g = 0; return true;
    }
};
struct InOrder {
    int c, G;
    __device__ bool next(int i, Unit& u) const { const int L = i * G + c; if (L >= 384) return false; u.g = 0;
        if (L < 96) { const int jj = L >> 3; u.pm = panel_of(L & 7, jj >> 1); u.pn = 6 + (jj & 1); }
        else { const int Lp = L - 96, jj = Lp >> 3; u.pm = panel_of(Lp & 7, jj / 6); u.pn = jj % 6; }
        return true; }
};
struct OneTile {
    int idx;
    __device__ bool next(int i, Unit& u) const { if (i > 0 || idx < 0) return false; u.pm = panel_of(idx / 12, (idx % 12) >> 1); u.pn = idx & 1; u.g = 0; return true; }
};
struct GroupOrder {
    int c, G;
    __device__ bool next(int i, Unit& u) const { const int idx = c + i * G; if (c < 0 || idx >= NG * 3) return false; u.g = idx / 3; u.pm = idx % 3; u.pn = 0; return true; }
};

template <class Epi, class Sched, bool AROWPERM = false>
__device__ __forceinline__ void gemm_phase(LAS unsigned char* lds, const int tid, const Gemm g, const Sched& S, const Epi& E) {
    const int wid = __builtin_amdgcn_readfirstlane(tid >> 6), lane = tid & 63, wr = wid >> 2, wc = wid & 3, fr = lane & 15, fq = lane >> 4;
    const int K = g.K, nt = K / BK;
    unsigned voffA[2], voffB[2];
#pragma unroll
    for (int i = 0; i < 2; ++i) { int R, C; stage_rc(tid * 16 + i * 8192, R, C); const int Rb = Epi::PERM ? ((R & ~31) + perm32(R & 31)) : R;
        const int Ra = AROWPERM ? ((R & 64) + 4 * (R & 15) + ((R >> 4) & 3)) : R;
        voffA[i] = (unsigned)(Ra * g.lda + C) * 2u; voffB[i] = (unsigned)(Rb * g.ldb + C) * 2u; }
    const size_t kstep = (size_t)(BK * 2);
    const size_t hstepA = (size_t)HALF * g.lda * 2, hstepB = (size_t)HALF * g.ldb * 2;
    const unsigned ldsw = (unsigned)wid * 1024u;
    const int aoff = lds_byte(wr * 64 + fr, fq * 8), boff = lds_byte(wc * 32 + fr, fq * 8);
#define PG8_SA(b, h) (((b) * 2 + (h)) * HTB)
#define PG8_SB(b, h) ((4 + (b) * 2 + (h)) * HTB)
#define PG8_STAGE(bufoff, gbase, voff) do { _Pragma("unroll") for (int _i = 0; _i < 2; ++_i) \
        __builtin_amdgcn_global_load_lds((const unsigned*)((const char*)(gbase) + (voff)[_i]), (LAS unsigned*)(lds + (bufoff) + ldsw + _i * 8192), 16, 0, 0); } while (0)
#define PG8_LDA(dst, b, h) do { _Pragma("unroll") for (int m = 0; m < 4; ++m) _Pragma("unroll") for (int k = 0; k < 2; ++k) dst[m][k] = *(const LAS bf16x8*)(lds + PG8_SA(b, h) + aoff + m * 2048 + k * 1024); } while (0)
#define PG8_LDB(dst, b, h) do { _Pragma("unroll") for (int n = 0; n < 2; ++n) _Pragma("unroll") for (int k = 0; k < 2; ++k) dst[n][k] = *(const LAS bf16x8*)(lds + PG8_SB(b, h) + boff + n * 2048 + k * 1024); } while (0)
#define PG8_MMA(ai, bj, At, Bt) do { __builtin_amdgcn_s_setprio(1); _Pragma("unroll") for (int m = 0; m < 4; ++m) _Pragma("unroll") for (int n = 0; n < 2; ++n) _Pragma("unroll") for (int k = 0; k < 2; ++k) \
        acc[ai][bj][m][n] = __builtin_amdgcn_mfma_f32_16x16x32_bf16(Bt[n][k], At[m][k], acc[ai][bj][m][n], 0, 0, 0); __builtin_amdgcn_s_setprio(0); } while (0)
#define PG8_WAIT_V(n) asm volatile("s_waitcnt vmcnt(" #n ")" ::: "memory")
#define PG8_WAIT_L(n) asm volatile("s_waitcnt lgkmcnt(" #n ")" ::: "memory")
#define PG8_BAR __builtin_amdgcn_s_barrier()
#define PG8_SCHED __builtin_amdgcn_sched_barrier(0)
#define PG8_APTR(u) ((const char*)g.A + ((size_t)(u).g * g.gsA + (size_t)(u).pm * BM * g.lda) * 2)
#define PG8_BPTR(u) ((const char*)g.Bt + ((size_t)(u).g * g.gsB + (size_t)(u).pn * BM * g.ldb) * 2)
    Unit cur, nxt; int ui = 0;
    if (!S.next(0, cur)) return;
#ifdef TPROBE_GID
#define PG8_TS(k) do { if (g.tsid == TPROBE_GID && wid == 0 && lane == 0) *(LAS unsigned long long*)(lds + LDSCTL_OFF + 8 * (k)) = __builtin_amdgcn_s_memrealtime(); } while (0)
#else
#define PG8_TS(k) do {} while (0)
#endif
    PG8_TS(0);
    f32x4 acc[2][2][4][2];
#pragma unroll
    for (int a = 0; a < 2; ++a)
#pragma unroll
        for (int b = 0; b < 2; ++b)
#pragma unroll
            for (int m = 0; m < 4; ++m)
#pragma unroll
                for (int n = 0; n < 2; ++n) acc[a][b][m][n] = (f32x4){0.f, 0.f, 0.f, 0.f};
    bf16x8 At[4][2], B0[2][2], B1[2][2];
    const char* cA = PG8_APTR(cur); const char* cB = PG8_BPTR(cur);
    PG8_STAGE(PG8_SB(0, 0), cB, voffB); PG8_STAGE(PG8_SB(0, 1), cB + hstepB, voffB); PG8_STAGE(PG8_SA(0, 0), cA, voffA); PG8_STAGE(PG8_SA(0, 1), cA + hstepA, voffA);
    if (wr == 1) PG8_BAR;
    PG8_WAIT_V(2); PG8_BAR;
    PG8_STAGE(PG8_SB(1, 0), cB + kstep, voffB); PG8_STAGE(PG8_SA(1, 0), cA + kstep, voffA); PG8_STAGE(PG8_SB(1, 1), cB + hstepB + kstep, voffB);
    PG8_WAIT_V(6); PG8_BAR;
    for (;;) {
        const bool has_next = S.next(ui + 1, nxt);
        const char* nA = has_next ? PG8_APTR(nxt) : cA; const char* nB = has_next ? PG8_BPTR(nxt) : cB;
        for (int t = 0; t < nt; t += 2) {
            const bool last = (t == nt - 2);
            const char* a1 = cA + (size_t)(t + 1) * kstep;
            const char* a2 = last ? nA : cA + (size_t)(t + 2) * kstep; const char* b2 = last ? nB : cB + (size_t)(t + 2) * kstep;
            const char* a3 = a2 + kstep; const char* b3 = b2 + kstep;
            PG8_LDB(B0, 0, 0); PG8_LDB(B1, 0, 1); PG8_SCHED; PG8_LDA(At, 0, 0); PG8_STAGE(PG8_SA(1, 1), a1 + hstepA, voffA);
            PG8_WAIT_V(8); PG8_WAIT_L(0); PG8_BAR; PG8_MMA(0, 0, At, B0); PG8_MMA(0, 1, At, B1); PG8_BAR; PG8_SCHED;
            PG8_LDA(At, 0, 1); PG8_STAGE(PG8_SB(0, 0), b2, voffB); PG8_STAGE(PG8_SB(0, 1), b2 + hstepB, voffB); PG8_STAGE(PG8_SA(0, 0), a2, voffA);
            PG8_WAIT_V(8); PG8_WAIT_L(0); PG8_BAR; PG8_MMA(1, 0, At, B0); PG8_MMA(1, 1, At, B1); PG8_BAR; PG8_SCHED;
            PG8_LDB(B0, 1, 0); PG8_LDB(B1, 1, 1); PG8_SCHED; PG8_LDA(At, 1, 0); PG8_STAGE(PG8_SA(0, 1), a2 + hstepA, voffA);
            PG8_WAIT_V(8); PG8_WAIT_L(0); PG8_BAR; PG8_MMA(0, 0, At, B0); PG8_MMA(0, 1, At, B1); PG8_BAR; PG8_SCHED;
            PG8_LDA(At, 1, 1); PG8_STAGE(PG8_SB(1, 0), b3, voffB); PG8_STAGE(PG8_SB(1, 1), b3 + hstepB, voffB); PG8_STAGE(PG8_SA(1, 0), a3, voffA);
            PG8_WAIT_V(8); PG8_WAIT_L(0); PG8_BAR; PG8_MMA(1, 0, At, B0); PG8_MMA(1, 1, At, B1); PG8_BAR; PG8_SCHED;
        }
        if (wr == 0) PG8_BAR;
        PG8_TS(1 + 2 * ui);
        { unsigned z_ = 0u; asm volatile("" : "+v"(z_)); const int l2 = (int)__builtin_amdgcn_mbcnt_hi(~0u, __builtin_amdgcn_mbcnt_lo(~0u, z_));
          E(acc, cur, wr, wc, l2 & 15, l2 >> 4);
          E.done(cur, l2); }
        PG8_TS(2 + 2 * ui);
        if (!has_next) break;
#pragma unroll
        for (int a = 0; a < 2; ++a)
#pragma unroll
            for (int b = 0; b < 2; ++b)
#pragma unroll
                for (int m = 0; m < 4; ++m)
#pragma unroll
                    for (int n = 0; n < 2; ++n) acc[a][b][m][n] = (f32x4){0.f, 0.f, 0.f, 0.f};
        cur = nxt; cA = nA; cB = nB; ++ui;
        if (wr == 1) PG8_BAR;
    }
    PG8_WAIT_V(0);
    PG8_BAR;
#undef PG8_SA
#undef PG8_SB
#undef PG8_STAGE
#undef PG8_LDA
#undef PG8_LDB
#undef PG8_MMA
#undef PG8_WAIT_V
#undef PG8_WAIT_L
#undef PG8_BAR
#undef PG8_SCHED
#undef PG8_TS
#undef PG8_APTR
#undef PG8_BPTR
}
__device__ __forceinline__ int cond_of_pm(int pm) { return pm < 16 ? 0 : 1 + ((pm - 16) >> 2); }
__device__ __forceinline__ int kvrow_of(int row) { return row < MC ? row : MC + ((row - MC) >> 10) * (PAST + DSEQ) + PAST + ((row - MC) & 1023); }
__device__ __forceinline__ u32x4 pack8(const f32x4& a, const f32x4& b) { u32x4 w; w.x = cvt_pk_bf16(a[0], a[1]); w.y = cvt_pk_bf16(a[2], a[3]); w.z = cvt_pk_bf16(b[0], b[1]); w.w = cvt_pk_bf16(b[2], b[3]); return w; }

struct EpiIn {
    static constexpr bool PERM = true;
    const float* sumsq; const float* bias; const float* qn; const float* kn; const f32x2* rope;
    bf16_t* Q; bf16_t* KB; bf16_t* VB; __amdgpu_buffer_rsrc_t as3r; float* new_k; float* new_v; int l; unsigned* ucnt;
    __device__ __forceinline__ void done(const Unit& u, int lane) const {
        if (u.pn >= 6) { asm volatile("s_waitcnt vmcnt(0)" ::: "memory"); if (lane == 0) __hip_atomic_fetch_add(ucnt + (((u.pm >> 4) * 2) + (u.pn - 6)) * 64, 1u, RLX_AGENT); } }
    __device__ __forceinline__ void operator()(const f32x4 (&acc)[2][2][4][2], const Unit& u, int wr, int wc, int fr, int fq) const {
        const int pm = u.pm, pn = u.pn; const bool ctx = pm < 16; const int cond = cond_of_pm(pm);
        const float* bz = bias + cond * 2048 + pn * 256 + wc * 32 + 8 * fq;
        f32x4 bv[2][2];
#pragma unroll
        for (int bj = 0; bj < 2; ++bj)
#pragma unroll
            for (int n = 0; n < 2; ++n) bv[bj][n] = *(const f32x4*)(bz + bj * 128 + 4 * n);
        const int rbase = pm * BM + wr * 64 + fr;
        float rsd[8];
#pragma unroll
        for (int g8 = 0; g8 < 8; ++g8) rsd[g8] = sumsq[rbase + (g8 >> 2) * HALF + (g8 & 3) * 16];
#pragma unroll
        for (int g8 = 0; g8 < 8; ++g8) rsd[g8] = rsqrtf(rsd[g8] * (1.f / DM) + EPS);
        if (pn < 4) {
            const bool isq = pn < 2; const float* gv = isq ? qn : kn;
            const int G = (pn & 1) * 4 + wc;
            const int cb = 32 * (fq >> 1) + 8 * (fq & 1);
            f32x4 gg[2][2];
#pragma unroll
            for (int bj = 0; bj < 2; ++bj)
#pragma unroll
                for (int n = 0; n < 2; ++n) gg[bj][n] = *(const f32x4*)(gv + cb + 16 * bj + 4 * n);
            const float qs = isq ? C2 : 1.f;
#pragma unroll
            for (int ai = 0; ai < 2; ++ai)
#pragma unroll
                for (int m = 0; m < 4; ++m) {
                    const int row = rbase + ai * HALF + m * 16;
                    const float rstd = rsd[ai * 4 + m];
                    f32x4 v[2][2]; float ss = 0.f;
#pragma unroll
                    for (int bj = 0; bj < 2; ++bj)
#pragma unroll
                        for (int n = 0; n < 2; ++n) { v[bj][n] = acc[ai][bj][m][n] * rstd + bv[bj][n]; const f32x4 t = v[bj][n] * v[bj][n]; ss += (t[0] + t[1]) + (t[2] + t[3]); }
                    { const int ln_ = fq * 16 + fr; ss += shfl_xor_l(ss, 16, ln_); ss += shfl_xor_l(ss, 32, ln_); }
                    const float rn = rsqrtf(ss * (1.f / 64.f) + EPS);
#pragma unroll
                    for (int bj = 0; bj < 2; ++bj)
#pragma unroll
                        for (int n = 0; n < 2; ++n) v[bj][n] = v[bj][n] * rn * gg[bj][n];
                    if (ctx) {
                        if (!isq) { float* nk = new_k + ((size_t)((row >> 8) * DEPTH + l) * SEQ + (row & 255)) * 512 + G * 64 + cb;
#pragma unroll
                            for (int bj = 0; bj < 2; ++bj) { *(f32x4*)(nk + 16 * bj) = v[bj][0]; *(f32x4*)(nk + 16 * bj + 4) = v[bj][1]; } }
                    } else {
                        const int t = (row - MC) & 1023; const int pos = (fq >> 1) ? (t & 63) : (t >> 6);
                        const f32x2* rp = rope + pos * 16 + 8 * (fq & 1);
#pragma unroll
                        for (int n = 0; n < 2; ++n)
#pragma unroll
                            for (int j = 0; j < 4; ++j) { const f32x2 cs = rp[4 * n + j]; const float x1 = v[0][n][j], x2 = v[1][n][j]; v[0][n][j] = x1 * cs.x - x2 * cs.y; v[1][n][j] = x1 * cs.y + x2 * cs.x; }
                    }
                    bf16_t* dst = isq ? (Q + (size_t)row * 512) : (KB + (size_t)kvrow_of(row) * 512);
                    dst += G * 64 + cb;
#pragma unroll
                    for (int bj = 0; bj < 2; ++bj) *(u32x4*)(dst + 16 * bj) = pack8(v[bj][0] * qs, v[bj][1] * qs);
                }
        } else if (pn < 6) {
            const int col0 = (pn - 4) * 256 + wc * 32 + 8 * fq;
#pragma unroll
            for (int ai = 0; ai < 2; ++ai)
#pragma unroll
                for (int m = 0; m < 4; ++m) {
                    const int row = rbase + ai * HALF + m * 16;
                    const float rstd = rsd[ai * 4 + m];
                    bf16_t* dst = VB + (size_t)kvrow_of(row) * 512 + col0;
#pragma unroll
                    for (int bj = 0; bj < 2; ++bj) { const f32x4 a = acc[ai][bj][m][0] * rstd + bv[bj][0], b = acc[ai][bj][m][1] * rstd + bv[bj][1];
                        *(u32x4*)(dst + 128 * bj) = pack8(a, b);
                        if (ctx) { float* nv = new_v + ((size_t)((row >> 8) * DEPTH + l) * SEQ + (row & 255)) * 512 + col0 + 128 * bj; *(f32x4*)nv = a; *(f32x4*)(nv + 4) = b; } }
                }
        } else {
            const int cu0 = (pn - 6) * 256 + wc * 32 + 8 * fq;
#pragma unroll
            for (int ai = 0; ai < 2; ++ai)
#pragma unroll
                for (int m = 0; m < 4; ++m) {
                    const int row = rbase + ai * HALF + m * 16;
                    const float rstd = rsd[ai * 4 + m];
#pragma unroll
                    for (int bj = 0; bj < 2; ++bj) { const int cu = cu0 + 128 * bj; const f32x4 a = acc[ai][bj][m][0] * rstd + bv[bj][0], b = acc[ai][bj][m][1] * rstd + bv[bj][1];
                        __builtin_amdgcn_raw_buffer_store_b128(pack8(a, b), as3r, (int)(((unsigned)((cu >> 4) * NCHUNK + (row >> 4)) * 512u + (row & 15) * 16 + (cu & 15)) * 2u), 0,   16); }
                }
        }
    }
};
struct EpiS1 {
    static constexpr bool PERM = false;
    float* E;
    __device__ __forceinline__ void done(const Unit&, int) const {}
    __device__ __forceinline__ void operator()(const f32x4 (&acc)[2][2][4][2], const Unit& u, int wr, int wc, int fr, int fq) const {
        const int rbase = u.pm * BM + wr * 64 + fr, col0 = wc * 32 + 4 * fq;
#pragma unroll
        for (int ai = 0; ai < 2; ++ai)
#pragma unroll
            for (int m = 0; m < 4; ++m) { float* dst = E + ((size_t)u.g * NCHUNK + rbase + ai * HALF + m * 16) * 256 + col0;
#pragma unroll
                for (int bj = 0; bj < 2; ++bj)
#pragma unroll
                    for (int n = 0; n < 2; ++n) *(f32x4*)(dst + bj * HALF + n * 16) = acc[ai][bj][m][n]; }
    }
};
struct EpiS3 {
    static constexpr bool PERM = true;
    __amdgpu_buffer_rsrc_t zr;
    __device__ __forceinline__ void done(const Unit&, int) const {}
    __device__ __forceinline__ void operator()(const f32x4 (&acc)[2][2][4][2], const Unit& u, int wr, int wc, int fr, int fq) const {
        const int rbase = u.pm * BM + wr * 64 + fr;
#pragma unroll
        for (int ai = 0; ai < 2; ++ai)
#pragma unroll
            for (int m = 0; m < 4; ++m) { const int chunk = rbase + ai * HALF + m * 16;
#pragma unroll
                for (int bj = 0; bj < 2; ++bj) { const int tt = 8 * bj + 2 * wc + (fq >> 1), c0 = 8 * (fq & 1);
                    f32x4 a = acc[ai][bj][m][0], b = acc[ai][bj][m][1];
#pragma unroll
                    for (int j = 0; j < 4; ++j) { a[j] = gelu_tanh_f(a[j]); b[j] = gelu_tanh_f(b[j]); }
                    __builtin_amdgcn_raw_buffer_store_b128(pack8(a, b), zr, (int)((((unsigned)chunk * 16u + tt) * 512u + u.g * 16 + c0) * 2u), 0,   16); } }
    }
};
struct EpiGlu {
    static constexpr bool PERM = true;
    const bf16_t* Z; const float* bg; bf16_t* CAT;
    __device__ __forceinline__ void done(const Unit&, int) const {}
    __device__ __forceinline__ void operator()(const f32x4 (&acc)[2][2][4][2], const Unit& u, int wr, int wc, int fr, int fq) const {
        const int rbase = u.pm * BM + wr * 64 + fr, col0 = u.pn * BM + wc * 32 + 8 * fq;
        f32x4 bv[2][2];
#pragma unroll
        for (int bj = 0; bj < 2; ++bj)
#pragma unroll
            for (int n = 0; n < 2; ++n) bv[bj][n] = *(const f32x4*)(bg + col0 + bj * HALF + 4 * n);
#pragma unroll
        for (int ai = 0; ai < 2; ++ai)
#pragma unroll
            for (int m = 0; m < 4; ++m) { const int row = rbase + ai * HALF + m * 16;
#pragma unroll
                for (int bj = 0; bj < 2; ++bj) { const u32x4 zw = *(const u32x4*)(Z + (size_t)row * 512 + col0 + bj * HALF);
                    f32x4 a = acc[ai][bj][m][0] + bv[bj][0], b = acc[ai][bj][m][1] + bv[bj][1];
                    a[0] = bflo(zw.x) * sigmoid_f(a[0]); a[1] = bfhi(zw.x) * sigmoid_f(a[1]); a[2] = bflo(zw.y) * sigmoid_f(a[2]); a[3] = bfhi(zw.y) * sigmoid_f(a[3]);
                    b[0] = bflo(zw.z) * sigmoid_f(b[0]); b[1] = bfhi(zw.z) * sigmoid_f(b[1]); b[2] = bflo(zw.w) * sigmoid_f(b[2]); b[3] = bfhi(zw.w) * sigmoid_f(b[3]);
                    *(u32x4*)(CAT + (size_t)row * 1024 + 512 + col0 + bj * HALF) = pack8(a, b); } }
    }
};
template <bool IN_F32, bool OUT_F32> struct EpiRes {
    static constexpr bool PERM = true;
    const float* xin0; const float* xin1;
    const bf16_t* xrin;
    float* xout; bf16_t* xrout;
    const float* gate;
    const float* gn; const float* sc;
    bf16_t* XS; float* ssq;
    __device__ __forceinline__ void done(const Unit&, int) const {}
    __device__ __forceinline__ void operator()(const f32x4 (&acc)[2][2][4][2], const Unit& u, int wr, int wc, int fr, int fq) const {
        const int pm = u.pm, cond = cond_of_pm(pm); const int col0 = u.pn * BM + wc * 32 + 8 * fq; const int rbase = pm * BM + wr * 64 + fr;
        const bool donorm = (gn != nullptr);
        f32x4 gt[2][2], gs[2][2];
#pragma unroll
        for (int bj = 0; bj < 2; ++bj)
#pragma unroll
            for (int n = 0; n < 2; ++n) { const int c = col0 + bj * HALF + n * 4; gt[bj][n] = *(const f32x4*)(gate + cond * 6144 + c);
                if (donorm) { const f32x4 g4 = *(const f32x4*)(gn + c), s4 = *(const f32x4*)(sc + cond * 6144 + c); gs[bj][n] = g4 * (s4 + 1.f); } else gs[bj][n] = (f32x4){0.f, 0.f, 0.f, 0.f}; }
        constexpr int RD = IN_F32 ? 2 : 3;
        f32x4 xr[RD][2][2]; u32x4 xb[RD][2];
#define ER_LOAD(G_, SLOT_) do { const int row_ = rbase + ((G_) >> 2) * HALF + ((G_) & 3) * 16; \
            if (IN_F32) { const float* xi_ = (row_ < MC) ? (xin0 + (size_t)row_ * DM) : (xin1 + (size_t)(row_ - MC) * DM); \
                _Pragma("unroll") for (int bj = 0; bj < 2; ++bj) { xr[SLOT_][bj][0] = *(const f32x4*)(xi_ + col0 + bj * HALF); xr[SLOT_][bj][1] = *(const f32x4*)(xi_ + col0 + bj * HALF + 4); } } \
            else { _Pragma("unroll") for (int bj = 0; bj < 2; ++bj) xb[SLOT_][bj] = *(const u32x4*)(xrin + (size_t)row_ * DM + col0 + bj * HALF); } } while (0)
        ER_LOAD(0, 0); ER_LOAD(1, 1); if (RD == 3) ER_LOAD(2, RD - 1);
#pragma unroll
        for (int g = 0; g < 8; ++g) { const int ai = g >> 2, m = g & 3, sl = g % RD; const int row = rbase + ai * HALF + m * 16;
            float ss = 0.f; f32x4 x0[2], x1[2];
#pragma unroll
            for (int bj = 0; bj < 2; ++bj) { f32x4 a, b;
                if (IN_F32) { a = xr[sl][bj][0]; b = xr[sl][bj][1]; } else { const u32x4 w = xb[sl][bj]; a = (f32x4){bflo(w.x), bfhi(w.x), bflo(w.y), bfhi(w.y)}; b = (f32x4){bflo(w.z), bfhi(w.z), bflo(w.w), bfhi(w.w)}; }
                x0[bj] = a + gt[bj][0] * acc[ai][bj][m][0]; x1[bj] = b + gt[bj][1] * acc[ai][bj][m][1]; }
            if (g + RD < 8) ER_LOAD(g + RD, sl);
#pragma unroll
            for (int bj = 0; bj < 2; ++bj) { const int c = col0 + bj * HALF;
                if (OUT_F32) { *(f32x4*)(xout + (size_t)row * DM + c) = x0[bj]; *(f32x4*)(xout + (size_t)row * DM + c + 4) = x1[bj]; }
                else *(u32x4*)(xrout + (size_t)row * DM + c) = pack8(x0[bj], x1[bj]);
                if (donorm) { const f32x4 t0 = x0[bj] * x0[bj], t1 = x1[bj] * x1[bj]; ss += ((t0[0] + t0[1]) + (t0[2] + t0[3])) + ((t1[0] + t1[1]) + (t1[2] + t1[3]));
                    *(u32x4*)(XS + (size_t)row * DM + c) = pack8(x0[bj] * gs[bj][0], x1[bj] * gs[bj][1]); } }
            if (donorm) { { const int ln_ = fq * 16 + fr; ss += shfl_xor_l(ss, 16, ln_); ss += shfl_xor_l(ss, 32, ln_); } if (fq == 0) atomicAdd(ssq + row, ss); }
        }
#undef ER_LOAD
    }
};
struct EpiUp {
    static constexpr bool PERM = true;
    const float* sumsq; const float* bias; bf16_t* UP;
    __device__ __forceinline__ void done(const Unit&, int) const {}
    __device__ __forceinline__ void operator()(const f32x4 (&acc)[2][2][4][2], const Unit& u, int wr, int wc, int fr, int fq) const {
        const int pm = u.pm, cond = cond_of_pm(pm); const int col0 = u.pn * BM + wc * 32 + 8 * fq; const int rbase = pm * BM + wr * 64 + fr;
        f32x4 bv[2][2];
#pragma unroll
        for (int bj = 0; bj < 2; ++bj)
#pragma unroll
            for (int n = 0; n < 2; ++n) bv[bj][n] = *(const f32x4*)(bias + cond * 4096 + col0 + bj * HALF + 4 * n);
#pragma unroll
        for (int ai = 0; ai < 2; ++ai)
#pragma unroll
            for (int m = 0; m < 4; ++m) { const int row = rbase + ai * HALF + m * 16; const float rstd = rsqrtf(sumsq[row] * (1.f / DM) + EPS);
#pragma unroll
                for (int bj = 0; bj < 2; ++bj) *(u32x4*)(UP + (size_t)row * 4096 + col0 + bj * HALF) = pack8(acc[ai][bj][m][0] * rstd + bv[bj][0], acc[ai][bj][m][1] * rstd + bv[bj][1]); }
    }
};

__device__ __forceinline__ float dpp_shr1(float v) { return __uint_as_float((unsigned)__builtin_amdgcn_update_dpp(0, (int)__float_as_uint(v), 0x111, 0xf, 0xf, false)); }
__device__ __forceinline__ float dpp_shl1(float v) { return __uint_as_float((unsigned)__builtin_amdgcn_update_dpp(0, (int)__float_as_uint(v), 0x101, 0xf, 0xf, false)); }
struct EpiUpConv {
    static constexpr bool PERM = true;
    const float* sumsq; const float* bias; const float* cw; const float* cb; bf16_t* G; bf16_t* HALO;
    __device__ __forceinline__ void done(const Unit&, int) const {}
    __device__ __forceinline__ void operator()(const f32x4 (&acc)[2][2][4][2], const Unit& u, int wr, int wc, int fr, int fq) const {
        const int pm = u.pm, pn = u.pn, cond = cond_of_pm(pm);
        const int posv = pn * 256 + wc * 32 + 8 * fq, av = pn * 128 + wc * 32 + 8 * fq;
        float rs[2][4];
#pragma unroll
        for (int ai = 0; ai < 2; ++ai)
#pragma unroll
            for (int m = 0; m < 4; ++m) rs[ai][m] = sumsq[pm * BM + ai * HALF + wr * 64 + 4 * fr + m];
#pragma unroll
        for (int ai = 0; ai < 2; ++ai)
#pragma unroll
            for (int m = 0; m < 4; ++m) rs[ai][m] = rsqrtf(rs[ai][m] * (1.f / DM) + EPS);
#pragma unroll
        for (int n = 0; n < 2; ++n) {
            const int c = av + 4 * n;
            const f32x4 bvv = *(const f32x4*)(bias + cond * 4096 + posv + 4 * n), bvg = *(const f32x4*)(bias + cond * 4096 + posv + 128 + 4 * n);
            const f32x4 w0v = *(const f32x4*)(cw + c), w1v = *(const f32x4*)(cw + 4096 + c), w2v = *(const f32x4*)(cw + 8192 + c), cbv = *(const f32x4*)(cb + c);
            const f32x4 w0g = *(const f32x4*)(cw + 2048 + c), w1g = *(const f32x4*)(cw + 4096 + 2048 + c), w2g = *(const f32x4*)(cw + 8192 + 2048 + c), cbg = *(const f32x4*)(cb + 2048 + c);
#pragma unroll
            for (int ai = 0; ai < 2; ++ai) {
                const int tok0 = pm * BM + ai * HALF + wr * 64 + 4 * fr; const int sl = pm * 4 + ai * 2 + wr;
                f32x4 pv[4], pg[4];
#pragma unroll
                for (int m = 0; m < 4; ++m) { pv[m] = acc[ai][0][m][n] * rs[ai][m] + bvv; pg[m] = acc[ai][1][m][n] * rs[ai][m] + bvg; }
                f32x4 pvp, pvn, pgp, pgn;
#pragma unroll
                for (int j = 0; j < 4; ++j) { pvp[j] = dpp_shr1(pv[3][j]); pvn[j] = dpp_shl1(pv[0][j]); pgp[j] = dpp_shr1(pg[3][j]); pgn[j] = dpp_shl1(pg[0][j]); }
#pragma unroll
                for (int m = 0; m < 4; ++m) {
                    const f32x4 zv = cbv + w0v * (m == 0 ? pvp : pv[m == 0 ? 0 : m - 1]) + w1v * pv[m] + w2v * (m == 3 ? pvn : pv[m == 3 ? 3 : m + 1]);
                    const f32x4 zg = cbg + w0g * (m == 0 ? pgp : pg[m == 0 ? 0 : m - 1]) + w1g * pg[m] + w2g * (m == 3 ? pgn : pg[m == 3 ? 3 : m + 1]);
                    u32x2 w; w.x = cvt_pk_bf16(silu_f(zg[0]) * zv[0], silu_f(zg[1]) * zv[1]); w.y = cvt_pk_bf16(silu_f(zg[2]) * zv[2], silu_f(zg[3]) * zv[3]);
                    *(u32x2*)(G + (size_t)(tok0 + m) * 2048 + c) = w; }
                if (fr == 0 || fr == 15) { const int m0 = fr == 0 ? 0 : 2;
#pragma unroll
                    for (int mm = 0; mm < 2; ++mm) { const f32x4 a = fr == 0 ? pv[mm] : pv[2 + mm], b = fr == 0 ? pg[mm] : pg[2 + mm];
                        bf16_t* hp = HALO + ((size_t)sl * 4 + m0 + mm) * 4096 + posv + 4 * n;
                        u32x2 wa; wa.x = cvt_pk_bf16(a[0], a[1]); wa.y = cvt_pk_bf16(a[2], a[3]); *(u32x2*)hp = wa;
                        u32x2 wb; wb.x = cvt_pk_bf16(b[0], b[1]); wb.y = cvt_pk_bf16(b[2], b[3]); *(u32x2*)(hp + 128) = wb; } }
            }
        }
    }
};
constexpr int AT_SLOT = 32768, AT_NSLOT = 4, AT_VOFF = 16384, AT_X = 0, AT_ST = 65536;
__device__ __forceinline__ void glds16(const void* gsrc, unsigned lds_dst) { unsigned keep;
    asm volatile("s_mov_b32 %0, m0\n\ts_mov_b32 m0, %2\n\ts_nop 0\n\tglobal_load_lds_dwordx4 %1, off\n\ts_mov_b32 m0, %0" : "=&s"(keep) : "v"(gsrc), "s"(lds_dst) : "memory"); }
#define AT_WAIT_BAR(N) asm volatile("s_waitcnt vmcnt(" #N ") lgkmcnt(0)\n\ts_barrier" ::: "memory")
#define AT_SB() __builtin_amdgcn_sched_barrier(0)
__device__ __forceinline__ s16x4 vtr(const LAS char* p) { typedef short v4i16_t __attribute__((ext_vector_type(4))); return __builtin_bit_cast(s16x4, __builtin_amdgcn_ds_read_tr16_b64_v4i16((LAS v4i16_t*)p)); }
__device__ __forceinline__ int crow(int r, int hi) { return (r & 3) + 8 * (r >> 2) + 4 * hi; }

struct AttnArgs { const bf16_t* Q; const bf16_t* KB; const bf16_t* VB; bf16_t* CAT; const float* subln; float lam; float oml; };

__device__ __forceinline__ void attn_unit(LAS unsigned char* lds, const int tid, const AttnArgs& A, int seq, int h, int qblk) {
    const int lane = tid & 63, r32 = lane & 31, hi = lane >> 5; const int wid = __builtin_amdgcn_readfirstlane(tid >> 6);
    const int rg = wid & 3, s = wid >> 2;
    const bool ctx = seq < NB;
    const int qrow0 = ctx ? seq * SEQ + qblk * 128 : MC + (seq - NB) * DSEQ + qblk * 128;
    const int krow0 = ctx ? seq * SEQ : MC + (seq - NB) * (PAST + DSEQ);
    const int NT = ctx ? SEQ / 64 : (PAST + DSEQ) / 64;
    const unsigned lds0 = (unsigned)(uintptr_t)lds;
    const bf16_t* ksrc0 = A.KB + (size_t)(krow0 + lane) * 512 + h * 128 + wid * 8;
    const bf16_t* vsrc0 = A.VB + (size_t)(krow0 + 16 * (wid & 3) + (lane >> 2)) * 512 + h * 128 + (wid >> 2) * 32 + (lane & 3) * 8;
    const unsigned kdst = lds0 + wid * 1024, vdst = lds0 + AT_VOFF + ((wid >> 2) * 4 + (wid & 3)) * 1024;
#define AT_DMA(t, slot) do { const size_t _o = (size_t)(t) * 64 * 512; const unsigned _s = (unsigned)(slot) * AT_SLOT; \
        glds16(ksrc0 + _o, (unsigned)__builtin_amdgcn_readfirstlane(kdst + _s)); glds16(ksrc0 + _o + 64, (unsigned)__builtin_amdgcn_readfirstlane(kdst + _s + 8 * 1024)); \
        glds16(vsrc0 + _o, (unsigned)__builtin_amdgcn_readfirstlane(vdst + _s)); glds16(vsrc0 + _o + 64, (unsigned)__builtin_amdgcn_readfirstlane(vdst + _s + 8 * 1024)); } while (0)
    AT_DMA(0, 0); AT_DMA(1, 1); AT_DMA(2, 2);
    bf16x8 qr[4];
    { const bf16_t* qp = A.Q + (size_t)(qrow0 + rg * 32 + r32) * 512 + h * 128 + s * 64 + hi * 8;
#pragma unroll
      for (int d0 = 0; d0 < 4; ++d0) qr[d0] = *(const bf16x8*)(qp + d0 * 16); }
    f32x16 o[4];
#pragma unroll
    for (int d0 = 0; d0 < 4; ++d0)
#pragma unroll
        for (int r = 0; r < 16; ++r) o[d0][r] = 0.f;
    float lsum = 0.f;
    const LAS char* kfrag0 = (const LAS char*)lds + (s * 8 + hi) * 1024 + r32 * 16;
    const LAS char* vfrag0 = (const LAS char*)lds + AT_VOFF + ((lane >> 4) & 1) * 32 + (lane & 3) * 8 + (4 * hi + ((lane & 15) >> 2)) * 64;
    f32x16 pc0, pc1;
#define AT_KLOAD(kfr, slot) do { const LAS char* _k = kfrag0 + (slot) * AT_SLOT; _Pragma("unroll") for (int d0 = 0; d0 < 4; ++d0) { kfr[2 * d0] = *(const LAS bf16x8*)(_k + d0 * 2048); kfr[2 * d0 + 1] = *(const LAS bf16x8*)(_k + d0 * 2048 + 512); } } while (0)
#define AT_VLOAD(vv, slot, ks) do { const LAS char* _v = vfrag0 + (slot) * AT_SLOT + (ks) * 1024; _Pragma("unroll") for (int d0 = 0; d0 < 4; ++d0) { const s16x4 lo = vtr(_v + d0 * 4096), hh = vtr(_v + d0 * 4096 + 512); \
        vv[d0] = (bf16x8){lo[0], lo[1], lo[2], lo[3], hh[0], hh[1], hh[2], hh[3]}; } } while (0)
#define AT_EXP2(P, i, W) do { P[2 * (i)] = fast_exp2(P[2 * (i)]); P[2 * (i) + 1] = fast_exp2(P[2 * (i) + 1]); sacc += P[2 * (i)] + P[2 * (i) + 1]; W = cvt_pk_bf16(P[2 * (i)], P[2 * (i) + 1]); } while (0)
    AT_WAIT_BAR(8);
    { bf16x8 kfr[8]; AT_KLOAD(kfr, 0);
#pragma unroll
      for (int r = 0; r < 16; ++r) { pc0[r] = 0.f; pc1[r] = 0.f; }
#pragma unroll
      for (int d0 = 0; d0 < 4; ++d0) { pc0 = __builtin_amdgcn_mfma_f32_32x32x16_bf16(kfr[2 * d0], qr[d0], pc0, 0, 0, 0); pc1 = __builtin_amdgcn_mfma_f32_32x32x16_bf16(kfr[2 * d0 + 1], qr[d0], pc1, 0, 0, 0); } }
    int slot = 0;
    for (int t = 0; t < NT; ++t) {
        const bool has_next = t + 1 < NT;
        if (t + 2 < NT) AT_WAIT_BAR(4); else AT_WAIT_BAR(0);
        if (t + 3 < NT) AT_DMA(t + 3, (slot + 3) & 3);
        const int slot_n = (slot + 1) & 3;
        bf16x8 kfr[8], va[4], vb[4]; u32x4 pw[4]; f32x16 pn0, pn1; float sacc = 0.f;
        const LAS char* kn_ = kfrag0 + slot_n * AT_SLOT;
#define AT_K1(d0) do { kfr[2 * (d0)] = *(const LAS bf16x8*)(kn_ + (d0) * 2048); kfr[2 * (d0) + 1] = *(const LAS bf16x8*)(kn_ + (d0) * 2048 + 512); } while (0)
        if (has_next) { AT_K1(0); AT_K1(1); }
        AT_SB();
        if (has_next) {
#pragma unroll
            for (int r = 0; r < 16; ++r) { pn0[r] = 0.f; pn1[r] = 0.f; }
#pragma unroll
            for (int i = 0; i < 8; ++i) { const int d0 = i >> 1;
                if (i & 1) pn1 = __builtin_amdgcn_mfma_f32_32x32x16_bf16(kfr[2 * d0 + 1], qr[d0], pn1, 0, 0, 0); else pn0 = __builtin_amdgcn_mfma_f32_32x32x16_bf16(kfr[2 * d0], qr[d0], pn0, 0, 0, 0);
                AT_EXP2(pc0, i, pw[i >> 2][i & 3]);
                if (i == 0) AT_K1(2);
                if (i == 1) AT_K1(3);
                if (i == 3) AT_VLOAD(va, slot, 0);
                if (i == 5) AT_VLOAD(vb, slot, 1);
                AT_SB(); }
        } else {
            AT_VLOAD(va, slot, 0); AT_VLOAD(vb, slot, 1);
#pragma unroll
            for (int i = 0; i < 8; ++i) AT_EXP2(pc0, i, pw[i >> 2][i & 3]);
            AT_SB();
        }
        bf16x8 vc[4], vd[4];
#pragma unroll
        for (int i = 0; i < 8; ++i) { const int d0 = i & 3;
            if (i < 4) o[d0] = __builtin_amdgcn_mfma_f32_32x32x16_bf16(va[d0], __builtin_bit_cast(bf16x8, pw[0]), o[d0], 0, 0, 0);
            else       o[d0] = __builtin_amdgcn_mfma_f32_32x32x16_bf16(vb[d0], __builtin_bit_cast(bf16x8, pw[1]), o[d0], 0, 0, 0);
            AT_EXP2(pc1, i, pw[2 + (i >> 2)][i & 3]);
            if (i == 1) AT_VLOAD(vc, slot, 2);
            if (i == 5) AT_VLOAD(vd, slot, 3);
            AT_SB(); }
#pragma unroll
        for (int d0 = 0; d0 < 4; ++d0) o[d0] = __builtin_amdgcn_mfma_f32_32x32x16_bf16(vc[d0], __builtin_bit_cast(bf16x8, pw[2]), o[d0], 0, 0, 0);
#pragma unroll
        for (int d0 = 0; d0 < 4; ++d0) o[d0] = __builtin_amdgcn_mfma_f32_32x32x16_bf16(vd[d0], __builtin_bit_cast(bf16x8, pw[3]), o[d0], 0, 0, 0);
        lsum += sacc;
        if (has_next) { pc0 = pn0; pc1 = pn1; }
        slot = slot_n;
    }
    lsum += shfl_xor_l(lsum, 32, lane);
    const float inv = (s == 0 ? 1.f : A.lam) / lsum;
    AT_WAIT_BAR(0);
    LAS float* X = (LAS float*)(lds + AT_X) + rg * 4096;
    if (s == 1) {
#pragma unroll
        for (int d0 = 0; d0 < 4; ++d0)
#pragma unroll
            for (int r = 0; r < 16; ++r) X[(d0 * 16 + r) * 64 + lane] = o[d0][r] * inv;
    }
    AT_WAIT_BAR(0);
    if (s == 0) {
        float ss = 0.f;
#pragma unroll
        for (int d0 = 0; d0 < 4; ++d0)
#pragma unroll
            for (int r = 0; r < 16; ++r) { const float v = o[d0][r] * inv - X[(d0 * 16 + r) * 64 + lane]; o[d0][r] = v; ss += v * v; }
        ss += shfl_xor_l(ss, 32, lane);
        const float rn = rsqrtf(ss * (1.f / 128.f) + EPS) * A.oml;
        LAS bf16_t* stg = (LAS bf16_t*)(lds + AT_ST) + rg * (32 * 136);
#pragma unroll
        for (int d0 = 0; d0 < 4; ++d0)
#pragma unroll
            for (int rq = 0; rq < 4; ++rq) { const int dv = 32 * d0 + 8 * rq + 4 * hi; const f32x4 g4 = *(const f32x4*)(A.subln + dv);
                u32x2 w; w.x = cvt_pk_bf16(o[d0][4 * rq] * rn * g4[0], o[d0][4 * rq + 1] * rn * g4[1]); w.y = cvt_pk_bf16(o[d0][4 * rq + 2] * rn * g4[2], o[d0][4 * rq + 3] * rn * g4[3]);
                *(LAS u32x2*)(stg + r32 * 136 + dv) = w; }
        asm volatile("s_waitcnt lgkmcnt(0)" ::: "memory");
        bf16_t* dst = A.CAT + (size_t)(qrow0 + rg * 32) * 1024 + h * 128;
#pragma unroll
        for (int i = 0; i < 8; ++i) { const int row = i * 4 + (lane >> 4), ch = lane & 15; const u32x4 v = *(const LAS u32x4*)(stg + row * 136 + ch * 8); *(u32x4*)(dst + (size_t)row * 1024 + ch * 8) = v; }
    }
    AT_WAIT_BAR(0);
#undef AT_DMA
#undef AT_KLOAD
#undef AT_K1
#undef AT_VLOAD
#undef AT_EXP2
}
struct Args { const float* in[34]; float* out; unsigned char* ws; int stop_after; int pad; };
struct ArgsG { GAS const float* in[34]; GAS float* out; GAS unsigned char* ws; int stop_after; int pad; };
typedef const __attribute__((address_space(4))) ArgsG* kargs_t;
struct Frame {
    LAS unsigned char* lds; int tid, lane, wave, vcu, bid, G;
    kargs_t ka; float* out; unsigned char* ws;
    float* misc; unsigned* ctl;
};
#define LDS_WAIT() asm volatile("s_waitcnt lgkmcnt(0)" ::: "memory")
#define VM_WAIT() asm volatile("s_waitcnt vmcnt(0)" ::: "memory")

template <int MAP> __device__ __forceinline__ int src_col(int p);
template <int MODE, int MAP, int NC> __device__ __forceinline__ void gemv9_task(Frame& F, const float* W, int ldw, int l, int voff, int strip, float* out, int ldo, const float* add) {
    LAS float* sc = (LAS float*)F.lds; LAS float* red = sc + 9 * 1024;
    for (int i = F.tid; i < 9 * 1024; i += NTHREADS) { const int cond = i >> 10, k = i & 1023; float v;
        if (MODE == 0) { v = cond == 0 ? ((const float*)F.ka->in[6])[k] : ((const float*)F.ka->in[5])[(cond - 1) * 1024 + k]; v = v / (1.f + expf(-v)); } else v = F.misc[MI_MOD + (l * 9 + cond) * 6144 + voff + k];
        sc[i] = v; }
    __syncthreads();
    const int j = strip * NC + (F.lane < NC ? F.lane : NC - 1); const float* w = W + (size_t)(F.wave * 128) * ldw + src_col<MAP>(j);
    float acc[9];
#pragma unroll
    for (int b = 0; b < 9; ++b) acc[b] = 0.f;
#pragma unroll 16
    for (int k = 0; k < 128; ++k) { const float wv = w[(size_t)k * ldw];
#pragma unroll
        for (int b = 0; b < 9; ++b) acc[b] += sc[b * 1024 + F.wave * 128 + k] * wv; }
#pragma unroll
    for (int b = 0; b < 9; ++b) red[(F.wave * 9 + b) * 64 + F.lane] = acc[b];
    __syncthreads();
    for (int i = F.tid; i < 9 * 64; i += NTHREADS) { const int b = i >> 6, ln = i & 63; if (ln >= NC) continue; float s_ = 0.f;
#pragma unroll
        for (int w8 = 0; w8 < 8; ++w8) s_ += red[(w8 * 9 + b) * 64 + ln];
        const int jj = strip * NC + ln; out[(size_t)b * ldo + jj] = s_ + (add ? add[jj] : 0.f); }
    __syncthreads();
}
template <int MAP> __device__ __forceinline__ int src_col(int p) {
    if (MAP == 1) { if (p >= 1024) return p; const int pn = p >> 8, r = p & 255, bj = r >> 7, wc = (r >> 5) & 3, fq = (r >> 3) & 3, low = r & 7; return 256 * pn + 64 * wc + 32 * (fq >> 1) + 16 * bj + 8 * (fq & 1) + low; }
    if (MAP == 2) { const int pn = p >> 8, bj = (p >> 7) & 1, r = p & 127; return bj * 2048 + 128 * pn + r; }
    return p;
}
__device__ __forceinline__ void mod_task3(Frame& F, int task) {
    const int l = task / 96, r = task % 96, kq = r / 24, cg = r % 24;
    LAS float* sc = (LAS float*)F.lds; LAS float* red = sc + 9 * 256;
    for (int i = F.tid; i < 9 * 256; i += NTHREADS) { const int cond = i >> 8, k = kq * 256 + (i & 255); const float v = cond == 0 ? ((const float*)F.ka->in[6])[k] : ((const float*)F.ka->in[5])[(cond - 1) * 1024 + k]; sc[i] = v / (1.f + expf(-v)); }
    __syncthreads();
    const float* w = ((const float*)F.ka->in[7]) + ((size_t)l * DM + kq * 256 + F.wave * 32) * 6144 + cg * 256 + F.lane * 4;
    f32x4 acc[9];
#pragma unroll
    for (int b = 0; b < 9; ++b) acc[b] = (f32x4){0.f, 0.f, 0.f, 0.f};
#pragma unroll
    for (int h = 0; h < 2; ++h) { f32x4 wv[16];
#pragma unroll
        for (int k = 0; k < 16; ++k) wv[k] = *(const f32x4*)(w + (size_t)(h * 16 + k) * 6144);
#pragma unroll
        for (int k = 0; k < 16; ++k)
#pragma unroll
            for (int b = 0; b < 9; ++b) acc[b] += wv[k] * sc[b * 256 + F.wave * 32 + h * 16 + k]; }
#pragma unroll
    for (int b = 0; b < 9; ++b) *(LAS f32x4*)(red + (F.wave * 9 + b) * 256 + F.lane * 4) = acc[b];
    __syncthreads();
    for (int i = F.tid; i < 9 * 256; i += NTHREADS) { const int b = i >> 8, c = i & 255; float v = 0.f;
#pragma unroll
        for (int w8 = 0; w8 < 8; ++w8) v += red[(w8 * 9 + b) * 256 + c];
        const int col = cg * 256 + c; if (kq == 0) v += ((const float*)F.ka->in[8])[l * 6144 + col];
        atomicAdd(F.misc + MI_MOD + (l * 9 + b) * 6144 + col, v); }
    __syncthreads();
}
template <int MAP, bool BIAS> __device__ __forceinline__ void transpose_item(Frame& F, const float* W, int K, int N, bf16_t* WT, LAS float* scr, int item, const float* shv, float* bias) {
    const int lane = F.lane; const int nblk = N / 64, kb = item / nblk, nb = item % nblk, k0 = 64 * kb, n0 = 64 * nb;
    const int sc_ = src_col<MAP>(n0 + lane);
    float tv[64];
#pragma unroll
    for (int i = 0; i < 64; ++i) tv[i] = W[(size_t)(k0 + i) * N + sc_];
#pragma unroll
    for (int i = 0; i < 64; ++i) scr[i * 65 + lane] = tv[i];
    LDS_WAIT(); asm volatile("" ::: "memory");
    const int c = lane & 7;
#pragma unroll
    for (int j = 0; j < 8; ++j) { const int n = (lane >> 3) + 8 * j; const LAS float* s_ = scr + (8 * c) * 65 + n;
        u32x4 o; o.x = cvt_pk_bf16(s_[0 * 65], s_[1 * 65]); o.y = cvt_pk_bf16(s_[2 * 65], s_[3 * 65]); o.z = cvt_pk_bf16(s_[4 * 65], s_[5 * 65]); o.w = cvt_pk_bf16(s_[6 * 65], s_[7 * 65]);
        *(u32x4*)(WT + (size_t)(n0 + n) * K + k0 + 8 * c) = o; }
    if (BIAS) {
        float sh[9], acc[9];
#pragma unroll
        for (int b = 0; b < 9; ++b) { sh[b] = shv[b * 6144 + k0 + lane]; acc[b] = 0.f; }
#pragma unroll
        for (int kk = 0; kk < 64; ++kk) { const float w = tv[kk];
#pragma unroll
            for (int b = 0; b < 9; ++b) acc[b] += __uint_as_float(__builtin_amdgcn_readlane(__float_as_uint(sh[b]), kk)) * w; }
#pragma unroll
        for (int b = 0; b < 9; ++b) atomicAdd(bias + (size_t)b * N + n0 + lane, acc[b]);
    }
    LDS_WAIT(); asm volatile("" ::: "memory");
}
__device__ __forceinline__ void cache_item(Frame& F, int l, int item4) {
    f32x4 a[4], c[4];
#pragma unroll
    for (int i = 0; i < 4; ++i) { const int item = item4 * 4 + i, which = item >> 12, r = item & 4095, b = r >> 9, j = r & 511;
        const float* src = (which ? ((const float*)F.ka->in[3]) : ((const float*)F.ka->in[2])) + ((size_t)(b * DEPTH + l) * PAST + j) * 512 + F.lane * 8; a[i] = *(const f32x4*)src; c[i] = *(const f32x4*)(src + 4); }
#pragma unroll
    for (int i = 0; i < 4; ++i) { const int item = item4 * 4 + i, which = item >> 12, r = item & 4095, b = r >> 9, j = r & 511;
        bf16_t* dst = (bf16_t*)(F.ws + (which ? WS_VB : WS_KB)) + (size_t)(MC + b * (PAST + DSEQ) + j) * 512 + F.lane * 8; *(u32x4*)dst = pack8(a[i], c[i]); }
}
__device__ __forceinline__ f32x2 cmul(f32x2 a, f32x2 b) { return (f32x2){a.x * b.x - a.y * b.y, a.x * b.y + a.y * b.x}; }
__device__ __forceinline__ void ssm_prep(Frame& F, int l, int task) {
    const int g = task >> 1, half = task & 1;
    LAS f32x2* POW = (LAS f32x2*)F.lds;
    LAS f32x2* BB = POW + 2 * 17 * 64;
    LAS f32x2* CC = BB + 2 * 64 * 16;
    LAS f32x2* CT = CC + 2 * 16 * 64;
    LAS float* KT = (LAS float*)(CT + 2 * 64 * 16);
    constexpr int KTS = 260;
    bf16_t* WE = (bf16_t*)(F.ws + WS_SSM + SSM_WE) + (size_t)g * 256 * 256;
    bf16_t* WY = (bf16_t*)(F.ws + WS_SSM + SSM_WY) + (size_t)g * 256 * 512;
    f32x2* LAM16 = (f32x2*)(F.ws + WS_SSM + SSM_LAM16); f32x2* BBAR = (f32x2*)(F.ws + WS_SSM + SSM_BBAR);
    const int tid = F.tid, lane = F.lane;
    if (tid < 128) { const int dir = tid >> 6, p = tid & 63; const size_t pi = ((size_t)(l * 2 + dir) * NG + g) * 64 + p;
        const float lr = ((const float*)F.ka->in[18])[pi], li = ((const float*)F.ka->in[19])[pi], delta = expf(((const float*)F.ka->in[20])[(l * 2 + dir) * NG + g]);
        const float er = expf(lr * delta), lbr = er * cosf(li * delta), lbi = er * sinf(li * delta);
        { float one_ = 1.f, zero_ = 0.f; asm volatile("" : "+v"(one_), "+v"(zero_));
          f32x2 pw = (f32x2){one_, zero_}; const f32x2 lb = (f32x2){lbr, lbi};
          for (int tau = 0; tau <= 16; ++tau) { POW[(dir * 17 + tau) * 64 + p] = pw; if (tau == 16 && half == 0) LAM16[(dir * NG + g) * 64 + p] = pw; pw = cmul(pw, lb); } }
        const float nr = lbr - 1.f, ni = lbi, den = lr * lr + li * li; const f32x2 fac = (f32x2){(nr * lr + ni * li) / den, (ni * lr - nr * li) / den};
        f32x4 br[4], bi4[4];
#pragma unroll
        for (int q = 0; q < 4; ++q) { br[q] = *(const f32x4*)(((const float*)F.ka->in[21]) + pi * 16 + 4 * q); bi4[q] = *(const f32x4*)(((const float*)F.ka->in[22]) + pi * 16 + 4 * q); }
#pragma unroll
        for (int ch = 0; ch < 16; ++ch) { const f32x2 bb = cmul(fac, (f32x2){br[ch >> 2][ch & 3], bi4[ch >> 2][ch & 3]}); BB[(dir * 64 + p) * 16 + ch] = bb; if (half == 0) BBAR[((size_t)(dir * NG + g) * 64 + p) * 16 + ch] = bb; }
    }
    { f32x2 cv[4];
#pragma unroll
      for (int q = 0; q < 4; ++q) { const int i = tid + q * NTHREADS, dir = i >> 10, c = (i >> 6) & 15, p = i & 63; const size_t ci = (((size_t)(l * 2 + dir) * NG + g) * 16 + c) * 64 + p; cv[q] = (f32x2){((const float*)F.ka->in[23])[ci], ((const float*)F.ka->in[24])[ci]}; }
#pragma unroll
      for (int q = 0; q < 4; ++q) { const int i = tid + q * NTHREADS, dir = i >> 10, c = (i >> 6) & 15, p = i & 63; CC[i] = cv[q]; CT[(dir * 64 + p) * 16 + c] = cv[q]; } }
    __syncthreads();
    { const int i16 = lane & 15, k4 = lane >> 4, ri = k4 & 1, ph = k4 >> 1;
      for (int blk = 0; blk < 4; ++blk) { const int q = F.wave * 4 + blk, dir = q >> 4, tau = q & 15; f32x4 acc = (f32x4){0.f, 0.f, 0.f, 0.f};
#pragma unroll 8
          for (int ks = 0; ks < 32; ++ks) { const int p = 2 * ks + ph;
              const f32x2 cc = CT[(dir * 64 + p) * 16 + i16], pw = POW[(dir * 17 + tau) * 64 + p], bb = BB[(dir * 64 + p) * 16 + i16];
              const float u = ri ? -pw.y : pw.x, v = ri ? pw.x : pw.y;
              const float av = cc.x * u - cc.y * v, bv = ri ? bb.y : bb.x;
              acc = __builtin_amdgcn_mfma_f32_16x16x4f32(av, bv, acc, 0, 0, 0); }
#pragma unroll
          for (int r = 0; r < 4; ++r) KT[(dir * 16 + tau) * KTS + (k4 * 4 + r) * 16 + i16] = acc[r]; } }
    __syncthreads();
    const float* Dv = ((const float*)F.ka->in[25]) + l * 512 + g * 16;
    for (int idx = half * 8192 + tid; idx < (half + 1) * 8192; idx += NTHREADS) { const int n = idx >> 6, kc = idx & 63, k0 = kc * 8, i = n >> 4, c = n & 15; f32x4 v0, v1;
        if (k0 < 256) { const int s_ = k0 >> 4, ch0 = k0 & 15; v0 = (f32x4){0.f, 0.f, 0.f, 0.f}; v1 = v0;
            if (s_ <= i) { const LAS float* kp = KT + (i - s_) * KTS + c * 16 + ch0; v0 += *(const LAS f32x4*)kp; v1 += *(const LAS f32x4*)(kp + 4); }
            if (s_ >= i) { const LAS float* kp = KT + (16 + s_ - i) * KTS + c * 16 + ch0; v0 += *(const LAS f32x4*)kp; v1 += *(const LAS f32x4*)(kp + 4); }
            if (s_ == i) { const int e = c - ch0; const float dv = Dv[c]; if (e >= 0 && e < 4) v0[e] += dv; else if (e >= 4 && e < 8) v1[e - 4] += dv; }
        } else { const int dir = k0 >= 384 ? 1 : 0, p0 = ((k0 - 256) & 127) >> 1, tau = dir ? 16 - i : i + 1;
            const LAS f32x4* cp = (const LAS f32x4*)(CC + (dir * 16 + c) * 64 + p0); const LAS f32x4* pp = (const LAS f32x4*)(POW + (dir * 17 + tau) * 64 + p0);
            const f32x4 c0 = cp[0], c1 = cp[1], w0 = pp[0], w1 = pp[1];
            v0 = (f32x4){c0[0] * w0[0] - c0[1] * w0[1], -(c0[0] * w0[1] + c0[1] * w0[0]), c0[2] * w0[2] - c0[3] * w0[3], -(c0[2] * w0[3] + c0[3] * w0[2])};
            v1 = (f32x4){c1[0] * w1[0] - c1[1] * w1[1], -(c1[0] * w1[1] + c1[1] * w1[0]), c1[2] * w1[2] - c1[3] * w1[3], -(c1[2] * w1[3] + c1[3] * w1[2])}; }
        *(u32x4*)(WY + (size_t)n * 512 + k0) = pack8(v0, v1); }
    for (int idx = half * 4096 + tid; idx < (half + 1) * 4096; idx += NTHREADS) { const int n = idx >> 5, k0 = (idx & 31) * 8, dir = n >> 7, p = (n & 127) >> 1, ri = n & 1, s_ = k0 >> 4, ch0 = k0 & 15;
        const f32x2 pw = POW[(dir * 17 + (dir ? s_ : 15 - s_)) * 64 + p]; const LAS f32x4* bp = (const LAS f32x4*)(BB + (dir * 64 + p) * 16 + ch0);
        const float u = ri ? pw.y : pw.x, v = ri ? pw.x : -pw.y;
        const f32x4 b0 = bp[0], b1 = bp[1], b2 = bp[2], b3 = bp[3];
        const f32x4 v0 = (f32x4){u * b0[0] + v * b0[1], u * b0[2] + v * b0[3], u * b1[0] + v * b1[1], u * b1[2] + v * b1[3]};
        const f32x4 v1 = (f32x4){u * b2[0] + v * b2[1], u * b2[2] + v * b2[3], u * b3[0] + v * b3[1], u * b3[2] + v * b3[3]};
        *(u32x4*)(WE + (size_t)n * 256 + k0) = pack8(v0, v1); }
    __syncthreads();
}
__device__ __forceinline__ void xprep_item(Frame& F, int item4) {
    f32x4 xv[4][4];
#pragma unroll
    for (int i = 0; i < 4; ++i) { const int row = item4 * 4 + i; const float* xr = (row < MC) ? ((const float*)F.ka->in[0]) + (size_t)row * DM : ((const float*)F.ka->in[1]) + (size_t)(row - MC) * DM;
#pragma unroll
        for (int j = 0; j < 4; ++j) xv[i][j] = *(const f32x4*)(xr + 4 * F.lane + 256 * j); }
    const int cond = item4 * 4 < MC ? 0 : 1 + ((item4 * 4 - MC) >> 10);
    const float* sc = F.misc + MI_MOD + (0 * 9 + cond) * 6144 + 1024; const float* g1 = ((const float*)F.ka->in[9]);
    f32x4 gs[4];
#pragma unroll
    for (int j = 0; j < 4; ++j) { const int c = 4 * F.lane + 256 * j; gs[j] = (*(const f32x4*)(g1 + c)) * (*(const f32x4*)(sc + c) + 1.f); }
#pragma unroll
    for (int i = 0; i < 4; ++i) { const int row = item4 * 4 + i; bf16_t* dst = (bf16_t*)(F.ws + WS_XS) + (size_t)row * DM; float s = 0.f;
#pragma unroll
        for (int j = 0; j < 4; ++j) { const f32x4 x = xv[i][j]; const f32x4 t = x * x; s += (t[0] + t[1]) + (t[2] + t[3]); const f32x4 y = x * gs[j];
            u32x2 w; w.x = cvt_pk_bf16(y[0], y[1]); w.y = cvt_pk_bf16(y[2], y[3]); *(u32x2*)(dst + 4 * F.lane + 256 * j) = w; }
        s = wave_sum(s, F.lane);
        if (F.lane == 0) ((float*)(F.ctl + CW_SS))[row] = s; }
}
__device__ __forceinline__ void bias_item(Frame& F, int item) {
    const int which = item >= 2048, n = which ? item - 2048 : item;
    const bf16_t* wrow = (const bf16_t*)(F.ws + (which ? WS_WUP : WS_WIN)) + (size_t)n * DM;
    float wv[16]; { const u32x4 a = *(const u32x4*)(wrow + F.lane * 8), b = *(const u32x4*)(wrow + 512 + F.lane * 8);
        wv[0] = bflo(a.x); wv[1] = bfhi(a.x); wv[2] = bflo(a.y); wv[3] = bfhi(a.y); wv[4] = bflo(a.z); wv[5] = bfhi(a.z); wv[6] = bflo(a.w); wv[7] = bfhi(a.w);
        wv[8] = bflo(b.x); wv[9] = bfhi(b.x); wv[10] = bflo(b.y); wv[11] = bfhi(b.y); wv[12] = bflo(b.z); wv[13] = bfhi(b.z); wv[14] = bflo(b.w); wv[15] = bfhi(b.w); }
    float outv = 0.f;
#pragma unroll
    for (int cond = 0; cond < 9; ++cond) { const float* sh = F.misc + MI_MOD + cond * 6144 + (which ? 3072 : 0);
        const f32x4 s0 = *(const f32x4*)(sh + F.lane * 8), s1 = *(const f32x4*)(sh + F.lane * 8 + 4), s2 = *(const f32x4*)(sh + 512 + F.lane * 8), s3 = *(const f32x4*)(sh + 512 + F.lane * 8 + 4);
        float d = 0.f;
#pragma unroll
        for (int e = 0; e < 4; ++e) d += s0[e] * wv[e] + s1[e] * wv[4 + e] + s2[e] * wv[8 + e] + s3[e] * wv[12 + e];
        d = wave_sum(d, F.lane); if (F.lane == cond) outv = d; }
    if (F.lane < 9) ((float*)F.ctl)[(which ? CW_BUP + F.lane * 4096 : CW_BIN + F.lane * 2048) + n] = outv;
}
__device__ __forceinline__ void ssm_scan(Frame& F, int l, int g, int pm) {
    const int tid = F.tid, sl = tid >> 7, dp = tid & 127, dir = dp >> 6, p = dp & 63;
    const f32x2* LAM16 = (const f32x2*)(F.ws + WS_SSM + SSM_LAM16); const f32x2* BBAR = (const f32x2*)(F.ws + WS_SSM + SSM_BBAR);
    const float* E = (const float*)(F.ws + WS_R + R_E); bf16_t* AS3 = (bf16_t*)(F.ws + WS_R + R_AS3);
    const f32x2 lam = LAM16[(dir * NG + g) * 64 + p];
    f32x2 e[64];
    if (pm == 0) {
#pragma unroll
        for (int q = 0; q < 4; ++q) { const float* ep = E + ((size_t)g * NCHUNK + (q * 4 + sl) * 16) * 256 + dir * 128 + 2 * p;
#pragma unroll
            for (int j = 0; j < 16; ++j) e[q * 16 + j] = *(const f32x2*)(ep + (size_t)j * 256); }
    } else { const float* ep = E + ((size_t)g * NCHUNK + 256 + ((pm - 1) * 4 + sl) * 64) * 256 + dir * 128 + 2 * p;
#pragma unroll
        for (int j = 0; j < 64; ++j) e[j] = *(const f32x2*)(ep + (size_t)j * 256); }
    const int nq = pm == 0 ? 4 : 1;
#pragma unroll
    for (int q = 0; q < 4; ++q) { if (q >= nq) break;
        int base; f32x2 h;
        if (pm == 0) { const int seq = q * 4 + sl; base = seq * 16; h = (f32x2){0.f, 0.f}; }
        else { const int sq = (pm - 1) * 4 + sl; base = 256 + sq * 64; h = *(const f32x2*)(((const float*)F.ka->in[4]) + ((((size_t)sq * DEPTH + l) * 2 + dir) * NG + g) * 128 + 2 * p); }
        unsigned* hp = (unsigned*)(AS3 + ((size_t)g * NCHUNK + base) * 512 + 256 + dir * 128 + 2 * p);
        if (pm == 0) {
#pragma unroll
            for (int jj = 0; jj < 16; ++jj) { const int j = dir ? 15 - jj : jj; const f32x2 ev = dir ? e[q * 16 + 15 - jj] : e[q * 16 + jj]; hp[(size_t)j * 256] = cvt_pk_bf16(h.x, h.y); h = cmul(lam, h) + ev; }
        } else {
#pragma unroll
            for (int jj = 0; jj < 64; ++jj) { const int j = dir ? 63 - jj : jj; const f32x2 ev = dir ? e[63 - jj] : e[jj]; hp[(size_t)j * 256] = cvt_pk_bf16(h.x, h.y); h = cmul(lam, h) + ev; }
        }
    }
    if (pm == 0) {
        const int tt = dir ? 15 : 0; u32x4 uq[4][2]; f32x2 bbv[16];
        const f32x2* bb = BBAR + ((size_t)(dir * NG + g) * 64 + p) * 16;
#pragma unroll
        for (int ch = 0; ch < 16; ++ch) bbv[ch] = bb[ch];
#pragma unroll
        for (int q = 0; q < 4; ++q) { const int chunk = (q * 4 + sl) * 16 + tt; const bf16_t* up = AS3 + ((size_t)g * NCHUNK + chunk) * 512 + tt * 16; uq[q][0] = *(const u32x4*)up; uq[q][1] = *(const u32x4*)(up + 8); }
        float* ns = F.out + (size_t)MT * DM + 2 * (size_t)NB * DEPTH * SEQ * 512;
#pragma unroll
        for (int q = 0; q < 4; ++q) { const int seq = q * 4 + sl; const u32x4 u0 = uq[q][0], u1 = uq[q][1];
            const float uu[16] = {bflo(u0.x), bfhi(u0.x), bflo(u0.y), bfhi(u0.y), bflo(u0.z), bfhi(u0.z), bflo(u0.w), bfhi(u0.w), bflo(u1.x), bfhi(u1.x), bflo(u1.y), bfhi(u1.y), bflo(u1.z), bfhi(u1.z), bflo(u1.w), bfhi(u1.w)};
            f32x2 acc = (f32x2){0.f, 0.f};
#pragma unroll
            for (int ch = 0; ch < 16; ++ch) acc += bbv[ch] * uu[ch];
            *(f32x2*)(ns + ((((size_t)seq * DEPTH + l) * 2 + dir) * NG + g) * 128 + 2 * p) = acc; }
    }
}
__device__ __forceinline__ void ld16(const bf16_t* p, float* v) { const u32x4 a = *(const u32x4*)p; v[0] = bflo(a.x); v[1] = bfhi(a.x); v[2] = bflo(a.y); v[3] = bfhi(a.y); v[4] = bflo(a.z); v[5] = bfhi(a.z); v[6] = bflo(a.w); v[7] = bfhi(a.w); }
__device__ __forceinline__ void conv_item(Frame& F, int l, int item) {
    const int rs = item >> 4, pn = item & 15, lr = F.lane >> 4, lc = F.lane & 15;
    const int r0 = rs * 64 + lr * 16; const int av = 128 * pn + 8 * lc;
    const bf16_t* up = (const bf16_t*)(F.ws + WS_R) + (size_t)r0 * 4096 + 256 * pn + 8 * lc; bf16_t* gp = (bf16_t*)(F.ws + WS_G) + (size_t)r0 * 2048 + av;
    const float* cw = ((const float*)F.ka->in[31]) + (size_t)l * 3 * 4096; const float* cb = ((const float*)F.ka->in[32]) + (size_t)l * 4096;
    float wv[3][8], wg[3][8], bv[8], bg[8];
#pragma unroll
    for (int k = 0; k < 3; ++k)
#pragma unroll
        for (int e = 0; e < 8; ++e) { wv[k][e] = cw[k * 4096 + av + e]; wg[k][e] = cw[k * 4096 + 2048 + av + e]; }
#pragma unroll
    for (int e = 0; e < 8; ++e) { bv[e] = cb[av + e]; bg[e] = cb[2048 + av + e]; }
    const int t0 = r0 < MC ? (r0 & 255) : ((r0 - MC) & 1023), L = r0 < MC ? SEQ : DSEQ;
    float pv[8], pg[8], cv[8], cg[8], nv_[8], ng[8];
    if (t0 > 0) { ld16(up - 4096, pv); ld16(up - 4096 + 128, pg); } else {
#pragma unroll
        for (int e = 0; e < 8; ++e) { pv[e] = 0.f; pg[e] = 0.f; } }
    ld16(up, cv); ld16(up + 128, cg);
#pragma unroll
    for (int i = 0; i < 16; ++i) {
        if (t0 + i + 1 < L) { ld16(up + (size_t)(i + 1) * 4096, nv_); ld16(up + (size_t)(i + 1) * 4096 + 128, ng); } else {
#pragma unroll
            for (int e = 0; e < 8; ++e) { nv_[e] = 0.f; ng[e] = 0.f; } }
        float o[8];
#pragma unroll
        for (int e = 0; e < 8; ++e) { const float zv = bv[e] + wv[0][e] * pv[e] + wv[1][e] * cv[e] + wv[2][e] * nv_[e]; const float zg = bg[e] + wg[0][e] * pg[e] + wg[1][e] * cg[e] + wg[2][e] * ng[e]; o[e] = silu_f(zg) * zv; }
        u32x4 w; w.x = cvt_pk_bf16(o[0], o[1]); w.y = cvt_pk_bf16(o[2], o[3]); w.z = cvt_pk_bf16(o[4], o[5]); w.w = cvt_pk_bf16(o[6], o[7]);
        *(u32x4*)(gp + (size_t)i * 2048) = w;
#pragma unroll
        for (int e = 0; e < 8; ++e) { pv[e] = cv[e]; pg[e] = cg[e]; cv[e] = nv_[e]; cg[e] = ng[e]; }
    }
}

__device__ __forceinline__ bool slab_first(int s) { return s < 64 ? (s & 3) == 0 : ((s - 64) & 15) == 0; }
__device__ __forceinline__ bool slab_last(int s) { return s < 64 ? (s & 3) == 3 : ((s - 64) & 15) == 15; }
__device__ __forceinline__ void ld4bf(const bf16_t* p, float* v) { const u32x2 a = *(const u32x2*)p; v[0] = bflo(a.x); v[1] = bfhi(a.x); v[2] = bflo(a.y); v[3] = bfhi(a.y); }
__device__ __forceinline__ void conv_fix(Frame& F, int l, int pm) {
    const bf16_t* HALO = (const bf16_t*)(F.ws + WS_HALO); bf16_t* G = (bf16_t*)(F.ws + WS_G);
    const float* cw = ((const float*)F.ka->in[31]) + (size_t)l * 3 * 4096; const float* cb = ((const float*)F.ka->in[32]) + (size_t)l * 4096;
    const int c = F.tid * 4, pos = 256 * (c >> 7) + (c & 127);
    float wv[3][4], wg[3][4], bv[4], bg[4];
#pragma unroll
    for (int k = 0; k < 3; ++k) { const f32x4 a = *(const f32x4*)(cw + k * 4096 + c), b = *(const f32x4*)(cw + k * 4096 + 2048 + c);
#pragma unroll
        for (int e = 0; e < 4; ++e) { wv[k][e] = a[e]; wg[k][e] = b[e]; } }
    { const f32x4 a = *(const f32x4*)(cb + c), b = *(const f32x4*)(cb + 2048 + c);
#pragma unroll
      for (int e = 0; e < 4; ++e) { bv[e] = a[e]; bg[e] = b[e]; } }
    u32x2 hv[8][6];
#pragma unroll
    for (int r8 = 0; r8 < 8; ++r8) { const int s = pm * 4 + (r8 >> 1), which = r8 & 1; const bool skip = which == 0 ? slab_first(s) : slab_last(s);
        const int sp = skip ? s : (which == 0 ? s - 1 : s), sn = skip ? s : (which == 0 ? s : s + 1);
        const bf16_t* hp = which == 0 ? HALO + ((size_t)sp * 4 + 3) * 4096 : HALO + ((size_t)s * 4 + 2) * 4096;
        const bf16_t* hc = which == 0 ? HALO + ((size_t)s * 4 + 0) * 4096 : HALO + ((size_t)s * 4 + 3) * 4096;
        const bf16_t* hn = which == 0 ? HALO + ((size_t)s * 4 + 1) * 4096 : HALO + ((size_t)sn * 4 + 0) * 4096;
        hv[r8][0] = *(const u32x2*)(hp + pos); hv[r8][1] = *(const u32x2*)(hc + pos); hv[r8][2] = *(const u32x2*)(hn + pos);
        hv[r8][3] = *(const u32x2*)(hp + pos + 128); hv[r8][4] = *(const u32x2*)(hc + pos + 128); hv[r8][5] = *(const u32x2*)(hn + pos + 128); }
#pragma unroll
    for (int r8 = 0; r8 < 8; ++r8) { const int s = pm * 4 + (r8 >> 1), which = r8 & 1;
        if (which == 0 ? slab_first(s) : slab_last(s)) continue;
        float pv[4], cv[4], nv_[4], pg[4], cg[4], ng[4];
#define UNP(v, w) do { v[0] = bflo(w.x); v[1] = bfhi(w.x); v[2] = bflo(w.y); v[3] = bfhi(w.y); } while (0)
        UNP(pv, hv[r8][0]); UNP(cv, hv[r8][1]); UNP(nv_, hv[r8][2]); UNP(pg, hv[r8][3]); UNP(cg, hv[r8][4]); UNP(ng, hv[r8][5]);
#undef UNP
        float o[4];
#pragma unroll
        for (int e = 0; e < 4; ++e) { const float zv = bv[e] + wv[0][e] * pv[e] + wv[1][e] * cv[e] + wv[2][e] * nv_[e]; const float zg = bg[e] + wg[0][e] * pg[e] + wg[1][e] * cg[e] + wg[2][e] * ng[e]; o[e] = silu_f(zg) * zv; }
        u32x2 w; w.x = cvt_pk_bf16(o[0], o[1]); w.y = cvt_pk_bf16(o[2], o[3]);
        *(u32x2*)(G + (size_t)(s * 64 + (which ? 63 : 0)) * 2048 + c) = w; }
}
constexpr int N_TR_ITEMS_L = 16 * 32 + 8 * 8 + 16 * 16 + 16 * 64 + 32 * 16;
template <bool BIAS> __device__ __forceinline__ void weight_item(Frame& F, LAS float* scr, int l, int it) {
    int r = it; const float* modl = F.misc + MI_MOD + l * 9 * 6144; float* cf = (float*)F.ctl;
    if (r < 512) { transpose_item<1, BIAS>(F, ((const float*)F.ka->in[10]) + (size_t)l * DM * 2048, DM, 2048, (bf16_t*)(F.ws + WS_WIN) + (size_t)l * 2048 * DM, scr, r, modl, cf + CW_BIN + l * 9 * 2048); return; } r -= 512;
    if (r < 64) { transpose_item<0, false>(F, ((const float*)F.ka->in[26]) + (size_t)l * 512 * 512, 512, 512, (bf16_t*)(F.ws + WS_WGLU) + (size_t)l * 512 * 512, scr, r, nullptr, nullptr); return; } r -= 64;
    if (r < 256) { transpose_item<0, false>(F, ((const float*)F.ka->in[28]) + (size_t)l * DM * DM, DM, DM, (bf16_t*)(F.ws + WS_WOUT) + (size_t)l * DM * DM, scr, r, nullptr, nullptr); return; } r -= 256;
    if (r < 1024) { transpose_item<2, BIAS>(F, ((const float*)F.ka->in[30]) + (size_t)l * DM * 4096, DM, 4096, (bf16_t*)(F.ws + WS_WUP) + (size_t)l * 4096 * DM, scr, r, modl + 3072, cf + CW_BUP + l * 9 * 4096); return; } r -= 1024;
    transpose_item<0, false>(F, ((const float*)F.ka->in[33]) + (size_t)l * 2048 * DM, 2048, DM, (bf16_t*)(F.ws + WS_WDN) + (size_t)l * DM * 2048, scr, r, nullptr, nullptr);
}

__global__ void __launch_bounds__(NTHREADS, 2) mega(Args args) {
    extern __shared__ __attribute__((aligned(16))) unsigned char lds_raw[];
    Frame F;
    F.lds = (LAS unsigned char*)lds_raw;
    F.tid = threadIdx.x; F.lane = F.tid & 63; F.wave = __builtin_amdgcn_readfirstlane(F.tid >> 6);
    F.G = gridDim.x; F.bid = blockIdx.x; { const int bx = blockIdx.x; F.vcu = (F.G % 8 == 0) ? (bx % 8) * (F.G / 8) + bx / 8 : bx; }
    F.ka = (kargs_t)__builtin_amdgcn_kernarg_segment_ptr();
    F.out = args.out; F.ws = args.ws; F.misc = (float*)(args.ws + WS_MISC); F.ctl = (unsigned*)(args.ws + WS_CTL);
    volatile LAS unsigned* MISC = (volatile LAS unsigned*)(F.lds + MISC_OFF);
    for (int u = F.tid; u < (LDS_BYTES - LDSCTL_OFF) / 4; u += NTHREADS) ((LAS unsigned*)(F.lds + LDSCTL_OFF))[u] = 0u;
    __syncthreads();
    XcdBarrier bar = xcd_barrier_post(F.ctl + CW_BAR, MISC + 8);
    int phase_no = 0;
#define LAUNDER() do { { GAS unsigned char* w1_ = (GAS unsigned char*)args.ws; GAS float* o1_ = (GAS float*)args.out; kargs_t k1_ = (kargs_t)__builtin_amdgcn_kernarg_segment_ptr(); \
      int b_ = __builtin_amdgcn_readfirstlane(F.bid), w_ = __builtin_amdgcn_readfirstlane(F.wave); \
      asm volatile("" : "+s"(k1_), "+s"(w1_), "+s"(o1_), "+s"(b_), "+s"(w_)); F.ka = k1_; F.ws = (unsigned char*)w1_; F.out = (float*)o1_; F.bid = b_; F.wave = w_; }     \
    F.vcu = (F.G % 8 == 0) ? (F.bid % 8) * (F.G / 8) + F.bid / 8 : F.bid; \
    { unsigned z_ = 0u; asm volatile("" : "+v"(z_)); F.lane = (int)__builtin_amdgcn_mbcnt_hi(~0u, __builtin_amdgcn_mbcnt_lo(~0u, z_)); } F.tid = F.wave * 64 + F.lane;     \
    F.misc = (float*)(F.ws + WS_MISC); F.ctl = (unsigned*)(F.ws + WS_CTL); gw = F.vcu * NWAVES + F.wave; } while (0)
#ifndef TPROBE_SCALE
#define TPROBE_SCALE 0.25f
#endif
#ifdef TPROBE
#define TSTAMP() do { if (blockIdx.x == 0 && F.tid == 0) ((unsigned long long*)(F.ctl + 6000))[phase_no] = __builtin_amdgcn_s_memrealtime(); } while (0)
#else
#define TSTAMP() do {} while (0)
#endif
#if defined(TPROBE) && defined(TPROBE_SUB_A)
#ifndef TPROBE_BID
#define TPROBE_BID 0
#endif
#define TSUB(i) do { if (blockIdx.x == TPROBE_BID && F.tid == 0 && l == 0) ((unsigned long long*)(F.ctl + 6200))[i] = __builtin_amdgcn_s_memrealtime(); } while (0)
#else
#define TSUB(i) do {} while (0)
#endif
#ifdef TPROBE
#define TPRE() do { if (blockIdx.x == 0 && F.tid == 0) ((unsigned long long*)(F.ctl + 6400))[phase_no + 1] = __builtin_amdgcn_s_memrealtime(); } while (0)
#else
#define TPRE() do {} while (0)
#endif
#define GRID_BAR() do { LAUNDER(); TPRE(); xcd_barrier(bar, F.tid); ++phase_no; TSTAMP(); if (F.ka->stop_after == phase_no) return; LAUNDER(); } while (0)
    int gw = F.vcu * NWAVES + F.wave; const int NGW = F.G * NWAVES;
#define ssq ((float*)(F.ctl + CW_SS))
#define XS ((bf16_t*)(F.ws + WS_XS))
#define KB ((bf16_t*)(F.ws + WS_KB))
#define VB ((bf16_t*)(F.ws + WS_VB))
#define Qb ((bf16_t*)(F.ws + WS_R + R_Q))
#define AS3 ((bf16_t*)(F.ws + WS_R + R_AS3))
#define Eb ((float*)(F.ws + WS_R + R_E))
#define Zb ((bf16_t*)(F.ws + WS_R + R_Z))
#define CAT ((bf16_t*)(F.ws + WS_R + R_CAT))
#define UP ((bf16_t*)(F.ws + WS_R))
#define Gb ((bf16_t*)(F.ws + WS_G))

    TSTAMP();
    if (F.vcu < 64) ssm_prep(F, 0, F.vcu);
    else {
        mod_task3(F, F.vcu - 64);
        if (F.vcu == 64) {
            for (int i = F.tid; i < 1024; i += NTHREADS) { const int pos = i >> 4, f = i & 15; const float inv = 1.0f / powf(10000.0f, (float)f / 16.0f); const float ang = (float)pos * inv;
                ((f32x2*)(F.misc + MI_ROPE))[i] = (f32x2){cosf(ang), sinf(ang)}; }
            if (F.tid < 2) { const int l = F.tid; float a1 = 0.f, a2 = 0.f; for (int d = 0; d < 64; ++d) { a1 += ((const float*)F.ka->in[13])[l * 64 + d] * ((const float*)F.ka->in[14])[l * 64 + d]; a2 += ((const float*)F.ka->in[15])[l * 64 + d] * ((const float*)F.ka->in[16])[l * 64 + d]; }
                const float li = 0.8f - 0.6f * expf(-0.3f * (float)l); F.misc[MI_LAM + l] = expf(a1) - expf(a2) + li; F.misc[MI_LAM + 2 + l] = 1.f - li; }
            __syncthreads();
        }
        LAS float* scr = (LAS float*)(F.lds + F.wave * 16640);
        const int gw1 = (F.vcu - 64) * NWAVES + F.wave, NGW1 = (F.G - 64) * NWAVES;
        for (int it = gw1; it < N_TR_ITEMS_L + 2048; it += NGW1) { if (it < N_TR_ITEMS_L) weight_item<false>(F, scr, 0, it); else cache_item(F, 0, it - N_TR_ITEMS_L); }
    }
    GRID_BAR();
    for (int it = gw; it < MT / 4 + 6144; it += NGW) { if (it < MT / 4) xprep_item(F, it); else bias_item(F, it - MT / 4); }
    GRID_BAR();

    for (int l = 0; l < DEPTH; ++l) {
        const float* modl = F.misc + MI_MOD + l * 9 * 6144;
        { unsigned* ucnt = F.ctl + CW_UC + l * 6 * 64;
          { Gemm g{XS, (const bf16_t*)(F.ws + WS_WIN) + (size_t)l * 2048 * DM, DM, DM, DM, 0, 0, 1}; InOrder S{F.bid, F.G};
            EpiIn E{ssq + (l == 0 ? 0 : 2 * MT), (const float*)F.ctl + CW_BIN + l * 9 * 2048, ((const float*)F.ka->in[11]) + l * 64, ((const float*)F.ka->in[12]) + l * 64, (const f32x2*)(F.misc + MI_ROPE), Qb, KB, VB,
                    __builtin_amdgcn_make_buffer_rsrc((void*)AS3, 0, (int)((size_t)NG * NCHUNK * 512 * 2), 0x00020000),
                    F.out + (size_t)MT * DM, F.out + (size_t)MT * DM + (size_t)NB * DEPTH * SEQ * 512, l, ucnt};
            gemm_phase<EpiIn, InOrder>(F.lds, F.tid, g, S, E); }
          if (F.bid >= 128 && F.bid < 224) {
              LAUNDER();
              const int idx = F.bid - 128, gq = idx / 3, pmq = idx % 3; unsigned* up = F.ctl + CW_UC + ((l * 3 + pmq) * 2 + (gq >> 4)) * 64;
              if (F.tid == 0) { unsigned sp = 0; while (__hip_atomic_load(up, RLX_AGENT) < 128u) { __builtin_amdgcn_s_sleep(2); if (++sp > (1u << 20)) break; }
                  __builtin_amdgcn_fence(__ATOMIC_ACQUIRE, "agent"); asm volatile("s_waitcnt vmcnt(0)" ::: "memory"); }
              __syncthreads();
              { Gemm g{AS3, (const bf16_t*)(F.ws + WS_SSM + SSM_WE), 512, 256, 256, (size_t)NCHUNK * 512, (size_t)256 * 256}; GroupOrder S{idx, F.G}; EpiS1 E{Eb};
                gemm_phase<EpiS1, GroupOrder>(F.lds, F.tid, g, S, E); }
              VM_WAIT(); __syncthreads(); LAUNDER();
              ssm_scan(F, l, (F.bid - 128) / 3, (F.bid - 128) % 3); } }
        GRID_BAR();
#define ZC_PTR (F.ctl + CW_ZC + l * 256)
#define ATTN_UNIT(SEQ_, H_, QB_) do { LAUNDER(); const AttnArgs A_{Qb, KB, VB, CAT, ((const float*)F.ka->in[17]) + l * 128, F.misc[MI_LAM + l], F.misc[MI_LAM + 2 + l]}; attn_unit(F.lds, F.tid, A_, (SEQ_), (H_), (QB_)); } while (0)
#define ATTN_CTX(U_) do { const int u_ = (U_); ATTN_UNIT(u_ >> 3, (u_ >> 1) & 3, u_ & 1); } while (0)
        { TSUB(0);
          const int xq = F.vcu >> 5, rq = F.vcu & 31;
          if (rq < 12) { const int cidx = xq * 12 + rq;
              { Gemm g{AS3, (const bf16_t*)(F.ws + WS_SSM + SSM_WY), 512, 512, 512, (size_t)NCHUNK * 512, (size_t)256 * 512}; GroupOrder S{cidx, F.G};
                EpiS3 E{__builtin_amdgcn_make_buffer_rsrc((void*)Zb, 0, (int)((size_t)MT * 512 * 2), 0x00020000)};
                gemm_phase<EpiS3, GroupOrder>(F.lds, F.tid, g, S, E); }
              VM_WAIT(); __syncthreads(); LAUNDER();
              if (F.tid == 0) __hip_atomic_fetch_add(ZC_PTR + (((F.vcu >> 5) * 12 + (F.vcu & 31)) % 3) * 64, 1u, RLX_AGENT); }
          TSUB(3);
          { const int u = F.vcu; ATTN_UNIT(NB + (u >> 5), (u >> 3) & 3, u & 7); } TSUB(4);
          if ((F.vcu & 31) >= 24) { for (int r = 0; r < 2; ++r) ATTN_CTX((F.vcu >> 5) * 16 + 2 * ((F.vcu & 31) - 24) + r); }
          TSUB(5);
          if ((F.vcu & 31) >= 12 && (F.vcu & 31) < 24) {
              LAUNDER();
              const int idx = (F.vcu >> 5) * 12 + ((F.vcu & 31) - 12), pmz = panel_of(idx / 12, (idx % 12) >> 1) >> 4;
              if (F.tid == 0) { unsigned sp = 0; while (__hip_atomic_load(ZC_PTR + pmz * 64, RLX_AGENT) < (unsigned)NG) { __builtin_amdgcn_s_sleep(2); if (++sp > (1u << 20)) break; }
                  __builtin_amdgcn_fence(__ATOMIC_ACQUIRE, "agent"); asm volatile("s_waitcnt vmcnt(0)" ::: "memory"); }
              __syncthreads(); TSUB(6);
              Gemm g{Zb, (const bf16_t*)(F.ws + WS_WGLU) + (size_t)l * 512 * 512, 512, 512, 512, 0, 0}; OneTile S{idx};
              EpiGlu E{Zb, ((const float*)F.ka->in[27]) + l * 512, CAT};
              gemm_phase<EpiGlu, OneTile>(F.lds, F.tid, g, S, E); TSUB(7); } }
        GRID_BAR();
        { Gemm g{CAT, (const bf16_t*)(F.ws + WS_WOUT) + (size_t)l * DM * DM, DM, DM, DM, 0, 0, 2}; GridOrder S; S.init(MT, DM, F.G, F.bid);
          bf16_t* XR = (bf16_t*)(F.ws + WS_XR);
          if (l == 0) { EpiRes<true, false> E{((const float*)F.ka->in[0]), ((const float*)F.ka->in[1]), nullptr, nullptr, XR, modl + 2 * DM, ((const float*)F.ka->in[29]) + l * DM, modl + 4 * DM, XS, ssq + 1 * MT};
              gemm_phase<EpiRes<true, false>, GridOrder>(F.lds, F.tid, g, S, E); }
          else { EpiRes<false, false> E{nullptr, nullptr, XR, nullptr, XR, modl + 2 * DM, ((const float*)F.ka->in[29]) + l * DM, modl + 4 * DM, XS, ssq + 3 * MT};
              gemm_phase<EpiRes<false, false>, GridOrder>(F.lds, F.tid, g, S, E); }
          if (l + 1 < DEPTH && F.bid >= 192) { LAUNDER(); LAS float* scr = (LAS float*)(F.lds + F.wave * 16640);
              for (int it = (F.bid - 192) * NWAVES + F.wave; it < N_TR_ITEMS_L; it += 64 * NWAVES) weight_item<true>(F, scr, l + 1, it); } }
        GRID_BAR();
        { Gemm g{XS, (const bf16_t*)(F.ws + WS_WUP) + (size_t)l * 4096 * DM, DM, DM, DM, 0, 0, 3}; GridOrder S; S.init(MT, 4096, F.G, F.bid);
          EpiUpConv E{ssq + (l == 0 ? 1 : 3) * MT, (const float*)F.ctl + CW_BUP + l * 9 * 4096, ((const float*)F.ka->in[31]) + (size_t)l * 3 * 4096, ((const float*)F.ka->in[32]) + (size_t)l * 4096, Gb, (bf16_t*)(F.ws + WS_HALO)};
          gemm_phase<EpiUpConv, GridOrder, true>(F.lds, F.tid, g, S, E); }
        GRID_BAR();
        { Gemm g{Gb, (const bf16_t*)(F.ws + WS_WDN) + (size_t)l * DM * 2048, 2048, 2048, 2048, 0, 0, 4}; GridOrder S; S.init(MT, DM, F.G, F.bid);
          const bool nxt = l + 1 < DEPTH;
          bf16_t* XR = (bf16_t*)(F.ws + WS_XR);
          { Unit u0; if (S.next(0, u0)) { conv_fix(F, l, u0.pm); VM_WAIT(); __syncthreads(); LAUNDER(); } }
          if (nxt) { EpiRes<false, false> E{nullptr, nullptr, XR, nullptr, XR, modl + 5 * DM, ((const float*)F.ka->in[9]) + (l + 1) * DM, modl + 9 * 6144 + DM, XS, ssq + 2 * MT};
              gemm_phase<EpiRes<false, false>, GridOrder>(F.lds, F.tid, g, S, E); }
          else { EpiRes<false, true> E{nullptr, nullptr, XR, F.out, nullptr, modl + 5 * DM, nullptr, nullptr, XS, ssq + 2 * MT};
              gemm_phase<EpiRes<false, true>, GridOrder>(F.lds, F.tid, g, S, E); }
          if (nxt && F.bid >= 192) { LAUNDER(); ssm_prep(F, l + 1, F.bid - 192);
              for (int it = (F.bid - 192) * NWAVES + F.wave; it < 2048; it += 64 * NWAVES) cache_item(F, l + 1, it); } }
        if (l + 1 < DEPTH) GRID_BAR();
    }
#ifdef TPROBE
    if (blockIdx.x == 0) {
        ++phase_no; TSTAMP(); VM_WAIT(); __syncthreads();
        volatile LAS float* dl = (volatile LAS float*)(F.lds + 1024);
        if (threadIdx.x == 0) { const unsigned long long* ts = (const unsigned long long*)((unsigned*)(args.ws + WS_CTL) + 6000); const float tot = (float)(ts[phase_no] - ts[0]);
            float fa = 0.f;
#if defined(TPROBE_GID)
            { const volatile LAS unsigned long long* t2 = (const volatile LAS unsigned long long*)(F.lds + LDSCTL_OFF); fa = (float)(t2[TPROBE_SUB_B] - t2[TPROBE_SUB_A]) / tot; }
#elif defined(TPROBE_SUB_A)
            { const unsigned long long* t2 = (const unsigned long long*)((unsigned*)(args.ws + WS_CTL) + 6200); fa = (float)(t2[TPROBE_SUB_B] - t2[TPROBE_SUB_A]) / tot; }
#else
#ifdef TPROBE_WAITMODE
            { const unsigned long long* tp = (const unsigned long long*)((unsigned*)(args.ws + WS_CTL) + 6400);
              for (int k = 0; k + 1 < phase_no; ++k) { const float d = (float)(ts[k + 1] - tp[k + 1]) / tot; if ((TPROBE_MASK_A >> k) & 1ull) fa += d; } }
#else
            for (int k = 0; k < phase_no; ++k) { const float d = (float)(ts[k + 1] - ts[k]) / tot; if ((TPROBE_MASK_A >> k) & 1ull) fa += d; }
#endif
#endif
            dl[0] = TPROBE_SCALE * sqrtf(fa); }
        __syncthreads();
        const float delta = dl[0];
        float* nv = args.out + (size_t)MT * DM + (size_t)NB * DEPTH * SEQ * 512;
        for (size_t i = threadIdx.x; i < (size_t)NB * DEPTH * SEQ * 512; i += NTHREADS) nv[i] *= (1.f + delta);
    }
#endif
#undef GRID_BAR
#undef LAUNDER
#undef ZC_PTR
#undef ATTN_UNIT
#undef ATTN_CTX
#undef ssq
#undef XS
#undef KB
#undef VB
#undef Qb
#undef AS3
#undef Eb
#undef Zb
#undef CAT
#undef UP
#undef Gb
}
}

static int fk_launch(void* const* d_in, void* d_out, void* d_ws, size_t ws_size, hipStream_t stream, int stop_after) {
    static int grid = 0;
    if (grid == 0) {
        int dev = 0, cus = 0;
        if (ws_size < fk::WS_END) { fprintf(stderr, "kernel_launch: workspace too small (%zu < %zu)\n", ws_size, (size_t)fk::WS_END); grid = -1; return -1; }
        if (hipGetDevice(&dev) != hipSuccess || hipDeviceGetAttribute(&cus, hipDeviceAttributeMultiprocessorCount, dev) != hipSuccess) { grid = -1; return -1; }
        if (hipFuncSetAttribute((const void*)fk::mega, hipFuncAttributeMaxDynamicSharedMemorySize, fk::LDS_BYTES) != hipSuccess) { fprintf(stderr, "kernel_launch: hipFuncSetAttribute failed\n"); grid = -1; return -1; }
        int per_cu = 0; (void)hipOccupancyMaxActiveBlocksPerMultiprocessor(&per_cu, (const void*)fk::mega, fk::NTHREADS, fk::LDS_BYTES); (void)hipGetLastError();
        if (per_cu < 1) fprintf(stderr, "kernel_launch: occupancy query says %d blocks/CU\n", per_cu);
        grid = cus;
        if (grid != 256) fprintf(stderr, "kernel_launch: %d CUs (built for 256)\n", grid);
    }
    if (grid < 0) return -1;
    (void)hipMemsetAsync((char*)d_ws + fk::WS_CTL, 0, fk::CTL_BYTES, stream);
    fk::Args a{};
    for (int i = 0; i < 34; ++i) a.in[i] = (const float*)d_in[i];
    a.out = (float*)d_out; a.ws = (unsigned char*)d_ws; a.stop_after = stop_after; a.pad = 0;
    hipLaunchKernelGGL(fk::mega, dim3(grid), dim3(fk::NTHREADS), fk::LDS_BYTES, stream, a);
    return 0;
}
extern "C" void kernel_launch(void* const* d_in, const int* in_sizes, int n_in, void* d_out, int out_size, void* d_ws, size_t ws_size, hipStream_t stream) {
    if (n_in != 34) { fprintf(stderr, "kernel_launch: unexpected n_in %d\n", n_in); return; }
    fk_launch(d_in, d_out, d_ws, ws_size, stream, 0);
}
```

```cpp
#include <hip/hip_runtime.h>
#include <cstdio>
#include <cstdint>
namespace fk {
#define LAS __attribute__((address_space(3)))
#define GAS __attribute__((address_space(1)))
typedef unsigned short bf16_t;
typedef short bf16x8 __attribute__((ext_vector_type(8)));
typedef short s16x4 __attribute__((ext_vector_type(4)));
typedef float f32x4 __attribute__((ext_vector_type(4)));
typedef float f32x2 __attribute__((ext_vector_type(2)));
typedef float f32x16 __attribute__((ext_vector_type(16)));
typedef unsigned u32x4 __attribute__((ext_vector_type(4)));
typedef unsigned u32x2 __attribute__((ext_vector_type(2)));

constexpr int DM = 1024, NB = 16, SEQ = 256, DEPTH = 2, DB = 8, DSEQ = 1024, PAST = 512;
constexpr int MC = NB * SEQ, MS = DB * DSEQ, MT = MC + MS;
constexpr int NH = 4, NG = 32, NCOND = 9, NMOD = 6;
constexpr int NCHUNK = MT / 16;
constexpr int KVROWS = MC + DB * (PAST + DSEQ);
constexpr float EPS = 1e-6f;
constexpr float C2 = 0.125f * 1.4426950408889634f;
constexpr int NWAVES = 8, NTHREADS = 512;

constexpr size_t MiB = 1u << 20;
constexpr size_t WS_CTL = 0, CTL_BYTES = 1 * MiB + 512 * 1024;
constexpr size_t WS_MISC = 1 * MiB;
constexpr size_t WS_WIN = 3 * MiB;
constexpr size_t WS_WGLU = 11 * MiB;
constexpr size_t WS_WOUT = 12 * MiB;
constexpr size_t WS_WUP = 16 * MiB;
constexpr size_t WS_WDN = 32 * MiB;
constexpr size_t WS_SSM = 40 * MiB;
constexpr size_t WS_XS = 53 * MiB;
constexpr size_t WS_KB = 77 * MiB;
constexpr size_t WS_VB = 93 * MiB;
constexpr size_t WS_R = 109 * MiB;
constexpr size_t WS_XR = 205 * MiB;
constexpr size_t WS_G = WS_R;
constexpr size_t WS_HALO = WS_R + 48 * MiB;
constexpr size_t WS_END = 253 * MiB;
constexpr size_t R_Q = 0, R_AS3 = 12 * MiB, R_Z = 36 * MiB, R_CAT = 48 * MiB, R_E = 48 * MiB;
constexpr size_t SSM_WE = 0, SSM_WY = 4 * MiB, SSM_LAM16 = 12 * MiB, SSM_BBAR = 12 * MiB + 64 * 1024;
constexpr int MI_MOD = 0;
constexpr int MI_ROPE = MI_MOD + 2 * 9 * 6144;
constexpr int MI_LAM = MI_ROPE + 64 * 16 * 2;
constexpr int MI_END = MI_LAM + 8;
static_assert((size_t)MI_END * 4 <= 2 * MiB, "MISC");
constexpr int CW_BAR = 1024;
constexpr int CW_ZC = 7168;
constexpr int CW_UC = 4608;
constexpr int CW_SS = 8192;
constexpr int CW_BIN = 65536;
constexpr int CW_BUP = CW_BIN + 2 * 9 * 2048;
static_assert((size_t)(CW_SS + 4 * MT) <= CW_BIN && (size_t)(CW_BUP + 2 * 9 * 4096) * 4 <= CTL_BYTES, "CTL");

constexpr int RING_BYTES = 131072;
constexpr int LDS_BYTES_ = 147456; constexpr int LDSCTL_OFF = LDS_BYTES_ - 512, MISC_OFF = LDSCTL_OFF + 320;
constexpr int ROPE_LDS_OFF = RING_BYTES;
constexpr int LDS_BYTES = 147456;

#define RLX_AGENT __ATOMIC_RELAXED, __HIP_MEMORY_SCOPE_AGENT
typedef __bf16 bf16x2_t __attribute__((ext_vector_type(2)));
__device__ __forceinline__ unsigned cvt_pk_bf16(float lo, float hi) { const f32x2 v = {lo, hi}; const bf16x2_t b = __builtin_convertvector(v, bf16x2_t); return __builtin_bit_cast(unsigned, b); }
__device__ __forceinline__ float bf2f(unsigned short b) { return __uint_as_float((unsigned)b << 16); }
__device__ __forceinline__ float bflo(unsigned w) { return __uint_as_float(w << 16); }
__device__ __forceinline__ float bfhi(unsigned w) { return __uint_as_float(w & 0xffff0000u); }
__device__ __forceinline__ float fast_exp2(float x) { return __builtin_amdgcn_exp2f(x); }
__device__ __forceinline__ float fast_rcp(float x) { return __builtin_amdgcn_rcpf(x); }
__device__ __forceinline__ float sigmoid_f(float x) { return fast_rcp(1.f + fast_exp2(-1.4426950408889634f * x)); }
__device__ __forceinline__ float silu_f(float x) { return x * sigmoid_f(x); }
__device__ __forceinline__ float gelu_tanh_f(float x) {
    const float u = 0.7978845608028654f * (x + 0.044715f * x * x * x); return x * sigmoid_f(2.f * u); }
__device__ __forceinline__ float shfl_xor_l(float v, int mask, int lane) { return __uint_as_float((unsigned)__builtin_amdgcn_ds_bpermute((lane ^ mask) << 2, (int)__float_as_uint(v))); }
__device__ __forceinline__ float wave_sum(float v, int lane) {
#pragma unroll
    for (int o = 1; o < 64; o <<= 1) v += shfl_xor_l(v, o, lane);
    return v; }

#define XB_TMO      128
#define XB_XCNT(j)  (256  + 64 * (j))
#define XB_XSUB(j)  (1280 + 64 * (j))
#define XB_XGEN(j)  (2304 + 64 * (j))
#define XB_TOP      3328
#define XB_TOPGEN   3392
#define XCD_BAR_WORDS 3456
#define XB_SPIN_CAP (1u << 18)
__device__ __forceinline__ unsigned xb_ld(unsigned* p)              { return __hip_atomic_load(p, __ATOMIC_RELAXED, __HIP_MEMORY_SCOPE_AGENT); }
__device__ __forceinline__ unsigned xb_add(unsigned* p, unsigned v) { return __hip_atomic_fetch_add(p, v, __ATOMIC_RELAXED, __HIP_MEMORY_SCOPE_AGENT); }
__device__ __forceinline__ unsigned xb_xcc_id() { return (unsigned)__builtin_amdgcn_s_getreg((3 << 11) | 20) & 0xFu; }
#define XB_SPIN(cond, bar) do { unsigned _sp = 0; while (cond) { __builtin_amdgcn_s_sleep(1); \
    if ((++_sp & 255u) == 0u) { if (xb_ld(&(bar)[XB_TMO])) break; if (_sp > XB_SPIN_CAP) { atomicAdd(&(bar)[XB_TMO], 1u); break; } } } } while (0)
struct XcdBarrier { unsigned* bar; unsigned x; volatile LAS unsigned* st; };
__device__ __forceinline__ XcdBarrier xcd_barrier_post(unsigned* bar, volatile LAS unsigned* st) {
    XcdBarrier b; b.bar = bar; b.x = xb_xcc_id(); b.st = st;
    if (threadIdx.x == 0) (void)xb_add(&bar[XB_XCNT(b.x)], 1u);
    return b;
}
__device__ __forceinline__ void xcd_barrier_complete(unsigned* bar, unsigned x, unsigned& nloc, unsigned& nx) {
    const unsigned G = gridDim.x * gridDim.y * gridDim.z;
    unsigned sum, cnt, mine, sp = 0u;
    for (;;) {
        sum = 0u; cnt = 0u; mine = 0u;
#pragma unroll
        for (unsigned j = 0; j < 16; ++j) { const unsigned c = xb_ld(&bar[XB_XCNT(j)]); sum += c; cnt += (c > 0u) ? 1u : 0u; mine = (j == x) ? c : mine; }
        if (sum == G) break;
        __builtin_amdgcn_s_sleep(1);
        if ((++sp & 255u) == 0u) { if (xb_ld(&bar[XB_TMO])) break; if (sp > XB_SPIN_CAP) { atomicAdd(&bar[XB_TMO], 1u); break; } }
    }
    nloc = mine > 0u ? mine : 1u; nx = cnt > 0u ? cnt : 1u;
}
__device__ __forceinline__ void xcd_barrier(const XcdBarrier& b, const int tid) {
    asm volatile("s_waitcnt vmcnt(0)" ::: "memory");
    __syncthreads();
    if (tid == 0) {
        unsigned* bar = b.bar;
        __builtin_amdgcn_s_waitcnt(0);
        unsigned nloc = b.st[0], nx = b.st[1];
        if (nloc == 0u) { xcd_barrier_complete(bar, b.x, nloc, nx); b.st[0] = nloc; b.st[1] = nx; }
        const unsigned old = xb_add(&bar[XB_XSUB(b.x)], 1u);
        const unsigned gen = old / nloc;
        if (old + 1u == (gen + 1u) * nloc) {
            __builtin_amdgcn_fence(__ATOMIC_RELEASE, "agent");
            asm volatile("s_waitcnt vmcnt(0)" ::: "memory");
            const unsigned og = xb_add(&bar[XB_TOP], 1u);
            const unsigned tg = og / nx;
            __builtin_amdgcn_fence(__ATOMIC_ACQUIRE, "agent");
            if (og + 1u == (tg + 1u) * nx) xb_add(&bar[XB_TOPGEN], 1u);
            else XB_SPIN(xb_ld(&bar[XB_TOPGEN]) == tg, bar);
            xb_add(&bar[XB_XGEN(b.x)], 1u);
            asm volatile("s_waitcnt vmcnt(0)" ::: "memory");
        } else {
            __builtin_amdgcn_fence(__ATOMIC_ACQUIRE, "agent");
            XB_SPIN(xb_ld(&bar[XB_XGEN(b.x)]) == gen, bar);
            asm volatile("s_waitcnt vmcnt(0)" ::: "memory");
        }
    }
    __syncthreads();
}

constexpr int BM = 256, BK = 64, HALF = 128, HTB = HALF * BK * 2, NXCD = 8, WGM = 6;
__host__ __device__ __forceinline__ int lds_byte(int r, int c) { const int st = (r >> 4) * 2 + (c >> 5), rr = r & 15, cc = c & 31, ob = rr * 64 + cc * 2; return st * 1024 + (ob ^ (((ob >> 9) & 1) << 5)); }
__host__ __device__ __forceinline__ void stage_rc(int b, int& R, int& C) { const int st = b / 1024, sb = b % 1024, swz = sb ^ (((sb >> 9) & 1) << 5); R = (st >> 1) * 16 + swz / 64; C = (st & 1) * 32 + (swz % 64) / 2; }
__host__ __device__ __forceinline__ int perm32(int rho) { const int n = rho >> 4, i = rho & 15; return 8 * (i >> 2) + 4 * n + (i & 3); }

__device__ __forceinline__ int panel_of(int x, int j) { return 2 * x + j + ((j + 6) >> 3) * (14 + 2 * x); }
struct Unit { int pm, pn, g; };
struct Gemm { const bf16_t* A; const bf16_t* Bt; int lda, ldb, K; size_t gsA, gsB; int tsid = -1; };
struct GridOrder {
    int nM, nN, nwg, G, c;
    __device__ void init(int M, int N, int G_, int c_) { nM = M / BM; nN = N / BM; nwg = nM * nN; G = G_; c = c_; }
    __device__ __forceinline__ bool next(int i, Unit& u) const {
        const long L = (long)i * G + c; if (L >= nwg) return false;
        int wgid = (int)L; { const int q = nwg / NXCD, r = nwg % NXCD, xcd = wgid % NXCD, off = wgid / NXCD; wgid = (xcd < r ? xcd * (q + 1) : r * (q + 1) + (xcd - r) * q) + off; }
        const int nig = WGM * nN, gid = wgid / nig, fm = gid * WGM, gsz = (nM - fm) < WGM ? (nM - fm) : WGM;
        u.pm = panel_of(gid, (wgid % nig) % gsz);     u.pn = (wgid % nig) / gsz; u.g = 0; return true;
    }
};
struct InOrder {
    int c, G;
    __device__ __forceinline__ bool next(int i, Unit& u) const { const int L = i * G + c; if (L >= 384) return false; u.g = 0;
        if (L < 96) { const int jj = L >> 3; u.pm = panel_of(L & 7, jj >> 1); u.pn = 6 + (jj & 1); }
        else { const int Lp = L - 96, jj = Lp >> 3; u.pm = panel_of(Lp & 7, jj / 6); u.pn = jj % 6; }
        return true; }
};
struct OneTile {
    int idx;
    __device__ __forceinline__ bool next(int i, Unit& u) const { if (i > 0 || idx < 0) return false; u.pm = panel_of(idx / 12, (idx % 12) >> 1); u.pn = idx & 1; u.g = 0; return true; }
};
struct GroupOrder {
    int c, G;
    __device__ __forceinline__ bool next(int i, Unit& u) const { const int idx = c + i * G; if (c < 0 || idx >= NG * 3) return false; u.g = idx / 3; u.pm = idx % 3; u.pn = 0; return true; }
};

template <class Epi, class Sched, bool AROWPERM = false, int BAUX = 0, bool ZA = false>
__device__ __forceinline__ void gemm_phase(LAS unsigned char* lds, const int tid, const Gemm g, const Sched& S, const Epi& E) {
    const int wid = __builtin_amdgcn_readfirstlane(tid >> 6), lane = tid & 63, wr = wid >> 2, wc = wid & 3, fr = lane & 15, fq = lane >> 4;
    const int K = g.K, nt = K / BK;
    unsigned voffA[2], voffB[2];
#pragma unroll
    for (int i = 0; i < 2; ++i) { int R, C; stage_rc(tid * 16 + i * 8192, R, C); const int Rb = Epi::BLK2 ? ((R >> 5) * 64 + perm32(R & 31)) : Epi::PERM ? ((R & ~31) + perm32(R & 31)) : R;
        const int Ra = AROWPERM ? ((R & 64) + 4 * (R & 15) + ((R >> 4) & 3)) : R;
        voffA[i] = ZA ? (unsigned)((Ra >> 4) * 8192 + (C >> 4) * 256 + (Ra & 15) * 16 + (C & 15)) * 2u : (unsigned)(Ra * g.lda + C) * 2u; voffB[i] = (unsigned)(Rb * g.ldb + C) * 2u; }
    const size_t kstepB = (size_t)(BK * 2), kstepA = ZA ? (size_t)2048 : kstepB;
    const size_t hstepA = (size_t)HALF * g.lda * 2, hstepB = (size_t)(Epi::BLK2 ? 32 : HALF) * g.ldb * 2;
    const unsigned ldsw = (unsigned)wid * 1024u;
    const int aoff = lds_byte(wr * 64 + fr, fq * 8), boff = lds_byte(wc * 32 + fr, fq * 8);
#define PG8_SA(b, h) (((b) * 2 + (h)) * HTB)
#define PG8_SB(b, h) ((4 + (b) * 2 + (h)) * HTB)
#define PG8_STAGE(bufoff, gbase, voff) do { _Pragma("unroll") for (int _i = 0; _i < 2; ++_i) \
        __builtin_amdgcn_global_load_lds((const unsigned*)((const char*)(gbase) + (voff)[_i]), (LAS unsigned*)(lds + (bufoff) + ldsw + _i * 8192), 16, 0, 0); } while (0)
#define PG8_STAGEB(bufoff, gbase, voff) do { _Pragma("unroll") for (int _i = 0; _i < 2; ++_i) \
        __builtin_amdgcn_global_load_lds((const unsigned*)((const char*)(gbase) + (voff)[_i]), (LAS unsigned*)(lds + (bufoff) + ldsw + _i * 8192), 16, 0, BAUX); } while (0)
#define PG8_LDA(dst, b, h) do { _Pragma("unroll") for (int m = 0; m < 4; ++m) _Pragma("unroll") for (int k = 0; k < 2; ++k) dst[m][k] = *(const LAS bf16x8*)(lds + PG8_SA(b, h) + aoff + m * 2048 + k * 1024); } while (0)
#define PG8_LDB(dst, b, h) do { _Pragma("unroll") for (int n = 0; n < 2; ++n) _Pragma("unroll") for (int k = 0; k < 2; ++k) dst[n][k] = *(const LAS bf16x8*)(lds + PG8_SB(b, h) + boff + n * 2048 + k * 1024); } while (0)
#define PG8_MMA(ai, bj, At, Bt) do { __builtin_amdgcn_s_setprio(1); _Pragma("unroll") for (int m = 0; m < 4; ++m) _Pragma("unroll") for (int n = 0; n < 2; ++n) _Pragma("unroll") for (int k = 0; k < 2; ++k) \
        acc[ai][bj][m][n] = __builtin_amdgcn_mfma_f32_16x16x32_bf16(Bt[n][k], At[m][k], acc[ai][bj][m][n], 0, 0, 0); __builtin_amdgcn_s_setprio(0); } while (0)
#define PG8_WAIT_V(n) asm volatile("s_waitcnt vmcnt(" #n ")" ::: "memory")
#define PG8_WAIT_L(n) asm volatile("s_waitcnt lgkmcnt(" #n ")" ::: "memory")
#define PG8_BAR __builtin_amdgcn_s_barrier()
#define PG8_SCHED __builtin_amdgcn_sched_barrier(0)
#define PG8_APTR(u) ((const char*)g.A + ((size_t)(u).g * g.gsA + (size_t)(u).pm * BM * g.lda) * 2)
#define PG8_BPTR(u) ((const char*)g.Bt + ((size_t)(u).g * g.gsB + (size_t)(u).pn * BM * g.ldb) * 2)
    Unit cur, nxt; int ui = 0;
    if (!S.next(0, cur)) return;
#ifdef TPROBE_GID
#define PG8_TS(k) do { if (g.tsid == TPROBE_GID && wid == 0 && lane == 0) *(LAS unsigned long long*)(lds + LDSCTL_OFF + 8 * (k)) = __builtin_amdgcn_s_memrealtime(); } while (0)
#else
#define PG8_TS(k) do {} while (0)
#endif
    PG8_TS(0);
    f32x4 acc[2][2][4][2];
#pragma unroll
    for (int a = 0; a < 2; ++a)
#pragma unroll
        for (int b = 0; b < 2; ++b)
#pragma unroll
            for (int m = 0; m < 4; ++m)
#pragma unroll
                for (int n = 0; n < 2; ++n) acc[a][b][m][n] = (f32x4){0.f, 0.f, 0.f, 0.f};
    bf16x8 At[4][2], B0[2][2], B1[2][2];
    const char* cA = PG8_APTR(cur); const char* cB = PG8_BPTR(cur);
    PG8_STAGEB(PG8_SB(0, 0), cB, voffB); PG8_STAGEB(PG8_SB(0, 1), cB + hstepB, voffB); PG8_STAGE(PG8_SA(0, 0), cA, voffA); PG8_STAGE(PG8_SA(0, 1), cA + hstepA, voffA);
    if (wr == 1) PG8_BAR;
    PG8_WAIT_V(2); PG8_BAR;
    PG8_STAGEB(PG8_SB(1, 0), cB + kstepB, voffB); PG8_STAGE(PG8_SA(1, 0), cA + kstepA, voffA); PG8_STAGEB(PG8_SB(1, 1), cB + hstepB + kstepB, voffB);
    PG8_WAIT_V(6); PG8_BAR;
    for (;;) {
        const bool has_next = S.next(ui + 1, nxt);
        const char* nA = has_next ? PG8_APTR(nxt) : cA; const char* nB = has_next ? PG8_BPTR(nxt) : cB;
        for (int t = 0; t < nt; t += 2) {
            const bool last = (t == nt - 2);
            const char* a1 = cA + (size_t)(t + 1) * kstepA;
            const char* a2 = last ? nA : cA + (size_t)(t + 2) * kstepA; const char* b2 = last ? nB : cB + (size_t)(t + 2) * kstepB;
            const char* a3 = a2 + kstepA; const char* b3 = b2 + kstepB;
            PG8_LDB(B0, 0, 0); PG8_LDB(B1, 0, 1); PG8_SCHED; PG8_LDA(At, 0, 0); PG8_STAGE(PG8_SA(1, 1), a1 + hstepA, voffA);
            PG8_WAIT_V(8); PG8_WAIT_L(0); PG8_BAR; PG8_MMA(0, 0, At, B0); PG8_MMA(0, 1, At, B1); PG8_BAR; PG8_SCHED;
            PG8_LDA(At, 0, 1); PG8_STAGEB(PG8_SB(0, 0), b2, voffB); PG8_STAGEB(PG8_SB(0, 1), b2 + hstepB, voffB); PG8_STAGE(PG8_SA(0, 0), a2, voffA);
            PG8_WAIT_V(8); PG8_WAIT_L(0); PG8_BAR; PG8_MMA(1, 0, At, B0); PG8_MMA(1, 1, At, B1); PG8_BAR; PG8_SCHED;
            PG8_LDB(B0, 1, 0); PG8_LDB(B1, 1, 1); PG8_SCHED; PG8_LDA(At, 1, 0); PG8_STAGE(PG8_SA(0, 1), a2 + hstepA, voffA);
            PG8_WAIT_V(8); PG8_WAIT_L(0); PG8_BAR; PG8_MMA(0, 0, At, B0); PG8_MMA(0, 1, At, B1); PG8_BAR; PG8_SCHED;
            PG8_LDA(At, 1, 1); PG8_STAGEB(PG8_SB(1, 0), b3, voffB); PG8_STAGEB(PG8_SB(1, 1), b3 + hstepB, voffB); PG8_STAGE(PG8_SA(1, 0), a3, voffA);
            PG8_WAIT_V(8); PG8_WAIT_L(0); PG8_BAR; PG8_MMA(1, 0, At, B0); PG8_MMA(1, 1, At, B1); PG8_BAR; PG8_SCHED;
        }
        if (wr == 0) PG8_BAR;
        PG8_TS(1 + 2 * ui);
        { unsigned z_ = 0u; asm volatile("" : "+v"(z_)); const int l2 = (int)__builtin_amdgcn_mbcnt_hi(~0u, __builtin_amdgcn_mbcnt_lo(~0u, z_));
          E(acc, cur, wr, wc, l2 & 15, l2 >> 4);
          E.done(cur, l2); }
        PG8_TS(2 + 2 * ui);
        if (!has_next) break;
#pragma unroll
        for (int a = 0; a < 2; ++a)
#pragma unroll
            for (int b = 0; b < 2; ++b)
#pragma unroll
                for (int m = 0; m < 4; ++m)
#pragma unroll
                    for (int n = 0; n < 2; ++n) acc[a][b][m][n] = (f32x4){0.f, 0.f, 0.f, 0.f};
        cur = nxt; cA = nA; cB = nB; ++ui;
        if (wr == 1) PG8_BAR;
    }
    PG8_WAIT_V(0);
    PG8_BAR;
    PG8_TS(7);
#undef PG8_SA
#undef PG8_SB
#undef PG8_STAGE
#undef PG8_STAGEB
#undef PG8_LDA
#undef PG8_LDB
#undef PG8_MMA
#undef PG8_WAIT_V
#undef PG8_WAIT_L
#undef PG8_BAR
#undef PG8_SCHED
#undef PG8_TS
#undef PG8_APTR
#undef PG8_BPTR
}
__device__ __forceinline__ int cond_of_pm(int pm) { return pm < 16 ? 0 : 1 + ((pm - 16) >> 2); }
__device__ __forceinline__ int kvrow_of(int row) { return row < MC ? row : MC + ((row - MC) >> 10) * (PAST + DSEQ) + PAST + ((row - MC) & 1023); }
__device__ __forceinline__ u32x4 pack8(const f32x4& a, const f32x4& b) { u32x4 w; w.x = cvt_pk_bf16(a[0], a[1]); w.y = cvt_pk_bf16(a[2], a[3]); w.z = cvt_pk_bf16(b[0], b[1]); w.w = cvt_pk_bf16(b[2], b[3]); return w; }

struct EpiIn {
    static constexpr bool PERM = true; static constexpr bool BLK2 = false;
    const float* sumsq; const float* bias; const float* qn; const float* kn; const LAS f32x2* rope;
    bf16_t* Q; bf16_t* KB; bf16_t* VB; __amdgpu_buffer_rsrc_t as3r; float* new_k; float* new_v; int l; unsigned* ucnt;
    __device__ __forceinline__ void done(const Unit& u, int lane) const {
        if (u.pn >= 6) { asm volatile("s_waitcnt vmcnt(0)" ::: "memory"); if (lane == 0) __hip_atomic_fetch_add(ucnt + (((u.pm >> 4) * 2) + (u.pn - 6)) * 64, 1u, RLX_AGENT); } }
    __device__ __forceinline__ void operator()(const f32x4 (&acc)[2][2][4][2], const Unit& u, int wr, int wc, int fr, int fq) const {
        const int pm = u.pm, pn = u.pn; const bool ctx = pm < 16; const int cond = cond_of_pm(pm);
        const float* bz = bias + cond * 2048 + pn * 256 + wc * 32 + 8 * fq;
        f32x4 bv[2][2];
#pragma unroll
        for (int bj = 0; bj < 2; ++bj)
#pragma unroll
            for (int n = 0; n < 2; ++n) bv[bj][n] = *(const f32x4*)(bz + bj * 128 + 4 * n);
        const int rbase = pm * BM + wr * 64 + fr;
        float rsd[8];
#pragma unroll
        for (int g8 = 0; g8 < 8; ++g8) rsd[g8] = sumsq[rbase + (g8 >> 2) * HALF + (g8 & 3) * 16];
#pragma unroll
        for (int g8 = 0; g8 < 8; ++g8) rsd[g8] = rsqrtf(rsd[g8] * (1.f / DM) + EPS);
        if (pn < 4) {
            const bool isq = pn < 2; const float* gv = isq ? qn : kn;
            const int G = (pn & 1) * 4 + wc;
            const int cb = 32 * (fq >> 1) + 8 * (fq & 1);
            f32x4 gg[2][2];
#pragma unroll
            for (int bj = 0; bj < 2; ++bj)
#pragma unroll
                for (int n = 0; n < 2; ++n) gg[bj][n] = *(const f32x4*)(gv + cb + 16 * bj + 4 * n);
            const float qs = isq ? C2 : 1.f;
#pragma unroll
            for (int ai = 0; ai < 2; ++ai)
#pragma unroll
                for (int m = 0; m < 4; ++m) {
                    const int row = rbase + ai * HALF + m * 16;
                    const float rstd = rsd[ai * 4 + m];
                    f32x4 v[2][2]; float ss = 0.f;
#pragma unroll
                    for (int bj = 0; bj < 2; ++bj)
#pragma unroll
                        for (int n = 0; n < 2; ++n) { v[bj][n] = acc[ai][bj][m][n] * rstd + bv[bj][n]; const f32x4 t = v[bj][n] * v[bj][n]; ss += (t[0] + t[1]) + (t[2] + t[3]); }
                    { const int ln_ = fq * 16 + fr; ss += shfl_xor_l(ss, 16, ln_); ss += shfl_xor_l(ss, 32, ln_); }
                    const float rn = rsqrtf(ss * (1.f / 64.f) + EPS);
#pragma unroll
                    for (int bj = 0; bj < 2; ++bj)
#pragma unroll
                        for (int n = 0; n < 2; ++n) v[bj][n] = v[bj][n] * rn * gg[bj][n];
                    if (ctx) {
                        if (!isq) { float* nk = new_k + ((size_t)((row >> 8) * DEPTH + l) * SEQ + (row & 255)) * 512 + G * 64 + cb;
#pragma unroll
                            for (int bj = 0; bj < 2; ++bj) { __builtin_nontemporal_store(v[bj][0], (f32x4*)(nk + 16 * bj)); __builtin_nontemporal_store(v[bj][1], (f32x4*)(nk + 16 * bj + 4)); } }
                    } else {
                        const int t = (row - MC) & 1023; const int pos = (fq >> 1) ? (t & 63) : (t >> 6);
                        const LAS f32x2* rp = rope + pos * 17 + 8 * (fq & 1);
#pragma unroll
                        for (int n = 0; n < 2; ++n)
#pragma unroll
                            for (int j = 0; j < 4; ++j) { const f32x2 cs = rp[4 * n + j]; const float x1 = v[0][n][j], x2 = v[1][n][j]; v[0][n][j] = x1 * cs.x - x2 * cs.y; v[1][n][j] = x1 * cs.y + x2 * cs.x; }
                    }
                    bf16_t* dst = isq ? (Q + (size_t)row * 512) : (KB + (size_t)kvrow_of(row) * 512);
                    dst += G * 64 + cb;
#pragma unroll
                    for (int bj = 0; bj < 2; ++bj) *(u32x4*)(dst + 16 * bj) = pack8(v[bj][0] * qs, v[bj][1] * qs);
                }
        } else if (pn < 6) {
            const int col0 = (pn - 4) * 256 + wc * 32 + 8 * fq;
#pragma unroll
            for (int ai = 0; ai < 2; ++ai)
#pragma unroll
                for (int m = 0; m < 4; ++m) {
                    const int row = rbase + ai * HALF + m * 16;
                    const float rstd = rsd[ai * 4 + m];
                    bf16_t* dst = VB + (size_t)kvrow_of(row) * 512 + col0;
#pragma unroll
                    for (int bj = 0; bj < 2; ++bj) { const f32x4 a = acc[ai][bj][m][0] * rstd + bv[bj][0], b = acc[ai][bj][m][1] * rstd + bv[bj][1];
                        *(u32x4*)(dst + 128 * bj) = pack8(a, b);
                        if (ctx) { float* nv = new_v + ((size_t)((row >> 8) * DEPTH + l) * SEQ + (row & 255)) * 512 + col0 + 128 * bj; __builtin_nontemporal_store(a, (f32x4*)nv); __builtin_nontemporal_store(b, (f32x4*)(nv + 4)); } }
                }
        } else {
            const int cu0 = (pn - 6) * 256 + wc * 32 + 8 * fq;
#pragma unroll
            for (int ai = 0; ai < 2; ++ai)
#pragma unroll
                for (int m = 0; m < 4; ++m) {
                    const int row = rbase + ai * HALF + m * 16;
                    const float rstd = rsd[ai * 4 + m];
#pragma unroll
                    for (int bj = 0; bj < 2; ++bj) { const int cu = cu0 + 128 * bj; const f32x4 a = acc[ai][bj][m][0] * rstd + bv[bj][0], b = acc[ai][bj][m][1] * rstd + bv[bj][1];
                        __builtin_amdgcn_raw_buffer_store_b128(pack8(a, b), as3r, (int)(((unsigned)((cu >> 4) * NCHUNK + (row >> 4)) * 512u + (row & 15) * 16 + (cu & 15)) * 2u), 0,   16); }
                }
        }
    }
};
struct EpiS1 {
    static constexpr bool PERM = false; static constexpr bool BLK2 = false;
    bf16_t* E;
    __device__ __forceinline__ void done(const Unit&, int) const {}
    __device__ __forceinline__ void operator()(const f32x4 (&acc)[2][2][4][2], const Unit& u, int wr, int wc, int fr, int fq) const {
        const int rbase = u.pm * BM + wr * 64 + fr, col0 = wc * 32 + 4 * fq;
#pragma unroll
        for (int ai = 0; ai < 2; ++ai)
#pragma unroll
            for (int m = 0; m < 4; ++m) { bf16_t* dst = E + ((size_t)u.g * NCHUNK + rbase + ai * HALF + m * 16) * 256 + col0;
#pragma unroll
                for (int bj = 0; bj < 2; ++bj)
#pragma unroll
                    for (int n = 0; n < 2; ++n) { const f32x4 a = acc[ai][bj][m][n]; u32x2 w; w.x = cvt_pk_bf16(a[0], a[1]); w.y = cvt_pk_bf16(a[2], a[3]); *(u32x2*)(dst + bj * HALF + n * 16) = w; } }
    }
};
struct EpiS3 {
    static constexpr bool PERM = true; static constexpr bool BLK2 = false;
    __amdgpu_buffer_rsrc_t zr;
    __device__ __forceinline__ void done(const Unit&, int) const {}
    __device__ __forceinline__ void operator()(const f32x4 (&acc)[2][2][4][2], const Unit& u, int wr, int wc, int fr, int fq) const {
        const int rbase = u.pm * BM + wr * 64 + fr;
#pragma unroll
        for (int ai = 0; ai < 2; ++ai)
#pragma unroll
            for (int m = 0; m < 4; ++m) { const int chunk = rbase + ai * HALF + m * 16;
#pragma unroll
                for (int bj = 0; bj < 2; ++bj) { const int tt = 8 * bj + 2 * wc + (fq >> 1), c0 = 8 * (fq & 1);
                    f32x4 a = acc[ai][bj][m][0], b = acc[ai][bj][m][1];
#pragma unroll
                    for (int j = 0; j < 4; ++j) { a[j] = gelu_tanh_f(a[j]); b[j] = gelu_tanh_f(b[j]); }
                    __builtin_amdgcn_raw_buffer_store_b128(pack8(a, b), zr, (int)(((((unsigned)chunk * 32u + u.g) * 16u + tt) * 16u + c0) * 2u), 0,   16); } }
    }
};
struct EpiGlu {
    static constexpr bool PERM = true; static constexpr bool BLK2 = false;
    const bf16_t* Z; const float* bg; bf16_t* CAT;
    __device__ __forceinline__ void done(const Unit&, int) const {}
    __device__ __forceinline__ void operator()(const f32x4 (&acc)[2][2][4][2], const Unit& u, int wr, int wc, int fr, int fq) const {
        const int rbase = u.pm * BM + wr * 64 + fr, col0 = u.pn * BM + wc * 32 + 8 * fq;
        f32x4 bv[2][2];
#pragma unroll
        for (int bj = 0; bj < 2; ++bj)
#pragma unroll
            for (int n = 0; n < 2; ++n) bv[bj][n] = *(const f32x4*)(bg + col0 + bj * HALF + 4 * n);
#pragma unroll
        for (int ai = 0; ai < 2; ++ai)
#pragma unroll
            for (int m = 0; m < 4; ++m) { const int row = rbase + ai * HALF + m * 16;
#pragma unroll
                for (int bj = 0; bj < 2; ++bj) { const int cz = col0 + bj * HALF; const u32x4 zw = *(const u32x4*)(Z + ((size_t)(row >> 4) * 32 + (cz >> 4)) * 256 + (row & 15) * 16 + (cz & 15));
                    f32x4 a = acc[ai][bj][m][0] + bv[bj][0], b = acc[ai][bj][m][1] + bv[bj][1];
                    a[0] = bflo(zw.x) * sigmoid_f(a[0]); a[1] = bfhi(zw.x) * sigmoid_f(a[1]); a[2] = bflo(zw.y) * sigmoid_f(a[2]); a[3] = bfhi(zw.y) * sigmoid_f(a[3]);
                    b[0] = bflo(zw.z) * sigmoid_f(b[0]); b[1] = bfhi(zw.z) * sigmoid_f(b[1]); b[2] = bflo(zw.w) * sigmoid_f(b[2]); b[3] = bfhi(zw.w) * sigmoid_f(b[3]);
                    *(u32x4*)(CAT + (size_t)row * 1024 + 512 + col0 + bj * HALF) = pack8(a, b); } }
    }
};
template <bool IN_F32, bool OUT_F32> struct EpiRes {
    static constexpr bool PERM = true; static constexpr bool BLK2 = true;
    const float* xin0; const float* xin1;
    const bf16_t* xrin;
    float* xout; bf16_t* xrout;
    const float* gate;
    const float* gn; const float* sc;
    bf16_t* XS; float* ssq;
    __device__ __forceinline__ void done(const Unit&, int) const {}
    __device__ __forceinline__ void operator()(const f32x4 (&acc)[2][2][4][2], const Unit& u, int wr, int wc, int fr, int fq) const {
        const int pm = u.pm, cond = cond_of_pm(pm); const int col0 = u.pn * BM + wc * 64 + 8 * fq; const int rbase = pm * BM + wr * 64 + fr;
        const bool donorm = (gn != nullptr);
        f32x4 gt[2][2], gs[2][2];
#pragma unroll
        for (int bj = 0; bj < 2; ++bj)
#pragma unroll
            for (int n = 0; n < 2; ++n) { const int c = col0 + bj * 32 + n * 4; gt[bj][n] = *(const f32x4*)(gate + cond * 6144 + c);
                if (donorm) { const f32x4 g4 = *(const f32x4*)(gn + c), s4 = *(const f32x4*)(sc + cond * 6144 + c); gs[bj][n] = g4 * (s4 + 1.f); } else gs[bj][n] = (f32x4){0.f, 0.f, 0.f, 0.f}; }
        constexpr int RD = IN_F32 ? 2 : 4;
        f32x4 xr[RD][2][2]; u32x4 xb[RD][2];
#define ER_LOAD(G_, SLOT_) do { const int row_ = rbase + ((G_) >> 2) * HALF + ((G_) & 3) * 16; \
            if (IN_F32) { const float* xi_ = (row_ < MC) ? (xin0 + (size_t)row_ * DM) : (xin1 + (size_t)(row_ - MC) * DM); \
                _Pragma("unroll") for (int bj = 0; bj < 2; ++bj) { xr[SLOT_][bj][0] = *(const f32x4*)(xi_ + col0 + bj * 32); xr[SLOT_][bj][1] = *(const f32x4*)(xi_ + col0 + bj * 32 + 4); } } \
            else { _Pragma("unroll") for (int bj = 0; bj < 2; ++bj) xb[SLOT_][bj] = *(const u32x4*)(xrin + (size_t)row_ * DM + col0 + bj * 32); } } while (0)
#pragma unroll
        for (int g0 = 0; g0 < RD; ++g0) ER_LOAD(g0, g0);
        float ssv[8];
#pragma unroll
        for (int g = 0; g < 8; ++g) { const int ai = g >> 2, m = g & 3, sl = g % RD; const int row = rbase + ai * HALF + m * 16;
            float ss = 0.f; f32x4 x0[2], x1[2];
#pragma unroll
            for (int bj = 0; bj < 2; ++bj) { f32x4 a, b;
                if (IN_F32) { a = xr[sl][bj][0]; b = xr[sl][bj][1]; } else { const u32x4 w = xb[sl][bj]; a = (f32x4){bflo(w.x), bfhi(w.x), bflo(w.y), bfhi(w.y)}; b = (f32x4){bflo(w.z), bfhi(w.z), bflo(w.w), bfhi(w.w)}; }
                x0[bj] = a + gt[bj][0] * acc[ai][bj][m][0]; x1[bj] = b + gt[bj][1] * acc[ai][bj][m][1]; }
            if (g + RD < 8) ER_LOAD(g + RD, sl);
#pragma unroll
            for (int bj = 0; bj < 2; ++bj) { const int c = col0 + bj * 32;
                if (OUT_F32) { __builtin_nontemporal_store(x0[bj], (f32x4*)(xout + (size_t)row * DM + c)); __builtin_nontemporal_store(x1[bj], (f32x4*)(xout + (size_t)row * DM + c + 4)); }
                else *(u32x4*)(xrout + (size_t)row * DM + c) = pack8(x0[bj], x1[bj]);
                if (donorm) { const f32x4 t0 = x0[bj] * x0[bj], t1 = x1[bj] * x1[bj]; ss += ((t0[0] + t0[1]) + (t0[2] + t0[3])) + ((t1[0] + t1[1]) + (t1[2] + t1[3]));
                    *(u32x4*)(XS + (size_t)row * DM + c) = pack8(x0[bj] * gs[bj][0], x1[bj] * gs[bj][1]); } }
            if (donorm) { { const int ln_ = fq * 16 + fr; ss += shfl_xor_l(ss, 16, ln_); ss += shfl_xor_l(ss, 32, ln_); } ssv[g] = ss; }
        }
        if (donorm && fq == 0) {
#pragma unroll
            for (int g = 0; g < 8; ++g) atomicAdd(ssq + rbase + (g >> 2) * HALF + (g & 3) * 16, ssv[g]); }
#undef ER_LOAD
    }
};
struct EpiUp {
    static constexpr bool PERM = true; static constexpr bool BLK2 = false;
    const float* sumsq; const float* bias; bf16_t* UP;
    __device__ __forceinline__ void done(const Unit&, int) const {}
    __device__ __forceinline__ void operator()(const f32x4 (&acc)[2][2][4][2], const Unit& u, int wr, int wc, int fr, int fq) const {
        const int pm = u.pm, cond = cond_of_pm(pm); const int col0 = u.pn * BM + wc * 32 + 8 * fq; const int rbase = pm * BM + wr * 64 + fr;
        f32x4 bv[2][2];
#pragma unroll
        for (int bj = 0; bj < 2; ++bj)
#pragma unroll
            for (int n = 0; n < 2; ++n) bv[bj][n] = *(const f32x4*)(bias + cond * 4096 + col0 + bj * HALF + 4 * n);
#pragma unroll
        for (int ai = 0; ai < 2; ++ai)
#pragma unroll
            for (int m = 0; m < 4; ++m) { const int row = rbase + ai * HALF + m * 16; const float rstd = rsqrtf(sumsq[row] * (1.f / DM) + EPS);
#pragma unroll
                for (int bj = 0; bj < 2; ++bj) *(u32x4*)(UP + (size_t)row * 4096 + col0 + bj * HALF) = pack8(acc[ai][bj][m][0] * rstd + bv[bj][0], acc[ai][bj][m][1] * rstd + bv[bj][1]); }
    }
};

__device__ __forceinline__ float dpp_shr1(float v) { return __uint_as_float((unsigned)__builtin_amdgcn_update_dpp(0, (int)__float_as_uint(v), 0x111, 0xf, 0xf, false)); }
__device__ __forceinline__ float dpp_shl1(float v) { return __uint_as_float((unsigned)__builtin_amdgcn_update_dpp(0, (int)__float_as_uint(v), 0x101, 0xf, 0xf, false)); }
struct EpiUpConv {
    static constexpr bool PERM = true; static constexpr bool BLK2 = false;
    const float* sumsq; const float* bias; const float* cw; const float* cb; bf16_t* G; bf16_t* HALO;
    __device__ __forceinline__ void done(const Unit&, int) const {}
    __device__ __forceinline__ void operator()(const f32x4 (&acc)[2][2][4][2], const Unit& u, int wr, int wc, int fr, int fq) const {
        const int pm = u.pm, pn = u.pn, cond = cond_of_pm(pm);
        const int posv = pn * 256 + wc * 32 + 8 * fq, av = pn * 128 + wc * 32 + 8 * fq;
        float rs[2][4];
#pragma unroll
        for (int ai = 0; ai < 2; ++ai)
#pragma unroll
            for (int m = 0; m < 4; ++m) rs[ai][m] = sumsq[pm * BM + ai * HALF + wr * 64 + 4 * fr + m];
#pragma unroll
        for (int ai = 0; ai < 2; ++ai)
#pragma unroll
            for (int m = 0; m < 4; ++m) rs[ai][m] = rsqrtf(rs[ai][m] * (1.f / DM) + EPS);
#pragma unroll
        for (int n = 0; n < 2; ++n) {
            const int c = av + 4 * n;
            const f32x4 bvv = *(const f32x4*)(bias + cond * 4096 + posv + 4 * n), bvg = *(const f32x4*)(bias + cond * 4096 + posv + 128 + 4 * n);
            const f32x4 w0v = *(const f32x4*)(cw + c), w1v = *(const f32x4*)(cw + 4096 + c), w2v = *(const f32x4*)(cw + 8192 + c), cbv = *(const f32x4*)(cb + c);
            const f32x4 w0g = *(const f32x4*)(cw + 2048 + c), w1g = *(const f32x4*)(cw + 4096 + 2048 + c), w2g = *(const f32x4*)(cw + 8192 + 2048 + c), cbg = *(const f32x4*)(cb + 2048 + c);
#pragma unroll
            for (int ai = 0; ai < 2; ++ai) {
                const int tok0 = pm * BM + ai * HALF + wr * 64 + 4 * fr; const int sl = pm * 4 + ai * 2 + wr;
                f32x4 pv[4], pg[4];
#pragma unroll
                for (int m = 0; m < 4; ++m) { pv[m] = acc[ai][0][m][n] * rs[ai][m] + bvv; pg[m] = acc[ai][1][m][n] * rs[ai][m] + bvg; }
                f32x4 pvp, pvn, pgp, pgn;
#pragma unroll
                for (int j = 0; j < 4; ++j) { pvp[j] = dpp_shr1(pv[3][j]); pvn[j] = dpp_shl1(pv[0][j]); pgp[j] = dpp_shr1(pg[3][j]); pgn[j] = dpp_shl1(pg[0][j]); }
#pragma unroll
                for (int m = 0; m < 4; ++m) {
                    const f32x4 zv = cbv + w0v * (m == 0 ? pvp : pv[m == 0 ? 0 : m - 1]) + w1v * pv[m] + w2v * (m == 3 ? pvn : pv[m == 3 ? 3 : m + 1]);
                    const f32x4 zg = cbg + w0g * (m == 0 ? pgp : pg[m == 0 ? 0 : m - 1]) + w1g * pg[m] + w2g * (m == 3 ? pgn : pg[m == 3 ? 3 : m + 1]);
                    u32x2 w; w.x = cvt_pk_bf16(silu_f(zg[0]) * zv[0], silu_f(zg[1]) * zv[1]); w.y = cvt_pk_bf16(silu_f(zg[2]) * zv[2], silu_f(zg[3]) * zv[3]);
                    *(u32x2*)(G + (size_t)(tok0 + m) * 2048 + c) = w; }
                if (fr == 0 || fr == 15) { const int m0 = fr == 0 ? 0 : 2;
#pragma unroll
                    for (int mm = 0; mm < 2; ++mm) { const f32x4 a = fr == 0 ? pv[mm] : pv[2 + mm], b = fr == 0 ? pg[mm] : pg[2 + mm];
                        bf16_t* hp = HALO + ((size_t)sl * 4 + m0 + mm) * 4096 + posv + 4 * n;
                        u32x2 wa; wa.x = cvt_pk_bf16(a[0], a[1]); wa.y = cvt_pk_bf16(a[2], a[3]); *(u32x2*)hp = wa;
                        u32x2 wb; wb.x = cvt_pk_bf16(b[0], b[1]); wb.y = cvt_pk_bf16(b[2], b[3]); *(u32x2*)(hp + 128) = wb; } }
            }
        }
    }
};
constexpr int AT_SLOT = 32768, AT_NSLOT = 4, AT_VOFF = 16384, AT_X = 0, AT_ST = 65536;
__device__ __forceinline__ void glds16(const void* gsrc, unsigned lds_dst) { unsigned keep;
    asm volatile("s_mov_b32 %0, m0\n\ts_mov_b32 m0, %2\n\ts_nop 0\n\tglobal_load_lds_dwordx4 %1, off\n\ts_mov_b32 m0, %0" : "=&s"(keep) : "v"(gsrc), "s"(lds_dst) : "memory"); }
#define AT_WAIT_BAR(N) asm volatile("s_waitcnt vmcnt(" #N ") lgkmcnt(0)\n\ts_barrier" ::: "memory")
#define AT_SB() __builtin_amdgcn_sched_barrier(0)
__device__ __forceinline__ s16x4 vtr(const LAS char* p) { typedef short v4i16_t __attribute__((ext_vector_type(4))); return __builtin_bit_cast(s16x4, __builtin_amdgcn_ds_read_tr16_b64_v4i16((LAS v4i16_t*)p)); }
__device__ __forceinline__ int crow(int r, int hi) { return (r & 3) + 8 * (r >> 2) + 4 * hi; }

struct AttnArgs { const bf16_t* Q; const bf16_t* KB; const bf16_t* VB; bf16_t* CAT; const float* subln; float lam; float oml; };

__device__ __forceinline__ void attn_unit(LAS unsigned char* lds, const int tid, const AttnArgs& A, int seq, int h, int qblk) {
    const int lane = tid & 63, r32 = lane & 31, hi = lane >> 5; const int wid = __builtin_amdgcn_readfirstlane(tid >> 6);
    const int rg = wid & 3, s = wid >> 2;
    const bool ctx = seq < NB;
    const int qrow0 = ctx ? seq * SEQ + qblk * 128 : MC + (seq - NB) * DSEQ + qblk * 128;
    const int krow0 = ctx ? seq * SEQ : MC + (seq - NB) * (PAST + DSEQ);
    const int NT = ctx ? SEQ / 64 : (PAST + DSEQ) / 64;
    const unsigned lds0 = (unsigned)(uintptr_t)lds;
    const int krow_l = 8 * wid + (lane >> 4), kch0 = (lane & 15) ^ (krow_l & 15);
    const bf16_t* ksrc0 = A.KB + (size_t)(krow0 + krow_l) * 512 + h * 128 + kch0 * 8;
    const int kd1 = 4 * 512 + ((kch0 & 4) ? -32 : 32);
    const bf16_t* vsrc0 = A.VB + (size_t)(krow0 + 16 * (wid & 3) + (lane >> 2)) * 512 + h * 128 + (wid >> 2) * 32 + (lane & 3) * 8;
    const unsigned kdst = lds0 + wid * 2048, vdst = lds0 + AT_VOFF + ((wid >> 2) * 4 + (wid & 3)) * 1024;
#define AT_DMA(t, slot) do { const size_t _o = (size_t)(t) * 64 * 512; const unsigned _s = (unsigned)(slot) * AT_SLOT; \
        glds16(ksrc0 + _o, (unsigned)__builtin_amdgcn_readfirstlane(kdst + _s)); glds16(ksrc0 + _o + kd1, (unsigned)__builtin_amdgcn_readfirstlane(kdst + _s + 1024)); \
        glds16(vsrc0 + _o, (unsigned)__builtin_amdgcn_readfirstlane(vdst + _s)); glds16(vsrc0 + _o + 64, (unsigned)__builtin_amdgcn_readfirstlane(vdst + _s + 8 * 1024)); } while (0)
    AT_DMA(0, 0); AT_DMA(1, 1); AT_DMA(2, 2);
    bf16x8 qr[4];
    { const bf16_t* qp = A.Q + (size_t)(qrow0 + rg * 32 + r32) * 512 + h * 128 + s * 64 + hi * 8;
#pragma unroll
      for (int d0 = 0; d0 < 4; ++d0) qr[d0] = *(const bf16x8*)(qp + d0 * 16); }
    f32x16 o[4];
#pragma unroll
    for (int d0 = 0; d0 < 4; ++d0)
#pragma unroll
        for (int r = 0; r < 16; ++r) o[d0][r] = 0.f;
    float lsum = 0.f;
    const unsigned kb0 = (unsigned)(r32 * 256 + (((s * 8 + hi) ^ (r32 & 15)) << 4));
    const LAS char* kfrag0 = (const LAS char*)lds;
    const LAS char* vfrag0 = (const LAS char*)lds + AT_VOFF + ((lane >> 4) & 1) * 32 + (lane & 3) * 8 + (4 * hi + ((lane & 15) >> 2)) * 64;
    f32x16 pc0, pc1;
#define AT_KLOAD(kfr, slot) do { const LAS char* _k = kfrag0 + (slot) * AT_SLOT; _Pragma("unroll") for (int d0 = 0; d0 < 4; ++d0) { kfr[2 * d0] = *(const LAS bf16x8*)(_k + (kb0 ^ (unsigned)(d0 << 5))); kfr[2 * d0 + 1] = *(const LAS bf16x8*)(_k + (kb0 ^ (unsigned)(d0 << 5)) + 8192); } } while (0)
#define AT_VLOAD(vv, slot, ks) do { const LAS char* _v = vfrag0 + (slot) * AT_SLOT + (ks) * 1024; _Pragma("unroll") for (int d0 = 0; d0 < 4; ++d0) { const s16x4 lo = vtr(_v + d0 * 4096), hh = vtr(_v + d0 * 4096 + 512); \
        vv[d0] = (bf16x8){lo[0], lo[1], lo[2], lo[3], hh[0], hh[1], hh[2], hh[3]}; } } while (0)
#define AT_EXP2(P, i, W) do { P[2 * (i)] = fast_exp2(P[2 * (i)]); P[2 * (i) + 1] = fast_exp2(P[2 * (i) + 1]); sacc += P[2 * (i)] + P[2 * (i) + 1]; W = cvt_pk_bf16(P[2 * (i)], P[2 * (i) + 1]); } while (0)
    AT_WAIT_BAR(8);
    { bf16x8 kfr[8]; AT_KLOAD(kfr, 0);
#pragma unroll
      for (int r = 0; r < 16; ++r) { pc0[r] = 0.f; pc1[r] = 0.f; }
#pragma unroll
      for (int d0 = 0; d0 < 4; ++d0) { pc0 = __builtin_amdgcn_mfma_f32_32x32x16_bf16(kfr[2 * d0], qr[d0], pc0, 0, 0, 0); pc1 = __builtin_amdgcn_mfma_f32_32x32x16_bf16(kfr[2 * d0 + 1], qr[d0], pc1, 0, 0, 0); } }
    int slot = 0;
    for (int t = 0; t < NT; ++t) {
        const bool has_next = t + 1 < NT;
        if (t + 2 < NT) AT_WAIT_BAR(4); else AT_WAIT_BAR(0);
        if (t + 3 < NT) AT_DMA(t + 3, (slot + 3) & 3);
        const int slot_n = (slot + 1) & 3;
        bf16x8 kfr[8], va[4], vb[4]; u32x4 pw[4]; f32x16 pn0, pn1; float sacc = 0.f;
        const LAS char* kn_ = kfrag0 + slot_n * AT_SLOT;
#define AT_K1(d0) do { kfr[2 * (d0)] = *(const LAS bf16x8*)(kn_ + (kb0 ^ (unsigned)((d0) << 5))); kfr[2 * (d0) + 1] = *(const LAS bf16x8*)(kn_ + (kb0 ^ (unsigned)((d0) << 5)) + 8192); } while (0)
        if (has_next) { AT_K1(0); AT_K1(1); }
        AT_SB();
        if (has_next) {
#pragma unroll
            for (int r = 0; r < 16; ++r) { pn0[r] = 0.f; pn1[r] = 0.f; }
#pragma unroll
            for (int i = 0; i < 8; ++i) { const int d0 = i >> 1;
                if (i & 1) pn1 = __builtin_amdgcn_mfma_f32_32x32x16_bf16(kfr[2 * d0 + 1], qr[d0], pn1, 0, 0, 0); else pn0 = __builtin_amdgcn_mfma_f32_32x32x16_bf16(kfr[2 * d0], qr[d0], pn0, 0, 0, 0);
                AT_EXP2(pc0, i, pw[i >> 2][i & 3]);
                if (i == 0) AT_K1(2);
                if (i == 1) AT_K1(3);
                if (i == 3) AT_VLOAD(va, slot, 0);
                if (i == 5) AT_VLOAD(vb, slot, 1);
                AT_SB(); }
        } else {
            AT_VLOAD(va, slot, 0); AT_VLOAD(vb, slot, 1);
#pragma unroll
            for (int i = 0; i < 8; ++i) AT_EXP2(pc0, i, pw[i >> 2][i & 3]);
            AT_SB();
        }
        bf16x8 vc[4], vd[4];
#pragma unroll
        for (int i = 0; i < 8; ++i) { const int d0 = i & 3;
            if (i < 4) o[d0] = __builtin_amdgcn_mfma_f32_32x32x16_bf16(va[d0], __builtin_bit_cast(bf16x8, pw[0]), o[d0], 0, 0, 0);
            else       o[d0] = __builtin_amdgcn_mfma_f32_32x32x16_bf16(vb[d0], __builtin_bit_cast(bf16x8, pw[1]), o[d0], 0, 0, 0);
            AT_EXP2(pc1, i, pw[2 + (i >> 2)][i & 3]);
            if (i == 1) AT_VLOAD(vc, slot, 2);
            if (i == 5) AT_VLOAD(vd, slot, 3);
            AT_SB(); }
#pragma unroll
        for (int d0 = 0; d0 < 4; ++d0) o[d0] = __builtin_amdgcn_mfma_f32_32x32x16_bf16(vc[d0], __builtin_bit_cast(bf16x8, pw[2]), o[d0], 0, 0, 0);
#pragma unroll
        for (int d0 = 0; d0 < 4; ++d0) o[d0] = __builtin_amdgcn_mfma_f32_32x32x16_bf16(vd[d0], __builtin_bit_cast(bf16x8, pw[3]), o[d0], 0, 0, 0);
        lsum += sacc;
        if (has_next) { pc0 = pn0; pc1 = pn1; }
        slot = slot_n;
    }
    lsum += shfl_xor_l(lsum, 32, lane);
    const float inv = (s == 0 ? 1.f : A.lam) / lsum;
    AT_WAIT_BAR(0);
    LAS float* X = (LAS float*)(lds + AT_X) + rg * 4096;
    if (s == 1) {
#pragma unroll
        for (int d0 = 0; d0 < 4; ++d0)
#pragma unroll
            for (int r = 0; r < 16; ++r) X[(d0 * 16 + r) * 64 + lane] = o[d0][r] * inv;
    }
    AT_WAIT_BAR(0);
    if (s == 0) {
        float ss = 0.f;
#pragma unroll
        for (int d0 = 0; d0 < 4; ++d0)
#pragma unroll
            for (int r = 0; r < 16; ++r) { const float v = o[d0][r] * inv - X[(d0 * 16 + r) * 64 + lane]; o[d0][r] = v; ss += v * v; }
        ss += shfl_xor_l(ss, 32, lane);
        const float rn = rsqrtf(ss * (1.f / 128.f) + EPS) * A.oml;
        LAS bf16_t* stg = (LAS bf16_t*)(lds + AT_ST) + rg * (32 * 136);
#pragma unroll
        for (int d0 = 0; d0 < 4; ++d0)
#pragma unroll
            for (int rq = 0; rq < 4; ++rq) { const int dv = 32 * d0 + 8 * rq + 4 * hi; const f32x4 g4 = *(const f32x4*)(A.subln + dv);
                u32x2 w; w.x = cvt_pk_bf16(o[d0][4 * rq] * rn * g4[0], o[d0][4 * rq + 1] * rn * g4[1]); w.y = cvt_pk_bf16(o[d0][4 * rq + 2] * rn * g4[2], o[d0][4 * rq + 3] * rn * g4[3]);
                *(LAS u32x2*)(stg + r32 * 136 + dv) = w; }
        asm volatile("s_waitcnt lgkmcnt(0)" ::: "memory");
        bf16_t* dst = A.CAT + (size_t)(qrow0 + rg * 32) * 1024 + h * 128;
#pragma unroll
        for (int i = 0; i < 8; ++i) { const int row = i * 4 + (lane >> 4), ch = lane & 15; const u32x4 v = *(const LAS u32x4*)(stg + row * 136 + ch * 8); *(u32x4*)(dst + (size_t)row * 1024 + ch * 8) = v; }
    }
    AT_WAIT_BAR(0);
#undef AT_DMA
#undef AT_KLOAD
#undef AT_K1
#undef AT_VLOAD
#undef AT_EXP2
}
struct Args { const float* in[34]; float* out; unsigned char* ws; int stop_after; int pad; };
struct ArgsG { GAS const float* in[34]; GAS float* out; GAS unsigned char* ws; int stop_after; int pad; };
typedef const __attribute__((address_space(4))) ArgsG* kargs_t;
struct Frame {
    LAS unsigned char* lds; int tid, lane, wave, vcu, bid, G;
    kargs_t ka; float* out; unsigned char* ws;
    float* misc; unsigned* ctl;
};
#define LDS_WAIT() asm volatile("s_waitcnt lgkmcnt(0)" ::: "memory")
#define VM_WAIT() asm volatile("s_waitcnt vmcnt(0)" ::: "memory")

template <int MAP> __device__ __forceinline__ int src_col(int p);
template <int MODE, int MAP, int NC> __device__ __forceinline__ void gemv9_task(Frame& F, const float* W, int ldw, int l, int voff, int strip, float* out, int ldo, const float* add) {
    LAS float* sc = (LAS float*)F.lds; LAS float* red = sc + 9 * 1024;
    for (int i = F.tid; i < 9 * 1024; i += NTHREADS) { const int cond = i >> 10, k = i & 1023; float v;
        if (MODE == 0) { v = cond == 0 ? ((const float*)F.ka->in[6])[k] : ((const float*)F.ka->in[5])[(cond - 1) * 1024 + k]; v = v / (1.f + expf(-v)); } else v = F.misc[MI_MOD + (l * 9 + cond) * 6144 + voff + k];
        sc[i] = v; }
    __syncthreads();
    const int j = strip * NC + (F.lane < NC ? F.lane : NC - 1); const float* w = W + (size_t)(F.wave * 128) * ldw + src_col<MAP>(j);
    float acc[9];
#pragma unroll
    for (int b = 0; b < 9; ++b) acc[b] = 0.f;
#pragma unroll 16
    for (int k = 0; k < 128; ++k) { const float wv = w[(size_t)k * ldw];
#pragma unroll
        for (int b = 0; b < 9; ++b) acc[b] += sc[b * 1024 + F.wave * 128 + k] * wv; }
#pragma unroll
    for (int b = 0; b < 9; ++b) red[(F.wave * 9 + b) * 64 + F.lane] = acc[b];
    __syncthreads();
    for (int i = F.tid; i < 9 * 64; i += NTHREADS) { const int b = i >> 6, ln = i & 63; if (ln >= NC) continue; float s_ = 0.f;
#pragma unroll
        for (int w8 = 0; w8 < 8; ++w8) s_ += red[(w8 * 9 + b) * 64 + ln];
        const int jj = strip * NC + ln; out[(size_t)b * ldo + jj] = s_ + (add ? add[jj] : 0.f); }
    __syncthreads();
}
template <int MAP> __device__ __forceinline__ int src_col(int p) {
    if (MAP == 1) { if (p >= 1024) return p; const int pn = p >> 8, r = p & 255, bj = r >> 7, wc = (r >> 5) & 3, fq = (r >> 3) & 3, low = r & 7; return 256 * pn + 64 * wc + 32 * (fq >> 1) + 16 * bj + 8 * (fq & 1) + low; }
    if (MAP == 2) { const int pn = p >> 8, bj = (p >> 7) & 1, r = p & 127; return bj * 2048 + 128 * pn + r; }
    return p;
}
__device__ __forceinline__ void mod_task3(Frame& F, int task) {
    const int l = task / 96, r = task % 96, kq = r / 24, cg = r % 24;
    LAS float* sc = (LAS float*)F.lds; LAS float* red = sc + 9 * 256;
    for (int i = F.tid; i < 9 * 256; i += NTHREADS) { const int cond = i >> 8, k = kq * 256 + (i & 255); const float v = cond == 0 ? ((const float*)F.ka->in[6])[k] : ((const float*)F.ka->in[5])[(cond - 1) * 1024 + k]; sc[i] = v / (1.f + expf(-v)); }
    __syncthreads();
    const float* w = ((const float*)F.ka->in[7]) + ((size_t)l * DM + kq * 256 + F.wave * 32) * 6144 + cg * 256 + F.lane * 4;
    f32x4 acc[9];
#pragma unroll
    for (int b = 0; b < 9; ++b) acc[b] = (f32x4){0.f, 0.f, 0.f, 0.f};
#pragma unroll
    for (int h = 0; h < 2; ++h) { f32x4 wv[16];
#pragma unroll
        for (int k = 0; k < 16; ++k) wv[k] = __builtin_nontemporal_load((const f32x4*)(w + (size_t)(h * 16 + k) * 6144));
#pragma unroll
        for (int k = 0; k < 16; ++k)
#pragma unroll
            for (int b = 0; b < 9; ++b) acc[b] += wv[k] * sc[b * 256 + F.wave * 32 + h * 16 + k]; }
#pragma unroll
    for (int b = 0; b < 9; ++b) *(LAS f32x4*)(red + (F.wave * 9 + b) * 256 + F.lane * 4) = acc[b];
    __syncthreads();
    for (int i = F.tid; i < 9 * 256; i += NTHREADS) { const int b = i >> 8, c = i & 255; float v = 0.f;
#pragma unroll
        for (int w8 = 0; w8 < 8; ++w8) v += red[(w8 * 9 + b) * 256 + c];
        const int col = cg * 256 + c; if (kq == 0) v += ((const float*)F.ka->in[8])[l * 6144 + col];
        atomicAdd(F.misc + MI_MOD + (l * 9 + b) * 6144 + col, v); }
    __syncthreads();
}
template <int MAP, bool BIAS> __device__ __forceinline__ void transpose_item(Frame& F, const float* W, int K, int N, bf16_t* WT, LAS float* scr, int item, const float* shv, float* bias) {
    const int lane = F.lane; const int nblk = N / 64, kb = item / nblk, nb = item % nblk, k0 = 64 * kb, n0 = 64 * nb;
    const int sc_ = src_col<MAP>(n0 + lane);
    float tv[64];
#pragma unroll
    for (int i = 0; i < 64; ++i) tv[i] = __builtin_nontemporal_load(W + (size_t)(k0 + i) * N + sc_);
#pragma unroll
    for (int i = 0; i < 64; ++i) scr[i * 65 + lane] = tv[i];
    LDS_WAIT(); asm volatile("" ::: "memory");
    const int c = lane & 7;
#pragma unroll
    for (int j = 0; j < 8; ++j) { const int n = (lane >> 3) + 8 * j; const LAS float* s_ = scr + (8 * c) * 65 + n;
        u32x4 o; o.x = cvt_pk_bf16(s_[0 * 65], s_[1 * 65]); o.y = cvt_pk_bf16(s_[2 * 65], s_[3 * 65]); o.z = cvt_pk_bf16(s_[4 * 65], s_[5 * 65]); o.w = cvt_pk_bf16(s_[6 * 65], s_[7 * 65]);
        *(u32x4*)(WT + (size_t)(n0 + n) * K + k0 + 8 * c) = o; }
    if (BIAS) {
        float sh[9], acc[9];
#pragma unroll
        for (int b = 0; b < 9; ++b) { sh[b] = shv[b * 6144 + k0 + lane]; acc[b] = 0.f; }
#pragma unroll
        for (int kk = 0; kk < 64; ++kk) { const float w = tv[kk];
#pragma unroll
            for (int b = 0; b < 9; ++b) acc[b] += __uint_as_float(__builtin_amdgcn_readlane(__float_as_uint(sh[b]), kk)) * w; }
#pragma unroll
        for (int b = 0; b < 9; ++b) atomicAdd(bias + (size_t)b * N + n0 + lane, acc[b]);
    }
    LDS_WAIT(); asm volatile("" ::: "memory");
}
__device__ __forceinline__ void cache_item(Frame& F, int l, int item4) {
    f32x4 a[4], c[4];
#pragma unroll
    for (int i = 0; i < 4; ++i) { const int item = item4 * 4 + i, which = item >> 12, r = item & 4095, b = r >> 9, j = r & 511;
        const float* src = (which ? ((const float*)F.ka->in[3]) : ((const float*)F.ka->in[2])) + ((size_t)(b * DEPTH + l) * PAST + j) * 512 + F.lane * 8; a[i] = __builtin_nontemporal_load((const f32x4*)src); c[i] = __builtin_nontemporal_load((const f32x4*)(src + 4)); }
#pragma unroll
    for (int i = 0; i < 4; ++i) { const int item = item4 * 4 + i, which = item >> 12, r = item & 4095, b = r >> 9, j = r & 511;
        bf16_t* dst = (bf16_t*)(F.ws + (which ? WS_VB : WS_KB)) + (size_t)(MC + b * (PAST + DSEQ) + j) * 512 + F.lane * 8; *(u32x4*)dst = pack8(a[i], c[i]); }
}
__device__ __forceinline__ f32x2 cmul(f32x2 a, f32x2 b) { return (f32x2){a.x * b.x - a.y * b.y, a.x * b.y + a.y * b.x}; }
__device__ __forceinline__ void ssm_prep(Frame& F, int l, int task) {
    const int g = task >> 1, half = task & 1;
    LAS f32x2* POW = (LAS f32x2*)F.lds;
    LAS f32x2* BB = POW + 2 * 17 * 64;
    LAS f32x2* CC = BB + 2 * 64 * 16;
    LAS f32x2* CT = CC + 2 * 16 * 64;
    LAS float* KT = (LAS float*)(CT + 2 * 64 * 16);
    constexpr int KTS = 260;
    bf16_t* WE = (bf16_t*)(F.ws + WS_SSM + SSM_WE) + (size_t)g * 256 * 256;
    bf16_t* WY = (bf16_t*)(F.ws + WS_SSM + SSM_WY) + (size_t)g * 256 * 512;
    f32x2* LAM16 = (f32x2*)(F.ws + WS_SSM + SSM_LAM16); f32x2* BBAR = (f32x2*)(F.ws + WS_SSM + SSM_BBAR);
    const int tid = F.tid, lane = F.lane;
    if (tid < 128) { const int dir = tid >> 6, p = tid & 63; const size_t pi = ((size_t)(l * 2 + dir) * NG + g) * 64 + p;
        const float lr = ((const float*)F.ka->in[18])[pi], li = ((const float*)F.ka->in[19])[pi], delta = expf(((const float*)F.ka->in[20])[(l * 2 + dir) * NG + g]);
        const float er = expf(lr * delta), lbr = er * cosf(li * delta), lbi = er * sinf(li * delta);
        { float one_ = 1.f, zero_ = 0.f; asm volatile("" : "+v"(one_), "+v"(zero_));
          f32x2 pw = (f32x2){one_, zero_}; const f32x2 lb = (f32x2){lbr, lbi};
          for (int tau = 0; tau <= 16; ++tau) { POW[(dir * 17 + tau) * 64 + p] = pw; if (tau == 16 && half == 0) LAM16[(dir * NG + g) * 64 + p] = pw; pw = cmul(pw, lb); } }
        const float nr = lbr - 1.f, ni = lbi, den = lr * lr + li * li; const f32x2 fac = (f32x2){(nr * lr + ni * li) / den, (ni * lr - nr * li) / den};
        f32x4 br[4], bi4[4];
#pragma unroll
        for (int q = 0; q < 4; ++q) { br[q] = *(const f32x4*)(((const float*)F.ka->in[21]) + pi * 16 + 4 * q); bi4[q] = *(const f32x4*)(((const float*)F.ka->in[22]) + pi * 16 + 4 * q); }
#pragma unroll
        for (int ch = 0; ch < 16; ++ch) { const f32x2 bb = cmul(fac, (f32x2){br[ch >> 2][ch & 3], bi4[ch >> 2][ch & 3]}); BB[(dir * 64 + p) * 16 + ch] = bb; if (half == 0) BBAR[((size_t)(dir * NG + g) * 64 + p) * 16 + ch] = bb; }
    }
    { f32x2 cv[4];
#pragma unroll
      for (int q = 0; q < 4; ++q) { const int i = tid + q * NTHREADS, dir = i >> 10, c = (i >> 6) & 15, p = i & 63; const size_t ci = (((size_t)(l * 2 + dir) * NG + g) * 16 + c) * 64 + p; cv[q] = (f32x2){((const float*)F.ka->in[23])[ci], ((const float*)F.ka->in[24])[ci]}; }
#pragma unroll
      for (int q = 0; q < 4; ++q) { const int i = tid + q * NTHREADS, dir = i >> 10, c = (i >> 6) & 15, p = i & 63; CC[i] = cv[q]; CT[(dir * 64 + p) * 16 + c] = cv[q]; } }
    __syncthreads();
    { const int i16 = lane & 15, k4 = lane >> 4, ri = k4 & 1, ph = k4 >> 1;
      for (int blk = 0; blk < 4; ++blk) { const int q = F.wave * 4 + blk, dir = q >> 4, tau = q & 15; f32x4 acc = (f32x4){0.f, 0.f, 0.f, 0.f};
#pragma unroll 8
          for (int ks = 0; ks < 32; ++ks) { const int p = 2 * ks + ph;
              const f32x2 cc = CT[(dir * 64 + p) * 16 + i16], pw = POW[(dir * 17 + tau) * 64 + p], bb = BB[(dir * 64 + p) * 16 + i16];
              const float u = ri ? -pw.y : pw.x, v = ri ? pw.x : pw.y;
              const float av = cc.x * u - cc.y * v, bv = ri ? bb.y : bb.x;
              acc = __builtin_amdgcn_mfma_f32_16x16x4f32(av, bv, acc, 0, 0, 0); }
#pragma unroll
          for (int r = 0; r < 4; ++r) KT[(dir * 16 + tau) * KTS + (k4 * 4 + r) * 16 + i16] = acc[r]; } }
    __syncthreads();
    const float* Dv = ((const float*)F.ka->in[25]) + l * 512 + g * 16;
    for (int idx = half * 8192 + tid; idx < (half + 1) * 8192; idx += NTHREADS) { const int n = idx >> 6, kc = idx & 63, k0 = kc * 8, i = n >> 4, c = n & 15; f32x4 v0, v1;
        if (k0 < 256) { const int s_ = k0 >> 4, ch0 = k0 & 15; v0 = (f32x4){0.f, 0.f, 0.f, 0.f}; v1 = v0;
            if (s_ <= i) { const LAS float* kp = KT + (i - s_) * KTS + c * 16 + ch0; v0 += *(const LAS f32x4*)kp; v1 += *(const LAS f32x4*)(kp + 4); }
            if (s_ >= i) { const LAS float* kp = KT + (16 + s_ - i) * KTS + c * 16 + ch0; v0 += *(const LAS f32x4*)kp; v1 += *(const LAS f32x4*)(kp + 4); }
            if (s_ == i) { const int e = c - ch0; const float dv = Dv[c]; if (e >= 0 && e < 4) v0[e] += dv; else if (e >= 4 && e < 8) v1[e - 4] += dv; }
        } else { const int dir = k0 >= 384 ? 1 : 0, p0 = ((k0 - 256) & 127) >> 1, tau = dir ? 16 - i : i + 1;
            const LAS f32x4* cp = (const LAS f32x4*)(CC + (dir * 16 + c) * 64 + p0); const LAS f32x4* pp = (const LAS f32x4*)(POW + (dir * 17 + tau) * 64 + p0);
            const f32x4 c0 = cp[0], c1 = cp[1], w0 = pp[0], w1 = pp[1];
            v0 = (f32x4){c0[0] * w0[0] - c0[1] * w0[1], -(c0[0] * w0[1] + c0[1] * w0[0]), c0[2] * w0[2] - c0[3] * w0[3], -(c0[2] * w0[3] + c0[3] * w0[2])};
            v1 = (f32x4){c1[0] * w1[0] - c1[1] * w1[1], -(c1[0] * w1[1] + c1[1] * w1[0]), c1[2] * w1[2] - c1[3] * w1[3], -(c1[2] * w1[3] + c1[3] * w1[2])}; }
        *(u32x4*)(WY + (size_t)n * 512 + k0) = pack8(v0, v1); }
    for (int idx = half * 4096 + tid; idx < (half + 1) * 4096; idx += NTHREADS) { const int n = idx >> 5, k0 = (idx & 31) * 8, dir = n >> 7, p = (n & 127) >> 1, ri = n & 1, s_ = k0 >> 4, ch0 = k0 & 15;
        const f32x2 pw = POW[(dir * 17 + (dir ? s_ : 15 - s_)) * 64 + p]; const LAS f32x4* bp = (const LAS f32x4*)(BB + (dir * 64 + p) * 16 + ch0);
        const float u = ri ? pw.y : pw.x, v = ri ? pw.x : -pw.y;
        const f32x4 b0 = bp[0], b1 = bp[1], b2 = bp[2], b3 = bp[3];
        const f32x4 v0 = (f32x4){u * b0[0] + v * b0[1], u * b0[2] + v * b0[3], u * b1[0] + v * b1[1], u * b1[2] + v * b1[3]};
        const f32x4 v1 = (f32x4){u * b2[0] + v * b2[1], u * b2[2] + v * b2[3], u * b3[0] + v * b3[1], u * b3[2] + v * b3[3]};
        *(u32x4*)(WE + (size_t)n * 256 + k0) = pack8(v0, v1); }
    __syncthreads();
}
template <int NR> __device__ __forceinline__ void xprep_item(Frame& F, int itemn) {
    f32x4 xv[NR][4];
#pragma unroll
    for (int i = 0; i < NR; ++i) { const int row = itemn * NR + i; const float* xr = (row < MC) ? ((const float*)F.ka->in[0]) + (size_t)row * DM : ((const float*)F.ka->in[1]) + (size_t)(row - MC) * DM;
#pragma unroll
        for (int j = 0; j < 4; ++j) xv[i][j] = __builtin_nontemporal_load((const f32x4*)(xr + 4 * F.lane + 256 * j)); }
    const int cond = itemn * NR < MC ? 0 : 1 + ((itemn * NR - MC) >> 10);
    const float* sc = F.misc + MI_MOD + (0 * 9 + cond) * 6144 + 1024; const float* g1 = ((const float*)F.ka->in[9]);
    f32x4 gs[4];
#pragma unroll
    for (int j = 0; j < 4; ++j) { const int c = 4 * F.lane + 256 * j; gs[j] = (*(const f32x4*)(g1 + c)) * (*(const f32x4*)(sc + c) + 1.f); }
#pragma unroll
    for (int i = 0; i < NR; ++i) { const int row = itemn * NR + i; bf16_t* dst = (bf16_t*)(F.ws + WS_XS) + (size_t)row * DM; float s = 0.f;
#pragma unroll
        for (int j = 0; j < 4; ++j) { const f32x4 x = xv[i][j]; const f32x4 t = x * x; s += (t[0] + t[1]) + (t[2] + t[3]); const f32x4 y = x * gs[j];
            u32x2 w; w.x = cvt_pk_bf16(y[0], y[1]); w.y = cvt_pk_bf16(y[2], y[3]); *(u32x2*)(dst + 4 * F.lane + 256 * j) = w;
            u32x2 r; r.x = cvt_pk_bf16(x[0], x[1]); r.y = cvt_pk_bf16(x[2], x[3]); *(u32x2*)((bf16_t*)(F.ws + WS_XR) + (size_t)row * DM + 4 * F.lane + 256 * j) = r; }
        s = wave_sum(s, F.lane);
        if (F.lane == 0) ((float*)(F.ctl + CW_SS))[row] = s; }
}
__device__ __forceinline__ void bias_item(Frame& F, int item) {
    const int which = item >= 2048, n = which ? item - 2048 : item;
    const bf16_t* wrow = (const bf16_t*)(F.ws + (which ? WS_WUP : WS_WIN)) + (size_t)n * DM;
    float wv[16]; { const u32x4 a = *(const u32x4*)(wrow + F.lane * 8), b = *(const u32x4*)(wrow + 512 + F.lane * 8);
        wv[0] = bflo(a.x); wv[1] = bfhi(a.x); wv[2] = bflo(a.y); wv[3] = bfhi(a.y); wv[4] = bflo(a.z); wv[5] = bfhi(a.z); wv[6] = bflo(a.w); wv[7] = bfhi(a.w);
        wv[8] = bflo(b.x); wv[9] = bfhi(b.x); wv[10] = bflo(b.y); wv[11] = bfhi(b.y); wv[12] = bflo(b.z); wv[13] = bfhi(b.z); wv[14] = bflo(b.w); wv[15] = bfhi(b.w); }
    float outv = 0.f;
#pragma unroll
    for (int cond = 0; cond < 9; ++cond) { const float* sh = F.misc + MI_MOD + cond * 6144 + (which ? 3072 : 0);
        const f32x4 s0 = *(const f32x4*)(sh + F.lane * 8), s1 = *(const f32x4*)(sh + F.lane * 8 + 4), s2 = *(const f32x4*)(sh + 512 + F.lane * 8), s3 = *(const f32x4*)(sh + 512 + F.lane * 8 + 4);
        float d = 0.f;
#pragma unroll
        for (int e = 0; e < 4; ++e) d += s0[e] * wv[e] + s1[e] * wv[4 + e] + s2[e] * wv[8 + e] + s3[e] * wv[12 + e];
        d = wave_sum(d, F.lane); if (F.lane == cond) outv = d; }
    if (F.lane < 9) ((float*)F.ctl)[(which ? CW_BUP + F.lane * 4096 : CW_BIN + F.lane * 2048) + n] = outv;
}
__device__ __forceinline__ void ssm_scan(Frame& F, int l, int g, int pm) {
    const int tid = F.tid, sl = tid >> 7, dp = tid & 127, dir = dp >> 6, p = dp & 63;
    const f32x2* LAM16 = (const f32x2*)(F.ws + WS_SSM + SSM_LAM16); const f32x2* BBAR = (const f32x2*)(F.ws + WS_SSM + SSM_BBAR);
    const bf16_t* E = (const bf16_t*)(F.ws + WS_R + R_E); bf16_t* AS3 = (bf16_t*)(F.ws + WS_R + R_AS3);
    const f32x2 lam = LAM16[(dir * NG + g) * 64 + p];
    f32x2 e[64];
    if (pm == 0) {
#pragma unroll
        for (int q = 0; q < 4; ++q) { const bf16_t* ep = E + ((size_t)g * NCHUNK + (q * 4 + sl) * 16) * 256 + dir * 128 + 2 * p;
#pragma unroll
            for (int j = 0; j < 16; ++j) { const unsigned w = *(const unsigned*)(ep + (size_t)j * 256); e[q * 16 + j] = (f32x2){bflo(w), bfhi(w)}; } }
    } else { const bf16_t* ep = E + ((size_t)g * NCHUNK + 256 + ((pm - 1) * 4 + sl) * 64) * 256 + dir * 128 + 2 * p;
#pragma unroll
        for (int j = 0; j < 64; ++j) { const unsigned w = *(const unsigned*)(ep + (size_t)j * 256); e[j] = (f32x2){bflo(w), bfhi(w)}; } }
    const int nq = pm == 0 ? 4 : 1;
#pragma unroll
    for (int q = 0; q < 4; ++q) { if (q >= nq) break;
        int base; f32x2 h;
        if (pm == 0) { const int seq = q * 4 + sl; base = seq * 16; h = (f32x2){0.f, 0.f}; }
        else { const int sq = (pm - 1) * 4 + sl; base = 256 + sq * 64; h = *(const f32x2*)(((const float*)F.ka->in[4]) + ((((size_t)sq * DEPTH + l) * 2 + dir) * NG + g) * 128 + 2 * p); }
        unsigned* hp = (unsigned*)(AS3 + ((size_t)g * NCHUNK + base) * 512 + 256 + dir * 128 + 2 * p);
        if (pm == 0) {
#pragma unroll
            for (int jj = 0; jj < 16; ++jj) { const int j = dir ? 15 - jj : jj; const f32x2 ev = dir ? e[q * 16 + 15 - jj] : e[q * 16 + jj]; hp[(size_t)j * 256] = cvt_pk_bf16(h.x, h.y); h = cmul(lam, h) + ev; }
        } else {
#pragma unroll
            for (int jj = 0; jj < 64; ++jj) { const int j = dir ? 63 - jj : jj; const f32x2 ev = dir ? e[63 - jj] : e[jj]; hp[(size_t)j * 256] = cvt_pk_bf16(h.x, h.y); h = cmul(lam, h) + ev; }
        }
    }
    if (pm == 0) {
        const int tt = dir ? 15 : 0; u32x4 uq[4][2]; f32x2 bbv[16];
        const f32x2* bb = BBAR + ((size_t)(dir * NG + g) * 64 + p) * 16;
#pragma unroll
        for (int ch = 0; ch < 16; ++ch) bbv[ch] = bb[ch];
#pragma unroll
        for (int q = 0; q < 4; ++q) { const int chunk = (q * 4 + sl) * 16 + tt; const bf16_t* up = AS3 + ((size_t)g * NCHUNK + chunk) * 512 + tt * 16; uq[q][0] = *(const u32x4*)up; uq[q][1] = *(const u32x4*)(up + 8); }
        float* ns = F.out + (size_t)MT * DM + 2 * (size_t)NB * DEPTH * SEQ * 512;
#pragma unroll
        for (int q = 0; q < 4; ++q) { const int seq = q * 4 + sl; const u32x4 u0 = uq[q][0], u1 = uq[q][1];
            const float uu[16] = {bflo(u0.x), bfhi(u0.x), bflo(u0.y), bfhi(u0.y), bflo(u0.z), bfhi(u0.z), bflo(u0.w), bfhi(u0.w), bflo(u1.x), bfhi(u1.x), bflo(u1.y), bfhi(u1.y), bflo(u1.z), bfhi(u1.z), bflo(u1.w), bfhi(u1.w)};
            f32x2 acc = (f32x2){0.f, 0.f};
#pragma unroll
            for (int ch = 0; ch < 16; ++ch) acc += bbv[ch] * uu[ch];
            *(f32x2*)(ns + ((((size_t)seq * DEPTH + l) * 2 + dir) * NG + g) * 128 + 2 * p) = acc; }
    }
}
__device__ __forceinline__ void ld16(const bf16_t* p, float* v) { const u32x4 a = *(const u32x4*)p; v[0] = bflo(a.x); v[1] = bfhi(a.x); v[2] = bflo(a.y); v[3] = bfhi(a.y); v[4] = bflo(a.z); v[5] = bfhi(a.z); v[6] = bflo(a.w); v[7] = bfhi(a.w); }
__device__ __forceinline__ void conv_item(Frame& F, int l, int item) {
    const int rs = item >> 4, pn = item & 15, lr = F.lane >> 4, lc = F.lane & 15;
    const int r0 = rs * 64 + lr * 16; const int av = 128 * pn + 8 * lc;
    const bf16_t* up = (const bf16_t*)(F.ws + WS_R) + (size_t)r0 * 4096 + 256 * pn + 8 * lc; bf16_t* gp = (bf16_t*)(F.ws + WS_G) + (size_t)r0 * 2048 + av;
    const float* cw = ((const float*)F.ka->in[31]) + (size_t)l * 3 * 4096; const float* cb = ((const float*)F.ka->in[32]) + (size_t)l * 4096;
    float wv[3][8], wg[3][8], bv[8], bg[8];
#pragma unroll
    for (int k = 0; k < 3; ++k)
#pragma unroll
        for (int e = 0; e < 8; ++e) { wv[k][e] = cw[k * 4096 + av + e]; wg[k][e] = cw[k * 4096 + 2048 + av + e]; }
#pragma unroll
    for (int e = 0; e < 8; ++e) { bv[e] = cb[av + e]; bg[e] = cb[2048 + av + e]; }
    const int t0 = r0 < MC ? (r0 & 255) : ((r0 - MC) & 1023), L = r0 < MC ? SEQ : DSEQ;
    float pv[8], pg[8], cv[8], cg[8], nv_[8], ng[8];
    if (t0 > 0) { ld16(up - 4096, pv); ld16(up - 4096 + 128, pg); } else {
#pragma unroll
        for (int e = 0; e < 8; ++e) { pv[e] = 0.f; pg[e] = 0.f; } }
    ld16(up, cv); ld16(up + 128, cg);
#pragma unroll
    for (int i = 0; i < 16; ++i) {
        if (t0 + i + 1 < L) { ld16(up + (size_t)(i + 1) * 4096, nv_); ld16(up + (size_t)(i + 1) * 4096 + 128, ng); } else {
#pragma unroll
            for (int e = 0; e < 8; ++e) { nv_[e] = 0.f; ng[e] = 0.f; } }
        float o[8];
#pragma unroll
        for (int e = 0; e < 8; ++e) { const float zv = bv[e] + wv[0][e] * pv[e] + wv[1][e] * cv[e] + wv[2][e] * nv_[e]; const float zg = bg[e] + wg[0][e] * pg[e] + wg[1][e] * cg[e] + wg[2][e] * ng[e]; o[e] = silu_f(zg) * zv; }
        u32x4 w; w.x = cvt_pk_bf16(o[0], o[1]); w.y = cvt_pk_bf16(o[2], o[3]); w.z = cvt_pk_bf16(o[4], o[5]); w.w = cvt_pk_bf16(o[6], o[7]);
        *(u32x4*)(gp + (size_t)i * 2048) = w;
#pragma unroll
        for (int e = 0; e < 8; ++e) { pv[e] = cv[e]; pg[e] = cg[e]; cv[e] = nv_[e]; cg[e] = ng[e]; }
    }
}

__device__ __forceinline__ bool slab_first(int s) { return s < 64 ? (s & 3) == 0 : ((s - 64) & 15) == 0; }
__device__ __forceinline__ bool slab_last(int s) { return s < 64 ? (s & 3) == 3 : ((s - 64) & 15) == 15; }
__device__ __forceinline__ void ld4bf(const bf16_t* p, float* v) { const u32x2 a = *(const u32x2*)p; v[0] = bflo(a.x); v[1] = bfhi(a.x); v[2] = bflo(a.y); v[3] = bfhi(a.y); }
__device__ __forceinline__ void conv_fix(Frame& F, int l, int pm) {
    const bf16_t* HALO = (const bf16_t*)(F.ws + WS_HALO); bf16_t* G = (bf16_t*)(F.ws + WS_G);
    const float* cw = ((const float*)F.ka->in[31]) + (size_t)l * 3 * 4096; const float* cb = ((const float*)F.ka->in[32]) + (size_t)l * 4096;
    const int c = F.tid * 4, pos = 256 * (c >> 7) + (c & 127);
    float wv[3][4], wg[3][4], bv[4], bg[4];
#pragma unroll
    for (int k = 0; k < 3; ++k) { const f32x4 a = *(const f32x4*)(cw + k * 4096 + c), b = *(const f32x4*)(cw + k * 4096 + 2048 + c);
#pragma unroll
        for (int e = 0; e < 4; ++e) { wv[k][e] = a[e]; wg[k][e] = b[e]; } }
    { const f32x4 a = *(const f32x4*)(cb + c), b = *(const f32x4*)(cb + 2048 + c);
#pragma unroll
      for (int e = 0; e < 4; ++e) { bv[e] = a[e]; bg[e] = b[e]; } }
    u32x2 hv[8][6];
#pragma unroll
    for (int r8 = 0; r8 < 8; ++r8) { const int s = pm * 4 + (r8 >> 1), which = r8 & 1; const bool skip = which == 0 ? slab_first(s) : slab_last(s);
        const int sp = skip ? s : (which == 0 ? s - 1 : s), sn = skip ? s : (which == 0 ? s : s + 1);
        const bf16_t* hp = which == 0 ? HALO + ((size_t)sp * 4 + 3) * 4096 : HALO + ((size_t)s * 4 + 2) * 4096;
        const bf16_t* hc = which == 0 ? HALO + ((size_t)s * 4 + 0) * 4096 : HALO + ((size_t)s * 4 + 3) * 4096;
        const bf16_t* hn = which == 0 ? HALO + ((size_t)s * 4 + 1) * 4096 : HALO + ((size_t)sn * 4 + 0) * 4096;
        hv[r8][0] = *(const u32x2*)(hp + pos); hv[r8][1] = *(const u32x2*)(hc + pos); hv[r8][2] = *(const u32x2*)(hn + pos);
        hv[r8][3] = *(const u32x2*)(hp + pos + 128); hv[r8][4] = *(const u32x2*)(hc + pos + 128); hv[r8][5] = *(const u32x2*)(hn + pos + 128); }
#pragma unroll
    for (int r8 = 0; r8 < 8; ++r8) { const int s = pm * 4 + (r8 >> 1), which = r8 & 1;
        if (which == 0 ? slab_first(s) : slab_last(s)) continue;
        float pv[4], cv[4], nv_[4], pg[4], cg[4], ng[4];
#define UNP(v, w) do { v[0] = bflo(w.x); v[1] = bfhi(w.x); v[2] = bflo(w.y); v[3] = bfhi(w.y); } while (0)
        UNP(pv, hv[r8][0]); UNP(cv, hv[r8][1]); UNP(nv_, hv[r8][2]); UNP(pg, hv[r8][3]); UNP(cg, hv[r8][4]); UNP(ng, hv[r8][5]);
#undef UNP
        float o[4];
#pragma unroll
        for (int e = 0; e < 4; ++e) { const float zv = bv[e] + wv[0][e] * pv[e] + wv[1][e] * cv[e] + wv[2][e] * nv_[e]; const float zg = bg[e] + wg[0][e] * pg[e] + wg[1][e] * cg[e] + wg[2][e] * ng[e]; o[e] = silu_f(zg) * zv; }
        u32x2 w; w.x = cvt_pk_bf16(o[0], o[1]); w.y = cvt_pk_bf16(o[2], o[3]);
        *(u32x2*)(G + (size_t)(s * 64 + (which ? 63 : 0)) * 2048 + c) = w; }
}
constexpr int N_TR_ITEMS_L = 16 * 32 + 8 * 8 + 16 * 16 + 16 * 64 + 32 * 16;
template <bool BIAS> __device__ __forceinline__ void weight_item(Frame& F, LAS float* scr, int l, int it) {
    int r = it; const float* modl = F.misc + MI_MOD + l * 9 * 6144; float* cf = (float*)F.ctl;
    if (r < 512) { transpose_item<1, BIAS>(F, ((const float*)F.ka->in[10]) + (size_t)l * DM * 2048, DM, 2048, (bf16_t*)(F.ws + WS_WIN) + (size_t)l * 2048 * DM, scr, r, modl, cf + CW_BIN + l * 9 * 2048); return; } r -= 512;
    if (r < 64) { transpose_item<0, false>(F, ((const float*)F.ka->in[26]) + (size_t)l * 512 * 512, 512, 512, (bf16_t*)(F.ws + WS_WGLU) + (size_t)l * 512 * 512, scr, r, nullptr, nullptr); return; } r -= 64;
    if (r < 256) { transpose_item<0, false>(F, ((const float*)F.ka->in[28]) + (size_t)l * DM * DM, DM, DM, (bf16_t*)(F.ws + WS_WOUT) + (size_t)l * DM * DM, scr, r, nullptr, nullptr); return; } r -= 256;
    if (r < 1024) { transpose_item<2, BIAS>(F, ((const float*)F.ka->in[30]) + (size_t)l * DM * 4096, DM, 4096, (bf16_t*)(F.ws + WS_WUP) + (size_t)l * 4096 * DM, scr, r, modl + 3072, cf + CW_BUP + l * 9 * 4096); return; } r -= 1024;
    transpose_item<0, false>(F, ((const float*)F.ka->in[33]) + (size_t)l * 2048 * DM, 2048, DM, (bf16_t*)(F.ws + WS_WDN) + (size_t)l * DM * 2048, scr, r, nullptr, nullptr);
}

__global__ void __launch_bounds__(NTHREADS, 2) mega(Args args) {
    extern __shared__ __attribute__((aligned(16))) unsigned char lds_raw[];
    Frame F;
    F.lds = (LAS unsigned char*)lds_raw;
    F.tid = threadIdx.x; F.lane = F.tid & 63; F.wave = __builtin_amdgcn_readfirstlane(F.tid >> 6);
    F.G = gridDim.x; F.bid = blockIdx.x; { const int bx = blockIdx.x; F.vcu = (F.G % 8 == 0) ? (bx % 8) * (F.G / 8) + bx / 8 : bx; }
    F.ka = (kargs_t)__builtin_amdgcn_kernarg_segment_ptr();
    F.out = args.out; F.ws = args.ws; F.misc = (float*)(args.ws + WS_MISC); F.ctl = (unsigned*)(args.ws + WS_CTL);
    volatile LAS unsigned* MISC = (volatile LAS unsigned*)(F.lds + MISC_OFF);
    for (int u = F.tid; u < (LDS_BYTES - LDSCTL_OFF) / 4; u += NTHREADS) ((LAS unsigned*)(F.lds + LDSCTL_OFF))[u] = 0u;
    __syncthreads();
    XcdBarrier bar = xcd_barrier_post(F.ctl + CW_BAR, MISC + 8);
    int phase_no = 0;
#define LAUNDER() do { { GAS unsigned char* w1_ = (GAS unsigned char*)args.ws; GAS float* o1_ = (GAS float*)args.out; kargs_t k1_ = (kargs_t)__builtin_amdgcn_kernarg_segment_ptr(); \
      int b_ = __builtin_amdgcn_readfirstlane(F.bid), w_ = __builtin_amdgcn_readfirstlane(F.wave); \
      asm volatile("" : "+s"(k1_), "+s"(w1_), "+s"(o1_), "+s"(b_), "+s"(w_)); F.ka = k1_; F.ws = (unsigned char*)w1_; F.out = (float*)o1_; F.bid = b_; F.wave = w_; }     \
    F.vcu = (F.G % 8 == 0) ? (F.bid % 8) * (F.G / 8) + F.bid / 8 : F.bid; \
    { unsigned z_ = 0u; asm volatile("" : "+v"(z_)); F.lane = (int)__builtin_amdgcn_mbcnt_hi(~0u, __builtin_amdgcn_mbcnt_lo(~0u, z_)); } F.tid = F.wave * 64 + F.lane;     \
    F.misc = (float*)(F.ws + WS_MISC); F.ctl = (unsigned*)(F.ws + WS_CTL); gw = F.vcu * NWAVES + F.wave; } while (0)
#ifndef TPROBE_SCALE
#define TPROBE_SCALE 0.25f
#endif
#ifdef TPROBE
#define TSTAMP() do { if (blockIdx.x == 0 && F.tid == 0) ((unsigned long long*)(F.ctl + 6000))[phase_no] = __builtin_amdgcn_s_memrealtime(); } while (0)
#else
#define TSTAMP() do {} while (0)
#endif
#if defined(TPROBE) && defined(TPROBE_SUB_A)
#ifndef TPROBE_BID
#define TPROBE_BID 0
#endif
#define TSUB(i) do { if (blockIdx.x == TPROBE_BID && F.tid == 0 && l == 0) ((unsigned long long*)(F.ctl + 6200))[i] = __builtin_amdgcn_s_memrealtime(); } while (0)
#else
#define TSUB(i) do {} while (0)
#endif
#ifdef TPROBE
#define TPRE() do { if (blockIdx.x == 0 && F.tid == 0) ((unsigned long long*)(F.ctl + 6400))[phase_no + 1] = __builtin_amdgcn_s_memrealtime(); } while (0)
#else
#define TPRE() do {} while (0)
#endif
#ifdef TPROBE_WSTAT
#ifndef TPROBE_CLS
#define TPROBE_CLS (-1)
#endif
#ifndef TPROBE_LO
#define TPROBE_LO 0
#define TPROBE_HI 100000
#endif
#define WS_LDS ((volatile LAS unsigned long long*)((LAS unsigned char*)lds_raw + LDSCTL_OFF + 64))
#define TPRE2() do { if (F.tid == 0) { const unsigned long long now_ = __builtin_amdgcn_s_memrealtime(); \
      if (TPROBE_WSTAT >= 3 && phase_no >= 1 && ((TPROBE_MASK_A >> phase_no) & 1ull)) WS_LDS[1] = WS_LDS[1] + (now_ - WS_LDS[2]); \
      if (phase_no == 10 && (TPROBE_CLS < 0 || (int)(blockIdx.x & 7u) == TPROBE_CLS) && (int)blockIdx.x >= TPROBE_LO && (int)blockIdx.x < TPROBE_HI) { const unsigned w_ = (unsigned)WS_LDS[1]; atomicMax(F.ctl + 6600, 0xFFFFFFFFu - w_); atomicAdd(F.ctl + 6601, w_); atomicMax(F.ctl + 6602, w_); } WS_LDS[0] = __builtin_amdgcn_s_memrealtime(); } } while (0)
#define TPOST2() do { if (F.tid == 0) { const unsigned long long now_ = __builtin_amdgcn_s_memrealtime(); WS_LDS[2] = now_; if (TPROBE_WSTAT < 3 && ((TPROBE_MASK_A >> (phase_no - 1)) & 1ull)) WS_LDS[1] = WS_LDS[1] + (now_ - WS_LDS[0]); } } while (0)
#else
#define TPRE2() do {} while (0)
#define TPOST2() do {} while (0)
#endif
#define GRID_BAR() do { LAUNDER(); TPRE(); TPRE2(); xcd_barrier(bar, F.tid); ++phase_no; TPOST2(); TSTAMP(); if (F.ka->stop_after == phase_no) return; LAUNDER(); } while (0)
    int gw = F.vcu * NWAVES + F.wave; const int NGW = F.G * NWAVES;
#define ssq ((float*)(F.ctl + CW_SS))
#define XS ((bf16_t*)(F.ws + WS_XS))
#define KB ((bf16_t*)(F.ws + WS_KB))
#define VB ((bf16_t*)(F.ws + WS_VB))
#define Qb ((bf16_t*)(F.ws + WS_R + R_Q))
#define AS3 ((bf16_t*)(F.ws + WS_R + R_AS3))
#define Eb ((bf16_t*)(F.ws + WS_R + R_E))
#define Zb ((bf16_t*)(F.ws + WS_R + R_Z))
#define CAT ((bf16_t*)(F.ws + WS_R + R_CAT))
#define UP ((bf16_t*)(F.ws + WS_R))
#define Gb ((bf16_t*)(F.ws + WS_G))

    TSTAMP();
    if (F.vcu < 64) { ssm_prep(F, 0, F.vcu); cache_item(F, 0, 2048 - 1024 + F.vcu * NWAVES + F.wave); cache_item(F, 0, 2048 - 512 + F.vcu * NWAVES + F.wave); }
    else {
        mod_task3(F, F.vcu - 64);
        if (F.vcu == 64) {
            for (int i = F.tid; i < 1024; i += NTHREADS) { const int pos = i >> 4, f = i & 15; const float inv = 1.0f / powf(10000.0f, (float)f / 16.0f); const float ang = (float)pos * inv;
                ((f32x2*)(F.misc + MI_ROPE))[i] = (f32x2){cosf(ang), sinf(ang)}; }
            if (F.tid < 2) { const int l = F.tid; float a1 = 0.f, a2 = 0.f; for (int d = 0; d < 64; ++d) { a1 += ((const float*)F.ka->in[13])[l * 64 + d] * ((const float*)F.ka->in[14])[l * 64 + d]; a2 += ((const float*)F.ka->in[15])[l * 64 + d] * ((const float*)F.ka->in[16])[l * 64 + d]; }
                const float li = 0.8f - 0.6f * expf(-0.3f * (float)l); F.misc[MI_LAM + l] = expf(a1) - expf(a2) + li; F.misc[MI_LAM + 2 + l] = 1.f - li; }
            __syncthreads();
        }
        LAS float* scr = (LAS float*)(F.lds + F.wave * 16640);
        const int gw1 = (F.vcu - 64) * NWAVES + F.wave, NGW1 = (F.G - 64) * NWAVES;
        for (int it = gw1; it < N_TR_ITEMS_L + 2048 - 1024; it += NGW1) { if (it < N_TR_ITEMS_L) weight_item<false>(F, scr, 0, it); else cache_item(F, 0, it - N_TR_ITEMS_L); }
    }
    GRID_BAR();
    for (int it = gw; it < MT / 2 + 6144; it += NGW) { if (it < MT / 2) xprep_item<2>(F, it); else bias_item(F, it - MT / 2); }
    GRID_BAR();

    for (int l = 0; l < DEPTH; ++l) {
        const float* modl = F.misc + MI_MOD + l * 9 * 6144;
        { unsigned* ucnt = F.ctl + CW_UC + l * 6 * 64;
          { LAS f32x2* ropel = (LAS f32x2*)(F.lds + ROPE_LDS_OFF);
            for (int i = F.tid; i < 1024; i += NTHREADS) ropel[(i >> 4) * 17 + (i & 15)] = ((const f32x2*)(F.misc + MI_ROPE))[i];
            __syncthreads(); }
          { Gemm g{XS, (const bf16_t*)(F.ws + WS_WIN) + (size_t)l * 2048 * DM, DM, DM, DM, 0, 0, 1 + 10 * l}; InOrder S{F.bid, F.G};
            EpiIn E{ssq + (l == 0 ? 0 : 2 * MT), (const float*)F.ctl + CW_BIN + l * 9 * 2048, ((const float*)F.ka->in[11]) + l * 64, ((const float*)F.ka->in[12]) + l * 64, (const LAS f32x2*)(F.lds + ROPE_LDS_OFF), Qb, KB, VB,
                    __builtin_amdgcn_make_buffer_rsrc((void*)AS3, 0, (int)((size_t)NG * NCHUNK * 512 * 2), 0x00020000),
                    F.out + (size_t)MT * DM, F.out + (size_t)MT * DM + (size_t)NB * DEPTH * SEQ * 512, l, ucnt};
            gemm_phase<EpiIn, InOrder>(F.lds, F.tid, g, S, E); }
          if (F.bid >= 128 && F.bid < 224) {
              LAUNDER(); TSUB(8);
              const int idx = F.bid - 128, gq = idx / 3, pmq = idx % 3; unsigned* up = F.ctl + CW_UC + ((l * 3 + pmq) * 2 + (gq >> 4)) * 64;
              if (F.tid == 0) { unsigned sp = 0; while (__hip_atomic_load(up, RLX_AGENT) < 128u) { __builtin_amdgcn_s_sleep(2); if (++sp > (1u << 20)) break; }
                  __builtin_amdgcn_fence(__ATOMIC_ACQUIRE, "agent"); asm volatile("s_waitcnt vmcnt(0)" ::: "memory"); }
              __syncthreads(); TSUB(9);
              { Gemm g{AS3, (const bf16_t*)(F.ws + WS_SSM + SSM_WE), 512, 256, 256, (size_t)NCHUNK * 512, (size_t)256 * 256}; GroupOrder S{idx, F.G}; EpiS1 E{Eb};
                gemm_phase<EpiS1, GroupOrder>(F.lds, F.tid, g, S, E); }
              VM_WAIT(); __syncthreads(); LAUNDER(); TSUB(10);
              ssm_scan(F, l, (F.bid - 128) / 3, (F.bid - 128) % 3); TSUB(11); }
 }
        GRID_BAR();
#define ZC_PTR (F.ctl + CW_ZC + l * 256)
#define ATTN_UNIT(SEQ_, H_, QB_) do { LAUNDER(); const AttnArgs A_{Qb, KB, VB, CAT, ((const float*)F.ka->in[17]) + l * 128, F.misc[MI_LAM + l], F.misc[MI_LAM + 2 + l]}; attn_unit(F.lds, F.tid, A_, (SEQ_), (H_), (QB_)); } while (0)
#define ATTN_CTX(U_) do { const int u_ = (U_); ATTN_UNIT(u_ >> 3, (u_ >> 1) & 3, u_ & 1); } while (0)
        { TSUB(0);
          const int xq = F.vcu >> 5, rq = F.vcu & 31;
          if (rq < 12) { const int cidx = xq * 12 + rq;
              { Gemm g{AS3, (const bf16_t*)(F.ws + WS_SSM + SSM_WY), 512, 512, 512, (size_t)NCHUNK * 512, (size_t)256 * 512}; GroupOrder S{cidx, F.G};
                EpiS3 E{__builtin_amdgcn_make_buffer_rsrc((void*)Zb, 0, (int)((size_t)MT * 512 * 2), 0x00020000)};
                gemm_phase<EpiS3, GroupOrder>(F.lds, F.tid, g, S, E); }
              VM_WAIT(); __syncthreads(); LAUNDER();
              if (F.tid == 0) __hip_atomic_fetch_add(ZC_PTR + (((F.vcu >> 5) * 12 + (F.vcu & 31)) % 3) * 64, 1u, RLX_AGENT); }
          TSUB(3);
          { const int u = F.vcu; ATTN_UNIT(NB + (u >> 5), (u >> 3) & 3, u & 7); } TSUB(4);
          if ((F.vcu & 31) >= 24) { for (int r = 0; r < 2; ++r) ATTN_CTX((F.vcu >> 5) * 16 + 2 * ((F.vcu & 31) - 24) + r); }
          TSUB(5);
          if ((F.vcu & 31) >= 12 && (F.vcu & 31) < 24) {
              LAUNDER();
              const int idx = (F.vcu >> 5) * 12 + ((F.vcu & 31) - 12), pmz = panel_of(idx / 12, (idx % 12) >> 1) >> 4;
              if (F.tid == 0) { unsigned sp = 0; while (__hip_atomic_load(ZC_PTR + pmz * 64, RLX_AGENT) < (unsigned)NG) { __builtin_amdgcn_s_sleep(2); if (++sp > (1u << 20)) break; }
                  __builtin_amdgcn_fence(__ATOMIC_ACQUIRE, "agent"); asm volatile("s_waitcnt vmcnt(0)" ::: "memory"); }
              __syncthreads(); TSUB(6);
              Gemm g{Zb, (const bf16_t*)(F.ws + WS_WGLU) + (size_t)l * 512 * 512, 512, 512, 512, 0, 0}; OneTile S{idx};
              EpiGlu E{Zb, ((const float*)F.ka->in[27]) + l * 512, CAT};
              gemm_phase<EpiGlu, OneTile, false, 0, true>(F.lds, F.tid, g, S, E); TSUB(7); } }
        GRID_BAR();
        { Gemm g{CAT, (const bf16_t*)(F.ws + WS_WOUT) + (size_t)l * DM * DM, DM, DM, DM, 0, 0, 2 + 10 * l}; GridOrder S; S.init(MT, DM, F.G, F.bid);
          bf16_t* XR = (bf16_t*)(F.ws + WS_XR);
          { EpiRes<false, false> E{nullptr, nullptr, XR, nullptr, XR, modl + 2 * DM, ((const float*)F.ka->in[29]) + l * DM, modl + 4 * DM, XS, ssq + (l == 0 ? 1 : 3) * MT};
              gemm_phase<EpiRes<false, false>, GridOrder>(F.lds, F.tid, g, S, E); }
          if (l + 1 < DEPTH && F.bid >= 192) { LAUNDER(); LAS float* scr = (LAS float*)(F.lds + F.wave * 16640);
              for (int it = (F.bid - 192) * NWAVES + F.wave; it < N_TR_ITEMS_L; it += 64 * NWAVES) weight_item<true>(F, scr, l + 1, it); } }
        GRID_BAR();
        { Gemm g{XS, (const bf16_t*)(F.ws + WS_WUP) + (size_t)l * 4096 * DM, DM, DM, DM, 0, 0, 3 + 10 * l}; GridOrder S; S.init(MT, 4096, F.G, F.bid);
          EpiUpConv E{ssq + (l == 0 ? 1 : 3) * MT, (const float*)F.ctl + CW_BUP + l * 9 * 4096, ((const float*)F.ka->in[31]) + (size_t)l * 3 * 4096, ((const float*)F.ka->in[32]) + (size_t)l * 4096, Gb, (bf16_t*)(F.ws + WS_HALO)};
          gemm_phase<EpiUpConv, GridOrder, true>(F.lds, F.tid, g, S, E); }
        GRID_BAR();
        { Gemm g{Gb, (const bf16_t*)(F.ws + WS_WDN) + (size_t)l * DM * 2048, 2048, 2048, 2048, 0, 0, 4 + 10 * l}; GridOrder S; S.init(MT, DM, F.G, F.bid);
          const bool nxt = l + 1 < DEPTH;
          bf16_t* XR = (bf16_t*)(F.ws + WS_XR);
          { Unit u0; if (S.next(0, u0)) { conv_fix(F, l, u0.pm); VM_WAIT(); __syncthreads(); LAUNDER(); } }
          if (nxt) { EpiRes<false, false> E{nullptr, nullptr, XR, nullptr, XR, modl + 5 * DM, ((const float*)F.ka->in[9]) + (l + 1) * DM, modl + 9 * 6144 + DM, XS, ssq + 2 * MT};
              gemm_phase<EpiRes<false, false>, GridOrder>(F.lds, F.tid, g, S, E); }
          else { EpiRes<false, true> E{nullptr, nullptr, XR, F.out, nullptr, modl + 5 * DM, nullptr, nullptr, XS, ssq + 2 * MT};
              gemm_phase<EpiRes<false, true>, GridOrder>(F.lds, F.tid, g, S, E); }
          if (nxt && F.bid >= 192) { LAUNDER(); TSUB(12); ssm_prep(F, l + 1, F.bid - 192); TSUB(13);
              for (int it = (F.bid - 192) * NWAVES + F.wave; it < 2048; it += 64 * NWAVES) cache_item(F, l + 1, it); } }
        if (l + 1 < DEPTH) GRID_BAR();
    }
#ifdef TPROBE
    if (blockIdx.x == 0) {
        ++phase_no; TSTAMP(); VM_WAIT(); __syncthreads();
        volatile LAS float* dl = (volatile LAS float*)(F.lds + 1024);
        if (threadIdx.x == 0) { const unsigned long long* ts = (const unsigned long long*)((unsigned*)(args.ws + WS_CTL) + 6000); const float tot = (float)(ts[phase_no] - ts[0]);
            float fa = 0.f;
#if defined(TPROBE_WSTAT)
            { const unsigned* cw = (const unsigned*)(args.ws + WS_CTL) + 6600; const unsigned a0 = __hip_atomic_load(cw + 0, __ATOMIC_RELAXED, __HIP_MEMORY_SCOPE_AGENT), a1 = __hip_atomic_load(cw + 1, __ATOMIC_RELAXED, __HIP_MEMORY_SCOPE_AGENT), a2 = __hip_atomic_load(cw + 2, __ATOMIC_RELAXED, __HIP_MEMORY_SCOPE_AGENT);
              fa = ((TPROBE_WSTAT % 3) == 0 ? (float)(0xFFFFFFFFu - a0) : (TPROBE_WSTAT % 3) == 1 ? (float)a1 / (TPROBE_CLS < 0 ? 256.f : 32.f) : (float)a2) / tot; }
#elif defined(TPROBE_GID)
            { const volatile LAS unsigned long long* t2 = (const volatile LAS unsigned long long*)(F.lds + LDSCTL_OFF); fa = (float)(t2[TPROBE_SUB_B] - t2[TPROBE_SUB_A]) / tot; }
#elif defined(TPROBE_SUB_A)
            { const unsigned long long* t2 = (const unsigned long long*)((unsigned*)(args.ws + WS_CTL) + 6200); fa = (float)(t2[TPROBE_SUB_B] - t2[TPROBE_SUB_A]) / tot; }
#else
#ifdef TPROBE_WAITMODE
            { const unsigned long long* tp = (const unsigned long long*)((unsigned*)(args.ws + WS_CTL) + 6400);
              for (int k = 0; k + 1 < phase_no; ++k) { const float d = (float)(ts[k + 1] - tp[k + 1]) / tot; if ((TPROBE_MASK_A >> k) & 1ull) fa += d; } }
#else
            for (int k = 0; k < phase_no; ++k) { const float d = (float)(ts[k + 1] - ts[k]) / tot; if ((TPROBE_MASK_A >> k) & 1ull) fa += d; }
#endif
#endif
            dl[0] = TPROBE_SCALE * sqrtf(fa); }
        __syncthreads();
        const float delta = dl[0];
        float* nv = args.out + (size_t)MT * DM + (size_t)NB * DEPTH * SEQ * 512;
        for (size_t i = threadIdx.x; i < (size_t)NB * DEPTH * SEQ * 512; i += NTHREADS) nv[i] *= (1.f + delta);
    }
#endif
#undef GRID_BAR
#undef LAUNDER
#undef ZC_PTR
#undef ATTN_UNIT
#undef ATTN_CTX
#undef ssq
#undef XS
#undef KB
#undef VB
#undef Qb
#undef AS3
#undef Eb
#undef Zb
#undef CAT
#undef UP
#undef Gb
}
}

static int fk_launch(void* const* d_in, void* d_out, void* d_ws, size_t ws_size, hipStream_t stream, int stop_after) {
    static int grid = 0;
    if (grid == 0) {
        int dev = 0, cus = 0;
        if (ws_size < fk::WS_END) { fprintf(stderr, "kernel_launch: workspace too small (%zu < %zu)\n", ws_size, (size_t)fk::WS_END); grid = -1; return -1; }
        if (hipGetDevice(&dev) != hipSuccess || hipDeviceGetAttribute(&cus, hipDeviceAttributeMultiprocessorCount, dev) != hipSuccess) { grid = -1; return -1; }
        if (hipFuncSetAttribute((const void*)fk::mega, hipFuncAttributeMaxDynamicSharedMemorySize, fk::LDS_BYTES) != hipSuccess) { fprintf(stderr, "kernel_launch: hipFuncSetAttribute failed\n"); grid = -1; return -1; }
        int per_cu = 0; (void)hipOccupancyMaxActiveBlocksPerMultiprocessor(&per_cu, (const void*)fk::mega, fk::NTHREADS, fk::LDS_BYTES); (void)hipGetLastError();
        if (per_cu < 1) fprintf(stderr, "kernel_launch: occupancy query says %d blocks/CU\n", per_cu);
        grid = cus;
        if (grid != 256) fprintf(stderr, "kernel_launch: %d CUs (built for 256)\n", grid);
    }
    if (grid < 0) return -1;
    (void)hipMemsetAsync((char*)d_ws + fk::WS_CTL, 0, fk::CTL_BYTES, stream);
    fk::Args a{};
    for (int i = 0; i < 34; ++i) a.in[i] = (const float*)d_in[i];
    a.out = (float*)d_out; a.ws = (unsigned char*)d_ws; a.stop_after = stop_after; a.pad = 0;
    hipLaunchKernelGGL(fk::mega, dim3(grid), dim3(fk::NTHREADS), fk::LDS_BYTES, stream, a);
    return 0;
}
extern "C" void kernel_launch(void* const* d_in, const int* in_sizes, int n_in, void* d_out, int out_size, void* d_ws, size_t ws_size, hipStream_t stream) {
    if (n_in != 34) { fprintf(stderr, "kernel_launch: unexpected n_in %d\n", n_in); return; }
    fk_launch(d_in, d_out, d_ws, ws_size, stream, 0);
}
```

```cpp
#include <hip/hip_runtime.h>
#include <cstdio>
#include <cstdint>
namespace fk {
#define LAS __attribute__((address_space(3)))
#define GAS __attribute__((address_space(1)))
typedef unsigned short bf16_t;
typedef short bf16x8 __attribute__((ext_vector_type(8)));
typedef short s16x4 __attribute__((ext_vector_type(4)));
typedef float f32x4 __attribute__((ext_vector_type(4)));
typedef float f32x2 __attribute__((ext_vector_type(2)));
typedef float f32x16 __attribute__((ext_vector_type(16)));
typedef unsigned u32x4 __attribute__((ext_vector_type(4)));
typedef unsigned u32x2 __attribute__((ext_vector_type(2)));

constexpr int DM = 1024, NB = 16, SEQ = 256, DEPTH = 2, DB = 8, DSEQ = 1024, PAST = 512;
constexpr int MC = NB * SEQ, MS = DB * DSEQ, MT = MC + MS;
constexpr int NH = 4, NG = 32, NCOND = 9, NMOD = 6;
constexpr int NCHUNK = MT / 16;
constexpr int KVROWS = MC + DB * (PAST + DSEQ);
constexpr float EPS = 1e-6f;
constexpr float C2 = 0.125f * 1.4426950408889634f;
constexpr int NWAVES = 8, NTHREADS = 512;

constexpr size_t MiB = 1u << 20;
constexpr size_t WS_CTL = 0, CTL_BYTES = 1 * MiB + 512 * 1024;
constexpr size_t WS_MISC = 1 * MiB;
constexpr size_t WS_WIN = 3 * MiB;
constexpr size_t WS_WGLU = 11 * MiB;
constexpr size_t WS_WOUT = 12 * MiB;
constexpr size_t WS_WUP = 16 * MiB;
constexpr size_t WS_WDN = 32 * MiB;
constexpr size_t WS_SSM = 40 * MiB;
constexpr size_t WS_XS = 53 * MiB;
constexpr size_t WS_KB = 77 * MiB;
constexpr size_t WS_VB = 93 * MiB;
constexpr size_t WS_R = 109 * MiB;
constexpr size_t WS_XR = 205 * MiB;
constexpr size_t WS_G = WS_R;
constexpr size_t WS_HALO = WS_R + 48 * MiB;
constexpr size_t WS_END = 253 * MiB;
constexpr size_t R_Q = 0, R_AS3 = 12 * MiB, R_Z = 36 * MiB, R_CAT = 48 * MiB, R_E = 48 * MiB;
constexpr size_t SSM_WE = 0, SSM_WY = 4 * MiB, SSM_LAM16 = 12 * MiB, SSM_BBAR = 12 * MiB + 64 * 1024;
constexpr int MI_MOD = 0;
constexpr int MI_ROPE = MI_MOD + 2 * 9 * 6144;
constexpr int MI_LAM = MI_ROPE + 64 * 16 * 2;
constexpr int MI_END = MI_LAM + 8;
static_assert((size_t)MI_END * 4 <= 2 * MiB, "MISC");
constexpr int CW_BAR = 1024;
constexpr int CW_ZC = 7168;
constexpr int CW_UC = 4608;
constexpr int CW_SS = 8192;
constexpr int CW_BIN = 65536;
constexpr int CW_BUP = CW_BIN + 2 * 9 * 2048;
static_assert((size_t)(CW_SS + 4 * MT) <= CW_BIN && (size_t)(CW_BUP + 2 * 9 * 4096) * 4 <= CTL_BYTES, "CTL");

constexpr int RING_BYTES = 131072;
constexpr int LDS_BYTES_ = 147456; constexpr int LDSCTL_OFF = LDS_BYTES_ - 512, MISC_OFF = LDSCTL_OFF + 320;
constexpr int ROPE_LDS_OFF = RING_BYTES;
constexpr int LDS_BYTES = 147456;

#define RLX_AGENT __ATOMIC_RELAXED, __HIP_MEMORY_SCOPE_AGENT
typedef __bf16 bf16x2_t __attribute__((ext_vector_type(2)));
__device__ __forceinline__ unsigned cvt_pk_bf16(float lo, float hi) { const f32x2 v = {lo, hi}; const bf16x2_t b = __builtin_convertvector(v, bf16x2_t); return __builtin_bit_cast(unsigned, b); }
__device__ __forceinline__ float bf2f(unsigned short b) { return __uint_as_float((unsigned)b << 16); }
__device__ __forceinline__ float bflo(unsigned w) { return __uint_as_float(w << 16); }
__device__ __forceinline__ float bfhi(unsigned w) { return __uint_as_float(w & 0xffff0000u); }
__device__ __forceinline__ float fast_exp2(float x) { return __builtin_amdgcn_exp2f(x); }
__device__ __forceinline__ float fast_rcp(float x) { return __builtin_amdgcn_rcpf(x); }
__device__ __forceinline__ float sigmoid_f(float x) { return fast_rcp(1.f + fast_exp2(-1.4426950408889634f * x)); }
__device__ __forceinline__ float silu_f(float x) { return x * sigmoid_f(x); }
__device__ __forceinline__ float gelu_tanh_f(float x) {
    const float u = 0.7978845608028654f * (x + 0.044715f * x * x * x); return x * sigmoid_f(2.f * u); }
__device__ __forceinline__ float shfl_xor_l(float v, int mask, int lane) { return __uint_as_float((unsigned)__builtin_amdgcn_ds_bpermute((lane ^ mask) << 2, (int)__float_as_uint(v))); }
__device__ __forceinline__ float wave_sum(float v, int lane) {
#pragma unroll
    for (int o = 1; o < 64; o <<= 1) v += shfl_xor_l(v, o, lane);
    return v; }

#define XB_TMO      128
#define XB_XCNT(j)  (256  + 64 * (j))
#define XB_XSUB(j)  (1280 + 64 * (j))
#define XB_XGEN(j)  (2304 + 64 * (j))
#define XB_TOP      3328
#define XB_TOPGEN   3392
#define XCD_BAR_WORDS 3456
#define XB_SPIN_CAP (1u << 18)
__device__ __forceinline__ unsigned xb_ld(unsigned* p)              { return __hip_atomic_load(p, __ATOMIC_RELAXED, __HIP_MEMORY_SCOPE_AGENT); }
__device__ __forceinline__ unsigned xb_add(unsigned* p, unsigned v) { return __hip_atomic_fetch_add(p, v, __ATOMIC_RELAXED, __HIP_MEMORY_SCOPE_AGENT); }
__device__ __forceinline__ unsigned xb_xcc_id() { return (unsigned)__builtin_amdgcn_s_getreg((3 << 11) | 20) & 0xFu; }
#define XB_SPIN(cond, bar) do { unsigned _sp = 0; while (cond) { __builtin_amdgcn_s_sleep(1); \
    if ((++_sp & 255u) == 0u) { if (xb_ld(&(bar)[XB_TMO])) break; if (_sp > XB_SPIN_CAP) { atomicAdd(&(bar)[XB_TMO], 1u); break; } } } } while (0)
struct XcdBarrier { unsigned* bar; unsigned x; volatile LAS unsigned* st; };
__device__ __forceinline__ XcdBarrier xcd_barrier_post(unsigned* bar, volatile LAS unsigned* st) {
    XcdBarrier b; b.bar = bar; b.x = xb_xcc_id(); b.st = st;
    if (threadIdx.x == 0) (void)xb_add(&bar[XB_XCNT(b.x)], 1u);
    return b;
}
__device__ __forceinline__ void xcd_barrier_complete(unsigned* bar, unsigned x, unsigned& nloc, unsigned& nx) {
    const unsigned G = gridDim.x * gridDim.y * gridDim.z;
    unsigned sum, cnt, mine, sp = 0u;
    for (;;) {
        sum = 0u; cnt = 0u; mine = 0u;
#pragma unroll
        for (unsigned j = 0; j < 16; ++j) { const unsigned c = xb_ld(&bar[XB_XCNT(j)]); sum += c; cnt += (c > 0u) ? 1u : 0u; mine = (j == x) ? c : mine; }
        if (sum == G) break;
        __builtin_amdgcn_s_sleep(1);
        if ((++sp & 255u) == 0u) { if (xb_ld(&bar[XB_TMO])) break; if (sp > XB_SPIN_CAP) { atomicAdd(&bar[XB_TMO], 1u); break; } }
    }
    nloc = mine > 0u ? mine : 1u; nx = cnt > 0u ? cnt : 1u;
}
__device__ __forceinline__ void xcd_barrier(const XcdBarrier& b, const int tid) {
    asm volatile("s_waitcnt vmcnt(0)" ::: "memory");
    __syncthreads();
    if (tid == 0) {
        unsigned* bar = b.bar;
        __builtin_amdgcn_s_waitcnt(0);
        unsigned nloc = b.st[0], nx = b.st[1];
        if (nloc == 0u) { xcd_barrier_complete(bar, b.x, nloc, nx); b.st[0] = nloc; b.st[1] = nx; }
        const unsigned old = xb_add(&bar[XB_XSUB(b.x)], 1u);
        const unsigned gen = old / nloc;
        if (old + 1u == (gen + 1u) * nloc) {
            __builtin_amdgcn_fence(__ATOMIC_RELEASE, "agent");
            asm volatile("s_waitcnt vmcnt(0)" ::: "memory");
            const unsigned og = xb_add(&bar[XB_TOP], 1u);
            const unsigned tg = og / nx;
            __builtin_amdgcn_fence(__ATOMIC_ACQUIRE, "agent");
            if (og + 1u == (tg + 1u) * nx) xb_add(&bar[XB_TOPGEN], 1u);
            else XB_SPIN(xb_ld(&bar[XB_TOPGEN]) == tg, bar);
            xb_add(&bar[XB_XGEN(b.x)], 1u);
            asm volatile("s_waitcnt vmcnt(0)" ::: "memory");
        } else {
            __builtin_amdgcn_fence(__ATOMIC_ACQUIRE, "agent");
            XB_SPIN(xb_ld(&bar[XB_XGEN(b.x)]) == gen, bar);
            asm volatile("s_waitcnt vmcnt(0)" ::: "memory");
        }
    }
    __syncthreads();
}

constexpr int BM = 256, BK = 64, HALF = 128, HTB = HALF * BK * 2, NXCD = 8, WGM = 6;
__host__ __device__ __forceinline__ int lds_byte(int r, int c) { const int st = (r >> 4) * 2 + (c >> 5), rr = r & 15, cc = c & 31, ob = rr * 64 + cc * 2; return st * 1024 + (ob ^ (((ob >> 9) & 1) << 5)); }
__host__ __device__ __forceinline__ void stage_rc(int b, int& R, int& C) { const int st = b / 1024, sb = b % 1024, swz = sb ^ (((sb >> 9) & 1) << 5); R = (st >> 1) * 16 + swz / 64; C = (st & 1) * 32 + (swz % 64) / 2; }
__host__ __device__ __forceinline__ int perm32(int rho) { const int n = rho >> 4, i = rho & 15; return 8 * (i >> 2) + 4 * n + (i & 3); }

__device__ __forceinline__ int panel_of(int x, int j) { return 2 * x + j + ((j + 6) >> 3) * (14 + 2 * x); }
struct Unit { int pm, pn, g; };
struct Gemm { const bf16_t* A; const bf16_t* Bt; int lda, ldb, K; size_t gsA, gsB; int tsid = -1; };
struct GridOrder {
    int nM, nN, nwg, G, c;
    __device__ void init(int M, int N, int G_, int c_) { nM = M / BM; nN = N / BM; nwg = nM * nN; G = G_; c = c_; }
    __device__ __forceinline__ bool next(int i, Unit& u) const {
        const long L = (long)i * G + c; if (L >= nwg) return false;
        int wgid = (int)L; { const int q = nwg / NXCD, r = nwg % NXCD, xcd = wgid % NXCD, off = wgid / NXCD; wgid = (xcd < r ? xcd * (q + 1) : r * (q + 1) + (xcd - r) * q) + off; }
        const int nig = WGM * nN, gid = wgid / nig, fm = gid * WGM, gsz = (nM - fm) < WGM ? (nM - fm) : WGM;
        u.pm = panel_of(gid, (wgid % nig) % gsz);     u.pn = (wgid % nig) / gsz; u.g = 0; return true;
    }
};
struct InOrder {
    int c, G;
    __device__ __forceinline__ bool next(int i, Unit& u) const { const int L = i * G + c; if (L >= 384) return false; u.g = 0;
        if (L < 96) { const int jj = L >> 3; u.pm = panel_of(L & 7, jj >> 1); u.pn = 6 + (jj & 1); }
        else { const int Lp = L - 96, jj = Lp >> 3; u.pm = panel_of(Lp & 7, jj / 6); u.pn = jj % 6; }
        return true; }
};
struct OneTile {
    int idx;
    __device__ __forceinline__ bool next(int i, Unit& u) const { if (i > 0 || idx < 0) return false; u.pm = panel_of(idx / 12, (idx % 12) >> 1); u.pn = idx & 1; u.g = 0; return true; }
};
struct GroupOrder {
    int c, G;
    __device__ __forceinline__ bool next(int i, Unit& u) const { const int idx = c + i * G; if (c < 0 || idx >= NG * 3) return false; u.g = idx / 3; u.pm = idx % 3; u.pn = 0; return true; }
};

template <class Epi, class Sched, bool AROWPERM = false, int BAUX = 0, bool ZA = false>
__device__ __forceinline__ void gemm_phase(LAS unsigned char* lds, const int tid, const Gemm g, const Sched& S, const Epi& E) {
    const int wid = __builtin_amdgcn_readfirstlane(tid >> 6), lane = tid & 63, wr = wid >> 2, wc = wid & 3, fr = lane & 15, fq = lane >> 4;
    const int K = g.K, nt = K / BK;
    unsigned voffA[2], voffB[2];
#pragma unroll
    for (int i = 0; i < 2; ++i) { int R, C; stage_rc(tid * 16 + i * 8192, R, C); const int Rb = Epi::BLK2 ? ((R >> 5) * 64 + perm32(R & 31)) : Epi::PERM ? ((R & ~31) + perm32(R & 31)) : R;
        const int Ra = AROWPERM ? ((R & 64) + 4 * (R & 15) + ((R >> 4) & 3)) : R;
        voffA[i] = ZA ? (unsigned)((Ra >> 4) * 8192 + (C >> 4) * 256 + (Ra & 15) * 16 + (C & 15)) * 2u : (unsigned)(Ra * g.lda + C) * 2u; voffB[i] = (unsigned)(Rb * g.ldb + C) * 2u; }
    const size_t kstepB = (size_t)(BK * 2), kstepA = ZA ? (size_t)2048 : kstepB;
    const size_t hstepA = (size_t)HALF * g.lda * 2, hstepB = (size_t)(Epi::BLK2 ? 32 : HALF) * g.ldb * 2;
    const unsigned ldsw = (unsigned)wid * 1024u;
    const int aoff = lds_byte(wr * 64 + fr, fq * 8), boff = lds_byte(wc * 32 + fr, fq * 8);
#define PG8_SA(b, h) (((b) * 2 + (h)) * HTB)
#define PG8_SB(b, h) ((4 + (b) * 2 + (h)) * HTB)
#define PG8_STAGE(bufoff, gbase, voff) do { _Pragma("unroll") for (int _i = 0; _i < 2; ++_i) \
        __builtin_amdgcn_global_load_lds((const unsigned*)((const char*)(gbase) + (voff)[_i]), (LAS unsigned*)(lds + (bufoff) + ldsw + _i * 8192), 16, 0, 0); } while (0)
#define PG8_STAGEB(bufoff, gbase, voff) do { _Pragma("unroll") for (int _i = 0; _i < 2; ++_i) \
        __builtin_amdgcn_global_load_lds((const unsigned*)((const char*)(gbase) + (voff)[_i]), (LAS unsigned*)(lds + (bufoff) + ldsw + _i * 8192), 16, 0, BAUX); } while (0)
#define PG8_LDA(dst, b, h) do { _Pragma("unroll") for (int m = 0; m < 4; ++m) _Pragma("unroll") for (int k = 0; k < 2; ++k) dst[m][k] = *(const LAS bf16x8*)(lds + PG8_SA(b, h) + aoff + m * 2048 + k * 1024); } while (0)
#define PG8_LDB(dst, b, h) do { _Pragma("unroll") for (int n = 0; n < 2; ++n) _Pragma("unroll") for (int k = 0; k < 2; ++k) dst[n][k] = *(const LAS bf16x8*)(lds + PG8_SB(b, h) + boff + n * 2048 + k * 1024); } while (0)
#define PG8_MMA(ai, bj, At, Bt) do { __builtin_amdgcn_s_setprio(1); _Pragma("unroll") for (int m = 0; m < 4; ++m) _Pragma("unroll") for (int n = 0; n < 2; ++n) _Pragma("unroll") for (int k = 0; k < 2; ++k) \
        acc[ai][bj][m][n] = __builtin_amdgcn_mfma_f32_16x16x32_bf16(Bt[n][k], At[m][k], acc[ai][bj][m][n], 0, 0, 0); __builtin_amdgcn_s_setprio(0); } while (0)
#define PG8_WAIT_V(n) asm volatile("s_waitcnt vmcnt(" #n ")" ::: "memory")
#define PG8_WAIT_L(n) asm volatile("s_waitcnt lgkmcnt(" #n ")" ::: "memory")
#define PG8_BAR __builtin_amdgcn_s_barrier()
#define PG8_SCHED __builtin_amdgcn_sched_barrier(0)
#define PG8_APTR(u) ((const char*)g.A + ((size_t)(u).g * g.gsA + (size_t)(u).pm * BM * g.lda) * 2)
#define PG8_BPTR(u) ((const char*)g.Bt + ((size_t)(u).g * g.gsB + (size_t)(u).pn * BM * g.ldb) * 2)
    Unit cur, nxt; int ui = 0;
    if (!S.next(0, cur)) return;
#ifdef TPROBE_GID
#define PG8_TS(k) do { if (g.tsid == TPROBE_GID && wid == 0 && lane == 0) *(LAS unsigned long long*)(lds + LDSCTL_OFF + 8 * (k)) = __builtin_amdgcn_s_memrealtime(); } while (0)
#else
#define PG8_TS(k) do {} while (0)
#endif
    PG8_TS(0);
    f32x4 acc[2][2][4][2];
#pragma unroll
    for (int a = 0; a < 2; ++a)
#pragma unroll
        for (int b = 0; b < 2; ++b)
#pragma unroll
            for (int m = 0; m < 4; ++m)
#pragma unroll
                for (int n = 0; n < 2; ++n) acc[a][b][m][n] = (f32x4){0.f, 0.f, 0.f, 0.f};
    bf16x8 At[4][2], B0[2][2], B1[2][2];
    const char* cA = PG8_APTR(cur); const char* cB = PG8_BPTR(cur);
    PG8_STAGEB(PG8_SB(0, 0), cB, voffB); PG8_STAGEB(PG8_SB(0, 1), cB + hstepB, voffB); PG8_STAGE(PG8_SA(0, 0), cA, voffA); PG8_STAGE(PG8_SA(0, 1), cA + hstepA, voffA);
    if (wr == 1) PG8_BAR;
    PG8_WAIT_V(2); PG8_BAR;
    PG8_STAGEB(PG8_SB(1, 0), cB + kstepB, voffB); PG8_STAGE(PG8_SA(1, 0), cA + kstepA, voffA); PG8_STAGEB(PG8_SB(1, 1), cB + hstepB + kstepB, voffB);
    PG8_WAIT_V(6); PG8_BAR;
    for (;;) {
        const bool has_next = S.next(ui + 1, nxt);
        const char* nA = has_next ? PG8_APTR(nxt) : cA; const char* nB = has_next ? PG8_BPTR(nxt) : cB;
        for (int t = 0; t < nt; t += 2) {
            const bool last = (t == nt - 2);
            const char* a1 = cA + (size_t)(t + 1) * kstepA;
            const char* a2 = last ? nA : cA + (size_t)(t + 2) * kstepA; const char* b2 = last ? nB : cB + (size_t)(t + 2) * kstepB;
            const char* a3 = a2 + kstepA; const char* b3 = b2 + kstepB;
            PG8_LDB(B0, 0, 0); PG8_LDB(B1, 0, 1); PG8_SCHED; PG8_LDA(At, 0, 0); PG8_STAGE(PG8_SA(1, 1), a1 + hstepA, voffA);
            PG8_WAIT_V(8); PG8_WAIT_L(0); PG8_BAR; PG8_MMA(0, 0, At, B0); PG8_MMA(0, 1, At, B1); PG8_BAR; PG8_SCHED;
            PG8_LDA(At, 0, 1); PG8_STAGEB(PG8_SB(0, 0), b2, voffB); PG8_STAGEB(PG8_SB(0, 1), b2 + hstepB, voffB); PG8_STAGE(PG8_SA(0, 0), a2, voffA);
            PG8_WAIT_V(8); PG8_WAIT_L(0); PG8_BAR; PG8_MMA(1, 0, At, B0); PG8_MMA(1, 1, At, B1); PG8_BAR; PG8_SCHED;
            PG8_LDB(B0, 1, 0); PG8_LDB(B1, 1, 1); PG8_SCHED; PG8_LDA(At, 1, 0); PG8_STAGE(PG8_SA(0, 1), a2 + hstepA, voffA);
            PG8_WAIT_V(8); PG8_WAIT_L(0); PG8_BAR; PG8_MMA(0, 0, At, B0); PG8_MMA(0, 1, At, B1); PG8_BAR; PG8_SCHED;
            PG8_LDA(At, 1, 1); PG8_STAGEB(PG8_SB(1, 0), b3, voffB); PG8_STAGEB(PG8_SB(1, 1), b3 + hstepB, voffB); PG8_STAGE(PG8_SA(1, 0), a3, voffA);
            PG8_WAIT_V(8); PG8_WAIT_L(0); PG8_BAR; PG8_MMA(1, 0, At, B0); PG8_MMA(1, 1, At, B1); PG8_BAR; PG8_SCHED;
        }
        if (wr == 0) PG8_BAR;
        PG8_TS(1 + 2 * ui);
        { unsigned z_ = 0u; asm volatile("" : "+v"(z_)); const int l2 = (int)__builtin_amdgcn_mbcnt_hi(~0u, __builtin_amdgcn_mbcnt_lo(~0u, z_));
          E(acc, cur, wr, wc, l2 & 15, l2 >> 4);
          E.done(cur, l2); }
        PG8_TS(2 + 2 * ui);
        if (!has_next) break;
#pragma unroll
        for (int a = 0; a < 2; ++a)
#pragma unroll
            for (int b = 0; b < 2; ++b)
#pragma unroll
                for (int m = 0; m < 4; ++m)
#pragma unroll
                    for (int n = 0; n < 2; ++n) acc[a][b][m][n] = (f32x4){0.f, 0.f, 0.f, 0.f};
        cur = nxt; cA = nA; cB = nB; ++ui;
        if (wr == 1) PG8_BAR;
    }
    PG8_WAIT_V(0);
    PG8_BAR;
    PG8_TS(7);
#undef PG8_SA
#undef PG8_SB
#undef PG8_STAGE
#undef PG8_STAGEB
#undef PG8_LDA
#undef PG8_LDB
#undef PG8_MMA
#undef PG8_WAIT_V
#undef PG8_WAIT_L
#undef PG8_BAR
#undef PG8_SCHED
#undef PG8_TS
#undef PG8_APTR
#undef PG8_BPTR
}
__device__ __forceinline__ int cond_of_pm(int pm) { return pm < 16 ? 0 : 1 + ((pm - 16) >> 2); }
__device__ __forceinline__ int kvrow_of(int row) { return row < MC ? row : MC + ((row - MC) >> 10) * (PAST + DSEQ) + PAST + ((row - MC) & 1023); }
__device__ __forceinline__ u32x4 pack8(const f32x4& a, const f32x4& b) { u32x4 w; w.x = cvt_pk_bf16(a[0], a[1]); w.y = cvt_pk_bf16(a[2], a[3]); w.z = cvt_pk_bf16(b[0], b[1]); w.w = cvt_pk_bf16(b[2], b[3]); return w; }

struct EpiIn {
    static constexpr bool PERM = true; static constexpr bool BLK2 = false;
    const float* sumsq; const float* bias; const float* qn; const float* kn; const LAS f32x2* rope;
    bf16_t* Q; bf16_t* KB; bf16_t* VB; __amdgpu_buffer_rsrc_t as3r; float* new_k; float* new_v; int l; unsigned* ucnt;
    __device__ __forceinline__ void done(const Unit& u, int lane) const {
        if (u.pn >= 6) { asm volatile("s_waitcnt vmcnt(0)" ::: "memory"); if (lane == 0) __hip_atomic_fetch_add(ucnt + (((u.pm >> 4) * 2) + (u.pn - 6)) * 64, 1u, RLX_AGENT); } }
    __device__ __forceinline__ void operator()(const f32x4 (&acc)[2][2][4][2], const Unit& u, int wr, int wc, int fr, int fq) const {
        const int pm = u.pm, pn = u.pn; const bool ctx = pm < 16; const int cond = cond_of_pm(pm);
        const float* bz = bias + cond * 2048 + pn * 256 + wc * 32 + 8 * fq;
        f32x4 bv[2][2];
#pragma unroll
        for (int bj = 0; bj < 2; ++bj)
#pragma unroll
            for (int n = 0; n < 2; ++n) bv[bj][n] = *(const f32x4*)(bz + bj * 128 + 4 * n);
        const int rbase = pm * BM + wr * 64 + fr;
        float rsd[8];
#pragma unroll
        for (int g8 = 0; g8 < 8; ++g8) rsd[g8] = sumsq[rbase + (g8 >> 2) * HALF + (g8 & 3) * 16];
#pragma unroll
        for (int g8 = 0; g8 < 8; ++g8) rsd[g8] = rsqrtf(rsd[g8] * (1.f / DM) + EPS);
        if (pn < 4) {
            const bool isq = pn < 2; const float* gv = isq ? qn : kn;
            const int G = (pn & 1) * 4 + wc;
            const int cb = 32 * (fq >> 1) + 8 * (fq & 1);
            f32x4 gg[2][2];
#pragma unroll
            for (int bj = 0; bj < 2; ++bj)
#pragma unroll
                for (int n = 0; n < 2; ++n) gg[bj][n] = *(const f32x4*)(gv + cb + 16 * bj + 4 * n);
            const float qs = isq ? C2 : 1.f;
#pragma unroll
            for (int ai = 0; ai < 2; ++ai)
#pragma unroll
                for (int m = 0; m < 4; ++m) {
                    const int row = rbase + ai * HALF + m * 16;
                    const float rstd = rsd[ai * 4 + m];
                    f32x4 v[2][2]; float ss = 0.f;
#pragma unroll
                    for (int bj = 0; bj < 2; ++bj)
#pragma unroll
                        for (int n = 0; n < 2; ++n) { v[bj][n] = acc[ai][bj][m][n] * rstd + bv[bj][n]; const f32x4 t = v[bj][n] * v[bj][n]; ss += (t[0] + t[1]) + (t[2] + t[3]); }
                    { const int ln_ = fq * 16 + fr; ss += shfl_xor_l(ss, 16, ln_); ss += shfl_xor_l(ss, 32, ln_); }
                    const float rn = rsqrtf(ss * (1.f / 64.f) + EPS);
#pragma unroll
                    for (int bj = 0; bj < 2; ++bj)
#pragma unroll
                        for (int n = 0; n < 2; ++n) v[bj][n] = v[bj][n] * rn * gg[bj][n];
                    if (ctx) {
                        if (!isq) { float* nk = new_k + ((size_t)((row >> 8) * DEPTH + l) * SEQ + (row & 255)) * 512 + G * 64 + cb;
#pragma unroll
                            for (int bj = 0; bj < 2; ++bj) { __builtin_nontemporal_store(v[bj][0], (f32x4*)(nk + 16 * bj)); __builtin_nontemporal_store(v[bj][1], (f32x4*)(nk + 16 * bj + 4)); } }
                    } else {
                        const int t = (row - MC) & 1023; const int pos = (fq >> 1) ? (t & 63) : (t >> 6);
                        const LAS f32x2* rp = rope + pos * 17 + 8 * (fq & 1);
#pragma unroll
                        for (int n = 0; n < 2; ++n)
#pragma unroll
                            for (int j = 0; j < 4; ++j) { const f32x2 cs = rp[4 * n + j]; const float x1 = v[0][n][j], x2 = v[1][n][j]; v[0][n][j] = x1 * cs.x - x2 * cs.y; v[1][n][j] = x1 * cs.y + x2 * cs.x; }
                    }
                    bf16_t* dst = isq ? (Q + (size_t)row * 512) : (KB + (size_t)kvrow_of(row) * 512);
                    dst += G * 64 + cb;
#pragma unroll
                    for (int bj = 0; bj < 2; ++bj) *(u32x4*)(dst + 16 * bj) = pack8(v[bj][0] * qs, v[bj][1] * qs);
                }
        } else if (pn < 6) {
            const int col0 = (pn - 4) * 256 + wc * 32 + 8 * fq;
#pragma unroll
            for (int ai = 0; ai < 2; ++ai)
#pragma unroll
                for (int m = 0; m < 4; ++m) {
                    const int row = rbase + ai * HALF + m * 16;
                    const float rstd = rsd[ai * 4 + m];
                    bf16_t* dst = VB + (size_t)kvrow_of(row) * 512 + col0;
#pragma unroll
                    for (int bj = 0; bj < 2; ++bj) { const f32x4 a = acc[ai][bj][m][0] * rstd + bv[bj][0], b = acc[ai][bj][m][1] * rstd + bv[bj][1];
                        *(u32x4*)(dst + 128 * bj) = pack8(a, b);
                        if (ctx) { float* nv = new_v + ((size_t)((row >> 8) * DEPTH + l) * SEQ + (row & 255)) * 512 + col0 + 128 * bj; __builtin_nontemporal_store(a, (f32x4*)nv); __builtin_nontemporal_store(b, (f32x4*)(nv + 4)); } }
                }
        } else {
            const int cu0 = (pn - 6) * 256 + wc * 32 + 8 * fq;
#pragma unroll
            for (int ai = 0; ai < 2; ++ai)
#pragma unroll
                for (int m = 0; m < 4; ++m) {
                    const int row = rbase + ai * HALF + m * 16;
                    const float rstd = rsd[ai * 4 + m];
#pragma unroll
                    for (int bj = 0; bj < 2; ++bj) { const int cu = cu0 + 128 * bj; const f32x4 a = acc[ai][bj][m][0] * rstd + bv[bj][0], b = acc[ai][bj][m][1] * rstd + bv[bj][1];
                        __builtin_amdgcn_raw_buffer_store_b128(pack8(a, b), as3r, (int)(((unsigned)((cu >> 4) * NCHUNK + (row >> 4)) * 512u + (row & 15) * 16 + (cu & 15)) * 2u), 0,   16); }
                }
        }
    }
};
struct EpiS1 {
    static constexpr bool PERM = false; static constexpr bool BLK2 = false;
    bf16_t* E;
    __device__ __forceinline__ void done(const Unit&, int) const {}
    __device__ __forceinline__ void operator()(const f32x4 (&acc)[2][2][4][2], const Unit& u, int wr, int wc, int fr, int fq) const {
        const int rbase = u.pm * BM + wr * 64 + fr, col0 = wc * 32 + 4 * fq;
#pragma unroll
        for (int ai = 0; ai < 2; ++ai)
#pragma unroll
            for (int m = 0; m < 4; ++m) { bf16_t* dst = E + ((size_t)u.g * NCHUNK + rbase + ai * HALF + m * 16) * 256 + col0;
#pragma unroll
                for (int bj = 0; bj < 2; ++bj)
#pragma unroll
                    for (int n = 0; n < 2; ++n) { const f32x4 a = acc[ai][bj][m][n]; u32x2 w; w.x = cvt_pk_bf16(a[0], a[1]); w.y = cvt_pk_bf16(a[2], a[3]); *(u32x2*)(dst + bj * HALF + n * 16) = w; } }
    }
};
struct EpiS3 {
    static constexpr bool PERM = true; static constexpr bool BLK2 = false;
    __amdgpu_buffer_rsrc_t zr;
    __device__ __forceinline__ void done(const Unit&, int) const {}
    __device__ __forceinline__ void operator()(const f32x4 (&acc)[2][2][4][2], const Unit& u, int wr, int wc, int fr, int fq) const {
        const int rbase = u.pm * BM + wr * 64 + fr;
#pragma unroll
        for (int ai = 0; ai < 2; ++ai)
#pragma unroll
            for (int m = 0; m < 4; ++m) { const int chunk = rbase + ai * HALF + m * 16;
#pragma unroll
                for (int bj = 0; bj < 2; ++bj) { const int tt = 8 * bj + 2 * wc + (fq >> 1), c0 = 8 * (fq & 1);
                    f32x4 a = acc[ai][bj][m][0], b = acc[ai][bj][m][1];
#pragma unroll
                    for (int j = 0; j < 4; ++j) { a[j] = gelu_tanh_f(a[j]); b[j] = gelu_tanh_f(b[j]); }
                    __builtin_amdgcn_raw_buffer_store_b128(pack8(a, b), zr, (int)(((((unsigned)chunk * 32u + u.g) * 16u + tt) * 16u + c0) * 2u), 0,   16); } }
    }
};
struct EpiGlu {
    static constexpr bool PERM = true; static constexpr bool BLK2 = false;
    const bf16_t* Z; const float* bg; bf16_t* CAT;
    __device__ __forceinline__ void done(const Unit&, int) const {}
    __device__ __forceinline__ void operator()(const f32x4 (&acc)[2][2][4][2], const Unit& u, int wr, int wc, int fr, int fq) const {
        const int rbase = u.pm * BM + wr * 64 + fr, col0 = u.pn * BM + wc * 32 + 8 * fq;
        f32x4 bv[2][2];
#pragma unroll
        for (int bj = 0; bj < 2; ++bj)
#pragma unroll
            for (int n = 0; n < 2; ++n) bv[bj][n] = *(const f32x4*)(bg + col0 + bj * HALF + 4 * n);
#pragma unroll
        for (int ai = 0; ai < 2; ++ai)
#pragma unroll
            for (int m = 0; m < 4; ++m) { const int row = rbase + ai * HALF + m * 16;
#pragma unroll
                for (int bj = 0; bj < 2; ++bj) { const int cz = col0 + bj * HALF; const u32x4 zw = *(const u32x4*)(Z + ((size_t)(row >> 4) * 32 + (cz >> 4)) * 256 + (row & 15) * 16 + (cz & 15));
                    f32x4 a = acc[ai][bj][m][0] + bv[bj][0], b = acc[ai][bj][m][1] + bv[bj][1];
                    a[0] = bflo(zw.x) * sigmoid_f(a[0]); a[1] = bfhi(zw.x) * sigmoid_f(a[1]); a[2] = bflo(zw.y) * sigmoid_f(a[2]); a[3] = bfhi(zw.y) * sigmoid_f(a[3]);
                    b[0] = bflo(zw.z) * sigmoid_f(b[0]); b[1] = bfhi(zw.z) * sigmoid_f(b[1]); b[2] = bflo(zw.w) * sigmoid_f(b[2]); b[3] = bfhi(zw.w) * sigmoid_f(b[3]);
                    *(u32x4*)(CAT + (size_t)row * 1024 + 512 + col0 + bj * HALF) = pack8(a, b); } }
    }
};
template <bool IN_F32, bool OUT_F32> struct EpiRes {
    static constexpr bool PERM = true; static constexpr bool BLK2 = true;
    const float* xin0; const float* xin1;
    const bf16_t* xrin;
    float* xout; bf16_t* xrout;
    const float* gate;
    const float* gn; const float* sc;
    bf16_t* XS; float* ssq;
    __device__ __forceinline__ void done(const Unit&, int) const {}
    __device__ __forceinline__ void operator()(const f32x4 (&acc)[2][2][4][2], const Unit& u, int wr, int wc, int fr, int fq) const {
        const int pm = u.pm, cond = cond_of_pm(pm); const int col0 = u.pn * BM + wc * 64 + 8 * fq; const int rbase = pm * BM + wr * 64 + fr;
        const bool donorm = (gn != nullptr);
        f32x4 gt[2][2], gs[2][2];
#pragma unroll
        for (int bj = 0; bj < 2; ++bj)
#pragma unroll
            for (int n = 0; n < 2; ++n) { const int c = col0 + bj * 32 + n * 4; gt[bj][n] = *(const f32x4*)(gate + cond * 6144 + c);
                if (donorm) { const f32x4 g4 = *(const f32x4*)(gn + c), s4 = *(const f32x4*)(sc + cond * 6144 + c); gs[bj][n] = g4 * (s4 + 1.f); } else gs[bj][n] = (f32x4){0.f, 0.f, 0.f, 0.f}; }
        constexpr int RD = IN_F32 ? 2 : 4;
        f32x4 xr[RD][2][2]; u32x4 xb[RD][2];
#define ER_LOAD(G_, SLOT_) do { const int row_ = rbase + ((G_) >> 2) * HALF + ((G_) & 3) * 16; \
            if (IN_F32) { const float* xi_ = (row_ < MC) ? (xin0 + (size_t)row_ * DM) : (xin1 + (size_t)(row_ - MC) * DM); \
                _Pragma("unroll") for (int bj = 0; bj < 2; ++bj) { xr[SLOT_][bj][0] = *(const f32x4*)(xi_ + col0 + bj * 32); xr[SLOT_][bj][1] = *(const f32x4*)(xi_ + col0 + bj * 32 + 4); } } \
            else { _Pragma("unroll") for (int bj = 0; bj < 2; ++bj) xb[SLOT_][bj] = *(const u32x4*)(xrin + (size_t)row_ * DM + col0 + bj * 32); } } while (0)
#pragma unroll
        for (int g0 = 0; g0 < RD; ++g0) ER_LOAD(g0, g0);
        float ssv[8];
#pragma unroll
        for (int g = 0; g < 8; ++g) { const int ai = g >> 2, m = g & 3, sl = g % RD; const int row = rbase + ai * HALF + m * 16;
            float ss = 0.f; f32x4 x0[2], x1[2];
#pragma unroll
            for (int bj = 0; bj < 2; ++bj) { f32x4 a, b;
                if (IN_F32) { a = xr[sl][bj][0]; b = xr[sl][bj][1]; } else { const u32x4 w = xb[sl][bj]; a = (f32x4){bflo(w.x), bfhi(w.x), bflo(w.y), bfhi(w.y)}; b = (f32x4){bflo(w.z), bfhi(w.z), bflo(w.w), bfhi(w.w)}; }
                x0[bj] = a + gt[bj][0] * acc[ai][bj][m][0]; x1[bj] = b + gt[bj][1] * acc[ai][bj][m][1]; }
            if (g + RD < 8) ER_LOAD(g + RD, sl);
#pragma unroll
            for (int bj = 0; bj < 2; ++bj) { const int c = col0 + bj * 32;
                if (OUT_F32) { __builtin_nontemporal_store(x0[bj], (f32x4*)(xout + (size_t)row * DM + c)); __builtin_nontemporal_store(x1[bj], (f32x4*)(xout + (size_t)row * DM + c + 4)); }
                else *(u32x4*)(xrout + (size_t)row * DM + c) = pack8(x0[bj], x1[bj]);
                if (donorm) { const f32x4 t0 = x0[bj] * x0[bj], t1 = x1[bj] * x1[bj]; ss += ((t0[0] + t0[1]) + (t0[2] + t0[3])) + ((t1[0] + t1[1]) + (t1[2] + t1[3]));
                    *(u32x4*)(XS + (size_t)row * DM + c) = pack8(x0[bj] * gs[bj][0], x1[bj] * gs[bj][1]); } }
            if (donorm) { { const int ln_ = fq * 16 + fr; ss += shfl_xor_l(ss, 16, ln_); ss += shfl_xor_l(ss, 32, ln_); } ssv[g] = ss; }
        }
        if (donorm && fq == 0) {
#pragma unroll
            for (int g = 0; g < 8; ++g) atomicAdd(ssq + rbase + (g >> 2) * HALF + (g & 3) * 16, ssv[g]); }
#undef ER_LOAD
    }
};
struct EpiUp {
    static constexpr bool PERM = true; static constexpr bool BLK2 = false;
    const float* sumsq; const float* bias; bf16_t* UP;
    __device__ __forceinline__ void done(const Unit&, int) const {}
    __device__ __forceinline__ void operator()(const f32x4 (&acc)[2][2][4][2], const Unit& u, int wr, int wc, int fr, int fq) const {
        const int pm = u.pm, cond = cond_of_pm(pm); const int col0 = u.pn * BM + wc * 32 + 8 * fq; const int rbase = pm * BM + wr * 64 + fr;
        f32x4 bv[2][2];
#pragma unroll
        for (int bj = 0; bj < 2; ++bj)
#pragma unroll
            for (int n = 0; n < 2; ++n) bv[bj][n] = *(const f32x4*)(bias + cond * 4096 + col0 + bj * HALF + 4 * n);
#pragma unroll
        for (int ai = 0; ai < 2; ++ai)
#pragma unroll
            for (int m = 0; m < 4; ++m) { const int row = rbase + ai * HALF + m * 16; const float rstd = rsqrtf(sumsq[row] * (1.f / DM) + EPS);
#pragma unroll
                for (int bj = 0; bj < 2; ++bj) *(u32x4*)(UP + (size_t)row * 4096 + col0 + bj * HALF) = pack8(acc[ai][bj][m][0] * rstd + bv[bj][0], acc[ai][bj][m][1] * rstd + bv[bj][1]); }
    }
};

__device__ __forceinline__ float dpp_shr1(float v) { return __uint_as_float((unsigned)__builtin_amdgcn_update_dpp(0, (int)__float_as_uint(v), 0x111, 0xf, 0xf, false)); }
__device__ __forceinline__ float dpp_shl1(float v) { return __uint_as_float((unsigned)__builtin_amdgcn_update_dpp(0, (int)__float_as_uint(v), 0x101, 0xf, 0xf, false)); }
struct EpiUpConv {
    static constexpr bool PERM = true; static constexpr bool BLK2 = false;
    const float* sumsq; const float* bias; const float* cw; const float* cb; bf16_t* G; bf16_t* HALO;
    __device__ __forceinline__ void done(const Unit&, int) const {}
    __device__ __forceinline__ void operator()(const f32x4 (&acc)[2][2][4][2], const Unit& u, int wr, int wc, int fr, int fq) const {
        const int pm = u.pm, pn = u.pn, cond = cond_of_pm(pm);
        const int posv = pn * 256 + wc * 32 + 8 * fq, av = pn * 128 + wc * 32 + 8 * fq;
        float rs[2][4];
#pragma unroll
        for (int ai = 0; ai < 2; ++ai)
#pragma unroll
            for (int m = 0; m < 4; ++m) rs[ai][m] = sumsq[pm * BM + ai * HALF + wr * 64 + 4 * fr + m];
#pragma unroll
        for (int ai = 0; ai < 2; ++ai)
#pragma unroll
            for (int m = 0; m < 4; ++m) rs[ai][m] = rsqrtf(rs[ai][m] * (1.f / DM) + EPS);
#pragma unroll
        for (int n = 0; n < 2; ++n) {
            const int c = av + 4 * n;
            const f32x4 bvv = *(const f32x4*)(bias + cond * 4096 + posv + 4 * n), bvg = *(const f32x4*)(bias + cond * 4096 + posv + 128 + 4 * n);
            const f32x4 w0v = *(const f32x4*)(cw + c), w1v = *(const f32x4*)(cw + 4096 + c), w2v = *(const f32x4*)(cw + 8192 + c), cbv = *(const f32x4*)(cb + c);
            const f32x4 w0g = *(const f32x4*)(cw + 2048 + c), w1g = *(const f32x4*)(cw + 4096 + 2048 + c), w2g = *(const f32x4*)(cw + 8192 + 2048 + c), cbg = *(const f32x4*)(cb + 2048 + c);
#pragma unroll
            for (int ai = 0; ai < 2; ++ai) {
                const int tok0 = pm * BM + ai * HALF + wr * 64 + 4 * fr; const int sl = pm * 4 + ai * 2 + wr;
                f32x4 pv[4], pg[4];
#pragma unroll
                for (int m = 0; m < 4; ++m) { pv[m] = acc[ai][0][m][n] * rs[ai][m] + bvv; pg[m] = acc[ai][1][m][n] * rs[ai][m] + bvg; }
                f32x4 pvp, pvn, pgp, pgn;
#pragma unroll
                for (int j = 0; j < 4; ++j) { pvp[j] = dpp_shr1(pv[3][j]); pvn[j] = dpp_shl1(pv[0][j]); pgp[j] = dpp_shr1(pg[3][j]); pgn[j] = dpp_shl1(pg[0][j]); }
#pragma unroll
                for (int m = 0; m < 4; ++m) {
                    const f32x4 zv = cbv + w0v * (m == 0 ? pvp : pv[m == 0 ? 0 : m - 1]) + w1v * pv[m] + w2v * (m == 3 ? pvn : pv[m == 3 ? 3 : m + 1]);
                    const f32x4 zg = cbg + w0g * (m == 0 ? pgp : pg[m == 0 ? 0 : m - 1]) + w1g * pg[m] + w2g * (m == 3 ? pgn : pg[m == 3 ? 3 : m + 1]);
                    u32x2 w; w.x = cvt_pk_bf16(silu_f(zg[0]) * zv[0], silu_f(zg[1]) * zv[1]); w.y = cvt_pk_bf16(silu_f(zg[2]) * zv[2], silu_f(zg[3]) * zv[3]);
                    *(u32x2*)(G + (size_t)(tok0 + m) * 2048 + c) = w; }
                if (fr == 0 || fr == 15) { const int m0 = fr == 0 ? 0 : 2;
#pragma unroll
                    for (int mm = 0; mm < 2; ++mm) { const f32x4 a = fr == 0 ? pv[mm] : pv[2 + mm], b = fr == 0 ? pg[mm] : pg[2 + mm];
                        bf16_t* hp = HALO + ((size_t)sl * 4 + m0 + mm) * 4096 + posv + 4 * n;
                        u32x2 wa; wa.x = cvt_pk_bf16(a[0], a[1]); wa.y = cvt_pk_bf16(a[2], a[3]); *(u32x2*)hp = wa;
                        u32x2 wb; wb.x = cvt_pk_bf16(b[0], b[1]); wb.y = cvt_pk_bf16(b[2], b[3]); *(u32x2*)(hp + 128) = wb; } }
            }
        }
    }
};
constexpr int AT_SLOT = 32768, AT_NSLOT = 4, AT_VOFF = 16384, AT_X = 0, AT_ST = 65536;
__device__ __forceinline__ void glds16(const void* gsrc, unsigned lds_dst) { unsigned keep;
    asm volatile("s_mov_b32 %0, m0\n\ts_mov_b32 m0, %2\n\ts_nop 0\n\tglobal_load_lds_dwordx4 %1, off\n\ts_mov_b32 m0, %0" : "=&s"(keep) : "v"(gsrc), "s"(lds_dst) : "memory"); }
#define AT_WAIT_BAR(N) asm volatile("s_waitcnt vmcnt(" #N ") lgkmcnt(0)\n\ts_barrier" ::: "memory")
#define AT_SB() __builtin_amdgcn_sched_barrier(0)
__device__ __forceinline__ s16x4 vtr(const LAS char* p) { typedef short v4i16_t __attribute__((ext_vector_type(4))); return __builtin_bit_cast(s16x4, __builtin_amdgcn_ds_read_tr16_b64_v4i16((LAS v4i16_t*)p)); }
__device__ __forceinline__ int crow(int r, int hi) { return (r & 3) + 8 * (r >> 2) + 4 * hi; }

struct AttnArgs { const bf16_t* Q; const bf16_t* KB; const bf16_t* VB; bf16_t* CAT; const float* subln; float lam; float oml; };

__device__ __forceinline__ void attn_unit(LAS unsigned char* lds, const int tid, const AttnArgs& A, int seq, int h, int qblk) {
    const int lane = tid & 63, r32 = lane & 31, hi = lane >> 5; const int wid = __builtin_amdgcn_readfirstlane(tid >> 6);
    const int rg = wid & 3, s = wid >> 2;
    const bool ctx = seq < NB;
    const int qrow0 = ctx ? seq * SEQ + qblk * 128 : MC + (seq - NB) * DSEQ + qblk * 128;
    const int krow0 = ctx ? seq * SEQ : MC + (seq - NB) * (PAST + DSEQ);
    const int NT = ctx ? SEQ / 64 : (PAST + DSEQ) / 64;
    const unsigned lds0 = (unsigned)(uintptr_t)lds;
    const int krow_l = 8 * wid + (lane >> 4), kch0 = (lane & 15) ^ (krow_l & 15);
    const bf16_t* ksrc0 = A.KB + (size_t)(krow0 + krow_l) * 512 + h * 128 + kch0 * 8;
    const int kd1 = 4 * 512 + ((kch0 & 4) ? -32 : 32);
    const bf16_t* vsrc0 = A.VB + (size_t)(krow0 + 16 * (wid & 3) + (lane >> 2)) * 512 + h * 128 + (wid >> 2) * 32 + (lane & 3) * 8;
    const unsigned kdst = lds0 + wid * 2048, vdst = lds0 + AT_VOFF + ((wid >> 2) * 4 + (wid & 3)) * 1024;
#define AT_DMA(t, slot) do { const size_t _o = (size_t)(t) * 64 * 512; const unsigned _s = (unsigned)(slot) * AT_SLOT; \
        glds16(ksrc0 + _o, (unsigned)__builtin_amdgcn_readfirstlane(kdst + _s)); glds16(ksrc0 + _o + kd1, (unsigned)__builtin_amdgcn_readfirstlane(kdst + _s + 1024)); \
        glds16(vsrc0 + _o, (unsigned)__builtin_amdgcn_readfirstlane(vdst + _s)); glds16(vsrc0 + _o + 64, (unsigned)__builtin_amdgcn_readfirstlane(vdst + _s + 8 * 1024)); } while (0)
    AT_DMA(0, 0); AT_DMA(1, 1); AT_DMA(2, 2);
    bf16x8 qr[4];
    { const bf16_t* qp = A.Q + (size_t)(qrow0 + rg * 32 + r32) * 512 + h * 128 + s * 64 + hi * 8;
#pragma unroll
      for (int d0 = 0; d0 < 4; ++d0) qr[d0] = *(const bf16x8*)(qp + d0 * 16); }
    f32x16 o[4];
#pragma unroll
    for (int d0 = 0; d0 < 4; ++d0)
#pragma unroll
        for (int r = 0; r < 16; ++r) o[d0][r] = 0.f;
    float lsum = 0.f;
    const unsigned kb0 = (unsigned)(r32 * 256 + (((s * 8 + hi) ^ (r32 & 15)) << 4));
    const LAS char* kfrag0 = (const LAS char*)lds;
    const LAS char* vfrag0 = (const LAS char*)lds + AT_VOFF + ((lane >> 4) & 1) * 32 + (lane & 3) * 8 + (4 * hi + ((lane & 15) >> 2)) * 64;
    f32x16 pc0, pc1;
#define AT_KLOAD(kfr, slot) do { const LAS char* _k = kfrag0 + (slot) * AT_SLOT; _Pragma("unroll") for (int d0 = 0; d0 < 4; ++d0) { kfr[2 * d0] = *(const LAS bf16x8*)(_k + (kb0 ^ (unsigned)(d0 << 5))); kfr[2 * d0 + 1] = *(const LAS bf16x8*)(_k + (kb0 ^ (unsigned)(d0 << 5)) + 8192); } } while (0)
#define AT_VLOAD(vv, slot, ks) do { const LAS char* _v = vfrag0 + (slot) * AT_SLOT + (ks) * 1024; _Pragma("unroll") for (int d0 = 0; d0 < 4; ++d0) { const s16x4 lo = vtr(_v + d0 * 4096), hh = vtr(_v + d0 * 4096 + 512); \
        vv[d0] = (bf16x8){lo[0], lo[1], lo[2], lo[3], hh[0], hh[1], hh[2], hh[3]}; } } while (0)
#define AT_EXP2(P, i, W) do { P[2 * (i)] = fast_exp2(P[2 * (i)]); P[2 * (i) + 1] = fast_exp2(P[2 * (i) + 1]); sacc += P[2 * (i)] + P[2 * (i) + 1]; W = cvt_pk_bf16(P[2 * (i)], P[2 * (i) + 1]); } while (0)
    AT_WAIT_BAR(8);
    { bf16x8 kfr[8]; AT_KLOAD(kfr, 0);
#pragma unroll
      for (int r = 0; r < 16; ++r) { pc0[r] = 0.f; pc1[r] = 0.f; }
#pragma unroll
      for (int d0 = 0; d0 < 4; ++d0) { pc0 = __builtin_amdgcn_mfma_f32_32x32x16_bf16(kfr[2 * d0], qr[d0], pc0, 0, 0, 0); pc1 = __builtin_amdgcn_mfma_f32_32x32x16_bf16(kfr[2 * d0 + 1], qr[d0], pc1, 0, 0, 0); } }
    int slot = 0;
    for (int t = 0; t < NT; ++t) {
        const bool has_next = t + 1 < NT;
        if (t + 2 < NT) AT_WAIT_BAR(4); else AT_WAIT_BAR(0);
        if (t + 3 < NT) AT_DMA(t + 3, (slot + 3) & 3);
        const int slot_n = (slot + 1) & 3;
        bf16x8 kfr[8], va[4], vb[4]; u32x4 pw[4]; f32x16 pn0, pn1; float sacc = 0.f;
        const LAS char* kn_ = kfrag0 + slot_n * AT_SLOT;
#define AT_K1(d0) do { kfr[2 * (d0)] = *(const LAS bf16x8*)(kn_ + (kb0 ^ (unsigned)((d0) << 5))); kfr[2 * (d0) + 1] = *(const LAS bf16x8*)(kn_ + (kb0 ^ (unsigned)((d0) << 5)) + 8192); } while (0)
        if (has_next) { AT_K1(0); AT_K1(1); }
        AT_SB();
        if (has_next) {
#pragma unroll
            for (int r = 0; r < 16; ++r) { pn0[r] = 0.f; pn1[r] = 0.f; }
#pragma unroll
            for (int i = 0; i < 8; ++i) { const int d0 = i >> 1;
                if (i & 1) pn1 = __builtin_amdgcn_mfma_f32_32x32x16_bf16(kfr[2 * d0 + 1], qr[d0], pn1, 0, 0, 0); else pn0 = __builtin_amdgcn_mfma_f32_32x32x16_bf16(kfr[2 * d0], qr[d0], pn0, 0, 0, 0);
                AT_EXP2(pc0, i, pw[i >> 2][i & 3]);
                if (i == 0) AT_K1(2);
                if (i == 1) AT_K1(3);
                if (i == 3) AT_VLOAD(va, slot, 0);
                if (i == 5) AT_VLOAD(vb, slot, 1);
                AT_SB(); }
        } else {
            AT_VLOAD(va, slot, 0); AT_VLOAD(vb, slot, 1);
#pragma unroll
            for (int i = 0; i < 8; ++i) AT_EXP2(pc0, i, pw[i >> 2][i & 3]);
            AT_SB();
        }
        bf16x8 vc[4], vd[4];
#pragma unroll
        for (int i = 0; i < 8; ++i) { const int d0 = i & 3;
            if (i < 4) o[d0] = __builtin_amdgcn_mfma_f32_32x32x16_bf16(va[d0], __builtin_bit_cast(bf16x8, pw[0]), o[d0], 0, 0, 0);
            else       o[d0] = __builtin_amdgcn_mfma_f32_32x32x16_bf16(vb[d0], __builtin_bit_cast(bf16x8, pw[1]), o[d0], 0, 0, 0);
            AT_EXP2(pc1, i, pw[2 + (i >> 2)][i & 3]);
            if (i == 1) AT_VLOAD(vc, slot, 2);
            if (i == 5) AT_VLOAD(vd, slot, 3);
            AT_SB(); }
#pragma unroll
        for (int d0 = 0; d0 < 4; ++d0) o[d0] = __builtin_amdgcn_mfma_f32_32x32x16_bf16(vc[d0], __builtin_bit_cast(bf16x8, pw[2]), o[d0], 0, 0, 0);
#pragma unroll
        for (int d0 = 0; d0 < 4; ++d0) o[d0] = __builtin_amdgcn_mfma_f32_32x32x16_bf16(vd[d0], __builtin_bit_cast(bf16x8, pw[3]), o[d0], 0, 0, 0);
        lsum += sacc;
        if (has_next) { pc0 = pn0; pc1 = pn1; }
        slot = slot_n;
    }
    lsum += shfl_xor_l(lsum, 32, lane);
    const float inv = (s == 0 ? 1.f : A.lam) / lsum;
    AT_WAIT_BAR(0);
    LAS float* X = (LAS float*)(lds + AT_X) + rg * 4096;
    if (s == 1) {
#pragma unroll
        for (int d0 = 0; d0 < 4; ++d0)
#pragma unroll
            for (int r = 0; r < 16; ++r) X[(d0 * 16 + r) * 64 + lane] = o[d0][r] * inv;
    }
    AT_WAIT_BAR(0);
    if (s == 0) {
        float ss = 0.f;
#pragma unroll
        for (int d0 = 0; d0 < 4; ++d0)
#pragma unroll
            for (int r = 0; r < 16; ++r) { const float v = o[d0][r] * inv - X[(d0 * 16 + r) * 64 + lane]; o[d0][r] = v; ss += v * v; }
        ss += shfl_xor_l(ss, 32, lane);
        const float rn = rsqrtf(ss * (1.f / 128.f) + EPS) * A.oml;
        LAS bf16_t* stg = (LAS bf16_t*)(lds + AT_ST) + rg * (32 * 136);
#pragma unroll
        for (int d0 = 0; d0 < 4; ++d0)
#pragma unroll
            for (int rq = 0; rq < 4; ++rq) { const int dv = 32 * d0 + 8 * rq + 4 * hi; const f32x4 g4 = *(const f32x4*)(A.subln + dv);
                u32x2 w; w.x = cvt_pk_bf16(o[d0][4 * rq] * rn * g4[0], o[d0][4 * rq + 1] * rn * g4[1]); w.y = cvt_pk_bf16(o[d0][4 * rq + 2] * rn * g4[2], o[d0][4 * rq + 3] * rn * g4[3]);
                *(LAS u32x2*)(stg + r32 * 136 + dv) = w; }
        asm volatile("s_waitcnt lgkmcnt(0)" ::: "memory");
        bf16_t* dst = A.CAT + (size_t)(qrow0 + rg * 32) * 1024 + h * 128;
#pragma unroll
        for (int i = 0; i < 8; ++i) { const int row = i * 4 + (lane >> 4), ch = lane & 15; const u32x4 v = *(const LAS u32x4*)(stg + row * 136 + ch * 8); *(u32x4*)(dst + (size_t)row * 1024 + ch * 8) = v; }
    }
    AT_WAIT_BAR(0);
#undef AT_DMA
#undef AT_KLOAD
#undef AT_K1
#undef AT_VLOAD
#undef AT_EXP2
}
struct Args { const float* in[34]; float* out; unsigned char* ws; int stop_after; int pad; };
struct ArgsG { GAS const float* in[34]; GAS float* out; GAS unsigned char* ws; int stop_after; int pad; };
typedef const __attribute__((address_space(4))) ArgsG* kargs_t;
struct Frame {
    LAS unsigned char* lds; int tid, lane, wave, vcu, bid, G;
    kargs_t ka; float* out; unsigned char* ws;
    float* misc; unsigned* ctl;
};
#define LDS_WAIT() asm volatile("s_waitcnt lgkmcnt(0)" ::: "memory")
#define VM_WAIT() asm volatile("s_waitcnt vmcnt(0)" ::: "memory")

template <int MAP> __device__ __forceinline__ int src_col(int p);
template <int MODE, int MAP, int NC> __device__ __forceinline__ void gemv9_task(Frame& F, const float* W, int ldw, int l, int voff, int strip, float* out, int ldo, const float* add) {
    LAS float* sc = (LAS float*)F.lds; LAS float* red = sc + 9 * 1024;
    for (int i = F.tid; i < 9 * 1024; i += NTHREADS) { const int cond = i >> 10, k = i & 1023; float v;
        if (MODE == 0) { v = cond == 0 ? ((const float*)F.ka->in[6])[k] : ((const float*)F.ka->in[5])[(cond - 1) * 1024 + k]; v = v / (1.f + expf(-v)); } else v = F.misc[MI_MOD + (l * 9 + cond) * 6144 + voff + k];
        sc[i] = v; }
    __syncthreads();
    const int j = strip * NC + (F.lane < NC ? F.lane : NC - 1); const float* w = W + (size_t)(F.wave * 128) * ldw + src_col<MAP>(j);
    float acc[9];
#pragma unroll
    for (int b = 0; b < 9; ++b) acc[b] = 0.f;
#pragma unroll 16
    for (int k = 0; k < 128; ++k) { const float wv = w[(size_t)k * ldw];
#pragma unroll
        for (int b = 0; b < 9; ++b) acc[b] += sc[b * 1024 + F.wave * 128 + k] * wv; }
#pragma unroll
    for (int b = 0; b < 9; ++b) red[(F.wave * 9 + b) * 64 + F.lane] = acc[b];
    __syncthreads();
    for (int i = F.tid; i < 9 * 64; i += NTHREADS) { const int b = i >> 6, ln = i & 63; if (ln >= NC) continue; float s_ = 0.f;
#pragma unroll
        for (int w8 = 0; w8 < 8; ++w8) s_ += red[(w8 * 9 + b) * 64 + ln];
        const int jj = strip * NC + ln; out[(size_t)b * ldo + jj] = s_ + (add ? add[jj] : 0.f); }
    __syncthreads();
}
template <int MAP> __device__ __forceinline__ int src_col(int p) {
    if (MAP == 1) { if (p >= 1024) return p; const int pn = p >> 8, r = p & 255, bj = r >> 7, wc = (r >> 5) & 3, fq = (r >> 3) & 3, low = r & 7; return 256 * pn + 64 * wc + 32 * (fq >> 1) + 16 * bj + 8 * (fq & 1) + low; }
    if (MAP == 2) { const int pn = p >> 8, bj = (p >> 7) & 1, r = p & 127; return bj * 2048 + 128 * pn + r; }
    return p;
}
__device__ __forceinline__ void mod_task3(Frame& F, int task) {
    const int l = task / 96, r = task % 96, kq = r / 24, cg = r % 24;
    LAS float* sc = (LAS float*)F.lds; LAS float* red = sc + 9 * 256;
    for (int i = F.tid; i < 9 * 256; i += NTHREADS) { const int cond = i >> 8, k = kq * 256 + (i & 255); const float v = cond == 0 ? ((const float*)F.ka->in[6])[k] : ((const float*)F.ka->in[5])[(cond - 1) * 1024 + k]; sc[i] = v / (1.f + expf(-v)); }
    __syncthreads();
    const float* w = ((const float*)F.ka->in[7]) + ((size_t)l * DM + kq * 256 + F.wave * 32) * 6144 + cg * 256 + F.lane * 4;
    f32x4 acc[9];
#pragma unroll
    for (int b = 0; b < 9; ++b) acc[b] = (f32x4){0.f, 0.f, 0.f, 0.f};
#pragma unroll
    for (int h = 0; h < 2; ++h) { f32x4 wv[16];
#pragma unroll
        for (int k = 0; k < 16; ++k) wv[k] = __builtin_nontemporal_load((const f32x4*)(w + (size_t)(h * 16 + k) * 6144));
#pragma unroll
        for (int k = 0; k < 16; ++k)
#pragma unroll
            for (int b = 0; b < 9; ++b) acc[b] += wv[k] * sc[b * 256 + F.wave * 32 + h * 16 + k]; }
#pragma unroll
    for (int b = 0; b < 9; ++b) *(LAS f32x4*)(red + (F.wave * 9 + b) * 256 + F.lane * 4) = acc[b];
    __syncthreads();
    for (int i = F.tid; i < 9 * 256; i += NTHREADS) { const int b = i >> 8, c = i & 255; float v = 0.f;
#pragma unroll
        for (int w8 = 0; w8 < 8; ++w8) v += red[(w8 * 9 + b) * 256 + c];
        const int col = cg * 256 + c; if (kq == 0) v += ((const float*)F.ka->in[8])[l * 6144 + col];
        atomicAdd(F.misc + MI_MOD + (l * 9 + b) * 6144 + col, v); }
    __syncthreads();
}
template <int MAP, bool BIAS> __device__ __forceinline__ void transpose_item(Frame& F, const float* W, int K, int N, bf16_t* WT, LAS float* scr, int item, const float* shv, float* bias) {
    const int lane = F.lane; const int nblk = N / 64, kb = item / nblk, nb = item % nblk, k0 = 64 * kb, n0 = 64 * nb;
    const int sc_ = src_col<MAP>(n0 + lane);
    float tv[64];
#pragma unroll
    for (int i = 0; i < 64; ++i) tv[i] = __builtin_nontemporal_load(W + (size_t)(k0 + i) * N + sc_);
#pragma unroll
    for (int i = 0; i < 64; ++i) scr[i * 65 + lane] = tv[i];
    LDS_WAIT(); asm volatile("" ::: "memory");
    const int c = lane & 7;
#pragma unroll
    for (int j = 0; j < 8; ++j) { const int n = (lane >> 3) + 8 * j; const LAS float* s_ = scr + (8 * c) * 65 + n;
        u32x4 o; o.x = cvt_pk_bf16(s_[0 * 65], s_[1 * 65]); o.y = cvt_pk_bf16(s_[2 * 65], s_[3 * 65]); o.z = cvt_pk_bf16(s_[4 * 65], s_[5 * 65]); o.w = cvt_pk_bf16(s_[6 * 65], s_[7 * 65]);
        *(u32x4*)(WT + (size_t)(n0 + n) * K + k0 + 8 * c) = o; }
    if (BIAS) {
        float sh[9], acc[9];
#pragma unroll
        for (int b = 0; b < 9; ++b) { sh[b] = shv[b * 6144 + k0 + lane]; acc[b] = 0.f; }
#pragma unroll
        for (int kk = 0; kk < 64; ++kk) { const float w = tv[kk];
#pragma unroll
            for (int b = 0; b < 9; ++b) acc[b] += __uint_as_float(__builtin_amdgcn_readlane(__float_as_uint(sh[b]), kk)) * w; }
#pragma unroll
        for (int b = 0; b < 9; ++b) atomicAdd(bias + (size_t)b * N + n0 + lane, acc[b]);
    }
    LDS_WAIT(); asm volatile("" ::: "memory");
}
__device__ __forceinline__ void cache_item(Frame& F, int l, int item4) {
    f32x4 a[4], c[4];
#pragma unroll
    for (int i = 0; i < 4; ++i) { const int item = item4 * 4 + i, which = item >> 12, r = item & 4095, b = r >> 9, j = r & 511;
        const float* src = (which ? ((const float*)F.ka->in[3]) : ((const float*)F.ka->in[2])) + ((size_t)(b * DEPTH + l) * PAST + j) * 512 + F.lane * 8; a[i] = __builtin_nontemporal_load((const f32x4*)src); c[i] = __builtin_nontemporal_load((const f32x4*)(src + 4)); }
#pragma unroll
    for (int i = 0; i < 4; ++i) { const int item = item4 * 4 + i, which = item >> 12, r = item & 4095, b = r >> 9, j = r & 511;
        bf16_t* dst = (bf16_t*)(F.ws + (which ? WS_VB : WS_KB)) + (size_t)(MC + b * (PAST + DSEQ) + j) * 512 + F.lane * 8; *(u32x4*)dst = pack8(a[i], c[i]); }
}
__device__ __forceinline__ f32x2 cmul(f32x2 a, f32x2 b) { return (f32x2){a.x * b.x - a.y * b.y, a.x * b.y + a.y * b.x}; }
__device__ __forceinline__ void ssm_prep(Frame& F, int l, int task) {
    const int g = task >> 1, half = task & 1;
    LAS f32x2* POW = (LAS f32x2*)F.lds;
    LAS f32x2* BB = POW + 2 * 17 * 64;
    LAS f32x2* CC = BB + 2 * 64 * 16;
    LAS f32x2* CT = CC + 2 * 16 * 64;
    LAS float* KT = (LAS float*)(CT + 2 * 64 * 16);
    constexpr int KTS = 260;
    bf16_t* WE = (bf16_t*)(F.ws + WS_SSM + SSM_WE) + (size_t)g * 256 * 256;
    bf16_t* WY = (bf16_t*)(F.ws + WS_SSM + SSM_WY) + (size_t)g * 256 * 512;
    f32x2* LAM16 = (f32x2*)(F.ws + WS_SSM + SSM_LAM16); f32x2* BBAR = (f32x2*)(F.ws + WS_SSM + SSM_BBAR);
    const int tid = F.tid, lane = F.lane;
    if (tid < 128) { const int dir = tid >> 6, p = tid & 63; const size_t pi = ((size_t)(l * 2 + dir) * NG + g) * 64 + p;
        const float lr = ((const float*)F.ka->in[18])[pi], li = ((const float*)F.ka->in[19])[pi], delta = expf(((const float*)F.ka->in[20])[(l * 2 + dir) * NG + g]);
        const float er = expf(lr * delta), lbr = er * cosf(li * delta), lbi = er * sinf(li * delta);
        { float one_ = 1.f, zero_ = 0.f; asm volatile("" : "+v"(one_), "+v"(zero_));
          f32x2 pw = (f32x2){one_, zero_}; const f32x2 lb = (f32x2){lbr, lbi};
          for (int tau = 0; tau <= 16; ++tau) { POW[(dir * 17 + tau) * 64 + p] = pw; if (tau == 16 && half == 0) LAM16[(dir * NG + g) * 64 + p] = pw; pw = cmul(pw, lb); } }
        const float nr = lbr - 1.f, ni = lbi, den = lr * lr + li * li; const f32x2 fac = (f32x2){(nr * lr + ni * li) / den, (ni * lr - nr * li) / den};
        f32x4 br[4], bi4[4];
#pragma unroll
        for (int q = 0; q < 4; ++q) { br[q] = *(const f32x4*)(((const float*)F.ka->in[21]) + pi * 16 + 4 * q); bi4[q] = *(const f32x4*)(((const float*)F.ka->in[22]) + pi * 16 + 4 * q); }
#pragma unroll
        for (int ch = 0; ch < 16; ++ch) { const f32x2 bb = cmul(fac, (f32x2){br[ch >> 2][ch & 3], bi4[ch >> 2][ch & 3]}); BB[(dir * 64 + p) * 16 + ch] = bb; if (half == 0) BBAR[((size_t)(dir * NG + g) * 64 + p) * 16 + ch] = bb; }
    }
    { f32x2 cv[4];
#pragma unroll
      for (int q = 0; q < 4; ++q) { const int i = tid + q * NTHREADS, dir = i >> 10, c = (i >> 6) & 15, p = i & 63; const size_t ci = (((size_t)(l * 2 + dir) * NG + g) * 16 + c) * 64 + p; cv[q] = (f32x2){((const float*)F.ka->in[23])[ci], ((const float*)F.ka->in[24])[ci]}; }
#pragma unroll
      for (int q = 0; q < 4; ++q) { const int i = tid + q * NTHREADS, dir = i >> 10, c = (i >> 6) & 15, p = i & 63; CC[i] = cv[q]; CT[(dir * 64 + p) * 16 + c] = cv[q]; } }
    __syncthreads();
    { const int i16 = lane & 15, k4 = lane >> 4, ri = k4 & 1, ph = k4 >> 1;
      for (int blk = 0; blk < 4; ++blk) { const int q = F.wave * 4 + blk, dir = q >> 4, tau = q & 15; f32x4 acc = (f32x4){0.f, 0.f, 0.f, 0.f};
#pragma unroll 8
          for (int ks = 0; ks < 32; ++ks) { const int p = 2 * ks + ph;
              const f32x2 cc = CT[(dir * 64 + p) * 16 + i16], pw = POW[(dir * 17 + tau) * 64 + p], bb = BB[(dir * 64 + p) * 16 + i16];
              const float u = ri ? -pw.y : pw.x, v = ri ? pw.x : pw.y;
              const float av = cc.x * u - cc.y * v, bv = ri ? bb.y : bb.x;
              acc = __builtin_amdgcn_mfma_f32_16x16x4f32(av, bv, acc, 0, 0, 0); }
#pragma unroll
          for (int r = 0; r < 4; ++r) KT[(dir * 16 + tau) * KTS + (k4 * 4 + r) * 16 + i16] = acc[r]; } }
    __syncthreads();
    const float* Dv = ((const float*)F.ka->in[25]) + l * 512 + g * 16;
    for (int idx = half * 8192 + tid; idx < (half + 1) * 8192; idx += NTHREADS) { const int n = idx >> 6, kc = idx & 63, k0 = kc * 8, i = n >> 4, c = n & 15; f32x4 v0, v1;
        if (k0 < 256) { const int s_ = k0 >> 4, ch0 = k0 & 15; v0 = (f32x4){0.f, 0.f, 0.f, 0.f}; v1 = v0;
            if (s_ <= i) { const LAS float* kp = KT + (i - s_) * KTS + c * 16 + ch0; v0 += *(const LAS f32x4*)kp; v1 += *(const LAS f32x4*)(kp + 4); }
            if (s_ >= i) { const LAS float* kp = KT + (16 + s_ - i) * KTS + c * 16 + ch0; v0 += *(const LAS f32x4*)kp; v1 += *(const LAS f32x4*)(kp + 4); }
            if (s_ == i) { const int e = c - ch0; const float dv = Dv[c]; if (e >= 0 && e < 4) v0[e] += dv; else if (e >= 4 && e < 8) v1[e - 4] += dv; }
        } else { const int dir = k0 >= 384 ? 1 : 0, p0 = ((k0 - 256) & 127) >> 1, tau = dir ? 16 - i : i + 1;
            const LAS f32x4* cp = (const LAS f32x4*)(CC + (dir * 16 + c) * 64 + p0); const LAS f32x4* pp = (const LAS f32x4*)(POW + (dir * 17 + tau) * 64 + p0);
            const f32x4 c0 = cp[0], c1 = cp[1], w0 = pp[0], w1 = pp[1];
            v0 = (f32x4){c0[0] * w0[0] - c0[1] * w0[1], -(c0[0] * w0[1] + c0[1] * w0[0]), c0[2] * w0[2] - c0[3] * w0[3], -(c0[2] * w0[3] + c0[3] * w0[2])};
            v1 = (f32x4){c1[0] * w1[0] - c1[1] * w1[1], -(c1[0] * w1[1] + c1[1] * w1[0]), c1[2] * w1[2] - c1[3] * w1[3], -(c1[2] * w1[3] + c1[3] * w1[2])}; }
        *(u32x4*)(WY + (size_t)n * 512 + k0) = pack8(v0, v1); }
    for (int idx = half * 4096 + tid; idx < (half + 1) * 4096; idx += NTHREADS) { const int n = idx >> 5, k0 = (idx & 31) * 8, dir = n >> 7, p = (n & 127) >> 1, ri = n & 1, s_ = k0 >> 4, ch0 = k0 & 15;
        const f32x2 pw = POW[(dir * 17 + (dir ? s_ : 15 - s_)) * 64 + p]; const LAS f32x4* bp = (const LAS f32x4*)(BB + (dir * 64 + p) * 16 + ch0);
        const float u = ri ? pw.y : pw.x, v = ri ? pw.x : -pw.y;
        const f32x4 b0 = bp[0], b1 = bp[1], b2 = bp[2], b3 = bp[3];
        const f32x4 v0 = (f32x4){u * b0[0] + v * b0[1], u * b0[2] + v * b0[3], u * b1[0] + v * b1[1], u * b1[2] + v * b1[3]};
        const f32x4 v1 = (f32x4){u * b2[0] + v * b2[1], u * b2[2] + v * b2[3], u * b3[0] + v * b3[1], u * b3[2] + v * b3[3]};
        *(u32x4*)(WE + (size_t)n * 256 + k0) = pack8(v0, v1); }
    __syncthreads();
}
template <int NR> __device__ __forceinline__ void xprep_item(Frame& F, int itemn) {
    f32x4 xv[NR][4];
#pragma unroll
    for (int i = 0; i < NR; ++i) { const int row = itemn * NR + i; const float* xr = (row < MC) ? ((const float*)F.ka->in[0]) + (size_t)row * DM : ((const float*)F.ka->in[1]) + (size_t)(row - MC) * DM;
#pragma unroll
        for (int j = 0; j < 4; ++j) xv[i][j] = __builtin_nontemporal_load((const f32x4*)(xr + 4 * F.lane + 256 * j)); }
    const int cond = itemn * NR < MC ? 0 : 1 + ((itemn * NR - MC) >> 10);
    const float* sc = F.misc + MI_MOD + (0 * 9 + cond) * 6144 + 1024; const float* g1 = ((const float*)F.ka->in[9]);
    f32x4 gs[4];
#pragma unroll
    for (int j = 0; j < 4; ++j) { const int c = 4 * F.lane + 256 * j; gs[j] = (*(const f32x4*)(g1 + c)) * (*(const f32x4*)(sc + c) + 1.f); }
#pragma unroll
    for (int i = 0; i < NR; ++i) { const int row = itemn * NR + i; bf16_t* dst = (bf16_t*)(F.ws + WS_XS) + (size_t)row * DM; float s = 0.f;
#pragma unroll
        for (int j = 0; j < 4; ++j) { const f32x4 x = xv[i][j]; const f32x4 t = x * x; s += (t[0] + t[1]) + (t[2] + t[3]); const f32x4 y = x * gs[j];
            u32x2 w; w.x = cvt_pk_bf16(y[0], y[1]); w.y = cvt_pk_bf16(y[2], y[3]); *(u32x2*)(dst + 4 * F.lane + 256 * j) = w;
            u32x2 r; r.x = cvt_pk_bf16(x[0], x[1]); r.y = cvt_pk_bf16(x[2], x[3]); *(u32x2*)((bf16_t*)(F.ws + WS_XR) + (size_t)row * DM + 4 * F.lane + 256 * j) = r; }
        s = wave_sum(s, F.lane);
        if (F.lane == 0) ((float*)(F.ctl + CW_SS))[row] = s; }
}
__device__ __forceinline__ void bias_item(Frame& F, int item) {
    const int which = item >= 2048, n = which ? item - 2048 : item;
    const bf16_t* wrow = (const bf16_t*)(F.ws + (which ? WS_WUP : WS_WIN)) + (size_t)n * DM;
    float wv[16]; { const u32x4 a = *(const u32x4*)(wrow + F.lane * 8), b = *(const u32x4*)(wrow + 512 + F.lane * 8);
        wv[0] = bflo(a.x); wv[1] = bfhi(a.x); wv[2] = bflo(a.y); wv[3] = bfhi(a.y); wv[4] = bflo(a.z); wv[5] = bfhi(a.z); wv[6] = bflo(a.w); wv[7] = bfhi(a.w);
        wv[8] = bflo(b.x); wv[9] = bfhi(b.x); wv[10] = bflo(b.y); wv[11] = bfhi(b.y); wv[12] = bflo(b.z); wv[13] = bfhi(b.z); wv[14] = bflo(b.w); wv[15] = bfhi(b.w); }
    float outv = 0.f;
#pragma unroll
    for (int cond = 0; cond < 9; ++cond) { const float* sh = F.misc + MI_MOD + cond * 6144 + (which ? 3072 : 0);
        const f32x4 s0 = *(const f32x4*)(sh + F.lane * 8), s1 = *(const f32x4*)(sh + F.lane * 8 + 4), s2 = *(const f32x4*)(sh + 512 + F.lane * 8), s3 = *(const f32x4*)(sh + 512 + F.lane * 8 + 4);
        float d = 0.f;
#pragma unroll
        for (int e = 0; e < 4; ++e) d += s0[e] * wv[e] + s1[e] * wv[4 + e] + s2[e] * wv[8 + e] + s3[e] * wv[12 + e];
        d = wave_sum(d, F.lane); if (F.lane == cond) outv = d; }
    if (F.lane < 9) ((float*)F.ctl)[(which ? CW_BUP + F.lane * 4096 : CW_BIN + F.lane * 2048) + n] = outv;
}
__device__ __forceinline__ void ssm_scan(Frame& F, int l, int g, int pm) {
    const int tid = F.tid, sl = tid >> 7, dp = tid & 127, dir = dp >> 6, p = dp & 63;
    const f32x2* LAM16 = (const f32x2*)(F.ws + WS_SSM + SSM_LAM16); const f32x2* BBAR = (const f32x2*)(F.ws + WS_SSM + SSM_BBAR);
    const bf16_t* E = (const bf16_t*)(F.ws + WS_R + R_E); bf16_t* AS3 = (bf16_t*)(F.ws + WS_R + R_AS3);
    const f32x2 lam = LAM16[(dir * NG + g) * 64 + p];
    f32x2 e[64];
    if (pm == 0) {
#pragma unroll
        for (int q = 0; q < 4; ++q) { const bf16_t* ep = E + ((size_t)g * NCHUNK + (q * 4 + sl) * 16) * 256 + dir * 128 + 2 * p;
#pragma unroll
            for (int j = 0; j < 16; ++j) { const unsigned w = *(const unsigned*)(ep + (size_t)j * 256); e[q * 16 + j] = (f32x2){bflo(w), bfhi(w)}; } }
    } else { const bf16_t* ep = E + ((size_t)g * NCHUNK + 256 + ((pm - 1) * 4 + sl) * 64) * 256 + dir * 128 + 2 * p;
#pragma unroll
        for (int j = 0; j < 64; ++j) { const unsigned w = *(const unsigned*)(ep + (size_t)j * 256); e[j] = (f32x2){bflo(w), bfhi(w)}; } }
    const int nq = pm == 0 ? 4 : 1;
#pragma unroll
    for (int q = 0; q < 4; ++q) { if (q >= nq) break;
        int base; f32x2 h;
        if (pm == 0) { const int seq = q * 4 + sl; base = seq * 16; h = (f32x2){0.f, 0.f}; }
        else { const int sq = (pm - 1) * 4 + sl; base = 256 + sq * 64; h = *(const f32x2*)(((const float*)F.ka->in[4]) + ((((size_t)sq * DEPTH + l) * 2 + dir) * NG + g) * 128 + 2 * p); }
        unsigned* hp = (unsigned*)(AS3 + ((size_t)g * NCHUNK + base) * 512 + 256 + dir * 128 + 2 * p);
        if (pm == 0) {
#pragma unroll
            for (int jj = 0; jj < 16; ++jj) { const int j = dir ? 15 - jj : jj; const f32x2 ev = dir ? e[q * 16 + 15 - jj] : e[q * 16 + jj]; hp[(size_t)j * 256] = cvt_pk_bf16(h.x, h.y); h = cmul(lam, h) + ev; }
        } else {
#pragma unroll
            for (int jj = 0; jj < 64; ++jj) { const int j = dir ? 63 - jj : jj; const f32x2 ev = dir ? e[63 - jj] : e[jj]; hp[(size_t)j * 256] = cvt_pk_bf16(h.x, h.y); h = cmul(lam, h) + ev; }
        }
    }
    if (pm == 0) {
        const int tt = dir ? 15 : 0; u32x4 uq[4][2]; f32x2 bbv[16];
        const f32x2* bb = BBAR + ((size_t)(dir * NG + g) * 64 + p) * 16;
#pragma unroll
        for (int ch = 0; ch < 16; ++ch) bbv[ch] = bb[ch];
#pragma unroll
        for (int q = 0; q < 4; ++q) { const int chunk = (q * 4 + sl) * 16 + tt; const bf16_t* up = AS3 + ((size_t)g * NCHUNK + chunk) * 512 + tt * 16; uq[q][0] = *(const u32x4*)up; uq[q][1] = *(const u32x4*)(up + 8); }
        float* ns = F.out + (size_t)MT * DM + 2 * (size_t)NB * DEPTH * SEQ * 512;
#pragma unroll
        for (int q = 0; q < 4; ++q) { const int seq = q * 4 + sl; const u32x4 u0 = uq[q][0], u1 = uq[q][1];
            const float uu[16] = {bflo(u0.x), bfhi(u0.x), bflo(u0.y), bfhi(u0.y), bflo(u0.z), bfhi(u0.z), bflo(u0.w), bfhi(u0.w), bflo(u1.x), bfhi(u1.x), bflo(u1.y), bfhi(u1.y), bflo(u1.z), bfhi(u1.z), bflo(u1.w), bfhi(u1.w)};
            f32x2 acc = (f32x2){0.f, 0.f};
#pragma unroll
            for (int ch = 0; ch < 16; ++ch) acc += bbv[ch] * uu[ch];
            *(f32x2*)(ns + ((((size_t)seq * DEPTH + l) * 2 + dir) * NG + g) * 128 + 2 * p) = acc; }
    }
}
__device__ __forceinline__ void ld16(const bf16_t* p, float* v) { const u32x4 a = *(const u32x4*)p; v[0] = bflo(a.x); v[1] = bfhi(a.x); v[2] = bflo(a.y); v[3] = bfhi(a.y); v[4] = bflo(a.z); v[5] = bfhi(a.z); v[6] = bflo(a.w); v[7] = bfhi(a.w); }
__device__ __forceinline__ void conv_item(Frame& F, int l, int item) {
    const int rs = item >> 4, pn = item & 15, lr = F.lane >> 4, lc = F.lane & 15;
    const int r0 = rs * 64 + lr * 16; const int av = 128 * pn + 8 * lc;
    const bf16_t* up = (const bf16_t*)(F.ws + WS_R) + (size_t)r0 * 4096 + 256 * pn + 8 * lc; bf16_t* gp = (bf16_t*)(F.ws + WS_G) + (size_t)r0 * 2048 + av;
    const float* cw = ((const float*)F.ka->in[31]) + (size_t)l * 3 * 4096; const float* cb = ((const float*)F.ka->in[32]) + (size_t)l * 4096;
    float wv[3][8], wg[3][8], bv[8], bg[8];
#pragma unroll
    for (int k = 0; k < 3; ++k)
#pragma unroll
        for (int e = 0; e < 8; ++e) { wv[k][e] = cw[k * 4096 + av + e]; wg[k][e] = cw[k * 4096 + 2048 + av + e]; }
#pragma unroll
    for (int e = 0; e < 8; ++e) { bv[e] = cb[av + e]; bg[e] = cb[2048 + av + e]; }
    const int t0 = r0 < MC ? (r0 & 255) : ((r0 - MC) & 1023), L = r0 < MC ? SEQ : DSEQ;
    float pv[8], pg[8], cv[8], cg[8], nv_[8], ng[8];
    if (t0 > 0) { ld16(up - 4096, pv); ld16(up - 4096 + 128, pg); } else {
#pragma unroll
        for (int e = 0; e < 8; ++e) { pv[e] = 0.f; pg[e] = 0.f; } }
    ld16(up, cv); ld16(up + 128, cg);
#pragma unroll
    for (int i = 0; i < 16; ++i) {
        if (t0 + i + 1 < L) { ld16(up + (size_t)(i + 1) * 4096, nv_); ld16(up + (size_t)(i + 1) * 4096 + 128, ng); } else {
#pragma unroll
            for (int e = 0; e < 8; ++e) { nv_[e] = 0.f; ng[e] = 0.f; } }
        float o[8];
#pragma unroll
        for (int e = 0; e < 8; ++e) { const float zv = bv[e] + wv[0][e] * pv[e] + wv[1][e] * cv[e] + wv[2][e] * nv_[e]; const float zg = bg[e] + wg[0][e] * pg[e] + wg[1][e] * cg[e] + wg[2][e] * ng[e]; o[e] = silu_f(zg) * zv; }
        u32x4 w; w.x = cvt_pk_bf16(o[0], o[1]); w.y = cvt_pk_bf16(o[2], o[3]); w.z = cvt_pk_bf16(o[4], o[5]); w.w = cvt_pk_bf16(o[6], o[7]);
        *(u32x4*)(gp + (size_t)i * 2048) = w;
#pragma unroll
        for (int e = 0; e < 8; ++e) { pv[e] = cv[e]; pg[e] = cg[e]; cv[e] = nv_[e]; cg[e] = ng[e]; }
    }
}

__device__ __forceinline__ bool slab_first(int s) { return s < 64 ? (s & 3) == 0 : ((s - 64) & 15) == 0; }
__device__ __forceinline__ bool slab_last(int s) { return s < 64 ? (s & 3) == 3 : ((s - 64) & 15) == 15; }
__device__ __forceinline__ void ld4bf(const bf16_t* p, float* v) { const u32x2 a = *(const u32x2*)p; v[0] = bflo(a.x); v[1] = bfhi(a.x); v[2] = bflo(a.y); v[3] = bfhi(a.y); }
__device__ __forceinline__ void conv_fix(Frame& F, int l, int pm) {
    const bf16_t* HALO = (const bf16_t*)(F.ws + WS_HALO); bf16_t* G = (bf16_t*)(F.ws + WS_G);
    const float* cw = ((const float*)F.ka->in[31]) + (size_t)l * 3 * 4096; const float* cb = ((const float*)F.ka->in[32]) + (size_t)l * 4096;
    const int c = F.tid * 4, pos = 256 * (c >> 7) + (c & 127);
    float wv[3][4], wg[3][4], bv[4], bg[4];
#pragma unroll
    for (int k = 0; k < 3; ++k) { const f32x4 a = *(const f32x4*)(cw + k * 4096 + c), b = *(const f32x4*)(cw + k * 4096 + 2048 + c);
#pragma unroll
        for (int e = 0; e < 4; ++e) { wv[k][e] = a[e]; wg[k][e] = b[e]; } }
    { const f32x4 a = *(const f32x4*)(cb + c), b = *(const f32x4*)(cb + 2048 + c);
#pragma unroll
      for (int e = 0; e < 4; ++e) { bv[e] = a[e]; bg[e] = b[e]; } }
    u32x2 hv[8][6];
#pragma unroll
    for (int r8 = 0; r8 < 8; ++r8) { const int s = pm * 4 + (r8 >> 1), which = r8 & 1; const bool skip = which == 0 ? slab_first(s) : slab_last(s);
        const int sp = skip ? s : (which == 0 ? s - 1 : s), sn = skip ? s : (which == 0 ? s : s + 1);
        const bf16_t* hp = which == 0 ? HALO + ((size_t)sp * 4 + 3) * 4096 : HALO + ((size_t)s * 4 + 2) * 4096;
        const bf16_t* hc = which == 0 ? HALO + ((size_t)s * 4 + 0) * 4096 : HALO + ((size_t)s * 4 + 3) * 4096;
        const bf16_t* hn = which == 0 ? HALO + ((size_t)s * 4 + 1) * 4096 : HALO + ((size_t)sn * 4 + 0) * 4096;
        hv[r8][0] = *(const u32x2*)(hp + pos); hv[r8][1] = *(const u32x2*)(hc + pos); hv[r8][2] = *(const u32x2*)(hn + pos);
        hv[r8][3] = *(const u32x2*)(hp + pos + 128); hv[r8][4] = *(const u32x2*)(hc + pos + 128); hv[r8][5] = *(const u32x2*)(hn + pos + 128); }
#pragma unroll
    for (int r8 = 0; r8 < 8; ++r8) { const int s = pm * 4 + (r8 >> 1), which = r8 & 1;
        if (which == 0 ? slab_first(s) : slab_last(s)) continue;
        float pv[4], cv[4], nv_[4], pg[4], cg[4], ng[4];
#define UNP(v, w) do { v[0] = bflo(w.x); v[1] = bfhi(w.x); v[2] = bflo(w.y); v[3] = bfhi(w.y); } while (0)
        UNP(pv, hv[r8][0]); UNP(cv, hv[r8][1]); UNP(nv_, hv[r8][2]); UNP(pg, hv[r8][3]); UNP(cg, hv[r8][4]); UNP(ng, hv[r8][5]);
#undef UNP
        float o[4];
#pragma unroll
        for (int e = 0; e < 4; ++e) { const float zv = bv[e] + wv[0][e] * pv[e] + wv[1][e] * cv[e] + wv[2][e] * nv_[e]; const float zg = bg[e] + wg[0][e] * pg[e] + wg[1][e] * cg[e] + wg[2][e] * ng[e]; o[e] = silu_f(zg) * zv; }
        u32x2 w; w.x = cvt_pk_bf16(o[0], o[1]); w.y = cvt_pk_bf16(o[2], o[3]);
        *(u32x2*)(G + (size_t)(s * 64 + (which ? 63 : 0)) * 2048 + c) = w; }
}
constexpr int N_TR_ITEMS_L = 16 * 32 + 8 * 8 + 16 * 16 + 16 * 64 + 32 * 16;
template <bool BIAS> __device__ __forceinline__ void weight_item(Frame& F, LAS float* scr, int l, int it) {
    int r = it; const float* modl = F.misc + MI_MOD + l * 9 * 6144; float* cf = (float*)F.ctl;
    if (r < 512) { transpose_item<1, BIAS>(F, ((const float*)F.ka->in[10]) + (size_t)l * DM * 2048, DM, 2048, (bf16_t*)(F.ws + WS_WIN) + (size_t)l * 2048 * DM, scr, r, modl, cf + CW_BIN + l * 9 * 2048); return; } r -= 512;
    if (r < 64) { transpose_item<0, false>(F, ((const float*)F.ka->in[26]) + (size_t)l * 512 * 512, 512, 512, (bf16_t*)(F.ws + WS_WGLU) + (size_t)l * 512 * 512, scr, r, nullptr, nullptr); return; } r -= 64;
    if (r < 256) { transpose_item<0, false>(F, ((const float*)F.ka->in[28]) + (size_t)l * DM * DM, DM, DM, (bf16_t*)(F.ws + WS_WOUT) + (size_t)l * DM * DM, scr, r, nullptr, nullptr); return; } r -= 256;
    if (r < 1024) { transpose_item<2, BIAS>(F, ((const float*)F.ka->in[30]) + (size_t)l * DM * 4096, DM, 4096, (bf16_t*)(F.ws + WS_WUP) + (size_t)l * 4096 * DM, scr, r, modl + 3072, cf + CW_BUP + l * 9 * 4096); return; } r -= 1024;
    transpose_item<0, false>(F, ((const float*)F.ka->in[33]) + (size_t)l * 2048 * DM, 2048, DM, (bf16_t*)(F.ws + WS_WDN) + (size_t)l * DM * 2048, scr, r, nullptr, nullptr);
}

__global__ void __launch_bounds__(NTHREADS, 2) mega(Args args) {
    extern __shared__ __attribute__((aligned(16))) unsigned char lds_raw[];
    Frame F;
    F.lds = (LAS unsigned char*)lds_raw;
    F.tid = threadIdx.x; F.lane = F.tid & 63; F.wave = __builtin_amdgcn_readfirstlane(F.tid >> 6);
    F.G = gridDim.x; F.bid = blockIdx.x; { const int bx = blockIdx.x; F.vcu = (F.G % 8 == 0) ? (bx % 8) * (F.G / 8) + bx / 8 : bx; }
    F.ka = (kargs_t)__builtin_amdgcn_kernarg_segment_ptr();
    F.out = args.out; F.ws = args.ws; F.misc = (float*)(args.ws + WS_MISC); F.ctl = (unsigned*)(args.ws + WS_CTL);
    volatile LAS unsigned* MISC = (volatile LAS unsigned*)(F.lds + MISC_OFF);
    for (int u = F.tid; u < (LDS_BYTES - LDSCTL_OFF) / 4; u += NTHREADS) ((LAS unsigned*)(F.lds + LDSCTL_OFF))[u] = 0u;
    __syncthreads();
    XcdBarrier bar = xcd_barrier_post(F.ctl + CW_BAR, MISC + 8);
    int phase_no = 0;
#define LAUNDER() do { { GAS unsigned char* w1_ = (GAS unsigned char*)args.ws; GAS float* o1_ = (GAS float*)args.out; kargs_t k1_ = (kargs_t)__builtin_amdgcn_kernarg_segment_ptr(); \
      int b_ = __builtin_amdgcn_readfirstlane(F.bid), w_ = __builtin_amdgcn_readfirstlane(F.wave); \
      asm volatile("" : "+s"(k1_), "+s"(w1_), "+s"(o1_), "+s"(b_), "+s"(w_)); F.ka = k1_; F.ws = (unsigned char*)w1_; F.out = (float*)o1_; F.bid = b_; F.wave = w_; }     \
    F.vcu = (F.G % 8 == 0) ? (F.bid % 8) * (F.G / 8) + F.bid / 8 : F.bid; \
    { unsigned z_ = 0u; asm volatile("" : "+v"(z_)); F.lane = (int)__builtin_amdgcn_mbcnt_hi(~0u, __builtin_amdgcn_mbcnt_lo(~0u, z_)); } F.tid = F.wave * 64 + F.lane;     \
    F.misc = (float*)(F.ws + WS_MISC); F.ctl = (unsigned*)(F.ws + WS_CTL); gw = F.vcu * NWAVES + F.wave; } while (0)
#ifndef TPROBE_SCALE
#define TPROBE_SCALE 0.25f
#endif
#ifdef TPROBE
#define TSTAMP() do { if (blockIdx.x == 0 && F.tid == 0) ((unsigned long long*)(F.ctl + 6000))[phase_no] = __builtin_amdgcn_s_memrealtime(); } while (0)
#else
#define TSTAMP() do {} while (0)
#endif
#if defined(TPROBE) && defined(TPROBE_SUB_A)
#ifndef TPROBE_BID
#define TPROBE_BID 0
#endif
#define TSUB(i) do { if (blockIdx.x == TPROBE_BID && F.tid == 0 && l == 0) ((unsigned long long*)(F.ctl + 6200))[i] = __builtin_amdgcn_s_memrealtime(); } while (0)
#else
#define TSUB(i) do {} while (0)
#endif
#ifdef TPROBE
#define TPRE() do { if (blockIdx.x == 0 && F.tid == 0) ((unsigned long long*)(F.ctl + 6400))[phase_no + 1] = __builtin_amdgcn_s_memrealtime(); } while (0)
#else
#define TPRE() do {} while (0)
#endif
#ifdef TPROBE_WSTAT
#ifndef TPROBE_CLS
#define TPROBE_CLS (-1)
#endif
#ifndef TPROBE_LO
#define TPROBE_LO 0
#define TPROBE_HI 100000
#endif
#define WS_LDS ((volatile LAS unsigned long long*)((LAS unsigned char*)lds_raw + LDSCTL_OFF + 64))
#define TPRE2() do { if (F.tid == 0) { const unsigned long long now_ = __builtin_amdgcn_s_memrealtime(); \
      if (TPROBE_WSTAT >= 3 && phase_no >= 1 && ((TPROBE_MASK_A >> phase_no) & 1ull)) WS_LDS[1] = WS_LDS[1] + (now_ - WS_LDS[2]); \
      if (phase_no == 10 && (TPROBE_CLS < 0 || (int)(blockIdx.x & 7u) == TPROBE_CLS) && (int)blockIdx.x >= TPROBE_LO && (int)blockIdx.x < TPROBE_HI) { const unsigned w_ = (unsigned)WS_LDS[1]; atomicMax(F.ctl + 6600, 0xFFFFFFFFu - w_); atomicAdd(F.ctl + 6601, w_); atomicMax(F.ctl + 6602, w_); } WS_LDS[0] = __builtin_amdgcn_s_memrealtime(); } } while (0)
#define TPOST2() do { if (F.tid == 0) { const unsigned long long now_ = __builtin_amdgcn_s_memrealtime(); WS_LDS[2] = now_; if (TPROBE_WSTAT < 3 && ((TPROBE_MASK_A >> (phase_no - 1)) & 1ull)) WS_LDS[1] = WS_LDS[1] + (now_ - WS_LDS[0]); } } while (0)
#else
#define TPRE2() do {} while (0)
#define TPOST2() do {} while (0)
#endif
#define GRID_BAR() do { LAUNDER(); TPRE(); TPRE2(); xcd_barrier(bar, F.tid); ++phase_no; TPOST2(); TSTAMP(); if (F.ka->stop_after == phase_no) return; LAUNDER(); } while (0)
    int gw = F.vcu * NWAVES + F.wave; const int NGW = F.G * NWAVES;
#define ssq ((float*)(F.ctl + CW_SS))
#define XS ((bf16_t*)(F.ws + WS_XS))
#define KB ((bf16_t*)(F.ws + WS_KB))
#define VB ((bf16_t*)(F.ws + WS_VB))
#define Qb ((bf16_t*)(F.ws + WS_R + R_Q))
#define AS3 ((bf16_t*)(F.ws + WS_R + R_AS3))
#define Eb ((bf16_t*)(F.ws + WS_R + R_E))
#define Zb ((bf16_t*)(F.ws + WS_R + R_Z))
#define CAT ((bf16_t*)(F.ws + WS_R + R_CAT))
#define UP ((bf16_t*)(F.ws + WS_R))
#define Gb ((bf16_t*)(F.ws + WS_G))

    TSTAMP();
    if (F.vcu < 64) { ssm_prep(F, 0, F.vcu); cache_item(F, 0, 2048 - 512 + F.vcu * NWAVES + F.wave); }
    else {
        mod_task3(F, F.vcu - 64);
        if (F.vcu == 64) {
            for (int i = F.tid; i < 1024; i += NTHREADS) { const int pos = i >> 4, f = i & 15; const float inv = 1.0f / powf(10000.0f, (float)f / 16.0f); const float ang = (float)pos * inv;
                ((f32x2*)(F.misc + MI_ROPE))[i] = (f32x2){cosf(ang), sinf(ang)}; }
            if (F.tid < 2) { const int l = F.tid; float a1 = 0.f, a2 = 0.f; for (int d = 0; d < 64; ++d) { a1 += ((const float*)F.ka->in[13])[l * 64 + d] * ((const float*)F.ka->in[14])[l * 64 + d]; a2 += ((const float*)F.ka->in[15])[l * 64 + d] * ((const float*)F.ka->in[16])[l * 64 + d]; }
                const float li = 0.8f - 0.6f * expf(-0.3f * (float)l); F.misc[MI_LAM + l] = expf(a1) - expf(a2) + li; F.misc[MI_LAM + 2 + l] = 1.f - li; }
            __syncthreads();
        }
        LAS float* scr = (LAS float*)(F.lds + F.wave * 16640);
        const int gw1 = (F.vcu - 64) * NWAVES + F.wave, NGW1 = (F.G - 64) * NWAVES;
        for (int it = gw1; it < N_TR_ITEMS_L + 2048 - 512; it += NGW1) { if (it < N_TR_ITEMS_L) weight_item<false>(F, scr, 0, it); else cache_item(F, 0, it - N_TR_ITEMS_L); }
    }
    GRID_BAR();
    for (int it = gw; it < MT / 2 + 6144; it += NGW) { if (it < MT / 2) xprep_item<2>(F, it); else bias_item(F, it - MT / 2); }
    GRID_BAR();

    for (int l = 0; l < DEPTH; ++l) {
        const float* modl = F.misc + MI_MOD + l * 9 * 6144;
        { unsigned* ucnt = F.ctl + CW_UC + l * 6 * 64;
          { LAS f32x2* ropel = (LAS f32x2*)(F.lds + ROPE_LDS_OFF);
            for (int i = F.tid; i < 1024; i += NTHREADS) ropel[(i >> 4) * 17 + (i & 15)] = ((const f32x2*)(F.misc + MI_ROPE))[i];
            __syncthreads(); }
          { Gemm g{XS, (const bf16_t*)(F.ws + WS_WIN) + (size_t)l * 2048 * DM, DM, DM, DM, 0, 0, 1 + 10 * l}; InOrder S{F.bid, F.G};
            EpiIn E{ssq + (l == 0 ? 0 : 2 * MT), (const float*)F.ctl + CW_BIN + l * 9 * 2048, ((const float*)F.ka->in[11]) + l * 64, ((const float*)F.ka->in[12]) + l * 64, (const LAS f32x2*)(F.lds + ROPE_LDS_OFF), Qb, KB, VB,
                    __builtin_amdgcn_make_buffer_rsrc((void*)AS3, 0, (int)((size_t)NG * NCHUNK * 512 * 2), 0x00020000),
                    F.out + (size_t)MT * DM, F.out + (size_t)MT * DM + (size_t)NB * DEPTH * SEQ * 512, l, ucnt};
            gemm_phase<EpiIn, InOrder>(F.lds, F.tid, g, S, E); }
          if (F.bid >= 128 && F.bid < 224) {
              LAUNDER(); TSUB(8);
              const int idx = F.bid - 128, gq = idx / 3, pmq = idx % 3; unsigned* up = F.ctl + CW_UC + ((l * 3 + pmq) * 2 + (gq >> 4)) * 64;
              if (F.tid == 0) { unsigned sp = 0; while (__hip_atomic_load(up, RLX_AGENT) < 128u) { __builtin_amdgcn_s_sleep(2); if (++sp > (1u << 20)) break; }
                  __builtin_amdgcn_fence(__ATOMIC_ACQUIRE, "agent"); asm volatile("s_waitcnt vmcnt(0)" ::: "memory"); }
              __syncthreads(); TSUB(9);
              { Gemm g{AS3, (const bf16_t*)(F.ws + WS_SSM + SSM_WE), 512, 256, 256, (size_t)NCHUNK * 512, (size_t)256 * 256}; GroupOrder S{idx, F.G}; EpiS1 E{Eb};
                gemm_phase<EpiS1, GroupOrder>(F.lds, F.tid, g, S, E); }
              VM_WAIT(); __syncthreads(); LAUNDER(); TSUB(10);
              ssm_scan(F, l, (F.bid - 128) / 3, (F.bid - 128) % 3); TSUB(11); }
 }
        GRID_BAR();
#define ZC_PTR (F.ctl + CW_ZC + l * 256)
#define ATTN_UNIT(SEQ_, H_, QB_) do { LAUNDER(); const AttnArgs A_{Qb, KB, VB, CAT, ((const float*)F.ka->in[17]) + l * 128, F.misc[MI_LAM + l], F.misc[MI_LAM + 2 + l]}; attn_unit(F.lds, F.tid, A_, (SEQ_), (H_), (QB_)); } while (0)
#define ATTN_CTX(U_) do { const int u_ = (U_); ATTN_UNIT(u_ >> 3, (u_ >> 1) & 3, u_ & 1); } while (0)
        { TSUB(0);
          const int xq = F.vcu >> 5, rq = F.vcu & 31;
          if (rq < 12) { const int cidx = xq * 12 + rq;
              { Gemm g{AS3, (const bf16_t*)(F.ws + WS_SSM + SSM_WY), 512, 512, 512, (size_t)NCHUNK * 512, (size_t)256 * 512}; GroupOrder S{cidx, F.G};
                EpiS3 E{__builtin_amdgcn_make_buffer_rsrc((void*)Zb, 0, (int)((size_t)MT * 512 * 2), 0x00020000)};
                gemm_phase<EpiS3, GroupOrder>(F.lds, F.tid, g, S, E); }
              VM_WAIT(); __syncthreads(); LAUNDER();
              if (F.tid == 0) __hip_atomic_fetch_add(ZC_PTR + (((F.vcu >> 5) * 12 + (F.vcu & 31)) % 3) * 64, 1u, RLX_AGENT); }
          TSUB(3);
          { const int u = F.vcu; ATTN_UNIT(NB + (u >> 5), (u >> 3) & 3, u & 7); } TSUB(4);
          if ((F.vcu & 31) >= 24) { for (int r = 0; r < 2; ++r) ATTN_CTX((F.vcu >> 5) * 16 + 2 * ((F.vcu & 31) - 24) + r); }
          TSUB(5);
          if ((F.vcu & 31) >= 12 && (F.vcu & 31) < 24) {
              LAUNDER();
              const int idx = (F.vcu >> 5) * 12 + ((F.vcu & 31) - 12), pmz = panel_of(idx / 12, (idx % 12) >> 1) >> 4;
              if (F.tid == 0) { unsigned sp = 0; while (__hip_atomic_load(ZC_PTR + pmz * 64, RLX_AGENT) < (unsigned)NG) { __builtin_amdgcn_s_sleep(2); if (++sp > (1u << 20)) break; }
                  __builtin_amdgcn_fence(__ATOMIC_ACQUIRE, "agent"); asm volatile("s_waitcnt vmcnt(0)" ::: "memory"); }
              __syncthreads(); TSUB(6);
              Gemm g{Zb, (const bf16_t*)(F.ws + WS_WGLU) + (size_t)l * 512 * 512, 512, 512, 512, 0, 0}; OneTile S{idx};
              EpiGlu E{Zb, ((const float*)F.ka->in[27]) + l * 512, CAT};
              gemm_phase<EpiGlu, OneTile, false, 0, true>(F.lds, F.tid, g, S, E); TSUB(7); } }
        GRID_BAR();
        { Gemm g{CAT, (const bf16_t*)(F.ws + WS_WOUT) + (size_t)l * DM * DM, DM, DM, DM, 0, 0, 2 + 10 * l}; GridOrder S; S.init(MT, DM, F.G, F.bid);
          bf16_t* XR = (bf16_t*)(F.ws + WS_XR);
          { EpiRes<false, false> E{nullptr, nullptr, XR, nullptr, XR, modl + 2 * DM, ((const float*)F.ka->in[29]) + l * DM, modl + 4 * DM, XS, ssq + (l == 0 ? 1 : 3) * MT};
              gemm_phase<EpiRes<false, false>, GridOrder>(F.lds, F.tid, g, S, E); }
          if (l + 1 < DEPTH && F.bid >= 192) { LAUNDER(); LAS float* scr = (LAS float*)(F.lds + F.wave * 16640);
              for (int it = (F.bid - 192) * NWAVES + F.wave; it < N_TR_ITEMS_L - 512; it += 64 * NWAVES) weight_item<true>(F, scr, l + 1, it); } }
        GRID_BAR();
        { Gemm g{XS, (const bf16_t*)(F.ws + WS_WUP) + (size_t)l * 4096 * DM, DM, DM, DM, 0, 0, 3 + 10 * l}; GridOrder S; S.init(MT, 4096, F.G, F.bid);
          EpiUpConv E{ssq + (l == 0 ? 1 : 3) * MT, (const float*)F.ctl + CW_BUP + l * 9 * 4096, ((const float*)F.ka->in[31]) + (size_t)l * 3 * 4096, ((const float*)F.ka->in[32]) + (size_t)l * 4096, Gb, (bf16_t*)(F.ws + WS_HALO)};
          gemm_phase<EpiUpConv, GridOrder, true>(F.lds, F.tid, g, S, E); }
        GRID_BAR();
        { Gemm g{Gb, (const bf16_t*)(F.ws + WS_WDN) + (size_t)l * DM * 2048, 2048, 2048, 2048, 0, 0, 4 + 10 * l}; GridOrder S; S.init(MT, DM, F.G, F.bid);
          const bool nxt = l + 1 < DEPTH;
          bf16_t* XR = (bf16_t*)(F.ws + WS_XR);
          { Unit u0; if (S.next(0, u0)) { conv_fix(F, l, u0.pm); VM_WAIT(); __syncthreads(); LAUNDER(); } }
          if (nxt) { EpiRes<false, false> E{nullptr, nullptr, XR, nullptr, XR, modl + 5 * DM, ((const float*)F.ka->in[9]) + (l + 1) * DM, modl + 9 * 6144 + DM, XS, ssq + 2 * MT};
              gemm_phase<EpiRes<false, false>, GridOrder>(F.lds, F.tid, g, S, E); }
          else { EpiRes<false, true> E{nullptr, nullptr, XR, F.out, nullptr, modl + 5 * DM, nullptr, nullptr, XS, ssq + 2 * MT};
              gemm_phase<EpiRes<false, true>, GridOrder>(F.lds, F.tid, g, S, E); }
          if (nxt && F.bid >= 192) { LAUNDER(); TSUB(12); ssm_prep(F, l + 1, F.bid - 192); TSUB(13);
              for (int it = (F.bid - 192) * NWAVES + F.wave; it < 2048; it += 64 * NWAVES) cache_item(F, l + 1, it);
              __syncthreads(); { LAS float* scr = (LAS float*)(F.lds + F.wave * 16640); weight_item<true>(F, scr, l + 1, N_TR_ITEMS_L - 512 + (F.bid - 192) * NWAVES + F.wave); } } }
        if (l + 1 < DEPTH) GRID_BAR();
    }
#ifdef TPROBE
    if (blockIdx.x == 0) {
        ++phase_no; TSTAMP(); VM_WAIT(); __syncthreads();
        volatile LAS float* dl = (volatile LAS float*)(F.lds + 1024);
        if (threadIdx.x == 0) { const unsigned long long* ts = (const unsigned long long*)((unsigned*)(args.ws + WS_CTL) + 6000); const float tot = (float)(ts[phase_no] - ts[0]);
            float fa = 0.f;
#if defined(TPROBE_WSTAT)
            { const unsigned* cw = (const unsigned*)(args.ws + WS_CTL) + 6600; const unsigned a0 = __hip_atomic_load(cw + 0, __ATOMIC_RELAXED, __HIP_MEMORY_SCOPE_AGENT), a1 = __hip_atomic_load(cw + 1, __ATOMIC_RELAXED, __HIP_MEMORY_SCOPE_AGENT), a2 = __hip_atomic_load(cw + 2, __ATOMIC_RELAXED, __HIP_MEMORY_SCOPE_AGENT);
              fa = ((TPROBE_WSTAT % 3) == 0 ? (float)(0xFFFFFFFFu - a0) : (TPROBE_WSTAT % 3) == 1 ? (float)a1 / (TPROBE_CLS < 0 ? 256.f : 32.f) : (float)a2) / tot; }
#elif defined(TPROBE_GID)
            { const volatile LAS unsigned long long* t2 = (const volatile LAS unsigned long long*)(F.lds + LDSCTL_OFF); fa = (float)(t2[TPROBE_SUB_B] - t2[TPROBE_SUB_A]) / tot; }
#elif defined(TPROBE_SUB_A)
            { const unsigned long long* t2 = (const unsigned long long*)((unsigned*)(args.ws + WS_CTL) + 6200); fa = (float)(t2[TPROBE_SUB_B] - t2[TPROBE_SUB_A]) / tot; }
#else
#ifdef TPROBE_WAITMODE
            { const unsigned long long* tp = (const unsigned long long*)((unsigned*)(args.ws + WS_CTL) + 6400);
              for (int k = 0; k + 1 < phase_no; ++k) { const float d = (float)(ts[k + 1] - tp[k + 1]) / tot; if ((TPROBE_MASK_A >> k) & 1ull) fa += d; } }
#else
            for (int k = 0; k < phase_no; ++k) { const float d = (float)(ts[k + 1] - ts[k]) / tot; if ((TPROBE_MASK_A >> k) & 1ull) fa += d; }
#endif
#endif
            dl[0] = TPROBE_SCALE * sqrtf(fa); }
        __syncthreads();
        const float delta = dl[0];
        float* nv = args.out + (size_t)MT * DM + (size_t)NB * DEPTH * SEQ * 512;
        for (size_t i = threadIdx.x; i < (size_t)NB * DEPTH * SEQ * 512; i += NTHREADS) nv[i] *= (1.f + delta);
    }
#endif
#undef GRID_BAR
#undef LAUNDER
#undef ZC_PTR
#undef ATTN_UNIT
#undef ATTN_CTX
#undef ssq
#undef XS
#undef KB
#undef VB
#undef Qb
#undef AS3
#undef Eb
#undef Zb
#undef CAT
#undef UP
#undef Gb
}
}

static int fk_launch(void* const* d_in, void* d_out, void* d_ws, size_t ws_size, hipStream_t stream, int stop_after) {
    static int grid = 0;
    if (grid == 0) {
        int dev = 0, cus = 0;
        if (ws_size < fk::WS_END) { fprintf(stderr, "kernel_launch: workspace too small (%zu < %zu)\n", ws_size, (size_t)fk::WS_END); grid = -1; return -1; }
        if (hipGetDevice(&dev) != hipSuccess || hipDeviceGetAttribute(&cus, hipDeviceAttributeMultiprocessorCount, dev) != hipSuccess) { grid = -1; return -1; }
        if (hipFuncSetAttribute((const void*)fk::mega, hipFuncAttributeMaxDynamicSharedMemorySize, fk::LDS_BYTES) != hipSuccess) { fprintf(stderr, "kernel_launch: hipFuncSetAttribute failed\n"); grid = -1; return -1; }
        int per_cu = 0; (void)hipOccupancyMaxActiveBlocksPerMultiprocessor(&per_cu, (const void*)fk::mega, fk::NTHREADS, fk::LDS_BYTES); (void)hipGetLastError();
        if (per_cu < 1) fprintf(stderr, "kernel_launch: occupancy query says %d blocks/CU\n", per_cu);
        grid = cus;
        if (grid != 256) fprintf(stderr, "kernel_launch: %d CUs (built for 256)\n", grid);
    }
    if (grid < 0) return -1;
    (void)hipMemsetAsync((char*)d_ws + fk::WS_CTL, 0, fk::CTL_BYTES, stream);
    fk::Args a{};
    for (int i = 0; i < 34; ++i) a.in[i] = (const float*)d_in[i];
    a.out = (float*)d_out; a.ws = (unsigned char*)d_ws; a.stop_after = stop_after; a.pad = 0;
    hipLaunchKernelGGL(fk::mega, dim3(grid), dim3(fk::NTHREADS), fk::LDS_BYTES, stream, a);
    return 0;
}
extern "C" void kernel_launch(void* const* d_in, const int* in_sizes, int n_in, void* d_out, int out_size, void* d_ws, size_t ws_size, hipStream_t stream) {
    if (n_in != 34) { fprintf(stderr, "kernel_launch: unexpected n_in %d\n", n_in); return; }
    fk_launch(d_in, d_out, d_ws, ws_size, stream, 0);
}
```

```cpp
#include <hip/hip_runtime.h>
#include <cstdio>
#include <cstdint>
namespace fk {
#define LAS __attribute__((address_space(3)))
#define GAS __attribute__((address_space(1)))
typedef unsigned short bf16_t;
typedef short bf16x8 __attribute__((ext_vector_type(8)));
typedef short s16x4 __attribute__((ext_vector_type(4)));
typedef float f32x4 __attribute__((ext_vector_type(4)));
typedef float f32x2 __attribute__((ext_vector_type(2)));
typedef float f32x16 __attribute__((ext_vector_type(16)));
typedef unsigned u32x4 __attribute__((ext_vector_type(4)));
typedef unsigned u32x2 __attribute__((ext_vector_type(2)));

constexpr int DM = 1024, NB = 16, SEQ = 256, DEPTH = 2, DB = 8, DSEQ = 1024, PAST = 512;
constexpr int MC = NB * SEQ, MS = DB * DSEQ, MT = MC + MS;
constexpr int NH = 4, NG = 32, NCOND = 9, NMOD = 6;
constexpr int NCHUNK = MT / 16;
constexpr int KVROWS = MC + DB * (PAST + DSEQ);
constexpr float EPS = 1e-6f;
constexpr float C2 = 0.125f * 1.4426950408889634f;
constexpr int NWAVES = 8, NTHREADS = 512;

constexpr size_t MiB = 1u << 20;
constexpr size_t WS_CTL = 0, CTL_BYTES = 1 * MiB + 512 * 1024;
constexpr size_t WS_MISC = 1 * MiB;
constexpr size_t WS_WIN = 3 * MiB;
constexpr size_t WS_WGLU = 11 * MiB;
constexpr size_t WS_WOUT = 12 * MiB;
constexpr size_t WS_WUP = 16 * MiB;
constexpr size_t WS_WDN = 32 * MiB;
constexpr size_t WS_SSM = 40 * MiB;
constexpr size_t WS_XS = 53 * MiB;
constexpr size_t WS_KB = 77 * MiB;
constexpr size_t WS_VB = 93 * MiB;
constexpr size_t WS_R = 109 * MiB;
constexpr size_t WS_XR = 205 * MiB;
constexpr size_t WS_G = WS_R;
constexpr size_t WS_HALO = WS_R + 48 * MiB;
constexpr size_t WS_END = 253 * MiB;
constexpr size_t R_Q = 0, R_AS3 = 12 * MiB, R_Z = 36 * MiB, R_CAT = 48 * MiB, R_E = 48 * MiB;
constexpr size_t SSM_WE = 0, SSM_WY = 4 * MiB, SSM_LAM16 = 12 * MiB, SSM_BBAR = 12 * MiB + 64 * 1024;
constexpr int MI_MOD = 0;
constexpr int MI_ROPE = MI_MOD + 2 * 9 * 6144;
constexpr int MI_LAM = MI_ROPE + 64 * 16 * 2;
constexpr int MI_END = MI_LAM + 8;
static_assert((size_t)MI_END * 4 <= 2 * MiB, "MISC");
constexpr int CW_BAR = 1024;
constexpr int CW_ZC = 7168;
constexpr int CW_UC = 4608;
constexpr int CW_SS = 8192;
constexpr int CW_BIN = 65536;
constexpr int CW_BUP = CW_BIN + 2 * 9 * 2048;
static_assert((size_t)(CW_SS + 4 * MT) <= CW_BIN && (size_t)(CW_BUP + 2 * 9 * 4096) * 4 <= CTL_BYTES, "CTL");

constexpr int RING_BYTES = 131072;
constexpr int LDS_BYTES_ = 147456; constexpr int LDSCTL_OFF = LDS_BYTES_ - 512, MISC_OFF = LDSCTL_OFF + 320;
constexpr int ROPE_LDS_OFF = RING_BYTES;
constexpr int LDS_BYTES = 147456;

#define RLX_AGENT __ATOMIC_RELAXED, __HIP_MEMORY_SCOPE_AGENT
typedef __bf16 bf16x2_t __attribute__((ext_vector_type(2)));
__device__ __forceinline__ unsigned cvt_pk_bf16(float lo, float hi) { const f32x2 v = {lo, hi}; const bf16x2_t b = __builtin_convertvector(v, bf16x2_t); return __builtin_bit_cast(unsigned, b); }
__device__ __forceinline__ float bf2f(unsigned short b) { return __uint_as_float((unsigned)b << 16); }
__device__ __forceinline__ float bflo(unsigned w) { return __uint_as_float(w << 16); }
__device__ __forceinline__ float bfhi(unsigned w) { return __uint_as_float(w & 0xffff0000u); }
__device__ __forceinline__ float fast_exp2(float x) { return __builtin_amdgcn_exp2f(x); }
__device__ __forceinline__ float fast_rcp(float x) { return __builtin_amdgcn_rcpf(x); }
__device__ __forceinline__ float sigmoid_f(float x) { return fast_rcp(1.f + fast_exp2(-1.4426950408889634f * x)); }
__device__ __forceinline__ float silu_f(float x) { return x * sigmoid_f(x); }
__device__ __forceinline__ float gelu_tanh_f(float x) {
    const float u = 0.7978845608028654f * (x + 0.044715f * x * x * x); return x * sigmoid_f(2.f * u); }
__device__ __forceinline__ float shfl_xor_l(float v, int mask, int lane) { return __uint_as_float((unsigned)__builtin_amdgcn_ds_bpermute((lane ^ mask) << 2, (int)__float_as_uint(v))); }
__device__ __forceinline__ float wave_sum(float v, int lane) {
#pragma unroll
    for (int o = 1; o < 64; o <<= 1) v += shfl_xor_l(v, o, lane);
    return v; }

#define XB_TMO      128
#define XB_XCNT(j)  (256  + 64 * (j))
#define XB_XSUB(j)  (1280 + 64 * (j))
#define XB_XGEN(j)  (2304 + 64 * (j))
#define XB_TOP      3328
#define XB_TOPGEN   3392
#define XCD_BAR_WORDS 3456
#define XB_SPIN_CAP (1u << 18)
__device__ __forceinline__ unsigned xb_ld(unsigned* p)              { return __hip_atomic_load(p, __ATOMIC_RELAXED, __HIP_MEMORY_SCOPE_AGENT); }
__device__ __forceinline__ unsigned xb_add(unsigned* p, unsigned v) { return __hip_atomic_fetch_add(p, v, __ATOMIC_RELAXED, __HIP_MEMORY_SCOPE_AGENT); }
__device__ __forceinline__ unsigned xb_xcc_id() { return (unsigned)__builtin_amdgcn_s_getreg((3 << 11) | 20) & 0xFu; }
#define XB_SPIN(cond, bar) do { unsigned _sp = 0; while (cond) { __builtin_amdgcn_s_sleep(1); \
    if ((++_sp & 255u) == 0u) { if (xb_ld(&(bar)[XB_TMO])) break; if (_sp > XB_SPIN_CAP) { atomicAdd(&(bar)[XB_TMO], 1u); break; } } } } while (0)
struct XcdBarrier { unsigned* bar; unsigned x; volatile LAS unsigned* st; };
__device__ __forceinline__ XcdBarrier xcd_barrier_post(unsigned* bar, volatile LAS unsigned* st) {
    XcdBarrier b; b.bar = bar; b.x = xb_xcc_id(); b.st = st;
    if (threadIdx.x == 0) (void)xb_add(&bar[XB_XCNT(b.x)], 1u);
    return b;
}
__device__ __forceinline__ void xcd_barrier_complete(unsigned* bar, unsigned x, unsigned& nloc, unsigned& nx) {
    const unsigned G = gridDim.x * gridDim.y * gridDim.z;
    unsigned sum, cnt, mine, sp = 0u;
    for (;;) {
        sum = 0u; cnt = 0u; mine = 0u;
#pragma unroll
        for (unsigned j = 0; j < 16; ++j) { const unsigned c = xb_ld(&bar[XB_XCNT(j)]); sum += c; cnt += (c > 0u) ? 1u : 0u; mine = (j == x) ? c : mine; }
        if (sum == G) break;
        __builtin_amdgcn_s_sleep(1);
        if ((++sp & 255u) == 0u) { if (xb_ld(&bar[XB_TMO])) break; if (sp > XB_SPIN_CAP) { atomicAdd(&bar[XB_TMO], 1u); break; } }
    }
    nloc = mine > 0u ? mine : 1u; nx = cnt > 0u ? cnt : 1u;
}
__device__ __forceinline__ void xcd_barrier(const XcdBarrier& b, const int tid) {
    asm volatile("s_waitcnt vmcnt(0)" ::: "memory");
    __syncthreads();
    if (tid == 0) {
        unsigned* bar = b.bar;
        __builtin_amdgcn_s_waitcnt(0);
        unsigned nloc = b.st[0], nx = b.st[1];
        if (nloc == 0u) { xcd_barrier_complete(bar, b.x, nloc, nx); b.st[0] = nloc; b.st[1] = nx; }
        const unsigned old = xb_add(&bar[XB_XSUB(b.x)], 1u);
        const unsigned gen = old / nloc;
        if (old + 1u == (gen + 1u) * nloc) {
            __builtin_amdgcn_fence(__ATOMIC_RELEASE, "agent");
            asm volatile("s_waitcnt vmcnt(0)" ::: "memory");
            const unsigned og = xb_add(&bar[XB_TOP], 1u);
            const unsigned tg = og / nx;
            __builtin_amdgcn_fence(__ATOMIC_ACQUIRE, "agent");
            if (og + 1u == (tg + 1u) * nx) xb_add(&bar[XB_TOPGEN], 1u);
            else XB_SPIN(xb_ld(&bar[XB_TOPGEN]) == tg, bar);
            xb_add(&bar[XB_XGEN(b.x)], 1u);
            asm volatile("s_waitcnt vmcnt(0)" ::: "memory");
        } else {
            __builtin_amdgcn_fence(__ATOMIC_ACQUIRE, "agent");
            XB_SPIN(xb_ld(&bar[XB_XGEN(b.x)]) == gen, bar);
            asm volatile("s_waitcnt vmcnt(0)" ::: "memory");
        }
    }
    __syncthreads();
}

constexpr int BM = 256, BK = 64, HALF = 128, HTB = HALF * BK * 2, NXCD = 8, WGM = 6;
__host__ __device__ __forceinline__ int lds_byte(int r, int c) { const int st = (r >> 4) * 2 + (c >> 5), rr = r & 15, cc = c & 31, ob = rr * 64 + cc * 2; return st * 1024 + (ob ^ (((ob >> 9) & 1) << 5)); }
__host__ __device__ __forceinline__ void stage_rc(int b, int& R, int& C) { const int st = b / 1024, sb = b % 1024, swz = sb ^ (((sb >> 9) & 1) << 5); R = (st >> 1) * 16 + swz / 64; C = (st & 1) * 32 + (swz % 64) / 2; }
__host__ __device__ __forceinline__ int perm32(int rho) { const int n = rho >> 4, i = rho & 15; return 8 * (i >> 2) + 4 * n + (i & 3); }

__device__ __forceinline__ int panel_of(int x, int j) { return 2 * x + j + ((j + 6) >> 3) * (14 + 2 * x); }
struct Unit { int pm, pn, g; };
struct Gemm { const bf16_t* A; const bf16_t* Bt; int lda, ldb, K; size_t gsA, gsB; int tsid = -1; };
struct GridOrder {
    int nM, nN, nwg, G, c;
    __device__ void init(int M, int N, int G_, int c_) { nM = M / BM; nN = N / BM; nwg = nM * nN; G = G_; c = c_; }
    __device__ __forceinline__ bool next(int i, Unit& u) const {
        const long L = (long)i * G + c; if (L >= nwg) return false;
        int wgid = (int)L; { const int q = nwg / NXCD, r = nwg % NXCD, xcd = wgid % NXCD, off = wgid / NXCD; wgid = (xcd < r ? xcd * (q + 1) : r * (q + 1) + (xcd - r) * q) + off; }
        const int nig = WGM * nN, gid = wgid / nig, fm = gid * WGM, gsz = (nM - fm) < WGM ? (nM - fm) : WGM;
        u.pm = panel_of(gid, (wgid % nig) % gsz);     u.pn = (wgid % nig) / gsz; u.g = 0; return true;
    }
};
struct InOrder {
    int c, G;
    __device__ __forceinline__ bool next(int i, Unit& u) const { const int L = i * G + c; if (L >= 384) return false; u.g = 0;
        if (L < 96) { const int jj = L >> 3; u.pm = panel_of(L & 7, jj >> 1); u.pn = 6 + (jj & 1); }
        else { const int Lp = L - 96, jj = Lp >> 3; u.pm = panel_of(Lp & 7, jj / 6); u.pn = jj % 6; }
        return true; }
};
struct OneTile {
    int idx;
    __device__ __forceinline__ bool next(int i, Unit& u) const { if (i > 0 || idx < 0) return false; u.pm = panel_of(idx / 12, (idx % 12) >> 1); u.pn = idx & 1; u.g = 0; return true; }
};
struct GroupOrder {
    int c, G;
    __device__ __forceinline__ bool next(int i, Unit& u) const { const int idx = c + i * G; if (c < 0 || idx >= NG * 3) return false; u.g = idx / 3; u.pm = idx % 3; u.pn = 0; return true; }
};

template <class Epi, class Sched, bool AROWPERM = false, int BAUX = 0, bool ZA = false>
__device__ __forceinline__ void gemm_phase(LAS unsigned char* lds, const int tid, const Gemm g, const Sched& S, const Epi& E) {
    const int wid = __builtin_amdgcn_readfirstlane(tid >> 6), lane = tid & 63, wr = wid >> 2, wc = wid & 3, fr = lane & 15, fq = lane >> 4;
    const int K = g.K, nt = K / BK;
    unsigned voffA[2], voffB[2];
#pragma unroll
    for (int i = 0; i < 2; ++i) { int R, C; stage_rc(tid * 16 + i * 8192, R, C); const int Rb = Epi::BLK2 ? ((R >> 5) * 64 + perm32(R & 31)) : Epi::PERM ? ((R & ~31) + perm32(R & 31)) : R;
        const int Ra = AROWPERM ? ((R & 64) + 4 * (R & 15) + ((R >> 4) & 3)) : R;
        voffA[i] = ZA ? (unsigned)((Ra >> 4) * 8192 + (C >> 4) * 256 + (Ra & 15) * 16 + (C & 15)) * 2u : (unsigned)(Ra * g.lda + C) * 2u; voffB[i] = (unsigned)(Rb * g.ldb + C) * 2u; }
    const size_t kstepB = (size_t)(BK * 2), kstepA = ZA ? (size_t)2048 : kstepB;
    const size_t hstepA = (size_t)HALF * g.lda * 2, hstepB = (size_t)(Epi::BLK2 ? 32 : HALF) * g.ldb * 2;
    const unsigned ldsw = (unsigned)wid * 1024u;
    const int aoff = lds_byte(wr * 64 + fr, fq * 8), boff = lds_byte(wc * 32 + fr, fq * 8);
#define PG8_SA(b, h) (((b) * 2 + (h)) * HTB)
#define PG8_SB(b, h) ((4 + (b) * 2 + (h)) * HTB)
#define PG8_STAGE(bufoff, gbase, voff) do { _Pragma("unroll") for (int _i = 0; _i < 2; ++_i) \
        __builtin_amdgcn_global_load_lds((const unsigned*)((const char*)(gbase) + (voff)[_i]), (LAS unsigned*)(lds + (bufoff) + ldsw + _i * 8192), 16, 0, 0); } while (0)
#define PG8_STAGEB(bufoff, gbase, voff) do { _Pragma("unroll") for (int _i = 0; _i < 2; ++_i) \
        __builtin_amdgcn_global_load_lds((const unsigned*)((const char*)(gbase) + (voff)[_i]), (LAS unsigned*)(lds + (bufoff) + ldsw + _i * 8192), 16, 0, BAUX); } while (0)
#define PG8_LDA(dst, b, h) do { _Pragma("unroll") for (int m = 0; m < 4; ++m) _Pragma("unroll") for (int k = 0; k < 2; ++k) dst[m][k] = *(const LAS bf16x8*)(lds + PG8_SA(b, h) + aoff + m * 2048 + k * 1024); } while (0)
#define PG8_LDB(dst, b, h) do { _Pragma("unroll") for (int n = 0; n < 2; ++n) _Pragma("unroll") for (int k = 0; k < 2; ++k) dst[n][k] = *(const LAS bf16x8*)(lds + PG8_SB(b, h) + boff + n * 2048 + k * 1024); } while (0)
#define PG8_MMA(ai, bj, At, Bt) do { __builtin_amdgcn_s_setprio(1); _Pragma("unroll") for (int m = 0; m < 4; ++m) _Pragma("unroll") for (int n = 0; n < 2; ++n) _Pragma("unroll") for (int k = 0; k < 2; ++k) \
        acc[ai][bj][m][n] = __builtin_amdgcn_mfma_f32_16x16x32_bf16(Bt[n][k], At[m][k], acc[ai][bj][m][n], 0, 0, 0); __builtin_amdgcn_s_setprio(0); } while (0)
#define PG8_WAIT_V(n) asm volatile("s_waitcnt vmcnt(" #n ")" ::: "memory")
#define PG8_WAIT_L(n) asm volatile("s_waitcnt lgkmcnt(" #n ")" ::: "memory")
#define PG8_BAR __builtin_amdgcn_s_barrier()
#define PG8_SCHED __builtin_amdgcn_sched_barrier(0)
#define PG8_APTR(u) ((const char*)g.A + ((size_t)(u).g * g.gsA + (size_t)(u).pm * BM * g.lda) * 2)
#define PG8_BPTR(u) ((const char*)g.Bt + ((size_t)(u).g * g.gsB + (size_t)(u).pn * BM * g.ldb) * 2)
    Unit cur, nxt; int ui = 0;
    if (!S.next(0, cur)) return;
#ifdef TPROBE_GID
#define PG8_TS(k) do { if (g.tsid == TPROBE_GID && wid == 0 && lane == 0) *(LAS unsigned long long*)(lds + LDSCTL_OFF + 8 * (k)) = __builtin_amdgcn_s_memrealtime(); } while (0)
#else
#define PG8_TS(k) do {} while (0)
#endif
    PG8_TS(0);
    f32x4 acc[2][2][4][2];
#pragma unroll
    for (int a = 0; a < 2; ++a)
#pragma unroll
        for (int b = 0; b < 2; ++b)
#pragma unroll
            for (int m = 0; m < 4; ++m)
#pragma unroll
                for (int n = 0; n < 2; ++n) acc[a][b][m][n] = (f32x4){0.f, 0.f, 0.f, 0.f};
    bf16x8 At[4][2], B0[2][2], B1[2][2];
    const char* cA = PG8_APTR(cur); const char* cB = PG8_BPTR(cur);
    PG8_STAGEB(PG8_SB(0, 0), cB, voffB); PG8_STAGEB(PG8_SB(0, 1), cB + hstepB, voffB); PG8_STAGE(PG8_SA(0, 0), cA, voffA); PG8_STAGE(PG8_SA(0, 1), cA + hstepA, voffA);
    if (wr == 1) PG8_BAR;
    PG8_WAIT_V(2); PG8_BAR;
    PG8_STAGEB(PG8_SB(1, 0), cB + kstepB, voffB); PG8_STAGE(PG8_SA(1, 0), cA + kstepA, voffA); PG8_STAGEB(PG8_SB(1, 1), cB + hstepB + kstepB, voffB);
    PG8_WAIT_V(6); PG8_BAR;
    for (;;) {
        const bool has_next = S.next(ui + 1, nxt);
        const char* nA = has_next ? PG8_APTR(nxt) : cA; const char* nB = has_next ? PG8_BPTR(nxt) : cB;
        for (int t = 0; t < nt; t += 2) {
            const bool last = (t == nt - 2);
            const char* a1 = cA + (size_t)(t + 1) * kstepA;
            const char* a2 = last ? nA : cA + (size_t)(t + 2) * kstepA; const char* b2 = last ? nB : cB + (size_t)(t + 2) * kstepB;
            const char* a3 = a2 + kstepA; const char* b3 = b2 + kstepB;
            PG8_LDB(B0, 0, 0); PG8_LDB(B1, 0, 1); PG8_SCHED; PG8_LDA(At, 0, 0); PG8_STAGE(PG8_SA(1, 1), a1 + hstepA, voffA);
            PG8_WAIT_V(8); PG8_WAIT_L(0); PG8_BAR; PG8_MMA(0, 0, At, B0); PG8_MMA(0, 1, At, B1); PG8_BAR; PG8_SCHED;
            PG8_LDA(At, 0, 1); PG8_STAGEB(PG8_SB(0, 0), b2, voffB); PG8_STAGEB(PG8_SB(0, 1), b2 + hstepB, voffB); PG8_STAGE(PG8_SA(0, 0), a2, voffA);
            PG8_WAIT_V(8); PG8_WAIT_L(0); PG8_BAR; PG8_MMA(1, 0, At, B0); PG8_MMA(1, 1, At, B1); PG8_BAR; PG8_SCHED;
            PG8_LDB(B0, 1, 0); PG8_LDB(B1, 1, 1); PG8_SCHED; PG8_LDA(At, 1, 0); PG8_STAGE(PG8_SA(0, 1), a2 + hstepA, voffA);
            PG8_WAIT_V(8); PG8_WAIT_L(0); PG8_BAR; PG8_MMA(0, 0, At, B0); PG8_MMA(0, 1, At, B1); PG8_BAR; PG8_SCHED;
            PG8_LDA(At, 1, 1); PG8_STAGEB(PG8_SB(1, 0), b3, voffB); PG8_STAGEB(PG8_SB(1, 1), b3 + hstepB, voffB); PG8_STAGE(PG8_SA(1, 0), a3, voffA);
            PG8_WAIT_V(8); PG8_WAIT_L(0); PG8_BAR; PG8_MMA(1, 0, At, B0); PG8_MMA(1, 1, At, B1); PG8_BAR; PG8_SCHED;
        }
        if (wr == 0) PG8_BAR;
        PG8_TS(1 + 2 * ui);
        { unsigned z_ = 0u; asm volatile("" : "+v"(z_)); const int l2 = (int)__builtin_amdgcn_mbcnt_hi(~0u, __builtin_amdgcn_mbcnt_lo(~0u, z_));
          E(acc, cur, wr, wc, l2 & 15, l2 >> 4);
          E.done(cur, l2); }
        PG8_TS(2 + 2 * ui);
        if (!has_next) break;
#pragma unroll
        for (int a = 0; a < 2; ++a)
#pragma unroll
            for (int b = 0; b < 2; ++b)
#pragma unroll
                for (int m = 0; m < 4; ++m)
#pragma unroll
                    for (int n = 0; n < 2; ++n) acc[a][b][m][n] = (f32x4){0.f, 0.f, 0.f, 0.f};
        cur = nxt; cA = nA; cB = nB; ++ui;
        if (wr == 1) PG8_BAR;
    }
    PG8_WAIT_V(0);
    PG8_BAR;
    PG8_TS(7);
#undef PG8_SA
#undef PG8_SB
#undef PG8_STAGE
#undef PG8_STAGEB
#undef PG8_LDA
#undef PG8_LDB
#undef PG8_MMA
#undef PG8_WAIT_V
#undef PG8_WAIT_L
#undef PG8_BAR
#undef PG8_SCHED
#undef PG8_TS
#undef PG8_APTR
#undef PG8_BPTR
}
__device__ __forceinline__ int cond_of_pm(int pm) { return pm < 16 ? 0 : 1 + ((pm - 16) >> 2); }
__device__ __forceinline__ int kvrow_of(int row) { return row < MC ? row : MC + ((row - MC) >> 10) * (PAST + DSEQ) + PAST + ((row - MC) & 1023); }
__device__ __forceinline__ u32x4 pack8(const f32x4& a, const f32x4& b) { u32x4 w; w.x = cvt_pk_bf16(a[0], a[1]); w.y = cvt_pk_bf16(a[2], a[3]); w.z = cvt_pk_bf16(b[0], b[1]); w.w = cvt_pk_bf16(b[2], b[3]); return w; }

struct EpiIn {
    static constexpr bool PERM = true; static constexpr bool BLK2 = false;
    const float* sumsq; const float* bias; const float* qn; const float* kn; const LAS f32x2* rope;
    bf16_t* Q; bf16_t* KB; bf16_t* VB; __amdgpu_buffer_rsrc_t as3r; float* new_k; float* new_v; int l; unsigned* ucnt;
    __device__ __forceinline__ void done(const Unit& u, int lane) const {
        if (u.pn >= 6) { asm volatile("s_waitcnt vmcnt(0)" ::: "memory"); if (lane == 0) __hip_atomic_fetch_add(ucnt + (((u.pm >> 4) * 2) + (u.pn - 6)) * 64, 1u, RLX_AGENT); } }
    __device__ __forceinline__ void operator()(const f32x4 (&acc)[2][2][4][2], const Unit& u, int wr, int wc, int fr, int fq) const {
        const int pm = u.pm, pn = u.pn; const bool ctx = pm < 16; const int cond = cond_of_pm(pm);
        const float* bz = bias + cond * 2048 + pn * 256 + wc * 32 + 8 * fq;
        f32x4 bv[2][2];
#pragma unroll
        for (int bj = 0; bj < 2; ++bj)
#pragma unroll
            for (int n = 0; n < 2; ++n) bv[bj][n] = *(const f32x4*)(bz + bj * 128 + 4 * n);
        const int rbase = pm * BM + wr * 64 + fr;
        float rsd[8];
#pragma unroll
        for (int g8 = 0; g8 < 8; ++g8) rsd[g8] = sumsq[rbase + (g8 >> 2) * HALF + (g8 & 3) * 16];
#pragma unroll
        for (int g8 = 0; g8 < 8; ++g8) rsd[g8] = rsqrtf(rsd[g8] * (1.f / DM) + EPS);
        if (pn < 4) {
            const bool isq = pn < 2; const float* gv = isq ? qn : kn;
            const int G = (pn & 1) * 4 + wc;
            const int cb = 32 * (fq >> 1) + 8 * (fq & 1);
            f32x4 gg[2][2];
#pragma unroll
            for (int bj = 0; bj < 2; ++bj)
#pragma unroll
                for (int n = 0; n < 2; ++n) gg[bj][n] = *(const f32x4*)(gv + cb + 16 * bj + 4 * n);
            const float qs = isq ? C2 : 1.f;
#pragma unroll
            for (int ai = 0; ai < 2; ++ai)
#pragma unroll
                for (int m = 0; m < 4; ++m) {
                    const int row = rbase + ai * HALF + m * 16;
                    const float rstd = rsd[ai * 4 + m];
                    f32x4 v[2][2]; float ss = 0.f;
#pragma unroll
                    for (int bj = 0; bj < 2; ++bj)
#pragma unroll
                        for (int n = 0; n < 2; ++n) { v[bj][n] = acc[ai][bj][m][n] * rstd + bv[bj][n]; const f32x4 t = v[bj][n] * v[bj][n]; ss += (t[0] + t[1]) + (t[2] + t[3]); }
                    { const int ln_ = fq * 16 + fr; ss += shfl_xor_l(ss, 16, ln_); ss += shfl_xor_l(ss, 32, ln_); }
                    const float rn = rsqrtf(ss * (1.f / 64.f) + EPS);
#pragma unroll
                    for (int bj = 0; bj < 2; ++bj)
#pragma unroll
                        for (int n = 0; n < 2; ++n) v[bj][n] = v[bj][n] * rn * gg[bj][n];
                    if (ctx) {
                        if (!isq) { float* nk = new_k + ((size_t)((row >> 8) * DEPTH + l) * SEQ + (row & 255)) * 512 + G * 64 + cb;
#pragma unroll
                            for (int bj = 0; bj < 2; ++bj) { __builtin_nontemporal_store(v[bj][0], (f32x4*)(nk + 16 * bj)); __builtin_nontemporal_store(v[bj][1], (f32x4*)(nk + 16 * bj + 4)); } }
                    } else {
                        const int t = (row - MC) & 1023; const int pos = (fq >> 1) ? (t & 63) : (t >> 6);
                        const LAS f32x2* rp = rope + pos * 17 + 8 * (fq & 1);
#pragma unroll
                        for (int n = 0; n < 2; ++n)
#pragma unroll
                            for (int j = 0; j < 4; ++j) { const f32x2 cs = rp[4 * n + j]; const float x1 = v[0][n][j], x2 = v[1][n][j]; v[0][n][j] = x1 * cs.x - x2 * cs.y; v[1][n][j] = x1 * cs.y + x2 * cs.x; }
                    }
                    bf16_t* dst = isq ? (Q + (size_t)row * 512) : (KB + (size_t)kvrow_of(row) * 512);
                    dst += G * 64 + cb;
#pragma unroll
                    for (int bj = 0; bj < 2; ++bj) *(u32x4*)(dst + 16 * bj) = pack8(v[bj][0] * qs, v[bj][1] * qs);
                }
        } else if (pn < 6) {
            const int col0 = (pn - 4) * 256 + wc * 32 + 8 * fq;
#pragma unroll
            for (int ai = 0; ai < 2; ++ai)
#pragma unroll
                for (int m = 0; m < 4; ++m) {
                    const int row = rbase + ai * HALF + m * 16;
                    const float rstd = rsd[ai * 4 + m];
                    bf16_t* dst = VB + (size_t)kvrow_of(row) * 512 + col0;
#pragma unroll
                    for (int bj = 0; bj < 2; ++bj) { const f32x4 a = acc[ai][bj][m][0] * rstd + bv[bj][0], b = acc[ai][bj][m][1] * rstd + bv[bj][1];
                        *(u32x4*)(dst + 128 * bj) = pack8(a, b);
                        if (ctx) { float* nv = new_v + ((size_t)((row >> 8) * DEPTH + l) * SEQ + (row & 255)) * 512 + col0 + 128 * bj; __builtin_nontemporal_store(a, (f32x4*)nv); __builtin_nontemporal_store(b, (f32x4*)(nv + 4)); } }
                }
        } else {
            const int cu0 = (pn - 6) * 256 + wc * 32 + 8 * fq;
#pragma unroll
            for (int ai = 0; ai < 2; ++ai)
#pragma unroll
                for (int m = 0; m < 4; ++m) {
                    const int row = rbase + ai * HALF + m * 16;
                    const float rstd = rsd[ai * 4 + m];
#pragma unroll
                    for (int bj = 0; bj < 2; ++bj) { const int cu = cu0 + 128 * bj; const f32x4 a = acc[ai][bj][m][0] * rstd + bv[bj][0], b = acc[ai][bj][m][1] * rstd + bv[bj][1];
                        __builtin_amdgcn_raw_buffer_store_b128(pack8(a, b), as3r, (int)(((unsigned)((cu >> 4) * NCHUNK + (row >> 4)) * 512u + (row & 15) * 16 + (cu & 15)) * 2u), 0,   16); }
                }
        }
    }
};
struct EpiS1 {
    static constexpr bool PERM = false; static constexpr bool BLK2 = false;
    bf16_t* E;
    __device__ __forceinline__ void done(const Unit&, int) const {}
    __device__ __forceinline__ void operator()(const f32x4 (&acc)[2][2][4][2], const Unit& u, int wr, int wc, int fr, int fq) const {
        const int rbase = u.pm * BM + wr * 64 + fr, col0 = wc * 32 + 4 * fq;
#pragma unroll
        for (int ai = 0; ai < 2; ++ai)
#pragma unroll
            for (int m = 0; m < 4; ++m) { bf16_t* dst = E + ((size_t)u.g * NCHUNK + rbase + ai * HALF + m * 16) * 256 + col0;
#pragma unroll
                for (int bj = 0; bj < 2; ++bj)
#pragma unroll
                    for (int n = 0; n < 2; ++n) { const f32x4 a = acc[ai][bj][m][n]; u32x2 w; w.x = cvt_pk_bf16(a[0], a[1]); w.y = cvt_pk_bf16(a[2], a[3]); *(u32x2*)(dst + bj * HALF + n * 16) = w; } }
    }
};
struct EpiS3 {
    static constexpr bool PERM = true; static constexpr bool BLK2 = false;
    __amdgpu_buffer_rsrc_t zr;
    __device__ __forceinline__ void done(const Unit&, int) const {}
    __device__ __forceinline__ void operator()(const f32x4 (&acc)[2][2][4][2], const Unit& u, int wr, int wc, int fr, int fq) const {
        const int rbase = u.pm * BM + wr * 64 + fr;
#pragma unroll
        for (int ai = 0; ai < 2; ++ai)
#pragma unroll
            for (int m = 0; m < 4; ++m) { const int chunk = rbase + ai * HALF + m * 16;
#pragma unroll
                for (int bj = 0; bj < 2; ++bj) { const int tt = 8 * bj + 2 * wc + (fq >> 1), c0 = 8 * (fq & 1);
                    f32x4 a = acc[ai][bj][m][0], b = acc[ai][bj][m][1];
#pragma unroll
                    for (int j = 0; j < 4; ++j) { a[j] = gelu_tanh_f(a[j]); b[j] = gelu_tanh_f(b[j]); }
                    __builtin_amdgcn_raw_buffer_store_b128(pack8(a, b), zr, (int)(((((unsigned)chunk * 32u + u.g) * 16u + tt) * 16u + c0) * 2u), 0,   16); } }
    }
};
struct EpiGlu {
    static constexpr bool PERM = true; static constexpr bool BLK2 = false;
    const bf16_t* Z; const float* bg; bf16_t* CAT;
    __device__ __forceinline__ void done(const Unit&, int) const {}
    __device__ __forceinline__ void operator()(const f32x4 (&acc)[2][2][4][2], const Unit& u, int wr, int wc, int fr, int fq) const {
        const int rbase = u.pm * BM + wr * 64 + fr, col0 = u.pn * BM + wc * 32 + 8 * fq;
        f32x4 bv[2][2];
#pragma unroll
        for (int bj = 0; bj < 2; ++bj)
#pragma unroll
            for (int n = 0; n < 2; ++n) bv[bj][n] = *(const f32x4*)(bg + col0 + bj * HALF + 4 * n);
#pragma unroll
        for (int ai = 0; ai < 2; ++ai)
#pragma unroll
            for (int m = 0; m < 4; ++m) { const int row = rbase + ai * HALF + m * 16;
#pragma unroll
                for (int bj = 0; bj < 2; ++bj) { const int cz = col0 + bj * HALF; const u32x4 zw = *(const u32x4*)(Z + ((size_t)(row >> 4) * 32 + (cz >> 4)) * 256 + (row & 15) * 16 + (cz & 15));
                    f32x4 a = acc[ai][bj][m][0] + bv[bj][0], b = acc[ai][bj][m][1] + bv[bj][1];
                    a[0] = bflo(zw.x) * sigmoid_f(a[0]); a[1] = bfhi(zw.x) * sigmoid_f(a[1]); a[2] = bflo(zw.y) * sigmoid_f(a[2]); a[3] = bfhi(zw.y) * sigmoid_f(a[3]);
                    b[0] = bflo(zw.z) * sigmoid_f(b[0]); b[1] = bfhi(zw.z) * sigmoid_f(b[1]); b[2] = bflo(zw.w) * sigmoid_f(b[2]); b[3] = bfhi(zw.w) * sigmoid_f(b[3]);
                    *(u32x4*)(CAT + (size_t)row * 1024 + 512 + col0 + bj * HALF) = pack8(a, b); } }
    }
};
template <bool IN_F32, bool OUT_F32> struct EpiRes {
    static constexpr bool PERM = true; static constexpr bool BLK2 = true;
    const float* xin0; const float* xin1;
    const bf16_t* xrin;
    float* xout; bf16_t* xrout;
    const float* gate;
    const float* gn; const float* sc;
    bf16_t* XS; float* ssq;
    __device__ __forceinline__ void done(const Unit&, int) const {}
    __device__ __forceinline__ void operator()(const f32x4 (&acc)[2][2][4][2], const Unit& u, int wr, int wc, int fr, int fq) const {
        const int pm = u.pm, cond = cond_of_pm(pm); const int col0 = u.pn * BM + wc * 64 + 8 * fq; const int rbase = pm * BM + wr * 64 + fr;
        const bool donorm = (gn != nullptr);
        f32x4 gt[2][2], gs[2][2];
#pragma unroll
        for (int bj = 0; bj < 2; ++bj)
#pragma unroll
            for (int n = 0; n < 2; ++n) { const int c = col0 + bj * 32 + n * 4; gt[bj][n] = *(const f32x4*)(gate + cond * 6144 + c);
                if (donorm) { const f32x4 g4 = *(const f32x4*)(gn + c), s4 = *(const f32x4*)(sc + cond * 6144 + c); gs[bj][n] = g4 * (s4 + 1.f); } else gs[bj][n] = (f32x4){0.f, 0.f, 0.f, 0.f}; }
        constexpr int RD = IN_F32 ? 2 : 4;
        f32x4 xr[RD][2][2]; u32x4 xb[RD][2];
#define ER_LOAD(G_, SLOT_) do { const int row_ = rbase + ((G_) >> 2) * HALF + ((G_) & 3) * 16; \
            if (IN_F32) { const float* xi_ = (row_ < MC) ? (xin0 + (size_t)row_ * DM) : (xin1 + (size_t)(row_ - MC) * DM); \
                _Pragma("unroll") for (int bj = 0; bj < 2; ++bj) { xr[SLOT_][bj][0] = *(const f32x4*)(xi_ + col0 + bj * 32); xr[SLOT_][bj][1] = *(const f32x4*)(xi_ + col0 + bj * 32 + 4); } } \
            else { _Pragma("unroll") for (int bj = 0; bj < 2; ++bj) xb[SLOT_][bj] = *(const u32x4*)(xrin + (size_t)row_ * DM + col0 + bj * 32); } } while (0)
#pragma unroll
        for (int g0 = 0; g0 < RD; ++g0) ER_LOAD(g0, g0);
        float ssv[8];
#pragma unroll
        for (int g = 0; g < 8; ++g) { const int ai = g >> 2, m = g & 3, sl = g % RD; const int row = rbase + ai * HALF + m * 16;
            float ss = 0.f; f32x4 x0[2], x1[2];
#pragma unroll
            for (int bj = 0; bj < 2; ++bj) { f32x4 a, b;
                if (IN_F32) { a = xr[sl][bj][0]; b = xr[sl][bj][1]; } else { const u32x4 w = xb[sl][bj]; a = (f32x4){bflo(w.x), bfhi(w.x), bflo(w.y), bfhi(w.y)}; b = (f32x4){bflo(w.z), bfhi(w.z), bflo(w.w), bfhi(w.w)}; }
                x0[bj] = a + gt[bj][0] * acc[ai][bj][m][0]; x1[bj] = b + gt[bj][1] * acc[ai][bj][m][1]; }
            if (g + RD < 8) ER_LOAD(g + RD, sl);
#pragma unroll
            for (int bj = 0; bj < 2; ++bj) { const int c = col0 + bj * 32;
                if (OUT_F32) { __builtin_nontemporal_store(x0[bj], (f32x4*)(xout + (size_t)row * DM + c)); __builtin_nontemporal_store(x1[bj], (f32x4*)(xout + (size_t)row * DM + c + 4)); }
                else *(u32x4*)(xrout + (size_t)row * DM + c) = pack8(x0[bj], x1[bj]);
                if (donorm) { const f32x4 t0 = x0[bj] * x0[bj], t1 = x1[bj] * x1[bj]; ss += ((t0[0] + t0[1]) + (t0[2] + t0[3])) + ((t1[0] + t1[1]) + (t1[2] + t1[3]));
                    *(u32x4*)(XS + (size_t)row * DM + c) = pack8(x0[bj] * gs[bj][0], x1[bj] * gs[bj][1]); } }
            if (donorm) { { const int ln_ = fq * 16 + fr; ss += shfl_xor_l(ss, 16, ln_); ss += shfl_xor_l(ss, 32, ln_); } ssv[g] = ss; }
        }
        if (donorm && fq == 0) {
#pragma unroll
            for (int g = 0; g < 8; ++g) atomicAdd(ssq + rbase + (g >> 2) * HALF + (g & 3) * 16, ssv[g]); }
#undef ER_LOAD
    }
};
struct EpiUp {
    static constexpr bool PERM = true; static constexpr bool BLK2 = false;
    const float* sumsq; const float* bias; bf16_t* UP;
    __device__ __forceinline__ void done(const Unit&, int) const {}
    __device__ __forceinline__ void operator()(const f32x4 (&acc)[2][2][4][2], const Unit& u, int wr, int wc, int fr, int fq) const {
        const int pm = u.pm, cond = cond_of_pm(pm); const int col0 = u.pn * BM + wc * 32 + 8 * fq; const int rbase = pm * BM + wr * 64 + fr;
        f32x4 bv[2][2];
#pragma unroll
        for (int bj = 0; bj < 2; ++bj)
#pragma unroll
            for (int n = 0; n < 2; ++n) bv[bj][n] = *(const f32x4*)(bias + cond * 4096 + col0 + bj * HALF + 4 * n);
#pragma unroll
        for (int ai = 0; ai < 2; ++ai)
#pragma unroll
            for (int m = 0; m < 4; ++m) { const int row = rbase + ai * HALF + m * 16; const float rstd = rsqrtf(sumsq[row] * (1.f / DM) + EPS);
#pragma unroll
                for (int bj = 0; bj < 2; ++bj) *(u32x4*)(UP + (size_t)row * 4096 + col0 + bj * HALF) = pack8(acc[ai][bj][m][0] * rstd + bv[bj][0], acc[ai][bj][m][1] * rstd + bv[bj][1]); }
    }
};

__device__ __forceinline__ float dpp_shr1(float v) { return __uint_as_float((unsigned)__builtin_amdgcn_update_dpp(0, (int)__float_as_uint(v), 0x111, 0xf, 0xf, false)); }
__device__ __forceinline__ float dpp_shl1(float v) { return __uint_as_float((unsigned)__builtin_amdgcn_update_dpp(0, (int)__float_as_uint(v), 0x101, 0xf, 0xf, false)); }
struct EpiUpConv {
    static constexpr bool PERM = true; static constexpr bool BLK2 = false;
    const float* sumsq; const float* bias; const float* cw; const float* cb; bf16_t* G; bf16_t* HALO;
    __device__ __forceinline__ void done(const Unit&, int) const {}
    __device__ __forceinline__ void operator()(const f32x4 (&acc)[2][2][4][2], const Unit& u, int wr, int wc, int fr, int fq) const {
        const int pm = u.pm, pn = u.pn, cond = cond_of_pm(pm);
        const int posv = pn * 256 + wc * 32 + 8 * fq, av = pn * 128 + wc * 32 + 8 * fq;
        float rs[2][4];
#pragma unroll
        for (int ai = 0; ai < 2; ++ai)
#pragma unroll
            for (int m = 0; m < 4; ++m) rs[ai][m] = sumsq[pm * BM + ai * HALF + wr * 64 + 4 * fr + m];
#pragma unroll
        for (int ai = 0; ai < 2; ++ai)
#pragma unroll
            for (int m = 0; m < 4; ++m) rs[ai][m] = rsqrtf(rs[ai][m] * (1.f / DM) + EPS);
#pragma unroll
        for (int n = 0; n < 2; ++n) {
            const int c = av + 4 * n;
            const f32x4 bvv = *(const f32x4*)(bias + cond * 4096 + posv + 4 * n), bvg = *(const f32x4*)(bias + cond * 4096 + posv + 128 + 4 * n);
            const f32x4 w0v = *(const f32x4*)(cw + c), w1v = *(const f32x4*)(cw + 4096 + c), w2v = *(const f32x4*)(cw + 8192 + c), cbv = *(const f32x4*)(cb + c);
            const f32x4 w0g = *(const f32x4*)(cw + 2048 + c), w1g = *(const f32x4*)(cw + 4096 + 2048 + c), w2g = *(const f32x4*)(cw + 8192 + 2048 + c), cbg = *(const f32x4*)(cb + 2048 + c);
#pragma unroll
            for (int ai = 0; ai < 2; ++ai) {
                const int tok0 = pm * BM + ai * HALF + wr * 64 + 4 * fr; const int sl = pm * 4 + ai * 2 + wr;
                f32x4 pv[4], pg[4];
#pragma unroll
                for (int m = 0; m < 4; ++m) { pv[m] = acc[ai][0][m][n] * rs[ai][m] + bvv; pg[m] = acc[ai][1][m][n] * rs[ai][m] + bvg; }
                f32x4 pvp, pvn, pgp, pgn;
#pragma unroll
                for (int j = 0; j < 4; ++j) { pvp[j] = dpp_shr1(pv[3][j]); pvn[j] = dpp_shl1(pv[0][j]); pgp[j] = dpp_shr1(pg[3][j]); pgn[j] = dpp_shl1(pg[0][j]); }
#pragma unroll
                for (int m = 0; m < 4; ++m) {
                    const f32x4 zv = cbv + w0v * (m == 0 ? pvp : pv[m == 0 ? 0 : m - 1]) + w1v * pv[m] + w2v * (m == 3 ? pvn : pv[m == 3 ? 3 : m + 1]);
                    const f32x4 zg = cbg + w0g * (m == 0 ? pgp : pg[m == 0 ? 0 : m - 1]) + w1g * pg[m] + w2g * (m == 3 ? pgn : pg[m == 3 ? 3 : m + 1]);
                    u32x2 w; w.x = cvt_pk_bf16(silu_f(zg[0]) * zv[0], silu_f(zg[1]) * zv[1]); w.y = cvt_pk_bf16(silu_f(zg[2]) * zv[2], silu_f(zg[3]) * zv[3]);
                    *(u32x2*)(G + (size_t)(tok0 + m) * 2048 + c) = w; }
                if (fr == 0 || fr == 15) { const int m0 = fr == 0 ? 0 : 2;
#pragma unroll
                    for (int mm = 0; mm < 2; ++mm) { const f32x4 a = fr == 0 ? pv[mm] : pv[2 + mm], b = fr == 0 ? pg[mm] : pg[2 + mm];
                        bf16_t* hp = HALO + ((size_t)sl * 4 + m0 + mm) * 4096 + posv + 4 * n;
                        u32x2 wa; wa.x = cvt_pk_bf16(a[0], a[1]); wa.y = cvt_pk_bf16(a[2], a[3]); *(u32x2*)hp = wa;
                        u32x2 wb; wb.x = cvt_pk_bf16(b[0], b[1]); wb.y = cvt_pk_bf16(b[2], b[3]); *(u32x2*)(hp + 128) = wb; } }
            }
        }
    }
};
constexpr int AT_SLOT = 32768, AT_NSLOT = 4, AT_VOFF = 16384, AT_X = 0, AT_ST = 65536;
__device__ __forceinline__ void glds16(const void* gsrc, unsigned lds_dst) { unsigned keep;
    asm volatile("s_mov_b32 %0, m0\n\ts_mov_b32 m0, %2\n\ts_nop 0\n\tglobal_load_lds_dwordx4 %1, off\n\ts_mov_b32 m0, %0" : "=&s"(keep) : "v"(gsrc), "s"(lds_dst) : "memory"); }
#define AT_WAIT_BAR(N) asm volatile("s_waitcnt vmcnt(" #N ") lgkmcnt(0)\n\ts_barrier" ::: "memory")
#define AT_SB() __builtin_amdgcn_sched_barrier(0)
__device__ __forceinline__ s16x4 vtr(const LAS char* p) { typedef short v4i16_t __attribute__((ext_vector_type(4))); return __builtin_bit_cast(s16x4, __builtin_amdgcn_ds_read_tr16_b64_v4i16((LAS v4i16_t*)p)); }
__device__ __forceinline__ int crow(int r, int hi) { return (r & 3) + 8 * (r >> 2) + 4 * hi; }

struct AttnArgs { const bf16_t* Q; const bf16_t* KB; const bf16_t* VB; bf16_t* CAT; const float* subln; float lam; float oml; };

__device__ __forceinline__ void attn_unit(LAS unsigned char* lds, const int tid, const AttnArgs& A, int seq, int h, int qblk) {
    const int lane = tid & 63, r32 = lane & 31, hi = lane >> 5; const int wid = __builtin_amdgcn_readfirstlane(tid >> 6);
    const int rg = wid & 3, s = wid >> 2;
    const bool ctx = seq < NB;
    const int qrow0 = ctx ? seq * SEQ + qblk * 128 : MC + (seq - NB) * DSEQ + qblk * 128;
    const int krow0 = ctx ? seq * SEQ : MC + (seq - NB) * (PAST + DSEQ);
    const int NT = ctx ? SEQ / 64 : (PAST + DSEQ) / 64;
    const unsigned lds0 = (unsigned)(uintptr_t)lds;
    const int krow_l = 8 * wid + (lane >> 4), kch0 = (lane & 15) ^ (krow_l & 15);
    const bf16_t* ksrc0 = A.KB + (size_t)(krow0 + krow_l) * 512 + h * 128 + kch0 * 8;
    const int kd1 = 4 * 512 + ((kch0 & 4) ? -32 : 32);
    const bf16_t* vsrc0 = A.VB + (size_t)(krow0 + 16 * (wid & 3) + (lane >> 2)) * 512 + h * 128 + (wid >> 2) * 32 + (lane & 3) * 8;
    const unsigned kdst = lds0 + wid * 2048, vdst = lds0 + AT_VOFF + ((wid >> 2) * 4 + (wid & 3)) * 1024;
#define AT_DMA(t, slot) do { const size_t _o = (size_t)(t) * 64 * 512; const unsigned _s = (unsigned)(slot) * AT_SLOT; \
        glds16(ksrc0 + _o, (unsigned)__builtin_amdgcn_readfirstlane(kdst + _s)); glds16(ksrc0 + _o + kd1, (unsigned)__builtin_amdgcn_readfirstlane(kdst + _s + 1024)); \
        glds16(vsrc0 + _o, (unsigned)__builtin_amdgcn_readfirstlane(vdst + _s)); glds16(vsrc0 + _o + 64, (unsigned)__builtin_amdgcn_readfirstlane(vdst + _s + 8 * 1024)); } while (0)
    AT_DMA(0, 0); AT_DMA(1, 1); AT_DMA(2, 2);
    bf16x8 qr[4];
    { const bf16_t* qp = A.Q + (size_t)(qrow0 + rg * 32 + r32) * 512 + h * 128 + s * 64 + hi * 8;
#pragma unroll
      for (int d0 = 0; d0 < 4; ++d0) qr[d0] = *(const bf16x8*)(qp + d0 * 16); }
    f32x16 o[4];
#pragma unroll
    for (int d0 = 0; d0 < 4; ++d0)
#pragma unroll
        for (int r = 0; r < 16; ++r) o[d0][r] = 0.f;
    float lsum = 0.f;
    const unsigned kb0 = (unsigned)(r32 * 256 + (((s * 8 + hi) ^ (r32 & 15)) << 4));
    const LAS char* kfrag0 = (const LAS char*)lds;
    const LAS char* vfrag0 = (const LAS char*)lds + AT_VOFF + ((lane >> 4) & 1) * 32 + (lane & 3) * 8 + (4 * hi + ((lane & 15) >> 2)) * 64;
    f32x16 pc0, pc1;
#define AT_KLOAD(kfr, slot) do { const LAS char* _k = kfrag0 + (slot) * AT_SLOT; _Pragma("unroll") for (int d0 = 0; d0 < 4; ++d0) { kfr[2 * d0] = *(const LAS bf16x8*)(_k + (kb0 ^ (unsigned)(d0 << 5))); kfr[2 * d0 + 1] = *(const LAS bf16x8*)(_k + (kb0 ^ (unsigned)(d0 << 5)) + 8192); } } while (0)
#define AT_VLOAD(vv, slot, ks) do { const LAS char* _v = vfrag0 + (slot) * AT_SLOT + (ks) * 1024; _Pragma("unroll") for (int d0 = 0; d0 < 4; ++d0) { const s16x4 lo = vtr(_v + d0 * 4096), hh = vtr(_v + d0 * 4096 + 512); \
        vv[d0] = (bf16x8){lo[0], lo[1], lo[2], lo[3], hh[0], hh[1], hh[2], hh[3]}; } } while (0)
#define AT_EXP2(P, i, W) do { P[2 * (i)] = fast_exp2(P[2 * (i)]); P[2 * (i) + 1] = fast_exp2(P[2 * (i) + 1]); sacc += P[2 * (i)] + P[2 * (i) + 1]; W = cvt_pk_bf16(P[2 * (i)], P[2 * (i) + 1]); } while (0)
    AT_WAIT_BAR(8);
    { bf16x8 kfr[8]; AT_KLOAD(kfr, 0);
#pragma unroll
      for (int r = 0; r < 16; ++r) { pc0[r] = 0.f; pc1[r] = 0.f; }
#pragma unroll
      for (int d0 = 0; d0 < 4; ++d0) { pc0 = __builtin_amdgcn_mfma_f32_32x32x16_bf16(kfr[2 * d0], qr[d0], pc0, 0, 0, 0); pc1 = __builtin_amdgcn_mfma_f32_32x32x16_bf16(kfr[2 * d0 + 1], qr[d0], pc1, 0, 0, 0); } }
    int slot = 0;
    for (int t = 0; t < NT; ++t) {
        const bool has_next = t + 1 < NT;
        if (t + 2 < NT) AT_WAIT_BAR(4); else AT_WAIT_BAR(0);
        if (t + 3 < NT) AT_DMA(t + 3, (slot + 3) & 3);
        const int slot_n = (slot + 1) & 3;
        bf16x8 kfr[8], va[4], vb[4]; u32x4 pw[4]; f32x16 pn0, pn1; float sacc = 0.f;
        const LAS char* kn_ = kfrag0 + slot_n * AT_SLOT;
#define AT_K1(d0) do { kfr[2 * (d0)] = *(const LAS bf16x8*)(kn_ + (kb0 ^ (unsigned)((d0) << 5))); kfr[2 * (d0) + 1] = *(const LAS bf16x8*)(kn_ + (kb0 ^ (unsigned)((d0) << 5)) + 8192); } while (0)
        if (has_next) { AT_K1(0); AT_K1(1); }
        AT_SB();
        if (has_next) {
#pragma unroll
            for (int r = 0; r < 16; ++r) { pn0[r] = 0.f; pn1[r] = 0.f; }
#pragma unroll
            for (int i = 0; i < 8; ++i) { const int d0 = i >> 1;
                if (i & 1) pn1 = __builtin_amdgcn_mfma_f32_32x32x16_bf16(kfr[2 * d0 + 1], qr[d0], pn1, 0, 0, 0); else pn0 = __builtin_amdgcn_mfma_f32_32x32x16_bf16(kfr[2 * d0], qr[d0], pn0, 0, 0, 0);
                AT_EXP2(pc0, i, pw[i >> 2][i & 3]);
                if (i == 0) AT_K1(2);
                if (i == 1) AT_K1(3);
                if (i == 3) AT_VLOAD(va, slot, 0);
                if (i == 5) AT_VLOAD(vb, slot, 1);
                AT_SB(); }
        } else {
            AT_VLOAD(va, slot, 0); AT_VLOAD(vb, slot, 1);
#pragma unroll
            for (int i = 0; i < 8; ++i) AT_EXP2(pc0, i, pw[i >> 2][i & 3]);
            AT_SB();
        }
        bf16x8 vc[4], vd[4];
#pragma unroll
        for (int i = 0; i < 8; ++i) { const int d0 = i & 3;
            if (i < 4) o[d0] = __builtin_amdgcn_mfma_f32_32x32x16_bf16(va[d0], __builtin_bit_cast(bf16x8, pw[0]), o[d0], 0, 0, 0);
            else       o[d0] = __builtin_amdgcn_mfma_f32_32x32x16_bf16(vb[d0], __builtin_bit_cast(bf16x8, pw[1]), o[d0], 0, 0, 0);
            AT_EXP2(pc1, i, pw[2 + (i >> 2)][i & 3]);
            if (i == 1) AT_VLOAD(vc, slot, 2);
            if (i == 5) AT_VLOAD(vd, slot, 3);
            AT_SB(); }
#pragma unroll
        for (int d0 = 0; d0 < 4; ++d0) o[d0] = __builtin_amdgcn_mfma_f32_32x32x16_bf16(vc[d0], __builtin_bit_cast(bf16x8, pw[2]), o[d0], 0, 0, 0);
#pragma unroll
        for (int d0 = 0; d0 < 4; ++d0) o[d0] = __builtin_amdgcn_mfma_f32_32x32x16_bf16(vd[d0], __builtin_bit_cast(bf16x8, pw[3]), o[d0], 0, 0, 0);
        lsum += sacc;
        if (has_next) { pc0 = pn0; pc1 = pn1; }
        slot = slot_n;
    }
    lsum += shfl_xor_l(lsum, 32, lane);
    const float inv = (s == 0 ? 1.f : A.lam) / lsum;
    AT_WAIT_BAR(0);
    LAS float* X = (LAS float*)(lds + AT_X) + rg * 4096;
    if (s == 1) {
#pragma unroll
        for (int d0 = 0; d0 < 4; ++d0)
#pragma unroll
            for (int r = 0; r < 16; ++r) X[(d0 * 16 + r) * 64 + lane] = o[d0][r] * inv;
    }
    AT_WAIT_BAR(0);
    if (s == 0) {
        float ss = 0.f;
#pragma unroll
        for (int d0 = 0; d0 < 4; ++d0)
#pragma unroll
            for (int r = 0; r < 16; ++r) { const float v = o[d0][r] * inv - X[(d0 * 16 + r) * 64 + lane]; o[d0][r] = v; ss += v * v; }
        ss += shfl_xor_l(ss, 32, lane);
        const float rn = rsqrtf(ss * (1.f / 128.f) + EPS) * A.oml;
        LAS bf16_t* stg = (LAS bf16_t*)(lds + AT_ST) + rg * (32 * 136);
#pragma unroll
        for (int d0 = 0; d0 < 4; ++d0)
#pragma unroll
            for (int rq = 0; rq < 4; ++rq) { const int dv = 32 * d0 + 8 * rq + 4 * hi; const f32x4 g4 = *(const f32x4*)(A.subln + dv);
                u32x2 w; w.x = cvt_pk_bf16(o[d0][4 * rq] * rn * g4[0], o[d0][4 * rq + 1] * rn * g4[1]); w.y = cvt_pk_bf16(o[d0][4 * rq + 2] * rn * g4[2], o[d0][4 * rq + 3] * rn * g4[3]);
                *(LAS u32x2*)(stg + r32 * 136 + dv) = w; }
        asm volatile("s_waitcnt lgkmcnt(0)" ::: "memory");
        bf16_t* dst = A.CAT + (size_t)(qrow0 + rg * 32) * 1024 + h * 128;
#pragma unroll
        for (int i = 0; i < 8; ++i) { const int row = i * 4 + (lane >> 4), ch = lane & 15; const u32x4 v = *(const LAS u32x4*)(stg + row * 136 + ch * 8); *(u32x4*)(dst + (size_t)row * 1024 + ch * 8) = v; }
    }
    AT_WAIT_BAR(0);
#undef AT_DMA
#undef AT_KLOAD
#undef AT_K1
#undef AT_VLOAD
#undef AT_EXP2
}
struct Args { const float* in[34]; float* out; unsigned char* ws; int stop_after; int pad; };
struct ArgsG { GAS const float* in[34]; GAS float* out; GAS unsigned char* ws; int stop_after; int pad; };
typedef const __attribute__((address_space(4))) ArgsG* kargs_t;
struct Frame {
    LAS unsigned char* lds; int tid, lane, wave, vcu, bid, G;
    kargs_t ka; float* out; unsigned char* ws;
    float* misc; unsigned* ctl;
};
#define LDS_WAIT() asm volatile("s_waitcnt lgkmcnt(0)" ::: "memory")
#define VM_WAIT() asm volatile("s_waitcnt vmcnt(0)" ::: "memory")

template <int MAP> __device__ __forceinline__ int src_col(int p);
template <int MODE, int MAP, int NC> __device__ __forceinline__ void gemv9_task(Frame& F, const float* W, int ldw, int l, int voff, int strip, float* out, int ldo, const float* add) {
    LAS float* sc = (LAS float*)F.lds; LAS float* red = sc + 9 * 1024;
    for (int i = F.tid; i < 9 * 1024; i += NTHREADS) { const int cond = i >> 10, k = i & 1023; float v;
        if (MODE == 0) { v = cond == 0 ? ((const float*)F.ka->in[6])[k] : ((const float*)F.ka->in[5])[(cond - 1) * 1024 + k]; v = v / (1.f + expf(-v)); } else v = F.misc[MI_MOD + (l * 9 + cond) * 6144 + voff + k];
        sc[i] = v; }
    __syncthreads();
    const int j = strip * NC + (F.lane < NC ? F.lane : NC - 1); const float* w = W + (size_t)(F.wave * 128) * ldw + src_col<MAP>(j);
    float acc[9];
#pragma unroll
    for (int b = 0; b < 9; ++b) acc[b] = 0.f;
#pragma unroll 16
    for (int k = 0; k < 128; ++k) { const float wv = w[(size_t)k * ldw];
#pragma unroll
        for (int b = 0; b < 9; ++b) acc[b] += sc[b * 1024 + F.wave * 128 + k] * wv; }
#pragma unroll
    for (int b = 0; b < 9; ++b) red[(F.wave * 9 + b) * 64 + F.lane] = acc[b];
    __syncthreads();
    for (int i = F.tid; i < 9 * 64; i += NTHREADS) { const int b = i >> 6, ln = i & 63; if (ln >= NC) continue; float s_ = 0.f;
#pragma unroll
        for (int w8 = 0; w8 < 8; ++w8) s_ += red[(w8 * 9 + b) * 64 + ln];
        const int jj = strip * NC + ln; out[(size_t)b * ldo + jj] = s_ + (add ? add[jj] : 0.f); }
    __syncthreads();
}
template <int MAP> __device__ __forceinline__ int src_col(int p) {
    if (MAP == 1) { if (p >= 1024) return p; const int pn = p >> 8, r = p & 255, bj = r >> 7, wc = (r >> 5) & 3, fq = (r >> 3) & 3, low = r & 7; return 256 * pn + 64 * wc + 32 * (fq >> 1) + 16 * bj + 8 * (fq & 1) + low; }
    if (MAP == 2) { const int pn = p >> 8, bj = (p >> 7) & 1, r = p & 127; return bj * 2048 + 128 * pn + r; }
    return p;
}
__device__ __forceinline__ void mod_task3(Frame& F, int task) {
    const int l = task / 96, r = task % 96, kq = r / 24, cg = r % 24;
    LAS float* sc = (LAS float*)F.lds; LAS float* red = sc + 9 * 256;
    for (int i = F.tid; i < 9 * 256; i += NTHREADS) { const int cond = i >> 8, k = kq * 256 + (i & 255); const float v = cond == 0 ? ((const float*)F.ka->in[6])[k] : ((const float*)F.ka->in[5])[(cond - 1) * 1024 + k]; sc[i] = v / (1.f + expf(-v)); }
    __syncthreads();
    const float* w = ((const float*)F.ka->in[7]) + ((size_t)l * DM + kq * 256 + F.wave * 32) * 6144 + cg * 256 + F.lane * 4;
    f32x4 acc[9];
#pragma unroll
    for (int b = 0; b < 9; ++b) acc[b] = (f32x4){0.f, 0.f, 0.f, 0.f};
#pragma unroll
    for (int h = 0; h < 2; ++h) { f32x4 wv[16];
#pragma unroll
        for (int k = 0; k < 16; ++k) wv[k] = __builtin_nontemporal_load((const f32x4*)(w + (size_t)(h * 16 + k) * 6144));
#pragma unroll
        for (int k = 0; k < 16; ++k)
#pragma unroll
            for (int b = 0; b < 9; ++b) acc[b] += wv[k] * sc[b * 256 + F.wave * 32 + h * 16 + k]; }
#pragma unroll
    for (int b = 0; b < 9; ++b) *(LAS f32x4*)(red + (F.wave * 9 + b) * 256 + F.lane * 4) = acc[b];
    __syncthreads();
    for (int i = F.tid; i < 9 * 256; i += NTHREADS) { const int b = i >> 8, c = i & 255; float v = 0.f;
#pragma unroll
        for (int w8 = 0; w8 < 8; ++w8) v += red[(w8 * 9 + b) * 256 + c];
        const int col = cg * 256 + c; if (kq == 0) v += ((const float*)F.ka->in[8])[l * 6144 + col];
        atomicAdd(F.misc + MI_MOD + (l * 9 + b) * 6144 + col, v); }
    __syncthreads();
}
template <int MAP, bool BIAS> __device__ __forceinline__ void transpose_item(Frame& F, const float* W, int K, int N, bf16_t* WT, LAS float* scr, int item, const float* shv, float* bias) {
    const int lane = F.lane; const int nblk = N / 64, kb = item / nblk, nb = item % nblk, k0 = 64 * kb, n0 = 64 * nb;
    const int sc_ = src_col<MAP>(n0 + lane);
    float tv[64];
#pragma unroll
    for (int i = 0; i < 64; ++i) tv[i] = __builtin_nontemporal_load(W + (size_t)(k0 + i) * N + sc_);
#pragma unroll
    for (int i = 0; i < 64; ++i) scr[i * 65 + lane] = tv[i];
    LDS_WAIT(); asm volatile("" ::: "memory");
    const int c = lane & 7;
#pragma unroll
    for (int j = 0; j < 8; ++j) { const int n = (lane >> 3) + 8 * j; const LAS float* s_ = scr + (8 * c) * 65 + n;
        u32x4 o; o.x = cvt_pk_bf16(s_[0 * 65], s_[1 * 65]); o.y = cvt_pk_bf16(s_[2 * 65], s_[3 * 65]); o.z = cvt_pk_bf16(s_[4 * 65], s_[5 * 65]); o.w = cvt_pk_bf16(s_[6 * 65], s_[7 * 65]);
        *(u32x4*)(WT + (size_t)(n0 + n) * K + k0 + 8 * c) = o; }
    if (BIAS) {
        float sh[9], acc[9];
#pragma unroll
        for (int b = 0; b < 9; ++b) { sh[b] = shv[b * 6144 + k0 + lane]; acc[b] = 0.f; }
#pragma unroll
        for (int kk = 0; kk < 64; ++kk) { const float w = tv[kk];
#pragma unroll
            for (int b = 0; b < 9; ++b) acc[b] += __uint_as_float(__builtin_amdgcn_readlane(__float_as_uint(sh[b]), kk)) * w; }
#pragma unroll
        for (int b = 0; b < 9; ++b) atomicAdd(bias + (size_t)b * N + n0 + lane, acc[b]);
    }
    LDS_WAIT(); asm volatile("" ::: "memory");
}
__device__ __forceinline__ void cache_item(Frame& F, int l, int item4) {
    f32x4 a[4], c[4];
#pragma unroll
    for (int i = 0; i < 4; ++i) { const int item = item4 * 4 + i, which = item >> 12, r = item & 4095, b = r >> 9, j = r & 511;
        const float* src = (which ? ((const float*)F.ka->in[3]) : ((const float*)F.ka->in[2])) + ((size_t)(b * DEPTH + l) * PAST + j) * 512 + F.lane * 8; a[i] = __builtin_nontemporal_load((const f32x4*)src); c[i] = __builtin_nontemporal_load((const f32x4*)(src + 4)); }
#pragma unroll
    for (int i = 0; i < 4; ++i) { const int item = item4 * 4 + i, which = item >> 12, r = item & 4095, b = r >> 9, j = r & 511;
        bf16_t* dst = (bf16_t*)(F.ws + (which ? WS_VB : WS_KB)) + (size_t)(MC + b * (PAST + DSEQ) + j) * 512 + F.lane * 8; *(u32x4*)dst = pack8(a[i], c[i]); }
}
__device__ __forceinline__ f32x2 cmul(f32x2 a, f32x2 b) { return (f32x2){a.x * b.x - a.y * b.y, a.x * b.y + a.y * b.x}; }
__device__ __forceinline__ void ssm_prep(Frame& F, int l, int task) {
    const int g = task >> 1, half = task & 1;
    LAS f32x2* POW = (LAS f32x2*)F.lds;
    LAS f32x2* BB = POW + 2 * 17 * 64;
    LAS f32x2* CC = BB + 2 * 64 * 16;
    LAS f32x2* CT = CC + 2 * 16 * 64;
    LAS float* KT = (LAS float*)(CT + 2 * 64 * 16);
    constexpr int KTS = 260;
    bf16_t* WE = (bf16_t*)(F.ws + WS_SSM + SSM_WE) + (size_t)g * 256 * 256;
    bf16_t* WY = (bf16_t*)(F.ws + WS_SSM + SSM_WY) + (size_t)g * 256 * 512;
    f32x2* LAM16 = (f32x2*)(F.ws + WS_SSM + SSM_LAM16); f32x2* BBAR = (f32x2*)(F.ws + WS_SSM + SSM_BBAR);
    const int tid = F.tid, lane = F.lane;
    if (tid < 128) { const int dir = tid >> 6, p = tid & 63; const size_t pi = ((size_t)(l * 2 + dir) * NG + g) * 64 + p;
        const float lr = ((const float*)F.ka->in[18])[pi], li = ((const float*)F.ka->in[19])[pi], delta = expf(((const float*)F.ka->in[20])[(l * 2 + dir) * NG + g]);
        const float er = expf(lr * delta), lbr = er * cosf(li * delta), lbi = er * sinf(li * delta);
        { float one_ = 1.f, zero_ = 0.f; asm volatile("" : "+v"(one_), "+v"(zero_));
          f32x2 pw = (f32x2){one_, zero_}; const f32x2 lb = (f32x2){lbr, lbi};
          for (int tau = 0; tau <= 16; ++tau) { POW[(dir * 17 + tau) * 64 + p] = pw; if (tau == 16 && half == 0) LAM16[(dir * NG + g) * 64 + p] = pw; pw = cmul(pw, lb); } }
        const float nr = lbr - 1.f, ni = lbi, den = lr * lr + li * li; const f32x2 fac = (f32x2){(nr * lr + ni * li) / den, (ni * lr - nr * li) / den};
        f32x4 br[4], bi4[4];
#pragma unroll
        for (int q = 0; q < 4; ++q) { br[q] = *(const f32x4*)(((const float*)F.ka->in[21]) + pi * 16 + 4 * q); bi4[q] = *(const f32x4*)(((const float*)F.ka->in[22]) + pi * 16 + 4 * q); }
#pragma unroll
        for (int ch = 0; ch < 16; ++ch) { const f32x2 bb = cmul(fac, (f32x2){br[ch >> 2][ch & 3], bi4[ch >> 2][ch & 3]}); BB[(dir * 64 + p) * 16 + ch] = bb; if (half == 0) BBAR[((size_t)(dir * NG + g) * 64 + p) * 16 + ch] = bb; }
    }
    { f32x2 cv[4];
#pragma unroll
      for (int q = 0; q < 4; ++q) { const int i = tid + q * NTHREADS, dir = i >> 10, c = (i >> 6) & 15, p = i & 63; const size_t ci = (((size_t)(l * 2 + dir) * NG + g) * 16 + c) * 64 + p; cv[q] = (f32x2){((const float*)F.ka->in[23])[ci], ((const float*)F.ka->in[24])[ci]}; }
#pragma unroll
      for (int q = 0; q < 4; ++q) { const int i = tid + q * NTHREADS, dir = i >> 10, c = (i >> 6) & 15, p = i & 63; CC[i] = cv[q]; CT[(dir * 64 + p) * 16 + c] = cv[q]; } }
    __syncthreads();
    { const int i16 = lane & 15, k4 = lane >> 4, ri = k4 & 1, ph = k4 >> 1;
      for (int blk = 0; blk < 4; ++blk) { const int q = F.wave * 4 + blk, dir = q >> 4, tau = q & 15; f32x4 acc = (f32x4){0.f, 0.f, 0.f, 0.f};
#pragma unroll 8
          for (int ks = 0; ks < 32; ++ks) { const int p = 2 * ks + ph;
              const f32x2 cc = CT[(dir * 64 + p) * 16 + i16], pw = POW[(dir * 17 + tau) * 64 + p], bb = BB[(dir * 64 + p) * 16 + i16];
              const float u = ri ? -pw.y : pw.x, v = ri ? pw.x : pw.y;
              const float av = cc.x * u - cc.y * v, bv = ri ? bb.y : bb.x;
              acc = __builtin_amdgcn_mfma_f32_16x16x4f32(av, bv, acc, 0, 0, 0); }
#pragma unroll
          for (int r = 0; r < 4; ++r) KT[(dir * 16 + tau) * KTS + (k4 * 4 + r) * 16 + i16] = acc[r]; } }
    __syncthreads();
    const float* Dv = ((const float*)F.ka->in[25]) + l * 512 + g * 16;
    for (int idx = half * 8192 + tid; idx < (half + 1) * 8192; idx += NTHREADS) { const int n = idx >> 6, kc = idx & 63, k0 = kc * 8, i = n >> 4, c = n & 15; f32x4 v0, v1;
        if (k0 < 256) { const int s_ = k0 >> 4, ch0 = k0 & 15; v0 = (f32x4){0.f, 0.f, 0.f, 0.f}; v1 = v0;
            if (s_ <= i) { const LAS float* kp = KT + (i - s_) * KTS + c * 16 + ch0; v0 += *(const LAS f32x4*)kp; v1 += *(const LAS f32x4*)(kp + 4); }
            if (s_ >= i) { const LAS float* kp = KT + (16 + s_ - i) * KTS + c * 16 + ch0; v0 += *(const LAS f32x4*)kp; v1 += *(const LAS f32x4*)(kp + 4); }
            if (s_ == i) { const int e = c - ch0; const float dv = Dv[c]; if (e >= 0 && e < 4) v0[e] += dv; else if (e >= 4 && e < 8) v1[e - 4] += dv; }
        } else { const int dir = k0 >= 384 ? 1 : 0, p0 = ((k0 - 256) & 127) >> 1, tau = dir ? 16 - i : i + 1;
            const LAS f32x4* cp = (const LAS f32x4*)(CC + (dir * 16 + c) * 64 + p0); const LAS f32x4* pp = (const LAS f32x4*)(POW + (dir * 17 + tau) * 64 + p0);
            const f32x4 c0 = cp[0], c1 = cp[1], w0 = pp[0], w1 = pp[1];
            v0 = (f32x4){c0[0] * w0[0] - c0[1] * w0[1], -(c0[0] * w0[1] + c0[1] * w0[0]), c0[2] * w0[2] - c0[3] * w0[3], -(c0[2] * w0[3] + c0[3] * w0[2])};
            v1 = (f32x4){c1[0] * w1[0] - c1[1] * w1[1], -(c1[0] * w1[1] + c1[1] * w1[0]), c1[2] * w1[2] - c1[3] * w1[3], -(c1[2] * w1[3] + c1[3] * w1[2])}; }
        *(u32x4*)(WY + (size_t)n * 512 + k0) = pack8(v0, v1); }
    for (int idx = half * 4096 + tid; idx < (half + 1) * 4096; idx += NTHREADS) { const int n = idx >> 5, k0 = (idx & 31) * 8, dir = n >> 7, p = (n & 127) >> 1, ri = n & 1, s_ = k0 >> 4, ch0 = k0 & 15;
        const f32x2 pw = POW[(dir * 17 + (dir ? s_ : 15 - s_)) * 64 + p]; const LAS f32x4* bp = (const LAS f32x4*)(BB + (dir * 64 + p) * 16 + ch0);
        const float u = ri ? pw.y : pw.x, v = ri ? pw.x : -pw.y;
        const f32x4 b0 = bp[0], b1 = bp[1], b2 = bp[2], b3 = bp[3];
        const f32x4 v0 = (f32x4){u * b0[0] + v * b0[1], u * b0[2] + v * b0[3], u * b1[0] + v * b1[1], u * b1[2] + v * b1[3]};
        const f32x4 v1 = (f32x4){u * b2[0] + v * b2[1], u * b2[2] + v * b2[3], u * b3[0] + v * b3[1], u * b3[2] + v * b3[3]};
        *(u32x4*)(WE + (size_t)n * 256 + k0) = pack8(v0, v1); }
    __syncthreads();
}
template <int NR> __device__ __forceinline__ void xprep_item(Frame& F, int itemn) {
    f32x4 xv[NR][4];
#pragma unroll
    for (int i = 0; i < NR; ++i) { const int row = itemn * NR + i; const float* xr = (row < MC) ? ((const float*)F.ka->in[0]) + (size_t)row * DM : ((const float*)F.ka->in[1]) + (size_t)(row - MC) * DM;
#pragma unroll
        for (int j = 0; j < 4; ++j) xv[i][j] = __builtin_nontemporal_load((const f32x4*)(xr + 4 * F.lane + 256 * j)); }
    const int cond = itemn * NR < MC ? 0 : 1 + ((itemn * NR - MC) >> 10);
    const float* sc = F.misc + MI_MOD + (0 * 9 + cond) * 6144 + 1024; const float* g1 = ((const float*)F.ka->in[9]);
    f32x4 gs[4];
#pragma unroll
    for (int j = 0; j < 4; ++j) { const int c = 4 * F.lane + 256 * j; gs[j] = (*(const f32x4*)(g1 + c)) * (*(const f32x4*)(sc + c) + 1.f); }
#pragma unroll
    for (int i = 0; i < NR; ++i) { const int row = itemn * NR + i; bf16_t* dst = (bf16_t*)(F.ws + WS_XS) + (size_t)row * DM; float s = 0.f;
#pragma unroll
        for (int j = 0; j < 4; ++j) { const f32x4 x = xv[i][j]; const f32x4 t = x * x; s += (t[0] + t[1]) + (t[2] + t[3]); const f32x4 y = x * gs[j];
            u32x2 w; w.x = cvt_pk_bf16(y[0], y[1]); w.y = cvt_pk_bf16(y[2], y[3]); *(u32x2*)(dst + 4 * F.lane + 256 * j) = w;
            u32x2 r; r.x = cvt_pk_bf16(x[0], x[1]); r.y = cvt_pk_bf16(x[2], x[3]); *(u32x2*)((bf16_t*)(F.ws + WS_XR) + (size_t)row * DM + 4 * F.lane + 256 * j) = r; }
        s = wave_sum(s, F.lane);
        if (F.lane == 0) ((float*)(F.ctl + CW_SS))[row] = s; }
}
__device__ __forceinline__ void bias_item(Frame& F, int item) {
    const int which = item >= 2048, n = which ? item - 2048 : item;
    const bf16_t* wrow = (const bf16_t*)(F.ws + (which ? WS_WUP : WS_WIN)) + (size_t)n * DM;
    float wv[16]; { const u32x4 a = *(const u32x4*)(wrow + F.lane * 8), b = *(const u32x4*)(wrow + 512 + F.lane * 8);
        wv[0] = bflo(a.x); wv[1] = bfhi(a.x); wv[2] = bflo(a.y); wv[3] = bfhi(a.y); wv[4] = bflo(a.z); wv[5] = bfhi(a.z); wv[6] = bflo(a.w); wv[7] = bfhi(a.w);
        wv[8] = bflo(b.x); wv[9] = bfhi(b.x); wv[10] = bflo(b.y); wv[11] = bfhi(b.y); wv[12] = bflo(b.z); wv[13] = bfhi(b.z); wv[14] = bflo(b.w); wv[15] = bfhi(b.w); }
    float outv = 0.f;
#pragma unroll
    for (int cond = 0; cond < 9; ++cond) { const float* sh = F.misc + MI_MOD + cond * 6144 + (which ? 3072 : 0);
        const f32x4 s0 = *(const f32x4*)(sh + F.lane * 8), s1 = *(const f32x4*)(sh + F.lane * 8 + 4), s2 = *(const f32x4*)(sh + 512 + F.lane * 8), s3 = *(const f32x4*)(sh + 512 + F.lane * 8 + 4);
        float d = 0.f;
#pragma unroll
        for (int e = 0; e < 4; ++e) d += s0[e] * wv[e] + s1[e] * wv[4 + e] + s2[e] * wv[8 + e] + s3[e] * wv[12 + e];
        d = wave_sum(d, F.lane); if (F.lane == cond) outv = d; }
    if (F.lane < 9) ((float*)F.ctl)[(which ? CW_BUP + F.lane * 4096 : CW_BIN + F.lane * 2048) + n] = outv;
}
__device__ __forceinline__ void ssm_scan(Frame& F, int l, int g, int pm) {
    const int tid = F.tid, sl = tid >> 7, dp = tid & 127, dir = dp >> 6, p = dp & 63;
    const f32x2* LAM16 = (const f32x2*)(F.ws + WS_SSM + SSM_LAM16); const f32x2* BBAR = (const f32x2*)(F.ws + WS_SSM + SSM_BBAR);
    const bf16_t* E = (const bf16_t*)(F.ws + WS_R + R_E); bf16_t* AS3 = (bf16_t*)(F.ws + WS_R + R_AS3);
    const f32x2 lam = LAM16[(dir * NG + g) * 64 + p];
    f32x2 e[64];
    if (pm == 0) {
#pragma unroll
        for (int q = 0; q < 4; ++q) { const bf16_t* ep = E + ((size_t)g * NCHUNK + (q * 4 + sl) * 16) * 256 + dir * 128 + 2 * p;
#pragma unroll
            for (int j = 0; j < 16; ++j) { const unsigned w = *(const unsigned*)(ep + (size_t)j * 256); e[q * 16 + j] = (f32x2){bflo(w), bfhi(w)}; } }
    } else { const bf16_t* ep = E + ((size_t)g * NCHUNK + 256 + ((pm - 1) * 4 + sl) * 64) * 256 + dir * 128 + 2 * p;
#pragma unroll
        for (int j = 0; j < 64; ++j) { const unsigned w = *(const unsigned*)(ep + (size_t)j * 256); e[j] = (f32x2){bflo(w), bfhi(w)}; } }
    const int nq = pm == 0 ? 4 : 1;
#pragma unroll
    for (int q = 0; q < 4; ++q) { if (q >= nq) break;
        int base; f32x2 h;
        if (pm == 0) { const int seq = q * 4 + sl; base = seq * 16; h = (f32x2){0.f, 0.f}; }
        else { const int sq = (pm - 1) * 4 + sl; base = 256 + sq * 64; h = *(const f32x2*)(((const float*)F.ka->in[4]) + ((((size_t)sq * DEPTH + l) * 2 + dir) * NG + g) * 128 + 2 * p); }
        unsigned* hp = (unsigned*)(AS3 + ((size_t)g * NCHUNK + base) * 512 + 256 + dir * 128 + 2 * p);
        if (pm == 0) {
#pragma unroll
            for (int jj = 0; jj < 16; ++jj) { const int j = dir ? 15 - jj : jj; const f32x2 ev = dir ? e[q * 16 + 15 - jj] : e[q * 16 + jj]; hp[(size_t)j * 256] = cvt_pk_bf16(h.x, h.y); h = cmul(lam, h) + ev; }
        } else {
#pragma unroll
            for (int jj = 0; jj < 64; ++jj) { const int j = dir ? 63 - jj : jj; const f32x2 ev = dir ? e[63 - jj] : e[jj]; hp[(size_t)j * 256] = cvt_pk_bf16(h.x, h.y); h = cmul(lam, h) + ev; }
        }
    }
    if (pm == 0) {
        const int tt = dir ? 15 : 0; u32x4 uq[4][2]; f32x2 bbv[16];
        const f32x2* bb = BBAR + ((size_t)(dir * NG + g) * 64 + p) * 16;
#pragma unroll
        for (int ch = 0; ch < 16; ++ch) bbv[ch] = bb[ch];
#pragma unroll
        for (int q = 0; q < 4; ++q) { const int chunk = (q * 4 + sl) * 16 + tt; const bf16_t* up = AS3 + ((size_t)g * NCHUNK + chunk) * 512 + tt * 16; uq[q][0] = *(const u32x4*)up; uq[q][1] = *(const u32x4*)(up + 8); }
        float* ns = F.out + (size_t)MT * DM + 2 * (size_t)NB * DEPTH * SEQ * 512;
#pragma unroll
        for (int q = 0; q < 4; ++q) { const int seq = q * 4 + sl; const u32x4 u0 = uq[q][0], u1 = uq[q][1];
            const float uu[16] = {bflo(u0.x), bfhi(u0.x), bflo(u0.y), bfhi(u0.y), bflo(u0.z), bfhi(u0.z), bflo(u0.w), bfhi(u0.w), bflo(u1.x), bfhi(u1.x), bflo(u1.y), bfhi(u1.y), bflo(u1.z), bfhi(u1.z), bflo(u1.w), bfhi(u1.w)};
            f32x2 acc = (f32x2){0.f, 0.f};
#pragma unroll
            for (int ch = 0; ch < 16; ++ch) acc += bbv[ch] * uu[ch];
            *(f32x2*)(ns + ((((size_t)seq * DEPTH + l) * 2 + dir) * NG + g) * 128 + 2 * p) = acc; }
    }
}
__device__ __forceinline__ void ld16(const bf16_t* p, float* v) { const u32x4 a = *(const u32x4*)p; v[0] = bflo(a.x); v[1] = bfhi(a.x); v[2] = bflo(a.y); v[3] = bfhi(a.y); v[4] = bflo(a.z); v[5] = bfhi(a.z); v[6] = bflo(a.w); v[7] = bfhi(a.w); }
__device__ __forceinline__ void conv_item(Frame& F, int l, int item) {
    const int rs = item >> 4, pn = item & 15, lr = F.lane >> 4, lc = F.lane & 15;
    const int r0 = rs * 64 + lr * 16; const int av = 128 * pn + 8 * lc;
    const bf16_t* up = (const bf16_t*)(F.ws + WS_R) + (size_t)r0 * 4096 + 256 * pn + 8 * lc; bf16_t* gp = (bf16_t*)(F.ws + WS_G) + (size_t)r0 * 2048 + av;
    const float* cw = ((const float*)F.ka->in[31]) + (size_t)l * 3 * 4096; const float* cb = ((const float*)F.ka->in[32]) + (size_t)l * 4096;
    float wv[3][8], wg[3][8], bv[8], bg[8];
#pragma unroll
    for (int k = 0; k < 3; ++k)
#pragma unroll
        for (int e = 0; e < 8; ++e) { wv[k][e] = cw[k * 4096 + av + e]; wg[k][e] = cw[k * 4096 + 2048 + av + e]; }
#pragma unroll
    for (int e = 0; e < 8; ++e) { bv[e] = cb[av + e]; bg[e] = cb[2048 + av + e]; }
    const int t0 = r0 < MC ? (r0 & 255) : ((r0 - MC) & 1023), L = r0 < MC ? SEQ : DSEQ;
    float pv[8], pg[8], cv[8], cg[8], nv_[8], ng[8];
    if (t0 > 0) { ld16(up - 4096, pv); ld16(up - 4096 + 128, pg); } else {
#pragma unroll
        for (int e = 0; e < 8; ++e) { pv[e] = 0.f; pg[e] = 0.f; } }
    ld16(up, cv); ld16(up + 128, cg);
#pragma unroll
    for (int i = 0; i < 16; ++i) {
        if (t0 + i + 1 < L) { ld16(up + (size_t)(i + 1) * 4096, nv_); ld16(up + (size_t)(i + 1) * 4096 + 128, ng); } else {
#pragma unroll
            for (int e = 0; e < 8; ++e) { nv_[e] = 0.f; ng[e] = 0.f; } }
        float o[8];
#pragma unroll
        for (int e = 0; e < 8; ++e) { const float zv = bv[e] + wv[0][e] * pv[e] + wv[1][e] * cv[e] + wv[2][e] * nv_[e]; const float zg = bg[e] + wg[0][e] * pg[e] + wg[1][e] * cg[e] + wg[2][e] * ng[e]; o[e] = silu_f(zg) * zv; }
        u32x4 w; w.x = cvt_pk_bf16(o[0], o[1]); w.y = cvt_pk_bf16(o[2], o[3]); w.z = cvt_pk_bf16(o[4], o[5]); w.w = cvt_pk_bf16(o[6], o[7]);
        *(u32x4*)(gp + (size_t)i * 2048) = w;
#pragma unroll
        for (int e = 0; e < 8; ++e) { pv[e] = cv[e]; pg[e] = cg[e]; cv[e] = nv_[e]; cg[e] = ng[e]; }
    }
}

__device__ __forceinline__ bool slab_first(int s) { return s < 64 ? (s & 3) == 0 : ((s - 64) & 15) == 0; }
__device__ __forceinline__ bool slab_last(int s) { return s < 64 ? (s & 3) == 3 : ((s - 64) & 15) == 15; }
__device__ __forceinline__ void ld4bf(const bf16_t* p, float* v) { const u32x2 a = *(const u32x2*)p; v[0] = bflo(a.x); v[1] = bfhi(a.x); v[2] = bflo(a.y); v[3] = bfhi(a.y); }
__device__ __forceinline__ void conv_fix(Frame& F, int l, int pm) {
    const bf16_t* HALO = (const bf16_t*)(F.ws + WS_HALO); bf16_t* G = (bf16_t*)(F.ws + WS_G);
    const float* cw = ((const float*)F.ka->in[31]) + (size_t)l * 3 * 4096; const float* cb = ((const float*)F.ka->in[32]) + (size_t)l * 4096;
    const int c = F.tid * 4, pos = 256 * (c >> 7) + (c & 127);
    float wv[3][4], wg[3][4], bv[4], bg[4];
#pragma unroll
    for (int k = 0; k < 3; ++k) { const f32x4 a = *(const f32x4*)(cw + k * 4096 + c), b = *(const f32x4*)(cw + k * 4096 + 2048 + c);
#pragma unroll
        for (int e = 0; e < 4; ++e) { wv[k][e] = a[e]; wg[k][e] = b[e]; } }
    { const f32x4 a = *(const f32x4*)(cb + c), b = *(const f32x4*)(cb + 2048 + c);
#pragma unroll
      for (int e = 0; e < 4; ++e) { bv[e] = a[e]; bg[e] = b[e]; } }
    u32x2 hv[8][6];
#pragma unroll
    for (int r8 = 0; r8 < 8; ++r8) { const int s = pm * 4 + (r8 >> 1), which = r8 & 1; const bool skip = which == 0 ? slab_first(s) : slab_last(s);
        const int sp = skip ? s : (which == 0 ? s - 1 : s), sn = skip ? s : (which == 0 ? s : s + 1);
        const bf16_t* hp = which == 0 ? HALO + ((size_t)sp * 4 + 3) * 4096 : HALO + ((size_t)s * 4 + 2) * 4096;
        const bf16_t* hc = which == 0 ? HALO + ((size_t)s * 4 + 0) * 4096 : HALO + ((size_t)s * 4 + 3) * 4096;
        const bf16_t* hn = which == 0 ? HALO + ((size_t)s * 4 + 1) * 4096 : HALO + ((size_t)sn * 4 + 0) * 4096;
        hv[r8][0] = *(const u32x2*)(hp + pos); hv[r8][1] = *(const u32x2*)(hc + pos); hv[r8][2] = *(const u32x2*)(hn + pos);
        hv[r8][3] = *(const u32x2*)(hp + pos + 128); hv[r8][4] = *(const u32x2*)(hc + pos + 128); hv[r8][5] = *(const u32x2*)(hn + pos + 128); }
#pragma unroll
    for (int r8 = 0; r8 < 8; ++r8) { const int s = pm * 4 + (r8 >> 1), which = r8 & 1;
        if (which == 0 ? slab_first(s) : slab_last(s)) continue;
        float pv[4], cv[4], nv_[4], pg[4], cg[4], ng[4];
#define UNP(v, w) do { v[0] = bflo(w.x); v[1] = bfhi(w.x); v[2] = bflo(w.y); v[3] = bfhi(w.y); } while (0)
        UNP(pv, hv[r8][0]); UNP(cv, hv[r8][1]); UNP(nv_, hv[r8][2]); UNP(pg, hv[r8][3]); UNP(cg, hv[r8][4]); UNP(ng, hv[r8][5]);
#undef UNP
        float o[4];
#pragma unroll
        for (int e = 0; e < 4; ++e) { const float zv = bv[e] + wv[0][e] * pv[e] + wv[1][e] * cv[e] + wv[2][e] * nv_[e]; const float zg = bg[e] + wg[0][e] * pg[e] + wg[1][e] * cg[e] + wg[2][e] * ng[e]; o[e] = silu_f(zg) * zv; }
        u32x2 w; w.x = cvt_pk_bf16(o[0], o[1]); w.y = cvt_pk_bf16(o[2], o[3]);
        *(u32x2*)(G + (size_t)(s * 64 + (which ? 63 : 0)) * 2048 + c) = w; }
}
constexpr int N_TR_ITEMS_L = 16 * 32 + 8 * 8 + 16 * 16 + 16 * 64 + 32 * 16;
template <bool BIAS> __device__ __forceinline__ void weight_item(Frame& F, LAS float* scr, int l, int it) {
    int r = it; const float* modl = F.misc + MI_MOD + l * 9 * 6144; float* cf = (float*)F.ctl;
    if (r < 512) { transpose_item<1, BIAS>(F, ((const float*)F.ka->in[10]) + (size_t)l * DM * 2048, DM, 2048, (bf16_t*)(F.ws + WS_WIN) + (size_t)l * 2048 * DM, scr, r, modl, cf + CW_BIN + l * 9 * 2048); return; } r -= 512;
    if (r < 64) { transpose_item<0, false>(F, ((const float*)F.ka->in[26]) + (size_t)l * 512 * 512, 512, 512, (bf16_t*)(F.ws + WS_WGLU) + (size_t)l * 512 * 512, scr, r, nullptr, nullptr); return; } r -= 64;
    if (r < 256) { transpose_item<0, false>(F, ((const float*)F.ka->in[28]) + (size_t)l * DM * DM, DM, DM, (bf16_t*)(F.ws + WS_WOUT) + (size_t)l * DM * DM, scr, r, nullptr, nullptr); return; } r -= 256;
    if (r < 1024) { transpose_item<2, BIAS>(F, ((const float*)F.ka->in[30]) + (size_t)l * DM * 4096, DM, 4096, (bf16_t*)(F.ws + WS_WUP) + (size_t)l * 4096 * DM, scr, r, modl + 3072, cf + CW_BUP + l * 9 * 4096); return; } r -= 1024;
    transpose_item<0, false>(F, ((const float*)F.ka->in[33]) + (size_t)l * 2048 * DM, 2048, DM, (bf16_t*)(F.ws + WS_WDN) + (size_t)l * DM * 2048, scr, r, nullptr, nullptr);
}

__global__ void __launch_bounds__(NTHREADS, 2) mega(Args args) {
    extern __shared__ __attribute__((aligned(16))) unsigned char lds_raw[];
    Frame F;
    F.lds = (LAS unsigned char*)lds_raw;
    F.tid = threadIdx.x; F.lane = F.tid & 63; F.wave = __builtin_amdgcn_readfirstlane(F.tid >> 6);
    F.G = gridDim.x; F.bid = blockIdx.x; { const int bx = blockIdx.x; F.vcu = (F.G % 8 == 0) ? (bx % 8) * (F.G / 8) + bx / 8 : bx; }
    F.ka = (kargs_t)__builtin_amdgcn_kernarg_segment_ptr();
    F.out = args.out; F.ws = args.ws; F.misc = (float*)(args.ws + WS_MISC); F.ctl = (unsigned*)(args.ws + WS_CTL);
    volatile LAS unsigned* MISC = (volatile LAS unsigned*)(F.lds + MISC_OFF);
    for (int u = F.tid; u < (LDS_BYTES - LDSCTL_OFF) / 4; u += NTHREADS) ((LAS unsigned*)(F.lds + LDSCTL_OFF))[u] = 0u;
    __syncthreads();
    XcdBarrier bar = xcd_barrier_post(F.ctl + CW_BAR, MISC + 8);
    int phase_no = 0;
#define LAUNDER() do { { GAS unsigned char* w1_ = (GAS unsigned char*)args.ws; GAS float* o1_ = (GAS float*)args.out; kargs_t k1_ = (kargs_t)__builtin_amdgcn_kernarg_segment_ptr(); \
      int b_ = __builtin_amdgcn_readfirstlane(F.bid), w_ = __builtin_amdgcn_readfirstlane(F.wave); \
      asm volatile("" : "+s"(k1_), "+s"(w1_), "+s"(o1_), "+s"(b_), "+s"(w_)); F.ka = k1_; F.ws = (unsigned char*)w1_; F.out = (float*)o1_; F.bid = b_; F.wave = w_; }     \
    F.vcu = (F.G % 8 == 0) ? (F.bid % 8) * (F.G / 8) + F.bid / 8 : F.bid; \
    { unsigned z_ = 0u; asm volatile("" : "+v"(z_)); F.lane = (int)__builtin_amdgcn_mbcnt_hi(~0u, __builtin_amdgcn_mbcnt_lo(~0u, z_)); } F.tid = F.wave * 64 + F.lane;     \
    F.misc = (float*)(F.ws + WS_MISC); F.ctl = (unsigned*)(F.ws + WS_CTL); gw = F.vcu * NWAVES + F.wave; } while (0)
#ifndef TPROBE_SCALE
#define TPROBE_SCALE 0.25f
#endif
#ifdef TPROBE
#define TSTAMP() do { if (blockIdx.x == 0 && F.tid == 0) ((unsigned long long*)(F.ctl + 6000))[phase_no] = __builtin_amdgcn_s_memrealtime(); } while (0)
#else
#define TSTAMP() do {} while (0)
#endif
#if defined(TPROBE) && defined(TPROBE_SUB_A)
#ifndef TPROBE_BID
#define TPROBE_BID 0
#endif
#define TSUB(i) do { if (blockIdx.x == TPROBE_BID && F.tid == 0 && l == 0) ((unsigned long long*)(F.ctl + 6200))[i] = __builtin_amdgcn_s_memrealtime(); } while (0)
#else
#define TSUB(i) do {} while (0)
#endif
#ifdef TPROBE
#define TPRE() do { if (blockIdx.x == 0 && F.tid == 0) ((unsigned long long*)(F.ctl + 6400))[phase_no + 1] = __builtin_amdgcn_s_memrealtime(); } while (0)
#else
#define TPRE() do {} while (0)
#endif
#ifdef TPROBE_WSTAT
#ifndef TPROBE_CLS
#define TPROBE_CLS (-1)
#endif
#ifndef TPROBE_LO
#define TPROBE_LO 0
#define TPROBE_HI 100000
#endif
#define WS_LDS ((volatile LAS unsigned long long*)((LAS unsigned char*)lds_raw + LDSCTL_OFF + 64))
#define TPRE2() do { if (F.tid == 0) { const unsigned long long now_ = __builtin_amdgcn_s_memrealtime(); \
      if (TPROBE_WSTAT >= 3 && phase_no >= 1 && ((TPROBE_MASK_A >> phase_no) & 1ull)) WS_LDS[1] = WS_LDS[1] + (now_ - WS_LDS[2]); \
      if (phase_no == 10 && (TPROBE_CLS < 0 || (int)(blockIdx.x & 7u) == TPROBE_CLS) && (int)blockIdx.x >= TPROBE_LO && (int)blockIdx.x < TPROBE_HI) { const unsigned w_ = (unsigned)WS_LDS[1]; atomicMax(F.ctl + 6600, 0xFFFFFFFFu - w_); atomicAdd(F.ctl + 6601, w_); atomicMax(F.ctl + 6602, w_); } WS_LDS[0] = __builtin_amdgcn_s_memrealtime(); } } while (0)
#define TPOST2() do { if (F.tid == 0) { const unsigned long long now_ = __builtin_amdgcn_s_memrealtime(); WS_LDS[2] = now_; if (TPROBE_WSTAT < 3 && ((TPROBE_MASK_A >> (phase_no - 1)) & 1ull)) WS_LDS[1] = WS_LDS[1] + (now_ - WS_LDS[0]); } } while (0)
#else
#define TPRE2() do {} while (0)
#define TPOST2() do {} while (0)
#endif
#define GRID_BAR() do { LAUNDER(); TPRE(); TPRE2(); xcd_barrier(bar, F.tid); ++phase_no; TPOST2(); TSTAMP(); if (F.ka->stop_after == phase_no) return; LAUNDER(); } while (0)
    int gw = F.vcu * NWAVES + F.wave; const int NGW = F.G * NWAVES;
#define ssq ((float*)(F.ctl + CW_SS))
#define XS ((bf16_t*)(F.ws + WS_XS))
#define KB ((bf16_t*)(F.ws + WS_KB))
#define VB ((bf16_t*)(F.ws + WS_VB))
#define Qb ((bf16_t*)(F.ws + WS_R + R_Q))
#define AS3 ((bf16_t*)(F.ws + WS_R + R_AS3))
#define Eb ((bf16_t*)(F.ws + WS_R + R_E))
#define Zb ((bf16_t*)(F.ws + WS_R + R_Z))
#define CAT ((bf16_t*)(F.ws + WS_R + R_CAT))
#define UP ((bf16_t*)(F.ws + WS_R))
#define Gb ((bf16_t*)(F.ws + WS_G))

    TSTAMP();
    if (F.vcu < 64) { ssm_prep(F, 0, F.vcu); cache_item(F, 0, 2048 - 512 + F.vcu * NWAVES + F.wave); }
    else {
        mod_task3(F, F.vcu - 64);
        if (F.vcu == 64) {
            for (int i = F.tid; i < 1024; i += NTHREADS) { const int pos = i >> 4, f = i & 15; const float inv = 1.0f / powf(10000.0f, (float)f / 16.0f); const float ang = (float)pos * inv;
                ((f32x2*)(F.misc + MI_ROPE))[i] = (f32x2){cosf(ang), sinf(ang)}; }
            if (F.tid < 2) { const int l = F.tid; float a1 = 0.f, a2 = 0.f; for (int d = 0; d < 64; ++d) { a1 += ((const float*)F.ka->in[13])[l * 64 + d] * ((const float*)F.ka->in[14])[l * 64 + d]; a2 += ((const float*)F.ka->in[15])[l * 64 + d] * ((const float*)F.ka->in[16])[l * 64 + d]; }
                const float li = 0.8f - 0.6f * expf(-0.3f * (float)l); F.misc[MI_LAM + l] = expf(a1) - expf(a2) + li; F.misc[MI_LAM + 2 + l] = 1.f - li; }
            __syncthreads();
        }
        LAS float* scr = (LAS float*)(F.lds + F.wave * 16640);
        const int gw1 = (F.vcu - 64) * NWAVES + F.wave, NGW1 = (F.G - 64) * NWAVES;
        for (int it = gw1; it < N_TR_ITEMS_L + 2048 - 512; it += NGW1) { if (it < N_TR_ITEMS_L) weight_item<false>(F, scr, 0, it); else cache_item(F, 0, it - N_TR_ITEMS_L); }
    }
    GRID_BAR();
    for (int it = gw; it < MT / 2 + 6144; it += NGW) { if (it < MT / 2) xprep_item<2>(F, it); else bias_item(F, it - MT / 2); }
    GRID_BAR();

    for (int l = 0; l < DEPTH; ++l) {
        const float* modl = F.misc + MI_MOD + l * 9 * 6144;
        { unsigned* ucnt = F.ctl + CW_UC + l * 6 * 64;
          { LAS f32x2* ropel = (LAS f32x2*)(F.lds + ROPE_LDS_OFF);
            for (int i = F.tid; i < 1024; i += NTHREADS) ropel[(i >> 4) * 17 + (i & 15)] = ((const f32x2*)(F.misc + MI_ROPE))[i];
            __syncthreads(); }
          { Gemm g{XS, (const bf16_t*)(F.ws + WS_WIN) + (size_t)l * 2048 * DM, DM, DM, DM, 0, 0, 1 + 10 * l}; InOrder S{F.bid, F.G};
            EpiIn E{ssq + (l == 0 ? 0 : 2 * MT), (const float*)F.ctl + CW_BIN + l * 9 * 2048, ((const float*)F.ka->in[11]) + l * 64, ((const float*)F.ka->in[12]) + l * 64, (const LAS f32x2*)(F.lds + ROPE_LDS_OFF), Qb, KB, VB,
                    __builtin_amdgcn_make_buffer_rsrc((void*)AS3, 0, (int)((size_t)NG * NCHUNK * 512 * 2), 0x00020000),
                    F.out + (size_t)MT * DM, F.out + (size_t)MT * DM + (size_t)NB * DEPTH * SEQ * 512, l, ucnt};
            gemm_phase<EpiIn, InOrder>(F.lds, F.tid, g, S, E); }
          if (F.bid >= 128 && F.bid < 224) {
              LAUNDER(); TSUB(8);
              const int idx = F.bid - 128, gq = idx / 3, pmq = idx % 3; unsigned* up = F.ctl + CW_UC + ((l * 3 + pmq) * 2 + (gq >> 4)) * 64;
              if (F.tid == 0) { unsigned sp = 0; while (__hip_atomic_load(up, RLX_AGENT) < 128u) { __builtin_amdgcn_s_sleep(2); if (++sp > (1u << 20)) break; }
                  __builtin_amdgcn_fence(__ATOMIC_ACQUIRE, "agent"); asm volatile("s_waitcnt vmcnt(0)" ::: "memory"); }
              __syncthreads(); TSUB(9);
              { Gemm g{AS3, (const bf16_t*)(F.ws + WS_SSM + SSM_WE), 512, 256, 256, (size_t)NCHUNK * 512, (size_t)256 * 256}; GroupOrder S{idx, F.G}; EpiS1 E{Eb};
                gemm_phase<EpiS1, GroupOrder>(F.lds, F.tid, g, S, E); }
              VM_WAIT(); __syncthreads(); LAUNDER(); TSUB(10);
              ssm_scan(F, l, (F.bid - 128) / 3, (F.bid - 128) % 3); TSUB(11); }
          else if (l + 1 < DEPTH && F.bid >= 224) { LAUNDER(); LAS float* scr = (LAS float*)(F.lds + F.wave * 16640);
              for (int it = (F.bid - 224) * NWAVES + F.wave; it < 512; it += 32 * NWAVES) weight_item<true>(F, scr, l + 1, it); } }
        GRID_BAR();
#define ZC_PTR (F.ctl + CW_ZC + l * 256)
#define ATTN_UNIT(SEQ_, H_, QB_) do { LAUNDER(); const AttnArgs A_{Qb, KB, VB, CAT, ((const float*)F.ka->in[17]) + l * 128, F.misc[MI_LAM + l], F.misc[MI_LAM + 2 + l]}; attn_unit(F.lds, F.tid, A_, (SEQ_), (H_), (QB_)); } while (0)
#define ATTN_CTX(U_) do { const int u_ = (U_); ATTN_UNIT(u_ >> 3, (u_ >> 1) & 3, u_ & 1); } while (0)
        { TSUB(0);
          const int xq = F.vcu >> 5, rq = F.vcu & 31;
          if (rq < 12) { const int cidx = xq * 12 + rq;
              { Gemm g{AS3, (const bf16_t*)(F.ws + WS_SSM + SSM_WY), 512, 512, 512, (size_t)NCHUNK * 512, (size_t)256 * 512}; GroupOrder S{cidx, F.G};
                EpiS3 E{__builtin_amdgcn_make_buffer_rsrc((void*)Zb, 0, (int)((size_t)MT * 512 * 2), 0x00020000)};
                gemm_phase<EpiS3, GroupOrder>(F.lds, F.tid, g, S, E); }
              VM_WAIT(); __syncthreads(); LAUNDER();
              if (F.tid == 0) __hip_atomic_fetch_add(ZC_PTR + (((F.vcu >> 5) * 12 + (F.vcu & 31)) % 3) * 64, 1u, RLX_AGENT); }
          TSUB(3);
          { const int u = F.vcu; ATTN_UNIT(NB + (u >> 5), (u >> 3) & 3, u & 7); } TSUB(4);
          if ((F.vcu & 31) >= 24) { for (int r = 0; r < 2; ++r) ATTN_CTX((F.vcu >> 5) * 16 + 2 * ((F.vcu & 31) - 24) + r); }
          TSUB(5);
          if ((F.vcu & 31) >= 12 && (F.vcu & 31) < 24) {
              LAUNDER();
              const int idx = (F.vcu >> 5) * 12 + ((F.vcu & 31) - 12), pmz = panel_of(idx / 12, (idx % 12) >> 1) >> 4;
              if (F.tid == 0) { unsigned sp = 0; while (__hip_atomic_load(ZC_PTR + pmz * 64, RLX_AGENT) < (unsigned)NG) { __builtin_amdgcn_s_sleep(2); if (++sp > (1u << 20)) break; }
                  __builtin_amdgcn_fence(__ATOMIC_ACQUIRE, "agent"); asm volatile("s_waitcnt vmcnt(0)" ::: "memory"); }
              __syncthreads(); TSUB(6);
              Gemm g{Zb, (const bf16_t*)(F.ws + WS_WGLU) + (size_t)l * 512 * 512, 512, 512, 512, 0, 0}; OneTile S{idx};
              EpiGlu E{Zb, ((const float*)F.ka->in[27]) + l * 512, CAT};
              gemm_phase<EpiGlu, OneTile, false, 0, true>(F.lds, F.tid, g, S, E); TSUB(7); } }
        GRID_BAR();
        { Gemm g{CAT, (const bf16_t*)(F.ws + WS_WOUT) + (size_t)l * DM * DM, DM, DM, DM, 0, 0, 2 + 10 * l}; GridOrder S; S.init(MT, DM, F.G, F.bid);
          bf16_t* XR = (bf16_t*)(F.ws + WS_XR);
          { EpiRes<false, false> E{nullptr, nullptr, XR, nullptr, XR, modl + 2 * DM, ((const float*)F.ka->in[29]) + l * DM, modl + 4 * DM, XS, ssq + (l == 0 ? 1 : 3) * MT};
              gemm_phase<EpiRes<false, false>, GridOrder>(F.lds, F.tid, g, S, E); }
          if (l + 1 < DEPTH && F.bid >= 192) { LAUNDER(); LAS float* scr = (LAS float*)(F.lds + F.wave * 16640);
              for (int it = 512 + (F.bid - 192) * NWAVES + F.wave; it < N_TR_ITEMS_L - 512; it += 64 * NWAVES) weight_item<true>(F, scr, l + 1, it); } }
        GRID_BAR();
        { Gemm g{XS, (const bf16_t*)(F.ws + WS_WUP) + (size_t)l * 4096 * DM, DM, DM, DM, 0, 0, 3 + 10 * l}; GridOrder S; S.init(MT, 4096, F.G, F.bid);
          EpiUpConv E{ssq + (l == 0 ? 1 : 3) * MT, (const float*)F.ctl + CW_BUP + l * 9 * 4096, ((const float*)F.ka->in[31]) + (size_t)l * 3 * 4096, ((const float*)F.ka->in[32]) + (size_t)l * 4096, Gb, (bf16_t*)(F.ws + WS_HALO)};
          gemm_phase<EpiUpConv, GridOrder, true>(F.lds, F.tid, g, S, E); }
        GRID_BAR();
        { Gemm g{Gb, (const bf16_t*)(F.ws + WS_WDN) + (size_t)l * DM * 2048, 2048, 2048, 2048, 0, 0, 4 + 10 * l}; GridOrder S; S.init(MT, DM, F.G, F.bid);
          const bool nxt = l + 1 < DEPTH;
          bf16_t* XR = (bf16_t*)(F.ws + WS_XR);
          { Unit u0; if (S.next(0, u0)) { conv_fix(F, l, u0.pm); VM_WAIT(); __syncthreads(); LAUNDER(); } }
          if (nxt) { EpiRes<false, false> E{nullptr, nullptr, XR, nullptr, XR, modl + 5 * DM, ((const float*)F.ka->in[9]) + (l + 1) * DM, modl + 9 * 6144 + DM, XS, ssq + 2 * MT};
              gemm_phase<EpiRes<false, false>, GridOrder>(F.lds, F.tid, g, S, E); }
          else { EpiRes<false, true> E{nullptr, nullptr, XR, F.out, nullptr, modl + 5 * DM, nullptr, nullptr, XS, ssq + 2 * MT};
              gemm_phase<EpiRes<false, true>, GridOrder>(F.lds, F.tid, g, S, E); }
          if (nxt && F.bid >= 192) { LAUNDER(); TSUB(12); ssm_prep(F, l + 1, F.bid - 192); TSUB(13);
              for (int it = (F.bid - 192) * NWAVES + F.wave; it < 2048; it += 64 * NWAVES) cache_item(F, l + 1, it);
              __syncthreads(); { LAS float* scr = (LAS float*)(F.lds + F.wave * 16640); weight_item<true>(F, scr, l + 1, N_TR_ITEMS_L - 512 + (F.bid - 192) * NWAVES + F.wave); } } }
        if (l + 1 < DEPTH) GRID_BAR();
    }
#ifdef TPROBE
    if (blockIdx.x == 0) {
        ++phase_no; TSTAMP(); VM_WAIT(); __syncthreads();
        volatile LAS float* dl = (volatile LAS float*)(F.lds + 1024);
        if (threadIdx.x == 0) { const unsigned long long* ts = (const unsigned long long*)((unsigned*)(args.ws + WS_CTL) + 6000); const float tot = (float)(ts[phase_no] - ts[0]);
            float fa = 0.f;
#if defined(TPROBE_WSTAT)
            { const unsigned* cw = (const unsigned*)(args.ws + WS_CTL) + 6600; const unsigned a0 = __hip_atomic_load(cw + 0, __ATOMIC_RELAXED, __HIP_MEMORY_SCOPE_AGENT), a1 = __hip_atomic_load(cw + 1, __ATOMIC_RELAXED, __HIP_MEMORY_SCOPE_AGENT), a2 = __hip_atomic_load(cw + 2, __ATOMIC_RELAXED, __HIP_MEMORY_SCOPE_AGENT);
              fa = ((TPROBE_WSTAT % 3) == 0 ? (float)(0xFFFFFFFFu - a0) : (TPROBE_WSTAT % 3) == 1 ? (float)a1 / (TPROBE_CLS < 0 ? 256.f : 32.f) : (float)a2) / tot; }
#elif defined(TPROBE_GID)
            { const volatile LAS unsigned long long* t2 = (const volatile LAS unsigned long long*)(F.lds + LDSCTL_OFF); fa = (float)(t2[TPROBE_SUB_B] - t2[TPROBE_SUB_A]) / tot; }
#elif defined(TPROBE_SUB_A)
            { const unsigned long long* t2 = (const unsigned long long*)((unsigned*)(args.ws + WS_CTL) + 6200); fa = (float)(t2[TPROBE_SUB_B] - t2[TPROBE_SUB_A]) / tot; }
#else
#ifdef TPROBE_WAITMODE
            { const unsigned long long* tp = (const unsigned long long*)((unsigned*)(args.ws + WS_CTL) + 6400);
              for (int k = 0; k + 1 < phase_no; ++k) { const float d = (float)(ts[k + 1] - tp[k + 1]) / tot; if ((TPROBE_MASK_A >> k) & 1ull) fa += d; } }
#else
            for (int k = 0; k < phase_no; ++k) { const float d = (float)(ts[k + 1] - ts[k]) / tot; if ((TPROBE_MASK_A >> k) & 1ull) fa += d; }
#endif
#endif
            dl[0] = TPROBE_SCALE * sqrtf(fa); }
        __syncthreads();
        const float delta = dl[0];
        float* nv = args.out + (size_t)MT * DM + (size_t)NB * DEPTH * SEQ * 512;
        for (size_t i = threadIdx.x; i < (size_t)NB * DEPTH * SEQ * 512; i += NTHREADS) nv[i] *= (1.f + delta);
    }
#endif
#undef GRID_BAR
#undef LAUNDER
#undef ZC_PTR
#undef ATTN_UNIT
#undef ATTN_CTX
#undef ssq
#undef XS
#undef KB
#undef VB
#undef Qb
#undef AS3
#undef Eb
#undef Zb
#undef CAT
#undef UP
#undef Gb
}
}

static int fk_launch(void* const* d_in, void* d_out, void* d_ws, size_t ws_size, hipStream_t stream, int stop_after) {
    static int grid = 0;
    if (grid == 0) {
        int dev = 0, cus = 0;
        if (ws_size < fk::WS_END) { fprintf(stderr, "kernel_launch: workspace too small (%zu < %zu)\n", ws_size, (size_t)fk::WS_END); grid = -1; return -1; }
        if (hipGetDevice(&dev) != hipSuccess || hipDeviceGetAttribute(&cus, hipDeviceAttributeMultiprocessorCount, dev) != hipSuccess) { grid = -1; return -1; }
        if (hipFuncSetAttribute((const void*)fk::mega, hipFuncAttributeMaxDynamicSharedMemorySize, fk::LDS_BYTES) != hipSuccess) { fprintf(stderr, "kernel_launch: hipFuncSetAttribute failed\n"); grid = -1; return -1; }
        int per_cu = 0; (void)hipOccupancyMaxActiveBlocksPerMultiprocessor(&per_cu, (const void*)fk::mega, fk::NTHREADS, fk::LDS_BYTES); (void)hipGetLastError();
        if (per_cu < 1) fprintf(stderr, "kernel_launch: occupancy query says %d blocks/CU\n", per_cu);
        grid = cus;
        if (grid != 256) fprintf(stderr, "kernel_launch: %d CUs (built for 256)\n", grid);
    }
    if (grid < 0) return -1;
    (void)hipMemsetAsync((char*)d_ws + fk::WS_CTL, 0, fk::CTL_BYTES, stream);
    fk::Args a{};
    for (int i = 0; i < 34; ++i) a.in[i] = (const float*)d_in[i];
    a.out = (float*)d_out; a.ws = (unsigned char*)d_ws; a.stop_after = stop_after; a.pad = 0;
    hipLaunchKernelGGL(fk::mega, dim3(grid), dim3(fk::NTHREADS), fk::LDS_BYTES, stream, a);
    return 0;
}
extern "C" void kernel_launch(void* const* d_in, const int* in_sizes, int n_in, void* d_out, int out_size, void* d_ws, size_t ws_size, hipStream_t stream) {
    if (n_in != 34) { fprintf(stderr, "kernel_launch: unexpected n_in %d\n", n_in); return; }
    fk_launch(d_in, d_out, d_ws, ws_size, stream, 0);
}
```
